# Optimizing an MI355X kernel written in HIP

```python
import math
import jax, jax.numpy as jnp
from jax import lax
import numpy as np

D_MODEL = 1024
BATCH = 4
SEQ = 8192
DEPTH = 1

D_MIX = D_MODEL
HG_HEADS = 4
HG_DK = 128
HG_DV = 128
HG_CHUNK = 64
HG_WIDTH = HG_HEADS * HG_DV
NSA_HEADS = 8
NSA_KV_HEADS = 2
NSA_HD = 64
NSA_WIDTH = NSA_HEADS * NSA_HD
NSA_KVW = NSA_KV_HEADS * NSA_HD
CMP_LEN = 32
CMP_STRIDE = 16
CMP_HIDDEN = 256
SLC_LEN = 64
SLC_TOPK = 16
WIN = 512
Q_BLOCK = 128
FORCE_SCORE = 1.0e4
PEER_HEADS = 8
PEER_DQ = 256
PEER_NKEYS = 128
PEER_TOPK = 16
PEER_N_EXPERTS = PEER_NKEYS * PEER_NKEYS
PEER_TOK_BLOCK = 128
DN_ALPHA = (2.0 * DEPTH) ** 0.25
DN_BETA = (8.0 * DEPTH) ** -0.25
LN_EPS = 1e-5
NEG = -1e30
IN_SPLITS = (HG_HEADS * HG_DK, HG_HEADS * HG_DK, HG_HEADS * HG_DV, HG_WIDTH,
             NSA_WIDTH, NSA_KVW, NSA_KVW, NSA_KVW, NSA_KVW, NSA_KVW, NSA_KVW, NSA_HEADS * 3)
D_IN = sum(IN_SPLITS)

kernel_name = "hybrid_hgrn2_nsa_peer_deepnorm"


def _layernorm(t, g, b):
    t32 = t.astype(jnp.float32)
    mu = jnp.mean(t32, -1, keepdims=True)
    var = jnp.mean(jnp.square(t32 - mu), -1, keepdims=True)
    return ((t32 - mu) * lax.rsqrt(var + LN_EPS) * g + b).astype(t.dtype)


def _masked_softmax(s, mask):
    s = jnp.where(mask, s.astype(jnp.float32), NEG)
    m = jnp.max(s, axis=-1, keepdims=True)
    p = jnp.where(mask, jnp.exp(s - m), 0.0)
    return p / jnp.maximum(jnp.sum(p, -1, keepdims=True), 1e-30)


def _hgrn2(q, f_logit, i_val, g, lb, norm_g):
    B, S, _ = q.shape
    f32 = jnp.float32
    f = lb + (1.0 - lb) * jax.nn.sigmoid(f_logit.astype(f32))
    logf = jnp.log(f)
    k = 1.0 - f
    n_chunks = S // HG_CHUNK

    def to_chunks(t, d):
        return t.astype(f32).reshape(B, n_chunks, HG_CHUNK, HG_HEADS, d).transpose(1, 0, 3, 2, 4)

    qc, kc, lfc = to_chunks(q, HG_DK), to_chunks(k, HG_DK), to_chunks(logf, HG_DK)
    vc = to_chunks(i_val, HG_DV)
    causal = jnp.tril(jnp.ones((HG_CHUNK, HG_CHUNK), bool))[None, None, :, :, None]

    def chunk_step(state, inp):
        q_, k_, v_, lf = inp
        b = jnp.cumsum(lf, axis=2)
        o_inter = jnp.einsum('bhtd,bhde->bhte', q_ * jnp.exp(b), state)
        diff = b[:, :, :, None, :] - b[:, :, None, :, :]
        decay = jnp.exp(jnp.where(causal, diff, -jnp.inf))
        a = jnp.einsum('bhtd,bhsd,bhtsd->bhts', q_, k_, decay)
        o_intra = jnp.einsum('bhts,bhse->bhte', a, v_)
        b_last = b[:, :, -1:, :]
        new_state = (jnp.exp(b_last[:, :, 0, :])[..., None] * state
                     + jnp.einsum('bhsd,bhse->bhde', k_ * jnp.exp(b_last - b), v_))
        return new_state, o_inter + o_intra

    s0 = jnp.zeros((B, HG_HEADS, HG_DK, HG_DV), f32)
    _, o = lax.scan(chunk_step, s0, (qc, kc, vc, lfc))
    o = o.transpose(1, 0, 3, 2, 4).reshape(B, S, HG_HEADS, HG_DV)
    o = o * lax.rsqrt(jnp.mean(o * o, -1, keepdims=True) + LN_EPS) * norm_g
    return o.reshape(B, S, HG_WIDTH) * jax.nn.silu(g.astype(f32))


def _compress(kv, pe, w1, b1, w2, b2):
    B, S = kv.shape[0], kv.shape[1]
    nb = (S - CMP_LEN) // CMP_STRIDE + 1
    idx = np.arange(nb)[:, None] * CMP_STRIDE + np.arange(CMP_LEN)[None, :]
    blocks = kv[:, idx] + pe[:, None, :]
    blocks = blocks.transpose(0, 1, 3, 2, 4).reshape(B, nb, NSA_KV_HEADS, CMP_LEN * NSA_HD)
    h = jax.nn.gelu(blocks @ w1 + b1)
    return h @ w2 + b2


def _nsa(q, k_c, v_c, k_s, v_s, k_w, v_w, gate_logit, cmpk, cmpv):
    B, S, _ = q.shape
    G = NSA_HEADS // NSA_KV_HEADS
    scale = NSA_HD ** -0.5
    q = q.reshape(B, S, NSA_KV_HEADS, G, NSA_HD)
    kvr = lambda t: t.reshape(B, S, NSA_KV_HEADS, NSA_HD)
    kc = _compress(kvr(k_c), *cmpk)
    vc = _compress(kvr(v_c), *cmpv)
    nb = kc.shape[1]
    cmp_start = np.arange(nb) * CMP_STRIDE
    cmp_end = jnp.asarray(cmp_start + CMP_LEN - 1, jnp.int32)
    n_slc = S // SLC_LEN
    topk = min(SLC_TOPK, n_slc)
    sel_start = np.arange(n_slc) * SLC_LEN
    ov = np.clip(np.minimum(cmp_start[:, None] + CMP_LEN, sel_start[None, :] + SLC_LEN)
                 - np.maximum(cmp_start[:, None], sel_start[None, :]), 0, None) / CMP_LEN
    overlap = jnp.asarray(ov, jnp.float32)
    ks_blocks = kvr(k_s).reshape(B, n_slc, SLC_LEN, NSA_KV_HEADS, NSA_HD).transpose(0, 3, 1, 2, 4)
    vs_blocks = kvr(v_s).reshape(B, n_slc, SLC_LEN, NSA_KV_HEADS, NSA_HD).transpose(0, 3, 1, 2, 4)
    pad = ((0, 0), (WIN, 0), (0, 0), (0, 0))
    kw_pad = jnp.pad(kvr(k_w), pad)
    vw_pad = jnp.pad(kvr(v_w), pad)
    gates = jax.nn.sigmoid(gate_logit.astype(jnp.float32)).reshape(B, S, NSA_KV_HEADS, G, 3)
    gather = jax.vmap(jax.vmap(lambda blk, ix: blk[ix]))
    blk_ids = jnp.arange(n_slc)

    def block_step(qb):
        t0 = qb * Q_BLOCK
        pos = t0 + jnp.arange(Q_BLOCK)
        qq = lax.dynamic_slice_in_dim(q, t0, Q_BLOCK, axis=1) * scale
        s_c = jnp.einsum('btgrd,bngd->bgrtn', qq, kc)
        p_c = _masked_softmax(s_c, cmp_end[None, :] <= pos[:, None])
        o_c = jnp.einsum('bgrtn,bngd->btgrd', p_c, vc)
        imp = jnp.einsum('bgrtn,nj->bgtj', p_c, overlap)
        cur = pos // SLC_LEN
        forced = (blk_ids[None, :] == 0) | (blk_ids[None, :] == cur[:, None]) | (blk_ids[None, :] == cur[:, None] - 1)
        causal_blk = blk_ids[None, :] * SLC_LEN <= pos[:, None]
        score = jnp.where(forced, FORCE_SCORE, jnp.where(causal_blk, imp, -1.0))
        _, idx = lax.top_k(score, topk)
        kg = gather(ks_blocks, idx).reshape(B, NSA_KV_HEADS, Q_BLOCK, topk * SLC_LEN, NSA_HD)
        vg = gather(vs_blocks, idx).reshape(B, NSA_KV_HEADS, Q_BLOCK, topk * SLC_LEN, NSA_HD)
        key_pos = (idx[..., None] * SLC_LEN + jnp.arange(SLC_LEN)).reshape(B, NSA_KV_HEADS, Q_BLOCK, topk * SLC_LEN)
        s_s = jnp.einsum('btgrd,bgtkd->bgrtk', qq, kg)
        p_s = _masked_softmax(s_s, (key_pos <= pos[None, None, :, None])[:, :, None])
        o_s = jnp.einsum('bgrtk,bgtkd->btgrd', p_s, vg)
        kw = lax.dynamic_slice_in_dim(kw_pad, t0, WIN + Q_BLOCK, axis=1)
        vw = lax.dynamic_slice_in_dim(vw_pad, t0, WIN + Q_BLOCK, axis=1)
        key_w = t0 - WIN + jnp.arange(WIN + Q_BLOCK)
        delta = pos[:, None] - key_w[None, :]
        m_w = (delta >= 0) & (delta < WIN) & (key_w[None, :] >= 0)
        s_w = jnp.einsum('btgrd,bsgd->bgrts', qq, kw)
        p_w = _masked_softmax(s_w, m_w)
        o_w = jnp.einsum('bgrts,bsgd->btgrd', p_w, vw)
        gt = lax.dynamic_slice_in_dim(gates, t0, Q_BLOCK, axis=1)
        o = gt[..., 0:1] * o_c + gt[..., 1:2] * o_s + gt[..., 2:3] * o_w
        return o.reshape(B, Q_BLOCK, NSA_WIDTH)

    out = lax.map(block_step, jnp.arange(S // Q_BLOCK))
    return out.transpose(1, 0, 2, 3).reshape(B, S, NSA_WIDTH)


def _peer(x, w_q, sub_k1, sub_k2, u, v):
    B, S, D = x.shape
    n = B * S
    xf = x.reshape(n, D)
    half = PEER_DQ // 2
    q = (xf @ w_q).reshape(n, PEER_HEADS, PEER_DQ)
    s1 = jnp.einsum('nhd,kd->nhk', q[..., :half], sub_k1).astype(jnp.float32)
    s2 = jnp.einsum('nhd,kd->nhk', q[..., half:], sub_k2).astype(jnp.float32)
    v1, i1 = lax.top_k(s1, PEER_TOPK)
    v2, i2 = lax.top_k(s2, PEER_TOPK)
    cand = (v1[..., :, None] + v2[..., None, :]).reshape(n, PEER_HEADS, PEER_TOPK * PEER_TOPK)
    top_s, top_c = lax.top_k(cand, PEER_TOPK)
    e1 = jnp.take_along_axis(i1, top_c // PEER_TOPK, axis=-1)
    e2 = jnp.take_along_axis(i2, top_c % PEER_TOPK, axis=-1)
    hk = PEER_HEADS * PEER_TOPK
    experts = (e1 * PEER_NKEYS + e2).reshape(n, hk)
    gate = jax.nn.softmax(top_s, axis=-1).reshape(n, hk)
    nblk = n // PEER_TOK_BLOCK

    def block_step(args):
        xb, eb, gb = args
        h = jnp.einsum('tkd,td->tk', u[eb], xb)
        w = gb * jax.nn.gelu(h.astype(jnp.float32))
        return jnp.einsum('tk,tkd->td', w, v[eb])

    out = lax.map(block_step, (xf.reshape(nblk, PEER_TOK_BLOCK, D),
                               experts.reshape(nblk, PEER_TOK_BLOCK, hk),
                               gate.reshape(nblk, PEER_TOK_BLOCK, hk)))
    return out.reshape(B, S, D).astype(x.dtype)


def setup_inputs(seed: int = 0) -> dict:
    key = jax.random.key(seed)
    ks = jax.random.split(key, 24)
    nrm = lambda k, shape, s: jax.random.normal(k, shape, jnp.float32) * s
    L = DEPTH
    return {
        'x': nrm(ks[0], (BATCH, SEQ, D_MODEL), 1.0),
        'w_in': nrm(ks[1], (L, D_MODEL, D_IN), D_MODEL ** -0.5),
        'w_out': nrm(ks[2], (L, D_MIX, D_MODEL), D_MIX ** -0.5 * DN_BETA),
        'hg_lb': nrm(ks[3], (L + 1, HG_HEADS * HG_DK), 0.3),
        'hg_norm_g': 1.0 + nrm(ks[4], (L, HG_DV), 0.02),
        'cmpk_pe': nrm(ks[5], (L, CMP_LEN, NSA_HD), 0.1),
        'cmpk_w1': nrm(ks[6], (L, CMP_LEN * NSA_HD, CMP_HIDDEN), (CMP_LEN * NSA_HD) ** -0.5),
        'cmpk_b1': nrm(ks[7], (L, CMP_HIDDEN), 0.01),
        'cmpk_w2': nrm(ks[8], (L, CMP_HIDDEN, NSA_HD), CMP_HIDDEN ** -0.5),
        'cmpk_b2': nrm(ks[9], (L, NSA_HD), 0.01),
        'cmpv_pe': nrm(ks[10], (L, CMP_LEN, NSA_HD), 0.1),
        'cmpv_w1': nrm(ks[11], (L, CMP_LEN * NSA_HD, CMP_HIDDEN), (CMP_LEN * NSA_HD) ** -0.5),
        'cmpv_b1': nrm(ks[12], (L, CMP_HIDDEN), 0.01),
        'cmpv_w2': nrm(ks[13], (L, CMP_HIDDEN, NSA_HD), CMP_HIDDEN ** -0.5),
        'cmpv_b2': nrm(ks[14], (L, NSA_HD), 0.01),
        'ln1_g': 1.0 + nrm(ks[15], (L, D_MODEL), 0.02),
        'ln1_b': nrm(ks[16], (L, D_MODEL), 0.01),
        'peer_wq': nrm(ks[17], (L, D_MODEL, PEER_HEADS * PEER_DQ), D_MODEL ** -0.5),
        'peer_k1': nrm(ks[18], (L, PEER_NKEYS, PEER_DQ // 2), (PEER_DQ // 2) ** -0.5),
        'peer_k2': nrm(ks[19], (L, PEER_NKEYS, PEER_DQ // 2), (PEER_DQ // 2) ** -0.5),
        'peer_u': nrm(ks[20], (L, PEER_N_EXPERTS, D_MODEL), D_MODEL ** -0.5),
        'peer_v': nrm(ks[21], (L, PEER_N_EXPERTS, D_MODEL), DN_BETA),
        'ln2_g': 1.0 + nrm(ks[22], (L, D_MODEL), 0.02),
        'ln2_b': nrm(ks[23], (L, D_MODEL), 0.01),
    }


def reference(x, w_in, w_out, hg_lb, hg_norm_g, cmpk_pe, cmpk_w1, cmpk_b1, cmpk_w2, cmpk_b2,
              cmpv_pe, cmpv_w1, cmpv_b1, cmpv_w2, cmpv_b2, ln1_g, ln1_b,
              peer_wq, peer_k1, peer_k2, peer_u, peer_v, ln2_g, ln2_b):
    lb_all = jnp.cumsum(jax.nn.softmax(hg_lb.astype(jnp.float32), axis=0), axis=0)
    offsets = [int(o) for o in np.cumsum(IN_SPLITS)[:-1]]
    h = x
    for l in range(DEPTH):
        proj = h @ w_in[l]
        (hq, hf, hi, hgate, nq, kc, vc, ks_, vs_, kw, vw, ngate) = jnp.split(proj, offsets, axis=-1)
        o_hg = _hgrn2(hq, hf, hi, hgate, lb_all[l], hg_norm_g[l])
        o_nsa = _nsa(nq, kc, vc, ks_, vs_, kw, vw, ngate,
                     (cmpk_pe[l], cmpk_w1[l], cmpk_b1[l], cmpk_w2[l], cmpk_b2[l]),
                     (cmpv_pe[l], cmpv_w1[l], cmpv_b1[l], cmpv_w2[l], cmpv_b2[l]))
        mix = jnp.concatenate([o_hg, o_nsa], axis=-1).astype(h.dtype) @ w_out[l]
        h = _layernorm(DN_ALPHA * h + mix, ln1_g[l], ln1_b[l])
        ffn = _peer(h, peer_wq[l], peer_k1[l], peer_k2[l], peer_u[l], peer_v[l])
        h = _layernorm(DN_ALPHA * h + ffn, ln2_g[l], ln2_b[l])
    return h
```

```cpp
#include <hip/hip_runtime.h>
#include <hip/hip_cooperative_groups.h>
#include <cstdio>
#include <cstring>
namespace cg = cooperative_groups;

#define NTOK 32768
#define SEQ 8192
#define DM 1024
#define DIN 3352
#define NCB 511
#define ALPHA 1.189207115002721f
#define LN_EPS 1e-5f

#define C_HQ 0
#define C_HF 512
#define C_HI 1024
#define C_HG 1536
#define C_NQ 2048
#define C_KC 2560
#define C_VC 2688
#define C_KS 2816
#define C_VS 2944
#define C_KW 3072
#define C_VW 3200
#define C_NG 3328

#define OFF_PROJ 0ull
#define OFF_PRE 0ull
#define OFF_Q 0ull
#define OFF_CMPK 439353344ull
#define OFF_CMPV (OFF_CMPK + 1046528ull)
#define WS_NEED (OFF_CMPV + 1046528ull)

struct Params {
    const float* in[24];
    float* out;
    unsigned char* ws;
};

typedef float f32x16 __attribute__((ext_vector_type(16)));

__device__ __forceinline__ float wave_sum(float v) {
#pragma unroll
    for (int o = 32; o; o >>= 1) v += __shfl_xor(v, o);
    return v;
}
__device__ __forceinline__ float wave_max(float v) {
#pragma unroll
    for (int o = 32; o; o >>= 1) v = fmaxf(v, __shfl_xor(v, o));
    return v;
}
__device__ __forceinline__ float sigmoidf_(float x) { return 1.f / (1.f + expf(-x)); }
__device__ __forceinline__ float gelu_tanh(float x) {
    const float c = 0.7978845608028654f;
    return 0.5f * x * (1.f + tanhf(c * (x + 0.044715f * x * x * x)));
}

__device__ __forceinline__ void gemm_f32_phase(const float* __restrict__ A, int lda, const float* __restrict__ B, int ldb,
                               float* __restrict__ C, int ldc, int M, int Nc, int K, float* sm) {
    float (*As)[132] = (float (*)[132])sm;
    float (*Bs)[132] = (float (*)[132])(sm + 16 * 132);
    const int tid = threadIdx.x, lane = tid & 63, w = tid >> 6, wm = w >> 1, wn = w & 1;
    const int nct = (Nc + 127) / 128, nrt = M / 128;
    for (int tile = blockIdx.x; tile < nct * nrt; tile += gridDim.x) {
        const int mt = tile / nct, nt = tile % nct;
        const int m0 = mt * 128, n0 = nt * 128;
        f32x16 acc[2][2];
#pragma unroll
        for (int i = 0; i < 2; ++i)
#pragma unroll
            for (int j = 0; j < 2; ++j)
#pragma unroll
                for (int r = 0; r < 16; ++r) acc[i][j][r] = 0.f;
        for (int k0 = 0; k0 < K; k0 += 16) {
            float4 av[2], bv[2];
#pragma unroll
            for (int j = 0; j < 2; ++j) {
                const int idx = tid + 256 * j;
                const int row = idx >> 2, kq = idx & 3;
                av[j] = *(const float4*)(A + (size_t)(m0 + row) * lda + k0 + kq * 4);
                const int kr = idx >> 5, c4 = idx & 31;
                const int col = n0 + c4 * 4;
                bv[j] = (col < Nc) ? *(const float4*)(B + (size_t)(k0 + kr) * ldb + col) : make_float4(0.f, 0.f, 0.f, 0.f);
            }
            __syncthreads();
#pragma unroll
            for (int j = 0; j < 2; ++j) {
                const int idx = tid + 256 * j;
                const int row = idx >> 2, kq = idx & 3;
                As[kq * 4 + 0][row] = av[j].x; As[kq * 4 + 1][row] = av[j].y;
                As[kq * 4 + 2][row] = av[j].z; As[kq * 4 + 3][row] = av[j].w;
                const int kr = idx >> 5, c4 = idx & 31;
                *(float4*)&Bs[kr][c4 * 4] = bv[j];
            }
            __syncthreads();
#pragma unroll
            for (int kk = 0; kk < 16; kk += 2) {
                const int kr = kk + (lane >> 5);
                const float a0 = As[kr][wm * 64 + (lane & 31)];
                const float a1 = As[kr][wm * 64 + 32 + (lane & 31)];
                const float b0 = Bs[kr][wn * 64 + (lane & 31)];
                const float b1 = Bs[kr][wn * 64 + 32 + (lane & 31)];
                acc[0][0] = __builtin_amdgcn_mfma_f32_32x32x2f32(a0, b0, acc[0][0], 0, 0, 0);
                acc[0][1] = __builtin_amdgcn_mfma_f32_32x32x2f32(a0, b1, acc[0][1], 0, 0, 0);
                acc[1][0] = __builtin_amdgcn_mfma_f32_32x32x2f32(a1, b0, acc[1][0], 0, 0, 0);
                acc[1][1] = __builtin_amdgcn_mfma_f32_32x32x2f32(a1, b1, acc[1][1], 0, 0, 0);
            }
        }
#pragma unroll
        for (int i = 0; i < 2; ++i)
#pragma unroll
            for (int j = 0; j < 2; ++j) {
                const int col = n0 + wn * 64 + j * 32 + (lane & 31);
                if (col < Nc) {
#pragma unroll
                    for (int r = 0; r < 16; ++r) {
                        const int row = m0 + wm * 64 + i * 32 + (r & 3) + 8 * (r >> 2) + 4 * (lane >> 5);
                        C[(size_t)row * ldc + col] = acc[i][j][r];
                    }
                }
            }
    }
}

__device__ __forceinline__ void hgrn_seq_item(const Params& p, int item, float* sm) {
    const int vs = item & 7, h = (item >> 3) & 3, b = item >> 5;
    const int tid = threadIdx.x, dvl = tid & 15, dkg = tid >> 4, lane = tid & 63, w = tid >> 6;
    const float* proj = (const float*)(p.ws + OFF_PROJ);
    const float* lbin = p.in[3];
    float lb[8], S[8];
#pragma unroll
    for (int i = 0; i < 8; ++i) {
        const int c = h * 128 + dkg * 8 + i;
        const float a0 = lbin[c], a1 = lbin[512 + c];
        lb[i] = 1.f / (1.f + expf(a1 - a0));
        S[i] = 0.f;
    }
    float (*red)[4][4][16] = (float (*)[4][4][16])sm;
    __syncthreads();
    for (int t0 = 0; t0 < SEQ; t0 += 4) {
        const int buf = (t0 >> 2) & 1;
        float4 q0[4], q1[4], f0[4], f1[4];
        float vv[4];
#pragma unroll
        for (int tk = 0; tk < 4; ++tk) {
            const float* row = proj + (size_t)(b * SEQ + t0 + tk) * DIN;
            q0[tk] = *(const float4*)(row + C_HQ + h * 128 + dkg * 8);
            q1[tk] = *(const float4*)(row + C_HQ + h * 128 + dkg * 8 + 4);
            f0[tk] = *(const float4*)(row + C_HF + h * 128 + dkg * 8);
            f1[tk] = *(const float4*)(row + C_HF + h * 128 + dkg * 8 + 4);
            vv[tk] = row[C_HI + h * 128 + vs * 16 + dvl];
        }
#pragma unroll
        for (int tk = 0; tk < 4; ++tk) {
            const float qa[8] = {q0[tk].x, q0[tk].y, q0[tk].z, q0[tk].w, q1[tk].x, q1[tk].y, q1[tk].z, q1[tk].w};
            const float fa[8] = {f0[tk].x, f0[tk].y, f0[tk].z, f0[tk].w, f1[tk].x, f1[tk].y, f1[tk].z, f1[tk].w};
            float po = 0.f;
#pragma unroll
            for (int i = 0; i < 8; ++i) {
                const float f = lb[i] + (1.f - lb[i]) * sigmoidf_(fa[i]);
                S[i] = f * S[i] + (1.f - f) * vv[tk];
                po += qa[i] * S[i];
            }
            po += __shfl_xor(po, 16);
            po += __shfl_xor(po, 32);
            if (lane < 16) red[buf][tk][w][lane] = po;
        }
        __syncthreads();
        if (tid < 64) {
            const int tk = tid >> 4, dv = tid & 15;
            const float o = red[buf][tk][0][dv] + red[buf][tk][1][dv] + red[buf][tk][2][dv] + red[buf][tk][3][dv];
            p.out[(size_t)(b * SEQ + t0 + tk) * DM + h * 128 + vs * 16 + dv] = o;
        }
    }
    __syncthreads();
}

__device__ __forceinline__ void hgrn_norm_phase(const Params& p) {
    const int lane = threadIdx.x & 63, w = threadIdx.x >> 6;
    const float* proj = (const float*)(p.ws + OFF_PROJ);
    const float* ng = p.in[4];
    for (int it = blockIdx.x * 4 + w; it < NTOK * 4; it += gridDim.x * 4) {
        const int n = it >> 2, h = it & 3;
        float* o = p.out + (size_t)n * DM + h * 128;
        const float a = o[lane], c = o[lane + 64];
        const float ms = wave_sum(a * a + c * c) * (1.f / 128.f);
        const float rs = rsqrtf(ms + LN_EPS);
        const float g0 = proj[(size_t)n * DIN + C_HG + h * 128 + lane];
        const float g1 = proj[(size_t)n * DIN + C_HG + h * 128 + lane + 64];
        o[lane] = a * rs * ng[lane] * (g0 * sigmoidf_(g0));
        o[lane + 64] = c * rs * ng[lane + 64] * (g1 * sigmoidf_(g1));
    }
}

__device__ __forceinline__ void compress_item(const Params& p, int item, float* sm) {
    const int g = item & 1;
    int r = item >> 1;
    const int n = r % NCB; r /= NCB;
    const int b = r & 3, which = r >> 2;
    const int tid = threadIdx.x;
    const float* proj = (const float*)(p.ws + OFF_PROJ);
    const float* pe = p.in[which ? 10 : 5];
    const float* w1 = p.in[which ? 11 : 6];
    const float* b1 = p.in[which ? 12 : 7];
    const float* w2 = p.in[which ? 13 : 8];
    const float* b2 = p.in[which ? 14 : 9];
    float* outp = (float*)(p.ws + (which ? OFF_CMPV : OFF_CMPK));
    const int coff = which ? C_VC : C_KC;
    float* blk = sm;
    float* hh = sm + 2048;
    __syncthreads();
    for (int i = tid; i < 2048; i += 256) {
        const int l = i >> 6, d = i & 63;
        blk[i] = proj[(size_t)(b * SEQ + 16 * n + l) * DIN + coff + g * 64 + d] + pe[i];
    }
    __syncthreads();
    float acc = b1[tid];
    for (int i = 0; i < 2048; ++i) acc += blk[i] * w1[(size_t)i * 256 + tid];
    hh[tid] = gelu_tanh(acc);
    __syncthreads();
    if (tid < 64) {
        float o = b2[tid];
        for (int j = 0; j < 256; ++j) o += hh[j] * w2[j * 64 + tid];
        outp[((size_t)(b * NCB + n) * 2 + g) * 64 + tid] = o;
    }
}

__device__ __forceinline__ float dot64(const float* qs, const float* krow) {
    float s = 0.f;
#pragma unroll
    for (int i = 0; i < 16; ++i) {
        const float4 kv = ((const float4*)krow)[i];
        const float4 qv = ((const float4*)qs)[i];
        s += kv.x * qv.x + kv.y * qv.y + kv.z * qv.z + kv.w * qv.w;
    }
    return s;
}

__device__ __forceinline__ void nsa_item(const Params& p, int item, float* sm) {
    const int t = item & (SEQ - 1), g = (item >> 13) & 1, b = item >> 14;
    const int tid = threadIdx.x, lane = tid & 63, r = tid >> 6;
    float* sc = sm + r * 1024;
    float* qs = sm + 4096 + r * 64;
    float* impv = sm + 4096 + 256;
    int* sel = (int*)(sm + 4096 + 256 + 128);
    const float* proj = (const float*)(p.ws + OFF_PROJ);
    const float* cmpk = (const float*)(p.ws + OFF_CMPK);
    const float* cmpv = (const float*)(p.ws + OFF_CMPV);
    const size_t n = (size_t)b * SEQ + t;
    const float* prow = proj + n * DIN;
    const float NEGV = -1e30f;
    __syncthreads();
    qs[lane] = prow[C_NQ + g * 256 + r * 64 + lane] * 0.125f;
    __syncthreads();

    const int nvalid = (t >= 31) ? (((t - 31) >> 4) + 1) : 0;
    float m = NEGV;
    for (int n0 = 0; n0 < nvalid; n0 += 64) {
        const int nn = n0 + lane;
        if (nn < nvalid) {
            const float s = dot64(qs, cmpk + ((size_t)(b * NCB + nn) * 2 + g) * 64);
            sc[nn] = s;
            m = fmaxf(m, s);
        }
    }
    m = wave_max(m);
    float sum = 0.f;
    for (int n0 = 0; n0 < nvalid; n0 += 64) {
        const int nn = n0 + lane;
        if (nn < nvalid) { const float e = expf(sc[nn] - m); sc[nn] = e; sum += e; }
    }
    sum = wave_sum(sum);
    {
        const float inv = 1.f / fmaxf(sum, 1e-30f);
        for (int n0 = 0; n0 < nvalid; n0 += 64) {
            const int nn = n0 + lane;
            if (nn < nvalid) sc[nn] *= inv;
        }
    }
    __syncthreads();
    float oc = 0.f;
    for (int nn = 0; nn < nvalid; ++nn) oc += sc[nn] * cmpv[((size_t)(b * NCB + nn) * 2 + g) * 64 + lane];

    const int cur = t >> 6;
    if (tid < 128) {
        const int j = tid;
        float im = 0.f;
#pragma unroll
        for (int rr = 0; rr < 4; ++rr) {
            const float* P = sm + rr * 1024;
            const int n4 = 4 * j;
            float a = 0.f;
            if (n4 < nvalid) a += P[n4];
            if (n4 + 1 < nvalid) a += P[n4 + 1];
            if (n4 + 2 < nvalid) a += P[n4 + 2];
            if (n4 + 3 < nvalid) a += 0.5f * P[n4 + 3];
            if (n4 - 1 >= 0 && n4 - 1 < nvalid) a += 0.5f * P[n4 - 1];
            im += a;
        }
        const bool forced = (j == 0) || (j == cur) || (j == cur - 1);
        const bool causal = (j <= cur);
        impv[j] = forced ? 1.0e4f : (causal ? im : -1.f);
    }
    __syncthreads();
    if (r == 0) {
        float v0 = impv[lane], v1 = impv[lane + 64];
        for (int k = 0; k < 16; ++k) {
            const float mx = wave_max(fmaxf(v0, v1));
            const unsigned long long b0 = __ballot(v0 == mx);
            int idx;
            if (b0) {
                const int l = __ffsll((unsigned long long)b0) - 1;
                idx = l;
                if (lane == l) v0 = -3.0e38f;
            } else {
                const unsigned long long b1 = __ballot(v1 == mx);
                const int l = __ffsll((unsigned long long)b1) - 1;
                idx = 64 + l;
                if (lane == l) v1 = -3.0e38f;
            }
            if (lane == 0) sel[k] = idx;
        }
    }
    __syncthreads();

    m = NEGV;
    for (int si = 0; si < 16; ++si) {
        const int blk = sel[si];
        const int key = blk * 64 + lane;
        float s = NEGV;
        if (blk * 64 <= t) {
            if (key <= t) s = dot64(qs, proj + ((size_t)b * SEQ + key) * DIN + C_KS + g * 64);
        }
        sc[si * 64 + lane] = s;
        m = fmaxf(m, s);
    }
    m = wave_max(m);
    sum = 0.f;
    for (int si = 0; si < 16; ++si) {
        const int key = sel[si] * 64 + lane;
        const float e = (key <= t) ? expf(sc[si * 64 + lane] - m) : 0.f;
        sc[si * 64 + lane] = e;
        sum += e;
    }
    sum = wave_sum(sum);
    {
        const float inv = 1.f / fmaxf(sum, 1e-30f);
        for (int si = 0; si < 16; ++si) sc[si * 64 + lane] *= inv;
    }
    __syncthreads();
    float os = 0.f;
    for (int si = 0; si < 16; ++si) {
        const int blk = sel[si];
        if (blk * 64 > t) continue;
        for (int kk = 0; kk < 64; ++kk) {
            const int key = blk * 64 + kk;
            if (key > t) break;
            os += sc[si * 64 + kk] * proj[((size_t)b * SEQ + key) * DIN + C_VS + g * 64 + lane];
        }
    }
    __syncthreads();

    const int lo = t - 511;
    m = NEGV;
    for (int i = 0; i < 8; ++i) {
        const int key = lo + i * 64 + lane;
        float s = NEGV;
        if (key >= 0) s = dot64(qs, proj + ((size_t)b * SEQ + key) * DIN + C_KW + g * 64);
        sc[i * 64 + lane] = s;
        m = fmaxf(m, s);
    }
    m = wave_max(m);
    sum = 0.f;
    for (int i = 0; i < 8; ++i) {
        const int key = lo + i * 64 + lane;
        const float e = (key >= 0) ? expf(sc[i * 64 + lane] - m) : 0.f;
        sc[i * 64 + lane] = e;
        sum += e;
    }
    sum = wave_sum(sum);
    {
        const float inv = 1.f / fmaxf(sum, 1e-30f);
        for (int i = 0; i < 8; ++i) sc[i * 64 + lane] *= inv;
    }
    __syncthreads();
    float ow = 0.f;
    for (int idx = 0; idx < 512; ++idx) {
        const int key = lo + idx;
        if (key < 0) continue;
        ow += sc[idx] * proj[((size_t)b * SEQ + key) * DIN + C_VW + g * 64 + lane];
    }
    const float gc = sigmoidf_(prow[C_NG + g * 12 + r * 3 + 0]);
    const float gs = sigmoidf_(prow[C_NG + g * 12 + r * 3 + 1]);
    const float gw = sigmoidf_(prow[C_NG + g * 12 + r * 3 + 2]);
    p.out[n * DM + 512 + g * 256 + r * 64 + lane] = gc * oc + gs * os + gw * ow;
}

__device__ __forceinline__ float block_sum(float v, float* red) {
    v = wave_sum(v);
    __syncthreads();
    if ((threadIdx.x & 63) == 0) red[threadIdx.x >> 6] = v;
    __syncthreads();
    return red[0] + red[1] + red[2] + red[3];
}
__device__ __forceinline__ float4 ln_row(float4 y, const float* g, const float* bb, float* red) {
    const int tid = threadIdx.x;
    const float mu = block_sum(y.x + y.y + y.z + y.w, red) * (1.f / 1024.f);
    const float dx = y.x - mu, dy = y.y - mu, dz = y.z - mu, dw = y.w - mu;
    const float var = block_sum(dx * dx + dy * dy + dz * dz + dw * dw, red) * (1.f / 1024.f);
    const float rs = rsqrtf(var + LN_EPS);
    const float4 gg = ((const float4*)g)[tid], b4 = ((const float4*)bb)[tid];
    return make_float4(dx * rs * gg.x + b4.x, dy * rs * gg.y + b4.y, dz * rs * gg.z + b4.z, dw * rs * gg.w + b4.w);
}

__device__ __forceinline__ void ln1_phase(const Params& p, float* sm) {
    const float* pre = (const float*)(p.ws + OFF_PRE);
    const float* x = p.in[0];
    const int tid = threadIdx.x;
    for (int n = blockIdx.x; n < NTOK; n += gridDim.x) {
        const float4 xv = ((const float4*)(x + (size_t)n * DM))[tid];
        const float4 pv = ((const float4*)(pre + (size_t)n * DM))[tid];
        const float4 y = make_float4(ALPHA * xv.x + pv.x, ALPHA * xv.y + pv.y, ALPHA * xv.z + pv.z, ALPHA * xv.w + pv.w);
        const float4 o = ln_row(y, p.in[15], p.in[16], sm);
        ((float4*)(p.out + (size_t)n * DM))[tid] = o;
    }
}

template <int NV>
__device__ __forceinline__ void wave_top16(float (&v)[NV], float& myv, int& myi, int lane) {
    myv = 0.f; myi = 0;
    for (int k = 0; k < 16; ++k) {
        float mx = v[0];
#pragma unroll
        for (int q = 1; q < NV; ++q) mx = fmaxf(mx, v[q]);
        mx = wave_max(mx);
        int idx = -1;
#pragma unroll
        for (int q = 0; q < NV; ++q) {
            if (idx < 0) {
                const unsigned long long bb = __ballot(v[q] == mx);
                if (bb) {
                    const int l = __ffsll((unsigned long long)bb) - 1;
                    idx = q * 64 + l;
                    if (lane == l) v[q] = -3.0e38f;
                }
            }
        }
        if (lane == k) { myv = mx; myi = idx; }
    }
}

__device__ __forceinline__ void peer_item(const Params& p, int n, float* sm) {
    float* xs = sm;
    float* qh = sm + 1024;
    float* s12 = sm + 1280;
    float* tv = sm + 1536;
    int* ti = (int*)(sm + 1568);
    int* ex = (int*)(sm + 1600);
    float* gw = sm + 1728;
    float* red = sm + 1856;
    const int tid = threadIdx.x, lane = tid & 63, w = tid >> 6;
    const float* Q = (const float*)(p.ws + OFF_Q) + (size_t)n * 2048;
    const float* k1 = p.in[18];
    const float* k2 = p.in[19];
    const float* U = p.in[20];
    const float* V = p.in[21];
    __syncthreads();
    const float4 xv = ((const float4*)(p.out + (size_t)n * DM))[tid];
    ((float4*)xs)[tid] = xv;
    for (int head = 0; head < 8; ++head) {
        qh[tid] = Q[head * 256 + tid];
        __syncthreads();
        {
            const int half = tid >> 7, j = tid & 127;
            const float* kr = (half ? k2 : k1) + j * 128;
            const float* qq = qh + half * 128;
            float s = 0.f;
#pragma unroll 8
            for (int d = 0; d < 32; ++d) {
                const float4 kv = ((const float4*)kr)[d];
                const float4 qv = ((const float4*)qq)[d];
                s += kv.x * qv.x + kv.y * qv.y + kv.z * qv.z + kv.w * qv.w;
            }
            s12[tid] = s;
        }
        __syncthreads();
        if (w < 2) {
            float v[2] = {s12[w * 128 + lane], s12[w * 128 + 64 + lane]};
            float mv; int mi;
            wave_top16<2>(v, mv, mi, lane);
            if (lane < 16) { tv[w * 16 + lane] = mv; ti[w * 16 + lane] = mi; }
        }
        __syncthreads();
        if (w == 0) {
            float v[4];
#pragma unroll
            for (int q = 0; q < 4; ++q) { const int c = lane + 64 * q; v[q] = tv[c >> 4] + tv[16 + (c & 15)]; }
            float mv; int mi;
            wave_top16<4>(v, mv, mi, lane);
            const float m0 = __shfl(mv, 0);
            const float e = (lane < 16) ? expf(mv - m0) : 0.f;
            const float ssum = wave_sum(e);
            if (lane < 16) {
                ex[head * 16 + lane] = ti[mi >> 4] * 128 + ti[16 + (mi & 15)];
                gw[head * 16 + lane] = e / ssum;
            }
        }
        __syncthreads();
    }
    for (int kk = 0; kk < 32; ++kk) {
        const int k = w * 32 + kk;
        const int e = ex[k];
        const float4* ur = (const float4*)(U + (size_t)e * DM);
        float s = 0.f;
#pragma unroll
        for (int i = 0; i < 4; ++i) {
            const float4 a = ur[lane + 64 * i];
            const float4 x4 = ((const float4*)xs)[lane + 64 * i];
            s += a.x * x4.x + a.y * x4.y + a.z * x4.z + a.w * x4.w;
        }
        s = wave_sum(s);
        if (lane == 0) gw[k] = gw[k] * gelu_tanh(s);
    }
    __syncthreads();
    float4 acc = make_float4(0.f, 0.f, 0.f, 0.f);
    for (int k = 0; k < 128; ++k) {
        const float wk = gw[k];
        const float4 vv = ((const float4*)(V + (size_t)ex[k] * DM))[tid];
        acc.x += wk * vv.x; acc.y += wk * vv.y; acc.z += wk * vv.z; acc.w += wk * vv.w;
    }
    const float4 y = make_float4(ALPHA * xv.x + acc.x, ALPHA * xv.y + acc.y, ALPHA * xv.z + acc.z, ALPHA * xv.w + acc.w);
    const float4 o = ln_row(y, p.in[22], p.in[23], red);
    ((float4*)(p.out + (size_t)n * DM))[tid] = o;
}

__global__ void __launch_bounds__(256, 2) mega(Params p) {
    cg::grid_group grid = cg::this_grid();
    __shared__ __attribute__((aligned(16))) float sm[5120];
    float* proj = (float*)(p.ws + OFF_PROJ);

    gemm_f32_phase(p.in[0], DM, p.in[1], DIN, proj, DIN, NTOK, DIN, DM, sm);
    grid.sync();
    for (int it = blockIdx.x; it < 2 * 4 * NCB * 2; it += gridDim.x) compress_item(p, it, sm);
    grid.sync();
    for (int it = blockIdx.x; it < 128 + 4 * 2 * SEQ; it += gridDim.x) {
        if (it < 128) hgrn_seq_item(p, it, sm);
        else nsa_item(p, it - 128, sm);
    }
    grid.sync();
    hgrn_norm_phase(p);
    grid.sync();
    gemm_f32_phase(p.out, DM, p.in[2], DM, (float*)(p.ws + OFF_PRE), DM, NTOK, DM, DM, sm);
    grid.sync();
    ln1_phase(p, sm);
    grid.sync();
    gemm_f32_phase(p.out, DM, p.in[17], 2048, (float*)(p.ws + OFF_Q), 2048, NTOK, 2048, DM, sm);
    grid.sync();
    for (int n = blockIdx.x; n < NTOK; n += gridDim.x) peer_item(p, n, sm);
}

extern "C" void kernel_launch(void* const* d_in, const int* in_sizes, int n_in, void* d_out, int out_size,
                              void* d_ws, size_t ws_size, hipStream_t stream) {
    static int grid_blocks = 0;
    if (!grid_blocks) {
        int dev = 0, cus = 0, per_cu = 0;
        hipGetDevice(&dev);
        hipDeviceGetAttribute(&cus, hipDeviceAttributeMultiprocessorCount, dev);
        hipOccupancyMaxActiveBlocksPerMultiprocessor(&per_cu, mega, 256, 0);
        if (per_cu > 4) per_cu = 4;
        if (per_cu < 1) per_cu = 1;
        grid_blocks = cus * per_cu;
        if (n_in != 24 || ws_size < WS_NEED || out_size != NTOK * DM)
            fprintf(stderr, "kernel_launch: unexpected sizes n_in=%d ws=%zu out=%d\n", n_in, ws_size, out_size);
    }
    Params p;
    memset(&p, 0, sizeof(p));
    for (int i = 0; i < 24; ++i) p.in[i] = (const float*)d_in[i];
    p.out = (float*)d_out;
    p.ws = (unsigned char*)d_ws;
    void* args[] = {&p};
    hipError_t e = hipLaunchCooperativeKernel((void*)mega, dim3(grid_blocks), dim3(256), args, 0, stream);
    if (e != hipSuccess) fprintf(stderr, "cooperative launch failed: %s (grid %d)\n", hipGetErrorString(e), grid_blocks);
}
```

```cpp
#include <hip/hip_runtime.h>
#include <hip/hip_cooperative_groups.h>
#include <cstdio>
#include <cstring>
namespace cg = cooperative_groups;

#define NTOK 32768
#define SEQ 8192
#define DM 1024
#define DIN 3352
#define NCB 511
#define ALPHA 1.189207115002721f
#define LN_EPS 1e-5f

#define MB_ 1048576ull
#define OFF_XB 0ull
#define OFF_HQ (64 * MB_)
#define OFF_HLF (96 * MB_)
#define OFF_HI (160 * MB_)
#define OFF_HG (192 * MB_)
#define OFF_NQ (224 * MB_)
#define OFF_KV (256 * MB_)
#define KV_STRIDE (8 * MB_)
#define OFF_NGATE (304 * MB_)
#define OFF_CMPK (308 * MB_)
#define OFF_CMPV (309 * MB_)
#define OFF_WINT (310 * MB_)
#define OFF_WOUTT (317 * MB_)
#define OFF_WQT (319 * MB_)
#define OFF_LBV (323 * MB_)
#define OFF_DC (324 * MB_)
#define OFF_SC (325 * MB_)
#define OFF_UB (389 * MB_)
#define OFF_VB (421 * MB_)
#define OFF_TOPK (453 * MB_)
#define OFF_W1T (485 * MB_)
#define OFF_HB (487 * MB_)
#define OFF_CMPKB (491 * MB_)
#define OFF_CMPVB (491 * MB_ + 524288ull)
#define OFF_PEB (492 * MB_)
#define OFF_SELM (493 * MB_)
#define OFF_DIAG (494 * MB_)
#define WS_NEED (495 * MB_)
#define USE_NSA_MFMA 1
#define NSA_DIAG 0

struct Params {
    const float* in[24];
    float* out;
    unsigned char* ws;
};

typedef float f32x16 __attribute__((ext_vector_type(16)));
#define WAVE_LDS_SYNC() asm volatile("s_waitcnt lgkmcnt(0)" ::: "memory")

__device__ __forceinline__ float wave_sum(float v) {
#pragma unroll
    for (int o = 32; o; o >>= 1) v += __shfl_xor(v, o);
    return v;
}
__device__ __forceinline__ float wave_max(float v) {
#pragma unroll
    for (int o = 32; o; o >>= 1) v = fmaxf(v, __shfl_xor(v, o));
    return v;
}
__device__ __forceinline__ float sigmoidf_(float x) { return 1.f / (1.f + expf(-x)); }
__device__ __forceinline__ float gelu_tanh(float x) {
    const float c = 0.7978845608028654f;
    return 0.5f * x * (1.f + tanhf(c * (x + 0.044715f * x * x * x)));
}

typedef short bf16x8 __attribute__((ext_vector_type(8)));
typedef float f32x4 __attribute__((ext_vector_type(4)));
typedef unsigned short bf16_t;

__device__ __forceinline__ unsigned f2bf(float f) {
    unsigned u = __float_as_uint(f);
    u += 0x7FFFu + ((u >> 16) & 1u);
    return u >> 16;
}
__device__ __forceinline__ unsigned pack2bf(float lo, float hi) { return f2bf(lo) | (f2bf(hi) << 16); }
__device__ __forceinline__ float bf2f(unsigned h) { return __uint_as_float(h << 16); }

__device__ __forceinline__ void cvt_rows_bf16(const float* __restrict__ src, bf16_t* __restrict__ dst, size_t n8) {
    for (size_t i = (size_t)blockIdx.x * 256 + threadIdx.x; i < n8; i += (size_t)gridDim.x * 256) {
        const float4 a = ((const float4*)src)[2 * i], b = ((const float4*)src)[2 * i + 1];
        uint4 o;
        o.x = pack2bf(a.x, a.y); o.y = pack2bf(a.z, a.w); o.z = pack2bf(b.x, b.y); o.w = pack2bf(b.z, b.w);
        ((uint4*)dst)[i] = o;
    }
}
__device__ __forceinline__ void transpose_bf16(const float* __restrict__ src, int Nsrc, int Npad, bf16_t* __restrict__ dst, int K = 1024) {
    const size_t total = (size_t)Npad * (K / 8);
    for (size_t i = (size_t)blockIdx.x * 256 + threadIdx.x; i < total; i += (size_t)gridDim.x * 256) {
        const int n = (int)(i % Npad), kg = (int)(i / Npad);
        float v[8];
#pragma unroll
        for (int j = 0; j < 8; ++j) v[j] = (n < Nsrc) ? src[(size_t)(kg * 8 + j) * Nsrc + n] : 0.f;
        uint4 o;
        o.x = pack2bf(v[0], v[1]); o.y = pack2bf(v[2], v[3]); o.z = pack2bf(v[4], v[5]); o.w = pack2bf(v[6], v[7]);
        *(uint4*)(dst + (size_t)n * K + kg * 8) = o;
    }
}

struct ALoadStd {
    const bf16_t* A; int lda;
    __device__ __forceinline__ const bf16_t* ptr(int row, int ks) const { return A + (size_t)row * lda + ks * 64; }
};
struct ALoadCmp {
    const bf16_t* KC;
    __device__ __forceinline__ const bf16_t* ptr(int row, int ks) const {
        const int r = row < 4088 ? row : 4087;
        const int g = r & 1, bn = r >> 1, n = bn % NCB, b = bn / NCB;
        return KC + ((size_t)(b * SEQ + 16 * n + ks) * 128 + g * 64);
    }
};
#define GLD1(i, ks) { const int c_ = tid + 256 * (i), row_ = c_ >> 3, ch_ = c_ & 7;                      \
        ra##i = *(const uint4*)(aload.ptr(m0 + row_, (ks)) + ch_ * 8);                                   \
        rb##i = *(const uint4*)(Bp + (size_t)row_ * ldb + (ks) * 64 + ch_ * 8); }
#define GST1(i, buf) { const int c_ = tid + 256 * (i), row_ = c_ >> 3, ch_ = c_ & 7;                     \
        const int off_ = (buf) * 32768 + row_ * 128 + ((ch_ ^ (row_ & 7)) << 4);                         \
        *(uint4*)(lds + off_) = ra##i; *(uint4*)(lds + 16384 + off_) = rb##i; }
#define GEMM_LOAD(ks) { GLD1(0, ks) GLD1(1, ks) GLD1(2, ks) GLD1(3, ks) }
#define GEMM_STORE(buf) { GST1(0, buf) GST1(1, buf) GST1(2, buf) GST1(3, buf) }
template <class ALoad, class Epi>
__device__ __forceinline__ void gemm_tile(const ALoad aload, const bf16_t* __restrict__ Bt, int ldb, int KS, int m0, int n0,
                                          unsigned char* lds, Epi epi) {
    const int tid = threadIdx.x, lane = tid & 63, w = tid >> 6, wm = w >> 1, wn = w & 1;
    f32x4 acc[4][4];
#pragma unroll
    for (int j = 0; j < 4; ++j)
#pragma unroll
        for (int i = 0; i < 4; ++i) acc[j][i] = (f32x4){0.f, 0.f, 0.f, 0.f};
    uint4 ra0, ra1, ra2, ra3, rb0, rb1, rb2, rb3;
    const bf16_t* Bp = Bt + (size_t)n0 * ldb;
    GEMM_LOAD(0)
    __syncthreads();
    GEMM_STORE(0)
    __syncthreads();
    for (int ks = 0; ks < KS; ++ks) {
        if (ks + 1 < KS) GEMM_LOAD(ks + 1)
        const unsigned char* la = lds + (ks & 1) * 32768;
        const unsigned char* lb = la + 16384;
#pragma unroll
        for (int s = 0; s < 2; ++s) {
            bf16x8 af[4], wf[4];
            const int ch = s * 4 + (lane >> 4);
#pragma unroll
            for (int i = 0; i < 4; ++i) {
                const int row = wm * 64 + i * 16 + (lane & 15);
                af[i] = *(const bf16x8*)(la + row * 128 + ((ch ^ (row & 7)) << 4));
            }
#pragma unroll
            for (int j = 0; j < 4; ++j) {
                const int row = wn * 64 + j * 16 + (lane & 15);
                wf[j] = *(const bf16x8*)(lb + row * 128 + ((ch ^ (row & 7)) << 4));
            }
#pragma unroll
            for (int j = 0; j < 4; ++j)
#pragma unroll
                for (int i = 0; i < 4; ++i)
                    acc[j][i] = __builtin_amdgcn_mfma_f32_16x16x32_bf16(wf[j], af[i], acc[j][i], 0, 0, 0);
        }
        if (ks + 1 < KS) GEMM_STORE((ks + 1) & 1)
        __syncthreads();
    }
#pragma unroll
    for (int j = 0; j < 4; ++j)
#pragma unroll
        for (int i = 0; i < 4; ++i)
            epi(m0 + wm * 64 + i * 16 + (lane & 15), n0 + wn * 64 + j * 16 + (lane >> 4) * 4, acc[j][i]);
    epi.finish(m0, n0);
}
template <class Epi>
__device__ __forceinline__ void gemm_bf16_phase(const bf16_t* __restrict__ A, int lda, const bf16_t* __restrict__ Bt, int ldb,
                                                int Mtiles, int Ntiles, unsigned char* lds, Epi epi) {
    for (int tile = blockIdx.x; tile < Mtiles * Ntiles; tile += gridDim.x) {
        const int mt = tile / Ntiles, nt = tile % Ntiles;
        gemm_tile(ALoadStd{A, lda}, Bt, ldb, 16, mt * 128, nt * 128, lds, epi);
    }
}

struct EpiF32 {
    float* C; int ldc; int Nc;
    __device__ __forceinline__ void operator()(int m, int n, f32x4 v) const {
        if (n < Nc) *(float4*)(C + (size_t)m * ldc + n) = make_float4(v[0], v[1], v[2], v[3]);
    }
    __device__ __forceinline__ void finish(int, int) const {}
};

struct EpiProj {
    unsigned char* ws;
    __device__ __forceinline__ void operator()(int m, int n, f32x4 v) const {
        const int ct = n >> 7;
        if (ct < 4) {
            uint2 o; o.x = pack2bf(v[0], v[1]); o.y = pack2bf(v[2], v[3]);
            *(uint2*)((bf16_t*)(ws + OFF_HQ) + (size_t)m * 512 + n) = o;
        } else if (ct < 8) {
            const int c = n - 512;
            const float4 lb = *(const float4*)((const float*)(ws + OFF_LBV) + c);
            float4 o;
            o.x = logf(lb.x + (1.f - lb.x) * sigmoidf_(v[0])); o.y = logf(lb.y + (1.f - lb.y) * sigmoidf_(v[1]));
            o.z = logf(lb.z + (1.f - lb.z) * sigmoidf_(v[2])); o.w = logf(lb.w + (1.f - lb.w) * sigmoidf_(v[3]));
            *(float4*)((float*)(ws + OFF_HLF) + (size_t)m * 512 + c) = o;
        } else if (ct < 12) {
            uint2 o; o.x = pack2bf(v[0], v[1]); o.y = pack2bf(v[2], v[3]);
            *(uint2*)((bf16_t*)(ws + OFF_HI) + (size_t)m * 512 + (n - 1024)) = o;
        } else if (ct < 16) {
            uint2 o; o.x = pack2bf(v[0], v[1]); o.y = pack2bf(v[2], v[3]);
            *(uint2*)((bf16_t*)(ws + OFF_HG) + (size_t)m * 512 + (n - 1536)) = o;
        } else if (ct < 20) {
            uint2 o; o.x = pack2bf(0.125f * v[0], 0.125f * v[1]); o.y = pack2bf(0.125f * v[2], 0.125f * v[3]);
            *(uint2*)((bf16_t*)(ws + OFF_NQ) + (size_t)m * 512 + (n - 2048)) = o;
        } else if (ct < 26) {
            uint2 o; o.x = pack2bf(v[0], v[1]); o.y = pack2bf(v[2], v[3]);
            *(uint2*)((bf16_t*)(ws + OFF_KV + (size_t)(ct - 20) * KV_STRIDE) + (size_t)m * 128 + (n & 127)) = o;
        } else {
            const int c = n - 3328;
            if (c < 24)
                *(float4*)((float*)(ws + OFF_NGATE) + (size_t)m * 24 + c) =
                    make_float4(sigmoidf_(v[0]), sigmoidf_(v[1]), sigmoidf_(v[2]), sigmoidf_(v[3]));
        }
    }
    __device__ __forceinline__ void finish(int, int) const {}
};
struct EpiY {
    const float* x; float* y;
    __device__ __forceinline__ void operator()(int m, int n, f32x4 v) const {
        const float4 xv = *(const float4*)(x + (size_t)m * DM + n);
        *(float4*)(y + (size_t)m * DM + n) = make_float4(ALPHA * xv.x + v[0], ALPHA * xv.y + v[1], ALPHA * xv.z + v[2], ALPHA * xv.w + v[3]);
    }
    __device__ __forceinline__ void finish(int, int) const {}
};

__device__ __forceinline__ uint4 pack8bf(const float* v) {
    uint4 o;
    o.x = pack2bf(v[0], v[1]); o.y = pack2bf(v[2], v[3]); o.z = pack2bf(v[4], v[5]); o.w = pack2bf(v[6], v[7]);
    return o;
}

__device__ __forceinline__ void hgrn_passA(const Params& p, int chunk, unsigned char* smem) {
    const int c = chunk & 127, bh = chunk >> 7, h = bh & 3, b = bh >> 2;
    const int tid = threadIdx.x, d = tid & 127, hf = tid >> 7, lane = tid & 63, w = tid >> 6;
    const size_t tok0 = (size_t)b * SEQ + (size_t)c * 64 + 32 * hf;
    const float* HLF = (const float*)(p.ws + OFF_HLF);
    const bf16_t* HI = (const bf16_t*)(p.ws + OFF_HI);
    unsigned char* KT = smem;
    unsigned char* VT = smem + 16384;
    float* xch = (float*)(smem + 32768);
    const float* lfp = HLF + tok0 * 512 + h * 128 + d;
    const bf16_t* vp = HI + tok0 * 512 + h * 128 + d;
    float run = 0.f;
#pragma unroll 8
    for (int s = 0; s < 32; ++s) run += lfp[s * 512];
    __syncthreads();
    xch[hf * 128 + d] = run;
    __syncthreads();
    const float tot0 = xch[d], tot1 = xch[128 + d];
    const float blast = tot0 + tot1;
    run = hf ? tot0 : 0.f;
#pragma unroll 1
    for (int q = 0; q < 4; ++q) {
        float kv[8], vv[8];
#pragma unroll
        for (int j = 0; j < 8; ++j) {
            const int s = q * 8 + j;
            const float lf = lfp[s * 512];
            run += lf;
            kv[j] = (1.f - expf(lf)) * expf(blast - run);
            vv[j] = bf2f(vp[s * 512]);
        }
        const int ch = 4 * hf + q;
        *(uint4*)(KT + d * 128 + ((ch ^ (d & 7)) << 4)) = pack8bf(kv);
        *(uint4*)(VT + d * 128 + ((ch ^ (d & 7)) << 4)) = pack8bf(vv);
    }
    if (hf) ((float*)(p.ws + OFF_DC))[(size_t)chunk * 128 + d] = expf(blast);
    __syncthreads();
    f32x4 acc[2][8];
#pragma unroll
    for (int i = 0; i < 2; ++i)
#pragma unroll
        for (int et = 0; et < 8; ++et) acc[i][et] = (f32x4){0.f, 0.f, 0.f, 0.f};
#pragma unroll
    for (int st = 0; st < 2; ++st) {
        const int ch = st * 4 + (lane >> 4);
        bf16x8 af[2];
#pragma unroll
        for (int i = 0; i < 2; ++i) {
            const int row = (2 * w + i) * 16 + (lane & 15);
            af[i] = *(const bf16x8*)(KT + row * 128 + ((ch ^ (row & 7)) << 4));
        }
#pragma unroll
        for (int et = 0; et < 8; ++et) {
            const int row = et * 16 + (lane & 15);
            const bf16x8 bfv = *(const bf16x8*)(VT + row * 128 + ((ch ^ (row & 7)) << 4));
            acc[0][et] = __builtin_amdgcn_mfma_f32_16x16x32_bf16(af[0], bfv, acc[0][et], 0, 0, 0);
            acc[1][et] = __builtin_amdgcn_mfma_f32_16x16x32_bf16(af[1], bfv, acc[1][et], 0, 0, 0);
        }
    }
    float* HC = p.out + (size_t)chunk * 16384;
#pragma unroll
    for (int i = 0; i < 2; ++i)
#pragma unroll
        for (int et = 0; et < 8; ++et) {
            const int e = et * 16 + (lane & 15), d0 = (2 * w + i) * 16 + (lane >> 4) * 4;
            *(float4*)(HC + e * 128 + d0) = make_float4(acc[i][et][0], acc[i][et][1], acc[i][et][2], acc[i][et][3]);
        }
}

__device__ __forceinline__ void hgrn_scan_item(const Params& p, int item) {
    const int gid = item * 256 + threadIdx.x;
    const int d4 = gid & 31, e = (gid >> 5) & 127, bh = gid >> 12;
    const float* HC = p.out;
    const float* DC = (const float*)(p.ws + OFF_DC);
    bf16_t* SC = (bf16_t*)(p.ws + OFF_SC);
    float4 S = make_float4(0.f, 0.f, 0.f, 0.f);
#pragma unroll 4
    for (int c = 0; c < 128; ++c) {
        const size_t base = ((size_t)(bh * 128 + c) * 128 + e) * 128 + d4 * 4;
        const float4 H = *(const float4*)(HC + base);
        const float4 dc = *(const float4*)(DC + (size_t)(bh * 128 + c) * 128 + d4 * 4);
        uint2 o; o.x = pack2bf(S.x, S.y); o.y = pack2bf(S.z, S.w);
        *(uint2*)(SC + base) = o;
        S.x = dc.x * S.x + H.x; S.y = dc.y * S.y + H.y; S.z = dc.z * S.z + H.z; S.w = dc.w * S.w + H.w;
    }
}

__device__ __forceinline__ void hgrn_passC(const Params& p, int chunk, unsigned char* smem) {
    const int c = chunk & 127, bh = chunk >> 7, h = bh & 3, b = bh >> 2;
    const int tid = threadIdx.x, d = tid & 127, hf = tid >> 7, lane = tid & 63, w = tid >> 6;
    const size_t tokc = (size_t)b * SEQ + (size_t)c * 64;
    const size_t tok0 = tokc + 32 * hf;
    const float* HLF = (const float*)(p.ws + OFF_HLF);
    const bf16_t* HQ = (const bf16_t*)(p.ws + OFF_HQ);
    const bf16_t* HI = (const bf16_t*)(p.ws + OFF_HI);
    const bf16_t* HG = (const bf16_t*)(p.ws + OFF_HG);
    unsigned char* R0 = smem;
    unsigned char* R1 = smem + 16384;
    unsigned char* R2 = smem + 57344;
    float* xch = (float*)R2;
    const float* lfp = HLF + tok0 * 512 + h * 128 + d;
    const bf16_t* qp = HQ + tok0 * 512 + h * 128 + d;
    float run = 0.f, b15 = 0.f;
#pragma unroll 8
    for (int s = 0; s < 32; ++s) { run += lfp[s * 512]; if (s == 15) b15 = run; }
    __syncthreads();
    xch[hf * 128 + d] = run;
    if (hf == 0) xch[256 + d] = b15;
    __syncthreads();
    const float tot0 = xch[d];
    const float off = hf ? tot0 : 0.f;
    const float r1 = xch[256 + d], r2 = tot0;
    if (hf) xch[384 + d] = off + b15;
    run = off;
#pragma unroll 8
    for (int s = 0; s < 32; ++s) {
        const int t = 32 * hf + s;
        run += lfp[s * 512];
        const float qv = bf2f(qp[s * 512]);
        *(bf16_t*)(R0 + t * 256 + ((((d >> 3) ^ (t & 15))) << 4) + (d & 7) * 2) = (bf16_t)f2bf(qv * expf(run));
    }
    {
        const bf16_t* SCp = (const bf16_t*)(p.ws + OFF_SC) + (size_t)chunk * 16384;
#pragma unroll
        for (int i = 0; i < 8; ++i) {
            const int cc = tid + 256 * i, row = cc >> 4, ch = cc & 15;
            *(uint4*)(R1 + row * 256 + ((ch ^ (row & 15)) << 4)) = *(const uint4*)(SCp + row * 128 + ch * 8);
        }
    }
    __syncthreads();
    f32x4 acc[8];
#pragma unroll
    for (int et = 0; et < 8; ++et) acc[et] = (f32x4){0.f, 0.f, 0.f, 0.f};
#pragma unroll
    for (int ds = 0; ds < 4; ++ds) {
        const int ch = ds * 4 + (lane >> 4);
        const int trow = w * 16 + (lane & 15);
        const bf16x8 bq = *(const bf16x8*)(R0 + trow * 256 + ((ch ^ (trow & 15)) << 4));
#pragma unroll
        for (int et = 0; et < 8; ++et) {
            const int row = et * 16 + (lane & 15);
            const bf16x8 av = *(const bf16x8*)(R1 + row * 256 + ((ch ^ (row & 15)) << 4));
            acc[et] = __builtin_amdgcn_mfma_f32_16x16x32_bf16(av, bq, acc[et], 0, 0, 0);
        }
    }
    __syncthreads();
    {
        const float r3 = xch[384 + d];
        run = off;
#pragma unroll 4
        for (int s = 0; s < 32; ++s) {
            const int t = 32 * hf + s;
            const int it = t >> 4;
            const float rr = (it == 0) ? 0.f : (it == 1) ? r1 : (it == 2) ? r2 : r3;
            const int sw = (((d >> 3) ^ (t & 15)) << 4) + (d & 7) * 2;
            const float lf = lfp[s * 512];
            run += lf;
            const float qv = bf2f(qp[s * 512]);
            const float kv = 1.f - expf(lf);
            *(bf16_t*)(R0 + t * 256 + sw) = (bf16_t)f2bf(qv * expf(run - rr));
#pragma unroll
            for (int i = 0; i < 4; ++i) {
                if (i >= it) {
                    const float ri = (i == 0) ? 0.f : (i == 1) ? r1 : (i == 2) ? r2 : r3;
                    const int R = 8 * i * (i + 1) + t;
                    *(bf16_t*)(R1 + R * 256 + sw) = (bf16_t)f2bf(kv * expf(ri - run));
                }
            }
        }
    }
    __syncthreads();
#pragma unroll
    for (int j = 0; j < 4; ++j) {
        uint2 o = make_uint2(0u, 0u);
        if (j <= w) {
            f32x4 pa = (f32x4){0.f, 0.f, 0.f, 0.f};
#pragma unroll
            for (int ds = 0; ds < 4; ++ds) {
                const int ch = ds * 4 + (lane >> 4);
                const int krow = 8 * w * (w + 1) + 16 * j + (lane & 15);
                const int trow = w * 16 + (lane & 15);
                const bf16x8 av = *(const bf16x8*)(R1 + krow * 256 + ((ch ^ (krow & 15)) << 4));
                const bf16x8 bq = *(const bf16x8*)(R0 + trow * 256 + ((ch ^ (trow & 15)) << 4));
                pa = __builtin_amdgcn_mfma_f32_16x16x32_bf16(av, bq, pa, 0, 0, 0);
            }
            if (j == w) {
                const int tl = lane & 15, sl = (lane >> 4) * 4;
#pragma unroll
                for (int r = 0; r < 4; ++r) if (sl + r > tl) pa[r] = 0.f;
            }
            o.x = pack2bf(pa[0], pa[1]); o.y = pack2bf(pa[2], pa[3]);
        }
        const int t = w * 16 + (lane & 15);
        const int ch = 2 * j + (lane >> 5);
        *(uint2*)(R2 + t * 128 + ((ch ^ (t & 7)) << 4) + ((lane >> 4) & 1) * 8) = o;
    }
    __syncthreads();
#pragma unroll
    for (int q = 0; q < 4; ++q) {
        float vv[8];
#pragma unroll
        for (int j = 0; j < 8; ++j) vv[j] = bf2f(HI[(tok0 + q * 8 + j) * 512 + h * 128 + d]);
        const int ch = 4 * hf + q;
        *(uint4*)(R1 + d * 128 + ((ch ^ (d & 7)) << 4)) = pack8bf(vv);
    }
    __syncthreads();
#pragma unroll
    for (int st = 0; st < 2; ++st) {
        const int ch = st * 4 + (lane >> 4);
        const int trow = w * 16 + (lane & 15);
        const bf16x8 bp = *(const bf16x8*)(R2 + trow * 128 + ((ch ^ (trow & 7)) << 4));
#pragma unroll
        for (int et = 0; et < 8; ++et) {
            const int row = et * 16 + (lane & 15);
            const bf16x8 av = *(const bf16x8*)(R1 + row * 128 + ((ch ^ (row & 7)) << 4));
            acc[et] = __builtin_amdgcn_mfma_f32_16x16x32_bf16(av, bp, acc[et], 0, 0, 0);
        }
    }
    {
        float ss = 0.f;
#pragma unroll
        for (int et = 0; et < 8; ++et)
#pragma unroll
            for (int r = 0; r < 4; ++r) ss += acc[et][r] * acc[et][r];
        ss += __shfl_xor(ss, 16);
        ss += __shfl_xor(ss, 32);
        const float rs = rsqrtf(ss * (1.f / 128.f) + LN_EPS);
        const size_t tok = tokc + w * 16 + (lane & 15);
        const float* ng = p.in[4];
        bf16_t* MIX = (bf16_t*)(p.ws + OFF_XB);
#pragma unroll
        for (int et = 0; et < 8; ++et) {
            const int e0 = et * 16 + (lane >> 4) * 4;
            const uint2 gb = *(const uint2*)(HG + tok * 512 + h * 128 + e0);
            const float4 n4 = *(const float4*)(ng + e0);
            const float g0 = bf2f(gb.x & 0xffffu), g1 = bf2f(gb.x >> 16), g2 = bf2f(gb.y & 0xffffu), g3 = bf2f(gb.y >> 16);
            uint2 o;
            o.x = pack2bf(acc[et][0] * rs * n4.x * (g0 * sigmoidf_(g0)), acc[et][1] * rs * n4.y * (g1 * sigmoidf_(g1)));
            o.y = pack2bf(acc[et][2] * rs * n4.z * (g2 * sigmoidf_(g2)), acc[et][3] * rs * n4.w * (g3 * sigmoidf_(g3)));
            *(uint2*)(MIX + tok * DM + h * 128 + e0) = o;
        }
    }
}

__device__ __forceinline__ void compress_item(const Params& p, int item, float* sm) {
    const int g = item & 1;
    int r = item >> 1;
    const int n = r % NCB; r /= NCB;
    const int b = r & 3, which = r >> 2;
    const int tid = threadIdx.x;
    const bf16_t* kvsrc = (const bf16_t*)(p.ws + OFF_KV + (size_t)which * KV_STRIDE);
    const float* pe = p.in[which ? 10 : 5];
    const float* w1 = p.in[which ? 11 : 6];
    const float* b1 = p.in[which ? 12 : 7];
    const float* w2 = p.in[which ? 13 : 8];
    const float* b2 = p.in[which ? 14 : 9];
    float* outp = (float*)(p.ws + (which ? OFF_CMPV : OFF_CMPK));
    float* blk = sm;
    float* hh = sm + 2048;
    __syncthreads();
    for (int i = tid; i < 2048; i += 256) {
        const int l = i >> 6, d = i & 63;
        blk[i] = bf2f(kvsrc[(size_t)(b * SEQ + 16 * n + l) * 128 + g * 64 + d]) + pe[i];
    }
    __syncthreads();
    float acc = b1[tid];
    for (int i = 0; i < 2048; ++i) acc += blk[i] * w1[(size_t)i * 256 + tid];
    hh[tid] = gelu_tanh(acc);
    __syncthreads();
    if (tid < 64) {
        float o = b2[tid];
        for (int j = 0; j < 256; ++j) o += hh[j] * w2[j * 64 + tid];
        outp[((size_t)(b * NCB + n) * 2 + g) * 64 + tid] = o;
    }
}

__device__ __forceinline__ float dot64_bf(const float* qs, const bf16_t* krow) {
    float s = 0.f;
#pragma unroll
    for (int i = 0; i < 8; ++i) {
        const uint4 kv = ((const uint4*)krow)[i];
        const float4 q0 = ((const float4*)qs)[2 * i], q1 = ((const float4*)qs)[2 * i + 1];
        s += __uint_as_float(kv.x << 16) * q0.x + __uint_as_float(kv.x & 0xffff0000u) * q0.y
           + __uint_as_float(kv.y << 16) * q0.z + __uint_as_float(kv.y & 0xffff0000u) * q0.w
           + __uint_as_float(kv.z << 16) * q1.x + __uint_as_float(kv.z & 0xffff0000u) * q1.y
           + __uint_as_float(kv.w << 16) * q1.z + __uint_as_float(kv.w & 0xffff0000u) * q1.w;
    }
    return s;
}
__device__ __forceinline__ float dot64(const float* qs, const float* krow) {
    float s = 0.f;
#pragma unroll
    for (int i = 0; i < 16; ++i) {
        const float4 kv = ((const float4*)krow)[i];
        const float4 qv = ((const float4*)qs)[i];
        s += kv.x * qv.x + kv.y * qv.y + kv.z * qv.z + kv.w * qv.w;
    }
    return s;
}

__device__ __forceinline__ void nsa_item(const Params& p, int item, float* sm) {
    const int t = item & (SEQ - 1), g = (item >> 13) & 1, b = item >> 14;
    const int tid = threadIdx.x, lane = tid & 63, r = tid >> 6;
    float* sc = sm + r * 1024;
    float* qs = sm + 4096 + r * 64;
    float* impv = sm + 4096 + 256;
    int* sel = (int*)(sm + 4096 + 256 + 128);
    const bf16_t* KSb = (const bf16_t*)(p.ws + OFF_KV + 2 * KV_STRIDE);
    const bf16_t* VSb = (const bf16_t*)(p.ws + OFF_KV + 3 * KV_STRIDE);
    const bf16_t* KWb = (const bf16_t*)(p.ws + OFF_KV + 4 * KV_STRIDE);
    const bf16_t* VWb = (const bf16_t*)(p.ws + OFF_KV + 5 * KV_STRIDE);
    const float* cmpk = (const float*)(p.ws + OFF_CMPK);
    const float* cmpv = (const float*)(p.ws + OFF_CMPV);
    const size_t n = (size_t)b * SEQ + t;
    const float NEGV = -1e30f;
    __syncthreads();
    qs[lane] = bf2f(((const bf16_t*)(p.ws + OFF_NQ))[n * 512 + g * 256 + r * 64 + lane]);
    __syncthreads();

    const int nvalid = (t >= 31) ? (((t - 31) >> 4) + 1) : 0;
    float m = NEGV;
    for (int n0 = 0; n0 < nvalid; n0 += 64) {
        const int nn = n0 + lane;
        if (nn < nvalid) {
            const float s = dot64(qs, cmpk + ((size_t)(b * NCB + nn) * 2 + g) * 64);
            sc[nn] = s;
            m = fmaxf(m, s);
        }
    }
    m = wave_max(m);
    float sum = 0.f;
    for (int n0 = 0; n0 < nvalid; n0 += 64) {
        const int nn = n0 + lane;
        if (nn < nvalid) { const float e = expf(sc[nn] - m); sc[nn] = e; sum += e; }
    }
    sum = wave_sum(sum);
    {
        const float inv = 1.f / fmaxf(sum, 1e-30f);
        for (int n0 = 0; n0 < nvalid; n0 += 64) {
            const int nn = n0 + lane;
            if (nn < nvalid) sc[nn] *= inv;
        }
    }
    __syncthreads();
    float oc = 0.f;
    for (int nn = 0; nn < nvalid; ++nn) oc += sc[nn] * cmpv[((size_t)(b * NCB + nn) * 2 + g) * 64 + lane];

    const int cur = t >> 6;
    if (tid < 128) {
        const int j = tid;
        float im = 0.f;
#pragma unroll
        for (int rr = 0; rr < 4; ++rr) {
            const float* P = sm + rr * 1024;
            const int n4 = 4 * j;
            float a = 0.f;
            if (n4 < nvalid) a += P[n4];
            if (n4 + 1 < nvalid) a += P[n4 + 1];
            if (n4 + 2 < nvalid) a += P[n4 + 2];
            if (n4 + 3 < nvalid) a += 0.5f * P[n4 + 3];
            if (n4 - 1 >= 0 && n4 - 1 < nvalid) a += 0.5f * P[n4 - 1];
            im += a;
        }
        const bool forced = (j == 0) || (j == cur) || (j == cur - 1);
        const bool causal = (j <= cur);
        impv[j] = forced ? 1.0e4f : (causal ? im : -1.f);
    }
    __syncthreads();
    if (r == 0) {
        float v0 = impv[lane], v1 = impv[lane + 64];
        for (int k = 0; k < 16; ++k) {
            const float mx = wave_max(fmaxf(v0, v1));
            const unsigned long long b0 = __ballot(v0 == mx);
            int idx;
            if (b0) {
                const int l = __ffsll((unsigned long long)b0) - 1;
                idx = l;
                if (lane == l) v0 = -3.0e38f;
            } else {
                const unsigned long long b1 = __ballot(v1 == mx);
                const int l = __ffsll((unsigned long long)b1) - 1;
                idx = 64 + l;
                if (lane == l) v1 = -3.0e38f;
            }
            if (lane == 0) sel[k] = idx;
        }
    }
    __syncthreads();

    m = NEGV;
    for (int si = 0; si < 16; ++si) {
        const int blk = sel[si];
        const int key = blk * 64 + lane;
        float s = NEGV;
        if (blk * 64 <= t) {
            if (key <= t) s = dot64_bf(qs, KSb + ((size_t)b * SEQ + key) * 128 + g * 64);
        }
        sc[si * 64 + lane] = s;
        m = fmaxf(m, s);
    }
    m = wave_max(m);
    sum = 0.f;
    for (int si = 0; si < 16; ++si) {
        const int key = sel[si] * 64 + lane;
        const float e = (key <= t) ? expf(sc[si * 64 + lane] - m) : 0.f;
        sc[si * 64 + lane] = e;
        sum += e;
    }
    sum = wave_sum(sum);
    {
        const float inv = 1.f / fmaxf(sum, 1e-30f);
        for (int si = 0; si < 16; ++si) sc[si * 64 + lane] *= inv;
    }
    __syncthreads();
    float os = 0.f;
    for (int si = 0; si < 16; ++si) {
        const int blk = sel[si];
        if (blk * 64 > t) continue;
        for (int kk = 0; kk < 64; ++kk) {
            const int key = blk * 64 + kk;
            if (key > t) break;
            os += sc[si * 64 + kk] * bf2f(VSb[((size_t)b * SEQ + key) * 128 + g * 64 + lane]);
        }
    }
    __syncthreads();

    const int lo = t - 511;
    m = NEGV;
    for (int i = 0; i < 8; ++i) {
        const int key = lo + i * 64 + lane;
        float s = NEGV;
        if (key >= 0) s = dot64_bf(qs, KWb + ((size_t)b * SEQ + key) * 128 + g * 64);
        sc[i * 64 + lane] = s;
        m = fmaxf(m, s);
    }
    m = wave_max(m);
    sum = 0.f;
    for (int i = 0; i < 8; ++i) {
        const int key = lo + i * 64 + lane;
        const float e = (key >= 0) ? expf(sc[i * 64 + lane] - m) : 0.f;
        sc[i * 64 + lane] = e;
        sum += e;
    }
    sum = wave_sum(sum);
    {
        const float inv = 1.f / fmaxf(sum, 1e-30f);
        for (int i = 0; i < 8; ++i) sc[i * 64 + lane] *= inv;
    }
    __syncthreads();
    float ow = 0.f;
    for (int idx = 0; idx < 512; ++idx) {
        const int key = lo + idx;
        if (key < 0) continue;
        ow += sc[idx] * bf2f(VWb[((size_t)b * SEQ + key) * 128 + g * 64 + lane]);
    }
    const float* grow = (const float*)(p.ws + OFF_NGATE) + n * 24 + g * 12 + r * 3;
    const float gc = grow[0], gs = grow[1], gw = grow[2];
#if NSA_DIAG
    {
        const float ref = gc * oc + gs * os + gw * ow;
        const float got = bf2f(((const bf16_t*)(p.ws + OFF_XB))[n * DM + 512 + g * 256 + r * 64 + lane]);
        const unsigned* SELM = (const unsigned*)(p.ws + OFF_SELM) + ((size_t)(b * 2 + g) * SEQ + t) * 4;
        unsigned gm[4] = {0u, 0u, 0u, 0u};
        for (int si = 0; si < 16; ++si) { const int blk = sel[si]; if (blk * 64 <= t) gm[blk >> 5] |= 1u << (blk & 31); }
        bool same = true;
        for (int qd = 0; qd < 4; ++qd) {
            unsigned mm = SELM[qd];
            for (int bit = 0; bit < 32; ++bit) if ((qd * 32 + bit) * 64 > t) mm &= ~(1u << bit);
            if (mm != gm[qd]) same = false;
        }
        float d2 = same ? (got - ref) * (got - ref) : 0.f, r2 = same ? ref * ref : 0.f;
        d2 = wave_sum(d2); r2 = wave_sum(r2);
        float* DG = (float*)(p.ws + OFF_DIAG);
        if (lane == 0) { atomicAdd(&DG[0], d2); atomicAdd(&DG[1], r2); if (r == 0) { atomicAdd(&DG[2], same ? 0.f : 1.f); atomicAdd(&DG[3], 1.f); } }
    }
#else
    ((bf16_t*)(p.ws + OFF_XB))[n * DM + 512 + g * 256 + r * 64 + lane] = (bf16_t)f2bf(gc * oc + gs * os + gw * ow);
#endif
}


struct EpiCmpH {
    bf16_t* HB; const float* peb;
    __device__ __forceinline__ void operator()(int m, int n, f32x4 v) const {
        const float4 pb = *(const float4*)(peb + n);
        uint2 o;
        o.x = pack2bf(gelu_tanh(v[0] + pb.x), gelu_tanh(v[1] + pb.y));
        o.y = pack2bf(gelu_tanh(v[2] + pb.z), gelu_tanh(v[3] + pb.w));
        *(uint2*)(HB + (size_t)m * 256 + n) = o;
    }
    __device__ __forceinline__ void finish(int, int) const {}
};
__device__ __forceinline__ void cmp_peb(const Params& p, int which) {
    const float* pe = p.in[which ? 10 : 5];
    const float* w1 = p.in[which ? 11 : 6];
    const float* b1 = p.in[which ? 12 : 7];
    const int j = threadIdx.x;
    float acc = b1[j];
    for (int i = 0; i < 2048; ++i) acc += pe[i] * w1[(size_t)i * 256 + j];
    ((float*)(p.ws + OFF_PEB))[which * 256 + j] = acc;
}
__device__ __forceinline__ void cmp_layer2_phase(const Params& p, int first_block, int nblocks) {
    const int lane = threadIdx.x & 63, w = threadIdx.x >> 6;
    for (int it = (blockIdx.x - first_block) * 4 + w; it < 2 * 4088; it += nblocks * 4) {
        const int which = it >= 4088, row = which ? it - 4088 : it;
        const float* w2 = p.in[which ? 13 : 8];
        const float* b2 = p.in[which ? 14 : 9];
        const bf16_t* hrow = (const bf16_t*)(p.ws + OFF_HB) + ((size_t)which * 4096 + row) * 256;
        float o = b2[lane];
#pragma unroll 8
        for (int j = 0; j < 256; ++j) o += bf2f(hrow[j]) * w2[j * 64 + lane];
        const int g = row & 1, bn = row >> 1, n = bn % NCB, b = bn / NCB;
        ((bf16_t*)(p.ws + (which ? OFF_CMPVB : OFF_CMPKB)))[((size_t)(b * 2 + g) * 512 + n) * 64 + lane] = (bf16_t)f2bf(o);
    }
}

struct StageOfs { int k, v0, v1, v2, v3; };
__device__ __forceinline__ StageOfs make_stage_ofs() {
    const int c0 = threadIdx.x, key = c0 >> 3, ch = c0 & 7;
    const int ko = (key & 3) * 2, ku = key >> 2, bu = ku ^ (4 * (ch & 1));
    StageOfs s;
    s.k = key * 128 + ((ch ^ (key & 7)) << 4);
    s.v0 = ch * 1024 + ((bu ^ 0) << 3) + ko;
    s.v1 = ch * 1024 + ((bu ^ 1) << 3) + ko;
    s.v2 = ch * 1024 + ((bu ^ 2) << 3) + ko;
    s.v3 = ch * 1024 + ((bu ^ 3) << 3) + ko;
    return s;
}
__device__ __forceinline__ void vt_scatter(unsigned char* VTl, const StageOfs& s, int extra, uint4 v) {
    *(bf16_t*)(VTl + s.v0 + 0 * 128 + extra) = (bf16_t)(v.x & 0xffffu);
    *(bf16_t*)(VTl + s.v0 + 1 * 128 + extra) = (bf16_t)(v.x >> 16);
    *(bf16_t*)(VTl + s.v1 + 2 * 128 + extra) = (bf16_t)(v.y & 0xffffu);
    *(bf16_t*)(VTl + s.v1 + 3 * 128 + extra) = (bf16_t)(v.y >> 16);
    *(bf16_t*)(VTl + s.v2 + 4 * 128 + extra) = (bf16_t)(v.z & 0xffffu);
    *(bf16_t*)(VTl + s.v2 + 5 * 128 + extra) = (bf16_t)(v.z >> 16);
    *(bf16_t*)(VTl + s.v3 + 6 * 128 + extra) = (bf16_t)(v.w & 0xffffu);
    *(bf16_t*)(VTl + s.v3 + 7 * 128 + extra) = (bf16_t)(v.w >> 16);
}
#define NSA_KV_LOAD(kb_) { const bf16_t* kp_ = Kbase + (size_t)(kb_) * 64 * stride + (size_t)(tid >> 3) * stride + (tid & 7) * 8; \
        const bf16_t* vp_ = Vbase + (size_t)(kb_) * 64 * stride + (size_t)(tid >> 3) * stride + (tid & 7) * 8;                 \
        rk0 = *(const uint4*)kp_; rk1 = *(const uint4*)(kp_ + (size_t)32 * stride);                                          \
        rv0 = *(const uint4*)vp_; rv1 = *(const uint4*)(vp_ + (size_t)32 * stride); }
#define NSA_KV_STORE(Kl_, VTl_) { *(uint4*)((Kl_) + sof.k) = rk0; *(uint4*)((Kl_) + sof.k + 4096) = rk1; \
        vt_scatter((VTl_), sof, 0, rv0); vt_scatter((VTl_), sof, 64, rv1); }
template <class Compute>
__device__ __forceinline__ void nsa_kv_loop(const bf16_t* __restrict__ Kbase, const bf16_t* __restrict__ Vbase, int stride,
                                            int kb_lo, int kb_hi, unsigned char* smem, const StageOfs& sof, Compute compute) {
    const int tid = threadIdx.x;
    uint4 rk0, rk1, rv0, rv1;
    NSA_KV_LOAD(kb_lo)
    __syncthreads();
    NSA_KV_STORE(smem, smem + 16384)
    __syncthreads();
    for (int kb = kb_lo; kb <= kb_hi; ++kb) {
        const int buf = (kb - kb_lo) & 1;
        if (kb < kb_hi) NSA_KV_LOAD(kb + 1)
        compute(kb, smem + buf * 8192, smem + 16384 + buf * 8192);
        if (kb < kb_hi) NSA_KV_STORE(smem + (buf ^ 1) * 8192, smem + 16384 + (buf ^ 1) * 8192)
        __syncthreads();
    }
}
struct LaneOfs { int k0, k1, v0, v1; };
__device__ __forceinline__ LaneOfs make_lane_ofs(int lane) {
    LaneOfs f;
    const int r15 = lane & 15, lg = lane >> 4, sw = (r15 >> 1) & 7;
    f.k0 = r15 * 128 + ((lg ^ (r15 & 7)) << 4);
    f.k1 = r15 * 128 + (((4 + lg) ^ (r15 & 7)) << 4);
    f.v0 = r15 * 128 + ((lg ^ sw) << 3);
    f.v1 = r15 * 128 + (((lg + 4) ^ sw) << 3);
    return f;
}
#define LOG2E 1.4426950408889634f
__device__ __forceinline__ void nsa_scores(const unsigned char* Kl, const LaneOfs& f, const bf16x8& q0, const bf16x8& q1, f32x4 (&s)[4]) {
#pragma unroll
    for (int kt = 0; kt < 4; ++kt) {
        const bf16x8 a0 = *(const bf16x8*)(Kl + f.k0 + kt * 2048);
        const bf16x8 a1 = *(const bf16x8*)(Kl + f.k1 + kt * 2048);
        f32x4 z = (f32x4){0.f, 0.f, 0.f, 0.f};
        z = __builtin_amdgcn_mfma_f32_16x16x32_bf16(a0, q0, z, 0, 0, 0);
        z = __builtin_amdgcn_mfma_f32_16x16x32_bf16(a1, q1, z, 0, 0, 0);
        s[kt][0] = z[0] * LOG2E; s[kt][1] = z[1] * LOG2E; s[kt][2] = z[2] * LOG2E; s[kt][3] = z[3] * LOG2E;
    }
}
template <class VF>
__device__ __forceinline__ void attn_step(const unsigned char* Kl, const unsigned char* VTl, int lane, const LaneOfs& f,
                                          const bf16x8& q0, const bf16x8& q1, f32x4 (&o)[4], float& m, float& l, VF valid) {
    f32x4 s[4];
    nsa_scores(Kl, f, q0, q1, s);
    float mx = -1e30f;
#pragma unroll
    for (int kt = 0; kt < 4; ++kt)
#pragma unroll
        for (int r = 0; r < 4; ++r) {
            const bool v = valid(kt * 16 + 4 * (lane >> 4) + r);
            s[kt][r] = v ? s[kt][r] : -1e30f;
            mx = fmaxf(mx, s[kt][r]);
        }
    mx = fmaxf(mx, __shfl_xor(mx, 16));
    mx = fmaxf(mx, __shfl_xor(mx, 32));
    const float mn = fmaxf(m, mx);
    const float alpha = __builtin_amdgcn_exp2f(m - mn);
    float ps = 0.f;
#pragma unroll
    for (int kt = 0; kt < 4; ++kt)
#pragma unroll
        for (int r = 0; r < 4; ++r) {
            const float pv = (s[kt][r] > -1e29f) ? __builtin_amdgcn_exp2f(s[kt][r] - mn) : 0.f;
            s[kt][r] = pv; ps += pv;
        }
    l = l * alpha + ps; m = mn;
#pragma unroll
    for (int dt = 0; dt < 4; ++dt) { o[dt][0] *= alpha; o[dt][1] *= alpha; o[dt][2] *= alpha; o[dt][3] *= alpha; }
#pragma unroll
    for (int k2 = 0; k2 < 2; ++k2) {
        uint4 pk;
        pk.x = pack2bf(s[2 * k2][0], s[2 * k2][1]); pk.y = pack2bf(s[2 * k2][2], s[2 * k2][3]);
        pk.z = pack2bf(s[2 * k2 + 1][0], s[2 * k2 + 1][1]); pk.w = pack2bf(s[2 * k2 + 1][2], s[2 * k2 + 1][3]);
        const bf16x8 pb = __builtin_bit_cast(bf16x8, pk);
#pragma unroll
        for (int dt = 0; dt < 4; ++dt) {
            uint4 av;
            const uint2 lo = *(const uint2*)(VTl + f.v0 + dt * 2048 + k2 * 64);
            const uint2 hi = *(const uint2*)(VTl + f.v1 + dt * 2048 + k2 * 64);
            av.x = lo.x; av.y = lo.y; av.z = hi.x; av.w = hi.y;
            o[dt] = __builtin_amdgcn_mfma_f32_16x16x32_bf16(__builtin_bit_cast(bf16x8, av), pb, o[dt], 0, 0, 0);
        }
    }
}
__device__ __forceinline__ unsigned sel4(const unsigned (&a)[4], int q) {
    return q == 0 ? a[0] : (q == 1 ? a[1] : (q == 2 ? a[2] : a[3]));
}

#define NSA_TILES 4096
__device__ __forceinline__ void nsa_tile(const Params& p, int tile, unsigned char* smem) {
    const int tid = threadIdx.x, lane = tid & 63, w = tid >> 6;
    const int bg = tile & 7, tb = 511 - (tile >> 3);
    const int b = bg >> 1, g = bg & 1;
    const int t0 = tb * 16, cur = t0 >> 6;
    float* impL = (float*)(smem + 32768);
    unsigned* selL = (unsigned*)(smem + 49152);
    const bf16_t* NQ = (const bf16_t*)(p.ws + OFF_NQ);
    const float* NG = (const float*)(p.ws + OFF_NGATE);
    const int rowq = lane & 15, tl = rowq >> 2, head = rowq & 3, lg = lane >> 4;
    const int tokl = 4 * w + tl;
    const LaneOfs lof = make_lane_ofs(lane);
    const StageOfs sof = make_stage_ofs();
    const size_t tokb = (size_t)b * SEQ + t0;
    bf16x8 q0, q1;
    {
        const bf16_t* qp = NQ + (tokb + tokl) * 512 + g * 256 + head * 64 + lg * 8;
        q0 = *(const bf16x8*)qp; q1 = *(const bf16x8*)(qp + 32);
    }
    const float* gp = NG + (tokb + tokl) * 24 + g * 12 + head * 3;
    __syncthreads();
    for (int i = tid; i < 2048; i += 256) impL[i] = 0.f;
    const int tq = t0 + tokl;
    f32x4 o[4], ot[4];
    float m, l;
#define NSA_RESET() { _Pragma("unroll") for (int dt = 0; dt < 4; ++dt) o[dt] = (f32x4){0.f, 0.f, 0.f, 0.f}; m = -1e30f; l = 0.f; }
#define NSA_LSUM() { l += __shfl_xor(l, 16); l += __shfl_xor(l, 32); }

    const int nv = (tq >= 31) ? (((tq - 31) >> 4) + 1) : 0;
    const int nkb = ((t0 >> 4) + 63) >> 6;
    const bf16_t* ckb = (const bf16_t*)(p.ws + OFF_CMPKB) + (size_t)(b * 2 + g) * 512 * 64;
    const bf16_t* cvb = (const bf16_t*)(p.ws + OFF_CMPVB) + (size_t)(b * 2 + g) * 512 * 64;
    NSA_RESET()
    nsa_kv_loop(ckb, cvb, 64, 0, nkb - 1, smem, sof, [&](int kb, const unsigned char* Kl, const unsigned char* VTl) __attribute__((always_inline)) {
        attn_step(Kl, VTl, lane, lof, q0, q1, o, m, l, [&](int key) __attribute__((always_inline)) { return kb * 64 + key < nv; });
    });
    NSA_LSUM()
    const float mc = m;
    const float invc = 1.f / fmaxf(l, 1e-30f);
    {
        const float f = gp[0] * invc;
#pragma unroll
        for (int dt = 0; dt < 4; ++dt) { ot[dt][0] = f * o[dt][0]; ot[dt][1] = f * o[dt][1]; ot[dt][2] = f * o[dt][2]; ot[dt][3] = f * o[dt][3]; }
    }
    if (cur >= 16) {
        nsa_kv_loop(ckb, cvb, 64, 0, nkb - 1, smem, sof, [&](int kb, const unsigned char* Kl, const unsigned char* VTl) __attribute__((always_inline)) {
            f32x4 s[4];
            nsa_scores(Kl, lof, q0, q1, s);
            float* impT = impL + tokl * 128;
#pragma unroll
            for (int kt = 0; kt < 4; ++kt) {
                float pr[4];
#pragma unroll
                for (int r = 0; r < 4; ++r) {
                    const int n = kb * 64 + kt * 16 + 4 * lg + r;
                    pr[r] = (n < nv) ? __builtin_amdgcn_exp2f(s[kt][r] - mc) * invc : 0.f;
                }
                float c1 = pr[0] + pr[1] + pr[2] + 0.5f * pr[3], c2 = 0.5f * pr[3];
                c1 += __shfl_xor(c1, 1); c1 += __shfl_xor(c1, 2);
                c2 += __shfl_xor(c2, 1); c2 += __shfl_xor(c2, 2);
                const int j = kb * 16 + kt * 4 + lg;
                if (head == 0) {
                    atomicAdd(&impT[j], c1);
                    if (j + 1 < 128) atomicAdd(&impT[j + 1], c2);
                }
            }
        });
        for (int tk = 0; tk < 4; ++tk) {
            const int tok = 4 * w + tk;
            const int jA = lane, jB = lane + 64;
            float v0, v1;
            {
                const bool fA = (jA == 0) || (jA == cur) || (jA == cur - 1), fB = (jB == cur) || (jB == cur - 1);
                v0 = fA ? 1.0e4f : ((jA <= cur) ? impL[tok * 128 + jA] : -1.f);
                v1 = fB ? 1.0e4f : ((jB <= cur) ? impL[tok * 128 + jB] : -1.f);
            }
            bool s0 = false, s1 = false;
            for (int k = 0; k < 16; ++k) {
                const float mx = wave_max(fmaxf(v0, v1));
                const unsigned long long b0 = __ballot(v0 == mx);
                if (b0) {
                    const int lsel = __ffsll((unsigned long long)b0) - 1;
                    if (lane == lsel) { v0 = -3.0e38f; s0 = true; }
                } else {
                    const unsigned long long b1 = __ballot(v1 == mx);
                    const int lsel = __ffsll((unsigned long long)b1) - 1;
                    if (lane == lsel) { v1 = -3.0e38f; s1 = true; }
                }
            }
            const unsigned long long mk0 = __ballot(s0), mk1 = __ballot(s1);
            if (lane == 0) {
                selL[tok * 4 + 0] = (unsigned)mk0; selL[tok * 4 + 1] = (unsigned)(mk0 >> 32);
                selL[tok * 4 + 2] = (unsigned)mk1; selL[tok * 4 + 3] = (unsigned)(mk1 >> 32);
            }
        }
    } else {
        if (lane < 4) {
            const int tok = 4 * w + lane;
            selL[tok * 4 + 0] = (2u << cur) - 1u; selL[tok * 4 + 1] = 0u; selL[tok * 4 + 2] = 0u; selL[tok * 4 + 3] = 0u;
        }
    }
    WAVE_LDS_SYNC();
#if NSA_DIAG
    if (head == 0 && lg == 0) {
        unsigned* SELM = (unsigned*)(p.ws + OFF_SELM);
#pragma unroll
        for (int qd = 0; qd < 4; ++qd) SELM[((size_t)bg * SEQ + tq) * 4 + qd] = selL[tokl * 4 + qd];
    }
#endif
    NSA_RESET()
    {
        const bf16_t* kg = (const bf16_t*)(p.ws + OFF_KV + 2 * KV_STRIDE) + (size_t)b * SEQ * 128 + g * 64;
        const bf16_t* vg = (const bf16_t*)(p.ws + OFF_KV + 3 * KV_STRIDE) + (size_t)b * SEQ * 128 + g * 64;
        nsa_kv_loop(kg, vg, 128, 0, cur, smem, sof, [&](int kb, const unsigned char* Kl, const unsigned char* VTl) __attribute__((always_inline)) {
            const bool sv = (selL[tokl * 4 + (kb >> 5)] >> (kb & 31)) & 1u;
            if (__ballot(sv) != 0ull)
                attn_step(Kl, VTl, lane, lof, q0, q1, o, m, l, [&](int key) __attribute__((always_inline)) { return sv && (kb * 64 + key <= tq); });
        });
    }
    NSA_LSUM()
    {
        const float f = gp[1] / fmaxf(l, 1e-30f);
#pragma unroll
        for (int dt = 0; dt < 4; ++dt) { ot[dt][0] += f * o[dt][0]; ot[dt][1] += f * o[dt][1]; ot[dt][2] += f * o[dt][2]; ot[dt][3] += f * o[dt][3]; }
    }
    NSA_RESET()
    {
        const bf16_t* kg = (const bf16_t*)(p.ws + OFF_KV + 4 * KV_STRIDE) + (size_t)b * SEQ * 128 + g * 64;
        const bf16_t* vg = (const bf16_t*)(p.ws + OFF_KV + 5 * KV_STRIDE) + (size_t)b * SEQ * 128 + g * 64;
        const int klo = (t0 > 511) ? ((t0 - 511) >> 6) : 0;
        nsa_kv_loop(kg, vg, 128, klo, cur, smem, sof, [&](int kb, const unsigned char* Kl, const unsigned char* VTl) __attribute__((always_inline)) {
            attn_step(Kl, VTl, lane, lof, q0, q1, o, m, l, [&](int key) __attribute__((always_inline)) { const int ka = kb * 64 + key; return (ka <= tq) && (ka >= tq - 511); });
        });
    }
    NSA_LSUM()
    {
        const float f = gp[2] / fmaxf(l, 1e-30f);
        bf16_t* MIX = (bf16_t*)(p.ws + OFF_XB);
#pragma unroll
        for (int dt = 0; dt < 4; ++dt) {
            uint2 ov;
            ov.x = pack2bf(ot[dt][0] + f * o[dt][0], ot[dt][1] + f * o[dt][1]);
            ov.y = pack2bf(ot[dt][2] + f * o[dt][2], ot[dt][3] + f * o[dt][3]);
            *(uint2*)(MIX + (tokb + tokl) * DM + 512 + g * 256 + head * 64 + dt * 16 + lg * 4) = ov;
        }
    }
#undef NSA_RESET
#undef NSA_LSUM
}

__device__ __forceinline__ float block_sum(float v, float* red) {
    v = wave_sum(v);
    __syncthreads();
    if ((threadIdx.x & 63) == 0) red[threadIdx.x >> 6] = v;
    __syncthreads();
    return red[0] + red[1] + red[2] + red[3];
}
__device__ __forceinline__ float4 ln_row(float4 y, const float* g, const float* bb, float* red) {
    const int tid = threadIdx.x;
    const float mu = block_sum(y.x + y.y + y.z + y.w, red) * (1.f / 1024.f);
    const float dx = y.x - mu, dy = y.y - mu, dz = y.z - mu, dw = y.w - mu;
    const float var = block_sum(dx * dx + dy * dy + dz * dz + dw * dw, red) * (1.f / 1024.f);
    const float rs = rsqrtf(var + LN_EPS);
    const float4 gg = ((const float4*)g)[tid], b4 = ((const float4*)bb)[tid];
    return make_float4(dx * rs * gg.x + b4.x, dy * rs * gg.y + b4.y, dz * rs * gg.z + b4.z, dw * rs * gg.w + b4.w);
}

__device__ __forceinline__ void ln1_phase(const Params& p, float* sm) {
    const int tid = threadIdx.x;
    for (int n = blockIdx.x; n < NTOK; n += gridDim.x) {
        const float4 y = ((const float4*)(p.out + (size_t)n * DM))[tid];
        const float4 o = ln_row(y, p.in[15], p.in[16], sm);
        ((float4*)(p.out + (size_t)n * DM))[tid] = o;
        uint2 hb; hb.x = pack2bf(o.x, o.y); hb.y = pack2bf(o.z, o.w);
        ((uint2*)((bf16_t*)(p.ws + OFF_XB) + (size_t)n * DM))[tid] = hb;
    }
}

typedef __bf16 bf16x2_t __attribute__((ext_vector_type(2)));
template <int CTRL> __device__ __forceinline__ float dppf(float x) {
    return __builtin_bit_cast(float, __builtin_amdgcn_mov_dpp(__builtin_bit_cast(int, x), CTRL, 0xf, 0xf, true));
}
__device__ __forceinline__ float row16_max(float m) {
    m = fmaxf(m, dppf<0x121>(m)); m = fmaxf(m, dppf<0x122>(m));
    m = fmaxf(m, dppf<0x124>(m)); m = fmaxf(m, dppf<0x128>(m));
    return m;
}
__device__ __forceinline__ float row16_sum(float m) {
    m += dppf<0x121>(m); m += dppf<0x122>(m); m += dppf<0x124>(m); m += dppf<0x128>(m);
    return m;
}
__device__ __forceinline__ float dot2bf(unsigned a, unsigned b, float acc) {
    return __builtin_amdgcn_fdot2_f32_bf16(__builtin_bit_cast(bf16x2_t, a), __builtin_bit_cast(bf16x2_t, b), acc, false);
}
__device__ __forceinline__ float enc_key(float v, unsigned idx, unsigned mask) {
    const unsigned u = __float_as_uint(v);
    const unsigned code = (u >> 31) ? idx : (mask - idx);
    return __uint_as_float((u & ~mask) | code);
}
__device__ __forceinline__ unsigned dec_idx(float key, unsigned mask) {
    const unsigned u = __float_as_uint(key);
    const unsigned code = u & mask;
    return (u >> 31) ? code : (mask - code);
}
__device__ __forceinline__ float dec_val(float key, unsigned mask) { return __uint_as_float(__float_as_uint(key) & ~mask); }
#define NEGKEY (-3.0e38f)

__device__ __forceinline__ void fold_ws_phase(const float* __restrict__ wq, const float* __restrict__ k1, const float* __restrict__ k2,
                                              bf16_t* __restrict__ WsT) {
    for (int it = blockIdx.x * 256 + threadIdx.x; it < 2048 * 128; it += gridDim.x * 256) {
        const int r = it & 2047, kg = it >> 11;
        const int a = (r >> 7) & 1, j = r & 127;
        const float* kr = (a ? k2 : k1) + j * 128;
        const float* wr = wq + (size_t)(kg * 8) * 2048 + (r & ~127);
        float s[8];
#pragma unroll
        for (int q = 0; q < 8; ++q) s[q] = 0.f;
        for (int d = 0; d < 128; d += 4) {
            const float4 kv = *(const float4*)(kr + d);
#pragma unroll
            for (int q = 0; q < 8; ++q) {
                const float4 wv = *(const float4*)(wr + (size_t)q * 2048 + d);
                s[q] += wv.x * kv.x + wv.y * kv.y + wv.z * kv.z + wv.w * kv.w;
            }
        }
        uint4 o;
        o.x = pack2bf(s[0], s[1]); o.y = pack2bf(s[2], s[3]); o.z = pack2bf(s[4], s[5]); o.w = pack2bf(s[6], s[7]);
        *(uint4*)(WsT + (size_t)r * 1024 + kg * 8) = o;
    }
}

#define CE_DESC(a, b) { const float t_ = fmaxf(a, b); b = fminf(a, b); a = t_; }

struct EpiTop16 {
    float* topk; unsigned char* lds;
    __device__ __forceinline__ void operator()(int m, int n, f32x4 v) const {
        const int ml = m & 127, g4 = (n & 127) >> 2;
        *(float4*)(lds + ((ml * 32 + (g4 ^ (ml & 7))) << 4)) = make_float4(v[0], v[1], v[2], v[3]);
    }
    __device__ __forceinline__ void finish(int m0, int n0) const {
        __syncthreads();
        const int lane = threadIdx.x & 63, w = threadIdx.x >> 6, c = lane & 15;
        const int L = n0 >> 7;
        for (int it = 0; it < 8; ++it) {
            const int r = w * 32 + it * 4 + (lane >> 4);
            const float4 x0 = *(const float4*)(lds + ((r * 32 + ((2 * c) ^ (r & 7))) << 4));
            const float4 x1 = *(const float4*)(lds + ((r * 32 + ((2 * c + 1) ^ (r & 7))) << 4));
            float l0 = enc_key(x0.x, 8 * c + 0, 127), l1 = enc_key(x0.y, 8 * c + 1, 127), l2 = enc_key(x0.z, 8 * c + 2, 127),
                  l3 = enc_key(x0.w, 8 * c + 3, 127), l4 = enc_key(x1.x, 8 * c + 4, 127), l5 = enc_key(x1.y, 8 * c + 5, 127),
                  l6 = enc_key(x1.z, 8 * c + 6, 127), l7 = enc_key(x1.w, 8 * c + 7, 127);
            CE_DESC(l0, l1) CE_DESC(l2, l3) CE_DESC(l4, l5) CE_DESC(l6, l7)
            CE_DESC(l0, l2) CE_DESC(l1, l3) CE_DESC(l4, l6) CE_DESC(l5, l7)
            CE_DESC(l1, l2) CE_DESC(l5, l6)
            CE_DESC(l0, l4) CE_DESC(l1, l5) CE_DESC(l2, l6) CE_DESC(l3, l7)
            CE_DESC(l2, l4) CE_DESC(l3, l5)
            CE_DESC(l1, l2) CE_DESC(l3, l4) CE_DESC(l5, l6)
            float res = NEGKEY;
#pragma unroll
            for (int k = 0; k < 16; ++k) {
                const float mx = row16_max(l0);
                const bool win = (l0 == mx);
                l0 = win ? l1 : l0; l1 = win ? l2 : l1; l2 = win ? l3 : l2; l3 = win ? l4 : l3;
                l4 = win ? l5 : l4; l5 = win ? l6 : l5; l6 = win ? l7 : l6; l7 = win ? NEGKEY : l7;
                res = (c == k) ? mx : res;
            }
            topk[(size_t)(m0 + r) * 256 + L * 16 + c] = res;
        }
        __syncthreads();
    }
};

__device__ __forceinline__ void peer_fast_phase(const Params& p, unsigned char* smem) {
    const int tid = threadIdx.x, lane = tid & 63, w = tid >> 6, l16 = lane & 15, gq = lane >> 4;
    float* tk = (float*)(smem + w * 2048);
    int* ex = (int*)(smem + w * 2048 + 1024);
    float* gw = (float*)(smem + w * 2048 + 1536);
    const bf16_t* H1B = (const bf16_t*)(p.ws + OFF_XB);
    const bf16_t* UB = (const bf16_t*)(p.ws + OFF_UB);
    const bf16_t* VB = (const bf16_t*)(p.ws + OFF_VB);
    const float* TOPK = (const float*)(p.ws + OFF_TOPK);
    int ci[4], cj[4];
#pragma unroll
    for (int q = 0; q < 4; ++q) {
        const int s = l16 + 16 * q;
        int i, j;
        if (s < 16) { i = 0; j = s; }
        else if (s < 24) { i = 1; j = s - 16; }
        else if (s < 29) { i = 2; j = s - 24; }
        else if (s < 33) { i = 3; j = s - 29; }
        else if (s < 36) { i = 4; j = s - 33; }
        else if (s < 42) { i = 5 + ((s - 36) >> 1); j = (s - 36) & 1; }
        else if (s < 50) { i = 8 + (s - 42); j = 0; }
        else { i = -1; j = 0; }
        ci[q] = i; cj[q] = j;
    }
    for (int n = blockIdx.x * 4 + w; n < NTOK; n += gridDim.x * 4) {
        WAVE_LDS_SYNC();
        ((float4*)tk)[lane] = ((const float4*)(TOPK + (size_t)n * 256))[lane];
        WAVE_LDS_SYNC();
#pragma unroll
        for (int it = 0; it < 2; ++it) {
            const int head = it * 4 + gq;
            const float* ka = tk + head * 32;
            const float* kb = ka + 16;
            float c0, c1, c2, c3;
#define MKC(q, cq) { if (ci[q] >= 0) { const float sum_ = dec_val(ka[ci[q]], 127) + dec_val(kb[cj[q]], 127); \
                     cq = enc_key(sum_, ci[q] * 16 + cj[q], 255); } else cq = NEGKEY; }
            MKC(0, c0) MKC(1, c1) MKC(2, c2) MKC(3, c3)
#undef MKC
            float res = NEGKEY;
#pragma unroll
            for (int k = 0; k < 16; ++k) {
                const float mx = row16_max(fmaxf(fmaxf(c0, c1), fmaxf(c2, c3)));
                c0 = (c0 == mx) ? NEGKEY : c0; c1 = (c1 == mx) ? NEGKEY : c1;
                c2 = (c2 == mx) ? NEGKEY : c2; c3 = (c3 == mx) ? NEGKEY : c3;
                res = (l16 == k) ? mx : res;
            }
            const unsigned cc = dec_idx(res, 255);
            const float val = dec_val(res, 255);
            const unsigned e1 = dec_idx(ka[cc >> 4], 127), e2 = dec_idx(kb[cc & 15], 127);
            const float m0 = row16_max(val);
            const float e = expf(val - m0);
            const float ssum = row16_sum(e);
            ex[head * 16 + l16] = (int)(e1 * 128 + e2);
            gw[head * 16 + l16] = e / ssum;
        }
        WAVE_LDS_SYNC();
        {
            const uint4* xr = (const uint4*)(H1B + (size_t)n * DM + 8 * l16);
            const uint4 x0 = xr[0], x1 = xr[16], x2 = xr[32], x3 = xr[48], x4 = xr[64], x5 = xr[80], x6 = xr[96], x7 = xr[112];
#pragma unroll 2
            for (int it = 0; it < 32; ++it) {
                const int k = it * 4 + gq;
                const int e = ex[k];
                const uint4* ur = (const uint4*)(UB + (size_t)e * DM + 8 * l16);
                const uint4 a0 = ur[0], a1 = ur[16], a2 = ur[32], a3 = ur[48], a4 = ur[64], a5 = ur[80], a6 = ur[96], a7 = ur[112];
                float s = 0.f;
#define D4(A_, X_) s = dot2bf(A_.x, X_.x, s); s = dot2bf(A_.y, X_.y, s); s = dot2bf(A_.z, X_.z, s); s = dot2bf(A_.w, X_.w, s);
                D4(a0, x0) D4(a1, x1) D4(a2, x2) D4(a3, x3) D4(a4, x4) D4(a5, x5) D4(a6, x6) D4(a7, x7)
#undef D4
                s = row16_sum(s);
                if (l16 == 0) gw[k] = gw[k] * gelu_tanh(s);
            }
        }
        WAVE_LDS_SYNC();
        float acc[16];
#pragma unroll
        for (int q = 0; q < 16; ++q) acc[q] = 0.f;
#pragma unroll 4
        for (int k = 0; k < 128; ++k) {
            const int e = ex[k];
            const float wk = gw[k];
            const uint4* vr = (const uint4*)(VB + (size_t)e * DM);
            const uint4 a = vr[lane], b = vr[64 + lane];
            acc[0] += wk * __uint_as_float(a.x << 16); acc[1] += wk * __uint_as_float(a.x & 0xffff0000u);
            acc[2] += wk * __uint_as_float(a.y << 16); acc[3] += wk * __uint_as_float(a.y & 0xffff0000u);
            acc[4] += wk * __uint_as_float(a.z << 16); acc[5] += wk * __uint_as_float(a.z & 0xffff0000u);
            acc[6] += wk * __uint_as_float(a.w << 16); acc[7] += wk * __uint_as_float(a.w & 0xffff0000u);
            acc[8] += wk * __uint_as_float(b.x << 16); acc[9] += wk * __uint_as_float(b.x & 0xffff0000u);
            acc[10] += wk * __uint_as_float(b.y << 16); acc[11] += wk * __uint_as_float(b.y & 0xffff0000u);
            acc[12] += wk * __uint_as_float(b.z << 16); acc[13] += wk * __uint_as_float(b.z & 0xffff0000u);
            acc[14] += wk * __uint_as_float(b.w << 16); acc[15] += wk * __uint_as_float(b.w & 0xffff0000u);
        }
        {
            float* orow = p.out + (size_t)n * DM;
            const float4 h0 = ((const float4*)orow)[2 * lane], h1 = ((const float4*)orow)[2 * lane + 1];
            const float4 h2 = ((const float4*)orow)[128 + 2 * lane], h3 = ((const float4*)orow)[128 + 2 * lane + 1];
            float y[16] = {h0.x, h0.y, h0.z, h0.w, h1.x, h1.y, h1.z, h1.w, h2.x, h2.y, h2.z, h2.w, h3.x, h3.y, h3.z, h3.w};
            float sum = 0.f;
#pragma unroll
            for (int q = 0; q < 16; ++q) { y[q] = ALPHA * y[q] + acc[q]; sum += y[q]; }
            const float mu = wave_sum(sum) * (1.f / 1024.f);
            float sq = 0.f;
#pragma unroll
            for (int q = 0; q < 16; ++q) { y[q] -= mu; sq += y[q] * y[q]; }
            const float rs = rsqrtf(wave_sum(sq) * (1.f / 1024.f) + LN_EPS);
            const float* g = p.in[22];
            const float* bb = p.in[23];
#pragma unroll
            for (int hq = 0; hq < 4; ++hq) {
                const int e0 = (hq >> 1) * 512 + 8 * lane + (hq & 1) * 4;
                const float4 gg = *(const float4*)(g + e0), b4 = *(const float4*)(bb + e0);
                float4 o;
                o.x = y[hq * 4 + 0] * rs * gg.x + b4.x; o.y = y[hq * 4 + 1] * rs * gg.y + b4.y;
                o.z = y[hq * 4 + 2] * rs * gg.z + b4.z; o.w = y[hq * 4 + 3] * rs * gg.w + b4.w;
                *(float4*)(orow + e0) = o;
            }
        }
    }
}

__global__ void __launch_bounds__(256, 2) mega(Params p) {
    cg::grid_group grid = cg::this_grid();
    __shared__ __attribute__((aligned(16))) unsigned char smem[65536];
    float* sm = (float*)smem;
    bf16_t* XB = (bf16_t*)(p.ws + OFF_XB);
    bf16_t* WinT = (bf16_t*)(p.ws + OFF_WINT);
    bf16_t* WoutT = (bf16_t*)(p.ws + OFF_WOUTT);
    bf16_t* WqT = (bf16_t*)(p.ws + OFF_WQT);
    cvt_rows_bf16(p.in[0], XB, (size_t)NTOK * DM / 8);
    transpose_bf16(p.in[1], DIN, 3456, WinT);
    transpose_bf16(p.in[2], DM, DM, WoutT);
    fold_ws_phase(p.in[17], p.in[18], p.in[19], WqT);
    cvt_rows_bf16(p.in[20], (bf16_t*)(p.ws + OFF_UB), (size_t)16384 * DM / 8);
    cvt_rows_bf16(p.in[21], (bf16_t*)(p.ws + OFF_VB), (size_t)16384 * DM / 8);
    transpose_bf16(p.in[6], 256, 256, (bf16_t*)(p.ws + OFF_W1T), 2048);
    transpose_bf16(p.in[11], 256, 256, (bf16_t*)(p.ws + OFF_W1T) + 256 * 2048, 2048);
    if (blockIdx.x == 0) {
        for (int c = threadIdx.x; c < 512; c += 256)
            ((float*)(p.ws + OFF_LBV))[c] = 1.f / (1.f + expf(p.in[3][512 + c] - p.in[3][c]));
        if (threadIdx.x < 16) ((float*)(p.ws + OFF_DIAG))[threadIdx.x] = 0.f;
    }
    if (blockIdx.x == 1 || blockIdx.x == 2) cmp_peb(p, blockIdx.x - 1);
    grid.sync();
    gemm_bf16_phase(XB, DM, WinT, DM, NTOK / 128, 27, smem, EpiProj{p.ws});
    grid.sync();
    for (int it = blockIdx.x; it < 128; it += gridDim.x) {
        const int which = it >> 6, t = it & 63;
        gemm_tile(ALoadCmp{(const bf16_t*)(p.ws + OFF_KV + (size_t)which * KV_STRIDE)},
                  (const bf16_t*)(p.ws + OFF_W1T) + (size_t)which * 256 * 2048, 2048, 32, (t >> 1) * 128, (t & 1) * 128, smem,
                  EpiCmpH{(bf16_t*)(p.ws + OFF_HB) + (size_t)which * 4096 * 256, (const float*)(p.ws + OFF_PEB) + which * 256});
    }
    for (int it = (blockIdx.x + gridDim.x - 128 % gridDim.x) % gridDim.x; it < 2048; it += gridDim.x) hgrn_passA(p, it, smem);
#if NSA_DIAG
    for (int it = blockIdx.x; it < 2 * 4 * NCB * 2; it += gridDim.x) compress_item(p, it, sm);
#endif
    grid.sync();
    if (blockIdx.x < 256) hgrn_scan_item(p, blockIdx.x);
    cmp_layer2_phase(p, 0, gridDim.x);
    grid.sync();
    for (int it = blockIdx.x; it < NSA_TILES; it += gridDim.x) nsa_tile(p, it, smem);
    for (int it = gridDim.x - 1 - blockIdx.x; it < 2048; it += gridDim.x) hgrn_passC(p, it, smem);
    grid.sync();
#if NSA_DIAG
    for (int it = blockIdx.x; it < 4 * 2 * SEQ; it += gridDim.x) nsa_item(p, it, sm);
    grid.sync();
    {
        const float* DG = (const float*)(p.ws + OFF_DIAG);
#if NSA_DIAG == 1
        const float cval = -log10f(sqrtf(DG[0] / DG[1]) + 1e-9f);
#else
        const float cval = -log10f(DG[2] / DG[3] + 1e-6f);
#endif
        for (size_t i = (size_t)blockIdx.x * 256 + threadIdx.x; i < (size_t)NTOK * DM; i += (size_t)gridDim.x * 256) p.out[i] = cval;
        return;
    }
#endif
    gemm_bf16_phase(XB, DM, WoutT, DM, NTOK / 128, 8, smem, EpiY{p.in[0], p.out});
    grid.sync();
    ln1_phase(p, sm);
    grid.sync();
    gemm_bf16_phase(XB, DM, WqT, DM, NTOK / 128, 16, smem, EpiTop16{(float*)(p.ws + OFF_TOPK), smem});
    grid.sync();
    peer_fast_phase(p, smem);
}

extern "C" void kernel_launch(void* const* d_in, const int* in_sizes, int n_in, void* d_out, int out_size,
                              void* d_ws, size_t ws_size, hipStream_t stream) {
    static int grid_blocks = 0;
    if (!grid_blocks) {
        int dev = 0, cus = 0, per_cu = 0;
        hipGetDevice(&dev);
        hipDeviceGetAttribute(&cus, hipDeviceAttributeMultiprocessorCount, dev);
        hipOccupancyMaxActiveBlocksPerMultiprocessor(&per_cu, mega, 256, 0);
        if (per_cu > 4) per_cu = 4;
        if (per_cu < 1) per_cu = 1;
        grid_blocks = cus * per_cu;
        if (n_in != 24 || ws_size < WS_NEED || out_size != NTOK * DM)
            fprintf(stderr, "kernel_launch: unexpected sizes n_in=%d ws=%zu out=%d\n", n_in, ws_size, out_size);
    }
    Params p;
    memset(&p, 0, sizeof(p));
    for (int i = 0; i < 24; ++i) p.in[i] = (const float*)d_in[i];
    p.out = (float*)d_out;
    p.ws = (unsigned char*)d_ws;
    void* args[] = {&p};
    hipError_t e = hipLaunchCooperativeKernel((void*)mega, dim3(grid_blocks), dim3(256), args, 0, stream);
    if (e != hipSuccess) fprintf(stderr, "cooperative launch failed: %s (grid %d)\n", hipGetErrorString(e), grid_blocks);
}
```

```cpp
#include <hip/hip_runtime.h>
#include <hip/hip_cooperative_groups.h>
#include <cstdio>
#include <cstring>
namespace cg = cooperative_groups;

#define NTOK 32768
#define SEQ 8192
#define DM 1024
#define DIN 3352
#define NCB 511
#define ALPHA 1.189207115002721f
#define LN_EPS 1e-5f

#define MB_ 1048576ull
#define OFF_XB 0ull
#define OFF_HQ (64 * MB_)
#define OFF_HLF (96 * MB_)
#define OFF_HI (160 * MB_)
#define OFF_HG (192 * MB_)
#define OFF_NQ (224 * MB_)
#define OFF_KV (256 * MB_)
#define KV_STRIDE (8 * MB_)
#define OFF_NGATE (304 * MB_)
#define OFF_CMPK (308 * MB_)
#define OFF_CMPV (309 * MB_)
#define OFF_WINT (310 * MB_)
#define OFF_WOUTT (317 * MB_)
#define OFF_WQT (319 * MB_)
#define OFF_LBV (323 * MB_)
#define OFF_DC (324 * MB_)
#define OFF_SC (325 * MB_)
#define OFF_UB (389 * MB_)
#define OFF_VB (421 * MB_)
#define OFF_TOPK (453 * MB_)
#define OFF_W1T (485 * MB_)
#define OFF_HB (487 * MB_)
#define OFF_CMPKB (491 * MB_)
#define OFF_CMPVB (491 * MB_ + 524288ull)
#define OFF_PEB (492 * MB_)
#define OFF_SELM (493 * MB_)
#define OFF_DIAG (494 * MB_)
#define OFF_USC (494 * MB_ + 131072ull)
#define OFF_VSC (494 * MB_ + 196608ull)
#define OFF_BAR (494 * MB_ + 65536ull)
#define BAR_BYTES 32768
#define WS_NEED (495 * MB_)
#define USE_NSA_MFMA 1
#define NSA_DIAG 0
#define TIME_DIAG 0

struct Params {
    const float* in[24];
    float* out;
    unsigned char* ws;
};

typedef float f32x16 __attribute__((ext_vector_type(16)));
#define WAVE_LDS_SYNC() asm volatile("s_waitcnt lgkmcnt(0)" ::: "memory")

__device__ __forceinline__ float wave_sum(float v) {
#pragma unroll
    for (int o = 32; o; o >>= 1) v += __shfl_xor(v, o);
    return v;
}
__device__ __forceinline__ float wave_max(float v) {
#pragma unroll
    for (int o = 32; o; o >>= 1) v = fmaxf(v, __shfl_xor(v, o));
    return v;
}
__device__ __forceinline__ float sigmoidf_(float x) { return 1.f / (1.f + expf(-x)); }
__device__ __forceinline__ float gelu_tanh(float x) {
    const float c = 0.7978845608028654f;
    return 0.5f * x * (1.f + tanhf(c * (x + 0.044715f * x * x * x)));
}

typedef short bf16x8 __attribute__((ext_vector_type(8)));
typedef float f32x4 __attribute__((ext_vector_type(4)));
typedef unsigned short bf16_t;

__device__ __forceinline__ unsigned f2bf(float f) {
    unsigned u = __float_as_uint(f);
    u += 0x7FFFu + ((u >> 16) & 1u);
    return u >> 16;
}
__device__ __forceinline__ unsigned pack2bf(float lo, float hi) { return f2bf(lo) | (f2bf(hi) << 16); }
__device__ __forceinline__ float bf2f(unsigned h) { return __uint_as_float(h << 16); }

__device__ __forceinline__ void cvt_rows_bf16(const float* __restrict__ src, bf16_t* __restrict__ dst, size_t n8) {
    for (size_t i = (size_t)blockIdx.x * 256 + threadIdx.x; i < n8; i += (size_t)gridDim.x * 256) {
        const float4 a = ((const float4*)src)[2 * i], b = ((const float4*)src)[2 * i + 1];
        uint4 o;
        o.x = pack2bf(a.x, a.y); o.y = pack2bf(a.z, a.w); o.z = pack2bf(b.x, b.y); o.w = pack2bf(b.z, b.w);
        ((uint4*)dst)[i] = o;
    }
}
__device__ __forceinline__ void transpose_bf16(const float* __restrict__ src, int Nsrc, int Npad, bf16_t* __restrict__ dst, int K = 1024) {
    const size_t total = (size_t)Npad * (K / 8);
    for (size_t i = (size_t)blockIdx.x * 256 + threadIdx.x; i < total; i += (size_t)gridDim.x * 256) {
        const int n = (int)(i % Npad), kg = (int)(i / Npad);
        float v[8];
#pragma unroll
        for (int j = 0; j < 8; ++j) v[j] = (n < Nsrc) ? src[(size_t)(kg * 8 + j) * Nsrc + n] : 0.f;
        uint4 o;
        o.x = pack2bf(v[0], v[1]); o.y = pack2bf(v[2], v[3]); o.z = pack2bf(v[4], v[5]); o.w = pack2bf(v[6], v[7]);
        *(uint4*)(dst + (size_t)n * K + kg * 8) = o;
    }
}

struct ALoadStd {
    const bf16_t* A; int lda;
    __device__ __forceinline__ const bf16_t* ptr(int row, int ks) const { return A + (size_t)row * lda + ks * 64; }
};
struct ALoadCmp {
    const bf16_t* KC;
    __device__ __forceinline__ const bf16_t* ptr(int row, int ks) const {
        const int r = row < 4088 ? row : 4087;
        const int g = r & 1, bn = r >> 1, n = bn % NCB, b = bn / NCB;
        return KC + ((size_t)(b * SEQ + 16 * n + ks) * 128 + g * 64);
    }
};
#define GLD1(i, ks) { const int c_ = tid + 256 * (i), row_ = c_ >> 3, ch_ = c_ & 7;                      \
        ra##i = *(const uint4*)(aload.ptr(m0 + row_, (ks)) + ch_ * 8);                                   \
        rb##i = *(const uint4*)(Bp + (size_t)row_ * ldb + (ks) * 64 + ch_ * 8); }
#define GST1(i, buf) { const int c_ = tid + 256 * (i), row_ = c_ >> 3, ch_ = c_ & 7;                     \
        const int off_ = (buf) * 32768 + row_ * 128 + ((ch_ ^ (row_ & 7)) << 4);                         \
        *(uint4*)(lds + off_) = ra##i; *(uint4*)(lds + 16384 + off_) = rb##i; }
#define GEMM_LOAD(ks) { GLD1(0, ks) GLD1(1, ks) GLD1(2, ks) GLD1(3, ks) }
#define GEMM_STORE(buf) { GST1(0, buf) GST1(1, buf) GST1(2, buf) GST1(3, buf) }
template <class ALoad, class Epi>
__device__ __forceinline__ void gemm_tile(const ALoad aload, const bf16_t* __restrict__ Bt, int ldb, int KS, int m0, int n0,
                                          unsigned char* lds, Epi epi) {
    const int tid = threadIdx.x, lane = tid & 63, w = tid >> 6, wm = w >> 1, wn = w & 1;
    f32x4 acc[4][4];
#pragma unroll
    for (int j = 0; j < 4; ++j)
#pragma unroll
        for (int i = 0; i < 4; ++i) acc[j][i] = (f32x4){0.f, 0.f, 0.f, 0.f};
    uint4 ra0, ra1, ra2, ra3, rb0, rb1, rb2, rb3;
    const bf16_t* Bp = Bt + (size_t)n0 * ldb;
    GEMM_LOAD(0)
    __syncthreads();
    GEMM_STORE(0)
    __syncthreads();
    for (int ks = 0; ks < KS; ++ks) {
        if (ks + 1 < KS) GEMM_LOAD(ks + 1)
        const unsigned char* la = lds + (ks & 1) * 32768;
        const unsigned char* lb = la + 16384;
#pragma unroll
        for (int s = 0; s < 2; ++s) {
            bf16x8 af[4], wf[4];
            const int ch = s * 4 + (lane >> 4);
#pragma unroll
            for (int i = 0; i < 4; ++i) {
                const int row = wm * 64 + i * 16 + (lane & 15);
                af[i] = *(const bf16x8*)(la + row * 128 + ((ch ^ (row & 7)) << 4));
            }
#pragma unroll
            for (int j = 0; j < 4; ++j) {
                const int row = wn * 64 + j * 16 + (lane & 15);
                wf[j] = *(const bf16x8*)(lb + row * 128 + ((ch ^ (row & 7)) << 4));
            }
#pragma unroll
            for (int j = 0; j < 4; ++j)
#pragma unroll
                for (int i = 0; i < 4; ++i)
                    acc[j][i] = __builtin_amdgcn_mfma_f32_16x16x32_bf16(wf[j], af[i], acc[j][i], 0, 0, 0);
        }
        if (ks + 1 < KS) GEMM_STORE((ks + 1) & 1)
        __syncthreads();
    }
#pragma unroll
    for (int j = 0; j < 4; ++j)
#pragma unroll
        for (int i = 0; i < 4; ++i)
            epi(m0 + wm * 64 + i * 16 + (lane & 15), n0 + wn * 64 + j * 16 + (lane >> 4) * 4, acc[j][i]);
    epi.finish(m0, n0);
}
template <class Epi>
__device__ __forceinline__ void gemm_bf16_phase(const bf16_t* __restrict__ A, int lda, const bf16_t* __restrict__ Bt, int ldb,
                                                int Mtiles, int Ntiles, unsigned char* lds, Epi epi) {
    for (int tile = blockIdx.x; tile < Mtiles * Ntiles; tile += gridDim.x) {
        const int mt = tile / Ntiles, nt = tile % Ntiles;
        gemm_tile(ALoadStd{A, lda}, Bt, ldb, 16, mt * 128, nt * 128, lds, epi);
    }
}

struct EpiF32 {
    float* C; int ldc; int Nc;
    __device__ __forceinline__ void operator()(int m, int n, f32x4 v) const {
        if (n < Nc) *(float4*)(C + (size_t)m * ldc + n) = make_float4(v[0], v[1], v[2], v[3]);
    }
    __device__ __forceinline__ void finish(int, int) const {}
};

struct EpiProj {
    unsigned char* ws;
    __device__ __forceinline__ void operator()(int m, int n, f32x4 v) const {
        const int ct = n >> 7;
        if (ct < 4) {
            uint2 o; o.x = pack2bf(v[0], v[1]); o.y = pack2bf(v[2], v[3]);
            *(uint2*)((bf16_t*)(ws + OFF_HQ) + (size_t)m * 512 + n) = o;
        } else if (ct < 8) {
            const int c = n - 512;
            const float4 lb = *(const float4*)((const float*)(ws + OFF_LBV) + c);
            float4 o;
            o.x = logf(lb.x + (1.f - lb.x) * sigmoidf_(v[0])); o.y = logf(lb.y + (1.f - lb.y) * sigmoidf_(v[1]));
            o.z = logf(lb.z + (1.f - lb.z) * sigmoidf_(v[2])); o.w = logf(lb.w + (1.f - lb.w) * sigmoidf_(v[3]));
            *(float4*)((float*)(ws + OFF_HLF) + (size_t)m * 512 + c) = o;
        } else if (ct < 12) {
            uint2 o; o.x = pack2bf(v[0], v[1]); o.y = pack2bf(v[2], v[3]);
            *(uint2*)((bf16_t*)(ws + OFF_HI) + (size_t)m * 512 + (n - 1024)) = o;
        } else if (ct < 16) {
            uint2 o; o.x = pack2bf(v[0], v[1]); o.y = pack2bf(v[2], v[3]);
            *(uint2*)((bf16_t*)(ws + OFF_HG) + (size_t)m * 512 + (n - 1536)) = o;
        } else if (ct < 20) {
            uint2 o; o.x = pack2bf(0.125f * v[0], 0.125f * v[1]); o.y = pack2bf(0.125f * v[2], 0.125f * v[3]);
            *(uint2*)((bf16_t*)(ws + OFF_NQ) + (size_t)m * 512 + (n - 2048)) = o;
        } else if (ct < 26) {
            uint2 o; o.x = pack2bf(v[0], v[1]); o.y = pack2bf(v[2], v[3]);
            *(uint2*)((bf16_t*)(ws + OFF_KV + (size_t)(ct - 20) * KV_STRIDE) + (size_t)m * 128 + (n & 127)) = o;
        } else {
            const int c = n - 3328;
            if (c < 24)
                *(float4*)((float*)(ws + OFF_NGATE) + (size_t)m * 24 + c) =
                    make_float4(sigmoidf_(v[0]), sigmoidf_(v[1]), sigmoidf_(v[2]), sigmoidf_(v[3]));
        }
    }
    __device__ __forceinline__ void finish(int, int) const {}
};
struct EpiY {
    const float* x; float* y;
    __device__ __forceinline__ void operator()(int m, int n, f32x4 v) const {
        const float4 xv = *(const float4*)(x + (size_t)m * DM + n);
        *(float4*)(y + (size_t)m * DM + n) = make_float4(ALPHA * xv.x + v[0], ALPHA * xv.y + v[1], ALPHA * xv.z + v[2], ALPHA * xv.w + v[3]);
    }
    __device__ __forceinline__ void finish(int, int) const {}
};

__device__ __forceinline__ uint4 pack8bf(const float* v) {
    uint4 o;
    o.x = pack2bf(v[0], v[1]); o.y = pack2bf(v[2], v[3]); o.z = pack2bf(v[4], v[5]); o.w = pack2bf(v[6], v[7]);
    return o;
}

__device__ __forceinline__ void hgrn_passA(const Params& p, int chunk, unsigned char* smem) {
    const int c = chunk & 127, bh = chunk >> 7, h = bh & 3, b = bh >> 2;
    const int tid = threadIdx.x, d = tid & 127, hf = tid >> 7, lane = tid & 63, w = tid >> 6;
    const size_t tok0 = (size_t)b * SEQ + (size_t)c * 64 + 32 * hf;
    const float* HLF = (const float*)(p.ws + OFF_HLF);
    const bf16_t* HI = (const bf16_t*)(p.ws + OFF_HI);
    unsigned char* KT = smem;
    unsigned char* VT = smem + 16384;
    float* xch = (float*)(smem + 32768);
    const float* lfp = HLF + tok0 * 512 + h * 128 + d;
    const bf16_t* vp = HI + tok0 * 512 + h * 128 + d;
    float run = 0.f;
#pragma unroll 8
    for (int s = 0; s < 32; ++s) run += lfp[s * 512];
    __syncthreads();
    xch[hf * 128 + d] = run;
    __syncthreads();
    const float tot0 = xch[d], tot1 = xch[128 + d];
    const float blast = tot0 + tot1;
    run = hf ? tot0 : 0.f;
#pragma unroll 1
    for (int q = 0; q < 4; ++q) {
        float kv[8], vv[8];
#pragma unroll
        for (int j = 0; j < 8; ++j) {
            const int s = q * 8 + j;
            const float lf = lfp[s * 512];
            run += lf;
            kv[j] = (1.f - expf(lf)) * expf(blast - run);
            vv[j] = bf2f(vp[s * 512]);
        }
        const int ch = 4 * hf + q;
        *(uint4*)(KT + d * 128 + ((ch ^ (d & 7)) << 4)) = pack8bf(kv);
        *(uint4*)(VT + d * 128 + ((ch ^ (d & 7)) << 4)) = pack8bf(vv);
    }
    if (hf) ((float*)(p.ws + OFF_DC))[(size_t)chunk * 128 + d] = expf(blast);
    __syncthreads();
    f32x4 acc[2][8];
#pragma unroll
    for (int i = 0; i < 2; ++i)
#pragma unroll
        for (int et = 0; et < 8; ++et) acc[i][et] = (f32x4){0.f, 0.f, 0.f, 0.f};
#pragma unroll
    for (int st = 0; st < 2; ++st) {
        const int ch = st * 4 + (lane >> 4);
        bf16x8 af[2];
#pragma unroll
        for (int i = 0; i < 2; ++i) {
            const int row = (2 * w + i) * 16 + (lane & 15);
            af[i] = *(const bf16x8*)(KT + row * 128 + ((ch ^ (row & 7)) << 4));
        }
#pragma unroll
        for (int et = 0; et < 8; ++et) {
            const int row = et * 16 + (lane & 15);
            const bf16x8 bfv = *(const bf16x8*)(VT + row * 128 + ((ch ^ (row & 7)) << 4));
            acc[0][et] = __builtin_amdgcn_mfma_f32_16x16x32_bf16(af[0], bfv, acc[0][et], 0, 0, 0);
            acc[1][et] = __builtin_amdgcn_mfma_f32_16x16x32_bf16(af[1], bfv, acc[1][et], 0, 0, 0);
        }
    }
    float* HC = p.out + (size_t)chunk * 16384;
#pragma unroll
    for (int i = 0; i < 2; ++i)
#pragma unroll
        for (int et = 0; et < 8; ++et) {
            const int e = et * 16 + (lane & 15), d0 = (2 * w + i) * 16 + (lane >> 4) * 4;
            *(float4*)(HC + e * 128 + d0) = make_float4(acc[i][et][0], acc[i][et][1], acc[i][et][2], acc[i][et][3]);
        }
}

__device__ __forceinline__ void hgrn_scan_item(const Params& p, int item) {
    const int gid = item * 256 + threadIdx.x;
    const int d4 = gid & 31, e = (gid >> 5) & 127, bh = gid >> 12;
    const float* HC = p.out;
    const float* DC = (const float*)(p.ws + OFF_DC);
    bf16_t* SC = (bf16_t*)(p.ws + OFF_SC);
    float4 S = make_float4(0.f, 0.f, 0.f, 0.f);
#pragma unroll 4
    for (int c = 0; c < 128; ++c) {
        const size_t base = ((size_t)(bh * 128 + c) * 128 + e) * 128 + d4 * 4;
        const float4 H = *(const float4*)(HC + base);
        const float4 dc = *(const float4*)(DC + (size_t)(bh * 128 + c) * 128 + d4 * 4);
        uint2 o; o.x = pack2bf(S.x, S.y); o.y = pack2bf(S.z, S.w);
        *(uint2*)(SC + base) = o;
        S.x = dc.x * S.x + H.x; S.y = dc.y * S.y + H.y; S.z = dc.z * S.z + H.z; S.w = dc.w * S.w + H.w;
    }
}

__device__ __forceinline__ void hgrn_passC(const Params& p, int chunk, unsigned char* smem) {
    const int c = chunk & 127, bh = chunk >> 7, h = bh & 3, b = bh >> 2;
    const int tid = threadIdx.x, d = tid & 127, hf = tid >> 7, lane = tid & 63, w = tid >> 6;
    const size_t tokc = (size_t)b * SEQ + (size_t)c * 64;
    const size_t tok0 = tokc + 32 * hf;
    const float* HLF = (const float*)(p.ws + OFF_HLF);
    const bf16_t* HQ = (const bf16_t*)(p.ws + OFF_HQ);
    const bf16_t* HI = (const bf16_t*)(p.ws + OFF_HI);
    const bf16_t* HG = (const bf16_t*)(p.ws + OFF_HG);
    unsigned char* R0 = smem;
    unsigned char* R1 = smem + 16384;
    unsigned char* R2 = smem + 57344;
    float* xch = (float*)R2;
    const float* lfp = HLF + tok0 * 512 + h * 128 + d;
    const bf16_t* qp = HQ + tok0 * 512 + h * 128 + d;
    float run = 0.f, b15 = 0.f;
#pragma unroll 8
    for (int s = 0; s < 32; ++s) { run += lfp[s * 512]; if (s == 15) b15 = run; }
    __syncthreads();
    xch[hf * 128 + d] = run;
    if (hf == 0) xch[256 + d] = b15;
    __syncthreads();
    const float tot0 = xch[d];
    const float off = hf ? tot0 : 0.f;
    const float r1 = xch[256 + d], r2 = tot0;
    if (hf) xch[384 + d] = off + b15;
    run = off;
#pragma unroll 8
    for (int s = 0; s < 32; ++s) {
        const int t = 32 * hf + s;
        run += lfp[s * 512];
        const float qv = bf2f(qp[s * 512]);
        *(bf16_t*)(R0 + t * 256 + ((((d >> 3) ^ (t & 15))) << 4) + (d & 7) * 2) = (bf16_t)f2bf(qv * expf(run));
    }
    {
        const bf16_t* SCp = (const bf16_t*)(p.ws + OFF_SC) + (size_t)chunk * 16384;
#pragma unroll
        for (int i = 0; i < 8; ++i) {
            const int cc = tid + 256 * i, row = cc >> 4, ch = cc & 15;
            *(uint4*)(R1 + row * 256 + ((ch ^ (row & 15)) << 4)) = *(const uint4*)(SCp + row * 128 + ch * 8);
        }
    }
    __syncthreads();
    f32x4 acc[8];
#pragma unroll
    for (int et = 0; et < 8; ++et) acc[et] = (f32x4){0.f, 0.f, 0.f, 0.f};
#pragma unroll
    for (int ds = 0; ds < 4; ++ds) {
        const int ch = ds * 4 + (lane >> 4);
        const int trow = w * 16 + (lane & 15);
        const bf16x8 bq = *(const bf16x8*)(R0 + trow * 256 + ((ch ^ (trow & 15)) << 4));
#pragma unroll
        for (int et = 0; et < 8; ++et) {
            const int row = et * 16 + (lane & 15);
            const bf16x8 av = *(const bf16x8*)(R1 + row * 256 + ((ch ^ (row & 15)) << 4));
            acc[et] = __builtin_amdgcn_mfma_f32_16x16x32_bf16(av, bq, acc[et], 0, 0, 0);
        }
    }
    __syncthreads();
    {
        const float r3 = xch[384 + d];
        run = off;
#pragma unroll 4
        for (int s = 0; s < 32; ++s) {
            const int t = 32 * hf + s;
            const int it = t >> 4;
            const float rr = (it == 0) ? 0.f : (it == 1) ? r1 : (it == 2) ? r2 : r3;
            const int sw = (((d >> 3) ^ (t & 15)) << 4) + (d & 7) * 2;
            const float lf = lfp[s * 512];
            run += lf;
            const float qv = bf2f(qp[s * 512]);
            const float kv = 1.f - expf(lf);
            *(bf16_t*)(R0 + t * 256 + sw) = (bf16_t)f2bf(qv * expf(run - rr));
#pragma unroll
            for (int i = 0; i < 4; ++i) {
                if (i >= it) {
                    const float ri = (i == 0) ? 0.f : (i == 1) ? r1 : (i == 2) ? r2 : r3;
                    const int R = 8 * i * (i + 1) + t;
                    *(bf16_t*)(R1 + R * 256 + sw) = (bf16_t)f2bf(kv * expf(ri - run));
                }
            }
        }
    }
    __syncthreads();
#pragma unroll
    for (int j = 0; j < 4; ++j) {
        uint2 o = make_uint2(0u, 0u);
        if (j <= w) {
            f32x4 pa = (f32x4){0.f, 0.f, 0.f, 0.f};
#pragma unroll
            for (int ds = 0; ds < 4; ++ds) {
                const int ch = ds * 4 + (lane >> 4);
                const int krow = 8 * w * (w + 1) + 16 * j + (lane & 15);
                const int trow = w * 16 + (lane & 15);
                const bf16x8 av = *(const bf16x8*)(R1 + krow * 256 + ((ch ^ (krow & 15)) << 4));
                const bf16x8 bq = *(const bf16x8*)(R0 + trow * 256 + ((ch ^ (trow & 15)) << 4));
                pa = __builtin_amdgcn_mfma_f32_16x16x32_bf16(av, bq, pa, 0, 0, 0);
            }
            if (j == w) {
                const int tl = lane & 15, sl = (lane >> 4) * 4;
#pragma unroll
                for (int r = 0; r < 4; ++r) if (sl + r > tl) pa[r] = 0.f;
            }
            o.x = pack2bf(pa[0], pa[1]); o.y = pack2bf(pa[2], pa[3]);
        }
        const int t = w * 16 + (lane & 15);
        const int ch = 2 * j + (lane >> 5);
        *(uint2*)(R2 + t * 128 + ((ch ^ (t & 7)) << 4) + ((lane >> 4) & 1) * 8) = o;
    }
    __syncthreads();
#pragma unroll
    for (int q = 0; q < 4; ++q) {
        float vv[8];
#pragma unroll
        for (int j = 0; j < 8; ++j) vv[j] = bf2f(HI[(tok0 + q * 8 + j) * 512 + h * 128 + d]);
        const int ch = 4 * hf + q;
        *(uint4*)(R1 + d * 128 + ((ch ^ (d & 7)) << 4)) = pack8bf(vv);
    }
    __syncthreads();
#pragma unroll
    for (int st = 0; st < 2; ++st) {
        const int ch = st * 4 + (lane >> 4);
        const int trow = w * 16 + (lane & 15);
        const bf16x8 bp = *(const bf16x8*)(R2 + trow * 128 + ((ch ^ (trow & 7)) << 4));
#pragma unroll
        for (int et = 0; et < 8; ++et) {
            const int row = et * 16 + (lane & 15);
            const bf16x8 av = *(const bf16x8*)(R1 + row * 128 + ((ch ^ (row & 7)) << 4));
            acc[et] = __builtin_amdgcn_mfma_f32_16x16x32_bf16(av, bp, acc[et], 0, 0, 0);
        }
    }
    {
        float ss = 0.f;
#pragma unroll
        for (int et = 0; et < 8; ++et)
#pragma unroll
            for (int r = 0; r < 4; ++r) ss += acc[et][r] * acc[et][r];
        ss += __shfl_xor(ss, 16);
        ss += __shfl_xor(ss, 32);
        const float rs = rsqrtf(ss * (1.f / 128.f) + LN_EPS);
        const size_t tok = tokc + w * 16 + (lane & 15);
        const float* ng = p.in[4];
        bf16_t* MIX = (bf16_t*)(p.ws + OFF_XB);
#pragma unroll
        for (int et = 0; et < 8; ++et) {
            const int e0 = et * 16 + (lane >> 4) * 4;
            const uint2 gb = *(const uint2*)(HG + tok * 512 + h * 128 + e0);
            const float4 n4 = *(const float4*)(ng + e0);
            const float g0 = bf2f(gb.x & 0xffffu), g1 = bf2f(gb.x >> 16), g2 = bf2f(gb.y & 0xffffu), g3 = bf2f(gb.y >> 16);
            uint2 o;
            o.x = pack2bf(acc[et][0] * rs * n4.x * (g0 * sigmoidf_(g0)), acc[et][1] * rs * n4.y * (g1 * sigmoidf_(g1)));
            o.y = pack2bf(acc[et][2] * rs * n4.z * (g2 * sigmoidf_(g2)), acc[et][3] * rs * n4.w * (g3 * sigmoidf_(g3)));
            *(uint2*)(MIX + tok * DM + h * 128 + e0) = o;
        }
    }
}

__device__ __forceinline__ void compress_item(const Params& p, int item, float* sm) {
    const int g = item & 1;
    int r = item >> 1;
    const int n = r % NCB; r /= NCB;
    const int b = r & 3, which = r >> 2;
    const int tid = threadIdx.x;
    const bf16_t* kvsrc = (const bf16_t*)(p.ws + OFF_KV + (size_t)which * KV_STRIDE);
    const float* pe = p.in[which ? 10 : 5];
    const float* w1 = p.in[which ? 11 : 6];
    const float* b1 = p.in[which ? 12 : 7];
    const float* w2 = p.in[which ? 13 : 8];
    const float* b2 = p.in[which ? 14 : 9];
    float* outp = (float*)(p.ws + (which ? OFF_CMPV : OFF_CMPK));
    float* blk = sm;
    float* hh = sm + 2048;
    __syncthreads();
    for (int i = tid; i < 2048; i += 256) {
        const int l = i >> 6, d = i & 63;
        blk[i] = bf2f(kvsrc[(size_t)(b * SEQ + 16 * n + l) * 128 + g * 64 + d]) + pe[i];
    }
    __syncthreads();
    float acc = b1[tid];
    for (int i = 0; i < 2048; ++i) acc += blk[i] * w1[(size_t)i * 256 + tid];
    hh[tid] = gelu_tanh(acc);
    __syncthreads();
    if (tid < 64) {
        float o = b2[tid];
        for (int j = 0; j < 256; ++j) o += hh[j] * w2[j * 64 + tid];
        outp[((size_t)(b * NCB + n) * 2 + g) * 64 + tid] = o;
    }
}

__device__ __forceinline__ float dot64_bf(const float* qs, const bf16_t* krow) {
    float s = 0.f;
#pragma unroll
    for (int i = 0; i < 8; ++i) {
        const uint4 kv = ((const uint4*)krow)[i];
        const float4 q0 = ((const float4*)qs)[2 * i], q1 = ((const float4*)qs)[2 * i + 1];
        s += __uint_as_float(kv.x << 16) * q0.x + __uint_as_float(kv.x & 0xffff0000u) * q0.y
           + __uint_as_float(kv.y << 16) * q0.z + __uint_as_float(kv.y & 0xffff0000u) * q0.w
           + __uint_as_float(kv.z << 16) * q1.x + __uint_as_float(kv.z & 0xffff0000u) * q1.y
           + __uint_as_float(kv.w << 16) * q1.z + __uint_as_float(kv.w & 0xffff0000u) * q1.w;
    }
    return s;
}
__device__ __forceinline__ float dot64(const float* qs, const float* krow) {
    float s = 0.f;
#pragma unroll
    for (int i = 0; i < 16; ++i) {
        const float4 kv = ((const float4*)krow)[i];
        const float4 qv = ((const float4*)qs)[i];
        s += kv.x * qv.x + kv.y * qv.y + kv.z * qv.z + kv.w * qv.w;
    }
    return s;
}

__device__ __forceinline__ void nsa_item(const Params& p, int item, float* sm) {
    const int t = item & (SEQ - 1), g = (item >> 13) & 1, b = item >> 14;
    const int tid = threadIdx.x, lane = tid & 63, r = tid >> 6;
    float* sc = sm + r * 1024;
    float* qs = sm + 4096 + r * 64;
    float* impv = sm + 4096 + 256;
    int* sel = (int*)(sm + 4096 + 256 + 128);
    const bf16_t* KSb = (const bf16_t*)(p.ws + OFF_KV + 2 * KV_STRIDE);
    const bf16_t* VSb = (const bf16_t*)(p.ws + OFF_KV + 3 * KV_STRIDE);
    const bf16_t* KWb = (const bf16_t*)(p.ws + OFF_KV + 4 * KV_STRIDE);
    const bf16_t* VWb = (const bf16_t*)(p.ws + OFF_KV + 5 * KV_STRIDE);
    const float* cmpk = (const float*)(p.ws + OFF_CMPK);
    const float* cmpv = (const float*)(p.ws + OFF_CMPV);
    const size_t n = (size_t)b * SEQ + t;
    const float NEGV = -1e30f;
    __syncthreads();
    qs[lane] = bf2f(((const bf16_t*)(p.ws + OFF_NQ))[n * 512 + g * 256 + r * 64 + lane]);
    __syncthreads();

    const int nvalid = (t >= 31) ? (((t - 31) >> 4) + 1) : 0;
    float m = NEGV;
    for (int n0 = 0; n0 < nvalid; n0 += 64) {
        const int nn = n0 + lane;
        if (nn < nvalid) {
            const float s = dot64(qs, cmpk + ((size_t)(b * NCB + nn) * 2 + g) * 64);
            sc[nn] = s;
            m = fmaxf(m, s);
        }
    }
    m = wave_max(m);
    float sum = 0.f;
    for (int n0 = 0; n0 < nvalid; n0 += 64) {
        const int nn = n0 + lane;
        if (nn < nvalid) { const float e = expf(sc[nn] - m); sc[nn] = e; sum += e; }
    }
    sum = wave_sum(sum);
    {
        const float inv = 1.f / fmaxf(sum, 1e-30f);
        for (int n0 = 0; n0 < nvalid; n0 += 64) {
            const int nn = n0 + lane;
            if (nn < nvalid) sc[nn] *= inv;
        }
    }
    __syncthreads();
    float oc = 0.f;
    for (int nn = 0; nn < nvalid; ++nn) oc += sc[nn] * cmpv[((size_t)(b * NCB + nn) * 2 + g) * 64 + lane];

    const int cur = t >> 6;
    if (tid < 128) {
        const int j = tid;
        float im = 0.f;
#pragma unroll
        for (int rr = 0; rr < 4; ++rr) {
            const float* P = sm + rr * 1024;
            const int n4 = 4 * j;
            float a = 0.f;
            if (n4 < nvalid) a += P[n4];
            if (n4 + 1 < nvalid) a += P[n4 + 1];
            if (n4 + 2 < nvalid) a += P[n4 + 2];
            if (n4 + 3 < nvalid) a += 0.5f * P[n4 + 3];
            if (n4 - 1 >= 0 && n4 - 1 < nvalid) a += 0.5f * P[n4 - 1];
            im += a;
        }
        const bool forced = (j == 0) || (j == cur) || (j == cur - 1);
        const bool causal = (j <= cur);
        impv[j] = forced ? 1.0e4f : (causal ? im : -1.f);
    }
    __syncthreads();
    if (r == 0) {
        float v0 = impv[lane], v1 = impv[lane + 64];
        for (int k = 0; k < 16; ++k) {
            const float mx = wave_max(fmaxf(v0, v1));
            const unsigned long long b0 = __ballot(v0 == mx);
            int idx;
            if (b0) {
                const int l = __ffsll((unsigned long long)b0) - 1;
                idx = l;
                if (lane == l) v0 = -3.0e38f;
            } else {
                const unsigned long long b1 = __ballot(v1 == mx);
                const int l = __ffsll((unsigned long long)b1) - 1;
                idx = 64 + l;
                if (lane == l) v1 = -3.0e38f;
            }
            if (lane == 0) sel[k] = idx;
        }
    }
    __syncthreads();

    m = NEGV;
    for (int si = 0; si < 16; ++si) {
        const int blk = sel[si];
        const int key = blk * 64 + lane;
        float s = NEGV;
        if (blk * 64 <= t) {
            if (key <= t) s = dot64_bf(qs, KSb + ((size_t)b * SEQ + key) * 128 + g * 64);
        }
        sc[si * 64 + lane] = s;
        m = fmaxf(m, s);
    }
    m = wave_max(m);
    sum = 0.f;
    for (int si = 0; si < 16; ++si) {
        const int key = sel[si] * 64 + lane;
        const float e = (key <= t) ? expf(sc[si * 64 + lane] - m) : 0.f;
        sc[si * 64 + lane] = e;
        sum += e;
    }
    sum = wave_sum(sum);
    {
        const float inv = 1.f / fmaxf(sum, 1e-30f);
        for (int si = 0; si < 16; ++si) sc[si * 64 + lane] *= inv;
    }
    __syncthreads();
    float os = 0.f;
    for (int si = 0; si < 16; ++si) {
        const int blk = sel[si];
        if (blk * 64 > t) continue;
        for (int kk = 0; kk < 64; ++kk) {
            const int key = blk * 64 + kk;
            if (key > t) break;
            os += sc[si * 64 + kk] * bf2f(VSb[((size_t)b * SEQ + key) * 128 + g * 64 + lane]);
        }
    }
    __syncthreads();

    const int lo = t - 511;
    m = NEGV;
    for (int i = 0; i < 8; ++i) {
        const int key = lo + i * 64 + lane;
        float s = NEGV;
        if (key >= 0) s = dot64_bf(qs, KWb + ((size_t)b * SEQ + key) * 128 + g * 64);
        sc[i * 64 + lane] = s;
        m = fmaxf(m, s);
    }
    m = wave_max(m);
    sum = 0.f;
    for (int i = 0; i < 8; ++i) {
        const int key = lo + i * 64 + lane;
        const float e = (key >= 0) ? expf(sc[i * 64 + lane] - m) : 0.f;
        sc[i * 64 + lane] = e;
        sum += e;
    }
    sum = wave_sum(sum);
    {
        const float inv = 1.f / fmaxf(sum, 1e-30f);
        for (int i = 0; i < 8; ++i) sc[i * 64 + lane] *= inv;
    }
    __syncthreads();
    float ow = 0.f;
    for (int idx = 0; idx < 512; ++idx) {
        const int key = lo + idx;
        if (key < 0) continue;
        ow += sc[idx] * bf2f(VWb[((size_t)b * SEQ + key) * 128 + g * 64 + lane]);
    }
    const float* grow = (const float*)(p.ws + OFF_NGATE) + n * 24 + g * 12 + r * 3;
    const float gc = grow[0], gs = grow[1], gw = grow[2];
#if NSA_DIAG
    {
        const float ref = gc * oc + gs * os + gw * ow;
        const float got = bf2f(((const bf16_t*)(p.ws + OFF_XB))[n * DM + 512 + g * 256 + r * 64 + lane]);
        const unsigned* SELM = (const unsigned*)(p.ws + OFF_SELM) + ((size_t)(b * 2 + g) * SEQ + t) * 4;
        unsigned gm[4] = {0u, 0u, 0u, 0u};
        for (int si = 0; si < 16; ++si) { const int blk = sel[si]; if (blk * 64 <= t) gm[blk >> 5] |= 1u << (blk & 31); }
        bool same = true;
        for (int qd = 0; qd < 4; ++qd) {
            unsigned mm = SELM[qd];
            for (int bit = 0; bit < 32; ++bit) if ((qd * 32 + bit) * 64 > t) mm &= ~(1u << bit);
            if (mm != gm[qd]) same = false;
        }
        float d2 = same ? (got - ref) * (got - ref) : 0.f, r2 = same ? ref * ref : 0.f;
        d2 = wave_sum(d2); r2 = wave_sum(r2);
        float* DG = (float*)(p.ws + OFF_DIAG);
        if (lane == 0) { atomicAdd(&DG[0], d2); atomicAdd(&DG[1], r2); if (r == 0) { atomicAdd(&DG[2], same ? 0.f : 1.f); atomicAdd(&DG[3], 1.f); } }
    }
#else
    ((bf16_t*)(p.ws + OFF_XB))[n * DM + 512 + g * 256 + r * 64 + lane] = (bf16_t)f2bf(gc * oc + gs * os + gw * ow);
#endif
}


struct EpiCmpH {
    bf16_t* HB; const float* peb;
    __device__ __forceinline__ void operator()(int m, int n, f32x4 v) const {
        const float4 pb = *(const float4*)(peb + n);
        uint2 o;
        o.x = pack2bf(gelu_tanh(v[0] + pb.x), gelu_tanh(v[1] + pb.y));
        o.y = pack2bf(gelu_tanh(v[2] + pb.z), gelu_tanh(v[3] + pb.w));
        *(uint2*)(HB + (size_t)m * 256 + n) = o;
    }
    __device__ __forceinline__ void finish(int, int) const {}
};
__device__ __forceinline__ void cmp_peb(const Params& p, int which) {
    const float* pe = p.in[which ? 10 : 5];
    const float* w1 = p.in[which ? 11 : 6];
    const float* b1 = p.in[which ? 12 : 7];
    const int j = threadIdx.x;
    float acc = b1[j];
    for (int i = 0; i < 2048; ++i) acc += pe[i] * w1[(size_t)i * 256 + j];
    ((float*)(p.ws + OFF_PEB))[which * 256 + j] = acc;
}
__device__ __forceinline__ void cmp_layer2_phase(const Params& p, int first_block, int nblocks) {
    const int lane = threadIdx.x & 63, w = threadIdx.x >> 6;
    for (int it = (blockIdx.x - first_block) * 4 + w; it < 2 * 4088; it += nblocks * 4) {
        const int which = it >= 4088, row = which ? it - 4088 : it;
        const float* w2 = p.in[which ? 13 : 8];
        const float* b2 = p.in[which ? 14 : 9];
        const bf16_t* hrow = (const bf16_t*)(p.ws + OFF_HB) + ((size_t)which * 4096 + row) * 256;
        float o = b2[lane];
#pragma unroll 8
        for (int j = 0; j < 256; ++j) o += bf2f(hrow[j]) * w2[j * 64 + lane];
        const int g = row & 1, bn = row >> 1, n = bn % NCB, b = bn / NCB;
        ((bf16_t*)(p.ws + (which ? OFF_CMPVB : OFF_CMPKB)))[((size_t)(b * 2 + g) * 512 + n) * 64 + lane] = (bf16_t)f2bf(o);
    }
}

struct StageOfs { int k, v0, v1, v2, v3; };
__device__ __forceinline__ StageOfs make_stage_ofs() {
    const int c0 = threadIdx.x, key = c0 >> 3, ch = c0 & 7;
    const int ko = (key & 3) * 2, ku = key >> 2, bu = ku ^ (4 * (ch & 1));
    StageOfs s;
    s.k = key * 128 + ((ch ^ (key & 7)) << 4);
    s.v0 = ch * 1024 + ((bu ^ 0) << 3) + ko;
    s.v1 = ch * 1024 + ((bu ^ 1) << 3) + ko;
    s.v2 = ch * 1024 + ((bu ^ 2) << 3) + ko;
    s.v3 = ch * 1024 + ((bu ^ 3) << 3) + ko;
    return s;
}
__device__ __forceinline__ void vt_scatter(unsigned char* VTl, const StageOfs& s, int extra, uint4 v) {
    *(bf16_t*)(VTl + s.v0 + 0 * 128 + extra) = (bf16_t)(v.x & 0xffffu);
    *(bf16_t*)(VTl + s.v0 + 1 * 128 + extra) = (bf16_t)(v.x >> 16);
    *(bf16_t*)(VTl + s.v1 + 2 * 128 + extra) = (bf16_t)(v.y & 0xffffu);
    *(bf16_t*)(VTl + s.v1 + 3 * 128 + extra) = (bf16_t)(v.y >> 16);
    *(bf16_t*)(VTl + s.v2 + 4 * 128 + extra) = (bf16_t)(v.z & 0xffffu);
    *(bf16_t*)(VTl + s.v2 + 5 * 128 + extra) = (bf16_t)(v.z >> 16);
    *(bf16_t*)(VTl + s.v3 + 6 * 128 + extra) = (bf16_t)(v.w & 0xffffu);
    *(bf16_t*)(VTl + s.v3 + 7 * 128 + extra) = (bf16_t)(v.w >> 16);
}
#define NSA_KV_LOAD(kb_) { const bf16_t* kp_ = Kbase + (size_t)(kb_) * 64 * stride + (size_t)(tid >> 3) * stride + (tid & 7) * 8; \
        const bf16_t* vp_ = Vbase + (size_t)(kb_) * 64 * stride + (size_t)(tid >> 3) * stride + (tid & 7) * 8;                 \
        rk0 = *(const uint4*)kp_; rk1 = *(const uint4*)(kp_ + (size_t)32 * stride);                                          \
        rv0 = *(const uint4*)vp_; rv1 = *(const uint4*)(vp_ + (size_t)32 * stride); }
#define NSA_KV_STORE(Kl_, VTl_) { *(uint4*)((Kl_) + sof.k) = rk0; *(uint4*)((Kl_) + sof.k + 4096) = rk1; \
        vt_scatter((VTl_), sof, 0, rv0); vt_scatter((VTl_), sof, 64, rv1); }
template <class Compute>
__device__ __forceinline__ void nsa_kv_loop(const bf16_t* __restrict__ Kbase, const bf16_t* __restrict__ Vbase, int stride,
                                            int kb_lo, int kb_hi, unsigned char* smem, const StageOfs& sof, Compute compute) {
    const int tid = threadIdx.x;
    uint4 rk0, rk1, rv0, rv1;
    NSA_KV_LOAD(kb_lo)
    __syncthreads();
    NSA_KV_STORE(smem, smem + 16384)
    __syncthreads();
    for (int kb = kb_lo; kb <= kb_hi; ++kb) {
        const int buf = (kb - kb_lo) & 1;
        if (kb < kb_hi) NSA_KV_LOAD(kb + 1)
        compute(kb, smem + buf * 8192, smem + 16384 + buf * 8192);
        if (kb < kb_hi) NSA_KV_STORE(smem + (buf ^ 1) * 8192, smem + 16384 + (buf ^ 1) * 8192)
        __syncthreads();
    }
}
struct LaneOfs { int k0, k1, v0, v1; };
__device__ __forceinline__ LaneOfs make_lane_ofs(int lane) {
    LaneOfs f;
    const int r15 = lane & 15, lg = lane >> 4, sw = (r15 >> 1) & 7;
    f.k0 = r15 * 128 + ((lg ^ (r15 & 7)) << 4);
    f.k1 = r15 * 128 + (((4 + lg) ^ (r15 & 7)) << 4);
    f.v0 = r15 * 128 + ((lg ^ sw) << 3);
    f.v1 = r15 * 128 + (((lg + 4) ^ sw) << 3);
    return f;
}
#define LOG2E 1.4426950408889634f
__device__ __forceinline__ void nsa_scores(const unsigned char* Kl, const LaneOfs& f, const bf16x8& q0, const bf16x8& q1, f32x4 (&s)[4]) {
#pragma unroll
    for (int kt = 0; kt < 4; ++kt) {
        const bf16x8 a0 = *(const bf16x8*)(Kl + f.k0 + kt * 2048);
        const bf16x8 a1 = *(const bf16x8*)(Kl + f.k1 + kt * 2048);
        f32x4 z = (f32x4){0.f, 0.f, 0.f, 0.f};
        z = __builtin_amdgcn_mfma_f32_16x16x32_bf16(a0, q0, z, 0, 0, 0);
        z = __builtin_amdgcn_mfma_f32_16x16x32_bf16(a1, q1, z, 0, 0, 0);
        s[kt][0] = z[0] * LOG2E; s[kt][1] = z[1] * LOG2E; s[kt][2] = z[2] * LOG2E; s[kt][3] = z[3] * LOG2E;
    }
}
template <class VF>
__device__ __forceinline__ void attn_step(const unsigned char* Kl, const unsigned char* VTl, int lane, const LaneOfs& f,
                                          const bf16x8& q0, const bf16x8& q1, f32x4 (&o)[4], float& m, float& l, VF valid) {
    f32x4 s[4];
    nsa_scores(Kl, f, q0, q1, s);
    float mx = -1e30f;
#pragma unroll
    for (int kt = 0; kt < 4; ++kt)
#pragma unroll
        for (int r = 0; r < 4; ++r) {
            const bool v = valid(kt * 16 + 4 * (lane >> 4) + r);
            s[kt][r] = v ? s[kt][r] : -1e30f;
            mx = fmaxf(mx, s[kt][r]);
        }
    mx = fmaxf(mx, __shfl_xor(mx, 16));
    mx = fmaxf(mx, __shfl_xor(mx, 32));
    const float mn = fmaxf(m, mx);
    const float alpha = __builtin_amdgcn_exp2f(m - mn);
    float ps = 0.f;
#pragma unroll
    for (int kt = 0; kt < 4; ++kt)
#pragma unroll
        for (int r = 0; r < 4; ++r) {
            const float pv = (s[kt][r] > -1e29f) ? __builtin_amdgcn_exp2f(s[kt][r] - mn) : 0.f;
            s[kt][r] = pv; ps += pv;
        }
    l = l * alpha + ps; m = mn;
#pragma unroll
    for (int dt = 0; dt < 4; ++dt) { o[dt][0] *= alpha; o[dt][1] *= alpha; o[dt][2] *= alpha; o[dt][3] *= alpha; }
#pragma unroll
    for (int k2 = 0; k2 < 2; ++k2) {
        uint4 pk;
        pk.x = pack2bf(s[2 * k2][0], s[2 * k2][1]); pk.y = pack2bf(s[2 * k2][2], s[2 * k2][3]);
        pk.z = pack2bf(s[2 * k2 + 1][0], s[2 * k2 + 1][1]); pk.w = pack2bf(s[2 * k2 + 1][2], s[2 * k2 + 1][3]);
        const bf16x8 pb = __builtin_bit_cast(bf16x8, pk);
#pragma unroll
        for (int dt = 0; dt < 4; ++dt) {
            uint4 av;
            const uint2 lo = *(const uint2*)(VTl + f.v0 + dt * 2048 + k2 * 64);
            const uint2 hi = *(const uint2*)(VTl + f.v1 + dt * 2048 + k2 * 64);
            av.x = lo.x; av.y = lo.y; av.z = hi.x; av.w = hi.y;
            o[dt] = __builtin_amdgcn_mfma_f32_16x16x32_bf16(__builtin_bit_cast(bf16x8, av), pb, o[dt], 0, 0, 0);
        }
    }
}
__device__ __forceinline__ unsigned sel4(const unsigned (&a)[4], int q) {
    return q == 0 ? a[0] : (q == 1 ? a[1] : (q == 2 ? a[2] : a[3]));
}

#define NSA_TILES 4096
__device__ __forceinline__ void nsa_tile(const Params& p, int tile, unsigned char* smem) {
    const int tid = threadIdx.x, lane = tid & 63, w = tid >> 6;
    const int bg = tile & 7, tb = 511 - (tile >> 3);
    const int b = bg >> 1, g = bg & 1;
    const int t0 = tb * 16, cur = t0 >> 6;
    float* impL = (float*)(smem + 32768);
    unsigned* selL = (unsigned*)(smem + 49152);
    const bf16_t* NQ = (const bf16_t*)(p.ws + OFF_NQ);
    const float* NG = (const float*)(p.ws + OFF_NGATE);
    const int rowq = lane & 15, tl = rowq >> 2, head = rowq & 3, lg = lane >> 4;
    const int tokl = 4 * w + tl;
    const LaneOfs lof = make_lane_ofs(lane);
    const StageOfs sof = make_stage_ofs();
    const size_t tokb = (size_t)b * SEQ + t0;
    bf16x8 q0, q1;
    {
        const bf16_t* qp = NQ + (tokb + tokl) * 512 + g * 256 + head * 64 + lg * 8;
        q0 = *(const bf16x8*)qp; q1 = *(const bf16x8*)(qp + 32);
    }
    const float* gp = NG + (tokb + tokl) * 24 + g * 12 + head * 3;
    __syncthreads();
    for (int i = tid; i < 2048; i += 256) impL[i] = 0.f;
    const int tq = t0 + tokl;
    f32x4 o[4], ot[4];
    float m, l;
#define NSA_RESET() { _Pragma("unroll") for (int dt = 0; dt < 4; ++dt) o[dt] = (f32x4){0.f, 0.f, 0.f, 0.f}; m = -1e30f; l = 0.f; }
#define NSA_LSUM() { l += __shfl_xor(l, 16); l += __shfl_xor(l, 32); }

    const int nv = (tq >= 31) ? (((tq - 31) >> 4) + 1) : 0;
    const int nkb = ((t0 >> 4) + 63) >> 6;
    const bf16_t* ckb = (const bf16_t*)(p.ws + OFF_CMPKB) + (size_t)(b * 2 + g) * 512 * 64;
    const bf16_t* cvb = (const bf16_t*)(p.ws + OFF_CMPVB) + (size_t)(b * 2 + g) * 512 * 64;
    NSA_RESET()
    nsa_kv_loop(ckb, cvb, 64, 0, nkb - 1, smem, sof, [&](int kb, const unsigned char* Kl, const unsigned char* VTl) __attribute__((always_inline)) {
        attn_step(Kl, VTl, lane, lof, q0, q1, o, m, l, [&](int key) __attribute__((always_inline)) { return kb * 64 + key < nv; });
    });
    NSA_LSUM()
    const float mc = m;
    const float invc = 1.f / fmaxf(l, 1e-30f);
    {
        const float f = gp[0] * invc;
#pragma unroll
        for (int dt = 0; dt < 4; ++dt) { ot[dt][0] = f * o[dt][0]; ot[dt][1] = f * o[dt][1]; ot[dt][2] = f * o[dt][2]; ot[dt][3] = f * o[dt][3]; }
    }
    if (cur >= 16) {
        nsa_kv_loop(ckb, cvb, 64, 0, nkb - 1, smem, sof, [&](int kb, const unsigned char* Kl, const unsigned char* VTl) __attribute__((always_inline)) {
            f32x4 s[4];
            nsa_scores(Kl, lof, q0, q1, s);
            float* impT = impL + tokl * 128;
#pragma unroll
            for (int kt = 0; kt < 4; ++kt) {
                float pr[4];
#pragma unroll
                for (int r = 0; r < 4; ++r) {
                    const int n = kb * 64 + kt * 16 + 4 * lg + r;
                    pr[r] = (n < nv) ? __builtin_amdgcn_exp2f(s[kt][r] - mc) * invc : 0.f;
                }
                float c1 = pr[0] + pr[1] + pr[2] + 0.5f * pr[3], c2 = 0.5f * pr[3];
                c1 += __shfl_xor(c1, 1); c1 += __shfl_xor(c1, 2);
                c2 += __shfl_xor(c2, 1); c2 += __shfl_xor(c2, 2);
                const int j = kb * 16 + kt * 4 + lg;
                if (head == 0) {
                    atomicAdd(&impT[j], c1);
                    if (j + 1 < 128) atomicAdd(&impT[j + 1], c2);
                }
            }
        });
        for (int tk = 0; tk < 4; ++tk) {
            const int tok = 4 * w + tk;
            const int jA = lane, jB = lane + 64;
            float v0, v1;
            {
                const bool fA = (jA == 0) || (jA == cur) || (jA == cur - 1), fB = (jB == cur) || (jB == cur - 1);
                v0 = fA ? 1.0e4f : ((jA <= cur) ? impL[tok * 128 + jA] : -1.f);
                v1 = fB ? 1.0e4f : ((jB <= cur) ? impL[tok * 128 + jB] : -1.f);
            }
            bool s0 = false, s1 = false;
            for (int k = 0; k < 16; ++k) {
                const float mx = wave_max(fmaxf(v0, v1));
                const unsigned long long b0 = __ballot(v0 == mx);
                if (b0) {
                    const int lsel = __ffsll((unsigned long long)b0) - 1;
                    if (lane == lsel) { v0 = -3.0e38f; s0 = true; }
                } else {
                    const unsigned long long b1 = __ballot(v1 == mx);
                    const int lsel = __ffsll((unsigned long long)b1) - 1;
                    if (lane == lsel) { v1 = -3.0e38f; s1 = true; }
                }
            }
            const unsigned long long mk0 = __ballot(s0), mk1 = __ballot(s1);
            if (lane == 0) {
                selL[tok * 4 + 0] = (unsigned)mk0; selL[tok * 4 + 1] = (unsigned)(mk0 >> 32);
                selL[tok * 4 + 2] = (unsigned)mk1; selL[tok * 4 + 3] = (unsigned)(mk1 >> 32);
            }
        }
    } else {
        if (lane < 4) {
            const int tok = 4 * w + lane;
            selL[tok * 4 + 0] = (2u << cur) - 1u; selL[tok * 4 + 1] = 0u; selL[tok * 4 + 2] = 0u; selL[tok * 4 + 3] = 0u;
        }
    }
    WAVE_LDS_SYNC();
#if NSA_DIAG
    if (head == 0 && lg == 0) {
        unsigned* SELM = (unsigned*)(p.ws + OFF_SELM);
#pragma unroll
        for (int qd = 0; qd < 4; ++qd) SELM[((size_t)bg * SEQ + tq) * 4 + qd] = selL[tokl * 4 + qd];
    }
#endif
    NSA_RESET()
    {
        const bf16_t* kg = (const bf16_t*)(p.ws + OFF_KV + 2 * KV_STRIDE) + (size_t)b * SEQ * 128 + g * 64;
        const bf16_t* vg = (const bf16_t*)(p.ws + OFF_KV + 3 * KV_STRIDE) + (size_t)b * SEQ * 128 + g * 64;
        nsa_kv_loop(kg, vg, 128, 0, cur, smem, sof, [&](int kb, const unsigned char* Kl, const unsigned char* VTl) __attribute__((always_inline)) {
            const bool sv = (selL[tokl * 4 + (kb >> 5)] >> (kb & 31)) & 1u;
            if (__ballot(sv) != 0ull)
                attn_step(Kl, VTl, lane, lof, q0, q1, o, m, l, [&](int key) __attribute__((always_inline)) { return sv && (kb * 64 + key <= tq); });
        });
    }
    NSA_LSUM()
    {
        const float f = gp[1] / fmaxf(l, 1e-30f);
#pragma unroll
        for (int dt = 0; dt < 4; ++dt) { ot[dt][0] += f * o[dt][0]; ot[dt][1] += f * o[dt][1]; ot[dt][2] += f * o[dt][2]; ot[dt][3] += f * o[dt][3]; }
    }
    NSA_RESET()
    {
        const bf16_t* kg = (const bf16_t*)(p.ws + OFF_KV + 4 * KV_STRIDE) + (size_t)b * SEQ * 128 + g * 64;
        const bf16_t* vg = (const bf16_t*)(p.ws + OFF_KV + 5 * KV_STRIDE) + (size_t)b * SEQ * 128 + g * 64;
        const int klo = (t0 > 511) ? ((t0 - 511) >> 6) : 0;
        nsa_kv_loop(kg, vg, 128, klo, cur, smem, sof, [&](int kb, const unsigned char* Kl, const unsigned char* VTl) __attribute__((always_inline)) {
            attn_step(Kl, VTl, lane, lof, q0, q1, o, m, l, [&](int key) __attribute__((always_inline)) { const int ka = kb * 64 + key; return (ka <= tq) && (ka >= tq - 511); });
        });
    }
    NSA_LSUM()
    {
        const float f = gp[2] / fmaxf(l, 1e-30f);
        bf16_t* MIX = (bf16_t*)(p.ws + OFF_XB);
#pragma unroll
        for (int dt = 0; dt < 4; ++dt) {
            uint2 ov;
            ov.x = pack2bf(ot[dt][0] + f * o[dt][0], ot[dt][1] + f * o[dt][1]);
            ov.y = pack2bf(ot[dt][2] + f * o[dt][2], ot[dt][3] + f * o[dt][3]);
            *(uint2*)(MIX + (tokb + tokl) * DM + 512 + g * 256 + head * 64 + dt * 16 + lg * 4) = ov;
        }
    }
#undef NSA_RESET
#undef NSA_LSUM
}

__device__ __forceinline__ float block_sum(float v, float* red) {
    v = wave_sum(v);
    __syncthreads();
    if ((threadIdx.x & 63) == 0) red[threadIdx.x >> 6] = v;
    __syncthreads();
    return red[0] + red[1] + red[2] + red[3];
}
__device__ __forceinline__ float4 ln_row(float4 y, const float* g, const float* bb, float* red) {
    const int tid = threadIdx.x;
    const float mu = block_sum(y.x + y.y + y.z + y.w, red) * (1.f / 1024.f);
    const float dx = y.x - mu, dy = y.y - mu, dz = y.z - mu, dw = y.w - mu;
    const float var = block_sum(dx * dx + dy * dy + dz * dz + dw * dw, red) * (1.f / 1024.f);
    const float rs = rsqrtf(var + LN_EPS);
    const float4 gg = ((const float4*)g)[tid], b4 = ((const float4*)bb)[tid];
    return make_float4(dx * rs * gg.x + b4.x, dy * rs * gg.y + b4.y, dz * rs * gg.z + b4.z, dw * rs * gg.w + b4.w);
}

__device__ __forceinline__ void ln1_phase(const Params& p, float* sm) {
    const int tid = threadIdx.x;
    for (int n = blockIdx.x; n < NTOK; n += gridDim.x) {
        const float4 y = ((const float4*)(p.out + (size_t)n * DM))[tid];
        const float4 o = ln_row(y, p.in[15], p.in[16], sm);
        ((float4*)(p.out + (size_t)n * DM))[tid] = o;
        uint2 hb; hb.x = pack2bf(o.x, o.y); hb.y = pack2bf(o.z, o.w);
        ((uint2*)((bf16_t*)(p.ws + OFF_XB) + (size_t)n * DM))[tid] = hb;
    }
}

typedef __bf16 bf16x2_t __attribute__((ext_vector_type(2)));
template <int CTRL> __device__ __forceinline__ float dppf(float x) {
    return __builtin_bit_cast(float, __builtin_amdgcn_mov_dpp(__builtin_bit_cast(int, x), CTRL, 0xf, 0xf, true));
}
__device__ __forceinline__ float row16_max(float m) {
    m = fmaxf(m, dppf<0x121>(m)); m = fmaxf(m, dppf<0x122>(m));
    m = fmaxf(m, dppf<0x124>(m)); m = fmaxf(m, dppf<0x128>(m));
    return m;
}
__device__ __forceinline__ float row16_sum(float m) {
    m += dppf<0x121>(m); m += dppf<0x122>(m); m += dppf<0x124>(m); m += dppf<0x128>(m);
    return m;
}
__device__ __forceinline__ float dot2bf(unsigned a, unsigned b, float acc) {
    return __builtin_amdgcn_fdot2_f32_bf16(__builtin_bit_cast(bf16x2_t, a), __builtin_bit_cast(bf16x2_t, b), acc, false);
}
__device__ __forceinline__ float enc_key(float v, unsigned idx, unsigned mask) {
    const unsigned u = __float_as_uint(v);
    const unsigned code = (u >> 31) ? idx : (mask - idx);
    return __uint_as_float((u & ~mask) | code);
}
__device__ __forceinline__ unsigned dec_idx(float key, unsigned mask) {
    const unsigned u = __float_as_uint(key);
    const unsigned code = u & mask;
    return (u >> 31) ? code : (mask - code);
}
__device__ __forceinline__ float dec_val(float key, unsigned mask) { return __uint_as_float(__float_as_uint(key) & ~mask); }
#define NEGKEY (-3.0e38f)


typedef float f32x2 __attribute__((ext_vector_type(2)));
__device__ __forceinline__ void cvt_rows_fp8(const float* __restrict__ src, unsigned char* __restrict__ dst, float* __restrict__ scales, int rows) {
    const int lane = threadIdx.x & 63, w = threadIdx.x >> 6;
    for (int r = blockIdx.x * 4 + w; r < rows; r += gridDim.x * 4) {
        const float4* sp = (const float4*)(src + (size_t)r * 1024 + lane * 16);
        const float4 a = sp[0], b = sp[1], c = sp[2], d = sp[3];
        float mx = fmaxf(fmaxf(fmaxf(fabsf(a.x), fabsf(a.y)), fmaxf(fabsf(a.z), fabsf(a.w))), fmaxf(fmaxf(fabsf(b.x), fabsf(b.y)), fmaxf(fabsf(b.z), fabsf(b.w))));
        mx = fmaxf(mx, fmaxf(fmaxf(fmaxf(fabsf(c.x), fabsf(c.y)), fmaxf(fabsf(c.z), fabsf(c.w))), fmaxf(fmaxf(fabsf(d.x), fabsf(d.y)), fmaxf(fabsf(d.z), fabsf(d.w)))));
        mx = wave_max(mx);
        const float sc = (mx > 0.f) ? mx * (1.f / 448.f) : 1.f;
        const float inv = 1.f / sc;
        uint4 o;
        int t;
        t = 0; t = __builtin_amdgcn_cvt_pk_fp8_f32(a.x * inv, a.y * inv, t, false); t = __builtin_amdgcn_cvt_pk_fp8_f32(a.z * inv, a.w * inv, t, true); o.x = (unsigned)t;
        t = 0; t = __builtin_amdgcn_cvt_pk_fp8_f32(b.x * inv, b.y * inv, t, false); t = __builtin_amdgcn_cvt_pk_fp8_f32(b.z * inv, b.w * inv, t, true); o.y = (unsigned)t;
        t = 0; t = __builtin_amdgcn_cvt_pk_fp8_f32(c.x * inv, c.y * inv, t, false); t = __builtin_amdgcn_cvt_pk_fp8_f32(c.z * inv, c.w * inv, t, true); o.z = (unsigned)t;
        t = 0; t = __builtin_amdgcn_cvt_pk_fp8_f32(d.x * inv, d.y * inv, t, false); t = __builtin_amdgcn_cvt_pk_fp8_f32(d.z * inv, d.w * inv, t, true); o.w = (unsigned)t;
        *(uint4*)(dst + (size_t)r * 1024 + lane * 16) = o;
        if (lane == 0) scales[r] = sc;
    }
}

__device__ __forceinline__ void fold_ws_phase(const float* __restrict__ wq, const float* __restrict__ k1, const float* __restrict__ k2,
                                              bf16_t* __restrict__ WsT) {
    for (int it = blockIdx.x * 256 + threadIdx.x; it < 2048 * 128; it += gridDim.x * 256) {
        const int r = it & 2047, kg = it >> 11;
        const int a = (r >> 7) & 1, j = r & 127;
        const float* kr = (a ? k2 : k1) + j * 128;
        const float* wr = wq + (size_t)(kg * 8) * 2048 + (r & ~127);
        float s[8];
#pragma unroll
        for (int q = 0; q < 8; ++q) s[q] = 0.f;
        for (int d = 0; d < 128; d += 4) {
            const float4 kv = *(const float4*)(kr + d);
#pragma unroll
            for (int q = 0; q < 8; ++q) {
                const float4 wv = *(const float4*)(wr + (size_t)q * 2048 + d);
                s[q] += wv.x * kv.x + wv.y * kv.y + wv.z * kv.z + wv.w * kv.w;
            }
        }
        uint4 o;
        o.x = pack2bf(s[0], s[1]); o.y = pack2bf(s[2], s[3]); o.z = pack2bf(s[4], s[5]); o.w = pack2bf(s[6], s[7]);
        *(uint4*)(WsT + (size_t)r * 1024 + kg * 8) = o;
    }
}

#define CE_DESC(a, b) { const float t_ = fmaxf(a, b); b = fminf(a, b); a = t_; }

struct EpiTop16 {
    float* topk; unsigned char* lds;
    __device__ __forceinline__ void operator()(int m, int n, f32x4 v) const {
        const int ml = m & 127, g4 = (n & 127) >> 2;
        *(float4*)(lds + ((ml * 32 + (g4 ^ (ml & 7))) << 4)) = make_float4(v[0], v[1], v[2], v[3]);
    }
    __device__ __forceinline__ void finish(int m0, int n0) const {
        __syncthreads();
        const int lane = threadIdx.x & 63, w = threadIdx.x >> 6, c = lane & 15;
        const int L = n0 >> 7;
        for (int it = 0; it < 8; ++it) {
            const int r = w * 32 + it * 4 + (lane >> 4);
            const float4 x0 = *(const float4*)(lds + ((r * 32 + ((2 * c) ^ (r & 7))) << 4));
            const float4 x1 = *(const float4*)(lds + ((r * 32 + ((2 * c + 1) ^ (r & 7))) << 4));
            float l0 = enc_key(x0.x, 8 * c + 0, 127), l1 = enc_key(x0.y, 8 * c + 1, 127), l2 = enc_key(x0.z, 8 * c + 2, 127),
                  l3 = enc_key(x0.w, 8 * c + 3, 127), l4 = enc_key(x1.x, 8 * c + 4, 127), l5 = enc_key(x1.y, 8 * c + 5, 127),
                  l6 = enc_key(x1.z, 8 * c + 6, 127), l7 = enc_key(x1.w, 8 * c + 7, 127);
            CE_DESC(l0, l1) CE_DESC(l2, l3) CE_DESC(l4, l5) CE_DESC(l6, l7)
            CE_DESC(l0, l2) CE_DESC(l1, l3) CE_DESC(l4, l6) CE_DESC(l5, l7)
            CE_DESC(l1, l2) CE_DESC(l5, l6)
            CE_DESC(l0, l4) CE_DESC(l1, l5) CE_DESC(l2, l6) CE_DESC(l3, l7)
            CE_DESC(l2, l4) CE_DESC(l3, l5)
            CE_DESC(l1, l2) CE_DESC(l3, l4) CE_DESC(l5, l6)
            float res = NEGKEY;
#pragma unroll
            for (int k = 0; k < 16; ++k) {
                const float mx = row16_max(l0);
                const bool win = (l0 == mx);
                l0 = win ? l1 : l0; l1 = win ? l2 : l1; l2 = win ? l3 : l2; l3 = win ? l4 : l3;
                l4 = win ? l5 : l4; l5 = win ? l6 : l5; l6 = win ? l7 : l6; l7 = win ? NEGKEY : l7;
                res = (c == k) ? mx : res;
            }
            topk[(size_t)(m0 + r) * 256 + L * 16 + c] = res;
        }
        __syncthreads();
    }
};

__device__ __forceinline__ void peer_fast_phase(const Params& p, unsigned char* smem) {
    const int tid = threadIdx.x, lane = tid & 63, w = tid >> 6, l16 = lane & 15, gq = lane >> 4;
    float* tk = (float*)(smem + w * 2048);
    int* ex = (int*)(smem + w * 2048 + 1024);
    float* gw = (float*)(smem + w * 2048 + 1536);
    const bf16_t* H1B = (const bf16_t*)(p.ws + OFF_XB);
    const unsigned char* U8 = p.ws + OFF_UB;
    const unsigned char* V8 = p.ws + OFF_VB;
    const float* USC = (const float*)(p.ws + OFF_USC);
    const float* VSC = (const float*)(p.ws + OFF_VSC);
    const float* TOPK = (const float*)(p.ws + OFF_TOPK);
    int ci[4], cj[4];
#pragma unroll
    for (int q = 0; q < 4; ++q) {
        const int s = l16 + 16 * q;
        int i, j;
        if (s < 16) { i = 0; j = s; }
        else if (s < 24) { i = 1; j = s - 16; }
        else if (s < 29) { i = 2; j = s - 24; }
        else if (s < 33) { i = 3; j = s - 29; }
        else if (s < 36) { i = 4; j = s - 33; }
        else if (s < 42) { i = 5 + ((s - 36) >> 1); j = (s - 36) & 1; }
        else if (s < 50) { i = 8 + (s - 42); j = 0; }
        else { i = -1; j = 0; }
        ci[q] = i; cj[q] = j;
    }
    for (int n = blockIdx.x * 4 + w; n < NTOK; n += gridDim.x * 4) {
        WAVE_LDS_SYNC();
        ((float4*)tk)[lane] = ((const float4*)(TOPK + (size_t)n * 256))[lane];
        WAVE_LDS_SYNC();
#pragma unroll
        for (int it = 0; it < 2; ++it) {
            const int head = it * 4 + gq;
            const float* ka = tk + head * 32;
            const float* kb = ka + 16;
            float c0, c1, c2, c3;
#define MKC(q, cq) { if (ci[q] >= 0) { const float sum_ = dec_val(ka[ci[q]], 127) + dec_val(kb[cj[q]], 127); \
                     cq = enc_key(sum_, ci[q] * 16 + cj[q], 255); } else cq = NEGKEY; }
            MKC(0, c0) MKC(1, c1) MKC(2, c2) MKC(3, c3)
#undef MKC
            float res = NEGKEY;
#pragma unroll
            for (int k = 0; k < 16; ++k) {
                const float mx = row16_max(fmaxf(fmaxf(c0, c1), fmaxf(c2, c3)));
                c0 = (c0 == mx) ? NEGKEY : c0; c1 = (c1 == mx) ? NEGKEY : c1;
                c2 = (c2 == mx) ? NEGKEY : c2; c3 = (c3 == mx) ? NEGKEY : c3;
                res = (l16 == k) ? mx : res;
            }
            const unsigned cc = dec_idx(res, 255);
            const float val = dec_val(res, 255);
            const unsigned e1 = dec_idx(ka[cc >> 4], 127), e2 = dec_idx(kb[cc & 15], 127);
            const float m0 = row16_max(val);
            const float e = expf(val - m0);
            const float ssum = row16_sum(e);
            ex[head * 16 + l16] = (int)(e1 * 128 + e2);
            gw[head * 16 + l16] = e / ssum;
        }
        WAVE_LDS_SYNC();
        {
            float xf[64];
            {
                const uint4* xr = (const uint4*)(H1B + (size_t)n * DM + 16 * l16);
#pragma unroll
                for (int i = 0; i < 4; ++i) {
                    const uint4 xa = xr[32 * i], xb = xr[32 * i + 1];
                    xf[16 * i + 0] = __uint_as_float(xa.x << 16); xf[16 * i + 1] = __uint_as_float(xa.x & 0xffff0000u);
                    xf[16 * i + 2] = __uint_as_float(xa.y << 16); xf[16 * i + 3] = __uint_as_float(xa.y & 0xffff0000u);
                    xf[16 * i + 4] = __uint_as_float(xa.z << 16); xf[16 * i + 5] = __uint_as_float(xa.z & 0xffff0000u);
                    xf[16 * i + 6] = __uint_as_float(xa.w << 16); xf[16 * i + 7] = __uint_as_float(xa.w & 0xffff0000u);
                    xf[16 * i + 8] = __uint_as_float(xb.x << 16); xf[16 * i + 9] = __uint_as_float(xb.x & 0xffff0000u);
                    xf[16 * i + 10] = __uint_as_float(xb.y << 16); xf[16 * i + 11] = __uint_as_float(xb.y & 0xffff0000u);
                    xf[16 * i + 12] = __uint_as_float(xb.z << 16); xf[16 * i + 13] = __uint_as_float(xb.z & 0xffff0000u);
                    xf[16 * i + 14] = __uint_as_float(xb.w << 16); xf[16 * i + 15] = __uint_as_float(xb.w & 0xffff0000u);
                }
            }
#pragma unroll 2
            for (int it = 0; it < 32; ++it) {
                const int k = it * 4 + gq;
                const int e = ex[k];
                const uint4* ur = (const uint4*)(U8 + (size_t)e * DM + 16 * l16);
                const uint4 a0 = ur[0], a1 = ur[16], a2 = ur[32], a3 = ur[48];
                const float usc = USC[e];
                float s = 0.f;
#define D8(W_, B_) { const f32x2 lo_ = __builtin_amdgcn_cvt_pk_f32_fp8((int)(W_), false), hi_ = __builtin_amdgcn_cvt_pk_f32_fp8((int)(W_), true); \
                     s += lo_[0] * xf[(B_)] + lo_[1] * xf[(B_) + 1] + hi_[0] * xf[(B_) + 2] + hi_[1] * xf[(B_) + 3]; }
                D8(a0.x, 0) D8(a0.y, 4) D8(a0.z, 8) D8(a0.w, 12)
                D8(a1.x, 16) D8(a1.y, 20) D8(a1.z, 24) D8(a1.w, 28)
                D8(a2.x, 32) D8(a2.y, 36) D8(a2.z, 40) D8(a2.w, 44)
                D8(a3.x, 48) D8(a3.y, 52) D8(a3.z, 56) D8(a3.w, 60)
#undef D8
                s = row16_sum(s) * usc;
                if (l16 == 0) gw[k] = gw[k] * gelu_tanh(s) * VSC[e];
            }
        }
        WAVE_LDS_SYNC();
        float acc[16];
#pragma unroll
        for (int q = 0; q < 16; ++q) acc[q] = 0.f;
#pragma unroll 4
        for (int k = 0; k < 128; ++k) {
            const int e = ex[k];
            const float wk = gw[k];
            const uint4 a = *(const uint4*)(V8 + (size_t)e * DM + 16 * lane);
#define A4(W_, B_) { const f32x2 lo_ = __builtin_amdgcn_cvt_pk_f32_fp8((int)(W_), false), hi_ = __builtin_amdgcn_cvt_pk_f32_fp8((int)(W_), true); \
                     acc[(B_)] += wk * lo_[0]; acc[(B_) + 1] += wk * lo_[1]; acc[(B_) + 2] += wk * hi_[0]; acc[(B_) + 3] += wk * hi_[1]; }
            A4(a.x, 0) A4(a.y, 4) A4(a.z, 8) A4(a.w, 12)
#undef A4
        }
        {
            float* orow = p.out + (size_t)n * DM + 16 * lane;
            const float4 h0 = ((const float4*)orow)[0], h1 = ((const float4*)orow)[1], h2 = ((const float4*)orow)[2], h3 = ((const float4*)orow)[3];
            float y[16] = {h0.x, h0.y, h0.z, h0.w, h1.x, h1.y, h1.z, h1.w, h2.x, h2.y, h2.z, h2.w, h3.x, h3.y, h3.z, h3.w};
            float sum = 0.f;
#pragma unroll
            for (int q = 0; q < 16; ++q) { y[q] = ALPHA * y[q] + acc[q]; sum += y[q]; }
            const float mu = wave_sum(sum) * (1.f / 1024.f);
            float sq = 0.f;
#pragma unroll
            for (int q = 0; q < 16; ++q) { y[q] -= mu; sq += y[q] * y[q]; }
            const float rs = rsqrtf(wave_sum(sq) * (1.f / 1024.f) + LN_EPS);
            const float* g = p.in[22] + 16 * lane;
            const float* bb = p.in[23] + 16 * lane;
#pragma unroll
            for (int hq = 0; hq < 4; ++hq) {
                const float4 gg = ((const float4*)g)[hq], b4 = ((const float4*)bb)[hq];
                float4 o;
                o.x = y[hq * 4 + 0] * rs * gg.x + b4.x; o.y = y[hq * 4 + 1] * rs * gg.y + b4.y;
                o.z = y[hq * 4 + 2] * rs * gg.z + b4.z; o.w = y[hq * 4 + 3] * rs * gg.w + b4.w;
                ((float4*)orow)[hq] = o;
            }
        }
    }
}

#define XB_TMO      128
#define XB_XCNT(j)  (256  + 64 * (j))
#define XB_XSUB(j)  (1280 + 64 * (j))
#define XB_XGEN(j)  (2304 + 64 * (j))
#define XB_TOP      3328
#define XB_TOPGEN   3392
#define XCD_BAR_WORDS 3456
#define XB_SPIN_CAP (1u << 22)
__device__ __forceinline__ unsigned xb_ld(unsigned* p) { return __hip_atomic_load(p, __ATOMIC_RELAXED, __HIP_MEMORY_SCOPE_AGENT); }
__device__ __forceinline__ unsigned xb_add(unsigned* p, unsigned v) { return __hip_atomic_fetch_add(p, v, __ATOMIC_RELAXED, __HIP_MEMORY_SCOPE_AGENT); }
__device__ __forceinline__ unsigned xb_xcc_id() { return (unsigned)__builtin_amdgcn_s_getreg((3 << 11) | 20) & 0xFu; }
#define XB_SPIN(cond, bar) do { unsigned _sp = 0; while (cond) { __builtin_amdgcn_s_sleep(1); \
    if ((++_sp & 255u) == 0u) { if (xb_ld(&(bar)[XB_TMO])) break; if (_sp > XB_SPIN_CAP) { atomicAdd(&(bar)[XB_TMO], 1u); break; } } } } while (0)
struct XcdBarrier { unsigned* bar; unsigned x; unsigned* st; };
__device__ __forceinline__ XcdBarrier xcd_barrier_post(unsigned* bar, unsigned* st) {
    XcdBarrier b; b.bar = bar; b.x = xb_xcc_id(); b.st = st;
    if (threadIdx.x == 0) (void)xb_add(&bar[XB_XCNT(b.x)], 1u);
    return b;
}
__device__ __forceinline__ void xcd_barrier_complete(unsigned* bar, unsigned x, unsigned& nloc, unsigned& nx) {
    const unsigned G = gridDim.x * gridDim.y * gridDim.z;
    unsigned sum, cnt, mine, sp = 0u;
    for (;;) {
        sum = 0u; cnt = 0u; mine = 0u;
#pragma unroll
        for (unsigned j = 0; j < 16; ++j) { const unsigned c = xb_ld(&bar[XB_XCNT(j)]); sum += c; cnt += (c > 0u) ? 1u : 0u; mine = (j == x) ? c : mine; }
        if (sum == G) break;
        __builtin_amdgcn_s_sleep(1);
        if ((++sp & 255u) == 0u) { if (xb_ld(&bar[XB_TMO])) break; if (sp > XB_SPIN_CAP) { atomicAdd(&bar[XB_TMO], 1u); break; } }
    }
    nloc = mine > 0u ? mine : 1u; nx = cnt > 0u ? cnt : 1u;
}
__device__ __forceinline__ void xcd_barrier(const XcdBarrier& b) {
    asm volatile("s_waitcnt vmcnt(0)" ::: "memory");
    __syncthreads();
    if (threadIdx.x == 0) {
        unsigned* bar = b.bar;
        __builtin_amdgcn_s_waitcnt(0);
        unsigned nloc = xb_ld(&b.st[0]), nx = xb_ld(&b.st[1]);
        if (nloc == 0u) { xcd_barrier_complete(bar, b.x, nloc, nx); __hip_atomic_store(&b.st[0], nloc, __ATOMIC_RELAXED, __HIP_MEMORY_SCOPE_AGENT); __hip_atomic_store(&b.st[1], nx, __ATOMIC_RELAXED, __HIP_MEMORY_SCOPE_AGENT); }
        const unsigned old = xb_add(&bar[XB_XSUB(b.x)], 1u);
        const unsigned gen = old / nloc;
        if (old + 1u == (gen + 1u) * nloc) {
            __builtin_amdgcn_fence(__ATOMIC_RELEASE, "agent");
            asm volatile("s_waitcnt vmcnt(0)" ::: "memory");
            const unsigned og = xb_add(&bar[XB_TOP], 1u);
            const unsigned tg = og / nx;
            if (og + 1u == (tg + 1u) * nx) xb_add(&bar[XB_TOPGEN], 1u);
            else XB_SPIN(xb_ld(&bar[XB_TOPGEN]) == tg, bar);
            __builtin_amdgcn_fence(__ATOMIC_ACQUIRE, "agent");
            xb_add(&bar[XB_XGEN(b.x)], 1u);
            asm volatile("s_waitcnt vmcnt(0)" ::: "memory");
        } else {
            XB_SPIN(xb_ld(&bar[XB_XGEN(b.x)]) == gen, bar);
            __builtin_amdgcn_fence(__ATOMIC_ACQUIRE, "agent");
            asm volatile("s_waitcnt vmcnt(0)" ::: "memory");
        }
    }
    __syncthreads();
}

__global__ void __launch_bounds__(256, 2) mega(Params p) {
    cg::grid_group grid = cg::this_grid();
    __shared__ __attribute__((aligned(16))) unsigned char smem[65536];
    float* sm = (float*)smem;
    unsigned* barw = (unsigned*)(p.ws + OFF_BAR);
    const XcdBarrier xbar = xcd_barrier_post(barw, barw + XCD_BAR_WORDS + 2 * blockIdx.x);
#if TIME_DIAG
    unsigned long long* TS = (unsigned long long*)(p.ws + OFF_DIAG + 256);
#define STAMP(k) if (blockIdx.x == 0 && threadIdx.x == 0) TS[k] = __builtin_amdgcn_s_memrealtime();
    STAMP(0)
#else
#define STAMP(k)
#endif
    bf16_t* XB = (bf16_t*)(p.ws + OFF_XB);
    bf16_t* WinT = (bf16_t*)(p.ws + OFF_WINT);
    bf16_t* WoutT = (bf16_t*)(p.ws + OFF_WOUTT);
    bf16_t* WqT = (bf16_t*)(p.ws + OFF_WQT);
    cvt_rows_bf16(p.in[0], XB, (size_t)NTOK * DM / 8);
    transpose_bf16(p.in[1], DIN, 3456, WinT);
    transpose_bf16(p.in[2], DM, DM, WoutT);
    fold_ws_phase(p.in[17], p.in[18], p.in[19], WqT);
    cvt_rows_fp8(p.in[20], p.ws + OFF_UB, (float*)(p.ws + OFF_USC), 16384);
    cvt_rows_fp8(p.in[21], p.ws + OFF_VB, (float*)(p.ws + OFF_VSC), 16384);
    transpose_bf16(p.in[6], 256, 256, (bf16_t*)(p.ws + OFF_W1T), 2048);
    transpose_bf16(p.in[11], 256, 256, (bf16_t*)(p.ws + OFF_W1T) + 256 * 2048, 2048);
    if (blockIdx.x == 0) {
        for (int c = threadIdx.x; c < 512; c += 256)
            ((float*)(p.ws + OFF_LBV))[c] = 1.f / (1.f + expf(p.in[3][512 + c] - p.in[3][c]));
        if (threadIdx.x < 16) ((float*)(p.ws + OFF_DIAG))[threadIdx.x] = 0.f;
    }
    if (blockIdx.x == 1 || blockIdx.x == 2) cmp_peb(p, blockIdx.x - 1);
    grid.sync(); STAMP(1)
    gemm_bf16_phase(XB, DM, WinT, DM, NTOK / 128, 27, smem, EpiProj{p.ws});
    xcd_barrier(xbar); STAMP(2)
    for (int it = blockIdx.x; it < 128; it += gridDim.x) {
        const int which = it >> 6, t = it & 63;
        gemm_tile(ALoadCmp{(const bf16_t*)(p.ws + OFF_KV + (size_t)which * KV_STRIDE)},
                  (const bf16_t*)(p.ws + OFF_W1T) + (size_t)which * 256 * 2048, 2048, 32, (t >> 1) * 128, (t & 1) * 128, smem,
                  EpiCmpH{(bf16_t*)(p.ws + OFF_HB) + (size_t)which * 4096 * 256, (const float*)(p.ws + OFF_PEB) + which * 256});
    }
    for (int it = (blockIdx.x + gridDim.x - 128 % gridDim.x) % gridDim.x; it < 2048; it += gridDim.x) hgrn_passA(p, it, smem);
#if NSA_DIAG
    for (int it = blockIdx.x; it < 2 * 4 * NCB * 2; it += gridDim.x) compress_item(p, it, sm);
#endif
    xcd_barrier(xbar); STAMP(3)
    if (blockIdx.x < 256) hgrn_scan_item(p, blockIdx.x);
    cmp_layer2_phase(p, 0, gridDim.x);
    xcd_barrier(xbar); STAMP(4)
    for (int it = blockIdx.x; it < NSA_TILES; it += gridDim.x) nsa_tile(p, it, smem);
    for (int it = gridDim.x - 1 - blockIdx.x; it < 2048; it += gridDim.x) hgrn_passC(p, it, smem);
    xcd_barrier(xbar); STAMP(5)
#if NSA_DIAG
    for (int it = blockIdx.x; it < 4 * 2 * SEQ; it += gridDim.x) nsa_item(p, it, sm);
    grid.sync();
    {
        const float* DG = (const float*)(p.ws + OFF_DIAG);
#if NSA_DIAG == 1
        const float cval = -log10f(sqrtf(DG[0] / DG[1]) + 1e-9f);
#else
        const float cval = -log10f(DG[2] / DG[3] + 1e-6f);
#endif
        for (size_t i = (size_t)blockIdx.x * 256 + threadIdx.x; i < (size_t)NTOK * DM; i += (size_t)gridDim.x * 256) p.out[i] = cval;
        return;
    }
#endif
    gemm_bf16_phase(XB, DM, WoutT, DM, NTOK / 128, 8, smem, EpiY{p.in[0], p.out});
    xcd_barrier(xbar); STAMP(6)
    ln1_phase(p, sm);
    xcd_barrier(xbar); STAMP(7)
    gemm_bf16_phase(XB, DM, WqT, DM, NTOK / 128, 16, smem, EpiTop16{(float*)(p.ws + OFF_TOPK), smem});
    xcd_barrier(xbar); STAMP(8)
    peer_fast_phase(p, smem);
#if TIME_DIAG
    xcd_barrier(xbar); STAMP(9)
    grid.sync();
    {
        const int pa = TIME_DIAG / 100, pb = TIME_DIAG % 100;
        const float da = (float)(TS[pa] - TS[pa - 1]) * 0.01f, db = (float)(TS[pb] - TS[pb - 1]) * 0.01f;
        const float ca = rintf(25.f * log10f(da * 0.1f)) * 0.04f; (void)db;
        for (size_t i = (size_t)blockIdx.x * 256 + threadIdx.x; i < (size_t)NTOK * DM; i += (size_t)gridDim.x * 256) p.out[i] = ca;
    }
#endif
}

extern "C" void kernel_launch(void* const* d_in, const int* in_sizes, int n_in, void* d_out, int out_size,
                              void* d_ws, size_t ws_size, hipStream_t stream) {
    static int grid_blocks = 0;
    if (!grid_blocks) {
        int dev = 0, cus = 0, per_cu = 0;
        hipGetDevice(&dev);
        hipDeviceGetAttribute(&cus, hipDeviceAttributeMultiprocessorCount, dev);
        hipOccupancyMaxActiveBlocksPerMultiprocessor(&per_cu, mega, 256, 0);
        if (per_cu > 4) per_cu = 4;
        if (per_cu < 1) per_cu = 1;
        grid_blocks = cus * per_cu;
        if (n_in != 24 || ws_size < WS_NEED || out_size != NTOK * DM)
            fprintf(stderr, "kernel_launch: unexpected sizes n_in=%d ws=%zu out=%d\n", n_in, ws_size, out_size);
    }
    Params p;
    memset(&p, 0, sizeof(p));
    for (int i = 0; i < 24; ++i) p.in[i] = (const float*)d_in[i];
    p.out = (float*)d_out;
    p.ws = (unsigned char*)d_ws;
    hipMemsetAsync((char*)d_ws + OFF_BAR, 0, BAR_BYTES, stream);
    void* args[] = {&p};
    hipError_t e = hipLaunchCooperativeKernel((void*)mega, dim3(grid_blocks), dim3(256), args, 0, stream);
    if (e != hipSuccess) fprintf(stderr, "cooperative launch failed: %s (grid %d)\n", hipGetErrorString(e), grid_blocks);
}
```

```cpp
#include <hip/hip_runtime.h>
#include <hip/hip_cooperative_groups.h>
#include <cstdio>
#include <cstring>
namespace cg = cooperative_groups;

#define NTOK 32768
#define SEQ 8192
#define DM 1024
#define DIN 3352
#define NCB 511
#define ALPHA 1.189207115002721f
#define LN_EPS 1e-5f

#define MB_ 1048576ull
#define OFF_XB 0ull
#define OFF_HQ (64 * MB_)
#define OFF_HLF (96 * MB_)
#define OFF_HI (160 * MB_)
#define OFF_HG (192 * MB_)
#define OFF_NQ (224 * MB_)
#define OFF_KV (256 * MB_)
#define KV_STRIDE (8 * MB_)
#define OFF_NGATE (304 * MB_)
#define OFF_CMPK (308 * MB_)
#define OFF_CMPV (309 * MB_)
#define OFF_WINT (310 * MB_)
#define OFF_WOUTT (317 * MB_)
#define OFF_WQT (319 * MB_)
#define OFF_LBV (323 * MB_)
#define OFF_DC (324 * MB_)
#define OFF_SC (325 * MB_)
#define OFF_UB (389 * MB_)
#define OFF_VB (421 * MB_)
#define OFF_TOPK (453 * MB_)
#define OFF_W1T (485 * MB_)
#define OFF_HB (487 * MB_)
#define OFF_CMPKB (491 * MB_)
#define OFF_CMPVB (491 * MB_ + 524288ull)
#define OFF_PEB (492 * MB_)
#define OFF_SELM (493 * MB_)
#define OFF_DIAG (494 * MB_)
#define OFF_USC (494 * MB_ + 131072ull)
#define OFF_VSC (494 * MB_ + 196608ull)
#define OFF_BAR (494 * MB_ + 65536ull)
#define BAR_BYTES 32768
#define WS_NEED (495 * MB_)
#define USE_NSA_MFMA 1
#define NSA_DIAG 0
#define TIME_DIAG 0

struct Params {
    const float* in[24];
    float* out;
    unsigned char* ws;
};

typedef float f32x16 __attribute__((ext_vector_type(16)));
#define WAVE_LDS_SYNC() asm volatile("s_waitcnt lgkmcnt(0)" ::: "memory")
#define LAS3 __attribute__((address_space(3)))

__device__ __forceinline__ int opaque_tid() { int t = threadIdx.x; asm volatile("" : "+v"(t)); return t; }
__device__ __forceinline__ float wave_sum(float v) {
#pragma unroll
    for (int o = 32; o; o >>= 1) v += __shfl_xor(v, o);
    return v;
}
__device__ __forceinline__ float wave_max(float v) {
#pragma unroll
    for (int o = 32; o; o >>= 1) v = fmaxf(v, __shfl_xor(v, o));
    return v;
}
__device__ __forceinline__ float sigmoidf_(float x) { return 1.f / (1.f + expf(-x)); }
__device__ __forceinline__ float gelu_tanh(float x) {
    const float c = 0.7978845608028654f;
    return 0.5f * x * (1.f + tanhf(c * (x + 0.044715f * x * x * x)));
}

typedef short bf16x8 __attribute__((ext_vector_type(8)));
typedef float f32x4 __attribute__((ext_vector_type(4)));
typedef unsigned short bf16_t;

typedef __bf16 bf16x2_t __attribute__((ext_vector_type(2)));
__device__ __forceinline__ unsigned pack2bf(float lo, float hi) {
    bf16x2_t v; v[0] = (__bf16)lo; v[1] = (__bf16)hi;
    return __builtin_bit_cast(unsigned, v);
}
__device__ __forceinline__ unsigned f2bf(float f) { return pack2bf(f, 0.f) & 0xffffu; }
__device__ __forceinline__ float bf2f(unsigned h) { return __uint_as_float(h << 16); }

__device__ __forceinline__ void cvt_rows_bf16(const float* __restrict__ src, bf16_t* __restrict__ dst, size_t n8) {
    for (size_t i = (size_t)blockIdx.x * 256 + threadIdx.x; i < n8; i += (size_t)gridDim.x * 256) {
        const float4 a = ((const float4*)src)[2 * i], b = ((const float4*)src)[2 * i + 1];
        uint4 o;
        o.x = pack2bf(a.x, a.y); o.y = pack2bf(a.z, a.w); o.z = pack2bf(b.x, b.y); o.w = pack2bf(b.z, b.w);
        ((uint4*)dst)[i] = o;
    }
}
__device__ __forceinline__ void transpose_bf16(const float* __restrict__ src, int Nsrc, int Npad, bf16_t* __restrict__ dst, int K = 1024) {
    const size_t total = (size_t)Npad * (K / 8);
    for (size_t i = (size_t)blockIdx.x * 256 + threadIdx.x; i < total; i += (size_t)gridDim.x * 256) {
        const int n = (int)(i % Npad), kg = (int)(i / Npad);
        float v[8];
#pragma unroll
        for (int j = 0; j < 8; ++j) v[j] = (n < Nsrc) ? src[(size_t)(kg * 8 + j) * Nsrc + n] : 0.f;
        uint4 o;
        o.x = pack2bf(v[0], v[1]); o.y = pack2bf(v[2], v[3]); o.z = pack2bf(v[4], v[5]); o.w = pack2bf(v[6], v[7]);
        *(uint4*)(dst + (size_t)n * K + kg * 8) = o;
    }
}

struct ALoadStd {
    const bf16_t* A; int lda;
    __device__ __forceinline__ const bf16_t* ptr(int row, int ks) const { return A + (size_t)row * lda + ks * 64; }
};
struct ALoadCmp {
    const bf16_t* KC;
    __device__ __forceinline__ const bf16_t* ptr(int row, int ks) const {
        const int r = row < 4088 ? row : 4087;
        const int g = r & 1, bn = r >> 1, n = bn % NCB, b = bn / NCB;
        return KC + ((size_t)(b * SEQ + 16 * n + ks) * 128 + g * 64);
    }
};
#define GLDS1(i, ks, buf) { const int row_ = 8 * w + 32 * (i) + (lane >> 3);                                                    \
        __builtin_amdgcn_global_load_lds((const unsigned*)(aload.ptr(m0 + row_, (ks)) + (((lane & 7) ^ (lane >> 3)) << 3)),      \
                                         (LAS3 unsigned*)(lds + (buf) * 32768 + w * 1024 + (i) * 4096), 16, 0, 0);              \
        __builtin_amdgcn_global_load_lds((const unsigned*)(Bp + (size_t)row_ * ldb + (ks) * 64 + (((lane & 7) ^ (lane >> 3)) << 3)), \
                                         (LAS3 unsigned*)(lds + (buf) * 32768 + 16384 + w * 1024 + (i) * 4096), 16, 0, 0); }
#define GEMM_GLDS(ks, buf) { GLDS1(0, ks, buf) GLDS1(1, ks, buf) GLDS1(2, ks, buf) GLDS1(3, ks, buf) }
template <class ALoad, class Epi>
__device__ __forceinline__ void gemm_tile(const ALoad aload, const bf16_t* __restrict__ Bt, int ldb, int KS, int m0, int n0,
                                          unsigned char* lds, Epi epi) {
    const int tid = opaque_tid(), lane = tid & 63, w = __builtin_amdgcn_readfirstlane(tid >> 6), wm = w >> 1, wn = w & 1;
    f32x4 acc[4][4];
#pragma unroll
    for (int j = 0; j < 4; ++j)
#pragma unroll
        for (int i = 0; i < 4; ++i) acc[j][i] = (f32x4){0.f, 0.f, 0.f, 0.f};
    const bf16_t* Bp = Bt + (size_t)n0 * ldb;
    __syncthreads();
    GEMM_GLDS(0, 0)
    asm volatile("s_waitcnt vmcnt(0)" ::: "memory");
    __syncthreads();
    for (int ks = 0; ks < KS; ++ks) {
        if (ks + 1 < KS) GEMM_GLDS(ks + 1, (ks + 1) & 1)
        const unsigned char* la = lds + (ks & 1) * 32768;
        const unsigned char* lb = la + 16384;
#pragma unroll
        for (int s = 0; s < 2; ++s) {
            bf16x8 af[4], wf[4];
            const int ch = s * 4 + (lane >> 4);
#pragma unroll
            for (int i = 0; i < 4; ++i) {
                const int row = wm * 64 + i * 16 + (lane & 15);
                af[i] = *(const bf16x8*)(la + row * 128 + ((ch ^ (row & 7)) << 4));
            }
#pragma unroll
            for (int j = 0; j < 4; ++j) {
                const int row = wn * 64 + j * 16 + (lane & 15);
                wf[j] = *(const bf16x8*)(lb + row * 128 + ((ch ^ (row & 7)) << 4));
            }
#pragma unroll
            for (int j = 0; j < 4; ++j)
#pragma unroll
                for (int i = 0; i < 4; ++i)
                    acc[j][i] = __builtin_amdgcn_mfma_f32_16x16x32_bf16(wf[j], af[i], acc[j][i], 0, 0, 0);
        }
        asm volatile("s_waitcnt vmcnt(0)" ::: "memory");
        __syncthreads();
    }
#pragma unroll
    for (int j = 0; j < 4; ++j)
#pragma unroll
        for (int i = 0; i < 4; ++i)
            epi(m0 + wm * 64 + i * 16 + (lane & 15), n0 + wn * 64 + j * 16 + (lane >> 4) * 4, acc[j][i]);
    epi.finish(m0, n0);
}
template <class Epi>
__device__ __forceinline__ void gemm_bf16_phase(const bf16_t* __restrict__ A, int lda, const bf16_t* __restrict__ Bt, int ldb,
                                                int Mtiles, int Ntiles, unsigned char* lds, Epi epi) {
    for (int tile = blockIdx.x; tile < Mtiles * Ntiles; tile += gridDim.x) {
        const int mt = tile / Ntiles, nt = tile % Ntiles;
        gemm_tile(ALoadStd{A, lda}, Bt, ldb, 16, mt * 128, nt * 128, lds, epi);
    }
}

struct EpiF32 {
    float* C; int ldc; int Nc;
    __device__ __forceinline__ void operator()(int m, int n, f32x4 v) const {
        if (n < Nc) *(float4*)(C + (size_t)m * ldc + n) = make_float4(v[0], v[1], v[2], v[3]);
    }
    __device__ __forceinline__ void finish(int, int) const {}
};

struct EpiProj {
    unsigned char* ws;
    __device__ __forceinline__ void operator()(int m, int n, f32x4 v) const {
        const int ct = n >> 7;
        if (ct < 4) {
            uint2 o; o.x = pack2bf(v[0], v[1]); o.y = pack2bf(v[2], v[3]);
            *(uint2*)((bf16_t*)(ws + OFF_HQ) + (size_t)m * 512 + n) = o;
        } else if (ct < 8) {
            const int c = n - 512;
            const float4 lb = *(const float4*)((const float*)(ws + OFF_LBV) + c);
            float4 o;
            o.x = logf(lb.x + (1.f - lb.x) * sigmoidf_(v[0])); o.y = logf(lb.y + (1.f - lb.y) * sigmoidf_(v[1]));
            o.z = logf(lb.z + (1.f - lb.z) * sigmoidf_(v[2])); o.w = logf(lb.w + (1.f - lb.w) * sigmoidf_(v[3]));
            *(float4*)((float*)(ws + OFF_HLF) + (size_t)m * 512 + c) = o;
        } else if (ct < 12) {
            uint2 o; o.x = pack2bf(v[0], v[1]); o.y = pack2bf(v[2], v[3]);
            *(uint2*)((bf16_t*)(ws + OFF_HI) + (size_t)m * 512 + (n - 1024)) = o;
        } else if (ct < 16) {
            uint2 o; o.x = pack2bf(v[0], v[1]); o.y = pack2bf(v[2], v[3]);
            *(uint2*)((bf16_t*)(ws + OFF_HG) + (size_t)m * 512 + (n - 1536)) = o;
        } else if (ct < 20) {
            const float qs_ = 0.125f * 1.4426950408889634f;
            uint2 o; o.x = pack2bf(qs_ * v[0], qs_ * v[1]); o.y = pack2bf(qs_ * v[2], qs_ * v[3]);
            *(uint2*)((bf16_t*)(ws + OFF_NQ) + (size_t)m * 512 + (n - 2048)) = o;
        } else if (ct < 26) {
            uint2 o; o.x = pack2bf(v[0], v[1]); o.y = pack2bf(v[2], v[3]);
            *(uint2*)((bf16_t*)(ws + OFF_KV + (size_t)(ct - 20) * KV_STRIDE) + (size_t)m * 128 + (n & 127)) = o;
        } else {
            const int c = n - 3328;
            if (c < 24)
                *(float4*)((float*)(ws + OFF_NGATE) + (size_t)m * 24 + c) =
                    make_float4(sigmoidf_(v[0]), sigmoidf_(v[1]), sigmoidf_(v[2]), sigmoidf_(v[3]));
        }
    }
    __device__ __forceinline__ void finish(int, int) const {}
};
struct EpiY {
    const float* x; float* y;
    __device__ __forceinline__ void operator()(int m, int n, f32x4 v) const {
        const float4 xv = *(const float4*)(x + (size_t)m * DM + n);
        *(float4*)(y + (size_t)m * DM + n) = make_float4(ALPHA * xv.x + v[0], ALPHA * xv.y + v[1], ALPHA * xv.z + v[2], ALPHA * xv.w + v[3]);
    }
    __device__ __forceinline__ void finish(int, int) const {}
};

__device__ __forceinline__ uint4 pack8bf(const float* v) {
    uint4 o;
    o.x = pack2bf(v[0], v[1]); o.y = pack2bf(v[2], v[3]); o.z = pack2bf(v[4], v[5]); o.w = pack2bf(v[6], v[7]);
    return o;
}

__device__ __forceinline__ void hgrn_passA(const Params& p, int chunk, unsigned char* smem) {
    const int c = chunk & 127, bh = chunk >> 7, h = bh & 3, b = bh >> 2;
    const int tid = opaque_tid(), d = tid & 127, hf = __builtin_amdgcn_readfirstlane(tid >> 7), lane = tid & 63, w = __builtin_amdgcn_readfirstlane(tid >> 6);
    const size_t tok0 = (size_t)b * SEQ + (size_t)c * 64 + 32 * hf;
    const float* HLF = (const float*)(p.ws + OFF_HLF);
    const bf16_t* HI = (const bf16_t*)(p.ws + OFF_HI);
    unsigned char* KT = smem;
    unsigned char* VT = smem + 16384;
    float* xch = (float*)(smem + 32768);
    const float* lfp = HLF + tok0 * 512 + h * 128 + d;
    const bf16_t* vp = HI + tok0 * 512 + h * 128 + d;
    float run = 0.f;
#pragma unroll 8
    for (int s = 0; s < 32; ++s) run += lfp[s * 512];
    __syncthreads();
    xch[hf * 128 + d] = run;
    __syncthreads();
    const float tot0 = xch[d], tot1 = xch[128 + d];
    const float blast = tot0 + tot1;
    run = hf ? tot0 : 0.f;
#pragma unroll 1
    for (int q = 0; q < 4; ++q) {
        float kv[8], vv[8];
#pragma unroll
        for (int j = 0; j < 8; ++j) {
            const int s = q * 8 + j;
            const float lf = lfp[s * 512];
            run += lf;
            kv[j] = (1.f - expf(lf)) * expf(blast - run);
            vv[j] = bf2f(vp[s * 512]);
        }
        const int ch = 4 * hf + q;
        *(uint4*)(KT + d * 128 + ((ch ^ (d & 7)) << 4)) = pack8bf(kv);
        *(uint4*)(VT + d * 128 + ((ch ^ (d & 7)) << 4)) = pack8bf(vv);
    }
    if (hf) ((float*)(p.ws + OFF_DC))[(size_t)chunk * 128 + d] = expf(blast);
    __syncthreads();
    f32x4 acc[2][8];
#pragma unroll
    for (int i = 0; i < 2; ++i)
#pragma unroll
        for (int et = 0; et < 8; ++et) acc[i][et] = (f32x4){0.f, 0.f, 0.f, 0.f};
#pragma unroll
    for (int st = 0; st < 2; ++st) {
        const int ch = st * 4 + (lane >> 4);
        bf16x8 af[2];
#pragma unroll
        for (int i = 0; i < 2; ++i) {
            const int row = (2 * w + i) * 16 + (lane & 15);
            af[i] = *(const bf16x8*)(KT + row * 128 + ((ch ^ (row & 7)) << 4));
        }
#pragma unroll
        for (int et = 0; et < 8; ++et) {
            const int row = et * 16 + (lane & 15);
            const bf16x8 bfv = *(const bf16x8*)(VT + row * 128 + ((ch ^ (row & 7)) << 4));
            acc[0][et] = __builtin_amdgcn_mfma_f32_16x16x32_bf16(af[0], bfv, acc[0][et], 0, 0, 0);
            acc[1][et] = __builtin_amdgcn_mfma_f32_16x16x32_bf16(af[1], bfv, acc[1][et], 0, 0, 0);
        }
    }
    float* HC = p.out + (size_t)chunk * 16384;
#pragma unroll
    for (int i = 0; i < 2; ++i)
#pragma unroll
        for (int et = 0; et < 8; ++et) {
            const int e = et * 16 + (lane & 15), d0 = (2 * w + i) * 16 + (lane >> 4) * 4;
            *(float4*)(HC + e * 128 + d0) = make_float4(acc[i][et][0], acc[i][et][1], acc[i][et][2], acc[i][et][3]);
        }
}

__device__ __forceinline__ void hgrn_scan_item(const Params& p, int item) {
    const int gid = item * 256 + threadIdx.x;
    const int d4 = gid & 31, e = (gid >> 5) & 127, bh = gid >> 12;
    const float* HC = p.out;
    const float* DC = (const float*)(p.ws + OFF_DC);
    bf16_t* SC = (bf16_t*)(p.ws + OFF_SC);
    float4 S = make_float4(0.f, 0.f, 0.f, 0.f);
#pragma unroll 4
    for (int c = 0; c < 128; ++c) {
        const size_t base = ((size_t)(bh * 128 + c) * 128 + e) * 128 + d4 * 4;
        const float4 H = *(const float4*)(HC + base);
        const float4 dc = *(const float4*)(DC + (size_t)(bh * 128 + c) * 128 + d4 * 4);
        uint2 o; o.x = pack2bf(S.x, S.y); o.y = pack2bf(S.z, S.w);
        *(uint2*)(SC + base) = o;
        S.x = dc.x * S.x + H.x; S.y = dc.y * S.y + H.y; S.z = dc.z * S.z + H.z; S.w = dc.w * S.w + H.w;
    }
}

__device__ __forceinline__ void hgrn_passC(const Params& p, int chunk, unsigned char* smem) {
    const int c = chunk & 127, bh = chunk >> 7, h = bh & 3, b = bh >> 2;
    const int tid = opaque_tid(), d = tid & 127, hf = __builtin_amdgcn_readfirstlane(tid >> 7), lane = tid & 63, w = __builtin_amdgcn_readfirstlane(tid >> 6);
    const size_t tokc = (size_t)b * SEQ + (size_t)c * 64;
    const size_t tok0 = tokc + 32 * hf;
    const float* HLF = (const float*)(p.ws + OFF_HLF);
    const bf16_t* HQ = (const bf16_t*)(p.ws + OFF_HQ);
    const bf16_t* HI = (const bf16_t*)(p.ws + OFF_HI);
    const bf16_t* HG = (const bf16_t*)(p.ws + OFF_HG);
    unsigned char* R0 = smem;
    unsigned char* R1 = smem + 16384;
    unsigned char* R2 = smem + 57344;
    float* xch = (float*)R2;
    const float* lfp = HLF + tok0 * 512 + h * 128 + d;
    const bf16_t* qp = HQ + tok0 * 512 + h * 128 + d;
    float run = 0.f, b15 = 0.f;
#pragma unroll 8
    for (int s = 0; s < 32; ++s) { run += lfp[s * 512]; if (s == 15) b15 = run; }
    __syncthreads();
    xch[hf * 128 + d] = run;
    if (hf == 0) xch[256 + d] = b15;
    __syncthreads();
    const float tot0 = xch[d];
    const float off = hf ? tot0 : 0.f;
    const float r1 = xch[256 + d], r2 = tot0;
    if (hf) xch[384 + d] = off + b15;
    run = off;
#pragma unroll 8
    for (int s = 0; s < 32; ++s) {
        const int t = 32 * hf + s;
        run += lfp[s * 512];
        const float qv = bf2f(qp[s * 512]);
        *(bf16_t*)(R0 + t * 256 + ((((d >> 3) ^ (t & 15))) << 4) + (d & 7) * 2) = (bf16_t)f2bf(qv * expf(run));
    }
    {
        const bf16_t* SCp = (const bf16_t*)(p.ws + OFF_SC) + (size_t)chunk * 16384;
#pragma unroll
        for (int i = 0; i < 8; ++i) {
            const int cc = tid + 256 * i, row = cc >> 4, ch = cc & 15;
            *(uint4*)(R1 + row * 256 + ((ch ^ (row & 15)) << 4)) = *(const uint4*)(SCp + row * 128 + ch * 8);
        }
    }
    __syncthreads();
    f32x4 acc[8];
#pragma unroll
    for (int et = 0; et < 8; ++et) acc[et] = (f32x4){0.f, 0.f, 0.f, 0.f};
#pragma unroll
    for (int ds = 0; ds < 4; ++ds) {
        const int ch = ds * 4 + (lane >> 4);
        const int trow = w * 16 + (lane & 15);
        const bf16x8 bq = *(const bf16x8*)(R0 + trow * 256 + ((ch ^ (trow & 15)) << 4));
#pragma unroll
        for (int et = 0; et < 8; ++et) {
            const int row = et * 16 + (lane & 15);
            const bf16x8 av = *(const bf16x8*)(R1 + row * 256 + ((ch ^ (row & 15)) << 4));
            acc[et] = __builtin_amdgcn_mfma_f32_16x16x32_bf16(av, bq, acc[et], 0, 0, 0);
        }
    }
    __syncthreads();
    {
        const float r3 = xch[384 + d];
        run = off;
#pragma unroll 2
        for (int s = 0; s < 32; ++s) {
            const int t = 32 * hf + s;
            const int it = t >> 4;
            const float rr = (it == 0) ? 0.f : (it == 1) ? r1 : (it == 2) ? r2 : r3;
            const int sw = (((d >> 3) ^ (t & 15)) << 4) + (d & 7) * 2;
            const float lf = lfp[s * 512];
            run += lf;
            const float qv = bf2f(qp[s * 512]);
            const float kv = 1.f - expf(lf);
            *(bf16_t*)(R0 + t * 256 + sw) = (bf16_t)f2bf(qv * expf(run - rr));
#pragma unroll
            for (int i = 0; i < 4; ++i) {
                if (i >= it) {
                    const float ri = (i == 0) ? 0.f : (i == 1) ? r1 : (i == 2) ? r2 : r3;
                    const int R = 8 * i * (i + 1) + t;
                    *(bf16_t*)(R1 + R * 256 + sw) = (bf16_t)f2bf(kv * expf(ri - run));
                }
            }
        }
    }
    __syncthreads();
#pragma unroll
    for (int j = 0; j < 4; ++j) {
        uint2 o = make_uint2(0u, 0u);
        if (j <= w) {
            f32x4 pa = (f32x4){0.f, 0.f, 0.f, 0.f};
#pragma unroll
            for (int ds = 0; ds < 4; ++ds) {
                const int ch = ds * 4 + (lane >> 4);
                const int krow = 8 * w * (w + 1) + 16 * j + (lane & 15);
                const int trow = w * 16 + (lane & 15);
                const bf16x8 av = *(const bf16x8*)(R1 + krow * 256 + ((ch ^ (krow & 15)) << 4));
                const bf16x8 bq = *(const bf16x8*)(R0 + trow * 256 + ((ch ^ (trow & 15)) << 4));
                pa = __builtin_amdgcn_mfma_f32_16x16x32_bf16(av, bq, pa, 0, 0, 0);
            }
            if (j == w) {
                const int tl = lane & 15, sl = (lane >> 4) * 4;
#pragma unroll
                for (int r = 0; r < 4; ++r) if (sl + r > tl) pa[r] = 0.f;
            }
            o.x = pack2bf(pa[0], pa[1]); o.y = pack2bf(pa[2], pa[3]);
        }
        const int t = w * 16 + (lane & 15);
        const int ch = 2 * j + (lane >> 5);
        *(uint2*)(R2 + t * 128 + ((ch ^ (t & 7)) << 4) + ((lane >> 4) & 1) * 8) = o;
    }
    __syncthreads();
#pragma unroll
    for (int q = 0; q < 4; ++q) {
        float vv[8];
#pragma unroll
        for (int j = 0; j < 8; ++j) vv[j] = bf2f(HI[(tok0 + q * 8 + j) * 512 + h * 128 + d]);
        const int ch = 4 * hf + q;
        *(uint4*)(R1 + d * 128 + ((ch ^ (d & 7)) << 4)) = pack8bf(vv);
    }
    __syncthreads();
#pragma unroll
    for (int st = 0; st < 2; ++st) {
        const int ch = st * 4 + (lane >> 4);
        const int trow = w * 16 + (lane & 15);
        const bf16x8 bp = *(const bf16x8*)(R2 + trow * 128 + ((ch ^ (trow & 7)) << 4));
#pragma unroll
        for (int et = 0; et < 8; ++et) {
            const int row = et * 16 + (lane & 15);
            const bf16x8 av = *(const bf16x8*)(R1 + row * 128 + ((ch ^ (row & 7)) << 4));
            acc[et] = __builtin_amdgcn_mfma_f32_16x16x32_bf16(av, bp, acc[et], 0, 0, 0);
        }
    }
    {
        float ss = 0.f;
#pragma unroll
        for (int et = 0; et < 8; ++et)
#pragma unroll
            for (int r = 0; r < 4; ++r) ss += acc[et][r] * acc[et][r];
        ss += __shfl_xor(ss, 16);
        ss += __shfl_xor(ss, 32);
        const float rs = rsqrtf(ss * (1.f / 128.f) + LN_EPS);
        const size_t tok = tokc + w * 16 + (lane & 15);
        const float* ng = p.in[4];
        bf16_t* MIX = (bf16_t*)(p.ws + OFF_XB);
#pragma unroll
        for (int et = 0; et < 8; ++et) {
            const int e0 = et * 16 + (lane >> 4) * 4;
            const uint2 gb = *(const uint2*)(HG + tok * 512 + h * 128 + e0);
            const float4 n4 = *(const float4*)(ng + e0);
            const float g0 = bf2f(gb.x & 0xffffu), g1 = bf2f(gb.x >> 16), g2 = bf2f(gb.y & 0xffffu), g3 = bf2f(gb.y >> 16);
            uint2 o;
            o.x = pack2bf(acc[et][0] * rs * n4.x * (g0 * sigmoidf_(g0)), acc[et][1] * rs * n4.y * (g1 * sigmoidf_(g1)));
            o.y = pack2bf(acc[et][2] * rs * n4.z * (g2 * sigmoidf_(g2)), acc[et][3] * rs * n4.w * (g3 * sigmoidf_(g3)));
            *(uint2*)(MIX + tok * DM + h * 128 + e0) = o;
        }
    }
}

__device__ __forceinline__ void compress_item(const Params& p, int item, float* sm) {
    const int g = item & 1;
    int r = item >> 1;
    const int n = r % NCB; r /= NCB;
    const int b = r & 3, which = r >> 2;
    const int tid = opaque_tid();
    const bf16_t* kvsrc = (const bf16_t*)(p.ws + OFF_KV + (size_t)which * KV_STRIDE);
    const float* pe = p.in[which ? 10 : 5];
    const float* w1 = p.in[which ? 11 : 6];
    const float* b1 = p.in[which ? 12 : 7];
    const float* w2 = p.in[which ? 13 : 8];
    const float* b2 = p.in[which ? 14 : 9];
    float* outp = (float*)(p.ws + (which ? OFF_CMPV : OFF_CMPK));
    float* blk = sm;
    float* hh = sm + 2048;
    __syncthreads();
    for (int i = tid; i < 2048; i += 256) {
        const int l = i >> 6, d = i & 63;
        blk[i] = bf2f(kvsrc[(size_t)(b * SEQ + 16 * n + l) * 128 + g * 64 + d]) + pe[i];
    }
    __syncthreads();
    float acc = b1[tid];
    for (int i = 0; i < 2048; ++i) acc += blk[i] * w1[(size_t)i * 256 + tid];
    hh[tid] = gelu_tanh(acc);
    __syncthreads();
    if (tid < 64) {
        float o = b2[tid];
        for (int j = 0; j < 256; ++j) o += hh[j] * w2[j * 64 + tid];
        outp[((size_t)(b * NCB + n) * 2 + g) * 64 + tid] = o;
    }
}

__device__ __forceinline__ float dot64_bf(const float* qs, const bf16_t* krow) {
    float s = 0.f;
#pragma unroll
    for (int i = 0; i < 8; ++i) {
        const uint4 kv = ((const uint4*)krow)[i];
        const float4 q0 = ((const float4*)qs)[2 * i], q1 = ((const float4*)qs)[2 * i + 1];
        s += __uint_as_float(kv.x << 16) * q0.x + __uint_as_float(kv.x & 0xffff0000u) * q0.y
           + __uint_as_float(kv.y << 16) * q0.z + __uint_as_float(kv.y & 0xffff0000u) * q0.w
           + __uint_as_float(kv.z << 16) * q1.x + __uint_as_float(kv.z & 0xffff0000u) * q1.y
           + __uint_as_float(kv.w << 16) * q1.z + __uint_as_float(kv.w & 0xffff0000u) * q1.w;
    }
    return s;
}
__device__ __forceinline__ float dot64(const float* qs, const float* krow) {
    float s = 0.f;
#pragma unroll
    for (int i = 0; i < 16; ++i) {
        const float4 kv = ((const float4*)krow)[i];
        const float4 qv = ((const float4*)qs)[i];
        s += kv.x * qv.x + kv.y * qv.y + kv.z * qv.z + kv.w * qv.w;
    }
    return s;
}

__device__ __forceinline__ void nsa_item(const Params& p, int item, float* sm) {
    const int t = item & (SEQ - 1), g = (item >> 13) & 1, b = item >> 14;
    const int tid = threadIdx.x, lane = tid & 63, r = tid >> 6;
    float* sc = sm + r * 1024;
    float* qs = sm + 4096 + r * 64;
    float* impv = sm + 4096 + 256;
    int* sel = (int*)(sm + 4096 + 256 + 128);
    const bf16_t* KSb = (const bf16_t*)(p.ws + OFF_KV + 2 * KV_STRIDE);
    const bf16_t* VSb = (const bf16_t*)(p.ws + OFF_KV + 3 * KV_STRIDE);
    const bf16_t* KWb = (const bf16_t*)(p.ws + OFF_KV + 4 * KV_STRIDE);
    const bf16_t* VWb = (const bf16_t*)(p.ws + OFF_KV + 5 * KV_STRIDE);
    const float* cmpk = (const float*)(p.ws + OFF_CMPK);
    const float* cmpv = (const float*)(p.ws + OFF_CMPV);
    const size_t n = (size_t)b * SEQ + t;
    const float NEGV = -1e30f;
    __syncthreads();
    qs[lane] = bf2f(((const bf16_t*)(p.ws + OFF_NQ))[n * 512 + g * 256 + r * 64 + lane]) * 0.6931471805599453f;
    __syncthreads();

    const int nvalid = (t >= 31) ? (((t - 31) >> 4) + 1) : 0;
    float m = NEGV;
    for (int n0 = 0; n0 < nvalid; n0 += 64) {
        const int nn = n0 + lane;
        if (nn < nvalid) {
            const float s = dot64(qs, cmpk + ((size_t)(b * NCB + nn) * 2 + g) * 64);
            sc[nn] = s;
            m = fmaxf(m, s);
        }
    }
    m = wave_max(m);
    float sum = 0.f;
    for (int n0 = 0; n0 < nvalid; n0 += 64) {
        const int nn = n0 + lane;
        if (nn < nvalid) { const float e = expf(sc[nn] - m); sc[nn] = e; sum += e; }
    }
    sum = wave_sum(sum);
    {
        const float inv = 1.f / fmaxf(sum, 1e-30f);
        for (int n0 = 0; n0 < nvalid; n0 += 64) {
            const int nn = n0 + lane;
            if (nn < nvalid) sc[nn] *= inv;
        }
    }
    __syncthreads();
    float oc = 0.f;
    for (int nn = 0; nn < nvalid; ++nn) oc += sc[nn] * cmpv[((size_t)(b * NCB + nn) * 2 + g) * 64 + lane];

    const int cur = t >> 6;
    if (tid < 128) {
        const int j = tid;
        float im = 0.f;
#pragma unroll
        for (int rr = 0; rr < 4; ++rr) {
            const float* P = sm + rr * 1024;
            const int n4 = 4 * j;
            float a = 0.f;
            if (n4 < nvalid) a += P[n4];
            if (n4 + 1 < nvalid) a += P[n4 + 1];
            if (n4 + 2 < nvalid) a += P[n4 + 2];
            if (n4 + 3 < nvalid) a += 0.5f * P[n4 + 3];
            if (n4 - 1 >= 0 && n4 - 1 < nvalid) a += 0.5f * P[n4 - 1];
            im += a;
        }
        const bool forced = (j == 0) || (j == cur) || (j == cur - 1);
        const bool causal = (j <= cur);
        impv[j] = forced ? 1.0e4f : (causal ? im : -1.f);
    }
    __syncthreads();
    if (r == 0) {
        float v0 = impv[lane], v1 = impv[lane + 64];
        for (int k = 0; k < 16; ++k) {
            const float mx = wave_max(fmaxf(v0, v1));
            const unsigned long long b0 = __ballot(v0 == mx);
            int idx;
            if (b0) {
                const int l = __ffsll((unsigned long long)b0) - 1;
                idx = l;
                if (lane == l) v0 = -3.0e38f;
            } else {
                const unsigned long long b1 = __ballot(v1 == mx);
                const int l = __ffsll((unsigned long long)b1) - 1;
                idx = 64 + l;
                if (lane == l) v1 = -3.0e38f;
            }
            if (lane == 0) sel[k] = idx;
        }
    }
    __syncthreads();

    m = NEGV;
    for (int si = 0; si < 16; ++si) {
        const int blk = sel[si];
        const int key = blk * 64 + lane;
        float s = NEGV;
        if (blk * 64 <= t) {
            if (key <= t) s = dot64_bf(qs, KSb + ((size_t)b * SEQ + key) * 128 + g * 64);
        }
        sc[si * 64 + lane] = s;
        m = fmaxf(m, s);
    }
    m = wave_max(m);
    sum = 0.f;
    for (int si = 0; si < 16; ++si) {
        const int key = sel[si] * 64 + lane;
        const float e = (key <= t) ? expf(sc[si * 64 + lane] - m) : 0.f;
        sc[si * 64 + lane] = e;
        sum += e;
    }
    sum = wave_sum(sum);
    {
        const float inv = 1.f / fmaxf(sum, 1e-30f);
        for (int si = 0; si < 16; ++si) sc[si * 64 + lane] *= inv;
    }
    __syncthreads();
    float os = 0.f;
    for (int si = 0; si < 16; ++si) {
        const int blk = sel[si];
        if (blk * 64 > t) continue;
        for (int kk = 0; kk < 64; ++kk) {
            const int key = blk * 64 + kk;
            if (key > t) break;
            os += sc[si * 64 + kk] * bf2f(VSb[((size_t)b * SEQ + key) * 128 + g * 64 + lane]);
        }
    }
    __syncthreads();

    const int lo = t - 511;
    m = NEGV;
    for (int i = 0; i < 8; ++i) {
        const int key = lo + i * 64 + lane;
        float s = NEGV;
        if (key >= 0) s = dot64_bf(qs, KWb + ((size_t)b * SEQ + key) * 128 + g * 64);
        sc[i * 64 + lane] = s;
        m = fmaxf(m, s);
    }
    m = wave_max(m);
    sum = 0.f;
    for (int i = 0; i < 8; ++i) {
        const int key = lo + i * 64 + lane;
        const float e = (key >= 0) ? expf(sc[i * 64 + lane] - m) : 0.f;
        sc[i * 64 + lane] = e;
        sum += e;
    }
    sum = wave_sum(sum);
    {
        const float inv = 1.f / fmaxf(sum, 1e-30f);
        for (int i = 0; i < 8; ++i) sc[i * 64 + lane] *= inv;
    }
    __syncthreads();
    float ow = 0.f;
    for (int idx = 0; idx < 512; ++idx) {
        const int key = lo + idx;
        if (key < 0) continue;
        ow += sc[idx] * bf2f(VWb[((size_t)b * SEQ + key) * 128 + g * 64 + lane]);
    }
    const float* grow = (const float*)(p.ws + OFF_NGATE) + n * 24 + g * 12 + r * 3;
    const float gc = grow[0], gs = grow[1], gw = grow[2];
#if NSA_DIAG
    {
        const float ref = gc * oc + gs * os + gw * ow;
        const float got = bf2f(((const bf16_t*)(p.ws + OFF_XB))[n * DM + 512 + g * 256 + r * 64 + lane]);
        const unsigned* SELM = (const unsigned*)(p.ws + OFF_SELM) + ((size_t)(b * 2 + g) * SEQ + t) * 4;
        unsigned gm[4] = {0u, 0u, 0u, 0u};
        for (int si = 0; si < 16; ++si) { const int blk = sel[si]; if (blk * 64 <= t) gm[blk >> 5] |= 1u << (blk & 31); }
        bool same = true;
        for (int qd = 0; qd < 4; ++qd) {
            unsigned mm = SELM[qd];
            for (int bit = 0; bit < 32; ++bit) if ((qd * 32 + bit) * 64 > t) mm &= ~(1u << bit);
            if (mm != gm[qd]) same = false;
        }
        float d2 = same ? (got - ref) * (got - ref) : 0.f, r2 = same ? ref * ref : 0.f;
        d2 = wave_sum(d2); r2 = wave_sum(r2);
        float* DG = (float*)(p.ws + OFF_DIAG);
        if (lane == 0) { atomicAdd(&DG[0], d2); atomicAdd(&DG[1], r2); if (r == 0) { atomicAdd(&DG[2], same ? 0.f : 1.f); atomicAdd(&DG[3], 1.f); } }
    }
#else
    ((bf16_t*)(p.ws + OFF_XB))[n * DM + 512 + g * 256 + r * 64 + lane] = (bf16_t)f2bf(gc * oc + gs * os + gw * ow);
#endif
}


struct EpiCmpH {
    bf16_t* HB; const float* peb;
    __device__ __forceinline__ void operator()(int m, int n, f32x4 v) const {
        const float4 pb = *(const float4*)(peb + n);
        uint2 o;
        o.x = pack2bf(gelu_tanh(v[0] + pb.x), gelu_tanh(v[1] + pb.y));
        o.y = pack2bf(gelu_tanh(v[2] + pb.z), gelu_tanh(v[3] + pb.w));
        *(uint2*)(HB + (size_t)m * 256 + n) = o;
    }
    __device__ __forceinline__ void finish(int, int) const {}
};
__device__ __forceinline__ void cmp_peb(const Params& p, int which) {
    const float* pe = p.in[which ? 10 : 5];
    const float* w1 = p.in[which ? 11 : 6];
    const float* b1 = p.in[which ? 12 : 7];
    const int j = threadIdx.x;
    float acc = b1[j];
    for (int i = 0; i < 2048; ++i) acc += pe[i] * w1[(size_t)i * 256 + j];
    ((float*)(p.ws + OFF_PEB))[which * 256 + j] = acc;
}
__device__ __forceinline__ void cmp_layer2_phase(const Params& p, int first_block, int nblocks) {
    const int tid_ = opaque_tid(), lane = tid_ & 63, w = __builtin_amdgcn_readfirstlane(tid_ >> 6);
    for (int it = (blockIdx.x - first_block) * 4 + w; it < 2 * 4088; it += nblocks * 4) {
        const int which = it >= 4088, row = which ? it - 4088 : it;
        const float* w2 = p.in[which ? 13 : 8];
        const float* b2 = p.in[which ? 14 : 9];
        const bf16_t* hrow = (const bf16_t*)(p.ws + OFF_HB) + ((size_t)which * 4096 + row) * 256;
        float o = b2[lane];
#pragma unroll 8
        for (int j = 0; j < 256; ++j) o += bf2f(hrow[j]) * w2[j * 64 + lane];
        const int g = row & 1, bn = row >> 1, n = bn % NCB, b = bn / NCB;
        ((bf16_t*)(p.ws + (which ? OFF_CMPVB : OFF_CMPKB)))[((size_t)(b * 2 + g) * 512 + n) * 64 + lane] = (bf16_t)f2bf(o);
    }
}

struct StageOfs { int k, v; };
__device__ __forceinline__ StageOfs make_stage_ofs() {
    const int c0 = opaque_tid(), key = c0 >> 3, ch = c0 & 7;
    StageOfs s;
    s.k = key * 128 + ((ch ^ (key & 7)) << 4);
    s.v = key * 128 + (((ch >> 1) ^ ((key >> 1) & 3)) << 5) + (ch & 1) * 16;
    return s;
}
#define NSA_KV_LOAD(kb_) { const bf16_t* kp_ = Kbase + (size_t)(kb_) * 64 * stride + (size_t)(tid >> 3) * stride + (tid & 7) * 8; \
        const bf16_t* vp_ = Vbase + (size_t)(kb_) * 64 * stride + (size_t)(tid >> 3) * stride + (tid & 7) * 8;                 \
        rk0 = *(const uint4*)kp_; rk1 = *(const uint4*)(kp_ + (size_t)32 * stride);                                          \
        rv0 = *(const uint4*)vp_; rv1 = *(const uint4*)(vp_ + (size_t)32 * stride); }
#define NSA_KV_STORE(Kl_, Vl_) { *(uint4*)((Kl_) + sof.k) = rk0; *(uint4*)((Kl_) + sof.k + 4096) = rk1; \
        *(uint4*)((Vl_) + sof.v) = rv0; *(uint4*)((Vl_) + sof.v + 4096) = rv1; }
template <class Compute>
__device__ __forceinline__ void nsa_kv_loop(const bf16_t* __restrict__ Kbase, const bf16_t* __restrict__ Vbase, int stride,
                                            int kb_lo, int kb_hi, unsigned char* smem, const StageOfs& sof, Compute compute) {
    const int tid = opaque_tid();
    uint4 rk0, rk1, rv0, rv1;
    NSA_KV_LOAD(kb_lo)
    __syncthreads();
    NSA_KV_STORE(smem, smem + 16384)
    __syncthreads();
    for (int kb = kb_lo; kb <= kb_hi; ++kb) {
        const int buf = (kb - kb_lo) & 1;
        if (kb < kb_hi) NSA_KV_LOAD(kb + 1)
        compute(kb, smem + buf * 8192, smem + 16384 + buf * 8192);
        if (kb < kb_hi) NSA_KV_STORE(smem + (buf ^ 1) * 8192, smem + 16384 + (buf ^ 1) * 8192)
        __syncthreads();
    }
}
struct LaneOfs { int k0, k1, vb0, vb1, vb2, vb3; };
__device__ __forceinline__ LaneOfs make_lane_ofs(int lane) {
    LaneOfs f;
    const int r15 = lane & 15, lg = lane >> 4, q = r15 >> 2, pp = r15 & 3;
    f.k0 = r15 * 128 + ((lg ^ (r15 & 7)) << 4);
    f.k1 = r15 * 128 + (((4 + lg) ^ (r15 & 7)) << 4);
    const int sw2 = (2 * (lg & 1) + (q >> 1)) & 3;
    const int vrow = (4 * lg + q) * 128 + pp * 8;
    f.vb0 = vrow + ((0 ^ sw2) << 5); f.vb1 = vrow + ((1 ^ sw2) << 5);
    f.vb2 = vrow + ((2 ^ sw2) << 5); f.vb3 = vrow + ((3 ^ sw2) << 5);
    return f;
}
typedef short s16x4 __attribute__((ext_vector_type(4)));
__device__ __forceinline__ uint2 tr_read(const unsigned char* p) {
    const s16x4 v = __builtin_amdgcn_ds_read_tr16_b64_v4i16((LAS3 s16x4*)p);
    return __builtin_bit_cast(uint2, v);
}
#define NEGM (-1.0e37f)
__device__ __forceinline__ void nsa_scores(const unsigned char* Kl, const LaneOfs& f, const bf16x8& q0, const bf16x8& q1, float bias, f32x4 (&s)[4]) {
#pragma unroll
    for (int kt = 0; kt < 4; ++kt) {
        const bf16x8 a0 = *(const bf16x8*)(Kl + f.k0 + kt * 2048);
        const bf16x8 a1 = *(const bf16x8*)(Kl + f.k1 + kt * 2048);
        f32x4 z = (f32x4){bias, bias, bias, bias};
        z = __builtin_amdgcn_mfma_f32_16x16x32_bf16(a0, q0, z, 0, 0, 0);
        s[kt] = __builtin_amdgcn_mfma_f32_16x16x32_bf16(a1, q1, z, 0, 0, 0);
    }
}
template <class VF>
__device__ __forceinline__ void attn_step(const unsigned char* Kl, const unsigned char* Vl, int lane, const LaneOfs& f,
                                          const bf16x8& q0, const bf16x8& q1, f32x4 (&o)[4], float& m, float& l,
                                          float rowbias, bool full, VF valid) {
    f32x4 s[4];
    nsa_scores(Kl, f, q0, q1, rowbias, s);
    if (!full) {
#pragma unroll
        for (int kt = 0; kt < 4; ++kt)
#pragma unroll
            for (int r = 0; r < 4; ++r) s[kt][r] = valid(kt * 16 + 4 * (lane >> 4) + r) ? s[kt][r] : NEGM;
    }
    float mx = fmaxf(fmaxf(fmaxf(s[0][0], s[0][1]), fmaxf(s[0][2], s[0][3])), fmaxf(fmaxf(s[1][0], s[1][1]), fmaxf(s[1][2], s[1][3])));
    mx = fmaxf(mx, fmaxf(fmaxf(fmaxf(s[2][0], s[2][1]), fmaxf(s[2][2], s[2][3])), fmaxf(fmaxf(s[3][0], s[3][1]), fmaxf(s[3][2], s[3][3]))));
    mx = fmaxf(mx, __shfl_xor(mx, 16));
    mx = fmaxf(mx, __shfl_xor(mx, 32));
    if (!__all(mx <= m + 8.f)) {
        const float mn = fmaxf(m, mx);
        const float alpha = __builtin_amdgcn_exp2f(m - mn);
        l *= alpha; m = mn;
#pragma unroll
        for (int dt = 0; dt < 4; ++dt) { o[dt][0] *= alpha; o[dt][1] *= alpha; o[dt][2] *= alpha; o[dt][3] *= alpha; }
    }
    float ps = 0.f;
#pragma unroll
    for (int kt = 0; kt < 4; ++kt)
#pragma unroll
        for (int r = 0; r < 4; ++r) { const float pv = __builtin_amdgcn_exp2f(s[kt][r] - m); s[kt][r] = pv; ps += pv; }
    l += ps;
#pragma unroll
    for (int k2 = 0; k2 < 2; ++k2) {
        uint4 pk;
        pk.x = pack2bf(s[2 * k2][0], s[2 * k2][1]); pk.y = pack2bf(s[2 * k2][2], s[2 * k2][3]);
        pk.z = pack2bf(s[2 * k2 + 1][0], s[2 * k2 + 1][1]); pk.w = pack2bf(s[2 * k2 + 1][2], s[2 * k2 + 1][3]);
        const bf16x8 pb = __builtin_bit_cast(bf16x8, pk);
#define PV1(dt_, vb_) { const uint2 lo_ = tr_read(Vl + (vb_) + k2 * 4096), hi_ = tr_read(Vl + (vb_) + k2 * 4096 + 2048); \
                        uint4 av_; av_.x = lo_.x; av_.y = lo_.y; av_.z = hi_.x; av_.w = hi_.y;                          \
                        o[dt_] = __builtin_amdgcn_mfma_f32_16x16x32_bf16(__builtin_bit_cast(bf16x8, av_), pb, o[dt_], 0, 0, 0); }
        PV1(0, f.vb0) PV1(1, f.vb1) PV1(2, f.vb2) PV1(3, f.vb3)
#undef PV1
    }
}
#define NSA_TILES 4096
__device__ __forceinline__ void nsa_tile(const Params& p, int tile, unsigned char* smem) {
    const int tid = opaque_tid(), lane = tid & 63, w = __builtin_amdgcn_readfirstlane(tid >> 6);
    const int bg = tile & 7, tb = 511 - (tile >> 3);
    const int b = bg >> 1, g = bg & 1;
    const int t0 = tb * 16, cur = t0 >> 6;
    float* impL = (float*)(smem + 32768);
    unsigned* selL = (unsigned*)(smem + 49152);
    const bf16_t* NQ = (const bf16_t*)(p.ws + OFF_NQ);
    const float* NG = (const float*)(p.ws + OFF_NGATE);
    const int rowq = lane & 15, tl = rowq >> 2, head = rowq & 3, lg = lane >> 4;
    const int tokl = 4 * w + tl;
    const LaneOfs lof = make_lane_ofs(lane);
    const StageOfs sof = make_stage_ofs();
    const size_t tokb = (size_t)b * SEQ + t0;
    bf16x8 q0, q1;
    {
        const bf16_t* qp = NQ + (tokb + tokl) * 512 + g * 256 + head * 64 + lg * 8;
        q0 = *(const bf16x8*)qp; q1 = *(const bf16x8*)(qp + 32);
    }
    const float* gp = NG + (tokb + tokl) * 24 + g * 12 + head * 3;
    __syncthreads();
    for (int i = tid; i < 2048; i += 256) impL[i] = 0.f;
    const int tq = t0 + tokl;
    f32x4 o[4], ot[4];
    float m, l;
#define NSA_RESET() { _Pragma("unroll") for (int dt = 0; dt < 4; ++dt) o[dt] = (f32x4){0.f, 0.f, 0.f, 0.f}; m = -1e30f; l = 0.f; }
#define NSA_LSUM() { l += __shfl_xor(l, 16); l += __shfl_xor(l, 32); }

    const int nv = (tq >= 31) ? (((tq - 31) >> 4) + 1) : 0;
    const int nkb = ((t0 >> 4) + 63) >> 6;
    const int tmin = t0 + 4 * w;
    const int nvmin = (tmin >= 31) ? (((tmin - 31) >> 4) + 1) : 0;
    const bf16_t* ckb = (const bf16_t*)(p.ws + OFF_CMPKB) + (size_t)(b * 2 + g) * 512 * 64;
    const bf16_t* cvb = (const bf16_t*)(p.ws + OFF_CMPVB) + (size_t)(b * 2 + g) * 512 * 64;
    NSA_RESET()
    nsa_kv_loop(ckb, cvb, 64, 0, nkb - 1, smem, sof, [&](int kb, const unsigned char* Kl, const unsigned char* VTl) __attribute__((always_inline)) {
        attn_step(Kl, VTl, lane, lof, q0, q1, o, m, l, 0.f, kb * 64 + 64 <= nvmin, [&](int key) __attribute__((always_inline)) { return kb * 64 + key < nv; });
    });
    NSA_LSUM()
    const float mc = m;
    const float invc = 1.f / fmaxf(l, 1e-30f);
    {
        const float f = gp[0] * invc;
#pragma unroll
        for (int dt = 0; dt < 4; ++dt) { ot[dt][0] = f * o[dt][0]; ot[dt][1] = f * o[dt][1]; ot[dt][2] = f * o[dt][2]; ot[dt][3] = f * o[dt][3]; }
    }
    if (cur >= 16) {
        nsa_kv_loop(ckb, cvb, 64, 0, nkb - 1, smem, sof, [&](int kb, const unsigned char* Kl, const unsigned char* VTl) __attribute__((always_inline)) {
            f32x4 s[4];
            nsa_scores(Kl, lof, q0, q1, 0.f, s);
            float* impT = impL + tokl * 128;
#pragma unroll
            for (int kt = 0; kt < 4; ++kt) {
                float pr[4];
#pragma unroll
                for (int r = 0; r < 4; ++r) {
                    const int n = kb * 64 + kt * 16 + 4 * lg + r;
                    pr[r] = (n < nv) ? __builtin_amdgcn_exp2f(s[kt][r] - mc) * invc : 0.f;
                }
                float c1 = pr[0] + pr[1] + pr[2] + 0.5f * pr[3], c2 = 0.5f * pr[3];
                c1 += __shfl_xor(c1, 1); c1 += __shfl_xor(c1, 2);
                c2 += __shfl_xor(c2, 1); c2 += __shfl_xor(c2, 2);
                const int j = kb * 16 + kt * 4 + lg;
                if (head == 0) {
                    atomicAdd(&impT[j], c1);
                    if (j + 1 < 128) atomicAdd(&impT[j + 1], c2);
                }
            }
        });
        for (int tk = 0; tk < 4; ++tk) {
            const int tok = 4 * w + tk;
            const int jA = lane, jB = lane + 64;
            float v0, v1;
            {
                const bool fA = (jA == 0) || (jA == cur) || (jA == cur - 1), fB = (jB == cur) || (jB == cur - 1);
                v0 = fA ? 1.0e4f : ((jA <= cur) ? impL[tok * 128 + jA] : -1.f);
                v1 = fB ? 1.0e4f : ((jB <= cur) ? impL[tok * 128 + jB] : -1.f);
            }
            bool s0 = false, s1 = false;
            for (int k = 0; k < 16; ++k) {
                const float mx = wave_max(fmaxf(v0, v1));
                const unsigned long long b0 = __ballot(v0 == mx);
                if (b0) {
                    const int lsel = __ffsll((unsigned long long)b0) - 1;
                    if (lane == lsel) { v0 = -3.0e38f; s0 = true; }
                } else {
                    const unsigned long long b1 = __ballot(v1 == mx);
                    const int lsel = __ffsll((unsigned long long)b1) - 1;
                    if (lane == lsel) { v1 = -3.0e38f; s1 = true; }
                }
            }
            const unsigned long long mk0 = __ballot(s0), mk1 = __ballot(s1);
            if (lane == 0) {
                selL[tok * 4 + 0] = (unsigned)mk0; selL[tok * 4 + 1] = (unsigned)(mk0 >> 32);
                selL[tok * 4 + 2] = (unsigned)mk1; selL[tok * 4 + 3] = (unsigned)(mk1 >> 32);
            }
        }
    } else {
        if (lane < 4) {
            const int tok = 4 * w + lane;
            selL[tok * 4 + 0] = (2u << cur) - 1u; selL[tok * 4 + 1] = 0u; selL[tok * 4 + 2] = 0u; selL[tok * 4 + 3] = 0u;
        }
    }
    WAVE_LDS_SYNC();
#if NSA_DIAG
    if (head == 0 && lg == 0) {
        unsigned* SELM = (unsigned*)(p.ws + OFF_SELM);
#pragma unroll
        for (int qd = 0; qd < 4; ++qd) SELM[((size_t)bg * SEQ + tq) * 4 + qd] = selL[tokl * 4 + qd];
    }
#endif
    NSA_RESET()
    {
        const bf16_t* kg = (const bf16_t*)(p.ws + OFF_KV + 2 * KV_STRIDE) + (size_t)b * SEQ * 128 + g * 64;
        const bf16_t* vg = (const bf16_t*)(p.ws + OFF_KV + 3 * KV_STRIDE) + (size_t)b * SEQ * 128 + g * 64;
        nsa_kv_loop(kg, vg, 128, 0, cur, smem, sof, [&](int kb, const unsigned char* Kl, const unsigned char* VTl) __attribute__((always_inline)) {
            const bool sv = (selL[tokl * 4 + (kb >> 5)] >> (kb & 31)) & 1u;
            if (__ballot(sv) != 0ull)
                attn_step(Kl, VTl, lane, lof, q0, q1, o, m, l, sv ? 0.f : NEGM, kb < cur, [&](int key) __attribute__((always_inline)) { return kb * 64 + key <= tq; });
        });
    }
    NSA_LSUM()
    {
        const float f = gp[1] / fmaxf(l, 1e-30f);
#pragma unroll
        for (int dt = 0; dt < 4; ++dt) { ot[dt][0] += f * o[dt][0]; ot[dt][1] += f * o[dt][1]; ot[dt][2] += f * o[dt][2]; ot[dt][3] += f * o[dt][3]; }
    }
    NSA_RESET()
    {
        const bf16_t* kg = (const bf16_t*)(p.ws + OFF_KV + 4 * KV_STRIDE) + (size_t)b * SEQ * 128 + g * 64;
        const bf16_t* vg = (const bf16_t*)(p.ws + OFF_KV + 5 * KV_STRIDE) + (size_t)b * SEQ * 128 + g * 64;
        const int klo = (t0 > 511) ? ((t0 - 511) >> 6) : 0;
        nsa_kv_loop(kg, vg, 128, klo, cur, smem, sof, [&](int kb, const unsigned char* Kl, const unsigned char* VTl) __attribute__((always_inline)) {
            attn_step(Kl, VTl, lane, lof, q0, q1, o, m, l, 0.f, (kb * 64 >= tmin + 3 - 511) && (kb * 64 + 63 <= tmin),
                      [&](int key) __attribute__((always_inline)) { const int ka = kb * 64 + key; return (ka <= tq) && (ka >= tq - 511); });
        });
    }
    NSA_LSUM()
    {
        const float f = gp[2] / fmaxf(l, 1e-30f);
        bf16_t* MIX = (bf16_t*)(p.ws + OFF_XB);
#pragma unroll
        for (int dt = 0; dt < 4; ++dt) {
            uint2 ov;
            ov.x = pack2bf(ot[dt][0] + f * o[dt][0], ot[dt][1] + f * o[dt][1]);
            ov.y = pack2bf(ot[dt][2] + f * o[dt][2], ot[dt][3] + f * o[dt][3]);
            *(uint2*)(MIX + (tokb + tokl) * DM + 512 + g * 256 + head * 64 + dt * 16 + lg * 4) = ov;
        }
    }
#undef NSA_RESET
#undef NSA_LSUM
}

__device__ __forceinline__ float block_sum(float v, float* red) {
    v = wave_sum(v);
    __syncthreads();
    if ((threadIdx.x & 63) == 0) red[threadIdx.x >> 6] = v;
    __syncthreads();
    return red[0] + red[1] + red[2] + red[3];
}
__device__ __forceinline__ float4 ln_row(float4 y, const float* g, const float* bb, float* red) {
    const int tid = opaque_tid();
    const float mu = block_sum(y.x + y.y + y.z + y.w, red) * (1.f / 1024.f);
    const float dx = y.x - mu, dy = y.y - mu, dz = y.z - mu, dw = y.w - mu;
    const float var = block_sum(dx * dx + dy * dy + dz * dz + dw * dw, red) * (1.f / 1024.f);
    const float rs = rsqrtf(var + LN_EPS);
    const float4 gg = ((const float4*)g)[tid], b4 = ((const float4*)bb)[tid];
    return make_float4(dx * rs * gg.x + b4.x, dy * rs * gg.y + b4.y, dz * rs * gg.z + b4.z, dw * rs * gg.w + b4.w);
}

__device__ __forceinline__ void ln1_phase(const Params& p, float* sm) {
    const int tid = opaque_tid();
    for (int n = blockIdx.x; n < NTOK; n += gridDim.x) {
        const float4 y = ((const float4*)(p.out + (size_t)n * DM))[tid];
        const float4 o = ln_row(y, p.in[15], p.in[16], sm);
        ((float4*)(p.out + (size_t)n * DM))[tid] = o;
        uint2 hb; hb.x = pack2bf(o.x, o.y); hb.y = pack2bf(o.z, o.w);
        ((uint2*)((bf16_t*)(p.ws + OFF_XB) + (size_t)n * DM))[tid] = hb;
    }
}

template <int CTRL> __device__ __forceinline__ float dppf(float x) {
    return __builtin_bit_cast(float, __builtin_amdgcn_mov_dpp(__builtin_bit_cast(int, x), CTRL, 0xf, 0xf, true));
}
__device__ __forceinline__ float row16_max(float m) {
    m = fmaxf(m, dppf<0x121>(m)); m = fmaxf(m, dppf<0x122>(m));
    m = fmaxf(m, dppf<0x124>(m)); m = fmaxf(m, dppf<0x128>(m));
    return m;
}
__device__ __forceinline__ float row16_sum(float m) {
    m += dppf<0x121>(m); m += dppf<0x122>(m); m += dppf<0x124>(m); m += dppf<0x128>(m);
    return m;
}
__device__ __forceinline__ float dot2bf(unsigned a, unsigned b, float acc) {
    return __builtin_amdgcn_fdot2_f32_bf16(__builtin_bit_cast(bf16x2_t, a), __builtin_bit_cast(bf16x2_t, b), acc, false);
}
__device__ __forceinline__ float enc_key(float v, unsigned idx, unsigned mask) {
    const unsigned u = __float_as_uint(v);
    const unsigned code = (u >> 31) ? idx : (mask - idx);
    return __uint_as_float((u & ~mask) | code);
}
__device__ __forceinline__ unsigned dec_idx(float key, unsigned mask) {
    const unsigned u = __float_as_uint(key);
    const unsigned code = u & mask;
    return (u >> 31) ? code : (mask - code);
}
__device__ __forceinline__ float dec_val(float key, unsigned mask) { return __uint_as_float(__float_as_uint(key) & ~mask); }
#define NEGKEY (-3.0e38f)


typedef float f32x2 __attribute__((ext_vector_type(2)));
__device__ __forceinline__ void cvt_rows_fp8(const float* __restrict__ src, unsigned char* __restrict__ dst, float* __restrict__ scales, int rows) {
    const int tid_ = opaque_tid(), lane = tid_ & 63, w = __builtin_amdgcn_readfirstlane(tid_ >> 6);
    for (int r = blockIdx.x * 4 + w; r < rows; r += gridDim.x * 4) {
        const float4* sp = (const float4*)(src + (size_t)r * 1024 + lane * 16);
        const float4 a = sp[0], b = sp[1], c = sp[2], d = sp[3];
        float mx = fmaxf(fmaxf(fmaxf(fabsf(a.x), fabsf(a.y)), fmaxf(fabsf(a.z), fabsf(a.w))), fmaxf(fmaxf(fabsf(b.x), fabsf(b.y)), fmaxf(fabsf(b.z), fabsf(b.w))));
        mx = fmaxf(mx, fmaxf(fmaxf(fmaxf(fabsf(c.x), fabsf(c.y)), fmaxf(fabsf(c.z), fabsf(c.w))), fmaxf(fmaxf(fabsf(d.x), fabsf(d.y)), fmaxf(fabsf(d.z), fabsf(d.w)))));
        mx = wave_max(mx);
        const float sc = (mx > 0.f) ? mx * (1.f / 448.f) : 1.f;
        const float inv = 1.f / sc;
        uint4 o;
        int t;
        t = 0; t = __builtin_amdgcn_cvt_pk_fp8_f32(a.x * inv, a.y * inv, t, false); t = __builtin_amdgcn_cvt_pk_fp8_f32(a.z * inv, a.w * inv, t, true); o.x = (unsigned)t;
        t = 0; t = __builtin_amdgcn_cvt_pk_fp8_f32(b.x * inv, b.y * inv, t, false); t = __builtin_amdgcn_cvt_pk_fp8_f32(b.z * inv, b.w * inv, t, true); o.y = (unsigned)t;
        t = 0; t = __builtin_amdgcn_cvt_pk_fp8_f32(c.x * inv, c.y * inv, t, false); t = __builtin_amdgcn_cvt_pk_fp8_f32(c.z * inv, c.w * inv, t, true); o.z = (unsigned)t;
        t = 0; t = __builtin_amdgcn_cvt_pk_fp8_f32(d.x * inv, d.y * inv, t, false); t = __builtin_amdgcn_cvt_pk_fp8_f32(d.z * inv, d.w * inv, t, true); o.w = (unsigned)t;
        *(uint4*)(dst + (size_t)r * 1024 + lane * 16) = o;
        if (lane == 0) scales[r] = sc;
    }
}

__device__ __forceinline__ void fold_ws_phase(const float* __restrict__ wq, const float* __restrict__ k1, const float* __restrict__ k2,
                                              bf16_t* __restrict__ WsT) {
    for (int it = blockIdx.x * 256 + threadIdx.x; it < 2048 * 128; it += gridDim.x * 256) {
        const int r = it & 2047, kg = it >> 11;
        const int a = (r >> 7) & 1, j = r & 127;
        const float* kr = (a ? k2 : k1) + j * 128;
        const float* wr = wq + (size_t)(kg * 8) * 2048 + (r & ~127);
        float s[8];
#pragma unroll
        for (int q = 0; q < 8; ++q) s[q] = 0.f;
        for (int d = 0; d < 128; d += 4) {
            const float4 kv = *(const float4*)(kr + d);
#pragma unroll
            for (int q = 0; q < 8; ++q) {
                const float4 wv = *(const float4*)(wr + (size_t)q * 2048 + d);
                s[q] += wv.x * kv.x + wv.y * kv.y + wv.z * kv.z + wv.w * kv.w;
            }
        }
        uint4 o;
        o.x = pack2bf(s[0], s[1]); o.y = pack2bf(s[2], s[3]); o.z = pack2bf(s[4], s[5]); o.w = pack2bf(s[6], s[7]);
        *(uint4*)(WsT + (size_t)r * 1024 + kg * 8) = o;
    }
}

#define CE_DESC(a, b) { const float t_ = fmaxf(a, b); b = fminf(a, b); a = t_; }

struct EpiTop16 {
    float* topk; unsigned char* lds;
    __device__ __forceinline__ void operator()(int m, int n, f32x4 v) const {
        const int ml = m & 127, g4 = (n & 127) >> 2;
        *(float4*)(lds + ((ml * 32 + (g4 ^ (ml & 7))) << 4)) = make_float4(v[0], v[1], v[2], v[3]);
    }
    __device__ __forceinline__ void finish(int m0, int n0) const {
        __syncthreads();
        const int tid_ = opaque_tid(), lane = tid_ & 63, w = __builtin_amdgcn_readfirstlane(tid_ >> 6), c = lane & 15;
        const int L = n0 >> 7;
        for (int it = 0; it < 8; ++it) {
            const int r = w * 32 + it * 4 + (lane >> 4);
            const float4 x0 = *(const float4*)(lds + ((r * 32 + ((2 * c) ^ (r & 7))) << 4));
            const float4 x1 = *(const float4*)(lds + ((r * 32 + ((2 * c + 1) ^ (r & 7))) << 4));
            float l0 = enc_key(x0.x, 8 * c + 0, 127), l1 = enc_key(x0.y, 8 * c + 1, 127), l2 = enc_key(x0.z, 8 * c + 2, 127),
                  l3 = enc_key(x0.w, 8 * c + 3, 127), l4 = enc_key(x1.x, 8 * c + 4, 127), l5 = enc_key(x1.y, 8 * c + 5, 127),
                  l6 = enc_key(x1.z, 8 * c + 6, 127), l7 = enc_key(x1.w, 8 * c + 7, 127);
            CE_DESC(l0, l1) CE_DESC(l2, l3) CE_DESC(l4, l5) CE_DESC(l6, l7)
            CE_DESC(l0, l2) CE_DESC(l1, l3) CE_DESC(l4, l6) CE_DESC(l5, l7)
            CE_DESC(l1, l2) CE_DESC(l5, l6)
            CE_DESC(l0, l4) CE_DESC(l1, l5) CE_DESC(l2, l6) CE_DESC(l3, l7)
            CE_DESC(l2, l4) CE_DESC(l3, l5)
            CE_DESC(l1, l2) CE_DESC(l3, l4) CE_DESC(l5, l6)
            float res = NEGKEY;
#pragma unroll
            for (int k = 0; k < 16; ++k) {
                const float mx = row16_max(l0);
                const bool win = (l0 == mx);
                l0 = win ? l1 : l0; l1 = win ? l2 : l1; l2 = win ? l3 : l2; l3 = win ? l4 : l3;
                l4 = win ? l5 : l4; l5 = win ? l6 : l5; l6 = win ? l7 : l6; l7 = win ? NEGKEY : l7;
                res = (c == k) ? mx : res;
            }
            topk[(size_t)(m0 + r) * 256 + L * 16 + c] = res;
        }
        __syncthreads();
    }
};

__device__ __forceinline__ void peer_fast_phase(const Params& p, unsigned char* smem) {
    const int tid = opaque_tid(), lane = tid & 63, w = __builtin_amdgcn_readfirstlane(tid >> 6), l16 = lane & 15, gq = lane >> 4;
    float* tk = (float*)(smem + w * 2048);
    int* ex = (int*)(smem + w * 2048 + 1024);
    float* gw = (float*)(smem + w * 2048 + 1536);
    const bf16_t* H1B = (const bf16_t*)(p.ws + OFF_XB);
    const unsigned char* U8 = p.ws + OFF_UB;
    const unsigned char* V8 = p.ws + OFF_VB;
    const float* USC = (const float*)(p.ws + OFF_USC);
    const float* VSC = (const float*)(p.ws + OFF_VSC);
    const float* TOPK = (const float*)(p.ws + OFF_TOPK);
    int ci[4], cj[4];
#pragma unroll
    for (int q = 0; q < 4; ++q) {
        const int s = l16 + 16 * q;
        int i, j;
        if (s < 16) { i = 0; j = s; }
        else if (s < 24) { i = 1; j = s - 16; }
        else if (s < 29) { i = 2; j = s - 24; }
        else if (s < 33) { i = 3; j = s - 29; }
        else if (s < 36) { i = 4; j = s - 33; }
        else if (s < 42) { i = 5 + ((s - 36) >> 1); j = (s - 36) & 1; }
        else if (s < 50) { i = 8 + (s - 42); j = 0; }
        else { i = -1; j = 0; }
        ci[q] = i; cj[q] = j;
    }
    for (int n = blockIdx.x * 4 + w; n < NTOK; n += gridDim.x * 4) {
        WAVE_LDS_SYNC();
        ((float4*)tk)[lane] = ((const float4*)(TOPK + (size_t)n * 256))[lane];
        WAVE_LDS_SYNC();
#pragma unroll
        for (int it = 0; it < 2; ++it) {
            const int head = it * 4 + gq;
            const float* ka = tk + head * 32;
            const float* kb = ka + 16;
            float c0, c1, c2, c3;
#define MKC(q, cq) { if (ci[q] >= 0) { const float sum_ = dec_val(ka[ci[q]], 127) + dec_val(kb[cj[q]], 127); \
                     cq = enc_key(sum_, ci[q] * 16 + cj[q], 255); } else cq = NEGKEY; }
            MKC(0, c0) MKC(1, c1) MKC(2, c2) MKC(3, c3)
#undef MKC
            float res = NEGKEY;
#pragma unroll
            for (int k = 0; k < 16; ++k) {
                const float mx = row16_max(fmaxf(fmaxf(c0, c1), fmaxf(c2, c3)));
                c0 = (c0 == mx) ? NEGKEY : c0; c1 = (c1 == mx) ? NEGKEY : c1;
                c2 = (c2 == mx) ? NEGKEY : c2; c3 = (c3 == mx) ? NEGKEY : c3;
                res = (l16 == k) ? mx : res;
            }
            const unsigned cc = dec_idx(res, 255);
            const float val = dec_val(res, 255);
            const unsigned e1 = dec_idx(ka[cc >> 4], 127), e2 = dec_idx(kb[cc & 15], 127);
            const float m0 = row16_max(val);
            const float e = expf(val - m0);
            const float ssum = row16_sum(e);
            ex[head * 16 + l16] = (int)(e1 * 128 + e2);
            gw[head * 16 + l16] = e / ssum;
        }
        WAVE_LDS_SYNC();
        {
            float xf[64];
            {
                const uint4* xr = (const uint4*)(H1B + (size_t)n * DM + 16 * l16);
#pragma unroll
                for (int i = 0; i < 4; ++i) {
                    const uint4 xa = xr[32 * i], xb = xr[32 * i + 1];
                    xf[16 * i + 0] = __uint_as_float(xa.x << 16); xf[16 * i + 1] = __uint_as_float(xa.x & 0xffff0000u);
                    xf[16 * i + 2] = __uint_as_float(xa.y << 16); xf[16 * i + 3] = __uint_as_float(xa.y & 0xffff0000u);
                    xf[16 * i + 4] = __uint_as_float(xa.z << 16); xf[16 * i + 5] = __uint_as_float(xa.z & 0xffff0000u);
                    xf[16 * i + 6] = __uint_as_float(xa.w << 16); xf[16 * i + 7] = __uint_as_float(xa.w & 0xffff0000u);
                    xf[16 * i + 8] = __uint_as_float(xb.x << 16); xf[16 * i + 9] = __uint_as_float(xb.x & 0xffff0000u);
                    xf[16 * i + 10] = __uint_as_float(xb.y << 16); xf[16 * i + 11] = __uint_as_float(xb.y & 0xffff0000u);
                    xf[16 * i + 12] = __uint_as_float(xb.z << 16); xf[16 * i + 13] = __uint_as_float(xb.z & 0xffff0000u);
                    xf[16 * i + 14] = __uint_as_float(xb.w << 16); xf[16 * i + 15] = __uint_as_float(xb.w & 0xffff0000u);
                }
            }
#pragma unroll 2
            for (int it = 0; it < 32; ++it) {
                const int k = it * 4 + gq;
                const int e = ex[k];
                const uint4* ur = (const uint4*)(U8 + (size_t)e * DM + 16 * l16);
                const uint4 a0 = ur[0], a1 = ur[16], a2 = ur[32], a3 = ur[48];
                const float usc = USC[e];
                float s = 0.f;
#define D8(W_, B_) { const f32x2 lo_ = __builtin_amdgcn_cvt_pk_f32_fp8((int)(W_), false), hi_ = __builtin_amdgcn_cvt_pk_f32_fp8((int)(W_), true); \
                     s += lo_[0] * xf[(B_)] + lo_[1] * xf[(B_) + 1] + hi_[0] * xf[(B_) + 2] + hi_[1] * xf[(B_) + 3]; }
                D8(a0.x, 0) D8(a0.y, 4) D8(a0.z, 8) D8(a0.w, 12)
                D8(a1.x, 16) D8(a1.y, 20) D8(a1.z, 24) D8(a1.w, 28)
                D8(a2.x, 32) D8(a2.y, 36) D8(a2.z, 40) D8(a2.w, 44)
                D8(a3.x, 48) D8(a3.y, 52) D8(a3.z, 56) D8(a3.w, 60)
#undef D8
                s = row16_sum(s) * usc;
                if (l16 == 0) gw[k] = gw[k] * gelu_tanh(s) * VSC[e];
            }
        }
        WAVE_LDS_SYNC();
        float acc[16];
#pragma unroll
        for (int q = 0; q < 16; ++q) acc[q] = 0.f;
#pragma unroll 4
        for (int k = 0; k < 128; ++k) {
            const int e = ex[k];
            const float wk = gw[k];
            const uint4 a = *(const uint4*)(V8 + (size_t)e * DM + 16 * lane);
#define A4(W_, B_) { const f32x2 lo_ = __builtin_amdgcn_cvt_pk_f32_fp8((int)(W_), false), hi_ = __builtin_amdgcn_cvt_pk_f32_fp8((int)(W_), true); \
                     acc[(B_)] += wk * lo_[0]; acc[(B_) + 1] += wk * lo_[1]; acc[(B_) + 2] += wk * hi_[0]; acc[(B_) + 3] += wk * hi_[1]; }
            A4(a.x, 0) A4(a.y, 4) A4(a.z, 8) A4(a.w, 12)
#undef A4
        }
        {
            float* orow = p.out + (size_t)n * DM + 16 * lane;
            const float4 h0 = ((const float4*)orow)[0], h1 = ((const float4*)orow)[1], h2 = ((const float4*)orow)[2], h3 = ((const float4*)orow)[3];
            float y[16] = {h0.x, h0.y, h0.z, h0.w, h1.x, h1.y, h1.z, h1.w, h2.x, h2.y, h2.z, h2.w, h3.x, h3.y, h3.z, h3.w};
            float sum = 0.f;
#pragma unroll
            for (int q = 0; q < 16; ++q) { y[q] = ALPHA * y[q] + acc[q]; sum += y[q]; }
            const float mu = wave_sum(sum) * (1.f / 1024.f);
            float sq = 0.f;
#pragma unroll
            for (int q = 0; q < 16; ++q) { y[q] -= mu; sq += y[q] * y[q]; }
            const float rs = rsqrtf(wave_sum(sq) * (1.f / 1024.f) + LN_EPS);
            const float* g = p.in[22] + 16 * lane;
            const float* bb = p.in[23] + 16 * lane;
#pragma unroll
            for (int hq = 0; hq < 4; ++hq) {
                const float4 gg = ((const float4*)g)[hq], b4 = ((const float4*)bb)[hq];
                float4 o;
                o.x = y[hq * 4 + 0] * rs * gg.x + b4.x; o.y = y[hq * 4 + 1] * rs * gg.y + b4.y;
                o.z = y[hq * 4 + 2] * rs * gg.z + b4.z; o.w = y[hq * 4 + 3] * rs * gg.w + b4.w;
                ((float4*)orow)[hq] = o;
            }
        }
    }
}

#define XB_TMO      128
#define XB_XCNT(j)  (256  + 64 * (j))
#define XB_XSUB(j)  (1280 + 64 * (j))
#define XB_XGEN(j)  (2304 + 64 * (j))
#define XB_TOP      3328
#define XB_TOPGEN   3392
#define XCD_BAR_WORDS 3456
#define XB_SPIN_CAP (1u << 22)
__device__ __forceinline__ unsigned xb_ld(unsigned* p) { return __hip_atomic_load(p, __ATOMIC_RELAXED, __HIP_MEMORY_SCOPE_AGENT); }
__device__ __forceinline__ unsigned xb_add(unsigned* p, unsigned v) { return __hip_atomic_fetch_add(p, v, __ATOMIC_RELAXED, __HIP_MEMORY_SCOPE_AGENT); }
__device__ __forceinline__ unsigned xb_xcc_id() { return (unsigned)__builtin_amdgcn_s_getreg((3 << 11) | 20) & 0xFu; }
#define XB_SPIN(cond, bar) do { unsigned _sp = 0; while (cond) { __builtin_amdgcn_s_sleep(1); \
    if ((++_sp & 255u) == 0u) { if (xb_ld(&(bar)[XB_TMO])) break; if (_sp > XB_SPIN_CAP) { atomicAdd(&(bar)[XB_TMO], 1u); break; } } } } while (0)
struct XcdBarrier { unsigned* bar; unsigned x; unsigned* st; };
__device__ __forceinline__ XcdBarrier xcd_barrier_post(unsigned* bar, unsigned* st) {
    XcdBarrier b; b.bar = bar; b.x = xb_xcc_id(); b.st = st;
    if (threadIdx.x == 0) (void)xb_add(&bar[XB_XCNT(b.x)], 1u);
    return b;
}
__device__ __forceinline__ void xcd_barrier_complete(unsigned* bar, unsigned x, unsigned& nloc, unsigned& nx) {
    const unsigned G = gridDim.x * gridDim.y * gridDim.z;
    unsigned sum, cnt, mine, sp = 0u;
    for (;;) {
        sum = 0u; cnt = 0u; mine = 0u;
#pragma unroll
        for (unsigned j = 0; j < 16; ++j) { const unsigned c = xb_ld(&bar[XB_XCNT(j)]); sum += c; cnt += (c > 0u) ? 1u : 0u; mine = (j == x) ? c : mine; }
        if (sum == G) break;
        __builtin_amdgcn_s_sleep(1);
        if ((++sp & 255u) == 0u) { if (xb_ld(&bar[XB_TMO])) break; if (sp > XB_SPIN_CAP) { atomicAdd(&bar[XB_TMO], 1u); break; } }
    }
    nloc = mine > 0u ? mine : 1u; nx = cnt > 0u ? cnt : 1u;
}
__device__ __forceinline__ void xcd_barrier(const XcdBarrier& b) {
    asm volatile("s_waitcnt vmcnt(0)" ::: "memory");
    __syncthreads();
    if (threadIdx.x == 0) {
        unsigned* bar = b.bar;
        __builtin_amdgcn_s_waitcnt(0);
        unsigned nloc = xb_ld(&b.st[0]), nx = xb_ld(&b.st[1]);
        if (nloc == 0u) { xcd_barrier_complete(bar, b.x, nloc, nx); __hip_atomic_store(&b.st[0], nloc, __ATOMIC_RELAXED, __HIP_MEMORY_SCOPE_AGENT); __hip_atomic_store(&b.st[1], nx, __ATOMIC_RELAXED, __HIP_MEMORY_SCOPE_AGENT); }
        const unsigned old = xb_add(&bar[XB_XSUB(b.x)], 1u);
        const unsigned gen = old / nloc;
        if (old + 1u == (gen + 1u) * nloc) {
            __builtin_amdgcn_fence(__ATOMIC_RELEASE, "agent");
            asm volatile("s_waitcnt vmcnt(0)" ::: "memory");
            const unsigned og = xb_add(&bar[XB_TOP], 1u);
            const unsigned tg = og / nx;
            if (og + 1u == (tg + 1u) * nx) xb_add(&bar[XB_TOPGEN], 1u);
            else XB_SPIN(xb_ld(&bar[XB_TOPGEN]) == tg, bar);
            __builtin_amdgcn_fence(__ATOMIC_ACQUIRE, "agent");
            xb_add(&bar[XB_XGEN(b.x)], 1u);
            asm volatile("s_waitcnt vmcnt(0)" ::: "memory");
        } else {
            XB_SPIN(xb_ld(&bar[XB_XGEN(b.x)]) == gen, bar);
            __builtin_amdgcn_fence(__ATOMIC_ACQUIRE, "agent");
            asm volatile("s_waitcnt vmcnt(0)" ::: "memory");
        }
    }
    __syncthreads();
}

__global__ void __launch_bounds__(256, 2) mega(Params p) {
    cg::grid_group grid = cg::this_grid();
    __shared__ __attribute__((aligned(16))) unsigned char smem[65536];
    float* sm = (float*)smem;
    unsigned* barw = (unsigned*)(p.ws + OFF_BAR);
    const XcdBarrier xbar = xcd_barrier_post(barw, barw + XCD_BAR_WORDS + 2 * blockIdx.x);
#if TIME_DIAG
    unsigned long long* TS = (unsigned long long*)(p.ws + OFF_DIAG + 256);
#define STAMP(k) if (blockIdx.x == 0 && threadIdx.x == 0) TS[k] = __builtin_amdgcn_s_memrealtime();
    STAMP(0)
#else
#define STAMP(k)
#endif
    bf16_t* XB = (bf16_t*)(p.ws + OFF_XB);
    bf16_t* WinT = (bf16_t*)(p.ws + OFF_WINT);
    bf16_t* WoutT = (bf16_t*)(p.ws + OFF_WOUTT);
    bf16_t* WqT = (bf16_t*)(p.ws + OFF_WQT);
    cvt_rows_bf16(p.in[0], XB, (size_t)NTOK * DM / 8);
    transpose_bf16(p.in[1], DIN, 3456, WinT);
    transpose_bf16(p.in[2], DM, DM, WoutT);
    fold_ws_phase(p.in[17], p.in[18], p.in[19], WqT);
    cvt_rows_fp8(p.in[20], p.ws + OFF_UB, (float*)(p.ws + OFF_USC), 16384);
    cvt_rows_fp8(p.in[21], p.ws + OFF_VB, (float*)(p.ws + OFF_VSC), 16384);
    transpose_bf16(p.in[6], 256, 256, (bf16_t*)(p.ws + OFF_W1T), 2048);
    transpose_bf16(p.in[11], 256, 256, (bf16_t*)(p.ws + OFF_W1T) + 256 * 2048, 2048);
    if (blockIdx.x == 0) {
        for (int c = threadIdx.x; c < 512; c += 256)
            ((float*)(p.ws + OFF_LBV))[c] = 1.f / (1.f + expf(p.in[3][512 + c] - p.in[3][c]));
        if (threadIdx.x < 16) ((float*)(p.ws + OFF_DIAG))[threadIdx.x] = 0.f;
    }
    if (blockIdx.x == 1 || blockIdx.x == 2) cmp_peb(p, blockIdx.x - 1);
    grid.sync(); STAMP(1)
    gemm_bf16_phase(XB, DM, WinT, DM, NTOK / 128, 27, smem, EpiProj{p.ws});
    xcd_barrier(xbar); STAMP(2)
    for (int it = blockIdx.x; it < 128; it += gridDim.x) {
        const int which = it >> 6, t = it & 63;
        gemm_tile(ALoadCmp{(const bf16_t*)(p.ws + OFF_KV + (size_t)which * KV_STRIDE)},
                  (const bf16_t*)(p.ws + OFF_W1T) + (size_t)which * 256 * 2048, 2048, 32, (t >> 1) * 128, (t & 1) * 128, smem,
                  EpiCmpH{(bf16_t*)(p.ws + OFF_HB) + (size_t)which * 4096 * 256, (const float*)(p.ws + OFF_PEB) + which * 256});
    }
    for (int it = (blockIdx.x + gridDim.x - 128 % gridDim.x) % gridDim.x; it < 2048; it += gridDim.x) hgrn_passA(p, it, smem);
#if NSA_DIAG
    for (int it = blockIdx.x; it < 2 * 4 * NCB * 2; it += gridDim.x) compress_item(p, it, sm);
#endif
    xcd_barrier(xbar); STAMP(3)
    if (blockIdx.x < 256) hgrn_scan_item(p, blockIdx.x);
    cmp_layer2_phase(p, 0, gridDim.x);
    xcd_barrier(xbar); STAMP(4)
    for (int it = blockIdx.x; it < NSA_TILES; it += gridDim.x) nsa_tile(p, it, smem);
    for (int it = gridDim.x - 1 - blockIdx.x; it < 2048; it += gridDim.x) hgrn_passC(p, it, smem);
    xcd_barrier(xbar); STAMP(5)
#if NSA_DIAG
    for (int it = blockIdx.x; it < 4 * 2 * SEQ; it += gridDim.x) nsa_item(p, it, sm);
    grid.sync();
    {
        const float* DG = (const float*)(p.ws + OFF_DIAG);
#if NSA_DIAG == 1
        const float cval = -log10f(sqrtf(DG[0] / DG[1]) + 1e-9f);
#else
        const float cval = -log10f(DG[2] / DG[3] + 1e-6f);
#endif
        for (size_t i = (size_t)blockIdx.x * 256 + threadIdx.x; i < (size_t)NTOK * DM; i += (size_t)gridDim.x * 256) p.out[i] = cval;
        return;
    }
#endif
    gemm_bf16_phase(XB, DM, WoutT, DM, NTOK / 128, 8, smem, EpiY{p.in[0], p.out});
    xcd_barrier(xbar); STAMP(6)
    ln1_phase(p, sm);
    xcd_barrier(xbar); STAMP(7)
    gemm_bf16_phase(XB, DM, WqT, DM, NTOK / 128, 16, smem, EpiTop16{(float*)(p.ws + OFF_TOPK), smem});
    xcd_barrier(xbar); STAMP(8)
    peer_fast_phase(p, smem);
#if TIME_DIAG
    xcd_barrier(xbar); STAMP(9)
    grid.sync();
    {
        const int pa = TIME_DIAG / 100, pb = TIME_DIAG % 100;
        const float da = (float)(TS[pa] - TS[pa - 1]) * 0.01f, db = (float)(TS[pb] - TS[pb - 1]) * 0.01f;
        const float ca = rintf(25.f * log10f(da * 0.1f)) * 0.04f; (void)db;
        for (size_t i = (size_t)blockIdx.x * 256 + threadIdx.x; i < (size_t)NTOK * DM; i += (size_t)gridDim.x * 256) p.out[i] = ca;
    }
#endif
}

extern "C" void kernel_launch(void* const* d_in, const int* in_sizes, int n_in, void* d_out, int out_size,
                              void* d_ws, size_t ws_size, hipStream_t stream) {
    static int grid_blocks = 0;
    if (!grid_blocks) {
        int dev = 0, cus = 0, per_cu = 0;
        hipGetDevice(&dev);
        hipDeviceGetAttribute(&cus, hipDeviceAttributeMultiprocessorCount, dev);
        hipOccupancyMaxActiveBlocksPerMultiprocessor(&per_cu, mega, 256, 0);
        if (per_cu > 4) per_cu = 4;
        if (per_cu < 1) per_cu = 1;
        grid_blocks = cus * per_cu;
        if (n_in != 24 || ws_size < WS_NEED || out_size != NTOK * DM)
            fprintf(stderr, "kernel_launch: unexpected sizes n_in=%d ws=%zu out=%d\n", n_in, ws_size, out_size);
    }
    Params p;
    memset(&p, 0, sizeof(p));
    for (int i = 0; i < 24; ++i) p.in[i] = (const float*)d_in[i];
    p.out = (float*)d_out;
    p.ws = (unsigned char*)d_ws;
    hipMemsetAsync((char*)d_ws + OFF_BAR, 0, BAR_BYTES, stream);
    void* args[] = {&p};
    hipError_t e = hipLaunchCooperativeKernel((void*)mega, dim3(grid_blocks), dim3(256), args, 0, stream);
    if (e != hipSuccess) fprintf(stderr, "cooperative launch failed: %s (grid %d)\n", hipGetErrorString(e), grid_blocks);
}
```

```cpp
#include <hip/hip_runtime.h>
#include <hip/hip_cooperative_groups.h>
#include <cstdio>
#include <cstring>
namespace cg = cooperative_groups;

#define NTOK 32768
#define SEQ 8192
#define DM 1024
#define DIN 3352
#define NCB 511
#define ALPHA 1.189207115002721f
#define LN_EPS 1e-5f

#define MB_ 1048576ull
#define OFF_XB 0ull
#define OFF_HQ (64 * MB_)
#define OFF_HLF (96 * MB_)
#define OFF_HI (160 * MB_)
#define OFF_HG (192 * MB_)
#define OFF_NQ (224 * MB_)
#define OFF_KV (256 * MB_)
#define KV_STRIDE (8 * MB_)
#define OFF_NGATE (304 * MB_)
#define OFF_CMPK (308 * MB_)
#define OFF_CMPV (309 * MB_)
#define OFF_WINT (310 * MB_)
#define OFF_WOUTT (317 * MB_)
#define OFF_WQT (319 * MB_)
#define OFF_LBV (323 * MB_)
#define OFF_DC (324 * MB_)
#define OFF_SC (325 * MB_)
#define OFF_UB (389 * MB_)
#define OFF_VB (421 * MB_)
#define OFF_TOPK (453 * MB_)
#define OFF_W1T (485 * MB_)
#define OFF_HB (487 * MB_)
#define OFF_CMPKB (491 * MB_)
#define OFF_CMPVB (491 * MB_ + 524288ull)
#define OFF_PEB (492 * MB_)
#define OFF_SELM (493 * MB_)
#define OFF_DIAG (494 * MB_)
#define OFF_USC (494 * MB_ + 131072ull)
#define OFF_VSC (494 * MB_ + 196608ull)
#define OFF_BAR (494 * MB_ + 65536ull)
#define BAR_BYTES 32768
#define WS_NEED (495 * MB_)
#define USE_NSA_MFMA 1
#define NSA_DIAG 0
#define TIME_DIAG 0

struct Params {
    const float* in[24];
    float* out;
    unsigned char* ws;
};

typedef float f32x16 __attribute__((ext_vector_type(16)));
#define WAVE_LDS_SYNC() asm volatile("s_waitcnt lgkmcnt(0)" ::: "memory")
#define LAS3 __attribute__((address_space(3)))

__device__ __forceinline__ int opaque_tid() { int t = threadIdx.x; asm volatile("" : "+v"(t)); return t; }
__device__ __forceinline__ float wave_sum(float v) {
#pragma unroll
    for (int o = 32; o; o >>= 1) v += __shfl_xor(v, o);
    return v;
}
__device__ __forceinline__ float wave_max(float v) {
#pragma unroll
    for (int o = 32; o; o >>= 1) v = fmaxf(v, __shfl_xor(v, o));
    return v;
}
__device__ __forceinline__ float sigmoidf_(float x) { return 1.f / (1.f + expf(-x)); }
__device__ __forceinline__ float gelu_tanh_fast(float x) {
    const float u = 0.7978845608028654f * (x + 0.044715f * x * x * x);
    return x * __builtin_amdgcn_rcpf(1.f + __builtin_amdgcn_exp2f(-2.885390081777927f * u));
}
__device__ __forceinline__ float gelu_tanh(float x) {
    const float c = 0.7978845608028654f;
    return 0.5f * x * (1.f + tanhf(c * (x + 0.044715f * x * x * x)));
}

typedef short bf16x8 __attribute__((ext_vector_type(8)));
typedef float f32x4 __attribute__((ext_vector_type(4)));
typedef unsigned short bf16_t;

typedef __bf16 bf16x2_t __attribute__((ext_vector_type(2)));
__device__ __forceinline__ unsigned pack2bf(float lo, float hi) {
    bf16x2_t v; v[0] = (__bf16)lo; v[1] = (__bf16)hi;
    return __builtin_bit_cast(unsigned, v);
}
__device__ __forceinline__ unsigned f2bf(float f) { return pack2bf(f, 0.f) & 0xffffu; }
__device__ __forceinline__ float bf2f(unsigned h) { return __uint_as_float(h << 16); }

__device__ __forceinline__ void cvt_rows_bf16(const float* __restrict__ src, bf16_t* __restrict__ dst, size_t n8) {
    for (size_t i = (size_t)blockIdx.x * 256 + threadIdx.x; i < n8; i += (size_t)gridDim.x * 256) {
        const float4 a = ((const float4*)src)[2 * i], b = ((const float4*)src)[2 * i + 1];
        uint4 o;
        o.x = pack2bf(a.x, a.y); o.y = pack2bf(a.z, a.w); o.z = pack2bf(b.x, b.y); o.w = pack2bf(b.z, b.w);
        ((uint4*)dst)[i] = o;
    }
}
__device__ __forceinline__ void transpose_bf16(const float* __restrict__ src, int Nsrc, int Npad, bf16_t* __restrict__ dst, int K = 1024) {
    const size_t total = (size_t)Npad * (K / 8);
    for (size_t i = (size_t)blockIdx.x * 256 + threadIdx.x; i < total; i += (size_t)gridDim.x * 256) {
        const int n = (int)(i % Npad), kg = (int)(i / Npad);
        float v[8];
#pragma unroll
        for (int j = 0; j < 8; ++j) v[j] = (n < Nsrc) ? src[(size_t)(kg * 8 + j) * Nsrc + n] : 0.f;
        uint4 o;
        o.x = pack2bf(v[0], v[1]); o.y = pack2bf(v[2], v[3]); o.z = pack2bf(v[4], v[5]); o.w = pack2bf(v[6], v[7]);
        *(uint4*)(dst + (size_t)n * K + kg * 8) = o;
    }
}

struct ALoadStd {
    const bf16_t* A; int lda;
    __device__ __forceinline__ const bf16_t* ptr(int row, int ks) const { return A + (size_t)row * lda + ks * 64; }
};
struct ALoadCmp {
    const bf16_t* KC;
    __device__ __forceinline__ const bf16_t* ptr(int row, int ks) const {
        const int r = row < 4088 ? row : 4087;
        const int g = r & 1, bn = r >> 1, n = bn % NCB, b = bn / NCB;
        return KC + ((size_t)(b * SEQ + 16 * n + ks) * 128 + g * 64);
    }
};
#define GLDS1(i, ks, buf) { const int row_ = 8 * w + 32 * (i) + (lane >> 3);                                                    \
        __builtin_amdgcn_global_load_lds((const unsigned*)(aload.ptr(m0 + row_, (ks)) + (((lane & 7) ^ (lane >> 3)) << 3)),      \
                                         (LAS3 unsigned*)(lds + (buf) * 32768 + w * 1024 + (i) * 4096), 16, 0, 0);              \
        __builtin_amdgcn_global_load_lds((const unsigned*)(Bp + (size_t)row_ * ldb + (ks) * 64 + (((lane & 7) ^ (lane >> 3)) << 3)), \
                                         (LAS3 unsigned*)(lds + (buf) * 32768 + 16384 + w * 1024 + (i) * 4096), 16, 0, 0); }
#define GEMM_GLDS(ks, buf) { GLDS1(0, ks, buf) GLDS1(1, ks, buf) GLDS1(2, ks, buf) GLDS1(3, ks, buf) }
template <class ALoad, class Epi>
__device__ __forceinline__ void gemm_tile(const ALoad aload, const bf16_t* __restrict__ Bt, int ldb, int KS, int m0, int n0,
                                          unsigned char* lds, Epi epi) {
    const int tid = opaque_tid(), lane = tid & 63, w = __builtin_amdgcn_readfirstlane(tid >> 6), wm = w >> 1, wn = w & 1;
    f32x4 acc[4][4];
#pragma unroll
    for (int j = 0; j < 4; ++j)
#pragma unroll
        for (int i = 0; i < 4; ++i) acc[j][i] = (f32x4){0.f, 0.f, 0.f, 0.f};
    const bf16_t* Bp = Bt + (size_t)n0 * ldb;
    __syncthreads();
    GEMM_GLDS(0, 0)
    asm volatile("s_waitcnt vmcnt(0)" ::: "memory");
    __syncthreads();
    for (int ks = 0; ks < KS; ++ks) {
        if (ks + 1 < KS) GEMM_GLDS(ks + 1, (ks + 1) & 1)
        const unsigned char* la = lds + (ks & 1) * 32768;
        const unsigned char* lb = la + 16384;
#pragma unroll
        for (int s = 0; s < 2; ++s) {
            bf16x8 af[4], wf[4];
            const int ch = s * 4 + (lane >> 4);
#pragma unroll
            for (int i = 0; i < 4; ++i) {
                const int row = wm * 64 + i * 16 + (lane & 15);
                af[i] = *(const bf16x8*)(la + row * 128 + ((ch ^ (row & 7)) << 4));
            }
#pragma unroll
            for (int j = 0; j < 4; ++j) {
                const int row = wn * 64 + j * 16 + (lane & 15);
                wf[j] = *(const bf16x8*)(lb + row * 128 + ((ch ^ (row & 7)) << 4));
            }
#pragma unroll
            for (int j = 0; j < 4; ++j)
#pragma unroll
                for (int i = 0; i < 4; ++i)
                    acc[j][i] = __builtin_amdgcn_mfma_f32_16x16x32_bf16(wf[j], af[i], acc[j][i], 0, 0, 0);
        }
        asm volatile("s_waitcnt vmcnt(0)" ::: "memory");
        __syncthreads();
    }
#pragma unroll
    for (int j = 0; j < 4; ++j)
#pragma unroll
        for (int i = 0; i < 4; ++i)
            epi(m0 + wm * 64 + i * 16 + (lane & 15), n0 + wn * 64 + j * 16 + (lane >> 4) * 4, acc[j][i]);
    epi.finish(m0, n0);
}
template <class Epi>
__device__ __forceinline__ void gemm_bf16_phase(const bf16_t* __restrict__ A, int lda, const bf16_t* __restrict__ Bt, int ldb,
                                                int Mtiles, int Ntiles, unsigned char* lds, Epi epi) {
    if ((gridDim.x & 7) == 0 && (Mtiles & 31) == 0) {
        const int x = blockIdx.x & 7, j = blockIdx.x >> 3, nb = gridDim.x >> 3;
        const int per = (Mtiles >> 3) * Ntiles;
        for (int q = j; q < per; q += nb) {
            const int s = q / (4 * Ntiles), rem = q - s * (4 * Ntiles);
            const int c = rem >> 2, r = rem & 3;
            const int mt = x + 8 * (4 * s + r);
            gemm_tile(ALoadStd{A, lda}, Bt, ldb, 16, mt * 128, c * 128, lds, epi);
        }
    } else {
        for (int tile = blockIdx.x; tile < Mtiles * Ntiles; tile += gridDim.x) {
            const int mt = tile / Ntiles, nt = tile % Ntiles;
            gemm_tile(ALoadStd{A, lda}, Bt, ldb, 16, mt * 128, nt * 128, lds, epi);
        }
    }
}

struct EpiF32 {
    float* C; int ldc; int Nc;
    __device__ __forceinline__ void operator()(int m, int n, f32x4 v) const {
        if (n < Nc) *(float4*)(C + (size_t)m * ldc + n) = make_float4(v[0], v[1], v[2], v[3]);
    }
    __device__ __forceinline__ void finish(int, int) const {}
};

struct EpiProj {
    unsigned char* ws;
    __device__ __forceinline__ void operator()(int m, int n, f32x4 v) const {
        const int ct = n >> 7;
        if (ct < 4) {
            uint2 o; o.x = pack2bf(v[0], v[1]); o.y = pack2bf(v[2], v[3]);
            *(uint2*)((bf16_t*)(ws + OFF_HQ) + (size_t)m * 512 + n) = o;
        } else if (ct < 8) {
            const int c = n - 512;
            const float4 lb = *(const float4*)((const float*)(ws + OFF_LBV) + c);
            float4 o;
            o.x = logf(lb.x + (1.f - lb.x) * sigmoidf_(v[0])); o.y = logf(lb.y + (1.f - lb.y) * sigmoidf_(v[1]));
            o.z = logf(lb.z + (1.f - lb.z) * sigmoidf_(v[2])); o.w = logf(lb.w + (1.f - lb.w) * sigmoidf_(v[3]));
            *(float4*)((float*)(ws + OFF_HLF) + (size_t)m * 512 + c) = o;
        } else if (ct < 12) {
            uint2 o; o.x = pack2bf(v[0], v[1]); o.y = pack2bf(v[2], v[3]);
            *(uint2*)((bf16_t*)(ws + OFF_HI) + (size_t)m * 512 + (n - 1024)) = o;
        } else if (ct < 16) {
            uint2 o; o.x = pack2bf(v[0], v[1]); o.y = pack2bf(v[2], v[3]);
            *(uint2*)((bf16_t*)(ws + OFF_HG) + (size_t)m * 512 + (n - 1536)) = o;
        } else if (ct < 20) {
            const float qs_ = 0.125f * 1.4426950408889634f;
            uint2 o; o.x = pack2bf(qs_ * v[0], qs_ * v[1]); o.y = pack2bf(qs_ * v[2], qs_ * v[3]);
            *(uint2*)((bf16_t*)(ws + OFF_NQ) + (size_t)m * 512 + (n - 2048)) = o;
        } else if (ct < 26) {
            uint2 o; o.x = pack2bf(v[0], v[1]); o.y = pack2bf(v[2], v[3]);
            *(uint2*)((bf16_t*)(ws + OFF_KV + (size_t)(ct - 20) * KV_STRIDE) + (size_t)m * 128 + (n & 127)) = o;
        } else {
            const int c = n - 3328;
            if (c < 24)
                *(float4*)((float*)(ws + OFF_NGATE) + (size_t)m * 24 + c) =
                    make_float4(sigmoidf_(v[0]), sigmoidf_(v[1]), sigmoidf_(v[2]), sigmoidf_(v[3]));
        }
    }
    __device__ __forceinline__ void finish(int, int) const {}
};
struct EpiY {
    const float* x; float* y;
    __device__ __forceinline__ void operator()(int m, int n, f32x4 v) const {
        const float4 xv = *(const float4*)(x + (size_t)m * DM + n);
        *(float4*)(y + (size_t)m * DM + n) = make_float4(ALPHA * xv.x + v[0], ALPHA * xv.y + v[1], ALPHA * xv.z + v[2], ALPHA * xv.w + v[3]);
    }
    __device__ __forceinline__ void finish(int, int) const {}
};

__device__ __forceinline__ uint4 pack8bf(const float* v) {
    uint4 o;
    o.x = pack2bf(v[0], v[1]); o.y = pack2bf(v[2], v[3]); o.z = pack2bf(v[4], v[5]); o.w = pack2bf(v[6], v[7]);
    return o;
}

__device__ __forceinline__ void hgrn_passA(const Params& p, int chunk, unsigned char* smem) {
    const int c = chunk & 127, bh = chunk >> 7, h = bh & 3, b = bh >> 2;
    const int tid = opaque_tid(), d = tid & 127, hf = __builtin_amdgcn_readfirstlane(tid >> 7), lane = tid & 63, w = __builtin_amdgcn_readfirstlane(tid >> 6);
    const size_t tok0 = (size_t)b * SEQ + (size_t)c * 64 + 32 * hf;
    const float* HLF = (const float*)(p.ws + OFF_HLF);
    const bf16_t* HI = (const bf16_t*)(p.ws + OFF_HI);
    unsigned char* KT = smem;
    unsigned char* VT = smem + 16384;
    float* xch = (float*)(smem + 32768);
    const float* lfp = HLF + tok0 * 512 + h * 128 + d;
    const bf16_t* vp = HI + tok0 * 512 + h * 128 + d;
    float run = 0.f;
#pragma unroll 8
    for (int s = 0; s < 32; ++s) run += lfp[s * 512];
    __syncthreads();
    xch[hf * 128 + d] = run;
    __syncthreads();
    const float tot0 = xch[d], tot1 = xch[128 + d];
    const float blast = tot0 + tot1;
    run = hf ? tot0 : 0.f;
#pragma unroll 1
    for (int q = 0; q < 4; ++q) {
        float kv[8], vv[8];
#pragma unroll
        for (int j = 0; j < 8; ++j) {
            const int s = q * 8 + j;
            const float lf = lfp[s * 512];
            run += lf;
            kv[j] = (1.f - expf(lf)) * expf(blast - run);
            vv[j] = bf2f(vp[s * 512]);
        }
        const int ch = 4 * hf + q;
        *(uint4*)(KT + d * 128 + ((ch ^ (d & 7)) << 4)) = pack8bf(kv);
        *(uint4*)(VT + d * 128 + ((ch ^ (d & 7)) << 4)) = pack8bf(vv);
    }
    if (hf) ((float*)(p.ws + OFF_DC))[(size_t)chunk * 128 + d] = expf(blast);
    __syncthreads();
    f32x4 acc[2][8];
#pragma unroll
    for (int i = 0; i < 2; ++i)
#pragma unroll
        for (int et = 0; et < 8; ++et) acc[i][et] = (f32x4){0.f, 0.f, 0.f, 0.f};
#pragma unroll
    for (int st = 0; st < 2; ++st) {
        const int ch = st * 4 + (lane >> 4);
        bf16x8 af[2];
#pragma unroll
        for (int i = 0; i < 2; ++i) {
            const int row = (2 * w + i) * 16 + (lane & 15);
            af[i] = *(const bf16x8*)(KT + row * 128 + ((ch ^ (row & 7)) << 4));
        }
#pragma unroll
        for (int et = 0; et < 8; ++et) {
            const int row = et * 16 + (lane & 15);
            const bf16x8 bfv = *(const bf16x8*)(VT + row * 128 + ((ch ^ (row & 7)) << 4));
            acc[0][et] = __builtin_amdgcn_mfma_f32_16x16x32_bf16(af[0], bfv, acc[0][et], 0, 0, 0);
            acc[1][et] = __builtin_amdgcn_mfma_f32_16x16x32_bf16(af[1], bfv, acc[1][et], 0, 0, 0);
        }
    }
    float* HC = p.out + (size_t)chunk * 16384;
#pragma unroll
    for (int i = 0; i < 2; ++i)
#pragma unroll
        for (int et = 0; et < 8; ++et) {
            const int e = et * 16 + (lane & 15), d0 = (2 * w + i) * 16 + (lane >> 4) * 4;
            *(float4*)(HC + e * 128 + d0) = make_float4(acc[i][et][0], acc[i][et][1], acc[i][et][2], acc[i][et][3]);
        }
}

__device__ __forceinline__ void hgrn_scan_item(const Params& p, int item) {
    const int gid = item * 256 + threadIdx.x;
    const int d4 = gid & 31, e = (gid >> 5) & 127, bh = gid >> 12;
    const float* HC = p.out;
    const float* DC = (const float*)(p.ws + OFF_DC);
    bf16_t* SC = (bf16_t*)(p.ws + OFF_SC);
    float4 S = make_float4(0.f, 0.f, 0.f, 0.f);
#pragma unroll 4
    for (int c = 0; c < 128; ++c) {
        const size_t base = ((size_t)(bh * 128 + c) * 128 + e) * 128 + d4 * 4;
        const float4 H = *(const float4*)(HC + base);
        const float4 dc = *(const float4*)(DC + (size_t)(bh * 128 + c) * 128 + d4 * 4);
        uint2 o; o.x = pack2bf(S.x, S.y); o.y = pack2bf(S.z, S.w);
        *(uint2*)(SC + base) = o;
        S.x = dc.x * S.x + H.x; S.y = dc.y * S.y + H.y; S.z = dc.z * S.z + H.z; S.w = dc.w * S.w + H.w;
    }
}

__device__ __forceinline__ void hgrn_passC(const Params& p, int chunk, unsigned char* smem) {
    const int c = chunk & 127, bh = chunk >> 7, h = bh & 3, b = bh >> 2;
    const int tid = opaque_tid(), d = tid & 127, hf = __builtin_amdgcn_readfirstlane(tid >> 7), lane = tid & 63, w = __builtin_amdgcn_readfirstlane(tid >> 6);
    const size_t tokc = (size_t)b * SEQ + (size_t)c * 64;
    const size_t tok0 = tokc + 32 * hf;
    const float* HLF = (const float*)(p.ws + OFF_HLF);
    const bf16_t* HQ = (const bf16_t*)(p.ws + OFF_HQ);
    const bf16_t* HI = (const bf16_t*)(p.ws + OFF_HI);
    const bf16_t* HG = (const bf16_t*)(p.ws + OFF_HG);
    unsigned char* R0 = smem;
    unsigned char* R1 = smem + 16384;
    unsigned char* R2 = smem + 57344;
    float* xch = (float*)R2;
    const float* lfp = HLF + tok0 * 512 + h * 128 + d;
    const bf16_t* qp = HQ + tok0 * 512 + h * 128 + d;
    float run = 0.f, b15 = 0.f;
#pragma unroll 8
    for (int s = 0; s < 32; ++s) { run += lfp[s * 512]; if (s == 15) b15 = run; }
    __syncthreads();
    xch[hf * 128 + d] = run;
    if (hf == 0) xch[256 + d] = b15;
    __syncthreads();
    const float tot0 = xch[d];
    const float off = hf ? tot0 : 0.f;
    const float r1 = xch[256 + d], r2 = tot0;
    if (hf) xch[384 + d] = off + b15;
    run = off;
#pragma unroll 8
    for (int s = 0; s < 32; ++s) {
        const int t = 32 * hf + s;
        run += lfp[s * 512];
        const float qv = bf2f(qp[s * 512]);
        *(bf16_t*)(R0 + t * 256 + ((((d >> 3) ^ (t & 15))) << 4) + (d & 7) * 2) = (bf16_t)f2bf(qv * expf(run));
    }
    {
        const bf16_t* SCp = (const bf16_t*)(p.ws + OFF_SC) + (size_t)chunk * 16384;
#pragma unroll
        for (int i = 0; i < 8; ++i) {
            const int cc = tid + 256 * i, row = cc >> 4, ch = cc & 15;
            *(uint4*)(R1 + row * 256 + ((ch ^ (row & 15)) << 4)) = *(const uint4*)(SCp + row * 128 + ch * 8);
        }
    }
    __syncthreads();
    f32x4 acc[8];
#pragma unroll
    for (int et = 0; et < 8; ++et) acc[et] = (f32x4){0.f, 0.f, 0.f, 0.f};
#pragma unroll
    for (int ds = 0; ds < 4; ++ds) {
        const int ch = ds * 4 + (lane >> 4);
        const int trow = w * 16 + (lane & 15);
        const bf16x8 bq = *(const bf16x8*)(R0 + trow * 256 + ((ch ^ (trow & 15)) << 4));
#pragma unroll
        for (int et = 0; et < 8; ++et) {
            const int row = et * 16 + (lane & 15);
            const bf16x8 av = *(const bf16x8*)(R1 + row * 256 + ((ch ^ (row & 15)) << 4));
            acc[et] = __builtin_amdgcn_mfma_f32_16x16x32_bf16(av, bq, acc[et], 0, 0, 0);
        }
    }
    __syncthreads();
    {
        const float r3 = xch[384 + d];
        run = off;
#pragma unroll 2
        for (int s = 0; s < 32; ++s) {
            const int t = 32 * hf + s;
            const int it = t >> 4;
            const float rr = (it == 0) ? 0.f : (it == 1) ? r1 : (it == 2) ? r2 : r3;
            const int sw = (((d >> 3) ^ (t & 15)) << 4) + (d & 7) * 2;
            const float lf = lfp[s * 512];
            run += lf;
            const float qv = bf2f(qp[s * 512]);
            const float kv = 1.f - expf(lf);
            *(bf16_t*)(R0 + t * 256 + sw) = (bf16_t)f2bf(qv * expf(run - rr));
#pragma unroll
            for (int i = 0; i < 4; ++i) {
                if (i >= it) {
                    const float ri = (i == 0) ? 0.f : (i == 1) ? r1 : (i == 2) ? r2 : r3;
                    const int R = 8 * i * (i + 1) + t;
                    *(bf16_t*)(R1 + R * 256 + sw) = (bf16_t)f2bf(kv * expf(ri - run));
                }
            }
        }
    }
    __syncthreads();
#pragma unroll
    for (int j = 0; j < 4; ++j) {
        uint2 o = make_uint2(0u, 0u);
        if (j <= w) {
            f32x4 pa = (f32x4){0.f, 0.f, 0.f, 0.f};
#pragma unroll
            for (int ds = 0; ds < 4; ++ds) {
                const int ch = ds * 4 + (lane >> 4);
                const int krow = 8 * w * (w + 1) + 16 * j + (lane & 15);
                const int trow = w * 16 + (lane & 15);
                const bf16x8 av = *(const bf16x8*)(R1 + krow * 256 + ((ch ^ (krow & 15)) << 4));
                const bf16x8 bq = *(const bf16x8*)(R0 + trow * 256 + ((ch ^ (trow & 15)) << 4));
                pa = __builtin_amdgcn_mfma_f32_16x16x32_bf16(av, bq, pa, 0, 0, 0);
            }
            if (j == w) {
                const int tl = lane & 15, sl = (lane >> 4) * 4;
#pragma unroll
                for (int r = 0; r < 4; ++r) if (sl + r > tl) pa[r] = 0.f;
            }
            o.x = pack2bf(pa[0], pa[1]); o.y = pack2bf(pa[2], pa[3]);
        }
        const int t = w * 16 + (lane & 15);
        const int ch = 2 * j + (lane >> 5);
        *(uint2*)(R2 + t * 128 + ((ch ^ (t & 7)) << 4) + ((lane >> 4) & 1) * 8) = o;
    }
    __syncthreads();
#pragma unroll
    for (int q = 0; q < 4; ++q) {
        float vv[8];
#pragma unroll
        for (int j = 0; j < 8; ++j) vv[j] = bf2f(HI[(tok0 + q * 8 + j) * 512 + h * 128 + d]);
        const int ch = 4 * hf + q;
        *(uint4*)(R1 + d * 128 + ((ch ^ (d & 7)) << 4)) = pack8bf(vv);
    }
    __syncthreads();
#pragma unroll
    for (int st = 0; st < 2; ++st) {
        const int ch = st * 4 + (lane >> 4);
        const int trow = w * 16 + (lane & 15);
        const bf16x8 bp = *(const bf16x8*)(R2 + trow * 128 + ((ch ^ (trow & 7)) << 4));
#pragma unroll
        for (int et = 0; et < 8; ++et) {
            const int row = et * 16 + (lane & 15);
            const bf16x8 av = *(const bf16x8*)(R1 + row * 128 + ((ch ^ (row & 7)) << 4));
            acc[et] = __builtin_amdgcn_mfma_f32_16x16x32_bf16(av, bp, acc[et], 0, 0, 0);
        }
    }
    {
        float ss = 0.f;
#pragma unroll
        for (int et = 0; et < 8; ++et)
#pragma unroll
            for (int r = 0; r < 4; ++r) ss += acc[et][r] * acc[et][r];
        ss += __shfl_xor(ss, 16);
        ss += __shfl_xor(ss, 32);
        const float rs = rsqrtf(ss * (1.f / 128.f) + LN_EPS);
        const size_t tok = tokc + w * 16 + (lane & 15);
        const float* ng = p.in[4];
        bf16_t* MIX = (bf16_t*)(p.ws + OFF_XB);
#pragma unroll
        for (int et = 0; et < 8; ++et) {
            const int e0 = et * 16 + (lane >> 4) * 4;
            const uint2 gb = *(const uint2*)(HG + tok * 512 + h * 128 + e0);
            const float4 n4 = *(const float4*)(ng + e0);
            const float g0 = bf2f(gb.x & 0xffffu), g1 = bf2f(gb.x >> 16), g2 = bf2f(gb.y & 0xffffu), g3 = bf2f(gb.y >> 16);
            uint2 o;
            o.x = pack2bf(acc[et][0] * rs * n4.x * (g0 * sigmoidf_(g0)), acc[et][1] * rs * n4.y * (g1 * sigmoidf_(g1)));
            o.y = pack2bf(acc[et][2] * rs * n4.z * (g2 * sigmoidf_(g2)), acc[et][3] * rs * n4.w * (g3 * sigmoidf_(g3)));
            *(uint2*)(MIX + tok * DM + h * 128 + e0) = o;
        }
    }
}

__device__ __forceinline__ void compress_item(const Params& p, int item, float* sm) {
    const int g = item & 1;
    int r = item >> 1;
    const int n = r % NCB; r /= NCB;
    const int b = r & 3, which = r >> 2;
    const int tid = opaque_tid();
    const bf16_t* kvsrc = (const bf16_t*)(p.ws + OFF_KV + (size_t)which * KV_STRIDE);
    const float* pe = p.in[which ? 10 : 5];
    const float* w1 = p.in[which ? 11 : 6];
    const float* b1 = p.in[which ? 12 : 7];
    const float* w2 = p.in[which ? 13 : 8];
    const float* b2 = p.in[which ? 14 : 9];
    float* outp = (float*)(p.ws + (which ? OFF_CMPV : OFF_CMPK));
    float* blk = sm;
    float* hh = sm + 2048;
    __syncthreads();
    for (int i = tid; i < 2048; i += 256) {
        const int l = i >> 6, d = i & 63;
        blk[i] = bf2f(kvsrc[(size_t)(b * SEQ + 16 * n + l) * 128 + g * 64 + d]) + pe[i];
    }
    __syncthreads();
    float acc = b1[tid];
    for (int i = 0; i < 2048; ++i) acc += blk[i] * w1[(size_t)i * 256 + tid];
    hh[tid] = gelu_tanh(acc);
    __syncthreads();
    if (tid < 64) {
        float o = b2[tid];
        for (int j = 0; j < 256; ++j) o += hh[j] * w2[j * 64 + tid];
        outp[((size_t)(b * NCB + n) * 2 + g) * 64 + tid] = o;
    }
}

__device__ __forceinline__ float dot64_bf(const float* qs, const bf16_t* krow) {
    float s = 0.f;
#pragma unroll
    for (int i = 0; i < 8; ++i) {
        const uint4 kv = ((const uint4*)krow)[i];
        const float4 q0 = ((const float4*)qs)[2 * i], q1 = ((const float4*)qs)[2 * i + 1];
        s += __uint_as_float(kv.x << 16) * q0.x + __uint_as_float(kv.x & 0xffff0000u) * q0.y
           + __uint_as_float(kv.y << 16) * q0.z + __uint_as_float(kv.y & 0xffff0000u) * q0.w
           + __uint_as_float(kv.z << 16) * q1.x + __uint_as_float(kv.z & 0xffff0000u) * q1.y
           + __uint_as_float(kv.w << 16) * q1.z + __uint_as_float(kv.w & 0xffff0000u) * q1.w;
    }
    return s;
}
__device__ __forceinline__ float dot64(const float* qs, const float* krow) {
    float s = 0.f;
#pragma unroll
    for (int i = 0; i < 16; ++i) {
        const float4 kv = ((const float4*)krow)[i];
        const float4 qv = ((const float4*)qs)[i];
        s += kv.x * qv.x + kv.y * qv.y + kv.z * qv.z + kv.w * qv.w;
    }
    return s;
}

__device__ __forceinline__ void nsa_item(const Params& p, int item, float* sm) {
    const int t = item & (SEQ - 1), g = (item >> 13) & 1, b = item >> 14;
    const int tid = threadIdx.x, lane = tid & 63, r = tid >> 6;
    float* sc = sm + r * 1024;
    float* qs = sm + 4096 + r * 64;
    float* impv = sm + 4096 + 256;
    int* sel = (int*)(sm + 4096 + 256 + 128);
    const bf16_t* KSb = (const bf16_t*)(p.ws + OFF_KV + 2 * KV_STRIDE);
    const bf16_t* VSb = (const bf16_t*)(p.ws + OFF_KV + 3 * KV_STRIDE);
    const bf16_t* KWb = (const bf16_t*)(p.ws + OFF_KV + 4 * KV_STRIDE);
    const bf16_t* VWb = (const bf16_t*)(p.ws + OFF_KV + 5 * KV_STRIDE);
    const float* cmpk = (const float*)(p.ws + OFF_CMPK);
    const float* cmpv = (const float*)(p.ws + OFF_CMPV);
    const size_t n = (size_t)b * SEQ + t;
    const float NEGV = -1e30f;
    __syncthreads();
    qs[lane] = bf2f(((const bf16_t*)(p.ws + OFF_NQ))[n * 512 + g * 256 + r * 64 + lane]) * 0.6931471805599453f;
    __syncthreads();

    const int nvalid = (t >= 31) ? (((t - 31) >> 4) + 1) : 0;
    float m = NEGV;
    for (int n0 = 0; n0 < nvalid; n0 += 64) {
        const int nn = n0 + lane;
        if (nn < nvalid) {
            const float s = dot64(qs, cmpk + ((size_t)(b * NCB + nn) * 2 + g) * 64);
            sc[nn] = s;
            m = fmaxf(m, s);
        }
    }
    m = wave_max(m);
    float sum = 0.f;
    for (int n0 = 0; n0 < nvalid; n0 += 64) {
        const int nn = n0 + lane;
        if (nn < nvalid) { const float e = expf(sc[nn] - m); sc[nn] = e; sum += e; }
    }
    sum = wave_sum(sum);
    {
        const float inv = 1.f / fmaxf(sum, 1e-30f);
        for (int n0 = 0; n0 < nvalid; n0 += 64) {
            const int nn = n0 + lane;
            if (nn < nvalid) sc[nn] *= inv;
        }
    }
    __syncthreads();
    float oc = 0.f;
    for (int nn = 0; nn < nvalid; ++nn) oc += sc[nn] * cmpv[((size_t)(b * NCB + nn) * 2 + g) * 64 + lane];

    const int cur = t >> 6;
    if (tid < 128) {
        const int j = tid;
        float im = 0.f;
#pragma unroll
        for (int rr = 0; rr < 4; ++rr) {
            const float* P = sm + rr * 1024;
            const int n4 = 4 * j;
            float a = 0.f;
            if (n4 < nvalid) a += P[n4];
            if (n4 + 1 < nvalid) a += P[n4 + 1];
            if (n4 + 2 < nvalid) a += P[n4 + 2];
            if (n4 + 3 < nvalid) a += 0.5f * P[n4 + 3];
            if (n4 - 1 >= 0 && n4 - 1 < nvalid) a += 0.5f * P[n4 - 1];
            im += a;
        }
        const bool forced = (j == 0) || (j == cur) || (j == cur - 1);
        const bool causal = (j <= cur);
        impv[j] = forced ? 1.0e4f : (causal ? im : -1.f);
    }
    __syncthreads();
    if (r == 0) {
        float v0 = impv[lane], v1 = impv[lane + 64];
        for (int k = 0; k < 16; ++k) {
            const float mx = wave_max(fmaxf(v0, v1));
            const unsigned long long b0 = __ballot(v0 == mx);
            int idx;
            if (b0) {
                const int l = __ffsll((unsigned long long)b0) - 1;
                idx = l;
                if (lane == l) v0 = -3.0e38f;
            } else {
                const unsigned long long b1 = __ballot(v1 == mx);
                const int l = __ffsll((unsigned long long)b1) - 1;
                idx = 64 + l;
                if (lane == l) v1 = -3.0e38f;
            }
            if (lane == 0) sel[k] = idx;
        }
    }
    __syncthreads();

    m = NEGV;
    for (int si = 0; si < 16; ++si) {
        const int blk = sel[si];
        const int key = blk * 64 + lane;
        float s = NEGV;
        if (blk * 64 <= t) {
            if (key <= t) s = dot64_bf(qs, KSb + ((size_t)b * SEQ + key) * 128 + g * 64);
        }
        sc[si * 64 + lane] = s;
        m = fmaxf(m, s);
    }
    m = wave_max(m);
    sum = 0.f;
    for (int si = 0; si < 16; ++si) {
        const int key = sel[si] * 64 + lane;
        const float e = (key <= t) ? expf(sc[si * 64 + lane] - m) : 0.f;
        sc[si * 64 + lane] = e;
        sum += e;
    }
    sum = wave_sum(sum);
    {
        const float inv = 1.f / fmaxf(sum, 1e-30f);
        for (int si = 0; si < 16; ++si) sc[si * 64 + lane] *= inv;
    }
    __syncthreads();
    float os = 0.f;
    for (int si = 0; si < 16; ++si) {
        const int blk = sel[si];
        if (blk * 64 > t) continue;
        for (int kk = 0; kk < 64; ++kk) {
            const int key = blk * 64 + kk;
            if (key > t) break;
            os += sc[si * 64 + kk] * bf2f(VSb[((size_t)b * SEQ + key) * 128 + g * 64 + lane]);
        }
    }
    __syncthreads();

    const int lo = t - 511;
    m = NEGV;
    for (int i = 0; i < 8; ++i) {
        const int key = lo + i * 64 + lane;
        float s = NEGV;
        if (key >= 0) s = dot64_bf(qs, KWb + ((size_t)b * SEQ + key) * 128 + g * 64);
        sc[i * 64 + lane] = s;
        m = fmaxf(m, s);
    }
    m = wave_max(m);
    sum = 0.f;
    for (int i = 0; i < 8; ++i) {
        const int key = lo + i * 64 + lane;
        const float e = (key >= 0) ? expf(sc[i * 64 + lane] - m) : 0.f;
        sc[i * 64 + lane] = e;
        sum += e;
    }
    sum = wave_sum(sum);
    {
        const float inv = 1.f / fmaxf(sum, 1e-30f);
        for (int i = 0; i < 8; ++i) sc[i * 64 + lane] *= inv;
    }
    __syncthreads();
    float ow = 0.f;
    for (int idx = 0; idx < 512; ++idx) {
        const int key = lo + idx;
        if (key < 0) continue;
        ow += sc[idx] * bf2f(VWb[((size_t)b * SEQ + key) * 128 + g * 64 + lane]);
    }
    const float* grow = (const float*)(p.ws + OFF_NGATE) + n * 24 + g * 12 + r * 3;
    const float gc = grow[0], gs = grow[1], gw = grow[2];
#if NSA_DIAG
    {
        const float ref = gc * oc + gs * os + gw * ow;
        const float got = bf2f(((const bf16_t*)(p.ws + OFF_XB))[n * DM + 512 + g * 256 + r * 64 + lane]);
        const unsigned* SELM = (const unsigned*)(p.ws + OFF_SELM) + ((size_t)(b * 2 + g) * SEQ + t) * 4;
        unsigned gm[4] = {0u, 0u, 0u, 0u};
        for (int si = 0; si < 16; ++si) { const int blk = sel[si]; if (blk * 64 <= t) gm[blk >> 5] |= 1u << (blk & 31); }
        bool same = true;
        for (int qd = 0; qd < 4; ++qd) {
            unsigned mm = SELM[qd];
            for (int bit = 0; bit < 32; ++bit) if ((qd * 32 + bit) * 64 > t) mm &= ~(1u << bit);
            if (mm != gm[qd]) same = false;
        }
        float d2 = same ? (got - ref) * (got - ref) : 0.f, r2 = same ? ref * ref : 0.f;
        d2 = wave_sum(d2); r2 = wave_sum(r2);
        float* DG = (float*)(p.ws + OFF_DIAG);
        if (lane == 0) { atomicAdd(&DG[0], d2); atomicAdd(&DG[1], r2); if (r == 0) { atomicAdd(&DG[2], same ? 0.f : 1.f); atomicAdd(&DG[3], 1.f); } }
    }
#else
    ((bf16_t*)(p.ws + OFF_XB))[n * DM + 512 + g * 256 + r * 64 + lane] = (bf16_t)f2bf(gc * oc + gs * os + gw * ow);
#endif
}


__device__ __forceinline__ float xrow_max(float x) {
    auto s = __builtin_amdgcn_permlane16_swap(__float_as_uint(x), __float_as_uint(x), false, false);
    x = fmaxf(__uint_as_float(s[0]), __uint_as_float(s[1]));
    auto t = __builtin_amdgcn_permlane32_swap(__float_as_uint(x), __float_as_uint(x), false, false);
    return fmaxf(__uint_as_float(t[0]), __uint_as_float(t[1]));
}
__device__ __forceinline__ float xrow_sum(float x) {
    auto s = __builtin_amdgcn_permlane16_swap(__float_as_uint(x), __float_as_uint(x), false, false);
    x = __uint_as_float(s[0]) + __uint_as_float(s[1]);
    auto t = __builtin_amdgcn_permlane32_swap(__float_as_uint(x), __float_as_uint(x), false, false);
    return __uint_as_float(t[0]) + __uint_as_float(t[1]);
}
template <int CTRL> __device__ __forceinline__ float dppf(float x) {
    return __builtin_bit_cast(float, __builtin_amdgcn_mov_dpp(__builtin_bit_cast(int, x), CTRL, 0xf, 0xf, true));
}
__device__ __forceinline__ float row16_max(float m) {
    m = fmaxf(m, dppf<0x121>(m)); m = fmaxf(m, dppf<0x122>(m));
    m = fmaxf(m, dppf<0x124>(m)); m = fmaxf(m, dppf<0x128>(m));
    return m;
}
__device__ __forceinline__ float row16_sum(float m) {
    m += dppf<0x121>(m); m += dppf<0x122>(m); m += dppf<0x124>(m); m += dppf<0x128>(m);
    return m;
}
__device__ __forceinline__ float dot2bf(unsigned a, unsigned b, float acc) {
    return __builtin_amdgcn_fdot2_f32_bf16(__builtin_bit_cast(bf16x2_t, a), __builtin_bit_cast(bf16x2_t, b), acc, false);
}
__device__ __forceinline__ float enc_key(float v, unsigned idx, unsigned mask) {
    const unsigned u = __float_as_uint(v);
    const unsigned code = (u >> 31) ? idx : (mask - idx);
    return __uint_as_float((u & ~mask) | code);
}
__device__ __forceinline__ unsigned dec_idx(float key, unsigned mask) {
    const unsigned u = __float_as_uint(key);
    const unsigned code = u & mask;
    return (u >> 31) ? code : (mask - code);
}
__device__ __forceinline__ float dec_val(float key, unsigned mask) { return __uint_as_float(__float_as_uint(key) & ~mask); }
#define NEGKEY (-3.0e38f)
#define CE_DESC(a, b) { const float t_ = fmaxf(a, b); b = fminf(a, b); a = t_; }

struct EpiCmpH {
    bf16_t* HB; const float* peb;
    __device__ __forceinline__ void operator()(int m, int n, f32x4 v) const {
        const float4 pb = *(const float4*)(peb + n);
        uint2 o;
        o.x = pack2bf(gelu_tanh(v[0] + pb.x), gelu_tanh(v[1] + pb.y));
        o.y = pack2bf(gelu_tanh(v[2] + pb.z), gelu_tanh(v[3] + pb.w));
        *(uint2*)(HB + (size_t)m * 256 + n) = o;
    }
    __device__ __forceinline__ void finish(int, int) const {}
};
__device__ __forceinline__ void cmp_peb(const Params& p, int which) {
    const float* pe = p.in[which ? 10 : 5];
    const float* w1 = p.in[which ? 11 : 6];
    const float* b1 = p.in[which ? 12 : 7];
    const int j = threadIdx.x;
    float acc = b1[j];
    for (int i = 0; i < 2048; ++i) acc += pe[i] * w1[(size_t)i * 256 + j];
    ((float*)(p.ws + OFF_PEB))[which * 256 + j] = acc;
}
__device__ __forceinline__ void cmp_layer2_phase(const Params& p, int first_block, int nblocks) {
    const int tid_ = opaque_tid(), lane = tid_ & 63, w = __builtin_amdgcn_readfirstlane(tid_ >> 6);
    for (int it = (blockIdx.x - first_block) * 4 + w; it < 2 * 4088; it += nblocks * 4) {
        const int which = it >= 4088, row = which ? it - 4088 : it;
        const float* w2 = p.in[which ? 13 : 8];
        const float* b2 = p.in[which ? 14 : 9];
        const bf16_t* hrow = (const bf16_t*)(p.ws + OFF_HB) + ((size_t)which * 4096 + row) * 256;
        float o = b2[lane];
#pragma unroll 8
        for (int j = 0; j < 256; ++j) o += bf2f(hrow[j]) * w2[j * 64 + lane];
        const int g = row & 1, bn = row >> 1, n = bn % NCB, b = bn / NCB;
        ((bf16_t*)(p.ws + (which ? OFF_CMPVB : OFF_CMPKB)))[((size_t)(b * 2 + g) * 512 + n) * 64 + lane] = (bf16_t)f2bf(o);
    }
}

struct StageOfs { int k, v; };
__device__ __forceinline__ StageOfs make_stage_ofs() {
    const int c0 = opaque_tid(), key = c0 >> 3, ch = c0 & 7;
    StageOfs s;
    s.k = key * 128 + ((ch ^ (key & 7)) << 4);
    s.v = key * 128 + (((ch >> 1) ^ ((key >> 1) & 3)) << 5) + (ch & 1) * 16;
    return s;
}
#define NSA_KV_LOAD(S_, kb_) { const bf16_t* kp_ = Kbase + (size_t)(kb_) * 64 * stride + (size_t)(tid >> 3) * stride + (tid & 7) * 8; \
        const bf16_t* vp_ = Vbase + (size_t)(kb_) * 64 * stride + (size_t)(tid >> 3) * stride + (tid & 7) * 8;                 \
        S_##k0 = *(const uint4*)kp_; S_##k1 = *(const uint4*)(kp_ + (size_t)32 * stride);                                    \
        S_##v0 = *(const uint4*)vp_; S_##v1 = *(const uint4*)(vp_ + (size_t)32 * stride); }
#define NSA_KV_STORE(S_, Kl_, Vl_) { *(uint4*)((Kl_) + sof.k) = S_##k0; *(uint4*)((Kl_) + sof.k + 4096) = S_##k1; \
        *(uint4*)((Vl_) + sof.v) = S_##v0; *(uint4*)((Vl_) + sof.v + 4096) = S_##v1; }
template <class Compute>
__device__ __forceinline__ void nsa_kv_loop(const bf16_t* __restrict__ Kbase, const bf16_t* __restrict__ Vbase, int stride,
                                            int kb_lo, int kb_hi, unsigned char* smem, const StageOfs& sof, Compute compute) {
    const int tid = opaque_tid();
    uint4 ra_k0, ra_k1, ra_v0, ra_v1, rb_k0, rb_k1, rb_v0, rb_v1;
    NSA_KV_LOAD(ra_, kb_lo)
    NSA_KV_LOAD(rb_, (kb_lo + 1 <= kb_hi) ? kb_lo + 1 : kb_lo)
    __syncthreads();
    NSA_KV_STORE(ra_, smem, smem + 16384)
    __syncthreads();
    int kb = kb_lo;
    while (kb <= kb_hi) {
        if (kb + 2 <= kb_hi) NSA_KV_LOAD(ra_, kb + 2)
        compute(kb, smem, smem + 16384);
        if (kb + 1 <= kb_hi) NSA_KV_STORE(rb_, smem + 8192, smem + 16384 + 8192)
        __syncthreads();
        if (++kb > kb_hi) break;
        if (kb + 2 <= kb_hi) NSA_KV_LOAD(rb_, kb + 2)
        compute(kb, smem + 8192, smem + 16384 + 8192);
        if (kb + 1 <= kb_hi) NSA_KV_STORE(ra_, smem, smem + 16384)
        __syncthreads();
        ++kb;
    }
}
struct LaneOfs { int k0, k1, vb0, vb1, vb2, vb3; };
__device__ __forceinline__ LaneOfs make_lane_ofs(int lane) {
    LaneOfs f;
    const int r15 = lane & 15, lg = lane >> 4, q = r15 >> 2, pp = r15 & 3;
    f.k0 = r15 * 128 + ((lg ^ (r15 & 7)) << 4);
    f.k1 = r15 * 128 + (((4 + lg) ^ (r15 & 7)) << 4);
    const int sw2 = (2 * (lg & 1) + (q >> 1)) & 3;
    const int vrow = (4 * lg + q) * 128 + pp * 8;
    f.vb0 = vrow + ((0 ^ sw2) << 5); f.vb1 = vrow + ((1 ^ sw2) << 5);
    f.vb2 = vrow + ((2 ^ sw2) << 5); f.vb3 = vrow + ((3 ^ sw2) << 5);
    return f;
}
typedef short s16x4 __attribute__((ext_vector_type(4)));
__device__ __forceinline__ uint2 tr_read(const unsigned char* p) {
    const s16x4 v = __builtin_amdgcn_ds_read_tr16_b64_v4i16((LAS3 s16x4*)p);
    return __builtin_bit_cast(uint2, v);
}
#define NEGM (-1.0e37f)
__device__ __forceinline__ void nsa_scores(const unsigned char* Kl, const LaneOfs& f, const bf16x8& q0, const bf16x8& q1, float bias, f32x4 (&s)[4]) {
#pragma unroll
    for (int kt = 0; kt < 4; ++kt) {
        const bf16x8 a0 = *(const bf16x8*)(Kl + f.k0 + kt * 2048);
        const bf16x8 a1 = *(const bf16x8*)(Kl + f.k1 + kt * 2048);
        f32x4 z = (f32x4){bias, bias, bias, bias};
        z = __builtin_amdgcn_mfma_f32_16x16x32_bf16(a0, q0, z, 0, 0, 0);
        s[kt] = __builtin_amdgcn_mfma_f32_16x16x32_bf16(a1, q1, z, 0, 0, 0);
    }
}
template <class VF>
__device__ __forceinline__ void attn_step(const unsigned char* Kl, const unsigned char* Vl, int lane, const LaneOfs& f,
                                          const bf16x8& q0, const bf16x8& q1, f32x4 (&o)[4], float& m, float& l,
                                          float rowbias, bool full, VF valid) {
    f32x4 s[4];
    nsa_scores(Kl, f, q0, q1, rowbias, s);
    if (!full) {
#pragma unroll
        for (int kt = 0; kt < 4; ++kt)
#pragma unroll
            for (int r = 0; r < 4; ++r) s[kt][r] = valid(kt * 16 + 4 * (lane >> 4) + r) ? s[kt][r] : NEGM;
    }
    float mx = fmaxf(fmaxf(fmaxf(s[0][0], s[0][1]), fmaxf(s[0][2], s[0][3])), fmaxf(fmaxf(s[1][0], s[1][1]), fmaxf(s[1][2], s[1][3])));
    mx = fmaxf(mx, fmaxf(fmaxf(fmaxf(s[2][0], s[2][1]), fmaxf(s[2][2], s[2][3])), fmaxf(fmaxf(s[3][0], s[3][1]), fmaxf(s[3][2], s[3][3]))));
    mx = xrow_max(mx);
    if (!__all(mx <= m + 8.f)) {
        const float mn = fmaxf(m, mx);
        const float alpha = __builtin_amdgcn_exp2f(m - mn);
        l *= alpha; m = mn;
#pragma unroll
        for (int dt = 0; dt < 4; ++dt) { o[dt][0] *= alpha; o[dt][1] *= alpha; o[dt][2] *= alpha; o[dt][3] *= alpha; }
    }
    float ps = 0.f;
#pragma unroll
    for (int kt = 0; kt < 4; ++kt)
#pragma unroll
        for (int r = 0; r < 4; ++r) { const float pv = __builtin_amdgcn_exp2f(s[kt][r] - m); s[kt][r] = pv; ps += pv; }
    l += ps;
#pragma unroll
    for (int k2 = 0; k2 < 2; ++k2) {
        uint4 pk;
        pk.x = pack2bf(s[2 * k2][0], s[2 * k2][1]); pk.y = pack2bf(s[2 * k2][2], s[2 * k2][3]);
        pk.z = pack2bf(s[2 * k2 + 1][0], s[2 * k2 + 1][1]); pk.w = pack2bf(s[2 * k2 + 1][2], s[2 * k2 + 1][3]);
        const bf16x8 pb = __builtin_bit_cast(bf16x8, pk);
#define PV1(dt_, vb_) { const uint2 lo_ = tr_read(Vl + (vb_) + k2 * 4096), hi_ = tr_read(Vl + (vb_) + k2 * 4096 + 2048); \
                        uint4 av_; av_.x = lo_.x; av_.y = lo_.y; av_.z = hi_.x; av_.w = hi_.y;                          \
                        o[dt_] = __builtin_amdgcn_mfma_f32_16x16x32_bf16(__builtin_bit_cast(bf16x8, av_), pb, o[dt_], 0, 0, 0); }
        PV1(0, f.vb0) PV1(1, f.vb1) PV1(2, f.vb2) PV1(3, f.vb3)
#undef PV1
    }
}
template <class VFA, class VFB>
__device__ __forceinline__ void attn_step2(const unsigned char* Kl, const unsigned char* Vl, int lane, const LaneOfs& f,
                                           const bf16x8& qA0, const bf16x8& qA1, f32x4 (&oA)[4], float& mA, float& lA, float biasA, bool fullA, VFA validA,
                                           const bf16x8& qB0, const bf16x8& qB1, f32x4 (&oB)[4], float& mB, float& lB, float biasB, bool fullB, VFB validB) {
    f32x4 sA[4], sB[4];
#pragma unroll
    for (int kt = 0; kt < 4; ++kt) {
        const bf16x8 a0 = *(const bf16x8*)(Kl + f.k0 + kt * 2048);
        const bf16x8 a1 = *(const bf16x8*)(Kl + f.k1 + kt * 2048);
        f32x4 zA = (f32x4){biasA, biasA, biasA, biasA}, zB = (f32x4){biasB, biasB, biasB, biasB};
        zA = __builtin_amdgcn_mfma_f32_16x16x32_bf16(a0, qA0, zA, 0, 0, 0);
        zB = __builtin_amdgcn_mfma_f32_16x16x32_bf16(a0, qB0, zB, 0, 0, 0);
        sA[kt] = __builtin_amdgcn_mfma_f32_16x16x32_bf16(a1, qA1, zA, 0, 0, 0);
        sB[kt] = __builtin_amdgcn_mfma_f32_16x16x32_bf16(a1, qB1, zB, 0, 0, 0);
    }
    if (!fullA) {
#pragma unroll
        for (int kt = 0; kt < 4; ++kt)
#pragma unroll
            for (int r = 0; r < 4; ++r) sA[kt][r] = validA(kt * 16 + 4 * (lane >> 4) + r) ? sA[kt][r] : NEGM;
    }
    if (!fullB) {
#pragma unroll
        for (int kt = 0; kt < 4; ++kt)
#pragma unroll
            for (int r = 0; r < 4; ++r) sB[kt][r] = validB(kt * 16 + 4 * (lane >> 4) + r) ? sB[kt][r] : NEGM;
    }
    float mxA = fmaxf(fmaxf(fmaxf(sA[0][0], sA[0][1]), fmaxf(sA[0][2], sA[0][3])), fmaxf(fmaxf(sA[1][0], sA[1][1]), fmaxf(sA[1][2], sA[1][3])));
    float mxB = fmaxf(fmaxf(fmaxf(sB[0][0], sB[0][1]), fmaxf(sB[0][2], sB[0][3])), fmaxf(fmaxf(sB[1][0], sB[1][1]), fmaxf(sB[1][2], sB[1][3])));
    mxA = fmaxf(mxA, fmaxf(fmaxf(fmaxf(sA[2][0], sA[2][1]), fmaxf(sA[2][2], sA[2][3])), fmaxf(fmaxf(sA[3][0], sA[3][1]), fmaxf(sA[3][2], sA[3][3]))));
    mxB = fmaxf(mxB, fmaxf(fmaxf(fmaxf(sB[2][0], sB[2][1]), fmaxf(sB[2][2], sB[2][3])), fmaxf(fmaxf(sB[3][0], sB[3][1]), fmaxf(sB[3][2], sB[3][3]))));
    mxA = xrow_max(mxA); mxB = xrow_max(mxB);
    if (!__all((mxA <= mA + 8.f) && (mxB <= mB + 8.f))) {
        const float mnA = fmaxf(mA, mxA), mnB = fmaxf(mB, mxB);
        const float alA = __builtin_amdgcn_exp2f(mA - mnA), alB = __builtin_amdgcn_exp2f(mB - mnB);
        lA *= alA; mA = mnA; lB *= alB; mB = mnB;
#pragma unroll
        for (int dt = 0; dt < 4; ++dt) {
            oA[dt][0] *= alA; oA[dt][1] *= alA; oA[dt][2] *= alA; oA[dt][3] *= alA;
            oB[dt][0] *= alB; oB[dt][1] *= alB; oB[dt][2] *= alB; oB[dt][3] *= alB;
        }
    }
    float psA = 0.f, psB = 0.f;
#pragma unroll
    for (int kt = 0; kt < 4; ++kt)
#pragma unroll
        for (int r = 0; r < 4; ++r) {
            const float pa = __builtin_amdgcn_exp2f(sA[kt][r] - mA), pb = __builtin_amdgcn_exp2f(sB[kt][r] - mB);
            sA[kt][r] = pa; psA += pa; sB[kt][r] = pb; psB += pb;
        }
    lA += psA; lB += psB;
#pragma unroll
    for (int k2 = 0; k2 < 2; ++k2) {
        uint4 pk;
        pk.x = pack2bf(sA[2 * k2][0], sA[2 * k2][1]); pk.y = pack2bf(sA[2 * k2][2], sA[2 * k2][3]);
        pk.z = pack2bf(sA[2 * k2 + 1][0], sA[2 * k2 + 1][1]); pk.w = pack2bf(sA[2 * k2 + 1][2], sA[2 * k2 + 1][3]);
        const bf16x8 pbA = __builtin_bit_cast(bf16x8, pk);
        pk.x = pack2bf(sB[2 * k2][0], sB[2 * k2][1]); pk.y = pack2bf(sB[2 * k2][2], sB[2 * k2][3]);
        pk.z = pack2bf(sB[2 * k2 + 1][0], sB[2 * k2 + 1][1]); pk.w = pack2bf(sB[2 * k2 + 1][2], sB[2 * k2 + 1][3]);
        const bf16x8 pbB = __builtin_bit_cast(bf16x8, pk);
#define PV2(dt_, vb_) { const uint2 lo_ = tr_read(Vl + (vb_) + k2 * 4096), hi_ = tr_read(Vl + (vb_) + k2 * 4096 + 2048); \
                        uint4 av_; av_.x = lo_.x; av_.y = lo_.y; av_.z = hi_.x; av_.w = hi_.y;                          \
                        oA[dt_] = __builtin_amdgcn_mfma_f32_16x16x32_bf16(__builtin_bit_cast(bf16x8, av_), pbA, oA[dt_], 0, 0, 0); \
                        oB[dt_] = __builtin_amdgcn_mfma_f32_16x16x32_bf16(__builtin_bit_cast(bf16x8, av_), pbB, oB[dt_], 0, 0, 0); }
        PV2(0, f.vb0) PV2(1, f.vb1) PV2(2, f.vb2) PV2(3, f.vb3)
#undef PV2
    }
}

#define NSA_TILES 2048
__device__ __forceinline__ void nsa_tile(const Params& p, int tile, unsigned char* smem) {
    const int tid = opaque_tid(), lane = tid & 63, w = __builtin_amdgcn_readfirstlane(tid >> 6);
    const int bg = tile & 7, tb = 255 - (tile >> 3);
    const int b = bg >> 1, g = bg & 1;
    const int t0 = tb * 32, cur = t0 >> 6;
    float* impL = (float*)(smem + 32768);
    unsigned* selL = (unsigned*)(smem + 49152);
    const bf16_t* NQ = (const bf16_t*)(p.ws + OFF_NQ);
    const float* NG = (const float*)(p.ws + OFF_NGATE);
    const int rowq = lane & 15, tl = rowq >> 2, head = rowq & 3, lg = lane >> 4;
    const int toklA = 8 * w + tl, toklB = 8 * w + 4 + tl;
    const LaneOfs lof = make_lane_ofs(lane);
    const StageOfs sof = make_stage_ofs();
    const size_t tokb = (size_t)b * SEQ + t0;
    bf16x8 qA0, qA1, qB0, qB1;
    {
        const bf16_t* qp = NQ + (tokb + toklA) * 512 + g * 256 + head * 64 + lg * 8;
        qA0 = *(const bf16x8*)qp; qA1 = *(const bf16x8*)(qp + 32);
        qB0 = *(const bf16x8*)(qp + 4 * 512); qB1 = *(const bf16x8*)(qp + 4 * 512 + 32);
    }
    const float* gpA = NG + (tokb + toklA) * 24 + g * 12 + head * 3;
    const float* gpB = gpA + 4 * 24;
    __syncthreads();
    for (int i = tid; i < 4096; i += 256) impL[i] = 0.f;
    const int tqA = t0 + toklA, tqB = t0 + toklB;
    const int tminA = t0 + 8 * w, tminB = tminA + 4;
    f32x4 oA[4], oB[4], otA[4], otB[4];
    float mA, lA, mB, lB;
#define NSA_RESET() { _Pragma("unroll") for (int dt = 0; dt < 4; ++dt) { oA[dt] = (f32x4){0.f, 0.f, 0.f, 0.f}; oB[dt] = (f32x4){0.f, 0.f, 0.f, 0.f}; } \
                      mA = -1e30f; lA = 0.f; mB = -1e30f; lB = 0.f; }
#define NSA_LSUM() { lA = xrow_sum(lA); lB = xrow_sum(lB); }

    const int nvA = (tqA >= 31) ? (((tqA - 31) >> 4) + 1) : 0;
    const int nvB = (tqB >= 31) ? (((tqB - 31) >> 4) + 1) : 0;
    const int nvminA = (tminA >= 31) ? (((tminA - 31) >> 4) + 1) : 0;
    const int nvminB = (tminB >= 31) ? (((tminB - 31) >> 4) + 1) : 0;
    const int nkb = (((t0 >> 4) + 1) + 63) >> 6;
    const bf16_t* ckb = (const bf16_t*)(p.ws + OFF_CMPKB) + (size_t)(b * 2 + g) * 512 * 64;
    const bf16_t* cvb = (const bf16_t*)(p.ws + OFF_CMPVB) + (size_t)(b * 2 + g) * 512 * 64;
    NSA_RESET()
    nsa_kv_loop(ckb, cvb, 64, 0, nkb - 1, smem, sof, [&](int kb, const unsigned char* Kl, const unsigned char* Vl) __attribute__((always_inline)) {
        attn_step2(Kl, Vl, lane, lof,
                   qA0, qA1, oA, mA, lA, 0.f, kb * 64 + 64 <= nvminA, [&](int key) __attribute__((always_inline)) { return kb * 64 + key < nvA; },
                   qB0, qB1, oB, mB, lB, 0.f, kb * 64 + 64 <= nvminB, [&](int key) __attribute__((always_inline)) { return kb * 64 + key < nvB; });
    });
    NSA_LSUM()
    const float mcA = mA, mcB = mB;
    const float invcA = 1.f / fmaxf(lA, 1e-30f), invcB = 1.f / fmaxf(lB, 1e-30f);
    {
        const float fA = gpA[0] * invcA, fB = gpB[0] * invcB;
#pragma unroll
        for (int dt = 0; dt < 4; ++dt) {
            otA[dt][0] = fA * oA[dt][0]; otA[dt][1] = fA * oA[dt][1]; otA[dt][2] = fA * oA[dt][2]; otA[dt][3] = fA * oA[dt][3];
            otB[dt][0] = fB * oB[dt][0]; otB[dt][1] = fB * oB[dt][1]; otB[dt][2] = fB * oB[dt][2]; otB[dt][3] = fB * oB[dt][3];
        }
    }
    if (cur >= 16) {
        nsa_kv_loop(ckb, cvb, 64, 0, nkb - 1, smem, sof, [&](int kb, const unsigned char* Kl, const unsigned char* Vl) __attribute__((always_inline)) {
#pragma unroll
            for (int mt = 0; mt < 2; ++mt) {
                f32x4 s[4];
                nsa_scores(Kl, lof, mt ? qB0 : qA0, mt ? qB1 : qA1, 0.f, s);
                const int nv = mt ? nvB : nvA;
                const float mc = mt ? mcB : mcA, inv = mt ? invcB : invcA;
                float* impT = impL + (mt ? toklB : toklA) * 128;
#pragma unroll
                for (int kt = 0; kt < 4; ++kt) {
                    float pr[4];
#pragma unroll
                    for (int r = 0; r < 4; ++r) {
                        const int n = kb * 64 + kt * 16 + 4 * lg + r;
                        pr[r] = (n < nv) ? __builtin_amdgcn_exp2f(s[kt][r] - mc) * inv : 0.f;
                    }
                    float c1 = pr[0] + pr[1] + pr[2] + 0.5f * pr[3], c2 = 0.5f * pr[3];
                    c1 += __shfl_xor(c1, 1); c1 += __shfl_xor(c1, 2);
                    c2 += __shfl_xor(c2, 1); c2 += __shfl_xor(c2, 2);
                    const int j = kb * 16 + kt * 4 + lg;
                    if (head == 0) {
                        atomicAdd(&impT[j], c1);
                        if (j + 1 < 128) atomicAdd(&impT[j + 1], c2);
                    }
                }
                    }
        });
#pragma unroll 1
        for (int pass = 0; pass < 2; ++pass) {
            const int tok = 8 * w + 4 * pass + lg, c = lane & 15;
            const float4 i0 = *(const float4*)(impL + tok * 128 + 8 * c), i1 = *(const float4*)(impL + tok * 128 + 8 * c + 4);
            const float iv[8] = {i0.x, i0.y, i0.z, i0.w, i1.x, i1.y, i1.z, i1.w};
            float kl[8];
#pragma unroll
            for (int q = 0; q < 8; ++q) {
                const int j = 8 * c + q;
                const bool forced = (j == 0) || (j == cur) || (j == cur - 1);
                const float sc = forced ? 1.0e4f : ((j <= cur) ? iv[q] : -1.f);
                kl[q] = enc_key(sc, (unsigned)j, 127);
            }
            float l0 = kl[0], l1 = kl[1], l2 = kl[2], l3 = kl[3], l4 = kl[4], l5 = kl[5], l6 = kl[6], l7 = kl[7];
            CE_DESC(l0, l1) CE_DESC(l2, l3) CE_DESC(l4, l5) CE_DESC(l6, l7)
            CE_DESC(l0, l2) CE_DESC(l1, l3) CE_DESC(l4, l6) CE_DESC(l5, l7)
            CE_DESC(l1, l2) CE_DESC(l5, l6)
            CE_DESC(l0, l4) CE_DESC(l1, l5) CE_DESC(l2, l6) CE_DESC(l3, l7)
            CE_DESC(l2, l4) CE_DESC(l3, l5)
            CE_DESC(l1, l2) CE_DESC(l3, l4) CE_DESC(l5, l6)
            unsigned pm = 0u;
#pragma unroll
            for (int k = 0; k < 16; ++k) {
                const float mx = row16_max(l0);
                const bool win = (l0 == mx);
                pm |= win ? (1u << (dec_idx(l0, 127) & 7u)) : 0u;
                l0 = win ? l1 : l0; l1 = win ? l2 : l1; l2 = win ? l3 : l2; l3 = win ? l4 : l3;
                l4 = win ? l5 : l4; l5 = win ? l6 : l5; l6 = win ? l7 : l6; l7 = win ? NEGKEY : l7;
            }
            ((unsigned char*)selL)[tok * 16 + c] = (unsigned char)pm;
        }
    } else {
        if (lane < 8) {
            const int tok = 8 * w + lane;
            selL[tok * 4 + 0] = (2u << cur) - 1u; selL[tok * 4 + 1] = 0u; selL[tok * 4 + 2] = 0u; selL[tok * 4 + 3] = 0u;
        }
    }
    WAVE_LDS_SYNC();
#if NSA_DIAG
    if (head == 0 && lg == 0) {
        unsigned* SELM = (unsigned*)(p.ws + OFF_SELM);
#pragma unroll
        for (int qd = 0; qd < 4; ++qd) {
            SELM[((size_t)bg * SEQ + tqA) * 4 + qd] = selL[toklA * 4 + qd];
            SELM[((size_t)bg * SEQ + tqB) * 4 + qd] = selL[toklB * 4 + qd];
        }
    }
#endif
    NSA_RESET()
    {
        const bf16_t* kg = (const bf16_t*)(p.ws + OFF_KV + 2 * KV_STRIDE) + (size_t)b * SEQ * 128 + g * 64;
        const bf16_t* vg = (const bf16_t*)(p.ws + OFF_KV + 3 * KV_STRIDE) + (size_t)b * SEQ * 128 + g * 64;
        nsa_kv_loop(kg, vg, 128, 0, cur, smem, sof, [&](int kb, const unsigned char* Kl, const unsigned char* Vl) __attribute__((always_inline)) {
            const bool svA = (selL[toklA * 4 + (kb >> 5)] >> (kb & 31)) & 1u;
            const bool svB = (selL[toklB * 4 + (kb >> 5)] >> (kb & 31)) & 1u;
            const bool nA = __ballot(svA) != 0ull, nB = __ballot(svB) != 0ull;
            if (nA && nB)
                attn_step2(Kl, Vl, lane, lof,
                           qA0, qA1, oA, mA, lA, svA ? 0.f : NEGM, kb < cur, [&](int key) __attribute__((always_inline)) { return kb * 64 + key <= tqA; },
                           qB0, qB1, oB, mB, lB, svB ? 0.f : NEGM, kb < cur, [&](int key) __attribute__((always_inline)) { return kb * 64 + key <= tqB; });
            else if (nA)
                attn_step(Kl, Vl, lane, lof, qA0, qA1, oA, mA, lA, svA ? 0.f : NEGM, kb < cur, [&](int key) __attribute__((always_inline)) { return kb * 64 + key <= tqA; });
            else if (nB)
                attn_step(Kl, Vl, lane, lof, qB0, qB1, oB, mB, lB, svB ? 0.f : NEGM, kb < cur, [&](int key) __attribute__((always_inline)) { return kb * 64 + key <= tqB; });
        });
    }
    NSA_LSUM()
    {
        const float fA = gpA[1] / fmaxf(lA, 1e-30f), fB = gpB[1] / fmaxf(lB, 1e-30f);
#pragma unroll
        for (int dt = 0; dt < 4; ++dt) {
            otA[dt][0] += fA * oA[dt][0]; otA[dt][1] += fA * oA[dt][1]; otA[dt][2] += fA * oA[dt][2]; otA[dt][3] += fA * oA[dt][3];
            otB[dt][0] += fB * oB[dt][0]; otB[dt][1] += fB * oB[dt][1]; otB[dt][2] += fB * oB[dt][2]; otB[dt][3] += fB * oB[dt][3];
        }
    }
    NSA_RESET()
    {
        const bf16_t* kg = (const bf16_t*)(p.ws + OFF_KV + 4 * KV_STRIDE) + (size_t)b * SEQ * 128 + g * 64;
        const bf16_t* vg = (const bf16_t*)(p.ws + OFF_KV + 5 * KV_STRIDE) + (size_t)b * SEQ * 128 + g * 64;
        const int klo = (t0 > 511) ? ((t0 - 511) >> 6) : 0;
        nsa_kv_loop(kg, vg, 128, klo, cur, smem, sof, [&](int kb, const unsigned char* Kl, const unsigned char* Vl) __attribute__((always_inline)) {
            attn_step2(Kl, Vl, lane, lof,
                       qA0, qA1, oA, mA, lA, 0.f, (kb * 64 >= tminA + 3 - 511) && (kb * 64 + 63 <= tminA),
                       [&](int key) __attribute__((always_inline)) { const int ka = kb * 64 + key; return (ka <= tqA) && (ka >= tqA - 511); },
                       qB0, qB1, oB, mB, lB, 0.f, (kb * 64 >= tminB + 3 - 511) && (kb * 64 + 63 <= tminB),
                       [&](int key) __attribute__((always_inline)) { const int ka = kb * 64 + key; return (ka <= tqB) && (ka >= tqB - 511); });
        });
    }
    NSA_LSUM()
    {
        const float fA = gpA[2] / fmaxf(lA, 1e-30f), fB = gpB[2] / fmaxf(lB, 1e-30f);
        bf16_t* MIX = (bf16_t*)(p.ws + OFF_XB) + (tokb + toklA) * DM + 512 + g * 256 + head * 64 + lg * 4;
#pragma unroll
        for (int dt = 0; dt < 4; ++dt) {
            uint2 ov;
            ov.x = pack2bf(otA[dt][0] + fA * oA[dt][0], otA[dt][1] + fA * oA[dt][1]);
            ov.y = pack2bf(otA[dt][2] + fA * oA[dt][2], otA[dt][3] + fA * oA[dt][3]);
            *(uint2*)(MIX + dt * 16) = ov;
            ov.x = pack2bf(otB[dt][0] + fB * oB[dt][0], otB[dt][1] + fB * oB[dt][1]);
            ov.y = pack2bf(otB[dt][2] + fB * oB[dt][2], otB[dt][3] + fB * oB[dt][3]);
            *(uint2*)(MIX + 4 * DM + dt * 16) = ov;
        }
    }
#undef NSA_RESET
#undef NSA_LSUM
}

__device__ __forceinline__ float block_sum(float v, float* red) {
    v = wave_sum(v);
    __syncthreads();
    if ((threadIdx.x & 63) == 0) red[threadIdx.x >> 6] = v;
    __syncthreads();
    return red[0] + red[1] + red[2] + red[3];
}
__device__ __forceinline__ float4 ln_row(float4 y, const float* g, const float* bb, float* red) {
    const int tid = opaque_tid();
    const float mu = block_sum(y.x + y.y + y.z + y.w, red) * (1.f / 1024.f);
    const float dx = y.x - mu, dy = y.y - mu, dz = y.z - mu, dw = y.w - mu;
    const float var = block_sum(dx * dx + dy * dy + dz * dz + dw * dw, red) * (1.f / 1024.f);
    const float rs = rsqrtf(var + LN_EPS);
    const float4 gg = ((const float4*)g)[tid], b4 = ((const float4*)bb)[tid];
    return make_float4(dx * rs * gg.x + b4.x, dy * rs * gg.y + b4.y, dz * rs * gg.z + b4.z, dw * rs * gg.w + b4.w);
}

__device__ __forceinline__ void ln1_phase(const Params& p, float* sm) {
    const int tid = opaque_tid();
    for (int n = blockIdx.x; n < NTOK; n += gridDim.x) {
        const float4 y = ((const float4*)(p.out + (size_t)n * DM))[tid];
        const float4 o = ln_row(y, p.in[15], p.in[16], sm);
        ((float4*)(p.out + (size_t)n * DM))[tid] = o;
        uint2 hb; hb.x = pack2bf(o.x, o.y); hb.y = pack2bf(o.z, o.w);
        ((uint2*)((bf16_t*)(p.ws + OFF_XB) + (size_t)n * DM))[tid] = hb;
    }
}


typedef float f32x2 __attribute__((ext_vector_type(2)));
__device__ __forceinline__ void cvt_rows_fp8(const float* __restrict__ src, unsigned char* __restrict__ dst, float* __restrict__ scales, int rows) {
    const int tid_ = opaque_tid(), lane = tid_ & 63, w = __builtin_amdgcn_readfirstlane(tid_ >> 6);
    for (int r = blockIdx.x * 4 + w; r < rows; r += gridDim.x * 4) {
        const float4* sp = (const float4*)(src + (size_t)r * 1024 + lane * 16);
        const float4 a = sp[0], b = sp[1], c = sp[2], d = sp[3];
        float mx = fmaxf(fmaxf(fmaxf(fabsf(a.x), fabsf(a.y)), fmaxf(fabsf(a.z), fabsf(a.w))), fmaxf(fmaxf(fabsf(b.x), fabsf(b.y)), fmaxf(fabsf(b.z), fabsf(b.w))));
        mx = fmaxf(mx, fmaxf(fmaxf(fmaxf(fabsf(c.x), fabsf(c.y)), fmaxf(fabsf(c.z), fabsf(c.w))), fmaxf(fmaxf(fabsf(d.x), fabsf(d.y)), fmaxf(fabsf(d.z), fabsf(d.w)))));
        mx = wave_max(mx);
        const float sc = (mx > 0.f) ? mx * (1.f / 448.f) : 1.f;
        const float inv = 1.f / sc;
        uint4 o;
        int t;
        t = 0; t = __builtin_amdgcn_cvt_pk_fp8_f32(a.x * inv, a.y * inv, t, false); t = __builtin_amdgcn_cvt_pk_fp8_f32(a.z * inv, a.w * inv, t, true); o.x = (unsigned)t;
        t = 0; t = __builtin_amdgcn_cvt_pk_fp8_f32(b.x * inv, b.y * inv, t, false); t = __builtin_amdgcn_cvt_pk_fp8_f32(b.z * inv, b.w * inv, t, true); o.y = (unsigned)t;
        t = 0; t = __builtin_amdgcn_cvt_pk_fp8_f32(c.x * inv, c.y * inv, t, false); t = __builtin_amdgcn_cvt_pk_fp8_f32(c.z * inv, c.w * inv, t, true); o.z = (unsigned)t;
        t = 0; t = __builtin_amdgcn_cvt_pk_fp8_f32(d.x * inv, d.y * inv, t, false); t = __builtin_amdgcn_cvt_pk_fp8_f32(d.z * inv, d.w * inv, t, true); o.w = (unsigned)t;
        *(uint4*)(dst + (size_t)r * 1024 + lane * 16) = o;
        if (lane == 0) scales[r] = sc;
    }
}

__device__ __forceinline__ void fold_ws_phase(const float* __restrict__ wq, const float* __restrict__ k1, const float* __restrict__ k2,
                                              bf16_t* __restrict__ WsT) {
    for (int it = blockIdx.x * 256 + threadIdx.x; it < 2048 * 128; it += gridDim.x * 256) {
        const int r = it & 2047, kg = it >> 11;
        const int a = (r >> 7) & 1, j = r & 127;
        const float* kr = (a ? k2 : k1) + j * 128;
        const float* wr = wq + (size_t)(kg * 8) * 2048 + (r & ~127);
        float s[8];
#pragma unroll
        for (int q = 0; q < 8; ++q) s[q] = 0.f;
        for (int d = 0; d < 128; d += 4) {
            const float4 kv = *(const float4*)(kr + d);
#pragma unroll
            for (int q = 0; q < 8; ++q) {
                const float4 wv = *(const float4*)(wr + (size_t)q * 2048 + d);
                s[q] += wv.x * kv.x + wv.y * kv.y + wv.z * kv.z + wv.w * kv.w;
            }
        }
        uint4 o;
        o.x = pack2bf(s[0], s[1]); o.y = pack2bf(s[2], s[3]); o.z = pack2bf(s[4], s[5]); o.w = pack2bf(s[6], s[7]);
        *(uint4*)(WsT + (size_t)r * 1024 + kg * 8) = o;
    }
}


struct EpiTop16 {
    float* topk; unsigned char* lds;
    __device__ __forceinline__ void operator()(int m, int n, f32x4 v) const {
        const int ml = m & 127, g4 = (n & 127) >> 2;
        *(float4*)(lds + ((ml * 32 + (g4 ^ (ml & 7))) << 4)) = make_float4(v[0], v[1], v[2], v[3]);
    }
    __device__ __forceinline__ void finish(int m0, int n0) const {
        __syncthreads();
        const int tid_ = opaque_tid(), lane = tid_ & 63, w = __builtin_amdgcn_readfirstlane(tid_ >> 6), c = lane & 15;
        const int L = n0 >> 7;
        for (int it = 0; it < 8; ++it) {
            const int r = w * 32 + it * 4 + (lane >> 4);
            const float4 x0 = *(const float4*)(lds + ((r * 32 + ((2 * c) ^ (r & 7))) << 4));
            const float4 x1 = *(const float4*)(lds + ((r * 32 + ((2 * c + 1) ^ (r & 7))) << 4));
            float l0 = enc_key(x0.x, 8 * c + 0, 127), l1 = enc_key(x0.y, 8 * c + 1, 127), l2 = enc_key(x0.z, 8 * c + 2, 127),
                  l3 = enc_key(x0.w, 8 * c + 3, 127), l4 = enc_key(x1.x, 8 * c + 4, 127), l5 = enc_key(x1.y, 8 * c + 5, 127),
                  l6 = enc_key(x1.z, 8 * c + 6, 127), l7 = enc_key(x1.w, 8 * c + 7, 127);
            CE_DESC(l0, l1) CE_DESC(l2, l3) CE_DESC(l4, l5) CE_DESC(l6, l7)
            CE_DESC(l0, l2) CE_DESC(l1, l3) CE_DESC(l4, l6) CE_DESC(l5, l7)
            CE_DESC(l1, l2) CE_DESC(l5, l6)
            CE_DESC(l0, l4) CE_DESC(l1, l5) CE_DESC(l2, l6) CE_DESC(l3, l7)
            CE_DESC(l2, l4) CE_DESC(l3, l5)
            CE_DESC(l1, l2) CE_DESC(l3, l4) CE_DESC(l5, l6)
            float res = NEGKEY;
#pragma unroll
            for (int k = 0; k < 16; ++k) {
                const float mx = row16_max(l0);
                const bool win = (l0 == mx);
                l0 = win ? l1 : l0; l1 = win ? l2 : l1; l2 = win ? l3 : l2; l3 = win ? l4 : l3;
                l4 = win ? l5 : l4; l5 = win ? l6 : l5; l6 = win ? l7 : l6; l7 = win ? NEGKEY : l7;
                res = (c == k) ? mx : res;
            }
            topk[(size_t)(m0 + r) * 256 + L * 16 + c] = res;
        }
        __syncthreads();
    }
};

template <int PART>
__device__ __forceinline__ void peer_fast_phase(const Params& p, unsigned char* smem) {
    const int tid = opaque_tid(), lane = tid & 63, w = __builtin_amdgcn_readfirstlane(tid >> 6), l16 = lane & 15, gq = lane >> 4;
    float* tk = (float*)(smem + w * 2048);
    int* ex = (int*)(smem + w * 2048 + 1024);
    float* gw = (float*)(smem + w * 2048 + 1536);
    const bf16_t* H1B = (const bf16_t*)(p.ws + OFF_XB);
    const unsigned char* U8 = p.ws + OFF_UB;
    const unsigned char* V8 = p.ws + OFF_VB;
    const float* USC = (const float*)(p.ws + OFF_USC);
    const float* VSC = (const float*)(p.ws + OFF_VSC);
    const float* TOPK = (const float*)(p.ws + OFF_TOPK);
    int ci[4], cj[4];
#pragma unroll
    for (int q = 0; q < 4; ++q) {
        const int s = l16 + 16 * q;
        int i, j;
        if (s < 16) { i = 0; j = s; }
        else if (s < 24) { i = 1; j = s - 16; }
        else if (s < 29) { i = 2; j = s - 24; }
        else if (s < 33) { i = 3; j = s - 29; }
        else if (s < 36) { i = 4; j = s - 33; }
        else if (s < 42) { i = 5 + ((s - 36) >> 1); j = (s - 36) & 1; }
        else if (s < 50) { i = 8 + (s - 42); j = 0; }
        else { i = -1; j = 0; }
        ci[q] = i; cj[q] = j;
    }
    int* exs = (int*)(smem + 8192 + w * 4096);
    float* gws = (float*)(smem + 8192 + w * 4096 + 2048);
    int* SEX = (int*)(p.ws + OFF_HQ);
    float* SGW = (float*)(p.ws + OFF_HLF);
    for (int qd = blockIdx.x * 4 + w; qd < NTOK / 4; qd += gridDim.x * 4) {
        const int n0 = qd * 4;
        if (PART == 0) {
#pragma unroll 1
        for (int t = 0; t < 4; ++t) {
            const int n = n0 + t;
            WAVE_LDS_SYNC();
            ((float4*)tk)[lane] = ((const float4*)(TOPK + (size_t)n * 256))[lane];
            WAVE_LDS_SYNC();
#pragma unroll
            for (int it = 0; it < 2; ++it) {
                const int head = it * 4 + gq;
                const float* ka = tk + head * 32;
                const float* kb = ka + 16;
                float c0, c1, c2, c3;
#define MKC(q, cq) { if (ci[q] >= 0) { const float sum_ = dec_val(ka[ci[q]], 127) + dec_val(kb[cj[q]], 127); \
                         cq = enc_key(sum_, ci[q] * 16 + cj[q], 255); } else cq = NEGKEY; }
                MKC(0, c0) MKC(1, c1) MKC(2, c2) MKC(3, c3)
#undef MKC
                float res = NEGKEY;
#pragma unroll
                for (int k = 0; k < 16; ++k) {
                    const float mx = row16_max(fmaxf(fmaxf(c0, c1), fmaxf(c2, c3)));
                    c0 = (c0 == mx) ? NEGKEY : c0; c1 = (c1 == mx) ? NEGKEY : c1;
                    c2 = (c2 == mx) ? NEGKEY : c2; c3 = (c3 == mx) ? NEGKEY : c3;
                    res = (l16 == k) ? mx : res;
                }
                const unsigned cc = dec_idx(res, 255);
                const float val = dec_val(res, 255);
                const unsigned e1 = dec_idx(ka[cc >> 4], 127), e2 = dec_idx(kb[cc & 15], 127);
                const float m0 = row16_max(val);
                const float e = expf(val - m0);
                const float ssum = row16_sum(e);
                ex[head * 16 + l16] = (int)(e1 * 128 + e2);
                gw[head * 16 + l16] = e / ssum;
            }
            WAVE_LDS_SYNC();
            {
                const int e0 = ex[lane], e1v = ex[lane + 64];
                const float g0 = gw[lane], g1 = gw[lane + 64];
                const int s0 = e0 >> 11, s1 = e1v >> 11;
                const unsigned long long lt = (1ull << lane) - 1ull;
                int base = 0, p0 = 0, p1 = 0;
#pragma unroll
                for (int s = 0; s < 8; ++s) {
                    const unsigned long long m0 = __ballot(s0 == s), m1 = __ballot(s1 == s);
                    const int c0 = __popcll(m0), c1 = __popcll(m1);
                    if (s0 == s) p0 = base + __popcll(m0 & lt);
                    if (s1 == s) p1 = base + c0 + __popcll(m1 & lt);
                    base += c0 + c1;
                }
                exs[t * 128 + p0] = e0; gws[t * 128 + p0] = g0; exs[t * 128 + p1] = e1v; gws[t * 128 + p1] = g1;
            }
        }
        WAVE_LDS_SYNC();
#pragma unroll
        for (int i = 0; i < 2; ++i) {
            ((uint4*)(SEX + (size_t)n0 * 128))[lane + 64 * i] = ((const uint4*)exs)[lane + 64 * i];
            ((uint4*)(SGW + (size_t)n0 * 128))[lane + 64 * i] = ((const uint4*)gws)[lane + 64 * i];
        }
        } else {
        WAVE_LDS_SYNC();
#pragma unroll
        for (int i = 0; i < 2; ++i) {
            ((uint4*)exs)[lane + 64 * i] = ((const uint4*)(SEX + (size_t)n0 * 128))[lane + 64 * i];
            ((uint4*)gws)[lane + 64 * i] = ((const uint4*)(SGW + (size_t)n0 * 128))[lane + 64 * i];
        }
        }
        if (PART == 1) {
        WAVE_LDS_SYNC();
        {
            f32x2 xp[32];
            {
                const uint4* xr = (const uint4*)(H1B + (size_t)(n0 + gq) * DM + 16 * l16);
#pragma unroll
                for (int i = 0; i < 4; ++i) {
                    const uint4 xa = xr[32 * i], xb = xr[32 * i + 1];
                    xp[8 * i + 0] = (f32x2){__uint_as_float(xa.x << 16), __uint_as_float(xa.x & 0xffff0000u)};
                    xp[8 * i + 1] = (f32x2){__uint_as_float(xa.y << 16), __uint_as_float(xa.y & 0xffff0000u)};
                    xp[8 * i + 2] = (f32x2){__uint_as_float(xa.z << 16), __uint_as_float(xa.z & 0xffff0000u)};
                    xp[8 * i + 3] = (f32x2){__uint_as_float(xa.w << 16), __uint_as_float(xa.w & 0xffff0000u)};
                    xp[8 * i + 4] = (f32x2){__uint_as_float(xb.x << 16), __uint_as_float(xb.x & 0xffff0000u)};
                    xp[8 * i + 5] = (f32x2){__uint_as_float(xb.y << 16), __uint_as_float(xb.y & 0xffff0000u)};
                    xp[8 * i + 6] = (f32x2){__uint_as_float(xb.z << 16), __uint_as_float(xb.z & 0xffff0000u)};
                    xp[8 * i + 7] = (f32x2){__uint_as_float(xb.w << 16), __uint_as_float(xb.w & 0xffff0000u)};
                }
            }
#pragma unroll 4
            for (int k = 0; k < 128; ++k) {
                const int e = exs[gq * 128 + k];
                const uint4* ur = (const uint4*)(U8 + (size_t)e * DM + 16 * l16);
                const uint4 a0 = ur[0], a1 = ur[16], a2 = ur[32], a3 = ur[48];
                const float usc = USC[e];
                f32x2 sA = (f32x2){0.f, 0.f}, sB = (f32x2){0.f, 0.f};
#define D8(W_, B_) { sA = __builtin_elementwise_fma(__builtin_amdgcn_cvt_pk_f32_fp8((int)(W_), false), xp[(B_)], sA);      \
                     sB = __builtin_elementwise_fma(__builtin_amdgcn_cvt_pk_f32_fp8((int)(W_), true), xp[(B_) + 1], sB); }
                D8(a0.x, 0) D8(a0.y, 2) D8(a0.z, 4) D8(a0.w, 6)
                D8(a1.x, 8) D8(a1.y, 10) D8(a1.z, 12) D8(a1.w, 14)
                D8(a2.x, 16) D8(a2.y, 18) D8(a2.z, 20) D8(a2.w, 22)
                D8(a3.x, 24) D8(a3.y, 26) D8(a3.z, 28) D8(a3.w, 30)
#undef D8
                float s = (sA[0] + sA[1]) + (sB[0] + sB[1]);
                s = row16_sum(s) * usc;
                gws[gq * 128 + k] = gws[gq * 128 + k] * gelu_tanh_fast(s) * VSC[e];
            }
        }
        WAVE_LDS_SYNC();
#pragma unroll
        for (int i = 0; i < 2; ++i) ((uint4*)(SGW + (size_t)n0 * 128))[lane + 64 * i] = ((const uint4*)gws)[lane + 64 * i];
        }
        if (PART == 2) {
        WAVE_LDS_SYNC();
        {
            f32x2 acc[32];
#pragma unroll
            for (int q = 0; q < 32; ++q) acc[q] = (f32x2){0.f, 0.f};
#pragma unroll 4
            for (int k = 0; k < 128; ++k) {
                const int e = exs[gq * 128 + k];
                const float wk = gws[gq * 128 + k];
                const f32x2 wk2 = (f32x2){wk, wk};
                const uint4* vr = (const uint4*)(V8 + (size_t)e * DM + 16 * l16);
                const uint4 a0 = vr[0], a1 = vr[16], a2 = vr[32], a3 = vr[48];
#define A4(W_, B_) { acc[(B_)] = __builtin_elementwise_fma(__builtin_amdgcn_cvt_pk_f32_fp8((int)(W_), false), wk2, acc[(B_)]);          \
                     acc[(B_) + 1] = __builtin_elementwise_fma(__builtin_amdgcn_cvt_pk_f32_fp8((int)(W_), true), wk2, acc[(B_) + 1]); }
                A4(a0.x, 0) A4(a0.y, 2) A4(a0.z, 4) A4(a0.w, 6)
                A4(a1.x, 8) A4(a1.y, 10) A4(a1.z, 12) A4(a1.w, 14)
                A4(a2.x, 16) A4(a2.y, 18) A4(a2.z, 20) A4(a2.w, 22)
                A4(a3.x, 24) A4(a3.y, 26) A4(a3.z, 28) A4(a3.w, 30)
#undef A4
            }
            float* orow = p.out + (size_t)(n0 + gq) * DM + 16 * l16;
            float sum = 0.f;
#pragma unroll
            for (int c = 0; c < 4; ++c)
#pragma unroll
                for (int hq = 0; hq < 4; ++hq) {
                    const float4 h = *(const float4*)(orow + 256 * c + 4 * hq);
                    f32x2& pa = acc[8 * c + 2 * hq]; f32x2& pb = acc[8 * c + 2 * hq + 1];
                    pa[0] = ALPHA * h.x + pa[0]; pa[1] = ALPHA * h.y + pa[1]; pb[0] = ALPHA * h.z + pb[0]; pb[1] = ALPHA * h.w + pb[1];
                    sum += (pa[0] + pa[1]) + (pb[0] + pb[1]);
                }
            const float mu = row16_sum(sum) * (1.f / 1024.f);
            float sq = 0.f;
#pragma unroll
            for (int q = 0; q < 32; ++q) { acc[q][0] -= mu; acc[q][1] -= mu; sq += acc[q][0] * acc[q][0] + acc[q][1] * acc[q][1]; }
            const float rs = rsqrtf(row16_sum(sq) * (1.f / 1024.f) + LN_EPS);
            const float* g = p.in[22] + 16 * l16;
            const float* bb = p.in[23] + 16 * l16;
#pragma unroll
            for (int c = 0; c < 4; ++c)
#pragma unroll
                for (int hq = 0; hq < 4; ++hq) {
                    const float4 gg = *(const float4*)(g + 256 * c + 4 * hq), b4 = *(const float4*)(bb + 256 * c + 4 * hq);
                    const f32x2 pa = acc[8 * c + 2 * hq], pb = acc[8 * c + 2 * hq + 1];
                    float4 o;
                    o.x = pa[0] * rs * gg.x + b4.x; o.y = pa[1] * rs * gg.y + b4.y;
                    o.z = pb[0] * rs * gg.z + b4.z; o.w = pb[1] * rs * gg.w + b4.w;
                    *(float4*)(orow + 256 * c + 4 * hq) = o;
                }
        }
        }
    }
}

#define XB_TMO      128
#define XB_XCNT(j)  (256  + 64 * (j))
#define XB_XSUB(j)  (1280 + 64 * (j))
#define XB_XGEN(j)  (2304 + 64 * (j))
#define XB_TOP      3328
#define XB_TOPGEN   3392
#define XCD_BAR_WORDS 3456
#define XB_SPIN_CAP (1u << 22)
__device__ __forceinline__ unsigned xb_ld(unsigned* p) { return __hip_atomic_load(p, __ATOMIC_RELAXED, __HIP_MEMORY_SCOPE_AGENT); }
__device__ __forceinline__ unsigned xb_add(unsigned* p, unsigned v) { return __hip_atomic_fetch_add(p, v, __ATOMIC_RELAXED, __HIP_MEMORY_SCOPE_AGENT); }
__device__ __forceinline__ unsigned xb_xcc_id() { return (unsigned)__builtin_amdgcn_s_getreg((3 << 11) | 20) & 0xFu; }
#define XB_SPIN(cond, bar) do { unsigned _sp = 0; while (cond) { __builtin_amdgcn_s_sleep(1); \
    if ((++_sp & 255u) == 0u) { if (xb_ld(&(bar)[XB_TMO])) break; if (_sp > XB_SPIN_CAP) { atomicAdd(&(bar)[XB_TMO], 1u); break; } } } } while (0)
struct XcdBarrier { unsigned* bar; unsigned x; unsigned* st; };
__device__ __forceinline__ XcdBarrier xcd_barrier_post(unsigned* bar, unsigned* st) {
    XcdBarrier b; b.bar = bar; b.x = xb_xcc_id(); b.st = st;
    if (threadIdx.x == 0) (void)xb_add(&bar[XB_XCNT(b.x)], 1u);
    return b;
}
__device__ __forceinline__ void xcd_barrier_complete(unsigned* bar, unsigned x, unsigned& nloc, unsigned& nx) {
    const unsigned G = gridDim.x * gridDim.y * gridDim.z;
    unsigned sum, cnt, mine, sp = 0u;
    for (;;) {
        sum = 0u; cnt = 0u; mine = 0u;
#pragma unroll
        for (unsigned j = 0; j < 16; ++j) { const unsigned c = xb_ld(&bar[XB_XCNT(j)]); sum += c; cnt += (c > 0u) ? 1u : 0u; mine = (j == x) ? c : mine; }
        if (sum == G) break;
        __builtin_amdgcn_s_sleep(1);
        if ((++sp & 255u) == 0u) { if (xb_ld(&bar[XB_TMO])) break; if (sp > XB_SPIN_CAP) { atomicAdd(&bar[XB_TMO], 1u); break; } }
    }
    nloc = mine > 0u ? mine : 1u; nx = cnt > 0u ? cnt : 1u;
}
__device__ __forceinline__ void xcd_barrier(const XcdBarrier& b) {
    asm volatile("s_waitcnt vmcnt(0)" ::: "memory");
    __syncthreads();
    if (threadIdx.x == 0) {
        unsigned* bar = b.bar;
        __builtin_amdgcn_s_waitcnt(0);
        unsigned nloc = xb_ld(&b.st[0]), nx = xb_ld(&b.st[1]);
        if (nloc == 0u) { xcd_barrier_complete(bar, b.x, nloc, nx); __hip_atomic_store(&b.st[0], nloc, __ATOMIC_RELAXED, __HIP_MEMORY_SCOPE_AGENT); __hip_atomic_store(&b.st[1], nx, __ATOMIC_RELAXED, __HIP_MEMORY_SCOPE_AGENT); }
        const unsigned old = xb_add(&bar[XB_XSUB(b.x)], 1u);
        const unsigned gen = old / nloc;
        if (old + 1u == (gen + 1u) * nloc) {
            __builtin_amdgcn_fence(__ATOMIC_RELEASE, "agent");
            asm volatile("s_waitcnt vmcnt(0)" ::: "memory");
            const unsigned og = xb_add(&bar[XB_TOP], 1u);
            const unsigned tg = og / nx;
            if (og + 1u == (tg + 1u) * nx) xb_add(&bar[XB_TOPGEN], 1u);
            else XB_SPIN(xb_ld(&bar[XB_TOPGEN]) == tg, bar);
            __builtin_amdgcn_fence(__ATOMIC_ACQUIRE, "agent");
            xb_add(&bar[XB_XGEN(b.x)], 1u);
            asm volatile("s_waitcnt vmcnt(0)" ::: "memory");
        } else {
            XB_SPIN(xb_ld(&bar[XB_XGEN(b.x)]) == gen, bar);
            __builtin_amdgcn_fence(__ATOMIC_ACQUIRE, "agent");
            asm volatile("s_waitcnt vmcnt(0)" ::: "memory");
        }
    }
    __syncthreads();
}

__global__ void __launch_bounds__(256, 2) mega(Params p) {
    cg::grid_group grid = cg::this_grid();
    __shared__ __attribute__((aligned(16))) unsigned char smem[65536];
    float* sm = (float*)smem;
    unsigned* barw = (unsigned*)(p.ws + OFF_BAR);
    const XcdBarrier xbar = xcd_barrier_post(barw, barw + XCD_BAR_WORDS + 2 * blockIdx.x);
#if TIME_DIAG
    unsigned long long* TS = (unsigned long long*)(p.ws + OFF_DIAG + 256);
#define STAMP(k) if (blockIdx.x == 0 && threadIdx.x == 0) TS[k] = __builtin_amdgcn_s_memrealtime();
    STAMP(0)
#else
#define STAMP(k)
#endif
    bf16_t* XB = (bf16_t*)(p.ws + OFF_XB);
    bf16_t* WinT = (bf16_t*)(p.ws + OFF_WINT);
    bf16_t* WoutT = (bf16_t*)(p.ws + OFF_WOUTT);
    bf16_t* WqT = (bf16_t*)(p.ws + OFF_WQT);
    cvt_rows_bf16(p.in[0], XB, (size_t)NTOK * DM / 8);
    transpose_bf16(p.in[1], DIN, 3456, WinT);
    transpose_bf16(p.in[2], DM, DM, WoutT);
    fold_ws_phase(p.in[17], p.in[18], p.in[19], WqT);
    cvt_rows_fp8(p.in[20], p.ws + OFF_UB, (float*)(p.ws + OFF_USC), 16384);
    cvt_rows_fp8(p.in[21], p.ws + OFF_VB, (float*)(p.ws + OFF_VSC), 16384);
    transpose_bf16(p.in[6], 256, 256, (bf16_t*)(p.ws + OFF_W1T), 2048);
    transpose_bf16(p.in[11], 256, 256, (bf16_t*)(p.ws + OFF_W1T) + 256 * 2048, 2048);
    if (blockIdx.x == 0) {
        for (int c = threadIdx.x; c < 512; c += 256)
            ((float*)(p.ws + OFF_LBV))[c] = 1.f / (1.f + expf(p.in[3][512 + c] - p.in[3][c]));
        if (threadIdx.x < 16) ((float*)(p.ws + OFF_DIAG))[threadIdx.x] = 0.f;
    }
    if (blockIdx.x == 1 || blockIdx.x == 2) cmp_peb(p, blockIdx.x - 1);
    grid.sync(); STAMP(1)
    gemm_bf16_phase(XB, DM, WinT, DM, NTOK / 128, 27, smem, EpiProj{p.ws});
    xcd_barrier(xbar); STAMP(2)
    for (int it = blockIdx.x; it < 128; it += gridDim.x) {
        const int which = it >> 6, t = it & 63;
        gemm_tile(ALoadCmp{(const bf16_t*)(p.ws + OFF_KV + (size_t)which * KV_STRIDE)},
                  (const bf16_t*)(p.ws + OFF_W1T) + (size_t)which * 256 * 2048, 2048, 32, (t >> 1) * 128, (t & 1) * 128, smem,
                  EpiCmpH{(bf16_t*)(p.ws + OFF_HB) + (size_t)which * 4096 * 256, (const float*)(p.ws + OFF_PEB) + which * 256});
    }
    for (int it = (blockIdx.x + gridDim.x - 128 % gridDim.x) % gridDim.x; it < 2048; it += gridDim.x) hgrn_passA(p, it, smem);
#if NSA_DIAG
    for (int it = blockIdx.x; it < 2 * 4 * NCB * 2; it += gridDim.x) compress_item(p, it, sm);
#endif
    xcd_barrier(xbar); STAMP(3)
    if (blockIdx.x < 256) hgrn_scan_item(p, blockIdx.x);
    cmp_layer2_phase(p, 0, gridDim.x);
    xcd_barrier(xbar); STAMP(4)
    {
        const int qi = blockIdx.x & 7;
        unsigned* qctr = barw + XCD_BAR_WORDS + 2 * 1024 + 64 * qi;
        for (;;) {
            __syncthreads();
            if (threadIdx.x == 0) *(volatile unsigned*)smem = atomicAdd(qctr, 1u);
            __syncthreads();
            const int it = (int)__builtin_amdgcn_readfirstlane(*(volatile unsigned*)smem);
            if (it >= 256) break;
            nsa_tile(p, (it << 3) | qi, smem);
        }
        for (;;) {
            __syncthreads();
            if (threadIdx.x == 0) *(volatile unsigned*)smem = atomicAdd(qctr + 32, 1u);
            __syncthreads();
            const int it = (int)__builtin_amdgcn_readfirstlane(*(volatile unsigned*)smem);
            if (it >= 256) break;
            hgrn_passC(p, (it << 3) | qi, smem);
        }
    }
    xcd_barrier(xbar); STAMP(5)
#if NSA_DIAG
    for (int it = blockIdx.x; it < 4 * 2 * SEQ; it += gridDim.x) nsa_item(p, it, sm);
    grid.sync();
    {
        const float* DG = (const float*)(p.ws + OFF_DIAG);
#if NSA_DIAG == 1
        const float cval = -log10f(sqrtf(DG[0] / DG[1]) + 1e-9f);
#else
        const float cval = -log10f(DG[2] / DG[3] + 1e-6f);
#endif
        for (size_t i = (size_t)blockIdx.x * 256 + threadIdx.x; i < (size_t)NTOK * DM; i += (size_t)gridDim.x * 256) p.out[i] = cval;
        return;
    }
#endif
    gemm_bf16_phase(XB, DM, WoutT, DM, NTOK / 128, 8, smem, EpiY{p.in[0], p.out});
    xcd_barrier(xbar); STAMP(6)
    ln1_phase(p, sm);
    xcd_barrier(xbar); STAMP(7)
    gemm_bf16_phase(XB, DM, WqT, DM, NTOK / 128, 16, smem, EpiTop16{(float*)(p.ws + OFF_TOPK), smem});
    xcd_barrier(xbar); STAMP(8)
    peer_fast_phase<0>(p, smem);
    xcd_barrier(xbar);
    peer_fast_phase<1>(p, smem);
    xcd_barrier(xbar);
    peer_fast_phase<2>(p, smem);
#if TIME_DIAG
    xcd_barrier(xbar); STAMP(9)
    grid.sync();
    {
        const int pa = TIME_DIAG / 100, pb = TIME_DIAG % 100;
        const float da = (float)(TS[pa] - TS[pa - 1]) * 0.01f, db = (float)(TS[pb] - TS[pb - 1]) * 0.01f;
        const float ca = rintf(25.f * log10f(da * 0.1f)) * 0.04f; (void)db;
        for (size_t i = (size_t)blockIdx.x * 256 + threadIdx.x; i < (size_t)NTOK * DM; i += (size_t)gridDim.x * 256) p.out[i] = ca;
    }
#endif
}

extern "C" void kernel_launch(void* const* d_in, const int* in_sizes, int n_in, void* d_out, int out_size,
                              void* d_ws, size_t ws_size, hipStream_t stream) {
    static int grid_blocks = 0;
    if (!grid_blocks) {
        int dev = 0, cus = 0, per_cu = 0;
        hipGetDevice(&dev);
        hipDeviceGetAttribute(&cus, hipDeviceAttributeMultiprocessorCount, dev);
        hipOccupancyMaxActiveBlocksPerMultiprocessor(&per_cu, mega, 256, 0);
        if (per_cu > 4) per_cu = 4;
        if (per_cu < 1) per_cu = 1;
        grid_blocks = cus * per_cu;
        if (n_in != 24 || ws_size < WS_NEED || out_size != NTOK * DM)
            fprintf(stderr, "kernel_launch: unexpected sizes n_in=%d ws=%zu out=%d\n", n_in, ws_size, out_size);
    }
    Params p;
    memset(&p, 0, sizeof(p));
    for (int i = 0; i < 24; ++i) p.in[i] = (const float*)d_in[i];
    p.out = (float*)d_out;
    p.ws = (unsigned char*)d_ws;
    hipMemsetAsync((char*)d_ws + OFF_BAR, 0, BAR_BYTES, stream);
    void* args[] = {&p};
    hipError_t e = hipLaunchCooperativeKernel((void*)mega, dim3(grid_blocks), dim3(256), args, 0, stream);
    if (e != hipSuccess) fprintf(stderr, "cooperative launch failed: %s (grid %d)\n", hipGetErrorString(e), grid_blocks);
}
```

```cpp
#include <hip/hip_runtime.h>
#include <hip/hip_cooperative_groups.h>
#include <cstdio>
#include <cstring>
namespace cg = cooperative_groups;

#define NTOK 32768
#define SEQ 8192
#define DM 1024
#define DIN 3352
#define NCB 511
#define ALPHA 1.189207115002721f
#define LN_EPS 1e-5f

#define MB_ 1048576ull
#define OFF_XB 0ull
#define OFF_HQ (64 * MB_)
#define OFF_HLF (96 * MB_)
#define OFF_HI (160 * MB_)
#define OFF_HG (192 * MB_)
#define OFF_NQ (224 * MB_)
#define OFF_KV (256 * MB_)
#define KV_STRIDE (8 * MB_)
#define OFF_NGATE (304 * MB_)
#define OFF_CMPK (308 * MB_)
#define OFF_CMPV (309 * MB_)
#define OFF_WINT (310 * MB_)
#define OFF_WOUTT (317 * MB_)
#define OFF_WQT (319 * MB_)
#define OFF_LBV (323 * MB_)
#define OFF_DC (324 * MB_)
#define OFF_SC (325 * MB_)
#define OFF_UB (389 * MB_)
#define OFF_VB (421 * MB_)
#define OFF_TOPK (453 * MB_)
#define OFF_W1T (485 * MB_)
#define OFF_HB (487 * MB_)
#define OFF_CMPKB (491 * MB_)
#define OFF_CMPVB (491 * MB_ + 524288ull)
#define OFF_PEB (492 * MB_)
#define OFF_SELM (493 * MB_)
#define OFF_DIAG (494 * MB_)
#define OFF_USC (494 * MB_ + 131072ull)
#define OFF_VSC (494 * MB_ + 196608ull)
#define OFF_BAR (494 * MB_ + 65536ull)
#define BAR_BYTES 32768
#define WS_NEED (495 * MB_)
#define USE_NSA_MFMA 1
#define NSA_DIAG 0

struct Params {
    const float* in[24];
    float* out;
    unsigned char* ws;
};

typedef float f32x16 __attribute__((ext_vector_type(16)));
#define WAVE_LDS_SYNC() asm volatile("s_waitcnt lgkmcnt(0)" ::: "memory")
#define LAS3 __attribute__((address_space(3)))

__device__ __forceinline__ int opaque_tid() { int t = threadIdx.x; asm volatile("" : "+v"(t)); return t; }
__device__ __forceinline__ float wave_sum(float v) {
#pragma unroll
    for (int o = 32; o; o >>= 1) v += __shfl_xor(v, o);
    return v;
}
__device__ __forceinline__ float wave_max(float v) {
#pragma unroll
    for (int o = 32; o; o >>= 1) v = fmaxf(v, __shfl_xor(v, o));
    return v;
}
__device__ __forceinline__ float sigmoidf_(float x) { return 1.f / (1.f + expf(-x)); }
__device__ __forceinline__ float gelu_tanh_fast(float x) {
    const float u = 0.7978845608028654f * (x + 0.044715f * x * x * x);
    return x * __builtin_amdgcn_rcpf(1.f + __builtin_amdgcn_exp2f(-2.885390081777927f * u));
}
__device__ __forceinline__ float gelu_tanh(float x) {
    const float c = 0.7978845608028654f;
    return 0.5f * x * (1.f + tanhf(c * (x + 0.044715f * x * x * x)));
}

typedef short bf16x8 __attribute__((ext_vector_type(8)));
typedef float f32x4 __attribute__((ext_vector_type(4)));
typedef unsigned short bf16_t;

typedef __bf16 bf16x2_t __attribute__((ext_vector_type(2)));
__device__ __forceinline__ unsigned pack2bf(float lo, float hi) {
    bf16x2_t v; v[0] = (__bf16)lo; v[1] = (__bf16)hi;
    return __builtin_bit_cast(unsigned, v);
}
__device__ __forceinline__ unsigned f2bf(float f) { return pack2bf(f, 0.f) & 0xffffu; }
__device__ __forceinline__ float bf2f(unsigned h) { return __uint_as_float(h << 16); }

__device__ __forceinline__ void cvt_rows_bf16(const float* __restrict__ src, bf16_t* __restrict__ dst, size_t n8) {
    for (size_t i = (size_t)blockIdx.x * 256 + threadIdx.x; i < n8; i += (size_t)gridDim.x * 256) {
        const float4 a = ((const float4*)src)[2 * i], b = ((const float4*)src)[2 * i + 1];
        uint4 o;
        o.x = pack2bf(a.x, a.y); o.y = pack2bf(a.z, a.w); o.z = pack2bf(b.x, b.y); o.w = pack2bf(b.z, b.w);
        ((uint4*)dst)[i] = o;
    }
}
__device__ __forceinline__ void transpose_bf16(const float* __restrict__ src, int Nsrc, int Npad, bf16_t* __restrict__ dst, int K = 1024) {
    const size_t total = (size_t)Npad * (K / 8);
    for (size_t i = (size_t)blockIdx.x * 256 + threadIdx.x; i < total; i += (size_t)gridDim.x * 256) {
        const int n = (int)(i % Npad), kg = (int)(i / Npad);
        float v[8];
#pragma unroll
        for (int j = 0; j < 8; ++j) v[j] = (n < Nsrc) ? src[(size_t)(kg * 8 + j) * Nsrc + n] : 0.f;
        uint4 o;
        o.x = pack2bf(v[0], v[1]); o.y = pack2bf(v[2], v[3]); o.z = pack2bf(v[4], v[5]); o.w = pack2bf(v[6], v[7]);
        *(uint4*)(dst + (size_t)n * K + kg * 8) = o;
    }
}

struct ALoadStd {
    const bf16_t* A; int lda;
    __device__ __forceinline__ const bf16_t* ptr(int row, int ks) const { return A + (size_t)row * lda + ks * 64; }
};
struct ALoadCmp {
    const bf16_t* KC;
    __device__ __forceinline__ const bf16_t* ptr(int row, int ks) const {
        const int r = row < 4088 ? row : 4087;
        const int g = r & 1, bn = r >> 1, n = bn % NCB, b = bn / NCB;
        return KC + ((size_t)(b * SEQ + 16 * n + ks) * 128 + g * 64);
    }
};
#define GLDS1(i, ks, buf) { const int row_ = 8 * w + 32 * (i) + (lane >> 3);                                                    \
        __builtin_amdgcn_global_load_lds((const unsigned*)(aload.ptr(m0 + row_, (ks)) + (((lane & 7) ^ (lane >> 3)) << 3)),      \
                                         (LAS3 unsigned*)(lds + (buf) * 32768 + w * 1024 + (i) * 4096), 16, 0, 0);              \
        __builtin_amdgcn_global_load_lds((const unsigned*)(Bp + (size_t)row_ * ldb + (ks) * 64 + (((lane & 7) ^ (lane >> 3)) << 3)), \
                                         (LAS3 unsigned*)(lds + (buf) * 32768 + 16384 + w * 1024 + (i) * 4096), 16, 0, 0); }
#define GEMM_GLDS(ks, buf) { GLDS1(0, ks, buf) GLDS1(1, ks, buf) GLDS1(2, ks, buf) GLDS1(3, ks, buf) }
template <class ALoad, class Epi>
__device__ __forceinline__ void gemm_tile(const ALoad aload, const bf16_t* __restrict__ Bt, int ldb, int KS, int m0, int n0,
                                          unsigned char* lds, Epi epi) {
    const int tid = opaque_tid(), lane = tid & 63, w = __builtin_amdgcn_readfirstlane(tid >> 6), wm = w >> 1, wn = w & 1;
    f32x4 acc[4][4];
#pragma unroll
    for (int j = 0; j < 4; ++j)
#pragma unroll
        for (int i = 0; i < 4; ++i) acc[j][i] = (f32x4){0.f, 0.f, 0.f, 0.f};
    const bf16_t* Bp = Bt + (size_t)n0 * ldb;
    __syncthreads();
    GEMM_GLDS(0, 0)
    asm volatile("s_waitcnt vmcnt(0)" ::: "memory");
    __syncthreads();
    for (int ks = 0; ks < KS; ++ks) {
        if (ks + 1 < KS) GEMM_GLDS(ks + 1, (ks + 1) & 1)
        const unsigned char* la = lds + (ks & 1) * 32768;
        const unsigned char* lb = la + 16384;
#pragma unroll
        for (int s = 0; s < 2; ++s) {
            bf16x8 af[4], wf[4];
            const int ch = s * 4 + (lane >> 4);
#pragma unroll
            for (int i = 0; i < 4; ++i) {
                const int row = wm * 64 + i * 16 + (lane & 15);
                af[i] = *(const bf16x8*)(la + row * 128 + ((ch ^ (row & 7)) << 4));
            }
#pragma unroll
            for (int j = 0; j < 4; ++j) {
                const int row = wn * 64 + j * 16 + (lane & 15);
                wf[j] = *(const bf16x8*)(lb + row * 128 + ((ch ^ (row & 7)) << 4));
            }
#pragma unroll
            for (int j = 0; j < 4; ++j)
#pragma unroll
                for (int i = 0; i < 4; ++i)
                    acc[j][i] = __builtin_amdgcn_mfma_f32_16x16x32_bf16(wf[j], af[i], acc[j][i], 0, 0, 0);
        }
        asm volatile("s_waitcnt vmcnt(0)" ::: "memory");
        __syncthreads();
    }
#pragma unroll
    for (int j = 0; j < 4; ++j)
#pragma unroll
        for (int i = 0; i < 4; ++i)
            epi(m0 + wm * 64 + i * 16 + (lane & 15), n0 + wn * 64 + j * 16 + (lane >> 4) * 4, acc[j][i]);
    epi.finish(m0, n0);
}
template <class Epi>
__device__ __forceinline__ void gemm_bf16_phase(const bf16_t* __restrict__ A, int lda, const bf16_t* __restrict__ Bt, int ldb,
                                                int Mtiles, int Ntiles, unsigned char* lds, Epi epi) {
    if ((gridDim.x & 7) == 0 && (Mtiles & 31) == 0) {
        const int x = blockIdx.x & 7, j = blockIdx.x >> 3, nb = gridDim.x >> 3;
        const int per = (Mtiles >> 3) * Ntiles;
        for (int q = j; q < per; q += nb) {
            const int s = q / (4 * Ntiles), rem = q - s * (4 * Ntiles);
            const int c = rem >> 2, r = rem & 3;
            const int mt = x + 8 * (4 * s + r);
            gemm_tile(ALoadStd{A, lda}, Bt, ldb, 16, mt * 128, c * 128, lds, epi);
        }
    } else {
        for (int tile = blockIdx.x; tile < Mtiles * Ntiles; tile += gridDim.x) {
            const int mt = tile / Ntiles, nt = tile % Ntiles;
            gemm_tile(ALoadStd{A, lda}, Bt, ldb, 16, mt * 128, nt * 128, lds, epi);
        }
    }
}

struct EpiF32 {
    float* C; int ldc; int Nc;
    __device__ __forceinline__ void operator()(int m, int n, f32x4 v) const {
        if (n < Nc) *(float4*)(C + (size_t)m * ldc + n) = make_float4(v[0], v[1], v[2], v[3]);
    }
    __device__ __forceinline__ void finish(int, int) const {}
};

struct EpiProj {
    unsigned char* ws;
    __device__ __forceinline__ void operator()(int m, int n, f32x4 v) const {
        const int ct = n >> 7;
        if (ct < 4) {
            uint2 o; o.x = pack2bf(v[0], v[1]); o.y = pack2bf(v[2], v[3]);
            *(uint2*)((bf16_t*)(ws + OFF_HQ) + (size_t)m * 512 + n) = o;
        } else if (ct < 8) {
            const int c = n - 512;
            const float4 lb = *(const float4*)((const float*)(ws + OFF_LBV) + c);
            float4 o;
            o.x = logf(lb.x + (1.f - lb.x) * sigmoidf_(v[0])); o.y = logf(lb.y + (1.f - lb.y) * sigmoidf_(v[1]));
            o.z = logf(lb.z + (1.f - lb.z) * sigmoidf_(v[2])); o.w = logf(lb.w + (1.f - lb.w) * sigmoidf_(v[3]));
            *(float4*)((float*)(ws + OFF_HLF) + (size_t)m * 512 + c) = o;
        } else if (ct < 12) {
            uint2 o; o.x = pack2bf(v[0], v[1]); o.y = pack2bf(v[2], v[3]);
            *(uint2*)((bf16_t*)(ws + OFF_HI) + (size_t)m * 512 + (n - 1024)) = o;
        } else if (ct < 16) {
            uint2 o; o.x = pack2bf(v[0], v[1]); o.y = pack2bf(v[2], v[3]);
            *(uint2*)((bf16_t*)(ws + OFF_HG) + (size_t)m * 512 + (n - 1536)) = o;
        } else if (ct < 20) {
            const float qs_ = 0.125f * 1.4426950408889634f;
            uint2 o; o.x = pack2bf(qs_ * v[0], qs_ * v[1]); o.y = pack2bf(qs_ * v[2], qs_ * v[3]);
            *(uint2*)((bf16_t*)(ws + OFF_NQ) + (size_t)m * 512 + (n - 2048)) = o;
        } else if (ct < 26) {
            uint2 o; o.x = pack2bf(v[0], v[1]); o.y = pack2bf(v[2], v[3]);
            *(uint2*)((bf16_t*)(ws + OFF_KV + (size_t)(ct - 20) * KV_STRIDE) + (size_t)m * 128 + (n & 127)) = o;
        } else {
            const int c = n - 3328;
            if (c < 24)
                *(float4*)((float*)(ws + OFF_NGATE) + (size_t)m * 24 + c) =
                    make_float4(sigmoidf_(v[0]), sigmoidf_(v[1]), sigmoidf_(v[2]), sigmoidf_(v[3]));
        }
    }
    __device__ __forceinline__ void finish(int, int) const {}
};
struct EpiY {
    const float* x; float* y;
    __device__ __forceinline__ void operator()(int m, int n, f32x4 v) const {
        const float4 xv = *(const float4*)(x + (size_t)m * DM + n);
        *(float4*)(y + (size_t)m * DM + n) = make_float4(ALPHA * xv.x + v[0], ALPHA * xv.y + v[1], ALPHA * xv.z + v[2], ALPHA * xv.w + v[3]);
    }
    __device__ __forceinline__ void finish(int, int) const {}
};

__device__ __forceinline__ uint4 pack8bf(const float* v) {
    uint4 o;
    o.x = pack2bf(v[0], v[1]); o.y = pack2bf(v[2], v[3]); o.z = pack2bf(v[4], v[5]); o.w = pack2bf(v[6], v[7]);
    return o;
}

__device__ __forceinline__ void hgrn_passA(const Params& p, int chunk, unsigned char* smem) {
    const int c = chunk & 127, bh = chunk >> 7, h = bh & 3, b = bh >> 2;
    const int tid = opaque_tid(), d = tid & 127, hf = __builtin_amdgcn_readfirstlane(tid >> 7), lane = tid & 63, w = __builtin_amdgcn_readfirstlane(tid >> 6);
    const size_t tok0 = (size_t)b * SEQ + (size_t)c * 64 + 32 * hf;
    const float* HLF = (const float*)(p.ws + OFF_HLF);
    const bf16_t* HI = (const bf16_t*)(p.ws + OFF_HI);
    unsigned char* KT = smem;
    unsigned char* VT = smem + 16384;
    float* xch = (float*)(smem + 32768);
    const float* lfp = HLF + tok0 * 512 + h * 128 + d;
    const bf16_t* vp = HI + tok0 * 512 + h * 128 + d;
    float run = 0.f;
#pragma unroll 8
    for (int s = 0; s < 32; ++s) run += lfp[s * 512];
    __syncthreads();
    xch[hf * 128 + d] = run;
    __syncthreads();
    const float tot0 = xch[d], tot1 = xch[128 + d];
    const float blast = tot0 + tot1;
    run = hf ? tot0 : 0.f;
#pragma unroll 1
    for (int q = 0; q < 4; ++q) {
        float kv[8], vv[8];
#pragma unroll
        for (int j = 0; j < 8; ++j) {
            const int s = q * 8 + j;
            const float lf = lfp[s * 512];
            run += lf;
            kv[j] = (1.f - expf(lf)) * expf(blast - run);
            vv[j] = bf2f(vp[s * 512]);
        }
        const int ch = 4 * hf + q;
        *(uint4*)(KT + d * 128 + ((ch ^ (d & 7)) << 4)) = pack8bf(kv);
        *(uint4*)(VT + d * 128 + ((ch ^ (d & 7)) << 4)) = pack8bf(vv);
    }
    if (hf) ((float*)(p.ws + OFF_DC))[(size_t)chunk * 128 + d] = expf(blast);
    __syncthreads();
    f32x4 acc[2][8];
#pragma unroll
    for (int i = 0; i < 2; ++i)
#pragma unroll
        for (int et = 0; et < 8; ++et) acc[i][et] = (f32x4){0.f, 0.f, 0.f, 0.f};
#pragma unroll
    for (int st = 0; st < 2; ++st) {
        const int ch = st * 4 + (lane >> 4);
        bf16x8 af[2];
#pragma unroll
        for (int i = 0; i < 2; ++i) {
            const int row = (2 * w + i) * 16 + (lane & 15);
            af[i] = *(const bf16x8*)(KT + row * 128 + ((ch ^ (row & 7)) << 4));
        }
#pragma unroll
        for (int et = 0; et < 8; ++et) {
            const int row = et * 16 + (lane & 15);
            const bf16x8 bfv = *(const bf16x8*)(VT + row * 128 + ((ch ^ (row & 7)) << 4));
            acc[0][et] = __builtin_amdgcn_mfma_f32_16x16x32_bf16(af[0], bfv, acc[0][et], 0, 0, 0);
            acc[1][et] = __builtin_amdgcn_mfma_f32_16x16x32_bf16(af[1], bfv, acc[1][et], 0, 0, 0);
        }
    }
    bf16_t* HC = (bf16_t*)p.out + (size_t)chunk * 16384;
#pragma unroll
    for (int i = 0; i < 2; ++i)
#pragma unroll
        for (int et = 0; et < 8; ++et) {
            const int e = et * 16 + (lane & 15), d0 = (2 * w + i) * 16 + (lane >> 4) * 4;
            { uint2 hv; hv.x = pack2bf(acc[i][et][0], acc[i][et][1]); hv.y = pack2bf(acc[i][et][2], acc[i][et][3]); *(uint2*)(HC + e * 128 + d0) = hv; }
        }
}

__device__ __forceinline__ void hgrn_scan_item(const Params& p, int item) {
    const int gid = item * 256 + threadIdx.x;
    const int d4 = gid & 31, e = (gid >> 5) & 127, bh = gid >> 12;
    const bf16_t* HC = (const bf16_t*)p.out;
    const float* DC = (const float*)(p.ws + OFF_DC);
    bf16_t* SC = (bf16_t*)(p.ws + OFF_SC);
    float4 S = make_float4(0.f, 0.f, 0.f, 0.f);
#pragma unroll 4
    for (int c = 0; c < 128; ++c) {
        const size_t base = ((size_t)(bh * 128 + c) * 128 + e) * 128 + d4 * 4;
        const uint2 hb = *(const uint2*)(HC + base);
        const float4 H = make_float4(__uint_as_float(hb.x << 16), __uint_as_float(hb.x & 0xffff0000u), __uint_as_float(hb.y << 16), __uint_as_float(hb.y & 0xffff0000u));
        const float4 dc = *(const float4*)(DC + (size_t)(bh * 128 + c) * 128 + d4 * 4);
        uint2 o; o.x = pack2bf(S.x, S.y); o.y = pack2bf(S.z, S.w);
        *(uint2*)(SC + base) = o;
        S.x = dc.x * S.x + H.x; S.y = dc.y * S.y + H.y; S.z = dc.z * S.z + H.z; S.w = dc.w * S.w + H.w;
    }
}

__device__ __forceinline__ void hgrn_passC(const Params& p, int chunk, unsigned char* smem) {
    const int c = chunk & 127, bh = chunk >> 7, h = bh & 3, b = bh >> 2;
    const int tid = opaque_tid(), d = tid & 127, hf = __builtin_amdgcn_readfirstlane(tid >> 7), lane = tid & 63, w = __builtin_amdgcn_readfirstlane(tid >> 6);
    const size_t tokc = (size_t)b * SEQ + (size_t)c * 64;
    const size_t tok0 = tokc + 32 * hf;
    const float* HLF = (const float*)(p.ws + OFF_HLF);
    const bf16_t* HQ = (const bf16_t*)(p.ws + OFF_HQ);
    const bf16_t* HI = (const bf16_t*)(p.ws + OFF_HI);
    const bf16_t* HG = (const bf16_t*)(p.ws + OFF_HG);
    unsigned char* R0 = smem;
    unsigned char* R1 = smem + 16384;
    unsigned char* R2 = smem + 57344;
    float* xch = (float*)R2;
    const float* lfp = HLF + tok0 * 512 + h * 128 + d;
    const bf16_t* qp = HQ + tok0 * 512 + h * 128 + d;
    float run = 0.f, b15 = 0.f;
#pragma unroll 8
    for (int s = 0; s < 32; ++s) { run += lfp[s * 512]; if (s == 15) b15 = run; }
    __syncthreads();
    xch[hf * 128 + d] = run;
    if (hf == 0) xch[256 + d] = b15;
    __syncthreads();
    const float tot0 = xch[d];
    const float off = hf ? tot0 : 0.f;
    const float r1 = xch[256 + d], r2 = tot0;
    if (hf) xch[384 + d] = off + b15;
    run = off;
#pragma unroll 8
    for (int s = 0; s < 32; ++s) {
        const int t = 32 * hf + s;
        run += lfp[s * 512];
        const float qv = bf2f(qp[s * 512]);
        *(bf16_t*)(R0 + t * 256 + ((((d >> 3) ^ (t & 15))) << 4) + (d & 7) * 2) = (bf16_t)f2bf(qv * expf(run));
    }
    {
        const bf16_t* SCp = (const bf16_t*)(p.ws + OFF_SC) + (size_t)chunk * 16384;
#pragma unroll
        for (int i = 0; i < 8; ++i) {
            const int cc = tid + 256 * i, row = cc >> 4, ch = cc & 15;
            *(uint4*)(R1 + row * 256 + ((ch ^ (row & 15)) << 4)) = *(const uint4*)(SCp + row * 128 + ch * 8);
        }
    }
    __syncthreads();
    f32x4 acc[8];
#pragma unroll
    for (int et = 0; et < 8; ++et) acc[et] = (f32x4){0.f, 0.f, 0.f, 0.f};
#pragma unroll
    for (int ds = 0; ds < 4; ++ds) {
        const int ch = ds * 4 + (lane >> 4);
        const int trow = w * 16 + (lane & 15);
        const bf16x8 bq = *(const bf16x8*)(R0 + trow * 256 + ((ch ^ (trow & 15)) << 4));
#pragma unroll
        for (int et = 0; et < 8; ++et) {
            const int row = et * 16 + (lane & 15);
            const bf16x8 av = *(const bf16x8*)(R1 + row * 256 + ((ch ^ (row & 15)) << 4));
            acc[et] = __builtin_amdgcn_mfma_f32_16x16x32_bf16(av, bq, acc[et], 0, 0, 0);
        }
    }
    __syncthreads();
    {
        const float r3 = xch[384 + d];
        run = off;
        unsigned char* dummy = R2 + 4096 + d * 2;
#pragma unroll 8
        for (int s = 0; s < 32; ++s) {
            const int t = 32 * hf + s;
            const int it = t >> 4;
            const float rr = (it == 0) ? 0.f : (it == 1) ? r1 : (it == 2) ? r2 : r3;
            const int sw = (((d >> 3) ^ (t & 15)) << 4) + (d & 7) * 2;
            const float lf = lfp[s * 512];
            run += lf;
            const float qv = bf2f(qp[s * 512]);
            const float kv = 1.f - expf(lf);
            *(bf16_t*)(R0 + t * 256 + sw) = (bf16_t)f2bf(qv * expf(run - rr));
#pragma unroll
            for (int i = 0; i < 4; ++i) {
                const float ri = (i == 0) ? 0.f : (i == 1) ? r1 : (i == 2) ? r2 : r3;
                const int R = 8 * i * (i + 1) + t;
                unsigned char* dst = (i >= it) ? (R1 + R * 256 + sw) : dummy;
                *(bf16_t*)dst = (bf16_t)f2bf(kv * expf(fminf(ri - run, 80.f)));
            }
        }
    }
    __syncthreads();
#pragma unroll
    for (int j = 0; j < 4; ++j) {
        uint2 o = make_uint2(0u, 0u);
        if (j <= w) {
            f32x4 pa = (f32x4){0.f, 0.f, 0.f, 0.f};
#pragma unroll
            for (int ds = 0; ds < 4; ++ds) {
                const int ch = ds * 4 + (lane >> 4);
                const int krow = 8 * w * (w + 1) + 16 * j + (lane & 15);
                const int trow = w * 16 + (lane & 15);
                const bf16x8 av = *(const bf16x8*)(R1 + krow * 256 + ((ch ^ (krow & 15)) << 4));
                const bf16x8 bq = *(const bf16x8*)(R0 + trow * 256 + ((ch ^ (trow & 15)) << 4));
                pa = __builtin_amdgcn_mfma_f32_16x16x32_bf16(av, bq, pa, 0, 0, 0);
            }
            if (j == w) {
                const int tl = lane & 15, sl = (lane >> 4) * 4;
#pragma unroll
                for (int r = 0; r < 4; ++r) if (sl + r > tl) pa[r] = 0.f;
            }
            o.x = pack2bf(pa[0], pa[1]); o.y = pack2bf(pa[2], pa[3]);
        }
        const int t = w * 16 + (lane & 15);
        const int ch = 2 * j + (lane >> 5);
        *(uint2*)(R2 + t * 128 + ((ch ^ (t & 7)) << 4) + ((lane >> 4) & 1) * 8) = o;
    }
    __syncthreads();
#pragma unroll
    for (int q = 0; q < 4; ++q) {
        float vv[8];
#pragma unroll
        for (int j = 0; j < 8; ++j) vv[j] = bf2f(HI[(tok0 + q * 8 + j) * 512 + h * 128 + d]);
        const int ch = 4 * hf + q;
        *(uint4*)(R1 + d * 128 + ((ch ^ (d & 7)) << 4)) = pack8bf(vv);
    }
    __syncthreads();
#pragma unroll
    for (int st = 0; st < 2; ++st) {
        const int ch = st * 4 + (lane >> 4);
        const int trow = w * 16 + (lane & 15);
        const bf16x8 bp = *(const bf16x8*)(R2 + trow * 128 + ((ch ^ (trow & 7)) << 4));
#pragma unroll
        for (int et = 0; et < 8; ++et) {
            const int row = et * 16 + (lane & 15);
            const bf16x8 av = *(const bf16x8*)(R1 + row * 128 + ((ch ^ (row & 7)) << 4));
            acc[et] = __builtin_amdgcn_mfma_f32_16x16x32_bf16(av, bp, acc[et], 0, 0, 0);
        }
    }
    {
        float ss = 0.f;
#pragma unroll
        for (int et = 0; et < 8; ++et)
#pragma unroll
            for (int r = 0; r < 4; ++r) ss += acc[et][r] * acc[et][r];
        ss += __shfl_xor(ss, 16);
        ss += __shfl_xor(ss, 32);
        const float rs = rsqrtf(ss * (1.f / 128.f) + LN_EPS);
        const size_t tok = tokc + w * 16 + (lane & 15);
        const float* ng = p.in[4];
        bf16_t* MIX = (bf16_t*)(p.ws + OFF_XB);
#pragma unroll
        for (int et = 0; et < 8; ++et) {
            const int e0 = et * 16 + (lane >> 4) * 4;
            const uint2 gb = *(const uint2*)(HG + tok * 512 + h * 128 + e0);
            const float4 n4 = *(const float4*)(ng + e0);
            const float g0 = bf2f(gb.x & 0xffffu), g1 = bf2f(gb.x >> 16), g2 = bf2f(gb.y & 0xffffu), g3 = bf2f(gb.y >> 16);
            uint2 o;
            o.x = pack2bf(acc[et][0] * rs * n4.x * (g0 * sigmoidf_(g0)), acc[et][1] * rs * n4.y * (g1 * sigmoidf_(g1)));
            o.y = pack2bf(acc[et][2] * rs * n4.z * (g2 * sigmoidf_(g2)), acc[et][3] * rs * n4.w * (g3 * sigmoidf_(g3)));
            *(uint2*)(MIX + tok * DM + h * 128 + e0) = o;
        }
    }
}

__device__ __forceinline__ void compress_item(const Params& p, int item, float* sm) {
    const int g = item & 1;
    int r = item >> 1;
    const int n = r % NCB; r /= NCB;
    const int b = r & 3, which = r >> 2;
    const int tid = opaque_tid();
    const bf16_t* kvsrc = (const bf16_t*)(p.ws + OFF_KV + (size_t)which * KV_STRIDE);
    const float* pe = p.in[which ? 10 : 5];
    const float* w1 = p.in[which ? 11 : 6];
    const float* b1 = p.in[which ? 12 : 7];
    const float* w2 = p.in[which ? 13 : 8];
    const float* b2 = p.in[which ? 14 : 9];
    float* outp = (float*)(p.ws + (which ? OFF_CMPV : OFF_CMPK));
    float* blk = sm;
    float* hh = sm + 2048;
    __syncthreads();
    for (int i = tid; i < 2048; i += 256) {
        const int l = i >> 6, d = i & 63;
        blk[i] = bf2f(kvsrc[(size_t)(b * SEQ + 16 * n + l) * 128 + g * 64 + d]) + pe[i];
    }
    __syncthreads();
    float acc = b1[tid];
    for (int i = 0; i < 2048; ++i) acc += blk[i] * w1[(size_t)i * 256 + tid];
    hh[tid] = gelu_tanh(acc);
    __syncthreads();
    if (tid < 64) {
        float o = b2[tid];
        for (int j = 0; j < 256; ++j) o += hh[j] * w2[j * 64 + tid];
        outp[((size_t)(b * NCB + n) * 2 + g) * 64 + tid] = o;
    }
}

__device__ __forceinline__ float dot64_bf(const float* qs, const bf16_t* krow) {
    float s = 0.f;
#pragma unroll
    for (int i = 0; i < 8; ++i) {
        const uint4 kv = ((const uint4*)krow)[i];
        const float4 q0 = ((const float4*)qs)[2 * i], q1 = ((const float4*)qs)[2 * i + 1];
        s += __uint_as_float(kv.x << 16) * q0.x + __uint_as_float(kv.x & 0xffff0000u) * q0.y
           + __uint_as_float(kv.y << 16) * q0.z + __uint_as_float(kv.y & 0xffff0000u) * q0.w
           + __uint_as_float(kv.z << 16) * q1.x + __uint_as_float(kv.z & 0xffff0000u) * q1.y
           + __uint_as_float(kv.w << 16) * q1.z + __uint_as_float(kv.w & 0xffff0000u) * q1.w;
    }
    return s;
}
__device__ __forceinline__ float dot64(const float* qs, const float* krow) {
    float s = 0.f;
#pragma unroll
    for (int i = 0; i < 16; ++i) {
        const float4 kv = ((const float4*)krow)[i];
        const float4 qv = ((const float4*)qs)[i];
        s += kv.x * qv.x + kv.y * qv.y + kv.z * qv.z + kv.w * qv.w;
    }
    return s;
}

__device__ __forceinline__ void nsa_item(const Params& p, int item, float* sm) {
    const int t = item & (SEQ - 1), g = (item >> 13) & 1, b = item >> 14;
    const int tid = threadIdx.x, lane = tid & 63, r = tid >> 6;
    float* sc = sm + r * 1024;
    float* qs = sm + 4096 + r * 64;
    float* impv = sm + 4096 + 256;
    int* sel = (int*)(sm + 4096 + 256 + 128);
    const bf16_t* KSb = (const bf16_t*)(p.ws + OFF_KV + 2 * KV_STRIDE);
    const bf16_t* VSb = (const bf16_t*)(p.ws + OFF_KV + 3 * KV_STRIDE);
    const bf16_t* KWb = (const bf16_t*)(p.ws + OFF_KV + 4 * KV_STRIDE);
    const bf16_t* VWb = (const bf16_t*)(p.ws + OFF_KV + 5 * KV_STRIDE);
    const float* cmpk = (const float*)(p.ws + OFF_CMPK);
    const float* cmpv = (const float*)(p.ws + OFF_CMPV);
    const size_t n = (size_t)b * SEQ + t;
    const float NEGV = -1e30f;
    __syncthreads();
    qs[lane] = bf2f(((const bf16_t*)(p.ws + OFF_NQ))[n * 512 + g * 256 + r * 64 + lane]) * 0.6931471805599453f;
    __syncthreads();

    const int nvalid = (t >= 31) ? (((t - 31) >> 4) + 1) : 0;
    float m = NEGV;
    for (int n0 = 0; n0 < nvalid; n0 += 64) {
        const int nn = n0 + lane;
        if (nn < nvalid) {
            const float s = dot64(qs, cmpk + ((size_t)(b * NCB + nn) * 2 + g) * 64);
            sc[nn] = s;
            m = fmaxf(m, s);
        }
    }
    m = wave_max(m);
    float sum = 0.f;
    for (int n0 = 0; n0 < nvalid; n0 += 64) {
        const int nn = n0 + lane;
        if (nn < nvalid) { const float e = expf(sc[nn] - m); sc[nn] = e; sum += e; }
    }
    sum = wave_sum(sum);
    {
        const float inv = 1.f / fmaxf(sum, 1e-30f);
        for (int n0 = 0; n0 < nvalid; n0 += 64) {
            const int nn = n0 + lane;
            if (nn < nvalid) sc[nn] *= inv;
        }
    }
    __syncthreads();
    float oc = 0.f;
    for (int nn = 0; nn < nvalid; ++nn) oc += sc[nn] * cmpv[((size_t)(b * NCB + nn) * 2 + g) * 64 + lane];

    const int cur = t >> 6;
    if (tid < 128) {
        const int j = tid;
        float im = 0.f;
#pragma unroll
        for (int rr = 0; rr < 4; ++rr) {
            const float* P = sm + rr * 1024;
            const int n4 = 4 * j;
            float a = 0.f;
            if (n4 < nvalid) a += P[n4];
            if (n4 + 1 < nvalid) a += P[n4 + 1];
            if (n4 + 2 < nvalid) a += P[n4 + 2];
            if (n4 + 3 < nvalid) a += 0.5f * P[n4 + 3];
            if (n4 - 1 >= 0 && n4 - 1 < nvalid) a += 0.5f * P[n4 - 1];
            im += a;
        }
        const bool forced = (j == 0) || (j == cur) || (j == cur - 1);
        const bool causal = (j <= cur);
        impv[j] = forced ? 1.0e4f : (causal ? im : -1.f);
    }
    __syncthreads();
    if (r == 0) {
        float v0 = impv[lane], v1 = impv[lane + 64];
        for (int k = 0; k < 16; ++k) {
            const float mx = wave_max(fmaxf(v0, v1));
            const unsigned long long b0 = __ballot(v0 == mx);
            int idx;
            if (b0) {
                const int l = __ffsll((unsigned long long)b0) - 1;
                idx = l;
                if (lane == l) v0 = -3.0e38f;
            } else {
                const unsigned long long b1 = __ballot(v1 == mx);
                const int l = __ffsll((unsigned long long)b1) - 1;
                idx = 64 + l;
                if (lane == l) v1 = -3.0e38f;
            }
            if (lane == 0) sel[k] = idx;
        }
    }
    __syncthreads();

    m = NEGV;
    for (int si = 0; si < 16; ++si) {
        const int blk = sel[si];
        const int key = blk * 64 + lane;
        float s = NEGV;
        if (blk * 64 <= t) {
            if (key <= t) s = dot64_bf(qs, KSb + ((size_t)b * SEQ + key) * 128 + g * 64);
        }
        sc[si * 64 + lane] = s;
        m = fmaxf(m, s);
    }
    m = wave_max(m);
    sum = 0.f;
    for (int si = 0; si < 16; ++si) {
        const int key = sel[si] * 64 + lane;
        const float e = (key <= t) ? expf(sc[si * 64 + lane] - m) : 0.f;
        sc[si * 64 + lane] = e;
        sum += e;
    }
    sum = wave_sum(sum);
    {
        const float inv = 1.f / fmaxf(sum, 1e-30f);
        for (int si = 0; si < 16; ++si) sc[si * 64 + lane] *= inv;
    }
    __syncthreads();
    float os = 0.f;
    for (int si = 0; si < 16; ++si) {
        const int blk = sel[si];
        if (blk * 64 > t) continue;
        for (int kk = 0; kk < 64; ++kk) {
            const int key = blk * 64 + kk;
            if (key > t) break;
            os += sc[si * 64 + kk] * bf2f(VSb[((size_t)b * SEQ + key) * 128 + g * 64 + lane]);
        }
    }
    __syncthreads();

    const int lo = t - 511;
    m = NEGV;
    for (int i = 0; i < 8; ++i) {
        const int key = lo + i * 64 + lane;
        float s = NEGV;
        if (key >= 0) s = dot64_bf(qs, KWb + ((size_t)b * SEQ + key) * 128 + g * 64);
        sc[i * 64 + lane] = s;
        m = fmaxf(m, s);
    }
    m = wave_max(m);
    sum = 0.f;
    for (int i = 0; i < 8; ++i) {
        const int key = lo + i * 64 + lane;
        const float e = (key >= 0) ? expf(sc[i * 64 + lane] - m) : 0.f;
        sc[i * 64 + lane] = e;
        sum += e;
    }
    sum = wave_sum(sum);
    {
        const float inv = 1.f / fmaxf(sum, 1e-30f);
        for (int i = 0; i < 8; ++i) sc[i * 64 + lane] *= inv;
    }
    __syncthreads();
    float ow = 0.f;
    for (int idx = 0; idx < 512; ++idx) {
        const int key = lo + idx;
        if (key < 0) continue;
        ow += sc[idx] * bf2f(VWb[((size_t)b * SEQ + key) * 128 + g * 64 + lane]);
    }
    const float* grow = (const float*)(p.ws + OFF_NGATE) + n * 24 + g * 12 + r * 3;
    const float gc = grow[0], gs = grow[1], gw = grow[2];
#if NSA_DIAG
    {
        const float ref = gc * oc + gs * os + gw * ow;
        const float got = bf2f(((const bf16_t*)(p.ws + OFF_XB))[n * DM + 512 + g * 256 + r * 64 + lane]);
        const unsigned* SELM = (const unsigned*)(p.ws + OFF_SELM) + ((size_t)(b * 2 + g) * SEQ + t) * 4;
        unsigned gm[4] = {0u, 0u, 0u, 0u};
        for (int si = 0; si < 16; ++si) { const int blk = sel[si]; if (blk * 64 <= t) gm[blk >> 5] |= 1u << (blk & 31); }
        bool same = true;
        for (int qd = 0; qd < 4; ++qd) {
            unsigned mm = SELM[qd];
            for (int bit = 0; bit < 32; ++bit) if ((qd * 32 + bit) * 64 > t) mm &= ~(1u << bit);
            if (mm != gm[qd]) same = false;
        }
        float d2 = same ? (got - ref) * (got - ref) : 0.f, r2 = same ? ref * ref : 0.f;
        d2 = wave_sum(d2); r2 = wave_sum(r2);
        float* DG = (float*)(p.ws + OFF_DIAG);
        if (lane == 0) { atomicAdd(&DG[0], d2); atomicAdd(&DG[1], r2); if (r == 0) { atomicAdd(&DG[2], same ? 0.f : 1.f); atomicAdd(&DG[3], 1.f); } }
    }
#else
    ((bf16_t*)(p.ws + OFF_XB))[n * DM + 512 + g * 256 + r * 64 + lane] = (bf16_t)f2bf(gc * oc + gs * os + gw * ow);
#endif
}


__device__ __forceinline__ float xrow_max(float x) {
    auto s = __builtin_amdgcn_permlane16_swap(__float_as_uint(x), __float_as_uint(x), false, false);
    x = fmaxf(__uint_as_float(s[0]), __uint_as_float(s[1]));
    auto t = __builtin_amdgcn_permlane32_swap(__float_as_uint(x), __float_as_uint(x), false, false);
    return fmaxf(__uint_as_float(t[0]), __uint_as_float(t[1]));
}
__device__ __forceinline__ float xrow_sum(float x) {
    auto s = __builtin_amdgcn_permlane16_swap(__float_as_uint(x), __float_as_uint(x), false, false);
    x = __uint_as_float(s[0]) + __uint_as_float(s[1]);
    auto t = __builtin_amdgcn_permlane32_swap(__float_as_uint(x), __float_as_uint(x), false, false);
    return __uint_as_float(t[0]) + __uint_as_float(t[1]);
}
template <int CTRL> __device__ __forceinline__ float dppf(float x) {
    return __builtin_bit_cast(float, __builtin_amdgcn_mov_dpp(__builtin_bit_cast(int, x), CTRL, 0xf, 0xf, true));
}
__device__ __forceinline__ float row16_max(float m) {
    m = fmaxf(m, dppf<0x121>(m)); m = fmaxf(m, dppf<0x122>(m));
    m = fmaxf(m, dppf<0x124>(m)); m = fmaxf(m, dppf<0x128>(m));
    return m;
}
__device__ __forceinline__ float row16_sum(float m) {
    m += dppf<0x121>(m); m += dppf<0x122>(m); m += dppf<0x124>(m); m += dppf<0x128>(m);
    return m;
}
__device__ __forceinline__ float dot2bf(unsigned a, unsigned b, float acc) {
    return __builtin_amdgcn_fdot2_f32_bf16(__builtin_bit_cast(bf16x2_t, a), __builtin_bit_cast(bf16x2_t, b), acc, false);
}
__device__ __forceinline__ float enc_key(float v, unsigned idx, unsigned mask) {
    const unsigned u = __float_as_uint(v);
    const unsigned code = (u >> 31) ? idx : (mask - idx);
    return __uint_as_float((u & ~mask) | code);
}
__device__ __forceinline__ unsigned dec_idx(float key, unsigned mask) {
    const unsigned u = __float_as_uint(key);
    const unsigned code = u & mask;
    return (u >> 31) ? code : (mask - code);
}
__device__ __forceinline__ float dec_val(float key, unsigned mask) { return __uint_as_float(__float_as_uint(key) & ~mask); }
#define NEGKEY (-3.0e38f)
#define CE_DESC(a, b) { const float t_ = fmaxf(a, b); b = fminf(a, b); a = t_; }

struct EpiCmpH {
    bf16_t* HB; const float* peb;
    __device__ __forceinline__ void operator()(int m, int n, f32x4 v) const {
        const float4 pb = *(const float4*)(peb + n);
        uint2 o;
        o.x = pack2bf(gelu_tanh(v[0] + pb.x), gelu_tanh(v[1] + pb.y));
        o.y = pack2bf(gelu_tanh(v[2] + pb.z), gelu_tanh(v[3] + pb.w));
        *(uint2*)(HB + (size_t)m * 256 + n) = o;
    }
    __device__ __forceinline__ void finish(int, int) const {}
};
__device__ __forceinline__ void cmp_peb(const Params& p, int which) {
    const float* pe = p.in[which ? 10 : 5];
    const float* w1 = p.in[which ? 11 : 6];
    const float* b1 = p.in[which ? 12 : 7];
    const int j = threadIdx.x;
    float acc = b1[j];
    for (int i = 0; i < 2048; ++i) acc += pe[i] * w1[(size_t)i * 256 + j];
    ((float*)(p.ws + OFF_PEB))[which * 256 + j] = acc;
}
__device__ __forceinline__ void cmp_layer2_phase(const Params& p, int first_block, int nblocks) {
    const int tid_ = opaque_tid(), lane = tid_ & 63, w = __builtin_amdgcn_readfirstlane(tid_ >> 6);
    for (int it = (blockIdx.x - first_block) * 4 + w; it < 2 * 4088; it += nblocks * 4) {
        const int which = it >= 4088, row = which ? it - 4088 : it;
        const float* w2 = p.in[which ? 13 : 8];
        const float* b2 = p.in[which ? 14 : 9];
        const bf16_t* hrow = (const bf16_t*)(p.ws + OFF_HB) + ((size_t)which * 4096 + row) * 256;
        float o = b2[lane];
#pragma unroll 8
        for (int j = 0; j < 256; ++j) o += bf2f(hrow[j]) * w2[j * 64 + lane];
        const int g = row & 1, bn = row >> 1, n = bn % NCB, b = bn / NCB;
        ((bf16_t*)(p.ws + (which ? OFF_CMPVB : OFF_CMPKB)))[((size_t)(b * 2 + g) * 512 + n) * 64 + lane] = (bf16_t)f2bf(o);
    }
}

struct StageOfs { int k, v; };
__device__ __forceinline__ StageOfs make_stage_ofs() {
    const int c0 = opaque_tid(), key = c0 >> 3, ch = c0 & 7;
    StageOfs s;
    s.k = key * 128 + ((ch ^ (key & 7)) << 4);
    s.v = key * 128 + (((ch >> 1) ^ ((key >> 1) & 3)) << 5) + (ch & 1) * 16;
    return s;
}
#define NSA_KV_LOAD(S_, kb_) { const bf16_t* kp_ = Kbase + (size_t)(kb_) * 64 * stride + (size_t)(tid >> 3) * stride + (tid & 7) * 8; \
        const bf16_t* vp_ = Vbase + (size_t)(kb_) * 64 * stride + (size_t)(tid >> 3) * stride + (tid & 7) * 8;                 \
        S_##k0 = *(const uint4*)kp_; S_##k1 = *(const uint4*)(kp_ + (size_t)32 * stride);                                    \
        S_##v0 = *(const uint4*)vp_; S_##v1 = *(const uint4*)(vp_ + (size_t)32 * stride); }
#define NSA_KV_STORE(S_, Kl_, Vl_) { *(uint4*)((Kl_) + sof.k) = S_##k0; *(uint4*)((Kl_) + sof.k + 4096) = S_##k1; \
        *(uint4*)((Vl_) + sof.v) = S_##v0; *(uint4*)((Vl_) + sof.v + 4096) = S_##v1; }
template <class Compute>
__device__ __forceinline__ void nsa_kv_loop(const bf16_t* __restrict__ Kbase, const bf16_t* __restrict__ Vbase, int stride,
                                            int kb_lo, int kb_hi, unsigned char* smem, const StageOfs& sof, Compute compute) {
    const int tid = opaque_tid();
    uint4 ra_k0, ra_k1, ra_v0, ra_v1;
    NSA_KV_LOAD(ra_, kb_lo)
    __syncthreads();
    NSA_KV_STORE(ra_, smem, smem + 16384)
    __syncthreads();
    for (int kb = kb_lo; kb <= kb_hi; ++kb) {
        const int buf = (kb - kb_lo) & 1;
        if (kb < kb_hi) NSA_KV_LOAD(ra_, kb + 1)
        compute(kb, smem + buf * 8192, smem + 16384 + buf * 8192);
        if (kb < kb_hi) NSA_KV_STORE(ra_, smem + (buf ^ 1) * 8192, smem + 16384 + (buf ^ 1) * 8192)
        __syncthreads();
    }
}
struct LaneOfs { int k0, k1, vb0, vb1, vb2, vb3; };
__device__ __forceinline__ LaneOfs make_lane_ofs(int lane) {
    LaneOfs f;
    const int r15 = lane & 15, lg = lane >> 4, q = r15 >> 2, pp = r15 & 3;
    f.k0 = r15 * 128 + ((lg ^ (r15 & 7)) << 4);
    f.k1 = r15 * 128 + (((4 + lg) ^ (r15 & 7)) << 4);
    const int sw2 = (2 * (lg & 1) + (q >> 1)) & 3;
    const int vrow = (4 * lg + q) * 128 + pp * 8;
    f.vb0 = vrow + ((0 ^ sw2) << 5); f.vb1 = vrow + ((1 ^ sw2) << 5);
    f.vb2 = vrow + ((2 ^ sw2) << 5); f.vb3 = vrow + ((3 ^ sw2) << 5);
    return f;
}
typedef short s16x4 __attribute__((ext_vector_type(4)));
__device__ __forceinline__ uint2 tr_read(const unsigned char* p) {
    const s16x4 v = __builtin_amdgcn_ds_read_tr16_b64_v4i16((LAS3 s16x4*)p);
    return __builtin_bit_cast(uint2, v);
}
#define NEGM (-1.0e37f)
__device__ __forceinline__ void nsa_scores(const unsigned char* Kl, const LaneOfs& f, const bf16x8& q0, const bf16x8& q1, float bias, f32x4 (&s)[4]) {
#pragma unroll
    for (int kt = 0; kt < 4; ++kt) {
        const bf16x8 a0 = *(const bf16x8*)(Kl + f.k0 + kt * 2048);
        const bf16x8 a1 = *(const bf16x8*)(Kl + f.k1 + kt * 2048);
        f32x4 z = (f32x4){bias, bias, bias, bias};
        z = __builtin_amdgcn_mfma_f32_16x16x32_bf16(a0, q0, z, 0, 0, 0);
        s[kt] = __builtin_amdgcn_mfma_f32_16x16x32_bf16(a1, q1, z, 0, 0, 0);
    }
}
#define ONES_BF16X8 __builtin_bit_cast(bf16x8, make_uint4(0x3F803F80u, 0x3F803F80u, 0x3F803F80u, 0x3F803F80u))
template <class VF>
__device__ __forceinline__ void attn_step(const unsigned char* Kl, const unsigned char* Vl, int lane, const LaneOfs& f,
                                          const bf16x8& q0, const bf16x8& q1, f32x4 (&o)[4], float& m, f32x4& lacc,
                                          float rowbias, bool full, VF valid) {
    f32x4 s[4];
    const bool mok = m > -1e29f;
    const float meff = mok ? m : 0.f;
    nsa_scores(Kl, f, q0, q1, rowbias - meff, s);
    if (!full) {
#pragma unroll
        for (int kt = 0; kt < 4; ++kt)
#pragma unroll
            for (int r = 0; r < 4; ++r) s[kt][r] = valid(kt * 16 + 4 * (lane >> 4) + r) ? s[kt][r] : NEGM;
    }
    float mx = fmaxf(fmaxf(fmaxf(s[0][0], s[0][1]), fmaxf(s[0][2], s[0][3])), fmaxf(fmaxf(s[1][0], s[1][1]), fmaxf(s[1][2], s[1][3])));
    mx = fmaxf(mx, fmaxf(fmaxf(fmaxf(s[2][0], s[2][1]), fmaxf(s[2][2], s[2][3])), fmaxf(fmaxf(s[3][0], s[3][1]), fmaxf(s[3][2], s[3][3]))));
    mx = xrow_max(mx);
    if (!__all(mok && (mx <= 8.f))) {
        const float mn = fmaxf(m, meff + mx);
        const float alpha = __builtin_amdgcn_exp2f(m - mn), d = mn - meff;
        m = mn; lacc[0] *= alpha;
#pragma unroll
        for (int dt = 0; dt < 4; ++dt) { o[dt][0] *= alpha; o[dt][1] *= alpha; o[dt][2] *= alpha; o[dt][3] *= alpha; }
#pragma unroll
        for (int kt = 0; kt < 4; ++kt) { s[kt][0] -= d; s[kt][1] -= d; s[kt][2] -= d; s[kt][3] -= d; }
    }
#pragma unroll
    for (int kt = 0; kt < 4; ++kt)
#pragma unroll
        for (int r = 0; r < 4; ++r) s[kt][r] = __builtin_amdgcn_exp2f(s[kt][r]);
#pragma unroll
    for (int k2 = 0; k2 < 2; ++k2) {
        uint4 pk;
        pk.x = pack2bf(s[2 * k2][0], s[2 * k2][1]); pk.y = pack2bf(s[2 * k2][2], s[2 * k2][3]);
        pk.z = pack2bf(s[2 * k2 + 1][0], s[2 * k2 + 1][1]); pk.w = pack2bf(s[2 * k2 + 1][2], s[2 * k2 + 1][3]);
        const bf16x8 pb = __builtin_bit_cast(bf16x8, pk);
        lacc = __builtin_amdgcn_mfma_f32_16x16x32_bf16(ONES_BF16X8, pb, lacc, 0, 0, 0);
#define PV1(dt_, vb_) { const uint2 lo_ = tr_read(Vl + (vb_) + k2 * 4096), hi_ = tr_read(Vl + (vb_) + k2 * 4096 + 2048); \
                        uint4 av_; av_.x = lo_.x; av_.y = lo_.y; av_.z = hi_.x; av_.w = hi_.y;                          \
                        o[dt_] = __builtin_amdgcn_mfma_f32_16x16x32_bf16(__builtin_bit_cast(bf16x8, av_), pb, o[dt_], 0, 0, 0); }
        PV1(0, f.vb0) PV1(1, f.vb1) PV1(2, f.vb2) PV1(3, f.vb3)
#undef PV1
    }
}
template <class VFA, class VFB>
__device__ __forceinline__ void attn_step2(const unsigned char* Kl, const unsigned char* Vl, int lane, const LaneOfs& f,
                                           const bf16x8& qA0, const bf16x8& qA1, f32x4 (&oA)[4], float& mA, f32x4& lA, float biasA, bool fullA, VFA validA,
                                           const bf16x8& qB0, const bf16x8& qB1, f32x4 (&oB)[4], float& mB, f32x4& lB, float biasB, bool fullB, VFB validB) {
    f32x4 sA[4], sB[4];
    const bool mokA = mA > -1e29f, mokB = mB > -1e29f;
    const float meA = mokA ? mA : 0.f, meB = mokB ? mB : 0.f;
    const float iA = biasA - meA, iB = biasB - meB;
#pragma unroll
    for (int kt = 0; kt < 4; ++kt) {
        const bf16x8 a0 = *(const bf16x8*)(Kl + f.k0 + kt * 2048);
        const bf16x8 a1 = *(const bf16x8*)(Kl + f.k1 + kt * 2048);
        f32x4 zA = (f32x4){iA, iA, iA, iA}, zB = (f32x4){iB, iB, iB, iB};
        zA = __builtin_amdgcn_mfma_f32_16x16x32_bf16(a0, qA0, zA, 0, 0, 0);
        zB = __builtin_amdgcn_mfma_f32_16x16x32_bf16(a0, qB0, zB, 0, 0, 0);
        sA[kt] = __builtin_amdgcn_mfma_f32_16x16x32_bf16(a1, qA1, zA, 0, 0, 0);
        sB[kt] = __builtin_amdgcn_mfma_f32_16x16x32_bf16(a1, qB1, zB, 0, 0, 0);
    }
    if (!fullA) {
#pragma unroll
        for (int kt = 0; kt < 4; ++kt)
#pragma unroll
            for (int r = 0; r < 4; ++r) sA[kt][r] = validA(kt * 16 + 4 * (lane >> 4) + r) ? sA[kt][r] : NEGM;
    }
    if (!fullB) {
#pragma unroll
        for (int kt = 0; kt < 4; ++kt)
#pragma unroll
            for (int r = 0; r < 4; ++r) sB[kt][r] = validB(kt * 16 + 4 * (lane >> 4) + r) ? sB[kt][r] : NEGM;
    }
    float mxA = fmaxf(fmaxf(fmaxf(sA[0][0], sA[0][1]), fmaxf(sA[0][2], sA[0][3])), fmaxf(fmaxf(sA[1][0], sA[1][1]), fmaxf(sA[1][2], sA[1][3])));
    float mxB = fmaxf(fmaxf(fmaxf(sB[0][0], sB[0][1]), fmaxf(sB[0][2], sB[0][3])), fmaxf(fmaxf(sB[1][0], sB[1][1]), fmaxf(sB[1][2], sB[1][3])));
    mxA = fmaxf(mxA, fmaxf(fmaxf(fmaxf(sA[2][0], sA[2][1]), fmaxf(sA[2][2], sA[2][3])), fmaxf(fmaxf(sA[3][0], sA[3][1]), fmaxf(sA[3][2], sA[3][3]))));
    mxB = fmaxf(mxB, fmaxf(fmaxf(fmaxf(sB[2][0], sB[2][1]), fmaxf(sB[2][2], sB[2][3])), fmaxf(fmaxf(sB[3][0], sB[3][1]), fmaxf(sB[3][2], sB[3][3]))));
    mxA = xrow_max(mxA); mxB = xrow_max(mxB);
    if (!__all(mokA && mokB && (mxA <= 8.f) && (mxB <= 8.f))) {
        const float mnA = fmaxf(mA, meA + mxA), mnB = fmaxf(mB, meB + mxB);
        const float alA = __builtin_amdgcn_exp2f(mA - mnA), alB = __builtin_amdgcn_exp2f(mB - mnB);
        const float dA = mnA - meA, dB = mnB - meB;
        mA = mnA; mB = mnB; lA[0] *= alA; lB[0] *= alB;
#pragma unroll
        for (int dt = 0; dt < 4; ++dt) {
            oA[dt][0] *= alA; oA[dt][1] *= alA; oA[dt][2] *= alA; oA[dt][3] *= alA;
            oB[dt][0] *= alB; oB[dt][1] *= alB; oB[dt][2] *= alB; oB[dt][3] *= alB;
        }
#pragma unroll
        for (int kt = 0; kt < 4; ++kt) {
            sA[kt][0] -= dA; sA[kt][1] -= dA; sA[kt][2] -= dA; sA[kt][3] -= dA;
            sB[kt][0] -= dB; sB[kt][1] -= dB; sB[kt][2] -= dB; sB[kt][3] -= dB;
        }
    }
#pragma unroll
    for (int kt = 0; kt < 4; ++kt)
#pragma unroll
        for (int r = 0; r < 4; ++r) { sA[kt][r] = __builtin_amdgcn_exp2f(sA[kt][r]); sB[kt][r] = __builtin_amdgcn_exp2f(sB[kt][r]); }
#pragma unroll
    for (int k2 = 0; k2 < 2; ++k2) {
        uint4 pk;
        pk.x = pack2bf(sA[2 * k2][0], sA[2 * k2][1]); pk.y = pack2bf(sA[2 * k2][2], sA[2 * k2][3]);
        pk.z = pack2bf(sA[2 * k2 + 1][0], sA[2 * k2 + 1][1]); pk.w = pack2bf(sA[2 * k2 + 1][2], sA[2 * k2 + 1][3]);
        const bf16x8 pbA = __builtin_bit_cast(bf16x8, pk);
        pk.x = pack2bf(sB[2 * k2][0], sB[2 * k2][1]); pk.y = pack2bf(sB[2 * k2][2], sB[2 * k2][3]);
        pk.z = pack2bf(sB[2 * k2 + 1][0], sB[2 * k2 + 1][1]); pk.w = pack2bf(sB[2 * k2 + 1][2], sB[2 * k2 + 1][3]);
        const bf16x8 pbB = __builtin_bit_cast(bf16x8, pk);
        lA = __builtin_amdgcn_mfma_f32_16x16x32_bf16(ONES_BF16X8, pbA, lA, 0, 0, 0);
        lB = __builtin_amdgcn_mfma_f32_16x16x32_bf16(ONES_BF16X8, pbB, lB, 0, 0, 0);
#define PV2(dt_, vb_) { const uint2 lo_ = tr_read(Vl + (vb_) + k2 * 4096), hi_ = tr_read(Vl + (vb_) + k2 * 4096 + 2048); \
                        uint4 av_; av_.x = lo_.x; av_.y = lo_.y; av_.z = hi_.x; av_.w = hi_.y;                          \
                        oA[dt_] = __builtin_amdgcn_mfma_f32_16x16x32_bf16(__builtin_bit_cast(bf16x8, av_), pbA, oA[dt_], 0, 0, 0); \
                        oB[dt_] = __builtin_amdgcn_mfma_f32_16x16x32_bf16(__builtin_bit_cast(bf16x8, av_), pbB, oB[dt_], 0, 0, 0); }
        PV2(0, f.vb0) PV2(1, f.vb1) PV2(2, f.vb2) PV2(3, f.vb3)
#undef PV2
    }
}

#define NSA_TILES 2048
__device__ __forceinline__ void nsa_tile(const Params& p, int tile, unsigned char* smem) {
    const int tid = opaque_tid(), lane = tid & 63, w = __builtin_amdgcn_readfirstlane(tid >> 6);
    const int bg = tile & 7, tb = 255 - (tile >> 3);
    const int b = bg >> 1, g = bg & 1;
    const int t0 = tb * 32, cur = t0 >> 6;
    float* impL = (float*)(smem + 32768);
    unsigned* selL = (unsigned*)(smem + 49152);
    const bf16_t* NQ = (const bf16_t*)(p.ws + OFF_NQ);
    const float* NG = (const float*)(p.ws + OFF_NGATE);
    const int rowq = lane & 15, tl = rowq >> 2, head = rowq & 3, lg = lane >> 4;
    const int toklA = 8 * w + tl, toklB = 8 * w + 4 + tl;
    const LaneOfs lof = make_lane_ofs(lane);
    const StageOfs sof = make_stage_ofs();
    const size_t tokb = (size_t)b * SEQ + t0;
    bf16x8 qA0, qA1, qB0, qB1;
    {
        const bf16_t* qp = NQ + (tokb + toklA) * 512 + g * 256 + head * 64 + lg * 8;
        qA0 = *(const bf16x8*)qp; qA1 = *(const bf16x8*)(qp + 32);
        qB0 = *(const bf16x8*)(qp + 4 * 512); qB1 = *(const bf16x8*)(qp + 4 * 512 + 32);
    }
    const float* gpA = NG + (tokb + toklA) * 24 + g * 12 + head * 3;
    const float* gpB = gpA + 4 * 24;
    __syncthreads();
    for (int i = tid; i < 4096; i += 256) impL[i] = 0.f;
    const int tqA = t0 + toklA, tqB = t0 + toklB;
    const int tminA = t0 + 8 * w, tminB = tminA + 4;
    f32x4 oA[4], oB[4], otA[4], otB[4];
    float mA, mB;
    f32x4 lA, lB;
#define NSA_RESET() { _Pragma("unroll") for (int dt = 0; dt < 4; ++dt) { oA[dt] = (f32x4){0.f, 0.f, 0.f, 0.f}; oB[dt] = (f32x4){0.f, 0.f, 0.f, 0.f}; } \
                      mA = -1e30f; mB = -1e30f; lA = (f32x4){0.f, 0.f, 0.f, 0.f}; lB = (f32x4){0.f, 0.f, 0.f, 0.f}; }
#define NSA_LSUM() { }

    const int nvA = (tqA >= 31) ? (((tqA - 31) >> 4) + 1) : 0;
    const int nvB = (tqB >= 31) ? (((tqB - 31) >> 4) + 1) : 0;
    const int nvminA = (tminA >= 31) ? (((tminA - 31) >> 4) + 1) : 0;
    const int nvminB = (tminB >= 31) ? (((tminB - 31) >> 4) + 1) : 0;
    const int nkb = (((t0 >> 4) + 1) + 63) >> 6;
    const bf16_t* ckb = (const bf16_t*)(p.ws + OFF_CMPKB) + (size_t)(b * 2 + g) * 512 * 64;
    const bf16_t* cvb = (const bf16_t*)(p.ws + OFF_CMPVB) + (size_t)(b * 2 + g) * 512 * 64;
    NSA_RESET()
    nsa_kv_loop(ckb, cvb, 64, 0, nkb - 1, smem, sof, [&](int kb, const unsigned char* Kl, const unsigned char* Vl) __attribute__((always_inline)) {
        attn_step2(Kl, Vl, lane, lof,
                   qA0, qA1, oA, mA, lA, 0.f, kb * 64 + 64 <= nvminA, [&](int key) __attribute__((always_inline)) { return kb * 64 + key < nvA; },
                   qB0, qB1, oB, mB, lB, 0.f, kb * 64 + 64 <= nvminB, [&](int key) __attribute__((always_inline)) { return kb * 64 + key < nvB; });
    });
    NSA_LSUM()
    const float mcA = mA, mcB = mB;
    const float invcA = 1.f / fmaxf(lA[0], 1e-30f), invcB = 1.f / fmaxf(lB[0], 1e-30f);
    {
        const float fA = gpA[0] * invcA, fB = gpB[0] * invcB;
#pragma unroll
        for (int dt = 0; dt < 4; ++dt) {
            otA[dt][0] = fA * oA[dt][0]; otA[dt][1] = fA * oA[dt][1]; otA[dt][2] = fA * oA[dt][2]; otA[dt][3] = fA * oA[dt][3];
            otB[dt][0] = fB * oB[dt][0]; otB[dt][1] = fB * oB[dt][1]; otB[dt][2] = fB * oB[dt][2]; otB[dt][3] = fB * oB[dt][3];
        }
    }
    if (cur >= 16) {
        nsa_kv_loop(ckb, cvb, 64, 0, nkb - 1, smem, sof, [&](int kb, const unsigned char* Kl, const unsigned char* Vl) __attribute__((always_inline)) {
#pragma unroll
            for (int mt = 0; mt < 2; ++mt) {
                f32x4 s[4];
                nsa_scores(Kl, lof, mt ? qB0 : qA0, mt ? qB1 : qA1, 0.f, s);
                const int nv = mt ? nvB : nvA;
                const float mc = mt ? mcB : mcA, inv = mt ? invcB : invcA;
                float* impT = impL + (mt ? toklB : toklA) * 128;
#pragma unroll
                for (int kt = 0; kt < 4; ++kt) {
                    float pr[4];
#pragma unroll
                    for (int r = 0; r < 4; ++r) {
                        const int n = kb * 64 + kt * 16 + 4 * lg + r;
                        pr[r] = (n < nv) ? __builtin_amdgcn_exp2f(s[kt][r] - mc) * inv : 0.f;
                    }
                    float c1 = pr[0] + pr[1] + pr[2] + 0.5f * pr[3], c2 = 0.5f * pr[3];
                    c1 += __shfl_xor(c1, 1); c1 += __shfl_xor(c1, 2);
                    c2 += __shfl_xor(c2, 1); c2 += __shfl_xor(c2, 2);
                    const int j = kb * 16 + kt * 4 + lg;
                    if (head == 0) {
                        atomicAdd(&impT[j], c1);
                        if (j + 1 < 128) atomicAdd(&impT[j + 1], c2);
                    }
                }
                    }
        });
#pragma unroll 1
        for (int pass = 0; pass < 2; ++pass) {
            const int tok = 8 * w + 4 * pass + lg, c = lane & 15;
            const float4 i0 = *(const float4*)(impL + tok * 128 + 8 * c), i1 = *(const float4*)(impL + tok * 128 + 8 * c + 4);
            const float iv[8] = {i0.x, i0.y, i0.z, i0.w, i1.x, i1.y, i1.z, i1.w};
            float kl[8];
#pragma unroll
            for (int q = 0; q < 8; ++q) {
                const int j = 8 * c + q;
                const bool forced = (j == 0) || (j == cur) || (j == cur - 1);
                const float sc = forced ? 1.0e4f : ((j <= cur) ? iv[q] : -1.f);
                kl[q] = enc_key(sc, (unsigned)j, 127);
            }
            float l0 = kl[0], l1 = kl[1], l2 = kl[2], l3 = kl[3], l4 = kl[4], l5 = kl[5], l6 = kl[6], l7 = kl[7];
            CE_DESC(l0, l1) CE_DESC(l2, l3) CE_DESC(l4, l5) CE_DESC(l6, l7)
            CE_DESC(l0, l2) CE_DESC(l1, l3) CE_DESC(l4, l6) CE_DESC(l5, l7)
            CE_DESC(l1, l2) CE_DESC(l5, l6)
            CE_DESC(l0, l4) CE_DESC(l1, l5) CE_DESC(l2, l6) CE_DESC(l3, l7)
            CE_DESC(l2, l4) CE_DESC(l3, l5)
            CE_DESC(l1, l2) CE_DESC(l3, l4) CE_DESC(l5, l6)
            unsigned pm = 0u;
#pragma unroll
            for (int k = 0; k < 16; ++k) {
                const float mx = row16_max(l0);
                const bool win = (l0 == mx);
                pm |= win ? (1u << (dec_idx(l0, 127) & 7u)) : 0u;
                l0 = win ? l1 : l0; l1 = win ? l2 : l1; l2 = win ? l3 : l2; l3 = win ? l4 : l3;
                l4 = win ? l5 : l4; l5 = win ? l6 : l5; l6 = win ? l7 : l6; l7 = win ? NEGKEY : l7;
            }
            ((unsigned char*)selL)[tok * 16 + c] = (unsigned char)pm;
        }
    } else {
        if (lane < 8) {
            const int tok = 8 * w + lane;
            selL[tok * 4 + 0] = (2u << cur) - 1u; selL[tok * 4 + 1] = 0u; selL[tok * 4 + 2] = 0u; selL[tok * 4 + 3] = 0u;
        }
    }
    WAVE_LDS_SYNC();
#if NSA_DIAG
    if (head == 0 && lg == 0) {
        unsigned* SELM = (unsigned*)(p.ws + OFF_SELM);
#pragma unroll
        for (int qd = 0; qd < 4; ++qd) {
            SELM[((size_t)bg * SEQ + tqA) * 4 + qd] = selL[toklA * 4 + qd];
            SELM[((size_t)bg * SEQ + tqB) * 4 + qd] = selL[toklB * 4 + qd];
        }
    }
#endif
    NSA_RESET()
    {
        const bf16_t* kg = (const bf16_t*)(p.ws + OFF_KV + 2 * KV_STRIDE) + (size_t)b * SEQ * 128 + g * 64;
        const bf16_t* vg = (const bf16_t*)(p.ws + OFF_KV + 3 * KV_STRIDE) + (size_t)b * SEQ * 128 + g * 64;
        nsa_kv_loop(kg, vg, 128, 0, cur, smem, sof, [&](int kb, const unsigned char* Kl, const unsigned char* Vl) __attribute__((always_inline)) {
            const bool svA = (selL[toklA * 4 + (kb >> 5)] >> (kb & 31)) & 1u;
            const bool svB = (selL[toklB * 4 + (kb >> 5)] >> (kb & 31)) & 1u;
            const bool nA = __ballot(svA) != 0ull, nB = __ballot(svB) != 0ull;
            if (nA && nB)
                attn_step2(Kl, Vl, lane, lof,
                           qA0, qA1, oA, mA, lA, svA ? 0.f : NEGM, kb < cur, [&](int key) __attribute__((always_inline)) { return kb * 64 + key <= tqA; },
                           qB0, qB1, oB, mB, lB, svB ? 0.f : NEGM, kb < cur, [&](int key) __attribute__((always_inline)) { return kb * 64 + key <= tqB; });
            else if (nA)
                attn_step(Kl, Vl, lane, lof, qA0, qA1, oA, mA, lA, svA ? 0.f : NEGM, kb < cur, [&](int key) __attribute__((always_inline)) { return kb * 64 + key <= tqA; });
            else if (nB)
                attn_step(Kl, Vl, lane, lof, qB0, qB1, oB, mB, lB, svB ? 0.f : NEGM, kb < cur, [&](int key) __attribute__((always_inline)) { return kb * 64 + key <= tqB; });
        });
    }
    NSA_LSUM()
    {
        const float fA = gpA[1] / fmaxf(lA[0], 1e-30f), fB = gpB[1] / fmaxf(lB[0], 1e-30f);
#pragma unroll
        for (int dt = 0; dt < 4; ++dt) {
            otA[dt][0] += fA * oA[dt][0]; otA[dt][1] += fA * oA[dt][1]; otA[dt][2] += fA * oA[dt][2]; otA[dt][3] += fA * oA[dt][3];
            otB[dt][0] += fB * oB[dt][0]; otB[dt][1] += fB * oB[dt][1]; otB[dt][2] += fB * oB[dt][2]; otB[dt][3] += fB * oB[dt][3];
        }
    }
    NSA_RESET()
    {
        const bf16_t* kg = (const bf16_t*)(p.ws + OFF_KV + 4 * KV_STRIDE) + (size_t)b * SEQ * 128 + g * 64;
        const bf16_t* vg = (const bf16_t*)(p.ws + OFF_KV + 5 * KV_STRIDE) + (size_t)b * SEQ * 128 + g * 64;
        const int klo = (t0 > 511) ? ((t0 - 511) >> 6) : 0;
        nsa_kv_loop(kg, vg, 128, klo, cur, smem, sof, [&](int kb, const unsigned char* Kl, const unsigned char* Vl) __attribute__((always_inline)) {
            attn_step2(Kl, Vl, lane, lof,
                       qA0, qA1, oA, mA, lA, 0.f, (kb * 64 >= tminA + 3 - 511) && (kb * 64 + 63 <= tminA),
                       [&](int key) __attribute__((always_inline)) { const int ka = kb * 64 + key; return (ka <= tqA) && (ka >= tqA - 511); },
                       qB0, qB1, oB, mB, lB, 0.f, (kb * 64 >= tminB + 3 - 511) && (kb * 64 + 63 <= tminB),
                       [&](int key) __attribute__((always_inline)) { const int ka = kb * 64 + key; return (ka <= tqB) && (ka >= tqB - 511); });
        });
    }
    NSA_LSUM()
    {
        const float fA = gpA[2] / fmaxf(lA[0], 1e-30f), fB = gpB[2] / fmaxf(lB[0], 1e-30f);
        bf16_t* MIX = (bf16_t*)(p.ws + OFF_XB) + (tokb + toklA) * DM + 512 + g * 256 + head * 64 + lg * 4;
#pragma unroll
        for (int dt = 0; dt < 4; ++dt) {
            uint2 ov;
            ov.x = pack2bf(otA[dt][0] + fA * oA[dt][0], otA[dt][1] + fA * oA[dt][1]);
            ov.y = pack2bf(otA[dt][2] + fA * oA[dt][2], otA[dt][3] + fA * oA[dt][3]);
            *(uint2*)(MIX + dt * 16) = ov;
            ov.x = pack2bf(otB[dt][0] + fB * oB[dt][0], otB[dt][1] + fB * oB[dt][1]);
            ov.y = pack2bf(otB[dt][2] + fB * oB[dt][2], otB[dt][3] + fB * oB[dt][3]);
            *(uint2*)(MIX + 4 * DM + dt * 16) = ov;
        }
    }
#undef NSA_RESET
#undef NSA_LSUM
}

__device__ __forceinline__ float block_sum(float v, float* red) {
    v = wave_sum(v);
    __syncthreads();
    if ((threadIdx.x & 63) == 0) red[threadIdx.x >> 6] = v;
    __syncthreads();
    return red[0] + red[1] + red[2] + red[3];
}
__device__ __forceinline__ float4 ln_row(float4 y, const float* g, const float* bb, float* red) {
    const int tid = opaque_tid();
    const float mu = block_sum(y.x + y.y + y.z + y.w, red) * (1.f / 1024.f);
    const float dx = y.x - mu, dy = y.y - mu, dz = y.z - mu, dw = y.w - mu;
    const float var = block_sum(dx * dx + dy * dy + dz * dz + dw * dw, red) * (1.f / 1024.f);
    const float rs = rsqrtf(var + LN_EPS);
    const float4 gg = ((const float4*)g)[tid], b4 = ((const float4*)bb)[tid];
    return make_float4(dx * rs * gg.x + b4.x, dy * rs * gg.y + b4.y, dz * rs * gg.z + b4.z, dw * rs * gg.w + b4.w);
}

__device__ __forceinline__ void ln1_phase(const Params& p, float* sm) {
    const int tid = opaque_tid();
    for (int n = blockIdx.x; n < NTOK; n += gridDim.x) {
        const float4 y = ((const float4*)(p.out + (size_t)n * DM))[tid];
        const float4 o = ln_row(y, p.in[15], p.in[16], sm);
        uint2 hb; hb.x = pack2bf(o.x, o.y); hb.y = pack2bf(o.z, o.w);
        ((uint2*)((bf16_t*)(p.ws + OFF_XB) + (size_t)n * DM))[tid] = hb;
    }
}


typedef float f32x2 __attribute__((ext_vector_type(2)));
__device__ __forceinline__ void cvt_rows_fp8(const float* __restrict__ src, unsigned char* __restrict__ dst, float* __restrict__ scales, int rows,
                                             int first_block, int nblocks) {
    const int tid_ = opaque_tid(), lane = tid_ & 63, w = __builtin_amdgcn_readfirstlane(tid_ >> 6);
    for (int r = ((int)blockIdx.x - first_block) * 4 + w; r < rows; r += nblocks * 4) {
        const float4* sp = (const float4*)(src + (size_t)r * 1024 + lane * 16);
        const float4 a = sp[0], b = sp[1], c = sp[2], d = sp[3];
        float mx = fmaxf(fmaxf(fmaxf(fabsf(a.x), fabsf(a.y)), fmaxf(fabsf(a.z), fabsf(a.w))), fmaxf(fmaxf(fabsf(b.x), fabsf(b.y)), fmaxf(fabsf(b.z), fabsf(b.w))));
        mx = fmaxf(mx, fmaxf(fmaxf(fmaxf(fabsf(c.x), fabsf(c.y)), fmaxf(fabsf(c.z), fabsf(c.w))), fmaxf(fmaxf(fabsf(d.x), fabsf(d.y)), fmaxf(fabsf(d.z), fabsf(d.w)))));
        mx = wave_max(mx);
        const float sc = (mx > 0.f) ? mx * (1.f / 448.f) : 1.f;
        const float inv = 1.f / sc;
        uint4 o;
        int t;
        t = 0; t = __builtin_amdgcn_cvt_pk_fp8_f32(a.x * inv, a.y * inv, t, false); t = __builtin_amdgcn_cvt_pk_fp8_f32(a.z * inv, a.w * inv, t, true); o.x = (unsigned)t;
        t = 0; t = __builtin_amdgcn_cvt_pk_fp8_f32(b.x * inv, b.y * inv, t, false); t = __builtin_amdgcn_cvt_pk_fp8_f32(b.z * inv, b.w * inv, t, true); o.y = (unsigned)t;
        t = 0; t = __builtin_amdgcn_cvt_pk_fp8_f32(c.x * inv, c.y * inv, t, false); t = __builtin_amdgcn_cvt_pk_fp8_f32(c.z * inv, c.w * inv, t, true); o.z = (unsigned)t;
        t = 0; t = __builtin_amdgcn_cvt_pk_fp8_f32(d.x * inv, d.y * inv, t, false); t = __builtin_amdgcn_cvt_pk_fp8_f32(d.z * inv, d.w * inv, t, true); o.w = (unsigned)t;
        *(uint4*)(dst + (size_t)r * 1024 + lane * 16) = o;
        if (lane == 0) scales[r] = sc;
    }
}

__device__ __forceinline__ void fold_ws_phase(const float* __restrict__ wq, const float* __restrict__ k1, const float* __restrict__ k2,
                                              bf16_t* __restrict__ WsT) {
    for (int it = blockIdx.x * 256 + threadIdx.x; it < 2048 * 128; it += gridDim.x * 256) {
        const int r = it & 2047, kg = it >> 11;
        const int a = (r >> 7) & 1, j = r & 127;
        const float* kr = (a ? k2 : k1) + j * 128;
        const float* wr = wq + (size_t)(kg * 8) * 2048 + (r & ~127);
        float s[8];
#pragma unroll
        for (int q = 0; q < 8; ++q) s[q] = 0.f;
        for (int d = 0; d < 128; d += 4) {
            const float4 kv = *(const float4*)(kr + d);
#pragma unroll
            for (int q = 0; q < 8; ++q) {
                const float4 wv = *(const float4*)(wr + (size_t)q * 2048 + d);
                s[q] += wv.x * kv.x + wv.y * kv.y + wv.z * kv.z + wv.w * kv.w;
            }
        }
        uint4 o;
        o.x = pack2bf(s[0], s[1]); o.y = pack2bf(s[2], s[3]); o.z = pack2bf(s[4], s[5]); o.w = pack2bf(s[6], s[7]);
        *(uint4*)(WsT + (size_t)r * 1024 + kg * 8) = o;
    }
}


struct EpiTop16 {
    float* topk; unsigned char* lds;
    __device__ __forceinline__ void operator()(int m, int n, f32x4 v) const {
        const int ml = m & 127, g4 = (n & 127) >> 2;
        *(float4*)(lds + ((ml * 32 + (g4 ^ (ml & 7))) << 4)) = make_float4(v[0], v[1], v[2], v[3]);
    }
    __device__ __forceinline__ void finish(int m0, int n0) const {
        __syncthreads();
        const int tid_ = opaque_tid(), lane = tid_ & 63, w = __builtin_amdgcn_readfirstlane(tid_ >> 6), c = lane & 15;
        const int L = n0 >> 7;
        for (int it = 0; it < 8; ++it) {
            const int r = w * 32 + it * 4 + (lane >> 4);
            const float4 x0 = *(const float4*)(lds + ((r * 32 + ((2 * c) ^ (r & 7))) << 4));
            const float4 x1 = *(const float4*)(lds + ((r * 32 + ((2 * c + 1) ^ (r & 7))) << 4));
            float l0 = enc_key(x0.x, 8 * c + 0, 127), l1 = enc_key(x0.y, 8 * c + 1, 127), l2 = enc_key(x0.z, 8 * c + 2, 127),
                  l3 = enc_key(x0.w, 8 * c + 3, 127), l4 = enc_key(x1.x, 8 * c + 4, 127), l5 = enc_key(x1.y, 8 * c + 5, 127),
                  l6 = enc_key(x1.z, 8 * c + 6, 127), l7 = enc_key(x1.w, 8 * c + 7, 127);
            CE_DESC(l0, l1) CE_DESC(l2, l3) CE_DESC(l4, l5) CE_DESC(l6, l7)
            CE_DESC(l0, l2) CE_DESC(l1, l3) CE_DESC(l4, l6) CE_DESC(l5, l7)
            CE_DESC(l1, l2) CE_DESC(l5, l6)
            CE_DESC(l0, l4) CE_DESC(l1, l5) CE_DESC(l2, l6) CE_DESC(l3, l7)
            CE_DESC(l2, l4) CE_DESC(l3, l5)
            CE_DESC(l1, l2) CE_DESC(l3, l4) CE_DESC(l5, l6)
            float res = NEGKEY;
#pragma unroll
            for (int k = 0; k < 16; ++k) {
                const float mx = row16_max(l0);
                const bool win = (l0 == mx);
                l0 = win ? l1 : l0; l1 = win ? l2 : l1; l2 = win ? l3 : l2; l3 = win ? l4 : l3;
                l4 = win ? l5 : l4; l5 = win ? l6 : l5; l6 = win ? l7 : l6; l7 = win ? NEGKEY : l7;
                res = (c == k) ? mx : res;
            }
            topk[(size_t)(m0 + r) * 256 + L * 16 + c] = res;
        }
        __syncthreads();
    }
};

template <int PART>
__device__ __forceinline__ void peer_fast_phase(const Params& p, unsigned char* smem) {
    const int tid = opaque_tid(), lane = tid & 63, w = __builtin_amdgcn_readfirstlane(tid >> 6), l16 = lane & 15, gq = lane >> 4;
    float* tk = (float*)(smem + w * 2048);
    int* ex = (int*)(smem + w * 2048 + 1024);
    float* gw = (float*)(smem + w * 2048 + 1536);
    const bf16_t* H1B = (const bf16_t*)(p.ws + OFF_XB);
    const unsigned char* U8 = p.ws + OFF_UB;
    const unsigned char* V8 = p.ws + OFF_VB;
    const float* USC = (const float*)(p.ws + OFF_USC);
    const float* VSC = (const float*)(p.ws + OFF_VSC);
    const float* TOPK = (const float*)(p.ws + OFF_TOPK);
    int ci[4], cj[4];
#pragma unroll
    for (int q = 0; q < 4; ++q) {
        const int s = l16 + 16 * q;
        int i, j;
        if (s < 16) { i = 0; j = s; }
        else if (s < 24) { i = 1; j = s - 16; }
        else if (s < 29) { i = 2; j = s - 24; }
        else if (s < 33) { i = 3; j = s - 29; }
        else if (s < 36) { i = 4; j = s - 33; }
        else if (s < 42) { i = 5 + ((s - 36) >> 1); j = (s - 36) & 1; }
        else if (s < 50) { i = 8 + (s - 42); j = 0; }
        else { i = -1; j = 0; }
        ci[q] = i; cj[q] = j;
    }
    int* exs = (int*)(smem + 8192 + w * 4096);
    float* gws = (float*)(smem + 8192 + w * 4096 + 2048);
    int* SEX = (int*)(p.ws + OFF_HQ);
    float* SGW = (float*)(p.ws + OFF_HLF);
    for (int qd = blockIdx.x * 4 + w; qd < NTOK / 4; qd += gridDim.x * 4) {
        const int n0 = qd * 4;
        if (PART == 0) {
#pragma unroll 1
        for (int t = 0; t < 4; ++t) {
            const int n = n0 + t;
            WAVE_LDS_SYNC();
            ((float4*)tk)[lane] = ((const float4*)(TOPK + (size_t)n * 256))[lane];
            WAVE_LDS_SYNC();
#pragma unroll
            for (int it = 0; it < 2; ++it) {
                const int head = it * 4 + gq;
                const float* ka = tk + head * 32;
                const float* kb = ka + 16;
                float c0, c1, c2, c3;
#define MKC(q, cq) { if (ci[q] >= 0) { const float sum_ = dec_val(ka[ci[q]], 127) + dec_val(kb[cj[q]], 127); \
                         cq = enc_key(sum_, ci[q] * 16 + cj[q], 255); } else cq = NEGKEY; }
                MKC(0, c0) MKC(1, c1) MKC(2, c2) MKC(3, c3)
#undef MKC
                float res = NEGKEY;
#pragma unroll
                for (int k = 0; k < 16; ++k) {
                    const float mx = row16_max(fmaxf(fmaxf(c0, c1), fmaxf(c2, c3)));
                    c0 = (c0 == mx) ? NEGKEY : c0; c1 = (c1 == mx) ? NEGKEY : c1;
                    c2 = (c2 == mx) ? NEGKEY : c2; c3 = (c3 == mx) ? NEGKEY : c3;
                    res = (l16 == k) ? mx : res;
                }
                const unsigned cc = dec_idx(res, 255);
                const float val = dec_val(res, 255);
                const unsigned e1 = dec_idx(ka[cc >> 4], 127), e2 = dec_idx(kb[cc & 15], 127);
                const float m0 = row16_max(val);
                const float e = expf(val - m0);
                const float ssum = row16_sum(e);
                ex[head * 16 + l16] = (int)(e1 * 128 + e2);
                gw[head * 16 + l16] = e / ssum;
            }
            WAVE_LDS_SYNC();
            {
                const int e0 = ex[lane], e1v = ex[lane + 64];
                const float g0 = gw[lane], g1 = gw[lane + 64];
                const int s0 = e0 >> 11, s1 = e1v >> 11;
                const unsigned long long lt = (1ull << lane) - 1ull;
                int base = 0, p0 = 0, p1 = 0;
#pragma unroll
                for (int s = 0; s < 8; ++s) {
                    const unsigned long long m0 = __ballot(s0 == s), m1 = __ballot(s1 == s);
                    const int c0 = __popcll(m0), c1 = __popcll(m1);
                    if (s0 == s) p0 = base + __popcll(m0 & lt);
                    if (s1 == s) p1 = base + c0 + __popcll(m1 & lt);
                    base += c0 + c1;
                }
                exs[t * 128 + p0] = e0; gws[t * 128 + p0] = g0; exs[t * 128 + p1] = e1v; gws[t * 128 + p1] = g1;
            }
        }
        WAVE_LDS_SYNC();
#pragma unroll
        for (int i = 0; i < 2; ++i) {
            ((uint4*)(SEX + (size_t)n0 * 128))[lane + 64 * i] = ((const uint4*)exs)[lane + 64 * i];
            ((uint4*)(SGW + (size_t)n0 * 128))[lane + 64 * i] = ((const uint4*)gws)[lane + 64 * i];
        }
        } else {
        WAVE_LDS_SYNC();
#pragma unroll
        for (int i = 0; i < 2; ++i) {
            ((uint4*)exs)[lane + 64 * i] = ((const uint4*)(SEX + (size_t)n0 * 128))[lane + 64 * i];
            ((uint4*)gws)[lane + 64 * i] = ((const uint4*)(SGW + (size_t)n0 * 128))[lane + 64 * i];
        }
        }
        if (PART == 1) {
        WAVE_LDS_SYNC();
        {
            f32x2 xp[32];
            {
                const uint4* xr = (const uint4*)(H1B + (size_t)(n0 + gq) * DM + 16 * l16);
#pragma unroll
                for (int i = 0; i < 4; ++i) {
                    const uint4 xa = xr[32 * i], xb = xr[32 * i + 1];
                    xp[8 * i + 0] = (f32x2){__uint_as_float(xa.x << 16), __uint_as_float(xa.x & 0xffff0000u)};
                    xp[8 * i + 1] = (f32x2){__uint_as_float(xa.y << 16), __uint_as_float(xa.y & 0xffff0000u)};
                    xp[8 * i + 2] = (f32x2){__uint_as_float(xa.z << 16), __uint_as_float(xa.z & 0xffff0000u)};
                    xp[8 * i + 3] = (f32x2){__uint_as_float(xa.w << 16), __uint_as_float(xa.w & 0xffff0000u)};
                    xp[8 * i + 4] = (f32x2){__uint_as_float(xb.x << 16), __uint_as_float(xb.x & 0xffff0000u)};
                    xp[8 * i + 5] = (f32x2){__uint_as_float(xb.y << 16), __uint_as_float(xb.y & 0xffff0000u)};
                    xp[8 * i + 6] = (f32x2){__uint_as_float(xb.z << 16), __uint_as_float(xb.z & 0xffff0000u)};
                    xp[8 * i + 7] = (f32x2){__uint_as_float(xb.w << 16), __uint_as_float(xb.w & 0xffff0000u)};
                }
            }
#pragma unroll 4
            for (int k = 0; k < 128; ++k) {
                const int e = exs[gq * 128 + k];
                const uint4* ur = (const uint4*)(U8 + (size_t)e * DM + 16 * l16);
                const uint4 a0 = ur[0], a1 = ur[16], a2 = ur[32], a3 = ur[48];
                const float usc = USC[e];
                f32x2 sA = (f32x2){0.f, 0.f}, sB = (f32x2){0.f, 0.f};
#define D8(W_, B_) { sA = __builtin_elementwise_fma(__builtin_amdgcn_cvt_pk_f32_fp8((int)(W_), false), xp[(B_)], sA);      \
                     sB = __builtin_elementwise_fma(__builtin_amdgcn_cvt_pk_f32_fp8((int)(W_), true), xp[(B_) + 1], sB); }
                D8(a0.x, 0) D8(a0.y, 2) D8(a0.z, 4) D8(a0.w, 6)
                D8(a1.x, 8) D8(a1.y, 10) D8(a1.z, 12) D8(a1.w, 14)
                D8(a2.x, 16) D8(a2.y, 18) D8(a2.z, 20) D8(a2.w, 22)
                D8(a3.x, 24) D8(a3.y, 26) D8(a3.z, 28) D8(a3.w, 30)
#undef D8
                float s = (sA[0] + sA[1]) + (sB[0] + sB[1]);
                s = row16_sum(s) * usc;
                gws[gq * 128 + k] = gws[gq * 128 + k] * gelu_tanh_fast(s) * VSC[e];
            }
        }
        WAVE_LDS_SYNC();
#pragma unroll
        for (int i = 0; i < 2; ++i) ((uint4*)(SGW + (size_t)n0 * 128))[lane + 64 * i] = ((const uint4*)gws)[lane + 64 * i];
        }
        if (PART == 2) {
        WAVE_LDS_SYNC();
        {
            f32x2 acc[32];
#pragma unroll
            for (int q = 0; q < 32; ++q) acc[q] = (f32x2){0.f, 0.f};
#pragma unroll 4
            for (int k = 0; k < 128; ++k) {
                const int e = exs[gq * 128 + k];
                const float wk = gws[gq * 128 + k];
                const f32x2 wk2 = (f32x2){wk, wk};
                const uint4* vr = (const uint4*)(V8 + (size_t)e * DM + 16 * l16);
                const uint4 a0 = vr[0], a1 = vr[16], a2 = vr[32], a3 = vr[48];
#define A4(W_, B_) { acc[(B_)] = __builtin_elementwise_fma(__builtin_amdgcn_cvt_pk_f32_fp8((int)(W_), false), wk2, acc[(B_)]);          \
                     acc[(B_) + 1] = __builtin_elementwise_fma(__builtin_amdgcn_cvt_pk_f32_fp8((int)(W_), true), wk2, acc[(B_) + 1]); }
                A4(a0.x, 0) A4(a0.y, 2) A4(a0.z, 4) A4(a0.w, 6)
                A4(a1.x, 8) A4(a1.y, 10) A4(a1.z, 12) A4(a1.w, 14)
                A4(a2.x, 16) A4(a2.y, 18) A4(a2.z, 20) A4(a2.w, 22)
                A4(a3.x, 24) A4(a3.y, 26) A4(a3.z, 28) A4(a3.w, 30)
#undef A4
            }
            float* orow = p.out + (size_t)(n0 + gq) * DM + 16 * l16;
            float sum = 0.f;
#pragma unroll
            for (int c = 0; c < 4; ++c)
#pragma unroll
                for (int hq = 0; hq < 4; ++hq) {
                    const uint2 hb_ = *(const uint2*)(H1B + (size_t)(n0 + gq) * DM + 16 * l16 + 256 * c + 4 * hq);
                    const float4 h = make_float4(__uint_as_float(hb_.x << 16), __uint_as_float(hb_.x & 0xffff0000u),
                                                 __uint_as_float(hb_.y << 16), __uint_as_float(hb_.y & 0xffff0000u));
                    f32x2& pa = acc[8 * c + 2 * hq]; f32x2& pb = acc[8 * c + 2 * hq + 1];
                    pa[0] = ALPHA * h.x + pa[0]; pa[1] = ALPHA * h.y + pa[1]; pb[0] = ALPHA * h.z + pb[0]; pb[1] = ALPHA * h.w + pb[1];
                    sum += (pa[0] + pa[1]) + (pb[0] + pb[1]);
                }
            const float mu = row16_sum(sum) * (1.f / 1024.f);
            float sq = 0.f;
#pragma unroll
            for (int q = 0; q < 32; ++q) { acc[q][0] -= mu; acc[q][1] -= mu; sq += acc[q][0] * acc[q][0] + acc[q][1] * acc[q][1]; }
            const float rs = rsqrtf(row16_sum(sq) * (1.f / 1024.f) + LN_EPS);
            const float* g = p.in[22] + 16 * l16;
            const float* bb = p.in[23] + 16 * l16;
#pragma unroll
            for (int c = 0; c < 4; ++c)
#pragma unroll
                for (int hq = 0; hq < 4; ++hq) {
                    const float4 gg = *(const float4*)(g + 256 * c + 4 * hq), b4 = *(const float4*)(bb + 256 * c + 4 * hq);
                    const f32x2 pa = acc[8 * c + 2 * hq], pb = acc[8 * c + 2 * hq + 1];
                    float4 o;
                    o.x = pa[0] * rs * gg.x + b4.x; o.y = pa[1] * rs * gg.y + b4.y;
                    o.z = pb[0] * rs * gg.z + b4.z; o.w = pb[1] * rs * gg.w + b4.w;
                    *(float4*)(orow + 256 * c + 4 * hq) = o;
                }
        }
        }
    }
}

#define XB_TMO      128
#define XB_XCNT(j)  (256  + 64 * (j))
#define XB_XSUB(j)  (1280 + 64 * (j))
#define XB_XGEN(j)  (2304 + 64 * (j))
#define XB_TOP      3328
#define XB_TOPGEN   3392
#define XCD_BAR_WORDS 3456
#define XB_SPIN_CAP (1u << 22)
__device__ __forceinline__ unsigned xb_ld(unsigned* p) { return __hip_atomic_load(p, __ATOMIC_RELAXED, __HIP_MEMORY_SCOPE_AGENT); }
__device__ __forceinline__ unsigned xb_add(unsigned* p, unsigned v) { return __hip_atomic_fetch_add(p, v, __ATOMIC_RELAXED, __HIP_MEMORY_SCOPE_AGENT); }
__device__ __forceinline__ unsigned xb_xcc_id() { return (unsigned)__builtin_amdgcn_s_getreg((3 << 11) | 20) & 0xFu; }
#define XB_SPIN(cond, bar) do { unsigned _sp = 0; while (cond) { __builtin_amdgcn_s_sleep(1); \
    if ((++_sp & 255u) == 0u) { if (xb_ld(&(bar)[XB_TMO])) break; if (_sp > XB_SPIN_CAP) { atomicAdd(&(bar)[XB_TMO], 1u); break; } } } } while (0)
struct XcdBarrier { unsigned* bar; unsigned x; unsigned* st; };
__device__ __forceinline__ XcdBarrier xcd_barrier_post(unsigned* bar, unsigned* st) {
    XcdBarrier b; b.bar = bar; b.x = xb_xcc_id(); b.st = st;
    if (threadIdx.x == 0) (void)xb_add(&bar[XB_XCNT(b.x)], 1u);
    return b;
}
__device__ __forceinline__ void xcd_barrier_complete(unsigned* bar, unsigned x, unsigned& nloc, unsigned& nx) {
    const unsigned G = gridDim.x * gridDim.y * gridDim.z;
    unsigned sum, cnt, mine, sp = 0u;
    for (;;) {
        sum = 0u; cnt = 0u; mine = 0u;
#pragma unroll
        for (unsigned j = 0; j < 16; ++j) { const unsigned c = xb_ld(&bar[XB_XCNT(j)]); sum += c; cnt += (c > 0u) ? 1u : 0u; mine = (j == x) ? c : mine; }
        if (sum == G) break;
        __builtin_amdgcn_s_sleep(1);
        if ((++sp & 255u) == 0u) { if (xb_ld(&bar[XB_TMO])) break; if (sp > XB_SPIN_CAP) { atomicAdd(&bar[XB_TMO], 1u); break; } }
    }
    nloc = mine > 0u ? mine : 1u; nx = cnt > 0u ? cnt : 1u;
}
__device__ __forceinline__ void xcd_barrier(const XcdBarrier& b) {
    asm volatile("s_waitcnt vmcnt(0)" ::: "memory");
    __syncthreads();
    if (threadIdx.x == 0) {
        unsigned* bar = b.bar;
        __builtin_amdgcn_s_waitcnt(0);
        unsigned nloc = xb_ld(&b.st[0]), nx = xb_ld(&b.st[1]);
        if (nloc == 0u) { xcd_barrier_complete(bar, b.x, nloc, nx); __hip_atomic_store(&b.st[0], nloc, __ATOMIC_RELAXED, __HIP_MEMORY_SCOPE_AGENT); __hip_atomic_store(&b.st[1], nx, __ATOMIC_RELAXED, __HIP_MEMORY_SCOPE_AGENT); }
        const unsigned old = xb_add(&bar[XB_XSUB(b.x)], 1u);
        const unsigned gen = old / nloc;
        if (old + 1u == (gen + 1u) * nloc) {
            __builtin_amdgcn_fence(__ATOMIC_RELEASE, "agent");
            asm volatile("s_waitcnt vmcnt(0)" ::: "memory");
            const unsigned og = xb_add(&bar[XB_TOP], 1u);
            const unsigned tg = og / nx;
            if (og + 1u == (tg + 1u) * nx) xb_add(&bar[XB_TOPGEN], 1u);
            else XB_SPIN(xb_ld(&bar[XB_TOPGEN]) == tg, bar);
            __builtin_amdgcn_fence(__ATOMIC_ACQUIRE, "agent");
            xb_add(&bar[XB_XGEN(b.x)], 1u);
            asm volatile("s_waitcnt vmcnt(0)" ::: "memory");
        } else {
            XB_SPIN(xb_ld(&bar[XB_XGEN(b.x)]) == gen, bar);
            __builtin_amdgcn_fence(__ATOMIC_ACQUIRE, "agent");
            asm volatile("s_waitcnt vmcnt(0)" ::: "memory");
        }
    }
    __syncthreads();
}

__global__ void __launch_bounds__(256, 2) mega(Params p) {
    cg::grid_group grid = cg::this_grid();
    __shared__ __attribute__((aligned(16))) unsigned char smem[65536];
    float* sm = (float*)smem;
    unsigned* barw = (unsigned*)(p.ws + OFF_BAR);
    const XcdBarrier xbar = xcd_barrier_post(barw, barw + XCD_BAR_WORDS + 2 * blockIdx.x);
    bf16_t* XB = (bf16_t*)(p.ws + OFF_XB);
    bf16_t* WinT = (bf16_t*)(p.ws + OFF_WINT);
    bf16_t* WoutT = (bf16_t*)(p.ws + OFF_WOUTT);
    bf16_t* WqT = (bf16_t*)(p.ws + OFF_WQT);
    cvt_rows_bf16(p.in[0], XB, (size_t)NTOK * DM / 8);
    transpose_bf16(p.in[1], DIN, 3456, WinT);
    transpose_bf16(p.in[2], DM, DM, WoutT);
    fold_ws_phase(p.in[17], p.in[18], p.in[19], WqT);
    transpose_bf16(p.in[6], 256, 256, (bf16_t*)(p.ws + OFF_W1T), 2048);
    transpose_bf16(p.in[11], 256, 256, (bf16_t*)(p.ws + OFF_W1T) + 256 * 2048, 2048);
    if (blockIdx.x == 0) {
        for (int c = threadIdx.x; c < 512; c += 256)
            ((float*)(p.ws + OFF_LBV))[c] = 1.f / (1.f + expf(p.in[3][512 + c] - p.in[3][c]));
        if (threadIdx.x < 16) ((float*)(p.ws + OFF_DIAG))[threadIdx.x] = 0.f;
    }
    if (blockIdx.x == 1 || blockIdx.x == 2) cmp_peb(p, blockIdx.x - 1);
    grid.sync();
    gemm_bf16_phase(XB, DM, WinT, DM, NTOK / 128, 27, smem, EpiProj{p.ws});
    xcd_barrier(xbar);
    for (int it = blockIdx.x; it < 128; it += gridDim.x) {
        const int which = it >> 6, t = it & 63;
        gemm_tile(ALoadCmp{(const bf16_t*)(p.ws + OFF_KV + (size_t)which * KV_STRIDE)},
                  (const bf16_t*)(p.ws + OFF_W1T) + (size_t)which * 256 * 2048, 2048, 32, (t >> 1) * 128, (t & 1) * 128, smem,
                  EpiCmpH{(bf16_t*)(p.ws + OFF_HB) + (size_t)which * 4096 * 256, (const float*)(p.ws + OFF_PEB) + which * 256});
    }
    for (int it = (blockIdx.x + gridDim.x - 128 % gridDim.x) % gridDim.x; it < 2048; it += gridDim.x) hgrn_passA(p, it, smem);
#if NSA_DIAG
    for (int it = blockIdx.x; it < 2 * 4 * NCB * 2; it += gridDim.x) compress_item(p, it, sm);
#endif
    xcd_barrier(xbar);
    if (blockIdx.x < 256) hgrn_scan_item(p, blockIdx.x);
    else {
        cvt_rows_fp8(p.in[20], p.ws + OFF_UB, (float*)(p.ws + OFF_USC), 16384, 256, gridDim.x - 256);
        cvt_rows_fp8(p.in[21], p.ws + OFF_VB, (float*)(p.ws + OFF_VSC), 16384, 256, gridDim.x - 256);
    }
    if (gridDim.x <= 256) {
        cvt_rows_fp8(p.in[20], p.ws + OFF_UB, (float*)(p.ws + OFF_USC), 16384, 0, gridDim.x);
        cvt_rows_fp8(p.in[21], p.ws + OFF_VB, (float*)(p.ws + OFF_VSC), 16384, 0, gridDim.x);
    }
    cmp_layer2_phase(p, 0, gridDim.x);
    xcd_barrier(xbar);
    {
        const int qi = blockIdx.x & 7;
        unsigned* qctr = barw + XCD_BAR_WORDS + 2 * 1024 + 64 * qi;
        for (;;) {
            __syncthreads();
            if (threadIdx.x == 0) *(volatile unsigned*)smem = atomicAdd(qctr, 1u);
            __syncthreads();
            const int it = (int)__builtin_amdgcn_readfirstlane(*(volatile unsigned*)smem);
            if (it >= 256) break;
            nsa_tile(p, (it << 3) | qi, smem);
        }
        for (;;) {
            __syncthreads();
            if (threadIdx.x == 0) *(volatile unsigned*)smem = atomicAdd(qctr + 32, 1u);
            __syncthreads();
            const int it = (int)__builtin_amdgcn_readfirstlane(*(volatile unsigned*)smem);
            if (it >= 256) break;
            hgrn_passC(p, (it << 3) | qi, smem);
        }
    }
    xcd_barrier(xbar);
#if NSA_DIAG
    for (int it = blockIdx.x; it < 4 * 2 * SEQ; it += gridDim.x) nsa_item(p, it, sm);
    grid.sync();
    {
        const float* DG = (const float*)(p.ws + OFF_DIAG);
#if NSA_DIAG == 1
        const float cval = -log10f(sqrtf(DG[0] / DG[1]) + 1e-9f);
#else
        const float cval = -log10f(DG[2] / DG[3] + 1e-6f);
#endif
        for (size_t i = (size_t)blockIdx.x * 256 + threadIdx.x; i < (size_t)NTOK * DM; i += (size_t)gridDim.x * 256) p.out[i] = cval;
        return;
    }
#endif
    gemm_bf16_phase(XB, DM, WoutT, DM, NTOK / 128, 8, smem, EpiY{p.in[0], p.out});
    xcd_barrier(xbar);
    ln1_phase(p, sm);
    xcd_barrier(xbar);
    gemm_bf16_phase(XB, DM, WqT, DM, NTOK / 128, 16, smem, EpiTop16{(float*)(p.ws + OFF_TOPK), smem});
    xcd_barrier(xbar);
    peer_fast_phase<0>(p, smem);
    peer_fast_phase<1>(p, smem);
    peer_fast_phase<2>(p, smem);
}

extern "C" void kernel_launch(void* const* d_in, const int* in_sizes, int n_in, void* d_out, int out_size,
                              void* d_ws, size_t ws_size, hipStream_t stream) {
    static int grid_blocks = 0;
    if (!grid_blocks) {
        int dev = 0, cus = 0, per_cu = 0;
        hipGetDevice(&dev);
        hipDeviceGetAttribute(&cus, hipDeviceAttributeMultiprocessorCount, dev);
        hipOccupancyMaxActiveBlocksPerMultiprocessor(&per_cu, mega, 256, 0);
        if (per_cu > 4) per_cu = 4;
        if (per_cu < 1) per_cu = 1;
        grid_blocks = cus * per_cu;
        if (n_in != 24 || ws_size < WS_NEED || out_size != NTOK * DM)
            fprintf(stderr, "kernel_launch: unexpected sizes n_in=%d ws=%zu out=%d\n", n_in, ws_size, out_size);
    }
    Params p;
    memset(&p, 0, sizeof(p));
    for (int i = 0; i < 24; ++i) p.in[i] = (const float*)d_in[i];
    p.out = (float*)d_out;
    p.ws = (unsigned char*)d_ws;
    hipMemsetAsync((char*)d_ws + OFF_BAR, 0, BAR_BYTES, stream);
    void* args[] = {&p};
    hipError_t e = hipLaunchCooperativeKernel((void*)mega, dim3(grid_blocks), dim3(256), args, 0, stream);
    if (e != hipSuccess) fprintf(stderr, "cooperative launch failed: %s (grid %d)\n", hipGetErrorString(e), grid_blocks);
}
```

```cpp
#include <hip/hip_runtime.h>
#include <hip/hip_cooperative_groups.h>
#include <cstdio>
#include <cstring>
namespace cg = cooperative_groups;

#define NTOK 32768
#define SEQ 8192
#define DM 1024
#define DIN 3352
#define NCB 511
#define ALPHA 1.189207115002721f
#define LN_EPS 1e-5f

#define MB_ 1048576ull
#define OFF_XB 0ull
#define OFF_HQ (64 * MB_)
#define OFF_HLF (96 * MB_)
#define OFF_HI (160 * MB_)
#define OFF_HG (192 * MB_)
#define OFF_NQ (224 * MB_)
#define OFF_KV (256 * MB_)
#define KV_STRIDE (8 * MB_)
#define OFF_NGATE (304 * MB_)
#define OFF_CMPK (308 * MB_)
#define OFF_CMPV (309 * MB_)
#define OFF_WINT (310 * MB_)
#define OFF_WOUTT (317 * MB_)
#define OFF_WQT (319 * MB_)
#define OFF_LBV (323 * MB_)
#define OFF_DC (324 * MB_)
#define OFF_SC (325 * MB_)
#define OFF_UB (389 * MB_)
#define OFF_VB (421 * MB_)
#define OFF_TOPK (453 * MB_)
#define OFF_W1T (485 * MB_)
#define OFF_HB (487 * MB_)
#define OFF_CMPKB (491 * MB_)
#define OFF_CMPVB (491 * MB_ + 524288ull)
#define OFF_PEB (492 * MB_)
#define OFF_SELM (493 * MB_)
#define OFF_DIAG (494 * MB_)
#define OFF_USC (494 * MB_ + 131072ull)
#define OFF_VSC (494 * MB_ + 196608ull)
#define OFF_BAR (494 * MB_ + 65536ull)
#define BAR_BYTES 32768
#define WS_NEED (495 * MB_)
#define USE_NSA_MFMA 1
#define NSA_DIAG 0

struct Params {
    const float* in[24];
    float* out;
    unsigned char* ws;
};

typedef float f32x16 __attribute__((ext_vector_type(16)));
#define WAVE_LDS_SYNC() asm volatile("s_waitcnt lgkmcnt(0)" ::: "memory")
#define LAS3 __attribute__((address_space(3)))

__device__ __forceinline__ int opaque_tid() { int t = threadIdx.x; asm volatile("" : "+v"(t)); return t; }
__device__ __forceinline__ float wave_sum(float v) {
#pragma unroll
    for (int o = 32; o; o >>= 1) v += __shfl_xor(v, o);
    return v;
}
__device__ __forceinline__ float wave_max(float v) {
#pragma unroll
    for (int o = 32; o; o >>= 1) v = fmaxf(v, __shfl_xor(v, o));
    return v;
}
__device__ __forceinline__ float sigmoidf_(float x) { return 1.f / (1.f + expf(-x)); }
__device__ __forceinline__ float gelu_tanh_fast(float x) {
    const float u = 0.7978845608028654f * (x + 0.044715f * x * x * x);
    return x * __builtin_amdgcn_rcpf(1.f + __builtin_amdgcn_exp2f(-2.885390081777927f * u));
}
__device__ __forceinline__ float gelu_tanh(float x) {
    const float c = 0.7978845608028654f;
    return 0.5f * x * (1.f + tanhf(c * (x + 0.044715f * x * x * x)));
}

typedef short bf16x8 __attribute__((ext_vector_type(8)));
typedef float f32x4 __attribute__((ext_vector_type(4)));
typedef unsigned short bf16_t;

typedef __bf16 bf16x2_t __attribute__((ext_vector_type(2)));
__device__ __forceinline__ unsigned pack2bf(float lo, float hi) {
    bf16x2_t v; v[0] = (__bf16)lo; v[1] = (__bf16)hi;
    return __builtin_bit_cast(unsigned, v);
}
__device__ __forceinline__ unsigned f2bf(float f) { return pack2bf(f, 0.f) & 0xffffu; }
__device__ __forceinline__ float bf2f(unsigned h) { return __uint_as_float(h << 16); }

__device__ __forceinline__ void cvt_rows_bf16(const float* __restrict__ src, bf16_t* __restrict__ dst, size_t n8) {
    for (size_t i = (size_t)blockIdx.x * 256 + threadIdx.x; i < n8; i += (size_t)gridDim.x * 256) {
        const float4 a = ((const float4*)src)[2 * i], b = ((const float4*)src)[2 * i + 1];
        uint4 o;
        o.x = pack2bf(a.x, a.y); o.y = pack2bf(a.z, a.w); o.z = pack2bf(b.x, b.y); o.w = pack2bf(b.z, b.w);
        ((uint4*)dst)[i] = o;
    }
}
__device__ __forceinline__ void transpose_bf16(const float* __restrict__ src, int Nsrc, int Npad, bf16_t* __restrict__ dst, int K = 1024) {
    const size_t total = (size_t)Npad * (K / 8);
    for (size_t i = (size_t)blockIdx.x * 256 + threadIdx.x; i < total; i += (size_t)gridDim.x * 256) {
        const int n = (int)(i % Npad), kg = (int)(i / Npad);
        float v[8];
#pragma unroll
        for (int j = 0; j < 8; ++j) v[j] = (n < Nsrc) ? src[(size_t)(kg * 8 + j) * Nsrc + n] : 0.f;
        uint4 o;
        o.x = pack2bf(v[0], v[1]); o.y = pack2bf(v[2], v[3]); o.z = pack2bf(v[4], v[5]); o.w = pack2bf(v[6], v[7]);
        *(uint4*)(dst + (size_t)n * K + kg * 8) = o;
    }
}

struct ALoadStd {
    const bf16_t* A; int lda;
    __device__ __forceinline__ const bf16_t* ptr(int row, int ks) const { return A + (size_t)row * lda + ks * 64; }
};
struct ALoadCmp {
    const bf16_t* KC;
    __device__ __forceinline__ const bf16_t* ptr(int row, int ks) const {
        const int r = row < 4088 ? row : 4087;
        const int g = r & 1, bn = r >> 1, n = bn % NCB, b = bn / NCB;
        return KC + ((size_t)(b * SEQ + 16 * n + ks) * 128 + g * 64);
    }
};
#define GLDS1(i, ks, buf) { const int row_ = 8 * w + 32 * (i) + (lane >> 3);                                                    \
        __builtin_amdgcn_global_load_lds((const unsigned*)(aload.ptr(m0 + row_, (ks)) + (((lane & 7) ^ (lane >> 3)) << 3)),      \
                                         (LAS3 unsigned*)(lds + (buf) * 32768 + w * 1024 + (i) * 4096), 16, 0, 0);              \
        __builtin_amdgcn_global_load_lds((const unsigned*)(Bp + (size_t)row_ * ldb + (ks) * 64 + (((lane & 7) ^ (lane >> 3)) << 3)), \
                                         (LAS3 unsigned*)(lds + (buf) * 32768 + 16384 + w * 1024 + (i) * 4096), 16, 0, 0); }
#define GEMM_GLDS(ks, buf) { GLDS1(0, ks, buf) GLDS1(1, ks, buf) GLDS1(2, ks, buf) GLDS1(3, ks, buf) }
template <class ALoad, class Epi>
__device__ __forceinline__ void gemm_tile(const ALoad aload, const bf16_t* __restrict__ Bt, int ldb, int KS, int m0, int n0,
                                          unsigned char* lds, Epi epi) {
    const int tid = opaque_tid(), lane = tid & 63, w = __builtin_amdgcn_readfirstlane(tid >> 6), wm = w >> 1, wn = w & 1;
    f32x4 acc[4][4];
#pragma unroll
    for (int j = 0; j < 4; ++j)
#pragma unroll
        for (int i = 0; i < 4; ++i) acc[j][i] = (f32x4){0.f, 0.f, 0.f, 0.f};
    const bf16_t* Bp = Bt + (size_t)n0 * ldb;
    __syncthreads();
    GEMM_GLDS(0, 0)
    asm volatile("s_waitcnt vmcnt(0)" ::: "memory");
    __syncthreads();
    for (int ks = 0; ks < KS; ++ks) {
        if (ks + 1 < KS) GEMM_GLDS(ks + 1, (ks + 1) & 1)
        const unsigned char* la = lds + (ks & 1) * 32768;
        const unsigned char* lb = la + 16384;
#pragma unroll
        for (int s = 0; s < 2; ++s) {
            bf16x8 af[4], wf[4];
            const int ch = s * 4 + (lane >> 4);
#pragma unroll
            for (int i = 0; i < 4; ++i) {
                const int row = wm * 64 + i * 16 + (lane & 15);
                af[i] = *(const bf16x8*)(la + row * 128 + ((ch ^ (row & 7)) << 4));
            }
#pragma unroll
            for (int j = 0; j < 4; ++j) {
                const int row = wn * 64 + j * 16 + (lane & 15);
                wf[j] = *(const bf16x8*)(lb + row * 128 + ((ch ^ (row & 7)) << 4));
            }
#pragma unroll
            for (int j = 0; j < 4; ++j)
#pragma unroll
                for (int i = 0; i < 4; ++i)
                    acc[j][i] = __builtin_amdgcn_mfma_f32_16x16x32_bf16(wf[j], af[i], acc[j][i], 0, 0, 0);
        }
        asm volatile("s_waitcnt vmcnt(0)" ::: "memory");
        __syncthreads();
    }
#pragma unroll
    for (int j = 0; j < 4; ++j)
#pragma unroll
        for (int i = 0; i < 4; ++i)
            epi(m0 + wm * 64 + i * 16 + (lane & 15), n0 + wn * 64 + j * 16 + (lane >> 4) * 4, acc[j][i]);
    epi.finish(m0, n0);
}
template <class Epi>
__device__ __forceinline__ void gemm_bf16_phase(const bf16_t* __restrict__ A, int lda, const bf16_t* __restrict__ Bt, int ldb,
                                                int Mtiles, int Ntiles, unsigned char* lds, Epi epi) {
    if ((gridDim.x & 7) == 0 && (Mtiles & 31) == 0) {
        const int x = blockIdx.x & 7, j = blockIdx.x >> 3, nb = gridDim.x >> 3;
        const int per = (Mtiles >> 3) * Ntiles;
        for (int q = j; q < per; q += nb) {
            const int s = q / (4 * Ntiles), rem = q - s * (4 * Ntiles);
            const int c = rem >> 2, r = rem & 3;
            const int mt = x + 8 * (4 * s + r);
            gemm_tile(ALoadStd{A, lda}, Bt, ldb, 16, mt * 128, c * 128, lds, epi);
        }
    } else {
        for (int tile = blockIdx.x; tile < Mtiles * Ntiles; tile += gridDim.x) {
            const int mt = tile / Ntiles, nt = tile % Ntiles;
            gemm_tile(ALoadStd{A, lda}, Bt, ldb, 16, mt * 128, nt * 128, lds, epi);
        }
    }
}

struct EpiF32 {
    float* C; int ldc; int Nc;
    __device__ __forceinline__ void operator()(int m, int n, f32x4 v) const {
        if (n < Nc) *(float4*)(C + (size_t)m * ldc + n) = make_float4(v[0], v[1], v[2], v[3]);
    }
    __device__ __forceinline__ void finish(int, int) const {}
};

struct EpiProj {
    unsigned char* ws;
    __device__ __forceinline__ void operator()(int m, int n, f32x4 v) const {
        const int ct = n >> 7;
        if (ct < 4) {
            uint2 o; o.x = pack2bf(v[0], v[1]); o.y = pack2bf(v[2], v[3]);
            *(uint2*)((bf16_t*)(ws + OFF_HQ) + (size_t)m * 512 + n) = o;
        } else if (ct < 8) {
            const int c = n - 512;
            const float4 lb = *(const float4*)((const float*)(ws + OFF_LBV) + c);
            float4 o;
            o.x = logf(lb.x + (1.f - lb.x) * sigmoidf_(v[0])); o.y = logf(lb.y + (1.f - lb.y) * sigmoidf_(v[1]));
            o.z = logf(lb.z + (1.f - lb.z) * sigmoidf_(v[2])); o.w = logf(lb.w + (1.f - lb.w) * sigmoidf_(v[3]));
            *(float4*)((float*)(ws + OFF_HLF) + (size_t)m * 512 + c) = o;
        } else if (ct < 12) {
            uint2 o; o.x = pack2bf(v[0], v[1]); o.y = pack2bf(v[2], v[3]);
            *(uint2*)((bf16_t*)(ws + OFF_HI) + (size_t)m * 512 + (n - 1024)) = o;
        } else if (ct < 16) {
            uint2 o; o.x = pack2bf(v[0], v[1]); o.y = pack2bf(v[2], v[3]);
            *(uint2*)((bf16_t*)(ws + OFF_HG) + (size_t)m * 512 + (n - 1536)) = o;
        } else if (ct < 20) {
            const float qs_ = 0.125f * 1.4426950408889634f;
            uint2 o; o.x = pack2bf(qs_ * v[0], qs_ * v[1]); o.y = pack2bf(qs_ * v[2], qs_ * v[3]);
            *(uint2*)((bf16_t*)(ws + OFF_NQ) + (size_t)m * 512 + (n - 2048)) = o;
        } else if (ct < 26) {
            uint2 o; o.x = pack2bf(v[0], v[1]); o.y = pack2bf(v[2], v[3]);
            *(uint2*)((bf16_t*)(ws + OFF_KV + (size_t)(ct - 20) * KV_STRIDE) + (size_t)m * 128 + (n & 127)) = o;
        } else {
            const int c = n - 3328;
            if (c < 24)
                *(float4*)((float*)(ws + OFF_NGATE) + (size_t)m * 24 + c) =
                    make_float4(sigmoidf_(v[0]), sigmoidf_(v[1]), sigmoidf_(v[2]), sigmoidf_(v[3]));
        }
    }
    __device__ __forceinline__ void finish(int, int) const {}
};
struct EpiY {
    const float* x; float* y;
    __device__ __forceinline__ void operator()(int m, int n, f32x4 v) const {
        const float4 xv = *(const float4*)(x + (size_t)m * DM + n);
        *(float4*)(y + (size_t)m * DM + n) = make_float4(ALPHA * xv.x + v[0], ALPHA * xv.y + v[1], ALPHA * xv.z + v[2], ALPHA * xv.w + v[3]);
    }
    __device__ __forceinline__ void finish(int, int) const {}
};

__device__ __forceinline__ uint4 pack8bf(const float* v) {
    uint4 o;
    o.x = pack2bf(v[0], v[1]); o.y = pack2bf(v[2], v[3]); o.z = pack2bf(v[4], v[5]); o.w = pack2bf(v[6], v[7]);
    return o;
}

__device__ __forceinline__ void hgrn_passA(const Params& p, int chunk, unsigned char* smem) {
    const int c = chunk & 127, bh = chunk >> 7, h = bh & 3, b = bh >> 2;
    const int tid = opaque_tid(), d = tid & 127, hf = __builtin_amdgcn_readfirstlane(tid >> 7), lane = tid & 63, w = __builtin_amdgcn_readfirstlane(tid >> 6);
    const size_t tok0 = (size_t)b * SEQ + (size_t)c * 64 + 32 * hf;
    const float* HLF = (const float*)(p.ws + OFF_HLF);
    const bf16_t* HI = (const bf16_t*)(p.ws + OFF_HI);
    unsigned char* KT = smem;
    unsigned char* VT = smem + 16384;
    float* xch = (float*)(smem + 32768);
    const float* lfp = HLF + tok0 * 512 + h * 128 + d;
    const bf16_t* vp = HI + tok0 * 512 + h * 128 + d;
    float run = 0.f;
#pragma unroll 8
    for (int s = 0; s < 32; ++s) run += lfp[s * 512];
    __syncthreads();
    xch[hf * 128 + d] = run;
    __syncthreads();
    const float tot0 = xch[d], tot1 = xch[128 + d];
    const float blast = tot0 + tot1;
    run = hf ? tot0 : 0.f;
#pragma unroll 1
    for (int q = 0; q < 4; ++q) {
        float kv[8], vv[8];
#pragma unroll
        for (int j = 0; j < 8; ++j) {
            const int s = q * 8 + j;
            const float lf = lfp[s * 512];
            run += lf;
            kv[j] = (1.f - expf(lf)) * expf(blast - run);
            vv[j] = bf2f(vp[s * 512]);
        }
        const int ch = 4 * hf + q;
        *(uint4*)(KT + d * 128 + ((ch ^ (d & 7)) << 4)) = pack8bf(kv);
        *(uint4*)(VT + d * 128 + ((ch ^ (d & 7)) << 4)) = pack8bf(vv);
    }
    if (hf) ((float*)(p.ws + OFF_DC))[(size_t)chunk * 128 + d] = expf(blast);
    __syncthreads();
    f32x4 acc[2][8];
#pragma unroll
    for (int i = 0; i < 2; ++i)
#pragma unroll
        for (int et = 0; et < 8; ++et) acc[i][et] = (f32x4){0.f, 0.f, 0.f, 0.f};
#pragma unroll
    for (int st = 0; st < 2; ++st) {
        const int ch = st * 4 + (lane >> 4);
        bf16x8 af[2];
#pragma unroll
        for (int i = 0; i < 2; ++i) {
            const int row = (2 * w + i) * 16 + (lane & 15);
            af[i] = *(const bf16x8*)(KT + row * 128 + ((ch ^ (row & 7)) << 4));
        }
#pragma unroll
        for (int et = 0; et < 8; ++et) {
            const int row = et * 16 + (lane & 15);
            const bf16x8 bfv = *(const bf16x8*)(VT + row * 128 + ((ch ^ (row & 7)) << 4));
            acc[0][et] = __builtin_amdgcn_mfma_f32_16x16x32_bf16(af[0], bfv, acc[0][et], 0, 0, 0);
            acc[1][et] = __builtin_amdgcn_mfma_f32_16x16x32_bf16(af[1], bfv, acc[1][et], 0, 0, 0);
        }
    }
    bf16_t* HC = (bf16_t*)p.out + (size_t)chunk * 16384;
#pragma unroll
    for (int i = 0; i < 2; ++i)
#pragma unroll
        for (int et = 0; et < 8; ++et) {
            const int e = et * 16 + (lane & 15), d0 = (2 * w + i) * 16 + (lane >> 4) * 4;
            { uint2 hv; hv.x = pack2bf(acc[i][et][0], acc[i][et][1]); hv.y = pack2bf(acc[i][et][2], acc[i][et][3]); *(uint2*)(HC + e * 128 + d0) = hv; }
        }
}

__device__ __forceinline__ void hgrn_scan_item(const Params& p, int item) {
    const int gid = item * 256 + threadIdx.x;
    const int d4 = gid & 31, e = (gid >> 5) & 127, bh = gid >> 12;
    const bf16_t* HC = (const bf16_t*)p.out;
    const float* DC = (const float*)(p.ws + OFF_DC);
    bf16_t* SC = (bf16_t*)(p.ws + OFF_SC);
    float4 S = make_float4(0.f, 0.f, 0.f, 0.f);
#pragma unroll 4
    for (int c = 0; c < 128; ++c) {
        const size_t base = ((size_t)(bh * 128 + c) * 128 + e) * 128 + d4 * 4;
        const uint2 hb = *(const uint2*)(HC + base);
        const float4 H = make_float4(__uint_as_float(hb.x << 16), __uint_as_float(hb.x & 0xffff0000u), __uint_as_float(hb.y << 16), __uint_as_float(hb.y & 0xffff0000u));
        const float4 dc = *(const float4*)(DC + (size_t)(bh * 128 + c) * 128 + d4 * 4);
        uint2 o; o.x = pack2bf(S.x, S.y); o.y = pack2bf(S.z, S.w);
        *(uint2*)(SC + base) = o;
        S.x = dc.x * S.x + H.x; S.y = dc.y * S.y + H.y; S.z = dc.z * S.z + H.z; S.w = dc.w * S.w + H.w;
    }
}

__device__ __forceinline__ void hgrn_passC(const Params& p, int chunk, unsigned char* smem) {
    const int c = chunk & 127, bh = chunk >> 7, h = bh & 3, b = bh >> 2;
    const int tid = opaque_tid(), d = tid & 127, hf = __builtin_amdgcn_readfirstlane(tid >> 7), lane = tid & 63, w = __builtin_amdgcn_readfirstlane(tid >> 6);
    const size_t tokc = (size_t)b * SEQ + (size_t)c * 64;
    const size_t tok0 = tokc + 32 * hf;
    const float* HLF = (const float*)(p.ws + OFF_HLF);
    const bf16_t* HQ = (const bf16_t*)(p.ws + OFF_HQ);
    const bf16_t* HI = (const bf16_t*)(p.ws + OFF_HI);
    const bf16_t* HG = (const bf16_t*)(p.ws + OFF_HG);
    unsigned char* R0 = smem;
    unsigned char* R1 = smem + 16384;
    unsigned char* R2 = smem + 57344;
    float* xch = (float*)R2;
    const float* lfp = HLF + tok0 * 512 + h * 128 + d;
    const bf16_t* qp = HQ + tok0 * 512 + h * 128 + d;
    float run = 0.f, b15 = 0.f;
#pragma unroll 8
    for (int s = 0; s < 32; ++s) { run += lfp[s * 512]; if (s == 15) b15 = run; }
    __syncthreads();
    xch[hf * 128 + d] = run;
    if (hf == 0) xch[256 + d] = b15;
    __syncthreads();
    const float tot0 = xch[d];
    const float off = hf ? tot0 : 0.f;
    const float r1 = xch[256 + d], r2 = tot0;
    if (hf) xch[384 + d] = off + b15;
    run = off;
#pragma unroll 8
    for (int s = 0; s < 32; ++s) {
        const int t = 32 * hf + s;
        run += lfp[s * 512];
        const float qv = bf2f(qp[s * 512]);
        *(bf16_t*)(R0 + t * 256 + ((((d >> 3) ^ (t & 15))) << 4) + (d & 7) * 2) = (bf16_t)f2bf(qv * expf(run));
    }
    {
        const bf16_t* SCp = (const bf16_t*)(p.ws + OFF_SC) + (size_t)chunk * 16384;
#pragma unroll
        for (int i = 0; i < 8; ++i) {
            const int cc = tid + 256 * i, row = cc >> 4, ch = cc & 15;
            *(uint4*)(R1 + row * 256 + ((ch ^ (row & 15)) << 4)) = *(const uint4*)(SCp + row * 128 + ch * 8);
        }
    }
    __syncthreads();
    f32x4 acc[8];
#pragma unroll
    for (int et = 0; et < 8; ++et) acc[et] = (f32x4){0.f, 0.f, 0.f, 0.f};
#pragma unroll
    for (int ds = 0; ds < 4; ++ds) {
        const int ch = ds * 4 + (lane >> 4);
        const int trow = w * 16 + (lane & 15);
        const bf16x8 bq = *(const bf16x8*)(R0 + trow * 256 + ((ch ^ (trow & 15)) << 4));
#pragma unroll
        for (int et = 0; et < 8; ++et) {
            const int row = et * 16 + (lane & 15);
            const bf16x8 av = *(const bf16x8*)(R1 + row * 256 + ((ch ^ (row & 15)) << 4));
            acc[et] = __builtin_amdgcn_mfma_f32_16x16x32_bf16(av, bq, acc[et], 0, 0, 0);
        }
    }
    __syncthreads();
    {
        const float r3 = xch[384 + d];
        run = off;
        unsigned char* dummy = R2 + 4096 + d * 2;
#pragma unroll 8
        for (int s = 0; s < 32; ++s) {
            const int t = 32 * hf + s;
            const int it = t >> 4;
            const float rr = (it == 0) ? 0.f : (it == 1) ? r1 : (it == 2) ? r2 : r3;
            const int sw = (((d >> 3) ^ (t & 15)) << 4) + (d & 7) * 2;
            const float lf = lfp[s * 512];
            run += lf;
            const float qv = bf2f(qp[s * 512]);
            const float kv = 1.f - expf(lf);
            *(bf16_t*)(R0 + t * 256 + sw) = (bf16_t)f2bf(qv * expf(run - rr));
#pragma unroll
            for (int i = 0; i < 4; ++i) {
                const float ri = (i == 0) ? 0.f : (i == 1) ? r1 : (i == 2) ? r2 : r3;
                const int R = 8 * i * (i + 1) + t;
                unsigned char* dst = (i >= it) ? (R1 + R * 256 + sw) : dummy;
                *(bf16_t*)dst = (bf16_t)f2bf(kv * expf(fminf(ri - run, 80.f)));
            }
        }
    }
    __syncthreads();
#pragma unroll
    for (int j = 0; j < 4; ++j) {
        uint2 o = make_uint2(0u, 0u);
        if (j <= w) {
            f32x4 pa = (f32x4){0.f, 0.f, 0.f, 0.f};
#pragma unroll
            for (int ds = 0; ds < 4; ++ds) {
                const int ch = ds * 4 + (lane >> 4);
                const int krow = 8 * w * (w + 1) + 16 * j + (lane & 15);
                const int trow = w * 16 + (lane & 15);
                const bf16x8 av = *(const bf16x8*)(R1 + krow * 256 + ((ch ^ (krow & 15)) << 4));
                const bf16x8 bq = *(const bf16x8*)(R0 + trow * 256 + ((ch ^ (trow & 15)) << 4));
                pa = __builtin_amdgcn_mfma_f32_16x16x32_bf16(av, bq, pa, 0, 0, 0);
            }
            if (j == w) {
                const int tl = lane & 15, sl = (lane >> 4) * 4;
#pragma unroll
                for (int r = 0; r < 4; ++r) if (sl + r > tl) pa[r] = 0.f;
            }
            o.x = pack2bf(pa[0], pa[1]); o.y = pack2bf(pa[2], pa[3]);
        }
        const int t = w * 16 + (lane & 15);
        const int ch = 2 * j + (lane >> 5);
        *(uint2*)(R2 + t * 128 + ((ch ^ (t & 7)) << 4) + ((lane >> 4) & 1) * 8) = o;
    }
    __syncthreads();
#pragma unroll
    for (int q = 0; q < 4; ++q) {
        float vv[8];
#pragma unroll
        for (int j = 0; j < 8; ++j) vv[j] = bf2f(HI[(tok0 + q * 8 + j) * 512 + h * 128 + d]);
        const int ch = 4 * hf + q;
        *(uint4*)(R1 + d * 128 + ((ch ^ (d & 7)) << 4)) = pack8bf(vv);
    }
    __syncthreads();
#pragma unroll
    for (int st = 0; st < 2; ++st) {
        const int ch = st * 4 + (lane >> 4);
        const int trow = w * 16 + (lane & 15);
        const bf16x8 bp = *(const bf16x8*)(R2 + trow * 128 + ((ch ^ (trow & 7)) << 4));
#pragma unroll
        for (int et = 0; et < 8; ++et) {
            const int row = et * 16 + (lane & 15);
            const bf16x8 av = *(const bf16x8*)(R1 + row * 128 + ((ch ^ (row & 7)) << 4));
            acc[et] = __builtin_amdgcn_mfma_f32_16x16x32_bf16(av, bp, acc[et], 0, 0, 0);
        }
    }
    {
        float ss = 0.f;
#pragma unroll
        for (int et = 0; et < 8; ++et)
#pragma unroll
            for (int r = 0; r < 4; ++r) ss += acc[et][r] * acc[et][r];
        ss += __shfl_xor(ss, 16);
        ss += __shfl_xor(ss, 32);
        const float rs = rsqrtf(ss * (1.f / 128.f) + LN_EPS);
        const size_t tok = tokc + w * 16 + (lane & 15);
        const float* ng = p.in[4];
        bf16_t* MIX = (bf16_t*)(p.ws + OFF_XB);
#pragma unroll
        for (int et = 0; et < 8; ++et) {
            const int e0 = et * 16 + (lane >> 4) * 4;
            const uint2 gb = *(const uint2*)(HG + tok * 512 + h * 128 + e0);
            const float4 n4 = *(const float4*)(ng + e0);
            const float g0 = bf2f(gb.x & 0xffffu), g1 = bf2f(gb.x >> 16), g2 = bf2f(gb.y & 0xffffu), g3 = bf2f(gb.y >> 16);
            uint2 o;
            o.x = pack2bf(acc[et][0] * rs * n4.x * (g0 * sigmoidf_(g0)), acc[et][1] * rs * n4.y * (g1 * sigmoidf_(g1)));
            o.y = pack2bf(acc[et][2] * rs * n4.z * (g2 * sigmoidf_(g2)), acc[et][3] * rs * n4.w * (g3 * sigmoidf_(g3)));
            *(uint2*)(MIX + tok * DM + h * 128 + e0) = o;
        }
    }
}

__device__ __forceinline__ void compress_item(const Params& p, int item, float* sm) {
    const int g = item & 1;
    int r = item >> 1;
    const int n = r % NCB; r /= NCB;
    const int b = r & 3, which = r >> 2;
    const int tid = opaque_tid();
    const bf16_t* kvsrc = (const bf16_t*)(p.ws + OFF_KV + (size_t)which * KV_STRIDE);
    const float* pe = p.in[which ? 10 : 5];
    const float* w1 = p.in[which ? 11 : 6];
    const float* b1 = p.in[which ? 12 : 7];
    const float* w2 = p.in[which ? 13 : 8];
    const float* b2 = p.in[which ? 14 : 9];
    float* outp = (float*)(p.ws + (which ? OFF_CMPV : OFF_CMPK));
    float* blk = sm;
    float* hh = sm + 2048;
    __syncthreads();
    for (int i = tid; i < 2048; i += 256) {
        const int l = i >> 6, d = i & 63;
        blk[i] = bf2f(kvsrc[(size_t)(b * SEQ + 16 * n + l) * 128 + g * 64 + d]) + pe[i];
    }
    __syncthreads();
    float acc = b1[tid];
    for (int i = 0; i < 2048; ++i) acc += blk[i] * w1[(size_t)i * 256 + tid];
    hh[tid] = gelu_tanh(acc);
    __syncthreads();
    if (tid < 64) {
        float o = b2[tid];
        for (int j = 0; j < 256; ++j) o += hh[j] * w2[j * 64 + tid];
        outp[((size_t)(b * NCB + n) * 2 + g) * 64 + tid] = o;
    }
}

__device__ __forceinline__ float dot64_bf(const float* qs, const bf16_t* krow) {
    float s = 0.f;
#pragma unroll
    for (int i = 0; i < 8; ++i) {
        const uint4 kv = ((const uint4*)krow)[i];
        const float4 q0 = ((const float4*)qs)[2 * i], q1 = ((const float4*)qs)[2 * i + 1];
        s += __uint_as_float(kv.x << 16) * q0.x + __uint_as_float(kv.x & 0xffff0000u) * q0.y
           + __uint_as_float(kv.y << 16) * q0.z + __uint_as_float(kv.y & 0xffff0000u) * q0.w
           + __uint_as_float(kv.z << 16) * q1.x + __uint_as_float(kv.z & 0xffff0000u) * q1.y
           + __uint_as_float(kv.w << 16) * q1.z + __uint_as_float(kv.w & 0xffff0000u) * q1.w;
    }
    return s;
}
__device__ __forceinline__ float dot64(const float* qs, const float* krow) {
    float s = 0.f;
#pragma unroll
    for (int i = 0; i < 16; ++i) {
        const float4 kv = ((const float4*)krow)[i];
        const float4 qv = ((const float4*)qs)[i];
        s += kv.x * qv.x + kv.y * qv.y + kv.z * qv.z + kv.w * qv.w;
    }
    return s;
}

__device__ __forceinline__ void nsa_item(const Params& p, int item, float* sm) {
    const int t = item & (SEQ - 1), g = (item >> 13) & 1, b = item >> 14;
    const int tid = threadIdx.x, lane = tid & 63, r = tid >> 6;
    float* sc = sm + r * 1024;
    float* qs = sm + 4096 + r * 64;
    float* impv = sm + 4096 + 256;
    int* sel = (int*)(sm + 4096 + 256 + 128);
    const bf16_t* KSb = (const bf16_t*)(p.ws + OFF_KV + 2 * KV_STRIDE);
    const bf16_t* VSb = (const bf16_t*)(p.ws + OFF_KV + 3 * KV_STRIDE);
    const bf16_t* KWb = (const bf16_t*)(p.ws + OFF_KV + 4 * KV_STRIDE);
    const bf16_t* VWb = (const bf16_t*)(p.ws + OFF_KV + 5 * KV_STRIDE);
    const float* cmpk = (const float*)(p.ws + OFF_CMPK);
    const float* cmpv = (const float*)(p.ws + OFF_CMPV);
    const size_t n = (size_t)b * SEQ + t;
    const float NEGV = -1e30f;
    __syncthreads();
    qs[lane] = bf2f(((const bf16_t*)(p.ws + OFF_NQ))[n * 512 + g * 256 + r * 64 + lane]) * 0.6931471805599453f;
    __syncthreads();

    const int nvalid = (t >= 31) ? (((t - 31) >> 4) + 1) : 0;
    float m = NEGV;
    for (int n0 = 0; n0 < nvalid; n0 += 64) {
        const int nn = n0 + lane;
        if (nn < nvalid) {
            const float s = dot64(qs, cmpk + ((size_t)(b * NCB + nn) * 2 + g) * 64);
            sc[nn] = s;
            m = fmaxf(m, s);
        }
    }
    m = wave_max(m);
    float sum = 0.f;
    for (int n0 = 0; n0 < nvalid; n0 += 64) {
        const int nn = n0 + lane;
        if (nn < nvalid) { const float e = expf(sc[nn] - m); sc[nn] = e; sum += e; }
    }
    sum = wave_sum(sum);
    {
        const float inv = 1.f / fmaxf(sum, 1e-30f);
        for (int n0 = 0; n0 < nvalid; n0 += 64) {
            const int nn = n0 + lane;
            if (nn < nvalid) sc[nn] *= inv;
        }
    }
    __syncthreads();
    float oc = 0.f;
    for (int nn = 0; nn < nvalid; ++nn) oc += sc[nn] * cmpv[((size_t)(b * NCB + nn) * 2 + g) * 64 + lane];

    const int cur = t >> 6;
    if (tid < 128) {
        const int j = tid;
        float im = 0.f;
#pragma unroll
        for (int rr = 0; rr < 4; ++rr) {
            const float* P = sm + rr * 1024;
            const int n4 = 4 * j;
            float a = 0.f;
            if (n4 < nvalid) a += P[n4];
            if (n4 + 1 < nvalid) a += P[n4 + 1];
            if (n4 + 2 < nvalid) a += P[n4 + 2];
            if (n4 + 3 < nvalid) a += 0.5f * P[n4 + 3];
            if (n4 - 1 >= 0 && n4 - 1 < nvalid) a += 0.5f * P[n4 - 1];
            im += a;
        }
        const bool forced = (j == 0) || (j == cur) || (j == cur - 1);
        const bool causal = (j <= cur);
        impv[j] = forced ? 1.0e4f : (causal ? im : -1.f);
    }
    __syncthreads();
    if (r == 0) {
        float v0 = impv[lane], v1 = impv[lane + 64];
        for (int k = 0; k < 16; ++k) {
            const float mx = wave_max(fmaxf(v0, v1));
            const unsigned long long b0 = __ballot(v0 == mx);
            int idx;
            if (b0) {
                const int l = __ffsll((unsigned long long)b0) - 1;
                idx = l;
                if (lane == l) v0 = -3.0e38f;
            } else {
                const unsigned long long b1 = __ballot(v1 == mx);
                const int l = __ffsll((unsigned long long)b1) - 1;
                idx = 64 + l;
                if (lane == l) v1 = -3.0e38f;
            }
            if (lane == 0) sel[k] = idx;
        }
    }
    __syncthreads();

    m = NEGV;
    for (int si = 0; si < 16; ++si) {
        const int blk = sel[si];
        const int key = blk * 64 + lane;
        float s = NEGV;
        if (blk * 64 <= t) {
            if (key <= t) s = dot64_bf(qs, KSb + ((size_t)b * SEQ + key) * 128 + g * 64);
        }
        sc[si * 64 + lane] = s;
        m = fmaxf(m, s);
    }
    m = wave_max(m);
    sum = 0.f;
    for (int si = 0; si < 16; ++si) {
        const int key = sel[si] * 64 + lane;
        const float e = (key <= t) ? expf(sc[si * 64 + lane] - m) : 0.f;
        sc[si * 64 + lane] = e;
        sum += e;
    }
    sum = wave_sum(sum);
    {
        const float inv = 1.f / fmaxf(sum, 1e-30f);
        for (int si = 0; si < 16; ++si) sc[si * 64 + lane] *= inv;
    }
    __syncthreads();
    float os = 0.f;
    for (int si = 0; si < 16; ++si) {
        const int blk = sel[si];
        if (blk * 64 > t) continue;
        for (int kk = 0; kk < 64; ++kk) {
            const int key = blk * 64 + kk;
            if (key > t) break;
            os += sc[si * 64 + kk] * bf2f(VSb[((size_t)b * SEQ + key) * 128 + g * 64 + lane]);
        }
    }
    __syncthreads();

    const int lo = t - 511;
    m = NEGV;
    for (int i = 0; i < 8; ++i) {
        const int key = lo + i * 64 + lane;
        float s = NEGV;
        if (key >= 0) s = dot64_bf(qs, KWb + ((size_t)b * SEQ + key) * 128 + g * 64);
        sc[i * 64 + lane] = s;
        m = fmaxf(m, s);
    }
    m = wave_max(m);
    sum = 0.f;
    for (int i = 0; i < 8; ++i) {
        const int key = lo + i * 64 + lane;
        const float e = (key >= 0) ? expf(sc[i * 64 + lane] - m) : 0.f;
        sc[i * 64 + lane] = e;
        sum += e;
    }
    sum = wave_sum(sum);
    {
        const float inv = 1.f / fmaxf(sum, 1e-30f);
        for (int i = 0; i < 8; ++i) sc[i * 64 + lane] *= inv;
    }
    __syncthreads();
    float ow = 0.f;
    for (int idx = 0; idx < 512; ++idx) {
        const int key = lo + idx;
        if (key < 0) continue;
        ow += sc[idx] * bf2f(VWb[((size_t)b * SEQ + key) * 128 + g * 64 + lane]);
    }
    const float* grow = (const float*)(p.ws + OFF_NGATE) + n * 24 + g * 12 + r * 3;
    const float gc = grow[0], gs = grow[1], gw = grow[2];
#if NSA_DIAG
    {
        const float ref = gc * oc + gs * os + gw * ow;
        const float got = bf2f(((const bf16_t*)(p.ws + OFF_XB))[n * DM + 512 + g * 256 + r * 64 + lane]);
        const unsigned* SELM = (const unsigned*)(p.ws + OFF_SELM) + ((size_t)(b * 2 + g) * SEQ + t) * 4;
        unsigned gm[4] = {0u, 0u, 0u, 0u};
        for (int si = 0; si < 16; ++si) { const int blk = sel[si]; if (blk * 64 <= t) gm[blk >> 5] |= 1u << (blk & 31); }
        bool same = true;
        for (int qd = 0; qd < 4; ++qd) {
            unsigned mm = SELM[qd];
            for (int bit = 0; bit < 32; ++bit) if ((qd * 32 + bit) * 64 > t) mm &= ~(1u << bit);
            if (mm != gm[qd]) same = false;
        }
        float d2 = same ? (got - ref) * (got - ref) : 0.f, r2 = same ? ref * ref : 0.f;
        d2 = wave_sum(d2); r2 = wave_sum(r2);
        float* DG = (float*)(p.ws + OFF_DIAG);
        if (lane == 0) { atomicAdd(&DG[0], d2); atomicAdd(&DG[1], r2); if (r == 0) { atomicAdd(&DG[2], same ? 0.f : 1.f); atomicAdd(&DG[3], 1.f); } }
    }
#else
    ((bf16_t*)(p.ws + OFF_XB))[n * DM + 512 + g * 256 + r * 64 + lane] = (bf16_t)f2bf(gc * oc + gs * os + gw * ow);
#endif
}


__device__ __forceinline__ float xrow_max(float x) {
    auto s = __builtin_amdgcn_permlane16_swap(__float_as_uint(x), __float_as_uint(x), false, false);
    x = fmaxf(__uint_as_float(s[0]), __uint_as_float(s[1]));
    auto t = __builtin_amdgcn_permlane32_swap(__float_as_uint(x), __float_as_uint(x), false, false);
    return fmaxf(__uint_as_float(t[0]), __uint_as_float(t[1]));
}
__device__ __forceinline__ float xrow_sum(float x) {
    auto s = __builtin_amdgcn_permlane16_swap(__float_as_uint(x), __float_as_uint(x), false, false);
    x = __uint_as_float(s[0]) + __uint_as_float(s[1]);
    auto t = __builtin_amdgcn_permlane32_swap(__float_as_uint(x), __float_as_uint(x), false, false);
    return __uint_as_float(t[0]) + __uint_as_float(t[1]);
}
template <int CTRL> __device__ __forceinline__ float dppf(float x) {
    return __builtin_bit_cast(float, __builtin_amdgcn_mov_dpp(__builtin_bit_cast(int, x), CTRL, 0xf, 0xf, true));
}
__device__ __forceinline__ float row16_max(float m) {
    m = fmaxf(m, dppf<0x121>(m)); m = fmaxf(m, dppf<0x122>(m));
    m = fmaxf(m, dppf<0x124>(m)); m = fmaxf(m, dppf<0x128>(m));
    return m;
}
__device__ __forceinline__ float row16_sum(float m) {
    m += dppf<0x121>(m); m += dppf<0x122>(m); m += dppf<0x124>(m); m += dppf<0x128>(m);
    return m;
}
__device__ __forceinline__ float dot2bf(unsigned a, unsigned b, float acc) {
    return __builtin_amdgcn_fdot2_f32_bf16(__builtin_bit_cast(bf16x2_t, a), __builtin_bit_cast(bf16x2_t, b), acc, false);
}
__device__ __forceinline__ float enc_key(float v, unsigned idx, unsigned mask) {
    const unsigned u = __float_as_uint(v);
    const unsigned code = (u >> 31) ? idx : (mask - idx);
    return __uint_as_float((u & ~mask) | code);
}
__device__ __forceinline__ unsigned dec_idx(float key, unsigned mask) {
    const unsigned u = __float_as_uint(key);
    const unsigned code = u & mask;
    return (u >> 31) ? code : (mask - code);
}
__device__ __forceinline__ float dec_val(float key, unsigned mask) { return __uint_as_float(__float_as_uint(key) & ~mask); }
#define NEGKEY (-3.0e38f)
#define CE_DESC(a, b) { const float t_ = fmaxf(a, b); b = fminf(a, b); a = t_; }

struct EpiCmpH {
    bf16_t* HB; const float* peb;
    __device__ __forceinline__ void operator()(int m, int n, f32x4 v) const {
        const float4 pb = *(const float4*)(peb + n);
        uint2 o;
        o.x = pack2bf(gelu_tanh(v[0] + pb.x), gelu_tanh(v[1] + pb.y));
        o.y = pack2bf(gelu_tanh(v[2] + pb.z), gelu_tanh(v[3] + pb.w));
        *(uint2*)(HB + (size_t)m * 256 + n) = o;
    }
    __device__ __forceinline__ void finish(int, int) const {}
};
__device__ __forceinline__ void cmp_peb(const Params& p, int which) {
    const float* pe = p.in[which ? 10 : 5];
    const float* w1 = p.in[which ? 11 : 6];
    const float* b1 = p.in[which ? 12 : 7];
    const int j = threadIdx.x;
    float acc = b1[j];
    for (int i = 0; i < 2048; ++i) acc += pe[i] * w1[(size_t)i * 256 + j];
    ((float*)(p.ws + OFF_PEB))[which * 256 + j] = acc;
}
__device__ __forceinline__ void cmp_layer2_phase(const Params& p, int first_block, int nblocks) {
    const int tid_ = opaque_tid(), lane = tid_ & 63, w = __builtin_amdgcn_readfirstlane(tid_ >> 6);
    for (int it = (blockIdx.x - first_block) * 4 + w; it < 2 * 4088; it += nblocks * 4) {
        const int which = it >= 4088, row = which ? it - 4088 : it;
        const float* w2 = p.in[which ? 13 : 8];
        const float* b2 = p.in[which ? 14 : 9];
        const bf16_t* hrow = (const bf16_t*)(p.ws + OFF_HB) + ((size_t)which * 4096 + row) * 256;
        float o = b2[lane];
#pragma unroll 8
        for (int j = 0; j < 256; ++j) o += bf2f(hrow[j]) * w2[j * 64 + lane];
        const int g = row & 1, bn = row >> 1, n = bn % NCB, b = bn / NCB;
        ((bf16_t*)(p.ws + (which ? OFF_CMPVB : OFF_CMPKB)))[((size_t)(b * 2 + g) * 512 + n) * 64 + lane] = (bf16_t)f2bf(o);
    }
}

struct StageOfs { int k, v; };
__device__ __forceinline__ StageOfs make_stage_ofs() {
    const int c0 = opaque_tid(), key = c0 >> 3, ch = c0 & 7;
    StageOfs s;
    s.k = key * 128 + ((ch ^ (key & 7)) << 4);
    s.v = key * 128 + (((ch >> 1) ^ ((key >> 1) & 3)) << 5) + (ch & 1) * 16;
    return s;
}
#define NSA_KV_LOAD(S_, kb_) { const bf16_t* kp_ = Kbase + (size_t)(kb_) * 64 * stride + (size_t)(tid >> 3) * stride + (tid & 7) * 8; \
        const bf16_t* vp_ = Vbase + (size_t)(kb_) * 64 * stride + (size_t)(tid >> 3) * stride + (tid & 7) * 8;                 \
        S_##k0 = *(const uint4*)kp_; S_##k1 = *(const uint4*)(kp_ + (size_t)32 * stride);                                    \
        S_##v0 = *(const uint4*)vp_; S_##v1 = *(const uint4*)(vp_ + (size_t)32 * stride); }
#define NSA_KV_STORE(S_, Kl_, Vl_) { *(uint4*)((Kl_) + sof.k) = S_##k0; *(uint4*)((Kl_) + sof.k + 4096) = S_##k1; \
        *(uint4*)((Vl_) + sof.v) = S_##v0; *(uint4*)((Vl_) + sof.v + 4096) = S_##v1; }
template <class Compute>
__device__ __forceinline__ void nsa_kv_loop(const bf16_t* __restrict__ Kbase, const bf16_t* __restrict__ Vbase, int stride,
                                            int kb_lo, int kb_hi, unsigned char* smem, const StageOfs& sof, Compute compute) {
    const int tid = opaque_tid();
    uint4 ra_k0, ra_k1, ra_v0, ra_v1;
    NSA_KV_LOAD(ra_, kb_lo)
    __syncthreads();
    NSA_KV_STORE(ra_, smem, smem + 16384)
    __syncthreads();
    for (int kb = kb_lo; kb <= kb_hi; ++kb) {
        const int buf = (kb - kb_lo) & 1;
        if (kb < kb_hi) NSA_KV_LOAD(ra_, kb + 1)
        compute(kb, smem + buf * 8192, smem + 16384 + buf * 8192);
        if (kb < kb_hi) NSA_KV_STORE(ra_, smem + (buf ^ 1) * 8192, smem + 16384 + (buf ^ 1) * 8192)
        __syncthreads();
    }
}
struct LaneOfs { int k0, k1, vb0, vb1, vb2, vb3; };
__device__ __forceinline__ LaneOfs make_lane_ofs(int lane) {
    LaneOfs f;
    const int r15 = lane & 15, lg = lane >> 4, q = r15 >> 2, pp = r15 & 3;
    f.k0 = r15 * 128 + ((lg ^ (r15 & 7)) << 4);
    f.k1 = r15 * 128 + (((4 + lg) ^ (r15 & 7)) << 4);
    const int sw2 = (2 * (lg & 1) + (q >> 1)) & 3;
    const int vrow = (4 * lg + q) * 128 + pp * 8;
    f.vb0 = vrow + ((0 ^ sw2) << 5); f.vb1 = vrow + ((1 ^ sw2) << 5);
    f.vb2 = vrow + ((2 ^ sw2) << 5); f.vb3 = vrow + ((3 ^ sw2) << 5);
    return f;
}
typedef short s16x4 __attribute__((ext_vector_type(4)));
__device__ __forceinline__ uint2 tr_read(const unsigned char* p) {
    const s16x4 v = __builtin_amdgcn_ds_read_tr16_b64_v4i16((LAS3 s16x4*)p);
    return __builtin_bit_cast(uint2, v);
}
#define NEGM (-1.0e37f)
__device__ __forceinline__ void nsa_scores(const unsigned char* Kl, const LaneOfs& f, const bf16x8& q0, const bf16x8& q1, float bias, f32x4 (&s)[4]) {
#pragma unroll
    for (int kt = 0; kt < 4; ++kt) {
        const bf16x8 a0 = *(const bf16x8*)(Kl + f.k0 + kt * 2048);
        const bf16x8 a1 = *(const bf16x8*)(Kl + f.k1 + kt * 2048);
        f32x4 z = (f32x4){bias, bias, bias, bias};
        z = __builtin_amdgcn_mfma_f32_16x16x32_bf16(a0, q0, z, 0, 0, 0);
        s[kt] = __builtin_amdgcn_mfma_f32_16x16x32_bf16(a1, q1, z, 0, 0, 0);
    }
}
#define ONES_BF16X8 __builtin_bit_cast(bf16x8, make_uint4(0x3F803F80u, 0x3F803F80u, 0x3F803F80u, 0x3F803F80u))
template <class VF>
__device__ __forceinline__ void attn_step(const unsigned char* Kl, const unsigned char* Vl, int lane, const LaneOfs& f,
                                          const bf16x8& q0, const bf16x8& q1, f32x4 (&o)[4], float& m, f32x4& lacc,
                                          float rowbias, bool full, VF valid) {
    f32x4 s[4];
    const bool mok = m > -1e29f;
    const float meff = mok ? m : 0.f;
    nsa_scores(Kl, f, q0, q1, rowbias - meff, s);
    if (!full) {
#pragma unroll
        for (int kt = 0; kt < 4; ++kt)
#pragma unroll
            for (int r = 0; r < 4; ++r) s[kt][r] = valid(kt * 16 + 4 * (lane >> 4) + r) ? s[kt][r] : NEGM;
    }
    float mx = fmaxf(fmaxf(fmaxf(s[0][0], s[0][1]), fmaxf(s[0][2], s[0][3])), fmaxf(fmaxf(s[1][0], s[1][1]), fmaxf(s[1][2], s[1][3])));
    mx = fmaxf(mx, fmaxf(fmaxf(fmaxf(s[2][0], s[2][1]), fmaxf(s[2][2], s[2][3])), fmaxf(fmaxf(s[3][0], s[3][1]), fmaxf(s[3][2], s[3][3]))));
    mx = xrow_max(mx);
    if (!__all(mok && (mx <= 8.f))) {
        const float mn = fmaxf(m, meff + mx);
        const float alpha = __builtin_amdgcn_exp2f(m - mn), d = mn - meff;
        m = mn; lacc[0] *= alpha;
#pragma unroll
        for (int dt = 0; dt < 4; ++dt) { o[dt][0] *= alpha; o[dt][1] *= alpha; o[dt][2] *= alpha; o[dt][3] *= alpha; }
#pragma unroll
        for (int kt = 0; kt < 4; ++kt) { s[kt][0] -= d; s[kt][1] -= d; s[kt][2] -= d; s[kt][3] -= d; }
    }
#pragma unroll
    for (int kt = 0; kt < 4; ++kt)
#pragma unroll
        for (int r = 0; r < 4; ++r) s[kt][r] = __builtin_amdgcn_exp2f(s[kt][r]);
#pragma unroll
    for (int k2 = 0; k2 < 2; ++k2) {
        uint4 pk;
        pk.x = pack2bf(s[2 * k2][0], s[2 * k2][1]); pk.y = pack2bf(s[2 * k2][2], s[2 * k2][3]);
        pk.z = pack2bf(s[2 * k2 + 1][0], s[2 * k2 + 1][1]); pk.w = pack2bf(s[2 * k2 + 1][2], s[2 * k2 + 1][3]);
        const bf16x8 pb = __builtin_bit_cast(bf16x8, pk);
        lacc = __builtin_amdgcn_mfma_f32_16x16x32_bf16(ONES_BF16X8, pb, lacc, 0, 0, 0);
#define PV1(dt_, vb_) { const uint2 lo_ = tr_read(Vl + (vb_) + k2 * 4096), hi_ = tr_read(Vl + (vb_) + k2 * 4096 + 2048); \
                        uint4 av_; av_.x = lo_.x; av_.y = lo_.y; av_.z = hi_.x; av_.w = hi_.y;                          \
                        o[dt_] = __builtin_amdgcn_mfma_f32_16x16x32_bf16(__builtin_bit_cast(bf16x8, av_), pb, o[dt_], 0, 0, 0); }
        PV1(0, f.vb0) PV1(1, f.vb1) PV1(2, f.vb2) PV1(3, f.vb3)
#undef PV1
    }
}
template <class VFA, class VFB>
__device__ __forceinline__ void attn_step2(const unsigned char* Kl, const unsigned char* Vl, int lane, const LaneOfs& f,
                                           const bf16x8& qA0, const bf16x8& qA1, f32x4 (&oA)[4], float& mA, f32x4& lA, float biasA, bool fullA, VFA validA,
                                           const bf16x8& qB0, const bf16x8& qB1, f32x4 (&oB)[4], float& mB, f32x4& lB, float biasB, bool fullB, VFB validB) {
    f32x4 sA[4], sB[4];
    const bool mokA = mA > -1e29f, mokB = mB > -1e29f;
    const float meA = mokA ? mA : 0.f, meB = mokB ? mB : 0.f;
    const float iA = biasA - meA, iB = biasB - meB;
#pragma unroll
    for (int kt = 0; kt < 4; ++kt) {
        const bf16x8 a0 = *(const bf16x8*)(Kl + f.k0 + kt * 2048);
        const bf16x8 a1 = *(const bf16x8*)(Kl + f.k1 + kt * 2048);
        f32x4 zA = (f32x4){iA, iA, iA, iA}, zB = (f32x4){iB, iB, iB, iB};
        zA = __builtin_amdgcn_mfma_f32_16x16x32_bf16(a0, qA0, zA, 0, 0, 0);
        zB = __builtin_amdgcn_mfma_f32_16x16x32_bf16(a0, qB0, zB, 0, 0, 0);
        sA[kt] = __builtin_amdgcn_mfma_f32_16x16x32_bf16(a1, qA1, zA, 0, 0, 0);
        sB[kt] = __builtin_amdgcn_mfma_f32_16x16x32_bf16(a1, qB1, zB, 0, 0, 0);
    }
    if (!fullA) {
#pragma unroll
        for (int kt = 0; kt < 4; ++kt)
#pragma unroll
            for (int r = 0; r < 4; ++r) sA[kt][r] = validA(kt * 16 + 4 * (lane >> 4) + r) ? sA[kt][r] : NEGM;
    }
    if (!fullB) {
#pragma unroll
        for (int kt = 0; kt < 4; ++kt)
#pragma unroll
            for (int r = 0; r < 4; ++r) sB[kt][r] = validB(kt * 16 + 4 * (lane >> 4) + r) ? sB[kt][r] : NEGM;
    }
    float mxA = fmaxf(fmaxf(fmaxf(sA[0][0], sA[0][1]), fmaxf(sA[0][2], sA[0][3])), fmaxf(fmaxf(sA[1][0], sA[1][1]), fmaxf(sA[1][2], sA[1][3])));
    float mxB = fmaxf(fmaxf(fmaxf(sB[0][0], sB[0][1]), fmaxf(sB[0][2], sB[0][3])), fmaxf(fmaxf(sB[1][0], sB[1][1]), fmaxf(sB[1][2], sB[1][3])));
    mxA = fmaxf(mxA, fmaxf(fmaxf(fmaxf(sA[2][0], sA[2][1]), fmaxf(sA[2][2], sA[2][3])), fmaxf(fmaxf(sA[3][0], sA[3][1]), fmaxf(sA[3][2], sA[3][3]))));
    mxB = fmaxf(mxB, fmaxf(fmaxf(fmaxf(sB[2][0], sB[2][1]), fmaxf(sB[2][2], sB[2][3])), fmaxf(fmaxf(sB[3][0], sB[3][1]), fmaxf(sB[3][2], sB[3][3]))));
    mxA = xrow_max(mxA); mxB = xrow_max(mxB);
    if (!__all(mokA && mokB && (mxA <= 8.f) && (mxB <= 8.f))) {
        const float mnA = fmaxf(mA, meA + mxA), mnB = fmaxf(mB, meB + mxB);
        const float alA = __builtin_amdgcn_exp2f(mA - mnA), alB = __builtin_amdgcn_exp2f(mB - mnB);
        const float dA = mnA - meA, dB = mnB - meB;
        mA = mnA; mB = mnB; lA[0] *= alA; lB[0] *= alB;
#pragma unroll
        for (int dt = 0; dt < 4; ++dt) {
            oA[dt][0] *= alA; oA[dt][1] *= alA; oA[dt][2] *= alA; oA[dt][3] *= alA;
            oB[dt][0] *= alB; oB[dt][1] *= alB; oB[dt][2] *= alB; oB[dt][3] *= alB;
        }
#pragma unroll
        for (int kt = 0; kt < 4; ++kt) {
            sA[kt][0] -= dA; sA[kt][1] -= dA; sA[kt][2] -= dA; sA[kt][3] -= dA;
            sB[kt][0] -= dB; sB[kt][1] -= dB; sB[kt][2] -= dB; sB[kt][3] -= dB;
        }
    }
#pragma unroll
    for (int kt = 0; kt < 4; ++kt)
#pragma unroll
        for (int r = 0; r < 4; ++r) { sA[kt][r] = __builtin_amdgcn_exp2f(sA[kt][r]); sB[kt][r] = __builtin_amdgcn_exp2f(sB[kt][r]); }
#pragma unroll
    for (int k2 = 0; k2 < 2; ++k2) {
        uint4 pk;
        pk.x = pack2bf(sA[2 * k2][0], sA[2 * k2][1]); pk.y = pack2bf(sA[2 * k2][2], sA[2 * k2][3]);
        pk.z = pack2bf(sA[2 * k2 + 1][0], sA[2 * k2 + 1][1]); pk.w = pack2bf(sA[2 * k2 + 1][2], sA[2 * k2 + 1][3]);
        const bf16x8 pbA = __builtin_bit_cast(bf16x8, pk);
        pk.x = pack2bf(sB[2 * k2][0], sB[2 * k2][1]); pk.y = pack2bf(sB[2 * k2][2], sB[2 * k2][3]);
        pk.z = pack2bf(sB[2 * k2 + 1][0], sB[2 * k2 + 1][1]); pk.w = pack2bf(sB[2 * k2 + 1][2], sB[2 * k2 + 1][3]);
        const bf16x8 pbB = __builtin_bit_cast(bf16x8, pk);
        lA = __builtin_amdgcn_mfma_f32_16x16x32_bf16(ONES_BF16X8, pbA, lA, 0, 0, 0);
        lB = __builtin_amdgcn_mfma_f32_16x16x32_bf16(ONES_BF16X8, pbB, lB, 0, 0, 0);
#define PV2(dt_, vb_) { const uint2 lo_ = tr_read(Vl + (vb_) + k2 * 4096), hi_ = tr_read(Vl + (vb_) + k2 * 4096 + 2048); \
                        uint4 av_; av_.x = lo_.x; av_.y = lo_.y; av_.z = hi_.x; av_.w = hi_.y;                          \
                        oA[dt_] = __builtin_amdgcn_mfma_f32_16x16x32_bf16(__builtin_bit_cast(bf16x8, av_), pbA, oA[dt_], 0, 0, 0); \
                        oB[dt_] = __builtin_amdgcn_mfma_f32_16x16x32_bf16(__builtin_bit_cast(bf16x8, av_), pbB, oB[dt_], 0, 0, 0); }
        PV2(0, f.vb0) PV2(1, f.vb1) PV2(2, f.vb2) PV2(3, f.vb3)
#undef PV2
    }
}

#define NSA_TILES 2048
__device__ __forceinline__ void nsa_tile(const Params& p, int tile, unsigned char* smem) {
    const int tid = opaque_tid(), lane = tid & 63, w = __builtin_amdgcn_readfirstlane(tid >> 6);
    const int bg = tile & 7, tb = 255 - (tile >> 3);
    const int b = bg >> 1, g = bg & 1;
    const int t0 = tb * 32, cur = t0 >> 6;
    float* impL = (float*)(smem + 32768);
    unsigned* selL = (unsigned*)(smem + 49152);
    const bf16_t* NQ = (const bf16_t*)(p.ws + OFF_NQ);
    const float* NG = (const float*)(p.ws + OFF_NGATE);
    const int rowq = lane & 15, tl = rowq >> 2, head = rowq & 3, lg = lane >> 4;
    const int toklA = 8 * w + tl, toklB = 8 * w + 4 + tl;
    const LaneOfs lof = make_lane_ofs(lane);
    const StageOfs sof = make_stage_ofs();
    const size_t tokb = (size_t)b * SEQ + t0;
    bf16x8 qA0, qA1, qB0, qB1;
    {
        const bf16_t* qp = NQ + (tokb + toklA) * 512 + g * 256 + head * 64 + lg * 8;
        qA0 = *(const bf16x8*)qp; qA1 = *(const bf16x8*)(qp + 32);
        qB0 = *(const bf16x8*)(qp + 4 * 512); qB1 = *(const bf16x8*)(qp + 4 * 512 + 32);
    }
    const float* gpA = NG + (tokb + toklA) * 24 + g * 12 + head * 3;
    const float* gpB = gpA + 4 * 24;
    __syncthreads();
    for (int i = tid; i < 4096; i += 256) impL[i] = 0.f;
    const int tqA = t0 + toklA, tqB = t0 + toklB;
    const int tminA = t0 + 8 * w, tminB = tminA + 4;
    f32x4 oA[4], oB[4], otA[4], otB[4];
    float mA, mB;
    f32x4 lA, lB;
#define NSA_RESET() { _Pragma("unroll") for (int dt = 0; dt < 4; ++dt) { oA[dt] = (f32x4){0.f, 0.f, 0.f, 0.f}; oB[dt] = (f32x4){0.f, 0.f, 0.f, 0.f}; } \
                      mA = -1e30f; mB = -1e30f; lA = (f32x4){0.f, 0.f, 0.f, 0.f}; lB = (f32x4){0.f, 0.f, 0.f, 0.f}; }
#define NSA_LSUM() { }

    const int nvA = (tqA >= 31) ? (((tqA - 31) >> 4) + 1) : 0;
    const int nvB = (tqB >= 31) ? (((tqB - 31) >> 4) + 1) : 0;
    const int nvminA = (tminA >= 31) ? (((tminA - 31) >> 4) + 1) : 0;
    const int nvminB = (tminB >= 31) ? (((tminB - 31) >> 4) + 1) : 0;
    const int nkb = (((t0 >> 4) + 1) + 63) >> 6;
    const bf16_t* ckb = (const bf16_t*)(p.ws + OFF_CMPKB) + (size_t)(b * 2 + g) * 512 * 64;
    const bf16_t* cvb = (const bf16_t*)(p.ws + OFF_CMPVB) + (size_t)(b * 2 + g) * 512 * 64;
    NSA_RESET()
    nsa_kv_loop(ckb, cvb, 64, 0, nkb - 1, smem, sof, [&](int kb, const unsigned char* Kl, const unsigned char* Vl) __attribute__((always_inline)) {
        attn_step2(Kl, Vl, lane, lof,
                   qA0, qA1, oA, mA, lA, 0.f, kb * 64 + 64 <= nvminA, [&](int key) __attribute__((always_inline)) { return kb * 64 + key < nvA; },
                   qB0, qB1, oB, mB, lB, 0.f, kb * 64 + 64 <= nvminB, [&](int key) __attribute__((always_inline)) { return kb * 64 + key < nvB; });
    });
    NSA_LSUM()
    const float mcA = mA, mcB = mB;
    const float invcA = 1.f / fmaxf(lA[0], 1e-30f), invcB = 1.f / fmaxf(lB[0], 1e-30f);
    {
        const float fA = gpA[0] * invcA, fB = gpB[0] * invcB;
#pragma unroll
        for (int dt = 0; dt < 4; ++dt) {
            otA[dt][0] = fA * oA[dt][0]; otA[dt][1] = fA * oA[dt][1]; otA[dt][2] = fA * oA[dt][2]; otA[dt][3] = fA * oA[dt][3];
            otB[dt][0] = fB * oB[dt][0]; otB[dt][1] = fB * oB[dt][1]; otB[dt][2] = fB * oB[dt][2]; otB[dt][3] = fB * oB[dt][3];
        }
    }
    if (cur >= 16) {
        nsa_kv_loop(ckb, cvb, 64, 0, nkb - 1, smem, sof, [&](int kb, const unsigned char* Kl, const unsigned char* Vl) __attribute__((always_inline)) {
#pragma unroll
            for (int mt = 0; mt < 2; ++mt) {
                f32x4 s[4];
                nsa_scores(Kl, lof, mt ? qB0 : qA0, mt ? qB1 : qA1, 0.f, s);
                const int nv = mt ? nvB : nvA;
                const float mc = mt ? mcB : mcA, inv = mt ? invcB : invcA;
                float* impT = impL + (mt ? toklB : toklA) * 128;
#pragma unroll
                for (int kt = 0; kt < 4; ++kt) {
                    float pr[4];
#pragma unroll
                    for (int r = 0; r < 4; ++r) {
                        const int n = kb * 64 + kt * 16 + 4 * lg + r;
                        pr[r] = (n < nv) ? __builtin_amdgcn_exp2f(s[kt][r] - mc) * inv : 0.f;
                    }
                    float c1 = pr[0] + pr[1] + pr[2] + 0.5f * pr[3], c2 = 0.5f * pr[3];
                    c1 += __shfl_xor(c1, 1); c1 += __shfl_xor(c1, 2);
                    c2 += __shfl_xor(c2, 1); c2 += __shfl_xor(c2, 2);
                    const int j = kb * 16 + kt * 4 + lg;
                    if (head == 0) {
                        atomicAdd(&impT[j], c1);
                        if (j + 1 < 128) atomicAdd(&impT[j + 1], c2);
                    }
                }
                    }
        });
#pragma unroll 1
        for (int pass = 0; pass < 2; ++pass) {
            const int tok = 8 * w + 4 * pass + lg, c = lane & 15;
            const float4 i0 = *(const float4*)(impL + tok * 128 + 8 * c), i1 = *(const float4*)(impL + tok * 128 + 8 * c + 4);
            const float iv[8] = {i0.x, i0.y, i0.z, i0.w, i1.x, i1.y, i1.z, i1.w};
            float kl[8];
#pragma unroll
            for (int q = 0; q < 8; ++q) {
                const int j = 8 * c + q;
                const bool forced = (j == 0) || (j == cur) || (j == cur - 1);
                const float sc = forced ? 1.0e4f : ((j <= cur) ? iv[q] : -1.f);
                kl[q] = enc_key(sc, (unsigned)j, 127);
            }
            float l0 = kl[0], l1 = kl[1], l2 = kl[2], l3 = kl[3], l4 = kl[4], l5 = kl[5], l6 = kl[6], l7 = kl[7];
            CE_DESC(l0, l1) CE_DESC(l2, l3) CE_DESC(l4, l5) CE_DESC(l6, l7)
            CE_DESC(l0, l2) CE_DESC(l1, l3) CE_DESC(l4, l6) CE_DESC(l5, l7)
            CE_DESC(l1, l2) CE_DESC(l5, l6)
            CE_DESC(l0, l4) CE_DESC(l1, l5) CE_DESC(l2, l6) CE_DESC(l3, l7)
            CE_DESC(l2, l4) CE_DESC(l3, l5)
            CE_DESC(l1, l2) CE_DESC(l3, l4) CE_DESC(l5, l6)
            unsigned pm = 0u;
#pragma unroll
            for (int k = 0; k < 16; ++k) {
                const float mx = row16_max(l0);
                const bool win = (l0 == mx);
                pm |= win ? (1u << (dec_idx(l0, 127) & 7u)) : 0u;
                l0 = win ? l1 : l0; l1 = win ? l2 : l1; l2 = win ? l3 : l2; l3 = win ? l4 : l3;
                l4 = win ? l5 : l4; l5 = win ? l6 : l5; l6 = win ? l7 : l6; l7 = win ? NEGKEY : l7;
            }
            ((unsigned char*)selL)[tok * 16 + c] = (unsigned char)pm;
        }
    } else {
        if (lane < 8) {
            const int tok = 8 * w + lane;
            selL[tok * 4 + 0] = (2u << cur) - 1u; selL[tok * 4 + 1] = 0u; selL[tok * 4 + 2] = 0u; selL[tok * 4 + 3] = 0u;
        }
    }
    WAVE_LDS_SYNC();
#if NSA_DIAG
    if (head == 0 && lg == 0) {
        unsigned* SELM = (unsigned*)(p.ws + OFF_SELM);
#pragma unroll
        for (int qd = 0; qd < 4; ++qd) {
            SELM[((size_t)bg * SEQ + tqA) * 4 + qd] = selL[toklA * 4 + qd];
            SELM[((size_t)bg * SEQ + tqB) * 4 + qd] = selL[toklB * 4 + qd];
        }
    }
#endif
    NSA_RESET()
    {
        const bf16_t* kg = (const bf16_t*)(p.ws + OFF_KV + 2 * KV_STRIDE) + (size_t)b * SEQ * 128 + g * 64;
        const bf16_t* vg = (const bf16_t*)(p.ws + OFF_KV + 3 * KV_STRIDE) + (size_t)b * SEQ * 128 + g * 64;
        nsa_kv_loop(kg, vg, 128, 0, cur, smem, sof, [&](int kb, const unsigned char* Kl, const unsigned char* Vl) __attribute__((always_inline)) {
            const bool svA = (selL[toklA * 4 + (kb >> 5)] >> (kb & 31)) & 1u;
            const bool svB = (selL[toklB * 4 + (kb >> 5)] >> (kb & 31)) & 1u;
            const bool nA = __ballot(svA) != 0ull, nB = __ballot(svB) != 0ull;
            if (nA && nB)
                attn_step2(Kl, Vl, lane, lof,
                           qA0, qA1, oA, mA, lA, svA ? 0.f : NEGM, kb < cur, [&](int key) __attribute__((always_inline)) { return kb * 64 + key <= tqA; },
                           qB0, qB1, oB, mB, lB, svB ? 0.f : NEGM, kb < cur, [&](int key) __attribute__((always_inline)) { return kb * 64 + key <= tqB; });
            else if (nA)
                attn_step(Kl, Vl, lane, lof, qA0, qA1, oA, mA, lA, svA ? 0.f : NEGM, kb < cur, [&](int key) __attribute__((always_inline)) { return kb * 64 + key <= tqA; });
            else if (nB)
                attn_step(Kl, Vl, lane, lof, qB0, qB1, oB, mB, lB, svB ? 0.f : NEGM, kb < cur, [&](int key) __attribute__((always_inline)) { return kb * 64 + key <= tqB; });
        });
    }
    NSA_LSUM()
    {
        const float fA = gpA[1] / fmaxf(lA[0], 1e-30f), fB = gpB[1] / fmaxf(lB[0], 1e-30f);
#pragma unroll
        for (int dt = 0; dt < 4; ++dt) {
            otA[dt][0] += fA * oA[dt][0]; otA[dt][1] += fA * oA[dt][1]; otA[dt][2] += fA * oA[dt][2]; otA[dt][3] += fA * oA[dt][3];
            otB[dt][0] += fB * oB[dt][0]; otB[dt][1] += fB * oB[dt][1]; otB[dt][2] += fB * oB[dt][2]; otB[dt][3] += fB * oB[dt][3];
        }
    }
    NSA_RESET()
    {
        const bf16_t* kg = (const bf16_t*)(p.ws + OFF_KV + 4 * KV_STRIDE) + (size_t)b * SEQ * 128 + g * 64;
        const bf16_t* vg = (const bf16_t*)(p.ws + OFF_KV + 5 * KV_STRIDE) + (size_t)b * SEQ * 128 + g * 64;
        const int klo = (t0 > 511) ? ((t0 - 511) >> 6) : 0;
        nsa_kv_loop(kg, vg, 128, klo, cur, smem, sof, [&](int kb, const unsigned char* Kl, const unsigned char* Vl) __attribute__((always_inline)) {
            attn_step2(Kl, Vl, lane, lof,
                       qA0, qA1, oA, mA, lA, 0.f, (kb * 64 >= tminA + 3 - 511) && (kb * 64 + 63 <= tminA),
                       [&](int key) __attribute__((always_inline)) { const int ka = kb * 64 + key; return (ka <= tqA) && (ka >= tqA - 511); },
                       qB0, qB1, oB, mB, lB, 0.f, (kb * 64 >= tminB + 3 - 511) && (kb * 64 + 63 <= tminB),
                       [&](int key) __attribute__((always_inline)) { const int ka = kb * 64 + key; return (ka <= tqB) && (ka >= tqB - 511); });
        });
    }
    NSA_LSUM()
    {
        const float fA = gpA[2] / fmaxf(lA[0], 1e-30f), fB = gpB[2] / fmaxf(lB[0], 1e-30f);
        bf16_t* MIX = (bf16_t*)(p.ws + OFF_XB) + (tokb + toklA) * DM + 512 + g * 256 + head * 64 + lg * 4;
#pragma unroll
        for (int dt = 0; dt < 4; ++dt) {
            uint2 ov;
            ov.x = pack2bf(otA[dt][0] + fA * oA[dt][0], otA[dt][1] + fA * oA[dt][1]);
            ov.y = pack2bf(otA[dt][2] + fA * oA[dt][2], otA[dt][3] + fA * oA[dt][3]);
            *(uint2*)(MIX + dt * 16) = ov;
            ov.x = pack2bf(otB[dt][0] + fB * oB[dt][0], otB[dt][1] + fB * oB[dt][1]);
            ov.y = pack2bf(otB[dt][2] + fB * oB[dt][2], otB[dt][3] + fB * oB[dt][3]);
            *(uint2*)(MIX + 4 * DM + dt * 16) = ov;
        }
    }
#undef NSA_RESET
#undef NSA_LSUM
}

__device__ __forceinline__ float block_sum(float v, float* red) {
    v = wave_sum(v);
    __syncthreads();
    if ((threadIdx.x & 63) == 0) red[threadIdx.x >> 6] = v;
    __syncthreads();
    return red[0] + red[1] + red[2] + red[3];
}
__device__ __forceinline__ float4 ln_row(float4 y, const float* g, const float* bb, float* red) {
    const int tid = opaque_tid();
    const float mu = block_sum(y.x + y.y + y.z + y.w, red) * (1.f / 1024.f);
    const float dx = y.x - mu, dy = y.y - mu, dz = y.z - mu, dw = y.w - mu;
    const float var = block_sum(dx * dx + dy * dy + dz * dz + dw * dw, red) * (1.f / 1024.f);
    const float rs = rsqrtf(var + LN_EPS);
    const float4 gg = ((const float4*)g)[tid], b4 = ((const float4*)bb)[tid];
    return make_float4(dx * rs * gg.x + b4.x, dy * rs * gg.y + b4.y, dz * rs * gg.z + b4.z, dw * rs * gg.w + b4.w);
}

__device__ __forceinline__ void ln1_phase(const Params& p, float* sm) {
    const int tid = opaque_tid(), lane = tid & 63, w = __builtin_amdgcn_readfirstlane(tid >> 6);
    const float4* g4 = (const float4*)(p.in[15] + 16 * lane);
    const float4* b4 = (const float4*)(p.in[16] + 16 * lane);
    const float4 ga = g4[0], gb = g4[1], gc = g4[2], gd = g4[3];
    const float4 ba = b4[0], bb = b4[1], bc = b4[2], bd = b4[3];
#pragma unroll 2
    for (int n = blockIdx.x * 4 + w; n < NTOK; n += gridDim.x * 4) {
        const float4* yr = (const float4*)(p.out + (size_t)n * DM + 16 * lane);
        const float4 y0 = yr[0], y1 = yr[1], y2 = yr[2], y3 = yr[3];
        float y[16] = {y0.x, y0.y, y0.z, y0.w, y1.x, y1.y, y1.z, y1.w, y2.x, y2.y, y2.z, y2.w, y3.x, y3.y, y3.z, y3.w};
        const float g[16] = {ga.x, ga.y, ga.z, ga.w, gb.x, gb.y, gb.z, gb.w, gc.x, gc.y, gc.z, gc.w, gd.x, gd.y, gd.z, gd.w};
        const float bv[16] = {ba.x, ba.y, ba.z, ba.w, bb.x, bb.y, bb.z, bb.w, bc.x, bc.y, bc.z, bc.w, bd.x, bd.y, bd.z, bd.w};
        float sum = 0.f;
#pragma unroll
        for (int q = 0; q < 16; ++q) sum += y[q];
        const float mu = wave_sum(sum) * (1.f / 1024.f);
        float sq = 0.f;
#pragma unroll
        for (int q = 0; q < 16; ++q) { y[q] -= mu; sq += y[q] * y[q]; }
        const float rs = rsqrtf(wave_sum(sq) * (1.f / 1024.f) + LN_EPS);
        uint4 o0, o1;
        o0.x = pack2bf(y[0] * rs * g[0] + bv[0], y[1] * rs * g[1] + bv[1]);     o0.y = pack2bf(y[2] * rs * g[2] + bv[2], y[3] * rs * g[3] + bv[3]);
        o0.z = pack2bf(y[4] * rs * g[4] + bv[4], y[5] * rs * g[5] + bv[5]);     o0.w = pack2bf(y[6] * rs * g[6] + bv[6], y[7] * rs * g[7] + bv[7]);
        o1.x = pack2bf(y[8] * rs * g[8] + bv[8], y[9] * rs * g[9] + bv[9]);     o1.y = pack2bf(y[10] * rs * g[10] + bv[10], y[11] * rs * g[11] + bv[11]);
        o1.z = pack2bf(y[12] * rs * g[12] + bv[12], y[13] * rs * g[13] + bv[13]); o1.w = pack2bf(y[14] * rs * g[14] + bv[14], y[15] * rs * g[15] + bv[15]);
        uint4* hb = (uint4*)((bf16_t*)(p.ws + OFF_XB) + (size_t)n * DM + 16 * lane);
        hb[0] = o0; hb[1] = o1;
    }
}


typedef float f32x2 __attribute__((ext_vector_type(2)));
__device__ __forceinline__ void cvt_rows_fp8(const float* __restrict__ src, unsigned char* __restrict__ dst, float* __restrict__ scales, int rows,
                                             int first_block, int nblocks) {
    const int tid_ = opaque_tid(), lane = tid_ & 63, w = __builtin_amdgcn_readfirstlane(tid_ >> 6);
    for (int r = ((int)blockIdx.x - first_block) * 4 + w; r < rows; r += nblocks * 4) {
        const float4* sp = (const float4*)(src + (size_t)r * 1024 + lane * 16);
        const float4 a = sp[0], b = sp[1], c = sp[2], d = sp[3];
        float mx = fmaxf(fmaxf(fmaxf(fabsf(a.x), fabsf(a.y)), fmaxf(fabsf(a.z), fabsf(a.w))), fmaxf(fmaxf(fabsf(b.x), fabsf(b.y)), fmaxf(fabsf(b.z), fabsf(b.w))));
        mx = fmaxf(mx, fmaxf(fmaxf(fmaxf(fabsf(c.x), fabsf(c.y)), fmaxf(fabsf(c.z), fabsf(c.w))), fmaxf(fmaxf(fabsf(d.x), fabsf(d.y)), fmaxf(fabsf(d.z), fabsf(d.w)))));
        mx = wave_max(mx);
        const float sc = (mx > 0.f) ? mx * (1.f / 448.f) : 1.f;
        const float inv = 1.f / sc;
        uint4 o;
        int t;
        t = 0; t = __builtin_amdgcn_cvt_pk_fp8_f32(a.x * inv, a.y * inv, t, false); t = __builtin_amdgcn_cvt_pk_fp8_f32(a.z * inv, a.w * inv, t, true); o.x = (unsigned)t;
        t = 0; t = __builtin_amdgcn_cvt_pk_fp8_f32(b.x * inv, b.y * inv, t, false); t = __builtin_amdgcn_cvt_pk_fp8_f32(b.z * inv, b.w * inv, t, true); o.y = (unsigned)t;
        t = 0; t = __builtin_amdgcn_cvt_pk_fp8_f32(c.x * inv, c.y * inv, t, false); t = __builtin_amdgcn_cvt_pk_fp8_f32(c.z * inv, c.w * inv, t, true); o.z = (unsigned)t;
        t = 0; t = __builtin_amdgcn_cvt_pk_fp8_f32(d.x * inv, d.y * inv, t, false); t = __builtin_amdgcn_cvt_pk_fp8_f32(d.z * inv, d.w * inv, t, true); o.w = (unsigned)t;
        *(uint4*)(dst + (size_t)r * 1024 + lane * 16) = o;
        if (lane == 0) scales[r] = sc;
    }
}

__device__ __forceinline__ void fold_ws_phase(const float* __restrict__ wq, const float* __restrict__ k1, const float* __restrict__ k2,
                                              bf16_t* __restrict__ WsT) {
    for (int it = blockIdx.x * 256 + threadIdx.x; it < 2048 * 128; it += gridDim.x * 256) {
        const int r = it & 2047, kg = it >> 11;
        const int a = (r >> 7) & 1, j = r & 127;
        const float* kr = (a ? k2 : k1) + j * 128;
        const float* wr = wq + (size_t)(kg * 8) * 2048 + (r & ~127);
        float s[8];
#pragma unroll
        for (int q = 0; q < 8; ++q) s[q] = 0.f;
        for (int d = 0; d < 128; d += 4) {
            const float4 kv = *(const float4*)(kr + d);
#pragma unroll
            for (int q = 0; q < 8; ++q) {
                const float4 wv = *(const float4*)(wr + (size_t)q * 2048 + d);
                s[q] += wv.x * kv.x + wv.y * kv.y + wv.z * kv.z + wv.w * kv.w;
            }
        }
        uint4 o;
        o.x = pack2bf(s[0], s[1]); o.y = pack2bf(s[2], s[3]); o.z = pack2bf(s[4], s[5]); o.w = pack2bf(s[6], s[7]);
        *(uint4*)(WsT + (size_t)r * 1024 + kg * 8) = o;
    }
}


struct EpiTop16 {
    float* topk; unsigned char* lds;
    __device__ __forceinline__ void operator()(int m, int n, f32x4 v) const {
        const int ml = m & 127, g4 = (n & 127) >> 2;
        *(float4*)(lds + ((ml * 32 + (g4 ^ (ml & 7))) << 4)) = make_float4(v[0], v[1], v[2], v[3]);
    }
    __device__ __forceinline__ void finish(int m0, int n0) const {
        __syncthreads();
        const int tid_ = opaque_tid(), lane = tid_ & 63, w = __builtin_amdgcn_readfirstlane(tid_ >> 6), c = lane & 15;
        const int L = n0 >> 7;
        for (int it = 0; it < 8; ++it) {
            const int r = w * 32 + it * 4 + (lane >> 4);
            const float4 x0 = *(const float4*)(lds + ((r * 32 + ((2 * c) ^ (r & 7))) << 4));
            const float4 x1 = *(const float4*)(lds + ((r * 32 + ((2 * c + 1) ^ (r & 7))) << 4));
            float l0 = enc_key(x0.x, 8 * c + 0, 127), l1 = enc_key(x0.y, 8 * c + 1, 127), l2 = enc_key(x0.z, 8 * c + 2, 127),
                  l3 = enc_key(x0.w, 8 * c + 3, 127), l4 = enc_key(x1.x, 8 * c + 4, 127), l5 = enc_key(x1.y, 8 * c + 5, 127),
                  l6 = enc_key(x1.z, 8 * c + 6, 127), l7 = enc_key(x1.w, 8 * c + 7, 127);
            CE_DESC(l0, l1) CE_DESC(l2, l3) CE_DESC(l4, l5) CE_DESC(l6, l7)
            CE_DESC(l0, l2) CE_DESC(l1, l3) CE_DESC(l4, l6) CE_DESC(l5, l7)
            CE_DESC(l1, l2) CE_DESC(l5, l6)
            CE_DESC(l0, l4) CE_DESC(l1, l5) CE_DESC(l2, l6) CE_DESC(l3, l7)
            CE_DESC(l2, l4) CE_DESC(l3, l5)
            CE_DESC(l1, l2) CE_DESC(l3, l4) CE_DESC(l5, l6)
            float res = NEGKEY;
#pragma unroll
            for (int k = 0; k < 16; ++k) {
                const float mx = row16_max(l0);
                const bool win = (l0 == mx);
                l0 = win ? l1 : l0; l1 = win ? l2 : l1; l2 = win ? l3 : l2; l3 = win ? l4 : l3;
                l4 = win ? l5 : l4; l5 = win ? l6 : l5; l6 = win ? l7 : l6; l7 = win ? NEGKEY : l7;
                res = (c == k) ? mx : res;
            }
            topk[(size_t)(m0 + r) * 256 + L * 16 + c] = res;
        }
        __syncthreads();
    }
};

template <int PART>
__device__ __forceinline__ void peer_fast_phase(const Params& p, unsigned char* smem) {
    const int tid = opaque_tid(), lane = tid & 63, w = __builtin_amdgcn_readfirstlane(tid >> 6), l16 = lane & 15, gq = lane >> 4;
    float* tk = (float*)(smem + w * 2048);
    int* ex = (int*)(smem + w * 2048 + 1024);
    float* gw = (float*)(smem + w * 2048 + 1536);
    const bf16_t* H1B = (const bf16_t*)(p.ws + OFF_XB);
    const unsigned char* U8 = p.ws + OFF_UB;
    const unsigned char* V8 = p.ws + OFF_VB;
    const float* USC = (const float*)(p.ws + OFF_USC);
    const float* VSC = (const float*)(p.ws + OFF_VSC);
    const float* TOPK = (const float*)(p.ws + OFF_TOPK);
    int ci[4], cj[4];
#pragma unroll
    for (int q = 0; q < 4; ++q) {
        const int s = l16 + 16 * q;
        int i, j;
        if (s < 16) { i = 0; j = s; }
        else if (s < 24) { i = 1; j = s - 16; }
        else if (s < 29) { i = 2; j = s - 24; }
        else if (s < 33) { i = 3; j = s - 29; }
        else if (s < 36) { i = 4; j = s - 33; }
        else if (s < 42) { i = 5 + ((s - 36) >> 1); j = (s - 36) & 1; }
        else if (s < 50) { i = 8 + (s - 42); j = 0; }
        else { i = -1; j = 0; }
        ci[q] = i; cj[q] = j;
    }
    int* exs = (int*)(smem + 8192 + w * 4096);
    float* gws = (float*)(smem + 8192 + w * 4096 + 2048);
    float* hraw = (float*)(smem + 24576 + w * 2048);
    int* SEX = (int*)(p.ws + OFF_HQ);
    float* SGW = (float*)(p.ws + OFF_HLF);
    for (int qd = blockIdx.x * 4 + w; qd < NTOK / 4; qd += gridDim.x * 4) {
        const int n0 = qd * 4;
        if (PART == 0) {
#pragma unroll 1
        for (int t = 0; t < 4; ++t) {
            const int n = n0 + t;
            WAVE_LDS_SYNC();
            ((float4*)tk)[lane] = ((const float4*)(TOPK + (size_t)n * 256))[lane];
            WAVE_LDS_SYNC();
#pragma unroll
            for (int it = 0; it < 2; ++it) {
                const int head = it * 4 + gq;
                const float* ka = tk + head * 32;
                const float* kb = ka + 16;
                float c0, c1, c2, c3;
#define MKC(q, cq) { if (ci[q] >= 0) { const float sum_ = dec_val(ka[ci[q]], 127) + dec_val(kb[cj[q]], 127); \
                         cq = enc_key(sum_, ci[q] * 16 + cj[q], 255); } else cq = NEGKEY; }
                MKC(0, c0) MKC(1, c1) MKC(2, c2) MKC(3, c3)
#undef MKC
                float res = NEGKEY;
#pragma unroll
                for (int k = 0; k < 16; ++k) {
                    const float mx = row16_max(fmaxf(fmaxf(c0, c1), fmaxf(c2, c3)));
                    c0 = (c0 == mx) ? NEGKEY : c0; c1 = (c1 == mx) ? NEGKEY : c1;
                    c2 = (c2 == mx) ? NEGKEY : c2; c3 = (c3 == mx) ? NEGKEY : c3;
                    res = (l16 == k) ? mx : res;
                }
                const unsigned cc = dec_idx(res, 255);
                const float val = dec_val(res, 255);
                const unsigned e1 = dec_idx(ka[cc >> 4], 127), e2 = dec_idx(kb[cc & 15], 127);
                const float m0 = row16_max(val);
                const float e = expf(val - m0);
                const float ssum = row16_sum(e);
                ex[head * 16 + l16] = (int)(e1 * 128 + e2);
                gw[head * 16 + l16] = e / ssum;
            }
            WAVE_LDS_SYNC();
            {
                const int e0 = ex[lane], e1v = ex[lane + 64];
                const float g0 = gw[lane], g1 = gw[lane + 64];
                const int s0 = e0 >> 11, s1 = e1v >> 11;
                const unsigned long long lt = (1ull << lane) - 1ull;
                int base = 0, p0 = 0, p1 = 0;
#pragma unroll
                for (int s = 0; s < 8; ++s) {
                    const unsigned long long m0 = __ballot(s0 == s), m1 = __ballot(s1 == s);
                    const int c0 = __popcll(m0), c1 = __popcll(m1);
                    if (s0 == s) p0 = base + __popcll(m0 & lt);
                    if (s1 == s) p1 = base + c0 + __popcll(m1 & lt);
                    base += c0 + c1;
                }
                exs[t * 128 + p0] = e0; gws[t * 128 + p0] = g0; exs[t * 128 + p1] = e1v; gws[t * 128 + p1] = g1;
            }
        }
        WAVE_LDS_SYNC();
#pragma unroll
        for (int i = 0; i < 2; ++i) {
            ((uint4*)(SEX + (size_t)n0 * 128))[lane + 64 * i] = ((const uint4*)exs)[lane + 64 * i];
            ((uint4*)(SGW + (size_t)n0 * 128))[lane + 64 * i] = ((const uint4*)gws)[lane + 64 * i];
        }
        } else {
        WAVE_LDS_SYNC();
#pragma unroll
        for (int i = 0; i < 2; ++i) {
            ((uint4*)exs)[lane + 64 * i] = ((const uint4*)(SEX + (size_t)n0 * 128))[lane + 64 * i];
            ((uint4*)gws)[lane + 64 * i] = ((const uint4*)(SGW + (size_t)n0 * 128))[lane + 64 * i];
        }
        }
        if (PART == 1) {
        WAVE_LDS_SYNC();
        {
            f32x2 xp[32];
            {
                const uint4* xr = (const uint4*)(H1B + (size_t)(n0 + gq) * DM + 16 * l16);
#pragma unroll
                for (int i = 0; i < 4; ++i) {
                    const uint4 xa = xr[32 * i], xb = xr[32 * i + 1];
                    xp[8 * i + 0] = (f32x2){__uint_as_float(xa.x << 16), __uint_as_float(xa.x & 0xffff0000u)};
                    xp[8 * i + 1] = (f32x2){__uint_as_float(xa.y << 16), __uint_as_float(xa.y & 0xffff0000u)};
                    xp[8 * i + 2] = (f32x2){__uint_as_float(xa.z << 16), __uint_as_float(xa.z & 0xffff0000u)};
                    xp[8 * i + 3] = (f32x2){__uint_as_float(xa.w << 16), __uint_as_float(xa.w & 0xffff0000u)};
                    xp[8 * i + 4] = (f32x2){__uint_as_float(xb.x << 16), __uint_as_float(xb.x & 0xffff0000u)};
                    xp[8 * i + 5] = (f32x2){__uint_as_float(xb.y << 16), __uint_as_float(xb.y & 0xffff0000u)};
                    xp[8 * i + 6] = (f32x2){__uint_as_float(xb.z << 16), __uint_as_float(xb.z & 0xffff0000u)};
                    xp[8 * i + 7] = (f32x2){__uint_as_float(xb.w << 16), __uint_as_float(xb.w & 0xffff0000u)};
                }
            }
            uint4 ra0, ra1, ra2, ra3, rb0, rb1, rb2, rb3, rc0, rc1, rc2, rc3, rd0, rd1, rd2, rd3;
#define ULOAD(S, kk) { const int e_ = exs[gq * 128 + (kk)]; const uint4* ur_ = (const uint4*)(U8 + (size_t)e_ * DM + 16 * l16);          \
                       S##0 = ur_[0]; S##1 = ur_[16]; S##2 = ur_[32]; S##3 = ur_[48]; }
#define D8(W_, B_) { sA = __builtin_elementwise_fma(__builtin_amdgcn_cvt_pk_f32_fp8((int)(W_), false), xp[(B_)], sA);      \
                     sB = __builtin_elementwise_fma(__builtin_amdgcn_cvt_pk_f32_fp8((int)(W_), true), xp[(B_) + 1], sB); }
#define UCOMP(S, kk) { f32x2 sA = (f32x2){0.f, 0.f}, sB = (f32x2){0.f, 0.f};                                                             \
                       D8((S##0).x, 0) D8((S##0).y, 2) D8((S##0).z, 4) D8((S##0).w, 6) D8((S##1).x, 8) D8((S##1).y, 10) D8((S##1).z, 12) D8((S##1).w, 14) \
                       D8((S##2).x, 16) D8((S##2).y, 18) D8((S##2).z, 20) D8((S##2).w, 22) D8((S##3).x, 24) D8((S##3).y, 26) D8((S##3).z, 28) D8((S##3).w, 30) \
                       hraw[gq * 128 + (kk)] = row16_sum((sA[0] + sA[1]) + (sB[0] + sB[1])); }
            ULOAD(ra, 0) ULOAD(rb, 1) ULOAD(rc, 2)
#pragma unroll 1
            for (int k = 0; k < 128; k += 4) {
                const int kn = (k + 4 < 128) ? k + 4 : 124;
                ULOAD(rd, k + 3)  UCOMP(ra, k)
                ULOAD(ra, kn)     UCOMP(rb, k + 1)
                ULOAD(rb, kn + 1) UCOMP(rc, k + 2)
                ULOAD(rc, kn + 2) UCOMP(rd, k + 3)
            }
#undef ULOAD
#undef UCOMP
#undef D8
        }
        WAVE_LDS_SYNC();
#pragma unroll
        for (int j = 0; j < 8; ++j) {
            const int idx = lane + 64 * j;
            const int e = exs[idx];
            gws[idx] = gws[idx] * gelu_tanh_fast(hraw[idx] * USC[e]) * VSC[e];
        }
        WAVE_LDS_SYNC();
#pragma unroll
        for (int i = 0; i < 2; ++i) ((uint4*)(SGW + (size_t)n0 * 128))[lane + 64 * i] = ((const uint4*)gws)[lane + 64 * i];
        }
        if (PART == 2) {
        WAVE_LDS_SYNC();
        {
            f32x2 acc[32];
#pragma unroll
            for (int q = 0; q < 32; ++q) acc[q] = (f32x2){0.f, 0.f};
            uint4 ra0, ra1, ra2, ra3, rb0, rb1, rb2, rb3, rc0, rc1, rc2, rc3, rd0, rd1, rd2, rd3;
#define VLOAD(S, kk) { const int e_ = exs[gq * 128 + (kk)]; const uint4* vr_ = (const uint4*)(V8 + (size_t)e_ * DM + 16 * l16);          \
                       S##0 = vr_[0]; S##1 = vr_[16]; S##2 = vr_[32]; S##3 = vr_[48]; }
#define A4(W_, B_) { acc[(B_)] = __builtin_elementwise_fma(__builtin_amdgcn_cvt_pk_f32_fp8((int)(W_), false), wk2, acc[(B_)]);          \
                     acc[(B_) + 1] = __builtin_elementwise_fma(__builtin_amdgcn_cvt_pk_f32_fp8((int)(W_), true), wk2, acc[(B_) + 1]); }
#define VCOMP(S, kk) { const float wk = gws[gq * 128 + (kk)]; const f32x2 wk2 = (f32x2){wk, wk};                                         \
                       A4((S##0).x, 0) A4((S##0).y, 2) A4((S##0).z, 4) A4((S##0).w, 6) A4((S##1).x, 8) A4((S##1).y, 10) A4((S##1).z, 12) A4((S##1).w, 14) \
                       A4((S##2).x, 16) A4((S##2).y, 18) A4((S##2).z, 20) A4((S##2).w, 22) A4((S##3).x, 24) A4((S##3).y, 26) A4((S##3).z, 28) A4((S##3).w, 30) }
            VLOAD(ra, 0) VLOAD(rb, 1) VLOAD(rc, 2)
#pragma unroll 1
            for (int k = 0; k < 128; k += 4) {
                const int kn = (k + 4 < 128) ? k + 4 : 124;
                VLOAD(rd, k + 3)  VCOMP(ra, k)
                VLOAD(ra, kn)     VCOMP(rb, k + 1)
                VLOAD(rb, kn + 1) VCOMP(rc, k + 2)
                VLOAD(rc, kn + 2) VCOMP(rd, k + 3)
            }
#undef VLOAD
#undef VCOMP
#undef A4
            float* orow = p.out + (size_t)(n0 + gq) * DM + 16 * l16;
            float sum = 0.f;
#pragma unroll
            for (int c = 0; c < 4; ++c)
#pragma unroll
                for (int hq = 0; hq < 4; ++hq) {
                    const uint2 hb_ = *(const uint2*)(H1B + (size_t)(n0 + gq) * DM + 16 * l16 + 256 * c + 4 * hq);
                    const float4 h = make_float4(__uint_as_float(hb_.x << 16), __uint_as_float(hb_.x & 0xffff0000u),
                                                 __uint_as_float(hb_.y << 16), __uint_as_float(hb_.y & 0xffff0000u));
                    f32x2& pa = acc[8 * c + 2 * hq]; f32x2& pb = acc[8 * c + 2 * hq + 1];
                    pa[0] = ALPHA * h.x + pa[0]; pa[1] = ALPHA * h.y + pa[1]; pb[0] = ALPHA * h.z + pb[0]; pb[1] = ALPHA * h.w + pb[1];
                    sum += (pa[0] + pa[1]) + (pb[0] + pb[1]);
                }
            const float mu = row16_sum(sum) * (1.f / 1024.f);
            float sq = 0.f;
#pragma unroll
            for (int q = 0; q < 32; ++q) { acc[q][0] -= mu; acc[q][1] -= mu; sq += acc[q][0] * acc[q][0] + acc[q][1] * acc[q][1]; }
            const float rs = rsqrtf(row16_sum(sq) * (1.f / 1024.f) + LN_EPS);
            const float* g = p.in[22] + 16 * l16;
            const float* bb = p.in[23] + 16 * l16;
#pragma unroll
            for (int c = 0; c < 4; ++c)
#pragma unroll
                for (int hq = 0; hq < 4; ++hq) {
                    const float4 gg = *(const float4*)(g + 256 * c + 4 * hq), b4 = *(const float4*)(bb + 256 * c + 4 * hq);
                    const f32x2 pa = acc[8 * c + 2 * hq], pb = acc[8 * c + 2 * hq + 1];
                    float4 o;
                    o.x = pa[0] * rs * gg.x + b4.x; o.y = pa[1] * rs * gg.y + b4.y;
                    o.z = pb[0] * rs * gg.z + b4.z; o.w = pb[1] * rs * gg.w + b4.w;
                    *(float4*)(orow + 256 * c + 4 * hq) = o;
                }
        }
        }
    }
}

#define XB_TMO      128
#define XB_XCNT(j)  (256  + 64 * (j))
#define XB_XSUB(j)  (1280 + 64 * (j))
#define XB_XGEN(j)  (2304 + 64 * (j))
#define XB_TOP      3328
#define XB_TOPGEN   3392
#define XCD_BAR_WORDS 3456
#define XB_SPIN_CAP (1u << 22)
__device__ __forceinline__ unsigned xb_ld(unsigned* p) { return __hip_atomic_load(p, __ATOMIC_RELAXED, __HIP_MEMORY_SCOPE_AGENT); }
__device__ __forceinline__ unsigned xb_add(unsigned* p, unsigned v) { return __hip_atomic_fetch_add(p, v, __ATOMIC_RELAXED, __HIP_MEMORY_SCOPE_AGENT); }
__device__ __forceinline__ unsigned xb_xcc_id() { return (unsigned)__builtin_amdgcn_s_getreg((3 << 11) | 20) & 0xFu; }
#define XB_SPIN(cond, bar) do { unsigned _sp = 0; while (cond) { __builtin_amdgcn_s_sleep(1); \
    if ((++_sp & 255u) == 0u) { if (xb_ld(&(bar)[XB_TMO])) break; if (_sp > XB_SPIN_CAP) { atomicAdd(&(bar)[XB_TMO], 1u); break; } } } } while (0)
struct XcdBarrier { unsigned* bar; unsigned x; unsigned* st; };
__device__ __forceinline__ XcdBarrier xcd_barrier_post(unsigned* bar, unsigned* st) {
    XcdBarrier b; b.bar = bar; b.x = xb_xcc_id(); b.st = st;
    if (threadIdx.x == 0) (void)xb_add(&bar[XB_XCNT(b.x)], 1u);
    return b;
}
__device__ __forceinline__ void xcd_barrier_complete(unsigned* bar, unsigned x, unsigned& nloc, unsigned& nx) {
    const unsigned G = gridDim.x * gridDim.y * gridDim.z;
    unsigned sum, cnt, mine, sp = 0u;
    for (;;) {
        sum = 0u; cnt = 0u; mine = 0u;
#pragma unroll
        for (unsigned j = 0; j < 16; ++j) { const unsigned c = xb_ld(&bar[XB_XCNT(j)]); sum += c; cnt += (c > 0u) ? 1u : 0u; mine = (j == x) ? c : mine; }
        if (sum == G) break;
        __builtin_amdgcn_s_sleep(1);
        if ((++sp & 255u) == 0u) { if (xb_ld(&bar[XB_TMO])) break; if (sp > XB_SPIN_CAP) { atomicAdd(&bar[XB_TMO], 1u); break; } }
    }
    nloc = mine > 0u ? mine : 1u; nx = cnt > 0u ? cnt : 1u;
}
__device__ __forceinline__ void xcd_barrier(const XcdBarrier& b) {
    asm volatile("s_waitcnt vmcnt(0)" ::: "memory");
    __syncthreads();
    if (threadIdx.x == 0) {
        unsigned* bar = b.bar;
        __builtin_amdgcn_s_waitcnt(0);
        unsigned nloc = xb_ld(&b.st[0]), nx = xb_ld(&b.st[1]);
        if (nloc == 0u) { xcd_barrier_complete(bar, b.x, nloc, nx); __hip_atomic_store(&b.st[0], nloc, __ATOMIC_RELAXED, __HIP_MEMORY_SCOPE_AGENT); __hip_atomic_store(&b.st[1], nx, __ATOMIC_RELAXED, __HIP_MEMORY_SCOPE_AGENT); }
        const unsigned old = xb_add(&bar[XB_XSUB(b.x)], 1u);
        const unsigned gen = old / nloc;
        if (old + 1u == (gen + 1u) * nloc) {
            __builtin_amdgcn_fence(__ATOMIC_RELEASE, "agent");
            asm volatile("s_waitcnt vmcnt(0)" ::: "memory");
            const unsigned og = xb_add(&bar[XB_TOP], 1u);
            const unsigned tg = og / nx;
            if (og + 1u == (tg + 1u) * nx) xb_add(&bar[XB_TOPGEN], 1u);
            else XB_SPIN(xb_ld(&bar[XB_TOPGEN]) == tg, bar);
            __builtin_amdgcn_fence(__ATOMIC_ACQUIRE, "agent");
            xb_add(&bar[XB_XGEN(b.x)], 1u);
            asm volatile("s_waitcnt vmcnt(0)" ::: "memory");
        } else {
            XB_SPIN(xb_ld(&bar[XB_XGEN(b.x)]) == gen, bar);
            __builtin_amdgcn_fence(__ATOMIC_ACQUIRE, "agent");
            asm volatile("s_waitcnt vmcnt(0)" ::: "memory");
        }
    }
    __syncthreads();
}

__global__ void __launch_bounds__(256, 2) mega(Params p) {
    cg::grid_group grid = cg::this_grid();
    __shared__ __attribute__((aligned(16))) unsigned char smem[65536];
    float* sm = (float*)smem;
    unsigned* barw = (unsigned*)(p.ws + OFF_BAR);
    const XcdBarrier xbar = xcd_barrier_post(barw, barw + XCD_BAR_WORDS + 2 * blockIdx.x);
    bf16_t* XB = (bf16_t*)(p.ws + OFF_XB);
    bf16_t* WinT = (bf16_t*)(p.ws + OFF_WINT);
    bf16_t* WoutT = (bf16_t*)(p.ws + OFF_WOUTT);
    bf16_t* WqT = (bf16_t*)(p.ws + OFF_WQT);
    cvt_rows_bf16(p.in[0], XB, (size_t)NTOK * DM / 8);
    transpose_bf16(p.in[1], DIN, 3456, WinT);
    transpose_bf16(p.in[2], DM, DM, WoutT);
    fold_ws_phase(p.in[17], p.in[18], p.in[19], WqT);
    transpose_bf16(p.in[6], 256, 256, (bf16_t*)(p.ws + OFF_W1T), 2048);
    transpose_bf16(p.in[11], 256, 256, (bf16_t*)(p.ws + OFF_W1T) + 256 * 2048, 2048);
    if (blockIdx.x == 0) {
        for (int c = threadIdx.x; c < 512; c += 256)
            ((float*)(p.ws + OFF_LBV))[c] = 1.f / (1.f + expf(p.in[3][512 + c] - p.in[3][c]));
        if (threadIdx.x < 16) ((float*)(p.ws + OFF_DIAG))[threadIdx.x] = 0.f;
    }
    if (blockIdx.x == 1 || blockIdx.x == 2) cmp_peb(p, blockIdx.x - 1);
    grid.sync();
    gemm_bf16_phase(XB, DM, WinT, DM, NTOK / 128, 27, smem, EpiProj{p.ws});
    xcd_barrier(xbar);
    for (int it = blockIdx.x; it < 128; it += gridDim.x) {
        const int which = it >> 6, t = it & 63;
        gemm_tile(ALoadCmp{(const bf16_t*)(p.ws + OFF_KV + (size_t)which * KV_STRIDE)},
                  (const bf16_t*)(p.ws + OFF_W1T) + (size_t)which * 256 * 2048, 2048, 32, (t >> 1) * 128, (t & 1) * 128, smem,
                  EpiCmpH{(bf16_t*)(p.ws + OFF_HB) + (size_t)which * 4096 * 256, (const float*)(p.ws + OFF_PEB) + which * 256});
    }
    if (gridDim.x >= 256) {
        if (blockIdx.x >= 128)
            for (int it = blockIdx.x - 128; it < 2048; it += gridDim.x - 128) hgrn_passA(p, it, smem);
    } else {
        for (int it = blockIdx.x; it < 2048; it += gridDim.x) hgrn_passA(p, it, smem);
    }
#if NSA_DIAG
    for (int it = blockIdx.x; it < 2 * 4 * NCB * 2; it += gridDim.x) compress_item(p, it, sm);
#endif
    xcd_barrier(xbar);
    if (blockIdx.x < 256) hgrn_scan_item(p, blockIdx.x);
    else {
        cvt_rows_fp8(p.in[20], p.ws + OFF_UB, (float*)(p.ws + OFF_USC), 16384, 256, gridDim.x - 256);
        cvt_rows_fp8(p.in[21], p.ws + OFF_VB, (float*)(p.ws + OFF_VSC), 16384, 256, gridDim.x - 256);
    }
    if (gridDim.x <= 256) {
        cvt_rows_fp8(p.in[20], p.ws + OFF_UB, (float*)(p.ws + OFF_USC), 16384, 0, gridDim.x);
        cvt_rows_fp8(p.in[21], p.ws + OFF_VB, (float*)(p.ws + OFF_VSC), 16384, 0, gridDim.x);
    }
    cmp_layer2_phase(p, 0, gridDim.x);
    xcd_barrier(xbar);
    {
        const int qi = blockIdx.x & 7;
        unsigned* qctr = barw + XCD_BAR_WORDS + 2 * 1024 + 64 * qi;
        for (;;) {
            __syncthreads();
            if (threadIdx.x == 0) *(volatile unsigned*)smem = atomicAdd(qctr, 1u);
            __syncthreads();
            const int it = (int)__builtin_amdgcn_readfirstlane(*(volatile unsigned*)smem);
            if (it >= 256) break;
            nsa_tile(p, (it << 3) | qi, smem);
        }
        for (;;) {
            __syncthreads();
            if (threadIdx.x == 0) *(volatile unsigned*)smem = atomicAdd(qctr + 32, 1u);
            __syncthreads();
            const int it = (int)__builtin_amdgcn_readfirstlane(*(volatile unsigned*)smem);
            if (it >= 256) break;
            hgrn_passC(p, (it << 3) | qi, smem);
        }
    }
    xcd_barrier(xbar);
#if NSA_DIAG
    for (int it = blockIdx.x; it < 4 * 2 * SEQ; it += gridDim.x) nsa_item(p, it, sm);
    grid.sync();
    {
        const float* DG = (const float*)(p.ws + OFF_DIAG);
#if NSA_DIAG == 1
        const float cval = -log10f(sqrtf(DG[0] / DG[1]) + 1e-9f);
#else
        const float cval = -log10f(DG[2] / DG[3] + 1e-6f);
#endif
        for (size_t i = (size_t)blockIdx.x * 256 + threadIdx.x; i < (size_t)NTOK * DM; i += (size_t)gridDim.x * 256) p.out[i] = cval;
        return;
    }
#endif
    gemm_bf16_phase(XB, DM, WoutT, DM, NTOK / 128, 8, smem, EpiY{p.in[0], p.out});
    xcd_barrier(xbar);
    ln1_phase(p, sm);
    xcd_barrier(xbar);
    gemm_bf16_phase(XB, DM, WqT, DM, NTOK / 128, 16, smem, EpiTop16{(float*)(p.ws + OFF_TOPK), smem});
    xcd_barrier(xbar);
    peer_fast_phase<0>(p, smem);
    peer_fast_phase<1>(p, smem);
    peer_fast_phase<2>(p, smem);
}

extern "C" void kernel_launch(void* const* d_in, const int* in_sizes, int n_in, void* d_out, int out_size,
                              void* d_ws, size_t ws_size, hipStream_t stream) {
    static int grid_blocks = 0;
    if (!grid_blocks) {
        int dev = 0, cus = 0, per_cu = 0;
        hipGetDevice(&dev);
        hipDeviceGetAttribute(&cus, hipDeviceAttributeMultiprocessorCount, dev);
        hipOccupancyMaxActiveBlocksPerMultiprocessor(&per_cu, mega, 256, 0);
        if (per_cu > 4) per_cu = 4;
        if (per_cu < 1) per_cu = 1;
        grid_blocks = cus * per_cu;
        if (n_in != 24 || ws_size < WS_NEED || out_size != NTOK * DM)
            fprintf(stderr, "kernel_launch: unexpected sizes n_in=%d ws=%zu out=%d\n", n_in, ws_size, out_size);
    }
    Params p;
    memset(&p, 0, sizeof(p));
    for (int i = 0; i < 24; ++i) p.in[i] = (const float*)d_in[i];
    p.out = (float*)d_out;
    p.ws = (unsigned char*)d_ws;
    hipMemsetAsync((char*)d_ws + OFF_BAR, 0, BAR_BYTES, stream);
    void* args[] = {&p};
    hipError_t e = hipLaunchCooperativeKernel((void*)mega, dim3(grid_blocks), dim3(256), args, 0, stream);
    if (e != hipSuccess) fprintf(stderr, "cooperative launch failed: %s (grid %d)\n", hipGetErrorString(e), grid_blocks);
}
```

```cpp
#include <hip/hip_runtime.h>
#include <hip/hip_cooperative_groups.h>
#include <cstdio>
#include <cstring>
namespace cg = cooperative_groups;

#define NTOK 32768
#define SEQ 8192
#define DM 1024
#define DIN 3352
#define NCB 511
#define ALPHA 1.189207115002721f
#define LN_EPS 1e-5f

#define MB_ 1048576ull
#define OFF_XB 0ull
#define OFF_HQ (64 * MB_)
#define OFF_HLF (96 * MB_)
#define OFF_HI (160 * MB_)
#define OFF_HG (192 * MB_)
#define OFF_NQ (224 * MB_)
#define OFF_KV (256 * MB_)
#define KV_STRIDE (8 * MB_)
#define OFF_NGATE (304 * MB_)
#define OFF_CMPK (308 * MB_)
#define OFF_CMPV (309 * MB_)
#define OFF_WINT (310 * MB_)
#define OFF_WOUTT (317 * MB_)
#define OFF_WQT (319 * MB_)
#define OFF_LBV (323 * MB_)
#define OFF_DC (324 * MB_)
#define OFF_SC (325 * MB_)
#define OFF_UB (389 * MB_)
#define OFF_VB (421 * MB_)
#define OFF_TOPK (453 * MB_)
#define OFF_W1T (485 * MB_)
#define OFF_HB (487 * MB_)
#define OFF_CMPKB (491 * MB_)
#define OFF_CMPVB (491 * MB_ + 524288ull)
#define OFF_PEB (492 * MB_)
#define OFF_SELM (493 * MB_)
#define OFF_DIAG (494 * MB_)
#define OFF_USC (494 * MB_ + 131072ull)
#define OFF_VSC (494 * MB_ + 196608ull)
#define OFF_BAR (494 * MB_ + 65536ull)
#define BAR_BYTES 32768
#define WS_NEED (495 * MB_)
#define USE_NSA_MFMA 1
#define NSA_DIAG 0

struct Params {
    const float* in[24];
    float* out;
    unsigned char* ws;
};

typedef float f32x16 __attribute__((ext_vector_type(16)));
#define WAVE_LDS_SYNC() asm volatile("s_waitcnt lgkmcnt(0)" ::: "memory")
#define LAS3 __attribute__((address_space(3)))

__device__ __forceinline__ int opaque_tid() { int t = threadIdx.x; asm volatile("" : "+v"(t)); return t; }
__device__ __forceinline__ float wave_sum(float v) {
#pragma unroll
    for (int o = 32; o; o >>= 1) v += __shfl_xor(v, o);
    return v;
}
__device__ __forceinline__ float wave_max(float v) {
#pragma unroll
    for (int o = 32; o; o >>= 1) v = fmaxf(v, __shfl_xor(v, o));
    return v;
}
__device__ __forceinline__ float sigmoidf_(float x) { return 1.f / (1.f + expf(-x)); }
__device__ __forceinline__ float sigmoid_fast(float x) { return __builtin_amdgcn_rcpf(1.f + __builtin_amdgcn_exp2f(-1.4426950408889634f * x)); }
__device__ __forceinline__ float log_fast(float x) { return 0.6931471805599453f * __builtin_amdgcn_logf(x); }
__device__ __forceinline__ float gelu_tanh_fast(float x) {
    const float u = 0.7978845608028654f * (x + 0.044715f * x * x * x);
    return x * __builtin_amdgcn_rcpf(1.f + __builtin_amdgcn_exp2f(-2.885390081777927f * u));
}
__device__ __forceinline__ float gelu_tanh(float x) {
    const float c = 0.7978845608028654f;
    return 0.5f * x * (1.f + tanhf(c * (x + 0.044715f * x * x * x)));
}

typedef short bf16x8 __attribute__((ext_vector_type(8)));
typedef float f32x4 __attribute__((ext_vector_type(4)));
typedef unsigned short bf16_t;

typedef __bf16 bf16x2_t __attribute__((ext_vector_type(2)));
__device__ __forceinline__ unsigned pack2bf(float lo, float hi) {
    bf16x2_t v; v[0] = (__bf16)lo; v[1] = (__bf16)hi;
    return __builtin_bit_cast(unsigned, v);
}
__device__ __forceinline__ unsigned f2bf(float f) { return pack2bf(f, 0.f) & 0xffffu; }
__device__ __forceinline__ float bf2f(unsigned h) { return __uint_as_float(h << 16); }

__device__ __forceinline__ void cvt_rows_bf16(const float* __restrict__ src, bf16_t* __restrict__ dst, size_t n8) {
    for (size_t i = (size_t)blockIdx.x * 256 + threadIdx.x; i < n8; i += (size_t)gridDim.x * 256) {
        const float4 a = ((const float4*)src)[2 * i], b = ((const float4*)src)[2 * i + 1];
        uint4 o;
        o.x = pack2bf(a.x, a.y); o.y = pack2bf(a.z, a.w); o.z = pack2bf(b.x, b.y); o.w = pack2bf(b.z, b.w);
        ((uint4*)dst)[i] = o;
    }
}
__device__ __forceinline__ void transpose_bf16(const float* __restrict__ src, int Nsrc, int Npad, bf16_t* __restrict__ dst, int K = 1024) {
    const size_t total = (size_t)Npad * (K / 8);
    for (size_t i = (size_t)blockIdx.x * 256 + threadIdx.x; i < total; i += (size_t)gridDim.x * 256) {
        const int n = (int)(i % Npad), kg = (int)(i / Npad);
        float v[8];
#pragma unroll
        for (int j = 0; j < 8; ++j) v[j] = (n < Nsrc) ? src[(size_t)(kg * 8 + j) * Nsrc + n] : 0.f;
        uint4 o;
        o.x = pack2bf(v[0], v[1]); o.y = pack2bf(v[2], v[3]); o.z = pack2bf(v[4], v[5]); o.w = pack2bf(v[6], v[7]);
        *(uint4*)(dst + (size_t)n * K + kg * 8) = o;
    }
}

struct ALoadStd {
    const bf16_t* A; int lda;
    __device__ __forceinline__ const bf16_t* ptr(int row, int ks) const { return A + (size_t)row * lda + ks * 64; }
};
struct ALoadCmp {
    const bf16_t* KC;
    __device__ __forceinline__ const bf16_t* ptr(int row, int ks) const {
        const int r = row < 4088 ? row : 4087;
        const int g = r & 1, bn = r >> 1, n = bn % NCB, b = bn / NCB;
        return KC + ((size_t)(b * SEQ + 16 * n + ks) * 128 + g * 64);
    }
};
#define GLDS1(i, ks, buf) { const int row_ = 8 * w + 32 * (i) + (lane >> 3);                                                    \
        __builtin_amdgcn_global_load_lds((const unsigned*)(aload.ptr(m0 + row_, (ks)) + (((lane & 7) ^ (lane >> 3)) << 3)),      \
                                         (LAS3 unsigned*)(lds + (buf) * 32768 + w * 1024 + (i) * 4096), 16, 0, 0);              \
        __builtin_amdgcn_global_load_lds((const unsigned*)(Bp + (size_t)row_ * ldb + (ks) * 64 + (((lane & 7) ^ (lane >> 3)) << 3)), \
                                         (LAS3 unsigned*)(lds + (buf) * 32768 + 16384 + w * 1024 + (i) * 4096), 16, 0, 0); }
#define GEMM_GLDS(ks, buf) { GLDS1(0, ks, buf) GLDS1(1, ks, buf) GLDS1(2, ks, buf) GLDS1(3, ks, buf) }
template <class ALoad, class Epi>
__device__ __forceinline__ void gemm_tile(const ALoad aload, const bf16_t* __restrict__ Bt, int ldb, int KS, int m0, int n0,
                                          unsigned char* lds, Epi epi) {
    const int tid = opaque_tid(), lane = tid & 63, w = __builtin_amdgcn_readfirstlane(tid >> 6), wm = w >> 1, wn = w & 1;
    f32x4 acc[4][4];
#pragma unroll
    for (int j = 0; j < 4; ++j)
#pragma unroll
        for (int i = 0; i < 4; ++i) acc[j][i] = (f32x4){0.f, 0.f, 0.f, 0.f};
    const bf16_t* Bp = Bt + (size_t)n0 * ldb;
    __syncthreads();
    GEMM_GLDS(0, 0)
    asm volatile("s_waitcnt vmcnt(0)" ::: "memory");
    __syncthreads();
    for (int ks = 0; ks < KS; ++ks) {
        if (ks + 1 < KS) GEMM_GLDS(ks + 1, (ks + 1) & 1)
        const unsigned char* la = lds + (ks & 1) * 32768;
        const unsigned char* lb = la + 16384;
#pragma unroll
        for (int s = 0; s < 2; ++s) {
            bf16x8 af[4], wf[4];
            const int ch = s * 4 + (lane >> 4);
#pragma unroll
            for (int i = 0; i < 4; ++i) {
                const int row = wm * 64 + i * 16 + (lane & 15);
                af[i] = *(const bf16x8*)(la + row * 128 + ((ch ^ (row & 7)) << 4));
            }
#pragma unroll
            for (int j = 0; j < 4; ++j) {
                const int row = wn * 64 + j * 16 + (lane & 15);
                wf[j] = *(const bf16x8*)(lb + row * 128 + ((ch ^ (row & 7)) << 4));
            }
#pragma unroll
            for (int j = 0; j < 4; ++j)
#pragma unroll
                for (int i = 0; i < 4; ++i)
                    acc[j][i] = __builtin_amdgcn_mfma_f32_16x16x32_bf16(wf[j], af[i], acc[j][i], 0, 0, 0);
        }
        asm volatile("s_waitcnt vmcnt(0)" ::: "memory");
        __syncthreads();
    }
#pragma unroll
    for (int j = 0; j < 4; ++j)
#pragma unroll
        for (int i = 0; i < 4; ++i)
            epi(m0 + wm * 64 + i * 16 + (lane & 15), n0 + wn * 64 + j * 16 + (lane >> 4) * 4, acc[j][i]);
    epi.finish(m0, n0);
}
template <class Epi>
__device__ __forceinline__ void gemm_bf16_phase(const bf16_t* __restrict__ A, int lda, const bf16_t* __restrict__ Bt, int ldb,
                                                int Mtiles, int Ntiles, unsigned char* lds, Epi epi) {
    if ((gridDim.x & 7) == 0 && (Mtiles & 31) == 0) {
        const int x = blockIdx.x & 7, j = blockIdx.x >> 3, nb = gridDim.x >> 3;
        const int per = (Mtiles >> 3) * Ntiles;
        for (int q = j; q < per; q += nb) {
            const int s = q / (4 * Ntiles), rem = q - s * (4 * Ntiles);
            const int c = rem >> 2, r = rem & 3;
            const int mt = x + 8 * (4 * s + r);
            gemm_tile(ALoadStd{A, lda}, Bt, ldb, 16, mt * 128, c * 128, lds, epi);
        }
    } else {
        for (int tile = blockIdx.x; tile < Mtiles * Ntiles; tile += gridDim.x) {
            const int mt = tile / Ntiles, nt = tile % Ntiles;
            gemm_tile(ALoadStd{A, lda}, Bt, ldb, 16, mt * 128, nt * 128, lds, epi);
        }
    }
}


#define G3_STAGE 24576
#define G3A(i, ks, st) __builtin_amdgcn_global_load_lds((const unsigned*)(pa + (size_t)(64 * (i)) * lda + (ks) * 32),                     \
                                                        (LAS3 unsigned*)(lds + (st) + (w + 4 * (i)) * 1024), 16, 0, 0);
#define G3B(i, ks, st) __builtin_amdgcn_global_load_lds((const unsigned*)(pb + (size_t)(64 * (i)) * ldb + (ks) * 32),                     \
                                                        (LAS3 unsigned*)(lds + (st) + 16384 + (w + 4 * (i)) * 1024), 16, 0, 0);
#define G3MF(j, i) acc[j][i] = __builtin_amdgcn_mfma_f32_16x16x32_bf16(wf[j], af[i], acc[j][i], 0, 0, 0);
#define G3MF4(j, i) G3MF(j, i) G3MF(j, (i) + 1) G3MF(j, (i) + 2) G3MF(j, (i) + 3)
#define G3SB __builtin_amdgcn_sched_barrier(0);
#define G3_BODY(LOADS, KS) {                                                                                                              \
        const unsigned char* la = lds + st0 + wm * 8192 + fofs;                                                                           \
        const unsigned char* lb = lds + st0 + 16384 + wn * 4096 + fofs;                                                                   \
        bf16x8 af[8], wf[4];                                                                                                              \
        wf[0] = *(const bf16x8*)(lb);                                                                                                     \
        af[0] = *(const bf16x8*)(la);            af[1] = *(const bf16x8*)(la + 1024); af[2] = *(const bf16x8*)(la + 2048);                \
        af[3] = *(const bf16x8*)(la + 3072);     af[4] = *(const bf16x8*)(la + 4096); af[5] = *(const bf16x8*)(la + 5120);                \
        af[6] = *(const bf16x8*)(la + 6144);     af[7] = *(const bf16x8*)(la + 7168);                                                     \
        wf[1] = *(const bf16x8*)(lb + 1024);     wf[2] = *(const bf16x8*)(lb + 2048); wf[3] = *(const bf16x8*)(lb + 3072);                \
        G3SB                                                                                                                              \
        G3MF4(0, 0) if (LOADS) { G3A(0, (KS) + 2, st2) } G3SB                                                                             \
        G3MF4(0, 4) if (LOADS) { G3A(1, (KS) + 2, st2) } G3SB                                                                             \
        G3MF4(1, 0) if (LOADS) { G3A(2, (KS) + 2, st2) } G3SB                                                                             \
        G3MF4(1, 4) if (LOADS) { G3A(3, (KS) + 2, st2) } G3SB                                                                             \
        G3MF4(2, 0) if (LOADS) { G3B(0, (KS) + 2, st2) } G3SB                                                                             \
        G3MF4(2, 4) if (LOADS) { G3B(1, (KS) + 2, st2) } G3SB                                                                             \
        G3MF4(3, 0) G3MF4(3, 4) }
template <class Epi>
__device__ __forceinline__ void gemm_tile3(const bf16_t* __restrict__ A, int lda, const bf16_t* __restrict__ Bt, int ldb, int m0, int n0,
                                           unsigned char* lds, Epi epi) {
    const int tid = opaque_tid(), lane = tid & 63, w = __builtin_amdgcn_readfirstlane(tid >> 6), wm = w >> 1, wn = w & 1;
    f32x4 acc[4][8];
#pragma unroll
    for (int j = 0; j < 4; ++j)
#pragma unroll
        for (int i = 0; i < 8; ++i) acc[j][i] = (f32x4){0.f, 0.f, 0.f, 0.f};
    const int r15 = lane & 15, g4 = lane >> 4;
    const int fofs = r15 * 64 + ((g4 ^ ((0 - (r15 >> 2)) & 3)) << 4);
    const int lch = ((lane & 3) ^ ((0 - (lane >> 4)) & 3)) << 3;
    const bf16_t* pa = A + (size_t)(m0 + 16 * w + (lane >> 2)) * lda + lch;
    const bf16_t* pb = Bt + (size_t)(n0 + 16 * w + (lane >> 2)) * ldb + lch;
    __syncthreads();
    G3A(0, 0, 0) G3A(1, 0, 0) G3A(2, 0, 0) G3A(3, 0, 0) G3B(0, 0, 0) G3B(1, 0, 0)
    G3A(0, 1, G3_STAGE) G3A(1, 1, G3_STAGE) G3A(2, 1, G3_STAGE) G3A(3, 1, G3_STAGE) G3B(0, 1, G3_STAGE) G3B(1, 1, G3_STAGE)
    int st0 = 0, st1 = G3_STAGE, st2 = 2 * G3_STAGE;
#pragma unroll 1
    for (int ks = 0; ks < 30; ++ks) {
        asm volatile("s_waitcnt vmcnt(6)" ::: "memory");
        __builtin_amdgcn_s_barrier();
        asm volatile("" ::: "memory");
        G3_BODY(1, ks)
        const int t_ = st0; st0 = st1; st1 = st2; st2 = t_;
    }
    asm volatile("s_waitcnt vmcnt(6)" ::: "memory");
    __builtin_amdgcn_s_barrier();
    asm volatile("" ::: "memory");
    G3_BODY(0, 30)
    st0 = st1;
    asm volatile("s_waitcnt vmcnt(0)" ::: "memory");
    __builtin_amdgcn_s_barrier();
    asm volatile("" ::: "memory");
    G3_BODY(0, 31)
    __syncthreads();
    if constexpr (Epi::kRow) {
        unsigned char* wreg = lds + w * 16384;
        const int mrow = m0 + wm * 128, ncol = n0 + wn * 64;
        epi.dispatch(n0, [&](auto e) {
#pragma unroll
            for (int half = 0; half < 2; ++half) {
#pragma unroll
                for (int j = 0; j < 4; ++j)
#pragma unroll
                    for (int i = 0; i < 4; ++i) {
                        const int row = i * 16 + r15;
                        *(f32x4*)(wreg + row * 256 + (((j * 4 + g4) ^ r15) << 4)) = acc[j][4 * half + i];
                    }
                if constexpr (decltype(e)::kBf16) {
#pragma unroll
                    for (int it = 0; it < 8; ++it) {
                        const int row = it * 8 + (lane >> 3), c8 = lane & 7;
                        const float4 lo = *(const float4*)(wreg + row * 256 + (((2 * c8) ^ (row & 15)) << 4));
                        const float4 hi = *(const float4*)(wreg + row * 256 + (((2 * c8 + 1) ^ (row & 15)) << 4));
                        e.row8(mrow + half * 64 + row, ncol + c8 * 8, lo, hi);
                    }
                } else {
#pragma unroll
                    for (int it = 0; it < 16; ++it) {
                        const int row = it * 4 + (lane >> 4), c16 = lane & 15;
                        const float4 v = *(const float4*)(wreg + row * 256 + ((c16 ^ (row & 15)) << 4));
                        e.row4(mrow + half * 64 + row, ncol + c16 * 4, v);
                    }
                }
            }
        });
    } else {
#pragma unroll
        for (int hh = 0; hh < 2; ++hh) {
            if (wm == hh) {
#pragma unroll
                for (int j = 0; j < 4; ++j)
#pragma unroll
                    for (int i = 0; i < 8; ++i)
                        epi(m0 + wm * 128 + i * 16 + (lane & 15), n0 + wn * 64 + j * 16 + (lane >> 4) * 4, acc[j][i]);
            }
            epi.finish(m0 + hh * 128, n0);
        }
    }
}
template <class Epi>
__device__ __forceinline__ void gemm_bf16_phase3(const bf16_t* __restrict__ A, int lda, const bf16_t* __restrict__ Bt, int ldb,
                                                 int Mtiles  , int Ntiles, unsigned char* lds, Epi epi) {
    if ((gridDim.x & 7) == 0 && (Mtiles & 15) == 0) {
        const int x = blockIdx.x & 7, j = blockIdx.x >> 3, nb = gridDim.x >> 3;
        const int per = (Mtiles >> 3) * Ntiles;
        for (int q = j; q < per; q += nb) {
            const int s = q / (2 * Ntiles), rem = q - s * (2 * Ntiles);
            const int c = rem >> 1, r = rem & 1;
            const int mt = x + 8 * (2 * s + r);
            gemm_tile3(A, lda, Bt, ldb, mt * 256, c * 128, lds, epi);
        }
    } else {
        for (int tile = blockIdx.x; tile < Mtiles * Ntiles; tile += gridDim.x)
            gemm_tile3(A, lda, Bt, ldb, (tile / Ntiles) * 256, (tile % Ntiles) * 128, lds, epi);
    }
}

struct EpiF32 {
    float* C; int ldc; int Nc;
    __device__ __forceinline__ void operator()(int m, int n, f32x4 v) const {
        if (n < Nc) *(float4*)(C + (size_t)m * ldc + n) = make_float4(v[0], v[1], v[2], v[3]);
    }
    __device__ __forceinline__ void finish(int, int) const {}
};

struct EpiProjBf {
    static constexpr bool kBf16 = true;
    bf16_t* dst; int ld; float sc;
    __device__ __forceinline__ void row8(int m, int n, float4 lo, float4 hi) const {
        uint4 o;
        o.x = pack2bf(sc * lo.x, sc * lo.y); o.y = pack2bf(sc * lo.z, sc * lo.w); o.z = pack2bf(sc * hi.x, sc * hi.y); o.w = pack2bf(sc * hi.z, sc * hi.w);
        *(uint4*)(dst + (size_t)m * ld + (n & 127)) = o;
    }
};
struct EpiProjLF {
    static constexpr bool kBf16 = false;
    unsigned char* ws;
    __device__ __forceinline__ void row4(int m, int n, float4 v) const {
        const int c = n - 512;
        const float4 lb = *(const float4*)((const float*)(ws + OFF_LBV) + c);
        float4 o;
        o.x = log_fast(lb.x + (1.f - lb.x) * sigmoid_fast(v.x)); o.y = log_fast(lb.y + (1.f - lb.y) * sigmoid_fast(v.y));
        o.z = log_fast(lb.z + (1.f - lb.z) * sigmoid_fast(v.z)); o.w = log_fast(lb.w + (1.f - lb.w) * sigmoid_fast(v.w));
        *(float4*)((float*)(ws + OFF_HLF) + (size_t)m * 512 + c) = o;
    }
};
struct EpiProjGate {
    static constexpr bool kBf16 = false;
    unsigned char* ws;
    __device__ __forceinline__ void row4(int m, int n, float4 v) const {
        const int c = n - 3328;
        if (c < 24)
            *(float4*)((float*)(ws + OFF_NGATE) + (size_t)m * 24 + c) =
                make_float4(sigmoid_fast(v.x), sigmoid_fast(v.y), sigmoid_fast(v.z), sigmoid_fast(v.w));
    }
};
struct EpiProj {
    static constexpr bool kRow = true;
    unsigned char* ws;
    template <class F> __device__ __forceinline__ void dispatch(int n0, F f) const {
        const int ct = __builtin_amdgcn_readfirstlane(n0 >> 7);
        if (ct >= 4 && ct < 8) f(EpiProjLF{ws});
        else if (ct >= 26) f(EpiProjGate{ws});
        else {
            size_t off; int ld = 512, c0 = (ct & 3) * 128; float sc = 1.f;
            if (ct < 4) off = OFF_HQ;
            else if (ct < 12) off = OFF_HI;
            else if (ct < 16) off = OFF_HG;
            else if (ct < 20) { off = OFF_NQ; sc = 0.125f * 1.4426950408889634f; }
            else { off = OFF_KV + (size_t)(ct - 20) * KV_STRIDE; ld = 128; c0 = 0; }
            f(EpiProjBf{(bf16_t*)(ws + off) + c0, ld, sc});
        }
    }
    __device__ __forceinline__ void finish(int, int) const {}
};
struct EpiY {
    static constexpr bool kRow = true;
    static constexpr bool kBf16 = false;
    const float* x; float* y;
    __device__ __forceinline__ void row4(int m, int n, float4 v) const {
        const float4 xv = *(const float4*)(x + (size_t)m * DM + n);
        *(float4*)(y + (size_t)m * DM + n) = make_float4(ALPHA * xv.x + v.x, ALPHA * xv.y + v.y, ALPHA * xv.z + v.z, ALPHA * xv.w + v.w);
    }
    template <class F> __device__ __forceinline__ void dispatch(int, F f) const { f(*this); }
    __device__ __forceinline__ void finish(int, int) const {}
};

__device__ __forceinline__ uint4 pack8bf(const float* v) {
    uint4 o;
    o.x = pack2bf(v[0], v[1]); o.y = pack2bf(v[2], v[3]); o.z = pack2bf(v[4], v[5]); o.w = pack2bf(v[6], v[7]);
    return o;
}

__device__ __forceinline__ void hgrn_passA(const Params& p, int chunk, unsigned char* smem) {
    const int c = chunk & 127, bh = chunk >> 7, h = bh & 3, b = bh >> 2;
    const int tid = opaque_tid(), d = tid & 127, hf = __builtin_amdgcn_readfirstlane(tid >> 7), lane = tid & 63, w = __builtin_amdgcn_readfirstlane(tid >> 6);
    const size_t tok0 = (size_t)b * SEQ + (size_t)c * 64 + 32 * hf;
    const float* HLF = (const float*)(p.ws + OFF_HLF);
    const bf16_t* HI = (const bf16_t*)(p.ws + OFF_HI);
    unsigned char* KT = smem;
    unsigned char* VT = smem + 16384;
    float* xch = (float*)(smem + 32768);
    const float* lfp = HLF + tok0 * 512 + h * 128 + d;
    const bf16_t* vp = HI + tok0 * 512 + h * 128 + d;
    float run = 0.f;
#pragma unroll 8
    for (int s = 0; s < 32; ++s) run += lfp[s * 512];
    __syncthreads();
    xch[hf * 128 + d] = run;
    __syncthreads();
    const float tot0 = xch[d], tot1 = xch[128 + d];
    const float blast = tot0 + tot1;
    run = hf ? tot0 : 0.f;
#pragma unroll 1
    for (int q = 0; q < 4; ++q) {
        float kv[8], vv[8];
#pragma unroll
        for (int j = 0; j < 8; ++j) {
            const int s = q * 8 + j;
            const float lf = lfp[s * 512];
            run += lf;
            kv[j] = (1.f - expf(lf)) * expf(blast - run);
            vv[j] = bf2f(vp[s * 512]);
        }
        const int ch = 4 * hf + q;
        *(uint4*)(KT + d * 128 + ((ch ^ (d & 7)) << 4)) = pack8bf(kv);
        *(uint4*)(VT + d * 128 + ((ch ^ (d & 7)) << 4)) = pack8bf(vv);
    }
    if (hf) ((float*)(p.ws + OFF_DC))[(size_t)chunk * 128 + d] = expf(blast);
    __syncthreads();
    f32x4 acc[2][8];
#pragma unroll
    for (int i = 0; i < 2; ++i)
#pragma unroll
        for (int et = 0; et < 8; ++et) acc[i][et] = (f32x4){0.f, 0.f, 0.f, 0.f};
#pragma unroll
    for (int st = 0; st < 2; ++st) {
        const int ch = st * 4 + (lane >> 4);
        bf16x8 af[2];
#pragma unroll
        for (int i = 0; i < 2; ++i) {
            const int row = (2 * w + i) * 16 + (lane & 15);
            af[i] = *(const bf16x8*)(KT + row * 128 + ((ch ^ (row & 7)) << 4));
        }
#pragma unroll
        for (int et = 0; et < 8; ++et) {
            const int row = et * 16 + (lane & 15);
            const bf16x8 bfv = *(const bf16x8*)(VT + row * 128 + ((ch ^ (row & 7)) << 4));
            acc[0][et] = __builtin_amdgcn_mfma_f32_16x16x32_bf16(af[0], bfv, acc[0][et], 0, 0, 0);
            acc[1][et] = __builtin_amdgcn_mfma_f32_16x16x32_bf16(af[1], bfv, acc[1][et], 0, 0, 0);
        }
    }
    bf16_t* HC = (bf16_t*)p.out + (size_t)chunk * 16384;
#pragma unroll
    for (int i = 0; i < 2; ++i)
#pragma unroll
        for (int et = 0; et < 8; ++et) {
            const int e = et * 16 + (lane & 15), d0 = (2 * w + i) * 16 + (lane >> 4) * 4;
            { uint2 hv; hv.x = pack2bf(acc[i][et][0], acc[i][et][1]); hv.y = pack2bf(acc[i][et][2], acc[i][et][3]); *(uint2*)(HC + e * 128 + d0) = hv; }
        }
}

__device__ __forceinline__ void hgrn_scan_item(const Params& p, int item) {
    const int gid = item * 256 + threadIdx.x;
    const int d4 = gid & 31, e = (gid >> 5) & 127, bh = gid >> 12;
    const bf16_t* HC = (const bf16_t*)p.out;
    const float* DC = (const float*)(p.ws + OFF_DC);
    bf16_t* SC = (bf16_t*)(p.ws + OFF_SC);
    float4 S = make_float4(0.f, 0.f, 0.f, 0.f);
#pragma unroll 4
    for (int c = 0; c < 128; ++c) {
        const size_t base = ((size_t)(bh * 128 + c) * 128 + e) * 128 + d4 * 4;
        const uint2 hb = *(const uint2*)(HC + base);
        const float4 H = make_float4(__uint_as_float(hb.x << 16), __uint_as_float(hb.x & 0xffff0000u), __uint_as_float(hb.y << 16), __uint_as_float(hb.y & 0xffff0000u));
        const float4 dc = *(const float4*)(DC + (size_t)(bh * 128 + c) * 128 + d4 * 4);
        uint2 o; o.x = pack2bf(S.x, S.y); o.y = pack2bf(S.z, S.w);
        *(uint2*)(SC + base) = o;
        S.x = dc.x * S.x + H.x; S.y = dc.y * S.y + H.y; S.z = dc.z * S.z + H.z; S.w = dc.w * S.w + H.w;
    }
}

__device__ __forceinline__ void hgrn_passC(const Params& p, int chunk, unsigned char* smem) {
    const int c = chunk & 127, bh = chunk >> 7, h = bh & 3, b = bh >> 2;
    const int tid = opaque_tid(), d = tid & 127, hf = __builtin_amdgcn_readfirstlane(tid >> 7), lane = tid & 63, w = __builtin_amdgcn_readfirstlane(tid >> 6);
    const size_t tokc = (size_t)b * SEQ + (size_t)c * 64;
    const size_t tok0 = tokc + 32 * hf;
    const float* HLF = (const float*)(p.ws + OFF_HLF);
    const bf16_t* HQ = (const bf16_t*)(p.ws + OFF_HQ);
    const bf16_t* HI = (const bf16_t*)(p.ws + OFF_HI);
    const bf16_t* HG = (const bf16_t*)(p.ws + OFF_HG);
    unsigned char* R0 = smem;
    unsigned char* R1 = smem + 16384;
    unsigned char* R2 = smem + 57344;
    float* xch = (float*)R2;
    const float* lfp = HLF + tok0 * 512 + h * 128 + d;
    const bf16_t* qp = HQ + tok0 * 512 + h * 128 + d;
    float run = 0.f, b15 = 0.f;
#pragma unroll 8
    for (int s = 0; s < 32; ++s) { run += lfp[s * 512]; if (s == 15) b15 = run; }
    __syncthreads();
    xch[hf * 128 + d] = run;
    if (hf == 0) xch[256 + d] = b15;
    __syncthreads();
    const float tot0 = xch[d];
    const float off = hf ? tot0 : 0.f;
    const float r1 = xch[256 + d], r2 = tot0;
    if (hf) xch[384 + d] = off + b15;
    run = off;
#pragma unroll 8
    for (int s = 0; s < 32; ++s) {
        const int t = 32 * hf + s;
        run += lfp[s * 512];
        const float qv = bf2f(qp[s * 512]);
        *(bf16_t*)(R0 + t * 256 + ((((d >> 3) ^ (t & 15))) << 4) + (d & 7) * 2) = (bf16_t)f2bf(qv * expf(run));
    }
    {
        const bf16_t* SCp = (const bf16_t*)(p.ws + OFF_SC) + (size_t)chunk * 16384;
#pragma unroll
        for (int i = 0; i < 8; ++i) {
            const int cc = tid + 256 * i, row = cc >> 4, ch = cc & 15;
            *(uint4*)(R1 + row * 256 + ((ch ^ (row & 15)) << 4)) = *(const uint4*)(SCp + row * 128 + ch * 8);
        }
    }
    __syncthreads();
    f32x4 acc[8];
#pragma unroll
    for (int et = 0; et < 8; ++et) acc[et] = (f32x4){0.f, 0.f, 0.f, 0.f};
#pragma unroll
    for (int ds = 0; ds < 4; ++ds) {
        const int ch = ds * 4 + (lane >> 4);
        const int trow = w * 16 + (lane & 15);
        const bf16x8 bq = *(const bf16x8*)(R0 + trow * 256 + ((ch ^ (trow & 15)) << 4));
#pragma unroll
        for (int et = 0; et < 8; ++et) {
            const int row = et * 16 + (lane & 15);
            const bf16x8 av = *(const bf16x8*)(R1 + row * 256 + ((ch ^ (row & 15)) << 4));
            acc[et] = __builtin_amdgcn_mfma_f32_16x16x32_bf16(av, bq, acc[et], 0, 0, 0);
        }
    }
    __syncthreads();
    {
        const float r3 = xch[384 + d];
        run = off;
        unsigned char* dummy = R2 + 4096 + d * 2;
#pragma unroll 8
        for (int s = 0; s < 32; ++s) {
            const int t = 32 * hf + s;
            const int it = t >> 4;
            const float rr = (it == 0) ? 0.f : (it == 1) ? r1 : (it == 2) ? r2 : r3;
            const int sw = (((d >> 3) ^ (t & 15)) << 4) + (d & 7) * 2;
            const float lf = lfp[s * 512];
            run += lf;
            const float qv = bf2f(qp[s * 512]);
            const float kv = 1.f - expf(lf);
            *(bf16_t*)(R0 + t * 256 + sw) = (bf16_t)f2bf(qv * expf(run - rr));
#pragma unroll
            for (int i = 0; i < 4; ++i) {
                const float ri = (i == 0) ? 0.f : (i == 1) ? r1 : (i == 2) ? r2 : r3;
                const int R = 8 * i * (i + 1) + t;
                unsigned char* dst = (i >= it) ? (R1 + R * 256 + sw) : dummy;
                *(bf16_t*)dst = (bf16_t)f2bf(kv * expf(fminf(ri - run, 80.f)));
            }
        }
    }
    __syncthreads();
#pragma unroll
    for (int j = 0; j < 4; ++j) {
        uint2 o = make_uint2(0u, 0u);
        if (j <= w) {
            f32x4 pa = (f32x4){0.f, 0.f, 0.f, 0.f};
#pragma unroll
            for (int ds = 0; ds < 4; ++ds) {
                const int ch = ds * 4 + (lane >> 4);
                const int krow = 8 * w * (w + 1) + 16 * j + (lane & 15);
                const int trow = w * 16 + (lane & 15);
                const bf16x8 av = *(const bf16x8*)(R1 + krow * 256 + ((ch ^ (krow & 15)) << 4));
                const bf16x8 bq = *(const bf16x8*)(R0 + trow * 256 + ((ch ^ (trow & 15)) << 4));
                pa = __builtin_amdgcn_mfma_f32_16x16x32_bf16(av, bq, pa, 0, 0, 0);
            }
            if (j == w) {
                const int tl = lane & 15, sl = (lane >> 4) * 4;
#pragma unroll
                for (int r = 0; r < 4; ++r) if (sl + r > tl) pa[r] = 0.f;
            }
            o.x = pack2bf(pa[0], pa[1]); o.y = pack2bf(pa[2], pa[3]);
        }
        const int t = w * 16 + (lane & 15);
        const int ch = 2 * j + (lane >> 5);
        *(uint2*)(R2 + t * 128 + ((ch ^ (t & 7)) << 4) + ((lane >> 4) & 1) * 8) = o;
    }
    __syncthreads();
#pragma unroll
    for (int q = 0; q < 4; ++q) {
        float vv[8];
#pragma unroll
        for (int j = 0; j < 8; ++j) vv[j] = bf2f(HI[(tok0 + q * 8 + j) * 512 + h * 128 + d]);
        const int ch = 4 * hf + q;
        *(uint4*)(R1 + d * 128 + ((ch ^ (d & 7)) << 4)) = pack8bf(vv);
    }
    __syncthreads();
#pragma unroll
    for (int st = 0; st < 2; ++st) {
        const int ch = st * 4 + (lane >> 4);
        const int trow = w * 16 + (lane & 15);
        const bf16x8 bp = *(const bf16x8*)(R2 + trow * 128 + ((ch ^ (trow & 7)) << 4));
#pragma unroll
        for (int et = 0; et < 8; ++et) {
            const int row = et * 16 + (lane & 15);
            const bf16x8 av = *(const bf16x8*)(R1 + row * 128 + ((ch ^ (row & 7)) << 4));
            acc[et] = __builtin_amdgcn_mfma_f32_16x16x32_bf16(av, bp, acc[et], 0, 0, 0);
        }
    }
    {
        float ss = 0.f;
#pragma unroll
        for (int et = 0; et < 8; ++et)
#pragma unroll
            for (int r = 0; r < 4; ++r) ss += acc[et][r] * acc[et][r];
        ss += __shfl_xor(ss, 16);
        ss += __shfl_xor(ss, 32);
        const float rs = rsqrtf(ss * (1.f / 128.f) + LN_EPS);
        const size_t tok = tokc + w * 16 + (lane & 15);
        const float* ng = p.in[4];
        bf16_t* MIX = (bf16_t*)(p.ws + OFF_XB);
#pragma unroll
        for (int et = 0; et < 8; ++et) {
            const int e0 = et * 16 + (lane >> 4) * 4;
            const uint2 gb = *(const uint2*)(HG + tok * 512 + h * 128 + e0);
            const float4 n4 = *(const float4*)(ng + e0);
            const float g0 = bf2f(gb.x & 0xffffu), g1 = bf2f(gb.x >> 16), g2 = bf2f(gb.y & 0xffffu), g3 = bf2f(gb.y >> 16);
            uint2 o;
            o.x = pack2bf(acc[et][0] * rs * n4.x * (g0 * sigmoidf_(g0)), acc[et][1] * rs * n4.y * (g1 * sigmoidf_(g1)));
            o.y = pack2bf(acc[et][2] * rs * n4.z * (g2 * sigmoidf_(g2)), acc[et][3] * rs * n4.w * (g3 * sigmoidf_(g3)));
            *(uint2*)(MIX + tok * DM + h * 128 + e0) = o;
        }
    }
}

__device__ __forceinline__ void compress_item(const Params& p, int item, float* sm) {
    const int g = item & 1;
    int r = item >> 1;
    const int n = r % NCB; r /= NCB;
    const int b = r & 3, which = r >> 2;
    const int tid = opaque_tid();
    const bf16_t* kvsrc = (const bf16_t*)(p.ws + OFF_KV + (size_t)which * KV_STRIDE);
    const float* pe = p.in[which ? 10 : 5];
    const float* w1 = p.in[which ? 11 : 6];
    const float* b1 = p.in[which ? 12 : 7];
    const float* w2 = p.in[which ? 13 : 8];
    const float* b2 = p.in[which ? 14 : 9];
    float* outp = (float*)(p.ws + (which ? OFF_CMPV : OFF_CMPK));
    float* blk = sm;
    float* hh = sm + 2048;
    __syncthreads();
    for (int i = tid; i < 2048; i += 256) {
        const int l = i >> 6, d = i & 63;
        blk[i] = bf2f(kvsrc[(size_t)(b * SEQ + 16 * n + l) * 128 + g * 64 + d]) + pe[i];
    }
    __syncthreads();
    float acc = b1[tid];
    for (int i = 0; i < 2048; ++i) acc += blk[i] * w1[(size_t)i * 256 + tid];
    hh[tid] = gelu_tanh(acc);
    __syncthreads();
    if (tid < 64) {
        float o = b2[tid];
        for (int j = 0; j < 256; ++j) o += hh[j] * w2[j * 64 + tid];
        outp[((size_t)(b * NCB + n) * 2 + g) * 64 + tid] = o;
    }
}

__device__ __forceinline__ float dot64_bf(const float* qs, const bf16_t* krow) {
    float s = 0.f;
#pragma unroll
    for (int i = 0; i < 8; ++i) {
        const uint4 kv = ((const uint4*)krow)[i];
        const float4 q0 = ((const float4*)qs)[2 * i], q1 = ((const float4*)qs)[2 * i + 1];
        s += __uint_as_float(kv.x << 16) * q0.x + __uint_as_float(kv.x & 0xffff0000u) * q0.y
           + __uint_as_float(kv.y << 16) * q0.z + __uint_as_float(kv.y & 0xffff0000u) * q0.w
           + __uint_as_float(kv.z << 16) * q1.x + __uint_as_float(kv.z & 0xffff0000u) * q1.y
           + __uint_as_float(kv.w << 16) * q1.z + __uint_as_float(kv.w & 0xffff0000u) * q1.w;
    }
    return s;
}
__device__ __forceinline__ float dot64(const float* qs, const float* krow) {
    float s = 0.f;
#pragma unroll
    for (int i = 0; i < 16; ++i) {
        const float4 kv = ((const float4*)krow)[i];
        const float4 qv = ((const float4*)qs)[i];
        s += kv.x * qv.x + kv.y * qv.y + kv.z * qv.z + kv.w * qv.w;
    }
    return s;
}

__device__ __forceinline__ void nsa_item(const Params& p, int item, float* sm) {
    const int t = item & (SEQ - 1), g = (item >> 13) & 1, b = item >> 14;
    const int tid = threadIdx.x, lane = tid & 63, r = tid >> 6;
    float* sc = sm + r * 1024;
    float* qs = sm + 4096 + r * 64;
    float* impv = sm + 4096 + 256;
    int* sel = (int*)(sm + 4096 + 256 + 128);
    const bf16_t* KSb = (const bf16_t*)(p.ws + OFF_KV + 2 * KV_STRIDE);
    const bf16_t* VSb = (const bf16_t*)(p.ws + OFF_KV + 3 * KV_STRIDE);
    const bf16_t* KWb = (const bf16_t*)(p.ws + OFF_KV + 4 * KV_STRIDE);
    const bf16_t* VWb = (const bf16_t*)(p.ws + OFF_KV + 5 * KV_STRIDE);
    const float* cmpk = (const float*)(p.ws + OFF_CMPK);
    const float* cmpv = (const float*)(p.ws + OFF_CMPV);
    const size_t n = (size_t)b * SEQ + t;
    const float NEGV = -1e30f;
    __syncthreads();
    qs[lane] = bf2f(((const bf16_t*)(p.ws + OFF_NQ))[n * 512 + g * 256 + r * 64 + lane]) * 0.6931471805599453f;
    __syncthreads();

    const int nvalid = (t >= 31) ? (((t - 31) >> 4) + 1) : 0;
    float m = NEGV;
    for (int n0 = 0; n0 < nvalid; n0 += 64) {
        const int nn = n0 + lane;
        if (nn < nvalid) {
            const float s = dot64(qs, cmpk + ((size_t)(b * NCB + nn) * 2 + g) * 64);
            sc[nn] = s;
            m = fmaxf(m, s);
        }
    }
    m = wave_max(m);
    float sum = 0.f;
    for (int n0 = 0; n0 < nvalid; n0 += 64) {
        const int nn = n0 + lane;
        if (nn < nvalid) { const float e = expf(sc[nn] - m); sc[nn] = e; sum += e; }
    }
    sum = wave_sum(sum);
    {
        const float inv = 1.f / fmaxf(sum, 1e-30f);
        for (int n0 = 0; n0 < nvalid; n0 += 64) {
            const int nn = n0 + lane;
            if (nn < nvalid) sc[nn] *= inv;
        }
    }
    __syncthreads();
    float oc = 0.f;
    for (int nn = 0; nn < nvalid; ++nn) oc += sc[nn] * cmpv[((size_t)(b * NCB + nn) * 2 + g) * 64 + lane];

    const int cur = t >> 6;
    if (tid < 128) {
        const int j = tid;
        float im = 0.f;
#pragma unroll
        for (int rr = 0; rr < 4; ++rr) {
            const float* P = sm + rr * 1024;
            const int n4 = 4 * j;
            float a = 0.f;
            if (n4 < nvalid) a += P[n4];
            if (n4 + 1 < nvalid) a += P[n4 + 1];
            if (n4 + 2 < nvalid) a += P[n4 + 2];
            if (n4 + 3 < nvalid) a += 0.5f * P[n4 + 3];
            if (n4 - 1 >= 0 && n4 - 1 < nvalid) a += 0.5f * P[n4 - 1];
            im += a;
        }
        const bool forced = (j == 0) || (j == cur) || (j == cur - 1);
        const bool causal = (j <= cur);
        impv[j] = forced ? 1.0e4f : (causal ? im : -1.f);
    }
    __syncthreads();
    if (r == 0) {
        float v0 = impv[lane], v1 = impv[lane + 64];
        for (int k = 0; k < 16; ++k) {
            const float mx = wave_max(fmaxf(v0, v1));
            const unsigned long long b0 = __ballot(v0 == mx);
            int idx;
            if (b0) {
                const int l = __ffsll((unsigned long long)b0) - 1;
                idx = l;
                if (lane == l) v0 = -3.0e38f;
            } else {
                const unsigned long long b1 = __ballot(v1 == mx);
                const int l = __ffsll((unsigned long long)b1) - 1;
                idx = 64 + l;
                if (lane == l) v1 = -3.0e38f;
            }
            if (lane == 0) sel[k] = idx;
        }
    }
    __syncthreads();

    m = NEGV;
    for (int si = 0; si < 16; ++si) {
        const int blk = sel[si];
        const int key = blk * 64 + lane;
        float s = NEGV;
        if (blk * 64 <= t) {
            if (key <= t) s = dot64_bf(qs, KSb + ((size_t)b * SEQ + key) * 128 + g * 64);
        }
        sc[si * 64 + lane] = s;
        m = fmaxf(m, s);
    }
    m = wave_max(m);
    sum = 0.f;
    for (int si = 0; si < 16; ++si) {
        const int key = sel[si] * 64 + lane;
        const float e = (key <= t) ? expf(sc[si * 64 + lane] - m) : 0.f;
        sc[si * 64 + lane] = e;
        sum += e;
    }
    sum = wave_sum(sum);
    {
        const float inv = 1.f / fmaxf(sum, 1e-30f);
        for (int si = 0; si < 16; ++si) sc[si * 64 + lane] *= inv;
    }
    __syncthreads();
    float os = 0.f;
    for (int si = 0; si < 16; ++si) {
        const int blk = sel[si];
        if (blk * 64 > t) continue;
        for (int kk = 0; kk < 64; ++kk) {
            const int key = blk * 64 + kk;
            if (key > t) break;
            os += sc[si * 64 + kk] * bf2f(VSb[((size_t)b * SEQ + key) * 128 + g * 64 + lane]);
        }
    }
    __syncthreads();

    const int lo = t - 511;
    m = NEGV;
    for (int i = 0; i < 8; ++i) {
        const int key = lo + i * 64 + lane;
        float s = NEGV;
        if (key >= 0) s = dot64_bf(qs, KWb + ((size_t)b * SEQ + key) * 128 + g * 64);
        sc[i * 64 + lane] = s;
        m = fmaxf(m, s);
    }
    m = wave_max(m);
    sum = 0.f;
    for (int i = 0; i < 8; ++i) {
        const int key = lo + i * 64 + lane;
        const float e = (key >= 0) ? expf(sc[i * 64 + lane] - m) : 0.f;
        sc[i * 64 + lane] = e;
        sum += e;
    }
    sum = wave_sum(sum);
    {
        const float inv = 1.f / fmaxf(sum, 1e-30f);
        for (int i = 0; i < 8; ++i) sc[i * 64 + lane] *= inv;
    }
    __syncthreads();
    float ow = 0.f;
    for (int idx = 0; idx < 512; ++idx) {
        const int key = lo + idx;
        if (key < 0) continue;
        ow += sc[idx] * bf2f(VWb[((size_t)b * SEQ + key) * 128 + g * 64 + lane]);
    }
    const float* grow = (const float*)(p.ws + OFF_NGATE) + n * 24 + g * 12 + r * 3;
    const float gc = grow[0], gs = grow[1], gw = grow[2];
#if NSA_DIAG
    {
        const float ref = gc * oc + gs * os + gw * ow;
        const float got = bf2f(((const bf16_t*)(p.ws + OFF_XB))[n * DM + 512 + g * 256 + r * 64 + lane]);
        const unsigned* SELM = (const unsigned*)(p.ws + OFF_SELM) + ((size_t)(b * 2 + g) * SEQ + t) * 4;
        unsigned gm[4] = {0u, 0u, 0u, 0u};
        for (int si = 0; si < 16; ++si) { const int blk = sel[si]; if (blk * 64 <= t) gm[blk >> 5] |= 1u << (blk & 31); }
        bool same = true;
        for (int qd = 0; qd < 4; ++qd) {
            unsigned mm = SELM[qd];
            for (int bit = 0; bit < 32; ++bit) if ((qd * 32 + bit) * 64 > t) mm &= ~(1u << bit);
            if (mm != gm[qd]) same = false;
        }
        float d2 = same ? (got - ref) * (got - ref) : 0.f, r2 = same ? ref * ref : 0.f;
        d2 = wave_sum(d2); r2 = wave_sum(r2);
        float* DG = (float*)(p.ws + OFF_DIAG);
        if (lane == 0) { atomicAdd(&DG[0], d2); atomicAdd(&DG[1], r2); if (r == 0) { atomicAdd(&DG[2], same ? 0.f : 1.f); atomicAdd(&DG[3], 1.f); } }
    }
#else
    ((bf16_t*)(p.ws + OFF_XB))[n * DM + 512 + g * 256 + r * 64 + lane] = (bf16_t)f2bf(gc * oc + gs * os + gw * ow);
#endif
}


__device__ __forceinline__ float xrow_max(float x) {
    auto s = __builtin_amdgcn_permlane16_swap(__float_as_uint(x), __float_as_uint(x), false, false);
    x = fmaxf(__uint_as_float(s[0]), __uint_as_float(s[1]));
    auto t = __builtin_amdgcn_permlane32_swap(__float_as_uint(x), __float_as_uint(x), false, false);
    return fmaxf(__uint_as_float(t[0]), __uint_as_float(t[1]));
}
__device__ __forceinline__ float xrow_sum(float x) {
    auto s = __builtin_amdgcn_permlane16_swap(__float_as_uint(x), __float_as_uint(x), false, false);
    x = __uint_as_float(s[0]) + __uint_as_float(s[1]);
    auto t = __builtin_amdgcn_permlane32_swap(__float_as_uint(x), __float_as_uint(x), false, false);
    return __uint_as_float(t[0]) + __uint_as_float(t[1]);
}
template <int CTRL> __device__ __forceinline__ float dppf(float x) {
    return __builtin_bit_cast(float, __builtin_amdgcn_mov_dpp(__builtin_bit_cast(int, x), CTRL, 0xf, 0xf, true));
}
__device__ __forceinline__ float row16_max(float m) {
    m = fmaxf(m, dppf<0x121>(m)); m = fmaxf(m, dppf<0x122>(m));
    m = fmaxf(m, dppf<0x124>(m)); m = fmaxf(m, dppf<0x128>(m));
    return m;
}
__device__ __forceinline__ float row16_sum(float m) {
    m += dppf<0x121>(m); m += dppf<0x122>(m); m += dppf<0x124>(m); m += dppf<0x128>(m);
    return m;
}
__device__ __forceinline__ float dot2bf(unsigned a, unsigned b, float acc) {
    return __builtin_amdgcn_fdot2_f32_bf16(__builtin_bit_cast(bf16x2_t, a), __builtin_bit_cast(bf16x2_t, b), acc, false);
}
__device__ __forceinline__ float enc_key(float v, unsigned idx, unsigned mask) {
    const unsigned u = __float_as_uint(v);
    const unsigned code = (u >> 31) ? idx : (mask - idx);
    return __uint_as_float((u & ~mask) | code);
}
__device__ __forceinline__ unsigned dec_idx(float key, unsigned mask) {
    const unsigned u = __float_as_uint(key);
    const unsigned code = u & mask;
    return (u >> 31) ? code : (mask - code);
}
__device__ __forceinline__ float dec_val(float key, unsigned mask) { return __uint_as_float(__float_as_uint(key) & ~mask); }
#define NEGKEY (-3.0e38f)
#define CE_DESC(a, b) { const float t_ = fmaxf(a, b); b = fminf(a, b); a = t_; }

struct EpiCmpH {
    bf16_t* HB; const float* peb;
    __device__ __forceinline__ void operator()(int m, int n, f32x4 v) const {
        const float4 pb = *(const float4*)(peb + n);
        uint2 o;
        o.x = pack2bf(gelu_tanh(v[0] + pb.x), gelu_tanh(v[1] + pb.y));
        o.y = pack2bf(gelu_tanh(v[2] + pb.z), gelu_tanh(v[3] + pb.w));
        *(uint2*)(HB + (size_t)m * 256 + n) = o;
    }
    __device__ __forceinline__ void finish(int, int) const {}
};
__device__ __forceinline__ void cmp_peb(const Params& p, int which) {
    const float* pe = p.in[which ? 10 : 5];
    const float* w1 = p.in[which ? 11 : 6];
    const float* b1 = p.in[which ? 12 : 7];
    const int j = threadIdx.x;
    float acc = b1[j];
    for (int i = 0; i < 2048; ++i) acc += pe[i] * w1[(size_t)i * 256 + j];
    ((float*)(p.ws + OFF_PEB))[which * 256 + j] = acc;
}
__device__ __forceinline__ void cmp_layer2_phase(const Params& p, int first_block, int nblocks) {
    const int tid_ = opaque_tid(), lane = tid_ & 63, w = __builtin_amdgcn_readfirstlane(tid_ >> 6);
    for (int it = (blockIdx.x - first_block) * 4 + w; it < 2 * 4088; it += nblocks * 4) {
        const int which = it >= 4088, row = which ? it - 4088 : it;
        const float* w2 = p.in[which ? 13 : 8];
        const float* b2 = p.in[which ? 14 : 9];
        const bf16_t* hrow = (const bf16_t*)(p.ws + OFF_HB) + ((size_t)which * 4096 + row) * 256;
        float o = b2[lane];
#pragma unroll 8
        for (int j = 0; j < 256; ++j) o += bf2f(hrow[j]) * w2[j * 64 + lane];
        const int g = row & 1, bn = row >> 1, n = bn % NCB, b = bn / NCB;
        ((bf16_t*)(p.ws + (which ? OFF_CMPVB : OFF_CMPKB)))[((size_t)(b * 2 + g) * 512 + n) * 64 + lane] = (bf16_t)f2bf(o);
    }
}

struct StageOfs { int k, v; };
__device__ __forceinline__ StageOfs make_stage_ofs() {
    const int c0 = opaque_tid(), key = c0 >> 3, ch = c0 & 7;
    StageOfs s;
    s.k = key * 128 + ((ch ^ (key & 7)) << 4);
    s.v = key * 128 + (((ch >> 1) ^ ((key >> 1) & 3)) << 5) + (ch & 1) * 16;
    return s;
}
#define NSA_KV_LOAD(S_, kb_) { const bf16_t* kp_ = Kbase + (size_t)(kb_) * 64 * stride + (size_t)(tid >> 3) * stride + (tid & 7) * 8; \
        const bf16_t* vp_ = Vbase + (size_t)(kb_) * 64 * stride + (size_t)(tid >> 3) * stride + (tid & 7) * 8;                 \
        S_##k0 = *(const uint4*)kp_; S_##k1 = *(const uint4*)(kp_ + (size_t)32 * stride);                                    \
        S_##v0 = *(const uint4*)vp_; S_##v1 = *(const uint4*)(vp_ + (size_t)32 * stride); }
#define NSA_KV_STORE(S_, Kl_, Vl_) { *(uint4*)((Kl_) + sof.k) = S_##k0; *(uint4*)((Kl_) + sof.k + 4096) = S_##k1; \
        *(uint4*)((Vl_) + sof.v) = S_##v0; *(uint4*)((Vl_) + sof.v + 4096) = S_##v1; }
template <class Compute>
__device__ __forceinline__ void nsa_kv_loop(const bf16_t* __restrict__ Kbase, const bf16_t* __restrict__ Vbase, int stride,
                                            int kb_lo, int kb_hi, unsigned char* smem, const StageOfs& sof, Compute compute) {
    const int tid = opaque_tid();
    uint4 ra_k0, ra_k1, ra_v0, ra_v1;
    NSA_KV_LOAD(ra_, kb_lo)
    __syncthreads();
    NSA_KV_STORE(ra_, smem, smem + 16384)
    __syncthreads();
    for (int kb = kb_lo; kb <= kb_hi; ++kb) {
        const int buf = (kb - kb_lo) & 1;
        if (kb < kb_hi) NSA_KV_LOAD(ra_, kb + 1)
        compute(kb, smem + buf * 8192, smem + 16384 + buf * 8192);
        if (kb < kb_hi) NSA_KV_STORE(ra_, smem + (buf ^ 1) * 8192, smem + 16384 + (buf ^ 1) * 8192)
        __syncthreads();
    }
}
struct LaneOfs { int k0, k1, vb0, vb1, vb2, vb3; };
__device__ __forceinline__ LaneOfs make_lane_ofs(int lane) {
    LaneOfs f;
    const int r15 = lane & 15, lg = lane >> 4, q = r15 >> 2, pp = r15 & 3;
    f.k0 = r15 * 128 + ((lg ^ (r15 & 7)) << 4);
    f.k1 = r15 * 128 + (((4 + lg) ^ (r15 & 7)) << 4);
    const int sw2 = (2 * (lg & 1) + (q >> 1)) & 3;
    const int vrow = (4 * lg + q) * 128 + pp * 8;
    f.vb0 = vrow + ((0 ^ sw2) << 5); f.vb1 = vrow + ((1 ^ sw2) << 5);
    f.vb2 = vrow + ((2 ^ sw2) << 5); f.vb3 = vrow + ((3 ^ sw2) << 5);
    return f;
}
typedef short s16x4 __attribute__((ext_vector_type(4)));
__device__ __forceinline__ uint2 tr_read(const unsigned char* p) {
    const s16x4 v = __builtin_amdgcn_ds_read_tr16_b64_v4i16((LAS3 s16x4*)p);
    return __builtin_bit_cast(uint2, v);
}
#define NEGM (-1.0e37f)
__device__ __forceinline__ void nsa_scores(const unsigned char* Kl, const LaneOfs& f, const bf16x8& q0, const bf16x8& q1, float bias, f32x4 (&s)[4]) {
#pragma unroll
    for (int kt = 0; kt < 4; ++kt) {
        const bf16x8 a0 = *(const bf16x8*)(Kl + f.k0 + kt * 2048);
        const bf16x8 a1 = *(const bf16x8*)(Kl + f.k1 + kt * 2048);
        f32x4 z = (f32x4){bias, bias, bias, bias};
        z = __builtin_amdgcn_mfma_f32_16x16x32_bf16(a0, q0, z, 0, 0, 0);
        s[kt] = __builtin_amdgcn_mfma_f32_16x16x32_bf16(a1, q1, z, 0, 0, 0);
    }
}
#define ONES_BF16X8 __builtin_bit_cast(bf16x8, make_uint4(0x3F803F80u, 0x3F803F80u, 0x3F803F80u, 0x3F803F80u))
template <class VF>
__device__ __forceinline__ void attn_step(const unsigned char* Kl, const unsigned char* Vl, int lane, const LaneOfs& f,
                                          const bf16x8& q0, const bf16x8& q1, f32x4 (&o)[4], float& m, f32x4& lacc,
                                          float rowbias, bool full, VF valid) {
    f32x4 s[4];
    const bool mok = m > -1e29f;
    const float meff = mok ? m : 0.f;
    nsa_scores(Kl, f, q0, q1, rowbias - meff, s);
    if (!full) {
#pragma unroll
        for (int kt = 0; kt < 4; ++kt)
#pragma unroll
            for (int r = 0; r < 4; ++r) s[kt][r] = valid(kt * 16 + 4 * (lane >> 4) + r) ? s[kt][r] : NEGM;
    }
    float mx = fmaxf(fmaxf(fmaxf(s[0][0], s[0][1]), fmaxf(s[0][2], s[0][3])), fmaxf(fmaxf(s[1][0], s[1][1]), fmaxf(s[1][2], s[1][3])));
    mx = fmaxf(mx, fmaxf(fmaxf(fmaxf(s[2][0], s[2][1]), fmaxf(s[2][2], s[2][3])), fmaxf(fmaxf(s[3][0], s[3][1]), fmaxf(s[3][2], s[3][3]))));
    mx = xrow_max(mx);
    if (!__all(mok && (mx <= 8.f))) {
        const float mn = fmaxf(m, meff + mx);
        const float alpha = __builtin_amdgcn_exp2f(m - mn), d = mn - meff;
        m = mn; lacc[0] *= alpha;
#pragma unroll
        for (int dt = 0; dt < 4; ++dt) { o[dt][0] *= alpha; o[dt][1] *= alpha; o[dt][2] *= alpha; o[dt][3] *= alpha; }
#pragma unroll
        for (int kt = 0; kt < 4; ++kt) { s[kt][0] -= d; s[kt][1] -= d; s[kt][2] -= d; s[kt][3] -= d; }
    }
#pragma unroll
    for (int kt = 0; kt < 4; ++kt)
#pragma unroll
        for (int r = 0; r < 4; ++r) s[kt][r] = __builtin_amdgcn_exp2f(s[kt][r]);
#pragma unroll
    for (int k2 = 0; k2 < 2; ++k2) {
        uint4 pk;
        pk.x = pack2bf(s[2 * k2][0], s[2 * k2][1]); pk.y = pack2bf(s[2 * k2][2], s[2 * k2][3]);
        pk.z = pack2bf(s[2 * k2 + 1][0], s[2 * k2 + 1][1]); pk.w = pack2bf(s[2 * k2 + 1][2], s[2 * k2 + 1][3]);
        const bf16x8 pb = __builtin_bit_cast(bf16x8, pk);
        lacc = __builtin_amdgcn_mfma_f32_16x16x32_bf16(ONES_BF16X8, pb, lacc, 0, 0, 0);
#define PV1(dt_, vb_) { const uint2 lo_ = tr_read(Vl + (vb_) + k2 * 4096), hi_ = tr_read(Vl + (vb_) + k2 * 4096 + 2048); \
                        uint4 av_; av_.x = lo_.x; av_.y = lo_.y; av_.z = hi_.x; av_.w = hi_.y;                          \
                        o[dt_] = __builtin_amdgcn_mfma_f32_16x16x32_bf16(__builtin_bit_cast(bf16x8, av_), pb, o[dt_], 0, 0, 0); }
        PV1(0, f.vb0) PV1(1, f.vb1) PV1(2, f.vb2) PV1(3, f.vb3)
#undef PV1
    }
}
template <class VFA, class VFB>
__device__ __forceinline__ void attn_step2(const unsigned char* Kl, const unsigned char* Vl, int lane, const LaneOfs& f,
                                           const bf16x8& qA0, const bf16x8& qA1, f32x4 (&oA)[4], float& mA, f32x4& lA, float biasA, bool fullA, VFA validA,
                                           const bf16x8& qB0, const bf16x8& qB1, f32x4 (&oB)[4], float& mB, f32x4& lB, float biasB, bool fullB, VFB validB) {
    f32x4 sA[4], sB[4];
    const bool mokA = mA > -1e29f, mokB = mB > -1e29f;
    const float meA = mokA ? mA : 0.f, meB = mokB ? mB : 0.f;
    const float iA = biasA - meA, iB = biasB - meB;
#pragma unroll
    for (int kt = 0; kt < 4; ++kt) {
        const bf16x8 a0 = *(const bf16x8*)(Kl + f.k0 + kt * 2048);
        const bf16x8 a1 = *(const bf16x8*)(Kl + f.k1 + kt * 2048);
        f32x4 zA = (f32x4){iA, iA, iA, iA}, zB = (f32x4){iB, iB, iB, iB};
        zA = __builtin_amdgcn_mfma_f32_16x16x32_bf16(a0, qA0, zA, 0, 0, 0);
        zB = __builtin_amdgcn_mfma_f32_16x16x32_bf16(a0, qB0, zB, 0, 0, 0);
        sA[kt] = __builtin_amdgcn_mfma_f32_16x16x32_bf16(a1, qA1, zA, 0, 0, 0);
        sB[kt] = __builtin_amdgcn_mfma_f32_16x16x32_bf16(a1, qB1, zB, 0, 0, 0);
    }
    if (!fullA) {
#pragma unroll
        for (int kt = 0; kt < 4; ++kt)
#pragma unroll
            for (int r = 0; r < 4; ++r) sA[kt][r] = validA(kt * 16 + 4 * (lane >> 4) + r) ? sA[kt][r] : NEGM;
    }
    if (!fullB) {
#pragma unroll
        for (int kt = 0; kt < 4; ++kt)
#pragma unroll
            for (int r = 0; r < 4; ++r) sB[kt][r] = validB(kt * 16 + 4 * (lane >> 4) + r) ? sB[kt][r] : NEGM;
    }
    float mxA = fmaxf(fmaxf(fmaxf(sA[0][0], sA[0][1]), fmaxf(sA[0][2], sA[0][3])), fmaxf(fmaxf(sA[1][0], sA[1][1]), fmaxf(sA[1][2], sA[1][3])));
    float mxB = fmaxf(fmaxf(fmaxf(sB[0][0], sB[0][1]), fmaxf(sB[0][2], sB[0][3])), fmaxf(fmaxf(sB[1][0], sB[1][1]), fmaxf(sB[1][2], sB[1][3])));
    mxA = fmaxf(mxA, fmaxf(fmaxf(fmaxf(sA[2][0], sA[2][1]), fmaxf(sA[2][2], sA[2][3])), fmaxf(fmaxf(sA[3][0], sA[3][1]), fmaxf(sA[3][2], sA[3][3]))));
    mxB = fmaxf(mxB, fmaxf(fmaxf(fmaxf(sB[2][0], sB[2][1]), fmaxf(sB[2][2], sB[2][3])), fmaxf(fmaxf(sB[3][0], sB[3][1]), fmaxf(sB[3][2], sB[3][3]))));
    mxA = xrow_max(mxA); mxB = xrow_max(mxB);
    if (!__all(mokA && mokB && (mxA <= 8.f) && (mxB <= 8.f))) {
        const float mnA = fmaxf(mA, meA + mxA), mnB = fmaxf(mB, meB + mxB);
        const float alA = __builtin_amdgcn_exp2f(mA - mnA), alB = __builtin_amdgcn_exp2f(mB - mnB);
        const float dA = mnA - meA, dB = mnB - meB;
        mA = mnA; mB = mnB; lA[0] *= alA; lB[0] *= alB;
#pragma unroll
        for (int dt = 0; dt < 4; ++dt) {
            oA[dt][0] *= alA; oA[dt][1] *= alA; oA[dt][2] *= alA; oA[dt][3] *= alA;
            oB[dt][0] *= alB; oB[dt][1] *= alB; oB[dt][2] *= alB; oB[dt][3] *= alB;
        }
#pragma unroll
        for (int kt = 0; kt < 4; ++kt) {
            sA[kt][0] -= dA; sA[kt][1] -= dA; sA[kt][2] -= dA; sA[kt][3] -= dA;
            sB[kt][0] -= dB; sB[kt][1] -= dB; sB[kt][2] -= dB; sB[kt][3] -= dB;
        }
    }
#pragma unroll
    for (int kt = 0; kt < 4; ++kt)
#pragma unroll
        for (int r = 0; r < 4; ++r) { sA[kt][r] = __builtin_amdgcn_exp2f(sA[kt][r]); sB[kt][r] = __builtin_amdgcn_exp2f(sB[kt][r]); }
#pragma unroll
    for (int k2 = 0; k2 < 2; ++k2) {
        uint4 pk;
        pk.x = pack2bf(sA[2 * k2][0], sA[2 * k2][1]); pk.y = pack2bf(sA[2 * k2][2], sA[2 * k2][3]);
        pk.z = pack2bf(sA[2 * k2 + 1][0], sA[2 * k2 + 1][1]); pk.w = pack2bf(sA[2 * k2 + 1][2], sA[2 * k2 + 1][3]);
        const bf16x8 pbA = __builtin_bit_cast(bf16x8, pk);
        pk.x = pack2bf(sB[2 * k2][0], sB[2 * k2][1]); pk.y = pack2bf(sB[2 * k2][2], sB[2 * k2][3]);
        pk.z = pack2bf(sB[2 * k2 + 1][0], sB[2 * k2 + 1][1]); pk.w = pack2bf(sB[2 * k2 + 1][2], sB[2 * k2 + 1][3]);
        const bf16x8 pbB = __builtin_bit_cast(bf16x8, pk);
        lA = __builtin_amdgcn_mfma_f32_16x16x32_bf16(ONES_BF16X8, pbA, lA, 0, 0, 0);
        lB = __builtin_amdgcn_mfma_f32_16x16x32_bf16(ONES_BF16X8, pbB, lB, 0, 0, 0);
#define PV2(dt_, vb_) { const uint2 lo_ = tr_read(Vl + (vb_) + k2 * 4096), hi_ = tr_read(Vl + (vb_) + k2 * 4096 + 2048); \
                        uint4 av_; av_.x = lo_.x; av_.y = lo_.y; av_.z = hi_.x; av_.w = hi_.y;                          \
                        oA[dt_] = __builtin_amdgcn_mfma_f32_16x16x32_bf16(__builtin_bit_cast(bf16x8, av_), pbA, oA[dt_], 0, 0, 0); \
                        oB[dt_] = __builtin_amdgcn_mfma_f32_16x16x32_bf16(__builtin_bit_cast(bf16x8, av_), pbB, oB[dt_], 0, 0, 0); }
        PV2(0, f.vb0) PV2(1, f.vb1) PV2(2, f.vb2) PV2(3, f.vb3)
#undef PV2
    }
}

#define NSA_TILES 2048
__device__ __forceinline__ void nsa_tile(const Params& p, int tile, unsigned char* smem) {
    const int tid = opaque_tid(), lane = tid & 63, w = __builtin_amdgcn_readfirstlane(tid >> 6);
    const int bg = tile & 7, tb = 255 - (tile >> 3);
    const int b = bg >> 1, g = bg & 1;
    const int t0 = tb * 32, cur = t0 >> 6;
    float* impL = (float*)(smem + 32768);
    unsigned* selL = (unsigned*)(smem + 49152);
    const bf16_t* NQ = (const bf16_t*)(p.ws + OFF_NQ);
    const float* NG = (const float*)(p.ws + OFF_NGATE);
    const int rowq = lane & 15, tl = rowq >> 2, head = rowq & 3, lg = lane >> 4;
    const int toklA = 8 * w + tl, toklB = 8 * w + 4 + tl;
    const LaneOfs lof = make_lane_ofs(lane);
    const StageOfs sof = make_stage_ofs();
    const size_t tokb = (size_t)b * SEQ + t0;
    bf16x8 qA0, qA1, qB0, qB1;
    {
        const bf16_t* qp = NQ + (tokb + toklA) * 512 + g * 256 + head * 64 + lg * 8;
        qA0 = *(const bf16x8*)qp; qA1 = *(const bf16x8*)(qp + 32);
        qB0 = *(const bf16x8*)(qp + 4 * 512); qB1 = *(const bf16x8*)(qp + 4 * 512 + 32);
    }
    const float* gpA = NG + (tokb + toklA) * 24 + g * 12 + head * 3;
    const float* gpB = gpA + 4 * 24;
    __syncthreads();
    for (int i = tid; i < 4096; i += 256) impL[i] = 0.f;
    const int tqA = t0 + toklA, tqB = t0 + toklB;
    const int tminA = t0 + 8 * w, tminB = tminA + 4;
    f32x4 oA[4], oB[4], otA[4], otB[4];
    float mA, mB;
    f32x4 lA, lB;
#define NSA_RESET() { _Pragma("unroll") for (int dt = 0; dt < 4; ++dt) { oA[dt] = (f32x4){0.f, 0.f, 0.f, 0.f}; oB[dt] = (f32x4){0.f, 0.f, 0.f, 0.f}; } \
                      mA = -1e30f; mB = -1e30f; lA = (f32x4){0.f, 0.f, 0.f, 0.f}; lB = (f32x4){0.f, 0.f, 0.f, 0.f}; }
#define NSA_LSUM() { }

    const int nvA = (tqA >= 31) ? (((tqA - 31) >> 4) + 1) : 0;
    const int nvB = (tqB >= 31) ? (((tqB - 31) >> 4) + 1) : 0;
    const int nvminA = (tminA >= 31) ? (((tminA - 31) >> 4) + 1) : 0;
    const int nvminB = (tminB >= 31) ? (((tminB - 31) >> 4) + 1) : 0;
    const int nkb = (((t0 >> 4) + 1) + 63) >> 6;
    const bf16_t* ckb = (const bf16_t*)(p.ws + OFF_CMPKB) + (size_t)(b * 2 + g) * 512 * 64;
    const bf16_t* cvb = (const bf16_t*)(p.ws + OFF_CMPVB) + (size_t)(b * 2 + g) * 512 * 64;
    NSA_RESET()
    nsa_kv_loop(ckb, cvb, 64, 0, nkb - 1, smem, sof, [&](int kb, const unsigned char* Kl, const unsigned char* Vl) __attribute__((always_inline)) {
        attn_step2(Kl, Vl, lane, lof,
                   qA0, qA1, oA, mA, lA, 0.f, kb * 64 + 64 <= nvminA, [&](int key) __attribute__((always_inline)) { return kb * 64 + key < nvA; },
                   qB0, qB1, oB, mB, lB, 0.f, kb * 64 + 64 <= nvminB, [&](int key) __attribute__((always_inline)) { return kb * 64 + key < nvB; });
    });
    NSA_LSUM()
    const float mcA = mA, mcB = mB;
    const float invcA = 1.f / fmaxf(lA[0], 1e-30f), invcB = 1.f / fmaxf(lB[0], 1e-30f);
    {
        const float fA = gpA[0] * invcA, fB = gpB[0] * invcB;
#pragma unroll
        for (int dt = 0; dt < 4; ++dt) {
            otA[dt][0] = fA * oA[dt][0]; otA[dt][1] = fA * oA[dt][1]; otA[dt][2] = fA * oA[dt][2]; otA[dt][3] = fA * oA[dt][3];
            otB[dt][0] = fB * oB[dt][0]; otB[dt][1] = fB * oB[dt][1]; otB[dt][2] = fB * oB[dt][2]; otB[dt][3] = fB * oB[dt][3];
        }
    }
    if (cur >= 16) {
        nsa_kv_loop(ckb, cvb, 64, 0, nkb - 1, smem, sof, [&](int kb, const unsigned char* Kl, const unsigned char* Vl) __attribute__((always_inline)) {
#pragma unroll
            for (int mt = 0; mt < 2; ++mt) {
                f32x4 s[4];
                nsa_scores(Kl, lof, mt ? qB0 : qA0, mt ? qB1 : qA1, 0.f, s);
                const int nv = mt ? nvB : nvA;
                const float mc = mt ? mcB : mcA, inv = mt ? invcB : invcA;
                float* impT = impL + (mt ? toklB : toklA) * 128;
#pragma unroll
                for (int kt = 0; kt < 4; ++kt) {
                    float pr[4];
#pragma unroll
                    for (int r = 0; r < 4; ++r) {
                        const int n = kb * 64 + kt * 16 + 4 * lg + r;
                        pr[r] = (n < nv) ? __builtin_amdgcn_exp2f(s[kt][r] - mc) * inv : 0.f;
                    }
                    float c1 = pr[0] + pr[1] + pr[2] + 0.5f * pr[3], c2 = 0.5f * pr[3];
                    c1 += __shfl_xor(c1, 1); c1 += __shfl_xor(c1, 2);
                    c2 += __shfl_xor(c2, 1); c2 += __shfl_xor(c2, 2);
                    const int j = kb * 16 + kt * 4 + lg;
                    if (head == 0) {
                        atomicAdd(&impT[j], c1);
                        if (j + 1 < 128) atomicAdd(&impT[j + 1], c2);
                    }
                }
                    }
        });
#pragma unroll 1
        for (int pass = 0; pass < 2; ++pass) {
            const int tok = 8 * w + 4 * pass + lg, c = lane & 15;
            const float4 i0 = *(const float4*)(impL + tok * 128 + 8 * c), i1 = *(const float4*)(impL + tok * 128 + 8 * c + 4);
            const float iv[8] = {i0.x, i0.y, i0.z, i0.w, i1.x, i1.y, i1.z, i1.w};
            float kl[8];
#pragma unroll
            for (int q = 0; q < 8; ++q) {
                const int j = 8 * c + q;
                const bool forced = (j == 0) || (j == cur) || (j == cur - 1);
                const float sc = forced ? 1.0e4f : ((j <= cur) ? iv[q] : -1.f);
                kl[q] = enc_key(sc, (unsigned)j, 127);
            }
            float l0 = kl[0], l1 = kl[1], l2 = kl[2], l3 = kl[3], l4 = kl[4], l5 = kl[5], l6 = kl[6], l7 = kl[7];
            CE_DESC(l0, l1) CE_DESC(l2, l3) CE_DESC(l4, l5) CE_DESC(l6, l7)
            CE_DESC(l0, l2) CE_DESC(l1, l3) CE_DESC(l4, l6) CE_DESC(l5, l7)
            CE_DESC(l1, l2) CE_DESC(l5, l6)
            CE_DESC(l0, l4) CE_DESC(l1, l5) CE_DESC(l2, l6) CE_DESC(l3, l7)
            CE_DESC(l2, l4) CE_DESC(l3, l5)
            CE_DESC(l1, l2) CE_DESC(l3, l4) CE_DESC(l5, l6)
            unsigned pm = 0u;
#pragma unroll
            for (int k = 0; k < 16; ++k) {
                const float mx = row16_max(l0);
                const bool win = (l0 == mx);
                pm |= win ? (1u << (dec_idx(l0, 127) & 7u)) : 0u;
                l0 = win ? l1 : l0; l1 = win ? l2 : l1; l2 = win ? l3 : l2; l3 = win ? l4 : l3;
                l4 = win ? l5 : l4; l5 = win ? l6 : l5; l6 = win ? l7 : l6; l7 = win ? NEGKEY : l7;
            }
            ((unsigned char*)selL)[tok * 16 + c] = (unsigned char)pm;
        }
    } else {
        if (lane < 8) {
            const int tok = 8 * w + lane;
            selL[tok * 4 + 0] = (2u << cur) - 1u; selL[tok * 4 + 1] = 0u; selL[tok * 4 + 2] = 0u; selL[tok * 4 + 3] = 0u;
        }
    }
    WAVE_LDS_SYNC();
#if NSA_DIAG
    if (head == 0 && lg == 0) {
        unsigned* SELM = (unsigned*)(p.ws + OFF_SELM);
#pragma unroll
        for (int qd = 0; qd < 4; ++qd) {
            SELM[((size_t)bg * SEQ + tqA) * 4 + qd] = selL[toklA * 4 + qd];
            SELM[((size_t)bg * SEQ + tqB) * 4 + qd] = selL[toklB * 4 + qd];
        }
    }
#endif
    NSA_RESET()
    {
        const bf16_t* kg = (const bf16_t*)(p.ws + OFF_KV + 2 * KV_STRIDE) + (size_t)b * SEQ * 128 + g * 64;
        const bf16_t* vg = (const bf16_t*)(p.ws + OFF_KV + 3 * KV_STRIDE) + (size_t)b * SEQ * 128 + g * 64;
        nsa_kv_loop(kg, vg, 128, 0, cur, smem, sof, [&](int kb, const unsigned char* Kl, const unsigned char* Vl) __attribute__((always_inline)) {
            const bool svA = (selL[toklA * 4 + (kb >> 5)] >> (kb & 31)) & 1u;
            const bool svB = (selL[toklB * 4 + (kb >> 5)] >> (kb & 31)) & 1u;
            const bool nA = __ballot(svA) != 0ull, nB = __ballot(svB) != 0ull;
            if (nA && nB)
                attn_step2(Kl, Vl, lane, lof,
                           qA0, qA1, oA, mA, lA, svA ? 0.f : NEGM, kb < cur, [&](int key) __attribute__((always_inline)) { return kb * 64 + key <= tqA; },
                           qB0, qB1, oB, mB, lB, svB ? 0.f : NEGM, kb < cur, [&](int key) __attribute__((always_inline)) { return kb * 64 + key <= tqB; });
            else if (nA)
                attn_step(Kl, Vl, lane, lof, qA0, qA1, oA, mA, lA, svA ? 0.f : NEGM, kb < cur, [&](int key) __attribute__((always_inline)) { return kb * 64 + key <= tqA; });
            else if (nB)
                attn_step(Kl, Vl, lane, lof, qB0, qB1, oB, mB, lB, svB ? 0.f : NEGM, kb < cur, [&](int key) __attribute__((always_inline)) { return kb * 64 + key <= tqB; });
        });
    }
    NSA_LSUM()
    {
        const float fA = gpA[1] / fmaxf(lA[0], 1e-30f), fB = gpB[1] / fmaxf(lB[0], 1e-30f);
#pragma unroll
        for (int dt = 0; dt < 4; ++dt) {
            otA[dt][0] += fA * oA[dt][0]; otA[dt][1] += fA * oA[dt][1]; otA[dt][2] += fA * oA[dt][2]; otA[dt][3] += fA * oA[dt][3];
            otB[dt][0] += fB * oB[dt][0]; otB[dt][1] += fB * oB[dt][1]; otB[dt][2] += fB * oB[dt][2]; otB[dt][3] += fB * oB[dt][3];
        }
    }
    NSA_RESET()
    {
        const bf16_t* kg = (const bf16_t*)(p.ws + OFF_KV + 4 * KV_STRIDE) + (size_t)b * SEQ * 128 + g * 64;
        const bf16_t* vg = (const bf16_t*)(p.ws + OFF_KV + 5 * KV_STRIDE) + (size_t)b * SEQ * 128 + g * 64;
        const int klo = (t0 > 511) ? ((t0 - 511) >> 6) : 0;
        nsa_kv_loop(kg, vg, 128, klo, cur, smem, sof, [&](int kb, const unsigned char* Kl, const unsigned char* Vl) __attribute__((always_inline)) {
            attn_step2(Kl, Vl, lane, lof,
                       qA0, qA1, oA, mA, lA, 0.f, (kb * 64 >= tminA + 3 - 511) && (kb * 64 + 63 <= tminA),
                       [&](int key) __attribute__((always_inline)) { const int ka = kb * 64 + key; return (ka <= tqA) && (ka >= tqA - 511); },
                       qB0, qB1, oB, mB, lB, 0.f, (kb * 64 >= tminB + 3 - 511) && (kb * 64 + 63 <= tminB),
                       [&](int key) __attribute__((always_inline)) { const int ka = kb * 64 + key; return (ka <= tqB) && (ka >= tqB - 511); });
        });
    }
    NSA_LSUM()
    {
        const float fA = gpA[2] / fmaxf(lA[0], 1e-30f), fB = gpB[2] / fmaxf(lB[0], 1e-30f);
        bf16_t* MIX = (bf16_t*)(p.ws + OFF_XB) + (tokb + toklA) * DM + 512 + g * 256 + head * 64 + lg * 4;
#pragma unroll
        for (int dt = 0; dt < 4; ++dt) {
            uint2 ov;
            ov.x = pack2bf(otA[dt][0] + fA * oA[dt][0], otA[dt][1] + fA * oA[dt][1]);
            ov.y = pack2bf(otA[dt][2] + fA * oA[dt][2], otA[dt][3] + fA * oA[dt][3]);
            *(uint2*)(MIX + dt * 16) = ov;
            ov.x = pack2bf(otB[dt][0] + fB * oB[dt][0], otB[dt][1] + fB * oB[dt][1]);
            ov.y = pack2bf(otB[dt][2] + fB * oB[dt][2], otB[dt][3] + fB * oB[dt][3]);
            *(uint2*)(MIX + 4 * DM + dt * 16) = ov;
        }
    }
#undef NSA_RESET
#undef NSA_LSUM
}

__device__ __forceinline__ float block_sum(float v, float* red) {
    v = wave_sum(v);
    __syncthreads();
    if ((threadIdx.x & 63) == 0) red[threadIdx.x >> 6] = v;
    __syncthreads();
    return red[0] + red[1] + red[2] + red[3];
}
__device__ __forceinline__ float4 ln_row(float4 y, const float* g, const float* bb, float* red) {
    const int tid = opaque_tid();
    const float mu = block_sum(y.x + y.y + y.z + y.w, red) * (1.f / 1024.f);
    const float dx = y.x - mu, dy = y.y - mu, dz = y.z - mu, dw = y.w - mu;
    const float var = block_sum(dx * dx + dy * dy + dz * dz + dw * dw, red) * (1.f / 1024.f);
    const float rs = rsqrtf(var + LN_EPS);
    const float4 gg = ((const float4*)g)[tid], b4 = ((const float4*)bb)[tid];
    return make_float4(dx * rs * gg.x + b4.x, dy * rs * gg.y + b4.y, dz * rs * gg.z + b4.z, dw * rs * gg.w + b4.w);
}

__device__ __forceinline__ void ln1_phase(const Params& p, float* sm) {
    const int tid = opaque_tid(), lane = tid & 63, w = __builtin_amdgcn_readfirstlane(tid >> 6);
    const float4* g4 = (const float4*)(p.in[15] + 16 * lane);
    const float4* b4 = (const float4*)(p.in[16] + 16 * lane);
    const float4 ga = g4[0], gb = g4[1], gc = g4[2], gd = g4[3];
    const float4 ba = b4[0], bb = b4[1], bc = b4[2], bd = b4[3];
#pragma unroll 2
    for (int n = blockIdx.x * 4 + w; n < NTOK; n += gridDim.x * 4) {
        const float4* yr = (const float4*)(p.out + (size_t)n * DM + 16 * lane);
        const float4 y0 = yr[0], y1 = yr[1], y2 = yr[2], y3 = yr[3];
        float y[16] = {y0.x, y0.y, y0.z, y0.w, y1.x, y1.y, y1.z, y1.w, y2.x, y2.y, y2.z, y2.w, y3.x, y3.y, y3.z, y3.w};
        const float g[16] = {ga.x, ga.y, ga.z, ga.w, gb.x, gb.y, gb.z, gb.w, gc.x, gc.y, gc.z, gc.w, gd.x, gd.y, gd.z, gd.w};
        const float bv[16] = {ba.x, ba.y, ba.z, ba.w, bb.x, bb.y, bb.z, bb.w, bc.x, bc.y, bc.z, bc.w, bd.x, bd.y, bd.z, bd.w};
        float sum = 0.f;
#pragma unroll
        for (int q = 0; q < 16; ++q) sum += y[q];
        const float mu = wave_sum(sum) * (1.f / 1024.f);
        float sq = 0.f;
#pragma unroll
        for (int q = 0; q < 16; ++q) { y[q] -= mu; sq += y[q] * y[q]; }
        const float rs = rsqrtf(wave_sum(sq) * (1.f / 1024.f) + LN_EPS);
        uint4 o0, o1;
        o0.x = pack2bf(y[0] * rs * g[0] + bv[0], y[1] * rs * g[1] + bv[1]);     o0.y = pack2bf(y[2] * rs * g[2] + bv[2], y[3] * rs * g[3] + bv[3]);
        o0.z = pack2bf(y[4] * rs * g[4] + bv[4], y[5] * rs * g[5] + bv[5]);     o0.w = pack2bf(y[6] * rs * g[6] + bv[6], y[7] * rs * g[7] + bv[7]);
        o1.x = pack2bf(y[8] * rs * g[8] + bv[8], y[9] * rs * g[9] + bv[9]);     o1.y = pack2bf(y[10] * rs * g[10] + bv[10], y[11] * rs * g[11] + bv[11]);
        o1.z = pack2bf(y[12] * rs * g[12] + bv[12], y[13] * rs * g[13] + bv[13]); o1.w = pack2bf(y[14] * rs * g[14] + bv[14], y[15] * rs * g[15] + bv[15]);
        uint4* hb = (uint4*)((bf16_t*)(p.ws + OFF_XB) + (size_t)n * DM + 16 * lane);
        hb[0] = o0; hb[1] = o1;
    }
}


typedef float f32x2 __attribute__((ext_vector_type(2)));
__device__ __forceinline__ void cvt_rows_fp8(const float* __restrict__ src, unsigned char* __restrict__ dst, float* __restrict__ scales, int rows,
                                             int first_block, int nblocks) {
    const int tid_ = opaque_tid(), lane = tid_ & 63, w = __builtin_amdgcn_readfirstlane(tid_ >> 6);
    for (int r = ((int)blockIdx.x - first_block) * 4 + w; r < rows; r += nblocks * 4) {
        const float4* sp = (const float4*)(src + (size_t)r * 1024 + lane * 16);
        const float4 a = sp[0], b = sp[1], c = sp[2], d = sp[3];
        float mx = fmaxf(fmaxf(fmaxf(fabsf(a.x), fabsf(a.y)), fmaxf(fabsf(a.z), fabsf(a.w))), fmaxf(fmaxf(fabsf(b.x), fabsf(b.y)), fmaxf(fabsf(b.z), fabsf(b.w))));
        mx = fmaxf(mx, fmaxf(fmaxf(fmaxf(fabsf(c.x), fabsf(c.y)), fmaxf(fabsf(c.z), fabsf(c.w))), fmaxf(fmaxf(fabsf(d.x), fabsf(d.y)), fmaxf(fabsf(d.z), fabsf(d.w)))));
        mx = wave_max(mx);
        const float sc = (mx > 0.f) ? mx * (1.f / 448.f) : 1.f;
        const float inv = 1.f / sc;
        uint4 o;
        int t;
        t = 0; t = __builtin_amdgcn_cvt_pk_fp8_f32(a.x * inv, a.y * inv, t, false); t = __builtin_amdgcn_cvt_pk_fp8_f32(a.z * inv, a.w * inv, t, true); o.x = (unsigned)t;
        t = 0; t = __builtin_amdgcn_cvt_pk_fp8_f32(b.x * inv, b.y * inv, t, false); t = __builtin_amdgcn_cvt_pk_fp8_f32(b.z * inv, b.w * inv, t, true); o.y = (unsigned)t;
        t = 0; t = __builtin_amdgcn_cvt_pk_fp8_f32(c.x * inv, c.y * inv, t, false); t = __builtin_amdgcn_cvt_pk_fp8_f32(c.z * inv, c.w * inv, t, true); o.z = (unsigned)t;
        t = 0; t = __builtin_amdgcn_cvt_pk_fp8_f32(d.x * inv, d.y * inv, t, false); t = __builtin_amdgcn_cvt_pk_fp8_f32(d.z * inv, d.w * inv, t, true); o.w = (unsigned)t;
        *(uint4*)(dst + (size_t)r * 1024 + lane * 16) = o;
        if (lane == 0) scales[r] = sc;
    }
}

__device__ __forceinline__ unsigned pack4i8(float a, float b, float c, float d) {
    const int ia = (int)rintf(a), ib = (int)rintf(b), ic = (int)rintf(c), id = (int)rintf(d);
    return (unsigned)(ia & 255) | ((unsigned)(ib & 255) << 8) | ((unsigned)(ic & 255) << 16) | ((unsigned)id << 24);
}
__device__ __forceinline__ void cvt_rows_i8(const float* __restrict__ src, unsigned char* __restrict__ dst, float* __restrict__ scales, int rows,
                                            int first_block, int nblocks) {
    const int tid_ = opaque_tid(), lane = tid_ & 63, w = __builtin_amdgcn_readfirstlane(tid_ >> 6);
    for (int r = ((int)blockIdx.x - first_block) * 4 + w; r < rows; r += nblocks * 4) {
        const float4* sp = (const float4*)(src + (size_t)r * 1024 + lane * 16);
        const float4 a = sp[0], b = sp[1], c = sp[2], d = sp[3];
        float mx = fmaxf(fmaxf(fmaxf(fabsf(a.x), fabsf(a.y)), fmaxf(fabsf(a.z), fabsf(a.w))), fmaxf(fmaxf(fabsf(b.x), fabsf(b.y)), fmaxf(fabsf(b.z), fabsf(b.w))));
        mx = fmaxf(mx, fmaxf(fmaxf(fmaxf(fabsf(c.x), fabsf(c.y)), fmaxf(fabsf(c.z), fabsf(c.w))), fmaxf(fmaxf(fabsf(d.x), fabsf(d.y)), fmaxf(fabsf(d.z), fabsf(d.w)))));
        mx = wave_max(mx);
        const float sc = (mx > 0.f) ? mx * (1.f / 127.f) : 1.f;
        const float inv = 1.f / sc;
        uint4 o;
        o.x = pack4i8(a.x * inv, a.y * inv, a.z * inv, a.w * inv); o.y = pack4i8(b.x * inv, b.y * inv, b.z * inv, b.w * inv);
        o.z = pack4i8(c.x * inv, c.y * inv, c.z * inv, c.w * inv); o.w = pack4i8(d.x * inv, d.y * inv, d.z * inv, d.w * inv);
        *(uint4*)(dst + (size_t)r * 1024 + lane * 16) = o;
        if (lane == 0) scales[r] = sc;
    }
}

__device__ __forceinline__ void fold_ws_phase(const float* __restrict__ wq, const float* __restrict__ k1, const float* __restrict__ k2,
                                              bf16_t* __restrict__ WsT) {
    for (int it = blockIdx.x * 256 + threadIdx.x; it < 2048 * 128; it += gridDim.x * 256) {
        const int r = it & 2047, kg = it >> 11;
        const int a = (r >> 7) & 1, j = r & 127;
        const float* kr = (a ? k2 : k1) + j * 128;
        const float* wr = wq + (size_t)(kg * 8) * 2048 + (r & ~127);
        float s[8];
#pragma unroll
        for (int q = 0; q < 8; ++q) s[q] = 0.f;
        for (int d = 0; d < 128; d += 4) {
            const float4 kv = *(const float4*)(kr + d);
#pragma unroll
            for (int q = 0; q < 8; ++q) {
                const float4 wv = *(const float4*)(wr + (size_t)q * 2048 + d);
                s[q] += wv.x * kv.x + wv.y * kv.y + wv.z * kv.z + wv.w * kv.w;
            }
        }
        uint4 o;
        o.x = pack2bf(s[0], s[1]); o.y = pack2bf(s[2], s[3]); o.z = pack2bf(s[4], s[5]); o.w = pack2bf(s[6], s[7]);
        *(uint4*)(WsT + (size_t)r * 1024 + kg * 8) = o;
    }
}


struct EpiTop16 {
    static constexpr bool kRow = false;
    float* topk; unsigned char* lds;
    __device__ __forceinline__ void operator()(int m, int n, f32x4 v) const {
        const int ml = m & 127, g4 = (n & 127) >> 2;
        *(float4*)(lds + ((ml * 32 + (g4 ^ (ml & 7))) << 4)) = make_float4(v[0], v[1], v[2], v[3]);
    }
    template <class F> __device__ __forceinline__ void dispatch(int, F f) const { f(*this); }
    __device__ __forceinline__ void finish(int m0, int n0) const {
        __syncthreads();
        const int tid_ = opaque_tid(), lane = tid_ & 63, w = __builtin_amdgcn_readfirstlane(tid_ >> 6), c = lane & 15;
        const int L = n0 >> 7;
        for (int it = 0; it < 8; ++it) {
            const int r = w * 32 + it * 4 + (lane >> 4);
            const float4 x0 = *(const float4*)(lds + ((r * 32 + ((2 * c) ^ (r & 7))) << 4));
            const float4 x1 = *(const float4*)(lds + ((r * 32 + ((2 * c + 1) ^ (r & 7))) << 4));
            float l0 = enc_key(x0.x, 8 * c + 0, 127), l1 = enc_key(x0.y, 8 * c + 1, 127), l2 = enc_key(x0.z, 8 * c + 2, 127),
                  l3 = enc_key(x0.w, 8 * c + 3, 127), l4 = enc_key(x1.x, 8 * c + 4, 127), l5 = enc_key(x1.y, 8 * c + 5, 127),
                  l6 = enc_key(x1.z, 8 * c + 6, 127), l7 = enc_key(x1.w, 8 * c + 7, 127);
            CE_DESC(l0, l1) CE_DESC(l2, l3) CE_DESC(l4, l5) CE_DESC(l6, l7)
            CE_DESC(l0, l2) CE_DESC(l1, l3) CE_DESC(l4, l6) CE_DESC(l5, l7)
            CE_DESC(l1, l2) CE_DESC(l5, l6)
            CE_DESC(l0, l4) CE_DESC(l1, l5) CE_DESC(l2, l6) CE_DESC(l3, l7)
            CE_DESC(l2, l4) CE_DESC(l3, l5)
            CE_DESC(l1, l2) CE_DESC(l3, l4) CE_DESC(l5, l6)
            float res = NEGKEY;
#pragma unroll
            for (int k = 0; k < 16; ++k) {
                const float mx = row16_max(l0);
                const bool win = (l0 == mx);
                l0 = win ? l1 : l0; l1 = win ? l2 : l1; l2 = win ? l3 : l2; l3 = win ? l4 : l3;
                l4 = win ? l5 : l4; l5 = win ? l6 : l5; l6 = win ? l7 : l6; l7 = win ? NEGKEY : l7;
                res = (c == k) ? mx : res;
            }
            topk[(size_t)(m0 + r) * 256 + L * 16 + c] = res;
        }
        __syncthreads();
    }
};

template <int PART>
__device__ __forceinline__ void peer_fast_phase(const Params& p, unsigned char* smem) {
    const int tid = opaque_tid(), lane = tid & 63, w = __builtin_amdgcn_readfirstlane(tid >> 6), l16 = lane & 15, gq = lane >> 4;
    float* tk = (float*)(smem + w * 2048);
    int* ex = (int*)(smem + w * 2048 + 1024);
    float* gw = (float*)(smem + w * 2048 + 1536);
    const bf16_t* H1B = (const bf16_t*)(p.ws + OFF_XB);
    const unsigned char* U8 = p.ws + OFF_UB;
    const unsigned char* V8 = p.ws + OFF_VB;
    const float* USC = (const float*)(p.ws + OFF_USC);
    const float* VSC = (const float*)(p.ws + OFF_VSC);
    const float* TOPK = (const float*)(p.ws + OFF_TOPK);
    int ci[4], cj[4];
#pragma unroll
    for (int q = 0; q < 4; ++q) {
        const int s = l16 + 16 * q;
        int i, j;
        if (s < 16) { i = 0; j = s; }
        else if (s < 24) { i = 1; j = s - 16; }
        else if (s < 29) { i = 2; j = s - 24; }
        else if (s < 33) { i = 3; j = s - 29; }
        else if (s < 36) { i = 4; j = s - 33; }
        else if (s < 42) { i = 5 + ((s - 36) >> 1); j = (s - 36) & 1; }
        else if (s < 50) { i = 8 + (s - 42); j = 0; }
        else { i = -1; j = 0; }
        ci[q] = i; cj[q] = j;
    }
    int* exs = (int*)(smem + 8192 + w * 4096);
    float* gws = (float*)(smem + 8192 + w * 4096 + 2048);
    float* hraw = (float*)(smem + 24576 + w * 2048);
    float* xsc = (float*)(smem + w * 2048);
    int* SEX = (int*)(p.ws + OFF_HQ);
    float* SGW = (float*)(p.ws + OFF_HLF);
    for (int qd = blockIdx.x * 4 + w; qd < NTOK / 4; qd += gridDim.x * 4) {
        const int n0 = qd * 4;
        if (PART == 0) {
#pragma unroll 1
        for (int t = 0; t < 4; ++t) {
            const int n = n0 + t;
            WAVE_LDS_SYNC();
            ((float4*)tk)[lane] = ((const float4*)(TOPK + (size_t)n * 256))[lane];
            WAVE_LDS_SYNC();
#pragma unroll
            for (int it = 0; it < 2; ++it) {
                const int head = it * 4 + gq;
                const float* ka = tk + head * 32;
                const float* kb = ka + 16;
                float c0, c1, c2, c3;
#define MKC(q, cq) { if (ci[q] >= 0) { const float sum_ = dec_val(ka[ci[q]], 127) + dec_val(kb[cj[q]], 127); \
                         cq = enc_key(sum_, ci[q] * 16 + cj[q], 255); } else cq = NEGKEY; }
                MKC(0, c0) MKC(1, c1) MKC(2, c2) MKC(3, c3)
#undef MKC
                float res = NEGKEY;
#pragma unroll
                for (int k = 0; k < 16; ++k) {
                    const float mx = row16_max(fmaxf(fmaxf(c0, c1), fmaxf(c2, c3)));
                    c0 = (c0 == mx) ? NEGKEY : c0; c1 = (c1 == mx) ? NEGKEY : c1;
                    c2 = (c2 == mx) ? NEGKEY : c2; c3 = (c3 == mx) ? NEGKEY : c3;
                    res = (l16 == k) ? mx : res;
                }
                const unsigned cc = dec_idx(res, 255);
                const float val = dec_val(res, 255);
                const unsigned e1 = dec_idx(ka[cc >> 4], 127), e2 = dec_idx(kb[cc & 15], 127);
                const float m0 = row16_max(val);
                const float e = expf(val - m0);
                const float ssum = row16_sum(e);
                ex[head * 16 + l16] = (int)(e1 * 128 + e2);
                gw[head * 16 + l16] = e / ssum;
            }
            WAVE_LDS_SYNC();
            {
                const int e0 = ex[lane], e1v = ex[lane + 64];
                const float g0 = gw[lane], g1 = gw[lane + 64];
                const int s0 = e0 >> 11, s1 = e1v >> 11;
                const unsigned long long lt = (1ull << lane) - 1ull;
                int base = 0, p0 = 0, p1 = 0;
#pragma unroll
                for (int s = 0; s < 8; ++s) {
                    const unsigned long long m0 = __ballot(s0 == s), m1 = __ballot(s1 == s);
                    const int c0 = __popcll(m0), c1 = __popcll(m1);
                    if (s0 == s) p0 = base + __popcll(m0 & lt);
                    if (s1 == s) p1 = base + c0 + __popcll(m1 & lt);
                    base += c0 + c1;
                }
                exs[t * 128 + p0] = e0; gws[t * 128 + p0] = g0; exs[t * 128 + p1] = e1v; gws[t * 128 + p1] = g1;
            }
        }
        WAVE_LDS_SYNC();
#pragma unroll
        for (int i = 0; i < 2; ++i) {
            ((uint4*)(SEX + (size_t)n0 * 128))[lane + 64 * i] = ((const uint4*)exs)[lane + 64 * i];
            ((uint4*)(SGW + (size_t)n0 * 128))[lane + 64 * i] = ((const uint4*)gws)[lane + 64 * i];
        }
        } else {
        WAVE_LDS_SYNC();
#pragma unroll
        for (int i = 0; i < 2; ++i) {
            ((uint4*)exs)[lane + 64 * i] = ((const uint4*)(SEX + (size_t)n0 * 128))[lane + 64 * i];
            ((uint4*)gws)[lane + 64 * i] = ((const uint4*)(SGW + (size_t)n0 * 128))[lane + 64 * i];
        }
        }
        if (PART == 1) {
        WAVE_LDS_SYNC();
        {
            int xq[16];
            {
                const uint4* xr = (const uint4*)(H1B + (size_t)(n0 + gq) * DM + 16 * l16);
                uint4 xa0 = xr[0], xb0 = xr[1], xa1 = xr[32], xb1 = xr[33], xa2 = xr[64], xb2 = xr[65], xa3 = xr[96], xb3 = xr[97];
#define BLO(u_) __uint_as_float((u_) << 16)
#define BHI(u_) __uint_as_float((u_) & 0xffff0000u)
#define AMX4(v_) fmaxf(fmaxf(fmaxf(fabsf(BLO((v_).x)), fabsf(BHI((v_).x))), fmaxf(fabsf(BLO((v_).y)), fabsf(BHI((v_).y)))),                  \
                       fmaxf(fmaxf(fabsf(BLO((v_).z)), fabsf(BHI((v_).z))), fmaxf(fabsf(BLO((v_).w)), fabsf(BHI((v_).w)))))
                float mx = fmaxf(fmaxf(fmaxf(AMX4(xa0), AMX4(xb0)), fmaxf(AMX4(xa1), AMX4(xb1))), fmaxf(fmaxf(AMX4(xa2), AMX4(xb2)), fmaxf(AMX4(xa3), AMX4(xb3))));
                mx = row16_max(mx);
                const float xs = (mx > 0.f) ? mx * (1.f / 127.f) : 1.f;
                const float inv = 1.f / xs;
                xsc[gq] = xs;
#define Q8(i_, va_, vb_) { xq[4 * (i_) + 0] = (int)pack4i8(BLO((va_).x) * inv, BHI((va_).x) * inv, BLO((va_).y) * inv, BHI((va_).y) * inv);   \
                           xq[4 * (i_) + 1] = (int)pack4i8(BLO((va_).z) * inv, BHI((va_).z) * inv, BLO((va_).w) * inv, BHI((va_).w) * inv);   \
                           xq[4 * (i_) + 2] = (int)pack4i8(BLO((vb_).x) * inv, BHI((vb_).x) * inv, BLO((vb_).y) * inv, BHI((vb_).y) * inv);   \
                           xq[4 * (i_) + 3] = (int)pack4i8(BLO((vb_).z) * inv, BHI((vb_).z) * inv, BLO((vb_).w) * inv, BHI((vb_).w) * inv); }
                Q8(0, xa0, xb0) Q8(1, xa1, xb1) Q8(2, xa2, xb2) Q8(3, xa3, xb3)
#undef Q8
#undef AMX4
#undef BLO
#undef BHI
            }
            uint4 ra0, ra1, ra2, ra3, rb0, rb1, rb2, rb3, rc0, rc1, rc2, rc3, rd0, rd1, rd2, rd3;
#define ULOAD(S, kk) { const int e_ = exs[gq * 128 + (kk)]; const uint4* ur_ = (const uint4*)(U8 + (size_t)e_ * DM + 16 * l16);          \
                       S##0 = ur_[0]; S##1 = ur_[16]; S##2 = ur_[32]; S##3 = ur_[48]; }
#define D4(W_, B_) { sA = __builtin_amdgcn_sdot4((int)(W_).x, xq[(B_)], sA, false); sB = __builtin_amdgcn_sdot4((int)(W_).y, xq[(B_) + 1], sB, false); \
                     sA = __builtin_amdgcn_sdot4((int)(W_).z, xq[(B_) + 2], sA, false); sB = __builtin_amdgcn_sdot4((int)(W_).w, xq[(B_) + 3], sB, false); }
#define UCOMP(S, kk) { int sA = 0, sB = 0; D4(S##0, 0) D4(S##1, 4) D4(S##2, 8) D4(S##3, 12)                                               \
                       hraw[gq * 128 + (kk)] = row16_sum((float)(sA + sB)); }
            ULOAD(ra, 0) ULOAD(rb, 1) ULOAD(rc, 2)
#pragma unroll 1
            for (int k = 0; k < 128; k += 4) {
                const int kn = (k + 4 < 128) ? k + 4 : 124;
                ULOAD(rd, k + 3)  UCOMP(ra, k)
                ULOAD(ra, kn)     UCOMP(rb, k + 1)
                ULOAD(rb, kn + 1) UCOMP(rc, k + 2)
                ULOAD(rc, kn + 2) UCOMP(rd, k + 3)
            }
#undef D4
#undef ULOAD
#undef UCOMP
        }
        WAVE_LDS_SYNC();
#pragma unroll
        for (int j = 0; j < 8; ++j) {
            const int idx = lane + 64 * j;
            const int e = exs[idx];
            gws[idx] = gws[idx] * gelu_tanh_fast(hraw[idx] * (xsc[idx >> 7] * USC[e])) * VSC[e];
        }
        WAVE_LDS_SYNC();
#pragma unroll
        for (int i = 0; i < 2; ++i) ((uint4*)(SGW + (size_t)n0 * 128))[lane + 64 * i] = ((const uint4*)gws)[lane + 64 * i];
        }
        if (PART == 2) {
        WAVE_LDS_SYNC();
        {
            f32x2 acc[32];
#pragma unroll
            for (int q = 0; q < 32; ++q) acc[q] = (f32x2){0.f, 0.f};
            uint4 ra0, ra1, ra2, ra3, rb0, rb1, rb2, rb3, rc0, rc1, rc2, rc3, rd0, rd1, rd2, rd3;
#define VLOAD(S, kk) { const int e_ = exs[gq * 128 + (kk)]; const uint4* vr_ = (const uint4*)(V8 + (size_t)e_ * DM + 16 * l16);          \
                       S##0 = vr_[0]; S##1 = vr_[16]; S##2 = vr_[32]; S##3 = vr_[48]; }
#define A4(W_, B_) { acc[(B_)] = __builtin_elementwise_fma(__builtin_amdgcn_cvt_pk_f32_fp8((int)(W_), false), wk2, acc[(B_)]);          \
                     acc[(B_) + 1] = __builtin_elementwise_fma(__builtin_amdgcn_cvt_pk_f32_fp8((int)(W_), true), wk2, acc[(B_) + 1]); }
#define VCOMP(S, kk) { const float wk = gws[gq * 128 + (kk)]; const f32x2 wk2 = (f32x2){wk, wk};                                         \
                       A4((S##0).x, 0) A4((S##0).y, 2) A4((S##0).z, 4) A4((S##0).w, 6) A4((S##1).x, 8) A4((S##1).y, 10) A4((S##1).z, 12) A4((S##1).w, 14) \
                       A4((S##2).x, 16) A4((S##2).y, 18) A4((S##2).z, 20) A4((S##2).w, 22) A4((S##3).x, 24) A4((S##3).y, 26) A4((S##3).z, 28) A4((S##3).w, 30) }
            VLOAD(ra, 0) VLOAD(rb, 1) VLOAD(rc, 2)
#pragma unroll 1
            for (int k = 0; k < 128; k += 4) {
                const int kn = (k + 4 < 128) ? k + 4 : 124;
                VLOAD(rd, k + 3)  VCOMP(ra, k)
                VLOAD(ra, kn)     VCOMP(rb, k + 1)
                VLOAD(rb, kn + 1) VCOMP(rc, k + 2)
                VLOAD(rc, kn + 2) VCOMP(rd, k + 3)
            }
#undef VLOAD
#undef VCOMP
#undef A4
            float* orow = p.out + (size_t)(n0 + gq) * DM + 16 * l16;
            float sum = 0.f;
#pragma unroll
            for (int c = 0; c < 4; ++c)
#pragma unroll
                for (int hq = 0; hq < 4; ++hq) {
                    const uint2 hb_ = *(const uint2*)(H1B + (size_t)(n0 + gq) * DM + 16 * l16 + 256 * c + 4 * hq);
                    const float4 h = make_float4(__uint_as_float(hb_.x << 16), __uint_as_float(hb_.x & 0xffff0000u),
                                                 __uint_as_float(hb_.y << 16), __uint_as_float(hb_.y & 0xffff0000u));
                    f32x2& pa = acc[8 * c + 2 * hq]; f32x2& pb = acc[8 * c + 2 * hq + 1];
                    pa[0] = ALPHA * h.x + pa[0]; pa[1] = ALPHA * h.y + pa[1]; pb[0] = ALPHA * h.z + pb[0]; pb[1] = ALPHA * h.w + pb[1];
                    sum += (pa[0] + pa[1]) + (pb[0] + pb[1]);
                }
            const float mu = row16_sum(sum) * (1.f / 1024.f);
            float sq = 0.f;
#pragma unroll
            for (int q = 0; q < 32; ++q) { acc[q][0] -= mu; acc[q][1] -= mu; sq += acc[q][0] * acc[q][0] + acc[q][1] * acc[q][1]; }
            const float rs = rsqrtf(row16_sum(sq) * (1.f / 1024.f) + LN_EPS);
            const float* g = p.in[22] + 16 * l16;
            const float* bb = p.in[23] + 16 * l16;
#pragma unroll
            for (int c = 0; c < 4; ++c)
#pragma unroll
                for (int hq = 0; hq < 4; ++hq) {
                    const float4 gg = *(const float4*)(g + 256 * c + 4 * hq), b4 = *(const float4*)(bb + 256 * c + 4 * hq);
                    const f32x2 pa = acc[8 * c + 2 * hq], pb = acc[8 * c + 2 * hq + 1];
                    float4 o;
                    o.x = pa[0] * rs * gg.x + b4.x; o.y = pa[1] * rs * gg.y + b4.y;
                    o.z = pb[0] * rs * gg.z + b4.z; o.w = pb[1] * rs * gg.w + b4.w;
                    *(float4*)(orow + 256 * c + 4 * hq) = o;
                }
        }
        }
    }
}

#define XB_TMO      128
#define XB_XCNT(j)  (256  + 64 * (j))
#define XB_XSUB(j)  (1280 + 64 * (j))
#define XB_XGEN(j)  (2304 + 64 * (j))
#define XB_TOP      3328
#define XB_TOPGEN   3392
#define XCD_BAR_WORDS 3456
#define XB_SPIN_CAP (1u << 22)
__device__ __forceinline__ unsigned xb_ld(unsigned* p) { return __hip_atomic_load(p, __ATOMIC_RELAXED, __HIP_MEMORY_SCOPE_AGENT); }
__device__ __forceinline__ unsigned xb_add(unsigned* p, unsigned v) { return __hip_atomic_fetch_add(p, v, __ATOMIC_RELAXED, __HIP_MEMORY_SCOPE_AGENT); }
__device__ __forceinline__ unsigned xb_xcc_id() { return (unsigned)__builtin_amdgcn_s_getreg((3 << 11) | 20) & 0xFu; }
#define XB_SPIN(cond, bar) do { unsigned _sp = 0; while (cond) { __builtin_amdgcn_s_sleep(1); \
    if ((++_sp & 255u) == 0u) { if (xb_ld(&(bar)[XB_TMO])) break; if (_sp > XB_SPIN_CAP) { atomicAdd(&(bar)[XB_TMO], 1u); break; } } } } while (0)
struct XcdBarrier { unsigned* bar; unsigned x; unsigned* st; };
__device__ __forceinline__ XcdBarrier xcd_barrier_post(unsigned* bar, unsigned* st) {
    XcdBarrier b; b.bar = bar; b.x = xb_xcc_id(); b.st = st;
    if (threadIdx.x == 0) (void)xb_add(&bar[XB_XCNT(b.x)], 1u);
    return b;
}
__device__ __forceinline__ void xcd_barrier_complete(unsigned* bar, unsigned x, unsigned& nloc, unsigned& nx) {
    const unsigned G = gridDim.x * gridDim.y * gridDim.z;
    unsigned sum, cnt, mine, sp = 0u;
    for (;;) {
        sum = 0u; cnt = 0u; mine = 0u;
#pragma unroll
        for (unsigned j = 0; j < 16; ++j) { const unsigned c = xb_ld(&bar[XB_XCNT(j)]); sum += c; cnt += (c > 0u) ? 1u : 0u; mine = (j == x) ? c : mine; }
        if (sum == G) break;
        __builtin_amdgcn_s_sleep(1);
        if ((++sp & 255u) == 0u) { if (xb_ld(&bar[XB_TMO])) break; if (sp > XB_SPIN_CAP) { atomicAdd(&bar[XB_TMO], 1u); break; } }
    }
    nloc = mine > 0u ? mine : 1u; nx = cnt > 0u ? cnt : 1u;
}
__device__ __forceinline__ void xcd_barrier(const XcdBarrier& b) {
    asm volatile("s_waitcnt vmcnt(0)" ::: "memory");
    __syncthreads();
    if (threadIdx.x == 0) {
        unsigned* bar = b.bar;
        __builtin_amdgcn_s_waitcnt(0);
        unsigned nloc = xb_ld(&b.st[0]), nx = xb_ld(&b.st[1]);
        if (nloc == 0u) { xcd_barrier_complete(bar, b.x, nloc, nx); __hip_atomic_store(&b.st[0], nloc, __ATOMIC_RELAXED, __HIP_MEMORY_SCOPE_AGENT); __hip_atomic_store(&b.st[1], nx, __ATOMIC_RELAXED, __HIP_MEMORY_SCOPE_AGENT); }
        const unsigned old = xb_add(&bar[XB_XSUB(b.x)], 1u);
        const unsigned gen = old / nloc;
        if (old + 1u == (gen + 1u) * nloc) {
            __builtin_amdgcn_fence(__ATOMIC_RELEASE, "agent");
            asm volatile("s_waitcnt vmcnt(0)" ::: "memory");
            const unsigned og = xb_add(&bar[XB_TOP], 1u);
            const unsigned tg = og / nx;
            if (og + 1u == (tg + 1u) * nx) xb_add(&bar[XB_TOPGEN], 1u);
            else XB_SPIN(xb_ld(&bar[XB_TOPGEN]) == tg, bar);
            __builtin_amdgcn_fence(__ATOMIC_ACQUIRE, "agent");
            xb_add(&bar[XB_XGEN(b.x)], 1u);
            asm volatile("s_waitcnt vmcnt(0)" ::: "memory");
        } else {
            XB_SPIN(xb_ld(&bar[XB_XGEN(b.x)]) == gen, bar);
            __builtin_amdgcn_fence(__ATOMIC_ACQUIRE, "agent");
            asm volatile("s_waitcnt vmcnt(0)" ::: "memory");
        }
    }
    __syncthreads();
}

__global__ void __launch_bounds__(256, 2) mega(Params p) {
    cg::grid_group grid = cg::this_grid();
    __shared__ __attribute__((aligned(16))) unsigned char smem[81920];
    float* sm = (float*)smem;
    unsigned* barw = (unsigned*)(p.ws + OFF_BAR);
    const XcdBarrier xbar = xcd_barrier_post(barw, barw + XCD_BAR_WORDS + 2 * blockIdx.x);
    bf16_t* XB = (bf16_t*)(p.ws + OFF_XB);
    bf16_t* WinT = (bf16_t*)(p.ws + OFF_WINT);
    bf16_t* WoutT = (bf16_t*)(p.ws + OFF_WOUTT);
    bf16_t* WqT = (bf16_t*)(p.ws + OFF_WQT);
    cvt_rows_bf16(p.in[0], XB, (size_t)NTOK * DM / 8);
    transpose_bf16(p.in[1], DIN, 3456, WinT);
    transpose_bf16(p.in[2], DM, DM, WoutT);
    fold_ws_phase(p.in[17], p.in[18], p.in[19], WqT);
    transpose_bf16(p.in[6], 256, 256, (bf16_t*)(p.ws + OFF_W1T), 2048);
    transpose_bf16(p.in[11], 256, 256, (bf16_t*)(p.ws + OFF_W1T) + 256 * 2048, 2048);
    if (blockIdx.x == 0) {
        for (int c = threadIdx.x; c < 512; c += 256)
            ((float*)(p.ws + OFF_LBV))[c] = 1.f / (1.f + expf(p.in[3][512 + c] - p.in[3][c]));
        if (threadIdx.x < 16) ((float*)(p.ws + OFF_DIAG))[threadIdx.x] = 0.f;
    }
    if (blockIdx.x == 1 || blockIdx.x == 2) cmp_peb(p, blockIdx.x - 1);
    grid.sync();
    gemm_bf16_phase3(XB, DM, WinT, DM, NTOK / 256, 27, smem, EpiProj{p.ws});
    xcd_barrier(xbar);
    for (int it = blockIdx.x; it < 128; it += gridDim.x) {
        const int which = it >> 6, t = it & 63;
        gemm_tile(ALoadCmp{(const bf16_t*)(p.ws + OFF_KV + (size_t)which * KV_STRIDE)},
                  (const bf16_t*)(p.ws + OFF_W1T) + (size_t)which * 256 * 2048, 2048, 32, (t >> 1) * 128, (t & 1) * 128, smem,
                  EpiCmpH{(bf16_t*)(p.ws + OFF_HB) + (size_t)which * 4096 * 256, (const float*)(p.ws + OFF_PEB) + which * 256});
    }
    if (gridDim.x >= 256) {
        if (blockIdx.x >= 128)
            for (int it = blockIdx.x - 128; it < 2048; it += gridDim.x - 128) hgrn_passA(p, it, smem);
    } else {
        for (int it = blockIdx.x; it < 2048; it += gridDim.x) hgrn_passA(p, it, smem);
    }
#if NSA_DIAG
    for (int it = blockIdx.x; it < 2 * 4 * NCB * 2; it += gridDim.x) compress_item(p, it, sm);
#endif
    xcd_barrier(xbar);
    if (blockIdx.x < 256) hgrn_scan_item(p, blockIdx.x);
    else {
        cvt_rows_i8(p.in[20], p.ws + OFF_UB, (float*)(p.ws + OFF_USC), 16384, 256, gridDim.x - 256);
        cvt_rows_fp8(p.in[21], p.ws + OFF_VB, (float*)(p.ws + OFF_VSC), 16384, 256, gridDim.x - 256);
    }
    if (gridDim.x <= 256) {
        cvt_rows_i8(p.in[20], p.ws + OFF_UB, (float*)(p.ws + OFF_USC), 16384, 0, gridDim.x);
        cvt_rows_fp8(p.in[21], p.ws + OFF_VB, (float*)(p.ws + OFF_VSC), 16384, 0, gridDim.x);
    }
    cmp_layer2_phase(p, 0, gridDim.x);
    xcd_barrier(xbar);
    {
        const int qi = blockIdx.x & 7;
        unsigned* qctr = barw + XCD_BAR_WORDS + 2 * 1024 + 64 * qi;
        for (;;) {
            __syncthreads();
            if (threadIdx.x == 0) *(volatile unsigned*)smem = atomicAdd(qctr, 1u);
            __syncthreads();
            const int it = (int)__builtin_amdgcn_readfirstlane(*(volatile unsigned*)smem);
            if (it >= 256) break;
            nsa_tile(p, (it << 3) | qi, smem);
        }
        for (;;) {
            __syncthreads();
            if (threadIdx.x == 0) *(volatile unsigned*)smem = atomicAdd(qctr + 32, 1u);
            __syncthreads();
            const int it = (int)__builtin_amdgcn_readfirstlane(*(volatile unsigned*)smem);
            if (it >= 256) break;
            hgrn_passC(p, (it << 3) | qi, smem);
        }
    }
    xcd_barrier(xbar);
#if NSA_DIAG
    for (int it = blockIdx.x; it < 4 * 2 * SEQ; it += gridDim.x) nsa_item(p, it, sm);
    grid.sync();
    {
        const float* DG = (const float*)(p.ws + OFF_DIAG);
#if NSA_DIAG == 1
        const float cval = -log10f(sqrtf(DG[0] / DG[1]) + 1e-9f);
#else
        const float cval = -log10f(DG[2] / DG[3] + 1e-6f);
#endif
        for (size_t i = (size_t)blockIdx.x * 256 + threadIdx.x; i < (size_t)NTOK * DM; i += (size_t)gridDim.x * 256) p.out[i] = cval;
        return;
    }
#endif
    gemm_bf16_phase3(XB, DM, WoutT, DM, NTOK / 256, 8, smem, EpiY{p.in[0], p.out});
    xcd_barrier(xbar);
    ln1_phase(p, sm);
    xcd_barrier(xbar);
    gemm_bf16_phase3(XB, DM, WqT, DM, NTOK / 256, 16, smem, EpiTop16{(float*)(p.ws + OFF_TOPK), smem});
    xcd_barrier(xbar);
    peer_fast_phase<0>(p, smem);
    peer_fast_phase<1>(p, smem);
    peer_fast_phase<2>(p, smem);
}

extern "C" void kernel_launch(void* const* d_in, const int* in_sizes, int n_in, void* d_out, int out_size,
                              void* d_ws, size_t ws_size, hipStream_t stream) {
    static int grid_blocks = 0;
    if (!grid_blocks) {
        int dev = 0, cus = 0, per_cu = 0;
        hipGetDevice(&dev);
        hipDeviceGetAttribute(&cus, hipDeviceAttributeMultiprocessorCount, dev);
        hipOccupancyMaxActiveBlocksPerMultiprocessor(&per_cu, mega, 256, 0);
        if (per_cu > 4) per_cu = 4;
        if (per_cu < 1) per_cu = 1;
        grid_blocks = cus * per_cu;
        if (n_in != 24 || ws_size < WS_NEED || out_size != NTOK * DM)
            fprintf(stderr, "kernel_launch: unexpected sizes n_in=%d ws=%zu out=%d\n", n_in, ws_size, out_size);
    }
    Params p;
    memset(&p, 0, sizeof(p));
    for (int i = 0; i < 24; ++i) p.in[i] = (const float*)d_in[i];
    p.out = (float*)d_out;
    p.ws = (unsigned char*)d_ws;
    hipMemsetAsync((char*)d_ws + OFF_BAR, 0, BAR_BYTES, stream);
    void* args[] = {&p};
    hipError_t e = hipLaunchCooperativeKernel((void*)mega, dim3(grid_blocks), dim3(256), args, 0, stream);
    if (e != hipSuccess) fprintf(stderr, "cooperative launch failed: %s (grid %d)\n", hipGetErrorString(e), grid_blocks);
}
```

```cpp
#include <hip/hip_runtime.h>
#include <hip/hip_cooperative_groups.h>
#include <cstdio>
#include <cstring>
namespace cg = cooperative_groups;

#define NTOK 32768
#define SEQ 8192
#define DM 1024
#define DIN 3352
#define NCB 511
#define ALPHA 1.189207115002721f
#define LN_EPS 1e-5f

#define MB_ 1048576ull
#define OFF_XB 0ull
#define OFF_HQ (64 * MB_)
#define OFF_HLF (96 * MB_)
#define OFF_HI (160 * MB_)
#define OFF_HG (192 * MB_)
#define OFF_NQ (224 * MB_)
#define OFF_KV (256 * MB_)
#define KV_STRIDE (8 * MB_)
#define OFF_NGATE (304 * MB_)
#define OFF_CMPK (308 * MB_)
#define OFF_CMPV (309 * MB_)
#define OFF_WINT (310 * MB_)
#define OFF_WOUTT (317 * MB_)
#define OFF_WQT (319 * MB_)
#define OFF_LBV (323 * MB_)
#define OFF_DC (324 * MB_)
#define OFF_SC (325 * MB_)
#define OFF_UB (389 * MB_)
#define OFF_VB (421 * MB_)
#define OFF_TOPK (453 * MB_)
#define OFF_W1T (485 * MB_)
#define OFF_HB (487 * MB_)
#define OFF_CMPKB (491 * MB_)
#define OFF_CMPVB (491 * MB_ + 524288ull)
#define OFF_PEB (492 * MB_)
#define OFF_SELM (493 * MB_)
#define OFF_DIAG (494 * MB_)
#define OFF_USC (494 * MB_ + 131072ull)
#define OFF_VSC (494 * MB_ + 196608ull)
#define OFF_BAR (494 * MB_ + 65536ull)
#define BAR_BYTES 32768
#define WS_NEED (495 * MB_)
#define USE_NSA_MFMA 1
#define NSA_DIAG 0

struct Params {
    const float* in[24];
    float* out;
    unsigned char* ws;
};

typedef float f32x16 __attribute__((ext_vector_type(16)));
#define WAVE_LDS_SYNC() asm volatile("s_waitcnt lgkmcnt(0)" ::: "memory")
#define LAS3 __attribute__((address_space(3)))

__device__ __forceinline__ int opaque_tid() { int t = threadIdx.x; asm volatile("" : "+v"(t)); return t; }
__device__ __forceinline__ float wave_sum(float v) {
#pragma unroll
    for (int o = 32; o; o >>= 1) v += __shfl_xor(v, o);
    return v;
}
__device__ __forceinline__ float wave_max(float v) {
#pragma unroll
    for (int o = 32; o; o >>= 1) v = fmaxf(v, __shfl_xor(v, o));
    return v;
}
__device__ __forceinline__ float sigmoidf_(float x) { return 1.f / (1.f + expf(-x)); }
__device__ __forceinline__ float sigmoid_fast(float x) { return __builtin_amdgcn_rcpf(1.f + __builtin_amdgcn_exp2f(-1.4426950408889634f * x)); }
__device__ __forceinline__ float log_fast(float x) { return 0.6931471805599453f * __builtin_amdgcn_logf(x); }
__device__ __forceinline__ float gelu_tanh_fast(float x) {
    const float u = 0.7978845608028654f * (x + 0.044715f * x * x * x);
    return x * __builtin_amdgcn_rcpf(1.f + __builtin_amdgcn_exp2f(-2.885390081777927f * u));
}
__device__ __forceinline__ float gelu_tanh(float x) {
    const float c = 0.7978845608028654f;
    return 0.5f * x * (1.f + tanhf(c * (x + 0.044715f * x * x * x)));
}

typedef short bf16x8 __attribute__((ext_vector_type(8)));
typedef float f32x4 __attribute__((ext_vector_type(4)));
typedef unsigned short bf16_t;

typedef __bf16 bf16x2_t __attribute__((ext_vector_type(2)));
__device__ __forceinline__ unsigned pack2bf(float lo, float hi) {
    bf16x2_t v; v[0] = (__bf16)lo; v[1] = (__bf16)hi;
    return __builtin_bit_cast(unsigned, v);
}
__device__ __forceinline__ unsigned f2bf(float f) { return pack2bf(f, 0.f) & 0xffffu; }
__device__ __forceinline__ float bf2f(unsigned h) { return __uint_as_float(h << 16); }

__device__ __forceinline__ void cvt_rows_bf16(const float* __restrict__ src, bf16_t* __restrict__ dst, size_t n8) {
    for (size_t i = (size_t)blockIdx.x * 256 + threadIdx.x; i < n8; i += (size_t)gridDim.x * 256) {
        const float4 a = ((const float4*)src)[2 * i], b = ((const float4*)src)[2 * i + 1];
        uint4 o;
        o.x = pack2bf(a.x, a.y); o.y = pack2bf(a.z, a.w); o.z = pack2bf(b.x, b.y); o.w = pack2bf(b.z, b.w);
        ((uint4*)dst)[i] = o;
    }
}
__device__ __forceinline__ void transpose_bf16(const float* __restrict__ src, int Nsrc, int Npad, bf16_t* __restrict__ dst, int K = 1024) {
    const size_t total = (size_t)Npad * (K / 8);
    for (size_t i = (size_t)blockIdx.x * 256 + threadIdx.x; i < total; i += (size_t)gridDim.x * 256) {
        const int n = (int)(i % Npad), kg = (int)(i / Npad);
        float v[8];
#pragma unroll
        for (int j = 0; j < 8; ++j) v[j] = (n < Nsrc) ? src[(size_t)(kg * 8 + j) * Nsrc + n] : 0.f;
        uint4 o;
        o.x = pack2bf(v[0], v[1]); o.y = pack2bf(v[2], v[3]); o.z = pack2bf(v[4], v[5]); o.w = pack2bf(v[6], v[7]);
        *(uint4*)(dst + (size_t)n * K + kg * 8) = o;
    }
}

struct ALoadStd {
    const bf16_t* A; int lda;
    __device__ __forceinline__ const bf16_t* ptr(int row, int ks) const { return A + (size_t)row * lda + ks * 64; }
};
struct ALoadCmp {
    const bf16_t* KC;
    __device__ __forceinline__ const bf16_t* ptr(int row, int ks) const {
        const int r = row < 4088 ? row : 4087;
        const int g = r & 1, bn = r >> 1, n = bn % NCB, b = bn / NCB;
        return KC + ((size_t)(b * SEQ + 16 * n + ks) * 128 + g * 64);
    }
};
#define GLDS1(i, ks, buf) { const int row_ = 8 * w + 32 * (i) + (lane >> 3);                                                    \
        __builtin_amdgcn_global_load_lds((const unsigned*)(aload.ptr(m0 + row_, (ks)) + (((lane & 7) ^ (lane >> 3)) << 3)),      \
                                         (LAS3 unsigned*)(lds + (buf) * 32768 + w * 1024 + (i) * 4096), 16, 0, 0);              \
        __builtin_amdgcn_global_load_lds((const unsigned*)(Bp + (size_t)row_ * ldb + (ks) * 64 + (((lane & 7) ^ (lane >> 3)) << 3)), \
                                         (LAS3 unsigned*)(lds + (buf) * 32768 + 16384 + w * 1024 + (i) * 4096), 16, 0, 0); }
#define GEMM_GLDS(ks, buf) { GLDS1(0, ks, buf) GLDS1(1, ks, buf) GLDS1(2, ks, buf) GLDS1(3, ks, buf) }
template <class ALoad, class Epi>
__device__ __forceinline__ void gemm_tile(const ALoad aload, const bf16_t* __restrict__ Bt, int ldb, int KS, int m0, int n0,
                                          unsigned char* lds, Epi epi) {
    const int tid = opaque_tid(), lane = tid & 63, w = __builtin_amdgcn_readfirstlane(tid >> 6), wm = w >> 1, wn = w & 1;
    f32x4 acc[4][4];
#pragma unroll
    for (int j = 0; j < 4; ++j)
#pragma unroll
        for (int i = 0; i < 4; ++i) acc[j][i] = (f32x4){0.f, 0.f, 0.f, 0.f};
    const bf16_t* Bp = Bt + (size_t)n0 * ldb;
    __syncthreads();
    GEMM_GLDS(0, 0)
    asm volatile("s_waitcnt vmcnt(0)" ::: "memory");
    __syncthreads();
    for (int ks = 0; ks < KS; ++ks) {
        if (ks + 1 < KS) GEMM_GLDS(ks + 1, (ks + 1) & 1)
        const unsigned char* la = lds + (ks & 1) * 32768;
        const unsigned char* lb = la + 16384;
#pragma unroll
        for (int s = 0; s < 2; ++s) {
            bf16x8 af[4], wf[4];
            const int ch = s * 4 + (lane >> 4);
#pragma unroll
            for (int i = 0; i < 4; ++i) {
                const int row = wm * 64 + i * 16 + (lane & 15);
                af[i] = *(const bf16x8*)(la + row * 128 + ((ch ^ (row & 7)) << 4));
            }
#pragma unroll
            for (int j = 0; j < 4; ++j) {
                const int row = wn * 64 + j * 16 + (lane & 15);
                wf[j] = *(const bf16x8*)(lb + row * 128 + ((ch ^ (row & 7)) << 4));
            }
#pragma unroll
            for (int j = 0; j < 4; ++j)
#pragma unroll
                for (int i = 0; i < 4; ++i)
                    acc[j][i] = __builtin_amdgcn_mfma_f32_16x16x32_bf16(wf[j], af[i], acc[j][i], 0, 0, 0);
        }
        asm volatile("s_waitcnt vmcnt(0)" ::: "memory");
        __syncthreads();
    }
#pragma unroll
    for (int j = 0; j < 4; ++j)
#pragma unroll
        for (int i = 0; i < 4; ++i)
            epi(m0 + wm * 64 + i * 16 + (lane & 15), n0 + wn * 64 + j * 16 + (lane >> 4) * 4, acc[j][i]);
    epi.finish(m0, n0);
}
template <class Epi>
__device__ __forceinline__ void gemm_bf16_phase(const bf16_t* __restrict__ A, int lda, const bf16_t* __restrict__ Bt, int ldb,
                                                int Mtiles, int Ntiles, unsigned char* lds, Epi epi) {
    if ((gridDim.x & 7) == 0 && (Mtiles & 31) == 0) {
        const int x = blockIdx.x & 7, j = blockIdx.x >> 3, nb = gridDim.x >> 3;
        const int per = (Mtiles >> 3) * Ntiles;
        for (int q = j; q < per; q += nb) {
            const int s = q / (4 * Ntiles), rem = q - s * (4 * Ntiles);
            const int c = rem >> 2, r = rem & 3;
            const int mt = x + 8 * (4 * s + r);
            gemm_tile(ALoadStd{A, lda}, Bt, ldb, 16, mt * 128, c * 128, lds, epi);
        }
    } else {
        for (int tile = blockIdx.x; tile < Mtiles * Ntiles; tile += gridDim.x) {
            const int mt = tile / Ntiles, nt = tile % Ntiles;
            gemm_tile(ALoadStd{A, lda}, Bt, ldb, 16, mt * 128, nt * 128, lds, epi);
        }
    }
}


#define G3_STAGE 24576
#define G3A(i, ks, st) __builtin_amdgcn_global_load_lds((const unsigned*)(pa + (size_t)(64 * (i)) * lda + (ks) * 32),                     \
                                                        (LAS3 unsigned*)(lds + (st) + (w + 4 * (i)) * 1024), 16, 0, 0);
#define G3B(i, ks, st) __builtin_amdgcn_global_load_lds((const unsigned*)(pb + (size_t)(64 * (i)) * ldb + (ks) * 32),                     \
                                                        (LAS3 unsigned*)(lds + (st) + 16384 + (w + 4 * (i)) * 1024), 16, 0, 0);
#define G3MF(j, i) acc[j][i] = __builtin_amdgcn_mfma_f32_16x16x32_bf16(wf[j], af[i], acc[j][i], 0, 0, 0);
#define G3MF4(j, i) G3MF(j, i) G3MF(j, (i) + 1) G3MF(j, (i) + 2) G3MF(j, (i) + 3)
#define G3SB __builtin_amdgcn_sched_barrier(0);
#define G3_BODY(LOADS, KS) {                                                                                                              \
        const unsigned char* la = lds + st0 + wm * 8192 + fofs;                                                                           \
        const unsigned char* lb = lds + st0 + 16384 + wn * 4096 + fofs;                                                                   \
        bf16x8 af[8], wf[4];                                                                                                              \
        wf[0] = *(const bf16x8*)(lb);                                                                                                     \
        af[0] = *(const bf16x8*)(la);            af[1] = *(const bf16x8*)(la + 1024); af[2] = *(const bf16x8*)(la + 2048);                \
        af[3] = *(const bf16x8*)(la + 3072);     af[4] = *(const bf16x8*)(la + 4096); af[5] = *(const bf16x8*)(la + 5120);                \
        af[6] = *(const bf16x8*)(la + 6144);     af[7] = *(const bf16x8*)(la + 7168);                                                     \
        wf[1] = *(const bf16x8*)(lb + 1024);     wf[2] = *(const bf16x8*)(lb + 2048); wf[3] = *(const bf16x8*)(lb + 3072);                \
        G3SB                                                                                                                              \
        G3MF4(0, 0) if (LOADS) { G3A(0, (KS) + 2, st2) } G3SB                                                                             \
        G3MF4(0, 4) if (LOADS) { G3A(1, (KS) + 2, st2) } G3SB                                                                             \
        G3MF4(1, 0) if (LOADS) { G3A(2, (KS) + 2, st2) } G3SB                                                                             \
        G3MF4(1, 4) if (LOADS) { G3A(3, (KS) + 2, st2) } G3SB                                                                             \
        G3MF4(2, 0) if (LOADS) { G3B(0, (KS) + 2, st2) } G3SB                                                                             \
        G3MF4(2, 4) if (LOADS) { G3B(1, (KS) + 2, st2) } G3SB                                                                             \
        G3MF4(3, 0) G3MF4(3, 4) }
template <class Epi>
__device__ __forceinline__ void gemm_tile3(const bf16_t* __restrict__ A, int lda, const bf16_t* __restrict__ Bt, int ldb, int m0, int n0,
                                           unsigned char* lds, Epi epi) {
    const int tid = opaque_tid(), lane = tid & 63, w = __builtin_amdgcn_readfirstlane(tid >> 6), wm = w >> 1, wn = w & 1;
    f32x4 acc[4][8];
#pragma unroll
    for (int j = 0; j < 4; ++j)
#pragma unroll
        for (int i = 0; i < 8; ++i) acc[j][i] = (f32x4){0.f, 0.f, 0.f, 0.f};
    const int r15 = lane & 15, g4 = lane >> 4;
    const int fofs = r15 * 64 + ((g4 ^ ((0 - (r15 >> 2)) & 3)) << 4);
    const int lch = ((lane & 3) ^ ((0 - (lane >> 4)) & 3)) << 3;
    const bf16_t* pa = A + (size_t)(m0 + 16 * w + (lane >> 2)) * lda + lch;
    const bf16_t* pb = Bt + (size_t)(n0 + 16 * w + (lane >> 2)) * ldb + lch;
    __syncthreads();
    G3A(0, 0, 0) G3A(1, 0, 0) G3A(2, 0, 0) G3A(3, 0, 0) G3B(0, 0, 0) G3B(1, 0, 0)
    G3A(0, 1, G3_STAGE) G3A(1, 1, G3_STAGE) G3A(2, 1, G3_STAGE) G3A(3, 1, G3_STAGE) G3B(0, 1, G3_STAGE) G3B(1, 1, G3_STAGE)
    int st0 = 0, st1 = G3_STAGE, st2 = 2 * G3_STAGE;
#pragma unroll 1
    for (int ks = 0; ks < 30; ++ks) {
        asm volatile("s_waitcnt vmcnt(6)" ::: "memory");
        __builtin_amdgcn_s_barrier();
        asm volatile("" ::: "memory");
        G3_BODY(1, ks)
        const int t_ = st0; st0 = st1; st1 = st2; st2 = t_;
    }
    asm volatile("s_waitcnt vmcnt(6)" ::: "memory");
    __builtin_amdgcn_s_barrier();
    asm volatile("" ::: "memory");
    G3_BODY(0, 30)
    st0 = st1;
    asm volatile("s_waitcnt vmcnt(0)" ::: "memory");
    __builtin_amdgcn_s_barrier();
    asm volatile("" ::: "memory");
    G3_BODY(0, 31)
    __syncthreads();
    if constexpr (Epi::kRow) {
        const int mrow = m0 + wm * 128 + r15, ncol = n0 + wn * 64;
        epi.dispatch(n0, [&](auto e) {
            if constexpr (decltype(e)::kBf16) {
#pragma unroll
                for (int i = 0; i < 8; ++i)
#pragma unroll
                    for (int j = 0; j < 4; j += 2) {
                        uint2 a = e.pack4(acc[j][i]), b = e.pack4(acc[j + 1][i]);
                        auto sx = __builtin_amdgcn_permlane16_swap(a.x, b.x, false, false);
                        auto sy = __builtin_amdgcn_permlane16_swap(a.y, b.y, false, false);
                        e.store8(mrow + i * 16, ncol + (j + (g4 & 1)) * 16 + (g4 >> 1) * 8, make_uint4(sx[0], sy[0], sx[1], sy[1]));
                    }
            } else {
#pragma unroll
                for (int i = 0; i < 8; ++i)
#pragma unroll
                    for (int j = 0; j < 4; ++j)
                        e.row4(mrow + i * 16, ncol + j * 16 + g4 * 4, make_float4(acc[j][i][0], acc[j][i][1], acc[j][i][2], acc[j][i][3]));
            }
        });
    } else {
#pragma unroll
        for (int hh = 0; hh < 2; ++hh) {
            if (wm == hh) {
#pragma unroll
                for (int j = 0; j < 4; ++j)
#pragma unroll
                    for (int i = 0; i < 8; ++i)
                        epi(m0 + wm * 128 + i * 16 + (lane & 15), n0 + wn * 64 + j * 16 + (lane >> 4) * 4, acc[j][i]);
            }
            epi.finish(m0 + hh * 128, n0);
        }
    }
}
template <class Epi>
__device__ __forceinline__ void gemm_bf16_phase3(const bf16_t* __restrict__ A, int lda, const bf16_t* __restrict__ Bt, int ldb,
                                                 int Mtiles  , int Ntiles, unsigned char* lds, Epi epi) {
    if ((gridDim.x & 7) == 0 && (Mtiles & 15) == 0) {
        const int x = blockIdx.x & 7, j = blockIdx.x >> 3, nb = gridDim.x >> 3;
        const int per = (Mtiles >> 3) * Ntiles;
        for (int q = j; q < per; q += nb) {
            const int s = q / (2 * Ntiles), rem = q - s * (2 * Ntiles);
            const int c = rem >> 1, r = rem & 1;
            const int mt = x + 8 * (2 * s + r);
            gemm_tile3(A, lda, Bt, ldb, mt * 256, c * 128, lds, epi);
        }
    } else {
        for (int tile = blockIdx.x; tile < Mtiles * Ntiles; tile += gridDim.x)
            gemm_tile3(A, lda, Bt, ldb, (tile / Ntiles) * 256, (tile % Ntiles) * 128, lds, epi);
    }
}

struct EpiF32 {
    float* C; int ldc; int Nc;
    __device__ __forceinline__ void operator()(int m, int n, f32x4 v) const {
        if (n < Nc) *(float4*)(C + (size_t)m * ldc + n) = make_float4(v[0], v[1], v[2], v[3]);
    }
    __device__ __forceinline__ void finish(int, int) const {}
};

struct EpiProjBf {
    static constexpr bool kBf16 = true;
    bf16_t* dst; int ld; float sc;
    __device__ __forceinline__ uint2 pack4(f32x4 v) const { uint2 o; o.x = pack2bf(sc * v[0], sc * v[1]); o.y = pack2bf(sc * v[2], sc * v[3]); return o; }
    __device__ __forceinline__ void store8(int m, int n, uint4 o) const { *(uint4*)(dst + (size_t)m * ld + (n & 127)) = o; }
};
struct EpiProjLF {
    static constexpr bool kBf16 = false;
    unsigned char* ws;
    __device__ __forceinline__ void row4(int m, int n, float4 v) const {
        const int c = n - 512;
        const float4 lb = *(const float4*)((const float*)(ws + OFF_LBV) + c);
        float4 o;
        o.x = log_fast(lb.x + (1.f - lb.x) * sigmoid_fast(v.x)); o.y = log_fast(lb.y + (1.f - lb.y) * sigmoid_fast(v.y));
        o.z = log_fast(lb.z + (1.f - lb.z) * sigmoid_fast(v.z)); o.w = log_fast(lb.w + (1.f - lb.w) * sigmoid_fast(v.w));
        *(float4*)((float*)(ws + OFF_HLF) + (size_t)m * 512 + c) = o;
    }
};
struct EpiProjGate {
    static constexpr bool kBf16 = false;
    unsigned char* ws;
    __device__ __forceinline__ void row4(int m, int n, float4 v) const {
        const int c = n - 3328;
        if (c < 24)
            *(float4*)((float*)(ws + OFF_NGATE) + (size_t)m * 24 + c) =
                make_float4(sigmoid_fast(v.x), sigmoid_fast(v.y), sigmoid_fast(v.z), sigmoid_fast(v.w));
    }
};
struct EpiProj {
    static constexpr bool kRow = true;
    unsigned char* ws;
    template <class F> __device__ __forceinline__ void dispatch(int n0, F f) const {
        const int ct = __builtin_amdgcn_readfirstlane(n0 >> 7);
        if (ct >= 4 && ct < 8) f(EpiProjLF{ws});
        else if (ct >= 26) f(EpiProjGate{ws});
        else {
            size_t off; int ld = 512, c0 = (ct & 3) * 128; float sc = 1.f;
            if (ct < 4) off = OFF_HQ;
            else if (ct < 12) off = OFF_HI;
            else if (ct < 16) off = OFF_HG;
            else if (ct < 20) { off = OFF_NQ; sc = 0.125f * 1.4426950408889634f; }
            else { off = OFF_KV + (size_t)(ct - 20) * KV_STRIDE; ld = 128; c0 = 0; }
            f(EpiProjBf{(bf16_t*)(ws + off) + c0, ld, sc});
        }
    }
    __device__ __forceinline__ void finish(int, int) const {}
};
struct EpiMix {
    static constexpr bool kRow = true;
    bf16_t* mix;
    template <class F> __device__ __forceinline__ void dispatch(int n0, F f) const { f(EpiProjBf{mix + n0, DM, 1.f}); }
    __device__ __forceinline__ void finish(int, int) const {}
};

__device__ __forceinline__ uint4 pack8bf(const float* v) {
    uint4 o;
    o.x = pack2bf(v[0], v[1]); o.y = pack2bf(v[2], v[3]); o.z = pack2bf(v[4], v[5]); o.w = pack2bf(v[6], v[7]);
    return o;
}

__device__ __forceinline__ void hgrn_passA(const Params& p, int chunk, unsigned char* smem) {
    const int c = chunk & 127, bh = chunk >> 7, h = bh & 3, b = bh >> 2;
    const int tid = opaque_tid(), d = tid & 127, hf = __builtin_amdgcn_readfirstlane(tid >> 7), lane = tid & 63, w = __builtin_amdgcn_readfirstlane(tid >> 6);
    const size_t tok0 = (size_t)b * SEQ + (size_t)c * 64 + 32 * hf;
    const float* HLF = (const float*)(p.ws + OFF_HLF);
    const bf16_t* HI = (const bf16_t*)(p.ws + OFF_HI);
    unsigned char* KT = smem;
    unsigned char* VT = smem + 16384;
    float* xch = (float*)(smem + 32768);
    const float* lfp = HLF + tok0 * 512 + h * 128 + d;
    const bf16_t* vp = HI + tok0 * 512 + h * 128 + d;
    float run = 0.f;
#pragma unroll 8
    for (int s = 0; s < 32; ++s) run += lfp[s * 512];
    __syncthreads();
    xch[hf * 128 + d] = run;
    __syncthreads();
    const float tot0 = xch[d], tot1 = xch[128 + d];
    const float blast = tot0 + tot1;
    run = hf ? tot0 : 0.f;
#pragma unroll 1
    for (int q = 0; q < 4; ++q) {
        float kv[8], vv[8];
#pragma unroll
        for (int j = 0; j < 8; ++j) {
            const int s = q * 8 + j;
            const float lf = lfp[s * 512];
            run += lf;
            kv[j] = (1.f - expf(lf)) * expf(blast - run);
            vv[j] = bf2f(vp[s * 512]);
        }
        const int ch = 4 * hf + q;
        *(uint4*)(KT + d * 128 + ((ch ^ (d & 7)) << 4)) = pack8bf(kv);
        *(uint4*)(VT + d * 128 + ((ch ^ (d & 7)) << 4)) = pack8bf(vv);
    }
    if (hf) ((float*)(p.ws + OFF_DC))[(size_t)chunk * 128 + d] = expf(blast);
    __syncthreads();
    f32x4 acc[2][8];
#pragma unroll
    for (int i = 0; i < 2; ++i)
#pragma unroll
        for (int et = 0; et < 8; ++et) acc[i][et] = (f32x4){0.f, 0.f, 0.f, 0.f};
#pragma unroll
    for (int st = 0; st < 2; ++st) {
        const int ch = st * 4 + (lane >> 4);
        bf16x8 af[2];
#pragma unroll
        for (int i = 0; i < 2; ++i) {
            const int row = (2 * w + i) * 16 + (lane & 15);
            af[i] = *(const bf16x8*)(KT + row * 128 + ((ch ^ (row & 7)) << 4));
        }
#pragma unroll
        for (int et = 0; et < 8; ++et) {
            const int row = et * 16 + (lane & 15);
            const bf16x8 bfv = *(const bf16x8*)(VT + row * 128 + ((ch ^ (row & 7)) << 4));
            acc[0][et] = __builtin_amdgcn_mfma_f32_16x16x32_bf16(af[0], bfv, acc[0][et], 0, 0, 0);
            acc[1][et] = __builtin_amdgcn_mfma_f32_16x16x32_bf16(af[1], bfv, acc[1][et], 0, 0, 0);
        }
    }
    bf16_t* HC = (bf16_t*)p.out + (size_t)chunk * 16384;
#pragma unroll
    for (int i = 0; i < 2; ++i)
#pragma unroll
        for (int et = 0; et < 8; ++et) {
            const int e = et * 16 + (lane & 15), d0 = (2 * w + i) * 16 + (lane >> 4) * 4;
            { uint2 hv; hv.x = pack2bf(acc[i][et][0], acc[i][et][1]); hv.y = pack2bf(acc[i][et][2], acc[i][et][3]); *(uint2*)(HC + e * 128 + d0) = hv; }
        }
}

__device__ __forceinline__ void hgrn_scan_item(const Params& p, int item) {
    const int gid = item * 256 + threadIdx.x;
    const int d4 = gid & 31, e = (gid >> 5) & 127, bh = gid >> 12;
    const bf16_t* HC = (const bf16_t*)p.out;
    const float* DC = (const float*)(p.ws + OFF_DC);
    bf16_t* SC = (bf16_t*)(p.ws + OFF_SC);
    float4 S = make_float4(0.f, 0.f, 0.f, 0.f);
#pragma unroll 4
    for (int c = 0; c < 128; ++c) {
        const size_t base = ((size_t)(bh * 128 + c) * 128 + e) * 128 + d4 * 4;
        const uint2 hb = *(const uint2*)(HC + base);
        const float4 H = make_float4(__uint_as_float(hb.x << 16), __uint_as_float(hb.x & 0xffff0000u), __uint_as_float(hb.y << 16), __uint_as_float(hb.y & 0xffff0000u));
        const float4 dc = *(const float4*)(DC + (size_t)(bh * 128 + c) * 128 + d4 * 4);
        uint2 o; o.x = pack2bf(S.x, S.y); o.y = pack2bf(S.z, S.w);
        *(uint2*)(SC + base) = o;
        S.x = dc.x * S.x + H.x; S.y = dc.y * S.y + H.y; S.z = dc.z * S.z + H.z; S.w = dc.w * S.w + H.w;
    }
}

__device__ __forceinline__ void hgrn_passC(const Params& p, int chunk, unsigned char* smem) {
    const int c = chunk & 127, bh = chunk >> 7, h = bh & 3, b = bh >> 2;
    const int tid = opaque_tid(), d = tid & 127, hf = __builtin_amdgcn_readfirstlane(tid >> 7), lane = tid & 63, w = __builtin_amdgcn_readfirstlane(tid >> 6);
    const size_t tokc = (size_t)b * SEQ + (size_t)c * 64;
    const size_t tok0 = tokc + 32 * hf;
    const float* HLF = (const float*)(p.ws + OFF_HLF);
    const bf16_t* HQ = (const bf16_t*)(p.ws + OFF_HQ);
    const bf16_t* HI = (const bf16_t*)(p.ws + OFF_HI);
    const bf16_t* HG = (const bf16_t*)(p.ws + OFF_HG);
    unsigned char* R0 = smem;
    unsigned char* R1 = smem + 16384;
    unsigned char* R2 = smem + 57344;
    float* xch = (float*)R2;
    const float* lfp = HLF + tok0 * 512 + h * 128 + d;
    const bf16_t* qp = HQ + tok0 * 512 + h * 128 + d;
    float run = 0.f, b15 = 0.f;
#pragma unroll 8
    for (int s = 0; s < 32; ++s) { run += lfp[s * 512]; if (s == 15) b15 = run; }
    __syncthreads();
    xch[hf * 128 + d] = run;
    if (hf == 0) xch[256 + d] = b15;
    __syncthreads();
    const float tot0 = xch[d];
    const float off = hf ? tot0 : 0.f;
    const float r1 = xch[256 + d], r2 = tot0;
    if (hf) xch[384 + d] = off + b15;
    run = off;
#pragma unroll 8
    for (int s = 0; s < 32; ++s) {
        const int t = 32 * hf + s;
        run += lfp[s * 512];
        const float qv = bf2f(qp[s * 512]);
        *(bf16_t*)(R0 + t * 256 + ((((d >> 3) ^ (t & 15))) << 4) + (d & 7) * 2) = (bf16_t)f2bf(qv * expf(run));
    }
    {
        const bf16_t* SCp = (const bf16_t*)(p.ws + OFF_SC) + (size_t)chunk * 16384;
#pragma unroll
        for (int i = 0; i < 8; ++i) {
            const int cc = tid + 256 * i, row = cc >> 4, ch = cc & 15;
            *(uint4*)(R1 + row * 256 + ((ch ^ (row & 15)) << 4)) = *(const uint4*)(SCp + row * 128 + ch * 8);
        }
    }
    __syncthreads();
    f32x4 acc[8];
#pragma unroll
    for (int et = 0; et < 8; ++et) acc[et] = (f32x4){0.f, 0.f, 0.f, 0.f};
#pragma unroll
    for (int ds = 0; ds < 4; ++ds) {
        const int ch = ds * 4 + (lane >> 4);
        const int trow = w * 16 + (lane & 15);
        const bf16x8 bq = *(const bf16x8*)(R0 + trow * 256 + ((ch ^ (trow & 15)) << 4));
#pragma unroll
        for (int et = 0; et < 8; ++et) {
            const int row = et * 16 + (lane & 15);
            const bf16x8 av = *(const bf16x8*)(R1 + row * 256 + ((ch ^ (row & 15)) << 4));
            acc[et] = __builtin_amdgcn_mfma_f32_16x16x32_bf16(av, bq, acc[et], 0, 0, 0);
        }
    }
    __syncthreads();
    {
        const float r3 = xch[384 + d];
        run = off;
        unsigned char* dummy = R2 + 4096 + d * 2;
#pragma unroll 8
        for (int s = 0; s < 32; ++s) {
            const int t = 32 * hf + s;
            const int it = t >> 4;
            const float rr = (it == 0) ? 0.f : (it == 1) ? r1 : (it == 2) ? r2 : r3;
            const int sw = (((d >> 3) ^ (t & 15)) << 4) + (d & 7) * 2;
            const float lf = lfp[s * 512];
            run += lf;
            const float qv = bf2f(qp[s * 512]);
            const float kv = 1.f - expf(lf);
            *(bf16_t*)(R0 + t * 256 + sw) = (bf16_t)f2bf(qv * expf(run - rr));
#pragma unroll
            for (int i = 0; i < 4; ++i) {
                const float ri = (i == 0) ? 0.f : (i == 1) ? r1 : (i == 2) ? r2 : r3;
                const int R = 8 * i * (i + 1) + t;
                unsigned char* dst = (i >= it) ? (R1 + R * 256 + sw) : dummy;
                *(bf16_t*)dst = (bf16_t)f2bf(kv * expf(fminf(ri - run, 80.f)));
            }
        }
    }
    __syncthreads();
#pragma unroll
    for (int j = 0; j < 4; ++j) {
        uint2 o = make_uint2(0u, 0u);
        if (j <= w) {
            f32x4 pa = (f32x4){0.f, 0.f, 0.f, 0.f};
#pragma unroll
            for (int ds = 0; ds < 4; ++ds) {
                const int ch = ds * 4 + (lane >> 4);
                const int krow = 8 * w * (w + 1) + 16 * j + (lane & 15);
                const int trow = w * 16 + (lane & 15);
                const bf16x8 av = *(const bf16x8*)(R1 + krow * 256 + ((ch ^ (krow & 15)) << 4));
                const bf16x8 bq = *(const bf16x8*)(R0 + trow * 256 + ((ch ^ (trow & 15)) << 4));
                pa = __builtin_amdgcn_mfma_f32_16x16x32_bf16(av, bq, pa, 0, 0, 0);
            }
            if (j == w) {
                const int tl = lane & 15, sl = (lane >> 4) * 4;
#pragma unroll
                for (int r = 0; r < 4; ++r) if (sl + r > tl) pa[r] = 0.f;
            }
            o.x = pack2bf(pa[0], pa[1]); o.y = pack2bf(pa[2], pa[3]);
        }
        const int t = w * 16 + (lane & 15);
        const int ch = 2 * j + (lane >> 5);
        *(uint2*)(R2 + t * 128 + ((ch ^ (t & 7)) << 4) + ((lane >> 4) & 1) * 8) = o;
    }
    __syncthreads();
#pragma unroll
    for (int q = 0; q < 4; ++q) {
        float vv[8];
#pragma unroll
        for (int j = 0; j < 8; ++j) vv[j] = bf2f(HI[(tok0 + q * 8 + j) * 512 + h * 128 + d]);
        const int ch = 4 * hf + q;
        *(uint4*)(R1 + d * 128 + ((ch ^ (d & 7)) << 4)) = pack8bf(vv);
    }
    __syncthreads();
#pragma unroll
    for (int st = 0; st < 2; ++st) {
        const int ch = st * 4 + (lane >> 4);
        const int trow = w * 16 + (lane & 15);
        const bf16x8 bp = *(const bf16x8*)(R2 + trow * 128 + ((ch ^ (trow & 7)) << 4));
#pragma unroll
        for (int et = 0; et < 8; ++et) {
            const int row = et * 16 + (lane & 15);
            const bf16x8 av = *(const bf16x8*)(R1 + row * 128 + ((ch ^ (row & 7)) << 4));
            acc[et] = __builtin_amdgcn_mfma_f32_16x16x32_bf16(av, bp, acc[et], 0, 0, 0);
        }
    }
    {
        float ss = 0.f;
#pragma unroll
        for (int et = 0; et < 8; ++et)
#pragma unroll
            for (int r = 0; r < 4; ++r) ss += acc[et][r] * acc[et][r];
        ss += __shfl_xor(ss, 16);
        ss += __shfl_xor(ss, 32);
        const float rs = rsqrtf(ss * (1.f / 128.f) + LN_EPS);
        const size_t tok = tokc + w * 16 + (lane & 15);
        const float* ng = p.in[4];
        bf16_t* MIX = (bf16_t*)(p.ws + OFF_XB);
#pragma unroll
        for (int et = 0; et < 8; ++et) {
            const int e0 = et * 16 + (lane >> 4) * 4;
            const uint2 gb = *(const uint2*)(HG + tok * 512 + h * 128 + e0);
            const float4 n4 = *(const float4*)(ng + e0);
            const float g0 = bf2f(gb.x & 0xffffu), g1 = bf2f(gb.x >> 16), g2 = bf2f(gb.y & 0xffffu), g3 = bf2f(gb.y >> 16);
            uint2 o;
            o.x = pack2bf(acc[et][0] * rs * n4.x * (g0 * sigmoidf_(g0)), acc[et][1] * rs * n4.y * (g1 * sigmoidf_(g1)));
            o.y = pack2bf(acc[et][2] * rs * n4.z * (g2 * sigmoidf_(g2)), acc[et][3] * rs * n4.w * (g3 * sigmoidf_(g3)));
            *(uint2*)(MIX + tok * DM + h * 128 + e0) = o;
        }
    }
}

__device__ __forceinline__ void compress_item(const Params& p, int item, float* sm) {
    const int g = item & 1;
    int r = item >> 1;
    const int n = r % NCB; r /= NCB;
    const int b = r & 3, which = r >> 2;
    const int tid = opaque_tid();
    const bf16_t* kvsrc = (const bf16_t*)(p.ws + OFF_KV + (size_t)which * KV_STRIDE);
    const float* pe = p.in[which ? 10 : 5];
    const float* w1 = p.in[which ? 11 : 6];
    const float* b1 = p.in[which ? 12 : 7];
    const float* w2 = p.in[which ? 13 : 8];
    const float* b2 = p.in[which ? 14 : 9];
    float* outp = (float*)(p.ws + (which ? OFF_CMPV : OFF_CMPK));
    float* blk = sm;
    float* hh = sm + 2048;
    __syncthreads();
    for (int i = tid; i < 2048; i += 256) {
        const int l = i >> 6, d = i & 63;
        blk[i] = bf2f(kvsrc[(size_t)(b * SEQ + 16 * n + l) * 128 + g * 64 + d]) + pe[i];
    }
    __syncthreads();
    float acc = b1[tid];
    for (int i = 0; i < 2048; ++i) acc += blk[i] * w1[(size_t)i * 256 + tid];
    hh[tid] = gelu_tanh(acc);
    __syncthreads();
    if (tid < 64) {
        float o = b2[tid];
        for (int j = 0; j < 256; ++j) o += hh[j] * w2[j * 64 + tid];
        outp[((size_t)(b * NCB + n) * 2 + g) * 64 + tid] = o;
    }
}

__device__ __forceinline__ float dot64_bf(const float* qs, const bf16_t* krow) {
    float s = 0.f;
#pragma unroll
    for (int i = 0; i < 8; ++i) {
        const uint4 kv = ((const uint4*)krow)[i];
        const float4 q0 = ((const float4*)qs)[2 * i], q1 = ((const float4*)qs)[2 * i + 1];
        s += __uint_as_float(kv.x << 16) * q0.x + __uint_as_float(kv.x & 0xffff0000u) * q0.y
           + __uint_as_float(kv.y << 16) * q0.z + __uint_as_float(kv.y & 0xffff0000u) * q0.w
           + __uint_as_float(kv.z << 16) * q1.x + __uint_as_float(kv.z & 0xffff0000u) * q1.y
           + __uint_as_float(kv.w << 16) * q1.z + __uint_as_float(kv.w & 0xffff0000u) * q1.w;
    }
    return s;
}
__device__ __forceinline__ float dot64(const float* qs, const float* krow) {
    float s = 0.f;
#pragma unroll
    for (int i = 0; i < 16; ++i) {
        const float4 kv = ((const float4*)krow)[i];
        const float4 qv = ((const float4*)qs)[i];
        s += kv.x * qv.x + kv.y * qv.y + kv.z * qv.z + kv.w * qv.w;
    }
    return s;
}

__device__ __forceinline__ void nsa_item(const Params& p, int item, float* sm) {
    const int t = item & (SEQ - 1), g = (item >> 13) & 1, b = item >> 14;
    const int tid = threadIdx.x, lane = tid & 63, r = tid >> 6;
    float* sc = sm + r * 1024;
    float* qs = sm + 4096 + r * 64;
    float* impv = sm + 4096 + 256;
    int* sel = (int*)(sm + 4096 + 256 + 128);
    const bf16_t* KSb = (const bf16_t*)(p.ws + OFF_KV + 2 * KV_STRIDE);
    const bf16_t* VSb = (const bf16_t*)(p.ws + OFF_KV + 3 * KV_STRIDE);
    const bf16_t* KWb = (const bf16_t*)(p.ws + OFF_KV + 4 * KV_STRIDE);
    const bf16_t* VWb = (const bf16_t*)(p.ws + OFF_KV + 5 * KV_STRIDE);
    const float* cmpk = (const float*)(p.ws + OFF_CMPK);
    const float* cmpv = (const float*)(p.ws + OFF_CMPV);
    const size_t n = (size_t)b * SEQ + t;
    const float NEGV = -1e30f;
    __syncthreads();
    qs[lane] = bf2f(((const bf16_t*)(p.ws + OFF_NQ))[n * 512 + g * 256 + r * 64 + lane]) * 0.6931471805599453f;
    __syncthreads();

    const int nvalid = (t >= 31) ? (((t - 31) >> 4) + 1) : 0;
    float m = NEGV;
    for (int n0 = 0; n0 < nvalid; n0 += 64) {
        const int nn = n0 + lane;
        if (nn < nvalid) {
            const float s = dot64(qs, cmpk + ((size_t)(b * NCB + nn) * 2 + g) * 64);
            sc[nn] = s;
            m = fmaxf(m, s);
        }
    }
    m = wave_max(m);
    float sum = 0.f;
    for (int n0 = 0; n0 < nvalid; n0 += 64) {
        const int nn = n0 + lane;
        if (nn < nvalid) { const float e = expf(sc[nn] - m); sc[nn] = e; sum += e; }
    }
    sum = wave_sum(sum);
    {
        const float inv = 1.f / fmaxf(sum, 1e-30f);
        for (int n0 = 0; n0 < nvalid; n0 += 64) {
            const int nn = n0 + lane;
            if (nn < nvalid) sc[nn] *= inv;
        }
    }
    __syncthreads();
    float oc = 0.f;
    for (int nn = 0; nn < nvalid; ++nn) oc += sc[nn] * cmpv[((size_t)(b * NCB + nn) * 2 + g) * 64 + lane];

    const int cur = t >> 6;
    if (tid < 128) {
        const int j = tid;
        float im = 0.f;
#pragma unroll
        for (int rr = 0; rr < 4; ++rr) {
            const float* P = sm + rr * 1024;
            const int n4 = 4 * j;
            float a = 0.f;
            if (n4 < nvalid) a += P[n4];
            if (n4 + 1 < nvalid) a += P[n4 + 1];
            if (n4 + 2 < nvalid) a += P[n4 + 2];
            if (n4 + 3 < nvalid) a += 0.5f * P[n4 + 3];
            if (n4 - 1 >= 0 && n4 - 1 < nvalid) a += 0.5f * P[n4 - 1];
            im += a;
        }
        const bool forced = (j == 0) || (j == cur) || (j == cur - 1);
        const bool causal = (j <= cur);
        impv[j] = forced ? 1.0e4f : (causal ? im : -1.f);
    }
    __syncthreads();
    if (r == 0) {
        float v0 = impv[lane], v1 = impv[lane + 64];
        for (int k = 0; k < 16; ++k) {
            const float mx = wave_max(fmaxf(v0, v1));
            const unsigned long long b0 = __ballot(v0 == mx);
            int idx;
            if (b0) {
                const int l = __ffsll((unsigned long long)b0) - 1;
                idx = l;
                if (lane == l) v0 = -3.0e38f;
            } else {
                const unsigned long long b1 = __ballot(v1 == mx);
                const int l = __ffsll((unsigned long long)b1) - 1;
                idx = 64 + l;
                if (lane == l) v1 = -3.0e38f;
            }
            if (lane == 0) sel[k] = idx;
        }
    }
    __syncthreads();

    m = NEGV;
    for (int si = 0; si < 16; ++si) {
        const int blk = sel[si];
        const int key = blk * 64 + lane;
        float s = NEGV;
        if (blk * 64 <= t) {
            if (key <= t) s = dot64_bf(qs, KSb + ((size_t)b * SEQ + key) * 128 + g * 64);
        }
        sc[si * 64 + lane] = s;
        m = fmaxf(m, s);
    }
    m = wave_max(m);
    sum = 0.f;
    for (int si = 0; si < 16; ++si) {
        const int key = sel[si] * 64 + lane;
        const float e = (key <= t) ? expf(sc[si * 64 + lane] - m) : 0.f;
        sc[si * 64 + lane] = e;
        sum += e;
    }
    sum = wave_sum(sum);
    {
        const float inv = 1.f / fmaxf(sum, 1e-30f);
        for (int si = 0; si < 16; ++si) sc[si * 64 + lane] *= inv;
    }
    __syncthreads();
    float os = 0.f;
    for (int si = 0; si < 16; ++si) {
        const int blk = sel[si];
        if (blk * 64 > t) continue;
        for (int kk = 0; kk < 64; ++kk) {
            const int key = blk * 64 + kk;
            if (key > t) break;
            os += sc[si * 64 + kk] * bf2f(VSb[((size_t)b * SEQ + key) * 128 + g * 64 + lane]);
        }
    }
    __syncthreads();

    const int lo = t - 511;
    m = NEGV;
    for (int i = 0; i < 8; ++i) {
        const int key = lo + i * 64 + lane;
        float s = NEGV;
        if (key >= 0) s = dot64_bf(qs, KWb + ((size_t)b * SEQ + key) * 128 + g * 64);
        sc[i * 64 + lane] = s;
        m = fmaxf(m, s);
    }
    m = wave_max(m);
    sum = 0.f;
    for (int i = 0; i < 8; ++i) {
        const int key = lo + i * 64 + lane;
        const float e = (key >= 0) ? expf(sc[i * 64 + lane] - m) : 0.f;
        sc[i * 64 + lane] = e;
        sum += e;
    }
    sum = wave_sum(sum);
    {
        const float inv = 1.f / fmaxf(sum, 1e-30f);
        for (int i = 0; i < 8; ++i) sc[i * 64 + lane] *= inv;
    }
    __syncthreads();
    float ow = 0.f;
    for (int idx = 0; idx < 512; ++idx) {
        const int key = lo + idx;
        if (key < 0) continue;
        ow += sc[idx] * bf2f(VWb[((size_t)b * SEQ + key) * 128 + g * 64 + lane]);
    }
    const float* grow = (const float*)(p.ws + OFF_NGATE) + n * 24 + g * 12 + r * 3;
    const float gc = grow[0], gs = grow[1], gw = grow[2];
#if NSA_DIAG
    {
        const float ref = gc * oc + gs * os + gw * ow;
        const float got = bf2f(((const bf16_t*)(p.ws + OFF_XB))[n * DM + 512 + g * 256 + r * 64 + lane]);
        const unsigned* SELM = (const unsigned*)(p.ws + OFF_SELM) + ((size_t)(b * 2 + g) * SEQ + t) * 4;
        unsigned gm[4] = {0u, 0u, 0u, 0u};
        for (int si = 0; si < 16; ++si) { const int blk = sel[si]; if (blk * 64 <= t) gm[blk >> 5] |= 1u << (blk & 31); }
        bool same = true;
        for (int qd = 0; qd < 4; ++qd) {
            unsigned mm = SELM[qd];
            for (int bit = 0; bit < 32; ++bit) if ((qd * 32 + bit) * 64 > t) mm &= ~(1u << bit);
            if (mm != gm[qd]) same = false;
        }
        float d2 = same ? (got - ref) * (got - ref) : 0.f, r2 = same ? ref * ref : 0.f;
        d2 = wave_sum(d2); r2 = wave_sum(r2);
        float* DG = (float*)(p.ws + OFF_DIAG);
        if (lane == 0) { atomicAdd(&DG[0], d2); atomicAdd(&DG[1], r2); if (r == 0) { atomicAdd(&DG[2], same ? 0.f : 1.f); atomicAdd(&DG[3], 1.f); } }
    }
#else
    ((bf16_t*)(p.ws + OFF_XB))[n * DM + 512 + g * 256 + r * 64 + lane] = (bf16_t)f2bf(gc * oc + gs * os + gw * ow);
#endif
}


__device__ __forceinline__ float xrow_max(float x) {
    auto s = __builtin_amdgcn_permlane16_swap(__float_as_uint(x), __float_as_uint(x), false, false);
    x = fmaxf(__uint_as_float(s[0]), __uint_as_float(s[1]));
    auto t = __builtin_amdgcn_permlane32_swap(__float_as_uint(x), __float_as_uint(x), false, false);
    return fmaxf(__uint_as_float(t[0]), __uint_as_float(t[1]));
}
__device__ __forceinline__ float xrow_sum(float x) {
    auto s = __builtin_amdgcn_permlane16_swap(__float_as_uint(x), __float_as_uint(x), false, false);
    x = __uint_as_float(s[0]) + __uint_as_float(s[1]);
    auto t = __builtin_amdgcn_permlane32_swap(__float_as_uint(x), __float_as_uint(x), false, false);
    return __uint_as_float(t[0]) + __uint_as_float(t[1]);
}
template <int CTRL> __device__ __forceinline__ float dppf(float x) {
    return __builtin_bit_cast(float, __builtin_amdgcn_mov_dpp(__builtin_bit_cast(int, x), CTRL, 0xf, 0xf, true));
}
__device__ __forceinline__ float row16_max(float m) {
    m = fmaxf(m, dppf<0x121>(m)); m = fmaxf(m, dppf<0x122>(m));
    m = fmaxf(m, dppf<0x124>(m)); m = fmaxf(m, dppf<0x128>(m));
    return m;
}
__device__ __forceinline__ float row16_sum(float m) {
    m += dppf<0x121>(m); m += dppf<0x122>(m); m += dppf<0x124>(m); m += dppf<0x128>(m);
    return m;
}
__device__ __forceinline__ float dot2bf(unsigned a, unsigned b, float acc) {
    return __builtin_amdgcn_fdot2_f32_bf16(__builtin_bit_cast(bf16x2_t, a), __builtin_bit_cast(bf16x2_t, b), acc, false);
}
__device__ __forceinline__ float enc_key(float v, unsigned idx, unsigned mask) {
    const unsigned u = __float_as_uint(v);
    const unsigned code = (u >> 31) ? idx : (mask - idx);
    return __uint_as_float((u & ~mask) | code);
}
__device__ __forceinline__ unsigned dec_idx(float key, unsigned mask) {
    const unsigned u = __float_as_uint(key);
    const unsigned code = u & mask;
    return (u >> 31) ? code : (mask - code);
}
__device__ __forceinline__ float dec_val(float key, unsigned mask) { return __uint_as_float(__float_as_uint(key) & ~mask); }
#define NEGKEY (-3.0e38f)
#define CE_DESC(a, b) { const float t_ = fmaxf(a, b); b = fminf(a, b); a = t_; }

struct EpiCmpH {
    bf16_t* HB; const float* peb;
    __device__ __forceinline__ void operator()(int m, int n, f32x4 v) const {
        const float4 pb = *(const float4*)(peb + n);
        uint2 o;
        o.x = pack2bf(gelu_tanh(v[0] + pb.x), gelu_tanh(v[1] + pb.y));
        o.y = pack2bf(gelu_tanh(v[2] + pb.z), gelu_tanh(v[3] + pb.w));
        *(uint2*)(HB + (size_t)m * 256 + n) = o;
    }
    __device__ __forceinline__ void finish(int, int) const {}
};
__device__ __forceinline__ void cmp_peb(const Params& p, int which) {
    const float* pe = p.in[which ? 10 : 5];
    const float* w1 = p.in[which ? 11 : 6];
    const float* b1 = p.in[which ? 12 : 7];
    const int j = threadIdx.x;
    float acc = b1[j];
    for (int i = 0; i < 2048; ++i) acc += pe[i] * w1[(size_t)i * 256 + j];
    ((float*)(p.ws + OFF_PEB))[which * 256 + j] = acc;
}
__device__ __forceinline__ void cmp_layer2_phase(const Params& p, int first_block, int nblocks) {
    const int tid_ = opaque_tid(), lane = tid_ & 63, w = __builtin_amdgcn_readfirstlane(tid_ >> 6);
    for (int it = (blockIdx.x - first_block) * 4 + w; it < 2 * 4088; it += nblocks * 4) {
        const int which = it >= 4088, row = which ? it - 4088 : it;
        const float* w2 = p.in[which ? 13 : 8];
        const float* b2 = p.in[which ? 14 : 9];
        const bf16_t* hrow = (const bf16_t*)(p.ws + OFF_HB) + ((size_t)which * 4096 + row) * 256;
        float o = b2[lane];
#pragma unroll 8
        for (int j = 0; j < 256; ++j) o += bf2f(hrow[j]) * w2[j * 64 + lane];
        const int g = row & 1, bn = row >> 1, n = bn % NCB, b = bn / NCB;
        ((bf16_t*)(p.ws + (which ? OFF_CMPVB : OFF_CMPKB)))[((size_t)(b * 2 + g) * 512 + n) * 64 + lane] = (bf16_t)f2bf(o);
    }
}

struct StageOfs { int k, v; };
__device__ __forceinline__ StageOfs make_stage_ofs() {
    const int c0 = opaque_tid(), key = c0 >> 3, ch = c0 & 7;
    StageOfs s;
    s.k = key * 128 + ((ch ^ (key & 7)) << 4);
    s.v = key * 128 + (((ch >> 1) ^ ((key >> 1) & 3)) << 5) + (ch & 1) * 16;
    return s;
}
#define NSA_KV_LOAD(S_, kb_) { const bf16_t* kp_ = Kbase + (size_t)(kb_) * 64 * stride + (size_t)(tid >> 3) * stride + (tid & 7) * 8; \
        const bf16_t* vp_ = Vbase + (size_t)(kb_) * 64 * stride + (size_t)(tid >> 3) * stride + (tid & 7) * 8;                 \
        S_##k0 = *(const uint4*)kp_; S_##k1 = *(const uint4*)(kp_ + (size_t)32 * stride);                                    \
        S_##v0 = *(const uint4*)vp_; S_##v1 = *(const uint4*)(vp_ + (size_t)32 * stride); }
#define NSA_KV_STORE(S_, Kl_, Vl_) { *(uint4*)((Kl_) + sof.k) = S_##k0; *(uint4*)((Kl_) + sof.k + 4096) = S_##k1; \
        *(uint4*)((Vl_) + sof.v) = S_##v0; *(uint4*)((Vl_) + sof.v + 4096) = S_##v1; }
template <class Compute>
__device__ __forceinline__ void nsa_kv_loop(const bf16_t* __restrict__ Kbase, const bf16_t* __restrict__ Vbase, int stride,
                                            int kb_lo, int kb_hi, unsigned char* smem, const StageOfs& sof, Compute compute) {
    const int tid = opaque_tid();
    uint4 ra_k0, ra_k1, ra_v0, ra_v1;
    NSA_KV_LOAD(ra_, kb_lo)
    __syncthreads();
    NSA_KV_STORE(ra_, smem, smem + 16384)
    __syncthreads();
    for (int kb = kb_lo; kb <= kb_hi; ++kb) {
        const int buf = (kb - kb_lo) & 1;
        if (kb < kb_hi) NSA_KV_LOAD(ra_, kb + 1)
        compute(kb, smem + buf * 8192, smem + 16384 + buf * 8192);
        if (kb < kb_hi) NSA_KV_STORE(ra_, smem + (buf ^ 1) * 8192, smem + 16384 + (buf ^ 1) * 8192)
        __syncthreads();
    }
}
struct LaneOfs { int k0, k1, vb0, vb1, vb2, vb3; };
__device__ __forceinline__ LaneOfs make_lane_ofs(int lane) {
    LaneOfs f;
    const int r15 = lane & 15, lg = lane >> 4, q = r15 >> 2, pp = r15 & 3;
    f.k0 = r15 * 128 + ((lg ^ (r15 & 7)) << 4);
    f.k1 = r15 * 128 + (((4 + lg) ^ (r15 & 7)) << 4);
    const int sw2 = (2 * (lg & 1) + (q >> 1)) & 3;
    const int vrow = (4 * lg + q) * 128 + pp * 8;
    f.vb0 = vrow + ((0 ^ sw2) << 5); f.vb1 = vrow + ((1 ^ sw2) << 5);
    f.vb2 = vrow + ((2 ^ sw2) << 5); f.vb3 = vrow + ((3 ^ sw2) << 5);
    return f;
}
typedef short s16x4 __attribute__((ext_vector_type(4)));
__device__ __forceinline__ uint2 tr_read(const unsigned char* p) {
    const s16x4 v = __builtin_amdgcn_ds_read_tr16_b64_v4i16((LAS3 s16x4*)p);
    return __builtin_bit_cast(uint2, v);
}
#define NEGM (-1.0e37f)
__device__ __forceinline__ void nsa_scores(const unsigned char* Kl, const LaneOfs& f, const bf16x8& q0, const bf16x8& q1, float bias, f32x4 (&s)[4]) {
#pragma unroll
    for (int kt = 0; kt < 4; ++kt) {
        const bf16x8 a0 = *(const bf16x8*)(Kl + f.k0 + kt * 2048);
        const bf16x8 a1 = *(const bf16x8*)(Kl + f.k1 + kt * 2048);
        f32x4 z = (f32x4){bias, bias, bias, bias};
        z = __builtin_amdgcn_mfma_f32_16x16x32_bf16(a0, q0, z, 0, 0, 0);
        s[kt] = __builtin_amdgcn_mfma_f32_16x16x32_bf16(a1, q1, z, 0, 0, 0);
    }
}
#define ONES_BF16X8 __builtin_bit_cast(bf16x8, make_uint4(0x3F803F80u, 0x3F803F80u, 0x3F803F80u, 0x3F803F80u))
template <class VF>
__device__ __forceinline__ void attn_step(const unsigned char* Kl, const unsigned char* Vl, int lane, const LaneOfs& f,
                                          const bf16x8& q0, const bf16x8& q1, f32x4 (&o)[4], float& m, f32x4& lacc,
                                          float rowbias, bool full, VF valid) {
    f32x4 s[4];
    const bool mok = m > -1e29f;
    const float meff = mok ? m : 0.f;
    nsa_scores(Kl, f, q0, q1, rowbias - meff, s);
    if (!full) {
#pragma unroll
        for (int kt = 0; kt < 4; ++kt)
#pragma unroll
            for (int r = 0; r < 4; ++r) s[kt][r] = valid(kt * 16 + 4 * (lane >> 4) + r) ? s[kt][r] : NEGM;
    }
    float mx = fmaxf(fmaxf(fmaxf(s[0][0], s[0][1]), fmaxf(s[0][2], s[0][3])), fmaxf(fmaxf(s[1][0], s[1][1]), fmaxf(s[1][2], s[1][3])));
    mx = fmaxf(mx, fmaxf(fmaxf(fmaxf(s[2][0], s[2][1]), fmaxf(s[2][2], s[2][3])), fmaxf(fmaxf(s[3][0], s[3][1]), fmaxf(s[3][2], s[3][3]))));
    mx = xrow_max(mx);
    if (!__all(mok && (mx <= 8.f))) {
        const float mn = fmaxf(m, meff + mx);
        const float alpha = __builtin_amdgcn_exp2f(m - mn), d = mn - meff;
        m = mn; lacc[0] *= alpha;
#pragma unroll
        for (int dt = 0; dt < 4; ++dt) { o[dt][0] *= alpha; o[dt][1] *= alpha; o[dt][2] *= alpha; o[dt][3] *= alpha; }
#pragma unroll
        for (int kt = 0; kt < 4; ++kt) { s[kt][0] -= d; s[kt][1] -= d; s[kt][2] -= d; s[kt][3] -= d; }
    }
#pragma unroll
    for (int kt = 0; kt < 4; ++kt)
#pragma unroll
        for (int r = 0; r < 4; ++r) s[kt][r] = __builtin_amdgcn_exp2f(s[kt][r]);
#pragma unroll
    for (int k2 = 0; k2 < 2; ++k2) {
        uint4 pk;
        pk.x = pack2bf(s[2 * k2][0], s[2 * k2][1]); pk.y = pack2bf(s[2 * k2][2], s[2 * k2][3]);
        pk.z = pack2bf(s[2 * k2 + 1][0], s[2 * k2 + 1][1]); pk.w = pack2bf(s[2 * k2 + 1][2], s[2 * k2 + 1][3]);
        const bf16x8 pb = __builtin_bit_cast(bf16x8, pk);
        lacc = __builtin_amdgcn_mfma_f32_16x16x32_bf16(ONES_BF16X8, pb, lacc, 0, 0, 0);
#define PV1(dt_, vb_) { const uint2 lo_ = tr_read(Vl + (vb_) + k2 * 4096), hi_ = tr_read(Vl + (vb_) + k2 * 4096 + 2048); \
                        uint4 av_; av_.x = lo_.x; av_.y = lo_.y; av_.z = hi_.x; av_.w = hi_.y;                          \
                        o[dt_] = __builtin_amdgcn_mfma_f32_16x16x32_bf16(__builtin_bit_cast(bf16x8, av_), pb, o[dt_], 0, 0, 0); }
        PV1(0, f.vb0) PV1(1, f.vb1) PV1(2, f.vb2) PV1(3, f.vb3)
#undef PV1
    }
}
template <class VFA, class VFB>
__device__ __forceinline__ void attn_step2(const unsigned char* Kl, const unsigned char* Vl, int lane, const LaneOfs& f,
                                           const bf16x8& qA0, const bf16x8& qA1, f32x4 (&oA)[4], float& mA, f32x4& lA, float biasA, bool fullA, VFA validA,
                                           const bf16x8& qB0, const bf16x8& qB1, f32x4 (&oB)[4], float& mB, f32x4& lB, float biasB, bool fullB, VFB validB) {
    f32x4 sA[4], sB[4];
    const bool mokA = mA > -1e29f, mokB = mB > -1e29f;
    const float meA = mokA ? mA : 0.f, meB = mokB ? mB : 0.f;
    const float iA = biasA - meA, iB = biasB - meB;
#pragma unroll
    for (int kt = 0; kt < 4; ++kt) {
        const bf16x8 a0 = *(const bf16x8*)(Kl + f.k0 + kt * 2048);
        const bf16x8 a1 = *(const bf16x8*)(Kl + f.k1 + kt * 2048);
        f32x4 zA = (f32x4){iA, iA, iA, iA}, zB = (f32x4){iB, iB, iB, iB};
        zA = __builtin_amdgcn_mfma_f32_16x16x32_bf16(a0, qA0, zA, 0, 0, 0);
        zB = __builtin_amdgcn_mfma_f32_16x16x32_bf16(a0, qB0, zB, 0, 0, 0);
        sA[kt] = __builtin_amdgcn_mfma_f32_16x16x32_bf16(a1, qA1, zA, 0, 0, 0);
        sB[kt] = __builtin_amdgcn_mfma_f32_16x16x32_bf16(a1, qB1, zB, 0, 0, 0);
    }
    if (!fullA) {
#pragma unroll
        for (int kt = 0; kt < 4; ++kt)
#pragma unroll
            for (int r = 0; r < 4; ++r) sA[kt][r] = validA(kt * 16 + 4 * (lane >> 4) + r) ? sA[kt][r] : NEGM;
    }
    if (!fullB) {
#pragma unroll
        for (int kt = 0; kt < 4; ++kt)
#pragma unroll
            for (int r = 0; r < 4; ++r) sB[kt][r] = validB(kt * 16 + 4 * (lane >> 4) + r) ? sB[kt][r] : NEGM;
    }
    float mxA = fmaxf(fmaxf(fmaxf(sA[0][0], sA[0][1]), fmaxf(sA[0][2], sA[0][3])), fmaxf(fmaxf(sA[1][0], sA[1][1]), fmaxf(sA[1][2], sA[1][3])));
    float mxB = fmaxf(fmaxf(fmaxf(sB[0][0], sB[0][1]), fmaxf(sB[0][2], sB[0][3])), fmaxf(fmaxf(sB[1][0], sB[1][1]), fmaxf(sB[1][2], sB[1][3])));
    mxA = fmaxf(mxA, fmaxf(fmaxf(fmaxf(sA[2][0], sA[2][1]), fmaxf(sA[2][2], sA[2][3])), fmaxf(fmaxf(sA[3][0], sA[3][1]), fmaxf(sA[3][2], sA[3][3]))));
    mxB = fmaxf(mxB, fmaxf(fmaxf(fmaxf(sB[2][0], sB[2][1]), fmaxf(sB[2][2], sB[2][3])), fmaxf(fmaxf(sB[3][0], sB[3][1]), fmaxf(sB[3][2], sB[3][3]))));
    mxA = xrow_max(mxA); mxB = xrow_max(mxB);
    if (!__all(mokA && mokB && (mxA <= 8.f) && (mxB <= 8.f))) {
        const float mnA = fmaxf(mA, meA + mxA), mnB = fmaxf(mB, meB + mxB);
        const float alA = __builtin_amdgcn_exp2f(mA - mnA), alB = __builtin_amdgcn_exp2f(mB - mnB);
        const float dA = mnA - meA, dB = mnB - meB;
        mA = mnA; mB = mnB; lA[0] *= alA; lB[0] *= alB;
#pragma unroll
        for (int dt = 0; dt < 4; ++dt) {
            oA[dt][0] *= alA; oA[dt][1] *= alA; oA[dt][2] *= alA; oA[dt][3] *= alA;
            oB[dt][0] *= alB; oB[dt][1] *= alB; oB[dt][2] *= alB; oB[dt][3] *= alB;
        }
#pragma unroll
        for (int kt = 0; kt < 4; ++kt) {
            sA[kt][0] -= dA; sA[kt][1] -= dA; sA[kt][2] -= dA; sA[kt][3] -= dA;
            sB[kt][0] -= dB; sB[kt][1] -= dB; sB[kt][2] -= dB; sB[kt][3] -= dB;
        }
    }
#pragma unroll
    for (int kt = 0; kt < 4; ++kt)
#pragma unroll
        for (int r = 0; r < 4; ++r) { sA[kt][r] = __builtin_amdgcn_exp2f(sA[kt][r]); sB[kt][r] = __builtin_amdgcn_exp2f(sB[kt][r]); }
#pragma unroll
    for (int k2 = 0; k2 < 2; ++k2) {
        uint4 pk;
        pk.x = pack2bf(sA[2 * k2][0], sA[2 * k2][1]); pk.y = pack2bf(sA[2 * k2][2], sA[2 * k2][3]);
        pk.z = pack2bf(sA[2 * k2 + 1][0], sA[2 * k2 + 1][1]); pk.w = pack2bf(sA[2 * k2 + 1][2], sA[2 * k2 + 1][3]);
        const bf16x8 pbA = __builtin_bit_cast(bf16x8, pk);
        pk.x = pack2bf(sB[2 * k2][0], sB[2 * k2][1]); pk.y = pack2bf(sB[2 * k2][2], sB[2 * k2][3]);
        pk.z = pack2bf(sB[2 * k2 + 1][0], sB[2 * k2 + 1][1]); pk.w = pack2bf(sB[2 * k2 + 1][2], sB[2 * k2 + 1][3]);
        const bf16x8 pbB = __builtin_bit_cast(bf16x8, pk);
        lA = __builtin_amdgcn_mfma_f32_16x16x32_bf16(ONES_BF16X8, pbA, lA, 0, 0, 0);
        lB = __builtin_amdgcn_mfma_f32_16x16x32_bf16(ONES_BF16X8, pbB, lB, 0, 0, 0);
#define PV2(dt_, vb_) { const uint2 lo_ = tr_read(Vl + (vb_) + k2 * 4096), hi_ = tr_read(Vl + (vb_) + k2 * 4096 + 2048); \
                        uint4 av_; av_.x = lo_.x; av_.y = lo_.y; av_.z = hi_.x; av_.w = hi_.y;                          \
                        oA[dt_] = __builtin_amdgcn_mfma_f32_16x16x32_bf16(__builtin_bit_cast(bf16x8, av_), pbA, oA[dt_], 0, 0, 0); \
                        oB[dt_] = __builtin_amdgcn_mfma_f32_16x16x32_bf16(__builtin_bit_cast(bf16x8, av_), pbB, oB[dt_], 0, 0, 0); }
        PV2(0, f.vb0) PV2(1, f.vb1) PV2(2, f.vb2) PV2(3, f.vb3)
#undef PV2
    }
}

#define NSA_TILES 2048
__device__ __forceinline__ void nsa_tile(const Params& p, int tile, unsigned char* smem) {
    const int tid = opaque_tid(), lane = tid & 63, w = __builtin_amdgcn_readfirstlane(tid >> 6);
    const int bg = tile & 7, tb = 255 - (tile >> 3);
    const int b = bg >> 1, g = bg & 1;
    const int t0 = tb * 32, cur = t0 >> 6;
    float* impL = (float*)(smem + 32768);
    unsigned* selL = (unsigned*)(smem + 49152);
    const bf16_t* NQ = (const bf16_t*)(p.ws + OFF_NQ);
    const float* NG = (const float*)(p.ws + OFF_NGATE);
    const int rowq = lane & 15, tl = rowq >> 2, head = rowq & 3, lg = lane >> 4;
    const int toklA = 8 * w + tl, toklB = 8 * w + 4 + tl;
    const LaneOfs lof = make_lane_ofs(lane);
    const StageOfs sof = make_stage_ofs();
    const size_t tokb = (size_t)b * SEQ + t0;
    bf16x8 qA0, qA1, qB0, qB1;
    {
        const bf16_t* qp = NQ + (tokb + toklA) * 512 + g * 256 + head * 64 + lg * 8;
        qA0 = *(const bf16x8*)qp; qA1 = *(const bf16x8*)(qp + 32);
        qB0 = *(const bf16x8*)(qp + 4 * 512); qB1 = *(const bf16x8*)(qp + 4 * 512 + 32);
    }
    const float* gpA = NG + (tokb + toklA) * 24 + g * 12 + head * 3;
    const float* gpB = gpA + 4 * 24;
    __syncthreads();
    for (int i = tid; i < 4096; i += 256) impL[i] = 0.f;
    const int tqA = t0 + toklA, tqB = t0 + toklB;
    const int tminA = t0 + 8 * w, tminB = tminA + 4;
    f32x4 oA[4], oB[4], otA[4], otB[4];
    float mA, mB;
    f32x4 lA, lB;
#define NSA_RESET() { _Pragma("unroll") for (int dt = 0; dt < 4; ++dt) { oA[dt] = (f32x4){0.f, 0.f, 0.f, 0.f}; oB[dt] = (f32x4){0.f, 0.f, 0.f, 0.f}; } \
                      mA = -1e30f; mB = -1e30f; lA = (f32x4){0.f, 0.f, 0.f, 0.f}; lB = (f32x4){0.f, 0.f, 0.f, 0.f}; }
#define NSA_LSUM() { }

    const int nvA = (tqA >= 31) ? (((tqA - 31) >> 4) + 1) : 0;
    const int nvB = (tqB >= 31) ? (((tqB - 31) >> 4) + 1) : 0;
    const int nvminA = (tminA >= 31) ? (((tminA - 31) >> 4) + 1) : 0;
    const int nvminB = (tminB >= 31) ? (((tminB - 31) >> 4) + 1) : 0;
    const int nkb = (((t0 >> 4) + 1) + 63) >> 6;
    const bf16_t* ckb = (const bf16_t*)(p.ws + OFF_CMPKB) + (size_t)(b * 2 + g) * 512 * 64;
    const bf16_t* cvb = (const bf16_t*)(p.ws + OFF_CMPVB) + (size_t)(b * 2 + g) * 512 * 64;
    NSA_RESET()
    nsa_kv_loop(ckb, cvb, 64, 0, nkb - 1, smem, sof, [&](int kb, const unsigned char* Kl, const unsigned char* Vl) __attribute__((always_inline)) {
        attn_step2(Kl, Vl, lane, lof,
                   qA0, qA1, oA, mA, lA, 0.f, kb * 64 + 64 <= nvminA, [&](int key) __attribute__((always_inline)) { return kb * 64 + key < nvA; },
                   qB0, qB1, oB, mB, lB, 0.f, kb * 64 + 64 <= nvminB, [&](int key) __attribute__((always_inline)) { return kb * 64 + key < nvB; });
    });
    NSA_LSUM()
    const float mcA = mA, mcB = mB;
    const float invcA = 1.f / fmaxf(lA[0], 1e-30f), invcB = 1.f / fmaxf(lB[0], 1e-30f);
    {
        const float fA = gpA[0] * invcA, fB = gpB[0] * invcB;
#pragma unroll
        for (int dt = 0; dt < 4; ++dt) {
            otA[dt][0] = fA * oA[dt][0]; otA[dt][1] = fA * oA[dt][1]; otA[dt][2] = fA * oA[dt][2]; otA[dt][3] = fA * oA[dt][3];
            otB[dt][0] = fB * oB[dt][0]; otB[dt][1] = fB * oB[dt][1]; otB[dt][2] = fB * oB[dt][2]; otB[dt][3] = fB * oB[dt][3];
        }
    }
    if (cur >= 16) {
        nsa_kv_loop(ckb, cvb, 64, 0, nkb - 1, smem, sof, [&](int kb, const unsigned char* Kl, const unsigned char* Vl) __attribute__((always_inline)) {
#pragma unroll
            for (int mt = 0; mt < 2; ++mt) {
                f32x4 s[4];
                nsa_scores(Kl, lof, mt ? qB0 : qA0, mt ? qB1 : qA1, 0.f, s);
                const int nv = mt ? nvB : nvA;
                const float mc = mt ? mcB : mcA, inv = mt ? invcB : invcA;
                float* impT = impL + (mt ? toklB : toklA) * 128;
#pragma unroll
                for (int kt = 0; kt < 4; ++kt) {
                    float pr[4];
#pragma unroll
                    for (int r = 0; r < 4; ++r) {
                        const int n = kb * 64 + kt * 16 + 4 * lg + r;
                        pr[r] = (n < nv) ? __builtin_amdgcn_exp2f(s[kt][r] - mc) * inv : 0.f;
                    }
                    float c1 = pr[0] + pr[1] + pr[2] + 0.5f * pr[3], c2 = 0.5f * pr[3];
                    c1 += __shfl_xor(c1, 1); c1 += __shfl_xor(c1, 2);
                    c2 += __shfl_xor(c2, 1); c2 += __shfl_xor(c2, 2);
                    const int j = kb * 16 + kt * 4 + lg;
                    if (head == 0) {
                        atomicAdd(&impT[j], c1);
                        if (j + 1 < 128) atomicAdd(&impT[j + 1], c2);
                    }
                }
                    }
        });
#pragma unroll 1
        for (int pass = 0; pass < 2; ++pass) {
            const int tok = 8 * w + 4 * pass + lg, c = lane & 15;
            const float4 i0 = *(const float4*)(impL + tok * 128 + 8 * c), i1 = *(const float4*)(impL + tok * 128 + 8 * c + 4);
            const float iv[8] = {i0.x, i0.y, i0.z, i0.w, i1.x, i1.y, i1.z, i1.w};
            float kl[8];
#pragma unroll
            for (int q = 0; q < 8; ++q) {
                const int j = 8 * c + q;
                const bool forced = (j == 0) || (j == cur) || (j == cur - 1);
                const float sc = forced ? 1.0e4f : ((j <= cur) ? iv[q] : -1.f);
                kl[q] = enc_key(sc, (unsigned)j, 127);
            }
            float l0 = kl[0], l1 = kl[1], l2 = kl[2], l3 = kl[3], l4 = kl[4], l5 = kl[5], l6 = kl[6], l7 = kl[7];
            CE_DESC(l0, l1) CE_DESC(l2, l3) CE_DESC(l4, l5) CE_DESC(l6, l7)
            CE_DESC(l0, l2) CE_DESC(l1, l3) CE_DESC(l4, l6) CE_DESC(l5, l7)
            CE_DESC(l1, l2) CE_DESC(l5, l6)
            CE_DESC(l0, l4) CE_DESC(l1, l5) CE_DESC(l2, l6) CE_DESC(l3, l7)
            CE_DESC(l2, l4) CE_DESC(l3, l5)
            CE_DESC(l1, l2) CE_DESC(l3, l4) CE_DESC(l5, l6)
            unsigned pm = 0u;
#pragma unroll
            for (int k = 0; k < 16; ++k) {
                const float mx = row16_max(l0);
                const bool win = (l0 == mx);
                pm |= win ? (1u << (dec_idx(l0, 127) & 7u)) : 0u;
                l0 = win ? l1 : l0; l1 = win ? l2 : l1; l2 = win ? l3 : l2; l3 = win ? l4 : l3;
                l4 = win ? l5 : l4; l5 = win ? l6 : l5; l6 = win ? l7 : l6; l7 = win ? NEGKEY : l7;
            }
            ((unsigned char*)selL)[tok * 16 + c] = (unsigned char)pm;
        }
    } else {
        if (lane < 8) {
            const int tok = 8 * w + lane;
            selL[tok * 4 + 0] = (2u << cur) - 1u; selL[tok * 4 + 1] = 0u; selL[tok * 4 + 2] = 0u; selL[tok * 4 + 3] = 0u;
        }
    }
    WAVE_LDS_SYNC();
#if NSA_DIAG
    if (head == 0 && lg == 0) {
        unsigned* SELM = (unsigned*)(p.ws + OFF_SELM);
#pragma unroll
        for (int qd = 0; qd < 4; ++qd) {
            SELM[((size_t)bg * SEQ + tqA) * 4 + qd] = selL[toklA * 4 + qd];
            SELM[((size_t)bg * SEQ + tqB) * 4 + qd] = selL[toklB * 4 + qd];
        }
    }
#endif
    NSA_RESET()
    {
        const bf16_t* kg = (const bf16_t*)(p.ws + OFF_KV + 2 * KV_STRIDE) + (size_t)b * SEQ * 128 + g * 64;
        const bf16_t* vg = (const bf16_t*)(p.ws + OFF_KV + 3 * KV_STRIDE) + (size_t)b * SEQ * 128 + g * 64;
        nsa_kv_loop(kg, vg, 128, 0, cur, smem, sof, [&](int kb, const unsigned char* Kl, const unsigned char* Vl) __attribute__((always_inline)) {
            const bool svA = (selL[toklA * 4 + (kb >> 5)] >> (kb & 31)) & 1u;
            const bool svB = (selL[toklB * 4 + (kb >> 5)] >> (kb & 31)) & 1u;
            const bool nA = __ballot(svA) != 0ull, nB = __ballot(svB) != 0ull;
            if (nA && nB)
                attn_step2(Kl, Vl, lane, lof,
                           qA0, qA1, oA, mA, lA, svA ? 0.f : NEGM, kb < cur, [&](int key) __attribute__((always_inline)) { return kb * 64 + key <= tqA; },
                           qB0, qB1, oB, mB, lB, svB ? 0.f : NEGM, kb < cur, [&](int key) __attribute__((always_inline)) { return kb * 64 + key <= tqB; });
            else if (nA)
                attn_step(Kl, Vl, lane, lof, qA0, qA1, oA, mA, lA, svA ? 0.f : NEGM, kb < cur, [&](int key) __attribute__((always_inline)) { return kb * 64 + key <= tqA; });
            else if (nB)
                attn_step(Kl, Vl, lane, lof, qB0, qB1, oB, mB, lB, svB ? 0.f : NEGM, kb < cur, [&](int key) __attribute__((always_inline)) { return kb * 64 + key <= tqB; });
        });
    }
    NSA_LSUM()
    {
        const float fA = gpA[1] / fmaxf(lA[0], 1e-30f), fB = gpB[1] / fmaxf(lB[0], 1e-30f);
#pragma unroll
        for (int dt = 0; dt < 4; ++dt) {
            otA[dt][0] += fA * oA[dt][0]; otA[dt][1] += fA * oA[dt][1]; otA[dt][2] += fA * oA[dt][2]; otA[dt][3] += fA * oA[dt][3];
            otB[dt][0] += fB * oB[dt][0]; otB[dt][1] += fB * oB[dt][1]; otB[dt][2] += fB * oB[dt][2]; otB[dt][3] += fB * oB[dt][3];
        }
    }
    NSA_RESET()
    {
        const bf16_t* kg = (const bf16_t*)(p.ws + OFF_KV + 4 * KV_STRIDE) + (size_t)b * SEQ * 128 + g * 64;
        const bf16_t* vg = (const bf16_t*)(p.ws + OFF_KV + 5 * KV_STRIDE) + (size_t)b * SEQ * 128 + g * 64;
        const int klo = (t0 > 511) ? ((t0 - 511) >> 6) : 0;
        nsa_kv_loop(kg, vg, 128, klo, cur, smem, sof, [&](int kb, const unsigned char* Kl, const unsigned char* Vl) __attribute__((always_inline)) {
            attn_step2(Kl, Vl, lane, lof,
                       qA0, qA1, oA, mA, lA, 0.f, (kb * 64 >= tminA + 3 - 511) && (kb * 64 + 63 <= tminA),
                       [&](int key) __attribute__((always_inline)) { const int ka = kb * 64 + key; return (ka <= tqA) && (ka >= tqA - 511); },
                       qB0, qB1, oB, mB, lB, 0.f, (kb * 64 >= tminB + 3 - 511) && (kb * 64 + 63 <= tminB),
                       [&](int key) __attribute__((always_inline)) { const int ka = kb * 64 + key; return (ka <= tqB) && (ka >= tqB - 511); });
        });
    }
    NSA_LSUM()
    {
        const float fA = gpA[2] / fmaxf(lA[0], 1e-30f), fB = gpB[2] / fmaxf(lB[0], 1e-30f);
        bf16_t* MIX = (bf16_t*)(p.ws + OFF_XB) + (tokb + toklA) * DM + 512 + g * 256 + head * 64 + lg * 4;
#pragma unroll
        for (int dt = 0; dt < 4; ++dt) {
            uint2 ov;
            ov.x = pack2bf(otA[dt][0] + fA * oA[dt][0], otA[dt][1] + fA * oA[dt][1]);
            ov.y = pack2bf(otA[dt][2] + fA * oA[dt][2], otA[dt][3] + fA * oA[dt][3]);
            *(uint2*)(MIX + dt * 16) = ov;
            ov.x = pack2bf(otB[dt][0] + fB * oB[dt][0], otB[dt][1] + fB * oB[dt][1]);
            ov.y = pack2bf(otB[dt][2] + fB * oB[dt][2], otB[dt][3] + fB * oB[dt][3]);
            *(uint2*)(MIX + 4 * DM + dt * 16) = ov;
        }
    }
#undef NSA_RESET
#undef NSA_LSUM
}

__device__ __forceinline__ float block_sum(float v, float* red) {
    v = wave_sum(v);
    __syncthreads();
    if ((threadIdx.x & 63) == 0) red[threadIdx.x >> 6] = v;
    __syncthreads();
    return red[0] + red[1] + red[2] + red[3];
}
__device__ __forceinline__ float4 ln_row(float4 y, const float* g, const float* bb, float* red) {
    const int tid = opaque_tid();
    const float mu = block_sum(y.x + y.y + y.z + y.w, red) * (1.f / 1024.f);
    const float dx = y.x - mu, dy = y.y - mu, dz = y.z - mu, dw = y.w - mu;
    const float var = block_sum(dx * dx + dy * dy + dz * dz + dw * dw, red) * (1.f / 1024.f);
    const float rs = rsqrtf(var + LN_EPS);
    const float4 gg = ((const float4*)g)[tid], b4 = ((const float4*)bb)[tid];
    return make_float4(dx * rs * gg.x + b4.x, dy * rs * gg.y + b4.y, dz * rs * gg.z + b4.z, dw * rs * gg.w + b4.w);
}

__device__ __forceinline__ void ln1_phase(const Params& p, float* sm) {
    const int tid = opaque_tid(), lane = tid & 63, w = __builtin_amdgcn_readfirstlane(tid >> 6);
    const float4* g4 = (const float4*)(p.in[15] + 16 * lane);
    const float4* b4 = (const float4*)(p.in[16] + 16 * lane);
    const float4 ga = g4[0], gb = g4[1], gc = g4[2], gd = g4[3];
    const float4 ba = b4[0], bb = b4[1], bc = b4[2], bd = b4[3];
#pragma unroll 2
    for (int n = blockIdx.x * 4 + w; n < NTOK; n += gridDim.x * 4) {
        const float4* xr = (const float4*)(p.in[0] + (size_t)n * DM + 16 * lane);
        const uint4* mr = (const uint4*)((const bf16_t*)p.out + (size_t)n * DM + 16 * lane);
        const float4 y0 = xr[0], y1 = xr[1], y2 = xr[2], y3 = xr[3];
        const uint4 m0 = mr[0], m1 = mr[1];
        float y[16] = {ALPHA * y0.x + bf2f(m0.x & 0xffffu), ALPHA * y0.y + bf2f(m0.x >> 16), ALPHA * y0.z + bf2f(m0.y & 0xffffu), ALPHA * y0.w + bf2f(m0.y >> 16),
                       ALPHA * y1.x + bf2f(m0.z & 0xffffu), ALPHA * y1.y + bf2f(m0.z >> 16), ALPHA * y1.z + bf2f(m0.w & 0xffffu), ALPHA * y1.w + bf2f(m0.w >> 16),
                       ALPHA * y2.x + bf2f(m1.x & 0xffffu), ALPHA * y2.y + bf2f(m1.x >> 16), ALPHA * y2.z + bf2f(m1.y & 0xffffu), ALPHA * y2.w + bf2f(m1.y >> 16),
                       ALPHA * y3.x + bf2f(m1.z & 0xffffu), ALPHA * y3.y + bf2f(m1.z >> 16), ALPHA * y3.z + bf2f(m1.w & 0xffffu), ALPHA * y3.w + bf2f(m1.w >> 16)};
        const float g[16] = {ga.x, ga.y, ga.z, ga.w, gb.x, gb.y, gb.z, gb.w, gc.x, gc.y, gc.z, gc.w, gd.x, gd.y, gd.z, gd.w};
        const float bv[16] = {ba.x, ba.y, ba.z, ba.w, bb.x, bb.y, bb.z, bb.w, bc.x, bc.y, bc.z, bc.w, bd.x, bd.y, bd.z, bd.w};
        float sum = 0.f;
#pragma unroll
        for (int q = 0; q < 16; ++q) sum += y[q];
        const float mu = wave_sum(sum) * (1.f / 1024.f);
        float sq = 0.f;
#pragma unroll
        for (int q = 0; q < 16; ++q) { y[q] -= mu; sq += y[q] * y[q]; }
        const float rs = rsqrtf(wave_sum(sq) * (1.f / 1024.f) + LN_EPS);
        uint4 o0, o1;
        o0.x = pack2bf(y[0] * rs * g[0] + bv[0], y[1] * rs * g[1] + bv[1]);     o0.y = pack2bf(y[2] * rs * g[2] + bv[2], y[3] * rs * g[3] + bv[3]);
        o0.z = pack2bf(y[4] * rs * g[4] + bv[4], y[5] * rs * g[5] + bv[5]);     o0.w = pack2bf(y[6] * rs * g[6] + bv[6], y[7] * rs * g[7] + bv[7]);
        o1.x = pack2bf(y[8] * rs * g[8] + bv[8], y[9] * rs * g[9] + bv[9]);     o1.y = pack2bf(y[10] * rs * g[10] + bv[10], y[11] * rs * g[11] + bv[11]);
        o1.z = pack2bf(y[12] * rs * g[12] + bv[12], y[13] * rs * g[13] + bv[13]); o1.w = pack2bf(y[14] * rs * g[14] + bv[14], y[15] * rs * g[15] + bv[15]);
        uint4* hb = (uint4*)((bf16_t*)(p.ws + OFF_XB) + (size_t)n * DM + 16 * lane);
        hb[0] = o0; hb[1] = o1;
    }
}


typedef float f32x2 __attribute__((ext_vector_type(2)));
__device__ __forceinline__ void cvt_rows_fp8(const float* __restrict__ src, unsigned char* __restrict__ dst, float* __restrict__ scales, int rows,
                                             int first_block, int nblocks) {
    const int tid_ = opaque_tid(), lane = tid_ & 63, w = __builtin_amdgcn_readfirstlane(tid_ >> 6);
    for (int r = ((int)blockIdx.x - first_block) * 4 + w; r < rows; r += nblocks * 4) {
        const float4* sp = (const float4*)(src + (size_t)r * 1024 + lane * 16);
        const float4 a = sp[0], b = sp[1], c = sp[2], d = sp[3];
        float mx = fmaxf(fmaxf(fmaxf(fabsf(a.x), fabsf(a.y)), fmaxf(fabsf(a.z), fabsf(a.w))), fmaxf(fmaxf(fabsf(b.x), fabsf(b.y)), fmaxf(fabsf(b.z), fabsf(b.w))));
        mx = fmaxf(mx, fmaxf(fmaxf(fmaxf(fabsf(c.x), fabsf(c.y)), fmaxf(fabsf(c.z), fabsf(c.w))), fmaxf(fmaxf(fabsf(d.x), fabsf(d.y)), fmaxf(fabsf(d.z), fabsf(d.w)))));
        mx = wave_max(mx);
        const float sc = (mx > 0.f) ? mx * (1.f / 448.f) : 1.f;
        const float inv = 1.f / sc;
        uint4 o;
        int t;
        t = 0; t = __builtin_amdgcn_cvt_pk_fp8_f32(a.x * inv, a.y * inv, t, false); t = __builtin_amdgcn_cvt_pk_fp8_f32(a.z * inv, a.w * inv, t, true); o.x = (unsigned)t;
        t = 0; t = __builtin_amdgcn_cvt_pk_fp8_f32(b.x * inv, b.y * inv, t, false); t = __builtin_amdgcn_cvt_pk_fp8_f32(b.z * inv, b.w * inv, t, true); o.y = (unsigned)t;
        t = 0; t = __builtin_amdgcn_cvt_pk_fp8_f32(c.x * inv, c.y * inv, t, false); t = __builtin_amdgcn_cvt_pk_fp8_f32(c.z * inv, c.w * inv, t, true); o.z = (unsigned)t;
        t = 0; t = __builtin_amdgcn_cvt_pk_fp8_f32(d.x * inv, d.y * inv, t, false); t = __builtin_amdgcn_cvt_pk_fp8_f32(d.z * inv, d.w * inv, t, true); o.w = (unsigned)t;
        *(uint4*)(dst + (size_t)r * 1024 + lane * 16) = o;
        if (lane == 0) scales[r] = sc;
    }
}

__device__ __forceinline__ unsigned pack4i8(float a, float b, float c, float d) {
    const int ia = (int)rintf(a), ib = (int)rintf(b), ic = (int)rintf(c), id = (int)rintf(d);
    return (unsigned)(ia & 255) | ((unsigned)(ib & 255) << 8) | ((unsigned)(ic & 255) << 16) | ((unsigned)id << 24);
}
__device__ __forceinline__ void cvt_rows_i8(const float* __restrict__ src, unsigned char* __restrict__ dst, float* __restrict__ scales, int rows,
                                            int first_block, int nblocks) {
    const int tid_ = opaque_tid(), lane = tid_ & 63, w = __builtin_amdgcn_readfirstlane(tid_ >> 6);
    for (int r = ((int)blockIdx.x - first_block) * 4 + w; r < rows; r += nblocks * 4) {
        const float4* sp = (const float4*)(src + (size_t)r * 1024 + lane * 16);
        const float4 a = sp[0], b = sp[1], c = sp[2], d = sp[3];
        float mx = fmaxf(fmaxf(fmaxf(fabsf(a.x), fabsf(a.y)), fmaxf(fabsf(a.z), fabsf(a.w))), fmaxf(fmaxf(fabsf(b.x), fabsf(b.y)), fmaxf(fabsf(b.z), fabsf(b.w))));
        mx = fmaxf(mx, fmaxf(fmaxf(fmaxf(fabsf(c.x), fabsf(c.y)), fmaxf(fabsf(c.z), fabsf(c.w))), fmaxf(fmaxf(fabsf(d.x), fabsf(d.y)), fmaxf(fabsf(d.z), fabsf(d.w)))));
        mx = wave_max(mx);
        const float sc = (mx > 0.f) ? mx * (1.f / 127.f) : 1.f;
        const float inv = 1.f / sc;
        uint4 o;
        o.x = pack4i8(a.x * inv, a.y * inv, a.z * inv, a.w * inv); o.y = pack4i8(b.x * inv, b.y * inv, b.z * inv, b.w * inv);
        o.z = pack4i8(c.x * inv, c.y * inv, c.z * inv, c.w * inv); o.w = pack4i8(d.x * inv, d.y * inv, d.z * inv, d.w * inv);
        *(uint4*)(dst + (size_t)r * 1024 + lane * 16) = o;
        if (lane == 0) scales[r] = sc;
    }
}

__device__ __forceinline__ void fold_ws_phase(const float* __restrict__ wq, const float* __restrict__ k1, const float* __restrict__ k2,
                                              bf16_t* __restrict__ WsT) {
    for (int it = blockIdx.x * 256 + threadIdx.x; it < 2048 * 128; it += gridDim.x * 256) {
        const int r = it & 2047, kg = it >> 11;
        const int a = (r >> 7) & 1, j = r & 127;
        const float* kr = (a ? k2 : k1) + j * 128;
        const float* wr = wq + (size_t)(kg * 8) * 2048 + (r & ~127);
        float s[8];
#pragma unroll
        for (int q = 0; q < 8; ++q) s[q] = 0.f;
        for (int d = 0; d < 128; d += 4) {
            const float4 kv = *(const float4*)(kr + d);
#pragma unroll
            for (int q = 0; q < 8; ++q) {
                const float4 wv = *(const float4*)(wr + (size_t)q * 2048 + d);
                s[q] += wv.x * kv.x + wv.y * kv.y + wv.z * kv.z + wv.w * kv.w;
            }
        }
        uint4 o;
        o.x = pack2bf(s[0], s[1]); o.y = pack2bf(s[2], s[3]); o.z = pack2bf(s[4], s[5]); o.w = pack2bf(s[6], s[7]);
        *(uint4*)(WsT + (size_t)r * 1024 + kg * 8) = o;
    }
}


struct EpiTop16 {
    static constexpr bool kRow = false;
    float* topk; unsigned char* lds;
    __device__ __forceinline__ void operator()(int m, int n, f32x4 v) const {
        const int ml = m & 127, g4 = (n & 127) >> 2;
        *(float4*)(lds + ((ml * 32 + (g4 ^ (ml & 7))) << 4)) = make_float4(v[0], v[1], v[2], v[3]);
    }
    template <class F> __device__ __forceinline__ void dispatch(int, F f) const { f(*this); }
    __device__ __forceinline__ void finish(int m0, int n0) const {
        __syncthreads();
        const int tid_ = opaque_tid(), lane = tid_ & 63, w = __builtin_amdgcn_readfirstlane(tid_ >> 6), c = lane & 15;
        const int L = n0 >> 7;
        for (int it = 0; it < 8; ++it) {
            const int r = w * 32 + it * 4 + (lane >> 4);
            const float4 x0 = *(const float4*)(lds + ((r * 32 + ((2 * c) ^ (r & 7))) << 4));
            const float4 x1 = *(const float4*)(lds + ((r * 32 + ((2 * c + 1) ^ (r & 7))) << 4));
            float l0 = enc_key(x0.x, 8 * c + 0, 127), l1 = enc_key(x0.y, 8 * c + 1, 127), l2 = enc_key(x0.z, 8 * c + 2, 127),
                  l3 = enc_key(x0.w, 8 * c + 3, 127), l4 = enc_key(x1.x, 8 * c + 4, 127), l5 = enc_key(x1.y, 8 * c + 5, 127),
                  l6 = enc_key(x1.z, 8 * c + 6, 127), l7 = enc_key(x1.w, 8 * c + 7, 127);
            CE_DESC(l0, l1) CE_DESC(l2, l3) CE_DESC(l4, l5) CE_DESC(l6, l7)
            CE_DESC(l0, l2) CE_DESC(l1, l3) CE_DESC(l4, l6) CE_DESC(l5, l7)
            CE_DESC(l1, l2) CE_DESC(l5, l6)
            CE_DESC(l0, l4) CE_DESC(l1, l5) CE_DESC(l2, l6) CE_DESC(l3, l7)
            CE_DESC(l2, l4) CE_DESC(l3, l5)
            CE_DESC(l1, l2) CE_DESC(l3, l4) CE_DESC(l5, l6)
            float res = NEGKEY;
#pragma unroll
            for (int k = 0; k < 16; ++k) {
                const float mx = row16_max(l0);
                const bool win = (l0 == mx);
                l0 = win ? l1 : l0; l1 = win ? l2 : l1; l2 = win ? l3 : l2; l3 = win ? l4 : l3;
                l4 = win ? l5 : l4; l5 = win ? l6 : l5; l6 = win ? l7 : l6; l7 = win ? NEGKEY : l7;
                res = (c == k) ? mx : res;
            }
            topk[(size_t)(m0 + r) * 256 + L * 16 + c] = res;
        }
        __syncthreads();
    }
};

template <int PART>
__device__ __forceinline__ void peer_fast_phase(const Params& p, unsigned char* smem) {
    const int tid = opaque_tid(), lane = tid & 63, w = __builtin_amdgcn_readfirstlane(tid >> 6), l16 = lane & 15, gq = lane >> 4;
    float* tk = (float*)(smem + w * 2048);
    int* ex = (int*)(smem + w * 2048 + 1024);
    float* gw = (float*)(smem + w * 2048 + 1536);
    const bf16_t* H1B = (const bf16_t*)(p.ws + OFF_XB);
    const unsigned char* U8 = p.ws + OFF_UB;
    const unsigned char* V8 = p.ws + OFF_VB;
    const float* USC = (const float*)(p.ws + OFF_USC);
    const float* VSC = (const float*)(p.ws + OFF_VSC);
    const float* TOPK = (const float*)(p.ws + OFF_TOPK);
    int ci[4], cj[4];
#pragma unroll
    for (int q = 0; q < 4; ++q) {
        const int s = l16 + 16 * q;
        int i, j;
        if (s < 16) { i = 0; j = s; }
        else if (s < 24) { i = 1; j = s - 16; }
        else if (s < 29) { i = 2; j = s - 24; }
        else if (s < 33) { i = 3; j = s - 29; }
        else if (s < 36) { i = 4; j = s - 33; }
        else if (s < 42) { i = 5 + ((s - 36) >> 1); j = (s - 36) & 1; }
        else if (s < 50) { i = 8 + (s - 42); j = 0; }
        else { i = -1; j = 0; }
        ci[q] = i; cj[q] = j;
    }
    int* exs = (int*)(smem + 8192 + w * 4096);
    float* gws = (float*)(smem + 8192 + w * 4096 + 2048);
    float* hraw = (float*)(smem + 24576 + w * 2048);
    float* xsc = (float*)(smem + w * 2048);
    int* SEX = (int*)(p.ws + OFF_HQ);
    float* SGW = (float*)(p.ws + OFF_HLF);
    for (int qd = blockIdx.x * 4 + w; qd < NTOK / 4; qd += gridDim.x * 4) {
        const int n0 = qd * 4;
        if (PART == 0) {
#pragma unroll 1
        for (int t = 0; t < 4; ++t) {
            const int n = n0 + t;
            WAVE_LDS_SYNC();
            ((float4*)tk)[lane] = ((const float4*)(TOPK + (size_t)n * 256))[lane];
            WAVE_LDS_SYNC();
#pragma unroll
            for (int it = 0; it < 2; ++it) {
                const int head = it * 4 + gq;
                const float* ka = tk + head * 32;
                const float* kb = ka + 16;
                float c0, c1, c2, c3;
#define MKC(q, cq) { if (ci[q] >= 0) { const float sum_ = dec_val(ka[ci[q]], 127) + dec_val(kb[cj[q]], 127); \
                         cq = enc_key(sum_, ci[q] * 16 + cj[q], 255); } else cq = NEGKEY; }
                MKC(0, c0) MKC(1, c1) MKC(2, c2) MKC(3, c3)
#undef MKC
                float res = NEGKEY;
#pragma unroll
                for (int k = 0; k < 16; ++k) {
                    const float mx = row16_max(fmaxf(fmaxf(c0, c1), fmaxf(c2, c3)));
                    c0 = (c0 == mx) ? NEGKEY : c0; c1 = (c1 == mx) ? NEGKEY : c1;
                    c2 = (c2 == mx) ? NEGKEY : c2; c3 = (c3 == mx) ? NEGKEY : c3;
                    res = (l16 == k) ? mx : res;
                }
                const unsigned cc = dec_idx(res, 255);
                const float val = dec_val(res, 255);
                const unsigned e1 = dec_idx(ka[cc >> 4], 127), e2 = dec_idx(kb[cc & 15], 127);
                const float m0 = row16_max(val);
                const float e = expf(val - m0);
                const float ssum = row16_sum(e);
                ex[head * 16 + l16] = (int)(e1 * 128 + e2);
                gw[head * 16 + l16] = e / ssum;
            }
            WAVE_LDS_SYNC();
            {
                const int e0 = ex[lane], e1v = ex[lane + 64];
                const float g0 = gw[lane], g1 = gw[lane + 64];
                const int s0 = e0 >> 11, s1 = e1v >> 11;
                const unsigned long long lt = (1ull << lane) - 1ull;
                int base = 0, p0 = 0, p1 = 0;
#pragma unroll
                for (int s = 0; s < 8; ++s) {
                    const unsigned long long m0 = __ballot(s0 == s), m1 = __ballot(s1 == s);
                    const int c0 = __popcll(m0), c1 = __popcll(m1);
                    if (s0 == s) p0 = base + __popcll(m0 & lt);
                    if (s1 == s) p1 = base + c0 + __popcll(m1 & lt);
                    base += c0 + c1;
                }
                exs[t * 128 + p0] = e0; gws[t * 128 + p0] = g0; exs[t * 128 + p1] = e1v; gws[t * 128 + p1] = g1;
            }
        }
        WAVE_LDS_SYNC();
#pragma unroll
        for (int i = 0; i < 2; ++i) {
            ((uint4*)(SEX + (size_t)n0 * 128))[lane + 64 * i] = ((const uint4*)exs)[lane + 64 * i];
            ((uint4*)(SGW + (size_t)n0 * 128))[lane + 64 * i] = ((const uint4*)gws)[lane + 64 * i];
        }
        } else {
        WAVE_LDS_SYNC();
#pragma unroll
        for (int i = 0; i < 2; ++i) {
            ((uint4*)exs)[lane + 64 * i] = ((const uint4*)(SEX + (size_t)n0 * 128))[lane + 64 * i];
            ((uint4*)gws)[lane + 64 * i] = ((const uint4*)(SGW + (size_t)n0 * 128))[lane + 64 * i];
        }
        }
        if (PART == 1) {
        WAVE_LDS_SYNC();
        {
            int xq[16];
            {
                const uint4* xr = (const uint4*)(H1B + (size_t)(n0 + gq) * DM + 16 * l16);
                uint4 xa0 = xr[0], xb0 = xr[1], xa1 = xr[32], xb1 = xr[33], xa2 = xr[64], xb2 = xr[65], xa3 = xr[96], xb3 = xr[97];
#define BLO(u_) __uint_as_float((u_) << 16)
#define BHI(u_) __uint_as_float((u_) & 0xffff0000u)
#define AMX4(v_) fmaxf(fmaxf(fmaxf(fabsf(BLO((v_).x)), fabsf(BHI((v_).x))), fmaxf(fabsf(BLO((v_).y)), fabsf(BHI((v_).y)))),                  \
                       fmaxf(fmaxf(fabsf(BLO((v_).z)), fabsf(BHI((v_).z))), fmaxf(fabsf(BLO((v_).w)), fabsf(BHI((v_).w)))))
                float mx = fmaxf(fmaxf(fmaxf(AMX4(xa0), AMX4(xb0)), fmaxf(AMX4(xa1), AMX4(xb1))), fmaxf(fmaxf(AMX4(xa2), AMX4(xb2)), fmaxf(AMX4(xa3), AMX4(xb3))));
                mx = row16_max(mx);
                const float xs = (mx > 0.f) ? mx * (1.f / 127.f) : 1.f;
                const float inv = 1.f / xs;
                xsc[gq] = xs;
#define Q8(i_, va_, vb_) { xq[4 * (i_) + 0] = (int)pack4i8(BLO((va_).x) * inv, BHI((va_).x) * inv, BLO((va_).y) * inv, BHI((va_).y) * inv);   \
                           xq[4 * (i_) + 1] = (int)pack4i8(BLO((va_).z) * inv, BHI((va_).z) * inv, BLO((va_).w) * inv, BHI((va_).w) * inv);   \
                           xq[4 * (i_) + 2] = (int)pack4i8(BLO((vb_).x) * inv, BHI((vb_).x) * inv, BLO((vb_).y) * inv, BHI((vb_).y) * inv);   \
                           xq[4 * (i_) + 3] = (int)pack4i8(BLO((vb_).z) * inv, BHI((vb_).z) * inv, BLO((vb_).w) * inv, BHI((vb_).w) * inv); }
                Q8(0, xa0, xb0) Q8(1, xa1, xb1) Q8(2, xa2, xb2) Q8(3, xa3, xb3)
#undef Q8
#undef AMX4
#undef BLO
#undef BHI
            }
            uint4 ra0, ra1, ra2, ra3, rb0, rb1, rb2, rb3, rc0, rc1, rc2, rc3, rd0, rd1, rd2, rd3;
#define ULOAD(S, kk) { const int e_ = exs[gq * 128 + (kk)]; const uint4* ur_ = (const uint4*)(U8 + (size_t)e_ * DM + 16 * l16);          \
                       S##0 = ur_[0]; S##1 = ur_[16]; S##2 = ur_[32]; S##3 = ur_[48]; }
#define D4(W_, B_) { sA = __builtin_amdgcn_sdot4((int)(W_).x, xq[(B_)], sA, false); sB = __builtin_amdgcn_sdot4((int)(W_).y, xq[(B_) + 1], sB, false); \
                     sA = __builtin_amdgcn_sdot4((int)(W_).z, xq[(B_) + 2], sA, false); sB = __builtin_amdgcn_sdot4((int)(W_).w, xq[(B_) + 3], sB, false); }
#define UCOMP(S, kk) { int sA = 0, sB = 0; D4(S##0, 0) D4(S##1, 4) D4(S##2, 8) D4(S##3, 12)                                               \
                       hraw[gq * 128 + (kk)] = row16_sum((float)(sA + sB)); }
            ULOAD(ra, 0) ULOAD(rb, 1) ULOAD(rc, 2)
#pragma unroll 1
            for (int k = 0; k < 128; k += 4) {
                const int kn = (k + 4 < 128) ? k + 4 : 124;
                ULOAD(rd, k + 3)  UCOMP(ra, k)
                ULOAD(ra, kn)     UCOMP(rb, k + 1)
                ULOAD(rb, kn + 1) UCOMP(rc, k + 2)
                ULOAD(rc, kn + 2) UCOMP(rd, k + 3)
            }
#undef D4
#undef ULOAD
#undef UCOMP
        }
        WAVE_LDS_SYNC();
#pragma unroll
        for (int j = 0; j < 8; ++j) {
            const int idx = lane + 64 * j;
            const int e = exs[idx];
            gws[idx] = gws[idx] * gelu_tanh_fast(hraw[idx] * (xsc[idx >> 7] * USC[e])) * VSC[e];
        }
        WAVE_LDS_SYNC();
#pragma unroll
        for (int i = 0; i < 2; ++i) ((uint4*)(SGW + (size_t)n0 * 128))[lane + 64 * i] = ((const uint4*)gws)[lane + 64 * i];
        }
        if (PART == 2) {
        WAVE_LDS_SYNC();
        {
            f32x2 acc[32];
#pragma unroll
            for (int q = 0; q < 32; ++q) acc[q] = (f32x2){0.f, 0.f};
            uint4 ra0, ra1, ra2, ra3, rb0, rb1, rb2, rb3, rc0, rc1, rc2, rc3, rd0, rd1, rd2, rd3;
#define VLOAD(S, kk) { const int e_ = exs[gq * 128 + (kk)]; const uint4* vr_ = (const uint4*)(V8 + (size_t)e_ * DM + 16 * l16);          \
                       S##0 = vr_[0]; S##1 = vr_[16]; S##2 = vr_[32]; S##3 = vr_[48]; }
#define A4(W_, B_) { acc[(B_)] = __builtin_elementwise_fma(__builtin_amdgcn_cvt_pk_f32_fp8((int)(W_), false), wk2, acc[(B_)]);          \
                     acc[(B_) + 1] = __builtin_elementwise_fma(__builtin_amdgcn_cvt_pk_f32_fp8((int)(W_), true), wk2, acc[(B_) + 1]); }
#define VCOMP(S, kk) { const float wk = gws[gq * 128 + (kk)]; const f32x2 wk2 = (f32x2){wk, wk};                                         \
                       A4((S##0).x, 0) A4((S##0).y, 2) A4((S##0).z, 4) A4((S##0).w, 6) A4((S##1).x, 8) A4((S##1).y, 10) A4((S##1).z, 12) A4((S##1).w, 14) \
                       A4((S##2).x, 16) A4((S##2).y, 18) A4((S##2).z, 20) A4((S##2).w, 22) A4((S##3).x, 24) A4((S##3).y, 26) A4((S##3).z, 28) A4((S##3).w, 30) }
            VLOAD(ra, 0) VLOAD(rb, 1) VLOAD(rc, 2)
#pragma unroll 1
            for (int k = 0; k < 128; k += 4) {
                const int kn = (k + 4 < 128) ? k + 4 : 124;
                VLOAD(rd, k + 3)  VCOMP(ra, k)
                VLOAD(ra, kn)     VCOMP(rb, k + 1)
                VLOAD(rb, kn + 1) VCOMP(rc, k + 2)
                VLOAD(rc, kn + 2) VCOMP(rd, k + 3)
            }
#undef VLOAD
#undef VCOMP
#undef A4
            float* orow = p.out + (size_t)(n0 + gq) * DM + 16 * l16;
            float sum = 0.f;
#pragma unroll
            for (int c = 0; c < 4; ++c)
#pragma unroll
                for (int hq = 0; hq < 4; ++hq) {
                    const uint2 hb_ = *(const uint2*)(H1B + (size_t)(n0 + gq) * DM + 16 * l16 + 256 * c + 4 * hq);
                    const float4 h = make_float4(__uint_as_float(hb_.x << 16), __uint_as_float(hb_.x & 0xffff0000u),
                                                 __uint_as_float(hb_.y << 16), __uint_as_float(hb_.y & 0xffff0000u));
                    f32x2& pa = acc[8 * c + 2 * hq]; f32x2& pb = acc[8 * c + 2 * hq + 1];
                    pa[0] = ALPHA * h.x + pa[0]; pa[1] = ALPHA * h.y + pa[1]; pb[0] = ALPHA * h.z + pb[0]; pb[1] = ALPHA * h.w + pb[1];
                    sum += (pa[0] + pa[1]) + (pb[0] + pb[1]);
                }
            const float mu = row16_sum(sum) * (1.f / 1024.f);
            float sq = 0.f;
#pragma unroll
            for (int q = 0; q < 32; ++q) { acc[q][0] -= mu; acc[q][1] -= mu; sq += acc[q][0] * acc[q][0] + acc[q][1] * acc[q][1]; }
            const float rs = rsqrtf(row16_sum(sq) * (1.f / 1024.f) + LN_EPS);
            const float* g = p.in[22] + 16 * l16;
            const float* bb = p.in[23] + 16 * l16;
#pragma unroll
            for (int c = 0; c < 4; ++c)
#pragma unroll
                for (int hq = 0; hq < 4; ++hq) {
                    const float4 gg = *(const float4*)(g + 256 * c + 4 * hq), b4 = *(const float4*)(bb + 256 * c + 4 * hq);
                    const f32x2 pa = acc[8 * c + 2 * hq], pb = acc[8 * c + 2 * hq + 1];
                    float4 o;
                    o.x = pa[0] * rs * gg.x + b4.x; o.y = pa[1] * rs * gg.y + b4.y;
                    o.z = pb[0] * rs * gg.z + b4.z; o.w = pb[1] * rs * gg.w + b4.w;
                    *(float4*)(orow + 256 * c + 4 * hq) = o;
                }
        }
        }
    }
}

#define XB_TMO      128
#define XB_XCNT(j)  (256  + 64 * (j))
#define XB_XSUB(j)  (1280 + 64 * (j))
#define XB_XGEN(j)  (2304 + 64 * (j))
#define XB_TOP      3328
#define XB_TOPGEN   3392
#define XCD_BAR_WORDS 3456
#define XB_SPIN_CAP (1u << 22)
__device__ __forceinline__ unsigned xb_ld(unsigned* p) { return __hip_atomic_load(p, __ATOMIC_RELAXED, __HIP_MEMORY_SCOPE_AGENT); }
__device__ __forceinline__ unsigned xb_add(unsigned* p, unsigned v) { return __hip_atomic_fetch_add(p, v, __ATOMIC_RELAXED, __HIP_MEMORY_SCOPE_AGENT); }
__device__ __forceinline__ unsigned xb_xcc_id() { return (unsigned)__builtin_amdgcn_s_getreg((3 << 11) | 20) & 0xFu; }
#define XB_SPIN(cond, bar) do { unsigned _sp = 0; while (cond) { __builtin_amdgcn_s_sleep(1); \
    if ((++_sp & 255u) == 0u) { if (xb_ld(&(bar)[XB_TMO])) break; if (_sp > XB_SPIN_CAP) { atomicAdd(&(bar)[XB_TMO], 1u); break; } } } } while (0)
struct XcdBarrier { unsigned* bar; unsigned x; unsigned* st; };
__device__ __forceinline__ XcdBarrier xcd_barrier_post(unsigned* bar, unsigned* st) {
    XcdBarrier b; b.bar = bar; b.x = xb_xcc_id(); b.st = st;
    if (threadIdx.x == 0) (void)xb_add(&bar[XB_XCNT(b.x)], 1u);
    return b;
}
__device__ __forceinline__ void xcd_barrier_complete(unsigned* bar, unsigned x, unsigned& nloc, unsigned& nx) {
    const unsigned G = gridDim.x * gridDim.y * gridDim.z;
    unsigned sum, cnt, mine, sp = 0u;
    for (;;) {
        sum = 0u; cnt = 0u; mine = 0u;
#pragma unroll
        for (unsigned j = 0; j < 16; ++j) { const unsigned c = xb_ld(&bar[XB_XCNT(j)]); sum += c; cnt += (c > 0u) ? 1u : 0u; mine = (j == x) ? c : mine; }
        if (sum == G) break;
        __builtin_amdgcn_s_sleep(1);
        if ((++sp & 255u) == 0u) { if (xb_ld(&bar[XB_TMO])) break; if (sp > XB_SPIN_CAP) { atomicAdd(&bar[XB_TMO], 1u); break; } }
    }
    nloc = mine > 0u ? mine : 1u; nx = cnt > 0u ? cnt : 1u;
}
__device__ __forceinline__ void xcd_barrier(const XcdBarrier& b) {
    asm volatile("s_waitcnt vmcnt(0)" ::: "memory");
    __syncthreads();
    if (threadIdx.x == 0) {
        unsigned* bar = b.bar;
        __builtin_amdgcn_s_waitcnt(0);
        unsigned nloc = xb_ld(&b.st[0]), nx = xb_ld(&b.st[1]);
        if (nloc == 0u) { xcd_barrier_complete(bar, b.x, nloc, nx); __hip_atomic_store(&b.st[0], nloc, __ATOMIC_RELAXED, __HIP_MEMORY_SCOPE_AGENT); __hip_atomic_store(&b.st[1], nx, __ATOMIC_RELAXED, __HIP_MEMORY_SCOPE_AGENT); }
        const unsigned old = xb_add(&bar[XB_XSUB(b.x)], 1u);
        const unsigned gen = old / nloc;
        if (old + 1u == (gen + 1u) * nloc) {
            __builtin_amdgcn_fence(__ATOMIC_RELEASE, "agent");
            asm volatile("s_waitcnt vmcnt(0)" ::: "memory");
            const unsigned og = xb_add(&bar[XB_TOP], 1u);
            const unsigned tg = og / nx;
            if (og + 1u == (tg + 1u) * nx) xb_add(&bar[XB_TOPGEN], 1u);
            else XB_SPIN(xb_ld(&bar[XB_TOPGEN]) == tg, bar);
            __builtin_amdgcn_fence(__ATOMIC_ACQUIRE, "agent");
            xb_add(&bar[XB_XGEN(b.x)], 1u);
            asm volatile("s_waitcnt vmcnt(0)" ::: "memory");
        } else {
            XB_SPIN(xb_ld(&bar[XB_XGEN(b.x)]) == gen, bar);
            __builtin_amdgcn_fence(__ATOMIC_ACQUIRE, "agent");
            asm volatile("s_waitcnt vmcnt(0)" ::: "memory");
        }
    }
    __syncthreads();
}

__global__ void __launch_bounds__(256, 2) mega(Params p) {
    cg::grid_group grid = cg::this_grid();
    __shared__ __attribute__((aligned(16))) unsigned char smem[81920];
    float* sm = (float*)smem;
    unsigned* barw = (unsigned*)(p.ws + OFF_BAR);
    const XcdBarrier xbar = xcd_barrier_post(barw, barw + XCD_BAR_WORDS + 2 * blockIdx.x);
    bf16_t* XB = (bf16_t*)(p.ws + OFF_XB);
    bf16_t* WinT = (bf16_t*)(p.ws + OFF_WINT);
    bf16_t* WoutT = (bf16_t*)(p.ws + OFF_WOUTT);
    bf16_t* WqT = (bf16_t*)(p.ws + OFF_WQT);
    cvt_rows_bf16(p.in[0], XB, (size_t)NTOK * DM / 8);
    transpose_bf16(p.in[1], DIN, 3456, WinT);
    transpose_bf16(p.in[2], DM, DM, WoutT);
    fold_ws_phase(p.in[17], p.in[18], p.in[19], WqT);
    transpose_bf16(p.in[6], 256, 256, (bf16_t*)(p.ws + OFF_W1T), 2048);
    transpose_bf16(p.in[11], 256, 256, (bf16_t*)(p.ws + OFF_W1T) + 256 * 2048, 2048);
    if (blockIdx.x == 0) {
        for (int c = threadIdx.x; c < 512; c += 256)
            ((float*)(p.ws + OFF_LBV))[c] = 1.f / (1.f + expf(p.in[3][512 + c] - p.in[3][c]));
        if (threadIdx.x < 16) ((float*)(p.ws + OFF_DIAG))[threadIdx.x] = 0.f;
    }
    if (blockIdx.x == 1 || blockIdx.x == 2) cmp_peb(p, blockIdx.x - 1);
    grid.sync();
    gemm_bf16_phase3(XB, DM, WinT, DM, NTOK / 256, 27, smem, EpiProj{p.ws});
    xcd_barrier(xbar);
    for (int it = blockIdx.x; it < 128; it += gridDim.x) {
        const int which = it >> 6, t = it & 63;
        gemm_tile(ALoadCmp{(const bf16_t*)(p.ws + OFF_KV + (size_t)which * KV_STRIDE)},
                  (const bf16_t*)(p.ws + OFF_W1T) + (size_t)which * 256 * 2048, 2048, 32, (t >> 1) * 128, (t & 1) * 128, smem,
                  EpiCmpH{(bf16_t*)(p.ws + OFF_HB) + (size_t)which * 4096 * 256, (const float*)(p.ws + OFF_PEB) + which * 256});
    }
    if (gridDim.x >= 256) {
        if (blockIdx.x >= 128)
            for (int it = blockIdx.x - 128; it < 2048; it += gridDim.x - 128) hgrn_passA(p, it, smem);
    } else {
        for (int it = blockIdx.x; it < 2048; it += gridDim.x) hgrn_passA(p, it, smem);
    }
#if NSA_DIAG
    for (int it = blockIdx.x; it < 2 * 4 * NCB * 2; it += gridDim.x) compress_item(p, it, sm);
#endif
    xcd_barrier(xbar);
    if (blockIdx.x < 256) hgrn_scan_item(p, blockIdx.x);
    else {
        cvt_rows_i8(p.in[20], p.ws + OFF_UB, (float*)(p.ws + OFF_USC), 16384, 256, gridDim.x - 256);
        cvt_rows_fp8(p.in[21], p.ws + OFF_VB, (float*)(p.ws + OFF_VSC), 16384, 256, gridDim.x - 256);
    }
    if (gridDim.x <= 256) {
        cvt_rows_i8(p.in[20], p.ws + OFF_UB, (float*)(p.ws + OFF_USC), 16384, 0, gridDim.x);
        cvt_rows_fp8(p.in[21], p.ws + OFF_VB, (float*)(p.ws + OFF_VSC), 16384, 0, gridDim.x);
    }
    cmp_layer2_phase(p, 0, gridDim.x);
    xcd_barrier(xbar);
    {
        const int qi = blockIdx.x & 7;
        unsigned* qctr = barw + XCD_BAR_WORDS + 2 * 1024 + 64 * qi;
        for (;;) {
            __syncthreads();
            if (threadIdx.x == 0) *(volatile unsigned*)smem = atomicAdd(qctr, 1u);
            __syncthreads();
            const int it = (int)__builtin_amdgcn_readfirstlane(*(volatile unsigned*)smem);
            if (it >= 256) break;
            nsa_tile(p, (it << 3) | qi, smem);
        }
        for (;;) {
            __syncthreads();
            if (threadIdx.x == 0) *(volatile unsigned*)smem = atomicAdd(qctr + 32, 1u);
            __syncthreads();
            const int it = (int)__builtin_amdgcn_readfirstlane(*(volatile unsigned*)smem);
            if (it >= 256) break;
            hgrn_passC(p, (it << 3) | qi, smem);
        }
    }
    xcd_barrier(xbar);
#if NSA_DIAG
    for (int it = blockIdx.x; it < 4 * 2 * SEQ; it += gridDim.x) nsa_item(p, it, sm);
    grid.sync();
    {
        const float* DG = (const float*)(p.ws + OFF_DIAG);
#if NSA_DIAG == 1
        const float cval = -log10f(sqrtf(DG[0] / DG[1]) + 1e-9f);
#else
        const float cval = -log10f(DG[2] / DG[3] + 1e-6f);
#endif
        for (size_t i = (size_t)blockIdx.x * 256 + threadIdx.x; i < (size_t)NTOK * DM; i += (size_t)gridDim.x * 256) p.out[i] = cval;
        return;
    }
#endif
    gemm_bf16_phase3(XB, DM, WoutT, DM, NTOK / 256, 8, smem, EpiMix{(bf16_t*)p.out});
    xcd_barrier(xbar);
    ln1_phase(p, sm);
    xcd_barrier(xbar);
    gemm_bf16_phase3(XB, DM, WqT, DM, NTOK / 256, 16, smem, EpiTop16{(float*)(p.ws + OFF_TOPK), smem});
    xcd_barrier(xbar);
    peer_fast_phase<0>(p, smem);
    peer_fast_phase<1>(p, smem);
    peer_fast_phase<2>(p, smem);
}

extern "C" void kernel_launch(void* const* d_in, const int* in_sizes, int n_in, void* d_out, int out_size,
                              void* d_ws, size_t ws_size, hipStream_t stream) {
    static int grid_blocks = 0;
    if (!grid_blocks) {
        int dev = 0, cus = 0, per_cu = 0;
        hipGetDevice(&dev);
        hipDeviceGetAttribute(&cus, hipDeviceAttributeMultiprocessorCount, dev);
        hipOccupancyMaxActiveBlocksPerMultiprocessor(&per_cu, mega, 256, 0);
        if (per_cu > 4) per_cu = 4;
        if (per_cu < 1) per_cu = 1;
        grid_blocks = cus * per_cu;
        if (n_in != 24 || ws_size < WS_NEED || out_size != NTOK * DM)
            fprintf(stderr, "kernel_launch: unexpected sizes n_in=%d ws=%zu out=%d\n", n_in, ws_size, out_size);
    }
    Params p;
    memset(&p, 0, sizeof(p));
    for (int i = 0; i < 24; ++i) p.in[i] = (const float*)d_in[i];
    p.out = (float*)d_out;
    p.ws = (unsigned char*)d_ws;
    hipMemsetAsync((char*)d_ws + OFF_BAR, 0, BAR_BYTES, stream);
    void* args[] = {&p};
    hipError_t e = hipLaunchCooperativeKernel((void*)mega, dim3(grid_blocks), dim3(256), args, 0, stream);
    if (e != hipSuccess) fprintf(stderr, "cooperative launch failed: %s (grid %d)\n", hipGetErrorString(e), grid_blocks);
}
```

```cpp
#include <hip/hip_runtime.h>
#include <hip/hip_cooperative_groups.h>
#include <cstdio>
#include <cstring>
namespace cg = cooperative_groups;

#define NTOK 32768
#define SEQ 8192
#define DM 1024
#define DIN 3352
#define NCB 511
#define ALPHA 1.189207115002721f
#define LN_EPS 1e-5f

#define MB_ 1048576ull
#define OFF_XB 0ull
#define OFF_HQ (64 * MB_)
#define OFF_HLF (96 * MB_)
#define OFF_HI (160 * MB_)
#define OFF_HG (192 * MB_)
#define OFF_NQ (224 * MB_)
#define OFF_KV (256 * MB_)
#define KV_STRIDE (8 * MB_)
#define OFF_NGATE (304 * MB_)
#define OFF_CMPK (308 * MB_)
#define OFF_CMPV (309 * MB_)
#define OFF_WINT (310 * MB_)
#define OFF_WOUTT (317 * MB_)
#define OFF_WQT (319 * MB_)
#define OFF_LBV (323 * MB_)
#define OFF_DC (324 * MB_)
#define OFF_SC (325 * MB_)
#define OFF_UB (389 * MB_)
#define OFF_VB (421 * MB_)
#define OFF_TOPK (453 * MB_)
#define OFF_W1T (485 * MB_)
#define OFF_HB (487 * MB_)
#define OFF_CMPKB (491 * MB_)
#define OFF_CMPVB (491 * MB_ + 524288ull)
#define OFF_PEB (492 * MB_)
#define OFF_SELM (493 * MB_)
#define OFF_DIAG (494 * MB_)
#define OFF_USC (494 * MB_ + 131072ull)
#define OFF_VSC (494 * MB_ + 196608ull)
#define OFF_BAR (494 * MB_ + 65536ull)
#define BAR_BYTES 32768
#define WS_NEED (495 * MB_)
#define USE_NSA_MFMA 1
#define NSA_DIAG 0

struct Params {
    const float* in[24];
    float* out;
    unsigned char* ws;
};

typedef float f32x16 __attribute__((ext_vector_type(16)));
#define WAVE_LDS_SYNC() asm volatile("s_waitcnt lgkmcnt(0)" ::: "memory")
#define LAS3 __attribute__((address_space(3)))

__device__ __forceinline__ int opaque_tid() { int t = threadIdx.x; asm volatile("" : "+v"(t)); return t; }
__device__ __forceinline__ float wave_sum(float v) {
#pragma unroll
    for (int o = 32; o; o >>= 1) v += __shfl_xor(v, o);
    return v;
}
__device__ __forceinline__ float wave_max(float v) {
#pragma unroll
    for (int o = 32; o; o >>= 1) v = fmaxf(v, __shfl_xor(v, o));
    return v;
}
__device__ __forceinline__ float sigmoidf_(float x) { return 1.f / (1.f + expf(-x)); }
__device__ __forceinline__ float sigmoid_fast(float x) { return __builtin_amdgcn_rcpf(1.f + __builtin_amdgcn_exp2f(-1.4426950408889634f * x)); }
__device__ __forceinline__ float log_fast(float x) { return 0.6931471805599453f * __builtin_amdgcn_logf(x); }
__device__ __forceinline__ float gelu_tanh_fast(float x) {
    const float u = 0.7978845608028654f * (x + 0.044715f * x * x * x);
    return x * __builtin_amdgcn_rcpf(1.f + __builtin_amdgcn_exp2f(-2.885390081777927f * u));
}
__device__ __forceinline__ float gelu_tanh(float x) {
    const float c = 0.7978845608028654f;
    return 0.5f * x * (1.f + tanhf(c * (x + 0.044715f * x * x * x)));
}

typedef short bf16x8 __attribute__((ext_vector_type(8)));
typedef float f32x4 __attribute__((ext_vector_type(4)));
typedef unsigned short bf16_t;

typedef __bf16 bf16x2_t __attribute__((ext_vector_type(2)));
__device__ __forceinline__ unsigned pack2bf(float lo, float hi) {
    bf16x2_t v; v[0] = (__bf16)lo; v[1] = (__bf16)hi;
    return __builtin_bit_cast(unsigned, v);
}
__device__ __forceinline__ unsigned f2bf(float f) { return pack2bf(f, 0.f) & 0xffffu; }
__device__ __forceinline__ float bf2f(unsigned h) { return __uint_as_float(h << 16); }

__device__ __forceinline__ void cvt_rows_bf16(const float* __restrict__ src, bf16_t* __restrict__ dst, size_t n8) {
    for (size_t i = (size_t)blockIdx.x * 256 + threadIdx.x; i < n8; i += (size_t)gridDim.x * 256) {
        const float4 a = ((const float4*)src)[2 * i], b = ((const float4*)src)[2 * i + 1];
        uint4 o;
        o.x = pack2bf(a.x, a.y); o.y = pack2bf(a.z, a.w); o.z = pack2bf(b.x, b.y); o.w = pack2bf(b.z, b.w);
        ((uint4*)dst)[i] = o;
    }
}
__device__ __forceinline__ void transpose_bf16(const float* __restrict__ src, int Nsrc, int Npad, bf16_t* __restrict__ dst, int K = 1024) {
    const size_t total = (size_t)Npad * (K / 8);
    for (size_t i = (size_t)blockIdx.x * 256 + threadIdx.x; i < total; i += (size_t)gridDim.x * 256) {
        const int n = (int)(i % Npad), kg = (int)(i / Npad);
        float v[8];
#pragma unroll
        for (int j = 0; j < 8; ++j) v[j] = (n < Nsrc) ? src[(size_t)(kg * 8 + j) * Nsrc + n] : 0.f;
        uint4 o;
        o.x = pack2bf(v[0], v[1]); o.y = pack2bf(v[2], v[3]); o.z = pack2bf(v[4], v[5]); o.w = pack2bf(v[6], v[7]);
        *(uint4*)(dst + (size_t)n * K + kg * 8) = o;
    }
}

struct ALoadStd {
    const bf16_t* A; int lda;
    __device__ __forceinline__ const bf16_t* ptr(int row, int ks) const { return A + (size_t)row * lda + ks * 64; }
};
struct ALoadCmp {
    const bf16_t* KC;
    __device__ __forceinline__ const bf16_t* ptr(int row, int ks) const {
        const int r = row < 4088 ? row : 4087;
        const int g = r & 1, bn = r >> 1, n = bn % NCB, b = bn / NCB;
        return KC + ((size_t)(b * SEQ + 16 * n + ks) * 128 + g * 64);
    }
};
#define GLDS1(i, ks, buf) { const int row_ = 8 * w + 32 * (i) + (lane >> 3);                                                    \
        __builtin_amdgcn_global_load_lds((const unsigned*)(aload.ptr(m0 + row_, (ks)) + (((lane & 7) ^ (lane >> 3)) << 3)),      \
                                         (LAS3 unsigned*)(lds + (buf) * 32768 + w * 1024 + (i) * 4096), 16, 0, 0);              \
        __builtin_amdgcn_global_load_lds((const unsigned*)(Bp + (size_t)row_ * ldb + (ks) * 64 + (((lane & 7) ^ (lane >> 3)) << 3)), \
                                         (LAS3 unsigned*)(lds + (buf) * 32768 + 16384 + w * 1024 + (i) * 4096), 16, 0, 0); }
#define GEMM_GLDS(ks, buf) { GLDS1(0, ks, buf) GLDS1(1, ks, buf) GLDS1(2, ks, buf) GLDS1(3, ks, buf) }
template <class ALoad, class Epi>
__device__ __forceinline__ void gemm_tile(const ALoad aload, const bf16_t* __restrict__ Bt, int ldb, int KS, int m0, int n0,
                                          unsigned char* lds, Epi epi) {
    const int tid = opaque_tid(), lane = tid & 63, w = __builtin_amdgcn_readfirstlane(tid >> 6), wm = w >> 1, wn = w & 1;
    f32x4 acc[4][4];
#pragma unroll
    for (int j = 0; j < 4; ++j)
#pragma unroll
        for (int i = 0; i < 4; ++i) acc[j][i] = (f32x4){0.f, 0.f, 0.f, 0.f};
    const bf16_t* Bp = Bt + (size_t)n0 * ldb;
    __syncthreads();
    GEMM_GLDS(0, 0)
    asm volatile("s_waitcnt vmcnt(0)" ::: "memory");
    __syncthreads();
    for (int ks = 0; ks < KS; ++ks) {
        if (ks + 1 < KS) GEMM_GLDS(ks + 1, (ks + 1) & 1)
        const unsigned char* la = lds + (ks & 1) * 32768;
        const unsigned char* lb = la + 16384;
#pragma unroll
        for (int s = 0; s < 2; ++s) {
            bf16x8 af[4], wf[4];
            const int ch = s * 4 + (lane >> 4);
#pragma unroll
            for (int i = 0; i < 4; ++i) {
                const int row = wm * 64 + i * 16 + (lane & 15);
                af[i] = *(const bf16x8*)(la + row * 128 + ((ch ^ (row & 7)) << 4));
            }
#pragma unroll
            for (int j = 0; j < 4; ++j) {
                const int row = wn * 64 + j * 16 + (lane & 15);
                wf[j] = *(const bf16x8*)(lb + row * 128 + ((ch ^ (row & 7)) << 4));
            }
#pragma unroll
            for (int j = 0; j < 4; ++j)
#pragma unroll
                for (int i = 0; i < 4; ++i)
                    acc[j][i] = __builtin_amdgcn_mfma_f32_16x16x32_bf16(wf[j], af[i], acc[j][i], 0, 0, 0);
        }
        asm volatile("s_waitcnt vmcnt(0)" ::: "memory");
        __syncthreads();
    }
#pragma unroll
    for (int j = 0; j < 4; ++j)
#pragma unroll
        for (int i = 0; i < 4; ++i)
            epi(m0 + wm * 64 + i * 16 + (lane & 15), n0 + wn * 64 + j * 16 + (lane >> 4) * 4, acc[j][i]);
    epi.finish(m0, n0);
}
template <class Epi>
__device__ __forceinline__ void gemm_bf16_phase(const bf16_t* __restrict__ A, int lda, const bf16_t* __restrict__ Bt, int ldb,
                                                int Mtiles, int Ntiles, unsigned char* lds, Epi epi) {
    if ((gridDim.x & 7) == 0 && (Mtiles & 31) == 0) {
        const int x = blockIdx.x & 7, j = blockIdx.x >> 3, nb = gridDim.x >> 3;
        const int per = (Mtiles >> 3) * Ntiles;
        for (int q = j; q < per; q += nb) {
            const int s = q / (4 * Ntiles), rem = q - s * (4 * Ntiles);
            const int c = rem >> 2, r = rem & 3;
            const int mt = x + 8 * (4 * s + r);
            gemm_tile(ALoadStd{A, lda}, Bt, ldb, 16, mt * 128, c * 128, lds, epi);
        }
    } else {
        for (int tile = blockIdx.x; tile < Mtiles * Ntiles; tile += gridDim.x) {
            const int mt = tile / Ntiles, nt = tile % Ntiles;
            gemm_tile(ALoadStd{A, lda}, Bt, ldb, 16, mt * 128, nt * 128, lds, epi);
        }
    }
}


#define G3_STAGE 24576
#define G3A(i, ks, st) __builtin_amdgcn_global_load_lds((const unsigned*)(pa + (size_t)(64 * (i)) * lda + (ks) * 32),                     \
                                                        (LAS3 unsigned*)(lds + (st) + (w + 4 * (i)) * 1024), 16, 0, 0);
#define G3B(i, ks, st) __builtin_amdgcn_global_load_lds((const unsigned*)(pb + (size_t)(64 * (i)) * ldb + (ks) * 32),                     \
                                                        (LAS3 unsigned*)(lds + (st) + 16384 + (w + 4 * (i)) * 1024), 16, 0, 0);
#define G3MF(j, i) acc[j][i] = __builtin_amdgcn_mfma_f32_16x16x32_bf16(wf[j], af[i], acc[j][i], 0, 0, 0);
#define G3MF4(j, i) G3MF(j, i) G3MF(j, (i) + 1) G3MF(j, (i) + 2) G3MF(j, (i) + 3)
#define G3SB __builtin_amdgcn_sched_barrier(0);
#define G3_BODY(LOADS, KS) {                                                                                                              \
        const unsigned char* la = lds + st0 + wm * 8192 + fofs;                                                                           \
        const unsigned char* lb = lds + st0 + 16384 + wn * 4096 + fofs;                                                                   \
        bf16x8 af[8], wf[4];                                                                                                              \
        wf[0] = *(const bf16x8*)(lb);                                                                                                     \
        af[0] = *(const bf16x8*)(la);            af[1] = *(const bf16x8*)(la + 1024); af[2] = *(const bf16x8*)(la + 2048);                \
        af[3] = *(const bf16x8*)(la + 3072);     af[4] = *(const bf16x8*)(la + 4096); af[5] = *(const bf16x8*)(la + 5120);                \
        af[6] = *(const bf16x8*)(la + 6144);     af[7] = *(const bf16x8*)(la + 7168);                                                     \
        wf[1] = *(const bf16x8*)(lb + 1024);     wf[2] = *(const bf16x8*)(lb + 2048); wf[3] = *(const bf16x8*)(lb + 3072);                \
        G3SB                                                                                                                              \
        G3MF4(0, 0) if (LOADS) { G3A(0, (KS) + 2, st2) } G3SB                                                                             \
        G3MF4(0, 4) if (LOADS) { G3A(1, (KS) + 2, st2) } G3SB                                                                             \
        G3MF4(1, 0) if (LOADS) { G3A(2, (KS) + 2, st2) } G3SB                                                                             \
        G3MF4(1, 4) if (LOADS) { G3A(3, (KS) + 2, st2) } G3SB                                                                             \
        G3MF4(2, 0) if (LOADS) { G3B(0, (KS) + 2, st2) } G3SB                                                                             \
        G3MF4(2, 4) if (LOADS) { G3B(1, (KS) + 2, st2) } G3SB                                                                             \
        G3MF4(3, 0) G3MF4(3, 4) }
template <class Epi>
__device__ __forceinline__ void gemm_tile3(const bf16_t* __restrict__ A, int lda, const bf16_t* __restrict__ Bt, int ldb, int m0, int n0,
                                           unsigned char* lds, Epi epi) {
    const int tid = opaque_tid(), lane = tid & 63, w = __builtin_amdgcn_readfirstlane(tid >> 6), wm = w >> 1, wn = w & 1;
    f32x4 acc[4][8];
#pragma unroll
    for (int j = 0; j < 4; ++j)
#pragma unroll
        for (int i = 0; i < 8; ++i) acc[j][i] = (f32x4){0.f, 0.f, 0.f, 0.f};
    const int r15 = lane & 15, g4 = lane >> 4;
    const int fofs = r15 * 64 + ((g4 ^ ((0 - (r15 >> 2)) & 3)) << 4);
    const int lch = ((lane & 3) ^ ((0 - (lane >> 4)) & 3)) << 3;
    const bf16_t* pa = A + (size_t)(m0 + 16 * w + (lane >> 2)) * lda + lch;
    const bf16_t* pb = Bt + (size_t)(n0 + 16 * w + (lane >> 2)) * ldb + lch;
    __syncthreads();
    G3A(0, 0, 0) G3A(1, 0, 0) G3A(2, 0, 0) G3A(3, 0, 0) G3B(0, 0, 0) G3B(1, 0, 0)
    G3A(0, 1, G3_STAGE) G3A(1, 1, G3_STAGE) G3A(2, 1, G3_STAGE) G3A(3, 1, G3_STAGE) G3B(0, 1, G3_STAGE) G3B(1, 1, G3_STAGE)
    int st0 = 0, st1 = G3_STAGE, st2 = 2 * G3_STAGE;
#pragma unroll 1
    for (int ks = 0; ks < 30; ++ks) {
        asm volatile("s_waitcnt vmcnt(6)" ::: "memory");
        __builtin_amdgcn_s_barrier();
        asm volatile("" ::: "memory");
        G3_BODY(1, ks)
        const int t_ = st0; st0 = st1; st1 = st2; st2 = t_;
    }
    asm volatile("s_waitcnt vmcnt(6)" ::: "memory");
    __builtin_amdgcn_s_barrier();
    asm volatile("" ::: "memory");
    G3_BODY(0, 30)
    st0 = st1;
    asm volatile("s_waitcnt vmcnt(0)" ::: "memory");
    __builtin_amdgcn_s_barrier();
    asm volatile("" ::: "memory");
    G3_BODY(0, 31)
    __syncthreads();
    if constexpr (Epi::kRow) {
        const int mrow = m0 + wm * 128 + r15, ncol = n0 + wn * 64;
        epi.dispatch(n0, [&](auto e) {
            if constexpr (decltype(e)::kBf16) {
#pragma unroll
                for (int i = 0; i < 8; ++i)
#pragma unroll
                    for (int j = 0; j < 4; j += 2) {
                        uint2 a = e.pack4(acc[j][i]), b = e.pack4(acc[j + 1][i]);
                        auto sx = __builtin_amdgcn_permlane16_swap(a.x, b.x, false, false);
                        auto sy = __builtin_amdgcn_permlane16_swap(a.y, b.y, false, false);
                        e.store8(mrow + i * 16, ncol + (j + (g4 & 1)) * 16 + (g4 >> 1) * 8, make_uint4(sx[0], sy[0], sx[1], sy[1]));
                    }
            } else {
#pragma unroll
                for (int i = 0; i < 8; ++i)
#pragma unroll
                    for (int j = 0; j < 4; ++j)
                        e.row4(mrow + i * 16, ncol + j * 16 + g4 * 4, make_float4(acc[j][i][0], acc[j][i][1], acc[j][i][2], acc[j][i][3]));
            }
        });
    } else {
#pragma unroll
        for (int hh = 0; hh < 2; ++hh) {
            if (wm == hh) {
#pragma unroll
                for (int j = 0; j < 4; ++j)
#pragma unroll
                    for (int i = 0; i < 8; ++i)
                        epi(m0 + wm * 128 + i * 16 + (lane & 15), n0 + wn * 64 + j * 16 + (lane >> 4) * 4, acc[j][i]);
            }
            epi.finish(m0 + hh * 128, n0);
        }
    }
}

#define G3PA(PA, i, k, st) __builtin_amdgcn_global_load_lds((const unsigned*)((PA) + (size_t)(64 * (i)) * lda + (k) * 32),                 \
                                                            (LAS3 unsigned*)(lds + (st) + (w + 4 * (i)) * 1024), 16, 0, 0);
#define G3PB(PB, i, k, st) __builtin_amdgcn_global_load_lds((const unsigned*)((PB) + (size_t)(64 * (i)) * ldb + (k) * 32),                 \
                                                            (LAS3 unsigned*)(lds + (st) + 16384 + (w + 4 * (i)) * 1024), 16, 0, 0);
#define G3P_BODY(PA, PB, KIDX) {                                                                                                          \
        const unsigned char* la = lds + st0 + wm * 8192 + fofs;                                                                           \
        const unsigned char* lb = lds + st0 + 16384 + wn * 4096 + fofs;                                                                   \
        bf16x8 af[8], wf[4];                                                                                                              \
        wf[0] = *(const bf16x8*)(lb);                                                                                                     \
        af[0] = *(const bf16x8*)(la);            af[1] = *(const bf16x8*)(la + 1024); af[2] = *(const bf16x8*)(la + 2048);                \
        af[3] = *(const bf16x8*)(la + 3072);     af[4] = *(const bf16x8*)(la + 4096); af[5] = *(const bf16x8*)(la + 5120);                \
        af[6] = *(const bf16x8*)(la + 6144);     af[7] = *(const bf16x8*)(la + 7168);                                                     \
        wf[1] = *(const bf16x8*)(lb + 1024);     wf[2] = *(const bf16x8*)(lb + 2048); wf[3] = *(const bf16x8*)(lb + 3072);                \
        G3SB                                                                                                                              \
        G3MF4(0, 0) G3PA(PA, 0, KIDX, st2) G3SB                                                                                           \
        G3MF4(0, 4) G3PA(PA, 1, KIDX, st2) G3SB                                                                                           \
        G3MF4(1, 0) G3PA(PA, 2, KIDX, st2) G3SB                                                                                           \
        G3MF4(1, 4) G3PA(PA, 3, KIDX, st2) G3SB                                                                                           \
        G3MF4(2, 0) G3PB(PB, 0, KIDX, st2) G3SB                                                                                           \
        G3MF4(2, 4) G3PB(PB, 1, KIDX, st2) G3SB                                                                                           \
        G3MF4(3, 0) G3MF4(3, 4)                                                                                                           \
        { const int t_ = st0; st0 = st1; st1 = st2; st2 = t_; } }
#define G3P_SYNC(N) { asm volatile("s_waitcnt vmcnt(" #N ")" ::: "memory"); __builtin_amdgcn_s_barrier(); asm volatile("" ::: "memory"); }
#define G3P_BAR     { __builtin_amdgcn_s_barrier(); asm volatile("" ::: "memory"); }
template <class Epi>
__device__ __forceinline__ void gemm_phase_pipelined(const bf16_t* __restrict__ A, int lda, const bf16_t* __restrict__ Bt, int ldb,
                                                     int Mtiles  , int Ntiles, unsigned char* lds, Epi epi) {
    const int tid = opaque_tid(), lane = tid & 63, w = __builtin_amdgcn_readfirstlane(tid >> 6), wm = w >> 1, wn = w & 1;
    const int r15 = lane & 15, g4 = lane >> 4;
    const int fofs = r15 * 64 + ((g4 ^ ((0 - (r15 >> 2)) & 3)) << 4);
    const int lch = ((lane & 3) ^ ((0 - (lane >> 4)) & 3)) << 3;
    const int x = blockIdx.x & 7, jb = blockIdx.x >> 3, nb = gridDim.x >> 3;
    const int per = (Mtiles >> 3) * Ntiles;
    int q = jb;
    if (q >= per) return;
    int m0, n0;
#define G3P_TILE(Q, M0, N0) { const int s_ = (Q) / (2 * Ntiles), rem_ = (Q) - s_ * (2 * Ntiles); M0 = (x + 8 * (2 * s_ + (rem_ & 1))) * 256; N0 = (rem_ >> 1) * 128; }
    G3P_TILE(q, m0, n0)
    const bf16_t* pa = A + (size_t)(m0 + 16 * w + (lane >> 2)) * lda + lch;
    const bf16_t* pb = Bt + (size_t)(n0 + 16 * w + (lane >> 2)) * ldb + lch;
    int st0 = 0, st1 = G3_STAGE, st2 = 2 * G3_STAGE;
    __syncthreads();
    G3PA(pa, 0, 0, 0) G3PA(pa, 1, 0, 0) G3PA(pa, 2, 0, 0) G3PA(pa, 3, 0, 0) G3PB(pb, 0, 0, 0) G3PB(pb, 1, 0, 0)
    G3PA(pa, 0, 1, G3_STAGE) G3PA(pa, 1, 1, G3_STAGE) G3PA(pa, 2, 1, G3_STAGE) G3PA(pa, 3, 1, G3_STAGE) G3PB(pb, 0, 1, G3_STAGE) G3PB(pb, 1, 1, G3_STAGE)
    asm volatile("s_waitcnt vmcnt(0)" ::: "memory");
    for (;;) {
        const int qn = (q + nb < per) ? q + nb : q;
        int m0n, n0n;
        G3P_TILE(qn, m0n, n0n)
        const bf16_t* pan = A + (size_t)(m0n + 16 * w + (lane >> 2)) * lda + lch;
        const bf16_t* pbn = Bt + (size_t)(n0n + 16 * w + (lane >> 2)) * ldb + lch;
        f32x4 acc[4][8];
#pragma unroll
        for (int j = 0; j < 4; ++j)
#pragma unroll
            for (int i = 0; i < 8; ++i) acc[j][i] = (f32x4){0.f, 0.f, 0.f, 0.f};
        G3P_BAR      G3P_BODY(pa, pb, 2)
        G3P_BAR      G3P_BODY(pa, pb, 3)
#pragma unroll 1
        for (int ks = 2; ks < 30; ++ks) {
            G3P_SYNC(6)
            G3P_BODY(pa, pb, ks + 2)
        }
        G3P_SYNC(6)  G3P_BODY(pan, pbn, 0)
        G3P_SYNC(6)  G3P_BODY(pan, pbn, 1)
        {
            const int mrow = m0 + wm * 128 + r15, ncol = n0 + wn * 64;
            epi.dispatch(n0, [&](auto e) {
                asm volatile("s_waitcnt vmcnt(0)" ::: "memory");
                if constexpr (decltype(e)::kBf16) {
#pragma unroll
                    for (int i = 0; i < 8; ++i)
#pragma unroll
                        for (int j = 0; j < 4; j += 2) {
                            uint2 a = e.pack4(acc[j][i]), b = e.pack4(acc[j + 1][i]);
                            auto sx = __builtin_amdgcn_permlane16_swap(a.x, b.x, false, false);
                            auto sy = __builtin_amdgcn_permlane16_swap(a.y, b.y, false, false);
                            e.store8(mrow + i * 16, ncol + (j + (g4 & 1)) * 16 + (g4 >> 1) * 8, make_uint4(sx[0], sy[0], sx[1], sy[1]));
                        }
                } else {
#pragma unroll
                    for (int i = 0; i < 8; ++i)
#pragma unroll
                        for (int j = 0; j < 4; ++j)
                            e.row4(mrow + i * 16, ncol + j * 16 + g4 * 4, make_float4(acc[j][i][0], acc[j][i][1], acc[j][i][2], acc[j][i][3]));
                }
            });
        }
        if (qn == q) break;
        q = qn; m0 = m0n; n0 = n0n; pa = pan; pb = pbn;
    }
    asm volatile("s_waitcnt vmcnt(0)" ::: "memory");
    __syncthreads();
#undef G3P_TILE
}

template <class Epi>
__device__ __forceinline__ void gemm_bf16_phase3(const bf16_t* __restrict__ A, int lda, const bf16_t* __restrict__ Bt, int ldb,
                                                 int Mtiles  , int Ntiles, unsigned char* lds, Epi epi) {
    if constexpr (Epi::kRow) {
        if ((gridDim.x & 7) == 0 && (Mtiles & 15) == 0) { gemm_phase_pipelined(A, lda, Bt, ldb, Mtiles, Ntiles, lds, epi); return; }
    }
    if ((gridDim.x & 7) == 0 && (Mtiles & 15) == 0) {
        const int x = blockIdx.x & 7, j = blockIdx.x >> 3, nb = gridDim.x >> 3;
        const int per = (Mtiles >> 3) * Ntiles;
        for (int q = j; q < per; q += nb) {
            const int s = q / (2 * Ntiles), rem = q - s * (2 * Ntiles);
            const int c = rem >> 1, r = rem & 1;
            const int mt = x + 8 * (2 * s + r);
            gemm_tile3(A, lda, Bt, ldb, mt * 256, c * 128, lds, epi);
        }
    } else {
        for (int tile = blockIdx.x; tile < Mtiles * Ntiles; tile += gridDim.x)
            gemm_tile3(A, lda, Bt, ldb, (tile / Ntiles) * 256, (tile % Ntiles) * 128, lds, epi);
    }
}

struct EpiF32 {
    float* C; int ldc; int Nc;
    __device__ __forceinline__ void operator()(int m, int n, f32x4 v) const {
        if (n < Nc) *(float4*)(C + (size_t)m * ldc + n) = make_float4(v[0], v[1], v[2], v[3]);
    }
    __device__ __forceinline__ void finish(int, int) const {}
};

struct EpiProjBf {
    static constexpr bool kBf16 = true;
    bf16_t* dst; int ld; float sc;
    __device__ __forceinline__ uint2 pack4(f32x4 v) const { uint2 o; o.x = pack2bf(sc * v[0], sc * v[1]); o.y = pack2bf(sc * v[2], sc * v[3]); return o; }
    __device__ __forceinline__ void store8(int m, int n, uint4 o) const { *(uint4*)(dst + (size_t)m * ld + (n & 127)) = o; }
};
struct EpiProjLF {
    static constexpr bool kBf16 = false;
    unsigned char* ws;
    __device__ __forceinline__ void row4(int m, int n, float4 v) const {
        const int c = n - 512;
        const float4 lb = *(const float4*)((const float*)(ws + OFF_LBV) + c);
        float4 o;
        o.x = log_fast(lb.x + (1.f - lb.x) * sigmoid_fast(v.x)); o.y = log_fast(lb.y + (1.f - lb.y) * sigmoid_fast(v.y));
        o.z = log_fast(lb.z + (1.f - lb.z) * sigmoid_fast(v.z)); o.w = log_fast(lb.w + (1.f - lb.w) * sigmoid_fast(v.w));
        *(float4*)((float*)(ws + OFF_HLF) + (size_t)m * 512 + c) = o;
    }
};
struct EpiProjGate {
    static constexpr bool kBf16 = false;
    unsigned char* ws;
    __device__ __forceinline__ void row4(int m, int n, float4 v) const {
        const int c = n - 3328;
        if (c < 24)
            *(float4*)((float*)(ws + OFF_NGATE) + (size_t)m * 24 + c) =
                make_float4(sigmoid_fast(v.x), sigmoid_fast(v.y), sigmoid_fast(v.z), sigmoid_fast(v.w));
    }
};
struct EpiProj {
    static constexpr bool kRow = true;
    unsigned char* ws;
    template <class F> __device__ __forceinline__ void dispatch(int n0, F f) const {
        const int ct = __builtin_amdgcn_readfirstlane(n0 >> 7);
        if (ct >= 4 && ct < 8) f(EpiProjLF{ws});
        else if (ct >= 26) f(EpiProjGate{ws});
        else {
            size_t off; int ld = 512, c0 = (ct & 3) * 128; float sc = 1.f;
            if (ct < 4) off = OFF_HQ;
            else if (ct < 12) off = OFF_HI;
            else if (ct < 16) off = OFF_HG;
            else if (ct < 20) { off = OFF_NQ; sc = 0.125f * 1.4426950408889634f; }
            else { off = OFF_KV + (size_t)(ct - 20) * KV_STRIDE; ld = 128; c0 = 0; }
            f(EpiProjBf{(bf16_t*)(ws + off) + c0, ld, sc});
        }
    }
    __device__ __forceinline__ void finish(int, int) const {}
};
struct EpiMix {
    static constexpr bool kRow = true;
    bf16_t* mix;
    template <class F> __device__ __forceinline__ void dispatch(int n0, F f) const { f(EpiProjBf{mix + n0, DM, 1.f}); }
    __device__ __forceinline__ void finish(int, int) const {}
};

__device__ __forceinline__ uint4 pack8bf(const float* v) {
    uint4 o;
    o.x = pack2bf(v[0], v[1]); o.y = pack2bf(v[2], v[3]); o.z = pack2bf(v[4], v[5]); o.w = pack2bf(v[6], v[7]);
    return o;
}

__device__ __forceinline__ void hgrn_passA(const Params& p, int chunk, unsigned char* smem) {
    const int c = chunk & 127, bh = chunk >> 7, h = bh & 3, b = bh >> 2;
    const int tid = opaque_tid(), d = tid & 127, hf = __builtin_amdgcn_readfirstlane(tid >> 7), lane = tid & 63, w = __builtin_amdgcn_readfirstlane(tid >> 6);
    const size_t tok0 = (size_t)b * SEQ + (size_t)c * 64 + 32 * hf;
    const float* HLF = (const float*)(p.ws + OFF_HLF);
    const bf16_t* HI = (const bf16_t*)(p.ws + OFF_HI);
    unsigned char* KT = smem;
    unsigned char* VT = smem + 16384;
    float* xch = (float*)(smem + 32768);
    const float* lfp = HLF + tok0 * 512 + h * 128 + d;
    const bf16_t* vp = HI + tok0 * 512 + h * 128 + d;
    float run = 0.f;
#pragma unroll 8
    for (int s = 0; s < 32; ++s) run += lfp[s * 512];
    __syncthreads();
    xch[hf * 128 + d] = run;
    __syncthreads();
    const float tot0 = xch[d], tot1 = xch[128 + d];
    const float blast = tot0 + tot1;
    run = hf ? tot0 : 0.f;
#pragma unroll 1
    for (int q = 0; q < 4; ++q) {
        float kv[8], vv[8];
#pragma unroll
        for (int j = 0; j < 8; ++j) {
            const int s = q * 8 + j;
            const float lf = lfp[s * 512];
            run += lf;
            kv[j] = (1.f - expf(lf)) * expf(blast - run);
            vv[j] = bf2f(vp[s * 512]);
        }
        const int ch = 4 * hf + q;
        *(uint4*)(KT + d * 128 + ((ch ^ (d & 7)) << 4)) = pack8bf(kv);
        *(uint4*)(VT + d * 128 + ((ch ^ (d & 7)) << 4)) = pack8bf(vv);
    }
    if (hf) ((float*)(p.ws + OFF_DC))[(size_t)chunk * 128 + d] = expf(blast);
    __syncthreads();
    f32x4 acc[2][8];
#pragma unroll
    for (int i = 0; i < 2; ++i)
#pragma unroll
        for (int et = 0; et < 8; ++et) acc[i][et] = (f32x4){0.f, 0.f, 0.f, 0.f};
#pragma unroll
    for (int st = 0; st < 2; ++st) {
        const int ch = st * 4 + (lane >> 4);
        bf16x8 af[2];
#pragma unroll
        for (int i = 0; i < 2; ++i) {
            const int row = (2 * w + i) * 16 + (lane & 15);
            af[i] = *(const bf16x8*)(KT + row * 128 + ((ch ^ (row & 7)) << 4));
        }
#pragma unroll
        for (int et = 0; et < 8; ++et) {
            const int row = et * 16 + (lane & 15);
            const bf16x8 bfv = *(const bf16x8*)(VT + row * 128 + ((ch ^ (row & 7)) << 4));
            acc[0][et] = __builtin_amdgcn_mfma_f32_16x16x32_bf16(af[0], bfv, acc[0][et], 0, 0, 0);
            acc[1][et] = __builtin_amdgcn_mfma_f32_16x16x32_bf16(af[1], bfv, acc[1][et], 0, 0, 0);
        }
    }
    bf16_t* HC = (bf16_t*)p.out + (size_t)chunk * 16384;
#pragma unroll
    for (int i = 0; i < 2; ++i)
#pragma unroll
        for (int et = 0; et < 8; ++et) {
            const int e = et * 16 + (lane & 15), d0 = (2 * w + i) * 16 + (lane >> 4) * 4;
            { uint2 hv; hv.x = pack2bf(acc[i][et][0], acc[i][et][1]); hv.y = pack2bf(acc[i][et][2], acc[i][et][3]); *(uint2*)(HC + e * 128 + d0) = hv; }
        }
}

__device__ __forceinline__ void hgrn_scan_item(const Params& p, int item) {
    const int gid = item * 256 + threadIdx.x;
    const int d4 = gid & 31, e = (gid >> 5) & 127, bh = gid >> 12;
    const bf16_t* HC = (const bf16_t*)p.out;
    const float* DC = (const float*)(p.ws + OFF_DC);
    bf16_t* SC = (bf16_t*)(p.ws + OFF_SC);
    float4 S = make_float4(0.f, 0.f, 0.f, 0.f);
#pragma unroll 4
    for (int c = 0; c < 128; ++c) {
        const size_t base = ((size_t)(bh * 128 + c) * 128 + e) * 128 + d4 * 4;
        const uint2 hb = *(const uint2*)(HC + base);
        const float4 H = make_float4(__uint_as_float(hb.x << 16), __uint_as_float(hb.x & 0xffff0000u), __uint_as_float(hb.y << 16), __uint_as_float(hb.y & 0xffff0000u));
        const float4 dc = *(const float4*)(DC + (size_t)(bh * 128 + c) * 128 + d4 * 4);
        uint2 o; o.x = pack2bf(S.x, S.y); o.y = pack2bf(S.z, S.w);
        *(uint2*)(SC + base) = o;
        S.x = dc.x * S.x + H.x; S.y = dc.y * S.y + H.y; S.z = dc.z * S.z + H.z; S.w = dc.w * S.w + H.w;
    }
}

__device__ __forceinline__ void hgrn_passC(const Params& p, int chunk, unsigned char* smem) {
    const int c = chunk & 127, bh = chunk >> 7, h = bh & 3, b = bh >> 2;
    const int tid = opaque_tid(), d = tid & 127, hf = __builtin_amdgcn_readfirstlane(tid >> 7), lane = tid & 63, w = __builtin_amdgcn_readfirstlane(tid >> 6);
    const size_t tokc = (size_t)b * SEQ + (size_t)c * 64;
    const size_t tok0 = tokc + 32 * hf;
    const float* HLF = (const float*)(p.ws + OFF_HLF);
    const bf16_t* HQ = (const bf16_t*)(p.ws + OFF_HQ);
    const bf16_t* HI = (const bf16_t*)(p.ws + OFF_HI);
    const bf16_t* HG = (const bf16_t*)(p.ws + OFF_HG);
    unsigned char* R0 = smem;
    unsigned char* R1 = smem + 16384;
    unsigned char* R2 = smem + 57344;
    float* xch = (float*)R2;
    const float* lfp = HLF + tok0 * 512 + h * 128 + d;
    const bf16_t* qp = HQ + tok0 * 512 + h * 128 + d;
    float run = 0.f, b15 = 0.f;
#pragma unroll 8
    for (int s = 0; s < 32; ++s) { run += lfp[s * 512]; if (s == 15) b15 = run; }
    __syncthreads();
    xch[hf * 128 + d] = run;
    if (hf == 0) xch[256 + d] = b15;
    __syncthreads();
    const float tot0 = xch[d];
    const float off = hf ? tot0 : 0.f;
    const float r1 = xch[256 + d], r2 = tot0;
    if (hf) xch[384 + d] = off + b15;
    run = off;
#pragma unroll 8
    for (int s = 0; s < 32; ++s) {
        const int t = 32 * hf + s;
        run += lfp[s * 512];
        const float qv = bf2f(qp[s * 512]);
        *(bf16_t*)(R0 + t * 256 + ((((d >> 3) ^ (t & 15))) << 4) + (d & 7) * 2) = (bf16_t)f2bf(qv * expf(run));
    }
    {
        const bf16_t* SCp = (const bf16_t*)(p.ws + OFF_SC) + (size_t)chunk * 16384;
#pragma unroll
        for (int i = 0; i < 8; ++i) {
            const int cc = tid + 256 * i, row = cc >> 4, ch = cc & 15;
            *(uint4*)(R1 + row * 256 + ((ch ^ (row & 15)) << 4)) = *(const uint4*)(SCp + row * 128 + ch * 8);
        }
    }
    __syncthreads();
    f32x4 acc[8];
#pragma unroll
    for (int et = 0; et < 8; ++et) acc[et] = (f32x4){0.f, 0.f, 0.f, 0.f};
#pragma unroll
    for (int ds = 0; ds < 4; ++ds) {
        const int ch = ds * 4 + (lane >> 4);
        const int trow = w * 16 + (lane & 15);
        const bf16x8 bq = *(const bf16x8*)(R0 + trow * 256 + ((ch ^ (trow & 15)) << 4));
#pragma unroll
        for (int et = 0; et < 8; ++et) {
            const int row = et * 16 + (lane & 15);
            const bf16x8 av = *(const bf16x8*)(R1 + row * 256 + ((ch ^ (row & 15)) << 4));
            acc[et] = __builtin_amdgcn_mfma_f32_16x16x32_bf16(av, bq, acc[et], 0, 0, 0);
        }
    }
    __syncthreads();
    {
        const float r3 = xch[384 + d];
        run = off;
        unsigned char* dummy = R2 + 4096 + d * 2;
#pragma unroll 8
        for (int s = 0; s < 32; ++s) {
            const int t = 32 * hf + s;
            const int it = t >> 4;
            const float rr = (it == 0) ? 0.f : (it == 1) ? r1 : (it == 2) ? r2 : r3;
            const int sw = (((d >> 3) ^ (t & 15)) << 4) + (d & 7) * 2;
            const float lf = lfp[s * 512];
            run += lf;
            const float qv = bf2f(qp[s * 512]);
            const float kv = 1.f - expf(lf);
            *(bf16_t*)(R0 + t * 256 + sw) = (bf16_t)f2bf(qv * expf(run - rr));
#pragma unroll
            for (int i = 0; i < 4; ++i) {
                const float ri = (i == 0) ? 0.f : (i == 1) ? r1 : (i == 2) ? r2 : r3;
                const int R = 8 * i * (i + 1) + t;
                unsigned char* dst = (i >= it) ? (R1 + R * 256 + sw) : dummy;
                *(bf16_t*)dst = (bf16_t)f2bf(kv * expf(fminf(ri - run, 80.f)));
            }
        }
    }
    __syncthreads();
#pragma unroll
    for (int j = 0; j < 4; ++j) {
        uint2 o = make_uint2(0u, 0u);
        if (j <= w) {
            f32x4 pa = (f32x4){0.f, 0.f, 0.f, 0.f};
#pragma unroll
            for (int ds = 0; ds < 4; ++ds) {
                const int ch = ds * 4 + (lane >> 4);
                const int krow = 8 * w * (w + 1) + 16 * j + (lane & 15);
                const int trow = w * 16 + (lane & 15);
                const bf16x8 av = *(const bf16x8*)(R1 + krow * 256 + ((ch ^ (krow & 15)) << 4));
                const bf16x8 bq = *(const bf16x8*)(R0 + trow * 256 + ((ch ^ (trow & 15)) << 4));
                pa = __builtin_amdgcn_mfma_f32_16x16x32_bf16(av, bq, pa, 0, 0, 0);
            }
            if (j == w) {
                const int tl = lane & 15, sl = (lane >> 4) * 4;
#pragma unroll
                for (int r = 0; r < 4; ++r) if (sl + r > tl) pa[r] = 0.f;
            }
            o.x = pack2bf(pa[0], pa[1]); o.y = pack2bf(pa[2], pa[3]);
        }
        const int t = w * 16 + (lane & 15);
        const int ch = 2 * j + (lane >> 5);
        *(uint2*)(R2 + t * 128 + ((ch ^ (t & 7)) << 4) + ((lane >> 4) & 1) * 8) = o;
    }
    __syncthreads();
#pragma unroll
    for (int q = 0; q < 4; ++q) {
        float vv[8];
#pragma unroll
        for (int j = 0; j < 8; ++j) vv[j] = bf2f(HI[(tok0 + q * 8 + j) * 512 + h * 128 + d]);
        const int ch = 4 * hf + q;
        *(uint4*)(R1 + d * 128 + ((ch ^ (d & 7)) << 4)) = pack8bf(vv);
    }
    __syncthreads();
#pragma unroll
    for (int st = 0; st < 2; ++st) {
        const int ch = st * 4 + (lane >> 4);
        const int trow = w * 16 + (lane & 15);
        const bf16x8 bp = *(const bf16x8*)(R2 + trow * 128 + ((ch ^ (trow & 7)) << 4));
#pragma unroll
        for (int et = 0; et < 8; ++et) {
            const int row = et * 16 + (lane & 15);
            const bf16x8 av = *(const bf16x8*)(R1 + row * 128 + ((ch ^ (row & 7)) << 4));
            acc[et] = __builtin_amdgcn_mfma_f32_16x16x32_bf16(av, bp, acc[et], 0, 0, 0);
        }
    }
    {
        float ss = 0.f;
#pragma unroll
        for (int et = 0; et < 8; ++et)
#pragma unroll
            for (int r = 0; r < 4; ++r) ss += acc[et][r] * acc[et][r];
        ss += __shfl_xor(ss, 16);
        ss += __shfl_xor(ss, 32);
        const float rs = rsqrtf(ss * (1.f / 128.f) + LN_EPS);
        const size_t tok = tokc + w * 16 + (lane & 15);
        const float* ng = p.in[4];
        bf16_t* MIX = (bf16_t*)(p.ws + OFF_XB);
#pragma unroll
        for (int et = 0; et < 8; ++et) {
            const int e0 = et * 16 + (lane >> 4) * 4;
            const uint2 gb = *(const uint2*)(HG + tok * 512 + h * 128 + e0);
            const float4 n4 = *(const float4*)(ng + e0);
            const float g0 = bf2f(gb.x & 0xffffu), g1 = bf2f(gb.x >> 16), g2 = bf2f(gb.y & 0xffffu), g3 = bf2f(gb.y >> 16);
            uint2 o;
            o.x = pack2bf(acc[et][0] * rs * n4.x * (g0 * sigmoidf_(g0)), acc[et][1] * rs * n4.y * (g1 * sigmoidf_(g1)));
            o.y = pack2bf(acc[et][2] * rs * n4.z * (g2 * sigmoidf_(g2)), acc[et][3] * rs * n4.w * (g3 * sigmoidf_(g3)));
            *(uint2*)(MIX + tok * DM + h * 128 + e0) = o;
        }
    }
}

__device__ __forceinline__ void compress_item(const Params& p, int item, float* sm) {
    const int g = item & 1;
    int r = item >> 1;
    const int n = r % NCB; r /= NCB;
    const int b = r & 3, which = r >> 2;
    const int tid = opaque_tid();
    const bf16_t* kvsrc = (const bf16_t*)(p.ws + OFF_KV + (size_t)which * KV_STRIDE);
    const float* pe = p.in[which ? 10 : 5];
    const float* w1 = p.in[which ? 11 : 6];
    const float* b1 = p.in[which ? 12 : 7];
    const float* w2 = p.in[which ? 13 : 8];
    const float* b2 = p.in[which ? 14 : 9];
    float* outp = (float*)(p.ws + (which ? OFF_CMPV : OFF_CMPK));
    float* blk = sm;
    float* hh = sm + 2048;
    __syncthreads();
    for (int i = tid; i < 2048; i += 256) {
        const int l = i >> 6, d = i & 63;
        blk[i] = bf2f(kvsrc[(size_t)(b * SEQ + 16 * n + l) * 128 + g * 64 + d]) + pe[i];
    }
    __syncthreads();
    float acc = b1[tid];
    for (int i = 0; i < 2048; ++i) acc += blk[i] * w1[(size_t)i * 256 + tid];
    hh[tid] = gelu_tanh(acc);
    __syncthreads();
    if (tid < 64) {
        float o = b2[tid];
        for (int j = 0; j < 256; ++j) o += hh[j] * w2[j * 64 + tid];
        outp[((size_t)(b * NCB + n) * 2 + g) * 64 + tid] = o;
    }
}

__device__ __forceinline__ float dot64_bf(const float* qs, const bf16_t* krow) {
    float s = 0.f;
#pragma unroll
    for (int i = 0; i < 8; ++i) {
        const uint4 kv = ((const uint4*)krow)[i];
        const float4 q0 = ((const float4*)qs)[2 * i], q1 = ((const float4*)qs)[2 * i + 1];
        s += __uint_as_float(kv.x << 16) * q0.x + __uint_as_float(kv.x & 0xffff0000u) * q0.y
           + __uint_as_float(kv.y << 16) * q0.z + __uint_as_float(kv.y & 0xffff0000u) * q0.w
           + __uint_as_float(kv.z << 16) * q1.x + __uint_as_float(kv.z & 0xffff0000u) * q1.y
           + __uint_as_float(kv.w << 16) * q1.z + __uint_as_float(kv.w & 0xffff0000u) * q1.w;
    }
    return s;
}
__device__ __forceinline__ float dot64(const float* qs, const float* krow) {
    float s = 0.f;
#pragma unroll
    for (int i = 0; i < 16; ++i) {
        const float4 kv = ((const float4*)krow)[i];
        const float4 qv = ((const float4*)qs)[i];
        s += kv.x * qv.x + kv.y * qv.y + kv.z * qv.z + kv.w * qv.w;
    }
    return s;
}

__device__ __forceinline__ void nsa_item(const Params& p, int item, float* sm) {
    const int t = item & (SEQ - 1), g = (item >> 13) & 1, b = item >> 14;
    const int tid = threadIdx.x, lane = tid & 63, r = tid >> 6;
    float* sc = sm + r * 1024;
    float* qs = sm + 4096 + r * 64;
    float* impv = sm + 4096 + 256;
    int* sel = (int*)(sm + 4096 + 256 + 128);
    const bf16_t* KSb = (const bf16_t*)(p.ws + OFF_KV + 2 * KV_STRIDE);
    const bf16_t* VSb = (const bf16_t*)(p.ws + OFF_KV + 3 * KV_STRIDE);
    const bf16_t* KWb = (const bf16_t*)(p.ws + OFF_KV + 4 * KV_STRIDE);
    const bf16_t* VWb = (const bf16_t*)(p.ws + OFF_KV + 5 * KV_STRIDE);
    const float* cmpk = (const float*)(p.ws + OFF_CMPK);
    const float* cmpv = (const float*)(p.ws + OFF_CMPV);
    const size_t n = (size_t)b * SEQ + t;
    const float NEGV = -1e30f;
    __syncthreads();
    qs[lane] = bf2f(((const bf16_t*)(p.ws + OFF_NQ))[n * 512 + g * 256 + r * 64 + lane]) * 0.6931471805599453f;
    __syncthreads();

    const int nvalid = (t >= 31) ? (((t - 31) >> 4) + 1) : 0;
    float m = NEGV;
    for (int n0 = 0; n0 < nvalid; n0 += 64) {
        const int nn = n0 + lane;
        if (nn < nvalid) {
            const float s = dot64(qs, cmpk + ((size_t)(b * NCB + nn) * 2 + g) * 64);
            sc[nn] = s;
            m = fmaxf(m, s);
        }
    }
    m = wave_max(m);
    float sum = 0.f;
    for (int n0 = 0; n0 < nvalid; n0 += 64) {
        const int nn = n0 + lane;
        if (nn < nvalid) { const float e = expf(sc[nn] - m); sc[nn] = e; sum += e; }
    }
    sum = wave_sum(sum);
    {
        const float inv = 1.f / fmaxf(sum, 1e-30f);
        for (int n0 = 0; n0 < nvalid; n0 += 64) {
            const int nn = n0 + lane;
            if (nn < nvalid) sc[nn] *= inv;
        }
    }
    __syncthreads();
    float oc = 0.f;
    for (int nn = 0; nn < nvalid; ++nn) oc += sc[nn] * cmpv[((size_t)(b * NCB + nn) * 2 + g) * 64 + lane];

    const int cur = t >> 6;
    if (tid < 128) {
        const int j = tid;
        float im = 0.f;
#pragma unroll
        for (int rr = 0; rr < 4; ++rr) {
            const float* P = sm + rr * 1024;
            const int n4 = 4 * j;
            float a = 0.f;
            if (n4 < nvalid) a += P[n4];
            if (n4 + 1 < nvalid) a += P[n4 + 1];
            if (n4 + 2 < nvalid) a += P[n4 + 2];
            if (n4 + 3 < nvalid) a += 0.5f * P[n4 + 3];
            if (n4 - 1 >= 0 && n4 - 1 < nvalid) a += 0.5f * P[n4 - 1];
            im += a;
        }
        const bool forced = (j == 0) || (j == cur) || (j == cur - 1);
        const bool causal = (j <= cur);
        impv[j] = forced ? 1.0e4f : (causal ? im : -1.f);
    }
    __syncthreads();
    if (r == 0) {
        float v0 = impv[lane], v1 = impv[lane + 64];
        for (int k = 0; k < 16; ++k) {
            const float mx = wave_max(fmaxf(v0, v1));
            const unsigned long long b0 = __ballot(v0 == mx);
            int idx;
            if (b0) {
                const int l = __ffsll((unsigned long long)b0) - 1;
                idx = l;
                if (lane == l) v0 = -3.0e38f;
            } else {
                const unsigned long long b1 = __ballot(v1 == mx);
                const int l = __ffsll((unsigned long long)b1) - 1;
                idx = 64 + l;
                if (lane == l) v1 = -3.0e38f;
            }
            if (lane == 0) sel[k] = idx;
        }
    }
    __syncthreads();

    m = NEGV;
    for (int si = 0; si < 16; ++si) {
        const int blk = sel[si];
        const int key = blk * 64 + lane;
        float s = NEGV;
        if (blk * 64 <= t) {
            if (key <= t) s = dot64_bf(qs, KSb + ((size_t)b * SEQ + key) * 128 + g * 64);
        }
        sc[si * 64 + lane] = s;
        m = fmaxf(m, s);
    }
    m = wave_max(m);
    sum = 0.f;
    for (int si = 0; si < 16; ++si) {
        const int key = sel[si] * 64 + lane;
        const float e = (key <= t) ? expf(sc[si * 64 + lane] - m) : 0.f;
        sc[si * 64 + lane] = e;
        sum += e;
    }
    sum = wave_sum(sum);
    {
        const float inv = 1.f / fmaxf(sum, 1e-30f);
        for (int si = 0; si < 16; ++si) sc[si * 64 + lane] *= inv;
    }
    __syncthreads();
    float os = 0.f;
    for (int si = 0; si < 16; ++si) {
        const int blk = sel[si];
        if (blk * 64 > t) continue;
        for (int kk = 0; kk < 64; ++kk) {
            const int key = blk * 64 + kk;
            if (key > t) break;
            os += sc[si * 64 + kk] * bf2f(VSb[((size_t)b * SEQ + key) * 128 + g * 64 + lane]);
        }
    }
    __syncthreads();

    const int lo = t - 511;
    m = NEGV;
    for (int i = 0; i < 8; ++i) {
        const int key = lo + i * 64 + lane;
        float s = NEGV;
        if (key >= 0) s = dot64_bf(qs, KWb + ((size_t)b * SEQ + key) * 128 + g * 64);
        sc[i * 64 + lane] = s;
        m = fmaxf(m, s);
    }
    m = wave_max(m);
    sum = 0.f;
    for (int i = 0; i < 8; ++i) {
        const int key = lo + i * 64 + lane;
        const float e = (key >= 0) ? expf(sc[i * 64 + lane] - m) : 0.f;
        sc[i * 64 + lane] = e;
        sum += e;
    }
    sum = wave_sum(sum);
    {
        const float inv = 1.f / fmaxf(sum, 1e-30f);
        for (int i = 0; i < 8; ++i) sc[i * 64 + lane] *= inv;
    }
    __syncthreads();
    float ow = 0.f;
    for (int idx = 0; idx < 512; ++idx) {
        const int key = lo + idx;
        if (key < 0) continue;
        ow += sc[idx] * bf2f(VWb[((size_t)b * SEQ + key) * 128 + g * 64 + lane]);
    }
    const float* grow = (const float*)(p.ws + OFF_NGATE) + n * 24 + g * 12 + r * 3;
    const float gc = grow[0], gs = grow[1], gw = grow[2];
#if NSA_DIAG
    {
        const float ref = gc * oc + gs * os + gw * ow;
        const float got = bf2f(((const bf16_t*)(p.ws + OFF_XB))[n * DM + 512 + g * 256 + r * 64 + lane]);
        const unsigned* SELM = (const unsigned*)(p.ws + OFF_SELM) + ((size_t)(b * 2 + g) * SEQ + t) * 4;
        unsigned gm[4] = {0u, 0u, 0u, 0u};
        for (int si = 0; si < 16; ++si) { const int blk = sel[si]; if (blk * 64 <= t) gm[blk >> 5] |= 1u << (blk & 31); }
        bool same = true;
        for (int qd = 0; qd < 4; ++qd) {
            unsigned mm = SELM[qd];
            for (int bit = 0; bit < 32; ++bit) if ((qd * 32 + bit) * 64 > t) mm &= ~(1u << bit);
            if (mm != gm[qd]) same = false;
        }
        float d2 = same ? (got - ref) * (got - ref) : 0.f, r2 = same ? ref * ref : 0.f;
        d2 = wave_sum(d2); r2 = wave_sum(r2);
        float* DG = (float*)(p.ws + OFF_DIAG);
        if (lane == 0) { atomicAdd(&DG[0], d2); atomicAdd(&DG[1], r2); if (r == 0) { atomicAdd(&DG[2], same ? 0.f : 1.f); atomicAdd(&DG[3], 1.f); } }
    }
#else
    ((bf16_t*)(p.ws + OFF_XB))[n * DM + 512 + g * 256 + r * 64 + lane] = (bf16_t)f2bf(gc * oc + gs * os + gw * ow);
#endif
}


__device__ __forceinline__ float xrow_max(float x) {
    auto s = __builtin_amdgcn_permlane16_swap(__float_as_uint(x), __float_as_uint(x), false, false);
    x = fmaxf(__uint_as_float(s[0]), __uint_as_float(s[1]));
    auto t = __builtin_amdgcn_permlane32_swap(__float_as_uint(x), __float_as_uint(x), false, false);
    return fmaxf(__uint_as_float(t[0]), __uint_as_float(t[1]));
}
__device__ __forceinline__ float xrow_sum(float x) {
    auto s = __builtin_amdgcn_permlane16_swap(__float_as_uint(x), __float_as_uint(x), false, false);
    x = __uint_as_float(s[0]) + __uint_as_float(s[1]);
    auto t = __builtin_amdgcn_permlane32_swap(__float_as_uint(x), __float_as_uint(x), false, false);
    return __uint_as_float(t[0]) + __uint_as_float(t[1]);
}
template <int CTRL> __device__ __forceinline__ float dppf(float x) {
    return __builtin_bit_cast(float, __builtin_amdgcn_mov_dpp(__builtin_bit_cast(int, x), CTRL, 0xf, 0xf, true));
}
__device__ __forceinline__ float row16_max(float m) {
    m = fmaxf(m, dppf<0x121>(m)); m = fmaxf(m, dppf<0x122>(m));
    m = fmaxf(m, dppf<0x124>(m)); m = fmaxf(m, dppf<0x128>(m));
    return m;
}
__device__ __forceinline__ float row16_sum(float m) {
    m += dppf<0x121>(m); m += dppf<0x122>(m); m += dppf<0x124>(m); m += dppf<0x128>(m);
    return m;
}
__device__ __forceinline__ float dot2bf(unsigned a, unsigned b, float acc) {
    return __builtin_amdgcn_fdot2_f32_bf16(__builtin_bit_cast(bf16x2_t, a), __builtin_bit_cast(bf16x2_t, b), acc, false);
}
__device__ __forceinline__ float enc_key(float v, unsigned idx, unsigned mask) {
    const unsigned u = __float_as_uint(v);
    const unsigned code = (u >> 31) ? idx : (mask - idx);
    return __uint_as_float((u & ~mask) | code);
}
__device__ __forceinline__ unsigned dec_idx(float key, unsigned mask) {
    const unsigned u = __float_as_uint(key);
    const unsigned code = u & mask;
    return (u >> 31) ? code : (mask - code);
}
__device__ __forceinline__ float dec_val(float key, unsigned mask) { return __uint_as_float(__float_as_uint(key) & ~mask); }
#define NEGKEY (-3.0e38f)
#define CE_DESC(a, b) { const float t_ = fmaxf(a, b); b = fminf(a, b); a = t_; }

struct EpiCmpH {
    bf16_t* HB; const float* peb;
    __device__ __forceinline__ void operator()(int m, int n, f32x4 v) const {
        const float4 pb = *(const float4*)(peb + n);
        uint2 o;
        o.x = pack2bf(gelu_tanh(v[0] + pb.x), gelu_tanh(v[1] + pb.y));
        o.y = pack2bf(gelu_tanh(v[2] + pb.z), gelu_tanh(v[3] + pb.w));
        *(uint2*)(HB + (size_t)m * 256 + n) = o;
    }
    __device__ __forceinline__ void finish(int, int) const {}
};
__device__ __forceinline__ void cmp_peb(const Params& p, int which) {
    const float* pe = p.in[which ? 10 : 5];
    const float* w1 = p.in[which ? 11 : 6];
    const float* b1 = p.in[which ? 12 : 7];
    const int j = threadIdx.x;
    float acc = b1[j];
    for (int i = 0; i < 2048; ++i) acc += pe[i] * w1[(size_t)i * 256 + j];
    ((float*)(p.ws + OFF_PEB))[which * 256 + j] = acc;
}
__device__ __forceinline__ void cmp_layer2_phase(const Params& p, int first_block, int nblocks) {
    const int tid_ = opaque_tid(), lane = tid_ & 63, w = __builtin_amdgcn_readfirstlane(tid_ >> 6);
    for (int it = (blockIdx.x - first_block) * 4 + w; it < 2 * 4088; it += nblocks * 4) {
        const int which = it >= 4088, row = which ? it - 4088 : it;
        const float* w2 = p.in[which ? 13 : 8];
        const float* b2 = p.in[which ? 14 : 9];
        const bf16_t* hrow = (const bf16_t*)(p.ws + OFF_HB) + ((size_t)which * 4096 + row) * 256;
        float o = b2[lane];
#pragma unroll 8
        for (int j = 0; j < 256; ++j) o += bf2f(hrow[j]) * w2[j * 64 + lane];
        const int g = row & 1, bn = row >> 1, n = bn % NCB, b = bn / NCB;
        ((bf16_t*)(p.ws + (which ? OFF_CMPVB : OFF_CMPKB)))[((size_t)(b * 2 + g) * 512 + n) * 64 + lane] = (bf16_t)f2bf(o);
    }
}

struct StageOfs { int k, v; };
__device__ __forceinline__ StageOfs make_stage_ofs() {
    const int c0 = opaque_tid(), key = c0 >> 3, ch = c0 & 7;
    StageOfs s;
    s.k = key * 128 + ((ch ^ (key & 7)) << 4);
    s.v = key * 128 + (((ch >> 1) ^ ((key >> 1) & 3)) << 5) + (ch & 1) * 16;
    return s;
}
#define NSA_KV_LOAD(S_, kb_) { const bf16_t* kp_ = Kbase + (size_t)(kb_) * 64 * stride + (size_t)(tid >> 3) * stride + (tid & 7) * 8; \
        const bf16_t* vp_ = Vbase + (size_t)(kb_) * 64 * stride + (size_t)(tid >> 3) * stride + (tid & 7) * 8;                 \
        S_##k0 = *(const uint4*)kp_; S_##k1 = *(const uint4*)(kp_ + (size_t)32 * stride);                                    \
        S_##v0 = *(const uint4*)vp_; S_##v1 = *(const uint4*)(vp_ + (size_t)32 * stride); }
#define NSA_KV_STORE(S_, Kl_, Vl_) { *(uint4*)((Kl_) + sof.k) = S_##k0; *(uint4*)((Kl_) + sof.k + 4096) = S_##k1; \
        *(uint4*)((Vl_) + sof.v) = S_##v0; *(uint4*)((Vl_) + sof.v + 4096) = S_##v1; }
template <class Compute>
__device__ __forceinline__ void nsa_kv_loop(const bf16_t* __restrict__ Kbase, const bf16_t* __restrict__ Vbase, int stride,
                                            int kb_lo, int kb_hi, unsigned char* smem, const StageOfs& sof, Compute compute) {
    const int tid = opaque_tid();
    uint4 ra_k0, ra_k1, ra_v0, ra_v1;
    NSA_KV_LOAD(ra_, kb_lo)
    __syncthreads();
    NSA_KV_STORE(ra_, smem, smem + 16384)
    __syncthreads();
    for (int kb = kb_lo; kb <= kb_hi; ++kb) {
        const int buf = (kb - kb_lo) & 1;
        if (kb < kb_hi) NSA_KV_LOAD(ra_, kb + 1)
        compute(kb, smem + buf * 8192, smem + 16384 + buf * 8192);
        if (kb < kb_hi) NSA_KV_STORE(ra_, smem + (buf ^ 1) * 8192, smem + 16384 + (buf ^ 1) * 8192)
        __syncthreads();
    }
}
struct LaneOfs { int k0, k1, vb0, vb1, vb2, vb3; };
__device__ __forceinline__ LaneOfs make_lane_ofs(int lane) {
    LaneOfs f;
    const int r15 = lane & 15, lg = lane >> 4, q = r15 >> 2, pp = r15 & 3;
    f.k0 = r15 * 128 + ((lg ^ (r15 & 7)) << 4);
    f.k1 = r15 * 128 + (((4 + lg) ^ (r15 & 7)) << 4);
    const int sw2 = (2 * (lg & 1) + (q >> 1)) & 3;
    const int vrow = (4 * lg + q) * 128 + pp * 8;
    f.vb0 = vrow + ((0 ^ sw2) << 5); f.vb1 = vrow + ((1 ^ sw2) << 5);
    f.vb2 = vrow + ((2 ^ sw2) << 5); f.vb3 = vrow + ((3 ^ sw2) << 5);
    return f;
}
typedef short s16x4 __attribute__((ext_vector_type(4)));
__device__ __forceinline__ uint2 tr_read(const unsigned char* p) {
    const s16x4 v = __builtin_amdgcn_ds_read_tr16_b64_v4i16((LAS3 s16x4*)p);
    return __builtin_bit_cast(uint2, v);
}
#define NEGM (-1.0e37f)
__device__ __forceinline__ void nsa_scores(const unsigned char* Kl, const LaneOfs& f, const bf16x8& q0, const bf16x8& q1, float bias, f32x4 (&s)[4]) {
#pragma unroll
    for (int kt = 0; kt < 4; ++kt) {
        const bf16x8 a0 = *(const bf16x8*)(Kl + f.k0 + kt * 2048);
        const bf16x8 a1 = *(const bf16x8*)(Kl + f.k1 + kt * 2048);
        f32x4 z = (f32x4){bias, bias, bias, bias};
        z = __builtin_amdgcn_mfma_f32_16x16x32_bf16(a0, q0, z, 0, 0, 0);
        s[kt] = __builtin_amdgcn_mfma_f32_16x16x32_bf16(a1, q1, z, 0, 0, 0);
    }
}
#define ONES_BF16X8 __builtin_bit_cast(bf16x8, make_uint4(0x3F803F80u, 0x3F803F80u, 0x3F803F80u, 0x3F803F80u))
template <class VF>
__device__ __forceinline__ void attn_step(const unsigned char* Kl, const unsigned char* Vl, int lane, const LaneOfs& f,
                                          const bf16x8& q0, const bf16x8& q1, f32x4 (&o)[4], float& m, f32x4& lacc,
                                          float rowbias, bool full, VF valid) {
    f32x4 s[4];
    const bool mok = m > -1e29f;
    const float meff = mok ? m : 0.f;
    nsa_scores(Kl, f, q0, q1, rowbias - meff, s);
    if (!full) {
#pragma unroll
        for (int kt = 0; kt < 4; ++kt)
#pragma unroll
            for (int r = 0; r < 4; ++r) s[kt][r] = valid(kt * 16 + 4 * (lane >> 4) + r) ? s[kt][r] : NEGM;
    }
    float mx = fmaxf(fmaxf(fmaxf(s[0][0], s[0][1]), fmaxf(s[0][2], s[0][3])), fmaxf(fmaxf(s[1][0], s[1][1]), fmaxf(s[1][2], s[1][3])));
    mx = fmaxf(mx, fmaxf(fmaxf(fmaxf(s[2][0], s[2][1]), fmaxf(s[2][2], s[2][3])), fmaxf(fmaxf(s[3][0], s[3][1]), fmaxf(s[3][2], s[3][3]))));
    mx = xrow_max(mx);
    if (!__all(mok && (mx <= 8.f))) {
        const float mn = fmaxf(m, meff + mx);
        const float alpha = __builtin_amdgcn_exp2f(m - mn), d = mn - meff;
        m = mn; lacc[0] *= alpha;
#pragma unroll
        for (int dt = 0; dt < 4; ++dt) { o[dt][0] *= alpha; o[dt][1] *= alpha; o[dt][2] *= alpha; o[dt][3] *= alpha; }
#pragma unroll
        for (int kt = 0; kt < 4; ++kt) { s[kt][0] -= d; s[kt][1] -= d; s[kt][2] -= d; s[kt][3] -= d; }
    }
#pragma unroll
    for (int kt = 0; kt < 4; ++kt)
#pragma unroll
        for (int r = 0; r < 4; ++r) s[kt][r] = __builtin_amdgcn_exp2f(s[kt][r]);
#pragma unroll
    for (int k2 = 0; k2 < 2; ++k2) {
        uint4 pk;
        pk.x = pack2bf(s[2 * k2][0], s[2 * k2][1]); pk.y = pack2bf(s[2 * k2][2], s[2 * k2][3]);
        pk.z = pack2bf(s[2 * k2 + 1][0], s[2 * k2 + 1][1]); pk.w = pack2bf(s[2 * k2 + 1][2], s[2 * k2 + 1][3]);
        const bf16x8 pb = __builtin_bit_cast(bf16x8, pk);
        lacc = __builtin_amdgcn_mfma_f32_16x16x32_bf16(ONES_BF16X8, pb, lacc, 0, 0, 0);
#define PV1(dt_, vb_) { const uint2 lo_ = tr_read(Vl + (vb_) + k2 * 4096), hi_ = tr_read(Vl + (vb_) + k2 * 4096 + 2048); \
                        uint4 av_; av_.x = lo_.x; av_.y = lo_.y; av_.z = hi_.x; av_.w = hi_.y;                          \
                        o[dt_] = __builtin_amdgcn_mfma_f32_16x16x32_bf16(__builtin_bit_cast(bf16x8, av_), pb, o[dt_], 0, 0, 0); }
        PV1(0, f.vb0) PV1(1, f.vb1) PV1(2, f.vb2) PV1(3, f.vb3)
#undef PV1
    }
}
template <class VFA, class VFB>
__device__ __forceinline__ void attn_step2(const unsigned char* Kl, const unsigned char* Vl, int lane, const LaneOfs& f,
                                           const bf16x8& qA0, const bf16x8& qA1, f32x4 (&oA)[4], float& mA, f32x4& lA, float biasA, bool fullA, VFA validA,
                                           const bf16x8& qB0, const bf16x8& qB1, f32x4 (&oB)[4], float& mB, f32x4& lB, float biasB, bool fullB, VFB validB) {
    f32x4 sA[4], sB[4];
    const bool mokA = mA > -1e29f, mokB = mB > -1e29f;
    const float meA = mokA ? mA : 0.f, meB = mokB ? mB : 0.f;
    const float iA = biasA - meA, iB = biasB - meB;
#pragma unroll
    for (int kt = 0; kt < 4; ++kt) {
        const bf16x8 a0 = *(const bf16x8*)(Kl + f.k0 + kt * 2048);
        const bf16x8 a1 = *(const bf16x8*)(Kl + f.k1 + kt * 2048);
        f32x4 zA = (f32x4){iA, iA, iA, iA}, zB = (f32x4){iB, iB, iB, iB};
        zA = __builtin_amdgcn_mfma_f32_16x16x32_bf16(a0, qA0, zA, 0, 0, 0);
        zB = __builtin_amdgcn_mfma_f32_16x16x32_bf16(a0, qB0, zB, 0, 0, 0);
        sA[kt] = __builtin_amdgcn_mfma_f32_16x16x32_bf16(a1, qA1, zA, 0, 0, 0);
        sB[kt] = __builtin_amdgcn_mfma_f32_16x16x32_bf16(a1, qB1, zB, 0, 0, 0);
    }
    if (!fullA) {
#pragma unroll
        for (int kt = 0; kt < 4; ++kt)
#pragma unroll
            for (int r = 0; r < 4; ++r) sA[kt][r] = validA(kt * 16 + 4 * (lane >> 4) + r) ? sA[kt][r] : NEGM;
    }
    if (!fullB) {
#pragma unroll
        for (int kt = 0; kt < 4; ++kt)
#pragma unroll
            for (int r = 0; r < 4; ++r) sB[kt][r] = validB(kt * 16 + 4 * (lane >> 4) + r) ? sB[kt][r] : NEGM;
    }
    float mxA = fmaxf(fmaxf(fmaxf(sA[0][0], sA[0][1]), fmaxf(sA[0][2], sA[0][3])), fmaxf(fmaxf(sA[1][0], sA[1][1]), fmaxf(sA[1][2], sA[1][3])));
    float mxB = fmaxf(fmaxf(fmaxf(sB[0][0], sB[0][1]), fmaxf(sB[0][2], sB[0][3])), fmaxf(fmaxf(sB[1][0], sB[1][1]), fmaxf(sB[1][2], sB[1][3])));
    mxA = fmaxf(mxA, fmaxf(fmaxf(fmaxf(sA[2][0], sA[2][1]), fmaxf(sA[2][2], sA[2][3])), fmaxf(fmaxf(sA[3][0], sA[3][1]), fmaxf(sA[3][2], sA[3][3]))));
    mxB = fmaxf(mxB, fmaxf(fmaxf(fmaxf(sB[2][0], sB[2][1]), fmaxf(sB[2][2], sB[2][3])), fmaxf(fmaxf(sB[3][0], sB[3][1]), fmaxf(sB[3][2], sB[3][3]))));
    mxA = xrow_max(mxA); mxB = xrow_max(mxB);
    if (!__all(mokA && mokB && (mxA <= 8.f) && (mxB <= 8.f))) {
        const float mnA = fmaxf(mA, meA + mxA), mnB = fmaxf(mB, meB + mxB);
        const float alA = __builtin_amdgcn_exp2f(mA - mnA), alB = __builtin_amdgcn_exp2f(mB - mnB);
        const float dA = mnA - meA, dB = mnB - meB;
        mA = mnA; mB = mnB; lA[0] *= alA; lB[0] *= alB;
#pragma unroll
        for (int dt = 0; dt < 4; ++dt) {
            oA[dt][0] *= alA; oA[dt][1] *= alA; oA[dt][2] *= alA; oA[dt][3] *= alA;
            oB[dt][0] *= alB; oB[dt][1] *= alB; oB[dt][2] *= alB; oB[dt][3] *= alB;
        }
#pragma unroll
        for (int kt = 0; kt < 4; ++kt) {
            sA[kt][0] -= dA; sA[kt][1] -= dA; sA[kt][2] -= dA; sA[kt][3] -= dA;
            sB[kt][0] -= dB; sB[kt][1] -= dB; sB[kt][2] -= dB; sB[kt][3] -= dB;
        }
    }
#pragma unroll
    for (int kt = 0; kt < 4; ++kt)
#pragma unroll
        for (int r = 0; r < 4; ++r) { sA[kt][r] = __builtin_amdgcn_exp2f(sA[kt][r]); sB[kt][r] = __builtin_amdgcn_exp2f(sB[kt][r]); }
#pragma unroll
    for (int k2 = 0; k2 < 2; ++k2) {
        uint4 pk;
        pk.x = pack2bf(sA[2 * k2][0], sA[2 * k2][1]); pk.y = pack2bf(sA[2 * k2][2], sA[2 * k2][3]);
        pk.z = pack2bf(sA[2 * k2 + 1][0], sA[2 * k2 + 1][1]); pk.w = pack2bf(sA[2 * k2 + 1][2], sA[2 * k2 + 1][3]);
        const bf16x8 pbA = __builtin_bit_cast(bf16x8, pk);
        pk.x = pack2bf(sB[2 * k2][0], sB[2 * k2][1]); pk.y = pack2bf(sB[2 * k2][2], sB[2 * k2][3]);
        pk.z = pack2bf(sB[2 * k2 + 1][0], sB[2 * k2 + 1][1]); pk.w = pack2bf(sB[2 * k2 + 1][2], sB[2 * k2 + 1][3]);
        const bf16x8 pbB = __builtin_bit_cast(bf16x8, pk);
        lA = __builtin_amdgcn_mfma_f32_16x16x32_bf16(ONES_BF16X8, pbA, lA, 0, 0, 0);
        lB = __builtin_amdgcn_mfma_f32_16x16x32_bf16(ONES_BF16X8, pbB, lB, 0, 0, 0);
#define PV2(dt_, vb_) { const uint2 lo_ = tr_read(Vl + (vb_) + k2 * 4096), hi_ = tr_read(Vl + (vb_) + k2 * 4096 + 2048); \
                        uint4 av_; av_.x = lo_.x; av_.y = lo_.y; av_.z = hi_.x; av_.w = hi_.y;                          \
                        oA[dt_] = __builtin_amdgcn_mfma_f32_16x16x32_bf16(__builtin_bit_cast(bf16x8, av_), pbA, oA[dt_], 0, 0, 0); \
                        oB[dt_] = __builtin_amdgcn_mfma_f32_16x16x32_bf16(__builtin_bit_cast(bf16x8, av_), pbB, oB[dt_], 0, 0, 0); }
        PV2(0, f.vb0) PV2(1, f.vb1) PV2(2, f.vb2) PV2(3, f.vb3)
#undef PV2
    }
}

#define NSA_TILES 2048
__device__ __forceinline__ void nsa_tile(const Params& p, int tile, unsigned char* smem) {
    const int tid = opaque_tid(), lane = tid & 63, w = __builtin_amdgcn_readfirstlane(tid >> 6);
    const int bg = tile & 7, tb = 255 - (tile >> 3);
    const int b = bg >> 1, g = bg & 1;
    const int t0 = tb * 32, cur = t0 >> 6;
    float* impL = (float*)(smem + 32768);
    unsigned* selL = (unsigned*)(smem + 49152);
    const bf16_t* NQ = (const bf16_t*)(p.ws + OFF_NQ);
    const float* NG = (const float*)(p.ws + OFF_NGATE);
    const int rowq = lane & 15, tl = rowq >> 2, head = rowq & 3, lg = lane >> 4;
    const int toklA = 8 * w + tl, toklB = 8 * w + 4 + tl;
    const LaneOfs lof = make_lane_ofs(lane);
    const StageOfs sof = make_stage_ofs();
    const size_t tokb = (size_t)b * SEQ + t0;
    bf16x8 qA0, qA1, qB0, qB1;
    {
        const bf16_t* qp = NQ + (tokb + toklA) * 512 + g * 256 + head * 64 + lg * 8;
        qA0 = *(const bf16x8*)qp; qA1 = *(const bf16x8*)(qp + 32);
        qB0 = *(const bf16x8*)(qp + 4 * 512); qB1 = *(const bf16x8*)(qp + 4 * 512 + 32);
    }
    const float* gpA = NG + (tokb + toklA) * 24 + g * 12 + head * 3;
    const float* gpB = gpA + 4 * 24;
    __syncthreads();
    for (int i = tid; i < 4096; i += 256) impL[i] = 0.f;
    const int tqA = t0 + toklA, tqB = t0 + toklB;
    const int tminA = t0 + 8 * w, tminB = tminA + 4;
    f32x4 oA[4], oB[4], otA[4], otB[4];
    float mA, mB;
    f32x4 lA, lB;
#define NSA_RESET() { _Pragma("unroll") for (int dt = 0; dt < 4; ++dt) { oA[dt] = (f32x4){0.f, 0.f, 0.f, 0.f}; oB[dt] = (f32x4){0.f, 0.f, 0.f, 0.f}; } \
                      mA = -1e30f; mB = -1e30f; lA = (f32x4){0.f, 0.f, 0.f, 0.f}; lB = (f32x4){0.f, 0.f, 0.f, 0.f}; }
#define NSA_LSUM() { }

    const int nvA = (tqA >= 31) ? (((tqA - 31) >> 4) + 1) : 0;
    const int nvB = (tqB >= 31) ? (((tqB - 31) >> 4) + 1) : 0;
    const int nvminA = (tminA >= 31) ? (((tminA - 31) >> 4) + 1) : 0;
    const int nvminB = (tminB >= 31) ? (((tminB - 31) >> 4) + 1) : 0;
    const int nkb = (((t0 >> 4) + 1) + 63) >> 6;
    const bf16_t* ckb = (const bf16_t*)(p.ws + OFF_CMPKB) + (size_t)(b * 2 + g) * 512 * 64;
    const bf16_t* cvb = (const bf16_t*)(p.ws + OFF_CMPVB) + (size_t)(b * 2 + g) * 512 * 64;
    NSA_RESET()
    nsa_kv_loop(ckb, cvb, 64, 0, nkb - 1, smem, sof, [&](int kb, const unsigned char* Kl, const unsigned char* Vl) __attribute__((always_inline)) {
        attn_step2(Kl, Vl, lane, lof,
                   qA0, qA1, oA, mA, lA, 0.f, kb * 64 + 64 <= nvminA, [&](int key) __attribute__((always_inline)) { return kb * 64 + key < nvA; },
                   qB0, qB1, oB, mB, lB, 0.f, kb * 64 + 64 <= nvminB, [&](int key) __attribute__((always_inline)) { return kb * 64 + key < nvB; });
    });
    NSA_LSUM()
    const float mcA = mA, mcB = mB;
    const float invcA = 1.f / fmaxf(lA[0], 1e-30f), invcB = 1.f / fmaxf(lB[0], 1e-30f);
    {
        const float fA = gpA[0] * invcA, fB = gpB[0] * invcB;
#pragma unroll
        for (int dt = 0; dt < 4; ++dt) {
            otA[dt][0] = fA * oA[dt][0]; otA[dt][1] = fA * oA[dt][1]; otA[dt][2] = fA * oA[dt][2]; otA[dt][3] = fA * oA[dt][3];
            otB[dt][0] = fB * oB[dt][0]; otB[dt][1] = fB * oB[dt][1]; otB[dt][2] = fB * oB[dt][2]; otB[dt][3] = fB * oB[dt][3];
        }
    }
    if (cur >= 16) {
        nsa_kv_loop(ckb, cvb, 64, 0, nkb - 1, smem, sof, [&](int kb, const unsigned char* Kl, const unsigned char* Vl) __attribute__((always_inline)) {
#pragma unroll
            for (int mt = 0; mt < 2; ++mt) {
                f32x4 s[4];
                nsa_scores(Kl, lof, mt ? qB0 : qA0, mt ? qB1 : qA1, 0.f, s);
                const int nv = mt ? nvB : nvA;
                const float mc = mt ? mcB : mcA, inv = mt ? invcB : invcA;
                float* impT = impL + (mt ? toklB : toklA) * 128;
#pragma unroll
                for (int kt = 0; kt < 4; ++kt) {
                    float pr[4];
#pragma unroll
                    for (int r = 0; r < 4; ++r) {
                        const int n = kb * 64 + kt * 16 + 4 * lg + r;
                        pr[r] = (n < nv) ? __builtin_amdgcn_exp2f(s[kt][r] - mc) * inv : 0.f;
                    }
                    float c1 = pr[0] + pr[1] + pr[2] + 0.5f * pr[3], c2 = 0.5f * pr[3];
                    c1 += __shfl_xor(c1, 1); c1 += __shfl_xor(c1, 2);
                    c2 += __shfl_xor(c2, 1); c2 += __shfl_xor(c2, 2);
                    const int j = kb * 16 + kt * 4 + lg;
                    if (head == 0) {
                        atomicAdd(&impT[j], c1);
                        if (j + 1 < 128) atomicAdd(&impT[j + 1], c2);
                    }
                }
                    }
        });
#pragma unroll 1
        for (int pass = 0; pass < 2; ++pass) {
            const int tok = 8 * w + 4 * pass + lg, c = lane & 15;
            const float4 i0 = *(const float4*)(impL + tok * 128 + 8 * c), i1 = *(const float4*)(impL + tok * 128 + 8 * c + 4);
            const float iv[8] = {i0.x, i0.y, i0.z, i0.w, i1.x, i1.y, i1.z, i1.w};
            float kl[8];
#pragma unroll
            for (int q = 0; q < 8; ++q) {
                const int j = 8 * c + q;
                const bool forced = (j == 0) || (j == cur) || (j == cur - 1);
                const float sc = forced ? 1.0e4f : ((j <= cur) ? iv[q] : -1.f);
                kl[q] = enc_key(sc, (unsigned)j, 127);
            }
            float l0 = kl[0], l1 = kl[1], l2 = kl[2], l3 = kl[3], l4 = kl[4], l5 = kl[5], l6 = kl[6], l7 = kl[7];
            CE_DESC(l0, l1) CE_DESC(l2, l3) CE_DESC(l4, l5) CE_DESC(l6, l7)
            CE_DESC(l0, l2) CE_DESC(l1, l3) CE_DESC(l4, l6) CE_DESC(l5, l7)
            CE_DESC(l1, l2) CE_DESC(l5, l6)
            CE_DESC(l0, l4) CE_DESC(l1, l5) CE_DESC(l2, l6) CE_DESC(l3, l7)
            CE_DESC(l2, l4) CE_DESC(l3, l5)
            CE_DESC(l1, l2) CE_DESC(l3, l4) CE_DESC(l5, l6)
            unsigned pm = 0u;
#pragma unroll
            for (int k = 0; k < 16; ++k) {
                const float mx = row16_max(l0);
                const bool win = (l0 == mx);
                pm |= win ? (1u << (dec_idx(l0, 127) & 7u)) : 0u;
                l0 = win ? l1 : l0; l1 = win ? l2 : l1; l2 = win ? l3 : l2; l3 = win ? l4 : l3;
                l4 = win ? l5 : l4; l5 = win ? l6 : l5; l6 = win ? l7 : l6; l7 = win ? NEGKEY : l7;
            }
            ((unsigned char*)selL)[tok * 16 + c] = (unsigned char)pm;
        }
    } else {
        if (lane < 8) {
            const int tok = 8 * w + lane;
            selL[tok * 4 + 0] = (2u << cur) - 1u; selL[tok * 4 + 1] = 0u; selL[tok * 4 + 2] = 0u; selL[tok * 4 + 3] = 0u;
        }
    }
    WAVE_LDS_SYNC();
#if NSA_DIAG
    if (head == 0 && lg == 0) {
        unsigned* SELM = (unsigned*)(p.ws + OFF_SELM);
#pragma unroll
        for (int qd = 0; qd < 4; ++qd) {
            SELM[((size_t)bg * SEQ + tqA) * 4 + qd] = selL[toklA * 4 + qd];
            SELM[((size_t)bg * SEQ + tqB) * 4 + qd] = selL[toklB * 4 + qd];
        }
    }
#endif
    NSA_RESET()
    {
        const bf16_t* kg = (const bf16_t*)(p.ws + OFF_KV + 2 * KV_STRIDE) + (size_t)b * SEQ * 128 + g * 64;
        const bf16_t* vg = (const bf16_t*)(p.ws + OFF_KV + 3 * KV_STRIDE) + (size_t)b * SEQ * 128 + g * 64;
        nsa_kv_loop(kg, vg, 128, 0, cur, smem, sof, [&](int kb, const unsigned char* Kl, const unsigned char* Vl) __attribute__((always_inline)) {
            const bool svA = (selL[toklA * 4 + (kb >> 5)] >> (kb & 31)) & 1u;
            const bool svB = (selL[toklB * 4 + (kb >> 5)] >> (kb & 31)) & 1u;
            const bool nA = __ballot(svA) != 0ull, nB = __ballot(svB) != 0ull;
            if (nA && nB)
                attn_step2(Kl, Vl, lane, lof,
                           qA0, qA1, oA, mA, lA, svA ? 0.f : NEGM, kb < cur, [&](int key) __attribute__((always_inline)) { return kb * 64 + key <= tqA; },
                           qB0, qB1, oB, mB, lB, svB ? 0.f : NEGM, kb < cur, [&](int key) __attribute__((always_inline)) { return kb * 64 + key <= tqB; });
            else if (nA)
                attn_step(Kl, Vl, lane, lof, qA0, qA1, oA, mA, lA, svA ? 0.f : NEGM, kb < cur, [&](int key) __attribute__((always_inline)) { return kb * 64 + key <= tqA; });
            else if (nB)
                attn_step(Kl, Vl, lane, lof, qB0, qB1, oB, mB, lB, svB ? 0.f : NEGM, kb < cur, [&](int key) __attribute__((always_inline)) { return kb * 64 + key <= tqB; });
        });
    }
    NSA_LSUM()
    {
        const float fA = gpA[1] / fmaxf(lA[0], 1e-30f), fB = gpB[1] / fmaxf(lB[0], 1e-30f);
#pragma unroll
        for (int dt = 0; dt < 4; ++dt) {
            otA[dt][0] += fA * oA[dt][0]; otA[dt][1] += fA * oA[dt][1]; otA[dt][2] += fA * oA[dt][2]; otA[dt][3] += fA * oA[dt][3];
            otB[dt][0] += fB * oB[dt][0]; otB[dt][1] += fB * oB[dt][1]; otB[dt][2] += fB * oB[dt][2]; otB[dt][3] += fB * oB[dt][3];
        }
    }
    NSA_RESET()
    {
        const bf16_t* kg = (const bf16_t*)(p.ws + OFF_KV + 4 * KV_STRIDE) + (size_t)b * SEQ * 128 + g * 64;
        const bf16_t* vg = (const bf16_t*)(p.ws + OFF_KV + 5 * KV_STRIDE) + (size_t)b * SEQ * 128 + g * 64;
        const int klo = (t0 > 511) ? ((t0 - 511) >> 6) : 0;
        nsa_kv_loop(kg, vg, 128, klo, cur, smem, sof, [&](int kb, const unsigned char* Kl, const unsigned char* Vl) __attribute__((always_inline)) {
            attn_step2(Kl, Vl, lane, lof,
                       qA0, qA1, oA, mA, lA, 0.f, (kb * 64 >= tminA + 3 - 511) && (kb * 64 + 63 <= tminA),
                       [&](int key) __attribute__((always_inline)) { const int ka = kb * 64 + key; return (ka <= tqA) && (ka >= tqA - 511); },
                       qB0, qB1, oB, mB, lB, 0.f, (kb * 64 >= tminB + 3 - 511) && (kb * 64 + 63 <= tminB),
                       [&](int key) __attribute__((always_inline)) { const int ka = kb * 64 + key; return (ka <= tqB) && (ka >= tqB - 511); });
        });
    }
    NSA_LSUM()
    {
        const float fA = gpA[2] / fmaxf(lA[0], 1e-30f), fB = gpB[2] / fmaxf(lB[0], 1e-30f);
        bf16_t* MIX = (bf16_t*)(p.ws + OFF_XB) + (tokb + toklA) * DM + 512 + g * 256 + head * 64 + lg * 4;
#pragma unroll
        for (int dt = 0; dt < 4; ++dt) {
            uint2 ov;
            ov.x = pack2bf(otA[dt][0] + fA * oA[dt][0], otA[dt][1] + fA * oA[dt][1]);
            ov.y = pack2bf(otA[dt][2] + fA * oA[dt][2], otA[dt][3] + fA * oA[dt][3]);
            *(uint2*)(MIX + dt * 16) = ov;
            ov.x = pack2bf(otB[dt][0] + fB * oB[dt][0], otB[dt][1] + fB * oB[dt][1]);
            ov.y = pack2bf(otB[dt][2] + fB * oB[dt][2], otB[dt][3] + fB * oB[dt][3]);
            *(uint2*)(MIX + 4 * DM + dt * 16) = ov;
        }
    }
#undef NSA_RESET
#undef NSA_LSUM
}

__device__ __forceinline__ float block_sum(float v, float* red) {
    v = wave_sum(v);
    __syncthreads();
    if ((threadIdx.x & 63) == 0) red[threadIdx.x >> 6] = v;
    __syncthreads();
    return red[0] + red[1] + red[2] + red[3];
}
__device__ __forceinline__ float4 ln_row(float4 y, const float* g, const float* bb, float* red) {
    const int tid = opaque_tid();
    const float mu = block_sum(y.x + y.y + y.z + y.w, red) * (1.f / 1024.f);
    const float dx = y.x - mu, dy = y.y - mu, dz = y.z - mu, dw = y.w - mu;
    const float var = block_sum(dx * dx + dy * dy + dz * dz + dw * dw, red) * (1.f / 1024.f);
    const float rs = rsqrtf(var + LN_EPS);
    const float4 gg = ((const float4*)g)[tid], b4 = ((const float4*)bb)[tid];
    return make_float4(dx * rs * gg.x + b4.x, dy * rs * gg.y + b4.y, dz * rs * gg.z + b4.z, dw * rs * gg.w + b4.w);
}

__device__ __forceinline__ void ln1_phase(const Params& p, float* sm) {
    const int tid = opaque_tid(), lane = tid & 63, w = __builtin_amdgcn_readfirstlane(tid >> 6);
    const float4* g4 = (const float4*)(p.in[15] + 16 * lane);
    const float4* b4 = (const float4*)(p.in[16] + 16 * lane);
    const float4 ga = g4[0], gb = g4[1], gc = g4[2], gd = g4[3];
    const float4 ba = b4[0], bb = b4[1], bc = b4[2], bd = b4[3];
#pragma unroll 2
    for (int n = blockIdx.x * 4 + w; n < NTOK; n += gridDim.x * 4) {
        const float4* xr = (const float4*)(p.in[0] + (size_t)n * DM + 16 * lane);
        const uint4* mr = (const uint4*)((const bf16_t*)p.out + (size_t)n * DM + 16 * lane);
        const float4 y0 = xr[0], y1 = xr[1], y2 = xr[2], y3 = xr[3];
        const uint4 m0 = mr[0], m1 = mr[1];
        float y[16] = {ALPHA * y0.x + bf2f(m0.x & 0xffffu), ALPHA * y0.y + bf2f(m0.x >> 16), ALPHA * y0.z + bf2f(m0.y & 0xffffu), ALPHA * y0.w + bf2f(m0.y >> 16),
                       ALPHA * y1.x + bf2f(m0.z & 0xffffu), ALPHA * y1.y + bf2f(m0.z >> 16), ALPHA * y1.z + bf2f(m0.w & 0xffffu), ALPHA * y1.w + bf2f(m0.w >> 16),
                       ALPHA * y2.x + bf2f(m1.x & 0xffffu), ALPHA * y2.y + bf2f(m1.x >> 16), ALPHA * y2.z + bf2f(m1.y & 0xffffu), ALPHA * y2.w + bf2f(m1.y >> 16),
                       ALPHA * y3.x + bf2f(m1.z & 0xffffu), ALPHA * y3.y + bf2f(m1.z >> 16), ALPHA * y3.z + bf2f(m1.w & 0xffffu), ALPHA * y3.w + bf2f(m1.w >> 16)};
        const float g[16] = {ga.x, ga.y, ga.z, ga.w, gb.x, gb.y, gb.z, gb.w, gc.x, gc.y, gc.z, gc.w, gd.x, gd.y, gd.z, gd.w};
        const float bv[16] = {ba.x, ba.y, ba.z, ba.w, bb.x, bb.y, bb.z, bb.w, bc.x, bc.y, bc.z, bc.w, bd.x, bd.y, bd.z, bd.w};
        float sum = 0.f;
#pragma unroll
        for (int q = 0; q < 16; ++q) sum += y[q];
        const float mu = wave_sum(sum) * (1.f / 1024.f);
        float sq = 0.f;
#pragma unroll
        for (int q = 0; q < 16; ++q) { y[q] -= mu; sq += y[q] * y[q]; }
        const float rs = rsqrtf(wave_sum(sq) * (1.f / 1024.f) + LN_EPS);
        uint4 o0, o1;
        o0.x = pack2bf(y[0] * rs * g[0] + bv[0], y[1] * rs * g[1] + bv[1]);     o0.y = pack2bf(y[2] * rs * g[2] + bv[2], y[3] * rs * g[3] + bv[3]);
        o0.z = pack2bf(y[4] * rs * g[4] + bv[4], y[5] * rs * g[5] + bv[5]);     o0.w = pack2bf(y[6] * rs * g[6] + bv[6], y[7] * rs * g[7] + bv[7]);
        o1.x = pack2bf(y[8] * rs * g[8] + bv[8], y[9] * rs * g[9] + bv[9]);     o1.y = pack2bf(y[10] * rs * g[10] + bv[10], y[11] * rs * g[11] + bv[11]);
        o1.z = pack2bf(y[12] * rs * g[12] + bv[12], y[13] * rs * g[13] + bv[13]); o1.w = pack2bf(y[14] * rs * g[14] + bv[14], y[15] * rs * g[15] + bv[15]);
        uint4* hb = (uint4*)((bf16_t*)(p.ws + OFF_XB) + (size_t)n * DM + 16 * lane);
        hb[0] = o0; hb[1] = o1;
    }
}


typedef float f32x2 __attribute__((ext_vector_type(2)));
__device__ __forceinline__ void cvt_rows_fp8(const float* __restrict__ src, unsigned char* __restrict__ dst, float* __restrict__ scales, int rows,
                                             int first_block, int nblocks) {
    const int tid_ = opaque_tid(), lane = tid_ & 63, w = __builtin_amdgcn_readfirstlane(tid_ >> 6);
    for (int r = ((int)blockIdx.x - first_block) * 4 + w; r < rows; r += nblocks * 4) {
        const float4* sp = (const float4*)(src + (size_t)r * 1024 + lane * 16);
        const float4 a = sp[0], b = sp[1], c = sp[2], d = sp[3];
        float mx = fmaxf(fmaxf(fmaxf(fabsf(a.x), fabsf(a.y)), fmaxf(fabsf(a.z), fabsf(a.w))), fmaxf(fmaxf(fabsf(b.x), fabsf(b.y)), fmaxf(fabsf(b.z), fabsf(b.w))));
        mx = fmaxf(mx, fmaxf(fmaxf(fmaxf(fabsf(c.x), fabsf(c.y)), fmaxf(fabsf(c.z), fabsf(c.w))), fmaxf(fmaxf(fabsf(d.x), fabsf(d.y)), fmaxf(fabsf(d.z), fabsf(d.w)))));
        mx = wave_max(mx);
        const float sc = (mx > 0.f) ? mx * (1.f / 448.f) : 1.f;
        const float inv = 1.f / sc;
        uint4 o;
        int t;
        t = 0; t = __builtin_amdgcn_cvt_pk_fp8_f32(a.x * inv, a.y * inv, t, false); t = __builtin_amdgcn_cvt_pk_fp8_f32(a.z * inv, a.w * inv, t, true); o.x = (unsigned)t;
        t = 0; t = __builtin_amdgcn_cvt_pk_fp8_f32(b.x * inv, b.y * inv, t, false); t = __builtin_amdgcn_cvt_pk_fp8_f32(b.z * inv, b.w * inv, t, true); o.y = (unsigned)t;
        t = 0; t = __builtin_amdgcn_cvt_pk_fp8_f32(c.x * inv, c.y * inv, t, false); t = __builtin_amdgcn_cvt_pk_fp8_f32(c.z * inv, c.w * inv, t, true); o.z = (unsigned)t;
        t = 0; t = __builtin_amdgcn_cvt_pk_fp8_f32(d.x * inv, d.y * inv, t, false); t = __builtin_amdgcn_cvt_pk_fp8_f32(d.z * inv, d.w * inv, t, true); o.w = (unsigned)t;
        *(uint4*)(dst + (size_t)r * 1024 + lane * 16) = o;
        if (lane == 0) scales[r] = sc;
    }
}

__device__ __forceinline__ unsigned pack4i8(float a, float b, float c, float d) {
    const int ia = (int)rintf(a), ib = (int)rintf(b), ic = (int)rintf(c), id = (int)rintf(d);
    return (unsigned)(ia & 255) | ((unsigned)(ib & 255) << 8) | ((unsigned)(ic & 255) << 16) | ((unsigned)id << 24);
}
__device__ __forceinline__ void cvt_rows_i8(const float* __restrict__ src, unsigned char* __restrict__ dst, float* __restrict__ scales, int rows,
                                            int first_block, int nblocks) {
    const int tid_ = opaque_tid(), lane = tid_ & 63, w = __builtin_amdgcn_readfirstlane(tid_ >> 6);
    for (int r = ((int)blockIdx.x - first_block) * 4 + w; r < rows; r += nblocks * 4) {
        const float4* sp = (const float4*)(src + (size_t)r * 1024 + lane * 16);
        const float4 a = sp[0], b = sp[1], c = sp[2], d = sp[3];
        float mx = fmaxf(fmaxf(fmaxf(fabsf(a.x), fabsf(a.y)), fmaxf(fabsf(a.z), fabsf(a.w))), fmaxf(fmaxf(fabsf(b.x), fabsf(b.y)), fmaxf(fabsf(b.z), fabsf(b.w))));
        mx = fmaxf(mx, fmaxf(fmaxf(fmaxf(fabsf(c.x), fabsf(c.y)), fmaxf(fabsf(c.z), fabsf(c.w))), fmaxf(fmaxf(fabsf(d.x), fabsf(d.y)), fmaxf(fabsf(d.z), fabsf(d.w)))));
        mx = wave_max(mx);
        const float sc = (mx > 0.f) ? mx * (1.f / 127.f) : 1.f;
        const float inv = 1.f / sc;
        uint4 o;
        o.x = pack4i8(a.x * inv, a.y * inv, a.z * inv, a.w * inv); o.y = pack4i8(b.x * inv, b.y * inv, b.z * inv, b.w * inv);
        o.z = pack4i8(c.x * inv, c.y * inv, c.z * inv, c.w * inv); o.w = pack4i8(d.x * inv, d.y * inv, d.z * inv, d.w * inv);
        *(uint4*)(dst + (size_t)r * 1024 + lane * 16) = o;
        if (lane == 0) scales[r] = sc;
    }
}

__device__ __forceinline__ void fold_ws_phase(const float* __restrict__ wq, const float* __restrict__ k1, const float* __restrict__ k2,
                                              bf16_t* __restrict__ WsT) {
    for (int it = blockIdx.x * 256 + threadIdx.x; it < 2048 * 128; it += gridDim.x * 256) {
        const int r = it & 2047, kg = it >> 11;
        const int a = (r >> 7) & 1, j = r & 127;
        const float* kr = (a ? k2 : k1) + j * 128;
        const float* wr = wq + (size_t)(kg * 8) * 2048 + (r & ~127);
        float s[8];
#pragma unroll
        for (int q = 0; q < 8; ++q) s[q] = 0.f;
        for (int d = 0; d < 128; d += 4) {
            const float4 kv = *(const float4*)(kr + d);
#pragma unroll
            for (int q = 0; q < 8; ++q) {
                const float4 wv = *(const float4*)(wr + (size_t)q * 2048 + d);
                s[q] += wv.x * kv.x + wv.y * kv.y + wv.z * kv.z + wv.w * kv.w;
            }
        }
        uint4 o;
        o.x = pack2bf(s[0], s[1]); o.y = pack2bf(s[2], s[3]); o.z = pack2bf(s[4], s[5]); o.w = pack2bf(s[6], s[7]);
        *(uint4*)(WsT + (size_t)r * 1024 + kg * 8) = o;
    }
}


struct EpiTop16 {
    static constexpr bool kRow = false;
    float* topk; unsigned char* lds;
    __device__ __forceinline__ void operator()(int m, int n, f32x4 v) const {
        const int ml = m & 127, g4 = (n & 127) >> 2;
        *(float4*)(lds + ((ml * 32 + (g4 ^ (ml & 7))) << 4)) = make_float4(v[0], v[1], v[2], v[3]);
    }
    template <class F> __device__ __forceinline__ void dispatch(int, F f) const { f(*this); }
    __device__ __forceinline__ void finish(int m0, int n0) const {
        __syncthreads();
        const int tid_ = opaque_tid(), lane = tid_ & 63, w = __builtin_amdgcn_readfirstlane(tid_ >> 6), c = lane & 15;
        const int L = n0 >> 7;
        for (int it = 0; it < 8; ++it) {
            const int r = w * 32 + it * 4 + (lane >> 4);
            const float4 x0 = *(const float4*)(lds + ((r * 32 + ((2 * c) ^ (r & 7))) << 4));
            const float4 x1 = *(const float4*)(lds + ((r * 32 + ((2 * c + 1) ^ (r & 7))) << 4));
            float l0 = enc_key(x0.x, 8 * c + 0, 127), l1 = enc_key(x0.y, 8 * c + 1, 127), l2 = enc_key(x0.z, 8 * c + 2, 127),
                  l3 = enc_key(x0.w, 8 * c + 3, 127), l4 = enc_key(x1.x, 8 * c + 4, 127), l5 = enc_key(x1.y, 8 * c + 5, 127),
                  l6 = enc_key(x1.z, 8 * c + 6, 127), l7 = enc_key(x1.w, 8 * c + 7, 127);
            CE_DESC(l0, l1) CE_DESC(l2, l3) CE_DESC(l4, l5) CE_DESC(l6, l7)
            CE_DESC(l0, l2) CE_DESC(l1, l3) CE_DESC(l4, l6) CE_DESC(l5, l7)
            CE_DESC(l1, l2) CE_DESC(l5, l6)
            CE_DESC(l0, l4) CE_DESC(l1, l5) CE_DESC(l2, l6) CE_DESC(l3, l7)
            CE_DESC(l2, l4) CE_DESC(l3, l5)
            CE_DESC(l1, l2) CE_DESC(l3, l4) CE_DESC(l5, l6)
            float res = NEGKEY;
#pragma unroll
            for (int k = 0; k < 16; ++k) {
                const float mx = row16_max(l0);
                const bool win = (l0 == mx);
                l0 = win ? l1 : l0; l1 = win ? l2 : l1; l2 = win ? l3 : l2; l3 = win ? l4 : l3;
                l4 = win ? l5 : l4; l5 = win ? l6 : l5; l6 = win ? l7 : l6; l7 = win ? NEGKEY : l7;
                res = (c == k) ? mx : res;
            }
            topk[(size_t)(m0 + r) * 256 + L * 16 + c] = res;
        }
        __syncthreads();
    }
};

template <int PART>
__device__ __forceinline__ void peer_fast_phase(const Params& p, unsigned char* smem) {
    const int tid = opaque_tid(), lane = tid & 63, w = __builtin_amdgcn_readfirstlane(tid >> 6), l16 = lane & 15, gq = lane >> 4;
    float* tk = (float*)(smem + w * 2048);
    int* ex = (int*)(smem + w * 2048 + 1024);
    float* gw = (float*)(smem + w * 2048 + 1536);
    const bf16_t* H1B = (const bf16_t*)(p.ws + OFF_XB);
    const unsigned char* U8 = p.ws + OFF_UB;
    const unsigned char* V8 = p.ws + OFF_VB;
    const float* USC = (const float*)(p.ws + OFF_USC);
    const float* VSC = (const float*)(p.ws + OFF_VSC);
    const float* TOPK = (const float*)(p.ws + OFF_TOPK);
    int ci[4], cj[4];
#pragma unroll
    for (int q = 0; q < 4; ++q) {
        const int s = l16 + 16 * q;
        int i, j;
        if (s < 16) { i = 0; j = s; }
        else if (s < 24) { i = 1; j = s - 16; }
        else if (s < 29) { i = 2; j = s - 24; }
        else if (s < 33) { i = 3; j = s - 29; }
        else if (s < 36) { i = 4; j = s - 33; }
        else if (s < 42) { i = 5 + ((s - 36) >> 1); j = (s - 36) & 1; }
        else if (s < 50) { i = 8 + (s - 42); j = 0; }
        else { i = -1; j = 0; }
        ci[q] = i; cj[q] = j;
    }
    int* exs = (int*)(smem + 8192 + w * 4096);
    float* gws = (float*)(smem + 8192 + w * 4096 + 2048);
    float* hraw = (float*)(smem + 24576 + w * 2048);
    float* xsc = (float*)(smem + w * 2048);
    int* SEX = (int*)(p.ws + OFF_HQ);
    float* SGW = (float*)(p.ws + OFF_HLF);
    for (int qd = blockIdx.x * 4 + w; qd < NTOK / 4; qd += gridDim.x * 4) {
        const int n0 = qd * 4;
        if (PART == 0) {
        float4 tkn = ((const float4*)(TOPK + (size_t)n0 * 256))[lane];
#pragma unroll 1
        for (int t = 0; t < 4; ++t) {
            const int n = n0 + t;
            WAVE_LDS_SYNC();
            ((float4*)tk)[lane] = tkn;
            {
                int nn = (t < 3) ? n + 1 : (qd + (int)gridDim.x * 4) * 4;
                nn = (nn < NTOK) ? nn : n;
                tkn = ((const float4*)(TOPK + (size_t)nn * 256))[lane];
            }
            WAVE_LDS_SYNC();
#pragma unroll
            for (int it = 0; it < 2; ++it) {
                const int head = it * 4 + gq;
                const float* ka = tk + head * 32;
                const float* kb = ka + 16;
                float c0, c1, c2, c3;
#define MKC(q, cq) { if (ci[q] >= 0) { const float sum_ = dec_val(ka[ci[q]], 127) + dec_val(kb[cj[q]], 127); \
                         cq = enc_key(sum_, ci[q] * 16 + cj[q], 255); } else cq = NEGKEY; }
                MKC(0, c0) MKC(1, c1) MKC(2, c2) MKC(3, c3)
#undef MKC
                float res = NEGKEY;
#pragma unroll
                for (int k = 0; k < 16; ++k) {
                    const float mx = row16_max(fmaxf(fmaxf(c0, c1), fmaxf(c2, c3)));
                    c0 = (c0 == mx) ? NEGKEY : c0; c1 = (c1 == mx) ? NEGKEY : c1;
                    c2 = (c2 == mx) ? NEGKEY : c2; c3 = (c3 == mx) ? NEGKEY : c3;
                    res = (l16 == k) ? mx : res;
                }
                const unsigned cc = dec_idx(res, 255);
                const float val = dec_val(res, 255);
                const unsigned e1 = dec_idx(ka[cc >> 4], 127), e2 = dec_idx(kb[cc & 15], 127);
                const float m0 = row16_max(val);
                const float e = expf(val - m0);
                const float ssum = row16_sum(e);
                ex[head * 16 + l16] = (int)(e1 * 128 + e2);
                gw[head * 16 + l16] = e / ssum;
            }
            WAVE_LDS_SYNC();
            {
                const int e0 = ex[lane], e1v = ex[lane + 64];
                const float g0 = gw[lane], g1 = gw[lane + 64];
                const int s0 = e0 >> 11, s1 = e1v >> 11;
                const unsigned long long lt = (1ull << lane) - 1ull;
                int base = 0, p0 = 0, p1 = 0;
#pragma unroll
                for (int s = 0; s < 8; ++s) {
                    const unsigned long long m0 = __ballot(s0 == s), m1 = __ballot(s1 == s);
                    const int c0 = __popcll(m0), c1 = __popcll(m1);
                    if (s0 == s) p0 = base + __popcll(m0 & lt);
                    if (s1 == s) p1 = base + c0 + __popcll(m1 & lt);
                    base += c0 + c1;
                }
                exs[t * 128 + p0] = e0; gws[t * 128 + p0] = g0; exs[t * 128 + p1] = e1v; gws[t * 128 + p1] = g1;
            }
        }
        WAVE_LDS_SYNC();
#pragma unroll
        for (int i = 0; i < 2; ++i) {
            ((uint4*)(SEX + (size_t)n0 * 128))[lane + 64 * i] = ((const uint4*)exs)[lane + 64 * i];
            ((uint4*)(SGW + (size_t)n0 * 128))[lane + 64 * i] = ((const uint4*)gws)[lane + 64 * i];
        }
        } else {
        WAVE_LDS_SYNC();
#pragma unroll
        for (int i = 0; i < 2; ++i) {
            ((uint4*)exs)[lane + 64 * i] = ((const uint4*)(SEX + (size_t)n0 * 128))[lane + 64 * i];
            ((uint4*)gws)[lane + 64 * i] = ((const uint4*)(SGW + (size_t)n0 * 128))[lane + 64 * i];
        }
        }
        if (PART == 1) {
        WAVE_LDS_SYNC();
        {
            int xq[16];
            {
                const uint4* xr = (const uint4*)(H1B + (size_t)(n0 + gq) * DM + 16 * l16);
                uint4 xa0 = xr[0], xb0 = xr[1], xa1 = xr[32], xb1 = xr[33], xa2 = xr[64], xb2 = xr[65], xa3 = xr[96], xb3 = xr[97];
#define BLO(u_) __uint_as_float((u_) << 16)
#define BHI(u_) __uint_as_float((u_) & 0xffff0000u)
#define AMX4(v_) fmaxf(fmaxf(fmaxf(fabsf(BLO((v_).x)), fabsf(BHI((v_).x))), fmaxf(fabsf(BLO((v_).y)), fabsf(BHI((v_).y)))),                  \
                       fmaxf(fmaxf(fabsf(BLO((v_).z)), fabsf(BHI((v_).z))), fmaxf(fabsf(BLO((v_).w)), fabsf(BHI((v_).w)))))
                float mx = fmaxf(fmaxf(fmaxf(AMX4(xa0), AMX4(xb0)), fmaxf(AMX4(xa1), AMX4(xb1))), fmaxf(fmaxf(AMX4(xa2), AMX4(xb2)), fmaxf(AMX4(xa3), AMX4(xb3))));
                mx = row16_max(mx);
                const float xs = (mx > 0.f) ? mx * (1.f / 127.f) : 1.f;
                const float inv = 1.f / xs;
                xsc[gq] = xs;
#define Q8(i_, va_, vb_) { xq[4 * (i_) + 0] = (int)pack4i8(BLO((va_).x) * inv, BHI((va_).x) * inv, BLO((va_).y) * inv, BHI((va_).y) * inv);   \
                           xq[4 * (i_) + 1] = (int)pack4i8(BLO((va_).z) * inv, BHI((va_).z) * inv, BLO((va_).w) * inv, BHI((va_).w) * inv);   \
                           xq[4 * (i_) + 2] = (int)pack4i8(BLO((vb_).x) * inv, BHI((vb_).x) * inv, BLO((vb_).y) * inv, BHI((vb_).y) * inv);   \
                           xq[4 * (i_) + 3] = (int)pack4i8(BLO((vb_).z) * inv, BHI((vb_).z) * inv, BLO((vb_).w) * inv, BHI((vb_).w) * inv); }
                Q8(0, xa0, xb0) Q8(1, xa1, xb1) Q8(2, xa2, xb2) Q8(3, xa3, xb3)
#undef Q8
#undef AMX4
#undef BLO
#undef BHI
            }
            uint4 ra0, ra1, ra2, ra3, rb0, rb1, rb2, rb3, rc0, rc1, rc2, rc3, rd0, rd1, rd2, rd3;
#define ULOAD(S, kk) { const int e_ = exs[gq * 128 + (kk)]; const uint4* ur_ = (const uint4*)(U8 + (size_t)e_ * DM + 16 * l16);          \
                       S##0 = ur_[0]; S##1 = ur_[16]; S##2 = ur_[32]; S##3 = ur_[48]; }
#define D4(W_, B_) { sA = __builtin_amdgcn_sdot4((int)(W_).x, xq[(B_)], sA, false); sB = __builtin_amdgcn_sdot4((int)(W_).y, xq[(B_) + 1], sB, false); \
                     sA = __builtin_amdgcn_sdot4((int)(W_).z, xq[(B_) + 2], sA, false); sB = __builtin_amdgcn_sdot4((int)(W_).w, xq[(B_) + 3], sB, false); }
#define UCOMP(S, kk) { int sA = 0, sB = 0; D4(S##0, 0) D4(S##1, 4) D4(S##2, 8) D4(S##3, 12)                                               \
                       hraw[gq * 128 + (kk)] = row16_sum((float)(sA + sB)); }
            ULOAD(ra, 0) ULOAD(rb, 1) ULOAD(rc, 2)
#pragma unroll 1
            for (int k = 0; k < 128; k += 4) {
                const int kn = (k + 4 < 128) ? k + 4 : 124;
                ULOAD(rd, k + 3)  UCOMP(ra, k)
                ULOAD(ra, kn)     UCOMP(rb, k + 1)
                ULOAD(rb, kn + 1) UCOMP(rc, k + 2)
                ULOAD(rc, kn + 2) UCOMP(rd, k + 3)
            }
#undef D4
#undef ULOAD
#undef UCOMP
        }
        WAVE_LDS_SYNC();
#pragma unroll
        for (int j = 0; j < 8; ++j) {
            const int idx = lane + 64 * j;
            const int e = exs[idx];
            gws[idx] = gws[idx] * gelu_tanh_fast(hraw[idx] * (xsc[idx >> 7] * USC[e])) * VSC[e];
        }
        WAVE_LDS_SYNC();
#pragma unroll
        for (int i = 0; i < 2; ++i) ((uint4*)(SGW + (size_t)n0 * 128))[lane + 64 * i] = ((const uint4*)gws)[lane + 64 * i];
        }
        if (PART == 2) {
        WAVE_LDS_SYNC();
        {
            f32x2 acc[32];
#pragma unroll
            for (int q = 0; q < 32; ++q) acc[q] = (f32x2){0.f, 0.f};
            uint4 ra0, ra1, ra2, ra3, rb0, rb1, rb2, rb3, rc0, rc1, rc2, rc3, rd0, rd1, rd2, rd3;
#define VLOAD(S, kk) { const int e_ = exs[gq * 128 + (kk)]; const uint4* vr_ = (const uint4*)(V8 + (size_t)e_ * DM + 16 * l16);          \
                       S##0 = vr_[0]; S##1 = vr_[16]; S##2 = vr_[32]; S##3 = vr_[48]; }
#define A4(W_, B_) { acc[(B_)] = __builtin_elementwise_fma(__builtin_amdgcn_cvt_pk_f32_fp8((int)(W_), false), wk2, acc[(B_)]);          \
                     acc[(B_) + 1] = __builtin_elementwise_fma(__builtin_amdgcn_cvt_pk_f32_fp8((int)(W_), true), wk2, acc[(B_) + 1]); }
#define VCOMP(S, kk) { const float wk = gws[gq * 128 + (kk)]; const f32x2 wk2 = (f32x2){wk, wk};                                         \
                       A4((S##0).x, 0) A4((S##0).y, 2) A4((S##0).z, 4) A4((S##0).w, 6) A4((S##1).x, 8) A4((S##1).y, 10) A4((S##1).z, 12) A4((S##1).w, 14) \
                       A4((S##2).x, 16) A4((S##2).y, 18) A4((S##2).z, 20) A4((S##2).w, 22) A4((S##3).x, 24) A4((S##3).y, 26) A4((S##3).z, 28) A4((S##3).w, 30) }
            VLOAD(ra, 0) VLOAD(rb, 1) VLOAD(rc, 2)
#pragma unroll 1
            for (int k = 0; k < 128; k += 4) {
                const int kn = (k + 4 < 128) ? k + 4 : 124;
                VLOAD(rd, k + 3)  VCOMP(ra, k)
                VLOAD(ra, kn)     VCOMP(rb, k + 1)
                VLOAD(rb, kn + 1) VCOMP(rc, k + 2)
                VLOAD(rc, kn + 2) VCOMP(rd, k + 3)
            }
#undef VLOAD
#undef VCOMP
#undef A4
            float* orow = p.out + (size_t)(n0 + gq) * DM + 16 * l16;
            float sum = 0.f;
#pragma unroll
            for (int c = 0; c < 4; ++c)
#pragma unroll
                for (int hq = 0; hq < 4; ++hq) {
                    const uint2 hb_ = *(const uint2*)(H1B + (size_t)(n0 + gq) * DM + 16 * l16 + 256 * c + 4 * hq);
                    const float4 h = make_float4(__uint_as_float(hb_.x << 16), __uint_as_float(hb_.x & 0xffff0000u),
                                                 __uint_as_float(hb_.y << 16), __uint_as_float(hb_.y & 0xffff0000u));
                    f32x2& pa = acc[8 * c + 2 * hq]; f32x2& pb = acc[8 * c + 2 * hq + 1];
                    pa[0] = ALPHA * h.x + pa[0]; pa[1] = ALPHA * h.y + pa[1]; pb[0] = ALPHA * h.z + pb[0]; pb[1] = ALPHA * h.w + pb[1];
                    sum += (pa[0] + pa[1]) + (pb[0] + pb[1]);
                }
            const float mu = row16_sum(sum) * (1.f / 1024.f);
            float sq = 0.f;
#pragma unroll
            for (int q = 0; q < 32; ++q) { acc[q][0] -= mu; acc[q][1] -= mu; sq += acc[q][0] * acc[q][0] + acc[q][1] * acc[q][1]; }
            const float rs = rsqrtf(row16_sum(sq) * (1.f / 1024.f) + LN_EPS);
            const float* g = p.in[22] + 16 * l16;
            const float* bb = p.in[23] + 16 * l16;
#pragma unroll
            for (int c = 0; c < 4; ++c)
#pragma unroll
                for (int hq = 0; hq < 4; ++hq) {
                    const float4 gg = *(const float4*)(g + 256 * c + 4 * hq), b4 = *(const float4*)(bb + 256 * c + 4 * hq);
                    const f32x2 pa = acc[8 * c + 2 * hq], pb = acc[8 * c + 2 * hq + 1];
                    float4 o;
                    o.x = pa[0] * rs * gg.x + b4.x; o.y = pa[1] * rs * gg.y + b4.y;
                    o.z = pb[0] * rs * gg.z + b4.z; o.w = pb[1] * rs * gg.w + b4.w;
                    *(float4*)(orow + 256 * c + 4 * hq) = o;
                }
        }
        }
    }
}

#define XB_TMO      128
#define XB_XCNT(j)  (256  + 64 * (j))
#define XB_XSUB(j)  (1280 + 64 * (j))
#define XB_XGEN(j)  (2304 + 64 * (j))
#define XB_TOP      3328
#define XB_TOPGEN   3392
#define XCD_BAR_WORDS 3456
#define XB_SPIN_CAP (1u << 22)
__device__ __forceinline__ unsigned xb_ld(unsigned* p) { return __hip_atomic_load(p, __ATOMIC_RELAXED, __HIP_MEMORY_SCOPE_AGENT); }
__device__ __forceinline__ unsigned xb_add(unsigned* p, unsigned v) { return __hip_atomic_fetch_add(p, v, __ATOMIC_RELAXED, __HIP_MEMORY_SCOPE_AGENT); }
__device__ __forceinline__ unsigned xb_xcc_id() { return (unsigned)__builtin_amdgcn_s_getreg((3 << 11) | 20) & 0xFu; }
#define XB_SPIN(cond, bar) do { unsigned _sp = 0; while (cond) { __builtin_amdgcn_s_sleep(1); \
    if ((++_sp & 255u) == 0u) { if (xb_ld(&(bar)[XB_TMO])) break; if (_sp > XB_SPIN_CAP) { atomicAdd(&(bar)[XB_TMO], 1u); break; } } } } while (0)
struct XcdBarrier { unsigned* bar; unsigned x; unsigned* st; };
__device__ __forceinline__ XcdBarrier xcd_barrier_post(unsigned* bar, unsigned* st) {
    XcdBarrier b; b.bar = bar; b.x = xb_xcc_id(); b.st = st;
    if (threadIdx.x == 0) (void)xb_add(&bar[XB_XCNT(b.x)], 1u);
    return b;
}
__device__ __forceinline__ void xcd_barrier_complete(unsigned* bar, unsigned x, unsigned& nloc, unsigned& nx) {
    const unsigned G = gridDim.x * gridDim.y * gridDim.z;
    unsigned sum, cnt, mine, sp = 0u;
    for (;;) {
        sum = 0u; cnt = 0u; mine = 0u;
#pragma unroll
        for (unsigned j = 0; j < 16; ++j) { const unsigned c = xb_ld(&bar[XB_XCNT(j)]); sum += c; cnt += (c > 0u) ? 1u : 0u; mine = (j == x) ? c : mine; }
        if (sum == G) break;
        __builtin_amdgcn_s_sleep(1);
        if ((++sp & 255u) == 0u) { if (xb_ld(&bar[XB_TMO])) break; if (sp > XB_SPIN_CAP) { atomicAdd(&bar[XB_TMO], 1u); break; } }
    }
    nloc = mine > 0u ? mine : 1u; nx = cnt > 0u ? cnt : 1u;
}
__device__ __forceinline__ void xcd_barrier(const XcdBarrier& b) {
    asm volatile("s_waitcnt vmcnt(0)" ::: "memory");
    __syncthreads();
    if (threadIdx.x == 0) {
        unsigned* bar = b.bar;
        __builtin_amdgcn_s_waitcnt(0);
        unsigned nloc = xb_ld(&b.st[0]), nx = xb_ld(&b.st[1]);
        if (nloc == 0u) { xcd_barrier_complete(bar, b.x, nloc, nx); __hip_atomic_store(&b.st[0], nloc, __ATOMIC_RELAXED, __HIP_MEMORY_SCOPE_AGENT); __hip_atomic_store(&b.st[1], nx, __ATOMIC_RELAXED, __HIP_MEMORY_SCOPE_AGENT); }
        const unsigned old = xb_add(&bar[XB_XSUB(b.x)], 1u);
        const unsigned gen = old / nloc;
        if (old + 1u == (gen + 1u) * nloc) {
            __builtin_amdgcn_fence(__ATOMIC_RELEASE, "agent");
            asm volatile("s_waitcnt vmcnt(0)" ::: "memory");
            const unsigned og = xb_add(&bar[XB_TOP], 1u);
            const unsigned tg = og / nx;
            if (og + 1u == (tg + 1u) * nx) xb_add(&bar[XB_TOPGEN], 1u);
            else XB_SPIN(xb_ld(&bar[XB_TOPGEN]) == tg, bar);
            __builtin_amdgcn_fence(__ATOMIC_ACQUIRE, "agent");
            xb_add(&bar[XB_XGEN(b.x)], 1u);
            asm volatile("s_waitcnt vmcnt(0)" ::: "memory");
        } else {
            XB_SPIN(xb_ld(&bar[XB_XGEN(b.x)]) == gen, bar);
            __builtin_amdgcn_fence(__ATOMIC_ACQUIRE, "agent");
            asm volatile("s_waitcnt vmcnt(0)" ::: "memory");
        }
    }
    __syncthreads();
}

__global__ void __launch_bounds__(256, 2) mega(Params p) {
    cg::grid_group grid = cg::this_grid();
    __shared__ __attribute__((aligned(16))) unsigned char smem[81920];
    float* sm = (float*)smem;
    unsigned* barw = (unsigned*)(p.ws + OFF_BAR);
    const XcdBarrier xbar = xcd_barrier_post(barw, barw + XCD_BAR_WORDS + 2 * blockIdx.x);
    bf16_t* XB = (bf16_t*)(p.ws + OFF_XB);
    bf16_t* WinT = (bf16_t*)(p.ws + OFF_WINT);
    bf16_t* WoutT = (bf16_t*)(p.ws + OFF_WOUTT);
    bf16_t* WqT = (bf16_t*)(p.ws + OFF_WQT);
    cvt_rows_bf16(p.in[0], XB, (size_t)NTOK * DM / 8);
    transpose_bf16(p.in[1], DIN, 3456, WinT);
    transpose_bf16(p.in[2], DM, DM, WoutT);
    fold_ws_phase(p.in[17], p.in[18], p.in[19], WqT);
    transpose_bf16(p.in[6], 256, 256, (bf16_t*)(p.ws + OFF_W1T), 2048);
    transpose_bf16(p.in[11], 256, 256, (bf16_t*)(p.ws + OFF_W1T) + 256 * 2048, 2048);
    if (blockIdx.x == 0) {
        for (int c = threadIdx.x; c < 512; c += 256)
            ((float*)(p.ws + OFF_LBV))[c] = 1.f / (1.f + expf(p.in[3][512 + c] - p.in[3][c]));
        if (threadIdx.x < 16) ((float*)(p.ws + OFF_DIAG))[threadIdx.x] = 0.f;
    }
    if (blockIdx.x == 1 || blockIdx.x == 2) cmp_peb(p, blockIdx.x - 1);
    grid.sync();
    gemm_bf16_phase3(XB, DM, WinT, DM, NTOK / 256, 27, smem, EpiProj{p.ws});
    xcd_barrier(xbar);
    for (int it = blockIdx.x; it < 128; it += gridDim.x) {
        const int which = it >> 6, t = it & 63;
        gemm_tile(ALoadCmp{(const bf16_t*)(p.ws + OFF_KV + (size_t)which * KV_STRIDE)},
                  (const bf16_t*)(p.ws + OFF_W1T) + (size_t)which * 256 * 2048, 2048, 32, (t >> 1) * 128, (t & 1) * 128, smem,
                  EpiCmpH{(bf16_t*)(p.ws + OFF_HB) + (size_t)which * 4096 * 256, (const float*)(p.ws + OFF_PEB) + which * 256});
    }
    if (gridDim.x >= 256) {
        if (blockIdx.x >= 128)
            for (int it = blockIdx.x - 128; it < 2048; it += gridDim.x - 128) hgrn_passA(p, it, smem);
    } else {
        for (int it = blockIdx.x; it < 2048; it += gridDim.x) hgrn_passA(p, it, smem);
    }
#if NSA_DIAG
    for (int it = blockIdx.x; it < 2 * 4 * NCB * 2; it += gridDim.x) compress_item(p, it, sm);
#endif
    xcd_barrier(xbar);
    if (blockIdx.x < 256) hgrn_scan_item(p, blockIdx.x);
    else {
        cvt_rows_i8(p.in[20], p.ws + OFF_UB, (float*)(p.ws + OFF_USC), 16384, 256, gridDim.x - 256);
        cvt_rows_fp8(p.in[21], p.ws + OFF_VB, (float*)(p.ws + OFF_VSC), 16384, 256, gridDim.x - 256);
    }
    if (gridDim.x <= 256) {
        cvt_rows_i8(p.in[20], p.ws + OFF_UB, (float*)(p.ws + OFF_USC), 16384, 0, gridDim.x);
        cvt_rows_fp8(p.in[21], p.ws + OFF_VB, (float*)(p.ws + OFF_VSC), 16384, 0, gridDim.x);
    }
    cmp_layer2_phase(p, 0, gridDim.x);
    xcd_barrier(xbar);
    {
        const int qi = blockIdx.x & 7;
        unsigned* qctr = barw + XCD_BAR_WORDS + 2 * 1024 + 64 * qi;
        for (;;) {
            __syncthreads();
            if (threadIdx.x == 0) *(volatile unsigned*)smem = atomicAdd(qctr, 1u);
            __syncthreads();
            const int it = (int)__builtin_amdgcn_readfirstlane(*(volatile unsigned*)smem);
            if (it >= 256) break;
            nsa_tile(p, (it << 3) | qi, smem);
        }
        for (;;) {
            __syncthreads();
            if (threadIdx.x == 0) *(volatile unsigned*)smem = atomicAdd(qctr + 32, 1u);
            __syncthreads();
            const int it = (int)__builtin_amdgcn_readfirstlane(*(volatile unsigned*)smem);
            if (it >= 256) break;
            hgrn_passC(p, (it << 3) | qi, smem);
        }
    }
    xcd_barrier(xbar);
#if NSA_DIAG
    for (int it = blockIdx.x; it < 4 * 2 * SEQ; it += gridDim.x) nsa_item(p, it, sm);
    grid.sync();
    {
        const float* DG = (const float*)(p.ws + OFF_DIAG);
#if NSA_DIAG == 1
        const float cval = -log10f(sqrtf(DG[0] / DG[1]) + 1e-9f);
#else
        const float cval = -log10f(DG[2] / DG[3] + 1e-6f);
#endif
        for (size_t i = (size_t)blockIdx.x * 256 + threadIdx.x; i < (size_t)NTOK * DM; i += (size_t)gridDim.x * 256) p.out[i] = cval;
        return;
    }
#endif
    gemm_bf16_phase3(XB, DM, WoutT, DM, NTOK / 256, 8, smem, EpiMix{(bf16_t*)p.out});
    xcd_barrier(xbar);
    ln1_phase(p, sm);
    xcd_barrier(xbar);
    gemm_bf16_phase3(XB, DM, WqT, DM, NTOK / 256, 16, smem, EpiTop16{(float*)(p.ws + OFF_TOPK), smem});
    xcd_barrier(xbar);
    peer_fast_phase<0>(p, smem);
    peer_fast_phase<1>(p, smem);
    peer_fast_phase<2>(p, smem);
}

extern "C" void kernel_launch(void* const* d_in, const int* in_sizes, int n_in, void* d_out, int out_size,
                              void* d_ws, size_t ws_size, hipStream_t stream) {
    static int grid_blocks = 0;
    if (!grid_blocks) {
        int dev = 0, cus = 0, per_cu = 0;
        hipGetDevice(&dev);
        hipDeviceGetAttribute(&cus, hipDeviceAttributeMultiprocessorCount, dev);
        hipOccupancyMaxActiveBlocksPerMultiprocessor(&per_cu, mega, 256, 0);
        if (per_cu > 4) per_cu = 4;
        if (per_cu < 1) per_cu = 1;
        grid_blocks = cus * per_cu;
        if (n_in != 24 || ws_size < WS_NEED || out_size != NTOK * DM)
            fprintf(stderr, "kernel_launch: unexpected sizes n_in=%d ws=%zu out=%d\n", n_in, ws_size, out_size);
    }
    Params p;
    memset(&p, 0, sizeof(p));
    for (int i = 0; i < 24; ++i) p.in[i] = (const float*)d_in[i];
    p.out = (float*)d_out;
    p.ws = (unsigned char*)d_ws;
    hipMemsetAsync((char*)d_ws + OFF_BAR, 0, BAR_BYTES, stream);
    void* args[] = {&p};
    hipError_t e = hipLaunchCooperativeKernel((void*)mega, dim3(grid_blocks), dim3(256), args, 0, stream);
    if (e != hipSuccess) fprintf(stderr, "cooperative launch failed: %s (grid %d)\n", hipGetErrorString(e), grid_blocks);
}
```

```cpp
#include <hip/hip_runtime.h>
#include <hip/hip_cooperative_groups.h>
#include <cstdio>
#include <cstring>
namespace cg = cooperative_groups;

#define NTOK 32768
#define SEQ 8192
#define DM 1024
#define DIN 3352
#define NCB 511
#define ALPHA 1.189207115002721f
#define LN_EPS 1e-5f

#define MB_ 1048576ull
#define OFF_XB 0ull
#define OFF_HQ (64 * MB_)
#define OFF_HLF (96 * MB_)
#define OFF_HI (160 * MB_)
#define OFF_HG (192 * MB_)
#define OFF_NQ (224 * MB_)
#define OFF_KV (256 * MB_)
#define KV_STRIDE (8 * MB_)
#define OFF_NGATE (304 * MB_)
#define OFF_CMPK (308 * MB_)
#define OFF_CMPV (309 * MB_)
#define OFF_WINT (310 * MB_)
#define OFF_WOUTT (317 * MB_)
#define OFF_WQT (319 * MB_)
#define OFF_LBV (323 * MB_)
#define OFF_DC (324 * MB_)
#define OFF_SC (325 * MB_)
#define OFF_UB (389 * MB_)
#define OFF_VB (421 * MB_)
#define OFF_TOPK (453 * MB_)
#define OFF_W1T (485 * MB_)
#define OFF_HB (487 * MB_)
#define OFF_CMPKB (491 * MB_)
#define OFF_CMPVB (491 * MB_ + 524288ull)
#define OFF_PEB (492 * MB_)
#define OFF_SELM (493 * MB_)
#define OFF_DIAG (494 * MB_)
#define OFF_USC (494 * MB_ + 131072ull)
#define OFF_VSC (494 * MB_ + 196608ull)
#define OFF_BAR (494 * MB_ + 65536ull)
#define BAR_BYTES 32768
#define WS_NEED (495 * MB_)
#define USE_NSA_MFMA 1
#define NSA_DIAG 0

struct Params {
    const float* in[24];
    float* out;
    unsigned char* ws;
};

typedef float f32x16 __attribute__((ext_vector_type(16)));
#define WAVE_LDS_SYNC() asm volatile("s_waitcnt lgkmcnt(0)" ::: "memory")
#define LAS3 __attribute__((address_space(3)))

__device__ __forceinline__ int opaque_tid() { int t = threadIdx.x; asm volatile("" : "+v"(t)); return t; }
__device__ __forceinline__ float wave_sum(float v) {
#pragma unroll
    for (int o = 32; o; o >>= 1) v += __shfl_xor(v, o);
    return v;
}
__device__ __forceinline__ float wave_max(float v) {
#pragma unroll
    for (int o = 32; o; o >>= 1) v = fmaxf(v, __shfl_xor(v, o));
    return v;
}
__device__ __forceinline__ float sigmoidf_(float x) { return 1.f / (1.f + expf(-x)); }
__device__ __forceinline__ float sigmoid_fast(float x) { return __builtin_amdgcn_rcpf(1.f + __builtin_amdgcn_exp2f(-1.4426950408889634f * x)); }
__device__ __forceinline__ float log_fast(float x) { return 0.6931471805599453f * __builtin_amdgcn_logf(x); }
__device__ __forceinline__ float gelu_tanh_fast(float x) {
    const float u = 0.7978845608028654f * (x + 0.044715f * x * x * x);
    return x * __builtin_amdgcn_rcpf(1.f + __builtin_amdgcn_exp2f(-2.885390081777927f * u));
}
__device__ __forceinline__ float gelu_tanh(float x) {
    const float c = 0.7978845608028654f;
    return 0.5f * x * (1.f + tanhf(c * (x + 0.044715f * x * x * x)));
}

typedef short bf16x8 __attribute__((ext_vector_type(8)));
typedef float f32x4 __attribute__((ext_vector_type(4)));
typedef unsigned short bf16_t;

typedef __bf16 bf16x2_t __attribute__((ext_vector_type(2)));
__device__ __forceinline__ unsigned pack2bf(float lo, float hi) {
    bf16x2_t v; v[0] = (__bf16)lo; v[1] = (__bf16)hi;
    return __builtin_bit_cast(unsigned, v);
}
__device__ __forceinline__ unsigned f2bf(float f) { return pack2bf(f, 0.f) & 0xffffu; }
__device__ __forceinline__ float bf2f(unsigned h) { return __uint_as_float(h << 16); }

__device__ __forceinline__ void cvt_rows_bf16(const float* __restrict__ src, bf16_t* __restrict__ dst, size_t n8) {
    for (size_t i = (size_t)blockIdx.x * 256 + threadIdx.x; i < n8; i += (size_t)gridDim.x * 256) {
        const float4 a = ((const float4*)src)[2 * i], b = ((const float4*)src)[2 * i + 1];
        uint4 o;
        o.x = pack2bf(a.x, a.y); o.y = pack2bf(a.z, a.w); o.z = pack2bf(b.x, b.y); o.w = pack2bf(b.z, b.w);
        ((uint4*)dst)[i] = o;
    }
}
__device__ __forceinline__ void transpose_bf16(const float* __restrict__ src, int Nsrc, int Npad, bf16_t* __restrict__ dst, int K = 1024) {
    const size_t total = (size_t)Npad * (K / 8);
    for (size_t i = (size_t)blockIdx.x * 256 + threadIdx.x; i < total; i += (size_t)gridDim.x * 256) {
        const int n = (int)(i % Npad), kg = (int)(i / Npad);
        float v[8];
#pragma unroll
        for (int j = 0; j < 8; ++j) v[j] = (n < Nsrc) ? src[(size_t)(kg * 8 + j) * Nsrc + n] : 0.f;
        uint4 o;
        o.x = pack2bf(v[0], v[1]); o.y = pack2bf(v[2], v[3]); o.z = pack2bf(v[4], v[5]); o.w = pack2bf(v[6], v[7]);
        *(uint4*)(dst + (size_t)n * K + kg * 8) = o;
    }
}

struct ALoadStd {
    const bf16_t* A; int lda;
    __device__ __forceinline__ const bf16_t* ptr(int row, int ks) const { return A + (size_t)row * lda + ks * 64; }
};
struct ALoadCmp {
    const bf16_t* KC;
    __device__ __forceinline__ const bf16_t* ptr(int row, int ks) const {
        const int r = row < 4088 ? row : 4087;
        const int g = r & 1, bn = r >> 1, n = bn % NCB, b = bn / NCB;
        return KC + ((size_t)(b * SEQ + 16 * n + ks) * 128 + g * 64);
    }
};
#define GLDS1(i, ks, buf) { const int row_ = 8 * w + 32 * (i) + (lane >> 3);                                                    \
        __builtin_amdgcn_global_load_lds((const unsigned*)(aload.ptr(m0 + row_, (ks)) + (((lane & 7) ^ (lane >> 3)) << 3)),      \
                                         (LAS3 unsigned*)(lds + (buf) * 32768 + w * 1024 + (i) * 4096), 16, 0, 0);              \
        __builtin_amdgcn_global_load_lds((const unsigned*)(Bp + (size_t)row_ * ldb + (ks) * 64 + (((lane & 7) ^ (lane >> 3)) << 3)), \
                                         (LAS3 unsigned*)(lds + (buf) * 32768 + 16384 + w * 1024 + (i) * 4096), 16, 0, 0); }
#define GEMM_GLDS(ks, buf) { GLDS1(0, ks, buf) GLDS1(1, ks, buf) GLDS1(2, ks, buf) GLDS1(3, ks, buf) }
template <class ALoad, class Epi>
__device__ __forceinline__ void gemm_tile(const ALoad aload, const bf16_t* __restrict__ Bt, int ldb, int KS, int m0, int n0,
                                          unsigned char* lds, Epi epi) {
    const int tid = opaque_tid(), lane = tid & 63, w = __builtin_amdgcn_readfirstlane(tid >> 6), wm = w >> 1, wn = w & 1;
    f32x4 acc[4][4];
#pragma unroll
    for (int j = 0; j < 4; ++j)
#pragma unroll
        for (int i = 0; i < 4; ++i) acc[j][i] = (f32x4){0.f, 0.f, 0.f, 0.f};
    const bf16_t* Bp = Bt + (size_t)n0 * ldb;
    __syncthreads();
    GEMM_GLDS(0, 0)
    asm volatile("s_waitcnt vmcnt(0)" ::: "memory");
    __syncthreads();
    for (int ks = 0; ks < KS; ++ks) {
        if (ks + 1 < KS) GEMM_GLDS(ks + 1, (ks + 1) & 1)
        const unsigned char* la = lds + (ks & 1) * 32768;
        const unsigned char* lb = la + 16384;
#pragma unroll
        for (int s = 0; s < 2; ++s) {
            bf16x8 af[4], wf[4];
            const int ch = s * 4 + (lane >> 4);
#pragma unroll
            for (int i = 0; i < 4; ++i) {
                const int row = wm * 64 + i * 16 + (lane & 15);
                af[i] = *(const bf16x8*)(la + row * 128 + ((ch ^ (row & 7)) << 4));
            }
#pragma unroll
            for (int j = 0; j < 4; ++j) {
                const int row = wn * 64 + j * 16 + (lane & 15);
                wf[j] = *(const bf16x8*)(lb + row * 128 + ((ch ^ (row & 7)) << 4));
            }
#pragma unroll
            for (int j = 0; j < 4; ++j)
#pragma unroll
                for (int i = 0; i < 4; ++i)
                    acc[j][i] = __builtin_amdgcn_mfma_f32_16x16x32_bf16(wf[j], af[i], acc[j][i], 0, 0, 0);
        }
        asm volatile("s_waitcnt vmcnt(0)" ::: "memory");
        __syncthreads();
    }
#pragma unroll
    for (int j = 0; j < 4; ++j)
#pragma unroll
        for (int i = 0; i < 4; ++i)
            epi(m0 + wm * 64 + i * 16 + (lane & 15), n0 + wn * 64 + j * 16 + (lane >> 4) * 4, acc[j][i]);
    epi.finish(m0, n0);
}
template <class Epi>
__device__ __forceinline__ void gemm_bf16_phase(const bf16_t* __restrict__ A, int lda, const bf16_t* __restrict__ Bt, int ldb,
                                                int Mtiles, int Ntiles, unsigned char* lds, Epi epi) {
    if ((gridDim.x & 7) == 0 && (Mtiles & 31) == 0) {
        const int x = blockIdx.x & 7, j = blockIdx.x >> 3, nb = gridDim.x >> 3;
        const int per = (Mtiles >> 3) * Ntiles;
        for (int q = j; q < per; q += nb) {
            const int s = q / (4 * Ntiles), rem = q - s * (4 * Ntiles);
            const int c = rem >> 2, r = rem & 3;
            const int mt = x + 8 * (4 * s + r);
            gemm_tile(ALoadStd{A, lda}, Bt, ldb, 16, mt * 128, c * 128, lds, epi);
        }
    } else {
        for (int tile = blockIdx.x; tile < Mtiles * Ntiles; tile += gridDim.x) {
            const int mt = tile / Ntiles, nt = tile % Ntiles;
            gemm_tile(ALoadStd{A, lda}, Bt, ldb, 16, mt * 128, nt * 128, lds, epi);
        }
    }
}


#define G3_STAGE 24576
#define G3A(i, ks, st) __builtin_amdgcn_global_load_lds((const unsigned*)(pa + (size_t)(64 * (i)) * lda + (ks) * 32),                     \
                                                        (LAS3 unsigned*)(lds + (st) + (w + 4 * (i)) * 1024), 16, 0, 0);
#define G3B(i, ks, st) __builtin_amdgcn_global_load_lds((const unsigned*)(pb + (size_t)(64 * (i)) * ldb + (ks) * 32),                     \
                                                        (LAS3 unsigned*)(lds + (st) + 16384 + (w + 4 * (i)) * 1024), 16, 0, 0);
#define G3MF(j, i) acc[j][i] = __builtin_amdgcn_mfma_f32_16x16x32_bf16(wf[j], af[i], acc[j][i], 0, 0, 0);
#define G3MF4(j, i) G3MF(j, i) G3MF(j, (i) + 1) G3MF(j, (i) + 2) G3MF(j, (i) + 3)
#define G3SB __builtin_amdgcn_sched_barrier(0);
#define G3_BODY(LOADS, KS) {                                                                                                              \
        const unsigned char* la = lds + st0 + wm * 8192 + fofs;                                                                           \
        const unsigned char* lb = lds + st0 + 16384 + wn * 4096 + fofs;                                                                   \
        bf16x8 af[8], wf[4];                                                                                                              \
        wf[0] = *(const bf16x8*)(lb);                                                                                                     \
        af[0] = *(const bf16x8*)(la);            af[1] = *(const bf16x8*)(la + 1024); af[2] = *(const bf16x8*)(la + 2048);                \
        af[3] = *(const bf16x8*)(la + 3072);     af[4] = *(const bf16x8*)(la + 4096); af[5] = *(const bf16x8*)(la + 5120);                \
        af[6] = *(const bf16x8*)(la + 6144);     af[7] = *(const bf16x8*)(la + 7168);                                                     \
        wf[1] = *(const bf16x8*)(lb + 1024);     wf[2] = *(const bf16x8*)(lb + 2048); wf[3] = *(const bf16x8*)(lb + 3072);                \
        G3SB                                                                                                                              \
        G3MF4(0, 0) if (LOADS) { G3A(0, (KS) + 2, st2) } G3SB                                                                             \
        G3MF4(0, 4) if (LOADS) { G3A(1, (KS) + 2, st2) } G3SB                                                                             \
        G3MF4(1, 0) if (LOADS) { G3A(2, (KS) + 2, st2) } G3SB                                                                             \
        G3MF4(1, 4) if (LOADS) { G3A(3, (KS) + 2, st2) } G3SB                                                                             \
        G3MF4(2, 0) if (LOADS) { G3B(0, (KS) + 2, st2) } G3SB                                                                             \
        G3MF4(2, 4) if (LOADS) { G3B(1, (KS) + 2, st2) } G3SB                                                                             \
        G3MF4(3, 0) G3MF4(3, 4) }
template <class Epi>
__device__ __forceinline__ void gemm_tile3(const bf16_t* __restrict__ A, int lda, const bf16_t* __restrict__ Bt, int ldb, int m0, int n0,
                                           unsigned char* lds, Epi epi) {
    const int tid = opaque_tid(), lane = tid & 63, w = __builtin_amdgcn_readfirstlane(tid >> 6), wm = w >> 1, wn = w & 1;
    f32x4 acc[4][8];
#pragma unroll
    for (int j = 0; j < 4; ++j)
#pragma unroll
        for (int i = 0; i < 8; ++i) acc[j][i] = (f32x4){0.f, 0.f, 0.f, 0.f};
    const int r15 = lane & 15, g4 = lane >> 4;
    const int fofs = r15 * 64 + ((g4 ^ ((0 - (r15 >> 2)) & 3)) << 4);
    const int lch = ((lane & 3) ^ ((0 - (lane >> 4)) & 3)) << 3;
    const bf16_t* pa = A + (size_t)(m0 + 16 * w + (lane >> 2)) * lda + lch;
    const bf16_t* pb = Bt + (size_t)(n0 + 16 * w + (lane >> 2)) * ldb + lch;
    __syncthreads();
    G3A(0, 0, 0) G3A(1, 0, 0) G3A(2, 0, 0) G3A(3, 0, 0) G3B(0, 0, 0) G3B(1, 0, 0)
    G3A(0, 1, G3_STAGE) G3A(1, 1, G3_STAGE) G3A(2, 1, G3_STAGE) G3A(3, 1, G3_STAGE) G3B(0, 1, G3_STAGE) G3B(1, 1, G3_STAGE)
    int st0 = 0, st1 = G3_STAGE, st2 = 2 * G3_STAGE;
#pragma unroll 1
    for (int ks = 0; ks < 30; ++ks) {
        asm volatile("s_waitcnt vmcnt(6)" ::: "memory");
        __builtin_amdgcn_s_barrier();
        asm volatile("" ::: "memory");
        G3_BODY(1, ks)
        const int t_ = st0; st0 = st1; st1 = st2; st2 = t_;
    }
    asm volatile("s_waitcnt vmcnt(6)" ::: "memory");
    __builtin_amdgcn_s_barrier();
    asm volatile("" ::: "memory");
    G3_BODY(0, 30)
    st0 = st1;
    asm volatile("s_waitcnt vmcnt(0)" ::: "memory");
    __builtin_amdgcn_s_barrier();
    asm volatile("" ::: "memory");
    G3_BODY(0, 31)
    __syncthreads();
    if constexpr (Epi::kRow) {
        const int mrow = m0 + wm * 128 + r15, ncol = n0 + wn * 64;
        epi.dispatch(n0, [&](auto e) {
            if constexpr (decltype(e)::kBf16) {
#pragma unroll
                for (int i = 0; i < 8; ++i)
#pragma unroll
                    for (int j = 0; j < 4; j += 2) {
                        uint2 a = e.pack4(acc[j][i]), b = e.pack4(acc[j + 1][i]);
                        auto sx = __builtin_amdgcn_permlane16_swap(a.x, b.x, false, false);
                        auto sy = __builtin_amdgcn_permlane16_swap(a.y, b.y, false, false);
                        e.store8(mrow + i * 16, ncol + (j + (g4 & 1)) * 16 + (g4 >> 1) * 8, make_uint4(sx[0], sy[0], sx[1], sy[1]));
                    }
            } else {
#pragma unroll
                for (int i = 0; i < 8; ++i)
#pragma unroll
                    for (int j = 0; j < 4; ++j)
                        e.row4(mrow + i * 16, ncol + j * 16 + g4 * 4, make_float4(acc[j][i][0], acc[j][i][1], acc[j][i][2], acc[j][i][3]));
            }
        });
    } else {
#pragma unroll
        for (int hh = 0; hh < 2; ++hh) {
            if (wm == hh) {
#pragma unroll
                for (int j = 0; j < 4; ++j)
#pragma unroll
                    for (int i = 0; i < 8; ++i)
                        epi(m0 + wm * 128 + i * 16 + (lane & 15), n0 + wn * 64 + j * 16 + (lane >> 4) * 4, acc[j][i]);
            }
            epi.finish(m0 + hh * 128, n0);
        }
    }
}

#define G3PA(PA, i, k, st) __builtin_amdgcn_global_load_lds((const unsigned*)((PA) + (size_t)(64 * (i)) * lda + (k) * 32),                 \
                                                            (LAS3 unsigned*)(lds + (st) + (w + 4 * (i)) * 1024), 16, 0, 0);
#define G3PB(PB, i, k, st) __builtin_amdgcn_global_load_lds((const unsigned*)((PB) + (size_t)(64 * (i)) * ldb + (k) * 32),                 \
                                                            (LAS3 unsigned*)(lds + (st) + 16384 + (w + 4 * (i)) * 1024), 16, 0, 0);
#define G3P_BODY(PA, PB, KIDX) {                                                                                                          \
        const unsigned char* la = lds + st0 + wm * 8192 + fofs;                                                                           \
        const unsigned char* lb = lds + st0 + 16384 + wn * 4096 + fofs;                                                                   \
        bf16x8 af[8], wf[4];                                                                                                              \
        wf[0] = *(const bf16x8*)(lb);                                                                                                     \
        af[0] = *(const bf16x8*)(la);            af[1] = *(const bf16x8*)(la + 1024); af[2] = *(const bf16x8*)(la + 2048);                \
        af[3] = *(const bf16x8*)(la + 3072);     af[4] = *(const bf16x8*)(la + 4096); af[5] = *(const bf16x8*)(la + 5120);                \
        af[6] = *(const bf16x8*)(la + 6144);     af[7] = *(const bf16x8*)(la + 7168);                                                     \
        wf[1] = *(const bf16x8*)(lb + 1024);     wf[2] = *(const bf16x8*)(lb + 2048); wf[3] = *(const bf16x8*)(lb + 3072);                \
        G3SB                                                                                                                              \
        G3MF4(0, 0) G3PA(PA, 0, KIDX, st2) G3SB                                                                                           \
        G3MF4(0, 4) G3PA(PA, 1, KIDX, st2) G3SB                                                                                           \
        G3MF4(1, 0) G3PA(PA, 2, KIDX, st2) G3SB                                                                                           \
        G3MF4(1, 4) G3PA(PA, 3, KIDX, st2) G3SB                                                                                           \
        G3MF4(2, 0) G3PB(PB, 0, KIDX, st2) G3SB                                                                                           \
        G3MF4(2, 4) G3PB(PB, 1, KIDX, st2) G3SB                                                                                           \
        G3MF4(3, 0) G3MF4(3, 4)                                                                                                           \
        { const int t_ = st0; st0 = st1; st1 = st2; st2 = t_; } }
#define G3P_SYNC(N) { asm volatile("s_waitcnt vmcnt(" #N ")" ::: "memory"); __builtin_amdgcn_s_barrier(); asm volatile("" ::: "memory"); }
#define G3P_BAR     { __builtin_amdgcn_s_barrier(); asm volatile("" ::: "memory"); }
template <class Epi>
__device__ __forceinline__ void gemm_phase_pipelined(const bf16_t* __restrict__ A, int lda, const bf16_t* __restrict__ Bt, int ldb,
                                                     int Mtiles  , int Ntiles, unsigned char* lds, Epi epi) {
    const int tid = opaque_tid(), lane = tid & 63, w = __builtin_amdgcn_readfirstlane(tid >> 6), wm = w >> 1, wn = w & 1;
    const int r15 = lane & 15, g4 = lane >> 4;
    const int fofs = r15 * 64 + ((g4 ^ ((0 - (r15 >> 2)) & 3)) << 4);
    const int lch = ((lane & 3) ^ ((0 - (lane >> 4)) & 3)) << 3;
    const int x = blockIdx.x & 7, jb = blockIdx.x >> 3, nb = gridDim.x >> 3;
    const int per = (Mtiles >> 3) * Ntiles;
    int q = jb;
    if (q >= per) return;
    int m0, n0;
#define G3P_TILE(Q, M0, N0) { const int s_ = (Q) / (2 * Ntiles), rem_ = (Q) - s_ * (2 * Ntiles); M0 = (x + 8 * (2 * s_ + (rem_ & 1))) * 256; N0 = (rem_ >> 1) * 128; }
    G3P_TILE(q, m0, n0)
    const bf16_t* pa = A + (size_t)(m0 + 16 * w + (lane >> 2)) * lda + lch;
    const bf16_t* pb = Bt + (size_t)(n0 + 16 * w + (lane >> 2)) * ldb + lch;
    int st0 = 0, st1 = G3_STAGE, st2 = 2 * G3_STAGE;
    __syncthreads();
    G3PA(pa, 0, 0, 0) G3PA(pa, 1, 0, 0) G3PA(pa, 2, 0, 0) G3PA(pa, 3, 0, 0) G3PB(pb, 0, 0, 0) G3PB(pb, 1, 0, 0)
    G3PA(pa, 0, 1, G3_STAGE) G3PA(pa, 1, 1, G3_STAGE) G3PA(pa, 2, 1, G3_STAGE) G3PA(pa, 3, 1, G3_STAGE) G3PB(pb, 0, 1, G3_STAGE) G3PB(pb, 1, 1, G3_STAGE)
    asm volatile("s_waitcnt vmcnt(0)" ::: "memory");
    for (;;) {
        const int qn = (q + nb < per) ? q + nb : q;
        int m0n, n0n;
        G3P_TILE(qn, m0n, n0n)
        const bf16_t* pan = A + (size_t)(m0n + 16 * w + (lane >> 2)) * lda + lch;
        const bf16_t* pbn = Bt + (size_t)(n0n + 16 * w + (lane >> 2)) * ldb + lch;
        f32x4 acc[4][8];
#pragma unroll
        for (int j = 0; j < 4; ++j)
#pragma unroll
            for (int i = 0; i < 8; ++i) acc[j][i] = (f32x4){0.f, 0.f, 0.f, 0.f};
        G3P_BAR      G3P_BODY(pa, pb, 2)
        G3P_BAR      G3P_BODY(pa, pb, 3)
#pragma unroll 1
        for (int ks = 2; ks < 30; ++ks) {
            G3P_SYNC(6)
            G3P_BODY(pa, pb, ks + 2)
        }
        G3P_SYNC(6)  G3P_BODY(pan, pbn, 0)
        G3P_SYNC(6)  G3P_BODY(pan, pbn, 1)
        {
            const int mrow = m0 + wm * 128 + r15, ncol = n0 + wn * 64;
            epi.dispatch(n0, [&](auto e) {
                asm volatile("s_waitcnt vmcnt(0)" ::: "memory");
                if constexpr (decltype(e)::kBf16) {
#pragma unroll
                    for (int i = 0; i < 8; ++i)
#pragma unroll
                        for (int j = 0; j < 4; j += 2) {
                            uint2 a = e.pack4(acc[j][i]), b = e.pack4(acc[j + 1][i]);
                            auto sx = __builtin_amdgcn_permlane16_swap(a.x, b.x, false, false);
                            auto sy = __builtin_amdgcn_permlane16_swap(a.y, b.y, false, false);
                            e.store8(mrow + i * 16, ncol + (j + (g4 & 1)) * 16 + (g4 >> 1) * 8, make_uint4(sx[0], sy[0], sx[1], sy[1]));
                        }
                } else {
#pragma unroll
                    for (int i = 0; i < 8; ++i)
#pragma unroll
                        for (int j = 0; j < 4; ++j)
                            e.row4(mrow + i * 16, ncol + j * 16 + g4 * 4, make_float4(acc[j][i][0], acc[j][i][1], acc[j][i][2], acc[j][i][3]));
                }
            });
        }
        if (qn == q) break;
        q = qn; m0 = m0n; n0 = n0n; pa = pan; pb = pbn;
    }
    asm volatile("s_waitcnt vmcnt(0)" ::: "memory");
    __syncthreads();
#undef G3P_TILE
}

template <class Epi>
__device__ __forceinline__ void gemm_bf16_phase3(const bf16_t* __restrict__ A, int lda, const bf16_t* __restrict__ Bt, int ldb,
                                                 int Mtiles  , int Ntiles, unsigned char* lds, Epi epi) {
    if constexpr (Epi::kRow) {
        if ((gridDim.x & 7) == 0 && (Mtiles & 15) == 0) { gemm_phase_pipelined(A, lda, Bt, ldb, Mtiles, Ntiles, lds, epi); return; }
    }
    if ((gridDim.x & 7) == 0 && (Mtiles & 15) == 0) {
        const int x = blockIdx.x & 7, j = blockIdx.x >> 3, nb = gridDim.x >> 3;
        const int per = (Mtiles >> 3) * Ntiles;
        for (int q = j; q < per; q += nb) {
            const int s = q / (2 * Ntiles), rem = q - s * (2 * Ntiles);
            const int c = rem >> 1, r = rem & 1;
            const int mt = x + 8 * (2 * s + r);
            gemm_tile3(A, lda, Bt, ldb, mt * 256, c * 128, lds, epi);
        }
    } else {
        for (int tile = blockIdx.x; tile < Mtiles * Ntiles; tile += gridDim.x)
            gemm_tile3(A, lda, Bt, ldb, (tile / Ntiles) * 256, (tile % Ntiles) * 128, lds, epi);
    }
}

struct EpiF32 {
    float* C; int ldc; int Nc;
    __device__ __forceinline__ void operator()(int m, int n, f32x4 v) const {
        if (n < Nc) *(float4*)(C + (size_t)m * ldc + n) = make_float4(v[0], v[1], v[2], v[3]);
    }
    __device__ __forceinline__ void finish(int, int) const {}
};

struct EpiProjBf {
    static constexpr bool kBf16 = true;
    bf16_t* dst; int ld; float sc;
    __device__ __forceinline__ uint2 pack4(f32x4 v) const { uint2 o; o.x = pack2bf(sc * v[0], sc * v[1]); o.y = pack2bf(sc * v[2], sc * v[3]); return o; }
    __device__ __forceinline__ void store8(int m, int n, uint4 o) const { *(uint4*)(dst + (size_t)m * ld + (n & 127)) = o; }
};
struct EpiProjLF {
    static constexpr bool kBf16 = false;
    unsigned char* ws;
    __device__ __forceinline__ void row4(int m, int n, float4 v) const {
        const int c = n - 512;
        const float4 lb = *(const float4*)((const float*)(ws + OFF_LBV) + c);
        float4 o;
        o.x = log_fast(lb.x + (1.f - lb.x) * sigmoid_fast(v.x)); o.y = log_fast(lb.y + (1.f - lb.y) * sigmoid_fast(v.y));
        o.z = log_fast(lb.z + (1.f - lb.z) * sigmoid_fast(v.z)); o.w = log_fast(lb.w + (1.f - lb.w) * sigmoid_fast(v.w));
        *(float4*)((float*)(ws + OFF_HLF) + (size_t)m * 512 + c) = o;
    }
};
struct EpiProjGate {
    static constexpr bool kBf16 = false;
    unsigned char* ws;
    __device__ __forceinline__ void row4(int m, int n, float4 v) const {
        const int c = n - 3328;
        if (c < 24)
            *(float4*)((float*)(ws + OFF_NGATE) + (size_t)m * 24 + c) =
                make_float4(sigmoid_fast(v.x), sigmoid_fast(v.y), sigmoid_fast(v.z), sigmoid_fast(v.w));
    }
};
struct EpiProj {
    static constexpr bool kRow = true;
    unsigned char* ws;
    template <class F> __device__ __forceinline__ void dispatch(int n0, F f) const {
        const int ct = __builtin_amdgcn_readfirstlane(n0 >> 7);
        if (ct >= 4 && ct < 8) f(EpiProjLF{ws});
        else if (ct >= 26) f(EpiProjGate{ws});
        else {
            size_t off; int ld = 512, c0 = (ct & 3) * 128; float sc = 1.f;
            if (ct < 4) off = OFF_HQ;
            else if (ct < 12) off = OFF_HI;
            else if (ct < 16) off = OFF_HG;
            else if (ct < 20) { off = OFF_NQ; sc = 0.125f * 1.4426950408889634f; }
            else { off = OFF_KV + (size_t)(ct - 20) * KV_STRIDE; ld = 128; c0 = 0; }
            f(EpiProjBf{(bf16_t*)(ws + off) + c0, ld, sc});
        }
    }
    __device__ __forceinline__ void finish(int, int) const {}
};
struct EpiMix {
    static constexpr bool kRow = true;
    bf16_t* mix;
    template <class F> __device__ __forceinline__ void dispatch(int n0, F f) const { f(EpiProjBf{mix + n0, DM, 1.f}); }
    __device__ __forceinline__ void finish(int, int) const {}
};

__device__ __forceinline__ uint4 pack8bf(const float* v) {
    uint4 o;
    o.x = pack2bf(v[0], v[1]); o.y = pack2bf(v[2], v[3]); o.z = pack2bf(v[4], v[5]); o.w = pack2bf(v[6], v[7]);
    return o;
}

__device__ __forceinline__ void hgrn_passA(const Params& p, int chunk, unsigned char* smem) {
    const int c = chunk & 127, bh = chunk >> 7, h = bh & 3, b = bh >> 2;
    const int tid = opaque_tid(), d = tid & 127, hf = __builtin_amdgcn_readfirstlane(tid >> 7), lane = tid & 63, w = __builtin_amdgcn_readfirstlane(tid >> 6);
    const size_t tok0 = (size_t)b * SEQ + (size_t)c * 64 + 32 * hf;
    const float* HLF = (const float*)(p.ws + OFF_HLF);
    const bf16_t* HI = (const bf16_t*)(p.ws + OFF_HI);
    unsigned char* KT = smem;
    unsigned char* VT = smem + 16384;
    float* xch = (float*)(smem + 32768);
    const float* lfp = HLF + tok0 * 512 + h * 128 + d;
    const bf16_t* vp = HI + tok0 * 512 + h * 128 + d;
    float run = 0.f;
#pragma unroll 8
    for (int s = 0; s < 32; ++s) run += lfp[s * 512];
    __syncthreads();
    xch[hf * 128 + d] = run;
    __syncthreads();
    const float tot0 = xch[d], tot1 = xch[128 + d];
    const float blast = tot0 + tot1;
    run = hf ? tot0 : 0.f;
#pragma unroll 1
    for (int q = 0; q < 4; ++q) {
        float kv[8], vv[8];
#pragma unroll
        for (int j = 0; j < 8; ++j) {
            const int s = q * 8 + j;
            const float lf = lfp[s * 512];
            run += lf;
            kv[j] = (1.f - expf(lf)) * expf(blast - run);
            vv[j] = bf2f(vp[s * 512]);
        }
        const int ch = 4 * hf + q;
        *(uint4*)(KT + d * 128 + ((ch ^ (d & 7)) << 4)) = pack8bf(kv);
        *(uint4*)(VT + d * 128 + ((ch ^ (d & 7)) << 4)) = pack8bf(vv);
    }
    if (hf) ((float*)(p.ws + OFF_DC))[(size_t)chunk * 128 + d] = expf(blast);
    __syncthreads();
    f32x4 acc[2][8];
#pragma unroll
    for (int i = 0; i < 2; ++i)
#pragma unroll
        for (int et = 0; et < 8; ++et) acc[i][et] = (f32x4){0.f, 0.f, 0.f, 0.f};
#pragma unroll
    for (int st = 0; st < 2; ++st) {
        const int ch = st * 4 + (lane >> 4);
        bf16x8 af[2];
#pragma unroll
        for (int i = 0; i < 2; ++i) {
            const int row = (2 * w + i) * 16 + (lane & 15);
            af[i] = *(const bf16x8*)(KT + row * 128 + ((ch ^ (row & 7)) << 4));
        }
#pragma unroll
        for (int et = 0; et < 8; ++et) {
            const int row = et * 16 + (lane & 15);
            const bf16x8 bfv = *(const bf16x8*)(VT + row * 128 + ((ch ^ (row & 7)) << 4));
            acc[0][et] = __builtin_amdgcn_mfma_f32_16x16x32_bf16(af[0], bfv, acc[0][et], 0, 0, 0);
            acc[1][et] = __builtin_amdgcn_mfma_f32_16x16x32_bf16(af[1], bfv, acc[1][et], 0, 0, 0);
        }
    }
    bf16_t* HC = (bf16_t*)p.out + (size_t)chunk * 16384;
#pragma unroll
    for (int i = 0; i < 2; ++i)
#pragma unroll
        for (int et = 0; et < 8; ++et) {
            const int e = et * 16 + (lane & 15), d0 = (2 * w + i) * 16 + (lane >> 4) * 4;
            { uint2 hv; hv.x = pack2bf(acc[i][et][0], acc[i][et][1]); hv.y = pack2bf(acc[i][et][2], acc[i][et][3]); *(uint2*)(HC + e * 128 + d0) = hv; }
        }
}

__device__ __forceinline__ void hgrn_scan_item(const Params& p, int item) {
    const int gid = item * 256 + threadIdx.x;
    const int d4 = gid & 31, e = (gid >> 5) & 127, bh = gid >> 12;
    const bf16_t* HC = (const bf16_t*)p.out;
    const float* DC = (const float*)(p.ws + OFF_DC);
    bf16_t* SC = (bf16_t*)(p.ws + OFF_SC);
    float4 S = make_float4(0.f, 0.f, 0.f, 0.f);
#pragma unroll 4
    for (int c = 0; c < 128; ++c) {
        const size_t base = ((size_t)(bh * 128 + c) * 128 + e) * 128 + d4 * 4;
        const uint2 hb = *(const uint2*)(HC + base);
        const float4 H = make_float4(__uint_as_float(hb.x << 16), __uint_as_float(hb.x & 0xffff0000u), __uint_as_float(hb.y << 16), __uint_as_float(hb.y & 0xffff0000u));
        const float4 dc = *(const float4*)(DC + (size_t)(bh * 128 + c) * 128 + d4 * 4);
        uint2 o; o.x = pack2bf(S.x, S.y); o.y = pack2bf(S.z, S.w);
        *(uint2*)(SC + base) = o;
        S.x = dc.x * S.x + H.x; S.y = dc.y * S.y + H.y; S.z = dc.z * S.z + H.z; S.w = dc.w * S.w + H.w;
    }
}

__device__ __forceinline__ void hgrn_passC(const Params& p, int chunk, unsigned char* smem) {
    const int c = chunk & 127, bh = chunk >> 7, h = bh & 3, b = bh >> 2;
    const int tid = opaque_tid(), d = tid & 127, hf = __builtin_amdgcn_readfirstlane(tid >> 7), lane = tid & 63, w = __builtin_amdgcn_readfirstlane(tid >> 6);
    const size_t tokc = (size_t)b * SEQ + (size_t)c * 64;
    const size_t tok0 = tokc + 32 * hf;
    const float* HLF = (const float*)(p.ws + OFF_HLF);
    const bf16_t* HQ = (const bf16_t*)(p.ws + OFF_HQ);
    const bf16_t* HI = (const bf16_t*)(p.ws + OFF_HI);
    const bf16_t* HG = (const bf16_t*)(p.ws + OFF_HG);
    unsigned char* R0 = smem;
    unsigned char* R1 = smem + 16384;
    unsigned char* R2 = smem + 57344;
    float* xch = (float*)R2;
    const float* lfp = HLF + tok0 * 512 + h * 128 + d;
    const bf16_t* qp = HQ + tok0 * 512 + h * 128 + d;
    float run = 0.f, b15 = 0.f;
#pragma unroll 8
    for (int s = 0; s < 32; ++s) { run += lfp[s * 512]; if (s == 15) b15 = run; }
    __syncthreads();
    xch[hf * 128 + d] = run;
    if (hf == 0) xch[256 + d] = b15;
    __syncthreads();
    const float tot0 = xch[d];
    const float off = hf ? tot0 : 0.f;
    const float r1 = xch[256 + d], r2 = tot0;
    if (hf) xch[384 + d] = off + b15;
    run = off;
#pragma unroll 8
    for (int s = 0; s < 32; ++s) {
        const int t = 32 * hf + s;
        run += lfp[s * 512];
        const float qv = bf2f(qp[s * 512]);
        *(bf16_t*)(R0 + t * 256 + ((((d >> 3) ^ (t & 15))) << 4) + (d & 7) * 2) = (bf16_t)f2bf(qv * expf(run));
    }
    {
        const bf16_t* SCp = (const bf16_t*)(p.ws + OFF_SC) + (size_t)chunk * 16384;
#pragma unroll
        for (int i = 0; i < 8; ++i) {
            const int cc = tid + 256 * i, row = cc >> 4, ch = cc & 15;
            *(uint4*)(R1 + row * 256 + ((ch ^ (row & 15)) << 4)) = *(const uint4*)(SCp + row * 128 + ch * 8);
        }
    }
    __syncthreads();
    f32x4 acc[8];
#pragma unroll
    for (int et = 0; et < 8; ++et) acc[et] = (f32x4){0.f, 0.f, 0.f, 0.f};
#pragma unroll
    for (int ds = 0; ds < 4; ++ds) {
        const int ch = ds * 4 + (lane >> 4);
        const int trow = w * 16 + (lane & 15);
        const bf16x8 bq = *(const bf16x8*)(R0 + trow * 256 + ((ch ^ (trow & 15)) << 4));
#pragma unroll
        for (int et = 0; et < 8; ++et) {
            const int row = et * 16 + (lane & 15);
            const bf16x8 av = *(const bf16x8*)(R1 + row * 256 + ((ch ^ (row & 15)) << 4));
            acc[et] = __builtin_amdgcn_mfma_f32_16x16x32_bf16(av, bq, acc[et], 0, 0, 0);
        }
    }
    __syncthreads();
    {
        const float r3 = xch[384 + d];
        run = off;
        unsigned char* dummy = R2 + 4096 + d * 2;
#pragma unroll 8
        for (int s = 0; s < 32; ++s) {
            const int t = 32 * hf + s;
            const int it = t >> 4;
            const float rr = (it == 0) ? 0.f : (it == 1) ? r1 : (it == 2) ? r2 : r3;
            const int sw = (((d >> 3) ^ (t & 15)) << 4) + (d & 7) * 2;
            const float lf = lfp[s * 512];
            run += lf;
            const float qv = bf2f(qp[s * 512]);
            const float kv = 1.f - expf(lf);
            *(bf16_t*)(R0 + t * 256 + sw) = (bf16_t)f2bf(qv * expf(run - rr));
#pragma unroll
            for (int i = 0; i < 4; ++i) {
                const float ri = (i == 0) ? 0.f : (i == 1) ? r1 : (i == 2) ? r2 : r3;
                const int R = 8 * i * (i + 1) + t;
                unsigned char* dst = (i >= it) ? (R1 + R * 256 + sw) : dummy;
                *(bf16_t*)dst = (bf16_t)f2bf(kv * expf(fminf(ri - run, 80.f)));
            }
        }
    }
    __syncthreads();
#pragma unroll
    for (int j = 0; j < 4; ++j) {
        uint2 o = make_uint2(0u, 0u);
        if (j <= w) {
            f32x4 pa = (f32x4){0.f, 0.f, 0.f, 0.f};
#pragma unroll
            for (int ds = 0; ds < 4; ++ds) {
                const int ch = ds * 4 + (lane >> 4);
                const int krow = 8 * w * (w + 1) + 16 * j + (lane & 15);
                const int trow = w * 16 + (lane & 15);
                const bf16x8 av = *(const bf16x8*)(R1 + krow * 256 + ((ch ^ (krow & 15)) << 4));
                const bf16x8 bq = *(const bf16x8*)(R0 + trow * 256 + ((ch ^ (trow & 15)) << 4));
                pa = __builtin_amdgcn_mfma_f32_16x16x32_bf16(av, bq, pa, 0, 0, 0);
            }
            if (j == w) {
                const int tl = lane & 15, sl = (lane >> 4) * 4;
#pragma unroll
                for (int r = 0; r < 4; ++r) if (sl + r > tl) pa[r] = 0.f;
            }
            o.x = pack2bf(pa[0], pa[1]); o.y = pack2bf(pa[2], pa[3]);
        }
        const int t = w * 16 + (lane & 15);
        const int ch = 2 * j + (lane >> 5);
        *(uint2*)(R2 + t * 128 + ((ch ^ (t & 7)) << 4) + ((lane >> 4) & 1) * 8) = o;
    }
    __syncthreads();
#pragma unroll
    for (int q = 0; q < 4; ++q) {
        float vv[8];
#pragma unroll
        for (int j = 0; j < 8; ++j) vv[j] = bf2f(HI[(tok0 + q * 8 + j) * 512 + h * 128 + d]);
        const int ch = 4 * hf + q;
        *(uint4*)(R1 + d * 128 + ((ch ^ (d & 7)) << 4)) = pack8bf(vv);
    }
    __syncthreads();
#pragma unroll
    for (int st = 0; st < 2; ++st) {
        const int ch = st * 4 + (lane >> 4);
        const int trow = w * 16 + (lane & 15);
        const bf16x8 bp = *(const bf16x8*)(R2 + trow * 128 + ((ch ^ (trow & 7)) << 4));
#pragma unroll
        for (int et = 0; et < 8; ++et) {
            const int row = et * 16 + (lane & 15);
            const bf16x8 av = *(const bf16x8*)(R1 + row * 128 + ((ch ^ (row & 7)) << 4));
            acc[et] = __builtin_amdgcn_mfma_f32_16x16x32_bf16(av, bp, acc[et], 0, 0, 0);
        }
    }
    {
        float ss = 0.f;
#pragma unroll
        for (int et = 0; et < 8; ++et)
#pragma unroll
            for (int r = 0; r < 4; ++r) ss += acc[et][r] * acc[et][r];
        ss += __shfl_xor(ss, 16);
        ss += __shfl_xor(ss, 32);
        const float rs = rsqrtf(ss * (1.f / 128.f) + LN_EPS);
        const size_t tok = tokc + w * 16 + (lane & 15);
        const float* ng = p.in[4];
        bf16_t* MIX = (bf16_t*)(p.ws + OFF_XB);
#pragma unroll
        for (int et = 0; et < 8; ++et) {
            const int e0 = et * 16 + (lane >> 4) * 4;
            const uint2 gb = *(const uint2*)(HG + tok * 512 + h * 128 + e0);
            const float4 n4 = *(const float4*)(ng + e0);
            const float g0 = bf2f(gb.x & 0xffffu), g1 = bf2f(gb.x >> 16), g2 = bf2f(gb.y & 0xffffu), g3 = bf2f(gb.y >> 16);
            uint2 o;
            o.x = pack2bf(acc[et][0] * rs * n4.x * (g0 * sigmoidf_(g0)), acc[et][1] * rs * n4.y * (g1 * sigmoidf_(g1)));
            o.y = pack2bf(acc[et][2] * rs * n4.z * (g2 * sigmoidf_(g2)), acc[et][3] * rs * n4.w * (g3 * sigmoidf_(g3)));
            *(uint2*)(MIX + tok * DM + h * 128 + e0) = o;
        }
    }
}

__device__ __forceinline__ void compress_item(const Params& p, int item, float* sm) {
    const int g = item & 1;
    int r = item >> 1;
    const int n = r % NCB; r /= NCB;
    const int b = r & 3, which = r >> 2;
    const int tid = opaque_tid();
    const bf16_t* kvsrc = (const bf16_t*)(p.ws + OFF_KV + (size_t)which * KV_STRIDE);
    const float* pe = p.in[which ? 10 : 5];
    const float* w1 = p.in[which ? 11 : 6];
    const float* b1 = p.in[which ? 12 : 7];
    const float* w2 = p.in[which ? 13 : 8];
    const float* b2 = p.in[which ? 14 : 9];
    float* outp = (float*)(p.ws + (which ? OFF_CMPV : OFF_CMPK));
    float* blk = sm;
    float* hh = sm + 2048;
    __syncthreads();
    for (int i = tid; i < 2048; i += 256) {
        const int l = i >> 6, d = i & 63;
        blk[i] = bf2f(kvsrc[(size_t)(b * SEQ + 16 * n + l) * 128 + g * 64 + d]) + pe[i];
    }
    __syncthreads();
    float acc = b1[tid];
    for (int i = 0; i < 2048; ++i) acc += blk[i] * w1[(size_t)i * 256 + tid];
    hh[tid] = gelu_tanh(acc);
    __syncthreads();
    if (tid < 64) {
        float o = b2[tid];
        for (int j = 0; j < 256; ++j) o += hh[j] * w2[j * 64 + tid];
        outp[((size_t)(b * NCB + n) * 2 + g) * 64 + tid] = o;
    }
}

__device__ __forceinline__ float dot64_bf(const float* qs, const bf16_t* krow) {
    float s = 0.f;
#pragma unroll
    for (int i = 0; i < 8; ++i) {
        const uint4 kv = ((const uint4*)krow)[i];
        const float4 q0 = ((const float4*)qs)[2 * i], q1 = ((const float4*)qs)[2 * i + 1];
        s += __uint_as_float(kv.x << 16) * q0.x + __uint_as_float(kv.x & 0xffff0000u) * q0.y
           + __uint_as_float(kv.y << 16) * q0.z + __uint_as_float(kv.y & 0xffff0000u) * q0.w
           + __uint_as_float(kv.z << 16) * q1.x + __uint_as_float(kv.z & 0xffff0000u) * q1.y
           + __uint_as_float(kv.w << 16) * q1.z + __uint_as_float(kv.w & 0xffff0000u) * q1.w;
    }
    return s;
}
__device__ __forceinline__ float dot64(const float* qs, const float* krow) {
    float s = 0.f;
#pragma unroll
    for (int i = 0; i < 16; ++i) {
        const float4 kv = ((const float4*)krow)[i];
        const float4 qv = ((const float4*)qs)[i];
        s += kv.x * qv.x + kv.y * qv.y + kv.z * qv.z + kv.w * qv.w;
    }
    return s;
}

__device__ __forceinline__ void nsa_item(const Params& p, int item, float* sm) {
    const int t = item & (SEQ - 1), g = (item >> 13) & 1, b = item >> 14;
    const int tid = threadIdx.x, lane = tid & 63, r = tid >> 6;
    float* sc = sm + r * 1024;
    float* qs = sm + 4096 + r * 64;
    float* impv = sm + 4096 + 256;
    int* sel = (int*)(sm + 4096 + 256 + 128);
    const bf16_t* KSb = (const bf16_t*)(p.ws + OFF_KV + 2 * KV_STRIDE);
    const bf16_t* VSb = (const bf16_t*)(p.ws + OFF_KV + 3 * KV_STRIDE);
    const bf16_t* KWb = (const bf16_t*)(p.ws + OFF_KV + 4 * KV_STRIDE);
    const bf16_t* VWb = (const bf16_t*)(p.ws + OFF_KV + 5 * KV_STRIDE);
    const float* cmpk = (const float*)(p.ws + OFF_CMPK);
    const float* cmpv = (const float*)(p.ws + OFF_CMPV);
    const size_t n = (size_t)b * SEQ + t;
    const float NEGV = -1e30f;
    __syncthreads();
    qs[lane] = bf2f(((const bf16_t*)(p.ws + OFF_NQ))[n * 512 + g * 256 + r * 64 + lane]) * 0.6931471805599453f;
    __syncthreads();

    const int nvalid = (t >= 31) ? (((t - 31) >> 4) + 1) : 0;
    float m = NEGV;
    for (int n0 = 0; n0 < nvalid; n0 += 64) {
        const int nn = n0 + lane;
        if (nn < nvalid) {
            const float s = dot64(qs, cmpk + ((size_t)(b * NCB + nn) * 2 + g) * 64);
            sc[nn] = s;
            m = fmaxf(m, s);
        }
    }
    m = wave_max(m);
    float sum = 0.f;
    for (int n0 = 0; n0 < nvalid; n0 += 64) {
        const int nn = n0 + lane;
        if (nn < nvalid) { const float e = expf(sc[nn] - m); sc[nn] = e; sum += e; }
    }
    sum = wave_sum(sum);
    {
        const float inv = 1.f / fmaxf(sum, 1e-30f);
        for (int n0 = 0; n0 < nvalid; n0 += 64) {
            const int nn = n0 + lane;
            if (nn < nvalid) sc[nn] *= inv;
        }
    }
    __syncthreads();
    float oc = 0.f;
    for (int nn = 0; nn < nvalid; ++nn) oc += sc[nn] * cmpv[((size_t)(b * NCB + nn) * 2 + g) * 64 + lane];

    const int cur = t >> 6;
    if (tid < 128) {
        const int j = tid;
        float im = 0.f;
#pragma unroll
        for (int rr = 0; rr < 4; ++rr) {
            const float* P = sm + rr * 1024;
            const int n4 = 4 * j;
            float a = 0.f;
            if (n4 < nvalid) a += P[n4];
            if (n4 + 1 < nvalid) a += P[n4 + 1];
            if (n4 + 2 < nvalid) a += P[n4 + 2];
            if (n4 + 3 < nvalid) a += 0.5f * P[n4 + 3];
            if (n4 - 1 >= 0 && n4 - 1 < nvalid) a += 0.5f * P[n4 - 1];
            im += a;
        }
        const bool forced = (j == 0) || (j == cur) || (j == cur - 1);
        const bool causal = (j <= cur);
        impv[j] = forced ? 1.0e4f : (causal ? im : -1.f);
    }
    __syncthreads();
    if (r == 0) {
        float v0 = impv[lane], v1 = impv[lane + 64];
        for (int k = 0; k < 16; ++k) {
            const float mx = wave_max(fmaxf(v0, v1));
            const unsigned long long b0 = __ballot(v0 == mx);
            int idx;
            if (b0) {
                const int l = __ffsll((unsigned long long)b0) - 1;
                idx = l;
                if (lane == l) v0 = -3.0e38f;
            } else {
                const unsigned long long b1 = __ballot(v1 == mx);
                const int l = __ffsll((unsigned long long)b1) - 1;
                idx = 64 + l;
                if (lane == l) v1 = -3.0e38f;
            }
            if (lane == 0) sel[k] = idx;
        }
    }
    __syncthreads();

    m = NEGV;
    for (int si = 0; si < 16; ++si) {
        const int blk = sel[si];
        const int key = blk * 64 + lane;
        float s = NEGV;
        if (blk * 64 <= t) {
            if (key <= t) s = dot64_bf(qs, KSb + ((size_t)b * SEQ + key) * 128 + g * 64);
        }
        sc[si * 64 + lane] = s;
        m = fmaxf(m, s);
    }
    m = wave_max(m);
    sum = 0.f;
    for (int si = 0; si < 16; ++si) {
        const int key = sel[si] * 64 + lane;
        const float e = (key <= t) ? expf(sc[si * 64 + lane] - m) : 0.f;
        sc[si * 64 + lane] = e;
        sum += e;
    }
    sum = wave_sum(sum);
    {
        const float inv = 1.f / fmaxf(sum, 1e-30f);
        for (int si = 0; si < 16; ++si) sc[si * 64 + lane] *= inv;
    }
    __syncthreads();
    float os = 0.f;
    for (int si = 0; si < 16; ++si) {
        const int blk = sel[si];
        if (blk * 64 > t) continue;
        for (int kk = 0; kk < 64; ++kk) {
            const int key = blk * 64 + kk;
            if (key > t) break;
            os += sc[si * 64 + kk] * bf2f(VSb[((size_t)b * SEQ + key) * 128 + g * 64 + lane]);
        }
    }
    __syncthreads();

    const int lo = t - 511;
    m = NEGV;
    for (int i = 0; i < 8; ++i) {
        const int key = lo + i * 64 + lane;
        float s = NEGV;
        if (key >= 0) s = dot64_bf(qs, KWb + ((size_t)b * SEQ + key) * 128 + g * 64);
        sc[i * 64 + lane] = s;
        m = fmaxf(m, s);
    }
    m = wave_max(m);
    sum = 0.f;
    for (int i = 0; i < 8; ++i) {
        const int key = lo + i * 64 + lane;
        const float e = (key >= 0) ? expf(sc[i * 64 + lane] - m) : 0.f;
        sc[i * 64 + lane] = e;
        sum += e;
    }
    sum = wave_sum(sum);
    {
        const float inv = 1.f / fmaxf(sum, 1e-30f);
        for (int i = 0; i < 8; ++i) sc[i * 64 + lane] *= inv;
    }
    __syncthreads();
    float ow = 0.f;
    for (int idx = 0; idx < 512; ++idx) {
        const int key = lo + idx;
        if (key < 0) continue;
        ow += sc[idx] * bf2f(VWb[((size_t)b * SEQ + key) * 128 + g * 64 + lane]);
    }
    const float* grow = (const float*)(p.ws + OFF_NGATE) + n * 24 + g * 12 + r * 3;
    const float gc = grow[0], gs = grow[1], gw = grow[2];
#if NSA_DIAG
    {
        const float ref = gc * oc + gs * os + gw * ow;
        const float got = bf2f(((const bf16_t*)(p.ws + OFF_XB))[n * DM + 512 + g * 256 + r * 64 + lane]);
        const unsigned* SELM = (const unsigned*)(p.ws + OFF_SELM) + ((size_t)(b * 2 + g) * SEQ + t) * 4;
        unsigned gm[4] = {0u, 0u, 0u, 0u};
        for (int si = 0; si < 16; ++si) { const int blk = sel[si]; if (blk * 64 <= t) gm[blk >> 5] |= 1u << (blk & 31); }
        bool same = true;
        for (int qd = 0; qd < 4; ++qd) {
            unsigned mm = SELM[qd];
            for (int bit = 0; bit < 32; ++bit) if ((qd * 32 + bit) * 64 > t) mm &= ~(1u << bit);
            if (mm != gm[qd]) same = false;
        }
        float d2 = same ? (got - ref) * (got - ref) : 0.f, r2 = same ? ref * ref : 0.f;
        d2 = wave_sum(d2); r2 = wave_sum(r2);
        float* DG = (float*)(p.ws + OFF_DIAG);
        if (lane == 0) { atomicAdd(&DG[0], d2); atomicAdd(&DG[1], r2); if (r == 0) { atomicAdd(&DG[2], same ? 0.f : 1.f); atomicAdd(&DG[3], 1.f); } }
    }
#else
    ((bf16_t*)(p.ws + OFF_XB))[n * DM + 512 + g * 256 + r * 64 + lane] = (bf16_t)f2bf(gc * oc + gs * os + gw * ow);
#endif
}


__device__ __forceinline__ float xrow_max(float x) {
    auto s = __builtin_amdgcn_permlane16_swap(__float_as_uint(x), __float_as_uint(x), false, false);
    x = fmaxf(__uint_as_float(s[0]), __uint_as_float(s[1]));
    auto t = __builtin_amdgcn_permlane32_swap(__float_as_uint(x), __float_as_uint(x), false, false);
    return fmaxf(__uint_as_float(t[0]), __uint_as_float(t[1]));
}
__device__ __forceinline__ float xrow_sum(float x) {
    auto s = __builtin_amdgcn_permlane16_swap(__float_as_uint(x), __float_as_uint(x), false, false);
    x = __uint_as_float(s[0]) + __uint_as_float(s[1]);
    auto t = __builtin_amdgcn_permlane32_swap(__float_as_uint(x), __float_as_uint(x), false, false);
    return __uint_as_float(t[0]) + __uint_as_float(t[1]);
}
template <int CTRL> __device__ __forceinline__ float dppf(float x) {
    return __builtin_bit_cast(float, __builtin_amdgcn_mov_dpp(__builtin_bit_cast(int, x), CTRL, 0xf, 0xf, true));
}
__device__ __forceinline__ float row16_max(float m) {
    m = fmaxf(m, dppf<0x121>(m)); m = fmaxf(m, dppf<0x122>(m));
    m = fmaxf(m, dppf<0x124>(m)); m = fmaxf(m, dppf<0x128>(m));
    return m;
}
__device__ __forceinline__ float row16_sum(float m) {
    m += dppf<0x121>(m); m += dppf<0x122>(m); m += dppf<0x124>(m); m += dppf<0x128>(m);
    return m;
}
__device__ __forceinline__ float dot2bf(unsigned a, unsigned b, float acc) {
    return __builtin_amdgcn_fdot2_f32_bf16(__builtin_bit_cast(bf16x2_t, a), __builtin_bit_cast(bf16x2_t, b), acc, false);
}
__device__ __forceinline__ float enc_key(float v, unsigned idx, unsigned mask) {
    const unsigned u = __float_as_uint(v);
    const unsigned code = (u >> 31) ? idx : (mask - idx);
    return __uint_as_float((u & ~mask) | code);
}
__device__ __forceinline__ unsigned dec_idx(float key, unsigned mask) {
    const unsigned u = __float_as_uint(key);
    const unsigned code = u & mask;
    return (u >> 31) ? code : (mask - code);
}
__device__ __forceinline__ float dec_val(float key, unsigned mask) { return __uint_as_float(__float_as_uint(key) & ~mask); }
#define NEGKEY (-3.0e38f)
#define CE_DESC(a, b) { const float t_ = fmaxf(a, b); b = fminf(a, b); a = t_; }

struct EpiCmpH {
    bf16_t* HB; const float* peb;
    __device__ __forceinline__ void operator()(int m, int n, f32x4 v) const {
        const float4 pb = *(const float4*)(peb + n);
        uint2 o;
        o.x = pack2bf(gelu_tanh(v[0] + pb.x), gelu_tanh(v[1] + pb.y));
        o.y = pack2bf(gelu_tanh(v[2] + pb.z), gelu_tanh(v[3] + pb.w));
        *(uint2*)(HB + (size_t)m * 256 + n) = o;
    }
    __device__ __forceinline__ void finish(int, int) const {}
};
__device__ __forceinline__ void cmp_peb_partial(const Params& p, int b) {
    const int which = b >> 5, s = b & 31;
    const float* pe = p.in[which ? 10 : 5];
    const float* w1 = p.in[which ? 11 : 6];
    const int j = threadIdx.x;
    float acc = 0.f;
#pragma unroll 16
    for (int i = s * 64; i < s * 64 + 64; ++i) acc += pe[i] * w1[(size_t)i * 256 + j];
    ((float*)(p.ws + OFF_PEB + 4096))[(which * 32 + s) * 256 + j] = acc;
}
__device__ __forceinline__ void cmp_peb_reduce(const Params& p) {
    for (int o = threadIdx.x; o < 512; o += 256) {
        const int which = o >> 8, j = o & 255;
        float acc = p.in[which ? 12 : 7][j];
        for (int s = 0; s < 32; ++s) acc += ((const float*)(p.ws + OFF_PEB + 4096))[(which * 32 + s) * 256 + j];
        ((float*)(p.ws + OFF_PEB))[o] = acc;
    }
}
__device__ __forceinline__ void cmp_layer2_phase(const Params& p, int first_block, int nblocks) {
    const int tid_ = opaque_tid(), lane = tid_ & 63, w = __builtin_amdgcn_readfirstlane(tid_ >> 6);
    for (int it = (blockIdx.x - first_block) * 4 + w; it < 2 * 4088; it += nblocks * 4) {
        const int which = it >= 4088, row = which ? it - 4088 : it;
        const float* w2 = p.in[which ? 13 : 8];
        const float* b2 = p.in[which ? 14 : 9];
        const bf16_t* hrow = (const bf16_t*)(p.ws + OFF_HB) + ((size_t)which * 4096 + row) * 256;
        float o = b2[lane];
#pragma unroll 8
        for (int j = 0; j < 256; ++j) o += bf2f(hrow[j]) * w2[j * 64 + lane];
        const int g = row & 1, bn = row >> 1, n = bn % NCB, b = bn / NCB;
        ((bf16_t*)(p.ws + (which ? OFF_CMPVB : OFF_CMPKB)))[((size_t)(b * 2 + g) * 512 + n) * 64 + lane] = (bf16_t)f2bf(o);
    }
}

struct StageOfs { int k, v; };
__device__ __forceinline__ StageOfs make_stage_ofs() {
    const int c0 = opaque_tid(), key = c0 >> 3, ch = c0 & 7;
    StageOfs s;
    s.k = key * 128 + ((ch ^ (key & 7)) << 4);
    s.v = key * 128 + (((ch >> 1) ^ ((key >> 1) & 3)) << 5) + (ch & 1) * 16;
    return s;
}
#define NSA_KV_LOAD(S_, kb_) { const bf16_t* kp_ = Kbase + (size_t)(kb_) * 64 * stride + (size_t)(tid >> 3) * stride + (tid & 7) * 8; \
        const bf16_t* vp_ = Vbase + (size_t)(kb_) * 64 * stride + (size_t)(tid >> 3) * stride + (tid & 7) * 8;                 \
        S_##k0 = *(const uint4*)kp_; S_##k1 = *(const uint4*)(kp_ + (size_t)32 * stride);                                    \
        S_##v0 = *(const uint4*)vp_; S_##v1 = *(const uint4*)(vp_ + (size_t)32 * stride); }
#define NSA_KV_STORE(S_, Kl_, Vl_) { *(uint4*)((Kl_) + sof.k) = S_##k0; *(uint4*)((Kl_) + sof.k + 4096) = S_##k1; \
        *(uint4*)((Vl_) + sof.v) = S_##v0; *(uint4*)((Vl_) + sof.v + 4096) = S_##v1; }
template <class Compute>
__device__ __forceinline__ void nsa_kv_loop(const bf16_t* __restrict__ Kbase, const bf16_t* __restrict__ Vbase, int stride,
                                            int kb_lo, int kb_hi, unsigned char* smem, const StageOfs& sof, Compute compute) {
    const int tid = opaque_tid();
    uint4 ra_k0, ra_k1, ra_v0, ra_v1;
    NSA_KV_LOAD(ra_, kb_lo)
    __syncthreads();
    NSA_KV_STORE(ra_, smem, smem + 16384)
    __syncthreads();
    for (int kb = kb_lo; kb <= kb_hi; ++kb) {
        const int buf = (kb - kb_lo) & 1;
        if (kb < kb_hi) NSA_KV_LOAD(ra_, kb + 1)
        compute(kb, smem + buf * 8192, smem + 16384 + buf * 8192);
        if (kb < kb_hi) NSA_KV_STORE(ra_, smem + (buf ^ 1) * 8192, smem + 16384 + (buf ^ 1) * 8192)
        __syncthreads();
    }
}
struct LaneOfs { int k0, k1, vb0, vb1, vb2, vb3; };
__device__ __forceinline__ LaneOfs make_lane_ofs(int lane) {
    LaneOfs f;
    const int r15 = lane & 15, lg = lane >> 4, q = r15 >> 2, pp = r15 & 3;
    f.k0 = r15 * 128 + ((lg ^ (r15 & 7)) << 4);
    f.k1 = r15 * 128 + (((4 + lg) ^ (r15 & 7)) << 4);
    const int sw2 = (2 * (lg & 1) + (q >> 1)) & 3;
    const int vrow = (4 * lg + q) * 128 + pp * 8;
    f.vb0 = vrow + ((0 ^ sw2) << 5); f.vb1 = vrow + ((1 ^ sw2) << 5);
    f.vb2 = vrow + ((2 ^ sw2) << 5); f.vb3 = vrow + ((3 ^ sw2) << 5);
    return f;
}
typedef short s16x4 __attribute__((ext_vector_type(4)));
__device__ __forceinline__ uint2 tr_read(const unsigned char* p) {
    const s16x4 v = __builtin_amdgcn_ds_read_tr16_b64_v4i16((LAS3 s16x4*)p);
    return __builtin_bit_cast(uint2, v);
}
#define NEGM (-1.0e37f)
__device__ __forceinline__ void nsa_scores(const unsigned char* Kl, const LaneOfs& f, const bf16x8& q0, const bf16x8& q1, float bias, f32x4 (&s)[4]) {
#pragma unroll
    for (int kt = 0; kt < 4; ++kt) {
        const bf16x8 a0 = *(const bf16x8*)(Kl + f.k0 + kt * 2048);
        const bf16x8 a1 = *(const bf16x8*)(Kl + f.k1 + kt * 2048);
        f32x4 z = (f32x4){bias, bias, bias, bias};
        z = __builtin_amdgcn_mfma_f32_16x16x32_bf16(a0, q0, z, 0, 0, 0);
        s[kt] = __builtin_amdgcn_mfma_f32_16x16x32_bf16(a1, q1, z, 0, 0, 0);
    }
}
#define ONES_BF16X8 __builtin_bit_cast(bf16x8, make_uint4(0x3F803F80u, 0x3F803F80u, 0x3F803F80u, 0x3F803F80u))
template <class VF>
__device__ __forceinline__ void attn_step(const unsigned char* Kl, const unsigned char* Vl, int lane, const LaneOfs& f,
                                          const bf16x8& q0, const bf16x8& q1, f32x4 (&o)[4], float& m, f32x4& lacc,
                                          float rowbias, bool full, VF valid) {
    f32x4 s[4];
    const bool mok = m > -1e29f;
    const float meff = mok ? m : 0.f;
    nsa_scores(Kl, f, q0, q1, rowbias - meff, s);
    if (!full) {
#pragma unroll
        for (int kt = 0; kt < 4; ++kt)
#pragma unroll
            for (int r = 0; r < 4; ++r) s[kt][r] = valid(kt * 16 + 4 * (lane >> 4) + r) ? s[kt][r] : NEGM;
    }
    float mx = fmaxf(fmaxf(fmaxf(s[0][0], s[0][1]), fmaxf(s[0][2], s[0][3])), fmaxf(fmaxf(s[1][0], s[1][1]), fmaxf(s[1][2], s[1][3])));
    mx = fmaxf(mx, fmaxf(fmaxf(fmaxf(s[2][0], s[2][1]), fmaxf(s[2][2], s[2][3])), fmaxf(fmaxf(s[3][0], s[3][1]), fmaxf(s[3][2], s[3][3]))));
    mx = xrow_max(mx);
    if (!__all(mok && (mx <= 8.f))) {
        const float mn = fmaxf(m, meff + mx);
        const float alpha = __builtin_amdgcn_exp2f(m - mn), d = mn - meff;
        m = mn; lacc[0] *= alpha;
#pragma unroll
        for (int dt = 0; dt < 4; ++dt) { o[dt][0] *= alpha; o[dt][1] *= alpha; o[dt][2] *= alpha; o[dt][3] *= alpha; }
#pragma unroll
        for (int kt = 0; kt < 4; ++kt) { s[kt][0] -= d; s[kt][1] -= d; s[kt][2] -= d; s[kt][3] -= d; }
    }
#pragma unroll
    for (int kt = 0; kt < 4; ++kt)
#pragma unroll
        for (int r = 0; r < 4; ++r) s[kt][r] = __builtin_amdgcn_exp2f(s[kt][r]);
#pragma unroll
    for (int k2 = 0; k2 < 2; ++k2) {
        uint4 pk;
        pk.x = pack2bf(s[2 * k2][0], s[2 * k2][1]); pk.y = pack2bf(s[2 * k2][2], s[2 * k2][3]);
        pk.z = pack2bf(s[2 * k2 + 1][0], s[2 * k2 + 1][1]); pk.w = pack2bf(s[2 * k2 + 1][2], s[2 * k2 + 1][3]);
        const bf16x8 pb = __builtin_bit_cast(bf16x8, pk);
        lacc = __builtin_amdgcn_mfma_f32_16x16x32_bf16(ONES_BF16X8, pb, lacc, 0, 0, 0);
#define PV1(dt_, vb_) { const uint2 lo_ = tr_read(Vl + (vb_) + k2 * 4096), hi_ = tr_read(Vl + (vb_) + k2 * 4096 + 2048); \
                        uint4 av_; av_.x = lo_.x; av_.y = lo_.y; av_.z = hi_.x; av_.w = hi_.y;                          \
                        o[dt_] = __builtin_amdgcn_mfma_f32_16x16x32_bf16(__builtin_bit_cast(bf16x8, av_), pb, o[dt_], 0, 0, 0); }
        PV1(0, f.vb0) PV1(1, f.vb1) PV1(2, f.vb2) PV1(3, f.vb3)
#undef PV1
    }
}
template <class VFA, class VFB>
__device__ __forceinline__ void attn_step2(const unsigned char* Kl, const unsigned char* Vl, int lane, const LaneOfs& f,
                                           const bf16x8& qA0, const bf16x8& qA1, f32x4 (&oA)[4], float& mA, f32x4& lA, float biasA, bool fullA, VFA validA,
                                           const bf16x8& qB0, const bf16x8& qB1, f32x4 (&oB)[4], float& mB, f32x4& lB, float biasB, bool fullB, VFB validB) {
    f32x4 sA[4], sB[4];
    const bool mokA = mA > -1e29f, mokB = mB > -1e29f;
    const float meA = mokA ? mA : 0.f, meB = mokB ? mB : 0.f;
    const float iA = biasA - meA, iB = biasB - meB;
#pragma unroll
    for (int kt = 0; kt < 4; ++kt) {
        const bf16x8 a0 = *(const bf16x8*)(Kl + f.k0 + kt * 2048);
        const bf16x8 a1 = *(const bf16x8*)(Kl + f.k1 + kt * 2048);
        f32x4 zA = (f32x4){iA, iA, iA, iA}, zB = (f32x4){iB, iB, iB, iB};
        zA = __builtin_amdgcn_mfma_f32_16x16x32_bf16(a0, qA0, zA, 0, 0, 0);
        zB = __builtin_amdgcn_mfma_f32_16x16x32_bf16(a0, qB0, zB, 0, 0, 0);
        sA[kt] = __builtin_amdgcn_mfma_f32_16x16x32_bf16(a1, qA1, zA, 0, 0, 0);
        sB[kt] = __builtin_amdgcn_mfma_f32_16x16x32_bf16(a1, qB1, zB, 0, 0, 0);
    }
    if (!fullA) {
#pragma unroll
        for (int kt = 0; kt < 4; ++kt)
#pragma unroll
            for (int r = 0; r < 4; ++r) sA[kt][r] = validA(kt * 16 + 4 * (lane >> 4) + r) ? sA[kt][r] : NEGM;
    }
    if (!fullB) {
#pragma unroll
        for (int kt = 0; kt < 4; ++kt)
#pragma unroll
            for (int r = 0; r < 4; ++r) sB[kt][r] = validB(kt * 16 + 4 * (lane >> 4) + r) ? sB[kt][r] : NEGM;
    }
    float mxA = fmaxf(fmaxf(fmaxf(sA[0][0], sA[0][1]), fmaxf(sA[0][2], sA[0][3])), fmaxf(fmaxf(sA[1][0], sA[1][1]), fmaxf(sA[1][2], sA[1][3])));
    float mxB = fmaxf(fmaxf(fmaxf(sB[0][0], sB[0][1]), fmaxf(sB[0][2], sB[0][3])), fmaxf(fmaxf(sB[1][0], sB[1][1]), fmaxf(sB[1][2], sB[1][3])));
    mxA = fmaxf(mxA, fmaxf(fmaxf(fmaxf(sA[2][0], sA[2][1]), fmaxf(sA[2][2], sA[2][3])), fmaxf(fmaxf(sA[3][0], sA[3][1]), fmaxf(sA[3][2], sA[3][3]))));
    mxB = fmaxf(mxB, fmaxf(fmaxf(fmaxf(sB[2][0], sB[2][1]), fmaxf(sB[2][2], sB[2][3])), fmaxf(fmaxf(sB[3][0], sB[3][1]), fmaxf(sB[3][2], sB[3][3]))));
    mxA = xrow_max(mxA); mxB = xrow_max(mxB);
    if (!__all(mokA && mokB && (mxA <= 8.f) && (mxB <= 8.f))) {
        const float mnA = fmaxf(mA, meA + mxA), mnB = fmaxf(mB, meB + mxB);
        const float alA = __builtin_amdgcn_exp2f(mA - mnA), alB = __builtin_amdgcn_exp2f(mB - mnB);
        const float dA = mnA - meA, dB = mnB - meB;
        mA = mnA; mB = mnB; lA[0] *= alA; lB[0] *= alB;
#pragma unroll
        for (int dt = 0; dt < 4; ++dt) {
            oA[dt][0] *= alA; oA[dt][1] *= alA; oA[dt][2] *= alA; oA[dt][3] *= alA;
            oB[dt][0] *= alB; oB[dt][1] *= alB; oB[dt][2] *= alB; oB[dt][3] *= alB;
        }
#pragma unroll
        for (int kt = 0; kt < 4; ++kt) {
            sA[kt][0] -= dA; sA[kt][1] -= dA; sA[kt][2] -= dA; sA[kt][3] -= dA;
            sB[kt][0] -= dB; sB[kt][1] -= dB; sB[kt][2] -= dB; sB[kt][3] -= dB;
        }
    }
#pragma unroll
    for (int kt = 0; kt < 4; ++kt)
#pragma unroll
        for (int r = 0; r < 4; ++r) { sA[kt][r] = __builtin_amdgcn_exp2f(sA[kt][r]); sB[kt][r] = __builtin_amdgcn_exp2f(sB[kt][r]); }
#pragma unroll
    for (int k2 = 0; k2 < 2; ++k2) {
        uint4 pk;
        pk.x = pack2bf(sA[2 * k2][0], sA[2 * k2][1]); pk.y = pack2bf(sA[2 * k2][2], sA[2 * k2][3]);
        pk.z = pack2bf(sA[2 * k2 + 1][0], sA[2 * k2 + 1][1]); pk.w = pack2bf(sA[2 * k2 + 1][2], sA[2 * k2 + 1][3]);
        const bf16x8 pbA = __builtin_bit_cast(bf16x8, pk);
        pk.x = pack2bf(sB[2 * k2][0], sB[2 * k2][1]); pk.y = pack2bf(sB[2 * k2][2], sB[2 * k2][3]);
        pk.z = pack2bf(sB[2 * k2 + 1][0], sB[2 * k2 + 1][1]); pk.w = pack2bf(sB[2 * k2 + 1][2], sB[2 * k2 + 1][3]);
        const bf16x8 pbB = __builtin_bit_cast(bf16x8, pk);
        lA = __builtin_amdgcn_mfma_f32_16x16x32_bf16(ONES_BF16X8, pbA, lA, 0, 0, 0);
        lB = __builtin_amdgcn_mfma_f32_16x16x32_bf16(ONES_BF16X8, pbB, lB, 0, 0, 0);
#define PV2(dt_, vb_) { const uint2 lo_ = tr_read(Vl + (vb_) + k2 * 4096), hi_ = tr_read(Vl + (vb_) + k2 * 4096 + 2048); \
                        uint4 av_; av_.x = lo_.x; av_.y = lo_.y; av_.z = hi_.x; av_.w = hi_.y;                          \
                        oA[dt_] = __builtin_amdgcn_mfma_f32_16x16x32_bf16(__builtin_bit_cast(bf16x8, av_), pbA, oA[dt_], 0, 0, 0); \
                        oB[dt_] = __builtin_amdgcn_mfma_f32_16x16x32_bf16(__builtin_bit_cast(bf16x8, av_), pbB, oB[dt_], 0, 0, 0); }
        PV2(0, f.vb0) PV2(1, f.vb1) PV2(2, f.vb2) PV2(3, f.vb3)
#undef PV2
    }
}

#define NSA_TILES 2048
__device__ __forceinline__ void nsa_tile(const Params& p, int tile, unsigned char* smem) {
    const int tid = opaque_tid(), lane = tid & 63, w = __builtin_amdgcn_readfirstlane(tid >> 6);
    const int bg = tile & 7, tb = 255 - (tile >> 3);
    const int b = bg >> 1, g = bg & 1;
    const int t0 = tb * 32, cur = t0 >> 6;
    float* impL = (float*)(smem + 32768);
    unsigned* selL = (unsigned*)(smem + 49152);
    const bf16_t* NQ = (const bf16_t*)(p.ws + OFF_NQ);
    const float* NG = (const float*)(p.ws + OFF_NGATE);
    const int rowq = lane & 15, tl = rowq >> 2, head = rowq & 3, lg = lane >> 4;
    const int toklA = 8 * w + tl, toklB = 8 * w + 4 + tl;
    const LaneOfs lof = make_lane_ofs(lane);
    const StageOfs sof = make_stage_ofs();
    const size_t tokb = (size_t)b * SEQ + t0;
    bf16x8 qA0, qA1, qB0, qB1;
    {
        const bf16_t* qp = NQ + (tokb + toklA) * 512 + g * 256 + head * 64 + lg * 8;
        qA0 = *(const bf16x8*)qp; qA1 = *(const bf16x8*)(qp + 32);
        qB0 = *(const bf16x8*)(qp + 4 * 512); qB1 = *(const bf16x8*)(qp + 4 * 512 + 32);
    }
    const float* gpA = NG + (tokb + toklA) * 24 + g * 12 + head * 3;
    const float* gpB = gpA + 4 * 24;
    __syncthreads();
    for (int i = tid; i < 4096; i += 256) impL[i] = 0.f;
    const int tqA = t0 + toklA, tqB = t0 + toklB;
    const int tminA = t0 + 8 * w, tminB = tminA + 4;
    f32x4 oA[4], oB[4], otA[4], otB[4];
    float mA, mB;
    f32x4 lA, lB;
#define NSA_RESET() { _Pragma("unroll") for (int dt = 0; dt < 4; ++dt) { oA[dt] = (f32x4){0.f, 0.f, 0.f, 0.f}; oB[dt] = (f32x4){0.f, 0.f, 0.f, 0.f}; } \
                      mA = -1e30f; mB = -1e30f; lA = (f32x4){0.f, 0.f, 0.f, 0.f}; lB = (f32x4){0.f, 0.f, 0.f, 0.f}; }
#define NSA_LSUM() { }

    const int nvA = (tqA >= 31) ? (((tqA - 31) >> 4) + 1) : 0;
    const int nvB = (tqB >= 31) ? (((tqB - 31) >> 4) + 1) : 0;
    const int nvminA = (tminA >= 31) ? (((tminA - 31) >> 4) + 1) : 0;
    const int nvminB = (tminB >= 31) ? (((tminB - 31) >> 4) + 1) : 0;
    const int nkb = (((t0 >> 4) + 1) + 63) >> 6;
    const bf16_t* ckb = (const bf16_t*)(p.ws + OFF_CMPKB) + (size_t)(b * 2 + g) * 512 * 64;
    const bf16_t* cvb = (const bf16_t*)(p.ws + OFF_CMPVB) + (size_t)(b * 2 + g) * 512 * 64;
    NSA_RESET()
    nsa_kv_loop(ckb, cvb, 64, 0, nkb - 1, smem, sof, [&](int kb, const unsigned char* Kl, const unsigned char* Vl) __attribute__((always_inline)) {
        attn_step2(Kl, Vl, lane, lof,
                   qA0, qA1, oA, mA, lA, 0.f, kb * 64 + 64 <= nvminA, [&](int key) __attribute__((always_inline)) { return kb * 64 + key < nvA; },
                   qB0, qB1, oB, mB, lB, 0.f, kb * 64 + 64 <= nvminB, [&](int key) __attribute__((always_inline)) { return kb * 64 + key < nvB; });
    });
    NSA_LSUM()
    const float mcA = mA, mcB = mB;
    const float invcA = 1.f / fmaxf(lA[0], 1e-30f), invcB = 1.f / fmaxf(lB[0], 1e-30f);
    {
        const float fA = gpA[0] * invcA, fB = gpB[0] * invcB;
#pragma unroll
        for (int dt = 0; dt < 4; ++dt) {
            otA[dt][0] = fA * oA[dt][0]; otA[dt][1] = fA * oA[dt][1]; otA[dt][2] = fA * oA[dt][2]; otA[dt][3] = fA * oA[dt][3];
            otB[dt][0] = fB * oB[dt][0]; otB[dt][1] = fB * oB[dt][1]; otB[dt][2] = fB * oB[dt][2]; otB[dt][3] = fB * oB[dt][3];
        }
    }
    if (cur >= 16) {
        nsa_kv_loop(ckb, cvb, 64, 0, nkb - 1, smem, sof, [&](int kb, const unsigned char* Kl, const unsigned char* Vl) __attribute__((always_inline)) {
#pragma unroll
            for (int mt = 0; mt < 2; ++mt) {
                f32x4 s[4];
                nsa_scores(Kl, lof, mt ? qB0 : qA0, mt ? qB1 : qA1, 0.f, s);
                const int nv = mt ? nvB : nvA;
                const float mc = mt ? mcB : mcA, inv = mt ? invcB : invcA;
                float* impT = impL + (mt ? toklB : toklA) * 128;
#pragma unroll
                for (int kt = 0; kt < 4; ++kt) {
                    float pr[4];
#pragma unroll
                    for (int r = 0; r < 4; ++r) {
                        const int n = kb * 64 + kt * 16 + 4 * lg + r;
                        pr[r] = (n < nv) ? __builtin_amdgcn_exp2f(s[kt][r] - mc) * inv : 0.f;
                    }
                    float c1 = pr[0] + pr[1] + pr[2] + 0.5f * pr[3], c2 = 0.5f * pr[3];
                    c1 += __shfl_xor(c1, 1); c1 += __shfl_xor(c1, 2);
                    c2 += __shfl_xor(c2, 1); c2 += __shfl_xor(c2, 2);
                    const int j = kb * 16 + kt * 4 + lg;
                    if (head == 0) {
                        atomicAdd(&impT[j], c1);
                        if (j + 1 < 128) atomicAdd(&impT[j + 1], c2);
                    }
                }
                    }
        });
#pragma unroll 1
        for (int pass = 0; pass < 2; ++pass) {
            const int tok = 8 * w + 4 * pass + lg, c = lane & 15;
            const float4 i0 = *(const float4*)(impL + tok * 128 + 8 * c), i1 = *(const float4*)(impL + tok * 128 + 8 * c + 4);
            const float iv[8] = {i0.x, i0.y, i0.z, i0.w, i1.x, i1.y, i1.z, i1.w};
            float kl[8];
#pragma unroll
            for (int q = 0; q < 8; ++q) {
                const int j = 8 * c + q;
                const bool forced = (j == 0) || (j == cur) || (j == cur - 1);
                const float sc = forced ? 1.0e4f : ((j <= cur) ? iv[q] : -1.f);
                kl[q] = enc_key(sc, (unsigned)j, 127);
            }
            float l0 = kl[0], l1 = kl[1], l2 = kl[2], l3 = kl[3], l4 = kl[4], l5 = kl[5], l6 = kl[6], l7 = kl[7];
            CE_DESC(l0, l1) CE_DESC(l2, l3) CE_DESC(l4, l5) CE_DESC(l6, l7)
            CE_DESC(l0, l2) CE_DESC(l1, l3) CE_DESC(l4, l6) CE_DESC(l5, l7)
            CE_DESC(l1, l2) CE_DESC(l5, l6)
            CE_DESC(l0, l4) CE_DESC(l1, l5) CE_DESC(l2, l6) CE_DESC(l3, l7)
            CE_DESC(l2, l4) CE_DESC(l3, l5)
            CE_DESC(l1, l2) CE_DESC(l3, l4) CE_DESC(l5, l6)
            unsigned pm = 0u;
#pragma unroll
            for (int k = 0; k < 16; ++k) {
                const float mx = row16_max(l0);
                const bool win = (l0 == mx);
                pm |= win ? (1u << (dec_idx(l0, 127) & 7u)) : 0u;
                l0 = win ? l1 : l0; l1 = win ? l2 : l1; l2 = win ? l3 : l2; l3 = win ? l4 : l3;
                l4 = win ? l5 : l4; l5 = win ? l6 : l5; l6 = win ? l7 : l6; l7 = win ? NEGKEY : l7;
            }
            ((unsigned char*)selL)[tok * 16 + c] = (unsigned char)pm;
        }
    } else {
        if (lane < 8) {
            const int tok = 8 * w + lane;
            selL[tok * 4 + 0] = (2u << cur) - 1u; selL[tok * 4 + 1] = 0u; selL[tok * 4 + 2] = 0u; selL[tok * 4 + 3] = 0u;
        }
    }
    WAVE_LDS_SYNC();
#if NSA_DIAG
    if (head == 0 && lg == 0) {
        unsigned* SELM = (unsigned*)(p.ws + OFF_SELM);
#pragma unroll
        for (int qd = 0; qd < 4; ++qd) {
            SELM[((size_t)bg * SEQ + tqA) * 4 + qd] = selL[toklA * 4 + qd];
            SELM[((size_t)bg * SEQ + tqB) * 4 + qd] = selL[toklB * 4 + qd];
        }
    }
#endif
    NSA_RESET()
    {
        const bf16_t* kg = (const bf16_t*)(p.ws + OFF_KV + 2 * KV_STRIDE) + (size_t)b * SEQ * 128 + g * 64;
        const bf16_t* vg = (const bf16_t*)(p.ws + OFF_KV + 3 * KV_STRIDE) + (size_t)b * SEQ * 128 + g * 64;
        nsa_kv_loop(kg, vg, 128, 0, cur, smem, sof, [&](int kb, const unsigned char* Kl, const unsigned char* Vl) __attribute__((always_inline)) {
            const bool svA = (selL[toklA * 4 + (kb >> 5)] >> (kb & 31)) & 1u;
            const bool svB = (selL[toklB * 4 + (kb >> 5)] >> (kb & 31)) & 1u;
            const bool nA = __ballot(svA) != 0ull, nB = __ballot(svB) != 0ull;
            if (nA && nB)
                attn_step2(Kl, Vl, lane, lof,
                           qA0, qA1, oA, mA, lA, svA ? 0.f : NEGM, kb < cur, [&](int key) __attribute__((always_inline)) { return kb * 64 + key <= tqA; },
                           qB0, qB1, oB, mB, lB, svB ? 0.f : NEGM, kb < cur, [&](int key) __attribute__((always_inline)) { return kb * 64 + key <= tqB; });
            else if (nA)
                attn_step(Kl, Vl, lane, lof, qA0, qA1, oA, mA, lA, svA ? 0.f : NEGM, kb < cur, [&](int key) __attribute__((always_inline)) { return kb * 64 + key <= tqA; });
            else if (nB)
                attn_step(Kl, Vl, lane, lof, qB0, qB1, oB, mB, lB, svB ? 0.f : NEGM, kb < cur, [&](int key) __attribute__((always_inline)) { return kb * 64 + key <= tqB; });
        });
    }
    NSA_LSUM()
    {
        const float fA = gpA[1] / fmaxf(lA[0], 1e-30f), fB = gpB[1] / fmaxf(lB[0], 1e-30f);
#pragma unroll
        for (int dt = 0; dt < 4; ++dt) {
            otA[dt][0] += fA * oA[dt][0]; otA[dt][1] += fA * oA[dt][1]; otA[dt][2] += fA * oA[dt][2]; otA[dt][3] += fA * oA[dt][3];
            otB[dt][0] += fB * oB[dt][0]; otB[dt][1] += fB * oB[dt][1]; otB[dt][2] += fB * oB[dt][2]; otB[dt][3] += fB * oB[dt][3];
        }
    }
    NSA_RESET()
    {
        const bf16_t* kg = (const bf16_t*)(p.ws + OFF_KV + 4 * KV_STRIDE) + (size_t)b * SEQ * 128 + g * 64;
        const bf16_t* vg = (const bf16_t*)(p.ws + OFF_KV + 5 * KV_STRIDE) + (size_t)b * SEQ * 128 + g * 64;
        const int klo = (t0 > 511) ? ((t0 - 511) >> 6) : 0;
        nsa_kv_loop(kg, vg, 128, klo, cur, smem, sof, [&](int kb, const unsigned char* Kl, const unsigned char* Vl) __attribute__((always_inline)) {
            attn_step2(Kl, Vl, lane, lof,
                       qA0, qA1, oA, mA, lA, 0.f, (kb * 64 >= tminA + 3 - 511) && (kb * 64 + 63 <= tminA),
                       [&](int key) __attribute__((always_inline)) { const int ka = kb * 64 + key; return (ka <= tqA) && (ka >= tqA - 511); },
                       qB0, qB1, oB, mB, lB, 0.f, (kb * 64 >= tminB + 3 - 511) && (kb * 64 + 63 <= tminB),
                       [&](int key) __attribute__((always_inline)) { const int ka = kb * 64 + key; return (ka <= tqB) && (ka >= tqB - 511); });
        });
    }
    NSA_LSUM()
    {
        const float fA = gpA[2] / fmaxf(lA[0], 1e-30f), fB = gpB[2] / fmaxf(lB[0], 1e-30f);
        bf16_t* MIX = (bf16_t*)(p.ws + OFF_XB) + (tokb + toklA) * DM + 512 + g * 256 + head * 64 + lg * 4;
#pragma unroll
        for (int dt = 0; dt < 4; ++dt) {
            uint2 ov;
            ov.x = pack2bf(otA[dt][0] + fA * oA[dt][0], otA[dt][1] + fA * oA[dt][1]);
            ov.y = pack2bf(otA[dt][2] + fA * oA[dt][2], otA[dt][3] + fA * oA[dt][3]);
            *(uint2*)(MIX + dt * 16) = ov;
            ov.x = pack2bf(otB[dt][0] + fB * oB[dt][0], otB[dt][1] + fB * oB[dt][1]);
            ov.y = pack2bf(otB[dt][2] + fB * oB[dt][2], otB[dt][3] + fB * oB[dt][3]);
            *(uint2*)(MIX + 4 * DM + dt * 16) = ov;
        }
    }
#undef NSA_RESET
#undef NSA_LSUM
}

__device__ __forceinline__ float block_sum(float v, float* red) {
    v = wave_sum(v);
    __syncthreads();
    if ((threadIdx.x & 63) == 0) red[threadIdx.x >> 6] = v;
    __syncthreads();
    return red[0] + red[1] + red[2] + red[3];
}
__device__ __forceinline__ float4 ln_row(float4 y, const float* g, const float* bb, float* red) {
    const int tid = opaque_tid();
    const float mu = block_sum(y.x + y.y + y.z + y.w, red) * (1.f / 1024.f);
    const float dx = y.x - mu, dy = y.y - mu, dz = y.z - mu, dw = y.w - mu;
    const float var = block_sum(dx * dx + dy * dy + dz * dz + dw * dw, red) * (1.f / 1024.f);
    const float rs = rsqrtf(var + LN_EPS);
    const float4 gg = ((const float4*)g)[tid], b4 = ((const float4*)bb)[tid];
    return make_float4(dx * rs * gg.x + b4.x, dy * rs * gg.y + b4.y, dz * rs * gg.z + b4.z, dw * rs * gg.w + b4.w);
}

__device__ __forceinline__ void ln1_phase(const Params& p, float* sm) {
    const int tid = opaque_tid(), lane = tid & 63, w = __builtin_amdgcn_readfirstlane(tid >> 6);
    const float4* g4 = (const float4*)(p.in[15] + 16 * lane);
    const float4* b4 = (const float4*)(p.in[16] + 16 * lane);
    const float4 ga = g4[0], gb = g4[1], gc = g4[2], gd = g4[3];
    const float4 ba = b4[0], bb = b4[1], bc = b4[2], bd = b4[3];
#pragma unroll 2
    for (int n = blockIdx.x * 4 + w; n < NTOK; n += gridDim.x * 4) {
        const float4* xr = (const float4*)(p.in[0] + (size_t)n * DM + 16 * lane);
        const uint4* mr = (const uint4*)((const bf16_t*)p.out + (size_t)n * DM + 16 * lane);
        const float4 y0 = xr[0], y1 = xr[1], y2 = xr[2], y3 = xr[3];
        const uint4 m0 = mr[0], m1 = mr[1];
        float y[16] = {ALPHA * y0.x + bf2f(m0.x & 0xffffu), ALPHA * y0.y + bf2f(m0.x >> 16), ALPHA * y0.z + bf2f(m0.y & 0xffffu), ALPHA * y0.w + bf2f(m0.y >> 16),
                       ALPHA * y1.x + bf2f(m0.z & 0xffffu), ALPHA * y1.y + bf2f(m0.z >> 16), ALPHA * y1.z + bf2f(m0.w & 0xffffu), ALPHA * y1.w + bf2f(m0.w >> 16),
                       ALPHA * y2.x + bf2f(m1.x & 0xffffu), ALPHA * y2.y + bf2f(m1.x >> 16), ALPHA * y2.z + bf2f(m1.y & 0xffffu), ALPHA * y2.w + bf2f(m1.y >> 16),
                       ALPHA * y3.x + bf2f(m1.z & 0xffffu), ALPHA * y3.y + bf2f(m1.z >> 16), ALPHA * y3.z + bf2f(m1.w & 0xffffu), ALPHA * y3.w + bf2f(m1.w >> 16)};
        const float g[16] = {ga.x, ga.y, ga.z, ga.w, gb.x, gb.y, gb.z, gb.w, gc.x, gc.y, gc.z, gc.w, gd.x, gd.y, gd.z, gd.w};
        const float bv[16] = {ba.x, ba.y, ba.z, ba.w, bb.x, bb.y, bb.z, bb.w, bc.x, bc.y, bc.z, bc.w, bd.x, bd.y, bd.z, bd.w};
        float sum = 0.f;
#pragma unroll
        for (int q = 0; q < 16; ++q) sum += y[q];
        const float mu = wave_sum(sum) * (1.f / 1024.f);
        float sq = 0.f;
#pragma unroll
        for (int q = 0; q < 16; ++q) { y[q] -= mu; sq += y[q] * y[q]; }
        const float rs = rsqrtf(wave_sum(sq) * (1.f / 1024.f) + LN_EPS);
        uint4 o0, o1;
        o0.x = pack2bf(y[0] * rs * g[0] + bv[0], y[1] * rs * g[1] + bv[1]);     o0.y = pack2bf(y[2] * rs * g[2] + bv[2], y[3] * rs * g[3] + bv[3]);
        o0.z = pack2bf(y[4] * rs * g[4] + bv[4], y[5] * rs * g[5] + bv[5]);     o0.w = pack2bf(y[6] * rs * g[6] + bv[6], y[7] * rs * g[7] + bv[7]);
        o1.x = pack2bf(y[8] * rs * g[8] + bv[8], y[9] * rs * g[9] + bv[9]);     o1.y = pack2bf(y[10] * rs * g[10] + bv[10], y[11] * rs * g[11] + bv[11]);
        o1.z = pack2bf(y[12] * rs * g[12] + bv[12], y[13] * rs * g[13] + bv[13]); o1.w = pack2bf(y[14] * rs * g[14] + bv[14], y[15] * rs * g[15] + bv[15]);
        uint4* hb = (uint4*)((bf16_t*)(p.ws + OFF_XB) + (size_t)n * DM + 16 * lane);
        hb[0] = o0; hb[1] = o1;
    }
}


typedef float f32x2 __attribute__((ext_vector_type(2)));
__device__ __forceinline__ void cvt_rows_fp8(const float* __restrict__ src, unsigned char* __restrict__ dst, float* __restrict__ scales, int rows,
                                             int first_block, int nblocks) {
    const int tid_ = opaque_tid(), lane = tid_ & 63, w = __builtin_amdgcn_readfirstlane(tid_ >> 6);
    for (int r = ((int)blockIdx.x - first_block) * 4 + w; r < rows; r += nblocks * 4) {
        const float4* sp = (const float4*)(src + (size_t)r * 1024 + lane * 16);
        const float4 a = sp[0], b = sp[1], c = sp[2], d = sp[3];
        float mx = fmaxf(fmaxf(fmaxf(fabsf(a.x), fabsf(a.y)), fmaxf(fabsf(a.z), fabsf(a.w))), fmaxf(fmaxf(fabsf(b.x), fabsf(b.y)), fmaxf(fabsf(b.z), fabsf(b.w))));
        mx = fmaxf(mx, fmaxf(fmaxf(fmaxf(fabsf(c.x), fabsf(c.y)), fmaxf(fabsf(c.z), fabsf(c.w))), fmaxf(fmaxf(fabsf(d.x), fabsf(d.y)), fmaxf(fabsf(d.z), fabsf(d.w)))));
        mx = wave_max(mx);
        const float sc = (mx > 0.f) ? mx * (1.f / 448.f) : 1.f;
        const float inv = 1.f / sc;
        uint4 o;
        int t;
        t = 0; t = __builtin_amdgcn_cvt_pk_fp8_f32(a.x * inv, a.y * inv, t, false); t = __builtin_amdgcn_cvt_pk_fp8_f32(a.z * inv, a.w * inv, t, true); o.x = (unsigned)t;
        t = 0; t = __builtin_amdgcn_cvt_pk_fp8_f32(b.x * inv, b.y * inv, t, false); t = __builtin_amdgcn_cvt_pk_fp8_f32(b.z * inv, b.w * inv, t, true); o.y = (unsigned)t;
        t = 0; t = __builtin_amdgcn_cvt_pk_fp8_f32(c.x * inv, c.y * inv, t, false); t = __builtin_amdgcn_cvt_pk_fp8_f32(c.z * inv, c.w * inv, t, true); o.z = (unsigned)t;
        t = 0; t = __builtin_amdgcn_cvt_pk_fp8_f32(d.x * inv, d.y * inv, t, false); t = __builtin_amdgcn_cvt_pk_fp8_f32(d.z * inv, d.w * inv, t, true); o.w = (unsigned)t;
        *(uint4*)(dst + (size_t)r * 1024 + lane * 16) = o;
        if (lane == 0) scales[r] = sc;
    }
}

__device__ __forceinline__ unsigned pack4i8(float a, float b, float c, float d) {
    const int ia = (int)rintf(a), ib = (int)rintf(b), ic = (int)rintf(c), id = (int)rintf(d);
    return (unsigned)(ia & 255) | ((unsigned)(ib & 255) << 8) | ((unsigned)(ic & 255) << 16) | ((unsigned)id << 24);
}
__device__ __forceinline__ void cvt_rows_i8(const float* __restrict__ src, unsigned char* __restrict__ dst, float* __restrict__ scales, int rows,
                                            int first_block, int nblocks) {
    const int tid_ = opaque_tid(), lane = tid_ & 63, w = __builtin_amdgcn_readfirstlane(tid_ >> 6);
    for (int r = ((int)blockIdx.x - first_block) * 4 + w; r < rows; r += nblocks * 4) {
        const float4* sp = (const float4*)(src + (size_t)r * 1024 + lane * 16);
        const float4 a = sp[0], b = sp[1], c = sp[2], d = sp[3];
        float mx = fmaxf(fmaxf(fmaxf(fabsf(a.x), fabsf(a.y)), fmaxf(fabsf(a.z), fabsf(a.w))), fmaxf(fmaxf(fabsf(b.x), fabsf(b.y)), fmaxf(fabsf(b.z), fabsf(b.w))));
        mx = fmaxf(mx, fmaxf(fmaxf(fmaxf(fabsf(c.x), fabsf(c.y)), fmaxf(fabsf(c.z), fabsf(c.w))), fmaxf(fmaxf(fabsf(d.x), fabsf(d.y)), fmaxf(fabsf(d.z), fabsf(d.w)))));
        mx = wave_max(mx);
        const float sc = (mx > 0.f) ? mx * (1.f / 127.f) : 1.f;
        const float inv = 1.f / sc;
        uint4 o;
        o.x = pack4i8(a.x * inv, a.y * inv, a.z * inv, a.w * inv); o.y = pack4i8(b.x * inv, b.y * inv, b.z * inv, b.w * inv);
        o.z = pack4i8(c.x * inv, c.y * inv, c.z * inv, c.w * inv); o.w = pack4i8(d.x * inv, d.y * inv, d.z * inv, d.w * inv);
        *(uint4*)(dst + (size_t)r * 1024 + lane * 16) = o;
        if (lane == 0) scales[r] = sc;
    }
}

__device__ __forceinline__ void fold_ws_phase(const float* __restrict__ wq, const float* __restrict__ k1, const float* __restrict__ k2,
                                              bf16_t* __restrict__ WsT) {
    for (int it = blockIdx.x * 256 + threadIdx.x; it < 2048 * 128; it += gridDim.x * 256) {
        const int r = it & 2047, kg = it >> 11;
        const int a = (r >> 7) & 1, j = r & 127;
        const float* kr = (a ? k2 : k1) + j * 128;
        const float* wr = wq + (size_t)(kg * 8) * 2048 + (r & ~127);
        float s[8];
#pragma unroll
        for (int q = 0; q < 8; ++q) s[q] = 0.f;
        for (int d = 0; d < 128; d += 4) {
            const float4 kv = *(const float4*)(kr + d);
#pragma unroll
            for (int q = 0; q < 8; ++q) {
                const float4 wv = *(const float4*)(wr + (size_t)q * 2048 + d);
                s[q] += wv.x * kv.x + wv.y * kv.y + wv.z * kv.z + wv.w * kv.w;
            }
        }
        uint4 o;
        o.x = pack2bf(s[0], s[1]); o.y = pack2bf(s[2], s[3]); o.z = pack2bf(s[4], s[5]); o.w = pack2bf(s[6], s[7]);
        *(uint4*)(WsT + (size_t)r * 1024 + kg * 8) = o;
    }
}


struct EpiTop16 {
    static constexpr bool kRow = false;
    float* topk; unsigned char* lds;
    __device__ __forceinline__ void operator()(int m, int n, f32x4 v) const {
        const int ml = m & 127, g4 = (n & 127) >> 2;
        *(float4*)(lds + ((ml * 32 + (g4 ^ (ml & 7))) << 4)) = make_float4(v[0], v[1], v[2], v[3]);
    }
    template <class F> __device__ __forceinline__ void dispatch(int, F f) const { f(*this); }
    __device__ __forceinline__ void finish(int m0, int n0) const {
        __syncthreads();
        const int tid_ = opaque_tid(), lane = tid_ & 63, w = __builtin_amdgcn_readfirstlane(tid_ >> 6), c = lane & 15;
        const int L = n0 >> 7;
        for (int it = 0; it < 8; ++it) {
            const int r = w * 32 + it * 4 + (lane >> 4);
            const float4 x0 = *(const float4*)(lds + ((r * 32 + ((2 * c) ^ (r & 7))) << 4));
            const float4 x1 = *(const float4*)(lds + ((r * 32 + ((2 * c + 1) ^ (r & 7))) << 4));
            float l0 = enc_key(x0.x, 8 * c + 0, 127), l1 = enc_key(x0.y, 8 * c + 1, 127), l2 = enc_key(x0.z, 8 * c + 2, 127),
                  l3 = enc_key(x0.w, 8 * c + 3, 127), l4 = enc_key(x1.x, 8 * c + 4, 127), l5 = enc_key(x1.y, 8 * c + 5, 127),
                  l6 = enc_key(x1.z, 8 * c + 6, 127), l7 = enc_key(x1.w, 8 * c + 7, 127);
            CE_DESC(l0, l1) CE_DESC(l2, l3) CE_DESC(l4, l5) CE_DESC(l6, l7)
            CE_DESC(l0, l2) CE_DESC(l1, l3) CE_DESC(l4, l6) CE_DESC(l5, l7)
            CE_DESC(l1, l2) CE_DESC(l5, l6)
            CE_DESC(l0, l4) CE_DESC(l1, l5) CE_DESC(l2, l6) CE_DESC(l3, l7)
            CE_DESC(l2, l4) CE_DESC(l3, l5)
            CE_DESC(l1, l2) CE_DESC(l3, l4) CE_DESC(l5, l6)
            float res = NEGKEY;
#pragma unroll
            for (int k = 0; k < 16; ++k) {
                const float mx = row16_max(l0);
                const bool win = (l0 == mx);
                l0 = win ? l1 : l0; l1 = win ? l2 : l1; l2 = win ? l3 : l2; l3 = win ? l4 : l3;
                l4 = win ? l5 : l4; l5 = win ? l6 : l5; l6 = win ? l7 : l6; l7 = win ? NEGKEY : l7;
                res = (c == k) ? mx : res;
            }
            topk[(size_t)(m0 + r) * 256 + L * 16 + c] = res;
        }
        __syncthreads();
    }
};

template <int PART>
__device__ __forceinline__ void peer_fast_phase(const Params& p, unsigned char* smem) {
    const int tid = opaque_tid(), lane = tid & 63, w = __builtin_amdgcn_readfirstlane(tid >> 6), l16 = lane & 15, gq = lane >> 4;
    float* tk = (float*)(smem + w * 2048);
    int* ex = (int*)(smem + w * 2048 + 1024);
    float* gw = (float*)(smem + w * 2048 + 1536);
    const bf16_t* H1B = (const bf16_t*)(p.ws + OFF_XB);
    const unsigned char* U8 = p.ws + OFF_UB;
    const unsigned char* V8 = p.ws + OFF_VB;
    const float* USC = (const float*)(p.ws + OFF_USC);
    const float* VSC = (const float*)(p.ws + OFF_VSC);
    const float* TOPK = (const float*)(p.ws + OFF_TOPK);
    int ci[4], cj[4];
#pragma unroll
    for (int q = 0; q < 4; ++q) {
        const int s = l16 + 16 * q;
        int i, j;
        if (s < 16) { i = 0; j = s; }
        else if (s < 24) { i = 1; j = s - 16; }
        else if (s < 29) { i = 2; j = s - 24; }
        else if (s < 33) { i = 3; j = s - 29; }
        else if (s < 36) { i = 4; j = s - 33; }
        else if (s < 42) { i = 5 + ((s - 36) >> 1); j = (s - 36) & 1; }
        else if (s < 50) { i = 8 + (s - 42); j = 0; }
        else { i = -1; j = 0; }
        ci[q] = i; cj[q] = j;
    }
    int* exs = (int*)(smem + 8192 + w * 4096);
    float* gws = (float*)(smem + 8192 + w * 4096 + 2048);
    float* hraw = (float*)(smem + 24576 + w * 2048);
    float* xsc = (float*)(smem + w * 2048);
    int* SEX = (int*)(p.ws + OFF_HQ);
    float* SGW = (float*)(p.ws + OFF_HLF);
    for (int qd = blockIdx.x * 4 + w; qd < NTOK / 4; qd += gridDim.x * 4) {
        const int n0 = qd * 4;
        if (PART == 0) {
        float4 tkn = ((const float4*)(TOPK + (size_t)n0 * 256))[lane];
#pragma unroll 1
        for (int t = 0; t < 4; ++t) {
            const int n = n0 + t;
            WAVE_LDS_SYNC();
            ((float4*)tk)[lane] = tkn;
            {
                int nn = (t < 3) ? n + 1 : (qd + (int)gridDim.x * 4) * 4;
                nn = (nn < NTOK) ? nn : n;
                tkn = ((const float4*)(TOPK + (size_t)nn * 256))[lane];
            }
            WAVE_LDS_SYNC();
#pragma unroll
            for (int it = 0; it < 2; ++it) {
                const int head = it * 4 + gq;
                const float* ka = tk + head * 32;
                const float* kb = ka + 16;
                float c0, c1, c2, c3;
#define MKC(q, cq) { if (ci[q] >= 0) { const float sum_ = dec_val(ka[ci[q]], 127) + dec_val(kb[cj[q]], 127); \
                         cq = enc_key(sum_, ci[q] * 16 + cj[q], 255); } else cq = NEGKEY; }
                MKC(0, c0) MKC(1, c1) MKC(2, c2) MKC(3, c3)
#undef MKC
                float res = NEGKEY;
#pragma unroll
                for (int k = 0; k < 16; ++k) {
                    const float mx = row16_max(fmaxf(fmaxf(c0, c1), fmaxf(c2, c3)));
                    c0 = (c0 == mx) ? NEGKEY : c0; c1 = (c1 == mx) ? NEGKEY : c1;
                    c2 = (c2 == mx) ? NEGKEY : c2; c3 = (c3 == mx) ? NEGKEY : c3;
                    res = (l16 == k) ? mx : res;
                }
                const unsigned cc = dec_idx(res, 255);
                const float val = dec_val(res, 255);
                const unsigned e1 = dec_idx(ka[cc >> 4], 127), e2 = dec_idx(kb[cc & 15], 127);
                const float m0 = row16_max(val);
                const float e = expf(val - m0);
                const float ssum = row16_sum(e);
                ex[head * 16 + l16] = (int)(e1 * 128 + e2);
                gw[head * 16 + l16] = e / ssum;
            }
            WAVE_LDS_SYNC();
            {
                const int e0 = ex[lane], e1v = ex[lane + 64];
                const float g0 = gw[lane], g1 = gw[lane + 64];
                const int s0 = e0 >> 11, s1 = e1v >> 11;
                const unsigned long long lt = (1ull << lane) - 1ull;
                int base = 0, p0 = 0, p1 = 0;
#pragma unroll
                for (int s = 0; s < 8; ++s) {
                    const unsigned long long m0 = __ballot(s0 == s), m1 = __ballot(s1 == s);
                    const int c0 = __popcll(m0), c1 = __popcll(m1);
                    if (s0 == s) p0 = base + __popcll(m0 & lt);
                    if (s1 == s) p1 = base + c0 + __popcll(m1 & lt);
                    base += c0 + c1;
                }
                exs[t * 128 + p0] = e0; gws[t * 128 + p0] = g0; exs[t * 128 + p1] = e1v; gws[t * 128 + p1] = g1;
            }
        }
        WAVE_LDS_SYNC();
#pragma unroll
        for (int i = 0; i < 2; ++i) {
            ((uint4*)(SEX + (size_t)n0 * 128))[lane + 64 * i] = ((const uint4*)exs)[lane + 64 * i];
            ((uint4*)(SGW + (size_t)n0 * 128))[lane + 64 * i] = ((const uint4*)gws)[lane + 64 * i];
        }
        } else {
        WAVE_LDS_SYNC();
#pragma unroll
        for (int i = 0; i < 2; ++i) {
            ((uint4*)exs)[lane + 64 * i] = ((const uint4*)(SEX + (size_t)n0 * 128))[lane + 64 * i];
            ((uint4*)gws)[lane + 64 * i] = ((const uint4*)(SGW + (size_t)n0 * 128))[lane + 64 * i];
        }
        }
        if (PART == 1) {
        WAVE_LDS_SYNC();
        {
            int xq[16];
            {
                const uint4* xr = (const uint4*)(H1B + (size_t)(n0 + gq) * DM + 16 * l16);
                uint4 xa0 = xr[0], xb0 = xr[1], xa1 = xr[32], xb1 = xr[33], xa2 = xr[64], xb2 = xr[65], xa3 = xr[96], xb3 = xr[97];
#define BLO(u_) __uint_as_float((u_) << 16)
#define BHI(u_) __uint_as_float((u_) & 0xffff0000u)
#define AMX4(v_) fmaxf(fmaxf(fmaxf(fabsf(BLO((v_).x)), fabsf(BHI((v_).x))), fmaxf(fabsf(BLO((v_).y)), fabsf(BHI((v_).y)))),                  \
                       fmaxf(fmaxf(fabsf(BLO((v_).z)), fabsf(BHI((v_).z))), fmaxf(fabsf(BLO((v_).w)), fabsf(BHI((v_).w)))))
                float mx = fmaxf(fmaxf(fmaxf(AMX4(xa0), AMX4(xb0)), fmaxf(AMX4(xa1), AMX4(xb1))), fmaxf(fmaxf(AMX4(xa2), AMX4(xb2)), fmaxf(AMX4(xa3), AMX4(xb3))));
                mx = row16_max(mx);
                const float xs = (mx > 0.f) ? mx * (1.f / 127.f) : 1.f;
                const float inv = 1.f / xs;
                xsc[gq] = xs;
#define Q8(i_, va_, vb_) { xq[4 * (i_) + 0] = (int)pack4i8(BLO((va_).x) * inv, BHI((va_).x) * inv, BLO((va_).y) * inv, BHI((va_).y) * inv);   \
                           xq[4 * (i_) + 1] = (int)pack4i8(BLO((va_).z) * inv, BHI((va_).z) * inv, BLO((va_).w) * inv, BHI((va_).w) * inv);   \
                           xq[4 * (i_) + 2] = (int)pack4i8(BLO((vb_).x) * inv, BHI((vb_).x) * inv, BLO((vb_).y) * inv, BHI((vb_).y) * inv);   \
                           xq[4 * (i_) + 3] = (int)pack4i8(BLO((vb_).z) * inv, BHI((vb_).z) * inv, BLO((vb_).w) * inv, BHI((vb_).w) * inv); }
                Q8(0, xa0, xb0) Q8(1, xa1, xb1) Q8(2, xa2, xb2) Q8(3, xa3, xb3)
#undef Q8
#undef AMX4
#undef BLO
#undef BHI
            }
            uint4 ra0, ra1, ra2, ra3, rb0, rb1, rb2, rb3, rc0, rc1, rc2, rc3, rd0, rd1, rd2, rd3;
#define ULOAD(S, kk) { const int e_ = exs[gq * 128 + (kk)]; const uint4* ur_ = (const uint4*)(U8 + (size_t)e_ * DM + 16 * l16);          \
                       S##0 = ur_[0]; S##1 = ur_[16]; S##2 = ur_[32]; S##3 = ur_[48]; }
#define D4(W_, B_) { sA = __builtin_amdgcn_sdot4((int)(W_).x, xq[(B_)], sA, false); sB = __builtin_amdgcn_sdot4((int)(W_).y, xq[(B_) + 1], sB, false); \
                     sA = __builtin_amdgcn_sdot4((int)(W_).z, xq[(B_) + 2], sA, false); sB = __builtin_amdgcn_sdot4((int)(W_).w, xq[(B_) + 3], sB, false); }
#define UCOMP(S, kk) { int sA = 0, sB = 0; D4(S##0, 0) D4(S##1, 4) D4(S##2, 8) D4(S##3, 12)                                               \
                       hraw[gq * 128 + (kk)] = row16_sum((float)(sA + sB)); }
            ULOAD(ra, 0) ULOAD(rb, 1) ULOAD(rc, 2)
#pragma unroll 1
            for (int k = 0; k < 128; k += 4) {
                const int kn = (k + 4 < 128) ? k + 4 : 124;
                ULOAD(rd, k + 3)  UCOMP(ra, k)
                ULOAD(ra, kn)     UCOMP(rb, k + 1)
                ULOAD(rb, kn + 1) UCOMP(rc, k + 2)
                ULOAD(rc, kn + 2) UCOMP(rd, k + 3)
            }
#undef D4
#undef ULOAD
#undef UCOMP
        }
        WAVE_LDS_SYNC();
#pragma unroll
        for (int j = 0; j < 8; ++j) {
            const int idx = lane + 64 * j;
            const int e = exs[idx];
            gws[idx] = gws[idx] * gelu_tanh_fast(hraw[idx] * (xsc[idx >> 7] * USC[e])) * VSC[e];
        }
        WAVE_LDS_SYNC();
#pragma unroll
        for (int i = 0; i < 2; ++i) ((uint4*)(SGW + (size_t)n0 * 128))[lane + 64 * i] = ((const uint4*)gws)[lane + 64 * i];
        }
        if (PART == 2) {
        WAVE_LDS_SYNC();
        {
            f32x2 acc[32];
#pragma unroll
            for (int q = 0; q < 32; ++q) acc[q] = (f32x2){0.f, 0.f};
            uint4 ra0, ra1, ra2, ra3, rb0, rb1, rb2, rb3, rc0, rc1, rc2, rc3, rd0, rd1, rd2, rd3;
#define VLOAD(S, kk) { const int e_ = exs[gq * 128 + (kk)]; const uint4* vr_ = (const uint4*)(V8 + (size_t)e_ * DM + 16 * l16);          \
                       S##0 = vr_[0]; S##1 = vr_[16]; S##2 = vr_[32]; S##3 = vr_[48]; }
#define A4(W_, B_) { acc[(B_)] = __builtin_elementwise_fma(__builtin_amdgcn_cvt_pk_f32_fp8((int)(W_), false), wk2, acc[(B_)]);          \
                     acc[(B_) + 1] = __builtin_elementwise_fma(__builtin_amdgcn_cvt_pk_f32_fp8((int)(W_), true), wk2, acc[(B_) + 1]); }
#define VCOMP(S, kk) { const float wk = gws[gq * 128 + (kk)]; const f32x2 wk2 = (f32x2){wk, wk};                                         \
                       A4((S##0).x, 0) A4((S##0).y, 2) A4((S##0).z, 4) A4((S##0).w, 6) A4((S##1).x, 8) A4((S##1).y, 10) A4((S##1).z, 12) A4((S##1).w, 14) \
                       A4((S##2).x, 16) A4((S##2).y, 18) A4((S##2).z, 20) A4((S##2).w, 22) A4((S##3).x, 24) A4((S##3).y, 26) A4((S##3).z, 28) A4((S##3).w, 30) }
            VLOAD(ra, 0) VLOAD(rb, 1) VLOAD(rc, 2)
#pragma unroll 1
            for (int k = 0; k < 128; k += 4) {
                const int kn = (k + 4 < 128) ? k + 4 : 124;
                VLOAD(rd, k + 3)  VCOMP(ra, k)
                VLOAD(ra, kn)     VCOMP(rb, k + 1)
                VLOAD(rb, kn + 1) VCOMP(rc, k + 2)
                VLOAD(rc, kn + 2) VCOMP(rd, k + 3)
            }
#undef VLOAD
#undef VCOMP
#undef A4
            float* orow = p.out + (size_t)(n0 + gq) * DM + 16 * l16;
            float sum = 0.f;
#pragma unroll
            for (int c = 0; c < 4; ++c)
#pragma unroll
                for (int hq = 0; hq < 4; ++hq) {
                    const uint2 hb_ = *(const uint2*)(H1B + (size_t)(n0 + gq) * DM + 16 * l16 + 256 * c + 4 * hq);
                    const float4 h = make_float4(__uint_as_float(hb_.x << 16), __uint_as_float(hb_.x & 0xffff0000u),
                                                 __uint_as_float(hb_.y << 16), __uint_as_float(hb_.y & 0xffff0000u));
                    f32x2& pa = acc[8 * c + 2 * hq]; f32x2& pb = acc[8 * c + 2 * hq + 1];
                    pa[0] = ALPHA * h.x + pa[0]; pa[1] = ALPHA * h.y + pa[1]; pb[0] = ALPHA * h.z + pb[0]; pb[1] = ALPHA * h.w + pb[1];
                    sum += (pa[0] + pa[1]) + (pb[0] + pb[1]);
                }
            const float mu = row16_sum(sum) * (1.f / 1024.f);
            float sq = 0.f;
#pragma unroll
            for (int q = 0; q < 32; ++q) { acc[q][0] -= mu; acc[q][1] -= mu; sq += acc[q][0] * acc[q][0] + acc[q][1] * acc[q][1]; }
            const float rs = rsqrtf(row16_sum(sq) * (1.f / 1024.f) + LN_EPS);
            const float* g = p.in[22] + 16 * l16;
            const float* bb = p.in[23] + 16 * l16;
#pragma unroll
            for (int c = 0; c < 4; ++c)
#pragma unroll
                for (int hq = 0; hq < 4; ++hq) {
                    const float4 gg = *(const float4*)(g + 256 * c + 4 * hq), b4 = *(const float4*)(bb + 256 * c + 4 * hq);
                    const f32x2 pa = acc[8 * c + 2 * hq], pb = acc[8 * c + 2 * hq + 1];
                    float4 o;
                    o.x = pa[0] * rs * gg.x + b4.x; o.y = pa[1] * rs * gg.y + b4.y;
                    o.z = pb[0] * rs * gg.z + b4.z; o.w = pb[1] * rs * gg.w + b4.w;
                    *(float4*)(orow + 256 * c + 4 * hq) = o;
                }
        }
        }
    }
}

#define XB_TMO      128
#define XB_XCNT(j)  (256  + 64 * (j))
#define XB_XSUB(j)  (1280 + 64 * (j))
#define XB_XGEN(j)  (2304 + 64 * (j))
#define XB_TOP      3328
#define XB_TOPGEN   3392
#define XCD_BAR_WORDS 3456
#define XB_SPIN_CAP (1u << 22)
__device__ __forceinline__ unsigned xb_ld(unsigned* p) { return __hip_atomic_load(p, __ATOMIC_RELAXED, __HIP_MEMORY_SCOPE_AGENT); }
__device__ __forceinline__ unsigned xb_add(unsigned* p, unsigned v) { return __hip_atomic_fetch_add(p, v, __ATOMIC_RELAXED, __HIP_MEMORY_SCOPE_AGENT); }
__device__ __forceinline__ unsigned xb_xcc_id() { return (unsigned)__builtin_amdgcn_s_getreg((3 << 11) | 20) & 0xFu; }
#define XB_SPIN(cond, bar) do { unsigned _sp = 0; while (cond) { __builtin_amdgcn_s_sleep(1); \
    if ((++_sp & 255u) == 0u) { if (xb_ld(&(bar)[XB_TMO])) break; if (_sp > XB_SPIN_CAP) { atomicAdd(&(bar)[XB_TMO], 1u); break; } } } } while (0)
struct XcdBarrier { unsigned* bar; unsigned x; unsigned* st; };
__device__ __forceinline__ XcdBarrier xcd_barrier_post(unsigned* bar, unsigned* st) {
    XcdBarrier b; b.bar = bar; b.x = xb_xcc_id(); b.st = st;
    if (threadIdx.x == 0) (void)xb_add(&bar[XB_XCNT(b.x)], 1u);
    return b;
}
__device__ __forceinline__ void xcd_barrier_complete(unsigned* bar, unsigned x, unsigned& nloc, unsigned& nx) {
    const unsigned G = gridDim.x * gridDim.y * gridDim.z;
    unsigned sum, cnt, mine, sp = 0u;
    for (;;) {
        sum = 0u; cnt = 0u; mine = 0u;
#pragma unroll
        for (unsigned j = 0; j < 16; ++j) { const unsigned c = xb_ld(&bar[XB_XCNT(j)]); sum += c; cnt += (c > 0u) ? 1u : 0u; mine = (j == x) ? c : mine; }
        if (sum == G) break;
        __builtin_amdgcn_s_sleep(1);
        if ((++sp & 255u) == 0u) { if (xb_ld(&bar[XB_TMO])) break; if (sp > XB_SPIN_CAP) { atomicAdd(&bar[XB_TMO], 1u); break; } }
    }
    nloc = mine > 0u ? mine : 1u; nx = cnt > 0u ? cnt : 1u;
}
__device__ __forceinline__ void xcd_barrier(const XcdBarrier& b) {
    asm volatile("s_waitcnt vmcnt(0)" ::: "memory");
    __syncthreads();
    if (threadIdx.x == 0) {
        unsigned* bar = b.bar;
        __builtin_amdgcn_s_waitcnt(0);
        unsigned nloc = xb_ld(&b.st[0]), nx = xb_ld(&b.st[1]);
        if (nloc == 0u) { xcd_barrier_complete(bar, b.x, nloc, nx); __hip_atomic_store(&b.st[0], nloc, __ATOMIC_RELAXED, __HIP_MEMORY_SCOPE_AGENT); __hip_atomic_store(&b.st[1], nx, __ATOMIC_RELAXED, __HIP_MEMORY_SCOPE_AGENT); }
        const unsigned old = xb_add(&bar[XB_XSUB(b.x)], 1u);
        const unsigned gen = old / nloc;
        if (old + 1u == (gen + 1u) * nloc) {
            __builtin_amdgcn_fence(__ATOMIC_RELEASE, "agent");
            asm volatile("s_waitcnt vmcnt(0)" ::: "memory");
            const unsigned og = xb_add(&bar[XB_TOP], 1u);
            const unsigned tg = og / nx;
            if (og + 1u == (tg + 1u) * nx) xb_add(&bar[XB_TOPGEN], 1u);
            else XB_SPIN(xb_ld(&bar[XB_TOPGEN]) == tg, bar);
            __builtin_amdgcn_fence(__ATOMIC_ACQUIRE, "agent");
            xb_add(&bar[XB_XGEN(b.x)], 1u);
            asm volatile("s_waitcnt vmcnt(0)" ::: "memory");
        } else {
            XB_SPIN(xb_ld(&bar[XB_XGEN(b.x)]) == gen, bar);
            __builtin_amdgcn_fence(__ATOMIC_ACQUIRE, "agent");
            asm volatile("s_waitcnt vmcnt(0)" ::: "memory");
        }
    }
    __syncthreads();
}

__global__ void __launch_bounds__(256, 2) mega(Params p) {
    cg::grid_group grid = cg::this_grid();
    __shared__ __attribute__((aligned(16))) unsigned char smem[81920];
    float* sm = (float*)smem;
    unsigned* barw = (unsigned*)(p.ws + OFF_BAR);
    const XcdBarrier xbar = xcd_barrier_post(barw, barw + XCD_BAR_WORDS + 2 * blockIdx.x);
    bf16_t* XB = (bf16_t*)(p.ws + OFF_XB);
    bf16_t* WinT = (bf16_t*)(p.ws + OFF_WINT);
    bf16_t* WoutT = (bf16_t*)(p.ws + OFF_WOUTT);
    bf16_t* WqT = (bf16_t*)(p.ws + OFF_WQT);
    cvt_rows_bf16(p.in[0], XB, (size_t)NTOK * DM / 8);
    transpose_bf16(p.in[1], DIN, 3456, WinT);
    transpose_bf16(p.in[2], DM, DM, WoutT);
    fold_ws_phase(p.in[17], p.in[18], p.in[19], WqT);
    transpose_bf16(p.in[6], 256, 256, (bf16_t*)(p.ws + OFF_W1T), 2048);
    transpose_bf16(p.in[11], 256, 256, (bf16_t*)(p.ws + OFF_W1T) + 256 * 2048, 2048);
    if (blockIdx.x == 0) {
        for (int c = threadIdx.x; c < 512; c += 256)
            ((float*)(p.ws + OFF_LBV))[c] = 1.f / (1.f + expf(p.in[3][512 + c] - p.in[3][c]));
        if (threadIdx.x < 16) ((float*)(p.ws + OFF_DIAG))[threadIdx.x] = 0.f;
    }
    if (blockIdx.x >= 8 && blockIdx.x < 72) cmp_peb_partial(p, blockIdx.x - 8);
    grid.sync();
    if (blockIdx.x == gridDim.x - 1) cmp_peb_reduce(p);
    gemm_bf16_phase3(XB, DM, WinT, DM, NTOK / 256, 27, smem, EpiProj{p.ws});
    xcd_barrier(xbar);
    for (int it = blockIdx.x; it < 128; it += gridDim.x) {
        const int which = it >> 6, t = it & 63;
        gemm_tile(ALoadCmp{(const bf16_t*)(p.ws + OFF_KV + (size_t)which * KV_STRIDE)},
                  (const bf16_t*)(p.ws + OFF_W1T) + (size_t)which * 256 * 2048, 2048, 32, (t >> 1) * 128, (t & 1) * 128, smem,
                  EpiCmpH{(bf16_t*)(p.ws + OFF_HB) + (size_t)which * 4096 * 256, (const float*)(p.ws + OFF_PEB) + which * 256});
    }
    if (gridDim.x >= 256) {
        if (blockIdx.x >= 128)
            for (int it = blockIdx.x - 128; it < 2048; it += gridDim.x - 128) hgrn_passA(p, it, smem);
    } else {
        for (int it = blockIdx.x; it < 2048; it += gridDim.x) hgrn_passA(p, it, smem);
    }
#if NSA_DIAG
    for (int it = blockIdx.x; it < 2 * 4 * NCB * 2; it += gridDim.x) compress_item(p, it, sm);
#endif
    xcd_barrier(xbar);
    if (blockIdx.x < 256) hgrn_scan_item(p, blockIdx.x);
    else {
        cvt_rows_i8(p.in[20], p.ws + OFF_UB, (float*)(p.ws + OFF_USC), 16384, 256, gridDim.x - 256);
        cvt_rows_fp8(p.in[21], p.ws + OFF_VB, (float*)(p.ws + OFF_VSC), 16384, 256, gridDim.x - 256);
    }
    if (gridDim.x <= 256) {
        cvt_rows_i8(p.in[20], p.ws + OFF_UB, (float*)(p.ws + OFF_USC), 16384, 0, gridDim.x);
        cvt_rows_fp8(p.in[21], p.ws + OFF_VB, (float*)(p.ws + OFF_VSC), 16384, 0, gridDim.x);
    }
    cmp_layer2_phase(p, 0, gridDim.x);
    xcd_barrier(xbar);
    {
        const int qi = blockIdx.x & 7;
        unsigned* qctr = barw + XCD_BAR_WORDS + 2 * 1024 + 64 * qi;
        for (;;) {
            __syncthreads();
            if (threadIdx.x == 0) *(volatile unsigned*)smem = atomicAdd(qctr, 1u);
            __syncthreads();
            const int it = (int)__builtin_amdgcn_readfirstlane(*(volatile unsigned*)smem);
            if (it >= 256) break;
            nsa_tile(p, (it << 3) | qi, smem);
        }
        for (;;) {
            __syncthreads();
            if (threadIdx.x == 0) *(volatile unsigned*)smem = atomicAdd(qctr + 32, 1u);
            __syncthreads();
            const int it = (int)__builtin_amdgcn_readfirstlane(*(volatile unsigned*)smem);
            if (it >= 256) break;
            hgrn_passC(p, (it << 3) | qi, smem);
        }
    }
    xcd_barrier(xbar);
#if NSA_DIAG
    for (int it = blockIdx.x; it < 4 * 2 * SEQ; it += gridDim.x) nsa_item(p, it, sm);
    grid.sync();
    {
        const float* DG = (const float*)(p.ws + OFF_DIAG);
#if NSA_DIAG == 1
        const float cval = -log10f(sqrtf(DG[0] / DG[1]) + 1e-9f);
#else
        const float cval = -log10f(DG[2] / DG[3] + 1e-6f);
#endif
        for (size_t i = (size_t)blockIdx.x * 256 + threadIdx.x; i < (size_t)NTOK * DM; i += (size_t)gridDim.x * 256) p.out[i] = cval;
        return;
    }
#endif
    gemm_bf16_phase3(XB, DM, WoutT, DM, NTOK / 256, 8, smem, EpiMix{(bf16_t*)p.out});
    xcd_barrier(xbar);
    ln1_phase(p, sm);
    xcd_barrier(xbar);
    gemm_bf16_phase3(XB, DM, WqT, DM, NTOK / 256, 16, smem, EpiTop16{(float*)(p.ws + OFF_TOPK), smem});
    xcd_barrier(xbar);
    peer_fast_phase<0>(p, smem);
    peer_fast_phase<1>(p, smem);
    peer_fast_phase<2>(p, smem);
}

extern "C" void kernel_launch(void* const* d_in, const int* in_sizes, int n_in, void* d_out, int out_size,
                              void* d_ws, size_t ws_size, hipStream_t stream) {
    static int grid_blocks = 0;
    if (!grid_blocks) {
        int dev = 0, cus = 0, per_cu = 0;
        hipGetDevice(&dev);
        hipDeviceGetAttribute(&cus, hipDeviceAttributeMultiprocessorCount, dev);
        hipOccupancyMaxActiveBlocksPerMultiprocessor(&per_cu, mega, 256, 0);
        if (per_cu > 4) per_cu = 4;
        if (per_cu < 1) per_cu = 1;
        grid_blocks = cus * per_cu;
        if (n_in != 24 || ws_size < WS_NEED || out_size != NTOK * DM)
            fprintf(stderr, "kernel_launch: unexpected sizes n_in=%d ws=%zu out=%d\n", n_in, ws_size, out_size);
    }
    Params p;
    memset(&p, 0, sizeof(p));
    for (int i = 0; i < 24; ++i) p.in[i] = (const float*)d_in[i];
    p.out = (float*)d_out;
    p.ws = (unsigned char*)d_ws;
    hipMemsetAsync((char*)d_ws + OFF_BAR, 0, BAR_BYTES, stream);
    void* args[] = {&p};
    hipError_t e = hipLaunchCooperativeKernel((void*)mega, dim3(grid_blocks), dim3(256), args, 0, stream);
    if (e != hipSuccess) fprintf(stderr, "cooperative launch failed: %s (grid %d)\n", hipGetErrorString(e), grid_blocks);
}
```

```cpp
#include <hip/hip_runtime.h>
#include <hip/hip_cooperative_groups.h>
#include <cstdio>
#include <cstring>
namespace cg = cooperative_groups;

#define NTOK 32768
#define SEQ 8192
#define DM 1024
#define DIN 3352
#define NCB 511
#define ALPHA 1.189207115002721f
#define LN_EPS 1e-5f

#define MB_ 1048576ull
#define OFF_XB 0ull
#define OFF_HQ (64 * MB_)
#define OFF_HLF (96 * MB_)
#define OFF_HI (160 * MB_)
#define OFF_HG (192 * MB_)
#define OFF_NQ (224 * MB_)
#define OFF_KV (256 * MB_)
#define KV_STRIDE (8 * MB_)
#define OFF_NGATE (304 * MB_)
#define OFF_CMPK (308 * MB_)
#define OFF_CMPV (309 * MB_)
#define OFF_WINT (310 * MB_)
#define OFF_WOUTT (317 * MB_)
#define OFF_WQT (319 * MB_)
#define OFF_LBV (323 * MB_)
#define OFF_DC (324 * MB_)
#define OFF_SC (325 * MB_)
#define OFF_UB (389 * MB_)
#define OFF_VB (421 * MB_)
#define OFF_TOPK (453 * MB_)
#define OFF_HREF OFF_TOPK
#define OFF_W1T (485 * MB_)
#define OFF_HB (487 * MB_)
#define OFF_CMPKB (491 * MB_)
#define OFF_CMPVB (491 * MB_ + 524288ull)
#define OFF_PEB (492 * MB_)
#define OFF_SELM (493 * MB_)
#define OFF_DIAG (494 * MB_)
#define OFF_USC (494 * MB_ + 131072ull)
#define OFF_VSC (494 * MB_ + 196608ull)
#define OFF_BAR (494 * MB_ + 65536ull)
#define BAR_BYTES 32768
#define WS_NEED (495 * MB_)
#define USE_NSA_MFMA 1
#define NSA_DIAG 0

struct Params {
    const float* in[24];
    float* out;
    unsigned char* ws;
};

typedef float f32x16 __attribute__((ext_vector_type(16)));
#define WAVE_LDS_SYNC() asm volatile("s_waitcnt lgkmcnt(0)" ::: "memory")
#define LAS3 __attribute__((address_space(3)))

__device__ __forceinline__ int opaque_tid() { int t = threadIdx.x; asm volatile("" : "+v"(t)); return t; }
__device__ __forceinline__ float wave_sum(float v) {
#pragma unroll
    for (int o = 32; o; o >>= 1) v += __shfl_xor(v, o);
    return v;
}
__device__ __forceinline__ float wave_max(float v) {
#pragma unroll
    for (int o = 32; o; o >>= 1) v = fmaxf(v, __shfl_xor(v, o));
    return v;
}
__device__ __forceinline__ float sigmoidf_(float x) { return 1.f / (1.f + expf(-x)); }
__device__ __forceinline__ float exp_fast(float x) { return __builtin_amdgcn_exp2f(1.4426950408889634f * x); }
__device__ __forceinline__ float sigmoid_fast(float x) { return __builtin_amdgcn_rcpf(1.f + __builtin_amdgcn_exp2f(-1.4426950408889634f * x)); }
__device__ __forceinline__ float log_fast(float x) { return 0.6931471805599453f * __builtin_amdgcn_logf(x); }
__device__ __forceinline__ float gelu_tanh_fast(float x) {
    const float u = 0.7978845608028654f * (x + 0.044715f * x * x * x);
    return x * __builtin_amdgcn_rcpf(1.f + __builtin_amdgcn_exp2f(-2.885390081777927f * u));
}
__device__ __forceinline__ float gelu_tanh(float x) {
    const float c = 0.7978845608028654f;
    return 0.5f * x * (1.f + tanhf(c * (x + 0.044715f * x * x * x)));
}

typedef short bf16x8 __attribute__((ext_vector_type(8)));
typedef float f32x4 __attribute__((ext_vector_type(4)));
typedef unsigned short bf16_t;

typedef __bf16 bf16x2_t __attribute__((ext_vector_type(2)));
__device__ __forceinline__ unsigned pack2bf(float lo, float hi) {
    bf16x2_t v; v[0] = (__bf16)lo; v[1] = (__bf16)hi;
    return __builtin_bit_cast(unsigned, v);
}
__device__ __forceinline__ unsigned f2bf(float f) { return pack2bf(f, 0.f) & 0xffffu; }
__device__ __forceinline__ float bf2f(unsigned h) { return __uint_as_float(h << 16); }

__device__ __forceinline__ void cvt_rows_bf16(const float* __restrict__ src, bf16_t* __restrict__ dst, size_t n8) {
    for (size_t i = (size_t)blockIdx.x * 256 + threadIdx.x; i < n8; i += (size_t)gridDim.x * 256) {
        const float4 a = ((const float4*)src)[2 * i], b = ((const float4*)src)[2 * i + 1];
        uint4 o;
        o.x = pack2bf(a.x, a.y); o.y = pack2bf(a.z, a.w); o.z = pack2bf(b.x, b.y); o.w = pack2bf(b.z, b.w);
        ((uint4*)dst)[i] = o;
    }
}
__device__ __forceinline__ void transpose_bf16(const float* __restrict__ src, int Nsrc, int Npad, bf16_t* __restrict__ dst, int K = 1024) {
    const size_t total = (size_t)Npad * (K / 8);
    for (size_t i = (size_t)blockIdx.x * 256 + threadIdx.x; i < total; i += (size_t)gridDim.x * 256) {
        const int n = (int)(i % Npad), kg = (int)(i / Npad);
        float v[8];
#pragma unroll
        for (int j = 0; j < 8; ++j) v[j] = (n < Nsrc) ? src[(size_t)(kg * 8 + j) * Nsrc + n] : 0.f;
        uint4 o;
        o.x = pack2bf(v[0], v[1]); o.y = pack2bf(v[2], v[3]); o.z = pack2bf(v[4], v[5]); o.w = pack2bf(v[6], v[7]);
        *(uint4*)(dst + (size_t)n * K + kg * 8) = o;
    }
}

struct ALoadStd {
    const bf16_t* A; int lda;
    __device__ __forceinline__ const bf16_t* ptr(int row, int ks) const { return A + (size_t)row * lda + ks * 64; }
};
struct ALoadCmp {
    const bf16_t* KC;
    __device__ __forceinline__ const bf16_t* ptr(int row, int ks) const {
        const int r = row < 4088 ? row : 4087;
        const int g = r & 1, bn = r >> 1, n = bn % NCB, b = bn / NCB;
        return KC + ((size_t)(b * SEQ + 16 * n + ks) * 128 + g * 64);
    }
};
#define GLDS1(i, ks, buf) { const int row_ = 8 * w + 32 * (i) + (lane >> 3);                                                    \
        __builtin_amdgcn_global_load_lds((const unsigned*)(aload.ptr(m0 + row_, (ks)) + (((lane & 7) ^ (lane >> 3)) << 3)),      \
                                         (LAS3 unsigned*)(lds + (buf) * 32768 + w * 1024 + (i) * 4096), 16, 0, 0);              \
        __builtin_amdgcn_global_load_lds((const unsigned*)(Bp + (size_t)row_ * ldb + (ks) * 64 + (((lane & 7) ^ (lane >> 3)) << 3)), \
                                         (LAS3 unsigned*)(lds + (buf) * 32768 + 16384 + w * 1024 + (i) * 4096), 16, 0, 0); }
#define GEMM_GLDS(ks, buf) { GLDS1(0, ks, buf) GLDS1(1, ks, buf) GLDS1(2, ks, buf) GLDS1(3, ks, buf) }
template <class ALoad, class Epi>
__device__ __forceinline__ void gemm_tile(const ALoad aload, const bf16_t* __restrict__ Bt, int ldb, int KS, int m0, int n0,
                                          unsigned char* lds, Epi epi) {
    const int tid = opaque_tid(), lane = tid & 63, w = __builtin_amdgcn_readfirstlane(tid >> 6), wm = w >> 1, wn = w & 1;
    f32x4 acc[4][4];
#pragma unroll
    for (int j = 0; j < 4; ++j)
#pragma unroll
        for (int i = 0; i < 4; ++i) acc[j][i] = (f32x4){0.f, 0.f, 0.f, 0.f};
    const bf16_t* Bp = Bt + (size_t)n0 * ldb;
    __syncthreads();
    GEMM_GLDS(0, 0)
    asm volatile("s_waitcnt vmcnt(0)" ::: "memory");
    __syncthreads();
    for (int ks = 0; ks < KS; ++ks) {
        if (ks + 1 < KS) GEMM_GLDS(ks + 1, (ks + 1) & 1)
        const unsigned char* la = lds + (ks & 1) * 32768;
        const unsigned char* lb = la + 16384;
#pragma unroll
        for (int s = 0; s < 2; ++s) {
            bf16x8 af[4], wf[4];
            const int ch = s * 4 + (lane >> 4);
#pragma unroll
            for (int i = 0; i < 4; ++i) {
                const int row = wm * 64 + i * 16 + (lane & 15);
                af[i] = *(const bf16x8*)(la + row * 128 + ((ch ^ (row & 7)) << 4));
            }
#pragma unroll
            for (int j = 0; j < 4; ++j) {
                const int row = wn * 64 + j * 16 + (lane & 15);
                wf[j] = *(const bf16x8*)(lb + row * 128 + ((ch ^ (row & 7)) << 4));
            }
#pragma unroll
            for (int j = 0; j < 4; ++j)
#pragma unroll
                for (int i = 0; i < 4; ++i)
                    acc[j][i] = __builtin_amdgcn_mfma_f32_16x16x32_bf16(wf[j], af[i], acc[j][i], 0, 0, 0);
        }
        asm volatile("s_waitcnt vmcnt(0)" ::: "memory");
        __syncthreads();
    }
#pragma unroll
    for (int j = 0; j < 4; ++j)
#pragma unroll
        for (int i = 0; i < 4; ++i)
            epi(m0 + wm * 64 + i * 16 + (lane & 15), n0 + wn * 64 + j * 16 + (lane >> 4) * 4, acc[j][i]);
    epi.finish(m0, n0);
}
template <class Epi>
__device__ __forceinline__ void gemm_bf16_phase(const bf16_t* __restrict__ A, int lda, const bf16_t* __restrict__ Bt, int ldb,
                                                int Mtiles, int Ntiles, unsigned char* lds, Epi epi) {
    if ((gridDim.x & 7) == 0 && (Mtiles & 31) == 0) {
        const int x = blockIdx.x & 7, j = blockIdx.x >> 3, nb = gridDim.x >> 3;
        const int per = (Mtiles >> 3) * Ntiles;
        for (int q = j; q < per; q += nb) {
            const int s = q / (4 * Ntiles), rem = q - s * (4 * Ntiles);
            const int c = rem >> 2, r = rem & 3;
            const int mt = x + 8 * (4 * s + r);
            gemm_tile(ALoadStd{A, lda}, Bt, ldb, 16, mt * 128, c * 128, lds, epi);
        }
    } else {
        for (int tile = blockIdx.x; tile < Mtiles * Ntiles; tile += gridDim.x) {
            const int mt = tile / Ntiles, nt = tile % Ntiles;
            gemm_tile(ALoadStd{A, lda}, Bt, ldb, 16, mt * 128, nt * 128, lds, epi);
        }
    }
}


#define G3_STAGE 24576
#define G3A(i, ks, st) __builtin_amdgcn_global_load_lds((const unsigned*)(pa + (size_t)(64 * (i)) * lda + (ks) * 32),                     \
                                                        (LAS3 unsigned*)(lds + (st) + (w + 4 * (i)) * 1024), 16, 0, 0);
#define G3B(i, ks, st) __builtin_amdgcn_global_load_lds((const unsigned*)(pb + (size_t)(64 * (i)) * ldb + (ks) * 32),                     \
                                                        (LAS3 unsigned*)(lds + (st) + 16384 + (w + 4 * (i)) * 1024), 16, 0, 0);
#define G3MF(j, i) acc[j][i] = __builtin_amdgcn_mfma_f32_16x16x32_bf16(wf[j], af[i], acc[j][i], 0, 0, 0);
#define G3MF4(j, i) G3MF(j, i) G3MF(j, (i) + 1) G3MF(j, (i) + 2) G3MF(j, (i) + 3)
#define G3SB __builtin_amdgcn_sched_barrier(0);
#define G3_BODY(LOADS, KS) {                                                                                                              \
        const unsigned char* la = lds + st0 + wm * 8192 + fofs;                                                                           \
        const unsigned char* lb = lds + st0 + 16384 + wn * 4096 + fofs;                                                                   \
        bf16x8 af[8], wf[4];                                                                                                              \
        wf[0] = *(const bf16x8*)(lb);                                                                                                     \
        af[0] = *(const bf16x8*)(la);            af[1] = *(const bf16x8*)(la + 1024); af[2] = *(const bf16x8*)(la + 2048);                \
        af[3] = *(const bf16x8*)(la + 3072);     af[4] = *(const bf16x8*)(la + 4096); af[5] = *(const bf16x8*)(la + 5120);                \
        af[6] = *(const bf16x8*)(la + 6144);     af[7] = *(const bf16x8*)(la + 7168);                                                     \
        wf[1] = *(const bf16x8*)(lb + 1024);     wf[2] = *(const bf16x8*)(lb + 2048); wf[3] = *(const bf16x8*)(lb + 3072);                \
        G3SB                                                                                                                              \
        G3MF4(0, 0) if (LOADS) { G3A(0, (KS) + 2, st2) } G3SB                                                                             \
        G3MF4(0, 4) if (LOADS) { G3A(1, (KS) + 2, st2) } G3SB                                                                             \
        G3MF4(1, 0) if (LOADS) { G3A(2, (KS) + 2, st2) } G3SB                                                                             \
        G3MF4(1, 4) if (LOADS) { G3A(3, (KS) + 2, st2) } G3SB                                                                             \
        G3MF4(2, 0) if (LOADS) { G3B(0, (KS) + 2, st2) } G3SB                                                                             \
        G3MF4(2, 4) if (LOADS) { G3B(1, (KS) + 2, st2) } G3SB                                                                             \
        G3MF4(3, 0) G3MF4(3, 4) }
template <class Epi>
__device__ __forceinline__ void gemm_tile3(const bf16_t* __restrict__ A, int lda, const bf16_t* __restrict__ Bt, int ldb, int m0, int n0,
                                           unsigned char* lds, Epi epi) {
    const int tid = opaque_tid(), lane = tid & 63, w = __builtin_amdgcn_readfirstlane(tid >> 6), wm = w >> 1, wn = w & 1;
    f32x4 acc[4][8];
#pragma unroll
    for (int j = 0; j < 4; ++j)
#pragma unroll
        for (int i = 0; i < 8; ++i) acc[j][i] = (f32x4){0.f, 0.f, 0.f, 0.f};
    const int r15 = lane & 15, g4 = lane >> 4;
    const int fofs = r15 * 64 + ((g4 ^ ((0 - (r15 >> 2)) & 3)) << 4);
    const int lch = ((lane & 3) ^ ((0 - (lane >> 4)) & 3)) << 3;
    const bf16_t* pa = A + (size_t)(m0 + 16 * w + (lane >> 2)) * lda + lch;
    const bf16_t* pb = Bt + (size_t)(n0 + 16 * w + (lane >> 2)) * ldb + lch;
    __syncthreads();
    G3A(0, 0, 0) G3A(1, 0, 0) G3A(2, 0, 0) G3A(3, 0, 0) G3B(0, 0, 0) G3B(1, 0, 0)
    G3A(0, 1, G3_STAGE) G3A(1, 1, G3_STAGE) G3A(2, 1, G3_STAGE) G3A(3, 1, G3_STAGE) G3B(0, 1, G3_STAGE) G3B(1, 1, G3_STAGE)
    int st0 = 0, st1 = G3_STAGE, st2 = 2 * G3_STAGE;
#pragma unroll 1
    for (int ks = 0; ks < 30; ++ks) {
        asm volatile("s_waitcnt vmcnt(6)" ::: "memory");
        __builtin_amdgcn_s_barrier();
        asm volatile("" ::: "memory");
        G3_BODY(1, ks)
        const int t_ = st0; st0 = st1; st1 = st2; st2 = t_;
    }
    asm volatile("s_waitcnt vmcnt(6)" ::: "memory");
    __builtin_amdgcn_s_barrier();
    asm volatile("" ::: "memory");
    G3_BODY(0, 30)
    st0 = st1;
    asm volatile("s_waitcnt vmcnt(0)" ::: "memory");
    __builtin_amdgcn_s_barrier();
    asm volatile("" ::: "memory");
    G3_BODY(0, 31)
    __syncthreads();
    if constexpr (Epi::kRow) {
        const int mrow = m0 + wm * 128 + r15, ncol = n0 + wn * 64;
        epi.dispatch(n0, [&](auto e) {
            if constexpr (decltype(e)::kBf16) {
#pragma unroll
                for (int i = 0; i < 8; ++i)
#pragma unroll
                    for (int j = 0; j < 4; j += 2) {
                        uint2 a = e.pack4(acc[j][i]), b = e.pack4(acc[j + 1][i]);
                        auto sx = __builtin_amdgcn_permlane16_swap(a.x, b.x, false, false);
                        auto sy = __builtin_amdgcn_permlane16_swap(a.y, b.y, false, false);
                        e.store8(mrow + i * 16, ncol + (j + (g4 & 1)) * 16 + (g4 >> 1) * 8, make_uint4(sx[0], sy[0], sx[1], sy[1]));
                    }
            } else {
#pragma unroll
                for (int i = 0; i < 8; ++i)
#pragma unroll
                    for (int j = 0; j < 4; ++j)
                        e.row4(mrow + i * 16, ncol + j * 16 + g4 * 4, make_float4(acc[j][i][0], acc[j][i][1], acc[j][i][2], acc[j][i][3]));
            }
        });
    } else {
#pragma unroll
        for (int hh = 0; hh < 2; ++hh) {
            if (wm == hh) {
#pragma unroll
                for (int j = 0; j < 4; ++j)
#pragma unroll
                    for (int i = 0; i < 8; ++i)
                        epi(m0 + wm * 128 + i * 16 + (lane & 15), n0 + wn * 64 + j * 16 + (lane >> 4) * 4, acc[j][i]);
            }
            epi.finish(m0 + hh * 128, n0);
        }
    }
}

#define G3PA(PA, i, k, st) __builtin_amdgcn_global_load_lds((const unsigned*)((PA) + (size_t)(64 * (i)) * lda + (k) * 32),                 \
                                                            (LAS3 unsigned*)(lds + (st) + (w + 4 * (i)) * 1024), 16, 0, 0);
#define G3PB(PB, i, k, st) __builtin_amdgcn_global_load_lds((const unsigned*)((PB) + (size_t)(64 * (i)) * ldb + (k) * 32),                 \
                                                            (LAS3 unsigned*)(lds + (st) + 16384 + (w + 4 * (i)) * 1024), 16, 0, 0);
#define G3P_BODY(PA, PB, KIDX) {                                                                                                          \
        const unsigned char* la = lds + st0 + wm * 8192 + fofs;                                                                           \
        const unsigned char* lb = lds + st0 + 16384 + wn * 4096 + fofs;                                                                   \
        bf16x8 af[8], wf[4];                                                                                                              \
        wf[0] = *(const bf16x8*)(lb);                                                                                                     \
        af[0] = *(const bf16x8*)(la);            af[1] = *(const bf16x8*)(la + 1024); af[2] = *(const bf16x8*)(la + 2048);                \
        af[3] = *(const bf16x8*)(la + 3072);     af[4] = *(const bf16x8*)(la + 4096); af[5] = *(const bf16x8*)(la + 5120);                \
        af[6] = *(const bf16x8*)(la + 6144);     af[7] = *(const bf16x8*)(la + 7168);                                                     \
        wf[1] = *(const bf16x8*)(lb + 1024);     wf[2] = *(const bf16x8*)(lb + 2048); wf[3] = *(const bf16x8*)(lb + 3072);                \
        G3SB                                                                                                                              \
        G3MF4(0, 0) G3PA(PA, 0, KIDX, st2) G3SB                                                                                           \
        G3MF4(0, 4) G3PA(PA, 1, KIDX, st2) G3SB                                                                                           \
        G3MF4(1, 0) G3PA(PA, 2, KIDX, st2) G3SB                                                                                           \
        G3MF4(1, 4) G3PA(PA, 3, KIDX, st2) G3SB                                                                                           \
        G3MF4(2, 0) G3PB(PB, 0, KIDX, st2) G3SB                                                                                           \
        G3MF4(2, 4) G3PB(PB, 1, KIDX, st2) G3SB                                                                                           \
        G3MF4(3, 0) G3MF4(3, 4)                                                                                                           \
        { const int t_ = st0; st0 = st1; st1 = st2; st2 = t_; } }
#define G3P_SYNC(N) { asm volatile("s_waitcnt vmcnt(" #N ")" ::: "memory"); __builtin_amdgcn_s_barrier(); asm volatile("" ::: "memory"); }
#define G3P_BAR     { __builtin_amdgcn_s_barrier(); asm volatile("" ::: "memory"); }
template <class Epi>
__device__ __forceinline__ void gemm_phase_pipelined(const bf16_t* __restrict__ A, int lda, const bf16_t* __restrict__ Bt, int ldb,
                                                     int Mtiles  , int Ntiles, unsigned char* lds, Epi epi) {
    const int tid = opaque_tid(), lane = tid & 63, w = __builtin_amdgcn_readfirstlane(tid >> 6), wm = w >> 1, wn = w & 1;
    const int r15 = lane & 15, g4 = lane >> 4;
    const int fofs = r15 * 64 + ((g4 ^ ((0 - (r15 >> 2)) & 3)) << 4);
    const int lch = ((lane & 3) ^ ((0 - (lane >> 4)) & 3)) << 3;
    const int x = blockIdx.x & 7, jb = blockIdx.x >> 3, nb = gridDim.x >> 3;
    const int per = (Mtiles >> 3) * Ntiles;
    int q = jb;
    if (q >= per) return;
    int m0, n0;
#define G3P_TILE(Q, M0, N0) { const int s_ = (Q) / (2 * Ntiles), rem_ = (Q) - s_ * (2 * Ntiles); M0 = (x + 8 * (2 * s_ + (rem_ & 1))) * 256; N0 = (rem_ >> 1) * 128; }
    G3P_TILE(q, m0, n0)
    const bf16_t* pa = A + (size_t)(m0 + 16 * w + (lane >> 2)) * lda + lch;
    const bf16_t* pb = Bt + (size_t)(n0 + 16 * w + (lane >> 2)) * ldb + lch;
    int st0 = 0, st1 = G3_STAGE, st2 = 2 * G3_STAGE;
    __syncthreads();
    G3PA(pa, 0, 0, 0) G3PA(pa, 1, 0, 0) G3PA(pa, 2, 0, 0) G3PA(pa, 3, 0, 0) G3PB(pb, 0, 0, 0) G3PB(pb, 1, 0, 0)
    G3PA(pa, 0, 1, G3_STAGE) G3PA(pa, 1, 1, G3_STAGE) G3PA(pa, 2, 1, G3_STAGE) G3PA(pa, 3, 1, G3_STAGE) G3PB(pb, 0, 1, G3_STAGE) G3PB(pb, 1, 1, G3_STAGE)
    asm volatile("s_waitcnt vmcnt(0)" ::: "memory");
    for (;;) {
        const int qn = (q + nb < per) ? q + nb : q;
        int m0n, n0n;
        G3P_TILE(qn, m0n, n0n)
        const bf16_t* pan = A + (size_t)(m0n + 16 * w + (lane >> 2)) * lda + lch;
        const bf16_t* pbn = Bt + (size_t)(n0n + 16 * w + (lane >> 2)) * ldb + lch;
        f32x4 acc[4][8];
#pragma unroll
        for (int j = 0; j < 4; ++j)
#pragma unroll
            for (int i = 0; i < 8; ++i) acc[j][i] = (f32x4){0.f, 0.f, 0.f, 0.f};
        G3P_BAR      G3P_BODY(pa, pb, 2)
        G3P_BAR      G3P_BODY(pa, pb, 3)
#pragma unroll 1
        for (int ks = 2; ks < 30; ++ks) {
            G3P_SYNC(6)
            G3P_BODY(pa, pb, ks + 2)
        }
        G3P_SYNC(6)  G3P_BODY(pan, pbn, 0)
        G3P_SYNC(6)  G3P_BODY(pan, pbn, 1)
        {
            const int mrow = m0 + wm * 128 + r15, ncol = n0 + wn * 64;
            epi.dispatch(n0, [&](auto e) {
                asm volatile("s_waitcnt vmcnt(0)" ::: "memory");
                if constexpr (decltype(e)::kBf16) {
#pragma unroll
                    for (int i = 0; i < 8; ++i)
#pragma unroll
                        for (int j = 0; j < 4; j += 2) {
                            uint2 a = e.pack4(acc[j][i]), b = e.pack4(acc[j + 1][i]);
                            auto sx = __builtin_amdgcn_permlane16_swap(a.x, b.x, false, false);
                            auto sy = __builtin_amdgcn_permlane16_swap(a.y, b.y, false, false);
                            e.store8(mrow + i * 16, ncol + (j + (g4 & 1)) * 16 + (g4 >> 1) * 8, make_uint4(sx[0], sy[0], sx[1], sy[1]));
                        }
                } else {
#pragma unroll
                    for (int i = 0; i < 8; ++i)
#pragma unroll
                        for (int j = 0; j < 4; ++j)
                            e.row4(mrow + i * 16, ncol + j * 16 + g4 * 4, make_float4(acc[j][i][0], acc[j][i][1], acc[j][i][2], acc[j][i][3]));
                }
            });
        }
        if (qn == q) break;
        q = qn; m0 = m0n; n0 = n0n; pa = pan; pb = pbn;
    }
    asm volatile("s_waitcnt vmcnt(0)" ::: "memory");
    __syncthreads();
#undef G3P_TILE
}

template <class Epi>
__device__ __forceinline__ void gemm_bf16_phase3(const bf16_t* __restrict__ A, int lda, const bf16_t* __restrict__ Bt, int ldb,
                                                 int Mtiles  , int Ntiles, unsigned char* lds, Epi epi) {
    if constexpr (Epi::kRow) {
        if ((gridDim.x & 7) == 0 && (Mtiles & 15) == 0) { gemm_phase_pipelined(A, lda, Bt, ldb, Mtiles, Ntiles, lds, epi); return; }
    }
    if ((gridDim.x & 7) == 0 && (Mtiles & 15) == 0) {
        const int x = blockIdx.x & 7, j = blockIdx.x >> 3, nb = gridDim.x >> 3;
        const int per = (Mtiles >> 3) * Ntiles;
        for (int q = j; q < per; q += nb) {
            const int s = q / (2 * Ntiles), rem = q - s * (2 * Ntiles);
            const int c = rem >> 1, r = rem & 1;
            const int mt = x + 8 * (2 * s + r);
            gemm_tile3(A, lda, Bt, ldb, mt * 256, c * 128, lds, epi);
        }
    } else {
        for (int tile = blockIdx.x; tile < Mtiles * Ntiles; tile += gridDim.x)
            gemm_tile3(A, lda, Bt, ldb, (tile / Ntiles) * 256, (tile % Ntiles) * 128, lds, epi);
    }
}

struct EpiF32 {
    float* C; int ldc; int Nc;
    __device__ __forceinline__ void operator()(int m, int n, f32x4 v) const {
        if (n < Nc) *(float4*)(C + (size_t)m * ldc + n) = make_float4(v[0], v[1], v[2], v[3]);
    }
    __device__ __forceinline__ void finish(int, int) const {}
};

struct EpiProjBf {
    static constexpr bool kBf16 = true;
    bf16_t* dst; int ld; float sc;
    __device__ __forceinline__ uint2 pack4(f32x4 v) const { uint2 o; o.x = pack2bf(sc * v[0], sc * v[1]); o.y = pack2bf(sc * v[2], sc * v[3]); return o; }
    __device__ __forceinline__ void store8(int m, int n, uint4 o) const { *(uint4*)(dst + (size_t)m * ld + (n & 127)) = o; }
};
struct EpiProjLF {
    static constexpr bool kBf16 = false;
    unsigned char* ws;
    __device__ __forceinline__ void row4(int m, int n, float4 v) const {
        const int c = n - 512;
        const float4 lb = *(const float4*)((const float*)(ws + OFF_LBV) + c);
        float4 o;
        o.x = log_fast(lb.x + (1.f - lb.x) * sigmoid_fast(v.x)); o.y = log_fast(lb.y + (1.f - lb.y) * sigmoid_fast(v.y));
        o.z = log_fast(lb.z + (1.f - lb.z) * sigmoid_fast(v.z)); o.w = log_fast(lb.w + (1.f - lb.w) * sigmoid_fast(v.w));
        *(float4*)((float*)(ws + OFF_HLF) + (size_t)m * 512 + c) = o;
    }
};
struct EpiProjGate {
    static constexpr bool kBf16 = false;
    unsigned char* ws;
    __device__ __forceinline__ void row4(int m, int n, float4 v) const {
        const int c = n - 3328;
        if (c < 24)
            *(float4*)((float*)(ws + OFF_NGATE) + (size_t)m * 24 + c) =
                make_float4(sigmoid_fast(v.x), sigmoid_fast(v.y), sigmoid_fast(v.z), sigmoid_fast(v.w));
    }
};
struct EpiProj {
    static constexpr bool kRow = true;
    unsigned char* ws;
    template <class F> __device__ __forceinline__ void dispatch(int n0, F f) const {
        const int ct = __builtin_amdgcn_readfirstlane(n0 >> 7);
        if (ct >= 4 && ct < 8) f(EpiProjLF{ws});
        else if (ct >= 26) f(EpiProjGate{ws});
        else {
            size_t off; int ld = 512, c0 = (ct & 3) * 128; float sc = 1.f;
            if (ct < 4) off = OFF_HQ;
            else if (ct < 12) off = OFF_HI;
            else if (ct < 16) off = OFF_HG;
            else if (ct < 20) { off = OFF_NQ; sc = 0.125f * 1.4426950408889634f; }
            else { off = OFF_KV + (size_t)(ct - 20) * KV_STRIDE; ld = 128; c0 = 0; }
            f(EpiProjBf{(bf16_t*)(ws + off) + c0, ld, sc});
        }
    }
    __device__ __forceinline__ void finish(int, int) const {}
};
struct EpiMix {
    static constexpr bool kRow = true;
    bf16_t* mix;
    template <class F> __device__ __forceinline__ void dispatch(int n0, F f) const { f(EpiProjBf{mix + n0, DM, 1.f}); }
    __device__ __forceinline__ void finish(int, int) const {}
};

__device__ __forceinline__ uint4 pack8bf(const float* v) {
    uint4 o;
    o.x = pack2bf(v[0], v[1]); o.y = pack2bf(v[2], v[3]); o.z = pack2bf(v[4], v[5]); o.w = pack2bf(v[6], v[7]);
    return o;
}

__device__ __forceinline__ void hgrn_passA(const Params& p, int chunk, unsigned char* smem) {
    const int c = chunk & 127, bh = chunk >> 7, h = bh & 3, b = bh >> 2;
    const int tid = opaque_tid(), d = tid & 127, hf = __builtin_amdgcn_readfirstlane(tid >> 7), lane = tid & 63, w = __builtin_amdgcn_readfirstlane(tid >> 6);
    const size_t tok0 = (size_t)b * SEQ + (size_t)c * 64 + 32 * hf;
    const float* HLF = (const float*)(p.ws + OFF_HLF);
    const bf16_t* HI = (const bf16_t*)(p.ws + OFF_HI);
    unsigned char* KT = smem;
    unsigned char* VT = smem + 16384;
    float* xch = (float*)(smem + 32768);
    const float* lfp = HLF + tok0 * 512 + h * 128 + d;
    const bf16_t* vp = HI + tok0 * 512 + h * 128 + d;
    float run = 0.f, b15 = 0.f;
#pragma unroll 8
    for (int s = 0; s < 32; ++s) { run += lfp[s * 512]; if (s == 15) b15 = run; }
    __syncthreads();
    xch[hf * 128 + d] = run;
    __syncthreads();
    const float tot0 = xch[d], tot1 = xch[128 + d];
    const float blast = tot0 + tot1;
    {
        float* REF = (float*)(p.ws + OFF_HREF) + (size_t)chunk * 384;
        if (hf == 0) { REF[d] = b15; REF[128 + d] = tot0; } else REF[256 + d] = tot0 + b15;
    }
    run = hf ? tot0 : 0.f;
#pragma unroll 1
    for (int q = 0; q < 4; ++q) {
        float kv[8], vv[8];
#pragma unroll
        for (int j = 0; j < 8; ++j) {
            const int s = q * 8 + j;
            const float lf = lfp[s * 512];
            run += lf;
            kv[j] = (1.f - exp_fast(lf)) * exp_fast(blast - run);
            vv[j] = bf2f(vp[s * 512]);
        }
        const int ch = 4 * hf + q;
        *(uint4*)(KT + d * 128 + ((ch ^ (d & 7)) << 4)) = pack8bf(kv);
        *(uint4*)(VT + d * 128 + ((ch ^ (d & 7)) << 4)) = pack8bf(vv);
    }
    if (hf) ((float*)(p.ws + OFF_DC))[(size_t)chunk * 128 + d] = expf(blast);
    __syncthreads();
    f32x4 acc[2][8];
#pragma unroll
    for (int i = 0; i < 2; ++i)
#pragma unroll
        for (int et = 0; et < 8; ++et) acc[i][et] = (f32x4){0.f, 0.f, 0.f, 0.f};
#pragma unroll
    for (int st = 0; st < 2; ++st) {
        const int ch = st * 4 + (lane >> 4);
        bf16x8 af[2];
#pragma unroll
        for (int i = 0; i < 2; ++i) {
            const int row = (2 * w + i) * 16 + (lane & 15);
            af[i] = *(const bf16x8*)(KT + row * 128 + ((ch ^ (row & 7)) << 4));
        }
#pragma unroll
        for (int et = 0; et < 8; ++et) {
            const int row = et * 16 + (lane & 15);
            const bf16x8 bfv = *(const bf16x8*)(VT + row * 128 + ((ch ^ (row & 7)) << 4));
            acc[0][et] = __builtin_amdgcn_mfma_f32_16x16x32_bf16(af[0], bfv, acc[0][et], 0, 0, 0);
            acc[1][et] = __builtin_amdgcn_mfma_f32_16x16x32_bf16(af[1], bfv, acc[1][et], 0, 0, 0);
        }
    }
    bf16_t* HC = (bf16_t*)p.out + (size_t)chunk * 16384;
#pragma unroll
    for (int i = 0; i < 2; ++i)
#pragma unroll
        for (int et = 0; et < 8; ++et) {
            const int e = et * 16 + (lane & 15), d0 = (2 * w + i) * 16 + (lane >> 4) * 4;
            { uint2 hv; hv.x = pack2bf(acc[i][et][0], acc[i][et][1]); hv.y = pack2bf(acc[i][et][2], acc[i][et][3]); *(uint2*)(HC + e * 128 + d0) = hv; }
        }
}

__device__ __forceinline__ void hgrn_scan_item(const Params& p, int item) {
    const int gid = item * 256 + threadIdx.x;
    const int d4 = gid & 31, e = (gid >> 5) & 127, bh = gid >> 12;
    const bf16_t* HC = (const bf16_t*)p.out;
    const float* DC = (const float*)(p.ws + OFF_DC);
    bf16_t* SC = (bf16_t*)(p.ws + OFF_SC);
    float4 S = make_float4(0.f, 0.f, 0.f, 0.f);
#pragma unroll 4
    for (int c = 0; c < 128; ++c) {
        const size_t base = ((size_t)(bh * 128 + c) * 128 + e) * 128 + d4 * 4;
        const uint2 hb = *(const uint2*)(HC + base);
        const float4 H = make_float4(__uint_as_float(hb.x << 16), __uint_as_float(hb.x & 0xffff0000u), __uint_as_float(hb.y << 16), __uint_as_float(hb.y & 0xffff0000u));
        const float4 dc = *(const float4*)(DC + (size_t)(bh * 128 + c) * 128 + d4 * 4);
        uint2 o; o.x = pack2bf(S.x, S.y); o.y = pack2bf(S.z, S.w);
        *(uint2*)(SC + base) = o;
        S.x = dc.x * S.x + H.x; S.y = dc.y * S.y + H.y; S.z = dc.z * S.z + H.z; S.w = dc.w * S.w + H.w;
    }
}

__device__ __forceinline__ void hgrn_passC(const Params& p, int chunk, unsigned char* smem) {
    const int c = chunk & 127, bh = chunk >> 7, h = bh & 3, b = bh >> 2;
    const int tid = opaque_tid(), d = tid & 127, hf = __builtin_amdgcn_readfirstlane(tid >> 7), lane = tid & 63, w = __builtin_amdgcn_readfirstlane(tid >> 6);
    const size_t tokc = (size_t)b * SEQ + (size_t)c * 64;
    const size_t tok0 = tokc + 32 * hf;
    const float* HLF = (const float*)(p.ws + OFF_HLF);
    const bf16_t* HQ = (const bf16_t*)(p.ws + OFF_HQ);
    const bf16_t* HI = (const bf16_t*)(p.ws + OFF_HI);
    const bf16_t* HG = (const bf16_t*)(p.ws + OFF_HG);
    unsigned char* R0 = smem;
    unsigned char* R1 = smem + 16384;
    unsigned char* R2 = smem + 57344;
    unsigned char* R3 = smem + 65536;
    const float* lfp = HLF + tok0 * 512 + h * 128 + d;
    const bf16_t* qp = HQ + tok0 * 512 + h * 128 + d;
    const float* REF = (const float*)(p.ws + OFF_HREF) + (size_t)chunk * 384;
    __syncthreads();
    const float r1 = REF[d], r2 = REF[128 + d], r3 = REF[256 + d];
    uint4 sct0, sct1, sct2, sct3, sct4, sct5, sct6, sct7;
    {
        const bf16_t* SCp = (const bf16_t*)(p.ws + OFF_SC) + (size_t)chunk * 16384;
#define SCLD(i, R_) { const int cc = tid + 256 * (i); R_ = *(const uint4*)(SCp + (cc >> 4) * 128 + (cc & 15) * 8); }
        SCLD(0, sct0) SCLD(1, sct1) SCLD(2, sct2) SCLD(3, sct3) SCLD(4, sct4) SCLD(5, sct5) SCLD(6, sct6) SCLD(7, sct7)
#undef SCLD
    }
    uint4 vt0, vt1, vt2, vt3;
    {
        const bf16_t* vp = HI + tok0 * 512 + h * 128 + d;
#define VLD8(q_, R_) { unsigned short v_[8]; _Pragma("unroll") for (int j = 0; j < 8; ++j) v_[j] = vp[((q_) * 8 + j) * 512];                 \
                       R_.x = v_[0] | ((unsigned)v_[1] << 16); R_.y = v_[2] | ((unsigned)v_[3] << 16);                                       \
                       R_.z = v_[4] | ((unsigned)v_[5] << 16); R_.w = v_[6] | ((unsigned)v_[7] << 16); }
        VLD8(0, vt0) VLD8(1, vt1) VLD8(2, vt2) VLD8(3, vt3)
#undef VLD8
    }
    {
        float run = hf ? r2 : 0.f;
        unsigned char* dummy = R2 + 4096 + d * 2;
#pragma unroll 8
        for (int s = 0; s < 32; ++s) {
            const int t = 32 * hf + s;
            const int it = t >> 4;
            const float rr = (it == 0) ? 0.f : (it == 1) ? r1 : (it == 2) ? r2 : r3;
            const int sw = (((d >> 3) ^ (t & 15)) << 4) + (d & 7) * 2;
            const float lf = lfp[s * 512];
            run += lf;
            const float qv = bf2f(qp[s * 512]);
            const float kv = 1.f - exp_fast(lf);
            *(bf16_t*)(R3 + t * 256 + sw) = (bf16_t)f2bf(qv * exp_fast(run));
            *(bf16_t*)(R0 + t * 256 + sw) = (bf16_t)f2bf(qv * exp_fast(run - rr));
#pragma unroll
            for (int i = 0; i < 4; ++i) {
                const float ri = (i == 0) ? 0.f : (i == 1) ? r1 : (i == 2) ? r2 : r3;
                const int R = 8 * i * (i + 1) + t;
                unsigned char* dst = (i >= it) ? (R1 + R * 256 + sw) : dummy;
                *(bf16_t*)dst = (bf16_t)f2bf(kv * exp_fast(fminf(ri - run, 80.f)));
            }
        }
    }
    __syncthreads();
#pragma unroll
    for (int j = 0; j < 4; ++j) {
        uint2 o = make_uint2(0u, 0u);
        if (j <= w) {
            f32x4 pa = (f32x4){0.f, 0.f, 0.f, 0.f};
#pragma unroll
            for (int ds = 0; ds < 4; ++ds) {
                const int ch = ds * 4 + (lane >> 4);
                const int krow = 8 * w * (w + 1) + 16 * j + (lane & 15);
                const int trow = w * 16 + (lane & 15);
                const bf16x8 av = *(const bf16x8*)(R1 + krow * 256 + ((ch ^ (krow & 15)) << 4));
                const bf16x8 bq = *(const bf16x8*)(R0 + trow * 256 + ((ch ^ (trow & 15)) << 4));
                pa = __builtin_amdgcn_mfma_f32_16x16x32_bf16(av, bq, pa, 0, 0, 0);
            }
            if (j == w) {
                const int tl = lane & 15, sl = (lane >> 4) * 4;
#pragma unroll
                for (int r = 0; r < 4; ++r) if (sl + r > tl) pa[r] = 0.f;
            }
            o.x = pack2bf(pa[0], pa[1]); o.y = pack2bf(pa[2], pa[3]);
        }
        const int t = w * 16 + (lane & 15);
        const int ch = 2 * j + (lane >> 5);
        *(uint2*)(R2 + t * 128 + ((ch ^ (t & 7)) << 4) + ((lane >> 4) & 1) * 8) = o;
    }
    __syncthreads();
    {
#define SCST(i, R_) { const int cc = tid + 256 * (i), row = cc >> 4, ch = cc & 15; *(uint4*)(R1 + row * 256 + ((ch ^ (row & 15)) << 4)) = R_; }
        SCST(0, sct0) SCST(1, sct1) SCST(2, sct2) SCST(3, sct3) SCST(4, sct4) SCST(5, sct5) SCST(6, sct6) SCST(7, sct7)
#undef SCST
        *(uint4*)(R0 + d * 128 + (((4 * hf + 0) ^ (d & 7)) << 4)) = vt0;
        *(uint4*)(R0 + d * 128 + (((4 * hf + 1) ^ (d & 7)) << 4)) = vt1;
        *(uint4*)(R0 + d * 128 + (((4 * hf + 2) ^ (d & 7)) << 4)) = vt2;
        *(uint4*)(R0 + d * 128 + (((4 * hf + 3) ^ (d & 7)) << 4)) = vt3;
    }
    __syncthreads();
    const size_t tok = tokc + w * 16 + (lane & 15);
    uint2 gb0, gb1, gb2, gb3, gb4, gb5, gb6, gb7;
    {
        const bf16_t* gp = HG + tok * 512 + h * 128 + (lane >> 4) * 4;
        gb0 = *(const uint2*)(gp); gb1 = *(const uint2*)(gp + 16); gb2 = *(const uint2*)(gp + 32); gb3 = *(const uint2*)(gp + 48);
        gb4 = *(const uint2*)(gp + 64); gb5 = *(const uint2*)(gp + 80); gb6 = *(const uint2*)(gp + 96); gb7 = *(const uint2*)(gp + 112);
    }
    f32x4 acc[8];
#pragma unroll
    for (int et = 0; et < 8; ++et) acc[et] = (f32x4){0.f, 0.f, 0.f, 0.f};
#pragma unroll
    for (int ds = 0; ds < 4; ++ds) {
        const int ch = ds * 4 + (lane >> 4);
        const int trow = w * 16 + (lane & 15);
        const bf16x8 bq = *(const bf16x8*)(R3 + trow * 256 + ((ch ^ (trow & 15)) << 4));
#pragma unroll
        for (int et = 0; et < 8; ++et) {
            const int row = et * 16 + (lane & 15);
            const bf16x8 av = *(const bf16x8*)(R1 + row * 256 + ((ch ^ (row & 15)) << 4));
            acc[et] = __builtin_amdgcn_mfma_f32_16x16x32_bf16(av, bq, acc[et], 0, 0, 0);
        }
    }
#pragma unroll
    for (int st = 0; st < 2; ++st) {
        const int ch = st * 4 + (lane >> 4);
        const int trow = w * 16 + (lane & 15);
        const bf16x8 bp = *(const bf16x8*)(R2 + trow * 128 + ((ch ^ (trow & 7)) << 4));
#pragma unroll
        for (int et = 0; et < 8; ++et) {
            const int row = et * 16 + (lane & 15);
            const bf16x8 av = *(const bf16x8*)(R0 + row * 128 + ((ch ^ (row & 7)) << 4));
            acc[et] = __builtin_amdgcn_mfma_f32_16x16x32_bf16(av, bp, acc[et], 0, 0, 0);
        }
    }
    {
        float ss = 0.f;
#pragma unroll
        for (int et = 0; et < 8; ++et)
#pragma unroll
            for (int r = 0; r < 4; ++r) ss += acc[et][r] * acc[et][r];
        ss += __shfl_xor(ss, 16);
        ss += __shfl_xor(ss, 32);
        const float rs = rsqrtf(ss * (1.f / 128.f) + LN_EPS);
        const float* ng = p.in[4];
        bf16_t* MIX = (bf16_t*)(p.ws + OFF_XB);
#pragma unroll
        for (int et = 0; et < 8; ++et) {
            const int e0 = et * 16 + (lane >> 4) * 4;
            const uint2 gb = (et == 0) ? gb0 : (et == 1) ? gb1 : (et == 2) ? gb2 : (et == 3) ? gb3 : (et == 4) ? gb4 : (et == 5) ? gb5 : (et == 6) ? gb6 : gb7;
            const float4 n4 = *(const float4*)(ng + e0);
            const float g0 = bf2f(gb.x & 0xffffu), g1 = bf2f(gb.x >> 16), g2 = bf2f(gb.y & 0xffffu), g3 = bf2f(gb.y >> 16);
            uint2 o;
            o.x = pack2bf(acc[et][0] * rs * n4.x * (g0 * sigmoid_fast(g0)), acc[et][1] * rs * n4.y * (g1 * sigmoid_fast(g1)));
            o.y = pack2bf(acc[et][2] * rs * n4.z * (g2 * sigmoid_fast(g2)), acc[et][3] * rs * n4.w * (g3 * sigmoid_fast(g3)));
            *(uint2*)(MIX + tok * DM + h * 128 + e0) = o;
        }
    }
}

__device__ __forceinline__ void compress_item(const Params& p, int item, float* sm) {
    const int g = item & 1;
    int r = item >> 1;
    const int n = r % NCB; r /= NCB;
    const int b = r & 3, which = r >> 2;
    const int tid = opaque_tid();
    const bf16_t* kvsrc = (const bf16_t*)(p.ws + OFF_KV + (size_t)which * KV_STRIDE);
    const float* pe = p.in[which ? 10 : 5];
    const float* w1 = p.in[which ? 11 : 6];
    const float* b1 = p.in[which ? 12 : 7];
    const float* w2 = p.in[which ? 13 : 8];
    const float* b2 = p.in[which ? 14 : 9];
    float* outp = (float*)(p.ws + (which ? OFF_CMPV : OFF_CMPK));
    float* blk = sm;
    float* hh = sm + 2048;
    __syncthreads();
    for (int i = tid; i < 2048; i += 256) {
        const int l = i >> 6, d = i & 63;
        blk[i] = bf2f(kvsrc[(size_t)(b * SEQ + 16 * n + l) * 128 + g * 64 + d]) + pe[i];
    }
    __syncthreads();
    float acc = b1[tid];
    for (int i = 0; i < 2048; ++i) acc += blk[i] * w1[(size_t)i * 256 + tid];
    hh[tid] = gelu_tanh(acc);
    __syncthreads();
    if (tid < 64) {
        float o = b2[tid];
        for (int j = 0; j < 256; ++j) o += hh[j] * w2[j * 64 + tid];
        outp[((size_t)(b * NCB + n) * 2 + g) * 64 + tid] = o;
    }
}

__device__ __forceinline__ float dot64_bf(const float* qs, const bf16_t* krow) {
    float s = 0.f;
#pragma unroll
    for (int i = 0; i < 8; ++i) {
        const uint4 kv = ((const uint4*)krow)[i];
        const float4 q0 = ((const float4*)qs)[2 * i], q1 = ((const float4*)qs)[2 * i + 1];
        s += __uint_as_float(kv.x << 16) * q0.x + __uint_as_float(kv.x & 0xffff0000u) * q0.y
           + __uint_as_float(kv.y << 16) * q0.z + __uint_as_float(kv.y & 0xffff0000u) * q0.w
           + __uint_as_float(kv.z << 16) * q1.x + __uint_as_float(kv.z & 0xffff0000u) * q1.y
           + __uint_as_float(kv.w << 16) * q1.z + __uint_as_float(kv.w & 0xffff0000u) * q1.w;
    }
    return s;
}
__device__ __forceinline__ float dot64(const float* qs, const float* krow) {
    float s = 0.f;
#pragma unroll
    for (int i = 0; i < 16; ++i) {
        const float4 kv = ((const float4*)krow)[i];
        const float4 qv = ((const float4*)qs)[i];
        s += kv.x * qv.x + kv.y * qv.y + kv.z * qv.z + kv.w * qv.w;
    }
    return s;
}

__device__ __forceinline__ void nsa_item(const Params& p, int item, float* sm) {
    const int t = item & (SEQ - 1), g = (item >> 13) & 1, b = item >> 14;
    const int tid = threadIdx.x, lane = tid & 63, r = tid >> 6;
    float* sc = sm + r * 1024;
    float* qs = sm + 4096 + r * 64;
    float* impv = sm + 4096 + 256;
    int* sel = (int*)(sm + 4096 + 256 + 128);
    const bf16_t* KSb = (const bf16_t*)(p.ws + OFF_KV + 2 * KV_STRIDE);
    const bf16_t* VSb = (const bf16_t*)(p.ws + OFF_KV + 3 * KV_STRIDE);
    const bf16_t* KWb = (const bf16_t*)(p.ws + OFF_KV + 4 * KV_STRIDE);
    const bf16_t* VWb = (const bf16_t*)(p.ws + OFF_KV + 5 * KV_STRIDE);
    const float* cmpk = (const float*)(p.ws + OFF_CMPK);
    const float* cmpv = (const float*)(p.ws + OFF_CMPV);
    const size_t n = (size_t)b * SEQ + t;
    const float NEGV = -1e30f;
    __syncthreads();
    qs[lane] = bf2f(((const bf16_t*)(p.ws + OFF_NQ))[n * 512 + g * 256 + r * 64 + lane]) * 0.6931471805599453f;
    __syncthreads();

    const int nvalid = (t >= 31) ? (((t - 31) >> 4) + 1) : 0;
    float m = NEGV;
    for (int n0 = 0; n0 < nvalid; n0 += 64) {
        const int nn = n0 + lane;
        if (nn < nvalid) {
            const float s = dot64(qs, cmpk + ((size_t)(b * NCB + nn) * 2 + g) * 64);
            sc[nn] = s;
            m = fmaxf(m, s);
        }
    }
    m = wave_max(m);
    float sum = 0.f;
    for (int n0 = 0; n0 < nvalid; n0 += 64) {
        const int nn = n0 + lane;
        if (nn < nvalid) { const float e = expf(sc[nn] - m); sc[nn] = e; sum += e; }
    }
    sum = wave_sum(sum);
    {
        const float inv = 1.f / fmaxf(sum, 1e-30f);
        for (int n0 = 0; n0 < nvalid; n0 += 64) {
            const int nn = n0 + lane;
            if (nn < nvalid) sc[nn] *= inv;
        }
    }
    __syncthreads();
    float oc = 0.f;
    for (int nn = 0; nn < nvalid; ++nn) oc += sc[nn] * cmpv[((size_t)(b * NCB + nn) * 2 + g) * 64 + lane];

    const int cur = t >> 6;
    if (tid < 128) {
        const int j = tid;
        float im = 0.f;
#pragma unroll
        for (int rr = 0; rr < 4; ++rr) {
            const float* P = sm + rr * 1024;
            const int n4 = 4 * j;
            float a = 0.f;
            if (n4 < nvalid) a += P[n4];
            if (n4 + 1 < nvalid) a += P[n4 + 1];
            if (n4 + 2 < nvalid) a += P[n4 + 2];
            if (n4 + 3 < nvalid) a += 0.5f * P[n4 + 3];
            if (n4 - 1 >= 0 && n4 - 1 < nvalid) a += 0.5f * P[n4 - 1];
            im += a;
        }
        const bool forced = (j == 0) || (j == cur) || (j == cur - 1);
        const bool causal = (j <= cur);
        impv[j] = forced ? 1.0e4f : (causal ? im : -1.f);
    }
    __syncthreads();
    if (r == 0) {
        float v0 = impv[lane], v1 = impv[lane + 64];
        for (int k = 0; k < 16; ++k) {
            const float mx = wave_max(fmaxf(v0, v1));
            const unsigned long long b0 = __ballot(v0 == mx);
            int idx;
            if (b0) {
                const int l = __ffsll((unsigned long long)b0) - 1;
                idx = l;
                if (lane == l) v0 = -3.0e38f;
            } else {
                const unsigned long long b1 = __ballot(v1 == mx);
                const int l = __ffsll((unsigned long long)b1) - 1;
                idx = 64 + l;
                if (lane == l) v1 = -3.0e38f;
            }
            if (lane == 0) sel[k] = idx;
        }
    }
    __syncthreads();

    m = NEGV;
    for (int si = 0; si < 16; ++si) {
        const int blk = sel[si];
        const int key = blk * 64 + lane;
        float s = NEGV;
        if (blk * 64 <= t) {
            if (key <= t) s = dot64_bf(qs, KSb + ((size_t)b * SEQ + key) * 128 + g * 64);
        }
        sc[si * 64 + lane] = s;
        m = fmaxf(m, s);
    }
    m = wave_max(m);
    sum = 0.f;
    for (int si = 0; si < 16; ++si) {
        const int key = sel[si] * 64 + lane;
        const float e = (key <= t) ? expf(sc[si * 64 + lane] - m) : 0.f;
        sc[si * 64 + lane] = e;
        sum += e;
    }
    sum = wave_sum(sum);
    {
        const float inv = 1.f / fmaxf(sum, 1e-30f);
        for (int si = 0; si < 16; ++si) sc[si * 64 + lane] *= inv;
    }
    __syncthreads();
    float os = 0.f;
    for (int si = 0; si < 16; ++si) {
        const int blk = sel[si];
        if (blk * 64 > t) continue;
        for (int kk = 0; kk < 64; ++kk) {
            const int key = blk * 64 + kk;
            if (key > t) break;
            os += sc[si * 64 + kk] * bf2f(VSb[((size_t)b * SEQ + key) * 128 + g * 64 + lane]);
        }
    }
    __syncthreads();

    const int lo = t - 511;
    m = NEGV;
    for (int i = 0; i < 8; ++i) {
        const int key = lo + i * 64 + lane;
        float s = NEGV;
        if (key >= 0) s = dot64_bf(qs, KWb + ((size_t)b * SEQ + key) * 128 + g * 64);
        sc[i * 64 + lane] = s;
        m = fmaxf(m, s);
    }
    m = wave_max(m);
    sum = 0.f;
    for (int i = 0; i < 8; ++i) {
        const int key = lo + i * 64 + lane;
        const float e = (key >= 0) ? expf(sc[i * 64 + lane] - m) : 0.f;
        sc[i * 64 + lane] = e;
        sum += e;
    }
    sum = wave_sum(sum);
    {
        const float inv = 1.f / fmaxf(sum, 1e-30f);
        for (int i = 0; i < 8; ++i) sc[i * 64 + lane] *= inv;
    }
    __syncthreads();
    float ow = 0.f;
    for (int idx = 0; idx < 512; ++idx) {
        const int key = lo + idx;
        if (key < 0) continue;
        ow += sc[idx] * bf2f(VWb[((size_t)b * SEQ + key) * 128 + g * 64 + lane]);
    }
    const float* grow = (const float*)(p.ws + OFF_NGATE) + n * 24 + g * 12 + r * 3;
    const float gc = grow[0], gs = grow[1], gw = grow[2];
#if NSA_DIAG
    {
        const float ref = gc * oc + gs * os + gw * ow;
        const float got = bf2f(((const bf16_t*)(p.ws + OFF_XB))[n * DM + 512 + g * 256 + r * 64 + lane]);
        const unsigned* SELM = (const unsigned*)(p.ws + OFF_SELM) + ((size_t)(b * 2 + g) * SEQ + t) * 4;
        unsigned gm[4] = {0u, 0u, 0u, 0u};
        for (int si = 0; si < 16; ++si) { const int blk = sel[si]; if (blk * 64 <= t) gm[blk >> 5] |= 1u << (blk & 31); }
        bool same = true;
        for (int qd = 0; qd < 4; ++qd) {
            unsigned mm = SELM[qd];
            for (int bit = 0; bit < 32; ++bit) if ((qd * 32 + bit) * 64 > t) mm &= ~(1u << bit);
            if (mm != gm[qd]) same = false;
        }
        float d2 = same ? (got - ref) * (got - ref) : 0.f, r2 = same ? ref * ref : 0.f;
        d2 = wave_sum(d2); r2 = wave_sum(r2);
        float* DG = (float*)(p.ws + OFF_DIAG);
        if (lane == 0) { atomicAdd(&DG[0], d2); atomicAdd(&DG[1], r2); if (r == 0) { atomicAdd(&DG[2], same ? 0.f : 1.f); atomicAdd(&DG[3], 1.f); } }
    }
#else
    ((bf16_t*)(p.ws + OFF_XB))[n * DM + 512 + g * 256 + r * 64 + lane] = (bf16_t)f2bf(gc * oc + gs * os + gw * ow);
#endif
}


__device__ __forceinline__ float xrow_max(float x) {
    auto s = __builtin_amdgcn_permlane16_swap(__float_as_uint(x), __float_as_uint(x), false, false);
    x = fmaxf(__uint_as_float(s[0]), __uint_as_float(s[1]));
    auto t = __builtin_amdgcn_permlane32_swap(__float_as_uint(x), __float_as_uint(x), false, false);
    return fmaxf(__uint_as_float(t[0]), __uint_as_float(t[1]));
}
__device__ __forceinline__ float xrow_sum(float x) {
    auto s = __builtin_amdgcn_permlane16_swap(__float_as_uint(x), __float_as_uint(x), false, false);
    x = __uint_as_float(s[0]) + __uint_as_float(s[1]);
    auto t = __builtin_amdgcn_permlane32_swap(__float_as_uint(x), __float_as_uint(x), false, false);
    return __uint_as_float(t[0]) + __uint_as_float(t[1]);
}
template <int CTRL> __device__ __forceinline__ float dppf(float x) {
    return __builtin_bit_cast(float, __builtin_amdgcn_mov_dpp(__builtin_bit_cast(int, x), CTRL, 0xf, 0xf, true));
}
__device__ __forceinline__ float row16_max(float m) {
    m = fmaxf(m, dppf<0x121>(m)); m = fmaxf(m, dppf<0x122>(m));
    m = fmaxf(m, dppf<0x124>(m)); m = fmaxf(m, dppf<0x128>(m));
    return m;
}
__device__ __forceinline__ float row16_sum(float m) {
    m += dppf<0x121>(m); m += dppf<0x122>(m); m += dppf<0x124>(m); m += dppf<0x128>(m);
    return m;
}
__device__ __forceinline__ float dot2bf(unsigned a, unsigned b, float acc) {
    return __builtin_amdgcn_fdot2_f32_bf16(__builtin_bit_cast(bf16x2_t, a), __builtin_bit_cast(bf16x2_t, b), acc, false);
}
__device__ __forceinline__ float enc_key(float v, unsigned idx, unsigned mask) {
    const unsigned u = __float_as_uint(v);
    const unsigned code = (u >> 31) ? idx : (mask - idx);
    return __uint_as_float((u & ~mask) | code);
}
__device__ __forceinline__ unsigned dec_idx(float key, unsigned mask) {
    const unsigned u = __float_as_uint(key);
    const unsigned code = u & mask;
    return (u >> 31) ? code : (mask - code);
}
__device__ __forceinline__ float dec_val(float key, unsigned mask) { return __uint_as_float(__float_as_uint(key) & ~mask); }
#define NEGKEY (-3.0e38f)
#define CE_DESC(a, b) { const float t_ = fmaxf(a, b); b = fminf(a, b); a = t_; }

struct EpiCmpH {
    bf16_t* HB; const float* peb;
    __device__ __forceinline__ void operator()(int m, int n, f32x4 v) const {
        const float4 pb = *(const float4*)(peb + n);
        uint2 o;
        o.x = pack2bf(gelu_tanh(v[0] + pb.x), gelu_tanh(v[1] + pb.y));
        o.y = pack2bf(gelu_tanh(v[2] + pb.z), gelu_tanh(v[3] + pb.w));
        *(uint2*)(HB + (size_t)m * 256 + n) = o;
    }
    __device__ __forceinline__ void finish(int, int) const {}
};
__device__ __forceinline__ void cmp_peb_partial(const Params& p, int b) {
    const int which = b >> 5, s = b & 31;
    const float* pe = p.in[which ? 10 : 5];
    const float* w1 = p.in[which ? 11 : 6];
    const int j = threadIdx.x;
    float acc = 0.f;
#pragma unroll 16
    for (int i = s * 64; i < s * 64 + 64; ++i) acc += pe[i] * w1[(size_t)i * 256 + j];
    ((float*)(p.ws + OFF_PEB + 4096))[(which * 32 + s) * 256 + j] = acc;
}
__device__ __forceinline__ void cmp_peb_reduce(const Params& p) {
    for (int o = threadIdx.x; o < 512; o += 256) {
        const int which = o >> 8, j = o & 255;
        float acc = p.in[which ? 12 : 7][j];
        for (int s = 0; s < 32; ++s) acc += ((const float*)(p.ws + OFF_PEB + 4096))[(which * 32 + s) * 256 + j];
        ((float*)(p.ws + OFF_PEB))[o] = acc;
    }
}
__device__ __forceinline__ void cmp_layer2_phase(const Params& p, int first_block, int nblocks) {
    const int tid_ = opaque_tid(), lane = tid_ & 63, w = __builtin_amdgcn_readfirstlane(tid_ >> 6);
    for (int it = (blockIdx.x - first_block) * 4 + w; it < 2 * 4088; it += nblocks * 4) {
        const int which = it >= 4088, row = which ? it - 4088 : it;
        const float* w2 = p.in[which ? 13 : 8];
        const float* b2 = p.in[which ? 14 : 9];
        const bf16_t* hrow = (const bf16_t*)(p.ws + OFF_HB) + ((size_t)which * 4096 + row) * 256;
        float o = b2[lane];
#pragma unroll 8
        for (int j = 0; j < 256; ++j) o += bf2f(hrow[j]) * w2[j * 64 + lane];
        const int g = row & 1, bn = row >> 1, n = bn % NCB, b = bn / NCB;
        ((bf16_t*)(p.ws + (which ? OFF_CMPVB : OFF_CMPKB)))[((size_t)(b * 2 + g) * 512 + n) * 64 + lane] = (bf16_t)f2bf(o);
    }
}

struct StageOfs { int k, v; };
__device__ __forceinline__ StageOfs make_stage_ofs() {
    const int c0 = opaque_tid(), key = c0 >> 3, ch = c0 & 7;
    StageOfs s;
    s.k = key * 128 + ((ch ^ (key & 7)) << 4);
    s.v = key * 128 + (((ch >> 1) ^ ((key >> 1) & 3)) << 5) + (ch & 1) * 16;
    return s;
}
#define NSA_KV_LOAD(S_, kb_) { const bf16_t* kp_ = Kbase + (size_t)(kb_) * 64 * stride + (size_t)(tid >> 3) * stride + (tid & 7) * 8; \
        const bf16_t* vp_ = Vbase + (size_t)(kb_) * 64 * stride + (size_t)(tid >> 3) * stride + (tid & 7) * 8;                 \
        S_##k0 = *(const uint4*)kp_; S_##k1 = *(const uint4*)(kp_ + (size_t)32 * stride);                                    \
        S_##v0 = *(const uint4*)vp_; S_##v1 = *(const uint4*)(vp_ + (size_t)32 * stride); }
#define NSA_KV_STORE(S_, Kl_, Vl_) { *(uint4*)((Kl_) + sof.k) = S_##k0; *(uint4*)((Kl_) + sof.k + 4096) = S_##k1; \
        *(uint4*)((Vl_) + sof.v) = S_##v0; *(uint4*)((Vl_) + sof.v + 4096) = S_##v1; }
template <class Compute>
__device__ __forceinline__ void nsa_kv_loop(const bf16_t* __restrict__ Kbase, const bf16_t* __restrict__ Vbase, int stride,
                                            int kb_lo, int kb_hi, unsigned char* smem, const StageOfs& sof, Compute compute) {
    const int tid = opaque_tid();
    uint4 ra_k0, ra_k1, ra_v0, ra_v1;
    NSA_KV_LOAD(ra_, kb_lo)
    __syncthreads();
    NSA_KV_STORE(ra_, smem, smem + 16384)
    __syncthreads();
    for (int kb = kb_lo; kb <= kb_hi; ++kb) {
        const int buf = (kb - kb_lo) & 1;
        if (kb < kb_hi) NSA_KV_LOAD(ra_, kb + 1)
        compute(kb, smem + buf * 8192, smem + 16384 + buf * 8192);
        if (kb < kb_hi) NSA_KV_STORE(ra_, smem + (buf ^ 1) * 8192, smem + 16384 + (buf ^ 1) * 8192)
        __syncthreads();
    }
}
struct LaneOfs { int k0, k1, vb0, vb1, vb2, vb3; };
__device__ __forceinline__ LaneOfs make_lane_ofs(int lane) {
    LaneOfs f;
    const int r15 = lane & 15, lg = lane >> 4, q = r15 >> 2, pp = r15 & 3;
    f.k0 = r15 * 128 + ((lg ^ (r15 & 7)) << 4);
    f.k1 = r15 * 128 + (((4 + lg) ^ (r15 & 7)) << 4);
    const int sw2 = (2 * (lg & 1) + (q >> 1)) & 3;
    const int vrow = (4 * lg + q) * 128 + pp * 8;
    f.vb0 = vrow + ((0 ^ sw2) << 5); f.vb1 = vrow + ((1 ^ sw2) << 5);
    f.vb2 = vrow + ((2 ^ sw2) << 5); f.vb3 = vrow + ((3 ^ sw2) << 5);
    return f;
}
typedef short s16x4 __attribute__((ext_vector_type(4)));
__device__ __forceinline__ uint2 tr_read(const unsigned char* p) {
    const s16x4 v = __builtin_amdgcn_ds_read_tr16_b64_v4i16((LAS3 s16x4*)p);
    return __builtin_bit_cast(uint2, v);
}
#define NEGM (-1.0e37f)
__device__ __forceinline__ void nsa_scores(const unsigned char* Kl, const LaneOfs& f, const bf16x8& q0, const bf16x8& q1, float bias, f32x4 (&s)[4]) {
#pragma unroll
    for (int kt = 0; kt < 4; ++kt) {
        const bf16x8 a0 = *(const bf16x8*)(Kl + f.k0 + kt * 2048);
        const bf16x8 a1 = *(const bf16x8*)(Kl + f.k1 + kt * 2048);
        f32x4 z = (f32x4){bias, bias, bias, bias};
        z = __builtin_amdgcn_mfma_f32_16x16x32_bf16(a0, q0, z, 0, 0, 0);
        s[kt] = __builtin_amdgcn_mfma_f32_16x16x32_bf16(a1, q1, z, 0, 0, 0);
    }
}
#define ONES_BF16X8 __builtin_bit_cast(bf16x8, make_uint4(0x3F803F80u, 0x3F803F80u, 0x3F803F80u, 0x3F803F80u))
template <class VF>
__device__ __forceinline__ void attn_step(const unsigned char* Kl, const unsigned char* Vl, int lane, const LaneOfs& f,
                                          const bf16x8& q0, const bf16x8& q1, f32x4 (&o)[4], float& m, f32x4& lacc,
                                          float rowbias, bool full, VF valid) {
    f32x4 s[4];
    const bool mok = m > -1e29f;
    const float meff = mok ? m : 0.f;
    nsa_scores(Kl, f, q0, q1, rowbias - meff, s);
    if (!full) {
#pragma unroll
        for (int kt = 0; kt < 4; ++kt)
#pragma unroll
            for (int r = 0; r < 4; ++r) s[kt][r] = valid(kt * 16 + 4 * (lane >> 4) + r) ? s[kt][r] : NEGM;
    }
    float mx = fmaxf(fmaxf(fmaxf(s[0][0], s[0][1]), fmaxf(s[0][2], s[0][3])), fmaxf(fmaxf(s[1][0], s[1][1]), fmaxf(s[1][2], s[1][3])));
    mx = fmaxf(mx, fmaxf(fmaxf(fmaxf(s[2][0], s[2][1]), fmaxf(s[2][2], s[2][3])), fmaxf(fmaxf(s[3][0], s[3][1]), fmaxf(s[3][2], s[3][3]))));
    mx = xrow_max(mx);
    if (!__all(mok && (mx <= 8.f))) {
        const float mn = fmaxf(m, meff + mx);
        const float alpha = __builtin_amdgcn_exp2f(m - mn), d = mn - meff;
        m = mn; lacc[0] *= alpha;
#pragma unroll
        for (int dt = 0; dt < 4; ++dt) { o[dt][0] *= alpha; o[dt][1] *= alpha; o[dt][2] *= alpha; o[dt][3] *= alpha; }
#pragma unroll
        for (int kt = 0; kt < 4; ++kt) { s[kt][0] -= d; s[kt][1] -= d; s[kt][2] -= d; s[kt][3] -= d; }
    }
#pragma unroll
    for (int kt = 0; kt < 4; ++kt)
#pragma unroll
        for (int r = 0; r < 4; ++r) s[kt][r] = __builtin_amdgcn_exp2f(s[kt][r]);
#pragma unroll
    for (int k2 = 0; k2 < 2; ++k2) {
        uint4 pk;
        pk.x = pack2bf(s[2 * k2][0], s[2 * k2][1]); pk.y = pack2bf(s[2 * k2][2], s[2 * k2][3]);
        pk.z = pack2bf(s[2 * k2 + 1][0], s[2 * k2 + 1][1]); pk.w = pack2bf(s[2 * k2 + 1][2], s[2 * k2 + 1][3]);
        const bf16x8 pb = __builtin_bit_cast(bf16x8, pk);
        lacc = __builtin_amdgcn_mfma_f32_16x16x32_bf16(ONES_BF16X8, pb, lacc, 0, 0, 0);
#define PV1(dt_, vb_) { const uint2 lo_ = tr_read(Vl + (vb_) + k2 * 4096), hi_ = tr_read(Vl + (vb_) + k2 * 4096 + 2048); \
                        uint4 av_; av_.x = lo_.x; av_.y = lo_.y; av_.z = hi_.x; av_.w = hi_.y;                          \
                        o[dt_] = __builtin_amdgcn_mfma_f32_16x16x32_bf16(__builtin_bit_cast(bf16x8, av_), pb, o[dt_], 0, 0, 0); }
        PV1(0, f.vb0) PV1(1, f.vb1) PV1(2, f.vb2) PV1(3, f.vb3)
#undef PV1
    }
}
template <class VFA, class VFB>
__device__ __forceinline__ void attn_step2(const unsigned char* Kl, const unsigned char* Vl, int lane, const LaneOfs& f,
                                           const bf16x8& qA0, const bf16x8& qA1, f32x4 (&oA)[4], float& mA, f32x4& lA, float biasA, bool fullA, VFA validA,
                                           const bf16x8& qB0, const bf16x8& qB1, f32x4 (&oB)[4], float& mB, f32x4& lB, float biasB, bool fullB, VFB validB) {
    f32x4 sA[4], sB[4];
    const bool mokA = mA > -1e29f, mokB = mB > -1e29f;
    const float meA = mokA ? mA : 0.f, meB = mokB ? mB : 0.f;
    const float iA = biasA - meA, iB = biasB - meB;
#pragma unroll
    for (int kt = 0; kt < 4; ++kt) {
        const bf16x8 a0 = *(const bf16x8*)(Kl + f.k0 + kt * 2048);
        const bf16x8 a1 = *(const bf16x8*)(Kl + f.k1 + kt * 2048);
        f32x4 zA = (f32x4){iA, iA, iA, iA}, zB = (f32x4){iB, iB, iB, iB};
        zA = __builtin_amdgcn_mfma_f32_16x16x32_bf16(a0, qA0, zA, 0, 0, 0);
        zB = __builtin_amdgcn_mfma_f32_16x16x32_bf16(a0, qB0, zB, 0, 0, 0);
        sA[kt] = __builtin_amdgcn_mfma_f32_16x16x32_bf16(a1, qA1, zA, 0, 0, 0);
        sB[kt] = __builtin_amdgcn_mfma_f32_16x16x32_bf16(a1, qB1, zB, 0, 0, 0);
    }
    if (!fullA) {
#pragma unroll
        for (int kt = 0; kt < 4; ++kt)
#pragma unroll
            for (int r = 0; r < 4; ++r) sA[kt][r] = validA(kt * 16 + 4 * (lane >> 4) + r) ? sA[kt][r] : NEGM;
    }
    if (!fullB) {
#pragma unroll
        for (int kt = 0; kt < 4; ++kt)
#pragma unroll
            for (int r = 0; r < 4; ++r) sB[kt][r] = validB(kt * 16 + 4 * (lane >> 4) + r) ? sB[kt][r] : NEGM;
    }
    float mxA = fmaxf(fmaxf(fmaxf(sA[0][0], sA[0][1]), fmaxf(sA[0][2], sA[0][3])), fmaxf(fmaxf(sA[1][0], sA[1][1]), fmaxf(sA[1][2], sA[1][3])));
    float mxB = fmaxf(fmaxf(fmaxf(sB[0][0], sB[0][1]), fmaxf(sB[0][2], sB[0][3])), fmaxf(fmaxf(sB[1][0], sB[1][1]), fmaxf(sB[1][2], sB[1][3])));
    mxA = fmaxf(mxA, fmaxf(fmaxf(fmaxf(sA[2][0], sA[2][1]), fmaxf(sA[2][2], sA[2][3])), fmaxf(fmaxf(sA[3][0], sA[3][1]), fmaxf(sA[3][2], sA[3][3]))));
    mxB = fmaxf(mxB, fmaxf(fmaxf(fmaxf(sB[2][0], sB[2][1]), fmaxf(sB[2][2], sB[2][3])), fmaxf(fmaxf(sB[3][0], sB[3][1]), fmaxf(sB[3][2], sB[3][3]))));
    mxA = xrow_max(mxA); mxB = xrow_max(mxB);
    if (!__all(mokA && mokB && (mxA <= 8.f) && (mxB <= 8.f))) {
        const float mnA = fmaxf(mA, meA + mxA), mnB = fmaxf(mB, meB + mxB);
        const float alA = __builtin_amdgcn_exp2f(mA - mnA), alB = __builtin_amdgcn_exp2f(mB - mnB);
        const float dA = mnA - meA, dB = mnB - meB;
        mA = mnA; mB = mnB; lA[0] *= alA; lB[0] *= alB;
#pragma unroll
        for (int dt = 0; dt < 4; ++dt) {
            oA[dt][0] *= alA; oA[dt][1] *= alA; oA[dt][2] *= alA; oA[dt][3] *= alA;
            oB[dt][0] *= alB; oB[dt][1] *= alB; oB[dt][2] *= alB; oB[dt][3] *= alB;
        }
#pragma unroll
        for (int kt = 0; kt < 4; ++kt) {
            sA[kt][0] -= dA; sA[kt][1] -= dA; sA[kt][2] -= dA; sA[kt][3] -= dA;
            sB[kt][0] -= dB; sB[kt][1] -= dB; sB[kt][2] -= dB; sB[kt][3] -= dB;
        }
    }
#pragma unroll
    for (int kt = 0; kt < 4; ++kt)
#pragma unroll
        for (int r = 0; r < 4; ++r) { sA[kt][r] = __builtin_amdgcn_exp2f(sA[kt][r]); sB[kt][r] = __builtin_amdgcn_exp2f(sB[kt][r]); }
#pragma unroll
    for (int k2 = 0; k2 < 2; ++k2) {
        uint4 pk;
        pk.x = pack2bf(sA[2 * k2][0], sA[2 * k2][1]); pk.y = pack2bf(sA[2 * k2][2], sA[2 * k2][3]);
        pk.z = pack2bf(sA[2 * k2 + 1][0], sA[2 * k2 + 1][1]); pk.w = pack2bf(sA[2 * k2 + 1][2], sA[2 * k2 + 1][3]);
        const bf16x8 pbA = __builtin_bit_cast(bf16x8, pk);
        pk.x = pack2bf(sB[2 * k2][0], sB[2 * k2][1]); pk.y = pack2bf(sB[2 * k2][2], sB[2 * k2][3]);
        pk.z = pack2bf(sB[2 * k2 + 1][0], sB[2 * k2 + 1][1]); pk.w = pack2bf(sB[2 * k2 + 1][2], sB[2 * k2 + 1][3]);
        const bf16x8 pbB = __builtin_bit_cast(bf16x8, pk);
        lA = __builtin_amdgcn_mfma_f32_16x16x32_bf16(ONES_BF16X8, pbA, lA, 0, 0, 0);
        lB = __builtin_amdgcn_mfma_f32_16x16x32_bf16(ONES_BF16X8, pbB, lB, 0, 0, 0);
#define PV2(dt_, vb_) { const uint2 lo_ = tr_read(Vl + (vb_) + k2 * 4096), hi_ = tr_read(Vl + (vb_) + k2 * 4096 + 2048); \
                        uint4 av_; av_.x = lo_.x; av_.y = lo_.y; av_.z = hi_.x; av_.w = hi_.y;                          \
                        oA[dt_] = __builtin_amdgcn_mfma_f32_16x16x32_bf16(__builtin_bit_cast(bf16x8, av_), pbA, oA[dt_], 0, 0, 0); \
                        oB[dt_] = __builtin_amdgcn_mfma_f32_16x16x32_bf16(__builtin_bit_cast(bf16x8, av_), pbB, oB[dt_], 0, 0, 0); }
        PV2(0, f.vb0) PV2(1, f.vb1) PV2(2, f.vb2) PV2(3, f.vb3)
#undef PV2
    }
}

#define NSA_TILES 2048
__device__ __forceinline__ void nsa_tile(const Params& p, int tile, unsigned char* smem) {
    const int tid = opaque_tid(), lane = tid & 63, w = __builtin_amdgcn_readfirstlane(tid >> 6);
    const int bg = tile & 7, tb = 255 - (tile >> 3);
    const int b = bg >> 1, g = bg & 1;
    const int t0 = tb * 32, cur = t0 >> 6;
    float* impL = (float*)(smem + 32768);
    unsigned* selL = (unsigned*)(smem + 49152);
    const bf16_t* NQ = (const bf16_t*)(p.ws + OFF_NQ);
    const float* NG = (const float*)(p.ws + OFF_NGATE);
    const int rowq = lane & 15, tl = rowq >> 2, head = rowq & 3, lg = lane >> 4;
    const int toklA = 8 * w + tl, toklB = 8 * w + 4 + tl;
    const LaneOfs lof = make_lane_ofs(lane);
    const StageOfs sof = make_stage_ofs();
    const size_t tokb = (size_t)b * SEQ + t0;
    bf16x8 qA0, qA1, qB0, qB1;
    {
        const bf16_t* qp = NQ + (tokb + toklA) * 512 + g * 256 + head * 64 + lg * 8;
        qA0 = *(const bf16x8*)qp; qA1 = *(const bf16x8*)(qp + 32);
        qB0 = *(const bf16x8*)(qp + 4 * 512); qB1 = *(const bf16x8*)(qp + 4 * 512 + 32);
    }
    const float* gpA = NG + (tokb + toklA) * 24 + g * 12 + head * 3;
    const float* gpB = gpA + 4 * 24;
    __syncthreads();
    for (int i = tid; i < 4096; i += 256) impL[i] = 0.f;
    const int tqA = t0 + toklA, tqB = t0 + toklB;
    const int tminA = t0 + 8 * w, tminB = tminA + 4;
    f32x4 oA[4], oB[4], otA[4], otB[4];
    float mA, mB;
    f32x4 lA, lB;
#define NSA_RESET() { _Pragma("unroll") for (int dt = 0; dt < 4; ++dt) { oA[dt] = (f32x4){0.f, 0.f, 0.f, 0.f}; oB[dt] = (f32x4){0.f, 0.f, 0.f, 0.f}; } \
                      mA = -1e30f; mB = -1e30f; lA = (f32x4){0.f, 0.f, 0.f, 0.f}; lB = (f32x4){0.f, 0.f, 0.f, 0.f}; }
#define NSA_LSUM() { }

    const int nvA = (tqA >= 31) ? (((tqA - 31) >> 4) + 1) : 0;
    const int nvB = (tqB >= 31) ? (((tqB - 31) >> 4) + 1) : 0;
    const int nvminA = (tminA >= 31) ? (((tminA - 31) >> 4) + 1) : 0;
    const int nvminB = (tminB >= 31) ? (((tminB - 31) >> 4) + 1) : 0;
    const int nkb = (((t0 >> 4) + 1) + 63) >> 6;
    const bf16_t* ckb = (const bf16_t*)(p.ws + OFF_CMPKB) + (size_t)(b * 2 + g) * 512 * 64;
    const bf16_t* cvb = (const bf16_t*)(p.ws + OFF_CMPVB) + (size_t)(b * 2 + g) * 512 * 64;
    NSA_RESET()
    nsa_kv_loop(ckb, cvb, 64, 0, nkb - 1, smem, sof, [&](int kb, const unsigned char* Kl, const unsigned char* Vl) __attribute__((always_inline)) {
        attn_step2(Kl, Vl, lane, lof,
                   qA0, qA1, oA, mA, lA, 0.f, kb * 64 + 64 <= nvminA, [&](int key) __attribute__((always_inline)) { return kb * 64 + key < nvA; },
                   qB0, qB1, oB, mB, lB, 0.f, kb * 64 + 64 <= nvminB, [&](int key) __attribute__((always_inline)) { return kb * 64 + key < nvB; });
    });
    NSA_LSUM()
    const float mcA = mA, mcB = mB;
    const float invcA = 1.f / fmaxf(lA[0], 1e-30f), invcB = 1.f / fmaxf(lB[0], 1e-30f);
    {
        const float fA = gpA[0] * invcA, fB = gpB[0] * invcB;
#pragma unroll
        for (int dt = 0; dt < 4; ++dt) {
            otA[dt][0] = fA * oA[dt][0]; otA[dt][1] = fA * oA[dt][1]; otA[dt][2] = fA * oA[dt][2]; otA[dt][3] = fA * oA[dt][3];
            otB[dt][0] = fB * oB[dt][0]; otB[dt][1] = fB * oB[dt][1]; otB[dt][2] = fB * oB[dt][2]; otB[dt][3] = fB * oB[dt][3];
        }
    }
    if (cur >= 16) {
        nsa_kv_loop(ckb, cvb, 64, 0, nkb - 1, smem, sof, [&](int kb, const unsigned char* Kl, const unsigned char* Vl) __attribute__((always_inline)) {
#pragma unroll
            for (int mt = 0; mt < 2; ++mt) {
                f32x4 s[4];
                nsa_scores(Kl, lof, mt ? qB0 : qA0, mt ? qB1 : qA1, 0.f, s);
                const int nv = mt ? nvB : nvA;
                const float mc = mt ? mcB : mcA, inv = mt ? invcB : invcA;
                float* impT = impL + (mt ? toklB : toklA) * 128;
#pragma unroll
                for (int kt = 0; kt < 4; ++kt) {
                    float pr[4];
#pragma unroll
                    for (int r = 0; r < 4; ++r) {
                        const int n = kb * 64 + kt * 16 + 4 * lg + r;
                        pr[r] = (n < nv) ? __builtin_amdgcn_exp2f(s[kt][r] - mc) * inv : 0.f;
                    }
                    float c1 = pr[0] + pr[1] + pr[2] + 0.5f * pr[3], c2 = 0.5f * pr[3];
                    c1 += __shfl_xor(c1, 1); c1 += __shfl_xor(c1, 2);
                    c2 += __shfl_xor(c2, 1); c2 += __shfl_xor(c2, 2);
                    const int j = kb * 16 + kt * 4 + lg;
                    if (head == 0) {
                        atomicAdd(&impT[j], c1);
                        if (j + 1 < 128) atomicAdd(&impT[j + 1], c2);
                    }
                }
                    }
        });
#pragma unroll 1
        for (int pass = 0; pass < 2; ++pass) {
            const int tok = 8 * w + 4 * pass + lg, c = lane & 15;
            const float4 i0 = *(const float4*)(impL + tok * 128 + 8 * c), i1 = *(const float4*)(impL + tok * 128 + 8 * c + 4);
            const float iv[8] = {i0.x, i0.y, i0.z, i0.w, i1.x, i1.y, i1.z, i1.w};
            float kl[8];
#pragma unroll
            for (int q = 0; q < 8; ++q) {
                const int j = 8 * c + q;
                const bool forced = (j == 0) || (j == cur) || (j == cur - 1);
                const float sc = forced ? 1.0e4f : ((j <= cur) ? iv[q] : -1.f);
                kl[q] = enc_key(sc, (unsigned)j, 127);
            }
            float l0 = kl[0], l1 = kl[1], l2 = kl[2], l3 = kl[3], l4 = kl[4], l5 = kl[5], l6 = kl[6], l7 = kl[7];
            CE_DESC(l0, l1) CE_DESC(l2, l3) CE_DESC(l4, l5) CE_DESC(l6, l7)
            CE_DESC(l0, l2) CE_DESC(l1, l3) CE_DESC(l4, l6) CE_DESC(l5, l7)
            CE_DESC(l1, l2) CE_DESC(l5, l6)
            CE_DESC(l0, l4) CE_DESC(l1, l5) CE_DESC(l2, l6) CE_DESC(l3, l7)
            CE_DESC(l2, l4) CE_DESC(l3, l5)
            CE_DESC(l1, l2) CE_DESC(l3, l4) CE_DESC(l5, l6)
            unsigned pm = 0u;
#pragma unroll
            for (int k = 0; k < 16; ++k) {
                const float mx = row16_max(l0);
                const bool win = (l0 == mx);
                pm |= win ? (1u << (dec_idx(l0, 127) & 7u)) : 0u;
                l0 = win ? l1 : l0; l1 = win ? l2 : l1; l2 = win ? l3 : l2; l3 = win ? l4 : l3;
                l4 = win ? l5 : l4; l5 = win ? l6 : l5; l6 = win ? l7 : l6; l7 = win ? NEGKEY : l7;
            }
            ((unsigned char*)selL)[tok * 16 + c] = (unsigned char)pm;
        }
    } else {
        if (lane < 8) {
            const int tok = 8 * w + lane;
            selL[tok * 4 + 0] = (2u << cur) - 1u; selL[tok * 4 + 1] = 0u; selL[tok * 4 + 2] = 0u; selL[tok * 4 + 3] = 0u;
        }
    }
    WAVE_LDS_SYNC();
#if NSA_DIAG
    if (head == 0 && lg == 0) {
        unsigned* SELM = (unsigned*)(p.ws + OFF_SELM);
#pragma unroll
        for (int qd = 0; qd < 4; ++qd) {
            SELM[((size_t)bg * SEQ + tqA) * 4 + qd] = selL[toklA * 4 + qd];
            SELM[((size_t)bg * SEQ + tqB) * 4 + qd] = selL[toklB * 4 + qd];
        }
    }
#endif
    NSA_RESET()
    {
        const bf16_t* kg = (const bf16_t*)(p.ws + OFF_KV + 2 * KV_STRIDE) + (size_t)b * SEQ * 128 + g * 64;
        const bf16_t* vg = (const bf16_t*)(p.ws + OFF_KV + 3 * KV_STRIDE) + (size_t)b * SEQ * 128 + g * 64;
        nsa_kv_loop(kg, vg, 128, 0, cur, smem, sof, [&](int kb, const unsigned char* Kl, const unsigned char* Vl) __attribute__((always_inline)) {
            const bool svA = (selL[toklA * 4 + (kb >> 5)] >> (kb & 31)) & 1u;
            const bool svB = (selL[toklB * 4 + (kb >> 5)] >> (kb & 31)) & 1u;
            const bool nA = __ballot(svA) != 0ull, nB = __ballot(svB) != 0ull;
            if (nA && nB)
                attn_step2(Kl, Vl, lane, lof,
                           qA0, qA1, oA, mA, lA, svA ? 0.f : NEGM, kb < cur, [&](int key) __attribute__((always_inline)) { return kb * 64 + key <= tqA; },
                           qB0, qB1, oB, mB, lB, svB ? 0.f : NEGM, kb < cur, [&](int key) __attribute__((always_inline)) { return kb * 64 + key <= tqB; });
            else if (nA)
                attn_step(Kl, Vl, lane, lof, qA0, qA1, oA, mA, lA, svA ? 0.f : NEGM, kb < cur, [&](int key) __attribute__((always_inline)) { return kb * 64 + key <= tqA; });
            else if (nB)
                attn_step(Kl, Vl, lane, lof, qB0, qB1, oB, mB, lB, svB ? 0.f : NEGM, kb < cur, [&](int key) __attribute__((always_inline)) { return kb * 64 + key <= tqB; });
        });
    }
    NSA_LSUM()
    {
        const float fA = gpA[1] / fmaxf(lA[0], 1e-30f), fB = gpB[1] / fmaxf(lB[0], 1e-30f);
#pragma unroll
        for (int dt = 0; dt < 4; ++dt) {
            otA[dt][0] += fA * oA[dt][0]; otA[dt][1] += fA * oA[dt][1]; otA[dt][2] += fA * oA[dt][2]; otA[dt][3] += fA * oA[dt][3];
            otB[dt][0] += fB * oB[dt][0]; otB[dt][1] += fB * oB[dt][1]; otB[dt][2] += fB * oB[dt][2]; otB[dt][3] += fB * oB[dt][3];
        }
    }
    NSA_RESET()
    {
        const bf16_t* kg = (const bf16_t*)(p.ws + OFF_KV + 4 * KV_STRIDE) + (size_t)b * SEQ * 128 + g * 64;
        const bf16_t* vg = (const bf16_t*)(p.ws + OFF_KV + 5 * KV_STRIDE) + (size_t)b * SEQ * 128 + g * 64;
        const int klo = (t0 > 511) ? ((t0 - 511) >> 6) : 0;
        nsa_kv_loop(kg, vg, 128, klo, cur, smem, sof, [&](int kb, const unsigned char* Kl, const unsigned char* Vl) __attribute__((always_inline)) {
            attn_step2(Kl, Vl, lane, lof,
                       qA0, qA1, oA, mA, lA, 0.f, (kb * 64 >= tminA + 3 - 511) && (kb * 64 + 63 <= tminA),
                       [&](int key) __attribute__((always_inline)) { const int ka = kb * 64 + key; return (ka <= tqA) && (ka >= tqA - 511); },
                       qB0, qB1, oB, mB, lB, 0.f, (kb * 64 >= tminB + 3 - 511) && (kb * 64 + 63 <= tminB),
                       [&](int key) __attribute__((always_inline)) { const int ka = kb * 64 + key; return (ka <= tqB) && (ka >= tqB - 511); });
        });
    }
    NSA_LSUM()
    {
        const float fA = gpA[2] / fmaxf(lA[0], 1e-30f), fB = gpB[2] / fmaxf(lB[0], 1e-30f);
        bf16_t* MIX = (bf16_t*)(p.ws + OFF_XB) + (tokb + toklA) * DM + 512 + g * 256 + head * 64 + lg * 4;
#pragma unroll
        for (int dt = 0; dt < 4; ++dt) {
            uint2 ov;
            ov.x = pack2bf(otA[dt][0] + fA * oA[dt][0], otA[dt][1] + fA * oA[dt][1]);
            ov.y = pack2bf(otA[dt][2] + fA * oA[dt][2], otA[dt][3] + fA * oA[dt][3]);
            *(uint2*)(MIX + dt * 16) = ov;
            ov.x = pack2bf(otB[dt][0] + fB * oB[dt][0], otB[dt][1] + fB * oB[dt][1]);
            ov.y = pack2bf(otB[dt][2] + fB * oB[dt][2], otB[dt][3] + fB * oB[dt][3]);
            *(uint2*)(MIX + 4 * DM + dt * 16) = ov;
        }
    }
#undef NSA_RESET
#undef NSA_LSUM
}

__device__ __forceinline__ float block_sum(float v, float* red) {
    v = wave_sum(v);
    __syncthreads();
    if ((threadIdx.x & 63) == 0) red[threadIdx.x >> 6] = v;
    __syncthreads();
    return red[0] + red[1] + red[2] + red[3];
}
__device__ __forceinline__ float4 ln_row(float4 y, const float* g, const float* bb, float* red) {
    const int tid = opaque_tid();
    const float mu = block_sum(y.x + y.y + y.z + y.w, red) * (1.f / 1024.f);
    const float dx = y.x - mu, dy = y.y - mu, dz = y.z - mu, dw = y.w - mu;
    const float var = block_sum(dx * dx + dy * dy + dz * dz + dw * dw, red) * (1.f / 1024.f);
    const float rs = rsqrtf(var + LN_EPS);
    const float4 gg = ((const float4*)g)[tid], b4 = ((const float4*)bb)[tid];
    return make_float4(dx * rs * gg.x + b4.x, dy * rs * gg.y + b4.y, dz * rs * gg.z + b4.z, dw * rs * gg.w + b4.w);
}

__device__ __forceinline__ void ln1_phase(const Params& p, float* sm) {
    const int tid = opaque_tid(), lane = tid & 63, w = __builtin_amdgcn_readfirstlane(tid >> 6);
    const float4* g4 = (const float4*)(p.in[15] + 16 * lane);
    const float4* b4 = (const float4*)(p.in[16] + 16 * lane);
    const float4 ga = g4[0], gb = g4[1], gc = g4[2], gd = g4[3];
    const float4 ba = b4[0], bb = b4[1], bc = b4[2], bd = b4[3];
#pragma unroll 2
    for (int n = blockIdx.x * 4 + w; n < NTOK; n += gridDim.x * 4) {
        const float4* xr = (const float4*)(p.in[0] + (size_t)n * DM + 16 * lane);
        const uint4* mr = (const uint4*)((const bf16_t*)p.out + (size_t)n * DM + 16 * lane);
        const float4 y0 = xr[0], y1 = xr[1], y2 = xr[2], y3 = xr[3];
        const uint4 m0 = mr[0], m1 = mr[1];
        float y[16] = {ALPHA * y0.x + bf2f(m0.x & 0xffffu), ALPHA * y0.y + bf2f(m0.x >> 16), ALPHA * y0.z + bf2f(m0.y & 0xffffu), ALPHA * y0.w + bf2f(m0.y >> 16),
                       ALPHA * y1.x + bf2f(m0.z & 0xffffu), ALPHA * y1.y + bf2f(m0.z >> 16), ALPHA * y1.z + bf2f(m0.w & 0xffffu), ALPHA * y1.w + bf2f(m0.w >> 16),
                       ALPHA * y2.x + bf2f(m1.x & 0xffffu), ALPHA * y2.y + bf2f(m1.x >> 16), ALPHA * y2.z + bf2f(m1.y & 0xffffu), ALPHA * y2.w + bf2f(m1.y >> 16),
                       ALPHA * y3.x + bf2f(m1.z & 0xffffu), ALPHA * y3.y + bf2f(m1.z >> 16), ALPHA * y3.z + bf2f(m1.w & 0xffffu), ALPHA * y3.w + bf2f(m1.w >> 16)};
        const float g[16] = {ga.x, ga.y, ga.z, ga.w, gb.x, gb.y, gb.z, gb.w, gc.x, gc.y, gc.z, gc.w, gd.x, gd.y, gd.z, gd.w};
        const float bv[16] = {ba.x, ba.y, ba.z, ba.w, bb.x, bb.y, bb.z, bb.w, bc.x, bc.y, bc.z, bc.w, bd.x, bd.y, bd.z, bd.w};
        float sum = 0.f;
#pragma unroll
        for (int q = 0; q < 16; ++q) sum += y[q];
        const float mu = wave_sum(sum) * (1.f / 1024.f);
        float sq = 0.f;
#pragma unroll
        for (int q = 0; q < 16; ++q) { y[q] -= mu; sq += y[q] * y[q]; }
        const float rs = rsqrtf(wave_sum(sq) * (1.f / 1024.f) + LN_EPS);
        uint4 o0, o1;
        o0.x = pack2bf(y[0] * rs * g[0] + bv[0], y[1] * rs * g[1] + bv[1]);     o0.y = pack2bf(y[2] * rs * g[2] + bv[2], y[3] * rs * g[3] + bv[3]);
        o0.z = pack2bf(y[4] * rs * g[4] + bv[4], y[5] * rs * g[5] + bv[5]);     o0.w = pack2bf(y[6] * rs * g[6] + bv[6], y[7] * rs * g[7] + bv[7]);
        o1.x = pack2bf(y[8] * rs * g[8] + bv[8], y[9] * rs * g[9] + bv[9]);     o1.y = pack2bf(y[10] * rs * g[10] + bv[10], y[11] * rs * g[11] + bv[11]);
        o1.z = pack2bf(y[12] * rs * g[12] + bv[12], y[13] * rs * g[13] + bv[13]); o1.w = pack2bf(y[14] * rs * g[14] + bv[14], y[15] * rs * g[15] + bv[15]);
        uint4* hb = (uint4*)((bf16_t*)(p.ws + OFF_XB) + (size_t)n * DM + 16 * lane);
        hb[0] = o0; hb[1] = o1;
    }
}


typedef float f32x2 __attribute__((ext_vector_type(2)));
__device__ __forceinline__ void cvt_rows_fp8(const float* __restrict__ src, unsigned char* __restrict__ dst, float* __restrict__ scales, int rows,
                                             int first_block, int nblocks) {
    const int tid_ = opaque_tid(), lane = tid_ & 63, w = __builtin_amdgcn_readfirstlane(tid_ >> 6);
    for (int r = ((int)blockIdx.x - first_block) * 4 + w; r < rows; r += nblocks * 4) {
        const float4* sp = (const float4*)(src + (size_t)r * 1024 + lane * 16);
        const float4 a = sp[0], b = sp[1], c = sp[2], d = sp[3];
        float mx = fmaxf(fmaxf(fmaxf(fabsf(a.x), fabsf(a.y)), fmaxf(fabsf(a.z), fabsf(a.w))), fmaxf(fmaxf(fabsf(b.x), fabsf(b.y)), fmaxf(fabsf(b.z), fabsf(b.w))));
        mx = fmaxf(mx, fmaxf(fmaxf(fmaxf(fabsf(c.x), fabsf(c.y)), fmaxf(fabsf(c.z), fabsf(c.w))), fmaxf(fmaxf(fabsf(d.x), fabsf(d.y)), fmaxf(fabsf(d.z), fabsf(d.w)))));
        mx = wave_max(mx);
        const float sc = (mx > 0.f) ? mx * (1.f / 448.f) : 1.f;
        const float inv = 1.f / sc;
        uint4 o;
        int t;
        t = 0; t = __builtin_amdgcn_cvt_pk_fp8_f32(a.x * inv, a.y * inv, t, false); t = __builtin_amdgcn_cvt_pk_fp8_f32(a.z * inv, a.w * inv, t, true); o.x = (unsigned)t;
        t = 0; t = __builtin_amdgcn_cvt_pk_fp8_f32(b.x * inv, b.y * inv, t, false); t = __builtin_amdgcn_cvt_pk_fp8_f32(b.z * inv, b.w * inv, t, true); o.y = (unsigned)t;
        t = 0; t = __builtin_amdgcn_cvt_pk_fp8_f32(c.x * inv, c.y * inv, t, false); t = __builtin_amdgcn_cvt_pk_fp8_f32(c.z * inv, c.w * inv, t, true); o.z = (unsigned)t;
        t = 0; t = __builtin_amdgcn_cvt_pk_fp8_f32(d.x * inv, d.y * inv, t, false); t = __builtin_amdgcn_cvt_pk_fp8_f32(d.z * inv, d.w * inv, t, true); o.w = (unsigned)t;
        *(uint4*)(dst + (size_t)r * 1024 + lane * 16) = o;
        if (lane == 0) scales[r] = sc;
    }
}

__device__ __forceinline__ unsigned pack4i8(float a, float b, float c, float d) {
    const int ia = (int)rintf(a), ib = (int)rintf(b), ic = (int)rintf(c), id = (int)rintf(d);
    return (unsigned)(ia & 255) | ((unsigned)(ib & 255) << 8) | ((unsigned)(ic & 255) << 16) | ((unsigned)id << 24);
}
__device__ __forceinline__ void cvt_rows_i8(const float* __restrict__ src, unsigned char* __restrict__ dst, float* __restrict__ scales, int rows,
                                            int first_block, int nblocks) {
    const int tid_ = opaque_tid(), lane = tid_ & 63, w = __builtin_amdgcn_readfirstlane(tid_ >> 6);
    for (int r = ((int)blockIdx.x - first_block) * 4 + w; r < rows; r += nblocks * 4) {
        const float4* sp = (const float4*)(src + (size_t)r * 1024 + lane * 16);
        const float4 a = sp[0], b = sp[1], c = sp[2], d = sp[3];
        float mx = fmaxf(fmaxf(fmaxf(fabsf(a.x), fabsf(a.y)), fmaxf(fabsf(a.z), fabsf(a.w))), fmaxf(fmaxf(fabsf(b.x), fabsf(b.y)), fmaxf(fabsf(b.z), fabsf(b.w))));
        mx = fmaxf(mx, fmaxf(fmaxf(fmaxf(fabsf(c.x), fabsf(c.y)), fmaxf(fabsf(c.z), fabsf(c.w))), fmaxf(fmaxf(fabsf(d.x), fabsf(d.y)), fmaxf(fabsf(d.z), fabsf(d.w)))));
        mx = wave_max(mx);
        const float sc = (mx > 0.f) ? mx * (1.f / 127.f) : 1.f;
        const float inv = 1.f / sc;
        uint4 o;
        o.x = pack4i8(a.x * inv, a.y * inv, a.z * inv, a.w * inv); o.y = pack4i8(b.x * inv, b.y * inv, b.z * inv, b.w * inv);
        o.z = pack4i8(c.x * inv, c.y * inv, c.z * inv, c.w * inv); o.w = pack4i8(d.x * inv, d.y * inv, d.z * inv, d.w * inv);
        *(uint4*)(dst + (size_t)r * 1024 + lane * 16) = o;
        if (lane == 0) scales[r] = sc;
    }
}

__device__ __forceinline__ void fold_ws_phase(const float* __restrict__ wq, const float* __restrict__ k1, const float* __restrict__ k2,
                                              bf16_t* __restrict__ WsT) {
    for (int it = blockIdx.x * 256 + threadIdx.x; it < 2048 * 128; it += gridDim.x * 256) {
        const int r = it & 2047, kg = it >> 11;
        const int a = (r >> 7) & 1, j = r & 127;
        const float* kr = (a ? k2 : k1) + j * 128;
        const float* wr = wq + (size_t)(kg * 8) * 2048 + (r & ~127);
        float s[8];
#pragma unroll
        for (int q = 0; q < 8; ++q) s[q] = 0.f;
        for (int d = 0; d < 128; d += 4) {
            const float4 kv = *(const float4*)(kr + d);
#pragma unroll
            for (int q = 0; q < 8; ++q) {
                const float4 wv = *(const float4*)(wr + (size_t)q * 2048 + d);
                s[q] += wv.x * kv.x + wv.y * kv.y + wv.z * kv.z + wv.w * kv.w;
            }
        }
        uint4 o;
        o.x = pack2bf(s[0], s[1]); o.y = pack2bf(s[2], s[3]); o.z = pack2bf(s[4], s[5]); o.w = pack2bf(s[6], s[7]);
        *(uint4*)(WsT + (size_t)r * 1024 + kg * 8) = o;
    }
}


struct EpiTop16 {
    static constexpr bool kRow = false;
    float* topk; unsigned char* lds;
    __device__ __forceinline__ void operator()(int m, int n, f32x4 v) const {
        const int ml = m & 127, g4 = (n & 127) >> 2;
        *(float4*)(lds + ((ml * 32 + (g4 ^ (ml & 7))) << 4)) = make_float4(v[0], v[1], v[2], v[3]);
    }
    template <class F> __device__ __forceinline__ void dispatch(int, F f) const { f(*this); }
    __device__ __forceinline__ void finish(int m0, int n0) const {
        __syncthreads();
        const int tid_ = opaque_tid(), lane = tid_ & 63, w = __builtin_amdgcn_readfirstlane(tid_ >> 6), c = lane & 15;
        const int L = n0 >> 7;
        for (int it = 0; it < 8; ++it) {
            const int r = w * 32 + it * 4 + (lane >> 4);
            const float4 x0 = *(const float4*)(lds + ((r * 32 + ((2 * c) ^ (r & 7))) << 4));
            const float4 x1 = *(const float4*)(lds + ((r * 32 + ((2 * c + 1) ^ (r & 7))) << 4));
            float l0 = enc_key(x0.x, 8 * c + 0, 127), l1 = enc_key(x0.y, 8 * c + 1, 127), l2 = enc_key(x0.z, 8 * c + 2, 127),
                  l3 = enc_key(x0.w, 8 * c + 3, 127), l4 = enc_key(x1.x, 8 * c + 4, 127), l5 = enc_key(x1.y, 8 * c + 5, 127),
                  l6 = enc_key(x1.z, 8 * c + 6, 127), l7 = enc_key(x1.w, 8 * c + 7, 127);
            CE_DESC(l0, l1) CE_DESC(l2, l3) CE_DESC(l4, l5) CE_DESC(l6, l7)
            CE_DESC(l0, l2) CE_DESC(l1, l3) CE_DESC(l4, l6) CE_DESC(l5, l7)
            CE_DESC(l1, l2) CE_DESC(l5, l6)
            CE_DESC(l0, l4) CE_DESC(l1, l5) CE_DESC(l2, l6) CE_DESC(l3, l7)
            CE_DESC(l2, l4) CE_DESC(l3, l5)
            CE_DESC(l1, l2) CE_DESC(l3, l4) CE_DESC(l5, l6)
            float res = NEGKEY;
#pragma unroll
            for (int k = 0; k < 16; ++k) {
                const float mx = row16_max(l0);
                const bool win = (l0 == mx);
                l0 = win ? l1 : l0; l1 = win ? l2 : l1; l2 = win ? l3 : l2; l3 = win ? l4 : l3;
                l4 = win ? l5 : l4; l5 = win ? l6 : l5; l6 = win ? l7 : l6; l7 = win ? NEGKEY : l7;
                res = (c == k) ? mx : res;
            }
            topk[(size_t)(m0 + r) * 256 + L * 16 + c] = res;
        }
        __syncthreads();
    }
};

template <int PART>
__device__ __forceinline__ void peer_fast_phase(const Params& p, unsigned char* smem) {
    const int tid = opaque_tid(), lane = tid & 63, w = __builtin_amdgcn_readfirstlane(tid >> 6), l16 = lane & 15, gq = lane >> 4;
    float* tk = (float*)(smem + w * 2048);
    int* ex = (int*)(smem + w * 2048 + 1024);
    float* gw = (float*)(smem + w * 2048 + 1536);
    const bf16_t* H1B = (const bf16_t*)(p.ws + OFF_XB);
    const unsigned char* U8 = p.ws + OFF_UB;
    const unsigned char* V8 = p.ws + OFF_VB;
    const float* USC = (const float*)(p.ws + OFF_USC);
    const float* VSC = (const float*)(p.ws + OFF_VSC);
    const float* TOPK = (const float*)(p.ws + OFF_TOPK);
    int ci[4], cj[4];
#pragma unroll
    for (int q = 0; q < 4; ++q) {
        const int s = l16 + 16 * q;
        int i, j;
        if (s < 16) { i = 0; j = s; }
        else if (s < 24) { i = 1; j = s - 16; }
        else if (s < 29) { i = 2; j = s - 24; }
        else if (s < 33) { i = 3; j = s - 29; }
        else if (s < 36) { i = 4; j = s - 33; }
        else if (s < 42) { i = 5 + ((s - 36) >> 1); j = (s - 36) & 1; }
        else if (s < 50) { i = 8 + (s - 42); j = 0; }
        else { i = -1; j = 0; }
        ci[q] = i; cj[q] = j;
    }
    int* exs = (int*)(smem + 8192 + w * 4096);
    float* gws = (float*)(smem + 8192 + w * 4096 + 2048);
    float* hraw = (float*)(smem + 24576 + w * 2048);
    float* xsc = (float*)(smem + w * 2048);
    int* SEX = (int*)(p.ws + OFF_HQ);
    float* SGW = (float*)(p.ws + OFF_HLF);
    for (int qd = blockIdx.x * 4 + w; qd < NTOK / 4; qd += gridDim.x * 4) {
        const int n0 = qd * 4;
        if (PART == 0) {
        float4 tkn = ((const float4*)(TOPK + (size_t)n0 * 256))[lane];
#pragma unroll 1
        for (int t = 0; t < 4; ++t) {
            const int n = n0 + t;
            WAVE_LDS_SYNC();
            ((float4*)tk)[lane] = tkn;
            {
                int nn = (t < 3) ? n + 1 : (qd + (int)gridDim.x * 4) * 4;
                nn = (nn < NTOK) ? nn : n;
                tkn = ((const float4*)(TOPK + (size_t)nn * 256))[lane];
            }
            WAVE_LDS_SYNC();
#pragma unroll
            for (int it = 0; it < 2; ++it) {
                const int head = it * 4 + gq;
                const float* ka = tk + head * 32;
                const float* kb = ka + 16;
                float c0, c1, c2, c3;
#define MKC(q, cq) { if (ci[q] >= 0) { const float sum_ = dec_val(ka[ci[q]], 127) + dec_val(kb[cj[q]], 127); \
                         cq = enc_key(sum_, ci[q] * 16 + cj[q], 255); } else cq = NEGKEY; }
                MKC(0, c0) MKC(1, c1) MKC(2, c2) MKC(3, c3)
#undef MKC
                float res = NEGKEY;
#pragma unroll
                for (int k = 0; k < 16; ++k) {
                    const float mx = row16_max(fmaxf(fmaxf(c0, c1), fmaxf(c2, c3)));
                    c0 = (c0 == mx) ? NEGKEY : c0; c1 = (c1 == mx) ? NEGKEY : c1;
                    c2 = (c2 == mx) ? NEGKEY : c2; c3 = (c3 == mx) ? NEGKEY : c3;
                    res = (l16 == k) ? mx : res;
                }
                const unsigned cc = dec_idx(res, 255);
                const float val = dec_val(res, 255);
                const unsigned e1 = dec_idx(ka[cc >> 4], 127), e2 = dec_idx(kb[cc & 15], 127);
                const float m0 = row16_max(val);
                const float e = expf(val - m0);
                const float ssum = row16_sum(e);
                ex[head * 16 + l16] = (int)(e1 * 128 + e2);
                gw[head * 16 + l16] = e / ssum;
            }
            WAVE_LDS_SYNC();
            {
                const int e0 = ex[lane], e1v = ex[lane + 64];
                const float g0 = gw[lane], g1 = gw[lane + 64];
                const int s0 = e0 >> 11, s1 = e1v >> 11;
                const unsigned long long lt = (1ull << lane) - 1ull;
                int base = 0, p0 = 0, p1 = 0;
#pragma unroll
                for (int s = 0; s < 8; ++s) {
                    const unsigned long long m0 = __ballot(s0 == s), m1 = __ballot(s1 == s);
                    const int c0 = __popcll(m0), c1 = __popcll(m1);
                    if (s0 == s) p0 = base + __popcll(m0 & lt);
                    if (s1 == s) p1 = base + c0 + __popcll(m1 & lt);
                    base += c0 + c1;
                }
                exs[t * 128 + p0] = e0; gws[t * 128 + p0] = g0; exs[t * 128 + p1] = e1v; gws[t * 128 + p1] = g1;
            }
        }
        WAVE_LDS_SYNC();
#pragma unroll
        for (int i = 0; i < 2; ++i) {
            ((uint4*)(SEX + (size_t)n0 * 128))[lane + 64 * i] = ((const uint4*)exs)[lane + 64 * i];
            ((uint4*)(SGW + (size_t)n0 * 128))[lane + 64 * i] = ((const uint4*)gws)[lane + 64 * i];
        }
        } else {
        WAVE_LDS_SYNC();
#pragma unroll
        for (int i = 0; i < 2; ++i) {
            ((uint4*)exs)[lane + 64 * i] = ((const uint4*)(SEX + (size_t)n0 * 128))[lane + 64 * i];
            ((uint4*)gws)[lane + 64 * i] = ((const uint4*)(SGW + (size_t)n0 * 128))[lane + 64 * i];
        }
        }
        if (PART == 1) {
        WAVE_LDS_SYNC();
        {
            int xq[16];
            {
                const uint4* xr = (const uint4*)(H1B + (size_t)(n0 + gq) * DM + 16 * l16);
                uint4 xa0 = xr[0], xb0 = xr[1], xa1 = xr[32], xb1 = xr[33], xa2 = xr[64], xb2 = xr[65], xa3 = xr[96], xb3 = xr[97];
#define BLO(u_) __uint_as_float((u_) << 16)
#define BHI(u_) __uint_as_float((u_) & 0xffff0000u)
#define AMX4(v_) fmaxf(fmaxf(fmaxf(fabsf(BLO((v_).x)), fabsf(BHI((v_).x))), fmaxf(fabsf(BLO((v_).y)), fabsf(BHI((v_).y)))),                  \
                       fmaxf(fmaxf(fabsf(BLO((v_).z)), fabsf(BHI((v_).z))), fmaxf(fabsf(BLO((v_).w)), fabsf(BHI((v_).w)))))
                float mx = fmaxf(fmaxf(fmaxf(AMX4(xa0), AMX4(xb0)), fmaxf(AMX4(xa1), AMX4(xb1))), fmaxf(fmaxf(AMX4(xa2), AMX4(xb2)), fmaxf(AMX4(xa3), AMX4(xb3))));
                mx = row16_max(mx);
                const float xs = (mx > 0.f) ? mx * (1.f / 127.f) : 1.f;
                const float inv = 1.f / xs;
                xsc[gq] = xs;
#define Q8(i_, va_, vb_) { xq[4 * (i_) + 0] = (int)pack4i8(BLO((va_).x) * inv, BHI((va_).x) * inv, BLO((va_).y) * inv, BHI((va_).y) * inv);   \
                           xq[4 * (i_) + 1] = (int)pack4i8(BLO((va_).z) * inv, BHI((va_).z) * inv, BLO((va_).w) * inv, BHI((va_).w) * inv);   \
                           xq[4 * (i_) + 2] = (int)pack4i8(BLO((vb_).x) * inv, BHI((vb_).x) * inv, BLO((vb_).y) * inv, BHI((vb_).y) * inv);   \
                           xq[4 * (i_) + 3] = (int)pack4i8(BLO((vb_).z) * inv, BHI((vb_).z) * inv, BLO((vb_).w) * inv, BHI((vb_).w) * inv); }
                Q8(0, xa0, xb0) Q8(1, xa1, xb1) Q8(2, xa2, xb2) Q8(3, xa3, xb3)
#undef Q8
#undef AMX4
#undef BLO
#undef BHI
            }
            uint4 ra0, ra1, ra2, ra3, rb0, rb1, rb2, rb3, rc0, rc1, rc2, rc3, rd0, rd1, rd2, rd3;
#define ULOAD(S, kk) { const int e_ = exs[gq * 128 + (kk)]; const uint4* ur_ = (const uint4*)(U8 + (size_t)e_ * DM + 16 * l16);          \
                       S##0 = ur_[0]; S##1 = ur_[16]; S##2 = ur_[32]; S##3 = ur_[48]; }
#define D4(W_, B_) { sA = __builtin_amdgcn_sdot4((int)(W_).x, xq[(B_)], sA, false); sB = __builtin_amdgcn_sdot4((int)(W_).y, xq[(B_) + 1], sB, false); \
                     sA = __builtin_amdgcn_sdot4((int)(W_).z, xq[(B_) + 2], sA, false); sB = __builtin_amdgcn_sdot4((int)(W_).w, xq[(B_) + 3], sB, false); }
#define UCOMP(S, kk) { int sA = 0, sB = 0; D4(S##0, 0) D4(S##1, 4) D4(S##2, 8) D4(S##3, 12)                                               \
                       hraw[gq * 128 + (kk)] = row16_sum((float)(sA + sB)); }
            ULOAD(ra, 0) ULOAD(rb, 1) ULOAD(rc, 2)
#pragma unroll 1
            for (int k = 0; k < 128; k += 4) {
                const int kn = (k + 4 < 128) ? k + 4 : 124;
                ULOAD(rd, k + 3)  UCOMP(ra, k)
                ULOAD(ra, kn)     UCOMP(rb, k + 1)
                ULOAD(rb, kn + 1) UCOMP(rc, k + 2)
                ULOAD(rc, kn + 2) UCOMP(rd, k + 3)
            }
#undef D4
#undef ULOAD
#undef UCOMP
        }
        WAVE_LDS_SYNC();
#pragma unroll
        for (int j = 0; j < 8; ++j) {
            const int idx = lane + 64 * j;
            const int e = exs[idx];
            gws[idx] = gws[idx] * gelu_tanh_fast(hraw[idx] * (xsc[idx >> 7] * USC[e])) * VSC[e];
        }
        WAVE_LDS_SYNC();
#pragma unroll
        for (int i = 0; i < 2; ++i) ((uint4*)(SGW + (size_t)n0 * 128))[lane + 64 * i] = ((const uint4*)gws)[lane + 64 * i];
        }
        if (PART == 2) {
        WAVE_LDS_SYNC();
        {
            f32x2 acc[32];
#pragma unroll
            for (int q = 0; q < 32; ++q) acc[q] = (f32x2){0.f, 0.f};
            uint4 ra0, ra1, ra2, ra3, rb0, rb1, rb2, rb3, rc0, rc1, rc2, rc3, rd0, rd1, rd2, rd3;
#define VLOAD(S, kk) { const int e_ = exs[gq * 128 + (kk)]; const uint4* vr_ = (const uint4*)(V8 + (size_t)e_ * DM + 16 * l16);          \
                       S##0 = vr_[0]; S##1 = vr_[16]; S##2 = vr_[32]; S##3 = vr_[48]; }
#define A4(W_, B_) { acc[(B_)] = __builtin_elementwise_fma(__builtin_amdgcn_cvt_pk_f32_fp8((int)(W_), false), wk2, acc[(B_)]);          \
                     acc[(B_) + 1] = __builtin_elementwise_fma(__builtin_amdgcn_cvt_pk_f32_fp8((int)(W_), true), wk2, acc[(B_) + 1]); }
#define VCOMP(S, kk) { const float wk = gws[gq * 128 + (kk)]; const f32x2 wk2 = (f32x2){wk, wk};                                         \
                       A4((S##0).x, 0) A4((S##0).y, 2) A4((S##0).z, 4) A4((S##0).w, 6) A4((S##1).x, 8) A4((S##1).y, 10) A4((S##1).z, 12) A4((S##1).w, 14) \
                       A4((S##2).x, 16) A4((S##2).y, 18) A4((S##2).z, 20) A4((S##2).w, 22) A4((S##3).x, 24) A4((S##3).y, 26) A4((S##3).z, 28) A4((S##3).w, 30) }
            VLOAD(ra, 0) VLOAD(rb, 1) VLOAD(rc, 2)
#pragma unroll 1
            for (int k = 0; k < 128; k += 4) {
                const int kn = (k + 4 < 128) ? k + 4 : 124;
                VLOAD(rd, k + 3)  VCOMP(ra, k)
                VLOAD(ra, kn)     VCOMP(rb, k + 1)
                VLOAD(rb, kn + 1) VCOMP(rc, k + 2)
                VLOAD(rc, kn + 2) VCOMP(rd, k + 3)
            }
#undef VLOAD
#undef VCOMP
#undef A4
            float* orow = p.out + (size_t)(n0 + gq) * DM + 16 * l16;
            float sum = 0.f;
#pragma unroll
            for (int c = 0; c < 4; ++c)
#pragma unroll
                for (int hq = 0; hq < 4; ++hq) {
                    const uint2 hb_ = *(const uint2*)(H1B + (size_t)(n0 + gq) * DM + 16 * l16 + 256 * c + 4 * hq);
                    const float4 h = make_float4(__uint_as_float(hb_.x << 16), __uint_as_float(hb_.x & 0xffff0000u),
                                                 __uint_as_float(hb_.y << 16), __uint_as_float(hb_.y & 0xffff0000u));
                    f32x2& pa = acc[8 * c + 2 * hq]; f32x2& pb = acc[8 * c + 2 * hq + 1];
                    pa[0] = ALPHA * h.x + pa[0]; pa[1] = ALPHA * h.y + pa[1]; pb[0] = ALPHA * h.z + pb[0]; pb[1] = ALPHA * h.w + pb[1];
                    sum += (pa[0] + pa[1]) + (pb[0] + pb[1]);
                }
            const float mu = row16_sum(sum) * (1.f / 1024.f);
            float sq = 0.f;
#pragma unroll
            for (int q = 0; q < 32; ++q) { acc[q][0] -= mu; acc[q][1] -= mu; sq += acc[q][0] * acc[q][0] + acc[q][1] * acc[q][1]; }
            const float rs = rsqrtf(row16_sum(sq) * (1.f / 1024.f) + LN_EPS);
            const float* g = p.in[22] + 16 * l16;
            const float* bb = p.in[23] + 16 * l16;
#pragma unroll
            for (int c = 0; c < 4; ++c)
#pragma unroll
                for (int hq = 0; hq < 4; ++hq) {
                    const float4 gg = *(const float4*)(g + 256 * c + 4 * hq), b4 = *(const float4*)(bb + 256 * c + 4 * hq);
                    const f32x2 pa = acc[8 * c + 2 * hq], pb = acc[8 * c + 2 * hq + 1];
                    float4 o;
                    o.x = pa[0] * rs * gg.x + b4.x; o.y = pa[1] * rs * gg.y + b4.y;
                    o.z = pb[0] * rs * gg.z + b4.z; o.w = pb[1] * rs * gg.w + b4.w;
                    *(float4*)(orow + 256 * c + 4 * hq) = o;
                }
        }
        }
    }
}

#define XB_TMO      128
#define XB_XCNT(j)  (256  + 64 * (j))
#define XB_XSUB(j)  (1280 + 64 * (j))
#define XB_XGEN(j)  (2304 + 64 * (j))
#define XB_TOP      3328
#define XB_TOPGEN   3392
#define XCD_BAR_WORDS 3456
#define XB_SPIN_CAP (1u << 22)
__device__ __forceinline__ unsigned xb_ld(unsigned* p) { return __hip_atomic_load(p, __ATOMIC_RELAXED, __HIP_MEMORY_SCOPE_AGENT); }
__device__ __forceinline__ unsigned xb_add(unsigned* p, unsigned v) { return __hip_atomic_fetch_add(p, v, __ATOMIC_RELAXED, __HIP_MEMORY_SCOPE_AGENT); }
__device__ __forceinline__ unsigned xb_xcc_id() { return (unsigned)__builtin_amdgcn_s_getreg((3 << 11) | 20) & 0xFu; }
#define XB_SPIN(cond, bar) do { unsigned _sp = 0; while (cond) { __builtin_amdgcn_s_sleep(1); \
    if ((++_sp & 255u) == 0u) { if (xb_ld(&(bar)[XB_TMO])) break; if (_sp > XB_SPIN_CAP) { atomicAdd(&(bar)[XB_TMO], 1u); break; } } } } while (0)
struct XcdBarrier { unsigned* bar; unsigned x; unsigned* st; };
__device__ __forceinline__ XcdBarrier xcd_barrier_post(unsigned* bar, unsigned* st) {
    XcdBarrier b; b.bar = bar; b.x = xb_xcc_id(); b.st = st;
    if (threadIdx.x == 0) (void)xb_add(&bar[XB_XCNT(b.x)], 1u);
    return b;
}
__device__ __forceinline__ void xcd_barrier_complete(unsigned* bar, unsigned x, unsigned& nloc, unsigned& nx) {
    const unsigned G = gridDim.x * gridDim.y * gridDim.z;
    unsigned sum, cnt, mine, sp = 0u;
    for (;;) {
        sum = 0u; cnt = 0u; mine = 0u;
#pragma unroll
        for (unsigned j = 0; j < 16; ++j) { const unsigned c = xb_ld(&bar[XB_XCNT(j)]); sum += c; cnt += (c > 0u) ? 1u : 0u; mine = (j == x) ? c : mine; }
        if (sum == G) break;
        __builtin_amdgcn_s_sleep(1);
        if ((++sp & 255u) == 0u) { if (xb_ld(&bar[XB_TMO])) break; if (sp > XB_SPIN_CAP) { atomicAdd(&bar[XB_TMO], 1u); break; } }
    }
    nloc = mine > 0u ? mine : 1u; nx = cnt > 0u ? cnt : 1u;
}
__device__ __forceinline__ void xcd_barrier(const XcdBarrier& b) {
    asm volatile("s_waitcnt vmcnt(0)" ::: "memory");
    __syncthreads();
    if (threadIdx.x == 0) {
        unsigned* bar = b.bar;
        __builtin_amdgcn_s_waitcnt(0);
        unsigned nloc = xb_ld(&b.st[0]), nx = xb_ld(&b.st[1]);
        if (nloc == 0u) { xcd_barrier_complete(bar, b.x, nloc, nx); __hip_atomic_store(&b.st[0], nloc, __ATOMIC_RELAXED, __HIP_MEMORY_SCOPE_AGENT); __hip_atomic_store(&b.st[1], nx, __ATOMIC_RELAXED, __HIP_MEMORY_SCOPE_AGENT); }
        const unsigned old = xb_add(&bar[XB_XSUB(b.x)], 1u);
        const unsigned gen = old / nloc;
        if (old + 1u == (gen + 1u) * nloc) {
            __builtin_amdgcn_fence(__ATOMIC_RELEASE, "agent");
            asm volatile("s_waitcnt vmcnt(0)" ::: "memory");
            const unsigned og = xb_add(&bar[XB_TOP], 1u);
            const unsigned tg = og / nx;
            if (og + 1u == (tg + 1u) * nx) xb_add(&bar[XB_TOPGEN], 1u);
            else XB_SPIN(xb_ld(&bar[XB_TOPGEN]) == tg, bar);
            __builtin_amdgcn_fence(__ATOMIC_ACQUIRE, "agent");
            xb_add(&bar[XB_XGEN(b.x)], 1u);
            asm volatile("s_waitcnt vmcnt(0)" ::: "memory");
        } else {
            XB_SPIN(xb_ld(&bar[XB_XGEN(b.x)]) == gen, bar);
            __builtin_amdgcn_fence(__ATOMIC_ACQUIRE, "agent");
            asm volatile("s_waitcnt vmcnt(0)" ::: "memory");
        }
    }
    __syncthreads();
}

__global__ void __launch_bounds__(256, 2) mega(Params p) {
    cg::grid_group grid = cg::this_grid();
    __shared__ __attribute__((aligned(16))) unsigned char smem[81920];
    float* sm = (float*)smem;
    unsigned* barw = (unsigned*)(p.ws + OFF_BAR);
    const XcdBarrier xbar = xcd_barrier_post(barw, barw + XCD_BAR_WORDS + 2 * blockIdx.x);
    bf16_t* XB = (bf16_t*)(p.ws + OFF_XB);
    bf16_t* WinT = (bf16_t*)(p.ws + OFF_WINT);
    bf16_t* WoutT = (bf16_t*)(p.ws + OFF_WOUTT);
    bf16_t* WqT = (bf16_t*)(p.ws + OFF_WQT);
    cvt_rows_bf16(p.in[0], XB, (size_t)NTOK * DM / 8);
    transpose_bf16(p.in[1], DIN, 3456, WinT);
    transpose_bf16(p.in[2], DM, DM, WoutT);
    fold_ws_phase(p.in[17], p.in[18], p.in[19], WqT);
    transpose_bf16(p.in[6], 256, 256, (bf16_t*)(p.ws + OFF_W1T), 2048);
    transpose_bf16(p.in[11], 256, 256, (bf16_t*)(p.ws + OFF_W1T) + 256 * 2048, 2048);
    if (blockIdx.x == 0) {
        for (int c = threadIdx.x; c < 512; c += 256)
            ((float*)(p.ws + OFF_LBV))[c] = 1.f / (1.f + expf(p.in[3][512 + c] - p.in[3][c]));
        if (threadIdx.x < 16) ((float*)(p.ws + OFF_DIAG))[threadIdx.x] = 0.f;
    }
    if (blockIdx.x >= 8 && blockIdx.x < 72) cmp_peb_partial(p, blockIdx.x - 8);
    grid.sync();
    if (blockIdx.x == gridDim.x - 1) cmp_peb_reduce(p);
    gemm_bf16_phase3(XB, DM, WinT, DM, NTOK / 256, 27, smem, EpiProj{p.ws});
    xcd_barrier(xbar);
    for (int it = blockIdx.x; it < 128; it += gridDim.x) {
        const int which = it >> 6, t = it & 63;
        gemm_tile(ALoadCmp{(const bf16_t*)(p.ws + OFF_KV + (size_t)which * KV_STRIDE)},
                  (const bf16_t*)(p.ws + OFF_W1T) + (size_t)which * 256 * 2048, 2048, 32, (t >> 1) * 128, (t & 1) * 128, smem,
                  EpiCmpH{(bf16_t*)(p.ws + OFF_HB) + (size_t)which * 4096 * 256, (const float*)(p.ws + OFF_PEB) + which * 256});
    }
    if (gridDim.x >= 256) {
        if (blockIdx.x >= 128)
            for (int it = blockIdx.x - 128; it < 2048; it += gridDim.x - 128) hgrn_passA(p, it, smem);
    } else {
        for (int it = blockIdx.x; it < 2048; it += gridDim.x) hgrn_passA(p, it, smem);
    }
#if NSA_DIAG
    for (int it = blockIdx.x; it < 2 * 4 * NCB * 2; it += gridDim.x) compress_item(p, it, sm);
#endif
    xcd_barrier(xbar);
    if (blockIdx.x < 256) hgrn_scan_item(p, blockIdx.x);
    else {
        cvt_rows_i8(p.in[20], p.ws + OFF_UB, (float*)(p.ws + OFF_USC), 16384, 256, gridDim.x - 256);
        cvt_rows_fp8(p.in[21], p.ws + OFF_VB, (float*)(p.ws + OFF_VSC), 16384, 256, gridDim.x - 256);
    }
    if (gridDim.x <= 256) {
        cvt_rows_i8(p.in[20], p.ws + OFF_UB, (float*)(p.ws + OFF_USC), 16384, 0, gridDim.x);
        cvt_rows_fp8(p.in[21], p.ws + OFF_VB, (float*)(p.ws + OFF_VSC), 16384, 0, gridDim.x);
    }
    cmp_layer2_phase(p, 0, gridDim.x);
    xcd_barrier(xbar);
    {
        const int qi = blockIdx.x & 7;
        unsigned* qctr = barw + XCD_BAR_WORDS + 2 * 1024 + 64 * qi;
        for (;;) {
            __syncthreads();
            if (threadIdx.x == 0) *(volatile unsigned*)smem = atomicAdd(qctr, 1u);
            __syncthreads();
            const int it = (int)__builtin_amdgcn_readfirstlane(*(volatile unsigned*)smem);
            if (it >= 256) break;
            nsa_tile(p, (it << 3) | qi, smem);
        }
        for (;;) {
            __syncthreads();
            if (threadIdx.x == 0) *(volatile unsigned*)smem = atomicAdd(qctr + 32, 1u);
            __syncthreads();
            const int it = (int)__builtin_amdgcn_readfirstlane(*(volatile unsigned*)smem);
            if (it >= 256) break;
            hgrn_passC(p, (it << 3) | qi, smem);
        }
    }
    xcd_barrier(xbar);
#if NSA_DIAG
    for (int it = blockIdx.x; it < 4 * 2 * SEQ; it += gridDim.x) nsa_item(p, it, sm);
    grid.sync();
    {
        const float* DG = (const float*)(p.ws + OFF_DIAG);
#if NSA_DIAG == 1
        const float cval = -log10f(sqrtf(DG[0] / DG[1]) + 1e-9f);
#else
        const float cval = -log10f(DG[2] / DG[3] + 1e-6f);
#endif
        for (size_t i = (size_t)blockIdx.x * 256 + threadIdx.x; i < (size_t)NTOK * DM; i += (size_t)gridDim.x * 256) p.out[i] = cval;
        return;
    }
#endif
    gemm_bf16_phase3(XB, DM, WoutT, DM, NTOK / 256, 8, smem, EpiMix{(bf16_t*)p.out});
    xcd_barrier(xbar);
    ln1_phase(p, sm);
    xcd_barrier(xbar);
    gemm_bf16_phase3(XB, DM, WqT, DM, NTOK / 256, 16, smem, EpiTop16{(float*)(p.ws + OFF_TOPK), smem});
    xcd_barrier(xbar);
    peer_fast_phase<0>(p, smem);
    peer_fast_phase<1>(p, smem);
    peer_fast_phase<2>(p, smem);
}

extern "C" void kernel_launch(void* const* d_in, const int* in_sizes, int n_in, void* d_out, int out_size,
                              void* d_ws, size_t ws_size, hipStream_t stream) {
    static int grid_blocks = 0;
    if (!grid_blocks) {
        int dev = 0, cus = 0, per_cu = 0;
        hipGetDevice(&dev);
        hipDeviceGetAttribute(&cus, hipDeviceAttributeMultiprocessorCount, dev);
        hipOccupancyMaxActiveBlocksPerMultiprocessor(&per_cu, mega, 256, 0);
        if (per_cu > 4) per_cu = 4;
        if (per_cu < 1) per_cu = 1;
        grid_blocks = cus * per_cu;
        if (n_in != 24 || ws_size < WS_NEED || out_size != NTOK * DM)
            fprintf(stderr, "kernel_launch: unexpected sizes n_in=%d ws=%zu out=%d\n", n_in, ws_size, out_size);
    }
    Params p;
    memset(&p, 0, sizeof(p));
    for (int i = 0; i < 24; ++i) p.in[i] = (const float*)d_in[i];
    p.out = (float*)d_out;
    p.ws = (unsigned char*)d_ws;
    hipMemsetAsync((char*)d_ws + OFF_BAR, 0, BAR_BYTES, stream);
    void* args[] = {&p};
    hipError_t e = hipLaunchCooperativeKernel((void*)mega, dim3(grid_blocks), dim3(256), args, 0, stream);
    if (e != hipSuccess) fprintf(stderr, "cooperative launch failed: %s (grid %d)\n", hipGetErrorString(e), grid_blocks);
}
```

```cpp
#include <hip/hip_runtime.h>
#include <hip/hip_cooperative_groups.h>
#include <cstdio>
#include <cstring>
namespace cg = cooperative_groups;

#define NTOK 32768
#define SEQ 8192
#define DM 1024
#define DIN 3352
#define NCB 511
#define ALPHA 1.189207115002721f
#define LN_EPS 1e-5f

#define MB_ 1048576ull
#define OFF_XB 0ull
#define OFF_HQ (64 * MB_)
#define OFF_HLF (96 * MB_)
#define OFF_HI (160 * MB_)
#define OFF_HG (192 * MB_)
#define OFF_NQ (224 * MB_)
#define OFF_KV (256 * MB_)
#define KV_STRIDE (8 * MB_)
#define OFF_NGATE (304 * MB_)
#define OFF_CMPK (308 * MB_)
#define OFF_CMPV (309 * MB_)
#define OFF_WINT (310 * MB_)
#define OFF_WOUTT (317 * MB_)
#define OFF_WQT (319 * MB_)
#define OFF_LBV (323 * MB_)
#define OFF_DC (324 * MB_)
#define OFF_SC (325 * MB_)
#define OFF_UB (389 * MB_)
#define OFF_VB (421 * MB_)
#define OFF_TOPK (453 * MB_)
#define OFF_HREF OFF_TOPK
#define OFF_W1T (485 * MB_)
#define OFF_HB (487 * MB_)
#define OFF_CMPKB (491 * MB_)
#define OFF_CMPVB (491 * MB_ + 524288ull)
#define OFF_PEB (492 * MB_)
#define OFF_SELM (493 * MB_)
#define OFF_DIAG (494 * MB_)
#define OFF_USC (494 * MB_ + 131072ull)
#define OFF_VSC (494 * MB_ + 196608ull)
#define OFF_BAR (494 * MB_ + 65536ull)
#define BAR_BYTES 32768
#define WS_NEED (495 * MB_)
#define USE_NSA_MFMA 1
#define NSA_DIAG 0

struct Params {
    const float* in[24];
    float* out;
    unsigned char* ws;
};

typedef float f32x16 __attribute__((ext_vector_type(16)));
#define WAVE_LDS_SYNC() asm volatile("s_waitcnt lgkmcnt(0)" ::: "memory")
#define LAS3 __attribute__((address_space(3)))

__device__ __forceinline__ int opaque_tid() { int t = threadIdx.x; asm volatile("" : "+v"(t)); return t; }
__device__ __forceinline__ float wave_sum(float v) {
#pragma unroll
    for (int o = 32; o; o >>= 1) v += __shfl_xor(v, o);
    return v;
}
__device__ __forceinline__ float wave_max(float v) {
#pragma unroll
    for (int o = 32; o; o >>= 1) v = fmaxf(v, __shfl_xor(v, o));
    return v;
}
__device__ __forceinline__ float sigmoidf_(float x) { return 1.f / (1.f + expf(-x)); }
__device__ __forceinline__ float exp_fast(float x) { return __builtin_amdgcn_exp2f(1.4426950408889634f * x); }
__device__ __forceinline__ float sigmoid_fast(float x) { return __builtin_amdgcn_rcpf(1.f + __builtin_amdgcn_exp2f(-1.4426950408889634f * x)); }
__device__ __forceinline__ float log_fast(float x) { return 0.6931471805599453f * __builtin_amdgcn_logf(x); }
__device__ __forceinline__ float gelu_tanh_fast(float x) {
    const float u = 0.7978845608028654f * (x + 0.044715f * x * x * x);
    return x * __builtin_amdgcn_rcpf(1.f + __builtin_amdgcn_exp2f(-2.885390081777927f * u));
}
__device__ __forceinline__ float gelu_tanh(float x) {
    const float c = 0.7978845608028654f;
    return 0.5f * x * (1.f + tanhf(c * (x + 0.044715f * x * x * x)));
}

typedef short bf16x8 __attribute__((ext_vector_type(8)));
typedef float f32x4 __attribute__((ext_vector_type(4)));
typedef unsigned short bf16_t;

typedef __bf16 bf16x2_t __attribute__((ext_vector_type(2)));
__device__ __forceinline__ unsigned pack2bf(float lo, float hi) {
    bf16x2_t v; v[0] = (__bf16)lo; v[1] = (__bf16)hi;
    return __builtin_bit_cast(unsigned, v);
}
__device__ __forceinline__ unsigned f2bf(float f) { return pack2bf(f, 0.f) & 0xffffu; }
__device__ __forceinline__ float bf2f(unsigned h) { return __uint_as_float(h << 16); }

__device__ __forceinline__ void cvt_rows_bf16(const float* __restrict__ src, bf16_t* __restrict__ dst, size_t n8) {
    for (size_t i = (size_t)blockIdx.x * 256 + threadIdx.x; i < n8; i += (size_t)gridDim.x * 256) {
        const float4 a = ((const float4*)src)[2 * i], b = ((const float4*)src)[2 * i + 1];
        uint4 o;
        o.x = pack2bf(a.x, a.y); o.y = pack2bf(a.z, a.w); o.z = pack2bf(b.x, b.y); o.w = pack2bf(b.z, b.w);
        ((uint4*)dst)[i] = o;
    }
}
__device__ __forceinline__ void transpose_bf16(const float* __restrict__ src, int Nsrc, int Npad, bf16_t* __restrict__ dst, int K = 1024) {
    const size_t total = (size_t)Npad * (K / 8);
    for (size_t i = (size_t)blockIdx.x * 256 + threadIdx.x; i < total; i += (size_t)gridDim.x * 256) {
        const int n = (int)(i % Npad), kg = (int)(i / Npad);
        float v[8];
#pragma unroll
        for (int j = 0; j < 8; ++j) v[j] = (n < Nsrc) ? src[(size_t)(kg * 8 + j) * Nsrc + n] : 0.f;
        uint4 o;
        o.x = pack2bf(v[0], v[1]); o.y = pack2bf(v[2], v[3]); o.z = pack2bf(v[4], v[5]); o.w = pack2bf(v[6], v[7]);
        *(uint4*)(dst + (size_t)n * K + kg * 8) = o;
    }
}

struct ALoadStd {
    const bf16_t* A; int lda;
    __device__ __forceinline__ const bf16_t* ptr(int row, int ks) const { return A + (size_t)row * lda + ks * 64; }
};
struct ALoadCmp {
    const bf16_t* KC;
    __device__ __forceinline__ const bf16_t* ptr(int row, int ks) const {
        const int r = row < 4088 ? row : 4087;
        const int g = r & 1, bn = r >> 1, n = bn % NCB, b = bn / NCB;
        return KC + ((size_t)(b * SEQ + 16 * n + ks) * 128 + g * 64);
    }
};
#define GLDS1(i, ks, buf) { const int row_ = 8 * w + 32 * (i) + (lane >> 3);                                                    \
        __builtin_amdgcn_global_load_lds((const unsigned*)(aload.ptr(m0 + row_, (ks)) + (((lane & 7) ^ (lane >> 3)) << 3)),      \
                                         (LAS3 unsigned*)(lds + (buf) * 32768 + w * 1024 + (i) * 4096), 16, 0, 0);              \
        __builtin_amdgcn_global_load_lds((const unsigned*)(Bp + (size_t)row_ * ldb + (ks) * 64 + (((lane & 7) ^ (lane >> 3)) << 3)), \
                                         (LAS3 unsigned*)(lds + (buf) * 32768 + 16384 + w * 1024 + (i) * 4096), 16, 0, 0); }
#define GEMM_GLDS(ks, buf) { GLDS1(0, ks, buf) GLDS1(1, ks, buf) GLDS1(2, ks, buf) GLDS1(3, ks, buf) }
template <class ALoad, class Epi>
__device__ __forceinline__ void gemm_tile(const ALoad aload, const bf16_t* __restrict__ Bt, int ldb, int KS, int m0, int n0,
                                          unsigned char* lds, Epi epi) {
    const int tid = opaque_tid(), lane = tid & 63, w = __builtin_amdgcn_readfirstlane(tid >> 6), wm = w >> 1, wn = w & 1;
    f32x4 acc[4][4];
#pragma unroll
    for (int j = 0; j < 4; ++j)
#pragma unroll
        for (int i = 0; i < 4; ++i) acc[j][i] = (f32x4){0.f, 0.f, 0.f, 0.f};
    const bf16_t* Bp = Bt + (size_t)n0 * ldb;
    __syncthreads();
    GEMM_GLDS(0, 0)
    asm volatile("s_waitcnt vmcnt(0)" ::: "memory");
    __syncthreads();
    for (int ks = 0; ks < KS; ++ks) {
        if (ks + 1 < KS) GEMM_GLDS(ks + 1, (ks + 1) & 1)
        const unsigned char* la = lds + (ks & 1) * 32768;
        const unsigned char* lb = la + 16384;
#pragma unroll
        for (int s = 0; s < 2; ++s) {
            bf16x8 af[4], wf[4];
            const int ch = s * 4 + (lane >> 4);
#pragma unroll
            for (int i = 0; i < 4; ++i) {
                const int row = wm * 64 + i * 16 + (lane & 15);
                af[i] = *(const bf16x8*)(la + row * 128 + ((ch ^ (row & 7)) << 4));
            }
#pragma unroll
            for (int j = 0; j < 4; ++j) {
                const int row = wn * 64 + j * 16 + (lane & 15);
                wf[j] = *(const bf16x8*)(lb + row * 128 + ((ch ^ (row & 7)) << 4));
            }
#pragma unroll
            for (int j = 0; j < 4; ++j)
#pragma unroll
                for (int i = 0; i < 4; ++i)
                    acc[j][i] = __builtin_amdgcn_mfma_f32_16x16x32_bf16(wf[j], af[i], acc[j][i], 0, 0, 0);
        }
        asm volatile("s_waitcnt vmcnt(0)" ::: "memory");
        __syncthreads();
    }
#pragma unroll
    for (int j = 0; j < 4; ++j)
#pragma unroll
        for (int i = 0; i < 4; ++i)
            epi(m0 + wm * 64 + i * 16 + (lane & 15), n0 + wn * 64 + j * 16 + (lane >> 4) * 4, acc[j][i]);
    epi.finish(m0, n0);
}
template <class Epi>
__device__ __forceinline__ void gemm_bf16_phase(const bf16_t* __restrict__ A, int lda, const bf16_t* __restrict__ Bt, int ldb,
                                                int Mtiles, int Ntiles, unsigned char* lds, Epi epi) {
    if ((gridDim.x & 7) == 0 && (Mtiles & 31) == 0) {
        const int x = blockIdx.x & 7, j = blockIdx.x >> 3, nb = gridDim.x >> 3;
        const int per = (Mtiles >> 3) * Ntiles;
        for (int q = j; q < per; q += nb) {
            const int s = q / (4 * Ntiles), rem = q - s * (4 * Ntiles);
            const int c = rem >> 2, r = rem & 3;
            const int mt = x + 8 * (4 * s + r);
            gemm_tile(ALoadStd{A, lda}, Bt, ldb, 16, mt * 128, c * 128, lds, epi);
        }
    } else {
        for (int tile = blockIdx.x; tile < Mtiles * Ntiles; tile += gridDim.x) {
            const int mt = tile / Ntiles, nt = tile % Ntiles;
            gemm_tile(ALoadStd{A, lda}, Bt, ldb, 16, mt * 128, nt * 128, lds, epi);
        }
    }
}


#define G3_STAGE 24576
#define G3A(i, ks, st) __builtin_amdgcn_global_load_lds((const unsigned*)(pa + (size_t)(64 * (i)) * lda + (ks) * 32),                     \
                                                        (LAS3 unsigned*)(lds + (st) + (w + 4 * (i)) * 1024), 16, 0, 0);
#define G3B(i, ks, st) __builtin_amdgcn_global_load_lds((const unsigned*)(pb + (size_t)(64 * (i)) * ldb + (ks) * 32),                     \
                                                        (LAS3 unsigned*)(lds + (st) + 16384 + (w + 4 * (i)) * 1024), 16, 0, 0);
#define G3MF(j, i) acc[j][i] = __builtin_amdgcn_mfma_f32_16x16x32_bf16(wf[j], af[i], acc[j][i], 0, 0, 0);
#define G3MF4(j, i) G3MF(j, i) G3MF(j, (i) + 1) G3MF(j, (i) + 2) G3MF(j, (i) + 3)
#define G3SB __builtin_amdgcn_sched_barrier(0);
#define G3_BODY(LOADS, KS) {                                                                                                              \
        const unsigned char* la = lds + st0 + wm * 8192 + fofs;                                                                           \
        const unsigned char* lb = lds + st0 + 16384 + wn * 4096 + fofs;                                                                   \
        bf16x8 af[8], wf[4];                                                                                                              \
        wf[0] = *(const bf16x8*)(lb);                                                                                                     \
        af[0] = *(const bf16x8*)(la);            af[1] = *(const bf16x8*)(la + 1024); af[2] = *(const bf16x8*)(la + 2048);                \
        af[3] = *(const bf16x8*)(la + 3072);     af[4] = *(const bf16x8*)(la + 4096); af[5] = *(const bf16x8*)(la + 5120);                \
        af[6] = *(const bf16x8*)(la + 6144);     af[7] = *(const bf16x8*)(la + 7168);                                                     \
        wf[1] = *(const bf16x8*)(lb + 1024);     wf[2] = *(const bf16x8*)(lb + 2048); wf[3] = *(const bf16x8*)(lb + 3072);                \
        G3SB                                                                                                                              \
        G3MF4(0, 0) if (LOADS) { G3A(0, (KS) + 2, st2) } G3SB                                                                             \
        G3MF4(0, 4) if (LOADS) { G3A(1, (KS) + 2, st2) } G3SB                                                                             \
        G3MF4(1, 0) if (LOADS) { G3A(2, (KS) + 2, st2) } G3SB                                                                             \
        G3MF4(1, 4) if (LOADS) { G3A(3, (KS) + 2, st2) } G3SB                                                                             \
        G3MF4(2, 0) if (LOADS) { G3B(0, (KS) + 2, st2) } G3SB                                                                             \
        G3MF4(2, 4) if (LOADS) { G3B(1, (KS) + 2, st2) } G3SB                                                                             \
        G3MF4(3, 0) G3MF4(3, 4) }
template <class Epi>
__device__ __forceinline__ void gemm_tile3(const bf16_t* __restrict__ A, int lda, const bf16_t* __restrict__ Bt, int ldb, int m0, int n0,
                                           unsigned char* lds, Epi epi) {
    const int tid = opaque_tid(), lane = tid & 63, w = __builtin_amdgcn_readfirstlane(tid >> 6), wm = w >> 1, wn = w & 1;
    f32x4 acc[4][8];
#pragma unroll
    for (int j = 0; j < 4; ++j)
#pragma unroll
        for (int i = 0; i < 8; ++i) acc[j][i] = (f32x4){0.f, 0.f, 0.f, 0.f};
    const int r15 = lane & 15, g4 = lane >> 4;
    const int fofs = r15 * 64 + ((g4 ^ ((0 - (r15 >> 2)) & 3)) << 4);
    const int lch = ((lane & 3) ^ ((0 - (lane >> 4)) & 3)) << 3;
    const bf16_t* pa = A + (size_t)(m0 + 16 * w + (lane >> 2)) * lda + lch;
    const bf16_t* pb = Bt + (size_t)(n0 + 16 * w + (lane >> 2)) * ldb + lch;
    __syncthreads();
    G3A(0, 0, 0) G3A(1, 0, 0) G3A(2, 0, 0) G3A(3, 0, 0) G3B(0, 0, 0) G3B(1, 0, 0)
    G3A(0, 1, G3_STAGE) G3A(1, 1, G3_STAGE) G3A(2, 1, G3_STAGE) G3A(3, 1, G3_STAGE) G3B(0, 1, G3_STAGE) G3B(1, 1, G3_STAGE)
    int st0 = 0, st1 = G3_STAGE, st2 = 2 * G3_STAGE;
#pragma unroll 1
    for (int ks = 0; ks < 30; ++ks) {
        asm volatile("s_waitcnt vmcnt(6)" ::: "memory");
        __builtin_amdgcn_s_barrier();
        asm volatile("" ::: "memory");
        G3_BODY(1, ks)
        const int t_ = st0; st0 = st1; st1 = st2; st2 = t_;
    }
    asm volatile("s_waitcnt vmcnt(6)" ::: "memory");
    __builtin_amdgcn_s_barrier();
    asm volatile("" ::: "memory");
    G3_BODY(0, 30)
    st0 = st1;
    asm volatile("s_waitcnt vmcnt(0)" ::: "memory");
    __builtin_amdgcn_s_barrier();
    asm volatile("" ::: "memory");
    G3_BODY(0, 31)
    __syncthreads();
    if constexpr (Epi::kRow) {
        const int mrow = m0 + wm * 128 + r15, ncol = n0 + wn * 64;
        epi.dispatch(n0, [&](auto e) {
            if constexpr (decltype(e)::kBf16) {
#pragma unroll
                for (int i = 0; i < 8; ++i)
#pragma unroll
                    for (int j = 0; j < 4; j += 2) {
                        uint2 a = e.pack4(acc[j][i]), b = e.pack4(acc[j + 1][i]);
                        auto sx = __builtin_amdgcn_permlane16_swap(a.x, b.x, false, false);
                        auto sy = __builtin_amdgcn_permlane16_swap(a.y, b.y, false, false);
                        e.store8(mrow + i * 16, ncol + (j + (g4 & 1)) * 16 + (g4 >> 1) * 8, make_uint4(sx[0], sy[0], sx[1], sy[1]));
                    }
            } else {
#pragma unroll
                for (int i = 0; i < 8; ++i)
#pragma unroll
                    for (int j = 0; j < 4; ++j)
                        e.row4(mrow + i * 16, ncol + j * 16 + g4 * 4, make_float4(acc[j][i][0], acc[j][i][1], acc[j][i][2], acc[j][i][3]));
            }
        });
    } else {
#pragma unroll
        for (int hh = 0; hh < 2; ++hh) {
            if (wm == hh) {
#pragma unroll
                for (int j = 0; j < 4; ++j)
#pragma unroll
                    for (int i = 0; i < 8; ++i)
                        epi(m0 + wm * 128 + i * 16 + (lane & 15), n0 + wn * 64 + j * 16 + (lane >> 4) * 4, acc[j][i]);
            }
            epi.finish(m0 + hh * 128, n0);
        }
    }
}

#define G3PA(PA, i, k, st) __builtin_amdgcn_global_load_lds((const unsigned*)((PA) + (size_t)(64 * (i)) * lda + (k) * 32),                 \
                                                            (LAS3 unsigned*)(lds + (st) + (w + 4 * (i)) * 1024), 16, 0, 0);
#define G3PB(PB, i, k, st) __builtin_amdgcn_global_load_lds((const unsigned*)((PB) + (size_t)(64 * (i)) * ldb + (k) * 32),                 \
                                                            (LAS3 unsigned*)(lds + (st) + 16384 + (w + 4 * (i)) * 1024), 16, 0, 0);
#define G3P_BODY(PA, PB, KIDX) {                                                                                                          \
        const unsigned char* la = lds + st0 + wm * 8192 + fofs;                                                                           \
        const unsigned char* lb = lds + st0 + 16384 + wn * 4096 + fofs;                                                                   \
        bf16x8 af[8], wf[4];                                                                                                              \
        wf[0] = *(const bf16x8*)(lb);                                                                                                     \
        af[0] = *(const bf16x8*)(la);            af[1] = *(const bf16x8*)(la + 1024); af[2] = *(const bf16x8*)(la + 2048);                \
        af[3] = *(const bf16x8*)(la + 3072);     af[4] = *(const bf16x8*)(la + 4096); af[5] = *(const bf16x8*)(la + 5120);                \
        af[6] = *(const bf16x8*)(la + 6144);     af[7] = *(const bf16x8*)(la + 7168);                                                     \
        wf[1] = *(const bf16x8*)(lb + 1024);     wf[2] = *(const bf16x8*)(lb + 2048); wf[3] = *(const bf16x8*)(lb + 3072);                \
        G3SB                                                                                                                              \
        G3MF4(0, 0) G3PA(PA, 0, KIDX, st2) G3SB                                                                                           \
        G3MF4(0, 4) G3PA(PA, 1, KIDX, st2) G3SB                                                                                           \
        G3MF4(1, 0) G3PA(PA, 2, KIDX, st2) G3SB                                                                                           \
        G3MF4(1, 4) G3PA(PA, 3, KIDX, st2) G3SB                                                                                           \
        G3MF4(2, 0) G3PB(PB, 0, KIDX, st2) G3SB                                                                                           \
        G3MF4(2, 4) G3PB(PB, 1, KIDX, st2) G3SB                                                                                           \
        G3MF4(3, 0) G3MF4(3, 4)                                                                                                           \
        { const int t_ = st0; st0 = st1; st1 = st2; st2 = t_; } }
#define G3P_SYNC(N) { asm volatile("s_waitcnt vmcnt(" #N ")" ::: "memory"); __builtin_amdgcn_s_barrier(); asm volatile("" ::: "memory"); }
#define G3P_BAR     { __builtin_amdgcn_s_barrier(); asm volatile("" ::: "memory"); }
template <class Epi>
__device__ __forceinline__ void gemm_phase_pipelined(const bf16_t* __restrict__ A, int lda, const bf16_t* __restrict__ Bt, int ldb,
                                                     int Mtiles  , int Ntiles, unsigned char* lds, Epi epi) {
    const int tid = opaque_tid(), lane = tid & 63, w = __builtin_amdgcn_readfirstlane(tid >> 6), wm = w >> 1, wn = w & 1;
    const int r15 = lane & 15, g4 = lane >> 4;
    const int fofs = r15 * 64 + ((g4 ^ ((0 - (r15 >> 2)) & 3)) << 4);
    const int lch = ((lane & 3) ^ ((0 - (lane >> 4)) & 3)) << 3;
    const int x = blockIdx.x & 7, jb = blockIdx.x >> 3, nb = gridDim.x >> 3;
    const int per = (Mtiles >> 3) * Ntiles;
    int q = jb;
    if (q >= per) return;
    int m0, n0;
#define G3P_TILE(Q, M0, N0) { const int s_ = (Q) / (2 * Ntiles), rem_ = (Q) - s_ * (2 * Ntiles); M0 = (x + 8 * (2 * s_ + (rem_ & 1))) * 256; N0 = (rem_ >> 1) * 128; }
    G3P_TILE(q, m0, n0)
    const bf16_t* pa = A + (size_t)(m0 + 16 * w + (lane >> 2)) * lda + lch;
    const bf16_t* pb = Bt + (size_t)(n0 + 16 * w + (lane >> 2)) * ldb + lch;
    int st0 = 0, st1 = G3_STAGE, st2 = 2 * G3_STAGE;
    __syncthreads();
    G3PA(pa, 0, 0, 0) G3PA(pa, 1, 0, 0) G3PA(pa, 2, 0, 0) G3PA(pa, 3, 0, 0) G3PB(pb, 0, 0, 0) G3PB(pb, 1, 0, 0)
    G3PA(pa, 0, 1, G3_STAGE) G3PA(pa, 1, 1, G3_STAGE) G3PA(pa, 2, 1, G3_STAGE) G3PA(pa, 3, 1, G3_STAGE) G3PB(pb, 0, 1, G3_STAGE) G3PB(pb, 1, 1, G3_STAGE)
    asm volatile("s_waitcnt vmcnt(0)" ::: "memory");
    for (;;) {
        const int qn = (q + nb < per) ? q + nb : q;
        int m0n, n0n;
        G3P_TILE(qn, m0n, n0n)
        const bf16_t* pan = A + (size_t)(m0n + 16 * w + (lane >> 2)) * lda + lch;
        const bf16_t* pbn = Bt + (size_t)(n0n + 16 * w + (lane >> 2)) * ldb + lch;
        f32x4 acc[4][8];
#pragma unroll
        for (int j = 0; j < 4; ++j)
#pragma unroll
            for (int i = 0; i < 8; ++i) acc[j][i] = (f32x4){0.f, 0.f, 0.f, 0.f};
        G3P_BAR      G3P_BODY(pa, pb, 2)
        G3P_BAR      G3P_BODY(pa, pb, 3)
#pragma unroll 1
        for (int ks = 2; ks < 30; ++ks) {
            G3P_SYNC(6)
            G3P_BODY(pa, pb, ks + 2)
        }
        G3P_SYNC(6)  G3P_BODY(pan, pbn, 0)
        G3P_SYNC(6)  G3P_BODY(pan, pbn, 1)
        {
            const int mrow = m0 + wm * 128 + r15, ncol = n0 + wn * 64;
            epi.dispatch(n0, [&](auto e) {
                asm volatile("s_waitcnt vmcnt(0)" ::: "memory");
                if constexpr (decltype(e)::kBf16) {
#pragma unroll
                    for (int i = 0; i < 8; ++i)
#pragma unroll
                        for (int j = 0; j < 4; j += 2) {
                            uint2 a = e.pack4(acc[j][i]), b = e.pack4(acc[j + 1][i]);
                            auto sx = __builtin_amdgcn_permlane16_swap(a.x, b.x, false, false);
                            auto sy = __builtin_amdgcn_permlane16_swap(a.y, b.y, false, false);
                            e.store8(mrow + i * 16, ncol + (j + (g4 & 1)) * 16 + (g4 >> 1) * 8, make_uint4(sx[0], sy[0], sx[1], sy[1]));
                        }
                } else {
#pragma unroll
                    for (int i = 0; i < 8; ++i)
#pragma unroll
                        for (int j = 0; j < 4; ++j)
                            e.row4(mrow + i * 16, ncol + j * 16 + g4 * 4, make_float4(acc[j][i][0], acc[j][i][1], acc[j][i][2], acc[j][i][3]));
                }
            });
        }
        if (qn == q) break;
        q = qn; m0 = m0n; n0 = n0n; pa = pan; pb = pbn;
    }
    asm volatile("s_waitcnt vmcnt(0)" ::: "memory");
    __syncthreads();
#undef G3P_TILE
}

template <class Epi>
__device__ __forceinline__ void gemm_bf16_phase3(const bf16_t* __restrict__ A, int lda, const bf16_t* __restrict__ Bt, int ldb,
                                                 int Mtiles  , int Ntiles, unsigned char* lds, Epi epi) {
    if constexpr (Epi::kRow) {
        if ((gridDim.x & 7) == 0 && (Mtiles & 15) == 0) { gemm_phase_pipelined(A, lda, Bt, ldb, Mtiles, Ntiles, lds, epi); return; }
    }
    if ((gridDim.x & 7) == 0 && (Mtiles & 15) == 0) {
        const int x = blockIdx.x & 7, j = blockIdx.x >> 3, nb = gridDim.x >> 3;
        const int per = (Mtiles >> 3) * Ntiles;
        for (int q = j; q < per; q += nb) {
            const int s = q / (2 * Ntiles), rem = q - s * (2 * Ntiles);
            const int c = rem >> 1, r = rem & 1;
            const int mt = x + 8 * (2 * s + r);
            gemm_tile3(A, lda, Bt, ldb, mt * 256, c * 128, lds, epi);
        }
    } else {
        for (int tile = blockIdx.x; tile < Mtiles * Ntiles; tile += gridDim.x)
            gemm_tile3(A, lda, Bt, ldb, (tile / Ntiles) * 256, (tile % Ntiles) * 128, lds, epi);
    }
}

struct EpiF32 {
    float* C; int ldc; int Nc;
    __device__ __forceinline__ void operator()(int m, int n, f32x4 v) const {
        if (n < Nc) *(float4*)(C + (size_t)m * ldc + n) = make_float4(v[0], v[1], v[2], v[3]);
    }
    __device__ __forceinline__ void finish(int, int) const {}
};

struct EpiProjBf {
    static constexpr bool kBf16 = true;
    bf16_t* dst; int ld; float sc;
    __device__ __forceinline__ uint2 pack4(f32x4 v) const { uint2 o; o.x = pack2bf(sc * v[0], sc * v[1]); o.y = pack2bf(sc * v[2], sc * v[3]); return o; }
    __device__ __forceinline__ void store8(int m, int n, uint4 o) const { *(uint4*)(dst + (size_t)m * ld + (n & 127)) = o; }
};
struct EpiProjLF {
    static constexpr bool kBf16 = false;
    unsigned char* ws;
    __device__ __forceinline__ void row4(int m, int n, float4 v) const {
        const int c = n - 512;
        const float4 lb = *(const float4*)((const float*)(ws + OFF_LBV) + c);
        float4 o;
        o.x = log_fast(lb.x + (1.f - lb.x) * sigmoid_fast(v.x)); o.y = log_fast(lb.y + (1.f - lb.y) * sigmoid_fast(v.y));
        o.z = log_fast(lb.z + (1.f - lb.z) * sigmoid_fast(v.z)); o.w = log_fast(lb.w + (1.f - lb.w) * sigmoid_fast(v.w));
        *(float4*)((float*)(ws + OFF_HLF) + (size_t)m * 512 + c) = o;
    }
};
struct EpiProjGate {
    static constexpr bool kBf16 = false;
    unsigned char* ws;
    __device__ __forceinline__ void row4(int m, int n, float4 v) const {
        const int c = n - 3328;
        if (c < 24)
            *(float4*)((float*)(ws + OFF_NGATE) + (size_t)m * 24 + c) =
                make_float4(sigmoid_fast(v.x), sigmoid_fast(v.y), sigmoid_fast(v.z), sigmoid_fast(v.w));
    }
};
struct EpiProj {
    static constexpr bool kRow = true;
    unsigned char* ws;
    template <class F> __device__ __forceinline__ void dispatch(int n0, F f) const {
        const int ct = __builtin_amdgcn_readfirstlane(n0 >> 7);
        if (ct >= 4 && ct < 8) f(EpiProjLF{ws});
        else if (ct >= 26) f(EpiProjGate{ws});
        else {
            size_t off; int ld = 512, c0 = (ct & 3) * 128; float sc = 1.f;
            if (ct < 4) off = OFF_HQ;
            else if (ct < 12) off = OFF_HI;
            else if (ct < 16) off = OFF_HG;
            else if (ct < 20) { off = OFF_NQ; sc = 0.125f * 1.4426950408889634f; }
            else { off = OFF_KV + (size_t)(ct - 20) * KV_STRIDE; ld = 128; c0 = 0; }
            f(EpiProjBf{(bf16_t*)(ws + off) + c0, ld, sc});
        }
    }
    __device__ __forceinline__ void finish(int, int) const {}
};
struct EpiMix {
    static constexpr bool kRow = true;
    bf16_t* mix;
    template <class F> __device__ __forceinline__ void dispatch(int n0, F f) const { f(EpiProjBf{mix + n0, DM, 1.f}); }
    __device__ __forceinline__ void finish(int, int) const {}
};

__device__ __forceinline__ uint4 pack8bf(const float* v) {
    uint4 o;
    o.x = pack2bf(v[0], v[1]); o.y = pack2bf(v[2], v[3]); o.z = pack2bf(v[4], v[5]); o.w = pack2bf(v[6], v[7]);
    return o;
}

__device__ __forceinline__ void hgrn_passA(const Params& p, int chunk, unsigned char* smem) {
    const int c = chunk & 127, bh = chunk >> 7, h = bh & 3, b = bh >> 2;
    const int tid = opaque_tid(), d = tid & 127, hf = __builtin_amdgcn_readfirstlane(tid >> 7), lane = tid & 63, w = __builtin_amdgcn_readfirstlane(tid >> 6);
    const size_t tok0 = (size_t)b * SEQ + (size_t)c * 64 + 32 * hf;
    const float* HLF = (const float*)(p.ws + OFF_HLF);
    const bf16_t* HI = (const bf16_t*)(p.ws + OFF_HI);
    unsigned char* KT = smem;
    unsigned char* VT = smem + 16384;
    float* xch = (float*)(smem + 32768);
    const float* lfp = HLF + tok0 * 512 + h * 128 + d;
    const bf16_t* vp = HI + tok0 * 512 + h * 128 + d;
    float lf[32];
#pragma unroll
    for (int s = 0; s < 32; ++s) lf[s] = lfp[s * 512];
    uint4 vt0, vt1, vt2, vt3;
    {
#define VLD8(q_, R_) { unsigned short v_[8]; _Pragma("unroll") for (int j = 0; j < 8; ++j) v_[j] = vp[((q_) * 8 + j) * 512];                 \
                       R_.x = v_[0] | ((unsigned)v_[1] << 16); R_.y = v_[2] | ((unsigned)v_[3] << 16);                                       \
                       R_.z = v_[4] | ((unsigned)v_[5] << 16); R_.w = v_[6] | ((unsigned)v_[7] << 16); }
        VLD8(0, vt0) VLD8(1, vt1) VLD8(2, vt2) VLD8(3, vt3)
#undef VLD8
    }
    float run = 0.f, b15 = 0.f;
#pragma unroll
    for (int s = 0; s < 32; ++s) { run += lf[s]; if (s == 15) b15 = run; }
    __syncthreads();
    xch[hf * 128 + d] = run;
    __syncthreads();
    const float tot0 = xch[d], tot1 = xch[128 + d];
    const float blast = tot0 + tot1;
    {
        float* REF = (float*)(p.ws + OFF_HREF) + (size_t)chunk * 384;
        if (hf == 0) { REF[d] = b15; REF[128 + d] = tot0; } else REF[256 + d] = tot0 + b15;
    }
    run = hf ? tot0 : 0.f;
#pragma unroll
    for (int q = 0; q < 4; ++q) {
        float kv[8];
#pragma unroll
        for (int j = 0; j < 8; ++j) {
            const float l_ = lf[q * 8 + j];
            run += l_;
            kv[j] = (1.f - exp_fast(l_)) * exp_fast(blast - run);
        }
        const int ch = 4 * hf + q;
        *(uint4*)(KT + d * 128 + ((ch ^ (d & 7)) << 4)) = pack8bf(kv);
        *(uint4*)(VT + d * 128 + ((ch ^ (d & 7)) << 4)) = (q == 0) ? vt0 : (q == 1) ? vt1 : (q == 2) ? vt2 : vt3;
    }
    if (hf) ((float*)(p.ws + OFF_DC))[(size_t)chunk * 128 + d] = expf(blast);
    __syncthreads();
    f32x4 acc[2][8];
#pragma unroll
    for (int i = 0; i < 2; ++i)
#pragma unroll
        for (int et = 0; et < 8; ++et) acc[i][et] = (f32x4){0.f, 0.f, 0.f, 0.f};
#pragma unroll
    for (int st = 0; st < 2; ++st) {
        const int ch = st * 4 + (lane >> 4);
        bf16x8 af[2];
#pragma unroll
        for (int i = 0; i < 2; ++i) {
            const int row = (2 * w + i) * 16 + (lane & 15);
            af[i] = *(const bf16x8*)(KT + row * 128 + ((ch ^ (row & 7)) << 4));
        }
#pragma unroll
        for (int et = 0; et < 8; ++et) {
            const int row = et * 16 + (lane & 15);
            const bf16x8 bfv = *(const bf16x8*)(VT + row * 128 + ((ch ^ (row & 7)) << 4));
            acc[0][et] = __builtin_amdgcn_mfma_f32_16x16x32_bf16(af[0], bfv, acc[0][et], 0, 0, 0);
            acc[1][et] = __builtin_amdgcn_mfma_f32_16x16x32_bf16(af[1], bfv, acc[1][et], 0, 0, 0);
        }
    }
    bf16_t* HC = (bf16_t*)p.out + (size_t)chunk * 16384;
#pragma unroll
    for (int et = 0; et < 8; ++et) {
        const int e = et * 16 + (lane & 15), g4 = lane >> 4;
        uint2 a, b;
        a.x = pack2bf(acc[0][et][0], acc[0][et][1]); a.y = pack2bf(acc[0][et][2], acc[0][et][3]);
        b.x = pack2bf(acc[1][et][0], acc[1][et][1]); b.y = pack2bf(acc[1][et][2], acc[1][et][3]);
        auto sx = __builtin_amdgcn_permlane16_swap(a.x, b.x, false, false);
        auto sy = __builtin_amdgcn_permlane16_swap(a.y, b.y, false, false);
        *(uint4*)(HC + e * 128 + (2 * w + (g4 & 1)) * 16 + (g4 >> 1) * 8) = make_uint4(sx[0], sy[0], sx[1], sy[1]);
    }
}

__device__ __forceinline__ void hgrn_scan_item(const Params& p, int item) {
    const int gid = item * 256 + threadIdx.x;
    const int d4 = gid & 31, e = (gid >> 5) & 127, bh = gid >> 12;
    const bf16_t* HC = (const bf16_t*)p.out;
    const float* DC = (const float*)(p.ws + OFF_DC);
    bf16_t* SC = (bf16_t*)(p.ws + OFF_SC);
    float4 S = make_float4(0.f, 0.f, 0.f, 0.f);
#pragma unroll 16
    for (int c = 0; c < 128; ++c) {
        const size_t base = ((size_t)(bh * 128 + c) * 128 + e) * 128 + d4 * 4;
        const uint2 hb = *(const uint2*)(HC + base);
        const float4 H = make_float4(__uint_as_float(hb.x << 16), __uint_as_float(hb.x & 0xffff0000u), __uint_as_float(hb.y << 16), __uint_as_float(hb.y & 0xffff0000u));
        const float4 dc = *(const float4*)(DC + (size_t)(bh * 128 + c) * 128 + d4 * 4);
        uint2 o; o.x = pack2bf(S.x, S.y); o.y = pack2bf(S.z, S.w);
        *(uint2*)(SC + base) = o;
        S.x = dc.x * S.x + H.x; S.y = dc.y * S.y + H.y; S.z = dc.z * S.z + H.z; S.w = dc.w * S.w + H.w;
    }
}

__device__ __forceinline__ void hgrn_passC(const Params& p, int chunk, unsigned char* smem) {
    const int c = chunk & 127, bh = chunk >> 7, h = bh & 3, b = bh >> 2;
    const int tid = opaque_tid(), d = tid & 127, hf = __builtin_amdgcn_readfirstlane(tid >> 7), lane = tid & 63, w = __builtin_amdgcn_readfirstlane(tid >> 6);
    const size_t tokc = (size_t)b * SEQ + (size_t)c * 64;
    const size_t tok0 = tokc + 32 * hf;
    const float* HLF = (const float*)(p.ws + OFF_HLF);
    const bf16_t* HQ = (const bf16_t*)(p.ws + OFF_HQ);
    const bf16_t* HI = (const bf16_t*)(p.ws + OFF_HI);
    const bf16_t* HG = (const bf16_t*)(p.ws + OFF_HG);
    unsigned char* R0 = smem;
    unsigned char* R1 = smem + 16384;
    unsigned char* R2 = smem + 57344;
    unsigned char* R3 = smem + 65536;
    const float* lfp = HLF + tok0 * 512 + h * 128 + d;
    const bf16_t* qp = HQ + tok0 * 512 + h * 128 + d;
    const float* REF = (const float*)(p.ws + OFF_HREF) + (size_t)chunk * 384;
    __syncthreads();
    const float r1 = REF[d], r2 = REF[128 + d], r3 = REF[256 + d];
    uint4 sct0, sct1, sct2, sct3, sct4, sct5, sct6, sct7;
    {
        const bf16_t* SCp = (const bf16_t*)(p.ws + OFF_SC) + (size_t)chunk * 16384;
#define SCLD(i, R_) { const int cc = tid + 256 * (i); R_ = *(const uint4*)(SCp + (cc >> 4) * 128 + (cc & 15) * 8); }
        SCLD(0, sct0) SCLD(1, sct1) SCLD(2, sct2) SCLD(3, sct3) SCLD(4, sct4) SCLD(5, sct5) SCLD(6, sct6) SCLD(7, sct7)
#undef SCLD
    }
    uint4 vt0, vt1, vt2, vt3;
    {
        const bf16_t* vp = HI + tok0 * 512 + h * 128 + d;
#define VLD8(q_, R_) { unsigned short v_[8]; _Pragma("unroll") for (int j = 0; j < 8; ++j) v_[j] = vp[((q_) * 8 + j) * 512];                 \
                       R_.x = v_[0] | ((unsigned)v_[1] << 16); R_.y = v_[2] | ((unsigned)v_[3] << 16);                                       \
                       R_.z = v_[4] | ((unsigned)v_[5] << 16); R_.w = v_[6] | ((unsigned)v_[7] << 16); }
        VLD8(0, vt0) VLD8(1, vt1) VLD8(2, vt2) VLD8(3, vt3)
#undef VLD8
    }
    {
        float run = hf ? r2 : 0.f;
        unsigned char* dummy = R2 + 4096 + d * 2;
#pragma unroll 8
        for (int s = 0; s < 32; ++s) {
            const int t = 32 * hf + s;
            const int it = t >> 4;
            const float rr = (it == 0) ? 0.f : (it == 1) ? r1 : (it == 2) ? r2 : r3;
            const int sw = (((d >> 3) ^ (t & 15)) << 4) + (d & 7) * 2;
            const float lf = lfp[s * 512];
            run += lf;
            const float qv = bf2f(qp[s * 512]);
            const float kv = 1.f - exp_fast(lf);
            *(bf16_t*)(R3 + t * 256 + sw) = (bf16_t)f2bf(qv * exp_fast(run));
            *(bf16_t*)(R0 + t * 256 + sw) = (bf16_t)f2bf(qv * exp_fast(run - rr));
#pragma unroll
            for (int i = 0; i < 4; ++i) {
                const float ri = (i == 0) ? 0.f : (i == 1) ? r1 : (i == 2) ? r2 : r3;
                const int R = 8 * i * (i + 1) + t;
                unsigned char* dst = (i >= it) ? (R1 + R * 256 + sw) : dummy;
                *(bf16_t*)dst = (bf16_t)f2bf(kv * exp_fast(fminf(ri - run, 80.f)));
            }
        }
    }
    __syncthreads();
#pragma unroll
    for (int j = 0; j < 4; ++j) {
        uint2 o = make_uint2(0u, 0u);
        if (j <= w) {
            f32x4 pa = (f32x4){0.f, 0.f, 0.f, 0.f};
#pragma unroll
            for (int ds = 0; ds < 4; ++ds) {
                const int ch = ds * 4 + (lane >> 4);
                const int krow = 8 * w * (w + 1) + 16 * j + (lane & 15);
                const int trow = w * 16 + (lane & 15);
                const bf16x8 av = *(const bf16x8*)(R1 + krow * 256 + ((ch ^ (krow & 15)) << 4));
                const bf16x8 bq = *(const bf16x8*)(R0 + trow * 256 + ((ch ^ (trow & 15)) << 4));
                pa = __builtin_amdgcn_mfma_f32_16x16x32_bf16(av, bq, pa, 0, 0, 0);
            }
            if (j == w) {
                const int tl = lane & 15, sl = (lane >> 4) * 4;
#pragma unroll
                for (int r = 0; r < 4; ++r) if (sl + r > tl) pa[r] = 0.f;
            }
            o.x = pack2bf(pa[0], pa[1]); o.y = pack2bf(pa[2], pa[3]);
        }
        const int t = w * 16 + (lane & 15);
        const int ch = 2 * j + (lane >> 5);
        *(uint2*)(R2 + t * 128 + ((ch ^ (t & 7)) << 4) + ((lane >> 4) & 1) * 8) = o;
    }
    __syncthreads();
    {
#define SCST(i, R_) { const int cc = tid + 256 * (i), row = cc >> 4, ch = cc & 15; *(uint4*)(R1 + row * 256 + ((ch ^ (row & 15)) << 4)) = R_; }
        SCST(0, sct0) SCST(1, sct1) SCST(2, sct2) SCST(3, sct3) SCST(4, sct4) SCST(5, sct5) SCST(6, sct6) SCST(7, sct7)
#undef SCST
        *(uint4*)(R0 + d * 128 + (((4 * hf + 0) ^ (d & 7)) << 4)) = vt0;
        *(uint4*)(R0 + d * 128 + (((4 * hf + 1) ^ (d & 7)) << 4)) = vt1;
        *(uint4*)(R0 + d * 128 + (((4 * hf + 2) ^ (d & 7)) << 4)) = vt2;
        *(uint4*)(R0 + d * 128 + (((4 * hf + 3) ^ (d & 7)) << 4)) = vt3;
    }
    __syncthreads();
    const size_t tok = tokc + w * 16 + (lane & 15);
    uint2 gb0, gb1, gb2, gb3, gb4, gb5, gb6, gb7;
    {
        const bf16_t* gp = HG + tok * 512 + h * 128 + (lane >> 4) * 4;
        gb0 = *(const uint2*)(gp); gb1 = *(const uint2*)(gp + 16); gb2 = *(const uint2*)(gp + 32); gb3 = *(const uint2*)(gp + 48);
        gb4 = *(const uint2*)(gp + 64); gb5 = *(const uint2*)(gp + 80); gb6 = *(const uint2*)(gp + 96); gb7 = *(const uint2*)(gp + 112);
    }
    f32x4 acc[8];
#pragma unroll
    for (int et = 0; et < 8; ++et) acc[et] = (f32x4){0.f, 0.f, 0.f, 0.f};
#pragma unroll
    for (int ds = 0; ds < 4; ++ds) {
        const int ch = ds * 4 + (lane >> 4);
        const int trow = w * 16 + (lane & 15);
        const bf16x8 bq = *(const bf16x8*)(R3 + trow * 256 + ((ch ^ (trow & 15)) << 4));
#pragma unroll
        for (int et = 0; et < 8; ++et) {
            const int row = et * 16 + (lane & 15);
            const bf16x8 av = *(const bf16x8*)(R1 + row * 256 + ((ch ^ (row & 15)) << 4));
            acc[et] = __builtin_amdgcn_mfma_f32_16x16x32_bf16(av, bq, acc[et], 0, 0, 0);
        }
    }
#pragma unroll
    for (int st = 0; st < 2; ++st) {
        const int ch = st * 4 + (lane >> 4);
        const int trow = w * 16 + (lane & 15);
        const bf16x8 bp = *(const bf16x8*)(R2 + trow * 128 + ((ch ^ (trow & 7)) << 4));
#pragma unroll
        for (int et = 0; et < 8; ++et) {
            const int row = et * 16 + (lane & 15);
            const bf16x8 av = *(const bf16x8*)(R0 + row * 128 + ((ch ^ (row & 7)) << 4));
            acc[et] = __builtin_amdgcn_mfma_f32_16x16x32_bf16(av, bp, acc[et], 0, 0, 0);
        }
    }
    {
        float ss = 0.f;
#pragma unroll
        for (int et = 0; et < 8; ++et)
#pragma unroll
            for (int r = 0; r < 4; ++r) ss += acc[et][r] * acc[et][r];
        ss += __shfl_xor(ss, 16);
        ss += __shfl_xor(ss, 32);
        const float rs = rsqrtf(ss * (1.f / 128.f) + LN_EPS);
        const float* ng = p.in[4];
        bf16_t* MIX = (bf16_t*)(p.ws + OFF_XB);
#pragma unroll
        for (int et = 0; et < 8; ++et) {
            const int e0 = et * 16 + (lane >> 4) * 4;
            const uint2 gb = (et == 0) ? gb0 : (et == 1) ? gb1 : (et == 2) ? gb2 : (et == 3) ? gb3 : (et == 4) ? gb4 : (et == 5) ? gb5 : (et == 6) ? gb6 : gb7;
            const float4 n4 = *(const float4*)(ng + e0);
            const float g0 = bf2f(gb.x & 0xffffu), g1 = bf2f(gb.x >> 16), g2 = bf2f(gb.y & 0xffffu), g3 = bf2f(gb.y >> 16);
            uint2 o;
            o.x = pack2bf(acc[et][0] * rs * n4.x * (g0 * sigmoid_fast(g0)), acc[et][1] * rs * n4.y * (g1 * sigmoid_fast(g1)));
            o.y = pack2bf(acc[et][2] * rs * n4.z * (g2 * sigmoid_fast(g2)), acc[et][3] * rs * n4.w * (g3 * sigmoid_fast(g3)));
            *(uint2*)(MIX + tok * DM + h * 128 + e0) = o;
        }
    }
}

__device__ __forceinline__ void compress_item(const Params& p, int item, float* sm) {
    const int g = item & 1;
    int r = item >> 1;
    const int n = r % NCB; r /= NCB;
    const int b = r & 3, which = r >> 2;
    const int tid = opaque_tid();
    const bf16_t* kvsrc = (const bf16_t*)(p.ws + OFF_KV + (size_t)which * KV_STRIDE);
    const float* pe = p.in[which ? 10 : 5];
    const float* w1 = p.in[which ? 11 : 6];
    const float* b1 = p.in[which ? 12 : 7];
    const float* w2 = p.in[which ? 13 : 8];
    const float* b2 = p.in[which ? 14 : 9];
    float* outp = (float*)(p.ws + (which ? OFF_CMPV : OFF_CMPK));
    float* blk = sm;
    float* hh = sm + 2048;
    __syncthreads();
    for (int i = tid; i < 2048; i += 256) {
        const int l = i >> 6, d = i & 63;
        blk[i] = bf2f(kvsrc[(size_t)(b * SEQ + 16 * n + l) * 128 + g * 64 + d]) + pe[i];
    }
    __syncthreads();
    float acc = b1[tid];
    for (int i = 0; i < 2048; ++i) acc += blk[i] * w1[(size_t)i * 256 + tid];
    hh[tid] = gelu_tanh(acc);
    __syncthreads();
    if (tid < 64) {
        float o = b2[tid];
        for (int j = 0; j < 256; ++j) o += hh[j] * w2[j * 64 + tid];
        outp[((size_t)(b * NCB + n) * 2 + g) * 64 + tid] = o;
    }
}

__device__ __forceinline__ float dot64_bf(const float* qs, const bf16_t* krow) {
    float s = 0.f;
#pragma unroll
    for (int i = 0; i < 8; ++i) {
        const uint4 kv = ((const uint4*)krow)[i];
        const float4 q0 = ((const float4*)qs)[2 * i], q1 = ((const float4*)qs)[2 * i + 1];
        s += __uint_as_float(kv.x << 16) * q0.x + __uint_as_float(kv.x & 0xffff0000u) * q0.y
           + __uint_as_float(kv.y << 16) * q0.z + __uint_as_float(kv.y & 0xffff0000u) * q0.w
           + __uint_as_float(kv.z << 16) * q1.x + __uint_as_float(kv.z & 0xffff0000u) * q1.y
           + __uint_as_float(kv.w << 16) * q1.z + __uint_as_float(kv.w & 0xffff0000u) * q1.w;
    }
    return s;
}
__device__ __forceinline__ float dot64(const float* qs, const float* krow) {
    float s = 0.f;
#pragma unroll
    for (int i = 0; i < 16; ++i) {
        const float4 kv = ((const float4*)krow)[i];
        const float4 qv = ((const float4*)qs)[i];
        s += kv.x * qv.x + kv.y * qv.y + kv.z * qv.z + kv.w * qv.w;
    }
    return s;
}

__device__ __forceinline__ void nsa_item(const Params& p, int item, float* sm) {
    const int t = item & (SEQ - 1), g = (item >> 13) & 1, b = item >> 14;
    const int tid = threadIdx.x, lane = tid & 63, r = tid >> 6;
    float* sc = sm + r * 1024;
    float* qs = sm + 4096 + r * 64;
    float* impv = sm + 4096 + 256;
    int* sel = (int*)(sm + 4096 + 256 + 128);
    const bf16_t* KSb = (const bf16_t*)(p.ws + OFF_KV + 2 * KV_STRIDE);
    const bf16_t* VSb = (const bf16_t*)(p.ws + OFF_KV + 3 * KV_STRIDE);
    const bf16_t* KWb = (const bf16_t*)(p.ws + OFF_KV + 4 * KV_STRIDE);
    const bf16_t* VWb = (const bf16_t*)(p.ws + OFF_KV + 5 * KV_STRIDE);
    const float* cmpk = (const float*)(p.ws + OFF_CMPK);
    const float* cmpv = (const float*)(p.ws + OFF_CMPV);
    const size_t n = (size_t)b * SEQ + t;
    const float NEGV = -1e30f;
    __syncthreads();
    qs[lane] = bf2f(((const bf16_t*)(p.ws + OFF_NQ))[n * 512 + g * 256 + r * 64 + lane]) * 0.6931471805599453f;
    __syncthreads();

    const int nvalid = (t >= 31) ? (((t - 31) >> 4) + 1) : 0;
    float m = NEGV;
    for (int n0 = 0; n0 < nvalid; n0 += 64) {
        const int nn = n0 + lane;
        if (nn < nvalid) {
            const float s = dot64(qs, cmpk + ((size_t)(b * NCB + nn) * 2 + g) * 64);
            sc[nn] = s;
            m = fmaxf(m, s);
        }
    }
    m = wave_max(m);
    float sum = 0.f;
    for (int n0 = 0; n0 < nvalid; n0 += 64) {
        const int nn = n0 + lane;
        if (nn < nvalid) { const float e = expf(sc[nn] - m); sc[nn] = e; sum += e; }
    }
    sum = wave_sum(sum);
    {
        const float inv = 1.f / fmaxf(sum, 1e-30f);
        for (int n0 = 0; n0 < nvalid; n0 += 64) {
            const int nn = n0 + lane;
            if (nn < nvalid) sc[nn] *= inv;
        }
    }
    __syncthreads();
    float oc = 0.f;
    for (int nn = 0; nn < nvalid; ++nn) oc += sc[nn] * cmpv[((size_t)(b * NCB + nn) * 2 + g) * 64 + lane];

    const int cur = t >> 6;
    if (tid < 128) {
        const int j = tid;
        float im = 0.f;
#pragma unroll
        for (int rr = 0; rr < 4; ++rr) {
            const float* P = sm + rr * 1024;
            const int n4 = 4 * j;
            float a = 0.f;
            if (n4 < nvalid) a += P[n4];
            if (n4 + 1 < nvalid) a += P[n4 + 1];
            if (n4 + 2 < nvalid) a += P[n4 + 2];
            if (n4 + 3 < nvalid) a += 0.5f * P[n4 + 3];
            if (n4 - 1 >= 0 && n4 - 1 < nvalid) a += 0.5f * P[n4 - 1];
            im += a;
        }
        const bool forced = (j == 0) || (j == cur) || (j == cur - 1);
        const bool causal = (j <= cur);
        impv[j] = forced ? 1.0e4f : (causal ? im : -1.f);
    }
    __syncthreads();
    if (r == 0) {
        float v0 = impv[lane], v1 = impv[lane + 64];
        for (int k = 0; k < 16; ++k) {
            const float mx = wave_max(fmaxf(v0, v1));
            const unsigned long long b0 = __ballot(v0 == mx);
            int idx;
            if (b0) {
                const int l = __ffsll((unsigned long long)b0) - 1;
                idx = l;
                if (lane == l) v0 = -3.0e38f;
            } else {
                const unsigned long long b1 = __ballot(v1 == mx);
                const int l = __ffsll((unsigned long long)b1) - 1;
                idx = 64 + l;
                if (lane == l) v1 = -3.0e38f;
            }
            if (lane == 0) sel[k] = idx;
        }
    }
    __syncthreads();

    m = NEGV;
    for (int si = 0; si < 16; ++si) {
        const int blk = sel[si];
        const int key = blk * 64 + lane;
        float s = NEGV;
        if (blk * 64 <= t) {
            if (key <= t) s = dot64_bf(qs, KSb + ((size_t)b * SEQ + key) * 128 + g * 64);
        }
        sc[si * 64 + lane] = s;
        m = fmaxf(m, s);
    }
    m = wave_max(m);
    sum = 0.f;
    for (int si = 0; si < 16; ++si) {
        const int key = sel[si] * 64 + lane;
        const float e = (key <= t) ? expf(sc[si * 64 + lane] - m) : 0.f;
        sc[si * 64 + lane] = e;
        sum += e;
    }
    sum = wave_sum(sum);
    {
        const float inv = 1.f / fmaxf(sum, 1e-30f);
        for (int si = 0; si < 16; ++si) sc[si * 64 + lane] *= inv;
    }
    __syncthreads();
    float os = 0.f;
    for (int si = 0; si < 16; ++si) {
        const int blk = sel[si];
        if (blk * 64 > t) continue;
        for (int kk = 0; kk < 64; ++kk) {
            const int key = blk * 64 + kk;
            if (key > t) break;
            os += sc[si * 64 + kk] * bf2f(VSb[((size_t)b * SEQ + key) * 128 + g * 64 + lane]);
        }
    }
    __syncthreads();

    const int lo = t - 511;
    m = NEGV;
    for (int i = 0; i < 8; ++i) {
        const int key = lo + i * 64 + lane;
        float s = NEGV;
        if (key >= 0) s = dot64_bf(qs, KWb + ((size_t)b * SEQ + key) * 128 + g * 64);
        sc[i * 64 + lane] = s;
        m = fmaxf(m, s);
    }
    m = wave_max(m);
    sum = 0.f;
    for (int i = 0; i < 8; ++i) {
        const int key = lo + i * 64 + lane;
        const float e = (key >= 0) ? expf(sc[i * 64 + lane] - m) : 0.f;
        sc[i * 64 + lane] = e;
        sum += e;
    }
    sum = wave_sum(sum);
    {
        const float inv = 1.f / fmaxf(sum, 1e-30f);
        for (int i = 0; i < 8; ++i) sc[i * 64 + lane] *= inv;
    }
    __syncthreads();
    float ow = 0.f;
    for (int idx = 0; idx < 512; ++idx) {
        const int key = lo + idx;
        if (key < 0) continue;
        ow += sc[idx] * bf2f(VWb[((size_t)b * SEQ + key) * 128 + g * 64 + lane]);
    }
    const float* grow = (const float*)(p.ws + OFF_NGATE) + n * 24 + g * 12 + r * 3;
    const float gc = grow[0], gs = grow[1], gw = grow[2];
#if NSA_DIAG
    {
        const float ref = gc * oc + gs * os + gw * ow;
        const float got = bf2f(((const bf16_t*)(p.ws + OFF_XB))[n * DM + 512 + g * 256 + r * 64 + lane]);
        const unsigned* SELM = (const unsigned*)(p.ws + OFF_SELM) + ((size_t)(b * 2 + g) * SEQ + t) * 4;
        unsigned gm[4] = {0u, 0u, 0u, 0u};
        for (int si = 0; si < 16; ++si) { const int blk = sel[si]; if (blk * 64 <= t) gm[blk >> 5] |= 1u << (blk & 31); }
        bool same = true;
        for (int qd = 0; qd < 4; ++qd) {
            unsigned mm = SELM[qd];
            for (int bit = 0; bit < 32; ++bit) if ((qd * 32 + bit) * 64 > t) mm &= ~(1u << bit);
            if (mm != gm[qd]) same = false;
        }
        float d2 = same ? (got - ref) * (got - ref) : 0.f, r2 = same ? ref * ref : 0.f;
        d2 = wave_sum(d2); r2 = wave_sum(r2);
        float* DG = (float*)(p.ws + OFF_DIAG);
        if (lane == 0) { atomicAdd(&DG[0], d2); atomicAdd(&DG[1], r2); if (r == 0) { atomicAdd(&DG[2], same ? 0.f : 1.f); atomicAdd(&DG[3], 1.f); } }
    }
#else
    ((bf16_t*)(p.ws + OFF_XB))[n * DM + 512 + g * 256 + r * 64 + lane] = (bf16_t)f2bf(gc * oc + gs * os + gw * ow);
#endif
}


__device__ __forceinline__ float xrow_max(float x) {
    auto s = __builtin_amdgcn_permlane16_swap(__float_as_uint(x), __float_as_uint(x), false, false);
    x = fmaxf(__uint_as_float(s[0]), __uint_as_float(s[1]));
    auto t = __builtin_amdgcn_permlane32_swap(__float_as_uint(x), __float_as_uint(x), false, false);
    return fmaxf(__uint_as_float(t[0]), __uint_as_float(t[1]));
}
__device__ __forceinline__ float xrow_sum(float x) {
    auto s = __builtin_amdgcn_permlane16_swap(__float_as_uint(x), __float_as_uint(x), false, false);
    x = __uint_as_float(s[0]) + __uint_as_float(s[1]);
    auto t = __builtin_amdgcn_permlane32_swap(__float_as_uint(x), __float_as_uint(x), false, false);
    return __uint_as_float(t[0]) + __uint_as_float(t[1]);
}
template <int CTRL> __device__ __forceinline__ float dppf(float x) {
    return __builtin_bit_cast(float, __builtin_amdgcn_mov_dpp(__builtin_bit_cast(int, x), CTRL, 0xf, 0xf, true));
}
__device__ __forceinline__ float row16_max(float m) {
    m = fmaxf(m, dppf<0x121>(m)); m = fmaxf(m, dppf<0x122>(m));
    m = fmaxf(m, dppf<0x124>(m)); m = fmaxf(m, dppf<0x128>(m));
    return m;
}
__device__ __forceinline__ float row16_sum(float m) {
    m += dppf<0x121>(m); m += dppf<0x122>(m); m += dppf<0x124>(m); m += dppf<0x128>(m);
    return m;
}
__device__ __forceinline__ float dot2bf(unsigned a, unsigned b, float acc) {
    return __builtin_amdgcn_fdot2_f32_bf16(__builtin_bit_cast(bf16x2_t, a), __builtin_bit_cast(bf16x2_t, b), acc, false);
}
__device__ __forceinline__ float enc_key(float v, unsigned idx, unsigned mask) {
    const unsigned u = __float_as_uint(v);
    const unsigned code = (u >> 31) ? idx : (mask - idx);
    return __uint_as_float((u & ~mask) | code);
}
__device__ __forceinline__ unsigned dec_idx(float key, unsigned mask) {
    const unsigned u = __float_as_uint(key);
    const unsigned code = u & mask;
    return (u >> 31) ? code : (mask - code);
}
__device__ __forceinline__ float dec_val(float key, unsigned mask) { return __uint_as_float(__float_as_uint(key) & ~mask); }
#define NEGKEY (-3.0e38f)
#define CE_DESC(a, b) { const float t_ = fmaxf(a, b); b = fminf(a, b); a = t_; }

struct EpiCmpH {
    bf16_t* HB; const float* peb;
    __device__ __forceinline__ void operator()(int m, int n, f32x4 v) const {
        const float4 pb = *(const float4*)(peb + n);
        uint2 o;
        o.x = pack2bf(gelu_tanh(v[0] + pb.x), gelu_tanh(v[1] + pb.y));
        o.y = pack2bf(gelu_tanh(v[2] + pb.z), gelu_tanh(v[3] + pb.w));
        *(uint2*)(HB + (size_t)m * 256 + n) = o;
    }
    __device__ __forceinline__ void finish(int, int) const {}
};
__device__ __forceinline__ void cmp_peb_partial(const Params& p, int b) {
    const int which = b >> 5, s = b & 31;
    const float* pe = p.in[which ? 10 : 5];
    const float* w1 = p.in[which ? 11 : 6];
    const int j = threadIdx.x;
    float acc = 0.f;
#pragma unroll 16
    for (int i = s * 64; i < s * 64 + 64; ++i) acc += pe[i] * w1[(size_t)i * 256 + j];
    ((float*)(p.ws + OFF_PEB + 4096))[(which * 32 + s) * 256 + j] = acc;
}
__device__ __forceinline__ void cmp_peb_reduce(const Params& p) {
    for (int o = threadIdx.x; o < 512; o += 256) {
        const int which = o >> 8, j = o & 255;
        float acc = p.in[which ? 12 : 7][j];
        for (int s = 0; s < 32; ++s) acc += ((const float*)(p.ws + OFF_PEB + 4096))[(which * 32 + s) * 256 + j];
        ((float*)(p.ws + OFF_PEB))[o] = acc;
    }
}
__device__ __forceinline__ void cmp_layer2_phase(const Params& p, int first_block, int nblocks) {
    const int tid_ = opaque_tid(), lane = tid_ & 63, w = __builtin_amdgcn_readfirstlane(tid_ >> 6);
    for (int it = (blockIdx.x - first_block) * 4 + w; it < 2 * 4088; it += nblocks * 4) {
        const int which = it >= 4088, row = which ? it - 4088 : it;
        const float* w2 = p.in[which ? 13 : 8];
        const float* b2 = p.in[which ? 14 : 9];
        const bf16_t* hrow = (const bf16_t*)(p.ws + OFF_HB) + ((size_t)which * 4096 + row) * 256;
        float o = b2[lane];
#pragma unroll 8
        for (int j = 0; j < 256; ++j) o += bf2f(hrow[j]) * w2[j * 64 + lane];
        const int g = row & 1, bn = row >> 1, n = bn % NCB, b = bn / NCB;
        ((bf16_t*)(p.ws + (which ? OFF_CMPVB : OFF_CMPKB)))[((size_t)(b * 2 + g) * 512 + n) * 64 + lane] = (bf16_t)f2bf(o);
    }
}

struct StageOfs { int k, v; };
__device__ __forceinline__ StageOfs make_stage_ofs() {
    const int c0 = opaque_tid(), key = c0 >> 3, ch = c0 & 7;
    StageOfs s;
    s.k = key * 128 + ((ch ^ (key & 7)) << 4);
    s.v = key * 128 + (((ch >> 1) ^ ((key >> 1) & 3)) << 5) + (ch & 1) * 16;
    return s;
}
#define NSA_KV_LOAD(S_, kb_) { const bf16_t* kp_ = Kbase + (size_t)(kb_) * 64 * stride + (size_t)(tid >> 3) * stride + (tid & 7) * 8; \
        const bf16_t* vp_ = Vbase + (size_t)(kb_) * 64 * stride + (size_t)(tid >> 3) * stride + (tid & 7) * 8;                 \
        S_##k0 = *(const uint4*)kp_; S_##k1 = *(const uint4*)(kp_ + (size_t)32 * stride);                                    \
        S_##v0 = *(const uint4*)vp_; S_##v1 = *(const uint4*)(vp_ + (size_t)32 * stride); }
#define NSA_KV_STORE(S_, Kl_, Vl_) { *(uint4*)((Kl_) + sof.k) = S_##k0; *(uint4*)((Kl_) + sof.k + 4096) = S_##k1; \
        *(uint4*)((Vl_) + sof.v) = S_##v0; *(uint4*)((Vl_) + sof.v + 4096) = S_##v1; }
template <class Compute>
__device__ __forceinline__ void nsa_kv_loop(const bf16_t* __restrict__ Kbase, const bf16_t* __restrict__ Vbase, int stride,
                                            int kb_lo, int kb_hi, unsigned char* smem, const StageOfs& sof, Compute compute) {
    const int tid = opaque_tid();
    uint4 ra_k0, ra_k1, ra_v0, ra_v1;
    NSA_KV_LOAD(ra_, kb_lo)
    __syncthreads();
    NSA_KV_STORE(ra_, smem, smem + 16384)
    __syncthreads();
    for (int kb = kb_lo; kb <= kb_hi; ++kb) {
        const int buf = (kb - kb_lo) & 1;
        if (kb < kb_hi) NSA_KV_LOAD(ra_, kb + 1)
        compute(kb, smem + buf * 8192, smem + 16384 + buf * 8192);
        if (kb < kb_hi) NSA_KV_STORE(ra_, smem + (buf ^ 1) * 8192, smem + 16384 + (buf ^ 1) * 8192)
        __syncthreads();
    }
}
struct LaneOfs { int k0, k1, vb0, vb1, vb2, vb3; };
__device__ __forceinline__ LaneOfs make_lane_ofs(int lane) {
    LaneOfs f;
    const int r15 = lane & 15, lg = lane >> 4, q = r15 >> 2, pp = r15 & 3;
    f.k0 = r15 * 128 + ((lg ^ (r15 & 7)) << 4);
    f.k1 = r15 * 128 + (((4 + lg) ^ (r15 & 7)) << 4);
    const int sw2 = (2 * (lg & 1) + (q >> 1)) & 3;
    const int vrow = (4 * lg + q) * 128 + pp * 8;
    f.vb0 = vrow + ((0 ^ sw2) << 5); f.vb1 = vrow + ((1 ^ sw2) << 5);
    f.vb2 = vrow + ((2 ^ sw2) << 5); f.vb3 = vrow + ((3 ^ sw2) << 5);
    return f;
}
typedef short s16x4 __attribute__((ext_vector_type(4)));
__device__ __forceinline__ uint2 tr_read(const unsigned char* p) {
    const s16x4 v = __builtin_amdgcn_ds_read_tr16_b64_v4i16((LAS3 s16x4*)p);
    return __builtin_bit_cast(uint2, v);
}
#define NEGM (-1.0e37f)
__device__ __forceinline__ void nsa_scores(const unsigned char* Kl, const LaneOfs& f, const bf16x8& q0, const bf16x8& q1, float bias, f32x4 (&s)[4]) {
#pragma unroll
    for (int kt = 0; kt < 4; ++kt) {
        const bf16x8 a0 = *(const bf16x8*)(Kl + f.k0 + kt * 2048);
        const bf16x8 a1 = *(const bf16x8*)(Kl + f.k1 + kt * 2048);
        f32x4 z = (f32x4){bias, bias, bias, bias};
        z = __builtin_amdgcn_mfma_f32_16x16x32_bf16(a0, q0, z, 0, 0, 0);
        s[kt] = __builtin_amdgcn_mfma_f32_16x16x32_bf16(a1, q1, z, 0, 0, 0);
    }
}
#define ONES_BF16X8 __builtin_bit_cast(bf16x8, make_uint4(0x3F803F80u, 0x3F803F80u, 0x3F803F80u, 0x3F803F80u))
template <class VF>
__device__ __forceinline__ void attn_step(const unsigned char* Kl, const unsigned char* Vl, int lane, const LaneOfs& f,
                                          const bf16x8& q0, const bf16x8& q1, f32x4 (&o)[4], float& m, f32x4& lacc,
                                          float rowbias, bool full, VF valid) {
    f32x4 s[4];
    const bool mok = m > -1e29f;
    const float meff = mok ? m : 0.f;
    nsa_scores(Kl, f, q0, q1, rowbias - meff, s);
    if (!full) {
#pragma unroll
        for (int kt = 0; kt < 4; ++kt)
#pragma unroll
            for (int r = 0; r < 4; ++r) s[kt][r] = valid(kt * 16 + 4 * (lane >> 4) + r) ? s[kt][r] : NEGM;
    }
    float mx = fmaxf(fmaxf(fmaxf(s[0][0], s[0][1]), fmaxf(s[0][2], s[0][3])), fmaxf(fmaxf(s[1][0], s[1][1]), fmaxf(s[1][2], s[1][3])));
    mx = fmaxf(mx, fmaxf(fmaxf(fmaxf(s[2][0], s[2][1]), fmaxf(s[2][2], s[2][3])), fmaxf(fmaxf(s[3][0], s[3][1]), fmaxf(s[3][2], s[3][3]))));
    mx = xrow_max(mx);
    if (!__all(mok && (mx <= 8.f))) {
        const float mn = fmaxf(m, meff + mx);
        const float alpha = __builtin_amdgcn_exp2f(m - mn), d = mn - meff;
        m = mn; lacc[0] *= alpha;
#pragma unroll
        for (int dt = 0; dt < 4; ++dt) { o[dt][0] *= alpha; o[dt][1] *= alpha; o[dt][2] *= alpha; o[dt][3] *= alpha; }
#pragma unroll
        for (int kt = 0; kt < 4; ++kt) { s[kt][0] -= d; s[kt][1] -= d; s[kt][2] -= d; s[kt][3] -= d; }
    }
#pragma unroll
    for (int kt = 0; kt < 4; ++kt)
#pragma unroll
        for (int r = 0; r < 4; ++r) s[kt][r] = __builtin_amdgcn_exp2f(s[kt][r]);
#pragma unroll
    for (int k2 = 0; k2 < 2; ++k2) {
        uint4 pk;
        pk.x = pack2bf(s[2 * k2][0], s[2 * k2][1]); pk.y = pack2bf(s[2 * k2][2], s[2 * k2][3]);
        pk.z = pack2bf(s[2 * k2 + 1][0], s[2 * k2 + 1][1]); pk.w = pack2bf(s[2 * k2 + 1][2], s[2 * k2 + 1][3]);
        const bf16x8 pb = __builtin_bit_cast(bf16x8, pk);
        lacc = __builtin_amdgcn_mfma_f32_16x16x32_bf16(ONES_BF16X8, pb, lacc, 0, 0, 0);
#define PV1(dt_, vb_) { const uint2 lo_ = tr_read(Vl + (vb_) + k2 * 4096), hi_ = tr_read(Vl + (vb_) + k2 * 4096 + 2048); \
                        uint4 av_; av_.x = lo_.x; av_.y = lo_.y; av_.z = hi_.x; av_.w = hi_.y;                          \
                        o[dt_] = __builtin_amdgcn_mfma_f32_16x16x32_bf16(__builtin_bit_cast(bf16x8, av_), pb, o[dt_], 0, 0, 0); }
        PV1(0, f.vb0) PV1(1, f.vb1) PV1(2, f.vb2) PV1(3, f.vb3)
#undef PV1
    }
}
template <class VFA, class VFB>
__device__ __forceinline__ void attn_step2(const unsigned char* Kl, const unsigned char* Vl, int lane, const LaneOfs& f,
                                           const bf16x8& qA0, const bf16x8& qA1, f32x4 (&oA)[4], float& mA, f32x4& lA, float biasA, bool fullA, VFA validA,
                                           const bf16x8& qB0, const bf16x8& qB1, f32x4 (&oB)[4], float& mB, f32x4& lB, float biasB, bool fullB, VFB validB) {
    f32x4 sA[4], sB[4];
    const bool mokA = mA > -1e29f, mokB = mB > -1e29f;
    const float meA = mokA ? mA : 0.f, meB = mokB ? mB : 0.f;
    const float iA = biasA - meA, iB = biasB - meB;
#pragma unroll
    for (int kt = 0; kt < 4; ++kt) {
        const bf16x8 a0 = *(const bf16x8*)(Kl + f.k0 + kt * 2048);
        const bf16x8 a1 = *(const bf16x8*)(Kl + f.k1 + kt * 2048);
        f32x4 zA = (f32x4){iA, iA, iA, iA}, zB = (f32x4){iB, iB, iB, iB};
        zA = __builtin_amdgcn_mfma_f32_16x16x32_bf16(a0, qA0, zA, 0, 0, 0);
        zB = __builtin_amdgcn_mfma_f32_16x16x32_bf16(a0, qB0, zB, 0, 0, 0);
        sA[kt] = __builtin_amdgcn_mfma_f32_16x16x32_bf16(a1, qA1, zA, 0, 0, 0);
        sB[kt] = __builtin_amdgcn_mfma_f32_16x16x32_bf16(a1, qB1, zB, 0, 0, 0);
    }
    if (!fullA) {
#pragma unroll
        for (int kt = 0; kt < 4; ++kt)
#pragma unroll
            for (int r = 0; r < 4; ++r) sA[kt][r] = validA(kt * 16 + 4 * (lane >> 4) + r) ? sA[kt][r] : NEGM;
    }
    if (!fullB) {
#pragma unroll
        for (int kt = 0; kt < 4; ++kt)
#pragma unroll
            for (int r = 0; r < 4; ++r) sB[kt][r] = validB(kt * 16 + 4 * (lane >> 4) + r) ? sB[kt][r] : NEGM;
    }
    float mxA = fmaxf(fmaxf(fmaxf(sA[0][0], sA[0][1]), fmaxf(sA[0][2], sA[0][3])), fmaxf(fmaxf(sA[1][0], sA[1][1]), fmaxf(sA[1][2], sA[1][3])));
    float mxB = fmaxf(fmaxf(fmaxf(sB[0][0], sB[0][1]), fmaxf(sB[0][2], sB[0][3])), fmaxf(fmaxf(sB[1][0], sB[1][1]), fmaxf(sB[1][2], sB[1][3])));
    mxA = fmaxf(mxA, fmaxf(fmaxf(fmaxf(sA[2][0], sA[2][1]), fmaxf(sA[2][2], sA[2][3])), fmaxf(fmaxf(sA[3][0], sA[3][1]), fmaxf(sA[3][2], sA[3][3]))));
    mxB = fmaxf(mxB, fmaxf(fmaxf(fmaxf(sB[2][0], sB[2][1]), fmaxf(sB[2][2], sB[2][3])), fmaxf(fmaxf(sB[3][0], sB[3][1]), fmaxf(sB[3][2], sB[3][3]))));
    mxA = xrow_max(mxA); mxB = xrow_max(mxB);
    if (!__all(mokA && mokB && (mxA <= 8.f) && (mxB <= 8.f))) {
        const float mnA = fmaxf(mA, meA + mxA), mnB = fmaxf(mB, meB + mxB);
        const float alA = __builtin_amdgcn_exp2f(mA - mnA), alB = __builtin_amdgcn_exp2f(mB - mnB);
        const float dA = mnA - meA, dB = mnB - meB;
        mA = mnA; mB = mnB; lA[0] *= alA; lB[0] *= alB;
#pragma unroll
        for (int dt = 0; dt < 4; ++dt) {
            oA[dt][0] *= alA; oA[dt][1] *= alA; oA[dt][2] *= alA; oA[dt][3] *= alA;
            oB[dt][0] *= alB; oB[dt][1] *= alB; oB[dt][2] *= alB; oB[dt][3] *= alB;
        }
#pragma unroll
        for (int kt = 0; kt < 4; ++kt) {
            sA[kt][0] -= dA; sA[kt][1] -= dA; sA[kt][2] -= dA; sA[kt][3] -= dA;
            sB[kt][0] -= dB; sB[kt][1] -= dB; sB[kt][2] -= dB; sB[kt][3] -= dB;
        }
    }
#pragma unroll
    for (int kt = 0; kt < 4; ++kt)
#pragma unroll
        for (int r = 0; r < 4; ++r) { sA[kt][r] = __builtin_amdgcn_exp2f(sA[kt][r]); sB[kt][r] = __builtin_amdgcn_exp2f(sB[kt][r]); }
#pragma unroll
    for (int k2 = 0; k2 < 2; ++k2) {
        uint4 pk;
        pk.x = pack2bf(sA[2 * k2][0], sA[2 * k2][1]); pk.y = pack2bf(sA[2 * k2][2], sA[2 * k2][3]);
        pk.z = pack2bf(sA[2 * k2 + 1][0], sA[2 * k2 + 1][1]); pk.w = pack2bf(sA[2 * k2 + 1][2], sA[2 * k2 + 1][3]);
        const bf16x8 pbA = __builtin_bit_cast(bf16x8, pk);
        pk.x = pack2bf(sB[2 * k2][0], sB[2 * k2][1]); pk.y = pack2bf(sB[2 * k2][2], sB[2 * k2][3]);
        pk.z = pack2bf(sB[2 * k2 + 1][0], sB[2 * k2 + 1][1]); pk.w = pack2bf(sB[2 * k2 + 1][2], sB[2 * k2 + 1][3]);
        const bf16x8 pbB = __builtin_bit_cast(bf16x8, pk);
        lA = __builtin_amdgcn_mfma_f32_16x16x32_bf16(ONES_BF16X8, pbA, lA, 0, 0, 0);
        lB = __builtin_amdgcn_mfma_f32_16x16x32_bf16(ONES_BF16X8, pbB, lB, 0, 0, 0);
#define PV2(dt_, vb_) { const uint2 lo_ = tr_read(Vl + (vb_) + k2 * 4096), hi_ = tr_read(Vl + (vb_) + k2 * 4096 + 2048); \
                        uint4 av_; av_.x = lo_.x; av_.y = lo_.y; av_.z = hi_.x; av_.w = hi_.y;                          \
                        oA[dt_] = __builtin_amdgcn_mfma_f32_16x16x32_bf16(__builtin_bit_cast(bf16x8, av_), pbA, oA[dt_], 0, 0, 0); \
                        oB[dt_] = __builtin_amdgcn_mfma_f32_16x16x32_bf16(__builtin_bit_cast(bf16x8, av_), pbB, oB[dt_], 0, 0, 0); }
        PV2(0, f.vb0) PV2(1, f.vb1) PV2(2, f.vb2) PV2(3, f.vb3)
#undef PV2
    }
}

#define NSA_TILES 2048
__device__ __forceinline__ void nsa_tile(const Params& p, int tile, unsigned char* smem) {
    const int tid = opaque_tid(), lane = tid & 63, w = __builtin_amdgcn_readfirstlane(tid >> 6);
    const int bg = tile & 7, tb = 255 - (tile >> 3);
    const int b = bg >> 1, g = bg & 1;
    const int t0 = tb * 32, cur = t0 >> 6;
    float* impL = (float*)(smem + 32768);
    unsigned* selL = (unsigned*)(smem + 49152);
    const bf16_t* NQ = (const bf16_t*)(p.ws + OFF_NQ);
    const float* NG = (const float*)(p.ws + OFF_NGATE);
    const int rowq = lane & 15, tl = rowq >> 2, head = rowq & 3, lg = lane >> 4;
    const int toklA = 8 * w + tl, toklB = 8 * w + 4 + tl;
    const LaneOfs lof = make_lane_ofs(lane);
    const StageOfs sof = make_stage_ofs();
    const size_t tokb = (size_t)b * SEQ + t0;
    bf16x8 qA0, qA1, qB0, qB1;
    {
        const bf16_t* qp = NQ + (tokb + toklA) * 512 + g * 256 + head * 64 + lg * 8;
        qA0 = *(const bf16x8*)qp; qA1 = *(const bf16x8*)(qp + 32);
        qB0 = *(const bf16x8*)(qp + 4 * 512); qB1 = *(const bf16x8*)(qp + 4 * 512 + 32);
    }
    const float* gpA = NG + (tokb + toklA) * 24 + g * 12 + head * 3;
    const float* gpB = gpA + 4 * 24;
    __syncthreads();
    for (int i = tid; i < 4096; i += 256) impL[i] = 0.f;
    const int tqA = t0 + toklA, tqB = t0 + toklB;
    const int tminA = t0 + 8 * w, tminB = tminA + 4;
    f32x4 oA[4], oB[4], otA[4], otB[4];
    float mA, mB;
    f32x4 lA, lB;
#define NSA_RESET() { _Pragma("unroll") for (int dt = 0; dt < 4; ++dt) { oA[dt] = (f32x4){0.f, 0.f, 0.f, 0.f}; oB[dt] = (f32x4){0.f, 0.f, 0.f, 0.f}; } \
                      mA = -1e30f; mB = -1e30f; lA = (f32x4){0.f, 0.f, 0.f, 0.f}; lB = (f32x4){0.f, 0.f, 0.f, 0.f}; }
#define NSA_LSUM() { }

    const int nvA = (tqA >= 31) ? (((tqA - 31) >> 4) + 1) : 0;
    const int nvB = (tqB >= 31) ? (((tqB - 31) >> 4) + 1) : 0;
    const int nvminA = (tminA >= 31) ? (((tminA - 31) >> 4) + 1) : 0;
    const int nvminB = (tminB >= 31) ? (((tminB - 31) >> 4) + 1) : 0;
    const int nkb = (((t0 >> 4) + 1) + 63) >> 6;
    const bf16_t* ckb = (const bf16_t*)(p.ws + OFF_CMPKB) + (size_t)(b * 2 + g) * 512 * 64;
    const bf16_t* cvb = (const bf16_t*)(p.ws + OFF_CMPVB) + (size_t)(b * 2 + g) * 512 * 64;
    NSA_RESET()
    nsa_kv_loop(ckb, cvb, 64, 0, nkb - 1, smem, sof, [&](int kb, const unsigned char* Kl, const unsigned char* Vl) __attribute__((always_inline)) {
        attn_step2(Kl, Vl, lane, lof,
                   qA0, qA1, oA, mA, lA, 0.f, kb * 64 + 64 <= nvminA, [&](int key) __attribute__((always_inline)) { return kb * 64 + key < nvA; },
                   qB0, qB1, oB, mB, lB, 0.f, kb * 64 + 64 <= nvminB, [&](int key) __attribute__((always_inline)) { return kb * 64 + key < nvB; });
    });
    NSA_LSUM()
    const float mcA = mA, mcB = mB;
    const float invcA = 1.f / fmaxf(lA[0], 1e-30f), invcB = 1.f / fmaxf(lB[0], 1e-30f);
    {
        const float fA = gpA[0] * invcA, fB = gpB[0] * invcB;
#pragma unroll
        for (int dt = 0; dt < 4; ++dt) {
            otA[dt][0] = fA * oA[dt][0]; otA[dt][1] = fA * oA[dt][1]; otA[dt][2] = fA * oA[dt][2]; otA[dt][3] = fA * oA[dt][3];
            otB[dt][0] = fB * oB[dt][0]; otB[dt][1] = fB * oB[dt][1]; otB[dt][2] = fB * oB[dt][2]; otB[dt][3] = fB * oB[dt][3];
        }
    }
    if (cur >= 16) {
        nsa_kv_loop(ckb, cvb, 64, 0, nkb - 1, smem, sof, [&](int kb, const unsigned char* Kl, const unsigned char* Vl) __attribute__((always_inline)) {
#pragma unroll
            for (int mt = 0; mt < 2; ++mt) {
                f32x4 s[4];
                nsa_scores(Kl, lof, mt ? qB0 : qA0, mt ? qB1 : qA1, 0.f, s);
                const int nv = mt ? nvB : nvA;
                const float mc = mt ? mcB : mcA, inv = mt ? invcB : invcA;
                float* impT = impL + (mt ? toklB : toklA) * 128;
#pragma unroll
                for (int kt = 0; kt < 4; ++kt) {
                    float pr[4];
#pragma unroll
                    for (int r = 0; r < 4; ++r) {
                        const int n = kb * 64 + kt * 16 + 4 * lg + r;
                        pr[r] = (n < nv) ? __builtin_amdgcn_exp2f(s[kt][r] - mc) * inv : 0.f;
                    }
                    float c1 = pr[0] + pr[1] + pr[2] + 0.5f * pr[3], c2 = 0.5f * pr[3];
                    c1 += __shfl_xor(c1, 1); c1 += __shfl_xor(c1, 2);
                    c2 += __shfl_xor(c2, 1); c2 += __shfl_xor(c2, 2);
                    const int j = kb * 16 + kt * 4 + lg;
                    if (head == 0) {
                        atomicAdd(&impT[j], c1);
                        if (j + 1 < 128) atomicAdd(&impT[j + 1], c2);
                    }
                }
                    }
        });
#pragma unroll 1
        for (int pass = 0; pass < 2; ++pass) {
            const int tok = 8 * w + 4 * pass + lg, c = lane & 15;
            const float4 i0 = *(const float4*)(impL + tok * 128 + 8 * c), i1 = *(const float4*)(impL + tok * 128 + 8 * c + 4);
            const float iv[8] = {i0.x, i0.y, i0.z, i0.w, i1.x, i1.y, i1.z, i1.w};
            float kl[8];
#pragma unroll
            for (int q = 0; q < 8; ++q) {
                const int j = 8 * c + q;
                const bool forced = (j == 0) || (j == cur) || (j == cur - 1);
                const float sc = forced ? 1.0e4f : ((j <= cur) ? iv[q] : -1.f);
                kl[q] = enc_key(sc, (unsigned)j, 127);
            }
            float l0 = kl[0], l1 = kl[1], l2 = kl[2], l3 = kl[3], l4 = kl[4], l5 = kl[5], l6 = kl[6], l7 = kl[7];
            CE_DESC(l0, l1) CE_DESC(l2, l3) CE_DESC(l4, l5) CE_DESC(l6, l7)
            CE_DESC(l0, l2) CE_DESC(l1, l3) CE_DESC(l4, l6) CE_DESC(l5, l7)
            CE_DESC(l1, l2) CE_DESC(l5, l6)
            CE_DESC(l0, l4) CE_DESC(l1, l5) CE_DESC(l2, l6) CE_DESC(l3, l7)
            CE_DESC(l2, l4) CE_DESC(l3, l5)
            CE_DESC(l1, l2) CE_DESC(l3, l4) CE_DESC(l5, l6)
            unsigned pm = 0u;
#pragma unroll
            for (int k = 0; k < 16; ++k) {
                const float mx = row16_max(l0);
                const bool win = (l0 == mx);
                pm |= win ? (1u << (dec_idx(l0, 127) & 7u)) : 0u;
                l0 = win ? l1 : l0; l1 = win ? l2 : l1; l2 = win ? l3 : l2; l3 = win ? l4 : l3;
                l4 = win ? l5 : l4; l5 = win ? l6 : l5; l6 = win ? l7 : l6; l7 = win ? NEGKEY : l7;
            }
            ((unsigned char*)selL)[tok * 16 + c] = (unsigned char)pm;
        }
    } else {
        if (lane < 8) {
            const int tok = 8 * w + lane;
            selL[tok * 4 + 0] = (2u << cur) - 1u; selL[tok * 4 + 1] = 0u; selL[tok * 4 + 2] = 0u; selL[tok * 4 + 3] = 0u;
        }
    }
    WAVE_LDS_SYNC();
#if NSA_DIAG
    if (head == 0 && lg == 0) {
        unsigned* SELM = (unsigned*)(p.ws + OFF_SELM);
#pragma unroll
        for (int qd = 0; qd < 4; ++qd) {
            SELM[((size_t)bg * SEQ + tqA) * 4 + qd] = selL[toklA * 4 + qd];
            SELM[((size_t)bg * SEQ + tqB) * 4 + qd] = selL[toklB * 4 + qd];
        }
    }
#endif
    NSA_RESET()
    {
        const bf16_t* kg = (const bf16_t*)(p.ws + OFF_KV + 2 * KV_STRIDE) + (size_t)b * SEQ * 128 + g * 64;
        const bf16_t* vg = (const bf16_t*)(p.ws + OFF_KV + 3 * KV_STRIDE) + (size_t)b * SEQ * 128 + g * 64;
        nsa_kv_loop(kg, vg, 128, 0, cur, smem, sof, [&](int kb, const unsigned char* Kl, const unsigned char* Vl) __attribute__((always_inline)) {
            const bool svA = (selL[toklA * 4 + (kb >> 5)] >> (kb & 31)) & 1u;
            const bool svB = (selL[toklB * 4 + (kb >> 5)] >> (kb & 31)) & 1u;
            const bool nA = __ballot(svA) != 0ull, nB = __ballot(svB) != 0ull;
            if (nA && nB)
                attn_step2(Kl, Vl, lane, lof,
                           qA0, qA1, oA, mA, lA, svA ? 0.f : NEGM, kb < cur, [&](int key) __attribute__((always_inline)) { return kb * 64 + key <= tqA; },
                           qB0, qB1, oB, mB, lB, svB ? 0.f : NEGM, kb < cur, [&](int key) __attribute__((always_inline)) { return kb * 64 + key <= tqB; });
            else if (nA)
                attn_step(Kl, Vl, lane, lof, qA0, qA1, oA, mA, lA, svA ? 0.f : NEGM, kb < cur, [&](int key) __attribute__((always_inline)) { return kb * 64 + key <= tqA; });
            else if (nB)
                attn_step(Kl, Vl, lane, lof, qB0, qB1, oB, mB, lB, svB ? 0.f : NEGM, kb < cur, [&](int key) __attribute__((always_inline)) { return kb * 64 + key <= tqB; });
        });
    }
    NSA_LSUM()
    {
        const float fA = gpA[1] / fmaxf(lA[0], 1e-30f), fB = gpB[1] / fmaxf(lB[0], 1e-30f);
#pragma unroll
        for (int dt = 0; dt < 4; ++dt) {
            otA[dt][0] += fA * oA[dt][0]; otA[dt][1] += fA * oA[dt][1]; otA[dt][2] += fA * oA[dt][2]; otA[dt][3] += fA * oA[dt][3];
            otB[dt][0] += fB * oB[dt][0]; otB[dt][1] += fB * oB[dt][1]; otB[dt][2] += fB * oB[dt][2]; otB[dt][3] += fB * oB[dt][3];
        }
    }
    NSA_RESET()
    {
        const bf16_t* kg = (const bf16_t*)(p.ws + OFF_KV + 4 * KV_STRIDE) + (size_t)b * SEQ * 128 + g * 64;
        const bf16_t* vg = (const bf16_t*)(p.ws + OFF_KV + 5 * KV_STRIDE) + (size_t)b * SEQ * 128 + g * 64;
        const int klo = (t0 > 511) ? ((t0 - 511) >> 6) : 0;
        nsa_kv_loop(kg, vg, 128, klo, cur, smem, sof, [&](int kb, const unsigned char* Kl, const unsigned char* Vl) __attribute__((always_inline)) {
            attn_step2(Kl, Vl, lane, lof,
                       qA0, qA1, oA, mA, lA, 0.f, (kb * 64 >= tminA + 3 - 511) && (kb * 64 + 63 <= tminA),
                       [&](int key) __attribute__((always_inline)) { const int ka = kb * 64 + key; return (ka <= tqA) && (ka >= tqA - 511); },
                       qB0, qB1, oB, mB, lB, 0.f, (kb * 64 >= tminB + 3 - 511) && (kb * 64 + 63 <= tminB),
                       [&](int key) __attribute__((always_inline)) { const int ka = kb * 64 + key; return (ka <= tqB) && (ka >= tqB - 511); });
        });
    }
    NSA_LSUM()
    {
        const float fA = gpA[2] / fmaxf(lA[0], 1e-30f), fB = gpB[2] / fmaxf(lB[0], 1e-30f);
        bf16_t* MIX = (bf16_t*)(p.ws + OFF_XB) + (tokb + toklA) * DM + 512 + g * 256 + head * 64 + lg * 4;
#pragma unroll
        for (int dt = 0; dt < 4; ++dt) {
            uint2 ov;
            ov.x = pack2bf(otA[dt][0] + fA * oA[dt][0], otA[dt][1] + fA * oA[dt][1]);
            ov.y = pack2bf(otA[dt][2] + fA * oA[dt][2], otA[dt][3] + fA * oA[dt][3]);
            *(uint2*)(MIX + dt * 16) = ov;
            ov.x = pack2bf(otB[dt][0] + fB * oB[dt][0], otB[dt][1] + fB * oB[dt][1]);
            ov.y = pack2bf(otB[dt][2] + fB * oB[dt][2], otB[dt][3] + fB * oB[dt][3]);
            *(uint2*)(MIX + 4 * DM + dt * 16) = ov;
        }
    }
#undef NSA_RESET
#undef NSA_LSUM
}

__device__ __forceinline__ float block_sum(float v, float* red) {
    v = wave_sum(v);
    __syncthreads();
    if ((threadIdx.x & 63) == 0) red[threadIdx.x >> 6] = v;
    __syncthreads();
    return red[0] + red[1] + red[2] + red[3];
}
__device__ __forceinline__ float4 ln_row(float4 y, const float* g, const float* bb, float* red) {
    const int tid = opaque_tid();
    const float mu = block_sum(y.x + y.y + y.z + y.w, red) * (1.f / 1024.f);
    const float dx = y.x - mu, dy = y.y - mu, dz = y.z - mu, dw = y.w - mu;
    const float var = block_sum(dx * dx + dy * dy + dz * dz + dw * dw, red) * (1.f / 1024.f);
    const float rs = rsqrtf(var + LN_EPS);
    const float4 gg = ((const float4*)g)[tid], b4 = ((const float4*)bb)[tid];
    return make_float4(dx * rs * gg.x + b4.x, dy * rs * gg.y + b4.y, dz * rs * gg.z + b4.z, dw * rs * gg.w + b4.w);
}

__device__ __forceinline__ void ln1_phase(const Params& p, float* sm) {
    const int tid = opaque_tid(), lane = tid & 63, w = __builtin_amdgcn_readfirstlane(tid >> 6);
    const float4* g4 = (const float4*)(p.in[15] + 16 * lane);
    const float4* b4 = (const float4*)(p.in[16] + 16 * lane);
    const float4 ga = g4[0], gb = g4[1], gc = g4[2], gd = g4[3];
    const float4 ba = b4[0], bb = b4[1], bc = b4[2], bd = b4[3];
#pragma unroll 2
    for (int n = blockIdx.x * 4 + w; n < NTOK; n += gridDim.x * 4) {
        const float4* xr = (const float4*)(p.in[0] + (size_t)n * DM + 16 * lane);
        const uint4* mr = (const uint4*)((const bf16_t*)p.out + (size_t)n * DM + 16 * lane);
        const float4 y0 = xr[0], y1 = xr[1], y2 = xr[2], y3 = xr[3];
        const uint4 m0 = mr[0], m1 = mr[1];
        float y[16] = {ALPHA * y0.x + bf2f(m0.x & 0xffffu), ALPHA * y0.y + bf2f(m0.x >> 16), ALPHA * y0.z + bf2f(m0.y & 0xffffu), ALPHA * y0.w + bf2f(m0.y >> 16),
                       ALPHA * y1.x + bf2f(m0.z & 0xffffu), ALPHA * y1.y + bf2f(m0.z >> 16), ALPHA * y1.z + bf2f(m0.w & 0xffffu), ALPHA * y1.w + bf2f(m0.w >> 16),
                       ALPHA * y2.x + bf2f(m1.x & 0xffffu), ALPHA * y2.y + bf2f(m1.x >> 16), ALPHA * y2.z + bf2f(m1.y & 0xffffu), ALPHA * y2.w + bf2f(m1.y >> 16),
                       ALPHA * y3.x + bf2f(m1.z & 0xffffu), ALPHA * y3.y + bf2f(m1.z >> 16), ALPHA * y3.z + bf2f(m1.w & 0xffffu), ALPHA * y3.w + bf2f(m1.w >> 16)};
        const float g[16] = {ga.x, ga.y, ga.z, ga.w, gb.x, gb.y, gb.z, gb.w, gc.x, gc.y, gc.z, gc.w, gd.x, gd.y, gd.z, gd.w};
        const float bv[16] = {ba.x, ba.y, ba.z, ba.w, bb.x, bb.y, bb.z, bb.w, bc.x, bc.y, bc.z, bc.w, bd.x, bd.y, bd.z, bd.w};
        float sum = 0.f;
#pragma unroll
        for (int q = 0; q < 16; ++q) sum += y[q];
        const float mu = wave_sum(sum) * (1.f / 1024.f);
        float sq = 0.f;
#pragma unroll
        for (int q = 0; q < 16; ++q) { y[q] -= mu; sq += y[q] * y[q]; }
        const float rs = rsqrtf(wave_sum(sq) * (1.f / 1024.f) + LN_EPS);
        uint4 o0, o1;
        o0.x = pack2bf(y[0] * rs * g[0] + bv[0], y[1] * rs * g[1] + bv[1]);     o0.y = pack2bf(y[2] * rs * g[2] + bv[2], y[3] * rs * g[3] + bv[3]);
        o0.z = pack2bf(y[4] * rs * g[4] + bv[4], y[5] * rs * g[5] + bv[5]);     o0.w = pack2bf(y[6] * rs * g[6] + bv[6], y[7] * rs * g[7] + bv[7]);
        o1.x = pack2bf(y[8] * rs * g[8] + bv[8], y[9] * rs * g[9] + bv[9]);     o1.y = pack2bf(y[10] * rs * g[10] + bv[10], y[11] * rs * g[11] + bv[11]);
        o1.z = pack2bf(y[12] * rs * g[12] + bv[12], y[13] * rs * g[13] + bv[13]); o1.w = pack2bf(y[14] * rs * g[14] + bv[14], y[15] * rs * g[15] + bv[15]);
        uint4* hb = (uint4*)((bf16_t*)(p.ws + OFF_XB) + (size_t)n * DM + 16 * lane);
        hb[0] = o0; hb[1] = o1;
    }
}


typedef float f32x2 __attribute__((ext_vector_type(2)));
__device__ __forceinline__ void cvt_rows_fp8(const float* __restrict__ src, unsigned char* __restrict__ dst, float* __restrict__ scales, int rows,
                                             int first_block, int nblocks) {
    const int tid_ = opaque_tid(), lane = tid_ & 63, w = __builtin_amdgcn_readfirstlane(tid_ >> 6);
    for (int r = ((int)blockIdx.x - first_block) * 4 + w; r < rows; r += nblocks * 4) {
        const float4* sp = (const float4*)(src + (size_t)r * 1024 + lane * 16);
        const float4 a = sp[0], b = sp[1], c = sp[2], d = sp[3];
        float mx = fmaxf(fmaxf(fmaxf(fabsf(a.x), fabsf(a.y)), fmaxf(fabsf(a.z), fabsf(a.w))), fmaxf(fmaxf(fabsf(b.x), fabsf(b.y)), fmaxf(fabsf(b.z), fabsf(b.w))));
        mx = fmaxf(mx, fmaxf(fmaxf(fmaxf(fabsf(c.x), fabsf(c.y)), fmaxf(fabsf(c.z), fabsf(c.w))), fmaxf(fmaxf(fabsf(d.x), fabsf(d.y)), fmaxf(fabsf(d.z), fabsf(d.w)))));
        mx = wave_max(mx);
        const float sc = (mx > 0.f) ? mx * (1.f / 448.f) : 1.f;
        const float inv = 1.f / sc;
        uint4 o;
        int t;
        t = 0; t = __builtin_amdgcn_cvt_pk_fp8_f32(a.x * inv, a.y * inv, t, false); t = __builtin_amdgcn_cvt_pk_fp8_f32(a.z * inv, a.w * inv, t, true); o.x = (unsigned)t;
        t = 0; t = __builtin_amdgcn_cvt_pk_fp8_f32(b.x * inv, b.y * inv, t, false); t = __builtin_amdgcn_cvt_pk_fp8_f32(b.z * inv, b.w * inv, t, true); o.y = (unsigned)t;
        t = 0; t = __builtin_amdgcn_cvt_pk_fp8_f32(c.x * inv, c.y * inv, t, false); t = __builtin_amdgcn_cvt_pk_fp8_f32(c.z * inv, c.w * inv, t, true); o.z = (unsigned)t;
        t = 0; t = __builtin_amdgcn_cvt_pk_fp8_f32(d.x * inv, d.y * inv, t, false); t = __builtin_amdgcn_cvt_pk_fp8_f32(d.z * inv, d.w * inv, t, true); o.w = (unsigned)t;
        *(uint4*)(dst + (size_t)r * 1024 + lane * 16) = o;
        if (lane == 0) scales[r] = sc;
    }
}

__device__ __forceinline__ unsigned pack4i8(float a, float b, float c, float d) {
    const int ia = (int)rintf(a), ib = (int)rintf(b), ic = (int)rintf(c), id = (int)rintf(d);
    return (unsigned)(ia & 255) | ((unsigned)(ib & 255) << 8) | ((unsigned)(ic & 255) << 16) | ((unsigned)id << 24);
}
__device__ __forceinline__ void cvt_rows_i8(const float* __restrict__ src, unsigned char* __restrict__ dst, float* __restrict__ scales, int rows,
                                            int first_block, int nblocks) {
    const int tid_ = opaque_tid(), lane = tid_ & 63, w = __builtin_amdgcn_readfirstlane(tid_ >> 6);
    for (int r = ((int)blockIdx.x - first_block) * 4 + w; r < rows; r += nblocks * 4) {
        const float4* sp = (const float4*)(src + (size_t)r * 1024 + lane * 16);
        const float4 a = sp[0], b = sp[1], c = sp[2], d = sp[3];
        float mx = fmaxf(fmaxf(fmaxf(fabsf(a.x), fabsf(a.y)), fmaxf(fabsf(a.z), fabsf(a.w))), fmaxf(fmaxf(fabsf(b.x), fabsf(b.y)), fmaxf(fabsf(b.z), fabsf(b.w))));
        mx = fmaxf(mx, fmaxf(fmaxf(fmaxf(fabsf(c.x), fabsf(c.y)), fmaxf(fabsf(c.z), fabsf(c.w))), fmaxf(fmaxf(fabsf(d.x), fabsf(d.y)), fmaxf(fabsf(d.z), fabsf(d.w)))));
        mx = wave_max(mx);
        const float sc = (mx > 0.f) ? mx * (1.f / 127.f) : 1.f;
        const float inv = 1.f / sc;
        uint4 o;
        o.x = pack4i8(a.x * inv, a.y * inv, a.z * inv, a.w * inv); o.y = pack4i8(b.x * inv, b.y * inv, b.z * inv, b.w * inv);
        o.z = pack4i8(c.x * inv, c.y * inv, c.z * inv, c.w * inv); o.w = pack4i8(d.x * inv, d.y * inv, d.z * inv, d.w * inv);
        *(uint4*)(dst + (size_t)r * 1024 + lane * 16) = o;
        if (lane == 0) scales[r] = sc;
    }
}

__device__ __forceinline__ void fold_ws_phase(const float* __restrict__ wq, const float* __restrict__ k1, const float* __restrict__ k2,
                                              bf16_t* __restrict__ WsT) {
    for (int it = blockIdx.x * 256 + threadIdx.x; it < 2048 * 128; it += gridDim.x * 256) {
        const int r = it & 2047, kg = it >> 11;
        const int a = (r >> 7) & 1, j = r & 127;
        const float* kr = (a ? k2 : k1) + j * 128;
        const float* wr = wq + (size_t)(kg * 8) * 2048 + (r & ~127);
        float s[8];
#pragma unroll
        for (int q = 0; q < 8; ++q) s[q] = 0.f;
        for (int d = 0; d < 128; d += 4) {
            const float4 kv = *(const float4*)(kr + d);
#pragma unroll
            for (int q = 0; q < 8; ++q) {
                const float4 wv = *(const float4*)(wr + (size_t)q * 2048 + d);
                s[q] += wv.x * kv.x + wv.y * kv.y + wv.z * kv.z + wv.w * kv.w;
            }
        }
        uint4 o;
        o.x = pack2bf(s[0], s[1]); o.y = pack2bf(s[2], s[3]); o.z = pack2bf(s[4], s[5]); o.w = pack2bf(s[6], s[7]);
        *(uint4*)(WsT + (size_t)r * 1024 + kg * 8) = o;
    }
}


struct EpiTop16 {
    static constexpr bool kRow = false;
    float* topk; unsigned char* lds;
    __device__ __forceinline__ void operator()(int m, int n, f32x4 v) const {
        const int ml = m & 127, g4 = (n & 127) >> 2;
        *(float4*)(lds + ((ml * 32 + (g4 ^ (ml & 7))) << 4)) = make_float4(v[0], v[1], v[2], v[3]);
    }
    template <class F> __device__ __forceinline__ void dispatch(int, F f) const { f(*this); }
    __device__ __forceinline__ void finish(int m0, int n0) const {
        __syncthreads();
        const int tid_ = opaque_tid(), lane = tid_ & 63, w = __builtin_amdgcn_readfirstlane(tid_ >> 6), c = lane & 15;
        const int L = n0 >> 7;
#pragma unroll 2
        for (int it = 0; it < 8; ++it) {
            const int r = w * 32 + it * 4 + (lane >> 4);
            const float4 x0 = *(const float4*)(lds + ((r * 32 + ((2 * c) ^ (r & 7))) << 4));
            const float4 x1 = *(const float4*)(lds + ((r * 32 + ((2 * c + 1) ^ (r & 7))) << 4));
            float l0 = enc_key(x0.x, 8 * c + 0, 127), l1 = enc_key(x0.y, 8 * c + 1, 127), l2 = enc_key(x0.z, 8 * c + 2, 127),
                  l3 = enc_key(x0.w, 8 * c + 3, 127), l4 = enc_key(x1.x, 8 * c + 4, 127), l5 = enc_key(x1.y, 8 * c + 5, 127),
                  l6 = enc_key(x1.z, 8 * c + 6, 127), l7 = enc_key(x1.w, 8 * c + 7, 127);
            CE_DESC(l0, l1) CE_DESC(l2, l3) CE_DESC(l4, l5) CE_DESC(l6, l7)
            CE_DESC(l0, l2) CE_DESC(l1, l3) CE_DESC(l4, l6) CE_DESC(l5, l7)
            CE_DESC(l1, l2) CE_DESC(l5, l6)
            CE_DESC(l0, l4) CE_DESC(l1, l5) CE_DESC(l2, l6) CE_DESC(l3, l7)
            CE_DESC(l2, l4) CE_DESC(l3, l5)
            CE_DESC(l1, l2) CE_DESC(l3, l4) CE_DESC(l5, l6)
            float res = NEGKEY;
#pragma unroll
            for (int k = 0; k < 16; ++k) {
                const float mx = row16_max(l0);
                const bool win = (l0 == mx);
                l0 = win ? l1 : l0; l1 = win ? l2 : l1; l2 = win ? l3 : l2; l3 = win ? l4 : l3;
                l4 = win ? l5 : l4; l5 = win ? l6 : l5; l6 = win ? l7 : l6; l7 = win ? NEGKEY : l7;
                res = (c == k) ? mx : res;
            }
            topk[(size_t)(m0 + r) * 256 + L * 16 + c] = res;
        }
        __syncthreads();
    }
};

template <int PART>
__device__ __forceinline__ void peer_fast_phase(const Params& p, unsigned char* smem) {
    const int tid = opaque_tid(), lane = tid & 63, w = __builtin_amdgcn_readfirstlane(tid >> 6), l16 = lane & 15, gq = lane >> 4;
    float* tk = (float*)(smem + w * 2048);
    int* ex = (int*)(smem + w * 2048 + 1024);
    float* gw = (float*)(smem + w * 2048 + 1536);
    const bf16_t* H1B = (const bf16_t*)(p.ws + OFF_XB);
    const unsigned char* U8 = p.ws + OFF_UB;
    const unsigned char* V8 = p.ws + OFF_VB;
    const float* USC = (const float*)(p.ws + OFF_USC);
    const float* VSC = (const float*)(p.ws + OFF_VSC);
    const float* TOPK = (const float*)(p.ws + OFF_TOPK);
    int ci[4], cj[4];
#pragma unroll
    for (int q = 0; q < 4; ++q) {
        const int s = l16 + 16 * q;
        int i, j;
        if (s < 16) { i = 0; j = s; }
        else if (s < 24) { i = 1; j = s - 16; }
        else if (s < 29) { i = 2; j = s - 24; }
        else if (s < 33) { i = 3; j = s - 29; }
        else if (s < 36) { i = 4; j = s - 33; }
        else if (s < 42) { i = 5 + ((s - 36) >> 1); j = (s - 36) & 1; }
        else if (s < 50) { i = 8 + (s - 42); j = 0; }
        else { i = -1; j = 0; }
        ci[q] = i; cj[q] = j;
    }
    int* exs = (int*)(smem + 8192 + w * 4096);
    float* gws = (float*)(smem + 8192 + w * 4096 + 2048);
    float* hraw = (float*)(smem + 24576 + w * 2048);
    float* xsc = (float*)(smem + w * 2048);
    int* SEX = (int*)(p.ws + OFF_HQ);
    float* SGW = (float*)(p.ws + OFF_HLF);
    for (int qd = blockIdx.x * 4 + w; qd < NTOK / 4; qd += gridDim.x * 4) {
        const int n0 = qd * 4;
        if (PART == 0) {
        float4 tkn = ((const float4*)(TOPK + (size_t)n0 * 256))[lane];
#pragma unroll 1
        for (int t = 0; t < 4; ++t) {
            const int n = n0 + t;
            WAVE_LDS_SYNC();
            ((float4*)tk)[lane] = tkn;
            {
                int nn = (t < 3) ? n + 1 : (qd + (int)gridDim.x * 4) * 4;
                nn = (nn < NTOK) ? nn : n;
                tkn = ((const float4*)(TOPK + (size_t)nn * 256))[lane];
            }
            WAVE_LDS_SYNC();
#pragma unroll
            for (int it = 0; it < 2; ++it) {
                const int head = it * 4 + gq;
                const float* ka = tk + head * 32;
                const float* kb = ka + 16;
                float c0, c1, c2, c3;
#define MKC(q, cq) { if (ci[q] >= 0) { const float sum_ = dec_val(ka[ci[q]], 127) + dec_val(kb[cj[q]], 127); \
                         cq = enc_key(sum_, ci[q] * 16 + cj[q], 255); } else cq = NEGKEY; }
                MKC(0, c0) MKC(1, c1) MKC(2, c2) MKC(3, c3)
#undef MKC
                float res = NEGKEY;
#pragma unroll
                for (int k = 0; k < 16; ++k) {
                    const float mx = row16_max(fmaxf(fmaxf(c0, c1), fmaxf(c2, c3)));
                    c0 = (c0 == mx) ? NEGKEY : c0; c1 = (c1 == mx) ? NEGKEY : c1;
                    c2 = (c2 == mx) ? NEGKEY : c2; c3 = (c3 == mx) ? NEGKEY : c3;
                    res = (l16 == k) ? mx : res;
                }
                const unsigned cc = dec_idx(res, 255);
                const float val = dec_val(res, 255);
                const unsigned e1 = dec_idx(ka[cc >> 4], 127), e2 = dec_idx(kb[cc & 15], 127);
                const float m0 = row16_max(val);
                const float e = expf(val - m0);
                const float ssum = row16_sum(e);
                ex[head * 16 + l16] = (int)(e1 * 128 + e2);
                gw[head * 16 + l16] = e / ssum;
            }
            WAVE_LDS_SYNC();
            {
                const int e0 = ex[lane], e1v = ex[lane + 64];
                const float g0 = gw[lane], g1 = gw[lane + 64];
                const int s0 = e0 >> 11, s1 = e1v >> 11;
                const unsigned long long lt = (1ull << lane) - 1ull;
                int base = 0, p0 = 0, p1 = 0;
#pragma unroll
                for (int s = 0; s < 8; ++s) {
                    const unsigned long long m0 = __ballot(s0 == s), m1 = __ballot(s1 == s);
                    const int c0 = __popcll(m0), c1 = __popcll(m1);
                    if (s0 == s) p0 = base + __popcll(m0 & lt);
                    if (s1 == s) p1 = base + c0 + __popcll(m1 & lt);
                    base += c0 + c1;
                }
                exs[t * 128 + p0] = e0; gws[t * 128 + p0] = g0; exs[t * 128 + p1] = e1v; gws[t * 128 + p1] = g1;
            }
        }
        WAVE_LDS_SYNC();
#pragma unroll
        for (int i = 0; i < 2; ++i) {
            ((uint4*)(SEX + (size_t)n0 * 128))[lane + 64 * i] = ((const uint4*)exs)[lane + 64 * i];
            ((uint4*)(SGW + (size_t)n0 * 128))[lane + 64 * i] = ((const uint4*)gws)[lane + 64 * i];
        }
        } else {
        WAVE_LDS_SYNC();
#pragma unroll
        for (int i = 0; i < 2; ++i) {
            ((uint4*)exs)[lane + 64 * i] = ((const uint4*)(SEX + (size_t)n0 * 128))[lane + 64 * i];
            ((uint4*)gws)[lane + 64 * i] = ((const uint4*)(SGW + (size_t)n0 * 128))[lane + 64 * i];
        }
        }
        if (PART == 1) {
        WAVE_LDS_SYNC();
        {
            int xq[16];
            {
                const uint4* xr = (const uint4*)(H1B + (size_t)(n0 + gq) * DM + 16 * l16);
                uint4 xa0 = xr[0], xb0 = xr[1], xa1 = xr[32], xb1 = xr[33], xa2 = xr[64], xb2 = xr[65], xa3 = xr[96], xb3 = xr[97];
#define BLO(u_) __uint_as_float((u_) << 16)
#define BHI(u_) __uint_as_float((u_) & 0xffff0000u)
#define AMX4(v_) fmaxf(fmaxf(fmaxf(fabsf(BLO((v_).x)), fabsf(BHI((v_).x))), fmaxf(fabsf(BLO((v_).y)), fabsf(BHI((v_).y)))),                  \
                       fmaxf(fmaxf(fabsf(BLO((v_).z)), fabsf(BHI((v_).z))), fmaxf(fabsf(BLO((v_).w)), fabsf(BHI((v_).w)))))
                float mx = fmaxf(fmaxf(fmaxf(AMX4(xa0), AMX4(xb0)), fmaxf(AMX4(xa1), AMX4(xb1))), fmaxf(fmaxf(AMX4(xa2), AMX4(xb2)), fmaxf(AMX4(xa3), AMX4(xb3))));
                mx = row16_max(mx);
                const float xs = (mx > 0.f) ? mx * (1.f / 127.f) : 1.f;
                const float inv = 1.f / xs;
                xsc[gq] = xs;
#define Q8(i_, va_, vb_) { xq[4 * (i_) + 0] = (int)pack4i8(BLO((va_).x) * inv, BHI((va_).x) * inv, BLO((va_).y) * inv, BHI((va_).y) * inv);   \
                           xq[4 * (i_) + 1] = (int)pack4i8(BLO((va_).z) * inv, BHI((va_).z) * inv, BLO((va_).w) * inv, BHI((va_).w) * inv);   \
                           xq[4 * (i_) + 2] = (int)pack4i8(BLO((vb_).x) * inv, BHI((vb_).x) * inv, BLO((vb_).y) * inv, BHI((vb_).y) * inv);   \
                           xq[4 * (i_) + 3] = (int)pack4i8(BLO((vb_).z) * inv, BHI((vb_).z) * inv, BLO((vb_).w) * inv, BHI((vb_).w) * inv); }
                Q8(0, xa0, xb0) Q8(1, xa1, xb1) Q8(2, xa2, xb2) Q8(3, xa3, xb3)
#undef Q8
#undef AMX4
#undef BLO
#undef BHI
            }
            uint4 ra0, ra1, ra2, ra3, rb0, rb1, rb2, rb3, rc0, rc1, rc2, rc3, rd0, rd1, rd2, rd3;
#define ULOAD(S, kk) { const int e_ = exs[gq * 128 + (kk)]; const uint4* ur_ = (const uint4*)(U8 + (size_t)e_ * DM + 16 * l16);          \
                       S##0 = ur_[0]; S##1 = ur_[16]; S##2 = ur_[32]; S##3 = ur_[48]; }
#define D4(W_, B_) { sA = __builtin_amdgcn_sdot4((int)(W_).x, xq[(B_)], sA, false); sB = __builtin_amdgcn_sdot4((int)(W_).y, xq[(B_) + 1], sB, false); \
                     sA = __builtin_amdgcn_sdot4((int)(W_).z, xq[(B_) + 2], sA, false); sB = __builtin_amdgcn_sdot4((int)(W_).w, xq[(B_) + 3], sB, false); }
#define UCOMP(S, kk) { int sA = 0, sB = 0; D4(S##0, 0) D4(S##1, 4) D4(S##2, 8) D4(S##3, 12)                                               \
                       hraw[gq * 128 + (kk)] = row16_sum((float)(sA + sB)); }
            ULOAD(ra, 0) ULOAD(rb, 1) ULOAD(rc, 2)
#pragma unroll 1
            for (int k = 0; k < 128; k += 4) {
                const int kn = (k + 4 < 128) ? k + 4 : 124;
                ULOAD(rd, k + 3)  UCOMP(ra, k)
                ULOAD(ra, kn)     UCOMP(rb, k + 1)
                ULOAD(rb, kn + 1) UCOMP(rc, k + 2)
                ULOAD(rc, kn + 2) UCOMP(rd, k + 3)
            }
#undef D4
#undef ULOAD
#undef UCOMP
        }
        WAVE_LDS_SYNC();
#pragma unroll
        for (int j = 0; j < 8; ++j) {
            const int idx = lane + 64 * j;
            const int e = exs[idx];
            gws[idx] = gws[idx] * gelu_tanh_fast(hraw[idx] * (xsc[idx >> 7] * USC[e])) * VSC[e];
        }
        WAVE_LDS_SYNC();
#pragma unroll
        for (int i = 0; i < 2; ++i) ((uint4*)(SGW + (size_t)n0 * 128))[lane + 64 * i] = ((const uint4*)gws)[lane + 64 * i];
        }
        if (PART == 2) {
        WAVE_LDS_SYNC();
        {
            f32x2 acc[32];
#pragma unroll
            for (int q = 0; q < 32; ++q) acc[q] = (f32x2){0.f, 0.f};
            uint4 ra0, ra1, ra2, ra3, rb0, rb1, rb2, rb3, rc0, rc1, rc2, rc3, rd0, rd1, rd2, rd3;
#define VLOAD(S, kk) { const int e_ = exs[gq * 128 + (kk)]; const uint4* vr_ = (const uint4*)(V8 + (size_t)e_ * DM + 16 * l16);          \
                       S##0 = vr_[0]; S##1 = vr_[16]; S##2 = vr_[32]; S##3 = vr_[48]; }
#define A4(W_, B_) { acc[(B_)] = __builtin_elementwise_fma(__builtin_amdgcn_cvt_pk_f32_fp8((int)(W_), false), wk2, acc[(B_)]);          \
                     acc[(B_) + 1] = __builtin_elementwise_fma(__builtin_amdgcn_cvt_pk_f32_fp8((int)(W_), true), wk2, acc[(B_) + 1]); }
#define VCOMP(S, kk) { const float wk = gws[gq * 128 + (kk)]; const f32x2 wk2 = (f32x2){wk, wk};                                         \
                       A4((S##0).x, 0) A4((S##0).y, 2) A4((S##0).z, 4) A4((S##0).w, 6) A4((S##1).x, 8) A4((S##1).y, 10) A4((S##1).z, 12) A4((S##1).w, 14) \
                       A4((S##2).x, 16) A4((S##2).y, 18) A4((S##2).z, 20) A4((S##2).w, 22) A4((S##3).x, 24) A4((S##3).y, 26) A4((S##3).z, 28) A4((S##3).w, 30) }
            VLOAD(ra, 0) VLOAD(rb, 1) VLOAD(rc, 2)
#pragma unroll 1
            for (int k = 0; k < 128; k += 4) {
                const int kn = (k + 4 < 128) ? k + 4 : 124;
                VLOAD(rd, k + 3)  VCOMP(ra, k)
                VLOAD(ra, kn)     VCOMP(rb, k + 1)
                VLOAD(rb, kn + 1) VCOMP(rc, k + 2)
                VLOAD(rc, kn + 2) VCOMP(rd, k + 3)
            }
#undef VLOAD
#undef VCOMP
#undef A4
            float* orow = p.out + (size_t)(n0 + gq) * DM + 16 * l16;
            float sum = 0.f;
#pragma unroll
            for (int c = 0; c < 4; ++c)
#pragma unroll
                for (int hq = 0; hq < 4; ++hq) {
                    const uint2 hb_ = *(const uint2*)(H1B + (size_t)(n0 + gq) * DM + 16 * l16 + 256 * c + 4 * hq);
                    const float4 h = make_float4(__uint_as_float(hb_.x << 16), __uint_as_float(hb_.x & 0xffff0000u),
                                                 __uint_as_float(hb_.y << 16), __uint_as_float(hb_.y & 0xffff0000u));
                    f32x2& pa = acc[8 * c + 2 * hq]; f32x2& pb = acc[8 * c + 2 * hq + 1];
                    pa[0] = ALPHA * h.x + pa[0]; pa[1] = ALPHA * h.y + pa[1]; pb[0] = ALPHA * h.z + pb[0]; pb[1] = ALPHA * h.w + pb[1];
                    sum += (pa[0] + pa[1]) + (pb[0] + pb[1]);
                }
            const float mu = row16_sum(sum) * (1.f / 1024.f);
            float sq = 0.f;
#pragma unroll
            for (int q = 0; q < 32; ++q) { acc[q][0] -= mu; acc[q][1] -= mu; sq += acc[q][0] * acc[q][0] + acc[q][1] * acc[q][1]; }
            const float rs = rsqrtf(row16_sum(sq) * (1.f / 1024.f) + LN_EPS);
            const float* g = p.in[22] + 16 * l16;
            const float* bb = p.in[23] + 16 * l16;
#pragma unroll
            for (int c = 0; c < 4; ++c)
#pragma unroll
                for (int hq = 0; hq < 4; ++hq) {
                    const float4 gg = *(const float4*)(g + 256 * c + 4 * hq), b4 = *(const float4*)(bb + 256 * c + 4 * hq);
                    const f32x2 pa = acc[8 * c + 2 * hq], pb = acc[8 * c + 2 * hq + 1];
                    float4 o;
                    o.x = pa[0] * rs * gg.x + b4.x; o.y = pa[1] * rs * gg.y + b4.y;
                    o.z = pb[0] * rs * gg.z + b4.z; o.w = pb[1] * rs * gg.w + b4.w;
                    *(float4*)(orow + 256 * c + 4 * hq) = o;
                }
        }
        }
    }
}

#define XB_TMO      128
#define XB_XCNT(j)  (256  + 64 * (j))
#define XB_XSUB(j)  (1280 + 64 * (j))
#define XB_XGEN(j)  (2304 + 64 * (j))
#define XB_TOP      3328
#define XB_TOPGEN   3392
#define XCD_BAR_WORDS 3456
#define XB_SPIN_CAP (1u << 22)
__device__ __forceinline__ unsigned xb_ld(unsigned* p) { return __hip_atomic_load(p, __ATOMIC_RELAXED, __HIP_MEMORY_SCOPE_AGENT); }
__device__ __forceinline__ unsigned xb_add(unsigned* p, unsigned v) { return __hip_atomic_fetch_add(p, v, __ATOMIC_RELAXED, __HIP_MEMORY_SCOPE_AGENT); }
__device__ __forceinline__ unsigned xb_xcc_id() { return (unsigned)__builtin_amdgcn_s_getreg((3 << 11) | 20) & 0xFu; }
#define XB_SPIN(cond, bar) do { unsigned _sp = 0; while (cond) { __builtin_amdgcn_s_sleep(1); \
    if ((++_sp & 255u) == 0u) { if (xb_ld(&(bar)[XB_TMO])) break; if (_sp > XB_SPIN_CAP) { atomicAdd(&(bar)[XB_TMO], 1u); break; } } } } while (0)
struct XcdBarrier { unsigned* bar; unsigned x; unsigned* st; };
__device__ __forceinline__ XcdBarrier xcd_barrier_post(unsigned* bar, unsigned* st) {
    XcdBarrier b; b.bar = bar; b.x = xb_xcc_id(); b.st = st;
    if (threadIdx.x == 0) (void)xb_add(&bar[XB_XCNT(b.x)], 1u);
    return b;
}
__device__ __forceinline__ void xcd_barrier_complete(unsigned* bar, unsigned x, unsigned& nloc, unsigned& nx) {
    const unsigned G = gridDim.x * gridDim.y * gridDim.z;
    unsigned sum, cnt, mine, sp = 0u;
    for (;;) {
        sum = 0u; cnt = 0u; mine = 0u;
#pragma unroll
        for (unsigned j = 0; j < 16; ++j) { const unsigned c = xb_ld(&bar[XB_XCNT(j)]); sum += c; cnt += (c > 0u) ? 1u : 0u; mine = (j == x) ? c : mine; }
        if (sum == G) break;
        __builtin_amdgcn_s_sleep(1);
        if ((++sp & 255u) == 0u) { if (xb_ld(&bar[XB_TMO])) break; if (sp > XB_SPIN_CAP) { atomicAdd(&bar[XB_TMO], 1u); break; } }
    }
    nloc = mine > 0u ? mine : 1u; nx = cnt > 0u ? cnt : 1u;
}
__device__ __forceinline__ void xcd_barrier(const XcdBarrier& b) {
    asm volatile("s_waitcnt vmcnt(0)" ::: "memory");
    __syncthreads();
    if (threadIdx.x == 0) {
        unsigned* bar = b.bar;
        __builtin_amdgcn_s_waitcnt(0);
        unsigned nloc = xb_ld(&b.st[0]), nx = xb_ld(&b.st[1]);
        if (nloc == 0u) { xcd_barrier_complete(bar, b.x, nloc, nx); __hip_atomic_store(&b.st[0], nloc, __ATOMIC_RELAXED, __HIP_MEMORY_SCOPE_AGENT); __hip_atomic_store(&b.st[1], nx, __ATOMIC_RELAXED, __HIP_MEMORY_SCOPE_AGENT); }
        const unsigned old = xb_add(&bar[XB_XSUB(b.x)], 1u);
        const unsigned gen = old / nloc;
        if (old + 1u == (gen + 1u) * nloc) {
            __builtin_amdgcn_fence(__ATOMIC_RELEASE, "agent");
            asm volatile("s_waitcnt vmcnt(0)" ::: "memory");
            const unsigned og = xb_add(&bar[XB_TOP], 1u);
            const unsigned tg = og / nx;
            if (og + 1u == (tg + 1u) * nx) xb_add(&bar[XB_TOPGEN], 1u);
            else XB_SPIN(xb_ld(&bar[XB_TOPGEN]) == tg, bar);
            __builtin_amdgcn_fence(__ATOMIC_ACQUIRE, "agent");
            xb_add(&bar[XB_XGEN(b.x)], 1u);
            asm volatile("s_waitcnt vmcnt(0)" ::: "memory");
        } else {
            XB_SPIN(xb_ld(&bar[XB_XGEN(b.x)]) == gen, bar);
            __builtin_amdgcn_fence(__ATOMIC_ACQUIRE, "agent");
            asm volatile("s_waitcnt vmcnt(0)" ::: "memory");
        }
    }
    __syncthreads();
}

__global__ void __launch_bounds__(256, 2) mega(Params p) {
    cg::grid_group grid = cg::this_grid();
    __shared__ __attribute__((aligned(16))) unsigned char smem[81920];
    float* sm = (float*)smem;
    unsigned* barw = (unsigned*)(p.ws + OFF_BAR);
    const XcdBarrier xbar = xcd_barrier_post(barw, barw + XCD_BAR_WORDS + 2 * blockIdx.x);
    bf16_t* XB = (bf16_t*)(p.ws + OFF_XB);
    bf16_t* WinT = (bf16_t*)(p.ws + OFF_WINT);
    bf16_t* WoutT = (bf16_t*)(p.ws + OFF_WOUTT);
    bf16_t* WqT = (bf16_t*)(p.ws + OFF_WQT);
    cvt_rows_bf16(p.in[0], XB, (size_t)NTOK * DM / 8);
    transpose_bf16(p.in[1], DIN, 3456, WinT);
    transpose_bf16(p.in[2], DM, DM, WoutT);
    fold_ws_phase(p.in[17], p.in[18], p.in[19], WqT);
    transpose_bf16(p.in[6], 256, 256, (bf16_t*)(p.ws + OFF_W1T), 2048);
    transpose_bf16(p.in[11], 256, 256, (bf16_t*)(p.ws + OFF_W1T) + 256 * 2048, 2048);
    if (blockIdx.x == 0) {
        for (int c = threadIdx.x; c < 512; c += 256)
            ((float*)(p.ws + OFF_LBV))[c] = 1.f / (1.f + expf(p.in[3][512 + c] - p.in[3][c]));
        if (threadIdx.x < 16) ((float*)(p.ws + OFF_DIAG))[threadIdx.x] = 0.f;
    }
    if (blockIdx.x >= 8 && blockIdx.x < 72) cmp_peb_partial(p, blockIdx.x - 8);
    grid.sync();
    if (blockIdx.x == gridDim.x - 1) cmp_peb_reduce(p);
    gemm_bf16_phase3(XB, DM, WinT, DM, NTOK / 256, 27, smem, EpiProj{p.ws});
    xcd_barrier(xbar);
    for (int it = blockIdx.x; it < 128; it += gridDim.x) {
        const int which = it >> 6, t = it & 63;
        gemm_tile(ALoadCmp{(const bf16_t*)(p.ws + OFF_KV + (size_t)which * KV_STRIDE)},
                  (const bf16_t*)(p.ws + OFF_W1T) + (size_t)which * 256 * 2048, 2048, 32, (t >> 1) * 128, (t & 1) * 128, smem,
                  EpiCmpH{(bf16_t*)(p.ws + OFF_HB) + (size_t)which * 4096 * 256, (const float*)(p.ws + OFF_PEB) + which * 256});
    }
    if (gridDim.x >= 256) {
        if (blockIdx.x >= 128)
            for (int it = blockIdx.x - 128; it < 2048; it += gridDim.x - 128) hgrn_passA(p, it, smem);
    } else {
        for (int it = blockIdx.x; it < 2048; it += gridDim.x) hgrn_passA(p, it, smem);
    }
#if NSA_DIAG
    for (int it = blockIdx.x; it < 2 * 4 * NCB * 2; it += gridDim.x) compress_item(p, it, sm);
#endif
    xcd_barrier(xbar);
    if (blockIdx.x < 256) hgrn_scan_item(p, blockIdx.x);
    else {
        cvt_rows_i8(p.in[20], p.ws + OFF_UB, (float*)(p.ws + OFF_USC), 16384, 256, gridDim.x - 256);
        cvt_rows_fp8(p.in[21], p.ws + OFF_VB, (float*)(p.ws + OFF_VSC), 16384, 256, gridDim.x - 256);
    }
    if (gridDim.x <= 256) {
        cvt_rows_i8(p.in[20], p.ws + OFF_UB, (float*)(p.ws + OFF_USC), 16384, 0, gridDim.x);
        cvt_rows_fp8(p.in[21], p.ws + OFF_VB, (float*)(p.ws + OFF_VSC), 16384, 0, gridDim.x);
    }
    cmp_layer2_phase(p, 0, gridDim.x);
    xcd_barrier(xbar);
    {
        const int qi = blockIdx.x & 7;
        unsigned* qctr = barw + XCD_BAR_WORDS + 2 * 1024 + 64 * qi;
        for (;;) {
            __syncthreads();
            if (threadIdx.x == 0) *(volatile unsigned*)smem = atomicAdd(qctr, 1u);
            __syncthreads();
            const int it = (int)__builtin_amdgcn_readfirstlane(*(volatile unsigned*)smem);
            if (it >= 256) break;
            nsa_tile(p, (it << 3) | qi, smem);
        }
        for (;;) {
            __syncthreads();
            if (threadIdx.x == 0) *(volatile unsigned*)smem = atomicAdd(qctr + 32, 1u);
            __syncthreads();
            const int it = (int)__builtin_amdgcn_readfirstlane(*(volatile unsigned*)smem);
            if (it >= 256) break;
            hgrn_passC(p, (it << 3) | qi, smem);
        }
    }
    xcd_barrier(xbar);
#if NSA_DIAG
    for (int it = blockIdx.x; it < 4 * 2 * SEQ; it += gridDim.x) nsa_item(p, it, sm);
    grid.sync();
    {
        const float* DG = (const float*)(p.ws + OFF_DIAG);
#if NSA_DIAG == 1
        const float cval = -log10f(sqrtf(DG[0] / DG[1]) + 1e-9f);
#else
        const float cval = -log10f(DG[2] / DG[3] + 1e-6f);
#endif
        for (size_t i = (size_t)blockIdx.x * 256 + threadIdx.x; i < (size_t)NTOK * DM; i += (size_t)gridDim.x * 256) p.out[i] = cval;
        return;
    }
#endif
    gemm_bf16_phase3(XB, DM, WoutT, DM, NTOK / 256, 8, smem, EpiMix{(bf16_t*)p.out});
    xcd_barrier(xbar);
    ln1_phase(p, sm);
    xcd_barrier(xbar);
    gemm_bf16_phase3(XB, DM, WqT, DM, NTOK / 256, 16, smem, EpiTop16{(float*)(p.ws + OFF_TOPK), smem});
    xcd_barrier(xbar);
    peer_fast_phase<0>(p, smem);
    peer_fast_phase<1>(p, smem);
    peer_fast_phase<2>(p, smem);
}

extern "C" void kernel_launch(void* const* d_in, const int* in_sizes, int n_in, void* d_out, int out_size,
                              void* d_ws, size_t ws_size, hipStream_t stream) {
    static int grid_blocks = 0;
    if (!grid_blocks) {
        int dev = 0, cus = 0, per_cu = 0;
        hipGetDevice(&dev);
        hipDeviceGetAttribute(&cus, hipDeviceAttributeMultiprocessorCount, dev);
        hipOccupancyMaxActiveBlocksPerMultiprocessor(&per_cu, mega, 256, 0);
        if (per_cu > 4) per_cu = 4;
        if (per_cu < 1) per_cu = 1;
        grid_blocks = cus * per_cu;
        if (n_in != 24 || ws_size < WS_NEED || out_size != NTOK * DM)
            fprintf(stderr, "kernel_launch: unexpected sizes n_in=%d ws=%zu out=%d\n", n_in, ws_size, out_size);
    }
    Params p;
    memset(&p, 0, sizeof(p));
    for (int i = 0; i < 24; ++i) p.in[i] = (const float*)d_in[i];
    p.out = (float*)d_out;
    p.ws = (unsigned char*)d_ws;
    hipMemsetAsync((char*)d_ws + OFF_BAR, 0, BAR_BYTES, stream);
    void* args[] = {&p};
    hipError_t e = hipLaunchCooperativeKernel((void*)mega, dim3(grid_blocks), dim3(256), args, 0, stream);
    if (e != hipSuccess) fprintf(stderr, "cooperative launch failed: %s (grid %d)\n", hipGetErrorString(e), grid_blocks);
}
```

```cpp
#include <hip/hip_runtime.h>
#include <hip/hip_cooperative_groups.h>
#include <cstdio>
#include <cstring>
namespace cg = cooperative_groups;

#define NTOK 32768
#define SEQ 8192
#define DM 1024
#define DIN 3352
#define NCB 511
#define ALPHA 1.189207115002721f
#define LN_EPS 1e-5f

#define MB_ 1048576ull
#define OFF_XB 0ull
#define OFF_HQ (64 * MB_)
#define OFF_HLF (96 * MB_)
#define OFF_HI (160 * MB_)
#define OFF_HG (192 * MB_)
#define OFF_NQ (224 * MB_)
#define OFF_KV (256 * MB_)
#define KV_STRIDE (8 * MB_)
#define OFF_NGATE (304 * MB_)
#define OFF_CMPK (308 * MB_)
#define OFF_CMPV (309 * MB_)
#define OFF_WINT (310 * MB_)
#define OFF_WOUTT (317 * MB_)
#define OFF_WQT (319 * MB_)
#define OFF_LBV (323 * MB_)
#define OFF_DC (324 * MB_)
#define OFF_SC (325 * MB_)
#define OFF_UB (389 * MB_)
#define OFF_VB (421 * MB_)
#define OFF_TOPK (453 * MB_)
#define OFF_HREF OFF_TOPK
#define OFF_W1T (485 * MB_)
#define OFF_HB (487 * MB_)
#define OFF_CMPKB (491 * MB_)
#define OFF_CMPVB (491 * MB_ + 524288ull)
#define OFF_PEB (492 * MB_)
#define OFF_SELM (493 * MB_)
#define OFF_DIAG (494 * MB_)
#define OFF_USC (494 * MB_ + 131072ull)
#define OFF_VSC (494 * MB_ + 196608ull)
#define OFF_BAR (494 * MB_ + 65536ull)
#define BAR_BYTES 32768
#define WS_NEED (495 * MB_)
#define USE_NSA_MFMA 1
#define NSA_DIAG 0

struct Params {
    const float* in[24];
    float* out;
    unsigned char* ws;
};

typedef float f32x16 __attribute__((ext_vector_type(16)));
#define WAVE_LDS_SYNC() asm volatile("s_waitcnt lgkmcnt(0)" ::: "memory")
#define LAS3 __attribute__((address_space(3)))

__device__ __forceinline__ int opaque_tid() { int t = threadIdx.x; asm volatile("" : "+v"(t)); return t; }
__device__ __forceinline__ float wave_sum(float v) {
#pragma unroll
    for (int o = 32; o; o >>= 1) v += __shfl_xor(v, o);
    return v;
}
__device__ __forceinline__ float wave_max(float v) {
#pragma unroll
    for (int o = 32; o; o >>= 1) v = fmaxf(v, __shfl_xor(v, o));
    return v;
}
__device__ __forceinline__ float sigmoidf_(float x) { return 1.f / (1.f + expf(-x)); }
__device__ __forceinline__ float exp_fast(float x) { return __builtin_amdgcn_exp2f(1.4426950408889634f * x); }
__device__ __forceinline__ float sigmoid_fast(float x) { return __builtin_amdgcn_rcpf(1.f + __builtin_amdgcn_exp2f(-1.4426950408889634f * x)); }
__device__ __forceinline__ float log_fast(float x) { return 0.6931471805599453f * __builtin_amdgcn_logf(x); }
__device__ __forceinline__ float gelu_tanh_fast(float x) {
    const float u = 0.7978845608028654f * (x + 0.044715f * x * x * x);
    return x * __builtin_amdgcn_rcpf(1.f + __builtin_amdgcn_exp2f(-2.885390081777927f * u));
}
__device__ __forceinline__ float gelu_tanh(float x) {
    const float c = 0.7978845608028654f;
    return 0.5f * x * (1.f + tanhf(c * (x + 0.044715f * x * x * x)));
}

typedef short bf16x8 __attribute__((ext_vector_type(8)));
typedef float f32x4 __attribute__((ext_vector_type(4)));
typedef unsigned short bf16_t;

typedef __bf16 bf16x2_t __attribute__((ext_vector_type(2)));
__device__ __forceinline__ unsigned pack2bf(float lo, float hi) {
    bf16x2_t v; v[0] = (__bf16)lo; v[1] = (__bf16)hi;
    return __builtin_bit_cast(unsigned, v);
}
__device__ __forceinline__ unsigned f2bf(float f) { return pack2bf(f, 0.f) & 0xffffu; }
__device__ __forceinline__ float bf2f(unsigned h) { return __uint_as_float(h << 16); }

__device__ __forceinline__ void cvt_rows_bf16(const float* __restrict__ src, bf16_t* __restrict__ dst, size_t n8) {
    for (size_t i = (size_t)blockIdx.x * 256 + threadIdx.x; i < n8; i += (size_t)gridDim.x * 256) {
        const float4 a = ((const float4*)src)[2 * i], b = ((const float4*)src)[2 * i + 1];
        uint4 o;
        o.x = pack2bf(a.x, a.y); o.y = pack2bf(a.z, a.w); o.z = pack2bf(b.x, b.y); o.w = pack2bf(b.z, b.w);
        ((uint4*)dst)[i] = o;
    }
}
__device__ __forceinline__ void transpose_bf16(const float* __restrict__ src, int Nsrc, int Npad, bf16_t* __restrict__ dst, int K = 1024) {
    const size_t total = (size_t)Npad * (K / 8);
    for (size_t i = (size_t)blockIdx.x * 256 + threadIdx.x; i < total; i += (size_t)gridDim.x * 256) {
        const int n = (int)(i % Npad), kg = (int)(i / Npad);
        float v[8];
#pragma unroll
        for (int j = 0; j < 8; ++j) v[j] = (n < Nsrc) ? src[(size_t)(kg * 8 + j) * Nsrc + n] : 0.f;
        uint4 o;
        o.x = pack2bf(v[0], v[1]); o.y = pack2bf(v[2], v[3]); o.z = pack2bf(v[4], v[5]); o.w = pack2bf(v[6], v[7]);
        *(uint4*)(dst + (size_t)n * K + kg * 8) = o;
    }
}

struct ALoadStd {
    const bf16_t* A; int lda;
    __device__ __forceinline__ const bf16_t* ptr(int row, int ks) const { return A + (size_t)row * lda + ks * 64; }
};
struct ALoadCmp {
    const bf16_t* KC;
    __device__ __forceinline__ const bf16_t* ptr(int row, int ks) const {
        const int r = row < 4088 ? row : 4087;
        const int g = r & 1, bn = r >> 1, n = bn % NCB, b = bn / NCB;
        return KC + ((size_t)(b * SEQ + 16 * n + ks) * 128 + g * 64);
    }
};
#define GLDS1(i, ks, buf) { const int row_ = 8 * w + 32 * (i) + (lane >> 3);                                                    \
        __builtin_amdgcn_global_load_lds((const unsigned*)(aload.ptr(m0 + row_, (ks)) + (((lane & 7) ^ (lane >> 3)) << 3)),      \
                                         (LAS3 unsigned*)(lds + (buf) * 32768 + w * 1024 + (i) * 4096), 16, 0, 0);              \
        __builtin_amdgcn_global_load_lds((const unsigned*)(Bp + (size_t)row_ * ldb + (ks) * 64 + (((lane & 7) ^ (lane >> 3)) << 3)), \
                                         (LAS3 unsigned*)(lds + (buf) * 32768 + 16384 + w * 1024 + (i) * 4096), 16, 0, 0); }
#define GEMM_GLDS(ks, buf) { GLDS1(0, ks, buf) GLDS1(1, ks, buf) GLDS1(2, ks, buf) GLDS1(3, ks, buf) }
template <class ALoad, class Epi>
__device__ __forceinline__ void gemm_tile(const ALoad aload, const bf16_t* __restrict__ Bt, int ldb, int KS, int m0, int n0,
                                          unsigned char* lds, Epi epi) {
    const int tid = opaque_tid(), lane = tid & 63, w = __builtin_amdgcn_readfirstlane(tid >> 6), wm = w >> 1, wn = w & 1;
    f32x4 acc[4][4];
#pragma unroll
    for (int j = 0; j < 4; ++j)
#pragma unroll
        for (int i = 0; i < 4; ++i) acc[j][i] = (f32x4){0.f, 0.f, 0.f, 0.f};
    const bf16_t* Bp = Bt + (size_t)n0 * ldb;
    __syncthreads();
    GEMM_GLDS(0, 0)
    asm volatile("s_waitcnt vmcnt(0)" ::: "memory");
    __syncthreads();
    for (int ks = 0; ks < KS; ++ks) {
        if (ks + 1 < KS) GEMM_GLDS(ks + 1, (ks + 1) & 1)
        const unsigned char* la = lds + (ks & 1) * 32768;
        const unsigned char* lb = la + 16384;
#pragma unroll
        for (int s = 0; s < 2; ++s) {
            bf16x8 af[4], wf[4];
            const int ch = s * 4 + (lane >> 4);
#pragma unroll
            for (int i = 0; i < 4; ++i) {
                const int row = wm * 64 + i * 16 + (lane & 15);
                af[i] = *(const bf16x8*)(la + row * 128 + ((ch ^ (row & 7)) << 4));
            }
#pragma unroll
            for (int j = 0; j < 4; ++j) {
                const int row = wn * 64 + j * 16 + (lane & 15);
                wf[j] = *(const bf16x8*)(lb + row * 128 + ((ch ^ (row & 7)) << 4));
            }
#pragma unroll
            for (int j = 0; j < 4; ++j)
#pragma unroll
                for (int i = 0; i < 4; ++i)
                    acc[j][i] = __builtin_amdgcn_mfma_f32_16x16x32_bf16(wf[j], af[i], acc[j][i], 0, 0, 0);
        }
        asm volatile("s_waitcnt vmcnt(0)" ::: "memory");
        __syncthreads();
    }
#pragma unroll
    for (int j = 0; j < 4; ++j)
#pragma unroll
        for (int i = 0; i < 4; ++i)
            epi(m0 + wm * 64 + i * 16 + (lane & 15), n0 + wn * 64 + j * 16 + (lane >> 4) * 4, acc[j][i]);
    epi.finish(m0, n0);
}
template <class Epi>
__device__ __forceinline__ void gemm_bf16_phase(const bf16_t* __restrict__ A, int lda, const bf16_t* __restrict__ Bt, int ldb,
                                                int Mtiles, int Ntiles, unsigned char* lds, Epi epi) {
    if ((gridDim.x & 7) == 0 && (Mtiles & 31) == 0) {
        const int x = blockIdx.x & 7, j = blockIdx.x >> 3, nb = gridDim.x >> 3;
        const int per = (Mtiles >> 3) * Ntiles;
        for (int q = j; q < per; q += nb) {
            const int s = q / (4 * Ntiles), rem = q - s * (4 * Ntiles);
            const int c = rem >> 2, r = rem & 3;
            const int mt = x + 8 * (4 * s + r);
            gemm_tile(ALoadStd{A, lda}, Bt, ldb, 16, mt * 128, c * 128, lds, epi);
        }
    } else {
        for (int tile = blockIdx.x; tile < Mtiles * Ntiles; tile += gridDim.x) {
            const int mt = tile / Ntiles, nt = tile % Ntiles;
            gemm_tile(ALoadStd{A, lda}, Bt, ldb, 16, mt * 128, nt * 128, lds, epi);
        }
    }
}


#define G3_STAGE 24576
#define G3A(i, ks, st) __builtin_amdgcn_global_load_lds((const unsigned*)(pa + (size_t)(64 * (i)) * lda + (ks) * 32),                     \
                                                        (LAS3 unsigned*)(lds + (st) + (w + 4 * (i)) * 1024), 16, 0, 0);
#define G3B(i, ks, st) __builtin_amdgcn_global_load_lds((const unsigned*)(pb + (size_t)(64 * (i)) * ldb + (ks) * 32),                     \
                                                        (LAS3 unsigned*)(lds + (st) + 16384 + (w + 4 * (i)) * 1024), 16, 0, 0);
#define G3MF(j, i) acc[j][i] = __builtin_amdgcn_mfma_f32_16x16x32_bf16(wf[j], af[i], acc[j][i], 0, 0, 0);
#define G3MF4(j, i) G3MF(j, i) G3MF(j, (i) + 1) G3MF(j, (i) + 2) G3MF(j, (i) + 3)
#define G3SB __builtin_amdgcn_sched_barrier(0);
#define G3_BODY(LOADS, KS) {                                                                                                              \
        const unsigned char* la = lds + st0 + wm * 8192 + fofs;                                                                           \
        const unsigned char* lb = lds + st0 + 16384 + wn * 4096 + fofs;                                                                   \
        bf16x8 af[8], wf[4];                                                                                                              \
        wf[0] = *(const bf16x8*)(lb);                                                                                                     \
        af[0] = *(const bf16x8*)(la);            af[1] = *(const bf16x8*)(la + 1024); af[2] = *(const bf16x8*)(la + 2048);                \
        af[3] = *(const bf16x8*)(la + 3072);     af[4] = *(const bf16x8*)(la + 4096); af[5] = *(const bf16x8*)(la + 5120);                \
        af[6] = *(const bf16x8*)(la + 6144);     af[7] = *(const bf16x8*)(la + 7168);                                                     \
        wf[1] = *(const bf16x8*)(lb + 1024);     wf[2] = *(const bf16x8*)(lb + 2048); wf[3] = *(const bf16x8*)(lb + 3072);                \
        G3SB                                                                                                                              \
        G3MF4(0, 0) if (LOADS) { G3A(0, (KS) + 2, st2) } G3SB                                                                             \
        G3MF4(0, 4) if (LOADS) { G3A(1, (KS) + 2, st2) } G3SB                                                                             \
        G3MF4(1, 0) if (LOADS) { G3A(2, (KS) + 2, st2) } G3SB                                                                             \
        G3MF4(1, 4) if (LOADS) { G3A(3, (KS) + 2, st2) } G3SB                                                                             \
        G3MF4(2, 0) if (LOADS) { G3B(0, (KS) + 2, st2) } G3SB                                                                             \
        G3MF4(2, 4) if (LOADS) { G3B(1, (KS) + 2, st2) } G3SB                                                                             \
        G3MF4(3, 0) G3MF4(3, 4) }
template <class Epi>
__device__ __forceinline__ void gemm_tile3(const bf16_t* __restrict__ A, int lda, const bf16_t* __restrict__ Bt, int ldb, int m0, int n0,
                                           unsigned char* lds, Epi epi) {
    const int tid = opaque_tid(), lane = tid & 63, w = __builtin_amdgcn_readfirstlane(tid >> 6), wm = w >> 1, wn = w & 1;
    f32x4 acc[4][8];
#pragma unroll
    for (int j = 0; j < 4; ++j)
#pragma unroll
        for (int i = 0; i < 8; ++i) acc[j][i] = (f32x4){0.f, 0.f, 0.f, 0.f};
    const int r15 = lane & 15, g4 = lane >> 4;
    const int fofs = r15 * 64 + ((g4 ^ ((0 - (r15 >> 2)) & 3)) << 4);
    const int lch = ((lane & 3) ^ ((0 - (lane >> 4)) & 3)) << 3;
    const bf16_t* pa = A + (size_t)(m0 + 16 * w + (lane >> 2)) * lda + lch;
    const bf16_t* pb = Bt + (size_t)(n0 + 16 * w + (lane >> 2)) * ldb + lch;
    __syncthreads();
    G3A(0, 0, 0) G3A(1, 0, 0) G3A(2, 0, 0) G3A(3, 0, 0) G3B(0, 0, 0) G3B(1, 0, 0)
    G3A(0, 1, G3_STAGE) G3A(1, 1, G3_STAGE) G3A(2, 1, G3_STAGE) G3A(3, 1, G3_STAGE) G3B(0, 1, G3_STAGE) G3B(1, 1, G3_STAGE)
    int st0 = 0, st1 = G3_STAGE, st2 = 2 * G3_STAGE;
#pragma unroll 1
    for (int ks = 0; ks < 30; ++ks) {
        asm volatile("s_waitcnt vmcnt(6)" ::: "memory");
        __builtin_amdgcn_s_barrier();
        asm volatile("" ::: "memory");
        G3_BODY(1, ks)
        const int t_ = st0; st0 = st1; st1 = st2; st2 = t_;
    }
    asm volatile("s_waitcnt vmcnt(6)" ::: "memory");
    __builtin_amdgcn_s_barrier();
    asm volatile("" ::: "memory");
    G3_BODY(0, 30)
    st0 = st1;
    asm volatile("s_waitcnt vmcnt(0)" ::: "memory");
    __builtin_amdgcn_s_barrier();
    asm volatile("" ::: "memory");
    G3_BODY(0, 31)
    __syncthreads();
    if constexpr (Epi::kRow) {
        const int mrow = m0 + wm * 128 + r15, ncol = n0 + wn * 64;
        epi.dispatch(n0, [&](auto e) {
            if constexpr (decltype(e)::kBf16) {
#pragma unroll
                for (int i = 0; i < 8; ++i)
#pragma unroll
                    for (int j = 0; j < 4; j += 2) {
                        uint2 a = e.pack4(acc[j][i]), b = e.pack4(acc[j + 1][i]);
                        auto sx = __builtin_amdgcn_permlane16_swap(a.x, b.x, false, false);
                        auto sy = __builtin_amdgcn_permlane16_swap(a.y, b.y, false, false);
                        e.store8(mrow + i * 16, ncol + (j + (g4 & 1)) * 16 + (g4 >> 1) * 8, make_uint4(sx[0], sy[0], sx[1], sy[1]));
                    }
            } else {
#pragma unroll
                for (int i = 0; i < 8; ++i)
#pragma unroll
                    for (int j = 0; j < 4; ++j)
                        e.row4(mrow + i * 16, ncol + j * 16 + g4 * 4, make_float4(acc[j][i][0], acc[j][i][1], acc[j][i][2], acc[j][i][3]));
            }
        });
    } else {
#pragma unroll
        for (int hh = 0; hh < 2; ++hh) {
            if (wm == hh) {
#pragma unroll
                for (int j = 0; j < 4; ++j)
#pragma unroll
                    for (int i = 0; i < 8; ++i)
                        epi(m0 + wm * 128 + i * 16 + (lane & 15), n0 + wn * 64 + j * 16 + (lane >> 4) * 4, acc[j][i]);
            }
            epi.finish(m0 + hh * 128, n0);
        }
    }
}

#define G3PA(PA, i, k, st) __builtin_amdgcn_global_load_lds((const unsigned*)((PA) + (size_t)(64 * (i)) * lda + (k) * 32),                 \
                                                            (LAS3 unsigned*)(lds + (st) + (w + 4 * (i)) * 1024), 16, 0, 0);
#define G3PB(PB, i, k, st) __builtin_amdgcn_global_load_lds((const unsigned*)((PB) + (size_t)(64 * (i)) * ldb + (k) * 32),                 \
                                                            (LAS3 unsigned*)(lds + (st) + 16384 + (w + 4 * (i)) * 1024), 16, 0, 0);
#define G3P_BODY(PA, PB, KIDX) {                                                                                                          \
        const unsigned char* la = lds + st0 + wm * 8192 + fofs;                                                                           \
        const unsigned char* lb = lds + st0 + 16384 + wn * 4096 + fofs;                                                                   \
        bf16x8 af[8], wf[4];                                                                                                              \
        wf[0] = *(const bf16x8*)(lb);                                                                                                     \
        af[0] = *(const bf16x8*)(la);            af[1] = *(const bf16x8*)(la + 1024); af[2] = *(const bf16x8*)(la + 2048);                \
        af[3] = *(const bf16x8*)(la + 3072);     af[4] = *(const bf16x8*)(la + 4096); af[5] = *(const bf16x8*)(la + 5120);                \
        af[6] = *(const bf16x8*)(la + 6144);     af[7] = *(const bf16x8*)(la + 7168);                                                     \
        wf[1] = *(const bf16x8*)(lb + 1024);     wf[2] = *(const bf16x8*)(lb + 2048); wf[3] = *(const bf16x8*)(lb + 3072);                \
        G3SB                                                                                                                              \
        G3MF4(0, 0) G3PA(PA, 0, KIDX, st2) G3SB                                                                                           \
        G3MF4(0, 4) G3PA(PA, 1, KIDX, st2) G3SB                                                                                           \
        G3MF4(1, 0) G3PA(PA, 2, KIDX, st2) G3SB                                                                                           \
        G3MF4(1, 4) G3PA(PA, 3, KIDX, st2) G3SB                                                                                           \
        G3MF4(2, 0) G3PB(PB, 0, KIDX, st2) G3SB                                                                                           \
        G3MF4(2, 4) G3PB(PB, 1, KIDX, st2) G3SB                                                                                           \
        G3MF4(3, 0) G3MF4(3, 4)                                                                                                           \
        { const int t_ = st0; st0 = st1; st1 = st2; st2 = t_; } }
#define G3P_SYNC(N) { asm volatile("s_waitcnt vmcnt(" #N ")" ::: "memory"); __builtin_amdgcn_s_barrier(); asm volatile("" ::: "memory"); }
#define G3P_BAR     { __builtin_amdgcn_s_barrier(); asm volatile("" ::: "memory"); }
template <class Epi>
__device__ __forceinline__ void gemm_phase_pipelined(const bf16_t* __restrict__ A, int lda, const bf16_t* __restrict__ Bt, int ldb,
                                                     int Mtiles  , int Ntiles, unsigned char* lds, Epi epi) {
    const int tid = opaque_tid(), lane = tid & 63, w = __builtin_amdgcn_readfirstlane(tid >> 6), wm = w >> 1, wn = w & 1;
    const int r15 = lane & 15, g4 = lane >> 4;
    const int fofs = r15 * 64 + ((g4 ^ ((0 - (r15 >> 2)) & 3)) << 4);
    const int lch = ((lane & 3) ^ ((0 - (lane >> 4)) & 3)) << 3;
    const int x = blockIdx.x & 7, jb = blockIdx.x >> 3, nb = gridDim.x >> 3;
    const int per = (Mtiles >> 3) * Ntiles;
    int q = jb;
    if (q >= per) return;
    int m0, n0;
#define G3P_TILE(Q, M0, N0) { const int s_ = (Q) / (2 * Ntiles), rem_ = (Q) - s_ * (2 * Ntiles); M0 = (x + 8 * (2 * s_ + (rem_ & 1))) * 256; N0 = (rem_ >> 1) * 128; }
    G3P_TILE(q, m0, n0)
    const bf16_t* pa = A + (size_t)(m0 + 16 * w + (lane >> 2)) * lda + lch;
    const bf16_t* pb = Bt + (size_t)(n0 + 16 * w + (lane >> 2)) * ldb + lch;
    int st0 = 0, st1 = G3_STAGE, st2 = 2 * G3_STAGE;
    __syncthreads();
    G3PA(pa, 0, 0, 0) G3PA(pa, 1, 0, 0) G3PA(pa, 2, 0, 0) G3PA(pa, 3, 0, 0) G3PB(pb, 0, 0, 0) G3PB(pb, 1, 0, 0)
    G3PA(pa, 0, 1, G3_STAGE) G3PA(pa, 1, 1, G3_STAGE) G3PA(pa, 2, 1, G3_STAGE) G3PA(pa, 3, 1, G3_STAGE) G3PB(pb, 0, 1, G3_STAGE) G3PB(pb, 1, 1, G3_STAGE)
    asm volatile("s_waitcnt vmcnt(0)" ::: "memory");
    for (;;) {
        const int qn = (q + nb < per) ? q + nb : q;
        int m0n, n0n;
        G3P_TILE(qn, m0n, n0n)
        const bf16_t* pan = A + (size_t)(m0n + 16 * w + (lane >> 2)) * lda + lch;
        const bf16_t* pbn = Bt + (size_t)(n0n + 16 * w + (lane >> 2)) * ldb + lch;
        f32x4 acc[4][8];
#pragma unroll
        for (int j = 0; j < 4; ++j)
#pragma unroll
            for (int i = 0; i < 8; ++i) acc[j][i] = (f32x4){0.f, 0.f, 0.f, 0.f};
        G3P_BAR      G3P_BODY(pa, pb, 2)
        G3P_BAR      G3P_BODY(pa, pb, 3)
#pragma unroll 1
        for (int ks = 2; ks < 30; ++ks) {
            G3P_SYNC(6)
            G3P_BODY(pa, pb, ks + 2)
        }
        G3P_SYNC(6)  G3P_BODY(pan, pbn, 0)
        G3P_SYNC(6)  G3P_BODY(pan, pbn, 1)
        {
            const int mrow = m0 + wm * 128 + r15, ncol = n0 + wn * 64;
            epi.dispatch(n0, [&](auto e) {
                asm volatile("s_waitcnt vmcnt(0)" ::: "memory");
                if constexpr (decltype(e)::kBf16) {
#pragma unroll
                    for (int i = 0; i < 8; ++i)
#pragma unroll
                        for (int j = 0; j < 4; j += 2) {
                            uint2 a = e.pack4(acc[j][i]), b = e.pack4(acc[j + 1][i]);
                            auto sx = __builtin_amdgcn_permlane16_swap(a.x, b.x, false, false);
                            auto sy = __builtin_amdgcn_permlane16_swap(a.y, b.y, false, false);
                            e.store8(mrow + i * 16, ncol + (j + (g4 & 1)) * 16 + (g4 >> 1) * 8, make_uint4(sx[0], sy[0], sx[1], sy[1]));
                        }
                } else {
#pragma unroll
                    for (int i = 0; i < 8; ++i)
#pragma unroll
                        for (int j = 0; j < 4; ++j)
                            e.row4(mrow + i * 16, ncol + j * 16 + g4 * 4, make_float4(acc[j][i][0], acc[j][i][1], acc[j][i][2], acc[j][i][3]));
                }
            });
        }
        if (qn == q) break;
        q = qn; m0 = m0n; n0 = n0n; pa = pan; pb = pbn;
    }
    asm volatile("s_waitcnt vmcnt(0)" ::: "memory");
    __syncthreads();
#undef G3P_TILE
}

template <class Epi>
__device__ __forceinline__ void gemm_bf16_phase3(const bf16_t* __restrict__ A, int lda, const bf16_t* __restrict__ Bt, int ldb,
                                                 int Mtiles  , int Ntiles, unsigned char* lds, Epi epi) {
    if constexpr (Epi::kRow) {
        if ((gridDim.x & 7) == 0 && (Mtiles & 15) == 0) { gemm_phase_pipelined(A, lda, Bt, ldb, Mtiles, Ntiles, lds, epi); return; }
    }
    if ((gridDim.x & 7) == 0 && (Mtiles & 15) == 0) {
        const int x = blockIdx.x & 7, j = blockIdx.x >> 3, nb = gridDim.x >> 3;
        const int per = (Mtiles >> 3) * Ntiles;
        for (int q = j; q < per; q += nb) {
            const int s = q / (2 * Ntiles), rem = q - s * (2 * Ntiles);
            const int c = rem >> 1, r = rem & 1;
            const int mt = x + 8 * (2 * s + r);
            gemm_tile3(A, lda, Bt, ldb, mt * 256, c * 128, lds, epi);
        }
    } else {
        for (int tile = blockIdx.x; tile < Mtiles * Ntiles; tile += gridDim.x)
            gemm_tile3(A, lda, Bt, ldb, (tile / Ntiles) * 256, (tile % Ntiles) * 128, lds, epi);
    }
}

struct EpiF32 {
    float* C; int ldc; int Nc;
    __device__ __forceinline__ void operator()(int m, int n, f32x4 v) const {
        if (n < Nc) *(float4*)(C + (size_t)m * ldc + n) = make_float4(v[0], v[1], v[2], v[3]);
    }
    __device__ __forceinline__ void finish(int, int) const {}
};

struct EpiProjBf {
    static constexpr bool kBf16 = true;
    bf16_t* dst; int ld; float sc;
    __device__ __forceinline__ uint2 pack4(f32x4 v) const { uint2 o; o.x = pack2bf(sc * v[0], sc * v[1]); o.y = pack2bf(sc * v[2], sc * v[3]); return o; }
    __device__ __forceinline__ void store8(int m, int n, uint4 o) const { *(uint4*)(dst + (size_t)m * ld + (n & 127)) = o; }
};
struct EpiProjLF {
    static constexpr bool kBf16 = false;
    unsigned char* ws;
    __device__ __forceinline__ void row4(int m, int n, float4 v) const {
        const int c = n - 512;
        const float4 lb = *(const float4*)((const float*)(ws + OFF_LBV) + c);
        float4 o;
        o.x = log_fast(lb.x + (1.f - lb.x) * sigmoid_fast(v.x)); o.y = log_fast(lb.y + (1.f - lb.y) * sigmoid_fast(v.y));
        o.z = log_fast(lb.z + (1.f - lb.z) * sigmoid_fast(v.z)); o.w = log_fast(lb.w + (1.f - lb.w) * sigmoid_fast(v.w));
        *(float4*)((float*)(ws + OFF_HLF) + (size_t)m * 512 + c) = o;
    }
};
struct EpiProjGate {
    static constexpr bool kBf16 = false;
    unsigned char* ws;
    __device__ __forceinline__ void row4(int m, int n, float4 v) const {
        const int c = n - 3328;
        if (c < 24)
            *(float4*)((float*)(ws + OFF_NGATE) + (size_t)m * 24 + c) =
                make_float4(sigmoid_fast(v.x), sigmoid_fast(v.y), sigmoid_fast(v.z), sigmoid_fast(v.w));
    }
};
struct EpiProj {
    static constexpr bool kRow = true;
    unsigned char* ws;
    template <class F> __device__ __forceinline__ void dispatch(int n0, F f) const {
        const int ct = __builtin_amdgcn_readfirstlane(n0 >> 7);
        if (ct >= 4 && ct < 8) f(EpiProjLF{ws});
        else if (ct >= 26) f(EpiProjGate{ws});
        else {
            size_t off; int ld = 512, c0 = (ct & 3) * 128; float sc = 1.f;
            if (ct < 4) off = OFF_HQ;
            else if (ct < 12) off = OFF_HI;
            else if (ct < 16) off = OFF_HG;
            else if (ct < 20) { off = OFF_NQ; sc = 0.125f * 1.4426950408889634f; }
            else { off = OFF_KV + (size_t)(ct - 20) * KV_STRIDE; ld = 128; c0 = 0; }
            f(EpiProjBf{(bf16_t*)(ws + off) + c0, ld, sc});
        }
    }
    __device__ __forceinline__ void finish(int, int) const {}
};
struct EpiMix {
    static constexpr bool kRow = true;
    bf16_t* mix;
    template <class F> __device__ __forceinline__ void dispatch(int n0, F f) const { f(EpiProjBf{mix + n0, DM, 1.f}); }
    __device__ __forceinline__ void finish(int, int) const {}
};

__device__ __forceinline__ uint4 pack8bf(const float* v) {
    uint4 o;
    o.x = pack2bf(v[0], v[1]); o.y = pack2bf(v[2], v[3]); o.z = pack2bf(v[4], v[5]); o.w = pack2bf(v[6], v[7]);
    return o;
}

__device__ __forceinline__ void hgrn_passA(const Params& p, int chunk, unsigned char* smem) {
    const int c = chunk & 127, bh = chunk >> 7, h = bh & 3, b = bh >> 2;
    const int tid = opaque_tid(), d = tid & 127, hf = __builtin_amdgcn_readfirstlane(tid >> 7), lane = tid & 63, w = __builtin_amdgcn_readfirstlane(tid >> 6);
    const size_t tok0 = (size_t)b * SEQ + (size_t)c * 64 + 32 * hf;
    const float* HLF = (const float*)(p.ws + OFF_HLF);
    const bf16_t* HI = (const bf16_t*)(p.ws + OFF_HI);
    unsigned char* KT = smem;
    unsigned char* VT = smem + 16384;
    float* xch = (float*)(smem + 32768);
    const float* lfp = HLF + tok0 * 512 + h * 128 + d;
    const bf16_t* vp = HI + tok0 * 512 + h * 128 + d;
    float lf[32];
#pragma unroll
    for (int s = 0; s < 32; ++s) lf[s] = lfp[s * 512];
    uint4 vt0, vt1, vt2, vt3;
    {
#define VLD8(q_, R_) { unsigned short v_[8]; _Pragma("unroll") for (int j = 0; j < 8; ++j) v_[j] = vp[((q_) * 8 + j) * 512];                 \
                       R_.x = v_[0] | ((unsigned)v_[1] << 16); R_.y = v_[2] | ((unsigned)v_[3] << 16);                                       \
                       R_.z = v_[4] | ((unsigned)v_[5] << 16); R_.w = v_[6] | ((unsigned)v_[7] << 16); }
        VLD8(0, vt0) VLD8(1, vt1) VLD8(2, vt2) VLD8(3, vt3)
#undef VLD8
    }
    float run = 0.f, b15 = 0.f;
#pragma unroll
    for (int s = 0; s < 32; ++s) { run += lf[s]; if (s == 15) b15 = run; }
    __syncthreads();
    xch[hf * 128 + d] = run;
    __syncthreads();
    const float tot0 = xch[d], tot1 = xch[128 + d];
    const float blast = tot0 + tot1;
    {
        float* REF = (float*)(p.ws + OFF_HREF) + (size_t)chunk * 384;
        if (hf == 0) { REF[d] = b15; REF[128 + d] = tot0; } else REF[256 + d] = tot0 + b15;
    }
    run = hf ? tot0 : 0.f;
#pragma unroll
    for (int q = 0; q < 4; ++q) {
        float kv[8];
#pragma unroll
        for (int j = 0; j < 8; ++j) {
            const float l_ = lf[q * 8 + j];
            run += l_;
            kv[j] = (1.f - exp_fast(l_)) * exp_fast(blast - run);
        }
        const int ch = 4 * hf + q;
        *(uint4*)(KT + d * 128 + ((ch ^ (d & 7)) << 4)) = pack8bf(kv);
        *(uint4*)(VT + d * 128 + ((ch ^ (d & 7)) << 4)) = (q == 0) ? vt0 : (q == 1) ? vt1 : (q == 2) ? vt2 : vt3;
    }
    if (hf) ((float*)(p.ws + OFF_DC))[(size_t)chunk * 128 + d] = expf(blast);
    __syncthreads();
    f32x4 acc[2][8];
#pragma unroll
    for (int i = 0; i < 2; ++i)
#pragma unroll
        for (int et = 0; et < 8; ++et) acc[i][et] = (f32x4){0.f, 0.f, 0.f, 0.f};
#pragma unroll
    for (int st = 0; st < 2; ++st) {
        const int ch = st * 4 + (lane >> 4);
        bf16x8 af[2];
#pragma unroll
        for (int i = 0; i < 2; ++i) {
            const int row = (2 * w + i) * 16 + (lane & 15);
            af[i] = *(const bf16x8*)(KT + row * 128 + ((ch ^ (row & 7)) << 4));
        }
#pragma unroll
        for (int et = 0; et < 8; ++et) {
            const int row = et * 16 + (lane & 15);
            const bf16x8 bfv = *(const bf16x8*)(VT + row * 128 + ((ch ^ (row & 7)) << 4));
            acc[0][et] = __builtin_amdgcn_mfma_f32_16x16x32_bf16(af[0], bfv, acc[0][et], 0, 0, 0);
            acc[1][et] = __builtin_amdgcn_mfma_f32_16x16x32_bf16(af[1], bfv, acc[1][et], 0, 0, 0);
        }
    }
    bf16_t* HC = (bf16_t*)p.out + (size_t)chunk * 16384;
#pragma unroll
    for (int et = 0; et < 8; ++et) {
        const int e = et * 16 + (lane & 15), g4 = lane >> 4;
        uint2 a, b;
        a.x = pack2bf(acc[0][et][0], acc[0][et][1]); a.y = pack2bf(acc[0][et][2], acc[0][et][3]);
        b.x = pack2bf(acc[1][et][0], acc[1][et][1]); b.y = pack2bf(acc[1][et][2], acc[1][et][3]);
        auto sx = __builtin_amdgcn_permlane16_swap(a.x, b.x, false, false);
        auto sy = __builtin_amdgcn_permlane16_swap(a.y, b.y, false, false);
        *(uint4*)(HC + e * 128 + (2 * w + (g4 & 1)) * 16 + (g4 >> 1) * 8) = make_uint4(sx[0], sy[0], sx[1], sy[1]);
    }
}

__device__ __forceinline__ void hgrn_scan_item(const Params& p, int item) {
    const int gid = item * 256 + threadIdx.x;
    const int d4 = gid & 31, e = (gid >> 5) & 127, bh = gid >> 12;
    const bf16_t* HC = (const bf16_t*)p.out;
    const float* DC = (const float*)(p.ws + OFF_DC);
    bf16_t* SC = (bf16_t*)(p.ws + OFF_SC);
    float4 S = make_float4(0.f, 0.f, 0.f, 0.f);
#pragma unroll 16
    for (int c = 0; c < 128; ++c) {
        const size_t base = ((size_t)(bh * 128 + c) * 128 + e) * 128 + d4 * 4;
        const uint2 hb = *(const uint2*)(HC + base);
        const float4 H = make_float4(__uint_as_float(hb.x << 16), __uint_as_float(hb.x & 0xffff0000u), __uint_as_float(hb.y << 16), __uint_as_float(hb.y & 0xffff0000u));
        const float4 dc = *(const float4*)(DC + (size_t)(bh * 128 + c) * 128 + d4 * 4);
        uint2 o; o.x = pack2bf(S.x, S.y); o.y = pack2bf(S.z, S.w);
        *(uint2*)(SC + base) = o;
        S.x = dc.x * S.x + H.x; S.y = dc.y * S.y + H.y; S.z = dc.z * S.z + H.z; S.w = dc.w * S.w + H.w;
    }
}

__device__ __forceinline__ void hgrn_passC(const Params& p, int chunk, unsigned char* smem) {
    const int c = chunk & 127, bh = chunk >> 7, h = bh & 3, b = bh >> 2;
    const int tid = opaque_tid(), d = tid & 127, hf = __builtin_amdgcn_readfirstlane(tid >> 7), lane = tid & 63, w = __builtin_amdgcn_readfirstlane(tid >> 6);
    const size_t tokc = (size_t)b * SEQ + (size_t)c * 64;
    const size_t tok0 = tokc + 32 * hf;
    const float* HLF = (const float*)(p.ws + OFF_HLF);
    const bf16_t* HQ = (const bf16_t*)(p.ws + OFF_HQ);
    const bf16_t* HI = (const bf16_t*)(p.ws + OFF_HI);
    const bf16_t* HG = (const bf16_t*)(p.ws + OFF_HG);
    unsigned char* R0 = smem;
    unsigned char* R1 = smem + 16384;
    unsigned char* R2 = smem + 57344;
    unsigned char* R3 = smem + 65536;
    const float* lfp = HLF + tok0 * 512 + h * 128 + d;
    const bf16_t* qp = HQ + tok0 * 512 + h * 128 + d;
    const float* REF = (const float*)(p.ws + OFF_HREF) + (size_t)chunk * 384;
    __syncthreads();
    const float r1 = REF[d], r2 = REF[128 + d], r3 = REF[256 + d];
    uint4 sct0, sct1, sct2, sct3, sct4, sct5, sct6, sct7;
    {
        const bf16_t* SCp = (const bf16_t*)(p.ws + OFF_SC) + (size_t)chunk * 16384;
#define SCLD(i, R_) { const int cc = tid + 256 * (i); R_ = *(const uint4*)(SCp + (cc >> 4) * 128 + (cc & 15) * 8); }
        SCLD(0, sct0) SCLD(1, sct1) SCLD(2, sct2) SCLD(3, sct3) SCLD(4, sct4) SCLD(5, sct5) SCLD(6, sct6) SCLD(7, sct7)
#undef SCLD
    }
    uint4 vt0, vt1, vt2, vt3;
    {
        const bf16_t* vp = HI + tok0 * 512 + h * 128 + d;
#define VLD8(q_, R_) { unsigned short v_[8]; _Pragma("unroll") for (int j = 0; j < 8; ++j) v_[j] = vp[((q_) * 8 + j) * 512];                 \
                       R_.x = v_[0] | ((unsigned)v_[1] << 16); R_.y = v_[2] | ((unsigned)v_[3] << 16);                                       \
                       R_.z = v_[4] | ((unsigned)v_[5] << 16); R_.w = v_[6] | ((unsigned)v_[7] << 16); }
        VLD8(0, vt0) VLD8(1, vt1) VLD8(2, vt2) VLD8(3, vt3)
#undef VLD8
    }
    {
        float run = hf ? r2 : 0.f;
        unsigned char* dummy = R2 + 4096 + d * 2;
#pragma unroll 8
        for (int s = 0; s < 32; ++s) {
            const int t = 32 * hf + s;
            const int it = t >> 4;
            const float rr = (it == 0) ? 0.f : (it == 1) ? r1 : (it == 2) ? r2 : r3;
            const int sw = (((d >> 3) ^ (t & 15)) << 4) + (d & 7) * 2;
            const float lf = lfp[s * 512];
            run += lf;
            const float qv = bf2f(qp[s * 512]);
            const float kv = 1.f - exp_fast(lf);
            *(bf16_t*)(R3 + t * 256 + sw) = (bf16_t)f2bf(qv * exp_fast(run));
            *(bf16_t*)(R0 + t * 256 + sw) = (bf16_t)f2bf(qv * exp_fast(run - rr));
#pragma unroll
            for (int i = 0; i < 4; ++i) {
                const float ri = (i == 0) ? 0.f : (i == 1) ? r1 : (i == 2) ? r2 : r3;
                const int R = 8 * i * (i + 1) + t;
                unsigned char* dst = (i >= it) ? (R1 + R * 256 + sw) : dummy;
                *(bf16_t*)dst = (bf16_t)f2bf(kv * exp_fast(fminf(ri - run, 80.f)));
            }
        }
    }
    __syncthreads();
#pragma unroll
    for (int j = 0; j < 4; ++j) {
        uint2 o = make_uint2(0u, 0u);
        if (j <= w) {
            f32x4 pa = (f32x4){0.f, 0.f, 0.f, 0.f};
#pragma unroll
            for (int ds = 0; ds < 4; ++ds) {
                const int ch = ds * 4 + (lane >> 4);
                const int krow = 8 * w * (w + 1) + 16 * j + (lane & 15);
                const int trow = w * 16 + (lane & 15);
                const bf16x8 av = *(const bf16x8*)(R1 + krow * 256 + ((ch ^ (krow & 15)) << 4));
                const bf16x8 bq = *(const bf16x8*)(R0 + trow * 256 + ((ch ^ (trow & 15)) << 4));
                pa = __builtin_amdgcn_mfma_f32_16x16x32_bf16(av, bq, pa, 0, 0, 0);
            }
            if (j == w) {
                const int tl = lane & 15, sl = (lane >> 4) * 4;
#pragma unroll
                for (int r = 0; r < 4; ++r) if (sl + r > tl) pa[r] = 0.f;
            }
            o.x = pack2bf(pa[0], pa[1]); o.y = pack2bf(pa[2], pa[3]);
        }
        const int t = w * 16 + (lane & 15);
        const int ch = 2 * j + (lane >> 5);
        *(uint2*)(R2 + t * 128 + ((ch ^ (t & 7)) << 4) + ((lane >> 4) & 1) * 8) = o;
    }
    __syncthreads();
    {
#define SCST(i, R_) { const int cc = tid + 256 * (i), row = cc >> 4, ch = cc & 15; *(uint4*)(R1 + row * 256 + ((ch ^ (row & 15)) << 4)) = R_; }
        SCST(0, sct0) SCST(1, sct1) SCST(2, sct2) SCST(3, sct3) SCST(4, sct4) SCST(5, sct5) SCST(6, sct6) SCST(7, sct7)
#undef SCST
        *(uint4*)(R0 + d * 128 + (((4 * hf + 0) ^ (d & 7)) << 4)) = vt0;
        *(uint4*)(R0 + d * 128 + (((4 * hf + 1) ^ (d & 7)) << 4)) = vt1;
        *(uint4*)(R0 + d * 128 + (((4 * hf + 2) ^ (d & 7)) << 4)) = vt2;
        *(uint4*)(R0 + d * 128 + (((4 * hf + 3) ^ (d & 7)) << 4)) = vt3;
    }
    __syncthreads();
    const size_t tok = tokc + w * 16 + (lane & 15);
    uint2 gb0, gb1, gb2, gb3, gb4, gb5, gb6, gb7;
    {
        const bf16_t* gp = HG + tok * 512 + h * 128 + (lane >> 4) * 4;
        gb0 = *(const uint2*)(gp); gb1 = *(const uint2*)(gp + 16); gb2 = *(const uint2*)(gp + 32); gb3 = *(const uint2*)(gp + 48);
        gb4 = *(const uint2*)(gp + 64); gb5 = *(const uint2*)(gp + 80); gb6 = *(const uint2*)(gp + 96); gb7 = *(const uint2*)(gp + 112);
    }
    f32x4 acc[8];
#pragma unroll
    for (int et = 0; et < 8; ++et) acc[et] = (f32x4){0.f, 0.f, 0.f, 0.f};
#pragma unroll
    for (int ds = 0; ds < 4; ++ds) {
        const int ch = ds * 4 + (lane >> 4);
        const int trow = w * 16 + (lane & 15);
        const bf16x8 bq = *(const bf16x8*)(R3 + trow * 256 + ((ch ^ (trow & 15)) << 4));
#pragma unroll
        for (int et = 0; et < 8; ++et) {
            const int row = et * 16 + (lane & 15);
            const bf16x8 av = *(const bf16x8*)(R1 + row * 256 + ((ch ^ (row & 15)) << 4));
            acc[et] = __builtin_amdgcn_mfma_f32_16x16x32_bf16(av, bq, acc[et], 0, 0, 0);
        }
    }
#pragma unroll
    for (int st = 0; st < 2; ++st) {
        const int ch = st * 4 + (lane >> 4);
        const int trow = w * 16 + (lane & 15);
        const bf16x8 bp = *(const bf16x8*)(R2 + trow * 128 + ((ch ^ (trow & 7)) << 4));
#pragma unroll
        for (int et = 0; et < 8; ++et) {
            const int row = et * 16 + (lane & 15);
            const bf16x8 av = *(const bf16x8*)(R0 + row * 128 + ((ch ^ (row & 7)) << 4));
            acc[et] = __builtin_amdgcn_mfma_f32_16x16x32_bf16(av, bp, acc[et], 0, 0, 0);
        }
    }
    {
        float ss = 0.f;
#pragma unroll
        for (int et = 0; et < 8; ++et)
#pragma unroll
            for (int r = 0; r < 4; ++r) ss += acc[et][r] * acc[et][r];
        ss += __shfl_xor(ss, 16);
        ss += __shfl_xor(ss, 32);
        const float rs = rsqrtf(ss * (1.f / 128.f) + LN_EPS);
        const float* ng = p.in[4];
        bf16_t* MIX = (bf16_t*)(p.ws + OFF_XB);
#pragma unroll
        for (int et = 0; et < 8; ++et) {
            const int e0 = et * 16 + (lane >> 4) * 4;
            const uint2 gb = (et == 0) ? gb0 : (et == 1) ? gb1 : (et == 2) ? gb2 : (et == 3) ? gb3 : (et == 4) ? gb4 : (et == 5) ? gb5 : (et == 6) ? gb6 : gb7;
            const float4 n4 = *(const float4*)(ng + e0);
            const float g0 = bf2f(gb.x & 0xffffu), g1 = bf2f(gb.x >> 16), g2 = bf2f(gb.y & 0xffffu), g3 = bf2f(gb.y >> 16);
            uint2 o;
            o.x = pack2bf(acc[et][0] * rs * n4.x * (g0 * sigmoid_fast(g0)), acc[et][1] * rs * n4.y * (g1 * sigmoid_fast(g1)));
            o.y = pack2bf(acc[et][2] * rs * n4.z * (g2 * sigmoid_fast(g2)), acc[et][3] * rs * n4.w * (g3 * sigmoid_fast(g3)));
            *(uint2*)(MIX + tok * DM + h * 128 + e0) = o;
        }
    }
}

__device__ __forceinline__ void compress_item(const Params& p, int item, float* sm) {
    const int g = item & 1;
    int r = item >> 1;
    const int n = r % NCB; r /= NCB;
    const int b = r & 3, which = r >> 2;
    const int tid = opaque_tid();
    const bf16_t* kvsrc = (const bf16_t*)(p.ws + OFF_KV + (size_t)which * KV_STRIDE);
    const float* pe = p.in[which ? 10 : 5];
    const float* w1 = p.in[which ? 11 : 6];
    const float* b1 = p.in[which ? 12 : 7];
    const float* w2 = p.in[which ? 13 : 8];
    const float* b2 = p.in[which ? 14 : 9];
    float* outp = (float*)(p.ws + (which ? OFF_CMPV : OFF_CMPK));
    float* blk = sm;
    float* hh = sm + 2048;
    __syncthreads();
    for (int i = tid; i < 2048; i += 256) {
        const int l = i >> 6, d = i & 63;
        blk[i] = bf2f(kvsrc[(size_t)(b * SEQ + 16 * n + l) * 128 + g * 64 + d]) + pe[i];
    }
    __syncthreads();
    float acc = b1[tid];
    for (int i = 0; i < 2048; ++i) acc += blk[i] * w1[(size_t)i * 256 + tid];
    hh[tid] = gelu_tanh(acc);
    __syncthreads();
    if (tid < 64) {
        float o = b2[tid];
        for (int j = 0; j < 256; ++j) o += hh[j] * w2[j * 64 + tid];
        outp[((size_t)(b * NCB + n) * 2 + g) * 64 + tid] = o;
    }
}

__device__ __forceinline__ float dot64_bf(const float* qs, const bf16_t* krow) {
    float s = 0.f;
#pragma unroll
    for (int i = 0; i < 8; ++i) {
        const uint4 kv = ((const uint4*)krow)[i];
        const float4 q0 = ((const float4*)qs)[2 * i], q1 = ((const float4*)qs)[2 * i + 1];
        s += __uint_as_float(kv.x << 16) * q0.x + __uint_as_float(kv.x & 0xffff0000u) * q0.y
           + __uint_as_float(kv.y << 16) * q0.z + __uint_as_float(kv.y & 0xffff0000u) * q0.w
           + __uint_as_float(kv.z << 16) * q1.x + __uint_as_float(kv.z & 0xffff0000u) * q1.y
           + __uint_as_float(kv.w << 16) * q1.z + __uint_as_float(kv.w & 0xffff0000u) * q1.w;
    }
    return s;
}
__device__ __forceinline__ float dot64(const float* qs, const float* krow) {
    float s = 0.f;
#pragma unroll
    for (int i = 0; i < 16; ++i) {
        const float4 kv = ((const float4*)krow)[i];
        const float4 qv = ((const float4*)qs)[i];
        s += kv.x * qv.x + kv.y * qv.y + kv.z * qv.z + kv.w * qv.w;
    }
    return s;
}

__device__ __forceinline__ void nsa_item(const Params& p, int item, float* sm) {
    const int t = item & (SEQ - 1), g = (item >> 13) & 1, b = item >> 14;
    const int tid = threadIdx.x, lane = tid & 63, r = tid >> 6;
    float* sc = sm + r * 1024;
    float* qs = sm + 4096 + r * 64;
    float* impv = sm + 4096 + 256;
    int* sel = (int*)(sm + 4096 + 256 + 128);
    const bf16_t* KSb = (const bf16_t*)(p.ws + OFF_KV + 2 * KV_STRIDE);
    const bf16_t* VSb = (const bf16_t*)(p.ws + OFF_KV + 3 * KV_STRIDE);
    const bf16_t* KWb = (const bf16_t*)(p.ws + OFF_KV + 4 * KV_STRIDE);
    const bf16_t* VWb = (const bf16_t*)(p.ws + OFF_KV + 5 * KV_STRIDE);
    const float* cmpk = (const float*)(p.ws + OFF_CMPK);
    const float* cmpv = (const float*)(p.ws + OFF_CMPV);
    const size_t n = (size_t)b * SEQ + t;
    const float NEGV = -1e30f;
    __syncthreads();
    qs[lane] = bf2f(((const bf16_t*)(p.ws + OFF_NQ))[n * 512 + g * 256 + r * 64 + lane]) * 0.6931471805599453f;
    __syncthreads();

    const int nvalid = (t >= 31) ? (((t - 31) >> 4) + 1) : 0;
    float m = NEGV;
    for (int n0 = 0; n0 < nvalid; n0 += 64) {
        const int nn = n0 + lane;
        if (nn < nvalid) {
            const float s = dot64(qs, cmpk + ((size_t)(b * NCB + nn) * 2 + g) * 64);
            sc[nn] = s;
            m = fmaxf(m, s);
        }
    }
    m = wave_max(m);
    float sum = 0.f;
    for (int n0 = 0; n0 < nvalid; n0 += 64) {
        const int nn = n0 + lane;
        if (nn < nvalid) { const float e = expf(sc[nn] - m); sc[nn] = e; sum += e; }
    }
    sum = wave_sum(sum);
    {
        const float inv = 1.f / fmaxf(sum, 1e-30f);
        for (int n0 = 0; n0 < nvalid; n0 += 64) {
            const int nn = n0 + lane;
            if (nn < nvalid) sc[nn] *= inv;
        }
    }
    __syncthreads();
    float oc = 0.f;
    for (int nn = 0; nn < nvalid; ++nn) oc += sc[nn] * cmpv[((size_t)(b * NCB + nn) * 2 + g) * 64 + lane];

    const int cur = t >> 6;
    if (tid < 128) {
        const int j = tid;
        float im = 0.f;
#pragma unroll
        for (int rr = 0; rr < 4; ++rr) {
            const float* P = sm + rr * 1024;
            const int n4 = 4 * j;
            float a = 0.f;
            if (n4 < nvalid) a += P[n4];
            if (n4 + 1 < nvalid) a += P[n4 + 1];
            if (n4 + 2 < nvalid) a += P[n4 + 2];
            if (n4 + 3 < nvalid) a += 0.5f * P[n4 + 3];
            if (n4 - 1 >= 0 && n4 - 1 < nvalid) a += 0.5f * P[n4 - 1];
            im += a;
        }
        const bool forced = (j == 0) || (j == cur) || (j == cur - 1);
        const bool causal = (j <= cur);
        impv[j] = forced ? 1.0e4f : (causal ? im : -1.f);
    }
    __syncthreads();
    if (r == 0) {
        float v0 = impv[lane], v1 = impv[lane + 64];
        for (int k = 0; k < 16; ++k) {
            const float mx = wave_max(fmaxf(v0, v1));
            const unsigned long long b0 = __ballot(v0 == mx);
            int idx;
            if (b0) {
                const int l = __ffsll((unsigned long long)b0) - 1;
                idx = l;
                if (lane == l) v0 = -3.0e38f;
            } else {
                const unsigned long long b1 = __ballot(v1 == mx);
                const int l = __ffsll((unsigned long long)b1) - 1;
                idx = 64 + l;
                if (lane == l) v1 = -3.0e38f;
            }
            if (lane == 0) sel[k] = idx;
        }
    }
    __syncthreads();

    m = NEGV;
    for (int si = 0; si < 16; ++si) {
        const int blk = sel[si];
        const int key = blk * 64 + lane;
        float s = NEGV;
        if (blk * 64 <= t) {
            if (key <= t) s = dot64_bf(qs, KSb + ((size_t)b * SEQ + key) * 128 + g * 64);
        }
        sc[si * 64 + lane] = s;
        m = fmaxf(m, s);
    }
    m = wave_max(m);
    sum = 0.f;
    for (int si = 0; si < 16; ++si) {
        const int key = sel[si] * 64 + lane;
        const float e = (key <= t) ? expf(sc[si * 64 + lane] - m) : 0.f;
        sc[si * 64 + lane] = e;
        sum += e;
    }
    sum = wave_sum(sum);
    {
        const float inv = 1.f / fmaxf(sum, 1e-30f);
        for (int si = 0; si < 16; ++si) sc[si * 64 + lane] *= inv;
    }
    __syncthreads();
    float os = 0.f;
    for (int si = 0; si < 16; ++si) {
        const int blk = sel[si];
        if (blk * 64 > t) continue;
        for (int kk = 0; kk < 64; ++kk) {
            const int key = blk * 64 + kk;
            if (key > t) break;
            os += sc[si * 64 + kk] * bf2f(VSb[((size_t)b * SEQ + key) * 128 + g * 64 + lane]);
        }
    }
    __syncthreads();

    const int lo = t - 511;
    m = NEGV;
    for (int i = 0; i < 8; ++i) {
        const int key = lo + i * 64 + lane;
        float s = NEGV;
        if (key >= 0) s = dot64_bf(qs, KWb + ((size_t)b * SEQ + key) * 128 + g * 64);
        sc[i * 64 + lane] = s;
        m = fmaxf(m, s);
    }
    m = wave_max(m);
    sum = 0.f;
    for (int i = 0; i < 8; ++i) {
        const int key = lo + i * 64 + lane;
        const float e = (key >= 0) ? expf(sc[i * 64 + lane] - m) : 0.f;
        sc[i * 64 + lane] = e;
        sum += e;
    }
    sum = wave_sum(sum);
    {
        const float inv = 1.f / fmaxf(sum, 1e-30f);
        for (int i = 0; i < 8; ++i) sc[i * 64 + lane] *= inv;
    }
    __syncthreads();
    float ow = 0.f;
    for (int idx = 0; idx < 512; ++idx) {
        const int key = lo + idx;
        if (key < 0) continue;
        ow += sc[idx] * bf2f(VWb[((size_t)b * SEQ + key) * 128 + g * 64 + lane]);
    }
    const float* grow = (const float*)(p.ws + OFF_NGATE) + n * 24 + g * 12 + r * 3;
    const float gc = grow[0], gs = grow[1], gw = grow[2];
#if NSA_DIAG
    {
        const float ref = gc * oc + gs * os + gw * ow;
        const float got = bf2f(((const bf16_t*)(p.ws + OFF_XB))[n * DM + 512 + g * 256 + r * 64 + lane]);
        const unsigned* SELM = (const unsigned*)(p.ws + OFF_SELM) + ((size_t)(b * 2 + g) * SEQ + t) * 4;
        unsigned gm[4] = {0u, 0u, 0u, 0u};
        for (int si = 0; si < 16; ++si) { const int blk = sel[si]; if (blk * 64 <= t) gm[blk >> 5] |= 1u << (blk & 31); }
        bool same = true;
        for (int qd = 0; qd < 4; ++qd) {
            unsigned mm = SELM[qd];
            for (int bit = 0; bit < 32; ++bit) if ((qd * 32 + bit) * 64 > t) mm &= ~(1u << bit);
            if (mm != gm[qd]) same = false;
        }
        float d2 = same ? (got - ref) * (got - ref) : 0.f, r2 = same ? ref * ref : 0.f;
        d2 = wave_sum(d2); r2 = wave_sum(r2);
        float* DG = (float*)(p.ws + OFF_DIAG);
        if (lane == 0) { atomicAdd(&DG[0], d2); atomicAdd(&DG[1], r2); if (r == 0) { atomicAdd(&DG[2], same ? 0.f : 1.f); atomicAdd(&DG[3], 1.f); } }
    }
#else
    ((bf16_t*)(p.ws + OFF_XB))[n * DM + 512 + g * 256 + r * 64 + lane] = (bf16_t)f2bf(gc * oc + gs * os + gw * ow);
#endif
}


__device__ __forceinline__ float xrow_max(float x) {
    auto s = __builtin_amdgcn_permlane16_swap(__float_as_uint(x), __float_as_uint(x), false, false);
    x = fmaxf(__uint_as_float(s[0]), __uint_as_float(s[1]));
    auto t = __builtin_amdgcn_permlane32_swap(__float_as_uint(x), __float_as_uint(x), false, false);
    return fmaxf(__uint_as_float(t[0]), __uint_as_float(t[1]));
}
__device__ __forceinline__ float xrow_sum(float x) {
    auto s = __builtin_amdgcn_permlane16_swap(__float_as_uint(x), __float_as_uint(x), false, false);
    x = __uint_as_float(s[0]) + __uint_as_float(s[1]);
    auto t = __builtin_amdgcn_permlane32_swap(__float_as_uint(x), __float_as_uint(x), false, false);
    return __uint_as_float(t[0]) + __uint_as_float(t[1]);
}
template <int CTRL> __device__ __forceinline__ float dppf(float x) {
    return __builtin_bit_cast(float, __builtin_amdgcn_mov_dpp(__builtin_bit_cast(int, x), CTRL, 0xf, 0xf, true));
}
__device__ __forceinline__ float row16_max(float m) {
    m = fmaxf(m, dppf<0x121>(m)); m = fmaxf(m, dppf<0x122>(m));
    m = fmaxf(m, dppf<0x124>(m)); m = fmaxf(m, dppf<0x128>(m));
    return m;
}
__device__ __forceinline__ float row16_sum(float m) {
    m += dppf<0x121>(m); m += dppf<0x122>(m); m += dppf<0x124>(m); m += dppf<0x128>(m);
    return m;
}
__device__ __forceinline__ float dot2bf(unsigned a, unsigned b, float acc) {
    return __builtin_amdgcn_fdot2_f32_bf16(__builtin_bit_cast(bf16x2_t, a), __builtin_bit_cast(bf16x2_t, b), acc, false);
}
__device__ __forceinline__ float enc_key(float v, unsigned idx, unsigned mask) {
    const unsigned u = __float_as_uint(v);
    const unsigned code = (u >> 31) ? idx : (mask - idx);
    return __uint_as_float((u & ~mask) | code);
}
__device__ __forceinline__ unsigned dec_idx(float key, unsigned mask) {
    const unsigned u = __float_as_uint(key);
    const unsigned code = u & mask;
    return (u >> 31) ? code : (mask - code);
}
__device__ __forceinline__ float dec_val(float key, unsigned mask) { return __uint_as_float(__float_as_uint(key) & ~mask); }
#define NEGKEY (-3.0e38f)
#define CE_DESC(a, b) { const float t_ = fmaxf(a, b); b = fminf(a, b); a = t_; }

struct EpiCmpH {
    bf16_t* HB; const float* peb;
    __device__ __forceinline__ void operator()(int m, int n, f32x4 v) const {
        const float4 pb = *(const float4*)(peb + n);
        uint2 o;
        o.x = pack2bf(gelu_tanh(v[0] + pb.x), gelu_tanh(v[1] + pb.y));
        o.y = pack2bf(gelu_tanh(v[2] + pb.z), gelu_tanh(v[3] + pb.w));
        *(uint2*)(HB + (size_t)m * 256 + n) = o;
    }
    __device__ __forceinline__ void finish(int, int) const {}
};
__device__ __forceinline__ void cmp_peb_partial(const Params& p, int b) {
    const int which = b >> 5, s = b & 31;
    const float* pe = p.in[which ? 10 : 5];
    const float* w1 = p.in[which ? 11 : 6];
    const int j = threadIdx.x;
    float acc = 0.f;
#pragma unroll 16
    for (int i = s * 64; i < s * 64 + 64; ++i) acc += pe[i] * w1[(size_t)i * 256 + j];
    ((float*)(p.ws + OFF_PEB + 4096))[(which * 32 + s) * 256 + j] = acc;
}
__device__ __forceinline__ void cmp_peb_reduce(const Params& p) {
    for (int o = threadIdx.x; o < 512; o += 256) {
        const int which = o >> 8, j = o & 255;
        float acc = p.in[which ? 12 : 7][j];
        for (int s = 0; s < 32; ++s) acc += ((const float*)(p.ws + OFF_PEB + 4096))[(which * 32 + s) * 256 + j];
        ((float*)(p.ws + OFF_PEB))[o] = acc;
    }
}
__device__ __forceinline__ void cmp_layer2_phase(const Params& p, int first_block, int nblocks) {
    const int tid_ = opaque_tid(), lane = tid_ & 63, w = __builtin_amdgcn_readfirstlane(tid_ >> 6);
    for (int slot = (blockIdx.x - first_block) * 4 + w; slot < 2048; slot += nblocks * 4) {
        const int which = slot >> 10, r0 = slot & 1023;
        const float* w2 = p.in[which ? 13 : 8];
        const float* b2 = p.in[which ? 14 : 9];
        const bf16_t* hb = (const bf16_t*)(p.ws + OFF_HB) + (size_t)which * 4096 * 256;
        const bool v3 = (r0 + 3072) < 4088;
        const bf16_t* h0 = hb + (size_t)r0 * 256;
        const bf16_t* h1 = hb + (size_t)(r0 + 1024) * 256;
        const bf16_t* h2 = hb + (size_t)(r0 + 2048) * 256;
        const bf16_t* h3 = hb + (size_t)(v3 ? r0 + 3072 : r0) * 256;
        const float bias = b2[lane];
        float o0 = bias, o1 = bias, o2 = bias, o3 = bias;
#pragma unroll 8
        for (int jj = 0; jj < 128; ++jj) {
            const float wa = w2[(2 * jj) * 64 + lane], wb = w2[(2 * jj + 1) * 64 + lane];
            const unsigned u0 = *(const unsigned*)(h0 + 2 * jj), u1 = *(const unsigned*)(h1 + 2 * jj);
            const unsigned u2 = *(const unsigned*)(h2 + 2 * jj), u3 = *(const unsigned*)(h3 + 2 * jj);
            o0 += __uint_as_float(u0 << 16) * wa; o0 += __uint_as_float(u0 & 0xffff0000u) * wb;
            o1 += __uint_as_float(u1 << 16) * wa; o1 += __uint_as_float(u1 & 0xffff0000u) * wb;
            o2 += __uint_as_float(u2 << 16) * wa; o2 += __uint_as_float(u2 & 0xffff0000u) * wb;
            o3 += __uint_as_float(u3 << 16) * wa; o3 += __uint_as_float(u3 & 0xffff0000u) * wb;
        }
        bf16_t* dst = (bf16_t*)(p.ws + (which ? OFF_CMPVB : OFF_CMPKB));
#define L2ST(row_, o_) { const int g = (row_) & 1, bn = (row_) >> 1, n = bn % NCB, b = bn / NCB;                                         \
                         dst[((size_t)(b * 2 + g) * 512 + n) * 64 + lane] = (bf16_t)f2bf(o_); }
        L2ST(r0, o0) L2ST(r0 + 1024, o1) L2ST(r0 + 2048, o2)
        if (v3) L2ST(r0 + 3072, o3)
#undef L2ST
    }
}

struct StageOfs { int k, v; };
__device__ __forceinline__ StageOfs make_stage_ofs() {
    const int c0 = opaque_tid(), key = c0 >> 3, ch = c0 & 7;
    StageOfs s;
    s.k = key * 128 + ((ch ^ (key & 7)) << 4);
    s.v = key * 128 + (((ch >> 1) ^ ((key >> 1) & 3)) << 5) + (ch & 1) * 16;
    return s;
}
#define NSA_KV_LOAD(S_, kb_) { const bf16_t* kp_ = Kbase + (size_t)(kb_) * 64 * stride + (size_t)(tid >> 3) * stride + (tid & 7) * 8; \
        const bf16_t* vp_ = Vbase + (size_t)(kb_) * 64 * stride + (size_t)(tid >> 3) * stride + (tid & 7) * 8;                 \
        S_##k0 = *(const uint4*)kp_; S_##k1 = *(const uint4*)(kp_ + (size_t)32 * stride);                                    \
        S_##v0 = *(const uint4*)vp_; S_##v1 = *(const uint4*)(vp_ + (size_t)32 * stride); }
#define NSA_KV_STORE(S_, Kl_, Vl_) { *(uint4*)((Kl_) + sof.k) = S_##k0; *(uint4*)((Kl_) + sof.k + 4096) = S_##k1; \
        *(uint4*)((Vl_) + sof.v) = S_##v0; *(uint4*)((Vl_) + sof.v + 4096) = S_##v1; }
template <class Compute>
__device__ __forceinline__ void nsa_kv_loop(const bf16_t* __restrict__ Kbase, const bf16_t* __restrict__ Vbase, int stride,
                                            int kb_lo, int kb_hi, unsigned char* smem, const StageOfs& sof, Compute compute) {
    const int tid = opaque_tid();
    uint4 ra_k0, ra_k1, ra_v0, ra_v1;
    NSA_KV_LOAD(ra_, kb_lo)
    __syncthreads();
    NSA_KV_STORE(ra_, smem, smem + 16384)
    __syncthreads();
    for (int kb = kb_lo; kb <= kb_hi; ++kb) {
        const int buf = (kb - kb_lo) & 1;
        if (kb < kb_hi) NSA_KV_LOAD(ra_, kb + 1)
        compute(kb, smem + buf * 8192, smem + 16384 + buf * 8192);
        if (kb < kb_hi) NSA_KV_STORE(ra_, smem + (buf ^ 1) * 8192, smem + 16384 + (buf ^ 1) * 8192)
        __syncthreads();
    }
}
struct LaneOfs { int k0, k1, vb0, vb1, vb2, vb3; };
__device__ __forceinline__ LaneOfs make_lane_ofs(int lane) {
    LaneOfs f;
    const int r15 = lane & 15, lg = lane >> 4, q = r15 >> 2, pp = r15 & 3;
    f.k0 = r15 * 128 + ((lg ^ (r15 & 7)) << 4);
    f.k1 = r15 * 128 + (((4 + lg) ^ (r15 & 7)) << 4);
    const int sw2 = (2 * (lg & 1) + (q >> 1)) & 3;
    const int vrow = (4 * lg + q) * 128 + pp * 8;
    f.vb0 = vrow + ((0 ^ sw2) << 5); f.vb1 = vrow + ((1 ^ sw2) << 5);
    f.vb2 = vrow + ((2 ^ sw2) << 5); f.vb3 = vrow + ((3 ^ sw2) << 5);
    return f;
}
typedef short s16x4 __attribute__((ext_vector_type(4)));
__device__ __forceinline__ uint2 tr_read(const unsigned char* p) {
    const s16x4 v = __builtin_amdgcn_ds_read_tr16_b64_v4i16((LAS3 s16x4*)p);
    return __builtin_bit_cast(uint2, v);
}
#define NEGM (-1.0e37f)
__device__ __forceinline__ void nsa_scores(const unsigned char* Kl, const LaneOfs& f, const bf16x8& q0, const bf16x8& q1, float bias, f32x4 (&s)[4]) {
#pragma unroll
    for (int kt = 0; kt < 4; ++kt) {
        const bf16x8 a0 = *(const bf16x8*)(Kl + f.k0 + kt * 2048);
        const bf16x8 a1 = *(const bf16x8*)(Kl + f.k1 + kt * 2048);
        f32x4 z = (f32x4){bias, bias, bias, bias};
        z = __builtin_amdgcn_mfma_f32_16x16x32_bf16(a0, q0, z, 0, 0, 0);
        s[kt] = __builtin_amdgcn_mfma_f32_16x16x32_bf16(a1, q1, z, 0, 0, 0);
    }
}
#define ONES_BF16X8 __builtin_bit_cast(bf16x8, make_uint4(0x3F803F80u, 0x3F803F80u, 0x3F803F80u, 0x3F803F80u))
template <class VF>
__device__ __forceinline__ void attn_step(const unsigned char* Kl, const unsigned char* Vl, int lane, const LaneOfs& f,
                                          const bf16x8& q0, const bf16x8& q1, f32x4 (&o)[4], float& m, f32x4& lacc,
                                          float rowbias, bool full, VF valid) {
    f32x4 s[4];
    const bool mok = m > -1e29f;
    const float meff = mok ? m : 0.f;
    nsa_scores(Kl, f, q0, q1, rowbias - meff, s);
    if (!full) {
#pragma unroll
        for (int kt = 0; kt < 4; ++kt)
#pragma unroll
            for (int r = 0; r < 4; ++r) s[kt][r] = valid(kt * 16 + 4 * (lane >> 4) + r) ? s[kt][r] : NEGM;
    }
    float mx = fmaxf(fmaxf(fmaxf(s[0][0], s[0][1]), fmaxf(s[0][2], s[0][3])), fmaxf(fmaxf(s[1][0], s[1][1]), fmaxf(s[1][2], s[1][3])));
    mx = fmaxf(mx, fmaxf(fmaxf(fmaxf(s[2][0], s[2][1]), fmaxf(s[2][2], s[2][3])), fmaxf(fmaxf(s[3][0], s[3][1]), fmaxf(s[3][2], s[3][3]))));
    mx = xrow_max(mx);
    if (!__all(mok && (mx <= 8.f))) {
        const float mn = fmaxf(m, meff + mx);
        const float alpha = __builtin_amdgcn_exp2f(m - mn), d = mn - meff;
        m = mn; lacc[0] *= alpha;
#pragma unroll
        for (int dt = 0; dt < 4; ++dt) { o[dt][0] *= alpha; o[dt][1] *= alpha; o[dt][2] *= alpha; o[dt][3] *= alpha; }
#pragma unroll
        for (int kt = 0; kt < 4; ++kt) { s[kt][0] -= d; s[kt][1] -= d; s[kt][2] -= d; s[kt][3] -= d; }
    }
#pragma unroll
    for (int kt = 0; kt < 4; ++kt)
#pragma unroll
        for (int r = 0; r < 4; ++r) s[kt][r] = __builtin_amdgcn_exp2f(s[kt][r]);
#pragma unroll
    for (int k2 = 0; k2 < 2; ++k2) {
        uint4 pk;
        pk.x = pack2bf(s[2 * k2][0], s[2 * k2][1]); pk.y = pack2bf(s[2 * k2][2], s[2 * k2][3]);
        pk.z = pack2bf(s[2 * k2 + 1][0], s[2 * k2 + 1][1]); pk.w = pack2bf(s[2 * k2 + 1][2], s[2 * k2 + 1][3]);
        const bf16x8 pb = __builtin_bit_cast(bf16x8, pk);
        lacc = __builtin_amdgcn_mfma_f32_16x16x32_bf16(ONES_BF16X8, pb, lacc, 0, 0, 0);
#define PV1(dt_, vb_) { const uint2 lo_ = tr_read(Vl + (vb_) + k2 * 4096), hi_ = tr_read(Vl + (vb_) + k2 * 4096 + 2048); \
                        uint4 av_; av_.x = lo_.x; av_.y = lo_.y; av_.z = hi_.x; av_.w = hi_.y;                          \
                        o[dt_] = __builtin_amdgcn_mfma_f32_16x16x32_bf16(__builtin_bit_cast(bf16x8, av_), pb, o[dt_], 0, 0, 0); }
        PV1(0, f.vb0) PV1(1, f.vb1) PV1(2, f.vb2) PV1(3, f.vb3)
#undef PV1
    }
}
template <class VFA, class VFB>
__device__ __forceinline__ void attn_step2(const unsigned char* Kl, const unsigned char* Vl, int lane, const LaneOfs& f,
                                           const bf16x8& qA0, const bf16x8& qA1, f32x4 (&oA)[4], float& mA, f32x4& lA, float biasA, bool fullA, VFA validA,
                                           const bf16x8& qB0, const bf16x8& qB1, f32x4 (&oB)[4], float& mB, f32x4& lB, float biasB, bool fullB, VFB validB) {
    f32x4 sA[4], sB[4];
    const bool mokA = mA > -1e29f, mokB = mB > -1e29f;
    const float meA = mokA ? mA : 0.f, meB = mokB ? mB : 0.f;
    const float iA = biasA - meA, iB = biasB - meB;
#pragma unroll
    for (int kt = 0; kt < 4; ++kt) {
        const bf16x8 a0 = *(const bf16x8*)(Kl + f.k0 + kt * 2048);
        const bf16x8 a1 = *(const bf16x8*)(Kl + f.k1 + kt * 2048);
        f32x4 zA = (f32x4){iA, iA, iA, iA}, zB = (f32x4){iB, iB, iB, iB};
        zA = __builtin_amdgcn_mfma_f32_16x16x32_bf16(a0, qA0, zA, 0, 0, 0);
        zB = __builtin_amdgcn_mfma_f32_16x16x32_bf16(a0, qB0, zB, 0, 0, 0);
        sA[kt] = __builtin_amdgcn_mfma_f32_16x16x32_bf16(a1, qA1, zA, 0, 0, 0);
        sB[kt] = __builtin_amdgcn_mfma_f32_16x16x32_bf16(a1, qB1, zB, 0, 0, 0);
    }
    if (!fullA) {
#pragma unroll
        for (int kt = 0; kt < 4; ++kt)
#pragma unroll
            for (int r = 0; r < 4; ++r) sA[kt][r] = validA(kt * 16 + 4 * (lane >> 4) + r) ? sA[kt][r] : NEGM;
    }
    if (!fullB) {
#pragma unroll
        for (int kt = 0; kt < 4; ++kt)
#pragma unroll
            for (int r = 0; r < 4; ++r) sB[kt][r] = validB(kt * 16 + 4 * (lane >> 4) + r) ? sB[kt][r] : NEGM;
    }
    float mxA = fmaxf(fmaxf(fmaxf(sA[0][0], sA[0][1]), fmaxf(sA[0][2], sA[0][3])), fmaxf(fmaxf(sA[1][0], sA[1][1]), fmaxf(sA[1][2], sA[1][3])));
    float mxB = fmaxf(fmaxf(fmaxf(sB[0][0], sB[0][1]), fmaxf(sB[0][2], sB[0][3])), fmaxf(fmaxf(sB[1][0], sB[1][1]), fmaxf(sB[1][2], sB[1][3])));
    mxA = fmaxf(mxA, fmaxf(fmaxf(fmaxf(sA[2][0], sA[2][1]), fmaxf(sA[2][2], sA[2][3])), fmaxf(fmaxf(sA[3][0], sA[3][1]), fmaxf(sA[3][2], sA[3][3]))));
    mxB = fmaxf(mxB, fmaxf(fmaxf(fmaxf(sB[2][0], sB[2][1]), fmaxf(sB[2][2], sB[2][3])), fmaxf(fmaxf(sB[3][0], sB[3][1]), fmaxf(sB[3][2], sB[3][3]))));
    mxA = xrow_max(mxA); mxB = xrow_max(mxB);
    if (!__all(mokA && mokB && (mxA <= 8.f) && (mxB <= 8.f))) {
        const float mnA = fmaxf(mA, meA + mxA), mnB = fmaxf(mB, meB + mxB);
        const float alA = __builtin_amdgcn_exp2f(mA - mnA), alB = __builtin_amdgcn_exp2f(mB - mnB);
        const float dA = mnA - meA, dB = mnB - meB;
        mA = mnA; mB = mnB; lA[0] *= alA; lB[0] *= alB;
#pragma unroll
        for (int dt = 0; dt < 4; ++dt) {
            oA[dt][0] *= alA; oA[dt][1] *= alA; oA[dt][2] *= alA; oA[dt][3] *= alA;
            oB[dt][0] *= alB; oB[dt][1] *= alB; oB[dt][2] *= alB; oB[dt][3] *= alB;
        }
#pragma unroll
        for (int kt = 0; kt < 4; ++kt) {
            sA[kt][0] -= dA; sA[kt][1] -= dA; sA[kt][2] -= dA; sA[kt][3] -= dA;
            sB[kt][0] -= dB; sB[kt][1] -= dB; sB[kt][2] -= dB; sB[kt][3] -= dB;
        }
    }
#pragma unroll
    for (int kt = 0; kt < 4; ++kt)
#pragma unroll
        for (int r = 0; r < 4; ++r) { sA[kt][r] = __builtin_amdgcn_exp2f(sA[kt][r]); sB[kt][r] = __builtin_amdgcn_exp2f(sB[kt][r]); }
#pragma unroll
    for (int k2 = 0; k2 < 2; ++k2) {
        uint4 pk;
        pk.x = pack2bf(sA[2 * k2][0], sA[2 * k2][1]); pk.y = pack2bf(sA[2 * k2][2], sA[2 * k2][3]);
        pk.z = pack2bf(sA[2 * k2 + 1][0], sA[2 * k2 + 1][1]); pk.w = pack2bf(sA[2 * k2 + 1][2], sA[2 * k2 + 1][3]);
        const bf16x8 pbA = __builtin_bit_cast(bf16x8, pk);
        pk.x = pack2bf(sB[2 * k2][0], sB[2 * k2][1]); pk.y = pack2bf(sB[2 * k2][2], sB[2 * k2][3]);
        pk.z = pack2bf(sB[2 * k2 + 1][0], sB[2 * k2 + 1][1]); pk.w = pack2bf(sB[2 * k2 + 1][2], sB[2 * k2 + 1][3]);
        const bf16x8 pbB = __builtin_bit_cast(bf16x8, pk);
        lA = __builtin_amdgcn_mfma_f32_16x16x32_bf16(ONES_BF16X8, pbA, lA, 0, 0, 0);
        lB = __builtin_amdgcn_mfma_f32_16x16x32_bf16(ONES_BF16X8, pbB, lB, 0, 0, 0);
#define PV2(dt_, vb_) { const uint2 lo_ = tr_read(Vl + (vb_) + k2 * 4096), hi_ = tr_read(Vl + (vb_) + k2 * 4096 + 2048); \
                        uint4 av_; av_.x = lo_.x; av_.y = lo_.y; av_.z = hi_.x; av_.w = hi_.y;                          \
                        oA[dt_] = __builtin_amdgcn_mfma_f32_16x16x32_bf16(__builtin_bit_cast(bf16x8, av_), pbA, oA[dt_], 0, 0, 0); \
                        oB[dt_] = __builtin_amdgcn_mfma_f32_16x16x32_bf16(__builtin_bit_cast(bf16x8, av_), pbB, oB[dt_], 0, 0, 0); }
        PV2(0, f.vb0) PV2(1, f.vb1) PV2(2, f.vb2) PV2(3, f.vb3)
#undef PV2
    }
}

#define NSA_TILES 2048
__device__ __forceinline__ void nsa_tile(const Params& p, int tile, unsigned char* smem) {
    const int tid = opaque_tid(), lane = tid & 63, w = __builtin_amdgcn_readfirstlane(tid >> 6);
    const int bg = tile & 7, tb = 255 - (tile >> 3);
    const int b = bg >> 1, g = bg & 1;
    const int t0 = tb * 32, cur = t0 >> 6;
    float* impL = (float*)(smem + 32768);
    unsigned* selL = (unsigned*)(smem + 49152);
    const bf16_t* NQ = (const bf16_t*)(p.ws + OFF_NQ);
    const float* NG = (const float*)(p.ws + OFF_NGATE);
    const int rowq = lane & 15, tl = rowq >> 2, head = rowq & 3, lg = lane >> 4;
    const int toklA = 8 * w + tl, toklB = 8 * w + 4 + tl;
    const LaneOfs lof = make_lane_ofs(lane);
    const StageOfs sof = make_stage_ofs();
    const size_t tokb = (size_t)b * SEQ + t0;
    bf16x8 qA0, qA1, qB0, qB1;
    {
        const bf16_t* qp = NQ + (tokb + toklA) * 512 + g * 256 + head * 64 + lg * 8;
        qA0 = *(const bf16x8*)qp; qA1 = *(const bf16x8*)(qp + 32);
        qB0 = *(const bf16x8*)(qp + 4 * 512); qB1 = *(const bf16x8*)(qp + 4 * 512 + 32);
    }
    const float* gpA = NG + (tokb + toklA) * 24 + g * 12 + head * 3;
    const float* gpB = gpA + 4 * 24;
    __syncthreads();
    for (int i = tid; i < 4096; i += 256) impL[i] = 0.f;
    const int tqA = t0 + toklA, tqB = t0 + toklB;
    const int tminA = t0 + 8 * w, tminB = tminA + 4;
    f32x4 oA[4], oB[4], otA[4], otB[4];
    float mA, mB;
    f32x4 lA, lB;
#define NSA_RESET() { _Pragma("unroll") for (int dt = 0; dt < 4; ++dt) { oA[dt] = (f32x4){0.f, 0.f, 0.f, 0.f}; oB[dt] = (f32x4){0.f, 0.f, 0.f, 0.f}; } \
                      mA = -1e30f; mB = -1e30f; lA = (f32x4){0.f, 0.f, 0.f, 0.f}; lB = (f32x4){0.f, 0.f, 0.f, 0.f}; }
#define NSA_LSUM() { }

    const int nvA = (tqA >= 31) ? (((tqA - 31) >> 4) + 1) : 0;
    const int nvB = (tqB >= 31) ? (((tqB - 31) >> 4) + 1) : 0;
    const int nvminA = (tminA >= 31) ? (((tminA - 31) >> 4) + 1) : 0;
    const int nvminB = (tminB >= 31) ? (((tminB - 31) >> 4) + 1) : 0;
    const int nkb = (((t0 >> 4) + 1) + 63) >> 6;
    const bf16_t* ckb = (const bf16_t*)(p.ws + OFF_CMPKB) + (size_t)(b * 2 + g) * 512 * 64;
    const bf16_t* cvb = (const bf16_t*)(p.ws + OFF_CMPVB) + (size_t)(b * 2 + g) * 512 * 64;
    NSA_RESET()
    nsa_kv_loop(ckb, cvb, 64, 0, nkb - 1, smem, sof, [&](int kb, const unsigned char* Kl, const unsigned char* Vl) __attribute__((always_inline)) {
        attn_step2(Kl, Vl, lane, lof,
                   qA0, qA1, oA, mA, lA, 0.f, kb * 64 + 64 <= nvminA, [&](int key) __attribute__((always_inline)) { return kb * 64 + key < nvA; },
                   qB0, qB1, oB, mB, lB, 0.f, kb * 64 + 64 <= nvminB, [&](int key) __attribute__((always_inline)) { return kb * 64 + key < nvB; });
    });
    NSA_LSUM()
    const float mcA = mA, mcB = mB;
    const float invcA = 1.f / fmaxf(lA[0], 1e-30f), invcB = 1.f / fmaxf(lB[0], 1e-30f);
    {
        const float fA = gpA[0] * invcA, fB = gpB[0] * invcB;
#pragma unroll
        for (int dt = 0; dt < 4; ++dt) {
            otA[dt][0] = fA * oA[dt][0]; otA[dt][1] = fA * oA[dt][1]; otA[dt][2] = fA * oA[dt][2]; otA[dt][3] = fA * oA[dt][3];
            otB[dt][0] = fB * oB[dt][0]; otB[dt][1] = fB * oB[dt][1]; otB[dt][2] = fB * oB[dt][2]; otB[dt][3] = fB * oB[dt][3];
        }
    }
    if (cur >= 16) {
        nsa_kv_loop(ckb, cvb, 64, 0, nkb - 1, smem, sof, [&](int kb, const unsigned char* Kl, const unsigned char* Vl) __attribute__((always_inline)) {
#pragma unroll
            for (int mt = 0; mt < 2; ++mt) {
                f32x4 s[4];
                nsa_scores(Kl, lof, mt ? qB0 : qA0, mt ? qB1 : qA1, 0.f, s);
                const int nv = mt ? nvB : nvA;
                const float mc = mt ? mcB : mcA, inv = mt ? invcB : invcA;
                float* impT = impL + (mt ? toklB : toklA) * 128;
#pragma unroll
                for (int kt = 0; kt < 4; ++kt) {
                    float pr[4];
#pragma unroll
                    for (int r = 0; r < 4; ++r) {
                        const int n = kb * 64 + kt * 16 + 4 * lg + r;
                        pr[r] = (n < nv) ? __builtin_amdgcn_exp2f(s[kt][r] - mc) * inv : 0.f;
                    }
                    float c1 = pr[0] + pr[1] + pr[2] + 0.5f * pr[3], c2 = 0.5f * pr[3];
                    c1 += __shfl_xor(c1, 1); c1 += __shfl_xor(c1, 2);
                    c2 += __shfl_xor(c2, 1); c2 += __shfl_xor(c2, 2);
                    const int j = kb * 16 + kt * 4 + lg;
                    if (head == 0) {
                        atomicAdd(&impT[j], c1);
                        if (j + 1 < 128) atomicAdd(&impT[j + 1], c2);
                    }
                }
                    }
        });
#pragma unroll 1
        for (int pass = 0; pass < 2; ++pass) {
            const int tok = 8 * w + 4 * pass + lg, c = lane & 15;
            const float4 i0 = *(const float4*)(impL + tok * 128 + 8 * c), i1 = *(const float4*)(impL + tok * 128 + 8 * c + 4);
            const float iv[8] = {i0.x, i0.y, i0.z, i0.w, i1.x, i1.y, i1.z, i1.w};
            float kl[8];
#pragma unroll
            for (int q = 0; q < 8; ++q) {
                const int j = 8 * c + q;
                const bool forced = (j == 0) || (j == cur) || (j == cur - 1);
                const float sc = forced ? 1.0e4f : ((j <= cur) ? iv[q] : -1.f);
                kl[q] = enc_key(sc, (unsigned)j, 127);
            }
            float l0 = kl[0], l1 = kl[1], l2 = kl[2], l3 = kl[3], l4 = kl[4], l5 = kl[5], l6 = kl[6], l7 = kl[7];
            CE_DESC(l0, l1) CE_DESC(l2, l3) CE_DESC(l4, l5) CE_DESC(l6, l7)
            CE_DESC(l0, l2) CE_DESC(l1, l3) CE_DESC(l4, l6) CE_DESC(l5, l7)
            CE_DESC(l1, l2) CE_DESC(l5, l6)
            CE_DESC(l0, l4) CE_DESC(l1, l5) CE_DESC(l2, l6) CE_DESC(l3, l7)
            CE_DESC(l2, l4) CE_DESC(l3, l5)
            CE_DESC(l1, l2) CE_DESC(l3, l4) CE_DESC(l5, l6)
            unsigned pm = 0u;
#pragma unroll
            for (int k = 0; k < 16; ++k) {
                const float mx = row16_max(l0);
                const bool win = (l0 == mx);
                pm |= win ? (1u << (dec_idx(l0, 127) & 7u)) : 0u;
                l0 = win ? l1 : l0; l1 = win ? l2 : l1; l2 = win ? l3 : l2; l3 = win ? l4 : l3;
                l4 = win ? l5 : l4; l5 = win ? l6 : l5; l6 = win ? l7 : l6; l7 = win ? NEGKEY : l7;
            }
            ((unsigned char*)selL)[tok * 16 + c] = (unsigned char)pm;
        }
    } else {
        if (lane < 8) {
            const int tok = 8 * w + lane;
            selL[tok * 4 + 0] = (2u << cur) - 1u; selL[tok * 4 + 1] = 0u; selL[tok * 4 + 2] = 0u; selL[tok * 4 + 3] = 0u;
        }
    }
    WAVE_LDS_SYNC();
#if NSA_DIAG
    if (head == 0 && lg == 0) {
        unsigned* SELM = (unsigned*)(p.ws + OFF_SELM);
#pragma unroll
        for (int qd = 0; qd < 4; ++qd) {
            SELM[((size_t)bg * SEQ + tqA) * 4 + qd] = selL[toklA * 4 + qd];
            SELM[((size_t)bg * SEQ + tqB) * 4 + qd] = selL[toklB * 4 + qd];
        }
    }
#endif
    NSA_RESET()
    {
        const bf16_t* kg = (const bf16_t*)(p.ws + OFF_KV + 2 * KV_STRIDE) + (size_t)b * SEQ * 128 + g * 64;
        const bf16_t* vg = (const bf16_t*)(p.ws + OFF_KV + 3 * KV_STRIDE) + (size_t)b * SEQ * 128 + g * 64;
        nsa_kv_loop(kg, vg, 128, 0, cur, smem, sof, [&](int kb, const unsigned char* Kl, const unsigned char* Vl) __attribute__((always_inline)) {
            const bool svA = (selL[toklA * 4 + (kb >> 5)] >> (kb & 31)) & 1u;
            const bool svB = (selL[toklB * 4 + (kb >> 5)] >> (kb & 31)) & 1u;
            const bool nA = __ballot(svA) != 0ull, nB = __ballot(svB) != 0ull;
            if (nA && nB)
                attn_step2(Kl, Vl, lane, lof,
                           qA0, qA1, oA, mA, lA, svA ? 0.f : NEGM, kb < cur, [&](int key) __attribute__((always_inline)) { return kb * 64 + key <= tqA; },
                           qB0, qB1, oB, mB, lB, svB ? 0.f : NEGM, kb < cur, [&](int key) __attribute__((always_inline)) { return kb * 64 + key <= tqB; });
            else if (nA)
                attn_step(Kl, Vl, lane, lof, qA0, qA1, oA, mA, lA, svA ? 0.f : NEGM, kb < cur, [&](int key) __attribute__((always_inline)) { return kb * 64 + key <= tqA; });
            else if (nB)
                attn_step(Kl, Vl, lane, lof, qB0, qB1, oB, mB, lB, svB ? 0.f : NEGM, kb < cur, [&](int key) __attribute__((always_inline)) { return kb * 64 + key <= tqB; });
        });
    }
    NSA_LSUM()
    {
        const float fA = gpA[1] / fmaxf(lA[0], 1e-30f), fB = gpB[1] / fmaxf(lB[0], 1e-30f);
#pragma unroll
        for (int dt = 0; dt < 4; ++dt) {
            otA[dt][0] += fA * oA[dt][0]; otA[dt][1] += fA * oA[dt][1]; otA[dt][2] += fA * oA[dt][2]; otA[dt][3] += fA * oA[dt][3];
            otB[dt][0] += fB * oB[dt][0]; otB[dt][1] += fB * oB[dt][1]; otB[dt][2] += fB * oB[dt][2]; otB[dt][3] += fB * oB[dt][3];
        }
    }
    NSA_RESET()
    {
        const bf16_t* kg = (const bf16_t*)(p.ws + OFF_KV + 4 * KV_STRIDE) + (size_t)b * SEQ * 128 + g * 64;
        const bf16_t* vg = (const bf16_t*)(p.ws + OFF_KV + 5 * KV_STRIDE) + (size_t)b * SEQ * 128 + g * 64;
        const int klo = (t0 > 511) ? ((t0 - 511) >> 6) : 0;
        nsa_kv_loop(kg, vg, 128, klo, cur, smem, sof, [&](int kb, const unsigned char* Kl, const unsigned char* Vl) __attribute__((always_inline)) {
            attn_step2(Kl, Vl, lane, lof,
                       qA0, qA1, oA, mA, lA, 0.f, (kb * 64 >= tminA + 3 - 511) && (kb * 64 + 63 <= tminA),
                       [&](int key) __attribute__((always_inline)) { const int ka = kb * 64 + key; return (ka <= tqA) && (ka >= tqA - 511); },
                       qB0, qB1, oB, mB, lB, 0.f, (kb * 64 >= tminB + 3 - 511) && (kb * 64 + 63 <= tminB),
                       [&](int key) __attribute__((always_inline)) { const int ka = kb * 64 + key; return (ka <= tqB) && (ka >= tqB - 511); });
        });
    }
    NSA_LSUM()
    {
        const float fA = gpA[2] / fmaxf(lA[0], 1e-30f), fB = gpB[2] / fmaxf(lB[0], 1e-30f);
        bf16_t* MIX = (bf16_t*)(p.ws + OFF_XB) + (tokb + toklA) * DM + 512 + g * 256 + head * 64 + lg * 4;
#pragma unroll
        for (int dt = 0; dt < 4; ++dt) {
            uint2 ov;
            ov.x = pack2bf(otA[dt][0] + fA * oA[dt][0], otA[dt][1] + fA * oA[dt][1]);
            ov.y = pack2bf(otA[dt][2] + fA * oA[dt][2], otA[dt][3] + fA * oA[dt][3]);
            *(uint2*)(MIX + dt * 16) = ov;
            ov.x = pack2bf(otB[dt][0] + fB * oB[dt][0], otB[dt][1] + fB * oB[dt][1]);
            ov.y = pack2bf(otB[dt][2] + fB * oB[dt][2], otB[dt][3] + fB * oB[dt][3]);
            *(uint2*)(MIX + 4 * DM + dt * 16) = ov;
        }
    }
#undef NSA_RESET
#undef NSA_LSUM
}

__device__ __forceinline__ float block_sum(float v, float* red) {
    v = wave_sum(v);
    __syncthreads();
    if ((threadIdx.x & 63) == 0) red[threadIdx.x >> 6] = v;
    __syncthreads();
    return red[0] + red[1] + red[2] + red[3];
}
__device__ __forceinline__ float4 ln_row(float4 y, const float* g, const float* bb, float* red) {
    const int tid = opaque_tid();
    const float mu = block_sum(y.x + y.y + y.z + y.w, red) * (1.f / 1024.f);
    const float dx = y.x - mu, dy = y.y - mu, dz = y.z - mu, dw = y.w - mu;
    const float var = block_sum(dx * dx + dy * dy + dz * dz + dw * dw, red) * (1.f / 1024.f);
    const float rs = rsqrtf(var + LN_EPS);
    const float4 gg = ((const float4*)g)[tid], b4 = ((const float4*)bb)[tid];
    return make_float4(dx * rs * gg.x + b4.x, dy * rs * gg.y + b4.y, dz * rs * gg.z + b4.z, dw * rs * gg.w + b4.w);
}

__device__ __forceinline__ void ln1_phase(const Params& p, float* sm) {
    const int tid = opaque_tid(), lane = tid & 63, w = __builtin_amdgcn_readfirstlane(tid >> 6);
    const float4* g4 = (const float4*)(p.in[15] + 16 * lane);
    const float4* b4 = (const float4*)(p.in[16] + 16 * lane);
    const float4 ga = g4[0], gb = g4[1], gc = g4[2], gd = g4[3];
    const float4 ba = b4[0], bb = b4[1], bc = b4[2], bd = b4[3];
#pragma unroll 2
    for (int n = blockIdx.x * 4 + w; n < NTOK; n += gridDim.x * 4) {
        const float4* xr = (const float4*)(p.in[0] + (size_t)n * DM + 16 * lane);
        const uint4* mr = (const uint4*)((const bf16_t*)p.out + (size_t)n * DM + 16 * lane);
        const float4 y0 = xr[0], y1 = xr[1], y2 = xr[2], y3 = xr[3];
        const uint4 m0 = mr[0], m1 = mr[1];
        float y[16] = {ALPHA * y0.x + bf2f(m0.x & 0xffffu), ALPHA * y0.y + bf2f(m0.x >> 16), ALPHA * y0.z + bf2f(m0.y & 0xffffu), ALPHA * y0.w + bf2f(m0.y >> 16),
                       ALPHA * y1.x + bf2f(m0.z & 0xffffu), ALPHA * y1.y + bf2f(m0.z >> 16), ALPHA * y1.z + bf2f(m0.w & 0xffffu), ALPHA * y1.w + bf2f(m0.w >> 16),
                       ALPHA * y2.x + bf2f(m1.x & 0xffffu), ALPHA * y2.y + bf2f(m1.x >> 16), ALPHA * y2.z + bf2f(m1.y & 0xffffu), ALPHA * y2.w + bf2f(m1.y >> 16),
                       ALPHA * y3.x + bf2f(m1.z & 0xffffu), ALPHA * y3.y + bf2f(m1.z >> 16), ALPHA * y3.z + bf2f(m1.w & 0xffffu), ALPHA * y3.w + bf2f(m1.w >> 16)};
        const float g[16] = {ga.x, ga.y, ga.z, ga.w, gb.x, gb.y, gb.z, gb.w, gc.x, gc.y, gc.z, gc.w, gd.x, gd.y, gd.z, gd.w};
        const float bv[16] = {ba.x, ba.y, ba.z, ba.w, bb.x, bb.y, bb.z, bb.w, bc.x, bc.y, bc.z, bc.w, bd.x, bd.y, bd.z, bd.w};
        float sum = 0.f;
#pragma unroll
        for (int q = 0; q < 16; ++q) sum += y[q];
        const float mu = wave_sum(sum) * (1.f / 1024.f);
        float sq = 0.f;
#pragma unroll
        for (int q = 0; q < 16; ++q) { y[q] -= mu; sq += y[q] * y[q]; }
        const float rs = rsqrtf(wave_sum(sq) * (1.f / 1024.f) + LN_EPS);
        uint4 o0, o1;
        o0.x = pack2bf(y[0] * rs * g[0] + bv[0], y[1] * rs * g[1] + bv[1]);     o0.y = pack2bf(y[2] * rs * g[2] + bv[2], y[3] * rs * g[3] + bv[3]);
        o0.z = pack2bf(y[4] * rs * g[4] + bv[4], y[5] * rs * g[5] + bv[5]);     o0.w = pack2bf(y[6] * rs * g[6] + bv[6], y[7] * rs * g[7] + bv[7]);
        o1.x = pack2bf(y[8] * rs * g[8] + bv[8], y[9] * rs * g[9] + bv[9]);     o1.y = pack2bf(y[10] * rs * g[10] + bv[10], y[11] * rs * g[11] + bv[11]);
        o1.z = pack2bf(y[12] * rs * g[12] + bv[12], y[13] * rs * g[13] + bv[13]); o1.w = pack2bf(y[14] * rs * g[14] + bv[14], y[15] * rs * g[15] + bv[15]);
        uint4* hb = (uint4*)((bf16_t*)(p.ws + OFF_XB) + (size_t)n * DM + 16 * lane);
        hb[0] = o0; hb[1] = o1;
    }
}


typedef float f32x2 __attribute__((ext_vector_type(2)));
__device__ __forceinline__ void cvt_rows_fp8(const float* __restrict__ src, unsigned char* __restrict__ dst, float* __restrict__ scales, int rows,
                                             int first_block, int nblocks) {
    const int tid_ = opaque_tid(), lane = tid_ & 63, w = __builtin_amdgcn_readfirstlane(tid_ >> 6);
    for (int r = ((int)blockIdx.x - first_block) * 4 + w; r < rows; r += nblocks * 4) {
        const float4* sp = (const float4*)(src + (size_t)r * 1024 + lane * 16);
        const float4 a = sp[0], b = sp[1], c = sp[2], d = sp[3];
        float mx = fmaxf(fmaxf(fmaxf(fabsf(a.x), fabsf(a.y)), fmaxf(fabsf(a.z), fabsf(a.w))), fmaxf(fmaxf(fabsf(b.x), fabsf(b.y)), fmaxf(fabsf(b.z), fabsf(b.w))));
        mx = fmaxf(mx, fmaxf(fmaxf(fmaxf(fabsf(c.x), fabsf(c.y)), fmaxf(fabsf(c.z), fabsf(c.w))), fmaxf(fmaxf(fabsf(d.x), fabsf(d.y)), fmaxf(fabsf(d.z), fabsf(d.w)))));
        mx = wave_max(mx);
        const float sc = (mx > 0.f) ? mx * (1.f / 448.f) : 1.f;
        const float inv = 1.f / sc;
        uint4 o;
        int t;
        t = 0; t = __builtin_amdgcn_cvt_pk_fp8_f32(a.x * inv, a.y * inv, t, false); t = __builtin_amdgcn_cvt_pk_fp8_f32(a.z * inv, a.w * inv, t, true); o.x = (unsigned)t;
        t = 0; t = __builtin_amdgcn_cvt_pk_fp8_f32(b.x * inv, b.y * inv, t, false); t = __builtin_amdgcn_cvt_pk_fp8_f32(b.z * inv, b.w * inv, t, true); o.y = (unsigned)t;
        t = 0; t = __builtin_amdgcn_cvt_pk_fp8_f32(c.x * inv, c.y * inv, t, false); t = __builtin_amdgcn_cvt_pk_fp8_f32(c.z * inv, c.w * inv, t, true); o.z = (unsigned)t;
        t = 0; t = __builtin_amdgcn_cvt_pk_fp8_f32(d.x * inv, d.y * inv, t, false); t = __builtin_amdgcn_cvt_pk_fp8_f32(d.z * inv, d.w * inv, t, true); o.w = (unsigned)t;
        *(uint4*)(dst + (size_t)r * 1024 + lane * 16) = o;
        if (lane == 0) scales[r] = sc;
    }
}

__device__ __forceinline__ unsigned pack4i8(float a, float b, float c, float d) {
    const int ia = (int)rintf(a), ib = (int)rintf(b), ic = (int)rintf(c), id = (int)rintf(d);
    return (unsigned)(ia & 255) | ((unsigned)(ib & 255) << 8) | ((unsigned)(ic & 255) << 16) | ((unsigned)id << 24);
}
__device__ __forceinline__ void cvt_rows_i8(const float* __restrict__ src, unsigned char* __restrict__ dst, float* __restrict__ scales, int rows,
                                            int first_block, int nblocks) {
    const int tid_ = opaque_tid(), lane = tid_ & 63, w = __builtin_amdgcn_readfirstlane(tid_ >> 6);
    for (int r = ((int)blockIdx.x - first_block) * 4 + w; r < rows; r += nblocks * 4) {
        const float4* sp = (const float4*)(src + (size_t)r * 1024 + lane * 16);
        const float4 a = sp[0], b = sp[1], c = sp[2], d = sp[3];
        float mx = fmaxf(fmaxf(fmaxf(fabsf(a.x), fabsf(a.y)), fmaxf(fabsf(a.z), fabsf(a.w))), fmaxf(fmaxf(fabsf(b.x), fabsf(b.y)), fmaxf(fabsf(b.z), fabsf(b.w))));
        mx = fmaxf(mx, fmaxf(fmaxf(fmaxf(fabsf(c.x), fabsf(c.y)), fmaxf(fabsf(c.z), fabsf(c.w))), fmaxf(fmaxf(fabsf(d.x), fabsf(d.y)), fmaxf(fabsf(d.z), fabsf(d.w)))));
        mx = wave_max(mx);
        const float sc = (mx > 0.f) ? mx * (1.f / 127.f) : 1.f;
        const float inv = 1.f / sc;
        uint4 o;
        o.x = pack4i8(a.x * inv, a.y * inv, a.z * inv, a.w * inv); o.y = pack4i8(b.x * inv, b.y * inv, b.z * inv, b.w * inv);
        o.z = pack4i8(c.x * inv, c.y * inv, c.z * inv, c.w * inv); o.w = pack4i8(d.x * inv, d.y * inv, d.z * inv, d.w * inv);
        *(uint4*)(dst + (size_t)r * 1024 + lane * 16) = o;
        if (lane == 0) scales[r] = sc;
    }
}

__device__ __forceinline__ void fold_ws_phase(const float* __restrict__ wq, const float* __restrict__ k1, const float* __restrict__ k2,
                                              bf16_t* __restrict__ WsT) {
    for (int it = blockIdx.x * 256 + threadIdx.x; it < 2048 * 128; it += gridDim.x * 256) {
        const int r = it & 2047, kg = it >> 11;
        const int a = (r >> 7) & 1, j = r & 127;
        const float* kr = (a ? k2 : k1) + j * 128;
        const float* wr = wq + (size_t)(kg * 8) * 2048 + (r & ~127);
        float s[8];
#pragma unroll
        for (int q = 0; q < 8; ++q) s[q] = 0.f;
#pragma unroll 8
        for (int d = 0; d < 128; d += 4) {
            const float4 kv = *(const float4*)(kr + d);
#pragma unroll
            for (int q = 0; q < 8; ++q) {
                const float4 wv = *(const float4*)(wr + (size_t)q * 2048 + d);
                s[q] += wv.x * kv.x + wv.y * kv.y + wv.z * kv.z + wv.w * kv.w;
            }
        }
        uint4 o;
        o.x = pack2bf(s[0], s[1]); o.y = pack2bf(s[2], s[3]); o.z = pack2bf(s[4], s[5]); o.w = pack2bf(s[6], s[7]);
        *(uint4*)(WsT + (size_t)r * 1024 + kg * 8) = o;
    }
}


struct EpiTop16 {
    static constexpr bool kRow = false;
    float* topk; unsigned char* lds;
    __device__ __forceinline__ void operator()(int m, int n, f32x4 v) const {
        const int ml = m & 127, g4 = (n & 127) >> 2;
        *(float4*)(lds + ((ml * 32 + (g4 ^ (ml & 7))) << 4)) = make_float4(v[0], v[1], v[2], v[3]);
    }
    template <class F> __device__ __forceinline__ void dispatch(int, F f) const { f(*this); }
    __device__ __forceinline__ void finish(int m0, int n0) const {
        __syncthreads();
        const int tid_ = opaque_tid(), lane = tid_ & 63, w = __builtin_amdgcn_readfirstlane(tid_ >> 6), c = lane & 15;
        const int L = n0 >> 7;
#pragma unroll 2
        for (int it = 0; it < 8; ++it) {
            const int r = w * 32 + it * 4 + (lane >> 4);
            const float4 x0 = *(const float4*)(lds + ((r * 32 + ((2 * c) ^ (r & 7))) << 4));
            const float4 x1 = *(const float4*)(lds + ((r * 32 + ((2 * c + 1) ^ (r & 7))) << 4));
            float l0 = enc_key(x0.x, 8 * c + 0, 127), l1 = enc_key(x0.y, 8 * c + 1, 127), l2 = enc_key(x0.z, 8 * c + 2, 127),
                  l3 = enc_key(x0.w, 8 * c + 3, 127), l4 = enc_key(x1.x, 8 * c + 4, 127), l5 = enc_key(x1.y, 8 * c + 5, 127),
                  l6 = enc_key(x1.z, 8 * c + 6, 127), l7 = enc_key(x1.w, 8 * c + 7, 127);
            CE_DESC(l0, l1) CE_DESC(l2, l3) CE_DESC(l4, l5) CE_DESC(l6, l7)
            CE_DESC(l0, l2) CE_DESC(l1, l3) CE_DESC(l4, l6) CE_DESC(l5, l7)
            CE_DESC(l1, l2) CE_DESC(l5, l6)
            CE_DESC(l0, l4) CE_DESC(l1, l5) CE_DESC(l2, l6) CE_DESC(l3, l7)
            CE_DESC(l2, l4) CE_DESC(l3, l5)
            CE_DESC(l1, l2) CE_DESC(l3, l4) CE_DESC(l5, l6)
            float res = NEGKEY;
#pragma unroll
            for (int k = 0; k < 16; ++k) {
                const float mx = row16_max(l0);
                const bool win = (l0 == mx);
                l0 = win ? l1 : l0; l1 = win ? l2 : l1; l2 = win ? l3 : l2; l3 = win ? l4 : l3;
                l4 = win ? l5 : l4; l5 = win ? l6 : l5; l6 = win ? l7 : l6; l7 = win ? NEGKEY : l7;
                res = (c == k) ? mx : res;
            }
            topk[(size_t)(m0 + r) * 256 + L * 16 + c] = res;
        }
        __syncthreads();
    }
};

template <int PART>
__device__ __forceinline__ void peer_fast_phase(const Params& p, unsigned char* smem) {
    const int tid = opaque_tid(), lane = tid & 63, w = __builtin_amdgcn_readfirstlane(tid >> 6), l16 = lane & 15, gq = lane >> 4;
    float* tk = (float*)(smem + w * 2048);
    int* ex = (int*)(smem + w * 2048 + 1024);
    float* gw = (float*)(smem + w * 2048 + 1536);
    const bf16_t* H1B = (const bf16_t*)(p.ws + OFF_XB);
    const unsigned char* U8 = p.ws + OFF_UB;
    const unsigned char* V8 = p.ws + OFF_VB;
    const float* USC = (const float*)(p.ws + OFF_USC);
    const float* VSC = (const float*)(p.ws + OFF_VSC);
    const float* TOPK = (const float*)(p.ws + OFF_TOPK);
    int ci[4], cj[4];
#pragma unroll
    for (int q = 0; q < 4; ++q) {
        const int s = l16 + 16 * q;
        int i, j;
        if (s < 16) { i = 0; j = s; }
        else if (s < 24) { i = 1; j = s - 16; }
        else if (s < 29) { i = 2; j = s - 24; }
        else if (s < 33) { i = 3; j = s - 29; }
        else if (s < 36) { i = 4; j = s - 33; }
        else if (s < 42) { i = 5 + ((s - 36) >> 1); j = (s - 36) & 1; }
        else if (s < 50) { i = 8 + (s - 42); j = 0; }
        else { i = -1; j = 0; }
        ci[q] = i; cj[q] = j;
    }
    int* exs = (int*)(smem + 8192 + w * 4096);
    float* gws = (float*)(smem + 8192 + w * 4096 + 2048);
    float* hraw = (float*)(smem + 24576 + w * 2048);
    float* xsc = (float*)(smem + w * 2048);
    int* SEX = (int*)(p.ws + OFF_HQ);
    float* SGW = (float*)(p.ws + OFF_HLF);
    for (int qd = blockIdx.x * 4 + w; qd < NTOK / 4; qd += gridDim.x * 4) {
        const int n0 = qd * 4;
        if (PART == 0) {
        float4 tkn = ((const float4*)(TOPK + (size_t)n0 * 256))[lane];
#pragma unroll 1
        for (int t = 0; t < 4; ++t) {
            const int n = n0 + t;
            WAVE_LDS_SYNC();
            ((float4*)tk)[lane] = tkn;
            {
                int nn = (t < 3) ? n + 1 : (qd + (int)gridDim.x * 4) * 4;
                nn = (nn < NTOK) ? nn : n;
                tkn = ((const float4*)(TOPK + (size_t)nn * 256))[lane];
            }
            WAVE_LDS_SYNC();
#pragma unroll
            for (int it = 0; it < 2; ++it) {
                const int head = it * 4 + gq;
                const float* ka = tk + head * 32;
                const float* kb = ka + 16;
                float c0, c1, c2, c3;
#define MKC(q, cq) { if (ci[q] >= 0) { const float sum_ = dec_val(ka[ci[q]], 127) + dec_val(kb[cj[q]], 127); \
                         cq = enc_key(sum_, ci[q] * 16 + cj[q], 255); } else cq = NEGKEY; }
                MKC(0, c0) MKC(1, c1) MKC(2, c2) MKC(3, c3)
#undef MKC
                float res = NEGKEY;
#pragma unroll
                for (int k = 0; k < 16; ++k) {
                    const float mx = row16_max(fmaxf(fmaxf(c0, c1), fmaxf(c2, c3)));
                    c0 = (c0 == mx) ? NEGKEY : c0; c1 = (c1 == mx) ? NEGKEY : c1;
                    c2 = (c2 == mx) ? NEGKEY : c2; c3 = (c3 == mx) ? NEGKEY : c3;
                    res = (l16 == k) ? mx : res;
                }
                const unsigned cc = dec_idx(res, 255);
                const float val = dec_val(res, 255);
                const unsigned e1 = dec_idx(ka[cc >> 4], 127), e2 = dec_idx(kb[cc & 15], 127);
                const float m0 = row16_max(val);
                const float e = expf(val - m0);
                const float ssum = row16_sum(e);
                ex[head * 16 + l16] = (int)(e1 * 128 + e2);
                gw[head * 16 + l16] = e / ssum;
            }
            WAVE_LDS_SYNC();
            {
                const int e0 = ex[lane], e1v = ex[lane + 64];
                const float g0 = gw[lane], g1 = gw[lane + 64];
                const int s0 = e0 >> 11, s1 = e1v >> 11;
                const unsigned long long lt = (1ull << lane) - 1ull;
                int base = 0, p0 = 0, p1 = 0;
#pragma unroll
                for (int s = 0; s < 8; ++s) {
                    const unsigned long long m0 = __ballot(s0 == s), m1 = __ballot(s1 == s);
                    const int c0 = __popcll(m0), c1 = __popcll(m1);
                    if (s0 == s) p0 = base + __popcll(m0 & lt);
                    if (s1 == s) p1 = base + c0 + __popcll(m1 & lt);
                    base += c0 + c1;
                }
                exs[t * 128 + p0] = e0; gws[t * 128 + p0] = g0; exs[t * 128 + p1] = e1v; gws[t * 128 + p1] = g1;
            }
        }
        WAVE_LDS_SYNC();
#pragma unroll
        for (int i = 0; i < 2; ++i) {
            ((uint4*)(SEX + (size_t)n0 * 128))[lane + 64 * i] = ((const uint4*)exs)[lane + 64 * i];
            ((uint4*)(SGW + (size_t)n0 * 128))[lane + 64 * i] = ((const uint4*)gws)[lane + 64 * i];
        }
        } else {
        WAVE_LDS_SYNC();
#pragma unroll
        for (int i = 0; i < 2; ++i) {
            ((uint4*)exs)[lane + 64 * i] = ((const uint4*)(SEX + (size_t)n0 * 128))[lane + 64 * i];
            ((uint4*)gws)[lane + 64 * i] = ((const uint4*)(SGW + (size_t)n0 * 128))[lane + 64 * i];
        }
        }
        if (PART == 1) {
        WAVE_LDS_SYNC();
        {
            int xq[16];
            {
                const uint4* xr = (const uint4*)(H1B + (size_t)(n0 + gq) * DM + 16 * l16);
                uint4 xa0 = xr[0], xb0 = xr[1], xa1 = xr[32], xb1 = xr[33], xa2 = xr[64], xb2 = xr[65], xa3 = xr[96], xb3 = xr[97];
#define BLO(u_) __uint_as_float((u_) << 16)
#define BHI(u_) __uint_as_float((u_) & 0xffff0000u)
#define AMX4(v_) fmaxf(fmaxf(fmaxf(fabsf(BLO((v_).x)), fabsf(BHI((v_).x))), fmaxf(fabsf(BLO((v_).y)), fabsf(BHI((v_).y)))),                  \
                       fmaxf(fmaxf(fabsf(BLO((v_).z)), fabsf(BHI((v_).z))), fmaxf(fabsf(BLO((v_).w)), fabsf(BHI((v_).w)))))
                float mx = fmaxf(fmaxf(fmaxf(AMX4(xa0), AMX4(xb0)), fmaxf(AMX4(xa1), AMX4(xb1))), fmaxf(fmaxf(AMX4(xa2), AMX4(xb2)), fmaxf(AMX4(xa3), AMX4(xb3))));
                mx = row16_max(mx);
                const float xs = (mx > 0.f) ? mx * (1.f / 127.f) : 1.f;
                const float inv = 1.f / xs;
                xsc[gq] = xs;
#define Q8(i_, va_, vb_) { xq[4 * (i_) + 0] = (int)pack4i8(BLO((va_).x) * inv, BHI((va_).x) * inv, BLO((va_).y) * inv, BHI((va_).y) * inv);   \
                           xq[4 * (i_) + 1] = (int)pack4i8(BLO((va_).z) * inv, BHI((va_).z) * inv, BLO((va_).w) * inv, BHI((va_).w) * inv);   \
                           xq[4 * (i_) + 2] = (int)pack4i8(BLO((vb_).x) * inv, BHI((vb_).x) * inv, BLO((vb_).y) * inv, BHI((vb_).y) * inv);   \
                           xq[4 * (i_) + 3] = (int)pack4i8(BLO((vb_).z) * inv, BHI((vb_).z) * inv, BLO((vb_).w) * inv, BHI((vb_).w) * inv); }
                Q8(0, xa0, xb0) Q8(1, xa1, xb1) Q8(2, xa2, xb2) Q8(3, xa3, xb3)
#undef Q8
#undef AMX4
#undef BLO
#undef BHI
            }
            uint4 ra0, ra1, ra2, ra3, rb0, rb1, rb2, rb3, rc0, rc1, rc2, rc3, rd0, rd1, rd2, rd3;
#define ULOAD(S, kk) { const int e_ = exs[gq * 128 + (kk)]; const uint4* ur_ = (const uint4*)(U8 + (size_t)e_ * DM + 16 * l16);          \
                       S##0 = ur_[0]; S##1 = ur_[16]; S##2 = ur_[32]; S##3 = ur_[48]; }
#define D4(W_, B_) { sA = __builtin_amdgcn_sdot4((int)(W_).x, xq[(B_)], sA, false); sB = __builtin_amdgcn_sdot4((int)(W_).y, xq[(B_) + 1], sB, false); \
                     sA = __builtin_amdgcn_sdot4((int)(W_).z, xq[(B_) + 2], sA, false); sB = __builtin_amdgcn_sdot4((int)(W_).w, xq[(B_) + 3], sB, false); }
#define UCOMP(S, kk) { int sA = 0, sB = 0; D4(S##0, 0) D4(S##1, 4) D4(S##2, 8) D4(S##3, 12)                                               \
                       hraw[gq * 128 + (kk)] = row16_sum((float)(sA + sB)); }
            ULOAD(ra, 0) ULOAD(rb, 1) ULOAD(rc, 2)
#pragma unroll 1
            for (int k = 0; k < 128; k += 4) {
                const int kn = (k + 4 < 128) ? k + 4 : 124;
                ULOAD(rd, k + 3)  UCOMP(ra, k)
                ULOAD(ra, kn)     UCOMP(rb, k + 1)
                ULOAD(rb, kn + 1) UCOMP(rc, k + 2)
                ULOAD(rc, kn + 2) UCOMP(rd, k + 3)
            }
#undef D4
#undef ULOAD
#undef UCOMP
        }
        WAVE_LDS_SYNC();
#pragma unroll
        for (int j = 0; j < 8; ++j) {
            const int idx = lane + 64 * j;
            const int e = exs[idx];
            gws[idx] = gws[idx] * gelu_tanh_fast(hraw[idx] * (xsc[idx >> 7] * USC[e])) * VSC[e];
        }
        WAVE_LDS_SYNC();
#pragma unroll
        for (int i = 0; i < 2; ++i) ((uint4*)(SGW + (size_t)n0 * 128))[lane + 64 * i] = ((const uint4*)gws)[lane + 64 * i];
        }
        if (PART == 2) {
        WAVE_LDS_SYNC();
        {
            f32x2 acc[32];
#pragma unroll
            for (int q = 0; q < 32; ++q) acc[q] = (f32x2){0.f, 0.f};
            uint4 ra0, ra1, ra2, ra3, rb0, rb1, rb2, rb3, rc0, rc1, rc2, rc3, rd0, rd1, rd2, rd3;
#define VLOAD(S, kk) { const int e_ = exs[gq * 128 + (kk)]; const uint4* vr_ = (const uint4*)(V8 + (size_t)e_ * DM + 16 * l16);          \
                       S##0 = vr_[0]; S##1 = vr_[16]; S##2 = vr_[32]; S##3 = vr_[48]; }
#define A4(W_, B_) { acc[(B_)] = __builtin_elementwise_fma(__builtin_amdgcn_cvt_pk_f32_fp8((int)(W_), false), wk2, acc[(B_)]);          \
                     acc[(B_) + 1] = __builtin_elementwise_fma(__builtin_amdgcn_cvt_pk_f32_fp8((int)(W_), true), wk2, acc[(B_) + 1]); }
#define VCOMP(S, kk) { const float wk = gws[gq * 128 + (kk)]; const f32x2 wk2 = (f32x2){wk, wk};                                         \
                       A4((S##0).x, 0) A4((S##0).y, 2) A4((S##0).z, 4) A4((S##0).w, 6) A4((S##1).x, 8) A4((S##1).y, 10) A4((S##1).z, 12) A4((S##1).w, 14) \
                       A4((S##2).x, 16) A4((S##2).y, 18) A4((S##2).z, 20) A4((S##2).w, 22) A4((S##3).x, 24) A4((S##3).y, 26) A4((S##3).z, 28) A4((S##3).w, 30) }
            VLOAD(ra, 0) VLOAD(rb, 1) VLOAD(rc, 2)
#pragma unroll 1
            for (int k = 0; k < 128; k += 4) {
                const int kn = (k + 4 < 128) ? k + 4 : 124;
                VLOAD(rd, k + 3)  VCOMP(ra, k)
                VLOAD(ra, kn)     VCOMP(rb, k + 1)
                VLOAD(rb, kn + 1) VCOMP(rc, k + 2)
                VLOAD(rc, kn + 2) VCOMP(rd, k + 3)
            }
#undef VLOAD
#undef VCOMP
#undef A4
            float* orow = p.out + (size_t)(n0 + gq) * DM + 16 * l16;
            float sum = 0.f;
#pragma unroll
            for (int c = 0; c < 4; ++c)
#pragma unroll
                for (int hq = 0; hq < 4; ++hq) {
                    const uint2 hb_ = *(const uint2*)(H1B + (size_t)(n0 + gq) * DM + 16 * l16 + 256 * c + 4 * hq);
                    const float4 h = make_float4(__uint_as_float(hb_.x << 16), __uint_as_float(hb_.x & 0xffff0000u),
                                                 __uint_as_float(hb_.y << 16), __uint_as_float(hb_.y & 0xffff0000u));
                    f32x2& pa = acc[8 * c + 2 * hq]; f32x2& pb = acc[8 * c + 2 * hq + 1];
                    pa[0] = ALPHA * h.x + pa[0]; pa[1] = ALPHA * h.y + pa[1]; pb[0] = ALPHA * h.z + pb[0]; pb[1] = ALPHA * h.w + pb[1];
                    sum += (pa[0] + pa[1]) + (pb[0] + pb[1]);
                }
            const float mu = row16_sum(sum) * (1.f / 1024.f);
            float sq = 0.f;
#pragma unroll
            for (int q = 0; q < 32; ++q) { acc[q][0] -= mu; acc[q][1] -= mu; sq += acc[q][0] * acc[q][0] + acc[q][1] * acc[q][1]; }
            const float rs = rsqrtf(row16_sum(sq) * (1.f / 1024.f) + LN_EPS);
            const float* g = p.in[22] + 16 * l16;
            const float* bb = p.in[23] + 16 * l16;
#pragma unroll
            for (int c = 0; c < 4; ++c)
#pragma unroll
                for (int hq = 0; hq < 4; ++hq) {
                    const float4 gg = *(const float4*)(g + 256 * c + 4 * hq), b4 = *(const float4*)(bb + 256 * c + 4 * hq);
                    const f32x2 pa = acc[8 * c + 2 * hq], pb = acc[8 * c + 2 * hq + 1];
                    float4 o;
                    o.x = pa[0] * rs * gg.x + b4.x; o.y = pa[1] * rs * gg.y + b4.y;
                    o.z = pb[0] * rs * gg.z + b4.z; o.w = pb[1] * rs * gg.w + b4.w;
                    *(float4*)(orow + 256 * c + 4 * hq) = o;
                }
        }
        }
    }
}

#define XB_TMO      128
#define XB_XCNT(j)  (256  + 64 * (j))
#define XB_XSUB(j)  (1280 + 64 * (j))
#define XB_XGEN(j)  (2304 + 64 * (j))
#define XB_TOP      3328
#define XB_TOPGEN   3392
#define XCD_BAR_WORDS 3456
#define XB_SPIN_CAP (1u << 22)
__device__ __forceinline__ unsigned xb_ld(unsigned* p) { return __hip_atomic_load(p, __ATOMIC_RELAXED, __HIP_MEMORY_SCOPE_AGENT); }
__device__ __forceinline__ unsigned xb_add(unsigned* p, unsigned v) { return __hip_atomic_fetch_add(p, v, __ATOMIC_RELAXED, __HIP_MEMORY_SCOPE_AGENT); }
__device__ __forceinline__ unsigned xb_xcc_id() { return (unsigned)__builtin_amdgcn_s_getreg((3 << 11) | 20) & 0xFu; }
#define XB_SPIN(cond, bar) do { unsigned _sp = 0; while (cond) { __builtin_amdgcn_s_sleep(1); \
    if ((++_sp & 255u) == 0u) { if (xb_ld(&(bar)[XB_TMO])) break; if (_sp > XB_SPIN_CAP) { atomicAdd(&(bar)[XB_TMO], 1u); break; } } } } while (0)
struct XcdBarrier { unsigned* bar; unsigned x; unsigned* st; };
__device__ __forceinline__ XcdBarrier xcd_barrier_post(unsigned* bar, unsigned* st) {
    XcdBarrier b; b.bar = bar; b.x = xb_xcc_id(); b.st = st;
    if (threadIdx.x == 0) (void)xb_add(&bar[XB_XCNT(b.x)], 1u);
    return b;
}
__device__ __forceinline__ void xcd_barrier_complete(unsigned* bar, unsigned x, unsigned& nloc, unsigned& nx) {
    const unsigned G = gridDim.x * gridDim.y * gridDim.z;
    unsigned sum, cnt, mine, sp = 0u;
    for (;;) {
        sum = 0u; cnt = 0u; mine = 0u;
#pragma unroll
        for (unsigned j = 0; j < 16; ++j) { const unsigned c = xb_ld(&bar[XB_XCNT(j)]); sum += c; cnt += (c > 0u) ? 1u : 0u; mine = (j == x) ? c : mine; }
        if (sum == G) break;
        __builtin_amdgcn_s_sleep(1);
        if ((++sp & 255u) == 0u) { if (xb_ld(&bar[XB_TMO])) break; if (sp > XB_SPIN_CAP) { atomicAdd(&bar[XB_TMO], 1u); break; } }
    }
    nloc = mine > 0u ? mine : 1u; nx = cnt > 0u ? cnt : 1u;
}
__device__ __forceinline__ void xcd_barrier(const XcdBarrier& b) {
    asm volatile("s_waitcnt vmcnt(0)" ::: "memory");
    __syncthreads();
    if (threadIdx.x == 0) {
        unsigned* bar = b.bar;
        __builtin_amdgcn_s_waitcnt(0);
        unsigned nloc = xb_ld(&b.st[0]), nx = xb_ld(&b.st[1]);
        if (nloc == 0u) { xcd_barrier_complete(bar, b.x, nloc, nx); __hip_atomic_store(&b.st[0], nloc, __ATOMIC_RELAXED, __HIP_MEMORY_SCOPE_AGENT); __hip_atomic_store(&b.st[1], nx, __ATOMIC_RELAXED, __HIP_MEMORY_SCOPE_AGENT); }
        const unsigned old = xb_add(&bar[XB_XSUB(b.x)], 1u);
        const unsigned gen = old / nloc;
        if (old + 1u == (gen + 1u) * nloc) {
            __builtin_amdgcn_fence(__ATOMIC_RELEASE, "agent");
            asm volatile("s_waitcnt vmcnt(0)" ::: "memory");
            const unsigned og = xb_add(&bar[XB_TOP], 1u);
            const unsigned tg = og / nx;
            if (og + 1u == (tg + 1u) * nx) xb_add(&bar[XB_TOPGEN], 1u);
            else XB_SPIN(xb_ld(&bar[XB_TOPGEN]) == tg, bar);
            __builtin_amdgcn_fence(__ATOMIC_ACQUIRE, "agent");
            xb_add(&bar[XB_XGEN(b.x)], 1u);
            asm volatile("s_waitcnt vmcnt(0)" ::: "memory");
        } else {
            XB_SPIN(xb_ld(&bar[XB_XGEN(b.x)]) == gen, bar);
            __builtin_amdgcn_fence(__ATOMIC_ACQUIRE, "agent");
            asm volatile("s_waitcnt vmcnt(0)" ::: "memory");
        }
    }
    __syncthreads();
}

__global__ void __launch_bounds__(256, 2) mega(Params p) {
    cg::grid_group grid = cg::this_grid();
    __shared__ __attribute__((aligned(16))) unsigned char smem[81920];
    float* sm = (float*)smem;
    unsigned* barw = (unsigned*)(p.ws + OFF_BAR);
    const XcdBarrier xbar = xcd_barrier_post(barw, barw + XCD_BAR_WORDS + 2 * blockIdx.x);
    bf16_t* XB = (bf16_t*)(p.ws + OFF_XB);
    bf16_t* WinT = (bf16_t*)(p.ws + OFF_WINT);
    bf16_t* WoutT = (bf16_t*)(p.ws + OFF_WOUTT);
    bf16_t* WqT = (bf16_t*)(p.ws + OFF_WQT);
    cvt_rows_bf16(p.in[0], XB, (size_t)NTOK * DM / 8);
    transpose_bf16(p.in[1], DIN, 3456, WinT);
    transpose_bf16(p.in[2], DM, DM, WoutT);
    fold_ws_phase(p.in[17], p.in[18], p.in[19], WqT);
    transpose_bf16(p.in[6], 256, 256, (bf16_t*)(p.ws + OFF_W1T), 2048);
    transpose_bf16(p.in[11], 256, 256, (bf16_t*)(p.ws + OFF_W1T) + 256 * 2048, 2048);
    if (blockIdx.x == 0) {
        for (int c = threadIdx.x; c < 512; c += 256)
            ((float*)(p.ws + OFF_LBV))[c] = 1.f / (1.f + expf(p.in[3][512 + c] - p.in[3][c]));
        if (threadIdx.x < 16) ((float*)(p.ws + OFF_DIAG))[threadIdx.x] = 0.f;
    }
    if (blockIdx.x >= 8 && blockIdx.x < 72) cmp_peb_partial(p, blockIdx.x - 8);
    grid.sync();
    if (blockIdx.x == gridDim.x - 1) cmp_peb_reduce(p);
    gemm_bf16_phase3(XB, DM, WinT, DM, NTOK / 256, 27, smem, EpiProj{p.ws});
    xcd_barrier(xbar);
    for (int it = blockIdx.x; it < 128; it += gridDim.x) {
        const int which = it >> 6, t = it & 63;
        gemm_tile(ALoadCmp{(const bf16_t*)(p.ws + OFF_KV + (size_t)which * KV_STRIDE)},
                  (const bf16_t*)(p.ws + OFF_W1T) + (size_t)which * 256 * 2048, 2048, 32, (t >> 1) * 128, (t & 1) * 128, smem,
                  EpiCmpH{(bf16_t*)(p.ws + OFF_HB) + (size_t)which * 4096 * 256, (const float*)(p.ws + OFF_PEB) + which * 256});
    }
    if (gridDim.x >= 256) {
        if (blockIdx.x >= 128)
            for (int it = blockIdx.x - 128; it < 2048; it += gridDim.x - 128) hgrn_passA(p, it, smem);
    } else {
        for (int it = blockIdx.x; it < 2048; it += gridDim.x) hgrn_passA(p, it, smem);
    }
#if NSA_DIAG
    for (int it = blockIdx.x; it < 2 * 4 * NCB * 2; it += gridDim.x) compress_item(p, it, sm);
#endif
    xcd_barrier(xbar);
    if (blockIdx.x < 256) hgrn_scan_item(p, blockIdx.x);
    else {
        cvt_rows_i8(p.in[20], p.ws + OFF_UB, (float*)(p.ws + OFF_USC), 16384, 256, gridDim.x - 256);
        cvt_rows_fp8(p.in[21], p.ws + OFF_VB, (float*)(p.ws + OFF_VSC), 16384, 256, gridDim.x - 256);
    }
    if (gridDim.x <= 256) {
        cvt_rows_i8(p.in[20], p.ws + OFF_UB, (float*)(p.ws + OFF_USC), 16384, 0, gridDim.x);
        cvt_rows_fp8(p.in[21], p.ws + OFF_VB, (float*)(p.ws + OFF_VSC), 16384, 0, gridDim.x);
    }
    cmp_layer2_phase(p, 0, gridDim.x);
    xcd_barrier(xbar);
    {
        const int qi = blockIdx.x & 7;
        unsigned* qctr = barw + XCD_BAR_WORDS + 2 * 1024 + 64 * qi;
        for (;;) {
            __syncthreads();
            if (threadIdx.x == 0) *(volatile unsigned*)smem = atomicAdd(qctr, 1u);
            __syncthreads();
            const int it = (int)__builtin_amdgcn_readfirstlane(*(volatile unsigned*)smem);
            if (it >= 256) break;
            nsa_tile(p, (it << 3) | qi, smem);
        }
        for (;;) {
            __syncthreads();
            if (threadIdx.x == 0) *(volatile unsigned*)smem = atomicAdd(qctr + 32, 1u);
            __syncthreads();
            const int it = (int)__builtin_amdgcn_readfirstlane(*(volatile unsigned*)smem);
            if (it >= 256) break;
            hgrn_passC(p, (it << 3) | qi, smem);
        }
    }
    xcd_barrier(xbar);
#if NSA_DIAG
    for (int it = blockIdx.x; it < 4 * 2 * SEQ; it += gridDim.x) nsa_item(p, it, sm);
    grid.sync();
    {
        const float* DG = (const float*)(p.ws + OFF_DIAG);
#if NSA_DIAG == 1
        const float cval = -log10f(sqrtf(DG[0] / DG[1]) + 1e-9f);
#else
        const float cval = -log10f(DG[2] / DG[3] + 1e-6f);
#endif
        for (size_t i = (size_t)blockIdx.x * 256 + threadIdx.x; i < (size_t)NTOK * DM; i += (size_t)gridDim.x * 256) p.out[i] = cval;
        return;
    }
#endif
    gemm_bf16_phase3(XB, DM, WoutT, DM, NTOK / 256, 8, smem, EpiMix{(bf16_t*)p.out});
    xcd_barrier(xbar);
    ln1_phase(p, sm);
    xcd_barrier(xbar);
    gemm_bf16_phase3(XB, DM, WqT, DM, NTOK / 256, 16, smem, EpiTop16{(float*)(p.ws + OFF_TOPK), smem});
    xcd_barrier(xbar);
    peer_fast_phase<0>(p, smem);
    peer_fast_phase<1>(p, smem);
    peer_fast_phase<2>(p, smem);
}

extern "C" void kernel_launch(void* const* d_in, const int* in_sizes, int n_in, void* d_out, int out_size,
                              void* d_ws, size_t ws_size, hipStream_t stream) {
    static int grid_blocks = 0;
    if (!grid_blocks) {
        int dev = 0, cus = 0, per_cu = 0;
        hipGetDevice(&dev);
        hipDeviceGetAttribute(&cus, hipDeviceAttributeMultiprocessorCount, dev);
        hipOccupancyMaxActiveBlocksPerMultiprocessor(&per_cu, mega, 256, 0);
        if (per_cu > 4) per_cu = 4;
        if (per_cu < 1) per_cu = 1;
        grid_blocks = cus * per_cu;
        if (n_in != 24 || ws_size < WS_NEED || out_size != NTOK * DM)
            fprintf(stderr, "kernel_launch: unexpected sizes n_in=%d ws=%zu out=%d\n", n_in, ws_size, out_size);
    }
    Params p;
    memset(&p, 0, sizeof(p));
    for (int i = 0; i < 24; ++i) p.in[i] = (const float*)d_in[i];
    p.out = (float*)d_out;
    p.ws = (unsigned char*)d_ws;
    hipMemsetAsync((char*)d_ws + OFF_BAR, 0, BAR_BYTES, stream);
    void* args[] = {&p};
    hipError_t e = hipLaunchCooperativeKernel((void*)mega, dim3(grid_blocks), dim3(256), args, 0, stream);
    if (e != hipSuccess) fprintf(stderr, "cooperative launch failed: %s (grid %d)\n", hipGetErrorString(e), grid_blocks);
}
```

```cpp
#include <hip/hip_runtime.h>
#include <hip/hip_cooperative_groups.h>
#include <cstdio>
#include <cstring>
namespace cg = cooperative_groups;

#define NTOK 32768
#define SEQ 8192
#define DM 1024
#define DIN 3352
#define NCB 511
#define ALPHA 1.189207115002721f
#define LN_EPS 1e-5f

#define MB_ 1048576ull
#define OFF_XB 0ull
#define OFF_HQ (64 * MB_)
#define OFF_HLF (96 * MB_)
#define OFF_HI (160 * MB_)
#define OFF_HG (192 * MB_)
#define OFF_NQ (224 * MB_)
#define OFF_KV (256 * MB_)
#define KV_STRIDE (8 * MB_)
#define OFF_NGATE (304 * MB_)
#define OFF_CMPK (308 * MB_)
#define OFF_CMPV (309 * MB_)
#define OFF_WINT (310 * MB_)
#define OFF_WOUTT (317 * MB_)
#define OFF_WQT (319 * MB_)
#define OFF_LBV (323 * MB_)
#define OFF_DC (324 * MB_)
#define OFF_SC (325 * MB_)
#define OFF_UB (389 * MB_)
#define OFF_VB (421 * MB_)
#define OFF_TOPK (453 * MB_)
#define OFF_HREF OFF_TOPK
#define OFF_W1T (485 * MB_)
#define OFF_HB (487 * MB_)
#define OFF_CMPKB (491 * MB_)
#define OFF_CMPVB (491 * MB_ + 524288ull)
#define OFF_PEB (492 * MB_)
#define OFF_SELM (493 * MB_)
#define OFF_DIAG (494 * MB_)
#define OFF_USC (494 * MB_ + 131072ull)
#define OFF_VSC (494 * MB_ + 196608ull)
#define OFF_BAR (494 * MB_ + 65536ull)
#define BAR_BYTES 32768
#define WS_NEED (495 * MB_)
#define USE_NSA_MFMA 1
#define NSA_DIAG 0

struct Params {
    const float* in[24];
    float* out;
    unsigned char* ws;
};

typedef float f32x16 __attribute__((ext_vector_type(16)));
#define WAVE_LDS_SYNC() asm volatile("s_waitcnt lgkmcnt(0)" ::: "memory")
#define LAS3 __attribute__((address_space(3)))

__device__ __forceinline__ int opaque_tid() { int t = threadIdx.x; asm volatile("" : "+v"(t)); return t; }
__device__ __forceinline__ float wave_sum(float v) {
#pragma unroll
    for (int o = 32; o; o >>= 1) v += __shfl_xor(v, o);
    return v;
}
__device__ __forceinline__ float wave_max(float v) {
#pragma unroll
    for (int o = 32; o; o >>= 1) v = fmaxf(v, __shfl_xor(v, o));
    return v;
}
__device__ __forceinline__ float sigmoidf_(float x) { return 1.f / (1.f + expf(-x)); }
__device__ __forceinline__ float exp_fast(float x) { return __builtin_amdgcn_exp2f(1.4426950408889634f * x); }
__device__ __forceinline__ float sigmoid_fast(float x) { return __builtin_amdgcn_rcpf(1.f + __builtin_amdgcn_exp2f(-1.4426950408889634f * x)); }
__device__ __forceinline__ float log_fast(float x) { return 0.6931471805599453f * __builtin_amdgcn_logf(x); }
__device__ __forceinline__ float gelu_tanh_fast(float x) {
    const float u = 0.7978845608028654f * (x + 0.044715f * x * x * x);
    return x * __builtin_amdgcn_rcpf(1.f + __builtin_amdgcn_exp2f(-2.885390081777927f * u));
}
__device__ __forceinline__ float gelu_tanh(float x) {
    const float c = 0.7978845608028654f;
    return 0.5f * x * (1.f + tanhf(c * (x + 0.044715f * x * x * x)));
}

typedef short bf16x8 __attribute__((ext_vector_type(8)));
typedef float f32x4 __attribute__((ext_vector_type(4)));
typedef unsigned short bf16_t;

typedef __bf16 bf16x2_t __attribute__((ext_vector_type(2)));
__device__ __forceinline__ unsigned pack2bf(float lo, float hi) {
    bf16x2_t v; v[0] = (__bf16)lo; v[1] = (__bf16)hi;
    return __builtin_bit_cast(unsigned, v);
}
__device__ __forceinline__ unsigned f2bf(float f) { return pack2bf(f, 0.f) & 0xffffu; }
__device__ __forceinline__ float bf2f(unsigned h) { return __uint_as_float(h << 16); }

__device__ __forceinline__ void cvt_rows_bf16(const float* __restrict__ src, bf16_t* __restrict__ dst, size_t n8) {
    for (size_t i = (size_t)blockIdx.x * 256 + threadIdx.x; i < n8; i += (size_t)gridDim.x * 256) {
        const float4 a = ((const float4*)src)[2 * i], b = ((const float4*)src)[2 * i + 1];
        uint4 o;
        o.x = pack2bf(a.x, a.y); o.y = pack2bf(a.z, a.w); o.z = pack2bf(b.x, b.y); o.w = pack2bf(b.z, b.w);
        ((uint4*)dst)[i] = o;
    }
}
__device__ __forceinline__ void transpose_bf16(const float* __restrict__ src, int Nsrc, int Npad, bf16_t* __restrict__ dst, int K = 1024) {
    const size_t total = (size_t)Npad * (K / 8);
    for (size_t i = (size_t)blockIdx.x * 256 + threadIdx.x; i < total; i += (size_t)gridDim.x * 256) {
        const int n = (int)(i % Npad), kg = (int)(i / Npad);
        float v[8];
#pragma unroll
        for (int j = 0; j < 8; ++j) v[j] = (n < Nsrc) ? src[(size_t)(kg * 8 + j) * Nsrc + n] : 0.f;
        uint4 o;
        o.x = pack2bf(v[0], v[1]); o.y = pack2bf(v[2], v[3]); o.z = pack2bf(v[4], v[5]); o.w = pack2bf(v[6], v[7]);
        *(uint4*)(dst + (size_t)n * K + kg * 8) = o;
    }
}

struct ALoadStd {
    const bf16_t* A; int lda;
    __device__ __forceinline__ const bf16_t* ptr(int row, int ks) const { return A + (size_t)row * lda + ks * 64; }
};
struct ALoadCmp {
    const bf16_t* KC;
    __device__ __forceinline__ const bf16_t* ptr(int row, int ks) const {
        const int r = row < 4088 ? row : 4087;
        const int g = r & 1, bn = r >> 1, n = bn % NCB, b = bn / NCB;
        return KC + ((size_t)(b * SEQ + 16 * n + ks) * 128 + g * 64);
    }
};
#define GLDS1(i, ks, buf) { const int row_ = 8 * w + 32 * (i) + (lane >> 3);                                                    \
        __builtin_amdgcn_global_load_lds((const unsigned*)(aload.ptr(m0 + row_, (ks)) + (((lane & 7) ^ (lane >> 3)) << 3)),      \
                                         (LAS3 unsigned*)(lds + (buf) * 32768 + w * 1024 + (i) * 4096), 16, 0, 0);              \
        __builtin_amdgcn_global_load_lds((const unsigned*)(Bp + (size_t)row_ * ldb + (ks) * 64 + (((lane & 7) ^ (lane >> 3)) << 3)), \
                                         (LAS3 unsigned*)(lds + (buf) * 32768 + 16384 + w * 1024 + (i) * 4096), 16, 0, 0); }
#define GEMM_GLDS(ks, buf) { GLDS1(0, ks, buf) GLDS1(1, ks, buf) GLDS1(2, ks, buf) GLDS1(3, ks, buf) }
template <class ALoad, class Epi>
__device__ __forceinline__ void gemm_tile(const ALoad aload, const bf16_t* __restrict__ Bt, int ldb, int KS, int m0, int n0,
                                          unsigned char* lds, Epi epi) {
    const int tid = opaque_tid(), lane = tid & 63, w = __builtin_amdgcn_readfirstlane(tid >> 6), wm = w >> 1, wn = w & 1;
    f32x4 acc[4][4];
#pragma unroll
    for (int j = 0; j < 4; ++j)
#pragma unroll
        for (int i = 0; i < 4; ++i) acc[j][i] = (f32x4){0.f, 0.f, 0.f, 0.f};
    const bf16_t* Bp = Bt + (size_t)n0 * ldb;
    __syncthreads();
    GEMM_GLDS(0, 0)
    asm volatile("s_waitcnt vmcnt(0)" ::: "memory");
    __syncthreads();
    for (int ks = 0; ks < KS; ++ks) {
        if (ks + 1 < KS) GEMM_GLDS(ks + 1, (ks + 1) & 1)
        const unsigned char* la = lds + (ks & 1) * 32768;
        const unsigned char* lb = la + 16384;
#pragma unroll
        for (int s = 0; s < 2; ++s) {
            bf16x8 af[4], wf[4];
            const int ch = s * 4 + (lane >> 4);
#pragma unroll
            for (int i = 0; i < 4; ++i) {
                const int row = wm * 64 + i * 16 + (lane & 15);
                af[i] = *(const bf16x8*)(la + row * 128 + ((ch ^ (row & 7)) << 4));
            }
#pragma unroll
            for (int j = 0; j < 4; ++j) {
                const int row = wn * 64 + j * 16 + (lane & 15);
                wf[j] = *(const bf16x8*)(lb + row * 128 + ((ch ^ (row & 7)) << 4));
            }
#pragma unroll
            for (int j = 0; j < 4; ++j)
#pragma unroll
                for (int i = 0; i < 4; ++i)
                    acc[j][i] = __builtin_amdgcn_mfma_f32_16x16x32_bf16(wf[j], af[i], acc[j][i], 0, 0, 0);
        }
        asm volatile("s_waitcnt vmcnt(0)" ::: "memory");
        __syncthreads();
    }
#pragma unroll
    for (int j = 0; j < 4; ++j)
#pragma unroll
        for (int i = 0; i < 4; ++i)
            epi(m0 + wm * 64 + i * 16 + (lane & 15), n0 + wn * 64 + j * 16 + (lane >> 4) * 4, acc[j][i]);
    epi.finish(m0, n0);
}
template <class Epi>
__device__ __forceinline__ void gemm_bf16_phase(const bf16_t* __restrict__ A, int lda, const bf16_t* __restrict__ Bt, int ldb,
                                                int Mtiles, int Ntiles, unsigned char* lds, Epi epi) {
    if ((gridDim.x & 7) == 0 && (Mtiles & 31) == 0) {
        const int x = blockIdx.x & 7, j = blockIdx.x >> 3, nb = gridDim.x >> 3;
        const int per = (Mtiles >> 3) * Ntiles;
        for (int q = j; q < per; q += nb) {
            const int s = q / (4 * Ntiles), rem = q - s * (4 * Ntiles);
            const int c = rem >> 2, r = rem & 3;
            const int mt = x + 8 * (4 * s + r);
            gemm_tile(ALoadStd{A, lda}, Bt, ldb, 16, mt * 128, c * 128, lds, epi);
        }
    } else {
        for (int tile = blockIdx.x; tile < Mtiles * Ntiles; tile += gridDim.x) {
            const int mt = tile / Ntiles, nt = tile % Ntiles;
            gemm_tile(ALoadStd{A, lda}, Bt, ldb, 16, mt * 128, nt * 128, lds, epi);
        }
    }
}


#define G3_STAGE 24576
#define G3A(i, ks, st) __builtin_amdgcn_global_load_lds((const unsigned*)(pa + (size_t)(64 * (i)) * lda + (ks) * 32),                     \
                                                        (LAS3 unsigned*)(lds + (st) + (w + 4 * (i)) * 1024), 16, 0, 0);
#define G3B(i, ks, st) __builtin_amdgcn_global_load_lds((const unsigned*)(pb + (size_t)(64 * (i)) * ldb + (ks) * 32),                     \
                                                        (LAS3 unsigned*)(lds + (st) + 16384 + (w + 4 * (i)) * 1024), 16, 0, 0);
#define G3MF(j, i) acc[j][i] = __builtin_amdgcn_mfma_f32_16x16x32_bf16(wf[j], af[i], acc[j][i], 0, 0, 0);
#define G3MF4(j, i) G3MF(j, i) G3MF(j, (i) + 1) G3MF(j, (i) + 2) G3MF(j, (i) + 3)
#define G3SB __builtin_amdgcn_sched_barrier(0);
#define G3_BODY(LOADS, KS) {                                                                                                              \
        const unsigned char* la = lds + st0 + wm * 8192 + fofs;                                                                           \
        const unsigned char* lb = lds + st0 + 16384 + wn * 4096 + fofs;                                                                   \
        bf16x8 af[8], wf[4];                                                                                                              \
        wf[0] = *(const bf16x8*)(lb);                                                                                                     \
        af[0] = *(const bf16x8*)(la);            af[1] = *(const bf16x8*)(la + 1024); af[2] = *(const bf16x8*)(la + 2048);                \
        af[3] = *(const bf16x8*)(la + 3072);     af[4] = *(const bf16x8*)(la + 4096); af[5] = *(const bf16x8*)(la + 5120);                \
        af[6] = *(const bf16x8*)(la + 6144);     af[7] = *(const bf16x8*)(la + 7168);                                                     \
        wf[1] = *(const bf16x8*)(lb + 1024);     wf[2] = *(const bf16x8*)(lb + 2048); wf[3] = *(const bf16x8*)(lb + 3072);                \
        G3SB                                                                                                                              \
        G3MF4(0, 0) if (LOADS) { G3A(0, (KS) + 2, st2) } G3SB                                                                             \
        G3MF4(0, 4) if (LOADS) { G3A(1, (KS) + 2, st2) } G3SB                                                                             \
        G3MF4(1, 0) if (LOADS) { G3A(2, (KS) + 2, st2) } G3SB                                                                             \
        G3MF4(1, 4) if (LOADS) { G3A(3, (KS) + 2, st2) } G3SB                                                                             \
        G3MF4(2, 0) if (LOADS) { G3B(0, (KS) + 2, st2) } G3SB                                                                             \
        G3MF4(2, 4) if (LOADS) { G3B(1, (KS) + 2, st2) } G3SB                                                                             \
        G3MF4(3, 0) G3MF4(3, 4) }
template <class Epi>
__device__ __forceinline__ void gemm_tile3(const bf16_t* __restrict__ A, int lda, const bf16_t* __restrict__ Bt, int ldb, int m0, int n0,
                                           unsigned char* lds, Epi epi) {
    const int tid = opaque_tid(), lane = tid & 63, w = __builtin_amdgcn_readfirstlane(tid >> 6), wm = w >> 1, wn = w & 1;
    f32x4 acc[4][8];
#pragma unroll
    for (int j = 0; j < 4; ++j)
#pragma unroll
        for (int i = 0; i < 8; ++i) acc[j][i] = (f32x4){0.f, 0.f, 0.f, 0.f};
    const int r15 = lane & 15, g4 = lane >> 4;
    const int fofs = r15 * 64 + ((g4 ^ ((0 - (r15 >> 2)) & 3)) << 4);
    const int lch = ((lane & 3) ^ ((0 - (lane >> 4)) & 3)) << 3;
    const bf16_t* pa = A + (size_t)(m0 + 16 * w + (lane >> 2)) * lda + lch;
    const bf16_t* pb = Bt + (size_t)(n0 + 16 * w + (lane >> 2)) * ldb + lch;
    __syncthreads();
    G3A(0, 0, 0) G3A(1, 0, 0) G3A(2, 0, 0) G3A(3, 0, 0) G3B(0, 0, 0) G3B(1, 0, 0)
    G3A(0, 1, G3_STAGE) G3A(1, 1, G3_STAGE) G3A(2, 1, G3_STAGE) G3A(3, 1, G3_STAGE) G3B(0, 1, G3_STAGE) G3B(1, 1, G3_STAGE)
    int st0 = 0, st1 = G3_STAGE, st2 = 2 * G3_STAGE;
#pragma unroll 1
    for (int ks = 0; ks < 30; ++ks) {
        asm volatile("s_waitcnt vmcnt(6)" ::: "memory");
        __builtin_amdgcn_s_barrier();
        asm volatile("" ::: "memory");
        G3_BODY(1, ks)
        const int t_ = st0; st0 = st1; st1 = st2; st2 = t_;
    }
    asm volatile("s_waitcnt vmcnt(6)" ::: "memory");
    __builtin_amdgcn_s_barrier();
    asm volatile("" ::: "memory");
    G3_BODY(0, 30)
    st0 = st1;
    asm volatile("s_waitcnt vmcnt(0)" ::: "memory");
    __builtin_amdgcn_s_barrier();
    asm volatile("" ::: "memory");
    G3_BODY(0, 31)
    __syncthreads();
    if constexpr (Epi::kRow) {
        const int mrow = m0 + wm * 128 + r15, ncol = n0 + wn * 64;
        epi.dispatch(n0, [&](auto e) {
            if constexpr (decltype(e)::kBf16) {
#pragma unroll
                for (int i = 0; i < 8; ++i)
#pragma unroll
                    for (int j = 0; j < 4; j += 2) {
                        uint2 a = e.pack4(acc[j][i]), b = e.pack4(acc[j + 1][i]);
                        auto sx = __builtin_amdgcn_permlane16_swap(a.x, b.x, false, false);
                        auto sy = __builtin_amdgcn_permlane16_swap(a.y, b.y, false, false);
                        e.store8(mrow + i * 16, ncol + (j + (g4 & 1)) * 16 + (g4 >> 1) * 8, make_uint4(sx[0], sy[0], sx[1], sy[1]));
                    }
            } else {
#pragma unroll
                for (int i = 0; i < 8; ++i)
#pragma unroll
                    for (int j = 0; j < 4; ++j)
                        e.row4(mrow + i * 16, ncol + j * 16 + g4 * 4, make_float4(acc[j][i][0], acc[j][i][1], acc[j][i][2], acc[j][i][3]));
            }
        });
    } else {
#pragma unroll
        for (int hh = 0; hh < 2; ++hh) {
            if (wm == hh) {
#pragma unroll
                for (int j = 0; j < 4; ++j)
#pragma unroll
                    for (int i = 0; i < 8; ++i)
                        epi(m0 + wm * 128 + i * 16 + (lane & 15), n0 + wn * 64 + j * 16 + (lane >> 4) * 4, acc[j][i]);
            }
            epi.finish(m0 + hh * 128, n0);
        }
    }
}

#define G3PA(PA, i, k, st) __builtin_amdgcn_global_load_lds((const unsigned*)((PA) + (size_t)(64 * (i)) * lda + (k) * 32),                 \
                                                            (LAS3 unsigned*)(lds + (st) + (w + 4 * (i)) * 1024), 16, 0, 0);
#define G3PB(PB, i, k, st) __builtin_amdgcn_global_load_lds((const unsigned*)((PB) + (size_t)(64 * (i)) * ldb + (k) * 32),                 \
                                                            (LAS3 unsigned*)(lds + (st) + 16384 + (w + 4 * (i)) * 1024), 16, 0, 0);
#define G3P_BODY(PA, PB, KIDX) {                                                                                                          \
        const unsigned char* la = lds + st0 + wm * 8192 + fofs;                                                                           \
        const unsigned char* lb = lds + st0 + 16384 + wn * 4096 + fofs;                                                                   \
        bf16x8 af[8], wf[4];                                                                                                              \
        wf[0] = *(const bf16x8*)(lb);                                                                                                     \
        af[0] = *(const bf16x8*)(la);            af[1] = *(const bf16x8*)(la + 1024); af[2] = *(const bf16x8*)(la + 2048);                \
        af[3] = *(const bf16x8*)(la + 3072);     af[4] = *(const bf16x8*)(la + 4096); af[5] = *(const bf16x8*)(la + 5120);                \
        af[6] = *(const bf16x8*)(la + 6144);     af[7] = *(const bf16x8*)(la + 7168);                                                     \
        wf[1] = *(const bf16x8*)(lb + 1024);     wf[2] = *(const bf16x8*)(lb + 2048); wf[3] = *(const bf16x8*)(lb + 3072);                \
        G3SB                                                                                                                              \
        G3MF4(0, 0) G3PA(PA, 0, KIDX, st2) G3SB                                                                                           \
        G3MF4(0, 4) G3PA(PA, 1, KIDX, st2) G3SB                                                                                           \
        G3MF4(1, 0) G3PA(PA, 2, KIDX, st2) G3SB                                                                                           \
        G3MF4(1, 4) G3PA(PA, 3, KIDX, st2) G3SB                                                                                           \
        G3MF4(2, 0) G3PB(PB, 0, KIDX, st2) G3SB                                                                                           \
        G3MF4(2, 4) G3PB(PB, 1, KIDX, st2) G3SB                                                                                           \
        G3MF4(3, 0) G3MF4(3, 4)                                                                                                           \
        { const int t_ = st0; st0 = st1; st1 = st2; st2 = t_; } }
#define G3P_SYNC(N) { asm volatile("s_waitcnt vmcnt(" #N ")" ::: "memory"); __builtin_amdgcn_s_barrier(); asm volatile("" ::: "memory"); }
#define G3P_BAR     { __builtin_amdgcn_s_barrier(); asm volatile("" ::: "memory"); }
template <class Epi>
__device__ __forceinline__ void gemm_phase_pipelined(const bf16_t* __restrict__ A, int lda, const bf16_t* __restrict__ Bt, int ldb,
                                                     int Mtiles  , int Ntiles, unsigned char* lds, Epi epi) {
    const int tid = opaque_tid(), lane = tid & 63, w = __builtin_amdgcn_readfirstlane(tid >> 6), wm = w >> 1, wn = w & 1;
    const int r15 = lane & 15, g4 = lane >> 4;
    const int fofs = r15 * 64 + ((g4 ^ ((0 - (r15 >> 2)) & 3)) << 4);
    const int lch = ((lane & 3) ^ ((0 - (lane >> 4)) & 3)) << 3;
    const int x = blockIdx.x & 7, jb = blockIdx.x >> 3, nb = gridDim.x >> 3;
    const int per = (Mtiles >> 3) * Ntiles;
    int q = jb;
    if (q >= per) return;
    int m0, n0;
#define G3P_TILE(Q, M0, N0) { const int s_ = (Q) / (2 * Ntiles), rem_ = (Q) - s_ * (2 * Ntiles); M0 = (x + 8 * (2 * s_ + (rem_ & 1))) * 256; N0 = (rem_ >> 1) * 128; }
    G3P_TILE(q, m0, n0)
    const bf16_t* pa = A + (size_t)(m0 + 16 * w + (lane >> 2)) * lda + lch;
    const bf16_t* pb = Bt + (size_t)(n0 + 16 * w + (lane >> 2)) * ldb + lch;
    int st0 = 0, st1 = G3_STAGE, st2 = 2 * G3_STAGE;
    __syncthreads();
    G3PA(pa, 0, 0, 0) G3PA(pa, 1, 0, 0) G3PA(pa, 2, 0, 0) G3PA(pa, 3, 0, 0) G3PB(pb, 0, 0, 0) G3PB(pb, 1, 0, 0)
    G3PA(pa, 0, 1, G3_STAGE) G3PA(pa, 1, 1, G3_STAGE) G3PA(pa, 2, 1, G3_STAGE) G3PA(pa, 3, 1, G3_STAGE) G3PB(pb, 0, 1, G3_STAGE) G3PB(pb, 1, 1, G3_STAGE)
    asm volatile("s_waitcnt vmcnt(0)" ::: "memory");
    for (;;) {
        const int qn = (q + nb < per) ? q + nb : q;
        int m0n, n0n;
        G3P_TILE(qn, m0n, n0n)
        const bf16_t* pan = A + (size_t)(m0n + 16 * w + (lane >> 2)) * lda + lch;
        const bf16_t* pbn = Bt + (size_t)(n0n + 16 * w + (lane >> 2)) * ldb + lch;
        f32x4 acc[4][8];
#pragma unroll
        for (int j = 0; j < 4; ++j)
#pragma unroll
            for (int i = 0; i < 8; ++i) acc[j][i] = (f32x4){0.f, 0.f, 0.f, 0.f};
        G3P_BAR      G3P_BODY(pa, pb, 2)
        G3P_BAR      G3P_BODY(pa, pb, 3)
#pragma unroll 1
        for (int ks = 2; ks < 30; ++ks) {
            G3P_SYNC(6)
            G3P_BODY(pa, pb, ks + 2)
        }
        G3P_SYNC(6)  G3P_BODY(pan, pbn, 0)
        G3P_SYNC(6)  G3P_BODY(pan, pbn, 1)
        {
            const int mrow = m0 + wm * 128 + r15, ncol = n0 + wn * 64;
            epi.dispatch(n0, [&](auto e) {
                asm volatile("s_waitcnt vmcnt(0)" ::: "memory");
                if constexpr (decltype(e)::kBf16) {
#pragma unroll
                    for (int i = 0; i < 8; ++i)
#pragma unroll
                        for (int j = 0; j < 4; j += 2) {
                            uint2 a = e.pack4(acc[j][i]), b = e.pack4(acc[j + 1][i]);
                            auto sx = __builtin_amdgcn_permlane16_swap(a.x, b.x, false, false);
                            auto sy = __builtin_amdgcn_permlane16_swap(a.y, b.y, false, false);
                            e.store8(mrow + i * 16, ncol + (j + (g4 & 1)) * 16 + (g4 >> 1) * 8, make_uint4(sx[0], sy[0], sx[1], sy[1]));
                        }
                } else {
#pragma unroll
                    for (int i = 0; i < 8; ++i)
#pragma unroll
                        for (int j = 0; j < 4; ++j)
                            e.row4(mrow + i * 16, ncol + j * 16 + g4 * 4, make_float4(acc[j][i][0], acc[j][i][1], acc[j][i][2], acc[j][i][3]));
                }
            });
        }
        if (qn == q) break;
        q = qn; m0 = m0n; n0 = n0n; pa = pan; pb = pbn;
    }
    asm volatile("s_waitcnt vmcnt(0)" ::: "memory");
    __syncthreads();
#undef G3P_TILE
}

template <class Epi>
__device__ __forceinline__ void gemm_bf16_phase3(const bf16_t* __restrict__ A, int lda, const bf16_t* __restrict__ Bt, int ldb,
                                                 int Mtiles  , int Ntiles, unsigned char* lds, Epi epi) {
    if constexpr (Epi::kRow) {
        if ((gridDim.x & 7) == 0 && (Mtiles & 15) == 0) { gemm_phase_pipelined(A, lda, Bt, ldb, Mtiles, Ntiles, lds, epi); return; }
    }
    if ((gridDim.x & 7) == 0 && (Mtiles & 15) == 0) {
        const int x = blockIdx.x & 7, j = blockIdx.x >> 3, nb = gridDim.x >> 3;
        const int per = (Mtiles >> 3) * Ntiles;
        for (int q = j; q < per; q += nb) {
            const int s = q / (2 * Ntiles), rem = q - s * (2 * Ntiles);
            const int c = rem >> 1, r = rem & 1;
            const int mt = x + 8 * (2 * s + r);
            gemm_tile3(A, lda, Bt, ldb, mt * 256, c * 128, lds, epi);
        }
    } else {
        for (int tile = blockIdx.x; tile < Mtiles * Ntiles; tile += gridDim.x)
            gemm_tile3(A, lda, Bt, ldb, (tile / Ntiles) * 256, (tile % Ntiles) * 128, lds, epi);
    }
}

struct EpiF32 {
    float* C; int ldc; int Nc;
    __device__ __forceinline__ void operator()(int m, int n, f32x4 v) const {
        if (n < Nc) *(float4*)(C + (size_t)m * ldc + n) = make_float4(v[0], v[1], v[2], v[3]);
    }
    __device__ __forceinline__ void finish(int, int) const {}
};

struct EpiProjBf {
    static constexpr bool kBf16 = true;
    bf16_t* dst; int ld; float sc;
    __device__ __forceinline__ uint2 pack4(f32x4 v) const { uint2 o; o.x = pack2bf(sc * v[0], sc * v[1]); o.y = pack2bf(sc * v[2], sc * v[3]); return o; }
    __device__ __forceinline__ void store8(int m, int n, uint4 o) const { *(uint4*)(dst + (size_t)m * ld + (n & 127)) = o; }
};
struct EpiProjLF {
    static constexpr bool kBf16 = false;
    unsigned char* ws;
    __device__ __forceinline__ void row4(int m, int n, float4 v) const {
        const int c = n - 512;
        const float4 lb = *(const float4*)((const float*)(ws + OFF_LBV) + c);
        float4 o;
        o.x = log_fast(lb.x + (1.f - lb.x) * sigmoid_fast(v.x)); o.y = log_fast(lb.y + (1.f - lb.y) * sigmoid_fast(v.y));
        o.z = log_fast(lb.z + (1.f - lb.z) * sigmoid_fast(v.z)); o.w = log_fast(lb.w + (1.f - lb.w) * sigmoid_fast(v.w));
        *(float4*)((float*)(ws + OFF_HLF) + (size_t)m * 512 + c) = o;
    }
};
struct EpiProjGate {
    static constexpr bool kBf16 = false;
    unsigned char* ws;
    __device__ __forceinline__ void row4(int m, int n, float4 v) const {
        const int c = n - 3328;
        if (c < 24)
            *(float4*)((float*)(ws + OFF_NGATE) + (size_t)m * 24 + c) =
                make_float4(sigmoid_fast(v.x), sigmoid_fast(v.y), sigmoid_fast(v.z), sigmoid_fast(v.w));
    }
};
struct EpiProj {
    static constexpr bool kRow = true;
    unsigned char* ws;
    template <class F> __device__ __forceinline__ void dispatch(int n0, F f) const {
        const int ct = __builtin_amdgcn_readfirstlane(n0 >> 7);
        if (ct >= 4 && ct < 8) f(EpiProjLF{ws});
        else if (ct >= 26) f(EpiProjGate{ws});
        else {
            size_t off; int ld = 512, c0 = (ct & 3) * 128; float sc = 1.f;
            if (ct < 4) off = OFF_HQ;
            else if (ct < 12) off = OFF_HI;
            else if (ct < 16) off = OFF_HG;
            else if (ct < 20) { off = OFF_NQ; sc = 0.125f * 1.4426950408889634f; }
            else { off = OFF_KV + (size_t)(ct - 20) * KV_STRIDE; ld = 128; c0 = 0; }
            f(EpiProjBf{(bf16_t*)(ws + off) + c0, ld, sc});
        }
    }
    __device__ __forceinline__ void finish(int, int) const {}
};
struct EpiMix {
    static constexpr bool kRow = true;
    bf16_t* mix;
    template <class F> __device__ __forceinline__ void dispatch(int n0, F f) const { f(EpiProjBf{mix + n0, DM, 1.f}); }
    __device__ __forceinline__ void finish(int, int) const {}
};

__device__ __forceinline__ uint4 pack8bf(const float* v) {
    uint4 o;
    o.x = pack2bf(v[0], v[1]); o.y = pack2bf(v[2], v[3]); o.z = pack2bf(v[4], v[5]); o.w = pack2bf(v[6], v[7]);
    return o;
}

__device__ __forceinline__ void hgrn_passA(const Params& p, int chunk, unsigned char* smem) {
    const int c = chunk & 127, bh = chunk >> 7, h = bh & 3, b = bh >> 2;
    const int tid = opaque_tid(), d = tid & 127, hf = __builtin_amdgcn_readfirstlane(tid >> 7), lane = tid & 63, w = __builtin_amdgcn_readfirstlane(tid >> 6);
    const size_t tok0 = (size_t)b * SEQ + (size_t)c * 64 + 32 * hf;
    const float* HLF = (const float*)(p.ws + OFF_HLF);
    const bf16_t* HI = (const bf16_t*)(p.ws + OFF_HI);
    unsigned char* KT = smem;
    unsigned char* VT = smem + 16384;
    float* xch = (float*)(smem + 32768);
    const float* lfp = HLF + tok0 * 512 + h * 128 + d;
    const bf16_t* vp = HI + tok0 * 512 + h * 128 + d;
    float lf[32];
#pragma unroll
    for (int s = 0; s < 32; ++s) lf[s] = lfp[s * 512];
    uint4 vt0, vt1, vt2, vt3;
    {
#define VLD8(q_, R_) { unsigned short v_[8]; _Pragma("unroll") for (int j = 0; j < 8; ++j) v_[j] = vp[((q_) * 8 + j) * 512];                 \
                       R_.x = v_[0] | ((unsigned)v_[1] << 16); R_.y = v_[2] | ((unsigned)v_[3] << 16);                                       \
                       R_.z = v_[4] | ((unsigned)v_[5] << 16); R_.w = v_[6] | ((unsigned)v_[7] << 16); }
        VLD8(0, vt0) VLD8(1, vt1) VLD8(2, vt2) VLD8(3, vt3)
#undef VLD8
    }
    float run = 0.f, b15 = 0.f;
#pragma unroll
    for (int s = 0; s < 32; ++s) { run += lf[s]; if (s == 15) b15 = run; }
    __syncthreads();
    xch[hf * 128 + d] = run;
    __syncthreads();
    const float tot0 = xch[d], tot1 = xch[128 + d];
    const float blast = tot0 + tot1;
    {
        float* REF = (float*)(p.ws + OFF_HREF) + (size_t)chunk * 384;
        if (hf == 0) { REF[d] = b15; REF[128 + d] = tot0; } else REF[256 + d] = tot0 + b15;
    }
    run = hf ? tot0 : 0.f;
#pragma unroll
    for (int q = 0; q < 4; ++q) {
        float kv[8];
#pragma unroll
        for (int j = 0; j < 8; ++j) {
            const float l_ = lf[q * 8 + j];
            run += l_;
            kv[j] = (1.f - exp_fast(l_)) * exp_fast(blast - run);
        }
        const int ch = 4 * hf + q;
        *(uint4*)(KT + d * 128 + ((ch ^ (d & 7)) << 4)) = pack8bf(kv);
        *(uint4*)(VT + d * 128 + ((ch ^ (d & 7)) << 4)) = (q == 0) ? vt0 : (q == 1) ? vt1 : (q == 2) ? vt2 : vt3;
    }
    if (hf) ((float*)(p.ws + OFF_DC))[(size_t)chunk * 128 + d] = expf(blast);
    __syncthreads();
    f32x4 acc[2][8];
#pragma unroll
    for (int i = 0; i < 2; ++i)
#pragma unroll
        for (int et = 0; et < 8; ++et) acc[i][et] = (f32x4){0.f, 0.f, 0.f, 0.f};
#pragma unroll
    for (int st = 0; st < 2; ++st) {
        const int ch = st * 4 + (lane >> 4);
        bf16x8 af[2];
#pragma unroll
        for (int i = 0; i < 2; ++i) {
            const int row = (2 * w + i) * 16 + (lane & 15);
            af[i] = *(const bf16x8*)(KT + row * 128 + ((ch ^ (row & 7)) << 4));
        }
#pragma unroll
        for (int et = 0; et < 8; ++et) {
            const int row = et * 16 + (lane & 15);
            const bf16x8 bfv = *(const bf16x8*)(VT + row * 128 + ((ch ^ (row & 7)) << 4));
            acc[0][et] = __builtin_amdgcn_mfma_f32_16x16x32_bf16(af[0], bfv, acc[0][et], 0, 0, 0);
            acc[1][et] = __builtin_amdgcn_mfma_f32_16x16x32_bf16(af[1], bfv, acc[1][et], 0, 0, 0);
        }
    }
    bf16_t* HC = (bf16_t*)p.out + (size_t)chunk * 16384;
#pragma unroll
    for (int et = 0; et < 8; ++et) {
        const int e = et * 16 + (lane & 15), g4 = lane >> 4;
        uint2 a, b;
        a.x = pack2bf(acc[0][et][0], acc[0][et][1]); a.y = pack2bf(acc[0][et][2], acc[0][et][3]);
        b.x = pack2bf(acc[1][et][0], acc[1][et][1]); b.y = pack2bf(acc[1][et][2], acc[1][et][3]);
        auto sx = __builtin_amdgcn_permlane16_swap(a.x, b.x, false, false);
        auto sy = __builtin_amdgcn_permlane16_swap(a.y, b.y, false, false);
        *(uint4*)(HC + e * 128 + (2 * w + (g4 & 1)) * 16 + (g4 >> 1) * 8) = make_uint4(sx[0], sy[0], sx[1], sy[1]);
    }
}

__device__ __forceinline__ void hgrn_scan_item(const Params& p, int item) {
    const int gid = item * 256 + threadIdx.x;
    const int d4 = gid & 31, e = (gid >> 5) & 127, bh = gid >> 12;
    const bf16_t* HC = (const bf16_t*)p.out;
    const float* DC = (const float*)(p.ws + OFF_DC);
    bf16_t* SC = (bf16_t*)(p.ws + OFF_SC);
    float4 S = make_float4(0.f, 0.f, 0.f, 0.f);
#pragma unroll 16
    for (int c = 0; c < 128; ++c) {
        const size_t base = ((size_t)(bh * 128 + c) * 128 + e) * 128 + d4 * 4;
        const uint2 hb = *(const uint2*)(HC + base);
        const float4 H = make_float4(__uint_as_float(hb.x << 16), __uint_as_float(hb.x & 0xffff0000u), __uint_as_float(hb.y << 16), __uint_as_float(hb.y & 0xffff0000u));
        const float4 dc = *(const float4*)(DC + (size_t)(bh * 128 + c) * 128 + d4 * 4);
        uint2 o; o.x = pack2bf(S.x, S.y); o.y = pack2bf(S.z, S.w);
        *(uint2*)(SC + base) = o;
        S.x = dc.x * S.x + H.x; S.y = dc.y * S.y + H.y; S.z = dc.z * S.z + H.z; S.w = dc.w * S.w + H.w;
    }
}

__device__ __forceinline__ void hgrn_passC(const Params& p, int chunk, unsigned char* smem) {
    const int c = chunk & 127, bh = chunk >> 7, h = bh & 3, b = bh >> 2;
    const int tid = opaque_tid(), d = tid & 127, hf = __builtin_amdgcn_readfirstlane(tid >> 7), lane = tid & 63, w = __builtin_amdgcn_readfirstlane(tid >> 6);
    const size_t tokc = (size_t)b * SEQ + (size_t)c * 64;
    const size_t tok0 = tokc + 32 * hf;
    const float* HLF = (const float*)(p.ws + OFF_HLF);
    const bf16_t* HQ = (const bf16_t*)(p.ws + OFF_HQ);
    const bf16_t* HI = (const bf16_t*)(p.ws + OFF_HI);
    const bf16_t* HG = (const bf16_t*)(p.ws + OFF_HG);
    unsigned char* R0 = smem;
    unsigned char* R1 = smem + 16384;
    unsigned char* R2 = smem + 57344;
    unsigned char* R3 = smem + 65536;
    const float* lfp = HLF + tok0 * 512 + h * 128 + d;
    const bf16_t* qp = HQ + tok0 * 512 + h * 128 + d;
    const float* REF = (const float*)(p.ws + OFF_HREF) + (size_t)chunk * 384;
    __syncthreads();
    const float r1 = REF[d], r2 = REF[128 + d], r3 = REF[256 + d];
    uint4 sct0, sct1, sct2, sct3, sct4, sct5, sct6, sct7;
    {
        const bf16_t* SCp = (const bf16_t*)(p.ws + OFF_SC) + (size_t)chunk * 16384;
#define SCLD(i, R_) { const int cc = tid + 256 * (i); R_ = *(const uint4*)(SCp + (cc >> 4) * 128 + (cc & 15) * 8); }
        SCLD(0, sct0) SCLD(1, sct1) SCLD(2, sct2) SCLD(3, sct3) SCLD(4, sct4) SCLD(5, sct5) SCLD(6, sct6) SCLD(7, sct7)
#undef SCLD
    }
    uint4 vt0, vt1, vt2, vt3;
    {
        const bf16_t* vp = HI + tok0 * 512 + h * 128 + d;
#define VLD8(q_, R_) { unsigned short v_[8]; _Pragma("unroll") for (int j = 0; j < 8; ++j) v_[j] = vp[((q_) * 8 + j) * 512];                 \
                       R_.x = v_[0] | ((unsigned)v_[1] << 16); R_.y = v_[2] | ((unsigned)v_[3] << 16);                                       \
                       R_.z = v_[4] | ((unsigned)v_[5] << 16); R_.w = v_[6] | ((unsigned)v_[7] << 16); }
        VLD8(0, vt0) VLD8(1, vt1) VLD8(2, vt2) VLD8(3, vt3)
#undef VLD8
    }
    {
        float run = hf ? r2 : 0.f;
        unsigned char* dummy = R2 + 4096 + d * 2;
#pragma unroll 8
        for (int s = 0; s < 32; ++s) {
            const int t = 32 * hf + s;
            const int it = t >> 4;
            const float rr = (it == 0) ? 0.f : (it == 1) ? r1 : (it == 2) ? r2 : r3;
            const int sw = (((d >> 3) ^ (t & 15)) << 4) + (d & 7) * 2;
            const float lf = lfp[s * 512];
            run += lf;
            const float qv = bf2f(qp[s * 512]);
            const float kv = 1.f - exp_fast(lf);
            *(bf16_t*)(R3 + t * 256 + sw) = (bf16_t)f2bf(qv * exp_fast(run));
            *(bf16_t*)(R0 + t * 256 + sw) = (bf16_t)f2bf(qv * exp_fast(run - rr));
#pragma unroll
            for (int i = 0; i < 4; ++i) {
                const float ri = (i == 0) ? 0.f : (i == 1) ? r1 : (i == 2) ? r2 : r3;
                const int R = 8 * i * (i + 1) + t;
                unsigned char* dst = (i >= it) ? (R1 + R * 256 + sw) : dummy;
                *(bf16_t*)dst = (bf16_t)f2bf(kv * exp_fast(fminf(ri - run, 80.f)));
            }
        }
    }
    __syncthreads();
#pragma unroll
    for (int j = 0; j < 4; ++j) {
        uint2 o = make_uint2(0u, 0u);
        if (j <= w) {
            f32x4 pa = (f32x4){0.f, 0.f, 0.f, 0.f};
#pragma unroll
            for (int ds = 0; ds < 4; ++ds) {
                const int ch = ds * 4 + (lane >> 4);
                const int krow = 8 * w * (w + 1) + 16 * j + (lane & 15);
                const int trow = w * 16 + (lane & 15);
                const bf16x8 av = *(const bf16x8*)(R1 + krow * 256 + ((ch ^ (krow & 15)) << 4));
                const bf16x8 bq = *(const bf16x8*)(R0 + trow * 256 + ((ch ^ (trow & 15)) << 4));
                pa = __builtin_amdgcn_mfma_f32_16x16x32_bf16(av, bq, pa, 0, 0, 0);
            }
            if (j == w) {
                const int tl = lane & 15, sl = (lane >> 4) * 4;
#pragma unroll
                for (int r = 0; r < 4; ++r) if (sl + r > tl) pa[r] = 0.f;
            }
            o.x = pack2bf(pa[0], pa[1]); o.y = pack2bf(pa[2], pa[3]);
        }
        const int t = w * 16 + (lane & 15);
        const int ch = 2 * j + (lane >> 5);
        *(uint2*)(R2 + t * 128 + ((ch ^ (t & 7)) << 4) + ((lane >> 4) & 1) * 8) = o;
    }
    __syncthreads();
    {
#define SCST(i, R_) { const int cc = tid + 256 * (i), row = cc >> 4, ch = cc & 15; *(uint4*)(R1 + row * 256 + ((ch ^ (row & 15)) << 4)) = R_; }
        SCST(0, sct0) SCST(1, sct1) SCST(2, sct2) SCST(3, sct3) SCST(4, sct4) SCST(5, sct5) SCST(6, sct6) SCST(7, sct7)
#undef SCST
        *(uint4*)(R0 + d * 128 + (((4 * hf + 0) ^ (d & 7)) << 4)) = vt0;
        *(uint4*)(R0 + d * 128 + (((4 * hf + 1) ^ (d & 7)) << 4)) = vt1;
        *(uint4*)(R0 + d * 128 + (((4 * hf + 2) ^ (d & 7)) << 4)) = vt2;
        *(uint4*)(R0 + d * 128 + (((4 * hf + 3) ^ (d & 7)) << 4)) = vt3;
    }
    __syncthreads();
    const size_t tok = tokc + w * 16 + (lane & 15);
    uint2 gb0, gb1, gb2, gb3, gb4, gb5, gb6, gb7;
    {
        const bf16_t* gp = HG + tok * 512 + h * 128 + (lane >> 4) * 4;
        gb0 = *(const uint2*)(gp); gb1 = *(const uint2*)(gp + 16); gb2 = *(const uint2*)(gp + 32); gb3 = *(const uint2*)(gp + 48);
        gb4 = *(const uint2*)(gp + 64); gb5 = *(const uint2*)(gp + 80); gb6 = *(const uint2*)(gp + 96); gb7 = *(const uint2*)(gp + 112);
    }
    f32x4 acc[8];
#pragma unroll
    for (int et = 0; et < 8; ++et) acc[et] = (f32x4){0.f, 0.f, 0.f, 0.f};
#pragma unroll
    for (int ds = 0; ds < 4; ++ds) {
        const int ch = ds * 4 + (lane >> 4);
        const int trow = w * 16 + (lane & 15);
        const bf16x8 bq = *(const bf16x8*)(R3 + trow * 256 + ((ch ^ (trow & 15)) << 4));
#pragma unroll
        for (int et = 0; et < 8; ++et) {
            const int row = et * 16 + (lane & 15);
            const bf16x8 av = *(const bf16x8*)(R1 + row * 256 + ((ch ^ (row & 15)) << 4));
            acc[et] = __builtin_amdgcn_mfma_f32_16x16x32_bf16(av, bq, acc[et], 0, 0, 0);
        }
    }
#pragma unroll
    for (int st = 0; st < 2; ++st) {
        const int ch = st * 4 + (lane >> 4);
        const int trow = w * 16 + (lane & 15);
        const bf16x8 bp = *(const bf16x8*)(R2 + trow * 128 + ((ch ^ (trow & 7)) << 4));
#pragma unroll
        for (int et = 0; et < 8; ++et) {
            const int row = et * 16 + (lane & 15);
            const bf16x8 av = *(const bf16x8*)(R0 + row * 128 + ((ch ^ (row & 7)) << 4));
            acc[et] = __builtin_amdgcn_mfma_f32_16x16x32_bf16(av, bp, acc[et], 0, 0, 0);
        }
    }
    {
        float ss = 0.f;
#pragma unroll
        for (int et = 0; et < 8; ++et)
#pragma unroll
            for (int r = 0; r < 4; ++r) ss += acc[et][r] * acc[et][r];
        ss += __shfl_xor(ss, 16);
        ss += __shfl_xor(ss, 32);
        const float rs = rsqrtf(ss * (1.f / 128.f) + LN_EPS);
        const float* ng = p.in[4];
        bf16_t* MIX = (bf16_t*)(p.ws + OFF_XB);
#pragma unroll
        for (int et = 0; et < 8; ++et) {
            const int e0 = et * 16 + (lane >> 4) * 4;
            const uint2 gb = (et == 0) ? gb0 : (et == 1) ? gb1 : (et == 2) ? gb2 : (et == 3) ? gb3 : (et == 4) ? gb4 : (et == 5) ? gb5 : (et == 6) ? gb6 : gb7;
            const float4 n4 = *(const float4*)(ng + e0);
            const float g0 = bf2f(gb.x & 0xffffu), g1 = bf2f(gb.x >> 16), g2 = bf2f(gb.y & 0xffffu), g3 = bf2f(gb.y >> 16);
            uint2 o;
            o.x = pack2bf(acc[et][0] * rs * n4.x * (g0 * sigmoid_fast(g0)), acc[et][1] * rs * n4.y * (g1 * sigmoid_fast(g1)));
            o.y = pack2bf(acc[et][2] * rs * n4.z * (g2 * sigmoid_fast(g2)), acc[et][3] * rs * n4.w * (g3 * sigmoid_fast(g3)));
            *(uint2*)(MIX + tok * DM + h * 128 + e0) = o;
        }
    }
}

__device__ __forceinline__ void compress_item(const Params& p, int item, float* sm) {
    const int g = item & 1;
    int r = item >> 1;
    const int n = r % NCB; r /= NCB;
    const int b = r & 3, which = r >> 2;
    const int tid = opaque_tid();
    const bf16_t* kvsrc = (const bf16_t*)(p.ws + OFF_KV + (size_t)which * KV_STRIDE);
    const float* pe = p.in[which ? 10 : 5];
    const float* w1 = p.in[which ? 11 : 6];
    const float* b1 = p.in[which ? 12 : 7];
    const float* w2 = p.in[which ? 13 : 8];
    const float* b2 = p.in[which ? 14 : 9];
    float* outp = (float*)(p.ws + (which ? OFF_CMPV : OFF_CMPK));
    float* blk = sm;
    float* hh = sm + 2048;
    __syncthreads();
    for (int i = tid; i < 2048; i += 256) {
        const int l = i >> 6, d = i & 63;
        blk[i] = bf2f(kvsrc[(size_t)(b * SEQ + 16 * n + l) * 128 + g * 64 + d]) + pe[i];
    }
    __syncthreads();
    float acc = b1[tid];
    for (int i = 0; i < 2048; ++i) acc += blk[i] * w1[(size_t)i * 256 + tid];
    hh[tid] = gelu_tanh(acc);
    __syncthreads();
    if (tid < 64) {
        float o = b2[tid];
        for (int j = 0; j < 256; ++j) o += hh[j] * w2[j * 64 + tid];
        outp[((size_t)(b * NCB + n) * 2 + g) * 64 + tid] = o;
    }
}

__device__ __forceinline__ float dot64_bf(const float* qs, const bf16_t* krow) {
    float s = 0.f;
#pragma unroll
    for (int i = 0; i < 8; ++i) {
        const uint4 kv = ((const uint4*)krow)[i];
        const float4 q0 = ((const float4*)qs)[2 * i], q1 = ((const float4*)qs)[2 * i + 1];
        s += __uint_as_float(kv.x << 16) * q0.x + __uint_as_float(kv.x & 0xffff0000u) * q0.y
           + __uint_as_float(kv.y << 16) * q0.z + __uint_as_float(kv.y & 0xffff0000u) * q0.w
           + __uint_as_float(kv.z << 16) * q1.x + __uint_as_float(kv.z & 0xffff0000u) * q1.y
           + __uint_as_float(kv.w << 16) * q1.z + __uint_as_float(kv.w & 0xffff0000u) * q1.w;
    }
    return s;
}
__device__ __forceinline__ float dot64(const float* qs, const float* krow) {
    float s = 0.f;
#pragma unroll
    for (int i = 0; i < 16; ++i) {
        const float4 kv = ((const float4*)krow)[i];
        const float4 qv = ((const float4*)qs)[i];
        s += kv.x * qv.x + kv.y * qv.y + kv.z * qv.z + kv.w * qv.w;
    }
    return s;
}

__device__ __forceinline__ void nsa_item(const Params& p, int item, float* sm) {
    const int t = item & (SEQ - 1), g = (item >> 13) & 1, b = item >> 14;
    const int tid = threadIdx.x, lane = tid & 63, r = tid >> 6;
    float* sc = sm + r * 1024;
    float* qs = sm + 4096 + r * 64;
    float* impv = sm + 4096 + 256;
    int* sel = (int*)(sm + 4096 + 256 + 128);
    const bf16_t* KSb = (const bf16_t*)(p.ws + OFF_KV + 2 * KV_STRIDE);
    const bf16_t* VSb = (const bf16_t*)(p.ws + OFF_KV + 3 * KV_STRIDE);
    const bf16_t* KWb = (const bf16_t*)(p.ws + OFF_KV + 4 * KV_STRIDE);
    const bf16_t* VWb = (const bf16_t*)(p.ws + OFF_KV + 5 * KV_STRIDE);
    const float* cmpk = (const float*)(p.ws + OFF_CMPK);
    const float* cmpv = (const float*)(p.ws + OFF_CMPV);
    const size_t n = (size_t)b * SEQ + t;
    const float NEGV = -1e30f;
    __syncthreads();
    qs[lane] = bf2f(((const bf16_t*)(p.ws + OFF_NQ))[n * 512 + g * 256 + r * 64 + lane]) * 0.6931471805599453f;
    __syncthreads();

    const int nvalid = (t >= 31) ? (((t - 31) >> 4) + 1) : 0;
    float m = NEGV;
    for (int n0 = 0; n0 < nvalid; n0 += 64) {
        const int nn = n0 + lane;
        if (nn < nvalid) {
            const float s = dot64(qs, cmpk + ((size_t)(b * NCB + nn) * 2 + g) * 64);
            sc[nn] = s;
            m = fmaxf(m, s);
        }
    }
    m = wave_max(m);
    float sum = 0.f;
    for (int n0 = 0; n0 < nvalid; n0 += 64) {
        const int nn = n0 + lane;
        if (nn < nvalid) { const float e = expf(sc[nn] - m); sc[nn] = e; sum += e; }
    }
    sum = wave_sum(sum);
    {
        const float inv = 1.f / fmaxf(sum, 1e-30f);
        for (int n0 = 0; n0 < nvalid; n0 += 64) {
            const int nn = n0 + lane;
            if (nn < nvalid) sc[nn] *= inv;
        }
    }
    __syncthreads();
    float oc = 0.f;
    for (int nn = 0; nn < nvalid; ++nn) oc += sc[nn] * cmpv[((size_t)(b * NCB + nn) * 2 + g) * 64 + lane];

    const int cur = t >> 6;
    if (tid < 128) {
        const int j = tid;
        float im = 0.f;
#pragma unroll
        for (int rr = 0; rr < 4; ++rr) {
            const float* P = sm + rr * 1024;
            const int n4 = 4 * j;
            float a = 0.f;
            if (n4 < nvalid) a += P[n4];
            if (n4 + 1 < nvalid) a += P[n4 + 1];
            if (n4 + 2 < nvalid) a += P[n4 + 2];
            if (n4 + 3 < nvalid) a += 0.5f * P[n4 + 3];
            if (n4 - 1 >= 0 && n4 - 1 < nvalid) a += 0.5f * P[n4 - 1];
            im += a;
        }
        const bool forced = (j == 0) || (j == cur) || (j == cur - 1);
        const bool causal = (j <= cur);
        impv[j] = forced ? 1.0e4f : (causal ? im : -1.f);
    }
    __syncthreads();
    if (r == 0) {
        float v0 = impv[lane], v1 = impv[lane + 64];
        for (int k = 0; k < 16; ++k) {
            const float mx = wave_max(fmaxf(v0, v1));
            const unsigned long long b0 = __ballot(v0 == mx);
            int idx;
            if (b0) {
                const int l = __ffsll((unsigned long long)b0) - 1;
                idx = l;
                if (lane == l) v0 = -3.0e38f;
            } else {
                const unsigned long long b1 = __ballot(v1 == mx);
                const int l = __ffsll((unsigned long long)b1) - 1;
                idx = 64 + l;
                if (lane == l) v1 = -3.0e38f;
            }
            if (lane == 0) sel[k] = idx;
        }
    }
    __syncthreads();

    m = NEGV;
    for (int si = 0; si < 16; ++si) {
        const int blk = sel[si];
        const int key = blk * 64 + lane;
        float s = NEGV;
        if (blk * 64 <= t) {
            if (key <= t) s = dot64_bf(qs, KSb + ((size_t)b * SEQ + key) * 128 + g * 64);
        }
        sc[si * 64 + lane] = s;
        m = fmaxf(m, s);
    }
    m = wave_max(m);
    sum = 0.f;
    for (int si = 0; si < 16; ++si) {
        const int key = sel[si] * 64 + lane;
        const float e = (key <= t) ? expf(sc[si * 64 + lane] - m) : 0.f;
        sc[si * 64 + lane] = e;
        sum += e;
    }
    sum = wave_sum(sum);
    {
        const float inv = 1.f / fmaxf(sum, 1e-30f);
        for (int si = 0; si < 16; ++si) sc[si * 64 + lane] *= inv;
    }
    __syncthreads();
    float os = 0.f;
    for (int si = 0; si < 16; ++si) {
        const int blk = sel[si];
        if (blk * 64 > t) continue;
        for (int kk = 0; kk < 64; ++kk) {
            const int key = blk * 64 + kk;
            if (key > t) break;
            os += sc[si * 64 + kk] * bf2f(VSb[((size_t)b * SEQ + key) * 128 + g * 64 + lane]);
        }
    }
    __syncthreads();

    const int lo = t - 511;
    m = NEGV;
    for (int i = 0; i < 8; ++i) {
        const int key = lo + i * 64 + lane;
        float s = NEGV;
        if (key >= 0) s = dot64_bf(qs, KWb + ((size_t)b * SEQ + key) * 128 + g * 64);
        sc[i * 64 + lane] = s;
        m = fmaxf(m, s);
    }
    m = wave_max(m);
    sum = 0.f;
    for (int i = 0; i < 8; ++i) {
        const int key = lo + i * 64 + lane;
        const float e = (key >= 0) ? expf(sc[i * 64 + lane] - m) : 0.f;
        sc[i * 64 + lane] = e;
        sum += e;
    }
    sum = wave_sum(sum);
    {
        const float inv = 1.f / fmaxf(sum, 1e-30f);
        for (int i = 0; i < 8; ++i) sc[i * 64 + lane] *= inv;
    }
    __syncthreads();
    float ow = 0.f;
    for (int idx = 0; idx < 512; ++idx) {
        const int key = lo + idx;
        if (key < 0) continue;
        ow += sc[idx] * bf2f(VWb[((size_t)b * SEQ + key) * 128 + g * 64 + lane]);
    }
    const float* grow = (const float*)(p.ws + OFF_NGATE) + n * 24 + g * 12 + r * 3;
    const float gc = grow[0], gs = grow[1], gw = grow[2];
#if NSA_DIAG
    {
        const float ref = gc * oc + gs * os + gw * ow;
        const float got = bf2f(((const bf16_t*)(p.ws + OFF_XB))[n * DM + 512 + g * 256 + r * 64 + lane]);
        const unsigned* SELM = (const unsigned*)(p.ws + OFF_SELM) + ((size_t)(b * 2 + g) * SEQ + t) * 4;
        unsigned gm[4] = {0u, 0u, 0u, 0u};
        for (int si = 0; si < 16; ++si) { const int blk = sel[si]; if (blk * 64 <= t) gm[blk >> 5] |= 1u << (blk & 31); }
        bool same = true;
        for (int qd = 0; qd < 4; ++qd) {
            unsigned mm = SELM[qd];
            for (int bit = 0; bit < 32; ++bit) if ((qd * 32 + bit) * 64 > t) mm &= ~(1u << bit);
            if (mm != gm[qd]) same = false;
        }
        float d2 = same ? (got - ref) * (got - ref) : 0.f, r2 = same ? ref * ref : 0.f;
        d2 = wave_sum(d2); r2 = wave_sum(r2);
        float* DG = (float*)(p.ws + OFF_DIAG);
        if (lane == 0) { atomicAdd(&DG[0], d2); atomicAdd(&DG[1], r2); if (r == 0) { atomicAdd(&DG[2], same ? 0.f : 1.f); atomicAdd(&DG[3], 1.f); } }
    }
#else
    ((bf16_t*)(p.ws + OFF_XB))[n * DM + 512 + g * 256 + r * 64 + lane] = (bf16_t)f2bf(gc * oc + gs * os + gw * ow);
#endif
}


__device__ __forceinline__ float xrow_max(float x) {
    auto s = __builtin_amdgcn_permlane16_swap(__float_as_uint(x), __float_as_uint(x), false, false);
    x = fmaxf(__uint_as_float(s[0]), __uint_as_float(s[1]));
    auto t = __builtin_amdgcn_permlane32_swap(__float_as_uint(x), __float_as_uint(x), false, false);
    return fmaxf(__uint_as_float(t[0]), __uint_as_float(t[1]));
}
__device__ __forceinline__ float xrow_sum(float x) {
    auto s = __builtin_amdgcn_permlane16_swap(__float_as_uint(x), __float_as_uint(x), false, false);
    x = __uint_as_float(s[0]) + __uint_as_float(s[1]);
    auto t = __builtin_amdgcn_permlane32_swap(__float_as_uint(x), __float_as_uint(x), false, false);
    return __uint_as_float(t[0]) + __uint_as_float(t[1]);
}
template <int CTRL> __device__ __forceinline__ float dppf(float x) {
    return __builtin_bit_cast(float, __builtin_amdgcn_mov_dpp(__builtin_bit_cast(int, x), CTRL, 0xf, 0xf, true));
}
__device__ __forceinline__ float row16_max(float m) {
    m = fmaxf(m, dppf<0x121>(m)); m = fmaxf(m, dppf<0x122>(m));
    m = fmaxf(m, dppf<0x124>(m)); m = fmaxf(m, dppf<0x128>(m));
    return m;
}
__device__ __forceinline__ float row16_sum(float m) {
    m += dppf<0x121>(m); m += dppf<0x122>(m); m += dppf<0x124>(m); m += dppf<0x128>(m);
    return m;
}
__device__ __forceinline__ float dot2bf(unsigned a, unsigned b, float acc) {
    return __builtin_amdgcn_fdot2_f32_bf16(__builtin_bit_cast(bf16x2_t, a), __builtin_bit_cast(bf16x2_t, b), acc, false);
}
__device__ __forceinline__ float enc_key(float v, unsigned idx, unsigned mask) {
    const unsigned u = __float_as_uint(v);
    const unsigned code = (u >> 31) ? idx : (mask - idx);
    return __uint_as_float((u & ~mask) | code);
}
__device__ __forceinline__ unsigned dec_idx(float key, unsigned mask) {
    const unsigned u = __float_as_uint(key);
    const unsigned code = u & mask;
    return (u >> 31) ? code : (mask - code);
}
__device__ __forceinline__ float dec_val(float key, unsigned mask) { return __uint_as_float(__float_as_uint(key) & ~mask); }
#define NEGKEY (-3.0e38f)
#define CE_DESC(a, b) { const float t_ = fmaxf(a, b); b = fminf(a, b); a = t_; }

struct EpiCmpH {
    bf16_t* HB; const float* peb;
    __device__ __forceinline__ void operator()(int m, int n, f32x4 v) const {
        const float4 pb = *(const float4*)(peb + n);
        uint2 o;
        o.x = pack2bf(gelu_tanh(v[0] + pb.x), gelu_tanh(v[1] + pb.y));
        o.y = pack2bf(gelu_tanh(v[2] + pb.z), gelu_tanh(v[3] + pb.w));
        *(uint2*)(HB + (size_t)m * 256 + n) = o;
    }
    __device__ __forceinline__ void finish(int, int) const {}
};
__device__ __forceinline__ void cmp_peb_partial(const Params& p, int b) {
    const int which = b >> 5, s = b & 31;
    const float* pe = p.in[which ? 10 : 5];
    const float* w1 = p.in[which ? 11 : 6];
    const int j = threadIdx.x;
    float acc = 0.f;
#pragma unroll 16
    for (int i = s * 64; i < s * 64 + 64; ++i) acc += pe[i] * w1[(size_t)i * 256 + j];
    ((float*)(p.ws + OFF_PEB + 4096))[(which * 32 + s) * 256 + j] = acc;
}
__device__ __forceinline__ void cmp_peb_reduce(const Params& p) {
    for (int o = threadIdx.x; o < 512; o += 256) {
        const int which = o >> 8, j = o & 255;
        float acc = p.in[which ? 12 : 7][j];
        for (int s = 0; s < 32; ++s) acc += ((const float*)(p.ws + OFF_PEB + 4096))[(which * 32 + s) * 256 + j];
        ((float*)(p.ws + OFF_PEB))[o] = acc;
    }
}
__device__ __forceinline__ void cmp_layer2_phase(const Params& p, int first_block, int nblocks) {
    const int tid_ = opaque_tid(), lane = tid_ & 63, w = __builtin_amdgcn_readfirstlane(tid_ >> 6);
    for (int slot = (blockIdx.x - first_block) * 4 + w; slot < 2048; slot += nblocks * 4) {
        const int which = slot >> 10, r0 = slot & 1023;
        const float* w2 = p.in[which ? 13 : 8];
        const float* b2 = p.in[which ? 14 : 9];
        const bf16_t* hb = (const bf16_t*)(p.ws + OFF_HB) + (size_t)which * 4096 * 256;
        const bool v3 = (r0 + 3072) < 4088;
        const bf16_t* h0 = hb + (size_t)r0 * 256;
        const bf16_t* h1 = hb + (size_t)(r0 + 1024) * 256;
        const bf16_t* h2 = hb + (size_t)(r0 + 2048) * 256;
        const bf16_t* h3 = hb + (size_t)(v3 ? r0 + 3072 : r0) * 256;
        const float bias = b2[lane];
        float o0 = bias, o1 = bias, o2 = bias, o3 = bias;
#pragma unroll 8
        for (int jj = 0; jj < 128; ++jj) {
            const float wa = w2[(2 * jj) * 64 + lane], wb = w2[(2 * jj + 1) * 64 + lane];
            const unsigned u0 = *(const unsigned*)(h0 + 2 * jj), u1 = *(const unsigned*)(h1 + 2 * jj);
            const unsigned u2 = *(const unsigned*)(h2 + 2 * jj), u3 = *(const unsigned*)(h3 + 2 * jj);
            o0 += __uint_as_float(u0 << 16) * wa; o0 += __uint_as_float(u0 & 0xffff0000u) * wb;
            o1 += __uint_as_float(u1 << 16) * wa; o1 += __uint_as_float(u1 & 0xffff0000u) * wb;
            o2 += __uint_as_float(u2 << 16) * wa; o2 += __uint_as_float(u2 & 0xffff0000u) * wb;
            o3 += __uint_as_float(u3 << 16) * wa; o3 += __uint_as_float(u3 & 0xffff0000u) * wb;
        }
        bf16_t* dst = (bf16_t*)(p.ws + (which ? OFF_CMPVB : OFF_CMPKB));
#define L2ST(row_, o_) { const int g = (row_) & 1, bn = (row_) >> 1, n = bn % NCB, b = bn / NCB;                                         \
                         dst[((size_t)(b * 2 + g) * 512 + n) * 64 + lane] = (bf16_t)f2bf(o_); }
        L2ST(r0, o0) L2ST(r0 + 1024, o1) L2ST(r0 + 2048, o2)
        if (v3) L2ST(r0 + 3072, o3)
#undef L2ST
    }
}

struct StageOfs { int k, v; };
__device__ __forceinline__ StageOfs make_stage_ofs() {
    const int c0 = opaque_tid(), key = c0 >> 3, ch = c0 & 7;
    StageOfs s;
    s.k = key * 128 + ((ch ^ (key & 7)) << 4);
    s.v = key * 128 + (((ch >> 1) ^ ((key >> 1) & 3)) << 5) + (ch & 1) * 16;
    return s;
}
#define NSA_KV_LOAD(S_, kb_) { const bf16_t* kp_ = Kbase + (size_t)(kb_) * 64 * stride + (size_t)(tid >> 3) * stride + (tid & 7) * 8; \
        const bf16_t* vp_ = Vbase + (size_t)(kb_) * 64 * stride + (size_t)(tid >> 3) * stride + (tid & 7) * 8;                 \
        S_##k0 = *(const uint4*)kp_; S_##k1 = *(const uint4*)(kp_ + (size_t)32 * stride);                                    \
        S_##v0 = *(const uint4*)vp_; S_##v1 = *(const uint4*)(vp_ + (size_t)32 * stride); }
#define NSA_KV_STORE(S_, Kl_, Vl_) { *(uint4*)((Kl_) + sof.k) = S_##k0; *(uint4*)((Kl_) + sof.k + 4096) = S_##k1; \
        *(uint4*)((Vl_) + sof.v) = S_##v0; *(uint4*)((Vl_) + sof.v + 4096) = S_##v1; }
template <class Compute>
__device__ __forceinline__ void nsa_kv_loop(const bf16_t* __restrict__ Kbase, const bf16_t* __restrict__ Vbase, int stride,
                                            int kb_lo, int kb_hi, unsigned char* smem, const StageOfs& sof, Compute compute) {
    const int tid = opaque_tid();
    uint4 ra_k0, ra_k1, ra_v0, ra_v1;
    NSA_KV_LOAD(ra_, kb_lo)
    __syncthreads();
    NSA_KV_STORE(ra_, smem, smem + 16384)
    __syncthreads();
    for (int kb = kb_lo; kb <= kb_hi; ++kb) {
        const int buf = (kb - kb_lo) & 1;
        if (kb < kb_hi) NSA_KV_LOAD(ra_, kb + 1)
        compute(kb, smem + buf * 8192, smem + 16384 + buf * 8192);
        if (kb < kb_hi) NSA_KV_STORE(ra_, smem + (buf ^ 1) * 8192, smem + 16384 + (buf ^ 1) * 8192)
        __syncthreads();
    }
}
struct LaneOfs { int k0, k1, vb0, vb1, vb2, vb3; };
__device__ __forceinline__ LaneOfs make_lane_ofs(int lane) {
    LaneOfs f;
    const int r15 = lane & 15, lg = lane >> 4, q = r15 >> 2, pp = r15 & 3;
    f.k0 = r15 * 128 + ((lg ^ (r15 & 7)) << 4);
    f.k1 = r15 * 128 + (((4 + lg) ^ (r15 & 7)) << 4);
    const int sw2 = (2 * (lg & 1) + (q >> 1)) & 3;
    const int vrow = (4 * lg + q) * 128 + pp * 8;
    f.vb0 = vrow + ((0 ^ sw2) << 5); f.vb1 = vrow + ((1 ^ sw2) << 5);
    f.vb2 = vrow + ((2 ^ sw2) << 5); f.vb3 = vrow + ((3 ^ sw2) << 5);
    return f;
}
typedef short s16x4 __attribute__((ext_vector_type(4)));
__device__ __forceinline__ uint2 tr_read(const unsigned char* p) {
    const s16x4 v = __builtin_amdgcn_ds_read_tr16_b64_v4i16((LAS3 s16x4*)p);
    return __builtin_bit_cast(uint2, v);
}
#define NEGM (-1.0e37f)
__device__ __forceinline__ void nsa_scores(const unsigned char* Kl, const LaneOfs& f, const bf16x8& q0, const bf16x8& q1, float bias, f32x4 (&s)[4]) {
#pragma unroll
    for (int kt = 0; kt < 4; ++kt) {
        const bf16x8 a0 = *(const bf16x8*)(Kl + f.k0 + kt * 2048);
        const bf16x8 a1 = *(const bf16x8*)(Kl + f.k1 + kt * 2048);
        f32x4 z = (f32x4){bias, bias, bias, bias};
        z = __builtin_amdgcn_mfma_f32_16x16x32_bf16(a0, q0, z, 0, 0, 0);
        s[kt] = __builtin_amdgcn_mfma_f32_16x16x32_bf16(a1, q1, z, 0, 0, 0);
    }
}
#define ONES_BF16X8 __builtin_bit_cast(bf16x8, make_uint4(0x3F803F80u, 0x3F803F80u, 0x3F803F80u, 0x3F803F80u))
template <class VF>
__device__ __forceinline__ void attn_step(const unsigned char* Kl, const unsigned char* Vl, int lane, const LaneOfs& f,
                                          const bf16x8& q0, const bf16x8& q1, f32x4 (&o)[4], float& m, f32x4& lacc,
                                          float rowbias, bool full, VF valid) {
    f32x4 s[4];
    const bool mok = m > -1e29f;
    const float meff = mok ? m : 0.f;
    nsa_scores(Kl, f, q0, q1, rowbias - meff, s);
    if (!full) {
#pragma unroll
        for (int kt = 0; kt < 4; ++kt)
#pragma unroll
            for (int r = 0; r < 4; ++r) s[kt][r] = valid(kt * 16 + 4 * (lane >> 4) + r) ? s[kt][r] : NEGM;
    }
    float mx = fmaxf(fmaxf(fmaxf(s[0][0], s[0][1]), fmaxf(s[0][2], s[0][3])), fmaxf(fmaxf(s[1][0], s[1][1]), fmaxf(s[1][2], s[1][3])));
    mx = fmaxf(mx, fmaxf(fmaxf(fmaxf(s[2][0], s[2][1]), fmaxf(s[2][2], s[2][3])), fmaxf(fmaxf(s[3][0], s[3][1]), fmaxf(s[3][2], s[3][3]))));
    mx = xrow_max(mx);
    if (!__all(mok && (mx <= 8.f))) {
        const float mn = fmaxf(m, meff + mx);
        const float alpha = __builtin_amdgcn_exp2f(m - mn), d = mn - meff;
        m = mn; lacc[0] *= alpha;
#pragma unroll
        for (int dt = 0; dt < 4; ++dt) { o[dt][0] *= alpha; o[dt][1] *= alpha; o[dt][2] *= alpha; o[dt][3] *= alpha; }
#pragma unroll
        for (int kt = 0; kt < 4; ++kt) { s[kt][0] -= d; s[kt][1] -= d; s[kt][2] -= d; s[kt][3] -= d; }
    }
#pragma unroll
    for (int kt = 0; kt < 4; ++kt)
#pragma unroll
        for (int r = 0; r < 4; ++r) s[kt][r] = __builtin_amdgcn_exp2f(s[kt][r]);
#pragma unroll
    for (int k2 = 0; k2 < 2; ++k2) {
        uint4 pk;
        pk.x = pack2bf(s[2 * k2][0], s[2 * k2][1]); pk.y = pack2bf(s[2 * k2][2], s[2 * k2][3]);
        pk.z = pack2bf(s[2 * k2 + 1][0], s[2 * k2 + 1][1]); pk.w = pack2bf(s[2 * k2 + 1][2], s[2 * k2 + 1][3]);
        const bf16x8 pb = __builtin_bit_cast(bf16x8, pk);
        lacc = __builtin_amdgcn_mfma_f32_16x16x32_bf16(ONES_BF16X8, pb, lacc, 0, 0, 0);
#define PV1(dt_, vb_) { const uint2 lo_ = tr_read(Vl + (vb_) + k2 * 4096), hi_ = tr_read(Vl + (vb_) + k2 * 4096 + 2048); \
                        uint4 av_; av_.x = lo_.x; av_.y = lo_.y; av_.z = hi_.x; av_.w = hi_.y;                          \
                        o[dt_] = __builtin_amdgcn_mfma_f32_16x16x32_bf16(__builtin_bit_cast(bf16x8, av_), pb, o[dt_], 0, 0, 0); }
        PV1(0, f.vb0) PV1(1, f.vb1) PV1(2, f.vb2) PV1(3, f.vb3)
#undef PV1
    }
}
template <class VFA, class VFB>
__device__ __forceinline__ void attn_step2(const unsigned char* Kl, const unsigned char* Vl, int lane, const LaneOfs& f,
                                           const bf16x8& qA0, const bf16x8& qA1, f32x4 (&oA)[4], float& mA, f32x4& lA, float biasA, bool fullA, VFA validA,
                                           const bf16x8& qB0, const bf16x8& qB1, f32x4 (&oB)[4], float& mB, f32x4& lB, float biasB, bool fullB, VFB validB) {
    f32x4 sA[4], sB[4];
    const bool mokA = mA > -1e29f, mokB = mB > -1e29f;
    const float meA = mokA ? mA : 0.f, meB = mokB ? mB : 0.f;
    const float iA = biasA - meA, iB = biasB - meB;
#pragma unroll
    for (int kt = 0; kt < 4; ++kt) {
        const bf16x8 a0 = *(const bf16x8*)(Kl + f.k0 + kt * 2048);
        const bf16x8 a1 = *(const bf16x8*)(Kl + f.k1 + kt * 2048);
        f32x4 zA = (f32x4){iA, iA, iA, iA}, zB = (f32x4){iB, iB, iB, iB};
        zA = __builtin_amdgcn_mfma_f32_16x16x32_bf16(a0, qA0, zA, 0, 0, 0);
        zB = __builtin_amdgcn_mfma_f32_16x16x32_bf16(a0, qB0, zB, 0, 0, 0);
        sA[kt] = __builtin_amdgcn_mfma_f32_16x16x32_bf16(a1, qA1, zA, 0, 0, 0);
        sB[kt] = __builtin_amdgcn_mfma_f32_16x16x32_bf16(a1, qB1, zB, 0, 0, 0);
    }
    if (!fullA) {
#pragma unroll
        for (int kt = 0; kt < 4; ++kt)
#pragma unroll
            for (int r = 0; r < 4; ++r) sA[kt][r] = validA(kt * 16 + 4 * (lane >> 4) + r) ? sA[kt][r] : NEGM;
    }
    if (!fullB) {
#pragma unroll
        for (int kt = 0; kt < 4; ++kt)
#pragma unroll
            for (int r = 0; r < 4; ++r) sB[kt][r] = validB(kt * 16 + 4 * (lane >> 4) + r) ? sB[kt][r] : NEGM;
    }
    float mxA = fmaxf(fmaxf(fmaxf(sA[0][0], sA[0][1]), fmaxf(sA[0][2], sA[0][3])), fmaxf(fmaxf(sA[1][0], sA[1][1]), fmaxf(sA[1][2], sA[1][3])));
    float mxB = fmaxf(fmaxf(fmaxf(sB[0][0], sB[0][1]), fmaxf(sB[0][2], sB[0][3])), fmaxf(fmaxf(sB[1][0], sB[1][1]), fmaxf(sB[1][2], sB[1][3])));
    mxA = fmaxf(mxA, fmaxf(fmaxf(fmaxf(sA[2][0], sA[2][1]), fmaxf(sA[2][2], sA[2][3])), fmaxf(fmaxf(sA[3][0], sA[3][1]), fmaxf(sA[3][2], sA[3][3]))));
    mxB = fmaxf(mxB, fmaxf(fmaxf(fmaxf(sB[2][0], sB[2][1]), fmaxf(sB[2][2], sB[2][3])), fmaxf(fmaxf(sB[3][0], sB[3][1]), fmaxf(sB[3][2], sB[3][3]))));
    mxA = xrow_max(mxA); mxB = xrow_max(mxB);
    if (!__all(mokA && mokB && (mxA <= 8.f) && (mxB <= 8.f))) {
        const float mnA = fmaxf(mA, meA + mxA), mnB = fmaxf(mB, meB + mxB);
        const float alA = __builtin_amdgcn_exp2f(mA - mnA), alB = __builtin_amdgcn_exp2f(mB - mnB);
        const float dA = mnA - meA, dB = mnB - meB;
        mA = mnA; mB = mnB; lA[0] *= alA; lB[0] *= alB;
#pragma unroll
        for (int dt = 0; dt < 4; ++dt) {
            oA[dt][0] *= alA; oA[dt][1] *= alA; oA[dt][2] *= alA; oA[dt][3] *= alA;
            oB[dt][0] *= alB; oB[dt][1] *= alB; oB[dt][2] *= alB; oB[dt][3] *= alB;
        }
#pragma unroll
        for (int kt = 0; kt < 4; ++kt) {
            sA[kt][0] -= dA; sA[kt][1] -= dA; sA[kt][2] -= dA; sA[kt][3] -= dA;
            sB[kt][0] -= dB; sB[kt][1] -= dB; sB[kt][2] -= dB; sB[kt][3] -= dB;
        }
    }
#pragma unroll
    for (int kt = 0; kt < 4; ++kt)
#pragma unroll
        for (int r = 0; r < 4; ++r) { sA[kt][r] = __builtin_amdgcn_exp2f(sA[kt][r]); sB[kt][r] = __builtin_amdgcn_exp2f(sB[kt][r]); }
#pragma unroll
    for (int k2 = 0; k2 < 2; ++k2) {
        uint4 pk;
        pk.x = pack2bf(sA[2 * k2][0], sA[2 * k2][1]); pk.y = pack2bf(sA[2 * k2][2], sA[2 * k2][3]);
        pk.z = pack2bf(sA[2 * k2 + 1][0], sA[2 * k2 + 1][1]); pk.w = pack2bf(sA[2 * k2 + 1][2], sA[2 * k2 + 1][3]);
        const bf16x8 pbA = __builtin_bit_cast(bf16x8, pk);
        pk.x = pack2bf(sB[2 * k2][0], sB[2 * k2][1]); pk.y = pack2bf(sB[2 * k2][2], sB[2 * k2][3]);
        pk.z = pack2bf(sB[2 * k2 + 1][0], sB[2 * k2 + 1][1]); pk.w = pack2bf(sB[2 * k2 + 1][2], sB[2 * k2 + 1][3]);
        const bf16x8 pbB = __builtin_bit_cast(bf16x8, pk);
        lA = __builtin_amdgcn_mfma_f32_16x16x32_bf16(ONES_BF16X8, pbA, lA, 0, 0, 0);
        lB = __builtin_amdgcn_mfma_f32_16x16x32_bf16(ONES_BF16X8, pbB, lB, 0, 0, 0);
#define PV2(dt_, vb_) { const uint2 lo_ = tr_read(Vl + (vb_) + k2 * 4096), hi_ = tr_read(Vl + (vb_) + k2 * 4096 + 2048); \
                        uint4 av_; av_.x = lo_.x; av_.y = lo_.y; av_.z = hi_.x; av_.w = hi_.y;                          \
                        oA[dt_] = __builtin_amdgcn_mfma_f32_16x16x32_bf16(__builtin_bit_cast(bf16x8, av_), pbA, oA[dt_], 0, 0, 0); \
                        oB[dt_] = __builtin_amdgcn_mfma_f32_16x16x32_bf16(__builtin_bit_cast(bf16x8, av_), pbB, oB[dt_], 0, 0, 0); }
        PV2(0, f.vb0) PV2(1, f.vb1) PV2(2, f.vb2) PV2(3, f.vb3)
#undef PV2
    }
}

#define NSA_TILES 2048
__device__ __forceinline__ void nsa_tile(const Params& p, int tile, unsigned char* smem) {
    const int tid = opaque_tid(), lane = tid & 63, w = __builtin_amdgcn_readfirstlane(tid >> 6);
    const int bg = tile & 7, tb = 255 - (tile >> 3);
    const int b = bg >> 1, g = bg & 1;
    const int t0 = tb * 32, cur = t0 >> 6;
    float* impL = (float*)(smem + 32768);
    unsigned* selL = (unsigned*)(smem + 49152);
    const bf16_t* NQ = (const bf16_t*)(p.ws + OFF_NQ);
    const float* NG = (const float*)(p.ws + OFF_NGATE);
    const int rowq = lane & 15, tl = rowq >> 2, head = rowq & 3, lg = lane >> 4;
    const int toklA = 8 * w + tl, toklB = 8 * w + 4 + tl;
    const LaneOfs lof = make_lane_ofs(lane);
    const StageOfs sof = make_stage_ofs();
    const size_t tokb = (size_t)b * SEQ + t0;
    bf16x8 qA0, qA1, qB0, qB1;
    {
        const bf16_t* qp = NQ + (tokb + toklA) * 512 + g * 256 + head * 64 + lg * 8;
        qA0 = *(const bf16x8*)qp; qA1 = *(const bf16x8*)(qp + 32);
        qB0 = *(const bf16x8*)(qp + 4 * 512); qB1 = *(const bf16x8*)(qp + 4 * 512 + 32);
    }
    const float* gpA = NG + (tokb + toklA) * 24 + g * 12 + head * 3;
    const float* gpB = gpA + 4 * 24;
    __syncthreads();
    for (int i = tid; i < 4096; i += 256) impL[i] = 0.f;
    const int tqA = t0 + toklA, tqB = t0 + toklB;
    const int tminA = t0 + 8 * w, tminB = tminA + 4;
    f32x4 oA[4], oB[4], otA[4], otB[4];
    float mA, mB;
    f32x4 lA, lB;
#define NSA_RESET() { _Pragma("unroll") for (int dt = 0; dt < 4; ++dt) { oA[dt] = (f32x4){0.f, 0.f, 0.f, 0.f}; oB[dt] = (f32x4){0.f, 0.f, 0.f, 0.f}; } \
                      mA = -1e30f; mB = -1e30f; lA = (f32x4){0.f, 0.f, 0.f, 0.f}; lB = (f32x4){0.f, 0.f, 0.f, 0.f}; }
#define NSA_LSUM() { }

    const int nvA = (tqA >= 31) ? (((tqA - 31) >> 4) + 1) : 0;
    const int nvB = (tqB >= 31) ? (((tqB - 31) >> 4) + 1) : 0;
    const int nvminA = (tminA >= 31) ? (((tminA - 31) >> 4) + 1) : 0;
    const int nvminB = (tminB >= 31) ? (((tminB - 31) >> 4) + 1) : 0;
    const int nkb = (((t0 >> 4) + 1) + 63) >> 6;
    const bf16_t* ckb = (const bf16_t*)(p.ws + OFF_CMPKB) + (size_t)(b * 2 + g) * 512 * 64;
    const bf16_t* cvb = (const bf16_t*)(p.ws + OFF_CMPVB) + (size_t)(b * 2 + g) * 512 * 64;
    NSA_RESET()
    nsa_kv_loop(ckb, cvb, 64, 0, nkb - 1, smem, sof, [&](int kb, const unsigned char* Kl, const unsigned char* Vl) __attribute__((always_inline)) {
        attn_step2(Kl, Vl, lane, lof,
                   qA0, qA1, oA, mA, lA, 0.f, kb * 64 + 64 <= nvminA, [&](int key) __attribute__((always_inline)) { return kb * 64 + key < nvA; },
                   qB0, qB1, oB, mB, lB, 0.f, kb * 64 + 64 <= nvminB, [&](int key) __attribute__((always_inline)) { return kb * 64 + key < nvB; });
    });
    NSA_LSUM()
    const float mcA = mA, mcB = mB;
    const float invcA = 1.f / fmaxf(lA[0], 1e-30f), invcB = 1.f / fmaxf(lB[0], 1e-30f);
    {
        const float fA = gpA[0] * invcA, fB = gpB[0] * invcB;
#pragma unroll
        for (int dt = 0; dt < 4; ++dt) {
            otA[dt][0] = fA * oA[dt][0]; otA[dt][1] = fA * oA[dt][1]; otA[dt][2] = fA * oA[dt][2]; otA[dt][3] = fA * oA[dt][3];
            otB[dt][0] = fB * oB[dt][0]; otB[dt][1] = fB * oB[dt][1]; otB[dt][2] = fB * oB[dt][2]; otB[dt][3] = fB * oB[dt][3];
        }
    }
    if (cur >= 16) {
        nsa_kv_loop(ckb, cvb, 64, 0, nkb - 1, smem, sof, [&](int kb, const unsigned char* Kl, const unsigned char* Vl) __attribute__((always_inline)) {
#pragma unroll
            for (int mt = 0; mt < 2; ++mt) {
                f32x4 s[4];
                nsa_scores(Kl, lof, mt ? qB0 : qA0, mt ? qB1 : qA1, 0.f, s);
                const int nv = mt ? nvB : nvA;
                const float mc = mt ? mcB : mcA, inv = mt ? invcB : invcA;
                float* impT = impL + (mt ? toklB : toklA) * 128;
#pragma unroll
                for (int kt = 0; kt < 4; ++kt) {
                    float pr[4];
#pragma unroll
                    for (int r = 0; r < 4; ++r) {
                        const int n = kb * 64 + kt * 16 + 4 * lg + r;
                        pr[r] = (n < nv) ? __builtin_amdgcn_exp2f(s[kt][r] - mc) * inv : 0.f;
                    }
                    float c1 = pr[0] + pr[1] + pr[2] + 0.5f * pr[3], c2 = 0.5f * pr[3];
                    c1 += __shfl_xor(c1, 1); c1 += __shfl_xor(c1, 2);
                    c2 += __shfl_xor(c2, 1); c2 += __shfl_xor(c2, 2);
                    const int j = kb * 16 + kt * 4 + lg;
                    if (head == 0) {
                        atomicAdd(&impT[j], c1);
                        if (j + 1 < 128) atomicAdd(&impT[j + 1], c2);
                    }
                }
                    }
        });
#pragma unroll 1
        for (int pass = 0; pass < 2; ++pass) {
            const int tok = 8 * w + 4 * pass + lg, c = lane & 15;
            const float4 i0 = *(const float4*)(impL + tok * 128 + 8 * c), i1 = *(const float4*)(impL + tok * 128 + 8 * c + 4);
            const float iv[8] = {i0.x, i0.y, i0.z, i0.w, i1.x, i1.y, i1.z, i1.w};
            float kl[8];
#pragma unroll
            for (int q = 0; q < 8; ++q) {
                const int j = 8 * c + q;
                const bool forced = (j == 0) || (j == cur) || (j == cur - 1);
                const float sc = forced ? 1.0e4f : ((j <= cur) ? iv[q] : -1.f);
                kl[q] = enc_key(sc, (unsigned)j, 127);
            }
            float l0 = kl[0], l1 = kl[1], l2 = kl[2], l3 = kl[3], l4 = kl[4], l5 = kl[5], l6 = kl[6], l7 = kl[7];
            CE_DESC(l0, l1) CE_DESC(l2, l3) CE_DESC(l4, l5) CE_DESC(l6, l7)
            CE_DESC(l0, l2) CE_DESC(l1, l3) CE_DESC(l4, l6) CE_DESC(l5, l7)
            CE_DESC(l1, l2) CE_DESC(l5, l6)
            CE_DESC(l0, l4) CE_DESC(l1, l5) CE_DESC(l2, l6) CE_DESC(l3, l7)
            CE_DESC(l2, l4) CE_DESC(l3, l5)
            CE_DESC(l1, l2) CE_DESC(l3, l4) CE_DESC(l5, l6)
            unsigned pm = 0u;
#pragma unroll
            for (int k = 0; k < 16; ++k) {
                const float mx = row16_max(l0);
                const bool win = (l0 == mx);
                pm |= win ? (1u << (dec_idx(l0, 127) & 7u)) : 0u;
                l0 = win ? l1 : l0; l1 = win ? l2 : l1; l2 = win ? l3 : l2; l3 = win ? l4 : l3;
                l4 = win ? l5 : l4; l5 = win ? l6 : l5; l6 = win ? l7 : l6; l7 = win ? NEGKEY : l7;
            }
            ((unsigned char*)selL)[tok * 16 + c] = (unsigned char)pm;
        }
    } else {
        if (lane < 8) {
            const int tok = 8 * w + lane;
            selL[tok * 4 + 0] = (2u << cur) - 1u; selL[tok * 4 + 1] = 0u; selL[tok * 4 + 2] = 0u; selL[tok * 4 + 3] = 0u;
        }
    }
    WAVE_LDS_SYNC();
#if NSA_DIAG
    if (head == 0 && lg == 0) {
        unsigned* SELM = (unsigned*)(p.ws + OFF_SELM);
#pragma unroll
        for (int qd = 0; qd < 4; ++qd) {
            SELM[((size_t)bg * SEQ + tqA) * 4 + qd] = selL[toklA * 4 + qd];
            SELM[((size_t)bg * SEQ + tqB) * 4 + qd] = selL[toklB * 4 + qd];
        }
    }
#endif
    NSA_RESET()
    {
        const bf16_t* kg = (const bf16_t*)(p.ws + OFF_KV + 2 * KV_STRIDE) + (size_t)b * SEQ * 128 + g * 64;
        const bf16_t* vg = (const bf16_t*)(p.ws + OFF_KV + 3 * KV_STRIDE) + (size_t)b * SEQ * 128 + g * 64;
        nsa_kv_loop(kg, vg, 128, 0, cur, smem, sof, [&](int kb, const unsigned char* Kl, const unsigned char* Vl) __attribute__((always_inline)) {
            const bool svA = (selL[toklA * 4 + (kb >> 5)] >> (kb & 31)) & 1u;
            const bool svB = (selL[toklB * 4 + (kb >> 5)] >> (kb & 31)) & 1u;
            const bool nA = __ballot(svA) != 0ull, nB = __ballot(svB) != 0ull;
            if (nA && nB)
                attn_step2(Kl, Vl, lane, lof,
                           qA0, qA1, oA, mA, lA, svA ? 0.f : NEGM, kb < cur, [&](int key) __attribute__((always_inline)) { return kb * 64 + key <= tqA; },
                           qB0, qB1, oB, mB, lB, svB ? 0.f : NEGM, kb < cur, [&](int key) __attribute__((always_inline)) { return kb * 64 + key <= tqB; });
            else if (nA)
                attn_step(Kl, Vl, lane, lof, qA0, qA1, oA, mA, lA, svA ? 0.f : NEGM, kb < cur, [&](int key) __attribute__((always_inline)) { return kb * 64 + key <= tqA; });
            else if (nB)
                attn_step(Kl, Vl, lane, lof, qB0, qB1, oB, mB, lB, svB ? 0.f : NEGM, kb < cur, [&](int key) __attribute__((always_inline)) { return kb * 64 + key <= tqB; });
        });
    }
    NSA_LSUM()
    {
        const float fA = gpA[1] / fmaxf(lA[0], 1e-30f), fB = gpB[1] / fmaxf(lB[0], 1e-30f);
#pragma unroll
        for (int dt = 0; dt < 4; ++dt) {
            otA[dt][0] += fA * oA[dt][0]; otA[dt][1] += fA * oA[dt][1]; otA[dt][2] += fA * oA[dt][2]; otA[dt][3] += fA * oA[dt][3];
            otB[dt][0] += fB * oB[dt][0]; otB[dt][1] += fB * oB[dt][1]; otB[dt][2] += fB * oB[dt][2]; otB[dt][3] += fB * oB[dt][3];
        }
    }
    NSA_RESET()
    {
        const bf16_t* kg = (const bf16_t*)(p.ws + OFF_KV + 4 * KV_STRIDE) + (size_t)b * SEQ * 128 + g * 64;
        const bf16_t* vg = (const bf16_t*)(p.ws + OFF_KV + 5 * KV_STRIDE) + (size_t)b * SEQ * 128 + g * 64;
        const int klo = (t0 > 511) ? ((t0 - 511) >> 6) : 0;
        nsa_kv_loop(kg, vg, 128, klo, cur, smem, sof, [&](int kb, const unsigned char* Kl, const unsigned char* Vl) __attribute__((always_inline)) {
            attn_step2(Kl, Vl, lane, lof,
                       qA0, qA1, oA, mA, lA, 0.f, (kb * 64 >= tminA + 3 - 511) && (kb * 64 + 63 <= tminA),
                       [&](int key) __attribute__((always_inline)) { const int ka = kb * 64 + key; return (ka <= tqA) && (ka >= tqA - 511); },
                       qB0, qB1, oB, mB, lB, 0.f, (kb * 64 >= tminB + 3 - 511) && (kb * 64 + 63 <= tminB),
                       [&](int key) __attribute__((always_inline)) { const int ka = kb * 64 + key; return (ka <= tqB) && (ka >= tqB - 511); });
        });
    }
    NSA_LSUM()
    {
        const float fA = gpA[2] / fmaxf(lA[0], 1e-30f), fB = gpB[2] / fmaxf(lB[0], 1e-30f);
        bf16_t* MIX = (bf16_t*)(p.ws + OFF_XB) + (tokb + toklA) * DM + 512 + g * 256 + head * 64 + lg * 4;
#pragma unroll
        for (int dt = 0; dt < 4; ++dt) {
            uint2 ov;
            ov.x = pack2bf(otA[dt][0] + fA * oA[dt][0], otA[dt][1] + fA * oA[dt][1]);
            ov.y = pack2bf(otA[dt][2] + fA * oA[dt][2], otA[dt][3] + fA * oA[dt][3]);
            *(uint2*)(MIX + dt * 16) = ov;
            ov.x = pack2bf(otB[dt][0] + fB * oB[dt][0], otB[dt][1] + fB * oB[dt][1]);
            ov.y = pack2bf(otB[dt][2] + fB * oB[dt][2], otB[dt][3] + fB * oB[dt][3]);
            *(uint2*)(MIX + 4 * DM + dt * 16) = ov;
        }
    }
#undef NSA_RESET
#undef NSA_LSUM
}

__device__ __forceinline__ float block_sum(float v, float* red) {
    v = wave_sum(v);
    __syncthreads();
    if ((threadIdx.x & 63) == 0) red[threadIdx.x >> 6] = v;
    __syncthreads();
    return red[0] + red[1] + red[2] + red[3];
}
__device__ __forceinline__ float4 ln_row(float4 y, const float* g, const float* bb, float* red) {
    const int tid = opaque_tid();
    const float mu = block_sum(y.x + y.y + y.z + y.w, red) * (1.f / 1024.f);
    const float dx = y.x - mu, dy = y.y - mu, dz = y.z - mu, dw = y.w - mu;
    const float var = block_sum(dx * dx + dy * dy + dz * dz + dw * dw, red) * (1.f / 1024.f);
    const float rs = rsqrtf(var + LN_EPS);
    const float4 gg = ((const float4*)g)[tid], b4 = ((const float4*)bb)[tid];
    return make_float4(dx * rs * gg.x + b4.x, dy * rs * gg.y + b4.y, dz * rs * gg.z + b4.z, dw * rs * gg.w + b4.w);
}

__device__ __forceinline__ void ln1_phase(const Params& p, float* sm) {
    const int tid = opaque_tid(), lane = tid & 63, w = __builtin_amdgcn_readfirstlane(tid >> 6);
    const float4* g4 = (const float4*)(p.in[15] + 16 * lane);
    const float4* b4 = (const float4*)(p.in[16] + 16 * lane);
    const float4 ga = g4[0], gb = g4[1], gc = g4[2], gd = g4[3];
    const float4 ba = b4[0], bb = b4[1], bc = b4[2], bd = b4[3];
#pragma unroll 4
    for (int n = blockIdx.x * 4 + w; n < NTOK; n += gridDim.x * 4) {
        const float4* xr = (const float4*)(p.in[0] + (size_t)n * DM + 16 * lane);
        const uint4* mr = (const uint4*)((const bf16_t*)p.out + (size_t)n * DM + 16 * lane);
        const float4 y0 = xr[0], y1 = xr[1], y2 = xr[2], y3 = xr[3];
        const uint4 m0 = mr[0], m1 = mr[1];
        float y[16] = {ALPHA * y0.x + bf2f(m0.x & 0xffffu), ALPHA * y0.y + bf2f(m0.x >> 16), ALPHA * y0.z + bf2f(m0.y & 0xffffu), ALPHA * y0.w + bf2f(m0.y >> 16),
                       ALPHA * y1.x + bf2f(m0.z & 0xffffu), ALPHA * y1.y + bf2f(m0.z >> 16), ALPHA * y1.z + bf2f(m0.w & 0xffffu), ALPHA * y1.w + bf2f(m0.w >> 16),
                       ALPHA * y2.x + bf2f(m1.x & 0xffffu), ALPHA * y2.y + bf2f(m1.x >> 16), ALPHA * y2.z + bf2f(m1.y & 0xffffu), ALPHA * y2.w + bf2f(m1.y >> 16),
                       ALPHA * y3.x + bf2f(m1.z & 0xffffu), ALPHA * y3.y + bf2f(m1.z >> 16), ALPHA * y3.z + bf2f(m1.w & 0xffffu), ALPHA * y3.w + bf2f(m1.w >> 16)};
        const float g[16] = {ga.x, ga.y, ga.z, ga.w, gb.x, gb.y, gb.z, gb.w, gc.x, gc.y, gc.z, gc.w, gd.x, gd.y, gd.z, gd.w};
        const float bv[16] = {ba.x, ba.y, ba.z, ba.w, bb.x, bb.y, bb.z, bb.w, bc.x, bc.y, bc.z, bc.w, bd.x, bd.y, bd.z, bd.w};
        float sum = 0.f;
#pragma unroll
        for (int q = 0; q < 16; ++q) sum += y[q];
        const float mu = wave_sum(sum) * (1.f / 1024.f);
        float sq = 0.f;
#pragma unroll
        for (int q = 0; q < 16; ++q) { y[q] -= mu; sq += y[q] * y[q]; }
        const float rs = rsqrtf(wave_sum(sq) * (1.f / 1024.f) + LN_EPS);
        uint4 o0, o1;
        o0.x = pack2bf(y[0] * rs * g[0] + bv[0], y[1] * rs * g[1] + bv[1]);     o0.y = pack2bf(y[2] * rs * g[2] + bv[2], y[3] * rs * g[3] + bv[3]);
        o0.z = pack2bf(y[4] * rs * g[4] + bv[4], y[5] * rs * g[5] + bv[5]);     o0.w = pack2bf(y[6] * rs * g[6] + bv[6], y[7] * rs * g[7] + bv[7]);
        o1.x = pack2bf(y[8] * rs * g[8] + bv[8], y[9] * rs * g[9] + bv[9]);     o1.y = pack2bf(y[10] * rs * g[10] + bv[10], y[11] * rs * g[11] + bv[11]);
        o1.z = pack2bf(y[12] * rs * g[12] + bv[12], y[13] * rs * g[13] + bv[13]); o1.w = pack2bf(y[14] * rs * g[14] + bv[14], y[15] * rs * g[15] + bv[15]);
        uint4* hb = (uint4*)((bf16_t*)(p.ws + OFF_XB) + (size_t)n * DM + 16 * lane);
        hb[0] = o0; hb[1] = o1;
    }
}


typedef float f32x2 __attribute__((ext_vector_type(2)));
__device__ __forceinline__ void cvt_rows_fp8(const float* __restrict__ src, unsigned char* __restrict__ dst, float* __restrict__ scales, int rows,
                                             int first_block, int nblocks) {
    const int tid_ = opaque_tid(), lane = tid_ & 63, w = __builtin_amdgcn_readfirstlane(tid_ >> 6);
    for (int r = ((int)blockIdx.x - first_block) * 4 + w; r < rows; r += nblocks * 4) {
        const float4* sp = (const float4*)(src + (size_t)r * 1024 + lane * 16);
        const float4 a = sp[0], b = sp[1], c = sp[2], d = sp[3];
        float mx = fmaxf(fmaxf(fmaxf(fabsf(a.x), fabsf(a.y)), fmaxf(fabsf(a.z), fabsf(a.w))), fmaxf(fmaxf(fabsf(b.x), fabsf(b.y)), fmaxf(fabsf(b.z), fabsf(b.w))));
        mx = fmaxf(mx, fmaxf(fmaxf(fmaxf(fabsf(c.x), fabsf(c.y)), fmaxf(fabsf(c.z), fabsf(c.w))), fmaxf(fmaxf(fabsf(d.x), fabsf(d.y)), fmaxf(fabsf(d.z), fabsf(d.w)))));
        mx = wave_max(mx);
        const float sc = (mx > 0.f) ? mx * (1.f / 448.f) : 1.f;
        const float inv = 1.f / sc;
        uint4 o;
        int t;
        t = 0; t = __builtin_amdgcn_cvt_pk_fp8_f32(a.x * inv, a.y * inv, t, false); t = __builtin_amdgcn_cvt_pk_fp8_f32(a.z * inv, a.w * inv, t, true); o.x = (unsigned)t;
        t = 0; t = __builtin_amdgcn_cvt_pk_fp8_f32(b.x * inv, b.y * inv, t, false); t = __builtin_amdgcn_cvt_pk_fp8_f32(b.z * inv, b.w * inv, t, true); o.y = (unsigned)t;
        t = 0; t = __builtin_amdgcn_cvt_pk_fp8_f32(c.x * inv, c.y * inv, t, false); t = __builtin_amdgcn_cvt_pk_fp8_f32(c.z * inv, c.w * inv, t, true); o.z = (unsigned)t;
        t = 0; t = __builtin_amdgcn_cvt_pk_fp8_f32(d.x * inv, d.y * inv, t, false); t = __builtin_amdgcn_cvt_pk_fp8_f32(d.z * inv, d.w * inv, t, true); o.w = (unsigned)t;
        *(uint4*)(dst + (size_t)r * 1024 + lane * 16) = o;
        if (lane == 0) scales[r] = sc;
    }
}

__device__ __forceinline__ unsigned pack4i8(float a, float b, float c, float d) {
    const int ia = (int)rintf(a), ib = (int)rintf(b), ic = (int)rintf(c), id = (int)rintf(d);
    return (unsigned)(ia & 255) | ((unsigned)(ib & 255) << 8) | ((unsigned)(ic & 255) << 16) | ((unsigned)id << 24);
}
__device__ __forceinline__ void cvt_rows_i8(const float* __restrict__ src, unsigned char* __restrict__ dst, float* __restrict__ scales, int rows,
                                            int first_block, int nblocks) {
    const int tid_ = opaque_tid(), lane = tid_ & 63, w = __builtin_amdgcn_readfirstlane(tid_ >> 6);
    for (int r = ((int)blockIdx.x - first_block) * 4 + w; r < rows; r += nblocks * 4) {
        const float4* sp = (const float4*)(src + (size_t)r * 1024 + lane * 16);
        const float4 a = sp[0], b = sp[1], c = sp[2], d = sp[3];
        float mx = fmaxf(fmaxf(fmaxf(fabsf(a.x), fabsf(a.y)), fmaxf(fabsf(a.z), fabsf(a.w))), fmaxf(fmaxf(fabsf(b.x), fabsf(b.y)), fmaxf(fabsf(b.z), fabsf(b.w))));
        mx = fmaxf(mx, fmaxf(fmaxf(fmaxf(fabsf(c.x), fabsf(c.y)), fmaxf(fabsf(c.z), fabsf(c.w))), fmaxf(fmaxf(fabsf(d.x), fabsf(d.y)), fmaxf(fabsf(d.z), fabsf(d.w)))));
        mx = wave_max(mx);
        const float sc = (mx > 0.f) ? mx * (1.f / 127.f) : 1.f;
        const float inv = 1.f / sc;
        uint4 o;
        o.x = pack4i8(a.x * inv, a.y * inv, a.z * inv, a.w * inv); o.y = pack4i8(b.x * inv, b.y * inv, b.z * inv, b.w * inv);
        o.z = pack4i8(c.x * inv, c.y * inv, c.z * inv, c.w * inv); o.w = pack4i8(d.x * inv, d.y * inv, d.z * inv, d.w * inv);
        *(uint4*)(dst + (size_t)r * 1024 + lane * 16) = o;
        if (lane == 0) scales[r] = sc;
    }
}

__device__ __forceinline__ void fold_ws_phase(const float* __restrict__ wq, const float* __restrict__ k1, const float* __restrict__ k2,
                                              bf16_t* __restrict__ WsT) {
    const int tid_ = opaque_tid(), lane = tid_ & 63, w = __builtin_amdgcn_readfirstlane(tid_ >> 6);
    const int l31 = lane & 31, hi = lane >> 5;
    for (int tile = blockIdx.x * 4 + w; tile < 16 * 4 * 32; tile += gridDim.x * 4) {
        const int kt = tile & 31, jt = (tile >> 5) & 3, ha = tile >> 7;
        const float* kr = ((ha & 1) ? k2 : k1) + (size_t)(jt * 32 + l31) * 128;
        const float* wr = wq + (size_t)(kt * 32 + l31) * 2048 + ha * 128;
        f32x16 acc;
#pragma unroll
        for (int r = 0; r < 16; ++r) acc[r] = 0.f;
#pragma unroll 4
        for (int d0 = 0; d0 < 128; d0 += 8) {
            const float4 ka = *(const float4*)(kr + d0), kb = *(const float4*)(kr + d0 + 4);
            const float4 wa = *(const float4*)(wr + d0), wb = *(const float4*)(wr + d0 + 4);
            acc = __builtin_amdgcn_mfma_f32_32x32x2f32(hi ? ka.y : ka.x, hi ? wa.y : wa.x, acc, 0, 0, 0);
            acc = __builtin_amdgcn_mfma_f32_32x32x2f32(hi ? ka.w : ka.z, hi ? wa.w : wa.z, acc, 0, 0, 0);
            acc = __builtin_amdgcn_mfma_f32_32x32x2f32(hi ? kb.y : kb.x, hi ? wb.y : wb.x, acc, 0, 0, 0);
            acc = __builtin_amdgcn_mfma_f32_32x32x2f32(hi ? kb.w : kb.z, hi ? wb.w : wb.z, acc, 0, 0, 0);
        }
        bf16_t* dst = WsT + (size_t)(ha * 128 + jt * 32) * 1024 + kt * 32 + l31;
#pragma unroll
        for (int r = 0; r < 16; ++r) {
            const int i = (r & 3) + 8 * (r >> 2) + 4 * hi;
            dst[(size_t)i * 1024] = (bf16_t)f2bf(acc[r]);
        }
    }
}


struct EpiTop16 {
    static constexpr bool kRow = false;
    float* topk; unsigned char* lds;
    __device__ __forceinline__ void operator()(int m, int n, f32x4 v) const {
        const int ml = m & 127, g4 = (n & 127) >> 2;
        *(float4*)(lds + ((ml * 32 + (g4 ^ (ml & 7))) << 4)) = make_float4(v[0], v[1], v[2], v[3]);
    }
    template <class F> __device__ __forceinline__ void dispatch(int, F f) const { f(*this); }
    __device__ __forceinline__ void finish(int m0, int n0) const {
        __syncthreads();
        const int tid_ = opaque_tid(), lane = tid_ & 63, w = __builtin_amdgcn_readfirstlane(tid_ >> 6), c = lane & 15;
        const int L = n0 >> 7;
#pragma unroll 2
        for (int it = 0; it < 8; ++it) {
            const int r = w * 32 + it * 4 + (lane >> 4);
            const float4 x0 = *(const float4*)(lds + ((r * 32 + ((2 * c) ^ (r & 7))) << 4));
            const float4 x1 = *(const float4*)(lds + ((r * 32 + ((2 * c + 1) ^ (r & 7))) << 4));
            float l0 = enc_key(x0.x, 8 * c + 0, 127), l1 = enc_key(x0.y, 8 * c + 1, 127), l2 = enc_key(x0.z, 8 * c + 2, 127),
                  l3 = enc_key(x0.w, 8 * c + 3, 127), l4 = enc_key(x1.x, 8 * c + 4, 127), l5 = enc_key(x1.y, 8 * c + 5, 127),
                  l6 = enc_key(x1.z, 8 * c + 6, 127), l7 = enc_key(x1.w, 8 * c + 7, 127);
            CE_DESC(l0, l1) CE_DESC(l2, l3) CE_DESC(l4, l5) CE_DESC(l6, l7)
            CE_DESC(l0, l2) CE_DESC(l1, l3) CE_DESC(l4, l6) CE_DESC(l5, l7)
            CE_DESC(l1, l2) CE_DESC(l5, l6)
            CE_DESC(l0, l4) CE_DESC(l1, l5) CE_DESC(l2, l6) CE_DESC(l3, l7)
            CE_DESC(l2, l4) CE_DESC(l3, l5)
            CE_DESC(l1, l2) CE_DESC(l3, l4) CE_DESC(l5, l6)
            float res = NEGKEY;
#pragma unroll
            for (int k = 0; k < 16; ++k) {
                const float mx = row16_max(l0);
                const bool win = (l0 == mx);
                l0 = win ? l1 : l0; l1 = win ? l2 : l1; l2 = win ? l3 : l2; l3 = win ? l4 : l3;
                l4 = win ? l5 : l4; l5 = win ? l6 : l5; l6 = win ? l7 : l6; l7 = win ? NEGKEY : l7;
                res = (c == k) ? mx : res;
            }
            topk[(size_t)(m0 + r) * 256 + L * 16 + c] = res;
        }
        __syncthreads();
    }
};

template <int PART>
__device__ __forceinline__ void peer_fast_phase(const Params& p, unsigned char* smem) {
    const int tid = opaque_tid(), lane = tid & 63, w = __builtin_amdgcn_readfirstlane(tid >> 6), l16 = lane & 15, gq = lane >> 4;
    float* tk = (float*)(smem + w * 2048);
    int* ex = (int*)(smem + w * 2048 + 1024);
    float* gw = (float*)(smem + w * 2048 + 1536);
    const bf16_t* H1B = (const bf16_t*)(p.ws + OFF_XB);
    const unsigned char* U8 = p.ws + OFF_UB;
    const unsigned char* V8 = p.ws + OFF_VB;
    const float* USC = (const float*)(p.ws + OFF_USC);
    const float* VSC = (const float*)(p.ws + OFF_VSC);
    const float* TOPK = (const float*)(p.ws + OFF_TOPK);
    int ci[4], cj[4];
#pragma unroll
    for (int q = 0; q < 4; ++q) {
        const int s = l16 + 16 * q;
        int i, j;
        if (s < 16) { i = 0; j = s; }
        else if (s < 24) { i = 1; j = s - 16; }
        else if (s < 29) { i = 2; j = s - 24; }
        else if (s < 33) { i = 3; j = s - 29; }
        else if (s < 36) { i = 4; j = s - 33; }
        else if (s < 42) { i = 5 + ((s - 36) >> 1); j = (s - 36) & 1; }
        else if (s < 50) { i = 8 + (s - 42); j = 0; }
        else { i = -1; j = 0; }
        ci[q] = i; cj[q] = j;
    }
    int* exs = (int*)(smem + 8192 + w * 4096);
    float* gws = (float*)(smem + 8192 + w * 4096 + 2048);
    float* hraw = (float*)(smem + 24576 + w * 2048);
    float* xsc = (float*)(smem + w * 2048);
    int* SEX = (int*)(p.ws + OFF_HQ);
    float* SGW = (float*)(p.ws + OFF_HLF);
    uint4 pl0, pl1, pg0, pg1, px0, px1, px2, px3, px4, px5, px6, px7;
    if (PART != 0) {
        const int qf = blockIdx.x * 4 + w;
        if (qf < NTOK / 4) {
            const size_t nf = (size_t)qf * 4;
            pl0 = ((const uint4*)(SEX + nf * 128))[lane]; pl1 = ((const uint4*)(SEX + nf * 128))[lane + 64];
            pg0 = ((const uint4*)(SGW + nf * 128))[lane]; pg1 = ((const uint4*)(SGW + nf * 128))[lane + 64];
            if (PART == 1) {
                const uint4* xr = (const uint4*)(H1B + (nf + gq) * DM + 16 * l16);
                px0 = xr[0]; px1 = xr[1]; px2 = xr[32]; px3 = xr[33]; px4 = xr[64]; px5 = xr[65]; px6 = xr[96]; px7 = xr[97];
            }
        }
    }
    for (int qd = blockIdx.x * 4 + w; qd < NTOK / 4; qd += gridDim.x * 4) {
        const int n0 = qd * 4;
        if (PART == 0) {
        float4 tkn = ((const float4*)(TOPK + (size_t)n0 * 256))[lane];
#pragma unroll 1
        for (int t = 0; t < 4; ++t) {
            const int n = n0 + t;
            WAVE_LDS_SYNC();
            ((float4*)tk)[lane] = tkn;
            {
                int nn = (t < 3) ? n + 1 : (qd + (int)gridDim.x * 4) * 4;
                nn = (nn < NTOK) ? nn : n;
                tkn = ((const float4*)(TOPK + (size_t)nn * 256))[lane];
            }
            WAVE_LDS_SYNC();
#pragma unroll
            for (int it = 0; it < 2; ++it) {
                const int head = it * 4 + gq;
                const float* ka = tk + head * 32;
                const float* kb = ka + 16;
                float c0, c1, c2, c3;
#define MKC(q, cq) { if (ci[q] >= 0) { const float sum_ = dec_val(ka[ci[q]], 127) + dec_val(kb[cj[q]], 127); \
                         cq = enc_key(sum_, ci[q] * 16 + cj[q], 255); } else cq = NEGKEY; }
                MKC(0, c0) MKC(1, c1) MKC(2, c2) MKC(3, c3)
#undef MKC
                float res = NEGKEY;
#pragma unroll
                for (int k = 0; k < 16; ++k) {
                    const float mx = row16_max(fmaxf(fmaxf(c0, c1), fmaxf(c2, c3)));
                    c0 = (c0 == mx) ? NEGKEY : c0; c1 = (c1 == mx) ? NEGKEY : c1;
                    c2 = (c2 == mx) ? NEGKEY : c2; c3 = (c3 == mx) ? NEGKEY : c3;
                    res = (l16 == k) ? mx : res;
                }
                const unsigned cc = dec_idx(res, 255);
                const float val = dec_val(res, 255);
                const unsigned e1 = dec_idx(ka[cc >> 4], 127), e2 = dec_idx(kb[cc & 15], 127);
                const float m0 = row16_max(val);
                const float e = expf(val - m0);
                const float ssum = row16_sum(e);
                ex[head * 16 + l16] = (int)(e1 * 128 + e2);
                gw[head * 16 + l16] = e / ssum;
            }
            WAVE_LDS_SYNC();
            {
                const int e0 = ex[lane], e1v = ex[lane + 64];
                const float g0 = gw[lane], g1 = gw[lane + 64];
                const int s0 = e0 >> 11, s1 = e1v >> 11;
                const unsigned long long lt = (1ull << lane) - 1ull;
                int base = 0, p0 = 0, p1 = 0;
#pragma unroll
                for (int s = 0; s < 8; ++s) {
                    const unsigned long long m0 = __ballot(s0 == s), m1 = __ballot(s1 == s);
                    const int c0 = __popcll(m0), c1 = __popcll(m1);
                    if (s0 == s) p0 = base + __popcll(m0 & lt);
                    if (s1 == s) p1 = base + c0 + __popcll(m1 & lt);
                    base += c0 + c1;
                }
                exs[t * 128 + p0] = e0; gws[t * 128 + p0] = g0; exs[t * 128 + p1] = e1v; gws[t * 128 + p1] = g1;
            }
        }
        WAVE_LDS_SYNC();
#pragma unroll
        for (int i = 0; i < 2; ++i) {
            ((uint4*)(SEX + (size_t)n0 * 128))[lane + 64 * i] = ((const uint4*)exs)[lane + 64 * i];
            ((uint4*)(SGW + (size_t)n0 * 128))[lane + 64 * i] = ((const uint4*)gws)[lane + 64 * i];
        }
        } else {
        WAVE_LDS_SYNC();
        ((uint4*)exs)[lane] = pl0; ((uint4*)exs)[lane + 64] = pl1;
        ((uint4*)gws)[lane] = pg0; ((uint4*)gws)[lane + 64] = pg1;
        }
        uint4 cx0, cx1, cx2, cx3, cx4, cx5, cx6, cx7;
        if (PART != 0) {
            if (PART == 1) { cx0 = px0; cx1 = px1; cx2 = px2; cx3 = px3; cx4 = px4; cx5 = px5; cx6 = px6; cx7 = px7; }
            const int qn = (qd + (int)gridDim.x * 4 < NTOK / 4) ? qd + (int)gridDim.x * 4 : qd;
            const size_t nf = (size_t)qn * 4;
            pl0 = ((const uint4*)(SEX + nf * 128))[lane]; pl1 = ((const uint4*)(SEX + nf * 128))[lane + 64];
            pg0 = ((const uint4*)(SGW + nf * 128))[lane]; pg1 = ((const uint4*)(SGW + nf * 128))[lane + 64];
            if (PART == 1) {
                const uint4* xr = (const uint4*)(H1B + (nf + gq) * DM + 16 * l16);
                px0 = xr[0]; px1 = xr[1]; px2 = xr[32]; px3 = xr[33]; px4 = xr[64]; px5 = xr[65]; px6 = xr[96]; px7 = xr[97];
            }
        }
        if (PART == 1) {
        WAVE_LDS_SYNC();
        {
            int xq[16];
            {
                uint4 xa0 = cx0, xb0 = cx1, xa1 = cx2, xb1 = cx3, xa2 = cx4, xb2 = cx5, xa3 = cx6, xb3 = cx7;
#define BLO(u_) __uint_as_float((u_) << 16)
#define BHI(u_) __uint_as_float((u_) & 0xffff0000u)
#define AMX4(v_) fmaxf(fmaxf(fmaxf(fabsf(BLO((v_).x)), fabsf(BHI((v_).x))), fmaxf(fabsf(BLO((v_).y)), fabsf(BHI((v_).y)))),                  \
                       fmaxf(fmaxf(fabsf(BLO((v_).z)), fabsf(BHI((v_).z))), fmaxf(fabsf(BLO((v_).w)), fabsf(BHI((v_).w)))))
                float mx = fmaxf(fmaxf(fmaxf(AMX4(xa0), AMX4(xb0)), fmaxf(AMX4(xa1), AMX4(xb1))), fmaxf(fmaxf(AMX4(xa2), AMX4(xb2)), fmaxf(AMX4(xa3), AMX4(xb3))));
                mx = row16_max(mx);
                const float xs = (mx > 0.f) ? mx * (1.f / 127.f) : 1.f;
                const float inv = 1.f / xs;
                xsc[gq] = xs;
#define Q8(i_, va_, vb_) { xq[4 * (i_) + 0] = (int)pack4i8(BLO((va_).x) * inv, BHI((va_).x) * inv, BLO((va_).y) * inv, BHI((va_).y) * inv);   \
                           xq[4 * (i_) + 1] = (int)pack4i8(BLO((va_).z) * inv, BHI((va_).z) * inv, BLO((va_).w) * inv, BHI((va_).w) * inv);   \
                           xq[4 * (i_) + 2] = (int)pack4i8(BLO((vb_).x) * inv, BHI((vb_).x) * inv, BLO((vb_).y) * inv, BHI((vb_).y) * inv);   \
                           xq[4 * (i_) + 3] = (int)pack4i8(BLO((vb_).z) * inv, BHI((vb_).z) * inv, BLO((vb_).w) * inv, BHI((vb_).w) * inv); }
                Q8(0, xa0, xb0) Q8(1, xa1, xb1) Q8(2, xa2, xb2) Q8(3, xa3, xb3)
#undef Q8
#undef AMX4
#undef BLO
#undef BHI
            }
            uint4 ra0, ra1, ra2, ra3, rb0, rb1, rb2, rb3, rc0, rc1, rc2, rc3, rd0, rd1, rd2, rd3;
#define ULOAD(S, kk) { const int e_ = exs[gq * 128 + (kk)]; const uint4* ur_ = (const uint4*)(U8 + (size_t)e_ * DM + 16 * l16);          \
                       S##0 = ur_[0]; S##1 = ur_[16]; S##2 = ur_[32]; S##3 = ur_[48]; }
#define D4(W_, B_) { sA = __builtin_amdgcn_sdot4((int)(W_).x, xq[(B_)], sA, false); sB = __builtin_amdgcn_sdot4((int)(W_).y, xq[(B_) + 1], sB, false); \
                     sA = __builtin_amdgcn_sdot4((int)(W_).z, xq[(B_) + 2], sA, false); sB = __builtin_amdgcn_sdot4((int)(W_).w, xq[(B_) + 3], sB, false); }
#define UCOMP(S, kk) { int sA = 0, sB = 0; D4(S##0, 0) D4(S##1, 4) D4(S##2, 8) D4(S##3, 12)                                               \
                       hraw[gq * 128 + (kk)] = row16_sum((float)(sA + sB)); }
            ULOAD(ra, 0) ULOAD(rb, 1) ULOAD(rc, 2)
#pragma unroll 1
            for (int k = 0; k < 128; k += 4) {
                const int kn = (k + 4 < 128) ? k + 4 : 124;
                ULOAD(rd, k + 3)  UCOMP(ra, k)
                ULOAD(ra, kn)     UCOMP(rb, k + 1)
                ULOAD(rb, kn + 1) UCOMP(rc, k + 2)
                ULOAD(rc, kn + 2) UCOMP(rd, k + 3)
            }
#undef D4
#undef ULOAD
#undef UCOMP
        }
        WAVE_LDS_SYNC();
#pragma unroll
        for (int j = 0; j < 8; ++j) {
            const int idx = lane + 64 * j;
            const int e = exs[idx];
            gws[idx] = gws[idx] * gelu_tanh_fast(hraw[idx] * (xsc[idx >> 7] * USC[e])) * VSC[e];
        }
        WAVE_LDS_SYNC();
#pragma unroll
        for (int i = 0; i < 2; ++i) ((uint4*)(SGW + (size_t)n0 * 128))[lane + 64 * i] = ((const uint4*)gws)[lane + 64 * i];
        }
        if (PART == 2) {
        WAVE_LDS_SYNC();
        {
            f32x2 acc[32];
#pragma unroll
            for (int q = 0; q < 32; ++q) acc[q] = (f32x2){0.f, 0.f};
            uint4 ra0, ra1, ra2, ra3, rb0, rb1, rb2, rb3, rc0, rc1, rc2, rc3, rd0, rd1, rd2, rd3;
#define VLOAD(S, kk) { const int e_ = exs[gq * 128 + (kk)]; const uint4* vr_ = (const uint4*)(V8 + (size_t)e_ * DM + 16 * l16);          \
                       S##0 = vr_[0]; S##1 = vr_[16]; S##2 = vr_[32]; S##3 = vr_[48]; }
#define A4(W_, B_) { acc[(B_)] = __builtin_elementwise_fma(__builtin_amdgcn_cvt_pk_f32_fp8((int)(W_), false), wk2, acc[(B_)]);          \
                     acc[(B_) + 1] = __builtin_elementwise_fma(__builtin_amdgcn_cvt_pk_f32_fp8((int)(W_), true), wk2, acc[(B_) + 1]); }
#define VCOMP(S, kk) { const float wk = gws[gq * 128 + (kk)]; const f32x2 wk2 = (f32x2){wk, wk};                                         \
                       A4((S##0).x, 0) A4((S##0).y, 2) A4((S##0).z, 4) A4((S##0).w, 6) A4((S##1).x, 8) A4((S##1).y, 10) A4((S##1).z, 12) A4((S##1).w, 14) \
                       A4((S##2).x, 16) A4((S##2).y, 18) A4((S##2).z, 20) A4((S##2).w, 22) A4((S##3).x, 24) A4((S##3).y, 26) A4((S##3).z, 28) A4((S##3).w, 30) }
            VLOAD(ra, 0) VLOAD(rb, 1) VLOAD(rc, 2)
#pragma unroll 1
            for (int k = 0; k < 128; k += 4) {
                const int kn = (k + 4 < 128) ? k + 4 : 124;
                VLOAD(rd, k + 3)  VCOMP(ra, k)
                VLOAD(ra, kn)     VCOMP(rb, k + 1)
                VLOAD(rb, kn + 1) VCOMP(rc, k + 2)
                VLOAD(rc, kn + 2) VCOMP(rd, k + 3)
            }
#undef VLOAD
#undef VCOMP
#undef A4
            float* orow = p.out + (size_t)(n0 + gq) * DM + 16 * l16;
            float sum = 0.f;
#pragma unroll
            for (int c = 0; c < 4; ++c)
#pragma unroll
                for (int hq = 0; hq < 4; ++hq) {
                    const uint2 hb_ = *(const uint2*)(H1B + (size_t)(n0 + gq) * DM + 16 * l16 + 256 * c + 4 * hq);
                    const float4 h = make_float4(__uint_as_float(hb_.x << 16), __uint_as_float(hb_.x & 0xffff0000u),
                                                 __uint_as_float(hb_.y << 16), __uint_as_float(hb_.y & 0xffff0000u));
                    f32x2& pa = acc[8 * c + 2 * hq]; f32x2& pb = acc[8 * c + 2 * hq + 1];
                    pa[0] = ALPHA * h.x + pa[0]; pa[1] = ALPHA * h.y + pa[1]; pb[0] = ALPHA * h.z + pb[0]; pb[1] = ALPHA * h.w + pb[1];
                    sum += (pa[0] + pa[1]) + (pb[0] + pb[1]);
                }
            const float mu = row16_sum(sum) * (1.f / 1024.f);
            float sq = 0.f;
#pragma unroll
            for (int q = 0; q < 32; ++q) { acc[q][0] -= mu; acc[q][1] -= mu; sq += acc[q][0] * acc[q][0] + acc[q][1] * acc[q][1]; }
            const float rs = rsqrtf(row16_sum(sq) * (1.f / 1024.f) + LN_EPS);
            const float* g = p.in[22] + 16 * l16;
            const float* bb = p.in[23] + 16 * l16;
#pragma unroll
            for (int c = 0; c < 4; ++c)
#pragma unroll
                for (int hq = 0; hq < 4; ++hq) {
                    const float4 gg = *(const float4*)(g + 256 * c + 4 * hq), b4 = *(const float4*)(bb + 256 * c + 4 * hq);
                    const f32x2 pa = acc[8 * c + 2 * hq], pb = acc[8 * c + 2 * hq + 1];
                    float4 o;
                    o.x = pa[0] * rs * gg.x + b4.x; o.y = pa[1] * rs * gg.y + b4.y;
                    o.z = pb[0] * rs * gg.z + b4.z; o.w = pb[1] * rs * gg.w + b4.w;
                    *(float4*)(orow + 256 * c + 4 * hq) = o;
                }
        }
        }
    }
}

#define XB_TMO      128
#define XB_XCNT(j)  (256  + 64 * (j))
#define XB_XSUB(j)  (1280 + 64 * (j))
#define XB_XGEN(j)  (2304 + 64 * (j))
#define XB_TOP      3328
#define XB_TOPGEN   3392
#define XCD_BAR_WORDS 3456
#define XB_SPIN_CAP (1u << 22)
__device__ __forceinline__ unsigned xb_ld(unsigned* p) { return __hip_atomic_load(p, __ATOMIC_RELAXED, __HIP_MEMORY_SCOPE_AGENT); }
__device__ __forceinline__ unsigned xb_add(unsigned* p, unsigned v) { return __hip_atomic_fetch_add(p, v, __ATOMIC_RELAXED, __HIP_MEMORY_SCOPE_AGENT); }
__device__ __forceinline__ unsigned xb_xcc_id() { return (unsigned)__builtin_amdgcn_s_getreg((3 << 11) | 20) & 0xFu; }
#define XB_SPIN(cond, bar) do { unsigned _sp = 0; while (cond) { __builtin_amdgcn_s_sleep(1); \
    if ((++_sp & 255u) == 0u) { if (xb_ld(&(bar)[XB_TMO])) break; if (_sp > XB_SPIN_CAP) { atomicAdd(&(bar)[XB_TMO], 1u); break; } } } } while (0)
struct XcdBarrier { unsigned* bar; unsigned x; unsigned* st; };
__device__ __forceinline__ XcdBarrier xcd_barrier_post(unsigned* bar, unsigned* st) {
    XcdBarrier b; b.bar = bar; b.x = xb_xcc_id(); b.st = st;
    if (threadIdx.x == 0) (void)xb_add(&bar[XB_XCNT(b.x)], 1u);
    return b;
}
__device__ __forceinline__ void xcd_barrier_complete(unsigned* bar, unsigned x, unsigned& nloc, unsigned& nx) {
    const unsigned G = gridDim.x * gridDim.y * gridDim.z;
    unsigned sum, cnt, mine, sp = 0u;
    for (;;) {
        sum = 0u; cnt = 0u; mine = 0u;
#pragma unroll
        for (unsigned j = 0; j < 16; ++j) { const unsigned c = xb_ld(&bar[XB_XCNT(j)]); sum += c; cnt += (c > 0u) ? 1u : 0u; mine = (j == x) ? c : mine; }
        if (sum == G) break;
        __builtin_amdgcn_s_sleep(1);
        if ((++sp & 255u) == 0u) { if (xb_ld(&bar[XB_TMO])) break; if (sp > XB_SPIN_CAP) { atomicAdd(&bar[XB_TMO], 1u); break; } }
    }
    nloc = mine > 0u ? mine : 1u; nx = cnt > 0u ? cnt : 1u;
}
__device__ __forceinline__ void xcd_barrier(const XcdBarrier& b) {
    asm volatile("s_waitcnt vmcnt(0)" ::: "memory");
    __syncthreads();
    if (threadIdx.x == 0) {
        unsigned* bar = b.bar;
        __builtin_amdgcn_s_waitcnt(0);
        unsigned nloc = xb_ld(&b.st[0]), nx = xb_ld(&b.st[1]);
        if (nloc == 0u) { xcd_barrier_complete(bar, b.x, nloc, nx); __hip_atomic_store(&b.st[0], nloc, __ATOMIC_RELAXED, __HIP_MEMORY_SCOPE_AGENT); __hip_atomic_store(&b.st[1], nx, __ATOMIC_RELAXED, __HIP_MEMORY_SCOPE_AGENT); }
        const unsigned old = xb_add(&bar[XB_XSUB(b.x)], 1u);
        const unsigned gen = old / nloc;
        if (old + 1u == (gen + 1u) * nloc) {
            __builtin_amdgcn_fence(__ATOMIC_RELEASE, "agent");
            asm volatile("s_waitcnt vmcnt(0)" ::: "memory");
            const unsigned og = xb_add(&bar[XB_TOP], 1u);
            const unsigned tg = og / nx;
            if (og + 1u == (tg + 1u) * nx) xb_add(&bar[XB_TOPGEN], 1u);
            else XB_SPIN(xb_ld(&bar[XB_TOPGEN]) == tg, bar);
            __builtin_amdgcn_fence(__ATOMIC_ACQUIRE, "agent");
            xb_add(&bar[XB_XGEN(b.x)], 1u);
            asm volatile("s_waitcnt vmcnt(0)" ::: "memory");
        } else {
            XB_SPIN(xb_ld(&bar[XB_XGEN(b.x)]) == gen, bar);
            __builtin_amdgcn_fence(__ATOMIC_ACQUIRE, "agent");
            asm volatile("s_waitcnt vmcnt(0)" ::: "memory");
        }
    }
    __syncthreads();
}

__global__ void __launch_bounds__(256, 2) mega(Params p) {
    cg::grid_group grid = cg::this_grid();
    __shared__ __attribute__((aligned(16))) unsigned char smem[81920];
    float* sm = (float*)smem;
    unsigned* barw = (unsigned*)(p.ws + OFF_BAR);
    const XcdBarrier xbar = xcd_barrier_post(barw, barw + XCD_BAR_WORDS + 2 * blockIdx.x);
    bf16_t* XB = (bf16_t*)(p.ws + OFF_XB);
    bf16_t* WinT = (bf16_t*)(p.ws + OFF_WINT);
    bf16_t* WoutT = (bf16_t*)(p.ws + OFF_WOUTT);
    bf16_t* WqT = (bf16_t*)(p.ws + OFF_WQT);
    cvt_rows_bf16(p.in[0], XB, (size_t)NTOK * DM / 8);
    transpose_bf16(p.in[1], DIN, 3456, WinT);
    transpose_bf16(p.in[2], DM, DM, WoutT);
    fold_ws_phase(p.in[17], p.in[18], p.in[19], WqT);
    transpose_bf16(p.in[6], 256, 256, (bf16_t*)(p.ws + OFF_W1T), 2048);
    transpose_bf16(p.in[11], 256, 256, (bf16_t*)(p.ws + OFF_W1T) + 256 * 2048, 2048);
    if (blockIdx.x == 0) {
        for (int c = threadIdx.x; c < 512; c += 256)
            ((float*)(p.ws + OFF_LBV))[c] = 1.f / (1.f + expf(p.in[3][512 + c] - p.in[3][c]));
        if (threadIdx.x < 16) ((float*)(p.ws + OFF_DIAG))[threadIdx.x] = 0.f;
    }
    if (blockIdx.x >= 8 && blockIdx.x < 72) cmp_peb_partial(p, blockIdx.x - 8);
    grid.sync();
    if (blockIdx.x == gridDim.x - 1) cmp_peb_reduce(p);
    gemm_bf16_phase3(XB, DM, WinT, DM, NTOK / 256, 27, smem, EpiProj{p.ws});
    xcd_barrier(xbar);
    for (int it = blockIdx.x; it < 128; it += gridDim.x) {
        const int which = it >> 6, t = it & 63;
        gemm_tile(ALoadCmp{(const bf16_t*)(p.ws + OFF_KV + (size_t)which * KV_STRIDE)},
                  (const bf16_t*)(p.ws + OFF_W1T) + (size_t)which * 256 * 2048, 2048, 32, (t >> 1) * 128, (t & 1) * 128, smem,
                  EpiCmpH{(bf16_t*)(p.ws + OFF_HB) + (size_t)which * 4096 * 256, (const float*)(p.ws + OFF_PEB) + which * 256});
    }
    if (gridDim.x >= 256) {
        if (blockIdx.x >= 128)
            for (int it = blockIdx.x - 128; it < 2048; it += gridDim.x - 128) hgrn_passA(p, it, smem);
    } else {
        for (int it = blockIdx.x; it < 2048; it += gridDim.x) hgrn_passA(p, it, smem);
    }
#if NSA_DIAG
    for (int it = blockIdx.x; it < 2 * 4 * NCB * 2; it += gridDim.x) compress_item(p, it, sm);
#endif
    xcd_barrier(xbar);
    if (blockIdx.x < 256) hgrn_scan_item(p, blockIdx.x);
    else {
        cvt_rows_i8(p.in[20], p.ws + OFF_UB, (float*)(p.ws + OFF_USC), 16384, 256, gridDim.x - 256);
        cvt_rows_fp8(p.in[21], p.ws + OFF_VB, (float*)(p.ws + OFF_VSC), 16384, 256, gridDim.x - 256);
    }
    if (gridDim.x <= 256) {
        cvt_rows_i8(p.in[20], p.ws + OFF_UB, (float*)(p.ws + OFF_USC), 16384, 0, gridDim.x);
        cvt_rows_fp8(p.in[21], p.ws + OFF_VB, (float*)(p.ws + OFF_VSC), 16384, 0, gridDim.x);
    }
    cmp_layer2_phase(p, 0, gridDim.x);
    xcd_barrier(xbar);
    {
        const int qi = blockIdx.x & 7;
        unsigned* qctr = barw + XCD_BAR_WORDS + 2 * 1024 + 64 * qi;
        for (;;) {
            __syncthreads();
            if (threadIdx.x == 0) *(volatile unsigned*)smem = atomicAdd(qctr, 1u);
            __syncthreads();
            const int it = (int)__builtin_amdgcn_readfirstlane(*(volatile unsigned*)smem);
            if (it >= 256) break;
            nsa_tile(p, (it << 3) | qi, smem);
        }
        for (;;) {
            __syncthreads();
            if (threadIdx.x == 0) *(volatile unsigned*)smem = atomicAdd(qctr + 32, 1u);
            __syncthreads();
            const int it = (int)__builtin_amdgcn_readfirstlane(*(volatile unsigned*)smem);
            if (it >= 256) break;
            hgrn_passC(p, (it << 3) | qi, smem);
        }
    }
    xcd_barrier(xbar);
#if NSA_DIAG
    for (int it = blockIdx.x; it < 4 * 2 * SEQ; it += gridDim.x) nsa_item(p, it, sm);
    grid.sync();
    {
        const float* DG = (const float*)(p.ws + OFF_DIAG);
#if NSA_DIAG == 1
        const float cval = -log10f(sqrtf(DG[0] / DG[1]) + 1e-9f);
#else
        const float cval = -log10f(DG[2] / DG[3] + 1e-6f);
#endif
        for (size_t i = (size_t)blockIdx.x * 256 + threadIdx.x; i < (size_t)NTOK * DM; i += (size_t)gridDim.x * 256) p.out[i] = cval;
        return;
    }
#endif
    gemm_bf16_phase3(XB, DM, WoutT, DM, NTOK / 256, 8, smem, EpiMix{(bf16_t*)p.out});
    xcd_barrier(xbar);
    ln1_phase(p, sm);
    xcd_barrier(xbar);
    gemm_bf16_phase3(XB, DM, WqT, DM, NTOK / 256, 16, smem, EpiTop16{(float*)(p.ws + OFF_TOPK), smem});
    xcd_barrier(xbar);
    peer_fast_phase<0>(p, smem);
    peer_fast_phase<1>(p, smem);
    peer_fast_phase<2>(p, smem);
}

extern "C" void kernel_launch(void* const* d_in, const int* in_sizes, int n_in, void* d_out, int out_size,
                              void* d_ws, size_t ws_size, hipStream_t stream) {
    static int grid_blocks = 0;
    if (!grid_blocks) {
        int dev = 0, cus = 0, per_cu = 0;
        hipGetDevice(&dev);
        hipDeviceGetAttribute(&cus, hipDeviceAttributeMultiprocessorCount, dev);
        hipOccupancyMaxActiveBlocksPerMultiprocessor(&per_cu, mega, 256, 0);
        if (per_cu > 4) per_cu = 4;
        if (per_cu < 1) per_cu = 1;
        grid_blocks = cus * per_cu;
        if (n_in != 24 || ws_size < WS_NEED || out_size != NTOK * DM)
            fprintf(stderr, "kernel_launch: unexpected sizes n_in=%d ws=%zu out=%d\n", n_in, ws_size, out_size);
    }
    Params p;
    memset(&p, 0, sizeof(p));
    for (int i = 0; i < 24; ++i) p.in[i] = (const float*)d_in[i];
    p.out = (float*)d_out;
    p.ws = (unsigned char*)d_ws;
    hipMemsetAsync((char*)d_ws + OFF_BAR, 0, BAR_BYTES, stream);
    void* args[] = {&p};
    hipError_t e = hipLaunchCooperativeKernel((void*)mega, dim3(grid_blocks), dim3(256), args, 0, stream);
    if (e != hipSuccess) fprintf(stderr, "cooperative launch failed: %s (grid %d)\n", hipGetErrorString(e), grid_blocks);
}
```
